# Optimizing an MI355X kernel written in HIP

```python
import math
import jax, jax.numpy as jnp
from jax import lax
import numpy as np

D_MODEL = 1024
BATCH = 8
SEQ = 4096
DEPTH = 2

HEAD_DIM = 64
A_GROUPS = ((128, 1), (512, 4), (2048, 16))
A_HEADS = 4
A_WIDTH = len(A_GROUPS) * A_HEADS * HEAD_DIM
A_OUT = A_HEADS * HEAD_DIM
B_HEADS = 16
B_KV_HEADS = 4
B_Q = B_HEADS * HEAD_DIM
B_KV = B_KV_HEADS * HEAD_DIM
Q_BLOCK = 128
GRID_W = 64
ROPE_THETA = 10000.0
N_BRANCH = 2
N_IN = 3 * A_WIDTH + B_Q + 2 * B_KV + N_BRANCH * D_MODEL
REL_BUCKETS = 32
REL_MAX_DIST = 1024
N_EXPERTS = 32
TOP_K = 4
D_EXPERT = D_MODEL
SWIGLU_LIMIT = 7.0
SWIGLU_ALPHA = 1.702
MOE_BLOCK = 512
N_MOD = 6
EPS = 1e-6
NEG_INF = -1e30

kernel_name = "hybrid_dilated_gqa_moe_encoder"


def _rmsnorm(x, g):
    xf = x.astype(jnp.float32)
    y = xf * lax.rsqrt(jnp.mean(xf * xf, axis=-1, keepdims=True) + EPS)
    return (y * g.astype(jnp.float32)).astype(x.dtype)


def _modulate(h, shift, scale):
    return h * (1.0 + scale[:, None, :]) + shift[:, None, :]


def _t5_bucket(rel):
    nb = REL_BUCKETS // 2
    max_exact = nb // 2
    ret = jnp.where(rel > 0, nb, 0)
    n = jnp.abs(rel)
    nf = jnp.maximum(n, 1).astype(jnp.float32)
    large = max_exact + (jnp.log(nf / max_exact) / math.log(REL_MAX_DIST / max_exact)
                         * (nb - max_exact)).astype(jnp.int32)
    large = jnp.minimum(large, nb - 1)
    return ret + jnp.where(n < max_exact, n, large)


def _dilated_window_attention(q, k, v, bias_tab, dilation, n_side):
    bsz, s, h, dh = q.shape
    L = s // dilation
    nb = n_side
    nblk = -(-L // nb)
    lp = nblk * nb

    def fold(t):
        return t.reshape(bsz, L, dilation, h, dh).swapaxes(1, 2).reshape(bsz * dilation, L, h, dh)

    qf, kf, vf = fold(q), fold(k), fold(v)
    qb = jnp.pad(qf, ((0, 0), (0, lp - L), (0, 0), (0, 0))).reshape(-1, nblk, nb, h, dh)

    def band(t):
        tp = jnp.pad(t, ((0, 0), (nb, lp - L + nb), (0, 0), (0, 0))).reshape(-1, nblk + 2, nb, h, dh)
        return jnp.concatenate([tp[:, :-2], tp[:, 1:-1], tp[:, 2:]], axis=2)

    kb, vb = band(kf), band(vf)
    rel = jnp.arange(3 * nb)[None, :] - nb - jnp.arange(nb)[:, None]
    key_idx = jnp.arange(nblk)[:, None] * nb + jnp.arange(3 * nb)[None, :] - nb
    mask = (jnp.abs(rel) <= n_side)[None] & ((key_idx >= 0) & (key_idx < L))[:, None, :]
    bias = jnp.transpose(bias_tab[_t5_bucket(rel * dilation)], (2, 0, 1)).astype(jnp.float32)

    scores = jnp.einsum('bnqhd,bnkhd->bnhqk', qb, kb).astype(jnp.float32) * (dh ** -0.5) + bias
    scores = jnp.where(mask[None, :, None], scores, NEG_INF)
    m = jnp.max(scores, axis=-1, keepdims=True)
    p = jnp.exp(scores - m)
    den = jnp.sum(p, axis=-1)
    o = jnp.einsum('bnhqk,bnkhd->bnqhd', p.astype(v.dtype), vb)
    o = o / jnp.transpose(den, (0, 1, 3, 2))[..., None].astype(o.dtype)
    lse = jnp.transpose(m[..., 0] + jnp.log(den), (0, 1, 3, 2))
    o = o.reshape(-1, lp, h, dh)[:, :L]
    lse = lse.reshape(-1, lp, h)[:, :L]
    o = o.reshape(bsz, dilation, L, h, dh).swapaxes(1, 2).reshape(bsz, s, h, dh)
    lse = lse.reshape(bsz, dilation, L, h).swapaxes(1, 2).reshape(bsz, s, h)
    return o, lse


def _mixer_dilated(za, rel_bias):
    bsz, s, _ = za.shape
    za = za.reshape(bsz, s, len(A_GROUPS), 3, A_HEADS, HEAD_DIM)
    outs, lses = [], []
    for g, (window, dilation) in enumerate(A_GROUPS):
        n_side = window // (2 * dilation)
        o, lse = _dilated_window_attention(za[:, :, g, 0], za[:, :, g, 1], za[:, :, g, 2],
                                           rel_bias[:, g * A_HEADS:(g + 1) * A_HEADS],
                                           dilation, n_side)
        outs.append(o)
        lses.append(lse)
    alpha = jax.nn.softmax(jnp.stack(lses, axis=0), axis=0)
    o = jnp.einsum('gbsh,gbshd->bshd', alpha.astype(outs[0].dtype), jnp.stack(outs, axis=0))
    return o.reshape(bsz, s, A_OUT)


def _axial_rope_tables(seq):
    n_rows = seq // GRID_W
    row = jnp.repeat(jnp.arange(n_rows), GRID_W).astype(jnp.float32)
    col = (jnp.arange(seq) % GRID_W).astype(jnp.float32)
    half = HEAD_DIM // 2
    inv = ROPE_THETA ** (-jnp.arange(0, half, 2, dtype=jnp.float32) / half)
    ang_r = row[:, None] * inv
    ang_c = col[:, None] * inv
    return jnp.cos(ang_r), jnp.sin(ang_r), jnp.cos(ang_c), jnp.sin(ang_c)


def _rotate(u, cos, sin):
    u1, u2 = jnp.split(u, 2, axis=-1)
    cos = cos[None, :, None, :]
    sin = sin[None, :, None, :]
    return jnp.concatenate([u1 * cos - u2 * sin, u2 * cos + u1 * sin], axis=-1)


def _axial_rope(x, tabs):
    cr, sr, cc, sc = tabs
    half = HEAD_DIM // 2
    xf = x.astype(jnp.float32)
    y = jnp.concatenate([_rotate(xf[..., :half], cr, sr), _rotate(xf[..., half:], cc, sc)], axis=-1)
    return y.astype(x.dtype)


def _mixer_gqa(zq, zk, zv, q_g, k_g, tabs):
    bsz, s, _ = zq.shape
    grp = B_HEADS // B_KV_HEADS
    q = _axial_rope(_rmsnorm(zq.reshape(bsz, s, B_HEADS, HEAD_DIM), q_g), tabs)
    k = _axial_rope(_rmsnorm(zk.reshape(bsz, s, B_KV_HEADS, HEAD_DIM), k_g), tabs)
    v = zv.reshape(bsz, s, B_KV_HEADS, HEAD_DIM)
    qb = q.reshape(bsz, s // Q_BLOCK, Q_BLOCK, B_KV_HEADS, grp, HEAD_DIM).transpose(1, 0, 2, 3, 4, 5)
    scale = HEAD_DIM ** -0.5

    def block(qblk):
        sc = jnp.einsum('bqhgd,bkhd->bhgqk', qblk, k).astype(jnp.float32) * scale
        p = jax.nn.softmax(sc, axis=-1)
        return jnp.einsum('bhgqk,bkhd->bqhgd', p.astype(v.dtype), v)

    o = lax.map(block, qb)
    return o.transpose(1, 0, 2, 3, 4, 5).reshape(bsz, s, B_Q)


def _moe(h, w_router, b_router, w_gu, b_gu, w_dn, b_dn):
    bsz, s, d = h.shape
    t = bsz * s
    ht = h.reshape(t, d)
    logits = (ht @ w_router + b_router).astype(jnp.float32)
    top_v, top_e = lax.top_k(logits, TOP_K)
    gates = jax.nn.softmax(top_v, axis=-1)
    n_assign = t * TOP_K
    e_flat = top_e.reshape(n_assign)
    tok_flat = jnp.repeat(jnp.arange(t, dtype=jnp.int32), TOP_K)
    w_flat = gates.reshape(n_assign)
    order = jnp.argsort(e_flat)
    e_s, tok_s, w_s = e_flat[order], tok_flat[order], w_flat[order]
    sizes = jax.ops.segment_sum(jnp.ones((n_assign,), jnp.int32), e_flat, num_segments=N_EXPERTS)
    starts = jnp.cumsum(sizes) - sizes
    padded = (sizes + MOE_BLOCK - 1) // MOE_BLOCK * MOE_BLOCK
    pad_end = jnp.cumsum(padded)
    pad_start = pad_end - padded
    dest = pad_start[e_s] + (jnp.arange(n_assign, dtype=jnp.int32) - starts[e_s])
    n_blocks = -(-n_assign // MOE_BLOCK) + N_EXPERTS
    cap = n_blocks * MOE_BLOCK
    buf_tok = jnp.zeros((cap,), jnp.int32).at[dest].set(tok_s)
    buf_w = jnp.zeros((cap,), jnp.float32).at[dest].set(w_s)
    blk_e = jnp.minimum(jnp.searchsorted(pad_end, jnp.arange(n_blocks) * MOE_BLOCK, side='right'),
                        N_EXPERTS - 1).astype(jnp.int32)

    def expert_block(args):
        tok_idx, e = args
        xb = ht[tok_idx]
        gu = xb @ w_gu[e] + b_gu[e]
        x_glu, x_lin = jnp.split(gu, 2, axis=-1)
        x_glu = jnp.minimum(x_glu, SWIGLU_LIMIT)
        x_lin = jnp.clip(x_lin, -SWIGLU_LIMIT, SWIGLU_LIMIT)
        act = x_glu * jax.nn.sigmoid(SWIGLU_ALPHA * x_glu) * (x_lin + 1.0)
        return act @ w_dn[e] + b_dn[e]

    out = lax.map(expert_block, (buf_tok.reshape(n_blocks, MOE_BLOCK), blk_e)).reshape(cap, d)
    y = jnp.zeros((t, d), h.dtype).at[buf_tok].add(out * buf_w[:, None].astype(out.dtype))
    return y.reshape(bsz, s, d)


def setup_inputs(seed: int = 0) -> dict:
    key = jax.random.key(seed)
    ks = jax.random.split(key, 22)
    f32 = jnp.float32

    def nrm(k, shape, scale):
        return jax.random.normal(k, shape, f32) * scale

    return {
        "x": nrm(ks[0], (BATCH, SEQ, D_MODEL), 1.0),
        "c": nrm(ks[1], (BATCH, D_MODEL), 1.0),
        "w_ada": nrm(ks[2], (DEPTH, D_MODEL, N_MOD * D_MODEL), 0.5 * D_MODEL ** -0.5),
        "b_ada": nrm(ks[3], (DEPTH, N_MOD * D_MODEL), 0.02),
        "norm1_g": 1.0 + nrm(ks[4], (DEPTH, D_MODEL), 0.01),
        "w_in": nrm(ks[5], (DEPTH, D_MODEL, N_IN), D_MODEL ** -0.5),
        "q_norm_g": 1.0 + nrm(ks[6], (DEPTH, HEAD_DIM), 0.01),
        "k_norm_g": 1.0 + nrm(ks[7], (DEPTH, HEAD_DIM), 0.01),
        "rel_bias": nrm(ks[8], (REL_BUCKETS, len(A_GROUPS) * A_HEADS), 0.5),
        "w_br_a": nrm(ks[9], (DEPTH, A_OUT, D_MODEL), A_OUT ** -0.5),
        "w_br_b": nrm(ks[10], (DEPTH, B_Q, D_MODEL), B_Q ** -0.5),
        "w_out": nrm(ks[11], (DEPTH, D_MODEL, D_MODEL), D_MODEL ** -0.5),
        "norm2_g": 1.0 + nrm(ks[12], (DEPTH, D_MODEL), 0.01),
        "w_router": nrm(ks[13], (DEPTH, D_MODEL, N_EXPERTS), D_MODEL ** -0.5),
        "b_router": nrm(ks[14], (DEPTH, N_EXPERTS), 0.01),
        "w_gate_up": nrm(ks[15], (DEPTH, N_EXPERTS, D_MODEL, 2 * D_EXPERT), D_MODEL ** -0.5),
        "b_gate_up": nrm(ks[16], (DEPTH, N_EXPERTS, 2 * D_EXPERT), 0.01),
        "w_down": nrm(ks[17], (DEPTH, N_EXPERTS, D_EXPERT, D_MODEL), D_EXPERT ** -0.5),
        "b_down": nrm(ks[18], (DEPTH, N_EXPERTS, D_MODEL), 0.01),
        "final_norm_g": 1.0 + nrm(ks[19], (D_MODEL,), 0.01),
    }


def reference(x, c, w_ada, b_ada, norm1_g, w_in, q_norm_g, k_norm_g, rel_bias, w_br_a, w_br_b,
              w_out, norm2_g, w_router, b_router, w_gate_up, b_gate_up, w_down, b_down,
              final_norm_g):
    bsz, s, d = x.shape
    tabs = _axial_rope_tables(s)
    c_act = jax.nn.silu(c)
    cuts = np.cumsum([3 * A_WIDTH, B_Q, B_KV, B_KV]).tolist()
    for l in range(DEPTH):
        mod = c_act @ w_ada[l] + b_ada[l]
        sh1, sc1, g1, sh2, sc2, g2 = jnp.split(mod, N_MOD, axis=-1)
        h = _modulate(_rmsnorm(x, norm1_g[l]), sh1, sc1)
        z = h @ w_in[l]
        za, zq, zk, zv, zg = jnp.split(z, cuts, axis=-1)
        o_a = _mixer_dilated(za, rel_bias)
        o_b = _mixer_gqa(zq, zk, zv, q_norm_g[l], k_norm_g[l], tabs)
        gate = jax.nn.sigmoid(zg.astype(jnp.float32)).astype(x.dtype).reshape(bsz, s, N_BRANCH, d)
        merged = gate[:, :, 0] * (o_a @ w_br_a[l]) + gate[:, :, 1] * (o_b @ w_br_b[l])
        x = x + g1[:, None, :] * (merged @ w_out[l])
        h2 = _modulate(_rmsnorm(x, norm2_g[l]), sh2, sc2)
        x = x + g2[:, None, :] * _moe(h2, w_router[l], b_router[l], w_gate_up[l], b_gate_up[l],
                                      w_down[l], b_down[l])
    return _rmsnorm(x, final_norm_g)
```

```cpp
#include <hip/hip_runtime.h>
#include <hip/hip_bf16.h>
#include <cstdio>
#include <cstdint>
#include <cmath>

#ifndef PH_KIND_MASK
#define PH_KIND_MASK 0xFFF
#endif
#ifndef MK_PER_PHASE
#define MK_PER_PHASE 0
#endif

constexpr int NB = 8, SEQ = 4096, T = NB * SEQ, D = 1024, DEPTH = 2;
constexpr int N_IN = 5888, NE = 32, TOPK = 4;
constexpr int NASSIGN = T * TOPK;
constexpr int MAX_MT = NASSIGN / 256 + NE;
constexpr int CAP_ROWS = MAX_MT * 256;
constexpr float C2 = 0.125f * 1.4426950408889634f;
constexpr float LOG2E = 1.4426950408889634f;
constexpr float EPS = 1e-6f;

__device__ __forceinline__ int lane_id_asm() { int l; asm volatile("v_mbcnt_lo_u32_b32 %0, -1, 0\n\tv_mbcnt_hi_u32_b32 %0, -1, %0" : "=v"(l)); return l; }

template <int M> __device__ __forceinline__ float xsum(float v) {
    if constexpr (M < 32) return v + __int_as_float(__builtin_amdgcn_ds_swizzle(__float_as_int(v), 0x1f | (M << 10)));
    else { auto rr = __builtin_amdgcn_permlane32_swap(__float_as_uint(v), __float_as_uint(v), false, false); return __uint_as_float(rr[0]) + __uint_as_float(rr[1]); }
}
template <class Tv> __device__ __forceinline__ Tv xget32(Tv v, int hf) {
    auto rr = __builtin_amdgcn_permlane32_swap(__builtin_bit_cast(unsigned, v), __builtin_bit_cast(unsigned, v), false, false); return __builtin_bit_cast(Tv, hf ? rr[0] : rr[1]);
}

namespace pg8 {
#define PG8_LAS __attribute__((address_space(3)))
typedef unsigned short bf16_t;
typedef short bf16x8 __attribute__((ext_vector_type(8)));
typedef float f32x4 __attribute__((ext_vector_type(4)));
typedef unsigned u32x4 __attribute__((ext_vector_type(4)));
typedef unsigned u32x2 __attribute__((ext_vector_type(2)));
constexpr int BM = 256, BK = 64, HALF = 128, HTB = HALF * BK * 2, STAGE_BYTES = 8 * HTB, NXCD = 8, WGM = 8;

__host__ __device__ __forceinline__ int lds_byte(int r, int c) { const int st = (r >> 4) * 2 + (c >> 5), rr = r & 15, cc = c & 31, ob = rr * 64 + cc * 2; return st * 1024 + (ob ^ (((ob >> 9) & 1) << 5)); }
__host__ __device__ __forceinline__ void stage_rc(int b, int& R, int& C) { const int st = b / 1024, sb = b % 1024, swz = sb ^ (((sb >> 9) & 1) << 5); R = (st >> 1) * 16 + swz / 64; C = (st & 1) * 32 + (swz % 64) / 2; }
__host__ __device__ __forceinline__ int perm32(int rho) { const int n = rho >> 4, i = rho & 15; return 8 * (i >> 2) + 4 * n + (i & 3); }

struct Unit { int pm, pn; };
struct Gemm { const bf16_t* A; const bf16_t* Bt; int K; };

struct StaticOrder {
    int nM, nN, nwg, G, c;
    __device__ void init(int M, int N, int G_, int c_) { nM = M / BM; nN = N / BM; nwg = nM * nN; G = G_; c = c_; }
    __device__ bool next(int i, Unit& u) const {
        const long L = (long)i * G + c; if (L >= nwg) return false;
        int wgid = (int)L; { const int q = nwg / NXCD, r = nwg % NXCD, xcd = wgid % NXCD, off = wgid / NXCD; wgid = (xcd < r ? xcd * (q + 1) : r * (q + 1) + (xcd - r) * q) + off; }
        const int nig = WGM * nN, gid = wgid / nig, fm = gid * WGM, gsz = (nM - fm) < WGM ? (nM - fm) : WGM;
        u.pm = fm + ((wgid % nig) % gsz); u.pn = (wgid % nig) / gsz; return true;
    }
};
struct MoeOrder {
    const int* tile_e; int n_units, nN, G, vcu;
    __device__ bool next(int i, Unit& u) const {
        const long L = (long)i * G + vcu; if (L >= n_units) return false;
        const int mt = (int)L / nN, pl = (int)L % nN; const int e = __builtin_amdgcn_readfirstlane(__hip_atomic_load(tile_e + mt, __ATOMIC_RELAXED, __HIP_MEMORY_SCOPE_AGENT));
        u.pm = mt; u.pn = e * nN + pl; return true;
    }
};

__device__ __forceinline__ unsigned cvt_pk_bf16(float lo, float hi) { unsigned r; asm volatile("v_cvt_pk_bf16_f32 %0, %1, %2" : "=v"(r) : "v"(lo), "v"(hi)); return r; }
__device__ __forceinline__ float bf_lo(unsigned w) { return __uint_as_float(w << 16); }
__device__ __forceinline__ float bf_hi(unsigned w) { return __uint_as_float(w & 0xffff0000u); }
__device__ __forceinline__ float sigmoid_f(float x) { return __builtin_amdgcn_rcpf(1.0f + __builtin_amdgcn_exp2f(-LOG2E * x)); }

template <class Epi, class Sched>
__device__ __forceinline__ void gemm_phase(PG8_LAS unsigned char* lds, const Gemm g, const Sched& S, const Epi& E, const int wid_in) {
    int wid = wid_in; asm volatile("" : "+s"(wid));
    const int lane = lane_id_asm(), tid = wid * 64 + lane, wr = wid >> 2, wc = wid & 3, fr = lane & 15, fq = lane >> 4;
    const int K = g.K, nt = K / BK;
    unsigned voff[2];
#pragma unroll
    for (int i = 0; i < 2; ++i) { int R, C; stage_rc(tid * 16 + i * 8192, R, C); voff[i] = (unsigned)(R * K + C) * 2u; }
    const size_t kstep = (size_t)(BK * 2);
    const size_t hstep = (size_t)HALF * K * 2;
    const size_t tstep = 2 * hstep;
    const unsigned ldsw = (unsigned)wid * 1024u;
    const int aoff = lds_byte(wr * 64 + fr, fq * 8), boff = lds_byte(wc * 32 + fr, fq * 8);
#define PG8_SA(b, h) (((b) * 2 + (h)) * HTB)
#define PG8_SB(b, h) ((4 + (b) * 2 + (h)) * HTB)
#define PG8_STAGE(bufoff, gbase) do { _Pragma("unroll") for (int _i = 0; _i < 2; ++_i) \
        __builtin_amdgcn_global_load_lds((const unsigned*)((const char*)(gbase) + voff[_i]), (PG8_LAS unsigned*)(lds + (bufoff) + ldsw + _i * 8192), 16, 0, 0); } while (0)
#define PG8_LDA(dst, b, h) do { _Pragma("unroll") for (int m = 0; m < 4; ++m) _Pragma("unroll") for (int k = 0; k < 2; ++k) dst[m][k] = *(const PG8_LAS bf16x8*)(lds + PG8_SA(b, h) + aoff + m * 2048 + k * 1024); } while (0)
#define PG8_LDB(dst, b, h) do { _Pragma("unroll") for (int n = 0; n < 2; ++n) _Pragma("unroll") for (int k = 0; k < 2; ++k) dst[n][k] = *(const PG8_LAS bf16x8*)(lds + PG8_SB(b, h) + boff + n * 2048 + k * 1024); } while (0)
#define PG8_MMA(ai, bj, At, Bt) do { __builtin_amdgcn_s_setprio(1); _Pragma("unroll") for (int m = 0; m < 4; ++m) _Pragma("unroll") for (int n = 0; n < 2; ++n) _Pragma("unroll") for (int k = 0; k < 2; ++k) \
        acc[ai][bj][m][n] = __builtin_amdgcn_mfma_f32_16x16x32_bf16(Bt[n][k], At[m][k], acc[ai][bj][m][n], 0, 0, 0); __builtin_amdgcn_s_setprio(0); } while (0)
#define PG8_WAIT_V(n) asm volatile("s_waitcnt vmcnt(" #n ")" ::: "memory")
#define PG8_WAIT_L(n) asm volatile("s_waitcnt lgkmcnt(" #n ")" ::: "memory")
#define PG8_BAR __builtin_amdgcn_s_barrier()
#define PG8_SCHED __builtin_amdgcn_sched_barrier(0)
    Unit cur, nxt; int ui = 0;
    if (!S.next(0, cur)) return;
    f32x4 acc[2][2][4][2];
#pragma unroll
    for (int a = 0; a < 2; ++a)
#pragma unroll
        for (int b = 0; b < 2; ++b)
#pragma unroll
            for (int m = 0; m < 4; ++m)
#pragma unroll
                for (int n = 0; n < 2; ++n) acc[a][b][m][n] = (f32x4){0.f, 0.f, 0.f, 0.f};
    bf16x8 At[4][2], B0[2][2], B1[2][2];
    const char* cA = (const char*)g.A + (size_t)cur.pm * tstep; const char* cB = (const char*)g.Bt + (size_t)cur.pn * tstep;
    PG8_STAGE(PG8_SB(0, 0), cB); PG8_STAGE(PG8_SB(0, 1), cB + hstep); PG8_STAGE(PG8_SA(0, 0), cA); PG8_STAGE(PG8_SA(0, 1), cA + hstep);
    if (wr == 1) PG8_BAR;
    PG8_WAIT_V(2); PG8_BAR;
    PG8_STAGE(PG8_SB(1, 0), cB + kstep); PG8_STAGE(PG8_SA(1, 0), cA + kstep); PG8_STAGE(PG8_SB(1, 1), cB + hstep + kstep);
    PG8_WAIT_V(6); PG8_BAR;
    for (;;) {
        const bool has_next = S.next(ui + 1, nxt);
        const char* nA = has_next ? (const char*)g.A + (size_t)nxt.pm * tstep : cA; const char* nB = has_next ? (const char*)g.Bt + (size_t)nxt.pn * tstep : cB;
        for (int t = 0; t < nt; t += 2) {
            const bool last = (t == nt - 2);
            const char* a1 = cA + (size_t)(t + 1) * kstep;
            const char* a2 = last ? nA : cA + (size_t)(t + 2) * kstep; const char* b2 = last ? nB : cB + (size_t)(t + 2) * kstep;
            const char* a3 = a2 + kstep; const char* b3 = b2 + kstep;
            PG8_LDB(B0, 0, 0); PG8_LDB(B1, 0, 1); PG8_SCHED; PG8_LDA(At, 0, 0); PG8_STAGE(PG8_SA(1, 1), a1 + hstep);
            PG8_WAIT_V(8); PG8_WAIT_L(0); PG8_BAR; PG8_MMA(0, 0, At, B0); PG8_MMA(0, 1, At, B1); PG8_BAR; PG8_SCHED;
            PG8_LDA(At, 0, 1); PG8_STAGE(PG8_SB(0, 0), b2); PG8_STAGE(PG8_SB(0, 1), b2 + hstep); PG8_STAGE(PG8_SA(0, 0), a2);
            PG8_WAIT_V(8); PG8_WAIT_L(0); PG8_BAR; PG8_MMA(1, 0, At, B0); PG8_MMA(1, 1, At, B1); PG8_BAR; PG8_SCHED;
            PG8_LDB(B0, 1, 0); PG8_LDB(B1, 1, 1); PG8_SCHED; PG8_LDA(At, 1, 0); PG8_STAGE(PG8_SA(0, 1), a2 + hstep);
            PG8_WAIT_V(8); PG8_WAIT_L(0); PG8_BAR; PG8_MMA(0, 0, At, B0); PG8_MMA(0, 1, At, B1); PG8_BAR; PG8_SCHED;
            PG8_LDA(At, 1, 1); PG8_STAGE(PG8_SB(1, 0), b3); PG8_STAGE(PG8_SB(1, 1), b3 + hstep); PG8_STAGE(PG8_SA(1, 0), a3);
            PG8_WAIT_V(8); PG8_WAIT_L(0); PG8_BAR; PG8_MMA(1, 0, At, B0); PG8_MMA(1, 1, At, B1); PG8_BAR; PG8_SCHED;
        }
        if (wr == 0) PG8_BAR;
        E(acc, cur, wr, wc, fr, fq);
        if (!has_next) break;
#pragma unroll
        for (int a = 0; a < 2; ++a)
#pragma unroll
            for (int b = 0; b < 2; ++b)
#pragma unroll
                for (int m = 0; m < 4; ++m)
#pragma unroll
                    for (int n = 0; n < 2; ++n) acc[a][b][m][n] = (f32x4){0.f, 0.f, 0.f, 0.f};
        cur = nxt; cA = nA; cB = nB; ++ui;
        if (wr == 1) PG8_BAR;
    }
    PG8_WAIT_V(0);
    PG8_BAR;
#undef PG8_SA
#undef PG8_SB
#undef PG8_STAGE
#undef PG8_LDA
#undef PG8_LDB
#undef PG8_MMA
#undef PG8_WAIT_V
#undef PG8_WAIT_L
#undef PG8_BAR
#undef PG8_SCHED
}

#define EPI_ROWS(...) _Pragma("unroll") for (int ai = 0; ai < 2; ++ai) _Pragma("unroll") for (int m = 0; m < 4; ++m) { const int row = u.pm * BM + ai * HALF + wr * 64 + m * 16 + fr; __VA_ARGS__ }
__device__ __forceinline__ u32x4 pack8(const f32x4 a, const f32x4 b) { u32x4 w; w.x = cvt_pk_bf16(a[0], a[1]); w.y = cvt_pk_bf16(a[2], a[3]); w.z = cvt_pk_bf16(b[0], b[1]); w.w = cvt_pk_bf16(b[2], b[3]); return w; }

struct EpiIn {
    bf16_t* aqkv; bf16_t* qb; bf16_t* kb; bf16_t* vb; bf16_t* gate; const float* qg; const float* kg; const float* rope;
    __device__ __forceinline__ void operator()(const f32x4 (&acc)[2][2][4][2], const Unit& u, int wr, int wc, int fr, int fq) const {
        const int pn = u.pn;
        if (pn >= 9 && pn < 14) {
            const bool isq = pn < 13; const int head = isq ? (pn - 9) * 4 + wc : wc; bf16_t* dst = isq ? qb : kb; const int pitch = isq ? 1024 : 256;
            const float* gvec = isq ? qg : kg; const float osc = isq ? C2 : 1.0f;
            f32x4 gv[2][2];
#pragma unroll
            for (int bj = 0; bj < 2; ++bj)
#pragma unroll
                for (int n = 0; n < 2; ++n) gv[bj][n] = *(const f32x4*)(gvec + 32 * bj + 16 * n + 4 * fq);
            EPI_ROWS(
                float ss = 0.f;
                _Pragma("unroll") for (int bj = 0; bj < 2; ++bj) _Pragma("unroll") for (int n = 0; n < 2; ++n) { const f32x4 x = acc[ai][bj][m][n]; ss += (x[0] * x[0] + x[1] * x[1]) + (x[2] * x[2] + x[3] * x[3]); }
                ss = xsum<16>(ss); ss = xsum<32>(ss);
                const float sc = rsqrtf(ss * (1.0f / 64.0f) + EPS) * osc;
                const int t = row & (SEQ - 1);
                _Pragma("unroll") for (int bj = 0; bj < 2; ++bj) {
                    const int pos = bj == 0 ? (t >> 6) : (t & 63);
                    const f32x4 cs = *(const f32x4*)(rope + pos * 16 + 4 * fq); const f32x4 sn = *(const f32x4*)(rope + 1024 + pos * 16 + 4 * fq);
                    const f32x4 y0 = acc[ai][bj][m][0] * sc * gv[bj][0]; const f32x4 y1 = acc[ai][bj][m][1] * sc * gv[bj][1];
                    const f32x4 o0 = y0 * cs - y1 * sn; const f32x4 o1 = y1 * cs + y0 * sn;
                    bf16_t* p = dst + (size_t)row * pitch + head * 64 + 32 * bj + 4 * fq;
                    u32x2 w0; w0.x = cvt_pk_bf16(o0[0], o0[1]); w0.y = cvt_pk_bf16(o0[2], o0[3]);
                    u32x2 w1; w1.x = cvt_pk_bf16(o1[0], o1[1]); w1.y = cvt_pk_bf16(o1[2], o1[3]);
                    *(u32x2*)p = w0; *(u32x2*)(p + 16) = w1;
                }
            )
        } else {
            bf16_t* dst; int pitch, colt, dsh = 0; float sc = 1.0f; bool sig = false, fold = false;
            if (pn < 9) { dst = aqkv + (size_t)pn * T * 256; pitch = 256; colt = 0; fold = true; dsh = 2 * (pn / 3); if (pn % 3 == 0) sc = C2; }
            else if (pn == 14) { dst = vb; pitch = 256; colt = 0; }
            else { dst = gate; pitch = 2048; colt = (pn - 15) * 256; sig = true; }
            const int col0 = colt + wc * 32 + 8 * fq;
            EPI_ROWS(
                int drow = row;
                if (fold) { const int t = row & (SEQ - 1); drow = (row & ~(SEQ - 1)) | ((t & ((1 << dsh) - 1)) << (12 - dsh)) | (t >> dsh); }
                bf16_t* rowp = dst + (size_t)drow * pitch + col0;
                _Pragma("unroll") for (int bj = 0; bj < 2; ++bj) {
                    f32x4 v0 = acc[ai][bj][m][0], v1 = acc[ai][bj][m][1];
                    if (sig) { _Pragma("unroll") for (int j = 0; j < 4; ++j) { v0[j] = sigmoid_f(v0[j]); v1[j] = sigmoid_f(v1[j]); } }
                    else { v0 = v0 * sc; v1 = v1 * sc; }
                    *(u32x4*)(rowp + bj * HALF) = pack8(v0, v1);
                }
            )
        }
    }
};
struct EpiMergeA {
    const bf16_t* gate; bf16_t* merged;
    __device__ __forceinline__ void operator()(const f32x4 (&acc)[2][2][4][2], const Unit& u, int wr, int wc, int fr, int fq) const {
        const int col0 = u.pn * BM + wc * 32 + 8 * fq;
        EPI_ROWS(
            _Pragma("unroll") for (int bj = 0; bj < 2; ++bj) {
                const u32x4 gw = *(const u32x4*)(gate + (size_t)row * 2048 + col0 + bj * HALF);
                f32x4 v0 = acc[ai][bj][m][0], v1 = acc[ai][bj][m][1];
                v0[0] *= bf_lo(gw.x); v0[1] *= bf_hi(gw.x); v0[2] *= bf_lo(gw.y); v0[3] *= bf_hi(gw.y);
                v1[0] *= bf_lo(gw.z); v1[1] *= bf_hi(gw.z); v1[2] *= bf_lo(gw.w); v1[3] *= bf_hi(gw.w);
                *(u32x4*)(merged + (size_t)row * 1024 + col0 + bj * HALF) = pack8(v0, v1);
            }
        )
    }
};
struct EpiMergeB {
    const bf16_t* gate; bf16_t* merged;
    __device__ __forceinline__ void operator()(const f32x4 (&acc)[2][2][4][2], const Unit& u, int wr, int wc, int fr, int fq) const {
        const int col0 = u.pn * BM + wc * 32 + 8 * fq;
        EPI_ROWS(
            _Pragma("unroll") for (int bj = 0; bj < 2; ++bj) {
                const u32x4 gw = *(const u32x4*)(gate + (size_t)row * 2048 + 1024 + col0 + bj * HALF);
                bf16_t* mp = merged + (size_t)row * 1024 + col0 + bj * HALF;
                const u32x4 mw = *(const u32x4*)mp;
                f32x4 v0 = acc[ai][bj][m][0], v1 = acc[ai][bj][m][1];
                v0[0] = v0[0] * bf_lo(gw.x) + bf_lo(mw.x); v0[1] = v0[1] * bf_hi(gw.x) + bf_hi(mw.x); v0[2] = v0[2] * bf_lo(gw.y) + bf_lo(mw.y); v0[3] = v0[3] * bf_hi(gw.y) + bf_hi(mw.y);
                v1[0] = v1[0] * bf_lo(gw.z) + bf_lo(mw.z); v1[1] = v1[1] * bf_hi(gw.z) + bf_hi(mw.z); v1[2] = v1[2] * bf_lo(gw.w) + bf_lo(mw.w); v1[3] = v1[3] * bf_hi(gw.w) + bf_hi(mw.w);
                *(u32x4*)mp = pack8(v0, v1);
            }
        )
    }
};
struct EpiOut {
    const float* xin; float* xout; const float* g1;
    __device__ __forceinline__ void operator()(const f32x4 (&acc)[2][2][4][2], const Unit& u, int wr, int wc, int fr, int fq) const {
        const int col0 = u.pn * BM + wc * 32 + 8 * fq; const int b = (u.pm * BM) >> 12;
        f32x4 gv[2][2];
#pragma unroll
        for (int bj = 0; bj < 2; ++bj)
#pragma unroll
            for (int n = 0; n < 2; ++n) gv[bj][n] = *(const f32x4*)(g1 + (size_t)b * 6144 + col0 + bj * HALF + 4 * n);
        EPI_ROWS(
            _Pragma("unroll") for (int bj = 0; bj < 2; ++bj) {
                const size_t off = (size_t)row * 1024 + col0 + bj * HALF;
                const f32x4 x0 = *(const f32x4*)(xin + off), x1 = *(const f32x4*)(xin + off + 4);
                *(f32x4*)(xout + off) = x0 + gv[bj][0] * acc[ai][bj][m][0]; *(f32x4*)(xout + off + 4) = x1 + gv[bj][1] * acc[ai][bj][m][1];
            }
        )
    }
};
struct EpiGU {
    const float* bgu; bf16_t* act;
    __device__ __forceinline__ void operator()(const f32x4 (&acc)[2][2][4][2], const Unit& u, int wr, int wc, int fr, int fq) const {
        const int e = u.pn >> 3, pl = u.pn & 7; const int c0 = pl * 128 + wc * 32 + 8 * fq;
        const float* bp = bgu + (size_t)e * 2048 + c0;
        const f32x4 bg0 = *(const f32x4*)bp, bg1 = *(const f32x4*)(bp + 4), bl0 = *(const f32x4*)(bp + 1024), bl1 = *(const f32x4*)(bp + 1028);
        EPI_ROWS(
            f32x4 o[2];
            _Pragma("unroll") for (int n = 0; n < 2; ++n) {
                const f32x4 gl = acc[ai][0][m][n] + (n == 0 ? bg0 : bg1); const f32x4 ln = acc[ai][1][m][n] + (n == 0 ? bl0 : bl1);
                _Pragma("unroll") for (int j = 0; j < 4; ++j) { const float xg = fminf(gl[j], 7.0f); const float xl = fminf(fmaxf(ln[j], -7.0f), 7.0f); o[n][j] = xg * sigmoid_f(1.702f * xg) * (xl + 1.0f); }
            }
            *(u32x4*)(act + (size_t)row * 1024 + c0) = pack8(o[0], o[1]);
        )
    }
};
struct EpiDN {
    const float* bdn; const float* roww; bf16_t* y;
    __device__ __forceinline__ void operator()(const f32x4 (&acc)[2][2][4][2], const Unit& u, int wr, int wc, int fr, int fq) const {
        const int e = u.pn >> 2, pl = u.pn & 3; const int col0 = pl * BM + wc * 32 + 8 * fq;
        f32x4 bv[2][2];
#pragma unroll
        for (int bj = 0; bj < 2; ++bj)
#pragma unroll
            for (int n = 0; n < 2; ++n) bv[bj][n] = *(const f32x4*)(bdn + (size_t)e * 1024 + col0 + bj * HALF + 4 * n);
        EPI_ROWS(
            const float w = roww[row];
            _Pragma("unroll") for (int bj = 0; bj < 2; ++bj)
                *(u32x4*)(y + (size_t)row * 1024 + col0 + bj * HALF) = pack8((acc[ai][bj][m][0] + bv[bj][0]) * w, (acc[ai][bj][m][1] + bv[bj][1]) * w);
        )
    }
};
}

namespace attn_body {
using bf16 = __hip_bfloat16;
using bf16x8 = __attribute__((ext_vector_type(8))) short;
using s16x4 = __attribute__((ext_vector_type(4))) short;
using f32x16 = __attribute__((ext_vector_type(16))) float;
using u32x4 = __attribute__((ext_vector_type(4))) unsigned;
constexpr int D = 64, NW = 8, QBLK = 32, QB = QBLK * NW, KVBLK = 64;
__device__ __forceinline__ int crow(int r, int hi) { return (r & 3) + 8 * (r >> 2) + 4 * hi; }
#define SBAR() __builtin_amdgcn_sched_barrier(0)
constexpr int NSLOT = 3, SLOTB = 8192;
constexpr int LDS_K = 0, LDS_V = NSLOT * SLOTB, LDS_WS = 2 * NSLOT * SLOTB, LDS_OST = LDS_WS + NW * 64 * 4, LDS_LUT = LDS_OST + NW * 4096, LUT_N = 768, LDS_BYTES = LDS_LUT + LUT_N * 4;
constexpr float MFLOOR = -1024.0f;
__device__ __forceinline__ void glds16(const void* gsrc, unsigned lds_dst) { unsigned keep;
  asm volatile("s_mov_b32 %0, m0\n\ts_mov_b32 m0, %2\n\ts_nop 0\n\tglobal_load_lds_dwordx4 %1, off\n\ts_mov_b32 m0, %0" : "=&s"(keep) : "v"(gsrc), "s"(lds_dst) : "memory"); }
__device__ __forceinline__ float max3f(float a, float b, float c) { float r; asm("v_max3_f32 %0, %1, %2, %3" : "=v"(r) : "v"(a), "v"(b), "v"(c)); return r; }
__device__ __forceinline__ float max2f(float a, float b) { float r; asm("v_max_f32_e32 %0, %1, %2" : "=v"(r) : "v"(a), "v"(b)); return r; }
__device__ __forceinline__ float fadd_s(float a, float b) { float r; asm("v_add_f32_e32 %0, %1, %2" : "=v"(r) : "v"(a), "v"(b)); return r; }
__device__ __forceinline__ float fsub_s(float a, float b) { float r; asm("v_sub_f32_e32 %0, %1, %2" : "=v"(r) : "v"(a), "v"(b)); return r; }
typedef float f32x2_t __attribute__((ext_vector_type(2))); typedef __bf16 bf16x2_t __attribute__((ext_vector_type(2)));
__device__ __forceinline__ unsigned cvtpk_s(float lo, float hi) { f32x2_t v = {lo, hi}; bf16x2_t b = __builtin_convertvector(v, bf16x2_t); return __builtin_bit_cast(unsigned, b); }
#define WAIT_BAR(N) asm volatile("s_waitcnt vmcnt(" #N ") lgkmcnt(0)\n\ts_barrier" ::: "memory")

__device__ __forceinline__ void qkt(f32x16& p0, f32x16& p1, const char* Kslot, const bf16x8* qr, const f32x16& negm, int r32, int hi) {
  const char* kb = Kslot + hi * 1024 + r32 * 16;
  #pragma unroll
  for (int d0 = 0; d0 < 4; ++d0) {
    const bf16x8 b0 = *reinterpret_cast<const bf16x8*>(kb + d0 * 2048);
    const bf16x8 b1 = *reinterpret_cast<const bf16x8*>(kb + d0 * 2048 + 512);
    if (d0 == 0) { p0 = __builtin_amdgcn_mfma_f32_32x32x16_bf16(b0, qr[0], negm, 0, 0, 0); p1 = __builtin_amdgcn_mfma_f32_32x32x16_bf16(b1, qr[0], negm, 0, 0, 0); }
    else { p0 = __builtin_amdgcn_mfma_f32_32x32x16_bf16(b0, qr[d0], p0, 0, 0, 0); p1 = __builtin_amdgcn_mfma_f32_32x32x16_bf16(b1, qr[d0], p1, 0, 0, 0); } }
}
typedef __attribute__((address_space(3))) const char* lds_cptr;
typedef short v4i16_t __attribute__((ext_vector_type(4)));
__device__ __forceinline__ void kload8(bf16x8* kf, lds_cptr kp) {
  kf[0] = *(const __attribute__((address_space(3))) bf16x8*)(kp);        kf[1] = *(const __attribute__((address_space(3))) bf16x8*)(kp + 512);
  kf[2] = *(const __attribute__((address_space(3))) bf16x8*)(kp + 2048); kf[3] = *(const __attribute__((address_space(3))) bf16x8*)(kp + 2560);
  kf[4] = *(const __attribute__((address_space(3))) bf16x8*)(kp + 4096); kf[5] = *(const __attribute__((address_space(3))) bf16x8*)(kp + 4608);
  kf[6] = *(const __attribute__((address_space(3))) bf16x8*)(kp + 6144); kf[7] = *(const __attribute__((address_space(3))) bf16x8*)(kp + 6656);
}
__device__ __forceinline__ void kload2(bf16x8* kf, lds_cptr kp, int j) { kf[2 * j] = *(const __attribute__((address_space(3))) bf16x8*)(kp + j * 2048); kf[2 * j + 1] = *(const __attribute__((address_space(3))) bf16x8*)(kp + j * 2048 + 512); }
__device__ __forceinline__ s16x4 vtr(lds_cptr p) { return __builtin_bit_cast(s16x4, __builtin_amdgcn_ds_read_tr16_b64_v4i16((__attribute__((address_space(3))) v4i16_t*)p)); }
__device__ __forceinline__ float rowmax(const f32x16& p0, const f32x16& p1) {
  float a = max3f(p0[0], p0[1], p1[0]), b = max3f(p0[2], p0[3], p1[1]); a = max3f(a, p1[2], p1[3]);
  #pragma unroll
  for (int r = 4; r < 16; r += 4) { a = max3f(a, p0[r], p0[r + 1]); b = max3f(b, p0[r + 2], p0[r + 3]); a = max3f(a, p1[r], p1[r + 1]); b = max3f(b, p1[r + 2], p1[r + 3]); }
  const float m = max2f(a, b);
  auto rr = __builtin_amdgcn_permlane32_swap(__float_as_uint(m), __float_as_uint(m), false, false);
  return max2f(__uint_as_float(rr[0]), __uint_as_float(rr[1]));
}
__device__ __forceinline__ void pv(f32x16* o, int vb, bf16x8 pa0, bf16x8 pa1, bf16x8 pa2, bf16x8 pa3) {
  #pragma unroll
  for (int d0 = 0; d0 < 2; ++d0) { s16x4 lo[4], hi[4];
    #pragma unroll
    for (int ks = 0; ks < 4; ++ks) {
      asm volatile("ds_read_b64_tr_b16 %0,%1 offset:%c2" : "=&v"(lo[ks]) : "v"(vb), "i"(d0 * 4096 + ks * 1024) : "memory");
      asm volatile("ds_read_b64_tr_b16 %0,%1 offset:%c2" : "=&v"(hi[ks]) : "v"(vb), "i"(d0 * 4096 + ks * 1024 + 512) : "memory"); }
    asm volatile("s_waitcnt lgkmcnt(0)" ::: "memory"); SBAR();
    #define PK(k) (bf16x8){lo[k][0], lo[k][1], lo[k][2], lo[k][3], hi[k][0], hi[k][1], hi[k][2], hi[k][3]}
    o[d0] = __builtin_amdgcn_mfma_f32_32x32x16_bf16(pa0, PK(0), o[d0], 0, 0, 0);
    o[d0] = __builtin_amdgcn_mfma_f32_32x32x16_bf16(pa1, PK(1), o[d0], 0, 0, 0);
    o[d0] = __builtin_amdgcn_mfma_f32_32x32x16_bf16(pa2, PK(2), o[d0], 0, 0, 0);
    o[d0] = __builtin_amdgcn_mfma_f32_32x32x16_bf16(pa3, PK(3), o[d0], 0, 0, 0);
    #undef PK
  }
}
struct Job { const bf16* Q; const bf16* K; const bf16* V; bf16* O; float* lse; const float* lutg; int NT, i0, kq0, dsh, cls; };
template <int MODE, int THRL> __device__ __forceinline__ void attn_unit(const Job& J, char* shm, const int wid_in) {
  int wid = wid_in; asm volatile("" : "+s"(wid));
  constexpr int QP = MODE == 0 ? 1024 : 256, KP = 256;
  const int lane = lane_id_asm(), tid = wid * 64 + lane, r32 = lane & 31, hi = lane >> 5;
  const bf16* Qw = J.Q + (long)(wid * QBLK) * QP;
  const bf16* Kh = J.K; const bf16* Vh = J.V;
  const unsigned lds0 = (unsigned)(uintptr_t)shm;
  float* wsf = (float*)(shm + LDS_WS) + wid * 64;
  const bf16* ksrc = Kh + (long)lane * KP + wid * 8;
  const bf16* vsrc = Vh + (long)(16 * (wid & 3) + (lane >> 2)) * KP + (wid >> 2) * 32 + (lane & 3) * 8;
  const unsigned kdst = lds0 + LDS_K + wid * 1024, vdst = lds0 + LDS_V + wid * 1024;
  #define DMA_K(t, slot) glds16(ksrc + (long)(t) * KVBLK * KP, (unsigned)__builtin_amdgcn_readfirstlane(kdst + (slot)))
  #define DMA_V(t, slot) glds16(vsrc + (long)(t) * KVBLK * KP, (unsigned)__builtin_amdgcn_readfirstlane(vdst + (slot)))
  const int vb0 = (int)(lds0 + LDS_V) + ((lane >> 4) & 1) * 32 + (lane & 3) * 8 + (4 * hi + ((lane & 15) >> 2)) * 64;
  const char* Kbase = shm + LDS_K; bf16x8 kf[8];
  const lds_cptr shm3 = (lds_cptr)shm; const lds_cptr kp0 = shm3 + LDS_K + hi * 1024 + r32 * 16; const lds_cptr vp0 = shm3 + LDS_V + ((lane >> 4) & 1) * 32 + (lane & 3) * 8 + (4 * hi + ((lane & 15) >> 2)) * 64;
  const int NT = J.NT;
  if (MODE == 1) {
    __attribute__((address_space(3))) float* lut = (__attribute__((address_space(3))) float*)(shm3 + LDS_LUT);
    lut[tid] = J.lutg[tid]; if (tid < LUT_N - 512) lut[512 + tid] = J.lutg[512 + tid];
  }
  DMA_K(0, 0); DMA_V(0, 0); DMA_K(1, SLOTB);
  bf16x8 qr[4];
  #pragma unroll
  for (int d0 = 0; d0 < 4; ++d0) qr[d0] = *reinterpret_cast<const bf16x8*>(&Qw[(long)r32 * QP + d0 * 16 + hi * 8]);
  float mhat = 0.f, l_reg = 0.f; f32x16 o[2]; o[0] = f32x16{}; o[1] = f32x16{}; f32x16 negm = f32x16{}; asm volatile("" : "+v"(negm));
  const int qrel = wid * QBLK + r32;
  const __attribute__((address_space(3))) float* lutq = (const __attribute__((address_space(3))) float*)(shm3 + LDS_LUT) + (J.kq0 - qrel + 383 + 4 * hi);
  #define CMASK(P0, P1, t) do { if (MODE == 1) { const __attribute__((address_space(3))) float* lp_ = lutq + 64 * (t); \
      _Pragma("unroll") for (int r = 0; r < 16; ++r) { const int ko_ = (r & 3) + 8 * (r >> 2); P0[r] += lp_[ko_]; P1[r] += lp_[ko_ + 32]; } } } while (0)
  bool resc = false;
  #define START(P0, P1) do { const float rm = rowmax(P0, P1); resc = false; \
    { const float dl = MODE == 1 ? max2f(rm, MFLOOR) : rm; mhat = fadd_s(mhat, dl); \
      _Pragma("unroll") for (int r = 0; r < 16; ++r) { P0[r] = fsub_s(P0[r], dl); P1[r] = fsub_s(P1[r], dl); } \
      _Pragma("unroll") for (int r = 0; r < 16; ++r) negm[r] = -mhat; asm volatile("" : "+v"(negm)); } \
    _Pragma("unroll") for (int r = 0; r < 16; ++r) P0[r] = __builtin_amdgcn_exp2f(P0[r]); } while (0)
  #define RESC() do { if (resc) { asm volatile("s_waitcnt lgkmcnt(0)" ::: "memory"); \
      _Pragma("unroll") for (int d_ = 0; d_ < 2; ++d_) _Pragma("unroll") for (int r = 0; r < 16; ++r) o[d_][r] *= wsf[crow(r, hi)]; } } while (0)
  f32x16 pA0, pA1, pB0, pB1;
  int sl_prev = 0, sl_cur = 0, sl_next = SLOTB;
  #define ROT() do { sl_prev = sl_cur; sl_cur = sl_next; sl_next = (sl_next == (NSLOT - 1) * SLOTB) ? 0 : sl_next + SLOTB; } while (0)
  DMA_K(2, 2 * SLOTB);
  WAIT_BAR(3);
  qkt(pA0, pA1, Kbase, qr, negm, r32, hi); asm volatile("s_nop 15\n\ts_nop 7" : "+v"(pA0), "+v"(pA1)); CMASK(pA0, pA1, 0);
  START(pA0, pA1);
  _Pragma("unroll") for (int r = 0; r < 16; ++r) pA1[r] = __builtin_amdgcn_exp2f(pA1[r]);
  WAIT_BAR(0);
  DMA_K(3, 0); DMA_V(1, SLOTB);
  ROT();
  kload8(kf, kp0 + sl_cur);
  WAIT_BAR(2);
  s16x4 vlo[8], vhi[8]; u32x4 pw0, pw1, pw2, pw3;
  #define PKW(P, B) cvtpk_s(P[B], P[B + 1])
  #define PAF(k) __builtin_bit_cast(bf16x8, pw##k)
  #define VFR(i) (bf16x8){vlo[i][0], vlo[i][1], vlo[i][2], vlo[i][3], vhi[i][0], vhi[i][1], vhi[i][2], vhi[i][3]}
  #define PIN(x) asm volatile("" : "+v"(x))
  #define MX3(a, b, c) __builtin_fmaxf(__builtin_fmaxf((a), (b)), (c))
  #define GAPA(MF, A0, A1, A2, A3, W0, W1, PW) do { MF; sacc += A0; sacc += A1; sacc += A2; sacc += A3; PIN(sacc); W0; W1; PIN(PW); SBAR(); } while (0)
  #define EX(v) __builtin_amdgcn_exp2f(v)
  #define GAPB(MF, X, B) do { MF; X[B] = EX(X[B]); X[B + 1] = EX(X[B + 1]); X[B + 2] = EX(X[B + 2]); X[B + 3] = EX(X[B + 3]); PIN(X); SBAR(); } while (0)
  #define VRD(i) do { vlo[i] = vtr(vp_ + (((i) >> 2) * 4096 + ((i) & 3) * 1024)); vhi[i] = vtr(vp_ + (((i) >> 2) * 4096 + ((i) & 3) * 1024 + 512)); } while (0)
  #define KRD(G, j) do { if (G) { kload2(kf, kp0 + sl_next, j); SBAR(); } } while (0)
  #define STEP(C0, C1, P0, P1, t, GK, GV, GL) do { SBAR(); \
    const lds_cptr vp_ = vp0 + sl_prev; \
    VRD(0); SBAR(); float sacc = (P0[0] + P0[1]); \
    GAPA(C0 = __builtin_amdgcn_mfma_f32_32x32x16_bf16(kf[0], qr[0], negm, 0, 0, 0), P0[2], P0[3], P0[4], P0[5],     pw0[0] = PKW(P0, 0), pw0[1] = PKW(P0, 2), pw0); \
    VRD(4); SBAR(); GAPA(C1 = __builtin_amdgcn_mfma_f32_32x32x16_bf16(kf[1], qr[0], negm, 0, 0, 0), P0[6], P0[7], P0[8], P0[9],     pw0[2] = PKW(P0, 4), pw0[3] = PKW(P0, 6), pw0); \
    VRD(1); SBAR(); GAPA(C0 = __builtin_amdgcn_mfma_f32_32x32x16_bf16(kf[2], qr[1], C0, 0, 0, 0),   P0[10], P0[11], P0[12], P0[13], pw1[0] = PKW(P0, 8), pw1[1] = PKW(P0, 10), pw1); \
    VRD(5); SBAR(); GAPA(C1 = __builtin_amdgcn_mfma_f32_32x32x16_bf16(kf[3], qr[1], C1, 0, 0, 0),   P0[14], P0[15], P1[0], P1[1],   pw1[2] = PKW(P0, 12), pw1[3] = PKW(P0, 14), pw1); \
    VRD(2); SBAR(); GAPA(C0 = __builtin_amdgcn_mfma_f32_32x32x16_bf16(kf[4], qr[2], C0, 0, 0, 0),   P1[2], P1[3], P1[4], P1[5],     pw2[0] = PKW(P1, 0), pw2[1] = PKW(P1, 2), pw2); \
    VRD(6); SBAR(); GAPA(C1 = __builtin_amdgcn_mfma_f32_32x32x16_bf16(kf[5], qr[2], C1, 0, 0, 0),   P1[6], P1[7], P1[8], P1[9],     pw2[2] = PKW(P1, 4), pw2[3] = PKW(P1, 6), pw2); \
    VRD(3); SBAR(); GAPA(C0 = __builtin_amdgcn_mfma_f32_32x32x16_bf16(kf[6], qr[3], C0, 0, 0, 0),   P1[10], P1[11], P1[12], P1[13], pw3[0] = PKW(P1, 8), pw3[1] = PKW(P1, 10), pw3); \
    VRD(7); SBAR(); GAPA(C1 = __builtin_amdgcn_mfma_f32_32x32x16_bf16(kf[7], qr[3], C1, 0, 0, 0),   P1[14], P1[15], 0.f, 0.f,       pw3[2] = PKW(P1, 12), pw3[3] = PKW(P1, 14), pw3); \
    l_reg += sacc; \
    if (GK) { DMA_K((t) + 3, sl_cur); } if (GV) { DMA_V((t) + 1, sl_next); } \
    CMASK(C0, C1, t); \
    { float a = MX3(C0[0], C0[1], C1[0]), b = MX3(C0[2], C0[3], C1[1]); a = MX3(a, C1[2], C1[3]); \
      _Pragma("unroll") for (int r = 4; r < 16; r += 4) { a = MX3(a, C0[r], C0[r + 1]); b = MX3(b, C0[r + 2], C0[r + 3]); a = MX3(a, C1[r], C1[r + 1]); b = MX3(b, C1[r + 2], C1[r + 3]); } \
      float rm = __builtin_fmaxf(a, b); { auto rr = __builtin_amdgcn_permlane32_swap(__float_as_uint(rm), __float_as_uint(rm), false, false); rm = __builtin_fmaxf(__uint_as_float(rr[0]), __uint_as_float(rr[1])); } \
      resc = false; \
      if (__builtin_expect(__any(rm > (float)THRL), 0)) { const float dl = __builtin_fmaxf(rm, 0.f); mhat += dl; \
        _Pragma("unroll") for (int r = 0; r < 16; ++r) { C0[r] -= dl; C1[r] -= dl; } \
        _Pragma("unroll") for (int r = 0; r < 16; ++r) negm[r] = -mhat; asm volatile("" : "+v"(negm)); \
        const float f = __builtin_amdgcn_exp2f(-dl); l_reg *= f; if (hi == 0) wsf[r32] = f; resc = true; } } \
    SBAR(); \
    GAPB(o[0] = __builtin_amdgcn_mfma_f32_32x32x16_bf16(PAF(0), VFR(0), o[0], 0, 0, 0), C0, 0); \
    GAPB(o[1] = __builtin_amdgcn_mfma_f32_32x32x16_bf16(PAF(0), VFR(4), o[1], 0, 0, 0), C0, 4); \
    KRD(GL, 0); GAPB(o[0] = __builtin_amdgcn_mfma_f32_32x32x16_bf16(PAF(1), VFR(1), o[0], 0, 0, 0), C0, 8); \
    KRD(GL, 1); GAPB(o[1] = __builtin_amdgcn_mfma_f32_32x32x16_bf16(PAF(1), VFR(5), o[1], 0, 0, 0), C0, 12); \
    KRD(GL, 2); GAPB(o[0] = __builtin_amdgcn_mfma_f32_32x32x16_bf16(PAF(2), VFR(2), o[0], 0, 0, 0), C1, 0); \
    KRD(GL, 3); GAPB(o[1] = __builtin_amdgcn_mfma_f32_32x32x16_bf16(PAF(2), VFR(6), o[1], 0, 0, 0), C1, 4); \
    GAPB(o[0] = __builtin_amdgcn_mfma_f32_32x32x16_bf16(PAF(3), VFR(3), o[0], 0, 0, 0), C1, 8); \
    GAPB(o[1] = __builtin_amdgcn_mfma_f32_32x32x16_bf16(PAF(3), VFR(7), o[1], 0, 0, 0), C1, 12); \
    } while (0)
  int t = 1;
  for (; t + 5 < NT; t += 2) {
    STEP(pB0, pB1, pA0, pA1, t, true, true, true);     WAIT_BAR(2); RESC(); ROT();
    STEP(pA0, pA1, pB0, pB1, t + 1, true, true, true); WAIT_BAR(2); RESC(); ROT();
  }
  #define ENDW(tt) do { if ((tt) + 3 < NT) { WAIT_BAR(2); } else if ((tt) + 2 < NT) { WAIT_BAR(1); } else { WAIT_BAR(0); } } while (0)
  for (; t + 1 < NT; t += 2) {
    STEP(pB0, pB1, pA0, pA1, t, (t + 3 < NT), (t + 1 < NT), (t + 1 < NT));       ENDW(t);     RESC(); ROT();
    STEP(pA0, pA1, pB0, pB1, t + 1, (t + 4 < NT), (t + 2 < NT), (t + 2 < NT));   ENDW(t + 1); RESC(); ROT();
  }
  STEP(pB0, pB1, pA0, pA1, NT - 1, false, false, false); RESC();
  { float sacc = pB0[0] + pB0[1]; _Pragma("unroll") for (int r = 2; r < 16; ++r) sacc += pB0[r]; _Pragma("unroll") for (int r = 0; r < 16; ++r) sacc += pB1[r]; l_reg += sacc;
    pw0 = (u32x4){PKW(pB0, 0), PKW(pB0, 2), PKW(pB0, 4), PKW(pB0, 6)}; pw1 = (u32x4){PKW(pB0, 8), PKW(pB0, 10), PKW(pB0, 12), PKW(pB0, 14)}; pw2 = (u32x4){PKW(pB1, 0), PKW(pB1, 2), PKW(pB1, 4), PKW(pB1, 6)}; pw3 = (u32x4){PKW(pB1, 8), PKW(pB1, 10), PKW(pB1, 12), PKW(pB1, 14)};
    SBAR(); pv(o, vb0 + sl_cur, PAF(0), PAF(1), PAF(2), PAF(3)); }
  #undef PKW
  #undef PAF
  #undef VFR
  #undef PIN
  #undef MX3
  #undef GAPA
  #undef GAPB
  #undef EX
  #undef VRD
  #undef KRD
  #undef STEP
  #undef ENDW
  { auto rr = __builtin_amdgcn_permlane32_swap(__float_as_uint(l_reg), __float_as_uint(l_reg), false, false); l_reg = __uint_as_float(rr[0]) + __uint_as_float(rr[1]); }
  if (hi == 0) wsf[32 + r32] = l_reg; asm volatile("s_waitcnt lgkmcnt(0)" ::: "memory");
  float rli[16];
  #pragma unroll
  for (int r = 0; r < 16; ++r) rli[r] = __builtin_amdgcn_rcpf(wsf[32 + crow(r, hi)]);
  { bf16* stg = (bf16*)(shm + LDS_OST) + wid * 2048;
    #pragma unroll
    for (int r = 0; r < 16; ++r) { const int orow = crow(r, hi);
      #pragma unroll
      for (int d0 = 0; d0 < 2; ++d0) stg[orow * 64 + d0 * 32 + r32] = __float2bfloat16(o[d0][r] * rli[r]); }
    asm volatile("s_waitcnt lgkmcnt(0)" ::: "memory");
    if (MODE == 0) {
      bf16* Ow = J.O + (long)(wid * QBLK) * 1024;
      #pragma unroll
      for (int i = 0; i < 4; ++i) { const int row = i * 8 + (lane >> 3), ch = lane & 7; const u32x4 v = *(const u32x4*)(stg + row * 64 + ch * 8); *(u32x4*)(Ow + (long)row * 1024 + ch * 8) = v; }
    } else {
      #pragma unroll
      for (int i = 0; i < 4; ++i) { const int row = i * 8 + (lane >> 3), ch = lane & 7; const u32x4 v = *(const u32x4*)(stg + row * 64 + ch * 8);
        const long tok = ((long)(J.i0 + wid * QBLK + row) << J.dsh) + J.cls; *(u32x4*)(J.O + tok * 256 + ch * 8) = v; }
      if (hi == 0) { const long tok = ((long)(J.i0 + qrel) << J.dsh) + J.cls; J.lse[tok * 4] = mhat + __builtin_amdgcn_logf(l_reg); }
    } }
  asm volatile("s_waitcnt lgkmcnt(0)\n\ts_barrier" ::: "memory");
  #undef DMA_K
  #undef DMA_V
  #undef CMASK
  #undef START
  #undef RESC
  #undef ROT
}
#undef SBAR
#undef WAIT_BAR
}

constexpr size_t MiB = 1u << 20;
constexpr size_t WS_CTL = 0, CTL_ZERO_BYTES = 1 * MiB;
constexpr size_t WS_MOD = 1 * MiB;
constexpr size_t WS_ROPE = WS_MOD + 512 * 1024;
constexpr size_t WS_BLUT = WS_ROPE + 8192;
constexpr size_t WS_RC0 = WS_BLUT + 12 * 768 * 4;
constexpr size_t WS_HIST = WS_RC0 + 4096;
constexpr size_t WS_TILEE = WS_HIST + 32768;
constexpr size_t WS_TOPE = 2 * MiB;
constexpr size_t WS_TOPW = WS_TOPE + 512 * 1024;
constexpr size_t WS_SLOT = WS_TOPW + 512 * 1024;
constexpr size_t WS_ROWW = WS_SLOT + 512 * 1024;
constexpr size_t WS_LSE = 5 * MiB;
constexpr size_t WS_WRHI = 7 * MiB;
constexpr size_t WS_WRLO = 8 * MiB;
constexpr size_t WS_WIN = 9 * MiB;
constexpr size_t WS_WBRA = 32 * MiB;
constexpr size_t WS_WBRB = 33 * MiB;
constexpr size_t WS_WOUT = 37 * MiB;
constexpr size_t WS_WGU = 41 * MiB;
constexpr size_t WS_WDN = 297 * MiB;
constexpr size_t WS_X = 425 * MiB;
constexpr size_t WS_H = 553 * MiB;
constexpr size_t WS_R = 617 * MiB;
constexpr size_t WS_AQKV = WS_R;
constexpr size_t WS_QB = WS_R + 144 * MiB;
constexpr size_t WS_KB = WS_R + 208 * MiB;
constexpr size_t WS_VB = WS_R + 224 * MiB;
constexpr size_t WS_GATE = WS_R + 240 * MiB;
constexpr size_t WS_OAG = WS_R + 368 * MiB;
constexpr size_t WS_OA = WS_R + 416 * MiB;
constexpr size_t WS_MERGED = WS_R + 432 * MiB;
constexpr size_t WS_XS = WS_R;
constexpr size_t WS_ACT = WS_R + 272 * MiB;
constexpr size_t WS_END = WS_R + 544 * MiB;
constexpr int CW_BAR = 4096;

constexpr int RING_BYTES = 133120;
constexpr int LDSCTL_OFF = RING_BYTES;
constexpr int LDS_BYTES = 147456;
constexpr int NWAVES = 8;

#define GAS __attribute__((address_space(1)))
#define LAS __attribute__((address_space(3)))
typedef unsigned short bf16;
typedef unsigned v4u __attribute__((ext_vector_type(4)));
typedef unsigned v2u __attribute__((ext_vector_type(2)));
typedef float f32x4 __attribute__((ext_vector_type(4)));
typedef float f32x16 __attribute__((ext_vector_type(16)));
typedef int i32x4 __attribute__((ext_vector_type(4)));
typedef short bf16x8 __attribute__((ext_vector_type(8)));
typedef GAS unsigned gu32;
#define RLX_AGENT __ATOMIC_RELAXED, __HIP_MEMORY_SCOPE_AGENT
#define LDS_WAIT() asm volatile("s_waitcnt lgkmcnt(0)" ::: "memory")
__device__ __forceinline__ unsigned f2bf(float f) { unsigned u = __builtin_bit_cast(unsigned, f); return (u + 0x7fffu + ((u >> 16) & 1u)) >> 16; }
__device__ __forceinline__ unsigned pk2(float lo, float hi) { return f2bf(lo) | (f2bf(hi) << 16); }
__device__ __forceinline__ float bfl(unsigned w) { return __uint_as_float(w << 16); }
__device__ __forceinline__ float bfh(unsigned w) { return __uint_as_float(w & 0xffff0000u); }

#define XB_TMO      128
#define XB_XCNT(j)  (256  + 64 * (j))
#define XB_XSUB(j)  (1280 + 64 * (j))
#define XB_XGEN(j)  (2304 + 64 * (j))
#define XB_TOP      3328
#define XB_TOPGEN   3392
#define XCD_BAR_WORDS 3456
#define XB_SPIN_CAP (1u << 18)
__device__ __forceinline__ unsigned xb_ld(unsigned* p)              { return __hip_atomic_load(p, __ATOMIC_RELAXED, __HIP_MEMORY_SCOPE_AGENT); }
__device__ __forceinline__ unsigned xb_add(unsigned* p, unsigned v) { return __hip_atomic_fetch_add(p, v, __ATOMIC_RELAXED, __HIP_MEMORY_SCOPE_AGENT); }
__device__ __forceinline__ unsigned xb_xcc_id() { return (unsigned)__builtin_amdgcn_s_getreg((3 << 11) | 20) & 0xFu; }
#define XB_SPIN(cond, bar) do { unsigned _sp = 0; while (cond) { __builtin_amdgcn_s_sleep(1); \
    if ((++_sp & 255u) == 0u) { if (xb_ld(&(bar)[XB_TMO])) break; if (_sp > XB_SPIN_CAP) { atomicAdd(&(bar)[XB_TMO], 1u); break; } } } } while (0)
struct XcdBarrier { unsigned* bar; unsigned x; volatile LAS unsigned* st; };
__device__ __forceinline__ XcdBarrier xcd_barrier_post(unsigned* bar, volatile LAS unsigned* st) {
    XcdBarrier b; b.bar = bar; b.x = xb_xcc_id(); b.st = st;
    if (threadIdx.x == 0) (void)xb_add(&bar[XB_XCNT(b.x)], 1u);
    return b;
}
__device__ __forceinline__ void xcd_barrier_complete(unsigned* bar, unsigned x, unsigned& nloc, unsigned& nx) {
    const unsigned G = gridDim.x * gridDim.y * gridDim.z;
    unsigned sum, cnt, mine, sp = 0u;
    for (;;) {
        sum = 0u; cnt = 0u; mine = 0u;
#pragma unroll
        for (unsigned j = 0; j < 16; ++j) { const unsigned c = xb_ld(&bar[XB_XCNT(j)]); sum += c; cnt += (c > 0u) ? 1u : 0u; mine = (j == x) ? c : mine; }
        if (sum == G) break;
        __builtin_amdgcn_s_sleep(1);
        if ((++sp & 255u) == 0u) { if (xb_ld(&bar[XB_TMO])) break; if (sp > XB_SPIN_CAP) { atomicAdd(&bar[XB_TMO], 1u); break; } }
    }
    nloc = mine > 0u ? mine : 1u; nx = cnt > 0u ? cnt : 1u;
}
__device__ __forceinline__ void xcd_barrier(const XcdBarrier& b) {
    asm volatile("s_waitcnt vmcnt(0)" ::: "memory");
    __syncthreads();
    if (threadIdx.x == 0) {
        unsigned* bar = b.bar;
        __builtin_amdgcn_s_waitcnt(0);
        unsigned nloc = b.st[0], nx = b.st[1];
        if (nloc == 0u) { xcd_barrier_complete(bar, b.x, nloc, nx); b.st[0] = nloc; b.st[1] = nx; }
        const unsigned old = xb_add(&bar[XB_XSUB(b.x)], 1u);
        const unsigned gen = old / nloc;
        if (old + 1u == (gen + 1u) * nloc) {
            __builtin_amdgcn_fence(__ATOMIC_RELEASE, "agent");
            asm volatile("s_waitcnt vmcnt(0)" ::: "memory");
            const unsigned og = xb_add(&bar[XB_TOP], 1u);
            const unsigned tg = og / nx;
            if (og + 1u == (tg + 1u) * nx) xb_add(&bar[XB_TOPGEN], 1u);
            else XB_SPIN(xb_ld(&bar[XB_TOPGEN]) == tg, bar);
            __builtin_amdgcn_fence(__ATOMIC_ACQUIRE, "agent");
            xb_add(&bar[XB_XGEN(b.x)], 1u);
            asm volatile("s_waitcnt vmcnt(0)" ::: "memory");
        } else {
            XB_SPIN(xb_ld(&bar[XB_XGEN(b.x)]) == gen, bar);
            __builtin_amdgcn_fence(__ATOMIC_ACQUIRE, "agent");
            asm volatile("s_waitcnt vmcnt(0)" ::: "memory");
        }
    }
    __syncthreads();
}

__device__ __forceinline__ float wave_sum(float v) {
    v = xsum<1>(v); v = xsum<2>(v); v = xsum<4>(v); v = xsum<8>(v); v = xsum<16>(v); v = xsum<32>(v);
    return v;
}
__device__ __forceinline__ void cvt_item(const float* W, int ldw, int K, int srcA, int srcB, bf16* WT, int dst_row0, int k0, LAS float* scr, int lane, bool ident = false) {
    const int kq = lane >> 4, nq = lane & 15; const int scol = (nq < 8 ? srcA + 4 * nq : srcB + 4 * (nq - 8));
    f32x4 v[16];
#pragma unroll
    for (int i = 0; i < 16; ++i) v[i] = *(const GAS f32x4*)(W + (size_t)(k0 + 4 * i + kq) * ldw + scol);
#pragma unroll
    for (int i = 0; i < 16; ++i)
#pragma unroll
        for (int e = 0; e < 4; ++e) scr[(4 * i + kq) * 65 + 4 * nq + e] = v[i][e];
    LDS_WAIT(); asm volatile("" ::: "memory");
    const int c = lane & 7, rr = lane >> 3;
#pragma unroll
    for (int j = 0; j < 8; ++j) { const int rho = rr + 8 * j; const int sc = (rho & 32) + (ident ? (rho & 31) : pg8::perm32(rho & 31)); const LAS float* s = scr + (8 * c) * 65 + sc;
        v4u o; o.x = pk2(s[0 * 65], s[1 * 65]); o.y = pk2(s[2 * 65], s[3 * 65]); o.z = pk2(s[4 * 65], s[5 * 65]); o.w = pk2(s[6 * 65], s[7 * 65]);
        *(GAS v4u*)(WT + (size_t)(dst_row0 + rho) * K + k0 + 8 * c) = o; }
    LDS_WAIT(); asm volatile("" ::: "memory");
}
__device__ __forceinline__ int win_src(int X) { const int pn = X >> 3, bj = (X >> 2) & 1, wc = X & 3; return (pn >= 9 && pn < 14) ? pn * 256 + 64 * wc + 32 * bj : 32 * X; }
__device__ __forceinline__ int wgu_src(int X) { const int pn = X >> 3, bj = (X >> 2) & 1, wc = X & 3; return bj * 1024 + 128 * pn + 32 * wc; }

__device__ __forceinline__ void norm_row_bf16(const float* xrow, const float* g, const float* sc, const float* sh, bf16* orow, int lane) {
    const GAS f32x4* xr = (const GAS f32x4*)xrow + lane;
    f32x4 v[4]; float s = 0.f;
#pragma unroll
    for (int j = 0; j < 4; ++j) { v[j] = xr[64 * j]; s += (v[j].x * v[j].x + v[j].y * v[j].y) + (v[j].z * v[j].z + v[j].w * v[j].w); }
    const float rs = rsqrtf(wave_sum(s) * (1.0f / D) + EPS);
#pragma unroll
    for (int j = 0; j < 4; ++j) { const int c = 256 * j + 4 * lane;
        const f32x4 gg = *(const GAS f32x4*)(g + c), s1 = *(const GAS f32x4*)(sc + c), s0 = *(const GAS f32x4*)(sh + c);
        const f32x4 y = (v[j] * rs * gg) * (s1 + 1.0f) + s0;
        v2u o; o.x = pk2(y.x, y.y); o.y = pk2(y.z, y.w); *(GAS v2u*)(orow + c) = o; }
}

struct Args { const float* in[20]; float* out; unsigned char* ws; int ph_lo, ph_hi, li, pad; };
constexpr int N_PHASES = 2 + 10 * DEPTH;

typedef const __attribute__((address_space(4))) Args* kargs_t;
__device__ __forceinline__ kargs_t kargs_opaque() { kargs_t p = (kargs_t)__builtin_amdgcn_kernarg_segment_ptr(); asm volatile("" : "+s"(p)); return p; }
#define PH_BEGIN() kargs_t ap = kargs_opaque(); unsigned char* ws = ap->ws; (void)ws; \
    int wave = wave_s; asm volatile("" : "+s"(wave)); const int lane = lane_id_asm(); const int tid = wave * 64 + lane; (void)lane; (void)tid; \
    int bx = blockIdx.x; asm volatile("" : "+s"(bx)); int G = gridDim.x; asm volatile("" : "+s"(G)); const int vcu = (G % 8 == 0) ? (bx % 8) * (G / 8) + bx / 8 : bx; (void)vcu; \
    const int gw = vcu * NWAVES + wave, NGW = G * NWAVES; (void)gw; (void)NGW; const int gtid = vcu * (NWAVES * 64) + tid, NGT = G * NWAVES * 64; (void)gtid; (void)NGT
#define INP(k) (ap->in[k])
#define x_in INP(0)
#define c_in INP(1)
#define w_ada INP(2)
#define b_ada INP(3)
#define norm1_g INP(4)
#define w_in INP(5)
#define q_norm_g INP(6)
#define k_norm_g INP(7)
#define rel_bias INP(8)
#define w_br_a INP(9)
#define w_br_b INP(10)
#define w_out INP(11)
#define norm2_g INP(12)
#define w_router INP(13)
#define b_router INP(14)
#define w_gate_up INP(15)
#define b_gate_up INP(16)
#define w_down INP(17)
#define b_down INP(18)
#define final_g INP(19)
#define MOD ((float*)(ws + WS_MOD))
#define ROPE ((float*)(ws + WS_ROPE))
#define BLUT ((float*)(ws + WS_BLUT))
#define RC0 ((float*)(ws + WS_RC0))
#define HIST ((int*)(ws + WS_HIST))
#define TILEE ((int*)(ws + WS_TILEE))
#define TOPE ((int*)(ws + WS_TOPE))
#define TOPW ((float*)(ws + WS_TOPW))
#define SLOT ((int*)(ws + WS_SLOT))
#define ROWW ((float*)(ws + WS_ROWW))
#define LSE ((float*)(ws + WS_LSE))
#define WRHI ((bf16*)(ws + WS_WRHI))
#define WRLO ((bf16*)(ws + WS_WRLO))
#define WIN ((bf16*)(ws + WS_WIN))
#define WBRA ((bf16*)(ws + WS_WBRA))
#define WBRB ((bf16*)(ws + WS_WBRB))
#define WOUT ((bf16*)(ws + WS_WOUT))
#define WGU ((bf16*)(ws + WS_WGU))
#define WDN ((bf16*)(ws + WS_WDN))
#define X ((float*)(ws + WS_X))
#define H ((bf16*)(ws + WS_H))
#define AQKV ((bf16*)(ws + WS_AQKV))
#define QB ((bf16*)(ws + WS_QB))
#define KB ((bf16*)(ws + WS_KB))
#define VB ((bf16*)(ws + WS_VB))
#define GATE ((bf16*)(ws + WS_GATE))
#define OAG ((bf16*)(ws + WS_OAG))
#define OA ((bf16*)(ws + WS_OA))
#define MERGED ((bf16*)(ws + WS_MERGED))
#define XS ((bf16*)(ws + WS_XS))
#define ACT ((bf16*)(ws + WS_ACT))
#define YB ((bf16*)(ws + WS_XS))
__global__ void __launch_bounds__(NWAVES * 64, 2) mk_fwd(Args args) {
    extern __shared__ __attribute__((aligned(16))) unsigned char lds[];
    LAS unsigned char* L = (LAS unsigned char*)lds;
    volatile LAS unsigned* MISC = (volatile LAS unsigned*)(L + LDSCTL_OFF);
    gu32* ctl = (gu32*)(args.ws + WS_CTL);
    const int wave_s = __builtin_amdgcn_readfirstlane(threadIdx.x >> 6);
    for (int u = threadIdx.x; u < (LDS_BYTES - LDSCTL_OFF) / 4; u += NWAVES * 64) ((LAS unsigned*)(L + LDSCTL_OFF))[u] = 0u;
    __syncthreads();
    XcdBarrier bar; bar.bar = (unsigned*)(ctl + CW_BAR) + args.li * XCD_BAR_WORDS; bar.x = 0; bar.st = nullptr;
    if (!MK_PER_PHASE) bar = xcd_barrier_post((unsigned*)(ctl + CW_BAR) + args.li * XCD_BAR_WORDS, MISC + 8);
    const int lo = args.ph_lo, hi = args.ph_hi;
#define IN(k) (lo <= (k) && (k) < hi)
#define KIND(q) ((PH_KIND_MASK >> (q)) & 1)
#define SEAM(k) do { if (IN(k) && IN((k) + 1)) xcd_barrier(bar); } while (0)

    if (KIND(0) && IN(0)) { PH_BEGIN();
        {
            LAS float* cact = (LAS float*)L;
            LAS float* part = (LAS float*)(L + 32768);
            for (int i = tid; i < NB * D; i += NWAVES * 64) { const float cv = c_in[i]; cact[i] = cv / (1.0f + __expf(-cv)); }
            __syncthreads();
            for (int vb = bx; vb < 256; vb += G) {
                const int gc = vb * 48 + lane;
                const int l = gc / 6144, col = gc % 6144;
                float a[NB];
#pragma unroll
                for (int b = 0; b < NB; ++b) a[b] = 0.f;
                if (lane < 48) {
                    const float* wp = w_ada + (size_t)l * D * 6144 + col;
                    for (int k = wave * 128; k < wave * 128 + 128; ++k) { const float w = wp[(size_t)k * 6144];
#pragma unroll
                        for (int b = 0; b < NB; ++b) a[b] += cact[b * D + k] * w; }
                }
#pragma unroll
                for (int b = 0; b < NB; ++b) part[(wave * NB + b) * 64 + lane] = a[b];
                __syncthreads();
                if (tid < NB * 48) { const int b = tid / 48, cl = tid % 48; const int gc2 = vb * 48 + cl; const int l2 = gc2 / 6144, col2 = gc2 % 6144;
                    float s = b_ada[l2 * 6144 + col2];
#pragma unroll
                    for (int w = 0; w < NWAVES; ++w) s += part[(w * NB + b) * 64 + cl];
                    MOD[((size_t)l2 * NB + b) * 6144 + col2] = s; }
                __syncthreads();
            }
        }
        for (int i = gtid; i < 1024 + 12 * 768; i += NGT) {
            if (i < 1024) { const int p = i >> 4, f = i & 15; const double inv = pow(10000.0, -(double)f / 16.0); const double ang = (double)p * inv; ROPE[i] = (float)cos(ang); ROPE[1024 + i] = (float)sin(ang); }
            else { const int j = i - 1024; const int hh = j / 768, di = j % 768; const int delta = di - 383; const int g = hh >> 2; const int dil = g == 0 ? 1 : (g == 1 ? 4 : 16);
                float val = -INFINITY;
                if (delta >= -64 && delta <= 64) { const int rel = delta * dil; const int n = rel < 0 ? -rel : rel; int bk = rel > 0 ? 16 : 0;
                    if (n < 8) bk += n; else { int lg = 8 + (int)(logf((float)n / 8.0f) / logf(128.0f) * 8.0f); if (lg > 15) lg = 15; bk += lg; }
                    val = rel_bias[bk * 12 + hh] * LOG2E; }
                BLUT[j] = val; }
        }
        {
            LAS float* scr = (LAS float*)(L + wave * 16640);
            __syncthreads();
            constexpr int I_IN = 16 * 92, I_BRA = 4 * 16, I_BRB = 16 * 16, I_OUT = 16 * 16, I_GU = 16 * 32, I_DN = 16 * 16;
            constexpr int PER_L = I_IN + I_BRA + I_BRB + I_OUT;
            constexpr int NITEMS = DEPTH * PER_L + DEPTH * NE * (I_GU + I_DN);
            for (int it = gw; it < NITEMS; it += NGW) {
                int r = it;
                if (r < DEPTH * PER_L) {
                    const int l = r / PER_L; r %= PER_L;
                    if (r < I_IN) { const int kb = r / 92, g64 = r % 92; cvt_item(w_in + (size_t)l * D * N_IN, N_IN, D, win_src(2 * g64), win_src(2 * g64 + 1), WIN + (size_t)l * N_IN * D, 64 * g64, 64 * kb, scr, lane, (g64 >> 2) >= 9 && (g64 >> 2) < 14); continue; } r -= I_IN;
                    if (r < I_BRA) { const int kb = r / 16, g64 = r % 16; cvt_item(w_br_a + (size_t)l * 256 * D, D, 256, 64 * g64, 64 * g64 + 32, WBRA + (size_t)l * D * 256, 64 * g64, 64 * kb, scr, lane); continue; } r -= I_BRA;
                    if (r < I_BRB) { const int kb = r / 16, g64 = r % 16; cvt_item(w_br_b + (size_t)l * D * D, D, D, 64 * g64, 64 * g64 + 32, WBRB + (size_t)l * D * D, 64 * g64, 64 * kb, scr, lane); continue; } r -= I_BRB;
                    { const int kb = r / 16, g64 = r % 16; cvt_item(w_out + (size_t)l * D * D, D, D, 64 * g64, 64 * g64 + 32, WOUT + (size_t)l * D * D, 64 * g64, 64 * kb, scr, lane); continue; }
                }
                r -= DEPTH * PER_L;
                if (r < DEPTH * NE * I_GU) { const int le = r / I_GU; r %= I_GU; const int kb = r / 32, g64 = r % 32;
                    cvt_item(w_gate_up + (size_t)le * D * 2048, 2048, D, wgu_src(2 * g64), wgu_src(2 * g64 + 1), WGU + (size_t)le * 2048 * D, 64 * g64, 64 * kb, scr, lane); continue; }
                r -= DEPTH * NE * I_GU;
                { const int le = r / I_DN; r %= I_DN; const int kb = r / 16, g64 = r % 16;
                    cvt_item(w_down + (size_t)le * D * D, D, D, 64 * g64, 64 * g64 + 32, WDN + (size_t)le * D * D, 64 * g64, 64 * kb, scr, lane); }
            }
        }
    }
    SEAM(0);
    if (KIND(1) && IN(1)) { PH_BEGIN();
        for (int m = gw; m < T; m += NGW) { const int b = m >> 12; const float* md = MOD + (size_t)b * 6144;
            norm_row_bf16(x_in + (size_t)m * D, norm1_g, md + 1024, md, H + (size_t)m * D, lane); }
        for (int i = gtid; i < DEPTH * NB * NE * D; i += NGT) { const int k = i & 1023, e = (i >> 10) & 31, b = (i >> 15) & 7, l = i >> 18;
            const float v = norm2_g[l * D + k] * (1.0f + MOD[((size_t)l * NB + b) * 6144 + 4 * 1024 + k]) * w_router[((size_t)l * D + k) * NE + e];
            const unsigned hb = f2bf(v); const float lv = v - __uint_as_float(hb << 16);
            WRHI[i] = (bf16)hb; WRLO[i] = (bf16)f2bf(lv); }
        for (int i = gw; i < DEPTH * NB * NE; i += NGW) { const int e = i & 31, b = (i >> 5) & 7, l = i >> 8; float s = 0.f;
            for (int k = lane; k < D; k += 64) s += MOD[((size_t)l * NB + b) * 6144 + 3 * 1024 + k] * w_router[((size_t)l * D + k) * NE + e];
            s = wave_sum(s); if (lane == 0) RC0[i] = s + b_router[l * NE + e]; }
    }
    SEAM(1);

    for (int l = 0; l < DEPTH; ++l) {
        const int P = 2 + 10 * l;
        if (KIND(2) && IN(P + 0)) { PH_BEGIN();
            pg8::Gemm g{H, WIN + (size_t)l * N_IN * D, D}; pg8::StaticOrder S; S.init(T, N_IN, G, bx);
            pg8::EpiIn E{AQKV, QB, KB, VB, GATE, q_norm_g + l * 64, k_norm_g + l * 64, ROPE};
            pg8::gemm_phase<pg8::EpiIn, pg8::StaticOrder>(L, g, S, E, wave);
        }
        SEAM(P + 0);
        if (KIND(3) && IN(P + 1)) { PH_BEGIN();
            namespace ab = attn_body;
            for (int j = 0; j < 8; ++j) {
                const int uidx = vcu * 8 + j; if (uidx >= 2048) break;
                const int pair = uidx >> 6, idx = uidx & 63; const int b = pair >> 2, kvh = pair & 3, hq = idx >> 4, qb = idx & 15; const int h = kvh * 4 + hq;
                ab::Job J; J.Q = (const ab::bf16*)QB + ((size_t)b * SEQ + qb * 256) * 1024 + h * 64; J.K = (const ab::bf16*)KB + (size_t)b * SEQ * 256 + kvh * 64; J.V = (const ab::bf16*)VB + (size_t)b * SEQ * 256 + kvh * 64;
                J.O = (ab::bf16*)QB + ((size_t)b * SEQ + qb * 256) * 1024 + h * 64; J.lse = nullptr; J.lutg = nullptr; J.NT = 64; J.i0 = 0; J.kq0 = 0; J.dsh = 0; J.cls = 0;
                ab::attn_unit<0, 8>(J, (char*)lds, wave);
            }
            for (int j = 0; j < 6; ++j) {
                const int uidx = vcu * 6 + j; if (uidx >= 1536) break;
                const int g = uidx / 512, r = uidx % 512; const int b = r >> 6, hs = (r >> 4) & 3, combo = r & 15;
                const int dsh = 2 * g; const int Lc = SEQ >> dsh; const int nqb = Lc >> 8;
                const int cls = combo / nqb, qb = combo % nqb; const int i0 = qb * 256;
                int t0 = (i0 >> 6) - 1; const int ntile = Lc >> 6; const int NT = ntile >= 6 ? 6 : 4; if (t0 < 0) t0 = 0; if (t0 > ntile - NT) t0 = ntile - NT;
                const size_t cbase = (size_t)b * SEQ + (size_t)cls * Lc;
                const ab::bf16* aq = (const ab::bf16*)AQKV + (size_t)(g * 3 + 0) * T * 256; const ab::bf16* ak = (const ab::bf16*)AQKV + (size_t)(g * 3 + 1) * T * 256; const ab::bf16* av = (const ab::bf16*)AQKV + (size_t)(g * 3 + 2) * T * 256;
                ab::Job J; J.Q = aq + (cbase + i0) * 256 + hs * 64; J.K = ak + (cbase + t0 * 64) * 256 + hs * 64; J.V = av + (cbase + t0 * 64) * 256 + hs * 64;
                J.O = (ab::bf16*)OAG + (size_t)g * T * 256 + (size_t)b * SEQ * 256 + hs * 64; J.lse = LSE + (size_t)g * T * 4 + (size_t)b * SEQ * 4 + hs; J.lutg = BLUT + (g * 4 + hs) * 768;
                J.NT = NT; J.i0 = i0; J.kq0 = t0 * 64 - i0; J.dsh = dsh; J.cls = cls;
                ab::attn_unit<1, 8>(J, (char*)lds, wave);
            }
        }
        SEAM(P + 1);
        if (KIND(4) && IN(P + 2)) { PH_BEGIN();
            for (int i = gtid; i < T * 32; i += NGT) { const int t = i >> 5, ch = i & 31, hs = ch >> 3;
                const float l0 = LSE[(size_t)t * 4 + hs], l1 = LSE[(size_t)T * 4 + (size_t)t * 4 + hs], l2 = LSE[(size_t)2 * T * 4 + (size_t)t * 4 + hs];
                const float mx = fmaxf(l0, fmaxf(l1, l2)); float w0 = exp2f(l0 - mx), w1 = exp2f(l1 - mx), w2 = exp2f(l2 - mx); const float inv = 1.0f / (w0 + w1 + w2); w0 *= inv; w1 *= inv; w2 *= inv;
                const v4u a = *(const GAS v4u*)(OAG + (size_t)t * 256 + ch * 8), bq = *(const GAS v4u*)(OAG + (size_t)T * 256 + (size_t)t * 256 + ch * 8), cq = *(const GAS v4u*)(OAG + (size_t)2 * T * 256 + (size_t)t * 256 + ch * 8);
                v4u o;
                o.x = pk2(w0 * bfl(a.x) + w1 * bfl(bq.x) + w2 * bfl(cq.x), w0 * bfh(a.x) + w1 * bfh(bq.x) + w2 * bfh(cq.x));
                o.y = pk2(w0 * bfl(a.y) + w1 * bfl(bq.y) + w2 * bfl(cq.y), w0 * bfh(a.y) + w1 * bfh(bq.y) + w2 * bfh(cq.y));
                o.z = pk2(w0 * bfl(a.z) + w1 * bfl(bq.z) + w2 * bfl(cq.z), w0 * bfh(a.z) + w1 * bfh(bq.z) + w2 * bfh(cq.z));
                o.w = pk2(w0 * bfl(a.w) + w1 * bfl(bq.w) + w2 * bfl(cq.w), w0 * bfh(a.w) + w1 * bfh(bq.w) + w2 * bfh(cq.w));
                *(GAS v4u*)(OA + (size_t)t * 256 + ch * 8) = o; }
        }
        SEAM(P + 2);
        if (KIND(5) && IN(P + 3)) { PH_BEGIN();
            pg8::StaticOrder S; S.init(T, D, G, bx);
            { pg8::Gemm g{OA, WBRA + (size_t)l * D * 256, 256}; pg8::EpiMergeA E{GATE, MERGED}; pg8::gemm_phase<pg8::EpiMergeA, pg8::StaticOrder>(L, g, S, E, wave); }
            { pg8::Gemm g{QB, WBRB + (size_t)l * D * D, D}; pg8::EpiMergeB E{GATE, MERGED}; pg8::gemm_phase<pg8::EpiMergeB, pg8::StaticOrder>(L, g, S, E, wave); }
        }
        SEAM(P + 3);
        if (KIND(6) && IN(P + 4)) { PH_BEGIN();
            pg8::Gemm g{MERGED, WOUT + (size_t)l * D * D, D}; pg8::StaticOrder S; S.init(T, D, G, bx);
            pg8::EpiOut E{l == 0 ? x_in : X, X, MOD + (size_t)l * NB * 6144 + 2 * 1024};
            pg8::gemm_phase<pg8::EpiOut, pg8::StaticOrder>(L, g, S, E, wave);
        }
        SEAM(P + 4);
        if (KIND(7) && IN(P + 5)) { PH_BEGIN();
            LAS int* hist = (LAS int*)(L + LDSCTL_OFF + 256);
            for (int vb = bx; vb < 256; vb += G) {
                if (tid < NE) hist[tid] = 0;
                __syncthreads();
                if (wave < 4) {
                    const int tt = vb + 256 * wave; const int r0 = tt * 32; const int b = r0 >> 12; const int i = lane & 31, hf = lane >> 5;
                    const float* xp = X + (size_t)(r0 + i) * D + 8 * hf;
                    const bf16* bh = WRHI + ((size_t)(l * NB + b) * NE + i) * D + 8 * hf; const bf16* bl = WRLO + ((size_t)(l * NB + b) * NE + i) * D + 8 * hf;
                    f32x16 acc = f32x16{}; float ss = 0.f;
#pragma unroll 4
                    for (int s = 0; s < 64; ++s) {
                        const f32x4 x0 = *(const GAS f32x4*)(xp + 16 * s), x1 = *(const GAS f32x4*)(xp + 16 * s + 4);
                        ss += (x0.x * x0.x + x0.y * x0.y) + (x0.z * x0.z + x0.w * x0.w) + (x1.x * x1.x + x1.y * x1.y) + (x1.z * x1.z + x1.w * x1.w);
                        v4u ah, al;
                        { const unsigned h0 = f2bf(x0.x), h1 = f2bf(x0.y), h2 = f2bf(x0.z), h3 = f2bf(x0.w), h4 = f2bf(x1.x), h5 = f2bf(x1.y), h6 = f2bf(x1.z), h7 = f2bf(x1.w);
                          ah.x = h0 | (h1 << 16); ah.y = h2 | (h3 << 16); ah.z = h4 | (h5 << 16); ah.w = h6 | (h7 << 16);
                          al.x = pk2(x0.x - __uint_as_float(h0 << 16), x0.y - __uint_as_float(h1 << 16)); al.y = pk2(x0.z - __uint_as_float(h2 << 16), x0.w - __uint_as_float(h3 << 16));
                          al.z = pk2(x1.x - __uint_as_float(h4 << 16), x1.y - __uint_as_float(h5 << 16)); al.w = pk2(x1.z - __uint_as_float(h6 << 16), x1.w - __uint_as_float(h7 << 16)); }
                        const bf16x8 bhv = *(const GAS bf16x8*)(bh + 16 * s), blv = *(const GAS bf16x8*)(bl + 16 * s);
                        const bf16x8 ahv = __builtin_bit_cast(bf16x8, ah), alv = __builtin_bit_cast(bf16x8, al);
                        acc = __builtin_amdgcn_mfma_f32_32x32x16_bf16(bhv, ahv, acc, 0, 0, 0);
                        acc = __builtin_amdgcn_mfma_f32_32x32x16_bf16(blv, ahv, acc, 0, 0, 0);
                        acc = __builtin_amdgcn_mfma_f32_32x32x16_bf16(bhv, alv, acc, 0, 0, 0);
                    }
                    ss = xsum<32>(ss);
                    const float rs = rsqrtf(ss * (1.0f / D) + EPS);
                    float v[16];
#pragma unroll
                    for (int r = 0; r < 16; ++r) v[r] = rs * acc[r] + RC0[(l * NB + b) * NE + ((r & 3) + 8 * (r >> 2) + 4 * hf)];
                    float bv[8]; int bi[8];
#pragma unroll
                    for (int k = 0; k < 4; ++k) { float best = v[0]; int br = 0;
#pragma unroll
                        for (int r = 1; r < 16; ++r) if (v[r] > best) { best = v[r]; br = r; }
#pragma unroll
                        for (int r = 0; r < 16; ++r) v[r] = (r == br) ? -INFINITY : v[r];
                        bv[k] = best; bi[k] = (br & 3) + 8 * (br >> 2) + 4 * hf; }
#pragma unroll
                    for (int k = 0; k < 4; ++k) { bv[4 + k] = xget32(bv[k], hf); bi[4 + k] = xget32(bi[k], hf); }
                    float tv[4]; int ti[4];
#pragma unroll
                    for (int k = 0; k < 4; ++k) { float best = bv[0]; int bq = 0;
#pragma unroll
                        for (int r = 1; r < 8; ++r) if (bv[r] > best || (bv[r] == best && bi[r] < bi[bq])) { best = bv[r]; bq = r; }
                        int sel = bi[0];
#pragma unroll
                        for (int r = 0; r < 8; ++r) { if (r == bq) sel = bi[r]; }
#pragma unroll
                        for (int r = 0; r < 8; ++r) bv[r] = (r == bq) ? -INFINITY : bv[r];
                        tv[k] = best; ti[k] = sel; }
                    if (hf == 0) {
                        const float e1 = __expf(tv[1] - tv[0]), e2 = __expf(tv[2] - tv[0]), e3 = __expf(tv[3] - tv[0]); const float inv = 1.0f / (1.0f + e1 + e2 + e3);
                        const int tok = r0 + i;
                        *(GAS i32x4*)(TOPE + (size_t)tok * 4) = (i32x4){ti[0], ti[1], ti[2], ti[3]};
                        *(GAS f32x4*)(TOPW + (size_t)tok * 4) = (f32x4){inv, e1 * inv, e2 * inv, e3 * inv};
#pragma unroll
                        for (int k = 0; k < 4; ++k) atomicAdd((int*)&hist[ti[k]], 1);
                    }
                }
                __syncthreads();
                if (tid < NE) HIST[vb * NE + tid] = hist[tid];
                __syncthreads();
            }
            for (int m = gw; m < T; m += NGW) { const int b = m >> 12; const float* md = MOD + ((size_t)l * NB + b) * 6144;
                norm_row_bf16(X + (size_t)m * D, norm2_g + l * D, md + 4 * 1024, md + 3 * 1024, H + (size_t)m * D, lane); }
        }
        SEAM(P + 5);
        if (KIND(8) && IN(P + 6)) { PH_BEGIN();
            LAS int* sm = (LAS int*)L;
            for (int vb = bx; vb < 256; vb += G) {
                { const int e = tid & 31, seg = tid >> 5; int tot = 0, bef = 0;
                    for (int q = seg * 16; q < seg * 16 + 16; ++q) { const int hv = HIST[q * NE + e]; tot += hv; if (q < vb) bef += hv; }
                    sm[tid] = tot; sm[512 + tid] = bef; }
                __syncthreads();
                if (tid < NE) { int tot = 0, bef = 0;
                    for (int s = 0; s < 16; ++s) { tot += sm[s * 32 + tid]; bef += sm[512 + s * 32 + tid]; }
                    sm[1024 + tid] = bef; sm[1056 + tid] = (tot + 255) & ~255; }
                __syncthreads();
                if (tid == 0) { int run = 0; for (int e = 0; e < NE; ++e) { const int pd = sm[1056 + e]; sm[1056 + e] = run; sm[1024 + e] += run;
                        if (vb == 0) { for (int q = run >> 8; q < (run + pd) >> 8; ++q) TILEE[q] = e; }
                        run += pd; }
                    if (vb == 0) TILEE[1000] = run >> 8; }
                __syncthreads();
                if (tid < 128) { const int tt = vb + 256 * (tid >> 5); const int tok = tt * 32 + (tid & 31);
                    const i32x4 te = *(const GAS i32x4*)(TOPE + (size_t)tok * 4); const f32x4 tw = *(const GAS f32x4*)(TOPW + (size_t)tok * 4);
                    const int s0 = atomicAdd((int*)&sm[1024 + te.x], 1), s1 = atomicAdd((int*)&sm[1024 + te.y], 1), s2 = atomicAdd((int*)&sm[1024 + te.z], 1), s3 = atomicAdd((int*)&sm[1024 + te.w], 1);
                    *(GAS i32x4*)(SLOT + (size_t)tok * 4) = (i32x4){s0, s1, s2, s3};
                    ROWW[s0] = tw.x; ROWW[s1] = tw.y; ROWW[s2] = tw.z; ROWW[s3] = tw.w;
                    sm[2048 + tid * 4 + 0] = s0; sm[2048 + tid * 4 + 1] = s1; sm[2048 + tid * 4 + 2] = s2; sm[2048 + tid * 4 + 3] = s3; }
                __syncthreads();
                for (int p = wave; p < 512; p += NWAVES) { const int q = p >> 2; const int tt = vb + 256 * (q >> 5); const int tok = tt * 32 + (q & 31); const int slot = sm[2048 + p];
                    const GAS v4u* src = (const GAS v4u*)(H + (size_t)tok * D); GAS v4u* dst = (GAS v4u*)(XS + (size_t)slot * D);
                    const v4u a = src[lane], b2 = src[64 + lane]; dst[lane] = a; dst[64 + lane] = b2; }
                __syncthreads();
            }
        }
        SEAM(P + 6);
        if (KIND(9) && IN(P + 7)) { PH_BEGIN();
            const int nmt = __builtin_amdgcn_readfirstlane(__hip_atomic_load(TILEE + 1000, __ATOMIC_RELAXED, __HIP_MEMORY_SCOPE_AGENT));
            pg8::Gemm g{XS, WGU + (size_t)l * NE * 2048 * D, D}; pg8::MoeOrder S{TILEE, nmt * 8, 8, G, vcu};
            pg8::EpiGU E{b_gate_up + (size_t)l * NE * 2048, ACT};
            pg8::gemm_phase<pg8::EpiGU, pg8::MoeOrder>(L, g, S, E, wave);
        }
        SEAM(P + 7);
        if (KIND(10) && IN(P + 8)) { PH_BEGIN();
            const int nmt = __builtin_amdgcn_readfirstlane(__hip_atomic_load(TILEE + 1000, __ATOMIC_RELAXED, __HIP_MEMORY_SCOPE_AGENT));
            pg8::Gemm g{ACT, WDN + (size_t)l * NE * D * D, D}; pg8::MoeOrder S{TILEE, nmt * 4, 4, G, vcu};
            pg8::EpiDN E{b_down + (size_t)l * NE * D, ROWW, YB};
            pg8::gemm_phase<pg8::EpiDN, pg8::MoeOrder>(L, g, S, E, wave);
        }
        SEAM(P + 8);
        if (KIND(11) && IN(P + 9)) { PH_BEGIN();
            const bool lastl = (l == DEPTH - 1);
            for (int m = gw; m < T; m += NGW) { const int b = m >> 12;
                i32x4 sl; sl.x = __hip_atomic_load(SLOT + (size_t)m * 4 + 0, RLX_AGENT); sl.y = __hip_atomic_load(SLOT + (size_t)m * 4 + 1, RLX_AGENT); sl.z = __hip_atomic_load(SLOT + (size_t)m * 4 + 2, RLX_AGENT); sl.w = __hip_atomic_load(SLOT + (size_t)m * 4 + 3, RLX_AGENT);
                const float* g2 = MOD + ((size_t)l * NB + b) * 6144 + 5 * 1024;
                f32x4 v[4]; float s = 0.f;
#pragma unroll
                for (int j = 0; j < 4; ++j) { const int c = 256 * j + 4 * lane;
                    const v2u y0 = *(const GAS v2u*)(YB + (size_t)sl.x * D + c), y1 = *(const GAS v2u*)(YB + (size_t)sl.y * D + c), y2 = *(const GAS v2u*)(YB + (size_t)sl.z * D + c), y3 = *(const GAS v2u*)(YB + (size_t)sl.w * D + c);
                    f32x4 ys; ys.x = (bfl(y0.x) + bfl(y1.x)) + (bfl(y2.x) + bfl(y3.x)); ys.y = (bfh(y0.x) + bfh(y1.x)) + (bfh(y2.x) + bfh(y3.x));
                    ys.z = (bfl(y0.y) + bfl(y1.y)) + (bfl(y2.y) + bfl(y3.y)); ys.w = (bfh(y0.y) + bfh(y1.y)) + (bfh(y2.y) + bfh(y3.y));
                    const f32x4 xv = *(const GAS f32x4*)(X + (size_t)m * D + c); const f32x4 gg = *(const GAS f32x4*)(g2 + c);
                    v[j] = xv + gg * ys;
                    if (!lastl) *(GAS f32x4*)(X + (size_t)m * D + c) = v[j];
                    s += (v[j].x * v[j].x + v[j].y * v[j].y) + (v[j].z * v[j].z + v[j].w * v[j].w); }
                const float rs = rsqrtf(wave_sum(s) * (1.0f / D) + EPS);
                if (!lastl) { const float* md = MOD + ((size_t)(l + 1) * NB + b) * 6144; const float* gn = norm1_g + (l + 1) * D;
#pragma unroll
                    for (int j = 0; j < 4; ++j) { const int c = 256 * j + 4 * lane;
                        const f32x4 gg = *(const GAS f32x4*)(gn + c), s1 = *(const GAS f32x4*)(md + 1024 + c), s0 = *(const GAS f32x4*)(md + c);
                        const f32x4 y = (v[j] * rs * gg) * (s1 + 1.0f) + s0; v2u o; o.x = pk2(y.x, y.y); o.y = pk2(y.z, y.w); *(GAS v2u*)(H + (size_t)m * D + c) = o; }
                } else {
#pragma unroll
                    for (int j = 0; j < 4; ++j) { const int c = 256 * j + 4 * lane; const f32x4 gg = *(const GAS f32x4*)(final_g + c); *(GAS f32x4*)(ap->out + (size_t)m * D + c) = v[j] * rs * gg; }
                }
            }
        }
        SEAM(P + 9);
    }
#undef IN
#undef SEAM
}

extern "C" void kernel_launch(void* const* d_in, const int* in_sizes, int n_in, void* d_out, int out_size, void* d_ws, size_t ws_size, hipStream_t stream) {
    static int grid = 0;
    if (grid == 0) {
        if (n_in != 20 || in_sizes[0] != T * D || out_size != T * D || ws_size < WS_END) { fprintf(stderr, "kernel_launch: unexpected shapes (n_in %d, in0 %d, out %d, ws %zu < %zu); nothing launched\n", n_in, n_in > 0 ? in_sizes[0] : -1, out_size, ws_size, (size_t)WS_END); grid = -1; return; }
        int dev = 0, cus = 0, per_cu = 0;
        if (hipGetDevice(&dev) != hipSuccess || hipDeviceGetAttribute(&cus, hipDeviceAttributeMultiprocessorCount, dev) != hipSuccess) { grid = -1; return; }
        if (hipFuncSetAttribute((const void*)mk_fwd, hipFuncAttributeMaxDynamicSharedMemorySize, LDS_BYTES) != hipSuccess) { fprintf(stderr, "kernel_launch: hipFuncSetAttribute failed\n"); grid = -1; return; }
        if (hipOccupancyMaxActiveBlocksPerMultiprocessor(&per_cu, (const void*)mk_fwd, NWAVES * 64, LDS_BYTES) != hipSuccess || per_cu < 1)
            fprintf(stderr, "kernel_launch: note: occupancy query reports %d workgroups per CU\n", per_cu);
        (void)hipGetLastError();
        grid = cus < 256 ? cus : 256;
        if (grid != 256) fprintf(stderr, "kernel_launch: %d CUs; this kernel's unit deals assume 256\n", grid);
    }
    if (grid < 0) return;
    if (hipMemsetAsync((char*)d_ws + WS_CTL, 0, CTL_ZERO_BYTES, stream) != hipSuccess) { fprintf(stderr, "kernel_launch: memset failed\n"); return; }
    Args a{};
    for (int i = 0; i < 20; ++i) a.in[i] = (const float*)d_in[i];
    a.out = (float*)d_out; a.ws = (unsigned char*)d_ws; a.pad = 0;
#if MK_PER_PHASE
    for (int p = 0; p < N_PHASES; ++p) { a.ph_lo = p; a.ph_hi = p + 1; a.li = 0; hipLaunchKernelGGL(mk_fwd, dim3(grid), dim3(NWAVES * 64), LDS_BYTES, stream, a); }
#else
    a.ph_lo = 0; a.ph_hi = N_PHASES; a.li = 0;
    hipLaunchKernelGGL(mk_fwd, dim3(grid), dim3(NWAVES * 64), LDS_BYTES, stream, a);
#endif
    const hipError_t le = hipPeekAtLastError();
    if (le != hipSuccess) fprintf(stderr, "kernel_launch: launch failed: %s\n", hipGetErrorName(le));
}
```

```cpp
#include <hip/hip_runtime.h>
#include <hip/hip_bf16.h>
#include <cstdio>
#include <cstdint>
#include <cmath>

#ifndef PH_KIND_MASK
#define PH_KIND_MASK 0xFFF
#endif
#ifndef PROBE_MASK
#define PROBE_MASK 0
#endif
#ifndef PROBE_P0
#define PROBE_P0 0
#endif
#ifndef MK_PER_PHASE
#define MK_PER_PHASE 0
#endif

constexpr int NB = 8, SEQ = 4096, T = NB * SEQ, D = 1024, DEPTH = 2;
constexpr int N_IN = 5888, NE = 32, TOPK = 4;
constexpr int NASSIGN = T * TOPK;
constexpr int MAX_MT = NASSIGN / 256 + NE;
constexpr int CAP_ROWS = MAX_MT * 256;
constexpr float C2 = 0.125f * 1.4426950408889634f;
constexpr float LOG2E = 1.4426950408889634f;
constexpr float EPS = 1e-6f;

__device__ __forceinline__ int lane_id_asm() { int l; asm volatile("v_mbcnt_lo_u32_b32 %0, -1, 0\n\tv_mbcnt_hi_u32_b32 %0, -1, %0" : "=v"(l)); return l; }

template <int M> __device__ __forceinline__ float xsum(float v) {
    if constexpr (M < 32) return v + __int_as_float(__builtin_amdgcn_ds_swizzle(__float_as_int(v), 0x1f | (M << 10)));
    else { auto rr = __builtin_amdgcn_permlane32_swap(__float_as_uint(v), __float_as_uint(v), false, false); return __uint_as_float(rr[0]) + __uint_as_float(rr[1]); }
}
template <class Tv> __device__ __forceinline__ Tv xget32(Tv v, int hf) {
    auto rr = __builtin_amdgcn_permlane32_swap(__builtin_bit_cast(unsigned, v), __builtin_bit_cast(unsigned, v), false, false); return __builtin_bit_cast(Tv, hf ? rr[0] : rr[1]);
}

namespace pg8 {
#define PG8_LAS __attribute__((address_space(3)))
typedef unsigned short bf16_t;
typedef short bf16x8 __attribute__((ext_vector_type(8)));
typedef float f32x4 __attribute__((ext_vector_type(4)));
typedef unsigned u32x4 __attribute__((ext_vector_type(4)));
typedef unsigned u32x2 __attribute__((ext_vector_type(2)));
constexpr int BM = 256, BK = 64, HALF = 128, HTB = HALF * BK * 2, STAGE_BYTES = 8 * HTB, NXCD = 8, WGM = 8;

__host__ __device__ __forceinline__ int lds_byte(int r, int c) { const int st = (r >> 4) * 2 + (c >> 5), rr = r & 15, cc = c & 31, ob = rr * 64 + cc * 2; return st * 1024 + (ob ^ (((ob >> 9) & 1) << 5)); }
__host__ __device__ __forceinline__ void stage_rc(int b, int& R, int& C) { const int st = b / 1024, sb = b % 1024, swz = sb ^ (((sb >> 9) & 1) << 5); R = (st >> 1) * 16 + swz / 64; C = (st & 1) * 32 + (swz % 64) / 2; }
__host__ __device__ __forceinline__ int perm32(int rho) { const int n = rho >> 4, i = rho & 15; return 8 * (i >> 2) + 4 * n + (i & 3); }

struct Unit { int pm, pn; };
struct Gemm { const bf16_t* A; const bf16_t* Bt; int K; };

struct StaticOrder {
    int nM, nN, nwg, G, c;
    __device__ void init(int M, int N, int G_, int c_) { nM = M / BM; nN = N / BM; nwg = nM * nN; G = G_; c = c_; }
    __device__ bool next(int i, Unit& u) const {
        const long L = (long)i * G + c; if (L >= nwg) return false;
        int wgid = (int)L; { const int q = nwg / NXCD, r = nwg % NXCD, xcd = wgid % NXCD, off = wgid / NXCD; wgid = (xcd < r ? xcd * (q + 1) : r * (q + 1) + (xcd - r) * q) + off; }
        const int nig = WGM * nN, gid = wgid / nig, fm = gid * WGM, gsz = (nM - fm) < WGM ? (nM - fm) : WGM;
        u.pm = fm + ((wgid % nig) % gsz); u.pn = (wgid % nig) / gsz; return true;
    }
};
struct MoeOrder {
    const int* tile_e; int n_units, nN, G, vcu;
    __device__ bool next(int i, Unit& u) const {
        const long L = (long)i * G + vcu; if (L >= n_units) return false;
        const int mt = (int)L / nN, pl = (int)L % nN; const int e = __builtin_amdgcn_readfirstlane(__hip_atomic_load(tile_e + mt, __ATOMIC_RELAXED, __HIP_MEMORY_SCOPE_AGENT));
        u.pm = mt; u.pn = e * nN + pl; return true;
    }
};

__device__ __forceinline__ unsigned cvt_pk_bf16(float lo, float hi) { unsigned r; asm volatile("v_cvt_pk_bf16_f32 %0, %1, %2" : "=v"(r) : "v"(lo), "v"(hi)); return r; }
__device__ __forceinline__ float bf_lo(unsigned w) { return __uint_as_float(w << 16); }
__device__ __forceinline__ float bf_hi(unsigned w) { return __uint_as_float(w & 0xffff0000u); }
__device__ __forceinline__ float sigmoid_f(float x) { return __builtin_amdgcn_rcpf(1.0f + __builtin_amdgcn_exp2f(-LOG2E * x)); }

template <class Epi, class Sched>
__device__ __forceinline__ void gemm_phase(PG8_LAS unsigned char* lds, const Gemm g, const Sched& S, const Epi& E, const int wid_in) {
    int wid = wid_in; asm volatile("" : "+s"(wid));
    const int lane = lane_id_asm(), tid = wid * 64 + lane, wr = wid >> 2, wc = wid & 3, fr = lane & 15, fq = lane >> 4;
    const int K = g.K, nt = K / BK;
    unsigned voff[2];
#pragma unroll
    for (int i = 0; i < 2; ++i) { int R, C; stage_rc(tid * 16 + i * 8192, R, C); voff[i] = (unsigned)(R * K + C) * 2u; }
    const size_t kstep = (size_t)(BK * 2);
    const size_t hstep = (size_t)HALF * K * 2;
    const size_t tstep = 2 * hstep;
    const unsigned ldsw = (unsigned)wid * 1024u;
    const int aoff = lds_byte(wr * 64 + fr, fq * 8), boff = lds_byte(wc * 32 + fr, fq * 8);
#define PG8_SA(b, h) (((b) * 2 + (h)) * HTB)
#define PG8_SB(b, h) ((4 + (b) * 2 + (h)) * HTB)
#define PG8_STAGE(bufoff, gbase) do { _Pragma("unroll") for (int _i = 0; _i < 2; ++_i) \
        __builtin_amdgcn_global_load_lds((const unsigned*)((const char*)(gbase) + voff[_i]), (PG8_LAS unsigned*)(lds + (bufoff) + ldsw + _i * 8192), 16, 0, 0); } while (0)
#define PG8_LDA(dst, b, h) do { _Pragma("unroll") for (int m = 0; m < 4; ++m) _Pragma("unroll") for (int k = 0; k < 2; ++k) dst[m][k] = *(const PG8_LAS bf16x8*)(lds + PG8_SA(b, h) + aoff + m * 2048 + k * 1024); } while (0)
#define PG8_LDB(dst, b, h) do { _Pragma("unroll") for (int n = 0; n < 2; ++n) _Pragma("unroll") for (int k = 0; k < 2; ++k) dst[n][k] = *(const PG8_LAS bf16x8*)(lds + PG8_SB(b, h) + boff + n * 2048 + k * 1024); } while (0)
#define PG8_MMA(ai, bj, At, Bt) do { __builtin_amdgcn_s_setprio(1); _Pragma("unroll") for (int m = 0; m < 4; ++m) _Pragma("unroll") for (int n = 0; n < 2; ++n) _Pragma("unroll") for (int k = 0; k < 2; ++k) \
        acc[ai][bj][m][n] = __builtin_amdgcn_mfma_f32_16x16x32_bf16(Bt[n][k], At[m][k], acc[ai][bj][m][n], 0, 0, 0); __builtin_amdgcn_s_setprio(0); } while (0)
#define PG8_WAIT_V(n) asm volatile("s_waitcnt vmcnt(" #n ")" ::: "memory")
#define PG8_WAIT_L(n) asm volatile("s_waitcnt lgkmcnt(" #n ")" ::: "memory")
#define PG8_BAR __builtin_amdgcn_s_barrier()
#define PG8_SCHED __builtin_amdgcn_sched_barrier(0)
    Unit cur, nxt; int ui = 0;
    if (!S.next(0, cur)) return;
    f32x4 acc[2][2][4][2];
#pragma unroll
    for (int a = 0; a < 2; ++a)
#pragma unroll
        for (int b = 0; b < 2; ++b)
#pragma unroll
            for (int m = 0; m < 4; ++m)
#pragma unroll
                for (int n = 0; n < 2; ++n) acc[a][b][m][n] = (f32x4){0.f, 0.f, 0.f, 0.f};
    bf16x8 At[4][2], B0[2][2], B1[2][2];
    const char* cA = (const char*)g.A + (size_t)cur.pm * tstep; const char* cB = (const char*)g.Bt + (size_t)cur.pn * tstep;
    PG8_STAGE(PG8_SB(0, 0), cB); PG8_STAGE(PG8_SB(0, 1), cB + hstep); PG8_STAGE(PG8_SA(0, 0), cA); PG8_STAGE(PG8_SA(0, 1), cA + hstep);
    if (wr == 1) PG8_BAR;
    PG8_WAIT_V(2); PG8_BAR;
    PG8_STAGE(PG8_SB(1, 0), cB + kstep); PG8_STAGE(PG8_SA(1, 0), cA + kstep); PG8_STAGE(PG8_SB(1, 1), cB + hstep + kstep);
    PG8_WAIT_V(6); PG8_BAR;
    for (;;) {
        const bool has_next = S.next(ui + 1, nxt);
        const char* nA = has_next ? (const char*)g.A + (size_t)nxt.pm * tstep : cA; const char* nB = has_next ? (const char*)g.Bt + (size_t)nxt.pn * tstep : cB;
        for (int t = 0; t < nt; t += 2) {
            const bool last = (t == nt - 2);
            const char* a1 = cA + (size_t)(t + 1) * kstep;
            const char* a2 = last ? nA : cA + (size_t)(t + 2) * kstep; const char* b2 = last ? nB : cB + (size_t)(t + 2) * kstep;
            const char* a3 = a2 + kstep; const char* b3 = b2 + kstep;
            PG8_LDB(B0, 0, 0); PG8_LDB(B1, 0, 1); PG8_SCHED; PG8_LDA(At, 0, 0); PG8_STAGE(PG8_SA(1, 1), a1 + hstep);
            PG8_WAIT_V(8); PG8_WAIT_L(0); PG8_BAR; PG8_MMA(0, 0, At, B0); PG8_MMA(0, 1, At, B1); PG8_BAR; PG8_SCHED;
            PG8_LDA(At, 0, 1); PG8_STAGE(PG8_SB(0, 0), b2); PG8_STAGE(PG8_SB(0, 1), b2 + hstep); PG8_STAGE(PG8_SA(0, 0), a2);
            PG8_WAIT_V(8); PG8_WAIT_L(0); PG8_BAR; PG8_MMA(1, 0, At, B0); PG8_MMA(1, 1, At, B1); PG8_BAR; PG8_SCHED;
            PG8_LDB(B0, 1, 0); PG8_LDB(B1, 1, 1); PG8_SCHED; PG8_LDA(At, 1, 0); PG8_STAGE(PG8_SA(0, 1), a2 + hstep);
            PG8_WAIT_V(8); PG8_WAIT_L(0); PG8_BAR; PG8_MMA(0, 0, At, B0); PG8_MMA(0, 1, At, B1); PG8_BAR; PG8_SCHED;
            PG8_LDA(At, 1, 1); PG8_STAGE(PG8_SB(1, 0), b3); PG8_STAGE(PG8_SB(1, 1), b3 + hstep); PG8_STAGE(PG8_SA(1, 0), a3);
            PG8_WAIT_V(8); PG8_WAIT_L(0); PG8_BAR; PG8_MMA(1, 0, At, B0); PG8_MMA(1, 1, At, B1); PG8_BAR; PG8_SCHED;
        }
        if (wr == 0) PG8_BAR;
        E(acc, cur, wr, wc, fr, fq);
        if (!has_next) break;
#pragma unroll
        for (int a = 0; a < 2; ++a)
#pragma unroll
            for (int b = 0; b < 2; ++b)
#pragma unroll
                for (int m = 0; m < 4; ++m)
#pragma unroll
                    for (int n = 0; n < 2; ++n) acc[a][b][m][n] = (f32x4){0.f, 0.f, 0.f, 0.f};
        cur = nxt; cA = nA; cB = nB; ++ui;
        if (wr == 1) PG8_BAR;
    }
    PG8_WAIT_V(0);
    PG8_BAR;
#undef PG8_SA
#undef PG8_SB
#undef PG8_STAGE
#undef PG8_LDA
#undef PG8_LDB
#undef PG8_MMA
#undef PG8_WAIT_V
#undef PG8_WAIT_L
#undef PG8_BAR
#undef PG8_SCHED
}

#define EPI_ROWS(...) _Pragma("unroll") for (int ai = 0; ai < 2; ++ai) _Pragma("unroll") for (int m = 0; m < 4; ++m) { const int row = u.pm * BM + ai * HALF + wr * 64 + m * 16 + fr; __VA_ARGS__ }
__device__ __forceinline__ u32x4 pack8(const f32x4 a, const f32x4 b) { u32x4 w; w.x = cvt_pk_bf16(a[0], a[1]); w.y = cvt_pk_bf16(a[2], a[3]); w.z = cvt_pk_bf16(b[0], b[1]); w.w = cvt_pk_bf16(b[2], b[3]); return w; }

struct EpiIn {
    bf16_t* aqkv; bf16_t* qb; bf16_t* kb; bf16_t* vb; bf16_t* gate; const float* qg; const float* kg; const float* rope;
    __device__ __forceinline__ void operator()(const f32x4 (&acc)[2][2][4][2], const Unit& u, int wr, int wc, int fr, int fq) const {
        const int pn = u.pn;
        if (pn >= 9 && pn < 14) {
            const bool isq = pn < 13; const int head = isq ? (pn - 9) * 4 + wc : wc; bf16_t* dst = isq ? qb : kb; const int pitch = isq ? 1024 : 256;
            const float* gvec = isq ? qg : kg; const float osc = isq ? C2 : 1.0f;
            f32x4 gv[2][2];
#pragma unroll
            for (int bj = 0; bj < 2; ++bj)
#pragma unroll
                for (int n = 0; n < 2; ++n) gv[bj][n] = *(const f32x4*)(gvec + 32 * bj + 16 * n + 4 * fq);
            EPI_ROWS(
                float ss = 0.f;
                _Pragma("unroll") for (int bj = 0; bj < 2; ++bj) _Pragma("unroll") for (int n = 0; n < 2; ++n) { const f32x4 x = acc[ai][bj][m][n]; ss += (x[0] * x[0] + x[1] * x[1]) + (x[2] * x[2] + x[3] * x[3]); }
                ss = xsum<16>(ss); ss = xsum<32>(ss);
                const float sc = rsqrtf(ss * (1.0f / 64.0f) + EPS) * osc;
                const int t = row & (SEQ - 1);
                _Pragma("unroll") for (int bj = 0; bj < 2; ++bj) {
                    const int pos = bj == 0 ? (t >> 6) : (t & 63);
                    const f32x4 cs = *(const f32x4*)(rope + pos * 16 + 4 * fq); const f32x4 sn = *(const f32x4*)(rope + 1024 + pos * 16 + 4 * fq);
                    const f32x4 y0 = acc[ai][bj][m][0] * sc * gv[bj][0]; const f32x4 y1 = acc[ai][bj][m][1] * sc * gv[bj][1];
                    const f32x4 o0 = y0 * cs - y1 * sn; const f32x4 o1 = y1 * cs + y0 * sn;
                    bf16_t* p = dst + (size_t)row * pitch + head * 64 + 32 * bj + 4 * fq;
                    u32x2 w0; w0.x = cvt_pk_bf16(o0[0], o0[1]); w0.y = cvt_pk_bf16(o0[2], o0[3]);
                    u32x2 w1; w1.x = cvt_pk_bf16(o1[0], o1[1]); w1.y = cvt_pk_bf16(o1[2], o1[3]);
                    *(u32x2*)p = w0; *(u32x2*)(p + 16) = w1;
                }
            )
        } else {
            bf16_t* dst; int pitch, colt, dsh = 0; float sc = 1.0f; bool sig = false, fold = false;
            if (pn < 9) { dst = aqkv + (size_t)pn * T * 256; pitch = 256; colt = 0; fold = true; dsh = 2 * (pn / 3); if (pn % 3 == 0) sc = C2; }
            else if (pn == 14) { dst = vb; pitch = 256; colt = 0; }
            else { dst = gate; pitch = 2048; colt = (pn - 15) * 256; sig = true; }
            const int col0 = colt + wc * 32 + 8 * fq;
            EPI_ROWS(
                int drow = row;
                if (fold) { const int t = row & (SEQ - 1); drow = (row & ~(SEQ - 1)) | ((t & ((1 << dsh) - 1)) << (12 - dsh)) | (t >> dsh); }
                bf16_t* rowp = dst + (size_t)drow * pitch + col0;
                _Pragma("unroll") for (int bj = 0; bj < 2; ++bj) {
                    f32x4 v0 = acc[ai][bj][m][0], v1 = acc[ai][bj][m][1];
                    if (sig) { _Pragma("unroll") for (int j = 0; j < 4; ++j) { v0[j] = sigmoid_f(v0[j]); v1[j] = sigmoid_f(v1[j]); } }
                    else { v0 = v0 * sc; v1 = v1 * sc; }
                    *(u32x4*)(rowp + bj * HALF) = pack8(v0, v1);
                }
            )
        }
    }
};
struct EpiMergeA {
    const bf16_t* gate; bf16_t* merged;
    __device__ __forceinline__ void operator()(const f32x4 (&acc)[2][2][4][2], const Unit& u, int wr, int wc, int fr, int fq) const {
        const int col0 = u.pn * BM + wc * 32 + 8 * fq;
        EPI_ROWS(
            _Pragma("unroll") for (int bj = 0; bj < 2; ++bj) {
                const u32x4 gw = *(const u32x4*)(gate + (size_t)row * 2048 + col0 + bj * HALF);
                f32x4 v0 = acc[ai][bj][m][0], v1 = acc[ai][bj][m][1];
                v0[0] *= bf_lo(gw.x); v0[1] *= bf_hi(gw.x); v0[2] *= bf_lo(gw.y); v0[3] *= bf_hi(gw.y);
                v1[0] *= bf_lo(gw.z); v1[1] *= bf_hi(gw.z); v1[2] *= bf_lo(gw.w); v1[3] *= bf_hi(gw.w);
                *(u32x4*)(merged + (size_t)row * 1024 + col0 + bj * HALF) = pack8(v0, v1);
            }
        )
    }
};
struct EpiMergeB {
    const bf16_t* gate; bf16_t* merged;
    __device__ __forceinline__ void operator()(const f32x4 (&acc)[2][2][4][2], const Unit& u, int wr, int wc, int fr, int fq) const {
        const int col0 = u.pn * BM + wc * 32 + 8 * fq;
        EPI_ROWS(
            _Pragma("unroll") for (int bj = 0; bj < 2; ++bj) {
                const u32x4 gw = *(const u32x4*)(gate + (size_t)row * 2048 + 1024 + col0 + bj * HALF);
                bf16_t* mp = merged + (size_t)row * 1024 + col0 + bj * HALF;
                const u32x4 mw = *(const u32x4*)mp;
                f32x4 v0 = acc[ai][bj][m][0], v1 = acc[ai][bj][m][1];
                v0[0] = v0[0] * bf_lo(gw.x) + bf_lo(mw.x); v0[1] = v0[1] * bf_hi(gw.x) + bf_hi(mw.x); v0[2] = v0[2] * bf_lo(gw.y) + bf_lo(mw.y); v0[3] = v0[3] * bf_hi(gw.y) + bf_hi(mw.y);
                v1[0] = v1[0] * bf_lo(gw.z) + bf_lo(mw.z); v1[1] = v1[1] * bf_hi(gw.z) + bf_hi(mw.z); v1[2] = v1[2] * bf_lo(gw.w) + bf_lo(mw.w); v1[3] = v1[3] * bf_hi(gw.w) + bf_hi(mw.w);
                *(u32x4*)mp = pack8(v0, v1);
            }
        )
    }
};
struct EpiOut {
    const float* xin; float* xout; const float* g1;
    __device__ __forceinline__ void operator()(const f32x4 (&acc)[2][2][4][2], const Unit& u, int wr, int wc, int fr, int fq) const {
        const int col0 = u.pn * BM + wc * 32 + 8 * fq; const int b = (u.pm * BM) >> 12;
        f32x4 gv[2][2];
#pragma unroll
        for (int bj = 0; bj < 2; ++bj)
#pragma unroll
            for (int n = 0; n < 2; ++n) gv[bj][n] = *(const f32x4*)(g1 + (size_t)b * 6144 + col0 + bj * HALF + 4 * n);
        EPI_ROWS(
            _Pragma("unroll") for (int bj = 0; bj < 2; ++bj) {
                const size_t off = (size_t)row * 1024 + col0 + bj * HALF;
                const f32x4 x0 = *(const f32x4*)(xin + off), x1 = *(const f32x4*)(xin + off + 4);
                *(f32x4*)(xout + off) = x0 + gv[bj][0] * acc[ai][bj][m][0]; *(f32x4*)(xout + off + 4) = x1 + gv[bj][1] * acc[ai][bj][m][1];
            }
        )
    }
};
struct EpiGU {
    const float* bgu; bf16_t* act;
    __device__ __forceinline__ void operator()(const f32x4 (&acc)[2][2][4][2], const Unit& u, int wr, int wc, int fr, int fq) const {
        const int e = u.pn >> 3, pl = u.pn & 7; const int c0 = pl * 128 + wc * 32 + 8 * fq;
        const float* bp = bgu + (size_t)e * 2048 + c0;
        const f32x4 bg0 = *(const f32x4*)bp, bg1 = *(const f32x4*)(bp + 4), bl0 = *(const f32x4*)(bp + 1024), bl1 = *(const f32x4*)(bp + 1028);
        EPI_ROWS(
            f32x4 o[2];
            _Pragma("unroll") for (int n = 0; n < 2; ++n) {
                const f32x4 gl = acc[ai][0][m][n] + (n == 0 ? bg0 : bg1); const f32x4 ln = acc[ai][1][m][n] + (n == 0 ? bl0 : bl1);
                _Pragma("unroll") for (int j = 0; j < 4; ++j) { const float xg = fminf(gl[j], 7.0f); const float xl = fminf(fmaxf(ln[j], -7.0f), 7.0f); o[n][j] = xg * sigmoid_f(1.702f * xg) * (xl + 1.0f); }
            }
            *(u32x4*)(act + (size_t)row * 1024 + c0) = pack8(o[0], o[1]);
        )
    }
};
struct EpiDN {
    const float* bdn; const float* roww; bf16_t* y;
    __device__ __forceinline__ void operator()(const f32x4 (&acc)[2][2][4][2], const Unit& u, int wr, int wc, int fr, int fq) const {
        const int e = u.pn >> 2, pl = u.pn & 3; const int col0 = pl * BM + wc * 32 + 8 * fq;
        f32x4 bv[2][2];
#pragma unroll
        for (int bj = 0; bj < 2; ++bj)
#pragma unroll
            for (int n = 0; n < 2; ++n) bv[bj][n] = *(const f32x4*)(bdn + (size_t)e * 1024 + col0 + bj * HALF + 4 * n);
        EPI_ROWS(
            const float w = roww[row];
            _Pragma("unroll") for (int bj = 0; bj < 2; ++bj)
                *(u32x4*)(y + (size_t)row * 1024 + col0 + bj * HALF) = pack8((acc[ai][bj][m][0] + bv[bj][0]) * w, (acc[ai][bj][m][1] + bv[bj][1]) * w);
        )
    }
};
}

namespace attn_body {
using bf16 = __hip_bfloat16;
using bf16x8 = __attribute__((ext_vector_type(8))) short;
using s16x4 = __attribute__((ext_vector_type(4))) short;
using f32x16 = __attribute__((ext_vector_type(16))) float;
using u32x4 = __attribute__((ext_vector_type(4))) unsigned;
constexpr int D = 64, NW = 8, QBLK = 32, QB = QBLK * NW, KVBLK = 64;
__device__ __forceinline__ int crow(int r, int hi) { return (r & 3) + 8 * (r >> 2) + 4 * hi; }
#define SBAR() __builtin_amdgcn_sched_barrier(0)
constexpr int NSLOT = 3, SLOTB = 8192;
constexpr int LDS_K = 0, LDS_V = NSLOT * SLOTB, LDS_WS = 2 * NSLOT * SLOTB, LDS_OST = LDS_WS + NW * 64 * 4, LDS_LUT = LDS_OST + NW * 4096, LUT_N = 768, LDS_BYTES = LDS_LUT + LUT_N * 4;
constexpr float MFLOOR = -1024.0f;
__device__ __forceinline__ void glds16(const void* gsrc, unsigned lds_dst) { unsigned keep;
  asm volatile("s_mov_b32 %0, m0\n\ts_mov_b32 m0, %2\n\ts_nop 0\n\tglobal_load_lds_dwordx4 %1, off\n\ts_mov_b32 m0, %0" : "=&s"(keep) : "v"(gsrc), "s"(lds_dst) : "memory"); }
__device__ __forceinline__ float max3f(float a, float b, float c) { float r; asm("v_max3_f32 %0, %1, %2, %3" : "=v"(r) : "v"(a), "v"(b), "v"(c)); return r; }
__device__ __forceinline__ float max2f(float a, float b) { float r; asm("v_max_f32_e32 %0, %1, %2" : "=v"(r) : "v"(a), "v"(b)); return r; }
__device__ __forceinline__ float fadd_s(float a, float b) { float r; asm("v_add_f32_e32 %0, %1, %2" : "=v"(r) : "v"(a), "v"(b)); return r; }
__device__ __forceinline__ float fsub_s(float a, float b) { float r; asm("v_sub_f32_e32 %0, %1, %2" : "=v"(r) : "v"(a), "v"(b)); return r; }
typedef float f32x2_t __attribute__((ext_vector_type(2))); typedef __bf16 bf16x2_t __attribute__((ext_vector_type(2)));
__device__ __forceinline__ unsigned cvtpk_s(float lo, float hi) { f32x2_t v = {lo, hi}; bf16x2_t b = __builtin_convertvector(v, bf16x2_t); return __builtin_bit_cast(unsigned, b); }
#define WAIT_BAR(N) asm volatile("s_waitcnt vmcnt(" #N ") lgkmcnt(0)\n\ts_barrier" ::: "memory")

__device__ __forceinline__ void qkt(f32x16& p0, f32x16& p1, const char* Kslot, const bf16x8* qr, const f32x16& negm, int r32, int hi) {
  const char* kb = Kslot + hi * 1024 + r32 * 16;
  #pragma unroll
  for (int d0 = 0; d0 < 4; ++d0) {
    const bf16x8 b0 = *reinterpret_cast<const bf16x8*>(kb + d0 * 2048);
    const bf16x8 b1 = *reinterpret_cast<const bf16x8*>(kb + d0 * 2048 + 512);
    if (d0 == 0) { p0 = __builtin_amdgcn_mfma_f32_32x32x16_bf16(b0, qr[0], negm, 0, 0, 0); p1 = __builtin_amdgcn_mfma_f32_32x32x16_bf16(b1, qr[0], negm, 0, 0, 0); }
    else { p0 = __builtin_amdgcn_mfma_f32_32x32x16_bf16(b0, qr[d0], p0, 0, 0, 0); p1 = __builtin_amdgcn_mfma_f32_32x32x16_bf16(b1, qr[d0], p1, 0, 0, 0); } }
}
typedef __attribute__((address_space(3))) const char* lds_cptr;
typedef short v4i16_t __attribute__((ext_vector_type(4)));
__device__ __forceinline__ void kload8(bf16x8* kf, lds_cptr kp) {
  kf[0] = *(const __attribute__((address_space(3))) bf16x8*)(kp);        kf[1] = *(const __attribute__((address_space(3))) bf16x8*)(kp + 512);
  kf[2] = *(const __attribute__((address_space(3))) bf16x8*)(kp + 2048); kf[3] = *(const __attribute__((address_space(3))) bf16x8*)(kp + 2560);
  kf[4] = *(const __attribute__((address_space(3))) bf16x8*)(kp + 4096); kf[5] = *(const __attribute__((address_space(3))) bf16x8*)(kp + 4608);
  kf[6] = *(const __attribute__((address_space(3))) bf16x8*)(kp + 6144); kf[7] = *(const __attribute__((address_space(3))) bf16x8*)(kp + 6656);
}
__device__ __forceinline__ void kload2(bf16x8* kf, lds_cptr kp, int j) { kf[2 * j] = *(const __attribute__((address_space(3))) bf16x8*)(kp + j * 2048); kf[2 * j + 1] = *(const __attribute__((address_space(3))) bf16x8*)(kp + j * 2048 + 512); }
__device__ __forceinline__ s16x4 vtr(lds_cptr p) { return __builtin_bit_cast(s16x4, __builtin_amdgcn_ds_read_tr16_b64_v4i16((__attribute__((address_space(3))) v4i16_t*)p)); }
__device__ __forceinline__ float rowmax(const f32x16& p0, const f32x16& p1) {
  float a = max3f(p0[0], p0[1], p1[0]), b = max3f(p0[2], p0[3], p1[1]); a = max3f(a, p1[2], p1[3]);
  #pragma unroll
  for (int r = 4; r < 16; r += 4) { a = max3f(a, p0[r], p0[r + 1]); b = max3f(b, p0[r + 2], p0[r + 3]); a = max3f(a, p1[r], p1[r + 1]); b = max3f(b, p1[r + 2], p1[r + 3]); }
  const float m = max2f(a, b);
  auto rr = __builtin_amdgcn_permlane32_swap(__float_as_uint(m), __float_as_uint(m), false, false);
  return max2f(__uint_as_float(rr[0]), __uint_as_float(rr[1]));
}
__device__ __forceinline__ void pv(f32x16* o, int vb, bf16x8 pa0, bf16x8 pa1, bf16x8 pa2, bf16x8 pa3) {
  #pragma unroll
  for (int d0 = 0; d0 < 2; ++d0) { s16x4 lo[4], hi[4];
    #pragma unroll
    for (int ks = 0; ks < 4; ++ks) {
      asm volatile("ds_read_b64_tr_b16 %0,%1 offset:%c2" : "=&v"(lo[ks]) : "v"(vb), "i"(d0 * 4096 + ks * 1024) : "memory");
      asm volatile("ds_read_b64_tr_b16 %0,%1 offset:%c2" : "=&v"(hi[ks]) : "v"(vb), "i"(d0 * 4096 + ks * 1024 + 512) : "memory"); }
    asm volatile("s_waitcnt lgkmcnt(0)" ::: "memory"); SBAR();
    #define PK(k) (bf16x8){lo[k][0], lo[k][1], lo[k][2], lo[k][3], hi[k][0], hi[k][1], hi[k][2], hi[k][3]}
    o[d0] = __builtin_amdgcn_mfma_f32_32x32x16_bf16(pa0, PK(0), o[d0], 0, 0, 0);
    o[d0] = __builtin_amdgcn_mfma_f32_32x32x16_bf16(pa1, PK(1), o[d0], 0, 0, 0);
    o[d0] = __builtin_amdgcn_mfma_f32_32x32x16_bf16(pa2, PK(2), o[d0], 0, 0, 0);
    o[d0] = __builtin_amdgcn_mfma_f32_32x32x16_bf16(pa3, PK(3), o[d0], 0, 0, 0);
    #undef PK
  }
}
struct Job { const bf16* Q; const bf16* K; const bf16* V; bf16* O; float* lse; const float* lutg; int NT, i0, kq0, dsh, cls; };
template <int MODE, int THRL> __device__ __forceinline__ void attn_unit(const Job& J, char* shm, const int wid_in) {
  int wid = wid_in; asm volatile("" : "+s"(wid));
  constexpr int QP = MODE == 0 ? 1024 : 256, KP = 256;
  const int lane = lane_id_asm(), tid = wid * 64 + lane, r32 = lane & 31, hi = lane >> 5;
  const bf16* Qw = J.Q + (long)(wid * QBLK) * QP;
  const bf16* Kh = J.K; const bf16* Vh = J.V;
  const unsigned lds0 = (unsigned)(uintptr_t)shm;
  float* wsf = (float*)(shm + LDS_WS) + wid * 64;
  const bf16* ksrc = Kh + (long)lane * KP + wid * 8;
  const bf16* vsrc = Vh + (long)(16 * (wid & 3) + (lane >> 2)) * KP + (wid >> 2) * 32 + (lane & 3) * 8;
  const unsigned kdst = lds0 + LDS_K + wid * 1024, vdst = lds0 + LDS_V + wid * 1024;
  #define DMA_K(t, slot) glds16(ksrc + (long)(t) * KVBLK * KP, (unsigned)__builtin_amdgcn_readfirstlane(kdst + (slot)))
  #define DMA_V(t, slot) glds16(vsrc + (long)(t) * KVBLK * KP, (unsigned)__builtin_amdgcn_readfirstlane(vdst + (slot)))
  const int vb0 = (int)(lds0 + LDS_V) + ((lane >> 4) & 1) * 32 + (lane & 3) * 8 + (4 * hi + ((lane & 15) >> 2)) * 64;
  const char* Kbase = shm + LDS_K; bf16x8 kf[8];
  const lds_cptr shm3 = (lds_cptr)shm; const lds_cptr kp0 = shm3 + LDS_K + hi * 1024 + r32 * 16; const lds_cptr vp0 = shm3 + LDS_V + ((lane >> 4) & 1) * 32 + (lane & 3) * 8 + (4 * hi + ((lane & 15) >> 2)) * 64;
  const int NT = J.NT;
  if (MODE == 1) {
    __attribute__((address_space(3))) float* lut = (__attribute__((address_space(3))) float*)(shm3 + LDS_LUT);
    lut[tid] = J.lutg[tid]; if (tid < LUT_N - 512) lut[512 + tid] = J.lutg[512 + tid];
  }
  DMA_K(0, 0); DMA_V(0, 0); DMA_K(1, SLOTB);
  bf16x8 qr[4];
  #pragma unroll
  for (int d0 = 0; d0 < 4; ++d0) qr[d0] = *reinterpret_cast<const bf16x8*>(&Qw[(long)r32 * QP + d0 * 16 + hi * 8]);
  float mhat = 0.f, l_reg = 0.f; f32x16 o[2]; o[0] = f32x16{}; o[1] = f32x16{}; f32x16 negm = f32x16{}; asm volatile("" : "+v"(negm));
  const int qrel = wid * QBLK + r32;
  const __attribute__((address_space(3))) float* lutq = (const __attribute__((address_space(3))) float*)(shm3 + LDS_LUT) + (J.kq0 - qrel + 383 + 4 * hi);
  #define CMASK(P0, P1, t) do { if (MODE == 1) { const __attribute__((address_space(3))) float* lp_ = lutq + 64 * (t); \
      _Pragma("unroll") for (int r = 0; r < 16; ++r) { const int ko_ = (r & 3) + 8 * (r >> 2); P0[r] += lp_[ko_]; P1[r] += lp_[ko_ + 32]; } } } while (0)
  bool resc = false;
  #define START(P0, P1) do { const float rm = rowmax(P0, P1); resc = false; \
    { const float dl = MODE == 1 ? max2f(rm, MFLOOR) : rm; mhat = fadd_s(mhat, dl); \
      _Pragma("unroll") for (int r = 0; r < 16; ++r) { P0[r] = fsub_s(P0[r], dl); P1[r] = fsub_s(P1[r], dl); } \
      _Pragma("unroll") for (int r = 0; r < 16; ++r) negm[r] = -mhat; asm volatile("" : "+v"(negm)); } \
    _Pragma("unroll") for (int r = 0; r < 16; ++r) P0[r] = __builtin_amdgcn_exp2f(P0[r]); } while (0)
  #define RESC() do { if (resc) { asm volatile("s_waitcnt lgkmcnt(0)" ::: "memory"); \
      _Pragma("unroll") for (int d_ = 0; d_ < 2; ++d_) _Pragma("unroll") for (int r = 0; r < 16; ++r) o[d_][r] *= wsf[crow(r, hi)]; } } while (0)
  f32x16 pA0, pA1, pB0, pB1;
  int sl_prev = 0, sl_cur = 0, sl_next = SLOTB;
  #define ROT() do { sl_prev = sl_cur; sl_cur = sl_next; sl_next = (sl_next == (NSLOT - 1) * SLOTB) ? 0 : sl_next + SLOTB; } while (0)
  DMA_K(2, 2 * SLOTB);
  WAIT_BAR(3);
  qkt(pA0, pA1, Kbase, qr, negm, r32, hi); asm volatile("s_nop 15\n\ts_nop 7" : "+v"(pA0), "+v"(pA1)); CMASK(pA0, pA1, 0);
  START(pA0, pA1);
  _Pragma("unroll") for (int r = 0; r < 16; ++r) pA1[r] = __builtin_amdgcn_exp2f(pA1[r]);
  WAIT_BAR(0);
  DMA_K(3, 0); DMA_V(1, SLOTB);
  ROT();
  kload8(kf, kp0 + sl_cur);
  WAIT_BAR(2);
  s16x4 vlo[8], vhi[8]; u32x4 pw0, pw1, pw2, pw3;
  #define PKW(P, B) cvtpk_s(P[B], P[B + 1])
  #define PAF(k) __builtin_bit_cast(bf16x8, pw##k)
  #define VFR(i) (bf16x8){vlo[i][0], vlo[i][1], vlo[i][2], vlo[i][3], vhi[i][0], vhi[i][1], vhi[i][2], vhi[i][3]}
  #define PIN(x) asm volatile("" : "+v"(x))
  #define MX3(a, b, c) __builtin_fmaxf(__builtin_fmaxf((a), (b)), (c))
  #define GAPA(MF, A0, A1, A2, A3, W0, W1, PW) do { MF; sacc += A0; sacc += A1; sacc += A2; sacc += A3; PIN(sacc); W0; W1; PIN(PW); SBAR(); } while (0)
  #define EX(v) __builtin_amdgcn_exp2f(v)
  #define GAPB(MF, X, B) do { MF; X[B] = EX(X[B]); X[B + 1] = EX(X[B + 1]); X[B + 2] = EX(X[B + 2]); X[B + 3] = EX(X[B + 3]); PIN(X); SBAR(); } while (0)
  #define VRD(i) do { vlo[i] = vtr(vp_ + (((i) >> 2) * 4096 + ((i) & 3) * 1024)); vhi[i] = vtr(vp_ + (((i) >> 2) * 4096 + ((i) & 3) * 1024 + 512)); } while (0)
  #define KRD(G, j) do { if (G) { kload2(kf, kp0 + sl_next, j); SBAR(); } } while (0)
  #define STEP(C0, C1, P0, P1, t, GK, GV, GL) do { SBAR(); \
    const lds_cptr vp_ = vp0 + sl_prev; \
    VRD(0); SBAR(); float sacc = (P0[0] + P0[1]); \
    GAPA(C0 = __builtin_amdgcn_mfma_f32_32x32x16_bf16(kf[0], qr[0], negm, 0, 0, 0), P0[2], P0[3], P0[4], P0[5],     pw0[0] = PKW(P0, 0), pw0[1] = PKW(P0, 2), pw0); \
    VRD(4); SBAR(); GAPA(C1 = __builtin_amdgcn_mfma_f32_32x32x16_bf16(kf[1], qr[0], negm, 0, 0, 0), P0[6], P0[7], P0[8], P0[9],     pw0[2] = PKW(P0, 4), pw0[3] = PKW(P0, 6), pw0); \
    VRD(1); SBAR(); GAPA(C0 = __builtin_amdgcn_mfma_f32_32x32x16_bf16(kf[2], qr[1], C0, 0, 0, 0),   P0[10], P0[11], P0[12], P0[13], pw1[0] = PKW(P0, 8), pw1[1] = PKW(P0, 10), pw1); \
    VRD(5); SBAR(); GAPA(C1 = __builtin_amdgcn_mfma_f32_32x32x16_bf16(kf[3], qr[1], C1, 0, 0, 0),   P0[14], P0[15], P1[0], P1[1],   pw1[2] = PKW(P0, 12), pw1[3] = PKW(P0, 14), pw1); \
    VRD(2); SBAR(); GAPA(C0 = __builtin_amdgcn_mfma_f32_32x32x16_bf16(kf[4], qr[2], C0, 0, 0, 0),   P1[2], P1[3], P1[4], P1[5],     pw2[0] = PKW(P1, 0), pw2[1] = PKW(P1, 2), pw2); \
    VRD(6); SBAR(); GAPA(C1 = __builtin_amdgcn_mfma_f32_32x32x16_bf16(kf[5], qr[2], C1, 0, 0, 0),   P1[6], P1[7], P1[8], P1[9],     pw2[2] = PKW(P1, 4), pw2[3] = PKW(P1, 6), pw2); \
    VRD(3); SBAR(); GAPA(C0 = __builtin_amdgcn_mfma_f32_32x32x16_bf16(kf[6], qr[3], C0, 0, 0, 0),   P1[10], P1[11], P1[12], P1[13], pw3[0] = PKW(P1, 8), pw3[1] = PKW(P1, 10), pw3); \
    VRD(7); SBAR(); GAPA(C1 = __builtin_amdgcn_mfma_f32_32x32x16_bf16(kf[7], qr[3], C1, 0, 0, 0),   P1[14], P1[15], 0.f, 0.f,       pw3[2] = PKW(P1, 12), pw3[3] = PKW(P1, 14), pw3); \
    l_reg += sacc; \
    if (GK) { DMA_K((t) + 3, sl_cur); } if (GV) { DMA_V((t) + 1, sl_next); } \
    CMASK(C0, C1, t); \
    { float a = MX3(C0[0], C0[1], C1[0]), b = MX3(C0[2], C0[3], C1[1]); a = MX3(a, C1[2], C1[3]); \
      _Pragma("unroll") for (int r = 4; r < 16; r += 4) { a = MX3(a, C0[r], C0[r + 1]); b = MX3(b, C0[r + 2], C0[r + 3]); a = MX3(a, C1[r], C1[r + 1]); b = MX3(b, C1[r + 2], C1[r + 3]); } \
      float rm = __builtin_fmaxf(a, b); { auto rr = __builtin_amdgcn_permlane32_swap(__float_as_uint(rm), __float_as_uint(rm), false, false); rm = __builtin_fmaxf(__uint_as_float(rr[0]), __uint_as_float(rr[1])); } \
      resc = false; \
      if (__builtin_expect(__any(rm > (float)THRL), 0)) { const float dl = __builtin_fmaxf(rm, 0.f); mhat += dl; \
        _Pragma("unroll") for (int r = 0; r < 16; ++r) { C0[r] -= dl; C1[r] -= dl; } \
        _Pragma("unroll") for (int r = 0; r < 16; ++r) negm[r] = -mhat; asm volatile("" : "+v"(negm)); \
        const float f = __builtin_amdgcn_exp2f(-dl); l_reg *= f; if (hi == 0) wsf[r32] = f; resc = true; } } \
    SBAR(); \
    GAPB(o[0] = __builtin_amdgcn_mfma_f32_32x32x16_bf16(PAF(0), VFR(0), o[0], 0, 0, 0), C0, 0); \
    GAPB(o[1] = __builtin_amdgcn_mfma_f32_32x32x16_bf16(PAF(0), VFR(4), o[1], 0, 0, 0), C0, 4); \
    KRD(GL, 0); GAPB(o[0] = __builtin_amdgcn_mfma_f32_32x32x16_bf16(PAF(1), VFR(1), o[0], 0, 0, 0), C0, 8); \
    KRD(GL, 1); GAPB(o[1] = __builtin_amdgcn_mfma_f32_32x32x16_bf16(PAF(1), VFR(5), o[1], 0, 0, 0), C0, 12); \
    KRD(GL, 2); GAPB(o[0] = __builtin_amdgcn_mfma_f32_32x32x16_bf16(PAF(2), VFR(2), o[0], 0, 0, 0), C1, 0); \
    KRD(GL, 3); GAPB(o[1] = __builtin_amdgcn_mfma_f32_32x32x16_bf16(PAF(2), VFR(6), o[1], 0, 0, 0), C1, 4); \
    GAPB(o[0] = __builtin_amdgcn_mfma_f32_32x32x16_bf16(PAF(3), VFR(3), o[0], 0, 0, 0), C1, 8); \
    GAPB(o[1] = __builtin_amdgcn_mfma_f32_32x32x16_bf16(PAF(3), VFR(7), o[1], 0, 0, 0), C1, 12); \
    } while (0)
  int t = 1;
  for (; t + 5 < NT; t += 2) {
    STEP(pB0, pB1, pA0, pA1, t, true, true, true);     WAIT_BAR(2); RESC(); ROT();
    STEP(pA0, pA1, pB0, pB1, t + 1, true, true, true); WAIT_BAR(2); RESC(); ROT();
  }
  #define ENDW(tt) do { if ((tt) + 3 < NT) { WAIT_BAR(2); } else if ((tt) + 2 < NT) { WAIT_BAR(1); } else { WAIT_BAR(0); } } while (0)
  for (; t + 1 < NT; t += 2) {
    STEP(pB0, pB1, pA0, pA1, t, (t + 3 < NT), (t + 1 < NT), (t + 1 < NT));       ENDW(t);     RESC(); ROT();
    STEP(pA0, pA1, pB0, pB1, t + 1, (t + 4 < NT), (t + 2 < NT), (t + 2 < NT));   ENDW(t + 1); RESC(); ROT();
  }
  STEP(pB0, pB1, pA0, pA1, NT - 1, false, false, false); RESC();
  { float sacc = pB0[0] + pB0[1]; _Pragma("unroll") for (int r = 2; r < 16; ++r) sacc += pB0[r]; _Pragma("unroll") for (int r = 0; r < 16; ++r) sacc += pB1[r]; l_reg += sacc;
    pw0 = (u32x4){PKW(pB0, 0), PKW(pB0, 2), PKW(pB0, 4), PKW(pB0, 6)}; pw1 = (u32x4){PKW(pB0, 8), PKW(pB0, 10), PKW(pB0, 12), PKW(pB0, 14)}; pw2 = (u32x4){PKW(pB1, 0), PKW(pB1, 2), PKW(pB1, 4), PKW(pB1, 6)}; pw3 = (u32x4){PKW(pB1, 8), PKW(pB1, 10), PKW(pB1, 12), PKW(pB1, 14)};
    SBAR(); pv(o, vb0 + sl_cur, PAF(0), PAF(1), PAF(2), PAF(3)); }
  #undef PKW
  #undef PAF
  #undef VFR
  #undef PIN
  #undef MX3
  #undef GAPA
  #undef GAPB
  #undef EX
  #undef VRD
  #undef KRD
  #undef STEP
  #undef ENDW
  { auto rr = __builtin_amdgcn_permlane32_swap(__float_as_uint(l_reg), __float_as_uint(l_reg), false, false); l_reg = __uint_as_float(rr[0]) + __uint_as_float(rr[1]); }
  if (hi == 0) wsf[32 + r32] = l_reg; asm volatile("s_waitcnt lgkmcnt(0)" ::: "memory");
  float rli[16];
  #pragma unroll
  for (int r = 0; r < 16; ++r) rli[r] = __builtin_amdgcn_rcpf(wsf[32 + crow(r, hi)]);
  { bf16* stg = (bf16*)(shm + LDS_OST) + wid * 2048;
    #pragma unroll
    for (int r = 0; r < 16; ++r) { const int orow = crow(r, hi);
      #pragma unroll
      for (int d0 = 0; d0 < 2; ++d0) stg[orow * 64 + d0 * 32 + r32] = __float2bfloat16(o[d0][r] * rli[r]); }
    asm volatile("s_waitcnt lgkmcnt(0)" ::: "memory");
    if (MODE == 0) {
      bf16* Ow = J.O + (long)(wid * QBLK) * 1024;
      #pragma unroll
      for (int i = 0; i < 4; ++i) { const int row = i * 8 + (lane >> 3), ch = lane & 7; const u32x4 v = *(const u32x4*)(stg + row * 64 + ch * 8); *(u32x4*)(Ow + (long)row * 1024 + ch * 8) = v; }
    } else {
      #pragma unroll
      for (int i = 0; i < 4; ++i) { const int row = i * 8 + (lane >> 3), ch = lane & 7; const u32x4 v = *(const u32x4*)(stg + row * 64 + ch * 8);
        const long tok = ((long)(J.i0 + wid * QBLK + row) << J.dsh) + J.cls; *(u32x4*)(J.O + tok * 256 + ch * 8) = v; }
      if (hi == 0) { const long tok = ((long)(J.i0 + qrel) << J.dsh) + J.cls; J.lse[tok * 4] = mhat + __builtin_amdgcn_logf(l_reg); }
    } }
  asm volatile("s_waitcnt lgkmcnt(0)\n\ts_barrier" ::: "memory");
  #undef DMA_K
  #undef DMA_V
  #undef CMASK
  #undef START
  #undef RESC
  #undef ROT
}
#undef SBAR
#undef WAIT_BAR
}

constexpr size_t MiB = 1u << 20;
constexpr size_t WS_CTL = 0, CTL_ZERO_BYTES = 1 * MiB;
constexpr size_t WS_MOD = 1 * MiB;
constexpr size_t WS_ROPE = WS_MOD + 512 * 1024;
constexpr size_t WS_BLUT = WS_ROPE + 8192;
constexpr size_t WS_RC0 = WS_BLUT + 12 * 768 * 4;
constexpr size_t WS_HIST = WS_RC0 + 4096;
constexpr size_t WS_TILEE = WS_HIST + 32768;
constexpr size_t WS_TOPE = 2 * MiB;
constexpr size_t WS_TOPW = WS_TOPE + 512 * 1024;
constexpr size_t WS_SLOT = WS_TOPW + 512 * 1024;
constexpr size_t WS_ROWW = WS_SLOT + 512 * 1024;
constexpr size_t WS_LSE = 5 * MiB;
constexpr size_t WS_WRHI = 7 * MiB;
constexpr size_t WS_WRLO = 8 * MiB;
constexpr size_t WS_WIN = 9 * MiB;
constexpr size_t WS_WBRA = 32 * MiB;
constexpr size_t WS_WBRB = 33 * MiB;
constexpr size_t WS_WOUT = 37 * MiB;
constexpr size_t WS_WGU = 41 * MiB;
constexpr size_t WS_WDN = 297 * MiB;
constexpr size_t WS_X = 425 * MiB;
constexpr size_t WS_H = 553 * MiB;
constexpr size_t WS_R = 617 * MiB;
constexpr size_t WS_AQKV = WS_R;
constexpr size_t WS_QB = WS_R + 144 * MiB;
constexpr size_t WS_KB = WS_R + 208 * MiB;
constexpr size_t WS_VB = WS_R + 224 * MiB;
constexpr size_t WS_GATE = WS_R + 240 * MiB;
constexpr size_t WS_OAG = WS_R + 368 * MiB;
constexpr size_t WS_OA = WS_R + 416 * MiB;
constexpr size_t WS_MERGED = WS_R + 432 * MiB;
constexpr size_t WS_XS = WS_R;
constexpr size_t WS_ACT = WS_R + 272 * MiB;
constexpr size_t WS_OB = WS_R + 496 * MiB;
constexpr size_t WS_END = WS_R + 560 * MiB;
constexpr int CW_BAR = 4096;

constexpr int RING_BYTES = 133120;
constexpr int LDSCTL_OFF = RING_BYTES;
constexpr int LDS_BYTES = 147456;
constexpr int NWAVES = 8;

#define GAS __attribute__((address_space(1)))
#define LAS __attribute__((address_space(3)))
typedef unsigned short bf16;
typedef unsigned v4u __attribute__((ext_vector_type(4)));
typedef unsigned v2u __attribute__((ext_vector_type(2)));
typedef float f32x4 __attribute__((ext_vector_type(4)));
typedef float f32x16 __attribute__((ext_vector_type(16)));
typedef int i32x4 __attribute__((ext_vector_type(4)));
typedef short bf16x8 __attribute__((ext_vector_type(8)));
typedef GAS unsigned gu32;
#define RLX_AGENT __ATOMIC_RELAXED, __HIP_MEMORY_SCOPE_AGENT
#define LDS_WAIT() asm volatile("s_waitcnt lgkmcnt(0)" ::: "memory")
__device__ __forceinline__ unsigned f2bf(float f) { unsigned u = __builtin_bit_cast(unsigned, f); return (u + 0x7fffu + ((u >> 16) & 1u)) >> 16; }
__device__ __forceinline__ unsigned pk2(float lo, float hi) { return f2bf(lo) | (f2bf(hi) << 16); }
__device__ __forceinline__ float bfl(unsigned w) { return __uint_as_float(w << 16); }
__device__ __forceinline__ float bfh(unsigned w) { return __uint_as_float(w & 0xffff0000u); }

#define XB_TMO      128
#define XB_XCNT(j)  (256  + 64 * (j))
#define XB_XSUB(j)  (1280 + 64 * (j))
#define XB_XGEN(j)  (2304 + 64 * (j))
#define XB_TOP      3328
#define XB_TOPGEN   3392
#define XCD_BAR_WORDS 3456
#define XB_SPIN_CAP (1u << 18)
__device__ __forceinline__ unsigned xb_ld(unsigned* p)              { return __hip_atomic_load(p, __ATOMIC_RELAXED, __HIP_MEMORY_SCOPE_AGENT); }
__device__ __forceinline__ unsigned xb_add(unsigned* p, unsigned v) { return __hip_atomic_fetch_add(p, v, __ATOMIC_RELAXED, __HIP_MEMORY_SCOPE_AGENT); }
__device__ __forceinline__ unsigned xb_xcc_id() { return (unsigned)__builtin_amdgcn_s_getreg((3 << 11) | 20) & 0xFu; }
#define XB_SPIN(cond, bar) do { unsigned _sp = 0; while (cond) { __builtin_amdgcn_s_sleep(1); \
    if ((++_sp & 255u) == 0u) { if (xb_ld(&(bar)[XB_TMO])) break; if (_sp > XB_SPIN_CAP) { atomicAdd(&(bar)[XB_TMO], 1u); break; } } } } while (0)
struct XcdBarrier { unsigned* bar; unsigned x; volatile LAS unsigned* st; };
__device__ __forceinline__ XcdBarrier xcd_barrier_post(unsigned* bar, volatile LAS unsigned* st) {
    XcdBarrier b; b.bar = bar; b.x = xb_xcc_id(); b.st = st;
    if (threadIdx.x == 0) (void)xb_add(&bar[XB_XCNT(b.x)], 1u);
    return b;
}
__device__ __forceinline__ void xcd_barrier_complete(unsigned* bar, unsigned x, unsigned& nloc, unsigned& nx) {
    const unsigned G = gridDim.x * gridDim.y * gridDim.z;
    unsigned sum, cnt, mine, sp = 0u;
    for (;;) {
        sum = 0u; cnt = 0u; mine = 0u;
#pragma unroll
        for (unsigned j = 0; j < 16; ++j) { const unsigned c = xb_ld(&bar[XB_XCNT(j)]); sum += c; cnt += (c > 0u) ? 1u : 0u; mine = (j == x) ? c : mine; }
        if (sum == G) break;
        __builtin_amdgcn_s_sleep(1);
        if ((++sp & 255u) == 0u) { if (xb_ld(&bar[XB_TMO])) break; if (sp > XB_SPIN_CAP) { atomicAdd(&bar[XB_TMO], 1u); break; } }
    }
    nloc = mine > 0u ? mine : 1u; nx = cnt > 0u ? cnt : 1u;
}
__device__ __forceinline__ void xcd_barrier(const XcdBarrier& b) {
    asm volatile("s_waitcnt vmcnt(0)" ::: "memory");
    __syncthreads();
    if (threadIdx.x == 0) {
        unsigned* bar = b.bar;
        __builtin_amdgcn_s_waitcnt(0);
        unsigned nloc = b.st[0], nx = b.st[1];
        if (nloc == 0u) { xcd_barrier_complete(bar, b.x, nloc, nx); b.st[0] = nloc; b.st[1] = nx; }
        const unsigned old = xb_add(&bar[XB_XSUB(b.x)], 1u);
        const unsigned gen = old / nloc;
        if (old + 1u == (gen + 1u) * nloc) {
            __builtin_amdgcn_fence(__ATOMIC_RELEASE, "agent");
            asm volatile("s_waitcnt vmcnt(0)" ::: "memory");
            const unsigned og = xb_add(&bar[XB_TOP], 1u);
            const unsigned tg = og / nx;
            if (og + 1u == (tg + 1u) * nx) xb_add(&bar[XB_TOPGEN], 1u);
            else XB_SPIN(xb_ld(&bar[XB_TOPGEN]) == tg, bar);
            __builtin_amdgcn_fence(__ATOMIC_ACQUIRE, "agent");
            xb_add(&bar[XB_XGEN(b.x)], 1u);
            asm volatile("s_waitcnt vmcnt(0)" ::: "memory");
        } else {
            XB_SPIN(xb_ld(&bar[XB_XGEN(b.x)]) == gen, bar);
            __builtin_amdgcn_fence(__ATOMIC_ACQUIRE, "agent");
            asm volatile("s_waitcnt vmcnt(0)" ::: "memory");
        }
    }
    __syncthreads();
}

__device__ __forceinline__ float wave_sum(float v) {
    v = xsum<1>(v); v = xsum<2>(v); v = xsum<4>(v); v = xsum<8>(v); v = xsum<16>(v); v = xsum<32>(v);
    return v;
}
__device__ __forceinline__ void cvt_item(const float* W, int ldw, int K, int srcA, int srcB, bf16* WT, int dst_row0, int k0, LAS float* scr, int lane, bool ident = false) {
    const int kq = lane >> 4, nq = lane & 15; const int scol = (nq < 8 ? srcA + 4 * nq : srcB + 4 * (nq - 8));
    f32x4 v[16];
#pragma unroll
    for (int i = 0; i < 16; ++i) v[i] = *(const GAS f32x4*)(W + (size_t)(k0 + 4 * i + kq) * ldw + scol);
#pragma unroll
    for (int i = 0; i < 16; ++i)
#pragma unroll
        for (int e = 0; e < 4; ++e) scr[(4 * i + kq) * 65 + 4 * nq + e] = v[i][e];
    LDS_WAIT(); asm volatile("" ::: "memory");
    const int c = lane & 7, rr = lane >> 3;
#pragma unroll
    for (int j = 0; j < 8; ++j) { const int rho = rr + 8 * j; const int sc = (rho & 32) + (ident ? (rho & 31) : pg8::perm32(rho & 31)); const LAS float* s = scr + (8 * c) * 65 + sc;
        v4u o; o.x = pk2(s[0 * 65], s[1 * 65]); o.y = pk2(s[2 * 65], s[3 * 65]); o.z = pk2(s[4 * 65], s[5 * 65]); o.w = pk2(s[6 * 65], s[7 * 65]);
        *(GAS v4u*)(WT + (size_t)(dst_row0 + rho) * K + k0 + 8 * c) = o; }
    LDS_WAIT(); asm volatile("" ::: "memory");
}
__device__ __forceinline__ int win_src(int X) { const int pn = X >> 3, bj = (X >> 2) & 1, wc = X & 3; return (pn >= 9 && pn < 14) ? pn * 256 + 64 * wc + 32 * bj : 32 * X; }
__device__ __forceinline__ int wgu_src(int X) { const int pn = X >> 3, bj = (X >> 2) & 1, wc = X & 3; return bj * 1024 + 128 * pn + 32 * wc; }

__device__ __forceinline__ void norm_row_bf16(const float* xrow, const float* g, const float* sc, const float* sh, bf16* orow, int lane) {
    const GAS f32x4* xr = (const GAS f32x4*)xrow + lane;
    f32x4 v[4]; float s = 0.f;
#pragma unroll
    for (int j = 0; j < 4; ++j) { v[j] = xr[64 * j]; s += (v[j].x * v[j].x + v[j].y * v[j].y) + (v[j].z * v[j].z + v[j].w * v[j].w); }
    const float rs = rsqrtf(wave_sum(s) * (1.0f / D) + EPS);
#pragma unroll
    for (int j = 0; j < 4; ++j) { const int c = 256 * j + 4 * lane;
        const f32x4 gg = *(const GAS f32x4*)(g + c), s1 = *(const GAS f32x4*)(sc + c), s0 = *(const GAS f32x4*)(sh + c);
        const f32x4 y = (v[j] * rs * gg) * (s1 + 1.0f) + s0;
        v2u o; o.x = pk2(y.x, y.y); o.y = pk2(y.z, y.w); *(GAS v2u*)(orow + c) = o; }
}

__device__ __forceinline__ void norm_rows2_bf16(const float* xrow, const float* g, const float* sc, const float* sh, bf16* orow, int lane) {
    const GAS f32x4* xr = (const GAS f32x4*)xrow + lane;
    f32x4 v[2][4]; float s0 = 0.f, s1 = 0.f;
#pragma unroll
    for (int j = 0; j < 4; ++j) { v[0][j] = xr[64 * j]; v[1][j] = xr[256 + 64 * j]; }
#pragma unroll
    for (int j = 0; j < 4; ++j) { s0 += (v[0][j].x * v[0][j].x + v[0][j].y * v[0][j].y) + (v[0][j].z * v[0][j].z + v[0][j].w * v[0][j].w); s1 += (v[1][j].x * v[1][j].x + v[1][j].y * v[1][j].y) + (v[1][j].z * v[1][j].z + v[1][j].w * v[1][j].w); }
    const float rs0 = rsqrtf(wave_sum(s0) * (1.0f / D) + EPS), rs1 = rsqrtf(wave_sum(s1) * (1.0f / D) + EPS);
#pragma unroll
    for (int j = 0; j < 4; ++j) { const int c = 256 * j + 4 * lane;
        const f32x4 gg = *(const GAS f32x4*)(g + c), a1 = *(const GAS f32x4*)(sc + c) + 1.0f, a0 = *(const GAS f32x4*)(sh + c);
        const f32x4 y0 = (v[0][j] * rs0 * gg) * a1 + a0, y1 = (v[1][j] * rs1 * gg) * a1 + a0;
        v2u o0; o0.x = pk2(y0.x, y0.y); o0.y = pk2(y0.z, y0.w); *(GAS v2u*)(orow + c) = o0;
        v2u o1; o1.x = pk2(y1.x, y1.y); o1.y = pk2(y1.z, y1.w); *(GAS v2u*)(orow + D + c) = o1; }
}

struct Args { const float* in[20]; float* out; unsigned char* ws; int ph_lo, ph_hi, li, pad; };
constexpr int N_PHASES = 2 + 10 * DEPTH;

typedef const __attribute__((address_space(4))) Args* kargs_t;
__device__ __forceinline__ kargs_t kargs_opaque() { kargs_t p = (kargs_t)__builtin_amdgcn_kernarg_segment_ptr(); asm volatile("" : "+s"(p)); return p; }
#define PH_BEGIN() kargs_t ap = kargs_opaque(); unsigned char* ws = ap->ws; (void)ws; \
    int wave = wave_s; asm volatile("" : "+s"(wave)); const int lane = lane_id_asm(); const int tid = wave * 64 + lane; (void)lane; (void)tid; \
    int bx = blockIdx.x; asm volatile("" : "+s"(bx)); int G = gridDim.x; asm volatile("" : "+s"(G)); const int vcu = (G % 8 == 0) ? (bx % 8) * (G / 8) + bx / 8 : bx; (void)vcu; \
    const int gw = vcu * NWAVES + wave, NGW = G * NWAVES; (void)gw; (void)NGW; const int gtid = vcu * (NWAVES * 64) + tid, NGT = G * NWAVES * 64; (void)gtid; (void)NGT
#define INP(k) (ap->in[k])
#define x_in INP(0)
#define c_in INP(1)
#define w_ada INP(2)
#define b_ada INP(3)
#define norm1_g INP(4)
#define w_in INP(5)
#define q_norm_g INP(6)
#define k_norm_g INP(7)
#define rel_bias INP(8)
#define w_br_a INP(9)
#define w_br_b INP(10)
#define w_out INP(11)
#define norm2_g INP(12)
#define w_router INP(13)
#define b_router INP(14)
#define w_gate_up INP(15)
#define b_gate_up INP(16)
#define w_down INP(17)
#define b_down INP(18)
#define final_g INP(19)
#define MOD ((float*)(ws + WS_MOD))
#define ROPE ((float*)(ws + WS_ROPE))
#define BLUT ((float*)(ws + WS_BLUT))
#define RC0 ((float*)(ws + WS_RC0))
#define HIST ((int*)(ws + WS_HIST))
#define TILEE ((int*)(ws + WS_TILEE))
#define TOPE ((int*)(ws + WS_TOPE))
#define TOPW ((float*)(ws + WS_TOPW))
#define SLOT ((int*)(ws + WS_SLOT))
#define ROWW ((float*)(ws + WS_ROWW))
#define LSE ((float*)(ws + WS_LSE))
#define WRHI ((bf16*)(ws + WS_WRHI))
#define WRLO ((bf16*)(ws + WS_WRLO))
#define WIN ((bf16*)(ws + WS_WIN))
#define WBRA ((bf16*)(ws + WS_WBRA))
#define WBRB ((bf16*)(ws + WS_WBRB))
#define WOUT ((bf16*)(ws + WS_WOUT))
#define WGU ((bf16*)(ws + WS_WGU))
#define WDN ((bf16*)(ws + WS_WDN))
#define X ((float*)(ws + WS_X))
#define H ((bf16*)(ws + WS_H))
#define AQKV ((bf16*)(ws + WS_AQKV))
#define QB ((bf16*)(ws + WS_QB))
#define KB ((bf16*)(ws + WS_KB))
#define VB ((bf16*)(ws + WS_VB))
#define GATE ((bf16*)(ws + WS_GATE))
#define OAG ((bf16*)(ws + WS_OAG))
#define OA ((bf16*)(ws + WS_OA))
#define MERGED ((bf16*)(ws + WS_MERGED))
#define OB ((bf16*)(ws + WS_OB))
#define XS ((bf16*)(ws + WS_XS))
#define ACT ((bf16*)(ws + WS_ACT))
#define YB ((bf16*)(ws + WS_XS))
__global__ void __launch_bounds__(NWAVES * 64, 2) mk_fwd(Args args) {
    extern __shared__ __attribute__((aligned(16))) unsigned char lds[];
    LAS unsigned char* L = (LAS unsigned char*)lds;
    volatile LAS unsigned* MISC = (volatile LAS unsigned*)(L + LDSCTL_OFF);
    gu32* ctl = (gu32*)(args.ws + WS_CTL);
    const int wave_s = __builtin_amdgcn_readfirstlane(threadIdx.x >> 6);
    for (int u = threadIdx.x; u < (LDS_BYTES - LDSCTL_OFF) / 4; u += NWAVES * 64) ((LAS unsigned*)(L + LDSCTL_OFF))[u] = 0u;
    __syncthreads();
    XcdBarrier bar; bar.bar = (unsigned*)(ctl + CW_BAR) + args.li * XCD_BAR_WORDS; bar.x = 0; bar.st = nullptr;
    if (!MK_PER_PHASE) bar = xcd_barrier_post((unsigned*)(ctl + CW_BAR) + args.li * XCD_BAR_WORDS, MISC + 8);
    const int lo = args.ph_lo, hi = args.ph_hi;
#define IN(k) (lo <= (k) && (k) < hi)
#define KIND(q) ((PH_KIND_MASK >> (q)) & 1)
#define SEAM(k) do { if (IN(k) && IN((k) + 1)) xcd_barrier(bar); } while (0)

    for (int rep0 = 0; rep0 < 1 + PROBE_P0; ++rep0) {
    if (KIND(0) && IN(0)) { PH_BEGIN();
        {
            LAS float* cact = (LAS float*)L;
            LAS float* part = (LAS float*)(L + 32768);
            for (int i = tid; i < NB * D; i += NWAVES * 64) { const float cv = c_in[i]; cact[i] = cv / (1.0f + __expf(-cv)); }
            __syncthreads();
            for (int vb = bx; vb < 256; vb += G) {
                const int gc = vb * 48 + lane;
                const int l = gc / 6144, col = gc % 6144;
                float a[NB];
#pragma unroll
                for (int b = 0; b < NB; ++b) a[b] = 0.f;
                if (lane < 48) {
                    const float* wp = w_ada + (size_t)l * D * 6144 + col;
                    for (int k = wave * 128; k < wave * 128 + 128; ++k) { const float w = wp[(size_t)k * 6144];
#pragma unroll
                        for (int b = 0; b < NB; ++b) a[b] += cact[b * D + k] * w; }
                }
#pragma unroll
                for (int b = 0; b < NB; ++b) part[(wave * NB + b) * 64 + lane] = a[b];
                __syncthreads();
                if (tid < NB * 48) { const int b = tid / 48, cl = tid % 48; const int gc2 = vb * 48 + cl; const int l2 = gc2 / 6144, col2 = gc2 % 6144;
                    float s = b_ada[l2 * 6144 + col2];
#pragma unroll
                    for (int w = 0; w < NWAVES; ++w) s += part[(w * NB + b) * 64 + cl];
                    MOD[((size_t)l2 * NB + b) * 6144 + col2] = s; }
                __syncthreads();
            }
        }
        for (int i = gtid; i < 1024 + 12 * 768; i += NGT) {
            if (i < 1024) { const int p = i >> 4, f = i & 15; const double inv = pow(10000.0, -(double)f / 16.0); const double ang = (double)p * inv; ROPE[i] = (float)cos(ang); ROPE[1024 + i] = (float)sin(ang); }
            else { const int j = i - 1024; const int hh = j / 768, di = j % 768; const int delta = di - 383; const int g = hh >> 2; const int dil = g == 0 ? 1 : (g == 1 ? 4 : 16);
                float val = -INFINITY;
                if (delta >= -64 && delta <= 64) { const int rel = delta * dil; const int n = rel < 0 ? -rel : rel; int bk = rel > 0 ? 16 : 0;
                    if (n < 8) bk += n; else { int lg = 8 + (int)(logf((float)n / 8.0f) / logf(128.0f) * 8.0f); if (lg > 15) lg = 15; bk += lg; }
                    val = rel_bias[bk * 12 + hh] * LOG2E; }
                BLUT[j] = val; }
        }
        {
            LAS float* scr = (LAS float*)(L + wave * 16640);
            __syncthreads();
            constexpr int I_IN = 16 * 92, I_BRA = 4 * 16, I_BRB = 16 * 16, I_OUT = 16 * 16, I_GU = 16 * 32, I_DN = 16 * 16;
            constexpr int PER_L = I_IN + I_BRA + I_BRB + I_OUT;
            constexpr int NITEMS = DEPTH * PER_L + DEPTH * NE * (I_GU + I_DN);
            for (int it = gw; it < NITEMS; it += NGW) {
                int r = it;
                if (r < DEPTH * PER_L) {
                    const int l = r / PER_L; r %= PER_L;
                    if (r < I_IN) { const int kb = r / 92, g64 = r % 92; cvt_item(w_in + (size_t)l * D * N_IN, N_IN, D, win_src(2 * g64), win_src(2 * g64 + 1), WIN + (size_t)l * N_IN * D, 64 * g64, 64 * kb, scr, lane, (g64 >> 2) >= 9 && (g64 >> 2) < 14); continue; } r -= I_IN;
                    if (r < I_BRA) { const int kb = r / 16, g64 = r % 16; cvt_item(w_br_a + (size_t)l * 256 * D, D, 256, 64 * g64, 64 * g64 + 32, WBRA + (size_t)l * D * 256, 64 * g64, 64 * kb, scr, lane); continue; } r -= I_BRA;
                    if (r < I_BRB) { const int kb = r / 16, g64 = r % 16; cvt_item(w_br_b + (size_t)l * D * D, D, D, 64 * g64, 64 * g64 + 32, WBRB + (size_t)l * D * D, 64 * g64, 64 * kb, scr, lane); continue; } r -= I_BRB;
                    { const int kb = r / 16, g64 = r % 16; cvt_item(w_out + (size_t)l * D * D, D, D, 64 * g64, 64 * g64 + 32, WOUT + (size_t)l * D * D, 64 * g64, 64 * kb, scr, lane); continue; }
                }
                r -= DEPTH * PER_L;
                if (r < DEPTH * NE * I_GU) { const int le = r / I_GU; r %= I_GU; const int kb = r / 32, g64 = r % 32;
                    cvt_item(w_gate_up + (size_t)le * D * 2048, 2048, D, wgu_src(2 * g64), wgu_src(2 * g64 + 1), WGU + (size_t)le * 2048 * D, 64 * g64, 64 * kb, scr, lane); continue; }
                r -= DEPTH * NE * I_GU;
                { const int le = r / I_DN; r %= I_DN; const int kb = r / 16, g64 = r % 16;
                    cvt_item(w_down + (size_t)le * D * D, D, D, 64 * g64, 64 * g64 + 32, WDN + (size_t)le * D * D, 64 * g64, 64 * kb, scr, lane); }
            }
        }
    }
    SEAM(0);
    }
    if (KIND(1) && IN(1)) { PH_BEGIN();
        for (int m = 2 * gw; m < T; m += 2 * NGW) { const int b = m >> 12; const float* md = MOD + (size_t)b * 6144;
            norm_rows2_bf16(x_in + (size_t)m * D, norm1_g, md + 1024, md, H + (size_t)m * D, lane); }
        for (int i = gtid; i < DEPTH * NB * NE * D; i += NGT) { const int k = i & 1023, e = (i >> 10) & 31, b = (i >> 15) & 7, l = i >> 18;
            const float v = norm2_g[l * D + k] * (1.0f + MOD[((size_t)l * NB + b) * 6144 + 4 * 1024 + k]) * w_router[((size_t)l * D + k) * NE + e];
            const unsigned hb = f2bf(v); const float lv = v - __uint_as_float(hb << 16);
            WRHI[i] = (bf16)hb; WRLO[i] = (bf16)f2bf(lv); }
        for (int i = gw; i < DEPTH * NB * NE; i += NGW) { const int e = i & 31, b = (i >> 5) & 7, l = i >> 8; float s = 0.f;
            for (int k = lane; k < D; k += 64) s += MOD[((size_t)l * NB + b) * 6144 + 3 * 1024 + k] * w_router[((size_t)l * D + k) * NE + e];
            s = wave_sum(s); if (lane == 0) RC0[i] = s + b_router[l * NE + e]; }
    }
    SEAM(1);

    for (int li = (PROBE_MASK ? -1 : 0); li < DEPTH; ++li) {
        const int l = li < 0 ? 0 : li; const bool virt = li < 0;
        const int P = 2 + 10 * l;
#define VK(q) (!virt || ((PROBE_MASK >> (q)) & 1))
        if (KIND(2) && IN(P + 0) && VK(2)) { PH_BEGIN();
            pg8::Gemm g{H, WIN + (size_t)l * N_IN * D, D}; pg8::StaticOrder S; S.init(T, N_IN, G, bx);
            pg8::EpiIn E{AQKV, QB, KB, VB, GATE, q_norm_g + l * 64, k_norm_g + l * 64, ROPE};
            pg8::gemm_phase<pg8::EpiIn, pg8::StaticOrder>(L, g, S, E, wave);
        }
        if (VK(2)) SEAM(P + 0);
        if (KIND(3) && IN(P + 1) && VK(3)) { PH_BEGIN();
            namespace ab = attn_body;
            for (int j = 0; j < 8; ++j) {
                const int uidx = vcu * 8 + j; if (uidx >= 2048) break;
                const int pair = uidx >> 6, idx = uidx & 63; const int b = pair >> 2, kvh = pair & 3, hq = idx >> 4, qb = idx & 15; const int h = kvh * 4 + hq;
                ab::Job J; J.Q = (const ab::bf16*)QB + ((size_t)b * SEQ + qb * 256) * 1024 + h * 64; J.K = (const ab::bf16*)KB + (size_t)b * SEQ * 256 + kvh * 64; J.V = (const ab::bf16*)VB + (size_t)b * SEQ * 256 + kvh * 64;
                J.O = (ab::bf16*)OB + ((size_t)b * SEQ + qb * 256) * 1024 + h * 64; J.lse = nullptr; J.lutg = nullptr; J.NT = 64; J.i0 = 0; J.kq0 = 0; J.dsh = 0; J.cls = 0;
                ab::attn_unit<0, 8>(J, (char*)lds, wave);
            }
            for (int j = 0; j < 6; ++j) {
                const int uidx = vcu * 6 + j; if (uidx >= 1536) break;
                const int g = uidx / 512, r = uidx % 512; const int b = r >> 6, hs = (r >> 4) & 3, combo = r & 15;
                const int dsh = 2 * g; const int Lc = SEQ >> dsh; const int nqb = Lc >> 8;
                const int cls = combo / nqb, qb = combo % nqb; const int i0 = qb * 256;
                int t0 = (i0 >> 6) - 1; const int ntile = Lc >> 6; const int NT = ntile >= 6 ? 6 : 4; if (t0 < 0) t0 = 0; if (t0 > ntile - NT) t0 = ntile - NT;
                const size_t cbase = (size_t)b * SEQ + (size_t)cls * Lc;
                const ab::bf16* aq = (const ab::bf16*)AQKV + (size_t)(g * 3 + 0) * T * 256; const ab::bf16* ak = (const ab::bf16*)AQKV + (size_t)(g * 3 + 1) * T * 256; const ab::bf16* av = (const ab::bf16*)AQKV + (size_t)(g * 3 + 2) * T * 256;
                ab::Job J; J.Q = aq + (cbase + i0) * 256 + hs * 64; J.K = ak + (cbase + t0 * 64) * 256 + hs * 64; J.V = av + (cbase + t0 * 64) * 256 + hs * 64;
                J.O = (ab::bf16*)OAG + (size_t)g * T * 256 + (size_t)b * SEQ * 256 + hs * 64; J.lse = LSE + (size_t)g * T * 4 + (size_t)b * SEQ * 4 + hs; J.lutg = BLUT + (g * 4 + hs) * 768;
                J.NT = NT; J.i0 = i0; J.kq0 = t0 * 64 - i0; J.dsh = dsh; J.cls = cls;
                ab::attn_unit<1, 8>(J, (char*)lds, wave);
            }
        }
        if (VK(3)) SEAM(P + 1);
        if (KIND(4) && IN(P + 2) && VK(4)) { PH_BEGIN();
            for (int i = gtid; i < T * 32; i += NGT) { const int t = i >> 5, ch = i & 31, hs = ch >> 3;
                const float l0 = LSE[(size_t)t * 4 + hs], l1 = LSE[(size_t)T * 4 + (size_t)t * 4 + hs], l2 = LSE[(size_t)2 * T * 4 + (size_t)t * 4 + hs];
                const float mx = fmaxf(l0, fmaxf(l1, l2)); float w0 = exp2f(l0 - mx), w1 = exp2f(l1 - mx), w2 = exp2f(l2 - mx); const float inv = 1.0f / (w0 + w1 + w2); w0 *= inv; w1 *= inv; w2 *= inv;
                const v4u a = *(const GAS v4u*)(OAG + (size_t)t * 256 + ch * 8), bq = *(const GAS v4u*)(OAG + (size_t)T * 256 + (size_t)t * 256 + ch * 8), cq = *(const GAS v4u*)(OAG + (size_t)2 * T * 256 + (size_t)t * 256 + ch * 8);
                v4u o;
                o.x = pk2(w0 * bfl(a.x) + w1 * bfl(bq.x) + w2 * bfl(cq.x), w0 * bfh(a.x) + w1 * bfh(bq.x) + w2 * bfh(cq.x));
                o.y = pk2(w0 * bfl(a.y) + w1 * bfl(bq.y) + w2 * bfl(cq.y), w0 * bfh(a.y) + w1 * bfh(bq.y) + w2 * bfh(cq.y));
                o.z = pk2(w0 * bfl(a.z) + w1 * bfl(bq.z) + w2 * bfl(cq.z), w0 * bfh(a.z) + w1 * bfh(bq.z) + w2 * bfh(cq.z));
                o.w = pk2(w0 * bfl(a.w) + w1 * bfl(bq.w) + w2 * bfl(cq.w), w0 * bfh(a.w) + w1 * bfh(bq.w) + w2 * bfh(cq.w));
                *(GAS v4u*)(OA + (size_t)t * 256 + ch * 8) = o; }
        }
        if (VK(4)) SEAM(P + 2);
        if (KIND(5) && IN(P + 3) && VK(5)) { PH_BEGIN();
            pg8::StaticOrder S; S.init(T, D, G, bx);
            { pg8::Gemm g{OA, WBRA + (size_t)l * D * 256, 256}; pg8::EpiMergeA E{GATE, MERGED}; pg8::gemm_phase<pg8::EpiMergeA, pg8::StaticOrder>(L, g, S, E, wave); }
            { pg8::Gemm g{OB, WBRB + (size_t)l * D * D, D}; pg8::EpiMergeB E{GATE, MERGED}; pg8::gemm_phase<pg8::EpiMergeB, pg8::StaticOrder>(L, g, S, E, wave); }
        }
        if (VK(5)) SEAM(P + 3);
        if (KIND(6) && IN(P + 4) && VK(6)) { PH_BEGIN();
            pg8::Gemm g{MERGED, WOUT + (size_t)l * D * D, D}; pg8::StaticOrder S; S.init(T, D, G, bx);
            pg8::EpiOut E{l == 0 ? x_in : X, X, MOD + (size_t)l * NB * 6144 + 2 * 1024};
            pg8::gemm_phase<pg8::EpiOut, pg8::StaticOrder>(L, g, S, E, wave);
        }
        if (VK(6)) SEAM(P + 4);
        if (KIND(7) && IN(P + 5) && VK(7)) { PH_BEGIN();
            LAS int* hist = (LAS int*)(L + LDSCTL_OFF + 256);
            for (int vb = bx; vb < 256; vb += G) {
                if (tid < NE) hist[tid] = 0;
                __syncthreads();
                {
                    const int tt = vb + 256 * wave; const int r0 = tt * 16; const int b = r0 >> 12; const int i = lane & 15, kb = lane >> 4;
                    const float* xp = X + (size_t)(r0 + i) * D + 8 * kb;
                    const bf16* bh = WRHI + ((size_t)(l * NB + b) * NE + i) * D + 8 * kb; const bf16* bl = WRLO + ((size_t)(l * NB + b) * NE + i) * D + 8 * kb;
                    f32x4 acc0 = (f32x4){0.f, 0.f, 0.f, 0.f}, acc1 = acc0; float ss = 0.f;
#pragma unroll 4
                    for (int s = 0; s < 32; ++s) {
                        const f32x4 x0 = *(const GAS f32x4*)(xp + 32 * s), x1 = *(const GAS f32x4*)(xp + 32 * s + 4);
                        const bf16x8 wh0 = *(const GAS bf16x8*)(bh + 32 * s), wh1 = *(const GAS bf16x8*)(bh + 16 * D + 32 * s), wl0 = *(const GAS bf16x8*)(bl + 32 * s), wl1 = *(const GAS bf16x8*)(bl + 16 * D + 32 * s);
                        ss += (x0.x * x0.x + x0.y * x0.y) + (x0.z * x0.z + x0.w * x0.w) + (x1.x * x1.x + x1.y * x1.y) + (x1.z * x1.z + x1.w * x1.w);
                        v4u ah, al;
                        { const unsigned h0 = f2bf(x0.x), h1 = f2bf(x0.y), h2 = f2bf(x0.z), h3 = f2bf(x0.w), h4 = f2bf(x1.x), h5 = f2bf(x1.y), h6 = f2bf(x1.z), h7 = f2bf(x1.w);
                          ah.x = h0 | (h1 << 16); ah.y = h2 | (h3 << 16); ah.z = h4 | (h5 << 16); ah.w = h6 | (h7 << 16);
                          al.x = pk2(x0.x - __uint_as_float(h0 << 16), x0.y - __uint_as_float(h1 << 16)); al.y = pk2(x0.z - __uint_as_float(h2 << 16), x0.w - __uint_as_float(h3 << 16));
                          al.z = pk2(x1.x - __uint_as_float(h4 << 16), x1.y - __uint_as_float(h5 << 16)); al.w = pk2(x1.z - __uint_as_float(h6 << 16), x1.w - __uint_as_float(h7 << 16)); }
                        const bf16x8 ahv = __builtin_bit_cast(bf16x8, ah), alv = __builtin_bit_cast(bf16x8, al);
                        acc0 = __builtin_amdgcn_mfma_f32_16x16x32_bf16(wh0, ahv, acc0, 0, 0, 0); acc1 = __builtin_amdgcn_mfma_f32_16x16x32_bf16(wh1, ahv, acc1, 0, 0, 0);
                        acc0 = __builtin_amdgcn_mfma_f32_16x16x32_bf16(wl0, ahv, acc0, 0, 0, 0); acc1 = __builtin_amdgcn_mfma_f32_16x16x32_bf16(wl1, ahv, acc1, 0, 0, 0);
                        acc0 = __builtin_amdgcn_mfma_f32_16x16x32_bf16(wh0, alv, acc0, 0, 0, 0); acc1 = __builtin_amdgcn_mfma_f32_16x16x32_bf16(wh1, alv, acc1, 0, 0, 0);
                    }
                    ss = xsum<16>(ss); ss = xsum<32>(ss);
                    const float rs = rsqrtf(ss * (1.0f / D) + EPS);
                    float v[8]; const float* rc = RC0 + (l * NB + b) * NE;
#pragma unroll
                    for (int r = 0; r < 4; ++r) { v[r] = rs * acc0[r] + rc[4 * kb + r]; v[4 + r] = rs * acc1[r] + rc[16 + 4 * kb + r]; }
                    float tv[4]; int ti[4];
#pragma unroll
                    for (int k = 0; k < 4; ++k) { float best = v[0]; int br = 0;
#pragma unroll
                        for (int r = 1; r < 8; ++r) if (v[r] > best) { best = v[r]; br = r; }
#pragma unroll
                        for (int r = 0; r < 8; ++r) v[r] = (r == br) ? -INFINITY : v[r];
                        tv[k] = best; ti[k] = (br & 3) + 16 * (br >> 2) + 4 * kb; }
#pragma unroll
                    for (int round = 0; round < 2; ++round) {
                        float bv[8]; int bi[8];
#pragma unroll
                        for (int k = 0; k < 4; ++k) { bv[k] = tv[k]; bi[k] = ti[k];
                            if (round == 0) { bv[4 + k] = __int_as_float(__builtin_amdgcn_ds_swizzle(__float_as_int(tv[k]), 0x1f | (16 << 10))); bi[4 + k] = __builtin_amdgcn_ds_swizzle(ti[k], 0x1f | (16 << 10)); }
                            else { bv[4 + k] = xget32(tv[k], lane >> 5); bi[4 + k] = xget32(ti[k], lane >> 5); } }
#pragma unroll
                        for (int k = 0; k < 4; ++k) { float best = bv[0]; int bq = 0;
#pragma unroll
                            for (int r = 1; r < 8; ++r) if (bv[r] > best || (bv[r] == best && bi[r] < bi[bq])) { best = bv[r]; bq = r; }
                            int sel = bi[0];
#pragma unroll
                            for (int r = 0; r < 8; ++r) { if (r == bq) sel = bi[r]; }
#pragma unroll
                            for (int r = 0; r < 8; ++r) bv[r] = (r == bq) ? -INFINITY : bv[r];
                            tv[k] = best; ti[k] = sel; }
                    }
                    if (kb == 0) {
                        const float e1 = __expf(tv[1] - tv[0]), e2 = __expf(tv[2] - tv[0]), e3 = __expf(tv[3] - tv[0]); const float inv = 1.0f / (1.0f + e1 + e2 + e3);
                        const int tok = r0 + i;
                        *(GAS i32x4*)(TOPE + (size_t)tok * 4) = (i32x4){ti[0], ti[1], ti[2], ti[3]};
                        *(GAS f32x4*)(TOPW + (size_t)tok * 4) = (f32x4){inv, e1 * inv, e2 * inv, e3 * inv};
#pragma unroll
                        for (int k = 0; k < 4; ++k) atomicAdd((int*)&hist[ti[k]], 1);
                    }
                }
                __syncthreads();
                if (tid < NE) HIST[vb * NE + tid] = hist[tid];
                __syncthreads();
            }
            for (int m = 2 * gw; m < T; m += 2 * NGW) { const int b = m >> 12; const float* md = MOD + ((size_t)l * NB + b) * 6144;
                norm_rows2_bf16(X + (size_t)m * D, norm2_g + l * D, md + 4 * 1024, md + 3 * 1024, H + (size_t)m * D, lane); }
        }
        if (VK(7)) SEAM(P + 5);
        if (KIND(8) && IN(P + 6) && VK(8)) { PH_BEGIN();
            LAS int* sm = (LAS int*)L;
            for (int vb = bx; vb < 256; vb += G) {
                { const int e = tid & 31, seg = tid >> 5; int tot = 0, bef = 0;
                    for (int q = seg * 16; q < seg * 16 + 16; ++q) { const int hv = HIST[q * NE + e]; tot += hv; if (q < vb) bef += hv; }
                    sm[tid] = tot; sm[512 + tid] = bef; }
                __syncthreads();
                if (tid < NE) { int tot = 0, bef = 0;
                    for (int s = 0; s < 16; ++s) { tot += sm[s * 32 + tid]; bef += sm[512 + s * 32 + tid]; }
                    sm[1024 + tid] = bef; sm[1056 + tid] = (tot + 255) & ~255; }
                __syncthreads();
                if (tid == 0) { int run = 0; for (int e = 0; e < NE; ++e) { const int pd = sm[1056 + e]; sm[1056 + e] = run; sm[1024 + e] += run;
                        if (vb == 0) { for (int q = run >> 8; q < (run + pd) >> 8; ++q) TILEE[q] = e; }
                        run += pd; }
                    if (vb == 0) TILEE[1000] = run >> 8; }
                __syncthreads();
                if (tid < 128) { const int tt = vb + 256 * (tid >> 4); const int tok = tt * 16 + (tid & 15);
                    const i32x4 te = *(const GAS i32x4*)(TOPE + (size_t)tok * 4); const f32x4 tw = *(const GAS f32x4*)(TOPW + (size_t)tok * 4);
                    const int s0 = atomicAdd((int*)&sm[1024 + te.x], 1), s1 = atomicAdd((int*)&sm[1024 + te.y], 1), s2 = atomicAdd((int*)&sm[1024 + te.z], 1), s3 = atomicAdd((int*)&sm[1024 + te.w], 1);
                    *(GAS i32x4*)(SLOT + (size_t)tok * 4) = (i32x4){s0, s1, s2, s3};
                    ROWW[s0] = tw.x; ROWW[s1] = tw.y; ROWW[s2] = tw.z; ROWW[s3] = tw.w;
                    sm[2048 + tid * 4 + 0] = s0; sm[2048 + tid * 4 + 1] = s1; sm[2048 + tid * 4 + 2] = s2; sm[2048 + tid * 4 + 3] = s3; }
                __syncthreads();
                for (int p = wave; p < 512; p += NWAVES) { const int q = p >> 2; const int tt = vb + 256 * (q >> 4); const int tok = tt * 16 + (q & 15); const int slot = sm[2048 + p];
                    const GAS v4u* src = (const GAS v4u*)(H + (size_t)tok * D); GAS v4u* dst = (GAS v4u*)(XS + (size_t)slot * D);
                    const v4u a = src[lane], b2 = src[64 + lane]; dst[lane] = a; dst[64 + lane] = b2; }
                __syncthreads();
            }
        }
        if (VK(8)) SEAM(P + 6);
        if (KIND(9) && IN(P + 7) && VK(9)) { PH_BEGIN();
            const int nmt = __builtin_amdgcn_readfirstlane(__hip_atomic_load(TILEE + 1000, __ATOMIC_RELAXED, __HIP_MEMORY_SCOPE_AGENT));
            pg8::Gemm g{XS, WGU + (size_t)l * NE * 2048 * D, D}; pg8::MoeOrder S{TILEE, nmt * 8, 8, G, vcu};
            pg8::EpiGU E{b_gate_up + (size_t)l * NE * 2048, ACT};
            pg8::gemm_phase<pg8::EpiGU, pg8::MoeOrder>(L, g, S, E, wave);
        }
        if (VK(9)) SEAM(P + 7);
        if (KIND(10) && IN(P + 8) && VK(10)) { PH_BEGIN();
            const int nmt = __builtin_amdgcn_readfirstlane(__hip_atomic_load(TILEE + 1000, __ATOMIC_RELAXED, __HIP_MEMORY_SCOPE_AGENT));
            pg8::Gemm g{ACT, WDN + (size_t)l * NE * D * D, D}; pg8::MoeOrder S{TILEE, nmt * 4, 4, G, vcu};
            pg8::EpiDN E{b_down + (size_t)l * NE * D, ROWW, YB};
            pg8::gemm_phase<pg8::EpiDN, pg8::MoeOrder>(L, g, S, E, wave);
        }
        if (VK(10)) SEAM(P + 8);
        if (KIND(11) && IN(P + 9) && VK(11)) { PH_BEGIN();
            const bool lastl = (l == DEPTH - 1);
            float* Xw = virt ? (float*)(ws + WS_ACT) : X; bf16* Hw = virt ? (bf16*)(ws + WS_ACT + 128 * MiB) : H;
            for (int m0 = 2 * gw; m0 < T; m0 += 2 * NGW) { const int b = m0 >> 12;
                i32x4 sl[2];
#pragma unroll
                for (int q = 0; q < 2; ++q) { const int* sp = SLOT + (size_t)(m0 + q) * 4;
                    sl[q].x = __hip_atomic_load(sp + 0, RLX_AGENT); sl[q].y = __hip_atomic_load(sp + 1, RLX_AGENT); sl[q].z = __hip_atomic_load(sp + 2, RLX_AGENT); sl[q].w = __hip_atomic_load(sp + 3, RLX_AGENT); }
                const float* g2 = MOD + ((size_t)l * NB + b) * 6144 + 5 * 1024;
                f32x4 v[2][4]; v2u yy[2][4][4];
#pragma unroll
                for (int q = 0; q < 2; ++q)
#pragma unroll
                    for (int j = 0; j < 4; ++j) { const int c = 256 * j + 4 * lane;
                        v[q][j] = *(const GAS f32x4*)(X + (size_t)(m0 + q) * D + c);
                        yy[q][j][0] = *(const GAS v2u*)(YB + (size_t)sl[q].x * D + c); yy[q][j][1] = *(const GAS v2u*)(YB + (size_t)sl[q].y * D + c);
                        yy[q][j][2] = *(const GAS v2u*)(YB + (size_t)sl[q].z * D + c); yy[q][j][3] = *(const GAS v2u*)(YB + (size_t)sl[q].w * D + c); }
                float s[2] = {0.f, 0.f};
#pragma unroll
                for (int q = 0; q < 2; ++q)
#pragma unroll
                    for (int j = 0; j < 4; ++j) { const int c = 256 * j + 4 * lane; const v2u y0 = yy[q][j][0], y1 = yy[q][j][1], y2 = yy[q][j][2], y3 = yy[q][j][3];
                        f32x4 ys; ys.x = (bfl(y0.x) + bfl(y1.x)) + (bfl(y2.x) + bfl(y3.x)); ys.y = (bfh(y0.x) + bfh(y1.x)) + (bfh(y2.x) + bfh(y3.x));
                        ys.z = (bfl(y0.y) + bfl(y1.y)) + (bfl(y2.y) + bfl(y3.y)); ys.w = (bfh(y0.y) + bfh(y1.y)) + (bfh(y2.y) + bfh(y3.y));
                        const f32x4 gg = *(const GAS f32x4*)(g2 + c);
                        v[q][j] = v[q][j] + gg * ys;
                        if (!lastl) *(GAS f32x4*)(Xw + (size_t)(m0 + q) * D + c) = v[q][j];
                        s[q] += (v[q][j].x * v[q][j].x + v[q][j].y * v[q][j].y) + (v[q][j].z * v[q][j].z + v[q][j].w * v[q][j].w); }
                const float rs0 = rsqrtf(wave_sum(s[0]) * (1.0f / D) + EPS), rs1 = rsqrtf(wave_sum(s[1]) * (1.0f / D) + EPS);
                if (!lastl) { const float* md = MOD + ((size_t)(l + 1) * NB + b) * 6144; const float* gn = norm1_g + (l + 1) * D;
#pragma unroll
                    for (int j = 0; j < 4; ++j) { const int c = 256 * j + 4 * lane;
                        const f32x4 gg = *(const GAS f32x4*)(gn + c), a1 = *(const GAS f32x4*)(md + 1024 + c) + 1.0f, a0 = *(const GAS f32x4*)(md + c);
                        const f32x4 y0 = (v[0][j] * rs0 * gg) * a1 + a0, y1 = (v[1][j] * rs1 * gg) * a1 + a0;
                        v2u o0; o0.x = pk2(y0.x, y0.y); o0.y = pk2(y0.z, y0.w); *(GAS v2u*)(Hw + (size_t)m0 * D + c) = o0;
                        v2u o1; o1.x = pk2(y1.x, y1.y); o1.y = pk2(y1.z, y1.w); *(GAS v2u*)(Hw + (size_t)(m0 + 1) * D + c) = o1; }
                } else {
#pragma unroll
                    for (int j = 0; j < 4; ++j) { const int c = 256 * j + 4 * lane; const f32x4 gg = *(const GAS f32x4*)(final_g + c);
                        *(GAS f32x4*)(ap->out + (size_t)m0 * D + c) = v[0][j] * rs0 * gg; *(GAS f32x4*)(ap->out + (size_t)(m0 + 1) * D + c) = v[1][j] * rs1 * gg; }
                }
            }
        }
        if (VK(11)) SEAM(P + 9);
        if (virt) { PH_BEGIN();
            for (int m = 2 * gw; m < T; m += 2 * NGW) { const int b = m >> 12; const float* md = MOD + (size_t)b * 6144; norm_rows2_bf16(x_in + (size_t)m * D, norm1_g, md + 1024, md, H + (size_t)m * D, lane); }
            xcd_barrier(bar); }
    }
#undef IN
#undef SEAM
}

extern "C" void kernel_launch(void* const* d_in, const int* in_sizes, int n_in, void* d_out, int out_size, void* d_ws, size_t ws_size, hipStream_t stream) {
    static int grid = 0;
    if (grid == 0) {
        if (n_in != 20 || in_sizes[0] != T * D || out_size != T * D || ws_size < WS_END) { fprintf(stderr, "kernel_launch: unexpected shapes (n_in %d, in0 %d, out %d, ws %zu < %zu); nothing launched\n", n_in, n_in > 0 ? in_sizes[0] : -1, out_size, ws_size, (size_t)WS_END); grid = -1; return; }
        int dev = 0, cus = 0, per_cu = 0;
        if (hipGetDevice(&dev) != hipSuccess || hipDeviceGetAttribute(&cus, hipDeviceAttributeMultiprocessorCount, dev) != hipSuccess) { grid = -1; return; }
        if (hipFuncSetAttribute((const void*)mk_fwd, hipFuncAttributeMaxDynamicSharedMemorySize, LDS_BYTES) != hipSuccess) { fprintf(stderr, "kernel_launch: hipFuncSetAttribute failed\n"); grid = -1; return; }
        if (hipOccupancyMaxActiveBlocksPerMultiprocessor(&per_cu, (const void*)mk_fwd, NWAVES * 64, LDS_BYTES) != hipSuccess || per_cu < 1)
            fprintf(stderr, "kernel_launch: note: occupancy query reports %d workgroups per CU\n", per_cu);
        (void)hipGetLastError();
        grid = cus < 256 ? cus : 256;
        if (grid != 256) fprintf(stderr, "kernel_launch: %d CUs; this kernel's unit deals assume 256\n", grid);
    }
    if (grid < 0) return;
    if (hipMemsetAsync((char*)d_ws + WS_CTL, 0, CTL_ZERO_BYTES, stream) != hipSuccess) { fprintf(stderr, "kernel_launch: memset failed\n"); return; }
    Args a{};
    for (int i = 0; i < 20; ++i) a.in[i] = (const float*)d_in[i];
    a.out = (float*)d_out; a.ws = (unsigned char*)d_ws; a.pad = 0;
#if MK_PER_PHASE
    for (int p = 0; p < N_PHASES; ++p) { a.ph_lo = p; a.ph_hi = p + 1; a.li = 0; hipLaunchKernelGGL(mk_fwd, dim3(grid), dim3(NWAVES * 64), LDS_BYTES, stream, a); }
#else
    a.ph_lo = 0; a.ph_hi = N_PHASES; a.li = 0;
    hipLaunchKernelGGL(mk_fwd, dim3(grid), dim3(NWAVES * 64), LDS_BYTES, stream, a);
#endif
    const hipError_t le = hipPeekAtLastError();
    if (le != hipSuccess) fprintf(stderr, "kernel_launch: launch failed: %s\n", hipGetErrorName(le));
}
```

```cpp
#include <hip/hip_runtime.h>
#include <hip/hip_bf16.h>
#include <cstdio>
#include <cstdint>
#include <cmath>

#ifndef PH_KIND_MASK
#define PH_KIND_MASK 0xFFF
#endif
#ifndef PROBE_MASK
#define PROBE_MASK 0
#endif
#ifndef PROBE_P0
#define PROBE_P0 0
#endif
#ifndef MK_PER_PHASE
#define MK_PER_PHASE 0
#endif

constexpr int NB = 8, SEQ = 4096, T = NB * SEQ, D = 1024, DEPTH = 2;
constexpr int N_IN = 5888, NE = 32, TOPK = 4;
constexpr int NASSIGN = T * TOPK;
constexpr int MAX_MT = NASSIGN / 256 + NE;
constexpr int CAP_ROWS = MAX_MT * 256;
constexpr float C2 = 0.125f * 1.4426950408889634f;
constexpr float LOG2E = 1.4426950408889634f;
constexpr float EPS = 1e-6f;

__device__ __forceinline__ int lane_id_asm() { int l; asm volatile("v_mbcnt_lo_u32_b32 %0, -1, 0\n\tv_mbcnt_hi_u32_b32 %0, -1, %0" : "=v"(l)); return l; }

template <int M> __device__ __forceinline__ float xsum(float v) {
    if constexpr (M < 32) return v + __int_as_float(__builtin_amdgcn_ds_swizzle(__float_as_int(v), 0x1f | (M << 10)));
    else { auto rr = __builtin_amdgcn_permlane32_swap(__float_as_uint(v), __float_as_uint(v), false, false); return __uint_as_float(rr[0]) + __uint_as_float(rr[1]); }
}
template <class Tv> __device__ __forceinline__ Tv xget32(Tv v, int hf) {
    auto rr = __builtin_amdgcn_permlane32_swap(__builtin_bit_cast(unsigned, v), __builtin_bit_cast(unsigned, v), false, false); return __builtin_bit_cast(Tv, hf ? rr[0] : rr[1]);
}

namespace pg8 {
#define PG8_LAS __attribute__((address_space(3)))
typedef unsigned short bf16_t;
typedef short bf16x8 __attribute__((ext_vector_type(8)));
typedef float f32x4 __attribute__((ext_vector_type(4)));
typedef unsigned u32x4 __attribute__((ext_vector_type(4)));
typedef unsigned u32x2 __attribute__((ext_vector_type(2)));
constexpr int BM = 256, BK = 64, HALF = 128, HTB = HALF * BK * 2, STAGE_BYTES = 8 * HTB, NXCD = 8, WGM = 8;

__host__ __device__ __forceinline__ int lds_byte(int r, int c) { const int st = (r >> 4) * 2 + (c >> 5), rr = r & 15, cc = c & 31, ob = rr * 64 + cc * 2; return st * 1024 + (ob ^ (((ob >> 9) & 1) << 5)); }
__host__ __device__ __forceinline__ void stage_rc(int b, int& R, int& C) { const int st = b / 1024, sb = b % 1024, swz = sb ^ (((sb >> 9) & 1) << 5); R = (st >> 1) * 16 + swz / 64; C = (st & 1) * 32 + (swz % 64) / 2; }
__host__ __device__ __forceinline__ int perm32(int rho) { const int n = rho >> 4, i = rho & 15; return 8 * (i >> 2) + 4 * n + (i & 3); }

struct Unit { int pm, pn; };
struct Gemm { const bf16_t* A; const bf16_t* Bt; int K; };

struct StaticOrder {
    int nM, nN, nwg, G, c;
    __device__ void init(int M, int N, int G_, int c_) { nM = M / BM; nN = N / BM; nwg = nM * nN; G = G_; c = c_; }
    __device__ bool next(int i, Unit& u) const {
        const long L = (long)i * G + c; if (L >= nwg) return false;
        int wgid = (int)L; { const int q = nwg / NXCD, r = nwg % NXCD, xcd = wgid % NXCD, off = wgid / NXCD; wgid = (xcd < r ? xcd * (q + 1) : r * (q + 1) + (xcd - r) * q) + off; }
        const int nig = WGM * nN, gid = wgid / nig, fm = gid * WGM, gsz = (nM - fm) < WGM ? (nM - fm) : WGM;
        u.pm = fm + ((wgid % nig) % gsz); u.pn = (wgid % nig) / gsz; return true;
    }
};
struct MoeOrder {
    const int* tile_e; int n_units, nN, G, vcu;
    __device__ bool next(int i, Unit& u) const {
        const long L = (long)i * G + vcu; if (L >= n_units) return false;
        const int mt = (int)L / nN, pl = (int)L % nN; const int e = __builtin_amdgcn_readfirstlane(__hip_atomic_load(tile_e + mt, __ATOMIC_RELAXED, __HIP_MEMORY_SCOPE_AGENT));
        u.pm = mt; u.pn = e * nN + pl; return true;
    }
};

__device__ __forceinline__ unsigned cvt_pk_bf16(float lo, float hi) { unsigned r; asm volatile("v_cvt_pk_bf16_f32 %0, %1, %2" : "=v"(r) : "v"(lo), "v"(hi)); return r; }
__device__ __forceinline__ float bf_lo(unsigned w) { return __uint_as_float(w << 16); }
__device__ __forceinline__ float bf_hi(unsigned w) { return __uint_as_float(w & 0xffff0000u); }
__device__ __forceinline__ float sigmoid_f(float x) { return __builtin_amdgcn_rcpf(1.0f + __builtin_amdgcn_exp2f(-LOG2E * x)); }

template <class Epi, class Sched>
__device__ __forceinline__ void gemm_phase(PG8_LAS unsigned char* lds, const Gemm g, const Sched& S, const Epi& E, const int wid_in) {
    int wid = wid_in; asm volatile("" : "+s"(wid));
    const int lane = lane_id_asm(), tid = wid * 64 + lane, wr = wid >> 2, wc = wid & 3, fr = lane & 15, fq = lane >> 4;
    int K_o = g.K; asm volatile("" : "+s"(K_o)); const int K = K_o, nt = K / BK;
    unsigned voff[2];
#pragma unroll
    for (int i = 0; i < 2; ++i) { int R, C; stage_rc(tid * 16 + i * 8192, R, C); voff[i] = (unsigned)(R * K + C) * 2u; }
    const size_t kstep = (size_t)(BK * 2);
    const size_t hstep = (size_t)HALF * K * 2;
    const size_t tstep = 2 * hstep;
    const unsigned ldsw = (unsigned)wid * 1024u;
    const int aoff = lds_byte(wr * 64 + fr, fq * 8), boff = lds_byte(wc * 32 + fr, fq * 8);
#define PG8_SA(b, h) (((b) * 2 + (h)) * HTB)
#define PG8_SB(b, h) ((4 + (b) * 2 + (h)) * HTB)
#define PG8_STAGE(bufoff, gbase) do { _Pragma("unroll") for (int _i = 0; _i < 2; ++_i) \
        __builtin_amdgcn_global_load_lds((const unsigned*)((const char*)(gbase) + voff[_i]), (PG8_LAS unsigned*)(lds + (bufoff) + ldsw + _i * 8192), 16, 0, 0); } while (0)
#define PG8_LDA(dst, b, h) do { _Pragma("unroll") for (int m = 0; m < 4; ++m) _Pragma("unroll") for (int k = 0; k < 2; ++k) dst[m][k] = *(const PG8_LAS bf16x8*)(lds + PG8_SA(b, h) + aoff + m * 2048 + k * 1024); } while (0)
#define PG8_LDB(dst, b, h) do { _Pragma("unroll") for (int n = 0; n < 2; ++n) _Pragma("unroll") for (int k = 0; k < 2; ++k) dst[n][k] = *(const PG8_LAS bf16x8*)(lds + PG8_SB(b, h) + boff + n * 2048 + k * 1024); } while (0)
#define PG8_MMA(ai, bj, At, Bt) do { __builtin_amdgcn_s_setprio(1); _Pragma("unroll") for (int m = 0; m < 4; ++m) _Pragma("unroll") for (int n = 0; n < 2; ++n) _Pragma("unroll") for (int k = 0; k < 2; ++k) \
        acc[ai][bj][m][n] = __builtin_amdgcn_mfma_f32_16x16x32_bf16(Bt[n][k], At[m][k], acc[ai][bj][m][n], 0, 0, 0); __builtin_amdgcn_s_setprio(0); } while (0)
#define PG8_WAIT_V(n) asm volatile("s_waitcnt vmcnt(" #n ")" ::: "memory")
#define PG8_WAIT_L(n) asm volatile("s_waitcnt lgkmcnt(" #n ")" ::: "memory")
#define PG8_BAR __builtin_amdgcn_s_barrier()
#define PG8_SCHED __builtin_amdgcn_sched_barrier(0)
    Unit cur, nxt; int ui = 0;
    if (!S.next(0, cur)) return;
    f32x4 acc[2][2][4][2];
#pragma unroll
    for (int a = 0; a < 2; ++a)
#pragma unroll
        for (int b = 0; b < 2; ++b)
#pragma unroll
            for (int m = 0; m < 4; ++m)
#pragma unroll
                for (int n = 0; n < 2; ++n) acc[a][b][m][n] = (f32x4){0.f, 0.f, 0.f, 0.f};
    bf16x8 At[4][2], B0[2][2], B1[2][2];
    const char* cA = (const char*)g.A + (size_t)cur.pm * tstep; const char* cB = (const char*)g.Bt + (size_t)cur.pn * tstep;
    PG8_STAGE(PG8_SB(0, 0), cB); PG8_STAGE(PG8_SB(0, 1), cB + hstep); PG8_STAGE(PG8_SA(0, 0), cA); PG8_STAGE(PG8_SA(0, 1), cA + hstep);
    if (wr == 1) PG8_BAR;
    PG8_WAIT_V(2); PG8_BAR;
    PG8_STAGE(PG8_SB(1, 0), cB + kstep); PG8_STAGE(PG8_SA(1, 0), cA + kstep); PG8_STAGE(PG8_SB(1, 1), cB + hstep + kstep);
    PG8_WAIT_V(6); PG8_BAR;
    for (;;) {
        const bool has_next = S.next(ui + 1, nxt);
        const char* nA = has_next ? (const char*)g.A + (size_t)nxt.pm * tstep : cA; const char* nB = has_next ? (const char*)g.Bt + (size_t)nxt.pn * tstep : cB;
        for (int t = 0; t < nt; t += 2) {
            const bool last = (t == nt - 2);
            const char* a1 = cA + (size_t)(t + 1) * kstep;
            const char* a2 = last ? nA : cA + (size_t)(t + 2) * kstep; const char* b2 = last ? nB : cB + (size_t)(t + 2) * kstep;
            const char* a3 = a2 + kstep; const char* b3 = b2 + kstep;
            PG8_LDB(B0, 0, 0); PG8_LDB(B1, 0, 1); PG8_SCHED; PG8_LDA(At, 0, 0); PG8_STAGE(PG8_SA(1, 1), a1 + hstep);
            PG8_WAIT_V(8); PG8_WAIT_L(0); PG8_BAR; PG8_MMA(0, 0, At, B0); PG8_MMA(0, 1, At, B1); PG8_BAR; PG8_SCHED;
            PG8_LDA(At, 0, 1); PG8_STAGE(PG8_SB(0, 0), b2); PG8_STAGE(PG8_SB(0, 1), b2 + hstep); PG8_STAGE(PG8_SA(0, 0), a2);
            PG8_WAIT_V(8); PG8_WAIT_L(0); PG8_BAR; PG8_MMA(1, 0, At, B0); PG8_MMA(1, 1, At, B1); PG8_BAR; PG8_SCHED;
            PG8_LDB(B0, 1, 0); PG8_LDB(B1, 1, 1); PG8_SCHED; PG8_LDA(At, 1, 0); PG8_STAGE(PG8_SA(0, 1), a2 + hstep);
            PG8_WAIT_V(8); PG8_WAIT_L(0); PG8_BAR; PG8_MMA(0, 0, At, B0); PG8_MMA(0, 1, At, B1); PG8_BAR; PG8_SCHED;
            PG8_LDA(At, 1, 1); PG8_STAGE(PG8_SB(1, 0), b3); PG8_STAGE(PG8_SB(1, 1), b3 + hstep); PG8_STAGE(PG8_SA(1, 0), a3);
            PG8_WAIT_V(8); PG8_WAIT_L(0); PG8_BAR; PG8_MMA(1, 0, At, B0); PG8_MMA(1, 1, At, B1); PG8_BAR; PG8_SCHED;
        }
        if (wr == 0) PG8_BAR;
        E(acc, cur, wr, wc, fr, fq);
        if (!has_next) break;
#pragma unroll
        for (int a = 0; a < 2; ++a)
#pragma unroll
            for (int b = 0; b < 2; ++b)
#pragma unroll
                for (int m = 0; m < 4; ++m)
#pragma unroll
                    for (int n = 0; n < 2; ++n) acc[a][b][m][n] = (f32x4){0.f, 0.f, 0.f, 0.f};
        cur = nxt; cA = nA; cB = nB; ++ui;
        if (wr == 1) PG8_BAR;
    }
    PG8_WAIT_V(0);
    PG8_BAR;
#undef PG8_SA
#undef PG8_SB
#undef PG8_STAGE
#undef PG8_LDA
#undef PG8_LDB
#undef PG8_MMA
#undef PG8_WAIT_V
#undef PG8_WAIT_L
#undef PG8_BAR
#undef PG8_SCHED
}

typedef int i32x4_t __attribute__((ext_vector_type(4)));
template <class Epi, class Sched>
__device__ __forceinline__ void gemm_phase_f8(PG8_LAS unsigned char* lds, const Gemm g, const Sched& S, const Epi& E, const int wid_in) {
    int wid = wid_in; asm volatile("" : "+s"(wid));
    const int lane = lane_id_asm(), tid = wid * 64 + lane, wr = wid >> 2, wc = wid & 3, fr = lane & 15, fq = lane >> 4;
    int K_o = g.K; asm volatile("" : "+s"(K_o)); const int K = K_o, nt = K / BK;
    unsigned voff[2];
#pragma unroll
    for (int i = 0; i < 2; ++i) { int R, C; stage_rc(tid * 16 + i * 8192, R, C); voff[i] = (unsigned)(R * K + C) * 2u; }
    const size_t kstep = (size_t)(BK * 2);
    const size_t hstep = (size_t)HALF * K * 2;
    const size_t tstep = 2 * hstep;
    const unsigned ldsw = (unsigned)wid * 1024u;
    const int aoff = lds_byte(wr * 64 + fr, fq * 16), boff = lds_byte(wc * 32 + fr, fq * 16);
#define PG8_SA(b, h) (((b) * 2 + (h)) * HTB)
#define PG8_SB(b, h) ((4 + (b) * 2 + (h)) * HTB)
#define PG8_STAGE(bufoff, gbase) do { _Pragma("unroll") for (int _i = 0; _i < 2; ++_i) \
        __builtin_amdgcn_global_load_lds((const unsigned*)((const char*)(gbase) + voff[_i]), (PG8_LAS unsigned*)(lds + (bufoff) + ldsw + _i * 8192), 16, 0, 0); } while (0)
#define PG8_LDA(dst, b, h) do { _Pragma("unroll") for (int m = 0; m < 4; ++m) _Pragma("unroll") for (int k = 0; k < 2; ++k) dst[m][k] = *(const PG8_LAS bf16x8*)(lds + PG8_SA(b, h) + aoff + m * 2048 + k * 16); } while (0)
#define PG8_LDB(dst, b, h) do { _Pragma("unroll") for (int n = 0; n < 2; ++n) _Pragma("unroll") for (int k = 0; k < 2; ++k) dst[n][k] = *(const PG8_LAS bf16x8*)(lds + PG8_SB(b, h) + boff + n * 2048 + k * 16); } while (0)
#define PG8_F8(x) __builtin_shufflevector(__builtin_bit_cast(i32x4_t, (x)[0]), __builtin_bit_cast(i32x4_t, (x)[1]), 0, 1, 2, 3, 4, 5, 6, 7)
#define PG8_MMA(ai, bj, At, Bt) do { __builtin_amdgcn_s_setprio(1); asm volatile("s_nop 1" ::: ); _Pragma("unroll") for (int m = 0; m < 4; ++m) _Pragma("unroll") for (int n = 0; n < 2; ++n) \
        asm volatile("v_mfma_f32_16x16x128_f8f6f4 %0, %1, %2, %0" : "+v"(acc[ai][bj][m][n]) : "v"(PG8_F8(Bt[n])), "v"(PG8_F8(At[m]))); __builtin_amdgcn_s_setprio(0); } while (0)
#define PG8_ACC_SETTLE asm volatile("s_nop 15\n\ts_nop 15" ::: "memory")
#define PG8_WAIT_V(n) asm volatile("s_waitcnt vmcnt(" #n ")" ::: "memory")
#define PG8_WAIT_L(n) asm volatile("s_waitcnt lgkmcnt(" #n ")" ::: "memory")
#define PG8_BAR __builtin_amdgcn_s_barrier()
#define PG8_SCHED __builtin_amdgcn_sched_barrier(0)
    Unit cur, nxt; int ui = 0;
    if (!S.next(0, cur)) return;
    f32x4 acc[2][2][4][2];
#pragma unroll
    for (int a = 0; a < 2; ++a)
#pragma unroll
        for (int b = 0; b < 2; ++b)
#pragma unroll
            for (int m = 0; m < 4; ++m)
#pragma unroll
                for (int n = 0; n < 2; ++n) acc[a][b][m][n] = (f32x4){0.f, 0.f, 0.f, 0.f};
    bf16x8 At[4][2], B0[2][2], B1[2][2];
    const char* cA = (const char*)g.A + (size_t)cur.pm * tstep; const char* cB = (const char*)g.Bt + (size_t)cur.pn * tstep;
    PG8_STAGE(PG8_SB(0, 0), cB); PG8_STAGE(PG8_SB(0, 1), cB + hstep); PG8_STAGE(PG8_SA(0, 0), cA); PG8_STAGE(PG8_SA(0, 1), cA + hstep);
    if (wr == 1) PG8_BAR;
    PG8_WAIT_V(2); PG8_BAR;
    PG8_STAGE(PG8_SB(1, 0), cB + kstep); PG8_STAGE(PG8_SA(1, 0), cA + kstep); PG8_STAGE(PG8_SB(1, 1), cB + hstep + kstep);
    PG8_WAIT_V(6); PG8_BAR;
    for (;;) {
        const bool has_next = S.next(ui + 1, nxt);
        const char* nA = has_next ? (const char*)g.A + (size_t)nxt.pm * tstep : cA; const char* nB = has_next ? (const char*)g.Bt + (size_t)nxt.pn * tstep : cB;
        for (int t = 0; t < nt; t += 2) {
            const bool last = (t == nt - 2);
            const char* a1 = cA + (size_t)(t + 1) * kstep;
            const char* a2 = last ? nA : cA + (size_t)(t + 2) * kstep; const char* b2 = last ? nB : cB + (size_t)(t + 2) * kstep;
            const char* a3 = a2 + kstep; const char* b3 = b2 + kstep;
            PG8_LDB(B0, 0, 0); PG8_LDB(B1, 0, 1); PG8_SCHED; PG8_LDA(At, 0, 0); PG8_STAGE(PG8_SA(1, 1), a1 + hstep);
            PG8_WAIT_V(8); PG8_WAIT_L(0); PG8_BAR; PG8_MMA(0, 0, At, B0); PG8_MMA(0, 1, At, B1); PG8_BAR; PG8_SCHED;
            PG8_LDA(At, 0, 1); PG8_STAGE(PG8_SB(0, 0), b2); PG8_STAGE(PG8_SB(0, 1), b2 + hstep); PG8_STAGE(PG8_SA(0, 0), a2);
            PG8_WAIT_V(8); PG8_WAIT_L(0); PG8_BAR; PG8_MMA(1, 0, At, B0); PG8_MMA(1, 1, At, B1); PG8_BAR; PG8_SCHED;
            PG8_LDB(B0, 1, 0); PG8_LDB(B1, 1, 1); PG8_SCHED; PG8_LDA(At, 1, 0); PG8_STAGE(PG8_SA(0, 1), a2 + hstep);
            PG8_WAIT_V(8); PG8_WAIT_L(0); PG8_BAR; PG8_MMA(0, 0, At, B0); PG8_MMA(0, 1, At, B1); PG8_BAR; PG8_SCHED;
            PG8_LDA(At, 1, 1); PG8_STAGE(PG8_SB(1, 0), b3); PG8_STAGE(PG8_SB(1, 1), b3 + hstep); PG8_STAGE(PG8_SA(1, 0), a3);
            PG8_WAIT_V(8); PG8_WAIT_L(0); PG8_BAR; PG8_MMA(1, 0, At, B0); PG8_MMA(1, 1, At, B1); PG8_BAR; PG8_SCHED;
        }
        if (wr == 0) PG8_BAR;
        PG8_ACC_SETTLE;
        E(acc, cur, wr, wc, fr, fq);
        if (!has_next) break;
#pragma unroll
        for (int a = 0; a < 2; ++a)
#pragma unroll
            for (int b = 0; b < 2; ++b)
#pragma unroll
                for (int m = 0; m < 4; ++m)
#pragma unroll
                    for (int n = 0; n < 2; ++n) acc[a][b][m][n] = (f32x4){0.f, 0.f, 0.f, 0.f};
        cur = nxt; cA = nA; cB = nB; ++ui;
        if (wr == 1) PG8_BAR;
    }
    PG8_WAIT_V(0);
    PG8_BAR;
#undef PG8_SA
#undef PG8_SB
#undef PG8_STAGE
#undef PG8_LDA
#undef PG8_LDB
#undef PG8_MMA
#undef PG8_F8
#undef PG8_ACC_SETTLE
#undef PG8_WAIT_V
#undef PG8_WAIT_L
#undef PG8_BAR
#undef PG8_SCHED
}

#define EPI_ROWS(...) _Pragma("unroll") for (int ai = 0; ai < 2; ++ai) _Pragma("unroll") for (int m = 0; m < 4; ++m) { const int row = u.pm * BM + ai * HALF + wr * 64 + m * 16 + fr; __VA_ARGS__ }
__device__ __forceinline__ u32x4 pack8(const f32x4 a, const f32x4 b) { u32x4 w; w.x = cvt_pk_bf16(a[0], a[1]); w.y = cvt_pk_bf16(a[2], a[3]); w.z = cvt_pk_bf16(b[0], b[1]); w.w = cvt_pk_bf16(b[2], b[3]); return w; }

struct EpiIn {
    bf16_t* aqkv; bf16_t* qb; bf16_t* kb; bf16_t* vb; bf16_t* gate; const float* qg; const float* kg; const float* rope;
    __device__ __forceinline__ void operator()(const f32x4 (&acc)[2][2][4][2], const Unit& u, int wr, int wc, int fr, int fq) const {
        const int pn = u.pn;
        if (pn >= 9 && pn < 14) {
            const bool isq = pn < 13; const int head = isq ? (pn - 9) * 4 + wc : wc; bf16_t* dst = isq ? qb : kb; const int pitch = isq ? 1024 : 256;
            const float* gvec = isq ? qg : kg; const float osc = isq ? C2 : 1.0f;
            f32x4 gv[2][2];
#pragma unroll
            for (int bj = 0; bj < 2; ++bj)
#pragma unroll
                for (int n = 0; n < 2; ++n) gv[bj][n] = *(const f32x4*)(gvec + 32 * bj + 16 * n + 4 * fq);
            EPI_ROWS(
                float ss = 0.f;
                _Pragma("unroll") for (int bj = 0; bj < 2; ++bj) _Pragma("unroll") for (int n = 0; n < 2; ++n) { const f32x4 x = acc[ai][bj][m][n]; ss += (x[0] * x[0] + x[1] * x[1]) + (x[2] * x[2] + x[3] * x[3]); }
                ss = xsum<16>(ss); ss = xsum<32>(ss);
                const float sc = rsqrtf(ss * (1.0f / 64.0f) + EPS) * osc;
                const int t = row & (SEQ - 1);
                _Pragma("unroll") for (int bj = 0; bj < 2; ++bj) {
                    const int pos = bj == 0 ? (t >> 6) : (t & 63);
                    const f32x4 cs = *(const f32x4*)(rope + pos * 16 + 4 * fq); const f32x4 sn = *(const f32x4*)(rope + 1024 + pos * 16 + 4 * fq);
                    const f32x4 y0 = acc[ai][bj][m][0] * sc * gv[bj][0]; const f32x4 y1 = acc[ai][bj][m][1] * sc * gv[bj][1];
                    const f32x4 o0 = y0 * cs - y1 * sn; const f32x4 o1 = y1 * cs + y0 * sn;
                    bf16_t* p = dst + (size_t)row * pitch + head * 64 + 32 * bj + 4 * fq;
                    u32x2 w0; w0.x = cvt_pk_bf16(o0[0], o0[1]); w0.y = cvt_pk_bf16(o0[2], o0[3]);
                    u32x2 w1; w1.x = cvt_pk_bf16(o1[0], o1[1]); w1.y = cvt_pk_bf16(o1[2], o1[3]);
                    *(u32x2*)p = w0; *(u32x2*)(p + 16) = w1;
                }
            )
        } else {
            bf16_t* dst; int pitch, colt, dsh = 0; float sc = 1.0f; bool sig = false, fold = false;
            if (pn < 9) { dst = aqkv + (size_t)pn * T * 256; pitch = 256; colt = 0; fold = true; dsh = 2 * (pn / 3); if (pn % 3 == 0) sc = C2; }
            else if (pn == 14) { dst = vb; pitch = 256; colt = 0; }
            else { dst = gate; pitch = 2048; colt = (pn - 15) * 256; sig = true; }
            const int col0 = colt + wc * 32 + 8 * fq;
            EPI_ROWS(
                int drow = row;
                if (fold) { const int t = row & (SEQ - 1); drow = (row & ~(SEQ - 1)) | ((t & ((1 << dsh) - 1)) << (12 - dsh)) | (t >> dsh); }
                bf16_t* rowp = dst + (size_t)drow * pitch + col0;
                _Pragma("unroll") for (int bj = 0; bj < 2; ++bj) {
                    f32x4 v0 = acc[ai][bj][m][0], v1 = acc[ai][bj][m][1];
                    if (sig) { _Pragma("unroll") for (int j = 0; j < 4; ++j) { v0[j] = sigmoid_f(v0[j]); v1[j] = sigmoid_f(v1[j]); } }
                    else { v0 = v0 * sc; v1 = v1 * sc; }
                    *(u32x4*)(rowp + bj * HALF) = pack8(v0, v1);
                }
            )
        }
    }
};
struct EpiMergeA {
    const bf16_t* gate; bf16_t* merged;
    __device__ __forceinline__ void operator()(const f32x4 (&acc)[2][2][4][2], const Unit& u, int wr, int wc, int fr, int fq) const {
        const int col0 = u.pn * BM + wc * 32 + 8 * fq;
        EPI_ROWS(
            _Pragma("unroll") for (int bj = 0; bj < 2; ++bj) {
                const u32x4 gw = *(const u32x4*)(gate + (size_t)row * 2048 + col0 + bj * HALF);
                f32x4 v0 = acc[ai][bj][m][0], v1 = acc[ai][bj][m][1];
                v0[0] *= bf_lo(gw.x); v0[1] *= bf_hi(gw.x); v0[2] *= bf_lo(gw.y); v0[3] *= bf_hi(gw.y);
                v1[0] *= bf_lo(gw.z); v1[1] *= bf_hi(gw.z); v1[2] *= bf_lo(gw.w); v1[3] *= bf_hi(gw.w);
                *(u32x4*)(merged + (size_t)row * 1024 + col0 + bj * HALF) = pack8(v0, v1);
            }
        )
    }
};
struct EpiMergeB {
    const bf16_t* gate; bf16_t* merged;
    __device__ __forceinline__ void operator()(const f32x4 (&acc)[2][2][4][2], const Unit& u, int wr, int wc, int fr, int fq) const {
        const int col0 = u.pn * BM + wc * 32 + 8 * fq;
        EPI_ROWS(
            _Pragma("unroll") for (int bj = 0; bj < 2; ++bj) {
                const u32x4 gw = *(const u32x4*)(gate + (size_t)row * 2048 + 1024 + col0 + bj * HALF);
                bf16_t* mp = merged + (size_t)row * 1024 + col0 + bj * HALF;
                const u32x4 mw = *(const u32x4*)mp;
                f32x4 v0 = acc[ai][bj][m][0], v1 = acc[ai][bj][m][1];
                v0[0] = v0[0] * bf_lo(gw.x) + bf_lo(mw.x); v0[1] = v0[1] * bf_hi(gw.x) + bf_hi(mw.x); v0[2] = v0[2] * bf_lo(gw.y) + bf_lo(mw.y); v0[3] = v0[3] * bf_hi(gw.y) + bf_hi(mw.y);
                v1[0] = v1[0] * bf_lo(gw.z) + bf_lo(mw.z); v1[1] = v1[1] * bf_hi(gw.z) + bf_hi(mw.z); v1[2] = v1[2] * bf_lo(gw.w) + bf_lo(mw.w); v1[3] = v1[3] * bf_hi(gw.w) + bf_hi(mw.w);
                *(u32x4*)mp = pack8(v0, v1);
            }
        )
    }
};
struct EpiOut {
    const float* xin; float* xout; const float* g1;
    __device__ __forceinline__ void operator()(const f32x4 (&acc)[2][2][4][2], const Unit& u, int wr, int wc, int fr, int fq) const {
        const int col0 = u.pn * BM + wc * 32 + 8 * fq; const int b = (u.pm * BM) >> 12;
        f32x4 gv[2][2];
#pragma unroll
        for (int bj = 0; bj < 2; ++bj)
#pragma unroll
            for (int n = 0; n < 2; ++n) gv[bj][n] = *(const f32x4*)(g1 + (size_t)b * 6144 + col0 + bj * HALF + 4 * n);
        EPI_ROWS(
            _Pragma("unroll") for (int bj = 0; bj < 2; ++bj) {
                const size_t off = (size_t)row * 1024 + col0 + bj * HALF;
                const f32x4 x0 = *(const f32x4*)(xin + off), x1 = *(const f32x4*)(xin + off + 4);
                *(f32x4*)(xout + off) = x0 + gv[bj][0] * acc[ai][bj][m][0]; *(f32x4*)(xout + off + 4) = x1 + gv[bj][1] * acc[ai][bj][m][1];
            }
        )
    }
};
struct EpiGU {
    const float* bgu; bf16_t* act;
    __device__ __forceinline__ void operator()(const f32x4 (&acc)[2][2][4][2], const Unit& u, int wr, int wc, int fr, int fq) const {
        const int e = u.pn >> 3, pl = u.pn & 7; const int c0 = pl * 128 + wc * 32 + 8 * fq;
        const float* bp = bgu + (size_t)e * 2048 + c0;
        const f32x4 bg0 = *(const f32x4*)bp, bg1 = *(const f32x4*)(bp + 4), bl0 = *(const f32x4*)(bp + 1024), bl1 = *(const f32x4*)(bp + 1028);
        EPI_ROWS(
            f32x4 o[2];
            _Pragma("unroll") for (int n = 0; n < 2; ++n) {
                const f32x4 gl = acc[ai][0][m][n] + (n == 0 ? bg0 : bg1); const f32x4 ln = acc[ai][1][m][n] + (n == 0 ? bl0 : bl1);
                _Pragma("unroll") for (int j = 0; j < 4; ++j) { const float xg = fminf(gl[j], 7.0f); const float xl = fminf(fmaxf(ln[j], -7.0f), 7.0f); o[n][j] = xg * sigmoid_f(1.702f * xg) * (xl + 1.0f); }
            }
            *(u32x4*)(act + (size_t)row * 1024 + c0) = pack8(o[0], o[1]);
        )
    }
};
__device__ __forceinline__ u32x2 pack8_f8(const f32x4 a, const f32x4 b) { unsigned w0 = 0, w1 = 0;
    w0 = __builtin_amdgcn_cvt_pk_fp8_f32(a[0], a[1], w0, false); w0 = __builtin_amdgcn_cvt_pk_fp8_f32(a[2], a[3], w0, true);
    w1 = __builtin_amdgcn_cvt_pk_fp8_f32(b[0], b[1], w1, false); w1 = __builtin_amdgcn_cvt_pk_fp8_f32(b[2], b[3], w1, true); u32x2 r; r.x = w0; r.y = w1; return r; }
constexpr float W8_SCALE = 64.0f, W8_INV = 1.0f / 64.0f;
struct EpiGU8 {
    const float* bgu; unsigned char* act;
    __device__ __forceinline__ void operator()(const f32x4 (&acc)[2][2][4][2], const Unit& u, int wr, int wc, int fr, int fq) const {
        const int e = u.pn >> 3, pl = u.pn & 7; const int c0 = pl * 128 + wc * 32 + 8 * fq;
        const float* bp = bgu + (size_t)e * 2048 + c0;
        const f32x4 bg0 = *(const f32x4*)bp, bg1 = *(const f32x4*)(bp + 4), bl0 = *(const f32x4*)(bp + 1024), bl1 = *(const f32x4*)(bp + 1028);
        EPI_ROWS(
            f32x4 o[2];
            _Pragma("unroll") for (int n = 0; n < 2; ++n) {
                const f32x4 gl = acc[ai][0][m][n] * W8_INV + (n == 0 ? bg0 : bg1); const f32x4 ln = acc[ai][1][m][n] * W8_INV + (n == 0 ? bl0 : bl1);
                _Pragma("unroll") for (int j = 0; j < 4; ++j) { const float xg = fminf(gl[j], 7.0f); const float xl = fminf(fmaxf(ln[j], -7.0f), 7.0f); o[n][j] = xg * sigmoid_f(1.702f * xg) * (xl + 1.0f); }
            }
            *(u32x2*)(act + (size_t)row * 1024 + c0) = pack8_f8(o[0], o[1]);
        )
    }
};
struct EpiDN8 {
    const float* bdn; const float* roww; bf16_t* y;
    __device__ __forceinline__ void operator()(const f32x4 (&acc)[2][2][4][2], const Unit& u, int wr, int wc, int fr, int fq) const {
        const int e = u.pn >> 2, pl = u.pn & 3; const int col0 = pl * BM + wc * 32 + 8 * fq;
        f32x4 bv[2][2];
#pragma unroll
        for (int bj = 0; bj < 2; ++bj)
#pragma unroll
            for (int n = 0; n < 2; ++n) bv[bj][n] = *(const f32x4*)(bdn + (size_t)e * 1024 + col0 + bj * HALF + 4 * n);
        EPI_ROWS(
            const float w = roww[row];
            _Pragma("unroll") for (int bj = 0; bj < 2; ++bj)
                *(u32x4*)(y + (size_t)row * 1024 + col0 + bj * HALF) = pack8((acc[ai][bj][m][0] * W8_INV + bv[bj][0]) * w, (acc[ai][bj][m][1] * W8_INV + bv[bj][1]) * w);
        )
    }
};
struct EpiDN {
    const float* bdn; const float* roww; bf16_t* y;
    __device__ __forceinline__ void operator()(const f32x4 (&acc)[2][2][4][2], const Unit& u, int wr, int wc, int fr, int fq) const {
        const int e = u.pn >> 2, pl = u.pn & 3; const int col0 = pl * BM + wc * 32 + 8 * fq;
        f32x4 bv[2][2];
#pragma unroll
        for (int bj = 0; bj < 2; ++bj)
#pragma unroll
            for (int n = 0; n < 2; ++n) bv[bj][n] = *(const f32x4*)(bdn + (size_t)e * 1024 + col0 + bj * HALF + 4 * n);
        EPI_ROWS(
            const float w = roww[row];
            _Pragma("unroll") for (int bj = 0; bj < 2; ++bj)
                *(u32x4*)(y + (size_t)row * 1024 + col0 + bj * HALF) = pack8((acc[ai][bj][m][0] + bv[bj][0]) * w, (acc[ai][bj][m][1] + bv[bj][1]) * w);
        )
    }
};
}

namespace attn_body {
using bf16 = __hip_bfloat16;
using bf16x8 = __attribute__((ext_vector_type(8))) short;
using s16x4 = __attribute__((ext_vector_type(4))) short;
using f32x16 = __attribute__((ext_vector_type(16))) float;
using u32x4 = __attribute__((ext_vector_type(4))) unsigned;
constexpr int D = 64, NW = 8, QBLK = 32, QB = QBLK * NW, KVBLK = 64;
__device__ __forceinline__ int crow(int r, int hi) { return (r & 3) + 8 * (r >> 2) + 4 * hi; }
#define SBAR() __builtin_amdgcn_sched_barrier(0)
constexpr int NSLOT = 3, SLOTB = 8192;
constexpr int LDS_K = 0, LDS_V = NSLOT * SLOTB, LDS_WS = 2 * NSLOT * SLOTB, LDS_OST = LDS_WS + NW * 64 * 4, LDS_LUT = LDS_OST + NW * 4096, LUT_N = 768, LDS_BYTES = LDS_LUT + LUT_N * 4;
constexpr float MFLOOR = -1024.0f;
__device__ __forceinline__ void glds16(const void* gsrc, unsigned lds_dst) { unsigned keep;
  asm volatile("s_mov_b32 %0, m0\n\ts_mov_b32 m0, %2\n\ts_nop 0\n\tglobal_load_lds_dwordx4 %1, off\n\ts_mov_b32 m0, %0" : "=&s"(keep) : "v"(gsrc), "s"(lds_dst) : "memory"); }
__device__ __forceinline__ float max3f(float a, float b, float c) { float r; asm("v_max3_f32 %0, %1, %2, %3" : "=v"(r) : "v"(a), "v"(b), "v"(c)); return r; }
__device__ __forceinline__ float max2f(float a, float b) { float r; asm("v_max_f32_e32 %0, %1, %2" : "=v"(r) : "v"(a), "v"(b)); return r; }
__device__ __forceinline__ float fadd_s(float a, float b) { float r; asm("v_add_f32_e32 %0, %1, %2" : "=v"(r) : "v"(a), "v"(b)); return r; }
__device__ __forceinline__ float fsub_s(float a, float b) { float r; asm("v_sub_f32_e32 %0, %1, %2" : "=v"(r) : "v"(a), "v"(b)); return r; }
typedef float f32x2_t __attribute__((ext_vector_type(2))); typedef __bf16 bf16x2_t __attribute__((ext_vector_type(2)));
__device__ __forceinline__ unsigned cvtpk_s(float lo, float hi) { f32x2_t v = {lo, hi}; bf16x2_t b = __builtin_convertvector(v, bf16x2_t); return __builtin_bit_cast(unsigned, b); }
#define WAIT_BAR(N) asm volatile("s_waitcnt vmcnt(" #N ") lgkmcnt(0)\n\ts_barrier" ::: "memory")

__device__ __forceinline__ void qkt(f32x16& p0, f32x16& p1, const char* Kslot, const bf16x8* qr, const f32x16& negm, int r32, int hi) {
  const char* kb = Kslot + hi * 1024 + r32 * 16;
  #pragma unroll
  for (int d0 = 0; d0 < 4; ++d0) {
    const bf16x8 b0 = *reinterpret_cast<const bf16x8*>(kb + d0 * 2048);
    const bf16x8 b1 = *reinterpret_cast<const bf16x8*>(kb + d0 * 2048 + 512);
    if (d0 == 0) { p0 = __builtin_amdgcn_mfma_f32_32x32x16_bf16(b0, qr[0], negm, 0, 0, 0); p1 = __builtin_amdgcn_mfma_f32_32x32x16_bf16(b1, qr[0], negm, 0, 0, 0); }
    else { p0 = __builtin_amdgcn_mfma_f32_32x32x16_bf16(b0, qr[d0], p0, 0, 0, 0); p1 = __builtin_amdgcn_mfma_f32_32x32x16_bf16(b1, qr[d0], p1, 0, 0, 0); } }
}
typedef __attribute__((address_space(3))) const char* lds_cptr;
typedef short v4i16_t __attribute__((ext_vector_type(4)));
__device__ __forceinline__ void kload8(bf16x8* kf, lds_cptr kp) {
  kf[0] = *(const __attribute__((address_space(3))) bf16x8*)(kp);        kf[1] = *(const __attribute__((address_space(3))) bf16x8*)(kp + 512);
  kf[2] = *(const __attribute__((address_space(3))) bf16x8*)(kp + 2048); kf[3] = *(const __attribute__((address_space(3))) bf16x8*)(kp + 2560);
  kf[4] = *(const __attribute__((address_space(3))) bf16x8*)(kp + 4096); kf[5] = *(const __attribute__((address_space(3))) bf16x8*)(kp + 4608);
  kf[6] = *(const __attribute__((address_space(3))) bf16x8*)(kp + 6144); kf[7] = *(const __attribute__((address_space(3))) bf16x8*)(kp + 6656);
}
__device__ __forceinline__ void kload2(bf16x8* kf, lds_cptr kp, int j) { kf[2 * j] = *(const __attribute__((address_space(3))) bf16x8*)(kp + j * 2048); kf[2 * j + 1] = *(const __attribute__((address_space(3))) bf16x8*)(kp + j * 2048 + 512); }
__device__ __forceinline__ s16x4 vtr(lds_cptr p) { return __builtin_bit_cast(s16x4, __builtin_amdgcn_ds_read_tr16_b64_v4i16((__attribute__((address_space(3))) v4i16_t*)p)); }
__device__ __forceinline__ float rowmax(const f32x16& p0, const f32x16& p1) {
  float a = max3f(p0[0], p0[1], p1[0]), b = max3f(p0[2], p0[3], p1[1]); a = max3f(a, p1[2], p1[3]);
  #pragma unroll
  for (int r = 4; r < 16; r += 4) { a = max3f(a, p0[r], p0[r + 1]); b = max3f(b, p0[r + 2], p0[r + 3]); a = max3f(a, p1[r], p1[r + 1]); b = max3f(b, p1[r + 2], p1[r + 3]); }
  const float m = max2f(a, b);
  auto rr = __builtin_amdgcn_permlane32_swap(__float_as_uint(m), __float_as_uint(m), false, false);
  return max2f(__uint_as_float(rr[0]), __uint_as_float(rr[1]));
}
__device__ __forceinline__ void pv(f32x16* o, int vb, bf16x8 pa0, bf16x8 pa1, bf16x8 pa2, bf16x8 pa3) {
  #pragma unroll
  for (int d0 = 0; d0 < 2; ++d0) { s16x4 lo[4], hi[4];
    #pragma unroll
    for (int ks = 0; ks < 4; ++ks) {
      asm volatile("ds_read_b64_tr_b16 %0,%1 offset:%c2" : "=&v"(lo[ks]) : "v"(vb), "i"(d0 * 4096 + ks * 1024) : "memory");
      asm volatile("ds_read_b64_tr_b16 %0,%1 offset:%c2" : "=&v"(hi[ks]) : "v"(vb), "i"(d0 * 4096 + ks * 1024 + 512) : "memory"); }
    asm volatile("s_waitcnt lgkmcnt(0)" ::: "memory"); SBAR();
    #define PK(k) (bf16x8){lo[k][0], lo[k][1], lo[k][2], lo[k][3], hi[k][0], hi[k][1], hi[k][2], hi[k][3]}
    o[d0] = __builtin_amdgcn_mfma_f32_32x32x16_bf16(pa0, PK(0), o[d0], 0, 0, 0);
    o[d0] = __builtin_amdgcn_mfma_f32_32x32x16_bf16(pa1, PK(1), o[d0], 0, 0, 0);
    o[d0] = __builtin_amdgcn_mfma_f32_32x32x16_bf16(pa2, PK(2), o[d0], 0, 0, 0);
    o[d0] = __builtin_amdgcn_mfma_f32_32x32x16_bf16(pa3, PK(3), o[d0], 0, 0, 0);
    #undef PK
  }
}
struct Job { const bf16* Q; const bf16* K; const bf16* V; bf16* O; float* lse; const float* lutg; int NT, i0, kq0, dsh, cls; };
template <int MODE, int THRL> __device__ __forceinline__ void attn_unit(const Job& J, char* shm, const int wid_in) {
  int wid = wid_in; asm volatile("" : "+s"(wid));
  constexpr int QP = MODE == 0 ? 1024 : 256, KP = 256;
  const int lane = lane_id_asm(), tid = wid * 64 + lane, r32 = lane & 31, hi = lane >> 5;
  const bf16* Qw = J.Q + (long)(wid * QBLK) * QP;
  const bf16* Kh = J.K; const bf16* Vh = J.V;
  const unsigned lds0 = (unsigned)(uintptr_t)shm;
  float* wsf = (float*)(shm + LDS_WS) + wid * 64;
  const bf16* ksrc = Kh + (long)lane * KP + wid * 8;
  const bf16* vsrc = Vh + (long)(16 * (wid & 3) + (lane >> 2)) * KP + (wid >> 2) * 32 + (lane & 3) * 8;
  const unsigned kdst = lds0 + LDS_K + wid * 1024, vdst = lds0 + LDS_V + wid * 1024;
  #define DMA_K(t, slot) glds16(ksrc + (long)(t) * KVBLK * KP, (unsigned)__builtin_amdgcn_readfirstlane(kdst + (slot)))
  #define DMA_V(t, slot) glds16(vsrc + (long)(t) * KVBLK * KP, (unsigned)__builtin_amdgcn_readfirstlane(vdst + (slot)))
  const int vb0 = (int)(lds0 + LDS_V) + ((lane >> 4) & 1) * 32 + (lane & 3) * 8 + (4 * hi + ((lane & 15) >> 2)) * 64;
  const char* Kbase = shm + LDS_K; bf16x8 kf[8];
  const lds_cptr shm3 = (lds_cptr)shm; const lds_cptr kp0 = shm3 + LDS_K + hi * 1024 + r32 * 16; const lds_cptr vp0 = shm3 + LDS_V + ((lane >> 4) & 1) * 32 + (lane & 3) * 8 + (4 * hi + ((lane & 15) >> 2)) * 64;
  const int NT = J.NT;
  if (MODE == 1) {
    __attribute__((address_space(3))) float* lut = (__attribute__((address_space(3))) float*)(shm3 + LDS_LUT);
    lut[tid] = J.lutg[tid]; if (tid < LUT_N - 512) lut[512 + tid] = J.lutg[512 + tid];
  }
  DMA_K(0, 0); DMA_V(0, 0); DMA_K(1, SLOTB);
  bf16x8 qr[4];
  #pragma unroll
  for (int d0 = 0; d0 < 4; ++d0) qr[d0] = *reinterpret_cast<const bf16x8*>(&Qw[(long)r32 * QP + d0 * 16 + hi * 8]);
  float mhat = 0.f, l_reg = 0.f; f32x16 o[2]; o[0] = f32x16{}; o[1] = f32x16{}; f32x16 negm = f32x16{}; asm volatile("" : "+v"(negm));
  const int qrel = wid * QBLK + r32;
  const __attribute__((address_space(3))) float* lutq = (const __attribute__((address_space(3))) float*)(shm3 + LDS_LUT) + (J.kq0 - qrel + 383 + 4 * hi);
  #define CMASK(P0, P1, t) do { if (MODE == 1) { const __attribute__((address_space(3))) float* lp_ = lutq + 64 * (t); \
      _Pragma("unroll") for (int r = 0; r < 16; ++r) { const int ko_ = (r & 3) + 8 * (r >> 2); P0[r] += lp_[ko_]; P1[r] += lp_[ko_ + 32]; } } } while (0)
  bool resc = false;
  #define START(P0, P1) do { const float rm = rowmax(P0, P1); resc = false; \
    { const float dl = MODE == 1 ? max2f(rm, MFLOOR) : rm; mhat = fadd_s(mhat, dl); \
      _Pragma("unroll") for (int r = 0; r < 16; ++r) { P0[r] = fsub_s(P0[r], dl); P1[r] = fsub_s(P1[r], dl); } \
      _Pragma("unroll") for (int r = 0; r < 16; ++r) negm[r] = -mhat; asm volatile("" : "+v"(negm)); } \
    _Pragma("unroll") for (int r = 0; r < 16; ++r) P0[r] = __builtin_amdgcn_exp2f(P0[r]); } while (0)
  #define RESC() do { if (resc) { asm volatile("s_waitcnt lgkmcnt(0)" ::: "memory"); \
      _Pragma("unroll") for (int d_ = 0; d_ < 2; ++d_) _Pragma("unroll") for (int r = 0; r < 16; ++r) o[d_][r] *= wsf[crow(r, hi)]; } } while (0)
  f32x16 pA0, pA1, pB0, pB1;
  int sl_prev = 0, sl_cur = 0, sl_next = SLOTB;
  #define ROT() do { sl_prev = sl_cur; sl_cur = sl_next; sl_next = (sl_next == (NSLOT - 1) * SLOTB) ? 0 : sl_next + SLOTB; } while (0)
  DMA_K(2, 2 * SLOTB);
  WAIT_BAR(3);
  qkt(pA0, pA1, Kbase, qr, negm, r32, hi); asm volatile("s_nop 15\n\ts_nop 7" : "+v"(pA0), "+v"(pA1)); CMASK(pA0, pA1, 0);
  START(pA0, pA1);
  _Pragma("unroll") for (int r = 0; r < 16; ++r) pA1[r] = __builtin_amdgcn_exp2f(pA1[r]);
  WAIT_BAR(0);
  DMA_K(3, 0); DMA_V(1, SLOTB);
  ROT();
  kload8(kf, kp0 + sl_cur);
  WAIT_BAR(2);
  s16x4 vlo[8], vhi[8]; u32x4 pw0, pw1, pw2, pw3;
  #define PKW(P, B) cvtpk_s(P[B], P[B + 1])
  #define PAF(k) __builtin_bit_cast(bf16x8, pw##k)
  #define VFR(i) (bf16x8){vlo[i][0], vlo[i][1], vlo[i][2], vlo[i][3], vhi[i][0], vhi[i][1], vhi[i][2], vhi[i][3]}
  #define PIN(x) asm volatile("" : "+v"(x))
  #define MX3(a, b, c) __builtin_fmaxf(__builtin_fmaxf((a), (b)), (c))
  #define GAPA(MF, A0, A1, A2, A3, W0, W1, PW) do { MF; sacc += A0; sacc += A1; sacc += A2; sacc += A3; PIN(sacc); W0; W1; PIN(PW); SBAR(); } while (0)
  #define EX(v) __builtin_amdgcn_exp2f(v)
  #define GAPB(MF, X, B) do { MF; X[B] = EX(X[B]); X[B + 1] = EX(X[B + 1]); X[B + 2] = EX(X[B + 2]); X[B + 3] = EX(X[B + 3]); PIN(X); SBAR(); } while (0)
  #define VRD(i) do { vlo[i] = vtr(vp_ + (((i) >> 2) * 4096 + ((i) & 3) * 1024)); vhi[i] = vtr(vp_ + (((i) >> 2) * 4096 + ((i) & 3) * 1024 + 512)); } while (0)
  #define KRD(G, j) do { if (G) { kload2(kf, kp0 + sl_next, j); SBAR(); } } while (0)
  #define STEP(C0, C1, P0, P1, t, GK, GV, GL) do { SBAR(); \
    const lds_cptr vp_ = vp0 + sl_prev; \
    VRD(0); SBAR(); float sacc = (P0[0] + P0[1]); \
    GAPA(C0 = __builtin_amdgcn_mfma_f32_32x32x16_bf16(kf[0], qr[0], negm, 0, 0, 0), P0[2], P0[3], P0[4], P0[5],     pw0[0] = PKW(P0, 0), pw0[1] = PKW(P0, 2), pw0); \
    VRD(4); SBAR(); GAPA(C1 = __builtin_amdgcn_mfma_f32_32x32x16_bf16(kf[1], qr[0], negm, 0, 0, 0), P0[6], P0[7], P0[8], P0[9],     pw0[2] = PKW(P0, 4), pw0[3] = PKW(P0, 6), pw0); \
    VRD(1); SBAR(); GAPA(C0 = __builtin_amdgcn_mfma_f32_32x32x16_bf16(kf[2], qr[1], C0, 0, 0, 0),   P0[10], P0[11], P0[12], P0[13], pw1[0] = PKW(P0, 8), pw1[1] = PKW(P0, 10), pw1); \
    VRD(5); SBAR(); GAPA(C1 = __builtin_amdgcn_mfma_f32_32x32x16_bf16(kf[3], qr[1], C1, 0, 0, 0),   P0[14], P0[15], P1[0], P1[1],   pw1[2] = PKW(P0, 12), pw1[3] = PKW(P0, 14), pw1); \
    VRD(2); SBAR(); GAPA(C0 = __builtin_amdgcn_mfma_f32_32x32x16_bf16(kf[4], qr[2], C0, 0, 0, 0),   P1[2], P1[3], P1[4], P1[5],     pw2[0] = PKW(P1, 0), pw2[1] = PKW(P1, 2), pw2); \
    VRD(6); SBAR(); GAPA(C1 = __builtin_amdgcn_mfma_f32_32x32x16_bf16(kf[5], qr[2], C1, 0, 0, 0),   P1[6], P1[7], P1[8], P1[9],     pw2[2] = PKW(P1, 4), pw2[3] = PKW(P1, 6), pw2); \
    VRD(3); SBAR(); GAPA(C0 = __builtin_amdgcn_mfma_f32_32x32x16_bf16(kf[6], qr[3], C0, 0, 0, 0),   P1[10], P1[11], P1[12], P1[13], pw3[0] = PKW(P1, 8), pw3[1] = PKW(P1, 10), pw3); \
    VRD(7); SBAR(); GAPA(C1 = __builtin_amdgcn_mfma_f32_32x32x16_bf16(kf[7], qr[3], C1, 0, 0, 0),   P1[14], P1[15], 0.f, 0.f,       pw3[2] = PKW(P1, 12), pw3[3] = PKW(P1, 14), pw3); \
    l_reg += sacc; \
    if (GK) { DMA_K((t) + 3, sl_cur); } if (GV) { DMA_V((t) + 1, sl_next); } \
    CMASK(C0, C1, t); \
    { float a = MX3(C0[0], C0[1], C1[0]), b = MX3(C0[2], C0[3], C1[1]); a = MX3(a, C1[2], C1[3]); \
      _Pragma("unroll") for (int r = 4; r < 16; r += 4) { a = MX3(a, C0[r], C0[r + 1]); b = MX3(b, C0[r + 2], C0[r + 3]); a = MX3(a, C1[r], C1[r + 1]); b = MX3(b, C1[r + 2], C1[r + 3]); } \
      float rm = __builtin_fmaxf(a, b); { auto rr = __builtin_amdgcn_permlane32_swap(__float_as_uint(rm), __float_as_uint(rm), false, false); rm = __builtin_fmaxf(__uint_as_float(rr[0]), __uint_as_float(rr[1])); } \
      resc = false; \
      if (__builtin_expect(__any(rm > (float)THRL), 0)) { const float dl = __builtin_fmaxf(rm, 0.f); mhat += dl; \
        _Pragma("unroll") for (int r = 0; r < 16; ++r) { C0[r] -= dl; C1[r] -= dl; } \
        _Pragma("unroll") for (int r = 0; r < 16; ++r) negm[r] = -mhat; asm volatile("" : "+v"(negm)); \
        const float f = __builtin_amdgcn_exp2f(-dl); l_reg *= f; if (hi == 0) wsf[r32] = f; resc = true; } } \
    SBAR(); \
    GAPB(o[0] = __builtin_amdgcn_mfma_f32_32x32x16_bf16(PAF(0), VFR(0), o[0], 0, 0, 0), C0, 0); \
    GAPB(o[1] = __builtin_amdgcn_mfma_f32_32x32x16_bf16(PAF(0), VFR(4), o[1], 0, 0, 0), C0, 4); \
    KRD(GL, 0); GAPB(o[0] = __builtin_amdgcn_mfma_f32_32x32x16_bf16(PAF(1), VFR(1), o[0], 0, 0, 0), C0, 8); \
    KRD(GL, 1); GAPB(o[1] = __builtin_amdgcn_mfma_f32_32x32x16_bf16(PAF(1), VFR(5), o[1], 0, 0, 0), C0, 12); \
    KRD(GL, 2); GAPB(o[0] = __builtin_amdgcn_mfma_f32_32x32x16_bf16(PAF(2), VFR(2), o[0], 0, 0, 0), C1, 0); \
    KRD(GL, 3); GAPB(o[1] = __builtin_amdgcn_mfma_f32_32x32x16_bf16(PAF(2), VFR(6), o[1], 0, 0, 0), C1, 4); \
    GAPB(o[0] = __builtin_amdgcn_mfma_f32_32x32x16_bf16(PAF(3), VFR(3), o[0], 0, 0, 0), C1, 8); \
    GAPB(o[1] = __builtin_amdgcn_mfma_f32_32x32x16_bf16(PAF(3), VFR(7), o[1], 0, 0, 0), C1, 12); \
    } while (0)
  int t = 1;
  for (; t + 5 < NT; t += 2) {
    STEP(pB0, pB1, pA0, pA1, t, true, true, true);     WAIT_BAR(2); RESC(); ROT();
    STEP(pA0, pA1, pB0, pB1, t + 1, true, true, true); WAIT_BAR(2); RESC(); ROT();
  }
  #define ENDW(tt) do { if ((tt) + 3 < NT) { WAIT_BAR(2); } else if ((tt) + 2 < NT) { WAIT_BAR(1); } else { WAIT_BAR(0); } } while (0)
  for (; t + 1 < NT; t += 2) {
    STEP(pB0, pB1, pA0, pA1, t, (t + 3 < NT), (t + 1 < NT), (t + 1 < NT));       ENDW(t);     RESC(); ROT();
    STEP(pA0, pA1, pB0, pB1, t + 1, (t + 4 < NT), (t + 2 < NT), (t + 2 < NT));   ENDW(t + 1); RESC(); ROT();
  }
  STEP(pB0, pB1, pA0, pA1, NT - 1, false, false, false); RESC();
  { float sacc = pB0[0] + pB0[1]; _Pragma("unroll") for (int r = 2; r < 16; ++r) sacc += pB0[r]; _Pragma("unroll") for (int r = 0; r < 16; ++r) sacc += pB1[r]; l_reg += sacc;
    pw0 = (u32x4){PKW(pB0, 0), PKW(pB0, 2), PKW(pB0, 4), PKW(pB0, 6)}; pw1 = (u32x4){PKW(pB0, 8), PKW(pB0, 10), PKW(pB0, 12), PKW(pB0, 14)}; pw2 = (u32x4){PKW(pB1, 0), PKW(pB1, 2), PKW(pB1, 4), PKW(pB1, 6)}; pw3 = (u32x4){PKW(pB1, 8), PKW(pB1, 10), PKW(pB1, 12), PKW(pB1, 14)};
    SBAR(); pv(o, vb0 + sl_cur, PAF(0), PAF(1), PAF(2), PAF(3)); }
  #undef PKW
  #undef PAF
  #undef VFR
  #undef PIN
  #undef MX3
  #undef GAPA
  #undef GAPB
  #undef EX
  #undef VRD
  #undef KRD
  #undef STEP
  #undef ENDW
  { auto rr = __builtin_amdgcn_permlane32_swap(__float_as_uint(l_reg), __float_as_uint(l_reg), false, false); l_reg = __uint_as_float(rr[0]) + __uint_as_float(rr[1]); }
  if (hi == 0) wsf[32 + r32] = l_reg; asm volatile("s_waitcnt lgkmcnt(0)" ::: "memory");
  float rli[16];
  #pragma unroll
  for (int r = 0; r < 16; ++r) rli[r] = __builtin_amdgcn_rcpf(wsf[32 + crow(r, hi)]);
  { bf16* stg = (bf16*)(shm + LDS_OST) + wid * 2048;
    #pragma unroll
    for (int r = 0; r < 16; ++r) { const int orow = crow(r, hi);
      #pragma unroll
      for (int d0 = 0; d0 < 2; ++d0) stg[orow * 64 + d0 * 32 + r32] = __float2bfloat16(o[d0][r] * rli[r]); }
    asm volatile("s_waitcnt lgkmcnt(0)" ::: "memory");
    if (MODE == 0) {
      bf16* Ow = J.O + (long)(wid * QBLK) * 1024;
      #pragma unroll
      for (int i = 0; i < 4; ++i) { const int row = i * 8 + (lane >> 3), ch = lane & 7; const u32x4 v = *(const u32x4*)(stg + row * 64 + ch * 8); *(u32x4*)(Ow + (long)row * 1024 + ch * 8) = v; }
    } else {
      #pragma unroll
      for (int i = 0; i < 4; ++i) { const int row = i * 8 + (lane >> 3), ch = lane & 7; const u32x4 v = *(const u32x4*)(stg + row * 64 + ch * 8);
        const long tok = ((long)(J.i0 + wid * QBLK + row) << J.dsh) + J.cls; *(u32x4*)(J.O + tok * 256 + ch * 8) = v; }
      if (hi == 0) { const long tok = ((long)(J.i0 + qrel) << J.dsh) + J.cls; J.lse[tok * 4] = mhat + __builtin_amdgcn_logf(l_reg); }
    } }
  asm volatile("s_waitcnt lgkmcnt(0)\n\ts_barrier" ::: "memory");
  #undef DMA_K
  #undef DMA_V
  #undef CMASK
  #undef START
  #undef RESC
  #undef ROT
}
#undef SBAR
#undef WAIT_BAR
}

constexpr size_t MiB = 1u << 20;
constexpr size_t WS_CTL = 0, CTL_ZERO_BYTES = 1 * MiB;
constexpr size_t WS_MOD = 1 * MiB;
constexpr size_t WS_ROPE = WS_MOD + 512 * 1024;
constexpr size_t WS_BLUT = WS_ROPE + 8192;
constexpr size_t WS_RC0 = WS_BLUT + 12 * 768 * 4;
constexpr size_t WS_HIST = WS_RC0 + 4096;
constexpr size_t WS_TILEE = WS_HIST + 32768;
constexpr size_t WS_TOPE = 2 * MiB;
constexpr size_t WS_TOPW = WS_TOPE + 512 * 1024;
constexpr size_t WS_SLOT = WS_TOPW + 512 * 1024;
constexpr size_t WS_ROWW = WS_SLOT + 512 * 1024;
constexpr size_t WS_LSE = 5 * MiB;
constexpr size_t WS_WRHI = 7 * MiB;
constexpr size_t WS_WRLO = 8 * MiB;
constexpr size_t WS_WIN = 9 * MiB;
constexpr size_t WS_WBRA = 32 * MiB;
constexpr size_t WS_WBRB = 33 * MiB;
constexpr size_t WS_WOUT = 37 * MiB;
constexpr size_t WS_WGU = 41 * MiB;
constexpr size_t WS_WDN = 297 * MiB;
constexpr size_t WS_X = 425 * MiB;
constexpr size_t WS_H = 553 * MiB;
constexpr size_t WS_R = 617 * MiB;
constexpr size_t WS_AQKV = WS_R;
constexpr size_t WS_QB = WS_R + 144 * MiB;
constexpr size_t WS_KB = WS_R + 208 * MiB;
constexpr size_t WS_VB = WS_R + 224 * MiB;
constexpr size_t WS_GATE = WS_R + 240 * MiB;
constexpr size_t WS_OAG = WS_R + 368 * MiB;
constexpr size_t WS_OA = WS_R + 416 * MiB;
constexpr size_t WS_MERGED = WS_R + 432 * MiB;
constexpr size_t WS_XS = WS_R;
constexpr size_t WS_ACT = WS_R + 136 * MiB;
constexpr size_t WS_Y = WS_R + 272 * MiB;
constexpr size_t WS_OB = WS_R + 496 * MiB;
constexpr size_t WS_END = WS_R + 560 * MiB;
constexpr int CW_BAR = 4096;

constexpr int RING_BYTES = 133120;
constexpr int LDSCTL_OFF = RING_BYTES;
constexpr int LDS_BYTES = 147456;
constexpr int NWAVES = 8;

#define GAS __attribute__((address_space(1)))
#define LAS __attribute__((address_space(3)))
typedef unsigned short bf16;
typedef unsigned v4u __attribute__((ext_vector_type(4)));
typedef unsigned v2u __attribute__((ext_vector_type(2)));
typedef float f32x4 __attribute__((ext_vector_type(4)));
typedef float f32x16 __attribute__((ext_vector_type(16)));
typedef int i32x4 __attribute__((ext_vector_type(4)));
typedef short bf16x8 __attribute__((ext_vector_type(8)));
typedef GAS unsigned gu32;
#define RLX_AGENT __ATOMIC_RELAXED, __HIP_MEMORY_SCOPE_AGENT
#define LDS_WAIT() asm volatile("s_waitcnt lgkmcnt(0)" ::: "memory")
__device__ __forceinline__ unsigned f2bf(float f) { unsigned u = __builtin_bit_cast(unsigned, f); return (u + 0x7fffu + ((u >> 16) & 1u)) >> 16; }
__device__ __forceinline__ unsigned pk2(float lo, float hi) { return f2bf(lo) | (f2bf(hi) << 16); }
__device__ __forceinline__ float bfl(unsigned w) { return __uint_as_float(w << 16); }
__device__ __forceinline__ float bfh(unsigned w) { return __uint_as_float(w & 0xffff0000u); }

#define XB_TMO      128
#define XB_XCNT(j)  (256  + 64 * (j))
#define XB_XSUB(j)  (1280 + 64 * (j))
#define XB_XGEN(j)  (2304 + 64 * (j))
#define XB_TOP      3328
#define XB_TOPGEN   3392
#define XCD_BAR_WORDS 3456
#define XB_SPIN_CAP (1u << 18)
__device__ __forceinline__ unsigned xb_ld(unsigned* p)              { return __hip_atomic_load(p, __ATOMIC_RELAXED, __HIP_MEMORY_SCOPE_AGENT); }
__device__ __forceinline__ unsigned xb_add(unsigned* p, unsigned v) { return __hip_atomic_fetch_add(p, v, __ATOMIC_RELAXED, __HIP_MEMORY_SCOPE_AGENT); }
__device__ __forceinline__ unsigned xb_xcc_id() { return (unsigned)__builtin_amdgcn_s_getreg((3 << 11) | 20) & 0xFu; }
#define XB_SPIN(cond, bar) do { unsigned _sp = 0; while (cond) { __builtin_amdgcn_s_sleep(1); \
    if ((++_sp & 255u) == 0u) { if (xb_ld(&(bar)[XB_TMO])) break; if (_sp > XB_SPIN_CAP) { atomicAdd(&(bar)[XB_TMO], 1u); break; } } } } while (0)
struct XcdBarrier { unsigned* bar; unsigned x; volatile LAS unsigned* st; };
__device__ __forceinline__ XcdBarrier xcd_barrier_post(unsigned* bar, volatile LAS unsigned* st) {
    XcdBarrier b; b.bar = bar; b.x = xb_xcc_id(); b.st = st;
    if (threadIdx.x == 0) (void)xb_add(&bar[XB_XCNT(b.x)], 1u);
    return b;
}
__device__ __forceinline__ void xcd_barrier_complete(unsigned* bar, unsigned x, unsigned& nloc, unsigned& nx) {
    const unsigned G = gridDim.x * gridDim.y * gridDim.z;
    unsigned sum, cnt, mine, sp = 0u;
    for (;;) {
        sum = 0u; cnt = 0u; mine = 0u;
#pragma unroll
        for (unsigned j = 0; j < 16; ++j) { const unsigned c = xb_ld(&bar[XB_XCNT(j)]); sum += c; cnt += (c > 0u) ? 1u : 0u; mine = (j == x) ? c : mine; }
        if (sum == G) break;
        __builtin_amdgcn_s_sleep(1);
        if ((++sp & 255u) == 0u) { if (xb_ld(&bar[XB_TMO])) break; if (sp > XB_SPIN_CAP) { atomicAdd(&bar[XB_TMO], 1u); break; } }
    }
    nloc = mine > 0u ? mine : 1u; nx = cnt > 0u ? cnt : 1u;
}
__device__ __forceinline__ void xcd_barrier(const XcdBarrier& b) {
    asm volatile("s_waitcnt vmcnt(0)" ::: "memory");
    __syncthreads();
    if (threadIdx.x == 0) {
        unsigned* bar = b.bar;
        __builtin_amdgcn_s_waitcnt(0);
        unsigned nloc = b.st[0], nx = b.st[1];
        if (nloc == 0u) { xcd_barrier_complete(bar, b.x, nloc, nx); b.st[0] = nloc; b.st[1] = nx; }
        const unsigned old = xb_add(&bar[XB_XSUB(b.x)], 1u);
        const unsigned gen = old / nloc;
        if (old + 1u == (gen + 1u) * nloc) {
            __builtin_amdgcn_fence(__ATOMIC_RELEASE, "agent");
            asm volatile("s_waitcnt vmcnt(0)" ::: "memory");
            const unsigned og = xb_add(&bar[XB_TOP], 1u);
            const unsigned tg = og / nx;
            if (og + 1u == (tg + 1u) * nx) xb_add(&bar[XB_TOPGEN], 1u);
            else XB_SPIN(xb_ld(&bar[XB_TOPGEN]) == tg, bar);
            __builtin_amdgcn_fence(__ATOMIC_ACQUIRE, "agent");
            xb_add(&bar[XB_XGEN(b.x)], 1u);
            asm volatile("s_waitcnt vmcnt(0)" ::: "memory");
        } else {
            XB_SPIN(xb_ld(&bar[XB_XGEN(b.x)]) == gen, bar);
            __builtin_amdgcn_fence(__ATOMIC_ACQUIRE, "agent");
            asm volatile("s_waitcnt vmcnt(0)" ::: "memory");
        }
    }
    __syncthreads();
}

__device__ __forceinline__ float wave_sum(float v) {
    v = xsum<1>(v); v = xsum<2>(v); v = xsum<4>(v); v = xsum<8>(v); v = xsum<16>(v); v = xsum<32>(v);
    return v;
}
__device__ __forceinline__ void cvt_item(const float* W, int ldw, int K, int srcA, int srcB, bf16* WT, int dst_row0, int k0, LAS float* scr, int lane, bool ident = false) {
    const int kq = lane >> 4, nq = lane & 15; const int scol = (nq < 8 ? srcA + 4 * nq : srcB + 4 * (nq - 8));
    f32x4 v[16];
#pragma unroll
    for (int i = 0; i < 16; ++i) v[i] = *(const GAS f32x4*)(W + (size_t)(k0 + 4 * i + kq) * ldw + scol);
#pragma unroll
    for (int i = 0; i < 16; ++i)
#pragma unroll
        for (int e = 0; e < 4; ++e) scr[(4 * i + kq) * 65 + 4 * nq + e] = v[i][e];
    LDS_WAIT(); asm volatile("" ::: "memory");
    const int c = lane & 7, rr = lane >> 3;
#pragma unroll
    for (int j = 0; j < 8; ++j) { const int rho = rr + 8 * j; const int sc = (rho & 32) + (ident ? (rho & 31) : pg8::perm32(rho & 31)); const LAS float* s = scr + (8 * c) * 65 + sc;
        v4u o; o.x = pk2(s[0 * 65], s[1 * 65]); o.y = pk2(s[2 * 65], s[3 * 65]); o.z = pk2(s[4 * 65], s[5 * 65]); o.w = pk2(s[6 * 65], s[7 * 65]);
        *(GAS v4u*)(WT + (size_t)(dst_row0 + rho) * K + k0 + 8 * c) = o; }
    LDS_WAIT(); asm volatile("" ::: "memory");
}
__device__ __forceinline__ void cvt_item_f8(const float* W, int ldw, int K, int srcA, int srcB, unsigned char* WT, int dst_row0, int k0, LAS float* scr, int lane) {
    const int kq = lane >> 4, nq = lane & 15; const int scol = (nq < 8 ? srcA + 4 * nq : srcB + 4 * (nq - 8));
    f32x4 v[16];
#pragma unroll
    for (int i = 0; i < 16; ++i) v[i] = *(const GAS f32x4*)(W + (size_t)(k0 + 4 * i + kq) * ldw + scol);
#pragma unroll
    for (int i = 0; i < 16; ++i)
#pragma unroll
        for (int e = 0; e < 4; ++e) scr[(4 * i + kq) * 65 + 4 * nq + e] = v[i][e] * pg8::W8_SCALE;
    LDS_WAIT(); asm volatile("" ::: "memory");
    const int c = lane & 7, rr = lane >> 3;
#pragma unroll
    for (int j = 0; j < 8; ++j) { const int rho = rr + 8 * j; const int sc = (rho & 32) + pg8::perm32(rho & 31); const LAS float* s = scr + (8 * c) * 65 + sc;
        unsigned w0 = 0, w1 = 0;
        w0 = __builtin_amdgcn_cvt_pk_fp8_f32(s[0 * 65], s[1 * 65], w0, false); w0 = __builtin_amdgcn_cvt_pk_fp8_f32(s[2 * 65], s[3 * 65], w0, true);
        w1 = __builtin_amdgcn_cvt_pk_fp8_f32(s[4 * 65], s[5 * 65], w1, false); w1 = __builtin_amdgcn_cvt_pk_fp8_f32(s[6 * 65], s[7 * 65], w1, true);
        v2u o; o.x = w0; o.y = w1; *(GAS v2u*)(WT + (size_t)(dst_row0 + rho) * K + k0 + 8 * c) = o; }
    LDS_WAIT(); asm volatile("" ::: "memory");
}
__device__ __forceinline__ int win_src(int X) { const int pn = X >> 3, bj = (X >> 2) & 1, wc = X & 3; return (pn >= 9 && pn < 14) ? pn * 256 + 64 * wc + 32 * bj : 32 * X; }
__device__ __forceinline__ int wgu_src(int X) { const int pn = X >> 3, bj = (X >> 2) & 1, wc = X & 3; return bj * 1024 + 128 * pn + 32 * wc; }

__device__ __forceinline__ void norm_row_bf16(const float* xrow, const float* g, const float* sc, const float* sh, bf16* orow, int lane) {
    const GAS f32x4* xr = (const GAS f32x4*)xrow + lane;
    f32x4 v[4]; float s = 0.f;
#pragma unroll
    for (int j = 0; j < 4; ++j) { v[j] = xr[64 * j]; s += (v[j].x * v[j].x + v[j].y * v[j].y) + (v[j].z * v[j].z + v[j].w * v[j].w); }
    const float rs = rsqrtf(wave_sum(s) * (1.0f / D) + EPS);
#pragma unroll
    for (int j = 0; j < 4; ++j) { const int c = 256 * j + 4 * lane;
        const f32x4 gg = *(const GAS f32x4*)(g + c), s1 = *(const GAS f32x4*)(sc + c), s0 = *(const GAS f32x4*)(sh + c);
        const f32x4 y = (v[j] * rs * gg) * (s1 + 1.0f) + s0;
        v2u o; o.x = pk2(y.x, y.y); o.y = pk2(y.z, y.w); *(GAS v2u*)(orow + c) = o; }
}

__device__ __forceinline__ void norm_rows2_bf16(const float* xrow, const float* g, const float* sc, const float* sh, bf16* orow, int lane) {
    const GAS f32x4* xr = (const GAS f32x4*)xrow + lane;
    f32x4 v[2][4]; float s0 = 0.f, s1 = 0.f;
#pragma unroll
    for (int j = 0; j < 4; ++j) { v[0][j] = xr[64 * j]; v[1][j] = xr[256 + 64 * j]; }
#pragma unroll
    for (int j = 0; j < 4; ++j) { s0 += (v[0][j].x * v[0][j].x + v[0][j].y * v[0][j].y) + (v[0][j].z * v[0][j].z + v[0][j].w * v[0][j].w); s1 += (v[1][j].x * v[1][j].x + v[1][j].y * v[1][j].y) + (v[1][j].z * v[1][j].z + v[1][j].w * v[1][j].w); }
    const float rs0 = rsqrtf(wave_sum(s0) * (1.0f / D) + EPS), rs1 = rsqrtf(wave_sum(s1) * (1.0f / D) + EPS);
#pragma unroll
    for (int j = 0; j < 4; ++j) { const int c = 256 * j + 4 * lane;
        const f32x4 gg = *(const GAS f32x4*)(g + c), a1 = *(const GAS f32x4*)(sc + c) + 1.0f, a0 = *(const GAS f32x4*)(sh + c);
        const f32x4 y0 = (v[0][j] * rs0 * gg) * a1 + a0, y1 = (v[1][j] * rs1 * gg) * a1 + a0;
        v2u o0; o0.x = pk2(y0.x, y0.y); o0.y = pk2(y0.z, y0.w); *(GAS v2u*)(orow + c) = o0;
        v2u o1; o1.x = pk2(y1.x, y1.y); o1.y = pk2(y1.z, y1.w); *(GAS v2u*)(orow + D + c) = o1; }
}

__device__ __forceinline__ void norm_rows2_f8(const float* xrow, const float* g, const float* sc, const float* sh, unsigned char* orow, int lane) {
    const GAS f32x4* xr = (const GAS f32x4*)xrow + lane;
    f32x4 v[2][4]; float s0 = 0.f, s1 = 0.f;
#pragma unroll
    for (int j = 0; j < 4; ++j) { v[0][j] = xr[64 * j]; v[1][j] = xr[256 + 64 * j]; }
#pragma unroll
    for (int j = 0; j < 4; ++j) { s0 += (v[0][j].x * v[0][j].x + v[0][j].y * v[0][j].y) + (v[0][j].z * v[0][j].z + v[0][j].w * v[0][j].w); s1 += (v[1][j].x * v[1][j].x + v[1][j].y * v[1][j].y) + (v[1][j].z * v[1][j].z + v[1][j].w * v[1][j].w); }
    const float rs0 = rsqrtf(wave_sum(s0) * (1.0f / D) + EPS), rs1 = rsqrtf(wave_sum(s1) * (1.0f / D) + EPS);
#pragma unroll
    for (int j = 0; j < 4; ++j) { const int c = 256 * j + 4 * lane;
        const f32x4 gg = *(const GAS f32x4*)(g + c), a1 = *(const GAS f32x4*)(sc + c) + 1.0f, a0 = *(const GAS f32x4*)(sh + c);
        const f32x4 y0 = (v[0][j] * rs0 * gg) * a1 + a0, y1 = (v[1][j] * rs1 * gg) * a1 + a0;
        unsigned w0 = 0, w1 = 0;
        w0 = __builtin_amdgcn_cvt_pk_fp8_f32(y0.x, y0.y, w0, false); w0 = __builtin_amdgcn_cvt_pk_fp8_f32(y0.z, y0.w, w0, true);
        w1 = __builtin_amdgcn_cvt_pk_fp8_f32(y1.x, y1.y, w1, false); w1 = __builtin_amdgcn_cvt_pk_fp8_f32(y1.z, y1.w, w1, true);
        *(GAS unsigned*)(orow + c) = w0; *(GAS unsigned*)(orow + D + c) = w1; }
}

struct Args { const float* in[20]; float* out; unsigned char* ws; int ph_lo, ph_hi, li, pad; };
constexpr int N_PHASES = 2 + 10 * DEPTH;

typedef const __attribute__((address_space(4))) Args* kargs_t;
__device__ __forceinline__ kargs_t kargs_opaque() { kargs_t p = (kargs_t)__builtin_amdgcn_kernarg_segment_ptr(); asm volatile("" : "+s"(p)); return p; }
#define PH_BEGIN() kargs_t ap = kargs_opaque(); unsigned char* ws = ap->ws; (void)ws; \
    int wave = wave_s; asm volatile("" : "+s"(wave)); const int lane = lane_id_asm(); const int tid = wave * 64 + lane; (void)lane; (void)tid; \
    int bx = blockIdx.x; asm volatile("" : "+s"(bx)); int G = gridDim.x; asm volatile("" : "+s"(G)); const int vcu = (G % 8 == 0) ? (bx % 8) * (G / 8) + bx / 8 : bx; (void)vcu; \
    const int gw = vcu * NWAVES + wave, NGW = G * NWAVES; (void)gw; (void)NGW; const int gtid = vcu * (NWAVES * 64) + tid, NGT = G * NWAVES * 64; (void)gtid; (void)NGT
#define INP(k) (ap->in[k])
#define x_in INP(0)
#define c_in INP(1)
#define w_ada INP(2)
#define b_ada INP(3)
#define norm1_g INP(4)
#define w_in INP(5)
#define q_norm_g INP(6)
#define k_norm_g INP(7)
#define rel_bias INP(8)
#define w_br_a INP(9)
#define w_br_b INP(10)
#define w_out INP(11)
#define norm2_g INP(12)
#define w_router INP(13)
#define b_router INP(14)
#define w_gate_up INP(15)
#define b_gate_up INP(16)
#define w_down INP(17)
#define b_down INP(18)
#define final_g INP(19)
#define MOD ((float*)(ws + WS_MOD))
#define ROPE ((float*)(ws + WS_ROPE))
#define BLUT ((float*)(ws + WS_BLUT))
#define RC0 ((float*)(ws + WS_RC0))
#define HIST ((int*)(ws + WS_HIST))
#define TILEE ((int*)(ws + WS_TILEE))
#define TOPE ((int*)(ws + WS_TOPE))
#define TOPW ((float*)(ws + WS_TOPW))
#define SLOT ((int*)(ws + WS_SLOT))
#define ROWW ((float*)(ws + WS_ROWW))
#define LSE ((float*)(ws + WS_LSE))
#define WRHI ((bf16*)(ws + WS_WRHI))
#define WRLO ((bf16*)(ws + WS_WRLO))
#define WIN ((bf16*)(ws + WS_WIN))
#define WBRA ((bf16*)(ws + WS_WBRA))
#define WBRB ((bf16*)(ws + WS_WBRB))
#define WOUT ((bf16*)(ws + WS_WOUT))
#define WGU ((unsigned char*)(ws + WS_WGU))
#define WDN ((unsigned char*)(ws + WS_WDN))
#define X ((float*)(ws + WS_X))
#define H ((bf16*)(ws + WS_H))
#define AQKV ((bf16*)(ws + WS_AQKV))
#define QB ((bf16*)(ws + WS_QB))
#define KB ((bf16*)(ws + WS_KB))
#define VB ((bf16*)(ws + WS_VB))
#define GATE ((bf16*)(ws + WS_GATE))
#define OAG ((bf16*)(ws + WS_OAG))
#define OA ((bf16*)(ws + WS_OA))
#define MERGED ((bf16*)(ws + WS_MERGED))
#define OB ((bf16*)(ws + WS_OB))
#define XS ((unsigned char*)(ws + WS_XS))
#define ACT ((unsigned char*)(ws + WS_ACT))
#define YB ((bf16*)(ws + WS_Y))
__global__ void __launch_bounds__(NWAVES * 64, 2) mk_fwd(Args args) {
    extern __shared__ __attribute__((aligned(16))) unsigned char lds[];
    LAS unsigned char* L = (LAS unsigned char*)lds;
    volatile LAS unsigned* MISC = (volatile LAS unsigned*)(L + LDSCTL_OFF);
    gu32* ctl = (gu32*)(args.ws + WS_CTL);
    const int wave_s = __builtin_amdgcn_readfirstlane(threadIdx.x >> 6);
    for (int u = threadIdx.x; u < (LDS_BYTES - LDSCTL_OFF) / 4; u += NWAVES * 64) ((LAS unsigned*)(L + LDSCTL_OFF))[u] = 0u;
    __syncthreads();
    XcdBarrier bar; bar.bar = (unsigned*)(ctl + CW_BAR) + args.li * XCD_BAR_WORDS; bar.x = 0; bar.st = nullptr;
    if (!MK_PER_PHASE) bar = xcd_barrier_post((unsigned*)(ctl + CW_BAR) + args.li * XCD_BAR_WORDS, MISC + 8);
    const int lo = args.ph_lo, hi = args.ph_hi;
#define IN(k) (lo <= (k) && (k) < hi)
#define KIND(q) ((PH_KIND_MASK >> (q)) & 1)
#define SEAM(k) do { if (IN(k) && IN((k) + 1)) xcd_barrier(bar); } while (0)

    for (int rep0 = 0; rep0 < 1 + PROBE_P0; ++rep0) {
    if (KIND(0) && IN(0)) { PH_BEGIN();
        {
            LAS float* cact = (LAS float*)L;
            LAS float* part = (LAS float*)(L + 32768);
            for (int i = tid; i < NB * D; i += NWAVES * 64) { const float cv = c_in[i]; cact[i] = cv / (1.0f + __expf(-cv)); }
            __syncthreads();
            for (int vb = bx; vb < 256; vb += G) {
                const int gc = vb * 48 + lane;
                const int l = gc / 6144, col = gc % 6144;
                float a[NB];
#pragma unroll
                for (int b = 0; b < NB; ++b) a[b] = 0.f;
                if (lane < 48) {
                    const float* wp = w_ada + (size_t)l * D * 6144 + col;
                    for (int k = wave * 128; k < wave * 128 + 128; ++k) { const float w = wp[(size_t)k * 6144];
#pragma unroll
                        for (int b = 0; b < NB; ++b) a[b] += cact[b * D + k] * w; }
                }
#pragma unroll
                for (int b = 0; b < NB; ++b) part[(wave * NB + b) * 64 + lane] = a[b];
                __syncthreads();
                if (tid < NB * 48) { const int b = tid / 48, cl = tid % 48; const int gc2 = vb * 48 + cl; const int l2 = gc2 / 6144, col2 = gc2 % 6144;
                    float s = b_ada[l2 * 6144 + col2];
#pragma unroll
                    for (int w = 0; w < NWAVES; ++w) s += part[(w * NB + b) * 64 + cl];
                    MOD[((size_t)l2 * NB + b) * 6144 + col2] = s; }
                __syncthreads();
            }
        }
        for (int i = gtid; i < 1024 + 12 * 768; i += NGT) {
            if (i < 1024) { const int p = i >> 4, f = i & 15; const double inv = pow(10000.0, -(double)f / 16.0); const double ang = (double)p * inv; ROPE[i] = (float)cos(ang); ROPE[1024 + i] = (float)sin(ang); }
            else { const int j = i - 1024; const int hh = j / 768, di = j % 768; const int delta = di - 383; const int g = hh >> 2; const int dil = g == 0 ? 1 : (g == 1 ? 4 : 16);
                float val = -INFINITY;
                if (delta >= -64 && delta <= 64) { const int rel = delta * dil; const int n = rel < 0 ? -rel : rel; int bk = rel > 0 ? 16 : 0;
                    if (n < 8) bk += n; else { int lg = 8 + (int)(logf((float)n / 8.0f) / logf(128.0f) * 8.0f); if (lg > 15) lg = 15; bk += lg; }
                    val = rel_bias[bk * 12 + hh] * LOG2E; }
                BLUT[j] = val; }
        }
        {
            LAS float* scr = (LAS float*)(L + wave * 16640);
            __syncthreads();
            constexpr int I_IN = 16 * 92, I_BRA = 4 * 16, I_BRB = 16 * 16, I_OUT = 16 * 16, I_GU = 16 * 32, I_DN = 16 * 16;
            constexpr int PER_L = I_IN + I_BRA + I_BRB + I_OUT;
            constexpr int NITEMS = DEPTH * PER_L + DEPTH * NE * (I_GU + I_DN);
            for (int it = gw; it < NITEMS; it += NGW) {
                int r = it;
                if (r < DEPTH * PER_L) {
                    const int l = r / PER_L; r %= PER_L;
                    if (r < I_IN) { const int kb = r / 92, g64 = r % 92; cvt_item(w_in + (size_t)l * D * N_IN, N_IN, D, win_src(2 * g64), win_src(2 * g64 + 1), WIN + (size_t)l * N_IN * D, 64 * g64, 64 * kb, scr, lane, (g64 >> 2) >= 9 && (g64 >> 2) < 14); continue; } r -= I_IN;
                    if (r < I_BRA) { const int kb = r / 16, g64 = r % 16; cvt_item(w_br_a + (size_t)l * 256 * D, D, 256, 64 * g64, 64 * g64 + 32, WBRA + (size_t)l * D * 256, 64 * g64, 64 * kb, scr, lane); continue; } r -= I_BRA;
                    if (r < I_BRB) { const int kb = r / 16, g64 = r % 16; cvt_item(w_br_b + (size_t)l * D * D, D, D, 64 * g64, 64 * g64 + 32, WBRB + (size_t)l * D * D, 64 * g64, 64 * kb, scr, lane); continue; } r -= I_BRB;
                    { const int kb = r / 16, g64 = r % 16; cvt_item(w_out + (size_t)l * D * D, D, D, 64 * g64, 64 * g64 + 32, WOUT + (size_t)l * D * D, 64 * g64, 64 * kb, scr, lane); continue; }
                }
                r -= DEPTH * PER_L;
                if (r < DEPTH * NE * I_GU) { const int le = r / I_GU; r %= I_GU; const int kb = r / 32, g64 = r % 32;
                    cvt_item_f8(w_gate_up + (size_t)le * D * 2048, 2048, D, wgu_src(2 * g64), wgu_src(2 * g64 + 1), WGU + (size_t)le * 2048 * D, 64 * g64, 64 * kb, scr, lane); continue; }
                r -= DEPTH * NE * I_GU;
                { const int le = r / I_DN; r %= I_DN; const int kb = r / 16, g64 = r % 16;
                    cvt_item_f8(w_down + (size_t)le * D * D, D, D, 64 * g64, 64 * g64 + 32, WDN + (size_t)le * D * D, 64 * g64, 64 * kb, scr, lane); }
            }
        }
    }
    SEAM(0);
    }
    if (KIND(1) && IN(1)) { PH_BEGIN();
        for (int m = 2 * gw; m < T; m += 2 * NGW) { const int b = m >> 12; const float* md = MOD + (size_t)b * 6144;
            norm_rows2_bf16(x_in + (size_t)m * D, norm1_g, md + 1024, md, H + (size_t)m * D, lane); }
        for (int i = gtid; i < DEPTH * NB * NE * D; i += NGT) { const int k = i & 1023, e = (i >> 10) & 31, b = (i >> 15) & 7, l = i >> 18;
            const float v = norm2_g[l * D + k] * (1.0f + MOD[((size_t)l * NB + b) * 6144 + 4 * 1024 + k]) * w_router[((size_t)l * D + k) * NE + e];
            const unsigned hb = f2bf(v); const float lv = v - __uint_as_float(hb << 16);
            WRHI[i] = (bf16)hb; WRLO[i] = (bf16)f2bf(lv); }
        for (int i = gw; i < DEPTH * NB * NE; i += NGW) { const int e = i & 31, b = (i >> 5) & 7, l = i >> 8; float s = 0.f;
            for (int k = lane; k < D; k += 64) s += MOD[((size_t)l * NB + b) * 6144 + 3 * 1024 + k] * w_router[((size_t)l * D + k) * NE + e];
            s = wave_sum(s); if (lane == 0) RC0[i] = s + b_router[l * NE + e]; }
    }
    SEAM(1);

    for (int li = (PROBE_MASK ? -1 : 0); li < DEPTH; ++li) {
        const int l = li < 0 ? 0 : li; const bool virt = li < 0;
        const int P = 2 + 10 * l;
#define VK(q) (!virt || ((PROBE_MASK >> (q)) & 1))
        if (KIND(2) && IN(P + 0) && VK(2)) { PH_BEGIN();
            pg8::Gemm g{H, WIN + (size_t)l * N_IN * D, D}; pg8::StaticOrder S; S.init(T, N_IN, G, bx);
            pg8::EpiIn E{AQKV, QB, KB, VB, GATE, q_norm_g + l * 64, k_norm_g + l * 64, ROPE};
            pg8::gemm_phase<pg8::EpiIn, pg8::StaticOrder>(L, g, S, E, wave);
        }
        if (VK(2)) SEAM(P + 0);
        if (KIND(3) && IN(P + 1) && VK(3)) { PH_BEGIN();
            namespace ab = attn_body;
            for (int j = 0; j < 8; ++j) {
                const int uidx = vcu * 8 + j; if (uidx >= 2048) break;
                const int pair = uidx >> 6, idx = uidx & 63; const int b = pair >> 2, kvh = pair & 3, hq = idx >> 4, qb = idx & 15; const int h = kvh * 4 + hq;
                ab::Job J; J.Q = (const ab::bf16*)QB + ((size_t)b * SEQ + qb * 256) * 1024 + h * 64; J.K = (const ab::bf16*)KB + (size_t)b * SEQ * 256 + kvh * 64; J.V = (const ab::bf16*)VB + (size_t)b * SEQ * 256 + kvh * 64;
                J.O = (ab::bf16*)OB + ((size_t)b * SEQ + qb * 256) * 1024 + h * 64; J.lse = nullptr; J.lutg = nullptr; J.NT = 64; J.i0 = 0; J.kq0 = 0; J.dsh = 0; J.cls = 0;
                ab::attn_unit<0, 8>(J, (char*)lds, wave);
            }
            for (int j = 0; j < 6; ++j) {
                const int uidx = vcu * 6 + j; if (uidx >= 1536) break;
                const int g = uidx / 512, r = uidx % 512; const int b = r >> 6, hs = (r >> 4) & 3, combo = r & 15;
                const int dsh = 2 * g; const int Lc = SEQ >> dsh; const int nqb = Lc >> 8;
                const int cls = combo / nqb, qb = combo % nqb; const int i0 = qb * 256;
                int t0 = (i0 >> 6) - 1; const int ntile = Lc >> 6; const int NT = ntile >= 6 ? 6 : 4; if (t0 < 0) t0 = 0; if (t0 > ntile - NT) t0 = ntile - NT;
                const size_t cbase = (size_t)b * SEQ + (size_t)cls * Lc;
                const ab::bf16* aq = (const ab::bf16*)AQKV + (size_t)(g * 3 + 0) * T * 256; const ab::bf16* ak = (const ab::bf16*)AQKV + (size_t)(g * 3 + 1) * T * 256; const ab::bf16* av = (const ab::bf16*)AQKV + (size_t)(g * 3 + 2) * T * 256;
                ab::Job J; J.Q = aq + (cbase + i0) * 256 + hs * 64; J.K = ak + (cbase + t0 * 64) * 256 + hs * 64; J.V = av + (cbase + t0 * 64) * 256 + hs * 64;
                J.O = (ab::bf16*)OAG + (size_t)g * T * 256 + (size_t)b * SEQ * 256 + hs * 64; J.lse = LSE + (size_t)g * T * 4 + (size_t)b * SEQ * 4 + hs; J.lutg = BLUT + (g * 4 + hs) * 768;
                J.NT = NT; J.i0 = i0; J.kq0 = t0 * 64 - i0; J.dsh = dsh; J.cls = cls;
                ab::attn_unit<1, 8>(J, (char*)lds, wave);
            }
        }
        if (VK(3)) SEAM(P + 1);
        if (KIND(4) && IN(P + 2) && VK(4)) { PH_BEGIN();
            for (int i = gtid; i < T * 32; i += NGT) { const int t = i >> 5, ch = i & 31, hs = ch >> 3;
                const float l0 = LSE[(size_t)t * 4 + hs], l1 = LSE[(size_t)T * 4 + (size_t)t * 4 + hs], l2 = LSE[(size_t)2 * T * 4 + (size_t)t * 4 + hs];
                const float mx = fmaxf(l0, fmaxf(l1, l2)); float w0 = exp2f(l0 - mx), w1 = exp2f(l1 - mx), w2 = exp2f(l2 - mx); const float inv = 1.0f / (w0 + w1 + w2); w0 *= inv; w1 *= inv; w2 *= inv;
                const v4u a = *(const GAS v4u*)(OAG + (size_t)t * 256 + ch * 8), bq = *(const GAS v4u*)(OAG + (size_t)T * 256 + (size_t)t * 256 + ch * 8), cq = *(const GAS v4u*)(OAG + (size_t)2 * T * 256 + (size_t)t * 256 + ch * 8);
                v4u o;
                o.x = pk2(w0 * bfl(a.x) + w1 * bfl(bq.x) + w2 * bfl(cq.x), w0 * bfh(a.x) + w1 * bfh(bq.x) + w2 * bfh(cq.x));
                o.y = pk2(w0 * bfl(a.y) + w1 * bfl(bq.y) + w2 * bfl(cq.y), w0 * bfh(a.y) + w1 * bfh(bq.y) + w2 * bfh(cq.y));
                o.z = pk2(w0 * bfl(a.z) + w1 * bfl(bq.z) + w2 * bfl(cq.z), w0 * bfh(a.z) + w1 * bfh(bq.z) + w2 * bfh(cq.z));
                o.w = pk2(w0 * bfl(a.w) + w1 * bfl(bq.w) + w2 * bfl(cq.w), w0 * bfh(a.w) + w1 * bfh(bq.w) + w2 * bfh(cq.w));
                *(GAS v4u*)(OA + (size_t)t * 256 + ch * 8) = o; }
        }
        if (VK(4)) SEAM(P + 2);
        if (KIND(5) && IN(P + 3) && VK(5)) { PH_BEGIN();
            pg8::StaticOrder S; S.init(T, D, G, bx);
            { pg8::Gemm g{OA, WBRA + (size_t)l * D * 256, 256}; pg8::EpiMergeA E{GATE, MERGED}; pg8::gemm_phase<pg8::EpiMergeA, pg8::StaticOrder>(L, g, S, E, wave); }
            { pg8::Gemm g{OB, WBRB + (size_t)l * D * D, D}; pg8::EpiMergeB E{GATE, MERGED}; pg8::gemm_phase<pg8::EpiMergeB, pg8::StaticOrder>(L, g, S, E, wave); }
        }
        if (VK(5)) SEAM(P + 3);
        if (KIND(6) && IN(P + 4) && VK(6)) { PH_BEGIN();
            pg8::Gemm g{MERGED, WOUT + (size_t)l * D * D, D}; pg8::StaticOrder S; S.init(T, D, G, bx);
            pg8::EpiOut E{l == 0 ? x_in : X, X, MOD + (size_t)l * NB * 6144 + 2 * 1024};
            pg8::gemm_phase<pg8::EpiOut, pg8::StaticOrder>(L, g, S, E, wave);
        }
        if (VK(6)) SEAM(P + 4);
        if (KIND(7) && IN(P + 5) && VK(7)) { PH_BEGIN();
            LAS int* hist = (LAS int*)(L + LDSCTL_OFF + 256);
            for (int vb = bx; vb < 256; vb += G) {
                if (tid < NE) hist[tid] = 0;
                __syncthreads();
                {
                    const int tt = vb + 256 * wave; const int r0 = tt * 16; const int b = r0 >> 12; const int i = lane & 15, kb = lane >> 4;
                    const float* xp = X + (size_t)(r0 + i) * D + 8 * kb;
                    const bf16* bh = WRHI + ((size_t)(l * NB + b) * NE + i) * D + 8 * kb; const bf16* bl = WRLO + ((size_t)(l * NB + b) * NE + i) * D + 8 * kb;
                    f32x4 acc0 = (f32x4){0.f, 0.f, 0.f, 0.f}, acc1 = acc0; float ss = 0.f;
#pragma unroll 4
                    for (int s = 0; s < 32; ++s) {
                        const f32x4 x0 = *(const GAS f32x4*)(xp + 32 * s), x1 = *(const GAS f32x4*)(xp + 32 * s + 4);
                        const bf16x8 wh0 = *(const GAS bf16x8*)(bh + 32 * s), wh1 = *(const GAS bf16x8*)(bh + 16 * D + 32 * s), wl0 = *(const GAS bf16x8*)(bl + 32 * s), wl1 = *(const GAS bf16x8*)(bl + 16 * D + 32 * s);
                        ss += (x0.x * x0.x + x0.y * x0.y) + (x0.z * x0.z + x0.w * x0.w) + (x1.x * x1.x + x1.y * x1.y) + (x1.z * x1.z + x1.w * x1.w);
                        v4u ah, al;
                        { const unsigned h0 = f2bf(x0.x), h1 = f2bf(x0.y), h2 = f2bf(x0.z), h3 = f2bf(x0.w), h4 = f2bf(x1.x), h5 = f2bf(x1.y), h6 = f2bf(x1.z), h7 = f2bf(x1.w);
                          ah.x = h0 | (h1 << 16); ah.y = h2 | (h3 << 16); ah.z = h4 | (h5 << 16); ah.w = h6 | (h7 << 16);
                          al.x = pk2(x0.x - __uint_as_float(h0 << 16), x0.y - __uint_as_float(h1 << 16)); al.y = pk2(x0.z - __uint_as_float(h2 << 16), x0.w - __uint_as_float(h3 << 16));
                          al.z = pk2(x1.x - __uint_as_float(h4 << 16), x1.y - __uint_as_float(h5 << 16)); al.w = pk2(x1.z - __uint_as_float(h6 << 16), x1.w - __uint_as_float(h7 << 16)); }
                        const bf16x8 ahv = __builtin_bit_cast(bf16x8, ah), alv = __builtin_bit_cast(bf16x8, al);
                        acc0 = __builtin_amdgcn_mfma_f32_16x16x32_bf16(wh0, ahv, acc0, 0, 0, 0); acc1 = __builtin_amdgcn_mfma_f32_16x16x32_bf16(wh1, ahv, acc1, 0, 0, 0);
                        acc0 = __builtin_amdgcn_mfma_f32_16x16x32_bf16(wl0, ahv, acc0, 0, 0, 0); acc1 = __builtin_amdgcn_mfma_f32_16x16x32_bf16(wl1, ahv, acc1, 0, 0, 0);
                        acc0 = __builtin_amdgcn_mfma_f32_16x16x32_bf16(wh0, alv, acc0, 0, 0, 0); acc1 = __builtin_amdgcn_mfma_f32_16x16x32_bf16(wh1, alv, acc1, 0, 0, 0);
                    }
                    ss = xsum<16>(ss); ss = xsum<32>(ss);
                    const float rs = rsqrtf(ss * (1.0f / D) + EPS);
                    float v[8]; const float* rc = RC0 + (l * NB + b) * NE;
#pragma unroll
                    for (int r = 0; r < 4; ++r) { v[r] = rs * acc0[r] + rc[4 * kb + r]; v[4 + r] = rs * acc1[r] + rc[16 + 4 * kb + r]; }
                    float tv[4]; int ti[4];
#pragma unroll
                    for (int k = 0; k < 4; ++k) { float best = v[0]; int br = 0;
#pragma unroll
                        for (int r = 1; r < 8; ++r) if (v[r] > best) { best = v[r]; br = r; }
#pragma unroll
                        for (int r = 0; r < 8; ++r) v[r] = (r == br) ? -INFINITY : v[r];
                        tv[k] = best; ti[k] = (br & 3) + 16 * (br >> 2) + 4 * kb; }
#pragma unroll
                    for (int round = 0; round < 2; ++round) {
                        float bv[8]; int bi[8];
#pragma unroll
                        for (int k = 0; k < 4; ++k) { bv[k] = tv[k]; bi[k] = ti[k];
                            if (round == 0) { bv[4 + k] = __int_as_float(__builtin_amdgcn_ds_swizzle(__float_as_int(tv[k]), 0x1f | (16 << 10))); bi[4 + k] = __builtin_amdgcn_ds_swizzle(ti[k], 0x1f | (16 << 10)); }
                            else { bv[4 + k] = xget32(tv[k], lane >> 5); bi[4 + k] = xget32(ti[k], lane >> 5); } }
#pragma unroll
                        for (int k = 0; k < 4; ++k) { float best = bv[0]; int bq = 0;
#pragma unroll
                            for (int r = 1; r < 8; ++r) if (bv[r] > best || (bv[r] == best && bi[r] < bi[bq])) { best = bv[r]; bq = r; }
                            int sel = bi[0];
#pragma unroll
                            for (int r = 0; r < 8; ++r) { if (r == bq) sel = bi[r]; }
#pragma unroll
                            for (int r = 0; r < 8; ++r) bv[r] = (r == bq) ? -INFINITY : bv[r];
                            tv[k] = best; ti[k] = sel; }
                    }
                    if (kb == 0) {
                        const float e1 = __expf(tv[1] - tv[0]), e2 = __expf(tv[2] - tv[0]), e3 = __expf(tv[3] - tv[0]); const float inv = 1.0f / (1.0f + e1 + e2 + e3);
                        const int tok = r0 + i;
                        *(GAS i32x4*)(TOPE + (size_t)tok * 4) = (i32x4){ti[0], ti[1], ti[2], ti[3]};
                        *(GAS f32x4*)(TOPW + (size_t)tok * 4) = (f32x4){inv, e1 * inv, e2 * inv, e3 * inv};
#pragma unroll
                        for (int k = 0; k < 4; ++k) atomicAdd((int*)&hist[ti[k]], 1);
                    }
                }
                __syncthreads();
                if (tid < NE) HIST[vb * NE + tid] = hist[tid];
                __syncthreads();
            }
            for (int m = 2 * gw; m < T; m += 2 * NGW) { const int b = m >> 12; const float* md = MOD + ((size_t)l * NB + b) * 6144;
                norm_rows2_f8(X + (size_t)m * D, norm2_g + l * D, md + 4 * 1024, md + 3 * 1024, (unsigned char*)H + (size_t)m * D, lane); }
        }
        if (VK(7)) SEAM(P + 5);
        if (KIND(8) && IN(P + 6) && VK(8)) { PH_BEGIN();
            LAS int* sm = (LAS int*)L;
            for (int vb = bx; vb < 256; vb += G) {
                { const int e = tid & 31, seg = tid >> 5; int tot = 0, bef = 0;
                    for (int q = seg * 16; q < seg * 16 + 16; ++q) { const int hv = HIST[q * NE + e]; tot += hv; if (q < vb) bef += hv; }
                    sm[tid] = tot; sm[512 + tid] = bef; }
                __syncthreads();
                if (tid < NE) { int tot = 0, bef = 0;
                    for (int s = 0; s < 16; ++s) { tot += sm[s * 32 + tid]; bef += sm[512 + s * 32 + tid]; }
                    sm[1024 + tid] = bef; sm[1056 + tid] = (tot + 255) & ~255; }
                __syncthreads();
                if (tid == 0) { int run = 0; for (int e = 0; e < NE; ++e) { const int pd = sm[1056 + e]; sm[1056 + e] = run; sm[1024 + e] += run;
                        if (vb == 0) { for (int q = run >> 8; q < (run + pd) >> 8; ++q) TILEE[q] = e; }
                        run += pd; }
                    if (vb == 0) TILEE[1000] = run >> 8; }
                __syncthreads();
                if (tid < 128) { const int tt = vb + 256 * (tid >> 4); const int tok = tt * 16 + (tid & 15);
                    const i32x4 te = *(const GAS i32x4*)(TOPE + (size_t)tok * 4); const f32x4 tw = *(const GAS f32x4*)(TOPW + (size_t)tok * 4);
                    const int s0 = atomicAdd((int*)&sm[1024 + te.x], 1), s1 = atomicAdd((int*)&sm[1024 + te.y], 1), s2 = atomicAdd((int*)&sm[1024 + te.z], 1), s3 = atomicAdd((int*)&sm[1024 + te.w], 1);
                    *(GAS i32x4*)(SLOT + (size_t)tok * 4) = (i32x4){s0, s1, s2, s3};
                    ROWW[s0] = tw.x; ROWW[s1] = tw.y; ROWW[s2] = tw.z; ROWW[s3] = tw.w;
                    sm[2048 + tid * 4 + 0] = s0; sm[2048 + tid * 4 + 1] = s1; sm[2048 + tid * 4 + 2] = s2; sm[2048 + tid * 4 + 3] = s3; }
                __syncthreads();
                for (int p = wave; p < 512; p += NWAVES) { const int q = p >> 2; const int tt = vb + 256 * (q >> 4); const int tok = tt * 16 + (q & 15); const int slot = sm[2048 + p];
                    const GAS v4u* src = (const GAS v4u*)((unsigned char*)H + (size_t)tok * D); GAS v4u* dst = (GAS v4u*)(XS + (size_t)slot * D);
                    dst[lane] = src[lane]; }
                __syncthreads();
            }
        }
        if (VK(8)) SEAM(P + 6);
        if (KIND(9) && IN(P + 7) && VK(9)) { PH_BEGIN();
            const int nmt = __builtin_amdgcn_readfirstlane(__hip_atomic_load(TILEE + 1000, __ATOMIC_RELAXED, __HIP_MEMORY_SCOPE_AGENT));
            pg8::Gemm g{(const bf16*)XS, (const bf16*)(WGU + (size_t)l * NE * 2048 * D), D / 2}; pg8::MoeOrder S{TILEE, nmt * 8, 8, G, vcu};
            pg8::EpiGU8 E{b_gate_up + (size_t)l * NE * 2048, ACT};
            pg8::gemm_phase_f8<pg8::EpiGU8, pg8::MoeOrder>(L, g, S, E, wave);
        }
        if (VK(9)) SEAM(P + 7);
        if (KIND(10) && IN(P + 8) && VK(10)) { PH_BEGIN();
            const int nmt = __builtin_amdgcn_readfirstlane(__hip_atomic_load(TILEE + 1000, __ATOMIC_RELAXED, __HIP_MEMORY_SCOPE_AGENT));
            pg8::Gemm g{(const bf16*)ACT, (const bf16*)(WDN + (size_t)l * NE * D * D), D / 2}; pg8::MoeOrder S{TILEE, nmt * 4, 4, G, vcu};
            pg8::EpiDN8 E{b_down + (size_t)l * NE * D, ROWW, YB};
            pg8::gemm_phase_f8<pg8::EpiDN8, pg8::MoeOrder>(L, g, S, E, wave);
        }
        if (VK(10)) SEAM(P + 8);
        if (KIND(11) && IN(P + 9) && VK(11)) { PH_BEGIN();
            const bool lastl = (l == DEPTH - 1);
            float* Xw = virt ? (float*)(ws + WS_R) : X; bf16* Hw = virt ? (bf16*)(ws + WS_R + 128 * MiB) : H;
            for (int m0 = 2 * gw; m0 < T; m0 += 2 * NGW) { const int b = m0 >> 12;
                i32x4 sl[2];
#pragma unroll
                for (int q = 0; q < 2; ++q) { const int* sp = SLOT + (size_t)(m0 + q) * 4;
                    sl[q].x = __hip_atomic_load(sp + 0, RLX_AGENT); sl[q].y = __hip_atomic_load(sp + 1, RLX_AGENT); sl[q].z = __hip_atomic_load(sp + 2, RLX_AGENT); sl[q].w = __hip_atomic_load(sp + 3, RLX_AGENT); }
                const float* g2 = MOD + ((size_t)l * NB + b) * 6144 + 5 * 1024;
                f32x4 v[2][4]; v2u yy[2][4][4];
#pragma unroll
                for (int q = 0; q < 2; ++q)
#pragma unroll
                    for (int j = 0; j < 4; ++j) { const int c = 256 * j + 4 * lane;
                        v[q][j] = *(const GAS f32x4*)(X + (size_t)(m0 + q) * D + c);
                        yy[q][j][0] = *(const GAS v2u*)(YB + (size_t)sl[q].x * D + c); yy[q][j][1] = *(const GAS v2u*)(YB + (size_t)sl[q].y * D + c);
                        yy[q][j][2] = *(const GAS v2u*)(YB + (size_t)sl[q].z * D + c); yy[q][j][3] = *(const GAS v2u*)(YB + (size_t)sl[q].w * D + c); }
                float s[2] = {0.f, 0.f};
#pragma unroll
                for (int q = 0; q < 2; ++q)
#pragma unroll
                    for (int j = 0; j < 4; ++j) { const int c = 256 * j + 4 * lane; const v2u y0 = yy[q][j][0], y1 = yy[q][j][1], y2 = yy[q][j][2], y3 = yy[q][j][3];
                        f32x4 ys; ys.x = (bfl(y0.x) + bfl(y1.x)) + (bfl(y2.x) + bfl(y3.x)); ys.y = (bfh(y0.x) + bfh(y1.x)) + (bfh(y2.x) + bfh(y3.x));
                        ys.z = (bfl(y0.y) + bfl(y1.y)) + (bfl(y2.y) + bfl(y3.y)); ys.w = (bfh(y0.y) + bfh(y1.y)) + (bfh(y2.y) + bfh(y3.y));
                        const f32x4 gg = *(const GAS f32x4*)(g2 + c);
                        v[q][j] = v[q][j] + gg * ys;
                        if (!lastl) *(GAS f32x4*)(Xw + (size_t)(m0 + q) * D + c) = v[q][j];
                        s[q] += (v[q][j].x * v[q][j].x + v[q][j].y * v[q][j].y) + (v[q][j].z * v[q][j].z + v[q][j].w * v[q][j].w); }
                const float rs0 = rsqrtf(wave_sum(s[0]) * (1.0f / D) + EPS), rs1 = rsqrtf(wave_sum(s[1]) * (1.0f / D) + EPS);
                if (!lastl) { const float* md = MOD + ((size_t)(l + 1) * NB + b) * 6144; const float* gn = norm1_g + (l + 1) * D;
#pragma unroll
                    for (int j = 0; j < 4; ++j) { const int c = 256 * j + 4 * lane;
                        const f32x4 gg = *(const GAS f32x4*)(gn + c), a1 = *(const GAS f32x4*)(md + 1024 + c) + 1.0f, a0 = *(const GAS f32x4*)(md + c);
                        const f32x4 y0 = (v[0][j] * rs0 * gg) * a1 + a0, y1 = (v[1][j] * rs1 * gg) * a1 + a0;
                        v2u o0; o0.x = pk2(y0.x, y0.y); o0.y = pk2(y0.z, y0.w); *(GAS v2u*)(Hw + (size_t)m0 * D + c) = o0;
                        v2u o1; o1.x = pk2(y1.x, y1.y); o1.y = pk2(y1.z, y1.w); *(GAS v2u*)(Hw + (size_t)(m0 + 1) * D + c) = o1; }
                } else {
#pragma unroll
                    for (int j = 0; j < 4; ++j) { const int c = 256 * j + 4 * lane; const f32x4 gg = *(const GAS f32x4*)(final_g + c);
                        *(GAS f32x4*)(ap->out + (size_t)m0 * D + c) = v[0][j] * rs0 * gg; *(GAS f32x4*)(ap->out + (size_t)(m0 + 1) * D + c) = v[1][j] * rs1 * gg; }
                }
            }
        }
        if (VK(11)) SEAM(P + 9);
        if (virt) { PH_BEGIN();
            for (int m = 2 * gw; m < T; m += 2 * NGW) { const int b = m >> 12; const float* md = MOD + (size_t)b * 6144; norm_rows2_bf16(x_in + (size_t)m * D, norm1_g, md + 1024, md, H + (size_t)m * D, lane); }
            xcd_barrier(bar); }
    }
#undef IN
#undef SEAM
}

extern "C" void kernel_launch(void* const* d_in, const int* in_sizes, int n_in, void* d_out, int out_size, void* d_ws, size_t ws_size, hipStream_t stream) {
    static int grid = 0;
    if (grid == 0) {
        if (n_in != 20 || in_sizes[0] != T * D || out_size != T * D || ws_size < WS_END) { fprintf(stderr, "kernel_launch: unexpected shapes (n_in %d, in0 %d, out %d, ws %zu < %zu); nothing launched\n", n_in, n_in > 0 ? in_sizes[0] : -1, out_size, ws_size, (size_t)WS_END); grid = -1; return; }
        int dev = 0, cus = 0, per_cu = 0;
        if (hipGetDevice(&dev) != hipSuccess || hipDeviceGetAttribute(&cus, hipDeviceAttributeMultiprocessorCount, dev) != hipSuccess) { grid = -1; return; }
        if (hipFuncSetAttribute((const void*)mk_fwd, hipFuncAttributeMaxDynamicSharedMemorySize, LDS_BYTES) != hipSuccess) { fprintf(stderr, "kernel_launch: hipFuncSetAttribute failed\n"); grid = -1; return; }
        if (hipOccupancyMaxActiveBlocksPerMultiprocessor(&per_cu, (const void*)mk_fwd, NWAVES * 64, LDS_BYTES) != hipSuccess || per_cu < 1)
            fprintf(stderr, "kernel_launch: note: occupancy query reports %d workgroups per CU\n", per_cu);
        (void)hipGetLastError();
        grid = cus < 256 ? cus : 256;
        if (grid != 256) fprintf(stderr, "kernel_launch: %d CUs; this kernel's unit deals assume 256\n", grid);
    }
    if (grid < 0) return;
    if (hipMemsetAsync((char*)d_ws + WS_CTL, 0, CTL_ZERO_BYTES, stream) != hipSuccess) { fprintf(stderr, "kernel_launch: memset failed\n"); return; }
    Args a{};
    for (int i = 0; i < 20; ++i) a.in[i] = (const float*)d_in[i];
    a.out = (float*)d_out; a.ws = (unsigned char*)d_ws; a.pad = 0;
#if MK_PER_PHASE
    for (int p = 0; p < N_PHASES; ++p) { a.ph_lo = p; a.ph_hi = p + 1; a.li = 0; hipLaunchKernelGGL(mk_fwd, dim3(grid), dim3(NWAVES * 64), LDS_BYTES, stream, a); }
#else
    a.ph_lo = 0; a.ph_hi = N_PHASES; a.li = 0;
    hipLaunchKernelGGL(mk_fwd, dim3(grid), dim3(NWAVES * 64), LDS_BYTES, stream, a);
#endif
    const hipError_t le = hipPeekAtLastError();
    if (le != hipSuccess) fprintf(stderr, "kernel_launch: launch failed: %s\n", hipGetErrorName(le));
}
```

```cpp
#include <hip/hip_runtime.h>
#include <hip/hip_bf16.h>
#include <cstdio>
#include <cstdint>
#include <cmath>

#ifndef PH_KIND_MASK
#define PH_KIND_MASK 0xFFF
#endif
#ifndef PROBE_MASK
#define PROBE_MASK 0
#endif
#ifndef PROBE_P0
#define PROBE_P0 0
#endif
#ifndef MK_PER_PHASE
#define MK_PER_PHASE 0
#endif

constexpr int NB = 8, SEQ = 4096, T = NB * SEQ, D = 1024, DEPTH = 2;
constexpr int N_IN = 5888, NE = 32, TOPK = 4;
constexpr int NASSIGN = T * TOPK;
constexpr int MAX_MT = NASSIGN / 256 + NE;
constexpr int CAP_ROWS = MAX_MT * 256;
constexpr float C2 = 0.125f * 1.4426950408889634f;
constexpr float LOG2E = 1.4426950408889634f;
constexpr float EPS = 1e-6f;

__device__ __forceinline__ int lane_id_asm() { int l; asm volatile("v_mbcnt_lo_u32_b32 %0, -1, 0\n\tv_mbcnt_hi_u32_b32 %0, -1, %0" : "=v"(l)); return l; }

template <int M> __device__ __forceinline__ float xsum(float v) {
    if constexpr (M < 32) return v + __int_as_float(__builtin_amdgcn_ds_swizzle(__float_as_int(v), 0x1f | (M << 10)));
    else { auto rr = __builtin_amdgcn_permlane32_swap(__float_as_uint(v), __float_as_uint(v), false, false); return __uint_as_float(rr[0]) + __uint_as_float(rr[1]); }
}
template <class Tv> __device__ __forceinline__ Tv xget32(Tv v, int hf) {
    auto rr = __builtin_amdgcn_permlane32_swap(__builtin_bit_cast(unsigned, v), __builtin_bit_cast(unsigned, v), false, false); return __builtin_bit_cast(Tv, hf ? rr[0] : rr[1]);
}

namespace pg8 {
#define PG8_LAS __attribute__((address_space(3)))
typedef unsigned short bf16_t;
typedef short bf16x8 __attribute__((ext_vector_type(8)));
typedef float f32x4 __attribute__((ext_vector_type(4)));
typedef unsigned u32x4 __attribute__((ext_vector_type(4)));
typedef unsigned u32x2 __attribute__((ext_vector_type(2)));
constexpr int BM = 256, BK = 64, HALF = 128, HTB = HALF * BK * 2, STAGE_BYTES = 8 * HTB, NXCD = 8, WGM = 8;

__host__ __device__ __forceinline__ int lds_byte(int r, int c) { const int st = (r >> 4) * 2 + (c >> 5), rr = r & 15, cc = c & 31, ob = rr * 64 + cc * 2; return st * 1024 + (ob ^ (((ob >> 9) & 1) << 5)); }
__host__ __device__ __forceinline__ void stage_rc(int b, int& R, int& C) { const int st = b / 1024, sb = b % 1024, swz = sb ^ (((sb >> 9) & 1) << 5); R = (st >> 1) * 16 + swz / 64; C = (st & 1) * 32 + (swz % 64) / 2; }
__host__ __device__ __forceinline__ int perm32(int rho) { const int n = rho >> 4, i = rho & 15; return 8 * (i >> 2) + 4 * n + (i & 3); }

struct Unit { int pm, pn; };
struct Gemm { const bf16_t* A; const bf16_t* Bt; int K; };

struct StaticOrder {
    int nM, nN, nwg, G, c;
    __device__ void init(int M, int N, int G_, int c_) { nM = M / BM; nN = N / BM; nwg = nM * nN; G = G_; c = c_; }
    __device__ bool next(int i, Unit& u) const {
        const long L = (long)i * G + c; if (L >= nwg) return false;
        int wgid = (int)L; { const int q = nwg / NXCD, r = nwg % NXCD, xcd = wgid % NXCD, off = wgid / NXCD; wgid = (xcd < r ? xcd * (q + 1) : r * (q + 1) + (xcd - r) * q) + off; }
        const int nig = WGM * nN, gid = wgid / nig, fm = gid * WGM, gsz = (nM - fm) < WGM ? (nM - fm) : WGM;
        u.pm = fm + ((wgid % nig) % gsz); u.pn = (wgid % nig) / gsz; return true;
    }
};
struct MoeOrder {
    const int* tile_e; int n_units, nN, G, vcu;
    __device__ bool next(int i, Unit& u) const {
        const long L = (long)i * G + vcu; if (L >= n_units) return false;
        const int mt = (int)L / nN, pl = (int)L % nN; const int e = __builtin_amdgcn_readfirstlane(__hip_atomic_load(tile_e + mt, __ATOMIC_RELAXED, __HIP_MEMORY_SCOPE_AGENT));
        u.pm = mt; u.pn = e * nN + pl; return true;
    }
};

__device__ __forceinline__ unsigned cvt_pk_bf16(float lo, float hi) { unsigned r; asm volatile("v_cvt_pk_bf16_f32 %0, %1, %2" : "=v"(r) : "v"(lo), "v"(hi)); return r; }
__device__ __forceinline__ float bf_lo(unsigned w) { return __uint_as_float(w << 16); }
__device__ __forceinline__ float bf_hi(unsigned w) { return __uint_as_float(w & 0xffff0000u); }
__device__ __forceinline__ float sigmoid_f(float x) { return __builtin_amdgcn_rcpf(1.0f + __builtin_amdgcn_exp2f(-LOG2E * x)); }

template <class Epi, class Sched>
__device__ __forceinline__ void gemm_phase(PG8_LAS unsigned char* lds, const Gemm g, const Sched& S, const Epi& E, const int wid_in) {
    int wid = wid_in; asm volatile("" : "+s"(wid));
    const int lane = lane_id_asm(), tid = wid * 64 + lane, wr = wid >> 2, wc = wid & 3, fr = lane & 15, fq = lane >> 4;
    int K_o = g.K; asm volatile("" : "+s"(K_o)); const int K = K_o, nt = K / BK;
    unsigned voff[2];
#pragma unroll
    for (int i = 0; i < 2; ++i) { int R, C; stage_rc(tid * 16 + i * 8192, R, C); voff[i] = (unsigned)(R * K + C) * 2u; }
    const size_t kstep = (size_t)(BK * 2);
    const size_t hstep = (size_t)HALF * K * 2;
    const size_t tstep = 2 * hstep;
    const unsigned ldsw = (unsigned)wid * 1024u;
    const int aoff = lds_byte(wr * 64 + fr, fq * 8), boff = lds_byte(wc * 32 + fr, fq * 8);
#define PG8_SA(b, h) (((b) * 2 + (h)) * HTB)
#define PG8_SB(b, h) ((4 + (b) * 2 + (h)) * HTB)
#define PG8_STAGE(bufoff, gbase) do { _Pragma("unroll") for (int _i = 0; _i < 2; ++_i) \
        __builtin_amdgcn_global_load_lds((const unsigned*)((const char*)(gbase) + voff[_i]), (PG8_LAS unsigned*)(lds + (bufoff) + ldsw + _i * 8192), 16, 0, 0); } while (0)
#define PG8_LDA(dst, b, h) do { _Pragma("unroll") for (int m = 0; m < 4; ++m) _Pragma("unroll") for (int k = 0; k < 2; ++k) dst[m][k] = *(const PG8_LAS bf16x8*)(lds + PG8_SA(b, h) + aoff + m * 2048 + k * 1024); } while (0)
#define PG8_LDB(dst, b, h) do { _Pragma("unroll") for (int n = 0; n < 2; ++n) _Pragma("unroll") for (int k = 0; k < 2; ++k) dst[n][k] = *(const PG8_LAS bf16x8*)(lds + PG8_SB(b, h) + boff + n * 2048 + k * 1024); } while (0)
#define PG8_MMA(ai, bj, At, Bt) do { __builtin_amdgcn_s_setprio(1); _Pragma("unroll") for (int m = 0; m < 4; ++m) _Pragma("unroll") for (int n = 0; n < 2; ++n) _Pragma("unroll") for (int k = 0; k < 2; ++k) \
        acc[ai][bj][m][n] = __builtin_amdgcn_mfma_f32_16x16x32_bf16(Bt[n][k], At[m][k], acc[ai][bj][m][n], 0, 0, 0); __builtin_amdgcn_s_setprio(0); } while (0)
#define PG8_WAIT_V(n) asm volatile("s_waitcnt vmcnt(" #n ")" ::: "memory")
#define PG8_WAIT_L(n) asm volatile("s_waitcnt lgkmcnt(" #n ")" ::: "memory")
#define PG8_BAR __builtin_amdgcn_s_barrier()
#define PG8_SCHED __builtin_amdgcn_sched_barrier(0)
    Unit cur, nxt; int ui = 0;
    if (!S.next(0, cur)) return;
    f32x4 acc[2][2][4][2];
#pragma unroll
    for (int a = 0; a < 2; ++a)
#pragma unroll
        for (int b = 0; b < 2; ++b)
#pragma unroll
            for (int m = 0; m < 4; ++m)
#pragma unroll
                for (int n = 0; n < 2; ++n) acc[a][b][m][n] = (f32x4){0.f, 0.f, 0.f, 0.f};
    bf16x8 At[4][2], B0[2][2], B1[2][2];
    const char* cA = (const char*)g.A + (size_t)cur.pm * tstep; const char* cB = (const char*)g.Bt + (size_t)cur.pn * tstep;
    PG8_STAGE(PG8_SB(0, 0), cB); PG8_STAGE(PG8_SB(0, 1), cB + hstep); PG8_STAGE(PG8_SA(0, 0), cA); PG8_STAGE(PG8_SA(0, 1), cA + hstep);
    if (wr == 1) PG8_BAR;
    PG8_WAIT_V(2); PG8_BAR;
    PG8_STAGE(PG8_SB(1, 0), cB + kstep); PG8_STAGE(PG8_SA(1, 0), cA + kstep); PG8_STAGE(PG8_SB(1, 1), cB + hstep + kstep);
    PG8_WAIT_V(6); PG8_BAR;
    for (;;) {
        const bool has_next = S.next(ui + 1, nxt);
        const char* nA = has_next ? (const char*)g.A + (size_t)nxt.pm * tstep : cA; const char* nB = has_next ? (const char*)g.Bt + (size_t)nxt.pn * tstep : cB;
        for (int t = 0; t < nt; t += 2) {
            const bool last = (t == nt - 2);
            const char* a1 = cA + (size_t)(t + 1) * kstep;
            const char* a2 = last ? nA : cA + (size_t)(t + 2) * kstep; const char* b2 = last ? nB : cB + (size_t)(t + 2) * kstep;
            const char* a3 = a2 + kstep; const char* b3 = b2 + kstep;
            PG8_LDB(B0, 0, 0); PG8_LDB(B1, 0, 1); PG8_SCHED; PG8_LDA(At, 0, 0); PG8_STAGE(PG8_SA(1, 1), a1 + hstep);
            PG8_WAIT_V(8); PG8_WAIT_L(0); PG8_BAR; PG8_MMA(0, 0, At, B0); PG8_MMA(0, 1, At, B1); PG8_BAR; PG8_SCHED;
            PG8_LDA(At, 0, 1); PG8_STAGE(PG8_SB(0, 0), b2); PG8_STAGE(PG8_SB(0, 1), b2 + hstep); PG8_STAGE(PG8_SA(0, 0), a2);
            PG8_WAIT_V(8); PG8_WAIT_L(0); PG8_BAR; PG8_MMA(1, 0, At, B0); PG8_MMA(1, 1, At, B1); PG8_BAR; PG8_SCHED;
            PG8_LDB(B0, 1, 0); PG8_LDB(B1, 1, 1); PG8_SCHED; PG8_LDA(At, 1, 0); PG8_STAGE(PG8_SA(0, 1), a2 + hstep);
            PG8_WAIT_V(8); PG8_WAIT_L(0); PG8_BAR; PG8_MMA(0, 0, At, B0); PG8_MMA(0, 1, At, B1); PG8_BAR; PG8_SCHED;
            PG8_LDA(At, 1, 1); PG8_STAGE(PG8_SB(1, 0), b3); PG8_STAGE(PG8_SB(1, 1), b3 + hstep); PG8_STAGE(PG8_SA(1, 0), a3);
            PG8_WAIT_V(8); PG8_WAIT_L(0); PG8_BAR; PG8_MMA(1, 0, At, B0); PG8_MMA(1, 1, At, B1); PG8_BAR; PG8_SCHED;
        }
        if (wr == 0) PG8_BAR;
        E(acc, cur, wr, wc, fr, fq);
        if (!has_next) break;
#pragma unroll
        for (int a = 0; a < 2; ++a)
#pragma unroll
            for (int b = 0; b < 2; ++b)
#pragma unroll
                for (int m = 0; m < 4; ++m)
#pragma unroll
                    for (int n = 0; n < 2; ++n) acc[a][b][m][n] = (f32x4){0.f, 0.f, 0.f, 0.f};
        cur = nxt; cA = nA; cB = nB; ++ui;
        if (wr == 1) PG8_BAR;
    }
    PG8_WAIT_V(0);
    PG8_BAR;
#undef PG8_SA
#undef PG8_SB
#undef PG8_STAGE
#undef PG8_LDA
#undef PG8_LDB
#undef PG8_MMA
#undef PG8_WAIT_V
#undef PG8_WAIT_L
#undef PG8_BAR
#undef PG8_SCHED
}

typedef int i32x4_t __attribute__((ext_vector_type(4)));
template <class Epi, class Sched>
__device__ __forceinline__ void gemm_phase_f8(PG8_LAS unsigned char* lds, const Gemm g, const Sched& S, const Epi& E, const int wid_in) {
    int wid = wid_in; asm volatile("" : "+s"(wid));
    const int lane = lane_id_asm(), tid = wid * 64 + lane, wr = wid >> 2, wc = wid & 3, fr = lane & 15, fq = lane >> 4;
    int K_o = g.K; asm volatile("" : "+s"(K_o)); const int K = K_o, nt = K / BK;
    unsigned voff[2];
#pragma unroll
    for (int i = 0; i < 2; ++i) { int R, C; stage_rc(tid * 16 + i * 8192, R, C); voff[i] = (unsigned)(R * K + C) * 2u; }
    const size_t kstep = (size_t)(BK * 2);
    const size_t hstep = (size_t)HALF * K * 2;
    const size_t tstep = 2 * hstep;
    const unsigned ldsw = (unsigned)wid * 1024u;
    const int aoff = lds_byte(wr * 64 + fr, fq * 16), boff = lds_byte(wc * 32 + fr, fq * 16);
#define PG8_SA(b, h) (((b) * 2 + (h)) * HTB)
#define PG8_SB(b, h) ((4 + (b) * 2 + (h)) * HTB)
#define PG8_STAGE(bufoff, gbase) do { _Pragma("unroll") for (int _i = 0; _i < 2; ++_i) \
        __builtin_amdgcn_global_load_lds((const unsigned*)((const char*)(gbase) + voff[_i]), (PG8_LAS unsigned*)(lds + (bufoff) + ldsw + _i * 8192), 16, 0, 0); } while (0)
#define PG8_LDA(dst, b, h) do { _Pragma("unroll") for (int m = 0; m < 4; ++m) _Pragma("unroll") for (int k = 0; k < 2; ++k) dst[m][k] = *(const PG8_LAS bf16x8*)(lds + PG8_SA(b, h) + aoff + m * 2048 + k * 16); } while (0)
#define PG8_LDB(dst, b, h) do { _Pragma("unroll") for (int n = 0; n < 2; ++n) _Pragma("unroll") for (int k = 0; k < 2; ++k) dst[n][k] = *(const PG8_LAS bf16x8*)(lds + PG8_SB(b, h) + boff + n * 2048 + k * 16); } while (0)
#define PG8_F8(x) __builtin_shufflevector(__builtin_bit_cast(i32x4_t, (x)[0]), __builtin_bit_cast(i32x4_t, (x)[1]), 0, 1, 2, 3, 4, 5, 6, 7)
#define PG8_MMA(ai, bj, At, Bt) do { __builtin_amdgcn_s_setprio(1); asm volatile("s_nop 1" ::: ); _Pragma("unroll") for (int m = 0; m < 4; ++m) _Pragma("unroll") for (int n = 0; n < 2; ++n) \
        asm volatile("v_mfma_f32_16x16x128_f8f6f4 %0, %1, %2, %0" : "+v"(acc[ai][bj][m][n]) : "v"(PG8_F8(Bt[n])), "v"(PG8_F8(At[m]))); __builtin_amdgcn_s_setprio(0); } while (0)
#define PG8_ACC_SETTLE asm volatile("s_nop 15\n\ts_nop 15" ::: "memory")
#define PG8_WAIT_V(n) asm volatile("s_waitcnt vmcnt(" #n ")" ::: "memory")
#define PG8_WAIT_L(n) asm volatile("s_waitcnt lgkmcnt(" #n ")" ::: "memory")
#define PG8_BAR __builtin_amdgcn_s_barrier()
#define PG8_SCHED __builtin_amdgcn_sched_barrier(0)
    Unit cur, nxt; int ui = 0;
    if (!S.next(0, cur)) return;
    f32x4 acc[2][2][4][2];
#pragma unroll
    for (int a = 0; a < 2; ++a)
#pragma unroll
        for (int b = 0; b < 2; ++b)
#pragma unroll
            for (int m = 0; m < 4; ++m)
#pragma unroll
                for (int n = 0; n < 2; ++n) acc[a][b][m][n] = (f32x4){0.f, 0.f, 0.f, 0.f};
    bf16x8 At[4][2], B0[2][2], B1[2][2];
    const char* cA = (const char*)g.A + (size_t)cur.pm * tstep; const char* cB = (const char*)g.Bt + (size_t)cur.pn * tstep;
    PG8_STAGE(PG8_SB(0, 0), cB); PG8_STAGE(PG8_SB(0, 1), cB + hstep); PG8_STAGE(PG8_SA(0, 0), cA); PG8_STAGE(PG8_SA(0, 1), cA + hstep);
    if (wr == 1) PG8_BAR;
    PG8_WAIT_V(2); PG8_BAR;
    PG8_STAGE(PG8_SB(1, 0), cB + kstep); PG8_STAGE(PG8_SA(1, 0), cA + kstep); PG8_STAGE(PG8_SB(1, 1), cB + hstep + kstep);
    PG8_WAIT_V(6); PG8_BAR;
    for (;;) {
        const bool has_next = S.next(ui + 1, nxt);
        const char* nA = has_next ? (const char*)g.A + (size_t)nxt.pm * tstep : cA; const char* nB = has_next ? (const char*)g.Bt + (size_t)nxt.pn * tstep : cB;
        for (int t = 0; t < nt; t += 2) {
            const bool last = (t == nt - 2);
            const char* a1 = cA + (size_t)(t + 1) * kstep;
            const char* a2 = last ? nA : cA + (size_t)(t + 2) * kstep; const char* b2 = last ? nB : cB + (size_t)(t + 2) * kstep;
            const char* a3 = a2 + kstep; const char* b3 = b2 + kstep;
            PG8_LDB(B0, 0, 0); PG8_LDB(B1, 0, 1); PG8_SCHED; PG8_LDA(At, 0, 0); PG8_STAGE(PG8_SA(1, 1), a1 + hstep);
            PG8_WAIT_V(8); PG8_WAIT_L(0); PG8_BAR; PG8_MMA(0, 0, At, B0); PG8_MMA(0, 1, At, B1); PG8_BAR; PG8_SCHED;
            PG8_LDA(At, 0, 1); PG8_STAGE(PG8_SB(0, 0), b2); PG8_STAGE(PG8_SB(0, 1), b2 + hstep); PG8_STAGE(PG8_SA(0, 0), a2);
            PG8_WAIT_V(8); PG8_WAIT_L(0); PG8_BAR; PG8_MMA(1, 0, At, B0); PG8_MMA(1, 1, At, B1); PG8_BAR; PG8_SCHED;
            PG8_LDB(B0, 1, 0); PG8_LDB(B1, 1, 1); PG8_SCHED; PG8_LDA(At, 1, 0); PG8_STAGE(PG8_SA(0, 1), a2 + hstep);
            PG8_WAIT_V(8); PG8_WAIT_L(0); PG8_BAR; PG8_MMA(0, 0, At, B0); PG8_MMA(0, 1, At, B1); PG8_BAR; PG8_SCHED;
            PG8_LDA(At, 1, 1); PG8_STAGE(PG8_SB(1, 0), b3); PG8_STAGE(PG8_SB(1, 1), b3 + hstep); PG8_STAGE(PG8_SA(1, 0), a3);
            PG8_WAIT_V(8); PG8_WAIT_L(0); PG8_BAR; PG8_MMA(1, 0, At, B0); PG8_MMA(1, 1, At, B1); PG8_BAR; PG8_SCHED;
        }
        if (wr == 0) PG8_BAR;
        PG8_ACC_SETTLE;
        E(acc, cur, wr, wc, fr, fq);
        if (!has_next) break;
#pragma unroll
        for (int a = 0; a < 2; ++a)
#pragma unroll
            for (int b = 0; b < 2; ++b)
#pragma unroll
                for (int m = 0; m < 4; ++m)
#pragma unroll
                    for (int n = 0; n < 2; ++n) acc[a][b][m][n] = (f32x4){0.f, 0.f, 0.f, 0.f};
        cur = nxt; cA = nA; cB = nB; ++ui;
        if (wr == 1) PG8_BAR;
    }
    PG8_WAIT_V(0);
    PG8_BAR;
#undef PG8_SA
#undef PG8_SB
#undef PG8_STAGE
#undef PG8_LDA
#undef PG8_LDB
#undef PG8_MMA
#undef PG8_F8
#undef PG8_ACC_SETTLE
#undef PG8_WAIT_V
#undef PG8_WAIT_L
#undef PG8_BAR
#undef PG8_SCHED
}

#define EPI_ROWS(...) _Pragma("unroll") for (int ai = 0; ai < 2; ++ai) _Pragma("unroll") for (int m = 0; m < 4; ++m) { const int row = u.pm * BM + ai * HALF + wr * 64 + m * 16 + fr; __VA_ARGS__ }
__device__ __forceinline__ u32x4 pack8(const f32x4 a, const f32x4 b) { u32x4 w; w.x = cvt_pk_bf16(a[0], a[1]); w.y = cvt_pk_bf16(a[2], a[3]); w.z = cvt_pk_bf16(b[0], b[1]); w.w = cvt_pk_bf16(b[2], b[3]); return w; }

struct EpiIn {
    bf16_t* aqkv; bf16_t* qb; bf16_t* kb; bf16_t* vb; bf16_t* gate; const float* qg; const float* kg; const float* rope; float asc;
    __device__ __forceinline__ void operator()(const f32x4 (&acc)[2][2][4][2], const Unit& u, int wr, int wc, int fr, int fq) const {
        const int pn = u.pn;
        if (pn >= 9 && pn < 14) {
            const bool isq = pn < 13; const int head = isq ? (pn - 9) * 4 + wc : wc; bf16_t* dst = isq ? qb : kb; const int pitch = isq ? 1024 : 256;
            const float* gvec = isq ? qg : kg; const float osc = isq ? C2 : 1.0f;
            f32x4 gv[2][2];
#pragma unroll
            for (int bj = 0; bj < 2; ++bj)
#pragma unroll
                for (int n = 0; n < 2; ++n) gv[bj][n] = *(const f32x4*)(gvec + 32 * bj + 16 * n + 4 * fq);
            EPI_ROWS(
                float ss = 0.f;
                _Pragma("unroll") for (int bj = 0; bj < 2; ++bj) _Pragma("unroll") for (int n = 0; n < 2; ++n) { const f32x4 x = acc[ai][bj][m][n] * asc; ss += (x[0] * x[0] + x[1] * x[1]) + (x[2] * x[2] + x[3] * x[3]); }
                ss = xsum<16>(ss); ss = xsum<32>(ss);
                const float sc = rsqrtf(ss * (1.0f / 64.0f) + EPS) * osc * asc;
                const int t = row & (SEQ - 1);
                _Pragma("unroll") for (int bj = 0; bj < 2; ++bj) {
                    const int pos = bj == 0 ? (t >> 6) : (t & 63);
                    const f32x4 cs = *(const f32x4*)(rope + pos * 16 + 4 * fq); const f32x4 sn = *(const f32x4*)(rope + 1024 + pos * 16 + 4 * fq);
                    const f32x4 y0 = acc[ai][bj][m][0] * sc * gv[bj][0]; const f32x4 y1 = acc[ai][bj][m][1] * sc * gv[bj][1];
                    const f32x4 o0 = y0 * cs - y1 * sn; const f32x4 o1 = y1 * cs + y0 * sn;
                    bf16_t* p = dst + (size_t)row * pitch + head * 64 + 32 * bj + 4 * fq;
                    u32x2 w0; w0.x = cvt_pk_bf16(o0[0], o0[1]); w0.y = cvt_pk_bf16(o0[2], o0[3]);
                    u32x2 w1; w1.x = cvt_pk_bf16(o1[0], o1[1]); w1.y = cvt_pk_bf16(o1[2], o1[3]);
                    *(u32x2*)p = w0; *(u32x2*)(p + 16) = w1;
                }
            )
        } else {
            bf16_t* dst; int pitch, colt, dsh = 0; float sc = asc; bool sig = false, fold = false;
            if (pn < 9) { dst = aqkv + (size_t)pn * T * 256; pitch = 256; colt = 0; fold = true; dsh = 2 * (pn / 3); if (pn % 3 == 0) sc = C2 * asc; }
            else if (pn == 14) { dst = vb; pitch = 256; colt = 0; }
            else { dst = gate; pitch = 2048; colt = (pn - 15) * 256; sig = true; }
            const int col0 = colt + wc * 32 + 8 * fq;
            EPI_ROWS(
                int drow = row;
                if (fold) { const int t = row & (SEQ - 1); drow = (row & ~(SEQ - 1)) | ((t & ((1 << dsh) - 1)) << (12 - dsh)) | (t >> dsh); }
                bf16_t* rowp = dst + (size_t)drow * pitch + col0;
                _Pragma("unroll") for (int bj = 0; bj < 2; ++bj) {
                    f32x4 v0 = acc[ai][bj][m][0], v1 = acc[ai][bj][m][1];
                    if (sig) { _Pragma("unroll") for (int j = 0; j < 4; ++j) { v0[j] = sigmoid_f(v0[j] * asc); v1[j] = sigmoid_f(v1[j] * asc); } }
                    else { v0 = v0 * sc; v1 = v1 * sc; }
                    *(u32x4*)(rowp + bj * HALF) = pack8(v0, v1);
                }
            )
        }
    }
};
struct EpiMergeA {
    const bf16_t* gate; bf16_t* merged;
    __device__ __forceinline__ void operator()(const f32x4 (&acc)[2][2][4][2], const Unit& u, int wr, int wc, int fr, int fq) const {
        const int col0 = u.pn * BM + wc * 32 + 8 * fq;
        EPI_ROWS(
            _Pragma("unroll") for (int bj = 0; bj < 2; ++bj) {
                const u32x4 gw = *(const u32x4*)(gate + (size_t)row * 2048 + col0 + bj * HALF);
                f32x4 v0 = acc[ai][bj][m][0], v1 = acc[ai][bj][m][1];
                v0[0] *= bf_lo(gw.x); v0[1] *= bf_hi(gw.x); v0[2] *= bf_lo(gw.y); v0[3] *= bf_hi(gw.y);
                v1[0] *= bf_lo(gw.z); v1[1] *= bf_hi(gw.z); v1[2] *= bf_lo(gw.w); v1[3] *= bf_hi(gw.w);
                *(u32x4*)(merged + (size_t)row * 1024 + col0 + bj * HALF) = pack8(v0, v1);
            }
        )
    }
};
struct EpiMergeB {
    const bf16_t* gate; bf16_t* merged;
    __device__ __forceinline__ void operator()(const f32x4 (&acc)[2][2][4][2], const Unit& u, int wr, int wc, int fr, int fq) const {
        const int col0 = u.pn * BM + wc * 32 + 8 * fq;
        EPI_ROWS(
            _Pragma("unroll") for (int bj = 0; bj < 2; ++bj) {
                const u32x4 gw = *(const u32x4*)(gate + (size_t)row * 2048 + 1024 + col0 + bj * HALF);
                bf16_t* mp = merged + (size_t)row * 1024 + col0 + bj * HALF;
                const u32x4 mw = *(const u32x4*)mp;
                f32x4 v0 = acc[ai][bj][m][0], v1 = acc[ai][bj][m][1];
                v0[0] = v0[0] * bf_lo(gw.x) + bf_lo(mw.x); v0[1] = v0[1] * bf_hi(gw.x) + bf_hi(mw.x); v0[2] = v0[2] * bf_lo(gw.y) + bf_lo(mw.y); v0[3] = v0[3] * bf_hi(gw.y) + bf_hi(mw.y);
                v1[0] = v1[0] * bf_lo(gw.z) + bf_lo(mw.z); v1[1] = v1[1] * bf_hi(gw.z) + bf_hi(mw.z); v1[2] = v1[2] * bf_lo(gw.w) + bf_lo(mw.w); v1[3] = v1[3] * bf_hi(gw.w) + bf_hi(mw.w);
                *(u32x4*)mp = pack8(v0, v1);
            }
        )
    }
};
struct EpiOut {
    const float* xin; float* xout; const float* g1;
    __device__ __forceinline__ void operator()(const f32x4 (&acc)[2][2][4][2], const Unit& u, int wr, int wc, int fr, int fq) const {
        const int col0 = u.pn * BM + wc * 32 + 8 * fq; const int b = (u.pm * BM) >> 12;
        f32x4 gv[2][2];
#pragma unroll
        for (int bj = 0; bj < 2; ++bj)
#pragma unroll
            for (int n = 0; n < 2; ++n) gv[bj][n] = *(const f32x4*)(g1 + (size_t)b * 6144 + col0 + bj * HALF + 4 * n);
        EPI_ROWS(
            _Pragma("unroll") for (int bj = 0; bj < 2; ++bj) {
                const size_t off = (size_t)row * 1024 + col0 + bj * HALF;
                const f32x4 x0 = *(const f32x4*)(xin + off), x1 = *(const f32x4*)(xin + off + 4);
                *(f32x4*)(xout + off) = x0 + gv[bj][0] * acc[ai][bj][m][0]; *(f32x4*)(xout + off + 4) = x1 + gv[bj][1] * acc[ai][bj][m][1];
            }
        )
    }
};
struct EpiGU {
    const float* bgu; bf16_t* act;
    __device__ __forceinline__ void operator()(const f32x4 (&acc)[2][2][4][2], const Unit& u, int wr, int wc, int fr, int fq) const {
        const int e = u.pn >> 3, pl = u.pn & 7; const int c0 = pl * 128 + wc * 32 + 8 * fq;
        const float* bp = bgu + (size_t)e * 2048 + c0;
        const f32x4 bg0 = *(const f32x4*)bp, bg1 = *(const f32x4*)(bp + 4), bl0 = *(const f32x4*)(bp + 1024), bl1 = *(const f32x4*)(bp + 1028);
        EPI_ROWS(
            f32x4 o[2];
            _Pragma("unroll") for (int n = 0; n < 2; ++n) {
                const f32x4 gl = acc[ai][0][m][n] + (n == 0 ? bg0 : bg1); const f32x4 ln = acc[ai][1][m][n] + (n == 0 ? bl0 : bl1);
                _Pragma("unroll") for (int j = 0; j < 4; ++j) { const float xg = fminf(gl[j], 7.0f); const float xl = fminf(fmaxf(ln[j], -7.0f), 7.0f); o[n][j] = xg * sigmoid_f(1.702f * xg) * (xl + 1.0f); }
            }
            *(u32x4*)(act + (size_t)row * 1024 + c0) = pack8(o[0], o[1]);
        )
    }
};
__device__ __forceinline__ u32x2 pack8_f8(const f32x4 a, const f32x4 b) { unsigned w0 = 0, w1 = 0;
    w0 = __builtin_amdgcn_cvt_pk_fp8_f32(a[0], a[1], w0, false); w0 = __builtin_amdgcn_cvt_pk_fp8_f32(a[2], a[3], w0, true);
    w1 = __builtin_amdgcn_cvt_pk_fp8_f32(b[0], b[1], w1, false); w1 = __builtin_amdgcn_cvt_pk_fp8_f32(b[2], b[3], w1, true); u32x2 r; r.x = w0; r.y = w1; return r; }
constexpr float W8_SCALE = 64.0f, W8_INV = 1.0f / 64.0f;
struct EpiGU8 {
    const float* bgu; unsigned char* act;
    __device__ __forceinline__ void operator()(const f32x4 (&acc)[2][2][4][2], const Unit& u, int wr, int wc, int fr, int fq) const {
        const int e = u.pn >> 3, pl = u.pn & 7; const int c0 = pl * 128 + wc * 32 + 8 * fq;
        const float* bp = bgu + (size_t)e * 2048 + c0;
        const f32x4 bg0 = *(const f32x4*)bp, bg1 = *(const f32x4*)(bp + 4), bl0 = *(const f32x4*)(bp + 1024), bl1 = *(const f32x4*)(bp + 1028);
        EPI_ROWS(
            f32x4 o[2];
            _Pragma("unroll") for (int n = 0; n < 2; ++n) {
                const f32x4 gl = acc[ai][0][m][n] * W8_INV + (n == 0 ? bg0 : bg1); const f32x4 ln = acc[ai][1][m][n] * W8_INV + (n == 0 ? bl0 : bl1);
                _Pragma("unroll") for (int j = 0; j < 4; ++j) { const float xg = fminf(gl[j], 7.0f); const float xl = fminf(fmaxf(ln[j], -7.0f), 7.0f); o[n][j] = xg * sigmoid_f(1.702f * xg) * (xl + 1.0f); }
            }
            *(u32x2*)(act + (size_t)row * 1024 + c0) = pack8_f8(o[0], o[1]);
        )
    }
};
struct EpiDN8 {
    const float* bdn; const float* roww; bf16_t* y;
    __device__ __forceinline__ void operator()(const f32x4 (&acc)[2][2][4][2], const Unit& u, int wr, int wc, int fr, int fq) const {
        const int e = u.pn >> 2, pl = u.pn & 3; const int col0 = pl * BM + wc * 32 + 8 * fq;
        f32x4 bv[2][2];
#pragma unroll
        for (int bj = 0; bj < 2; ++bj)
#pragma unroll
            for (int n = 0; n < 2; ++n) bv[bj][n] = *(const f32x4*)(bdn + (size_t)e * 1024 + col0 + bj * HALF + 4 * n);
        EPI_ROWS(
            const float w = roww[row];
            _Pragma("unroll") for (int bj = 0; bj < 2; ++bj)
                *(u32x4*)(y + (size_t)row * 1024 + col0 + bj * HALF) = pack8((acc[ai][bj][m][0] * W8_INV + bv[bj][0]) * w, (acc[ai][bj][m][1] * W8_INV + bv[bj][1]) * w);
        )
    }
};
struct EpiDN {
    const float* bdn; const float* roww; bf16_t* y;
    __device__ __forceinline__ void operator()(const f32x4 (&acc)[2][2][4][2], const Unit& u, int wr, int wc, int fr, int fq) const {
        const int e = u.pn >> 2, pl = u.pn & 3; const int col0 = pl * BM + wc * 32 + 8 * fq;
        f32x4 bv[2][2];
#pragma unroll
        for (int bj = 0; bj < 2; ++bj)
#pragma unroll
            for (int n = 0; n < 2; ++n) bv[bj][n] = *(const f32x4*)(bdn + (size_t)e * 1024 + col0 + bj * HALF + 4 * n);
        EPI_ROWS(
            const float w = roww[row];
            _Pragma("unroll") for (int bj = 0; bj < 2; ++bj)
                *(u32x4*)(y + (size_t)row * 1024 + col0 + bj * HALF) = pack8((acc[ai][bj][m][0] + bv[bj][0]) * w, (acc[ai][bj][m][1] + bv[bj][1]) * w);
        )
    }
};
}

namespace attn_body {
using bf16 = __hip_bfloat16;
using bf16x8 = __attribute__((ext_vector_type(8))) short;
using s16x4 = __attribute__((ext_vector_type(4))) short;
using f32x16 = __attribute__((ext_vector_type(16))) float;
using u32x4 = __attribute__((ext_vector_type(4))) unsigned;
constexpr int D = 64, NW = 8, QBLK = 32, QB = QBLK * NW, KVBLK = 64;
__device__ __forceinline__ int crow(int r, int hi) { return (r & 3) + 8 * (r >> 2) + 4 * hi; }
#define SBAR() __builtin_amdgcn_sched_barrier(0)
constexpr int NSLOT = 3, SLOTB = 8192;
constexpr int LDS_K = 0, LDS_V = NSLOT * SLOTB, LDS_WS = 2 * NSLOT * SLOTB, LDS_OST = LDS_WS + NW * 64 * 4, LDS_LUT = LDS_OST + NW * 4096, LUT_N = 768, LDS_BYTES = LDS_LUT + LUT_N * 4;
constexpr float MFLOOR = -1024.0f;
__device__ __forceinline__ void glds16(const void* gsrc, unsigned lds_dst) { unsigned keep;
  asm volatile("s_mov_b32 %0, m0\n\ts_mov_b32 m0, %2\n\ts_nop 0\n\tglobal_load_lds_dwordx4 %1, off\n\ts_mov_b32 m0, %0" : "=&s"(keep) : "v"(gsrc), "s"(lds_dst) : "memory"); }
__device__ __forceinline__ float max3f(float a, float b, float c) { float r; asm("v_max3_f32 %0, %1, %2, %3" : "=v"(r) : "v"(a), "v"(b), "v"(c)); return r; }
__device__ __forceinline__ float max2f(float a, float b) { float r; asm("v_max_f32_e32 %0, %1, %2" : "=v"(r) : "v"(a), "v"(b)); return r; }
__device__ __forceinline__ float fadd_s(float a, float b) { float r; asm("v_add_f32_e32 %0, %1, %2" : "=v"(r) : "v"(a), "v"(b)); return r; }
__device__ __forceinline__ float fsub_s(float a, float b) { float r; asm("v_sub_f32_e32 %0, %1, %2" : "=v"(r) : "v"(a), "v"(b)); return r; }
typedef float f32x2_t __attribute__((ext_vector_type(2))); typedef __bf16 bf16x2_t __attribute__((ext_vector_type(2)));
__device__ __forceinline__ unsigned cvtpk_s(float lo, float hi) { f32x2_t v = {lo, hi}; bf16x2_t b = __builtin_convertvector(v, bf16x2_t); return __builtin_bit_cast(unsigned, b); }
#define WAIT_BAR(N) asm volatile("s_waitcnt vmcnt(" #N ") lgkmcnt(0)\n\ts_barrier" ::: "memory")

__device__ __forceinline__ void qkt(f32x16& p0, f32x16& p1, const char* Kslot, const bf16x8* qr, const f32x16& negm, int r32, int hi) {
  const char* kb = Kslot + hi * 1024 + r32 * 16;
  #pragma unroll
  for (int d0 = 0; d0 < 4; ++d0) {
    const bf16x8 b0 = *reinterpret_cast<const bf16x8*>(kb + d0 * 2048);
    const bf16x8 b1 = *reinterpret_cast<const bf16x8*>(kb + d0 * 2048 + 512);
    if (d0 == 0) { p0 = __builtin_amdgcn_mfma_f32_32x32x16_bf16(b0, qr[0], negm, 0, 0, 0); p1 = __builtin_amdgcn_mfma_f32_32x32x16_bf16(b1, qr[0], negm, 0, 0, 0); }
    else { p0 = __builtin_amdgcn_mfma_f32_32x32x16_bf16(b0, qr[d0], p0, 0, 0, 0); p1 = __builtin_amdgcn_mfma_f32_32x32x16_bf16(b1, qr[d0], p1, 0, 0, 0); } }
}
typedef __attribute__((address_space(3))) const char* lds_cptr;
typedef short v4i16_t __attribute__((ext_vector_type(4)));
__device__ __forceinline__ void kload8(bf16x8* kf, lds_cptr kp) {
  kf[0] = *(const __attribute__((address_space(3))) bf16x8*)(kp);        kf[1] = *(const __attribute__((address_space(3))) bf16x8*)(kp + 512);
  kf[2] = *(const __attribute__((address_space(3))) bf16x8*)(kp + 2048); kf[3] = *(const __attribute__((address_space(3))) bf16x8*)(kp + 2560);
  kf[4] = *(const __attribute__((address_space(3))) bf16x8*)(kp + 4096); kf[5] = *(const __attribute__((address_space(3))) bf16x8*)(kp + 4608);
  kf[6] = *(const __attribute__((address_space(3))) bf16x8*)(kp + 6144); kf[7] = *(const __attribute__((address_space(3))) bf16x8*)(kp + 6656);
}
__device__ __forceinline__ void kload2(bf16x8* kf, lds_cptr kp, int j) { kf[2 * j] = *(const __attribute__((address_space(3))) bf16x8*)(kp + j * 2048); kf[2 * j + 1] = *(const __attribute__((address_space(3))) bf16x8*)(kp + j * 2048 + 512); }
__device__ __forceinline__ s16x4 vtr(lds_cptr p) { return __builtin_bit_cast(s16x4, __builtin_amdgcn_ds_read_tr16_b64_v4i16((__attribute__((address_space(3))) v4i16_t*)p)); }
__device__ __forceinline__ float rowmax(const f32x16& p0, const f32x16& p1) {
  float a = max3f(p0[0], p0[1], p1[0]), b = max3f(p0[2], p0[3], p1[1]); a = max3f(a, p1[2], p1[3]);
  #pragma unroll
  for (int r = 4; r < 16; r += 4) { a = max3f(a, p0[r], p0[r + 1]); b = max3f(b, p0[r + 2], p0[r + 3]); a = max3f(a, p1[r], p1[r + 1]); b = max3f(b, p1[r + 2], p1[r + 3]); }
  const float m = max2f(a, b);
  auto rr = __builtin_amdgcn_permlane32_swap(__float_as_uint(m), __float_as_uint(m), false, false);
  return max2f(__uint_as_float(rr[0]), __uint_as_float(rr[1]));
}
__device__ __forceinline__ void pv(f32x16* o, int vb, bf16x8 pa0, bf16x8 pa1, bf16x8 pa2, bf16x8 pa3) {
  #pragma unroll
  for (int d0 = 0; d0 < 2; ++d0) { s16x4 lo[4], hi[4];
    #pragma unroll
    for (int ks = 0; ks < 4; ++ks) {
      asm volatile("ds_read_b64_tr_b16 %0,%1 offset:%c2" : "=&v"(lo[ks]) : "v"(vb), "i"(d0 * 4096 + ks * 1024) : "memory");
      asm volatile("ds_read_b64_tr_b16 %0,%1 offset:%c2" : "=&v"(hi[ks]) : "v"(vb), "i"(d0 * 4096 + ks * 1024 + 512) : "memory"); }
    asm volatile("s_waitcnt lgkmcnt(0)" ::: "memory"); SBAR();
    #define PK(k) (bf16x8){lo[k][0], lo[k][1], lo[k][2], lo[k][3], hi[k][0], hi[k][1], hi[k][2], hi[k][3]}
    o[d0] = __builtin_amdgcn_mfma_f32_32x32x16_bf16(pa0, PK(0), o[d0], 0, 0, 0);
    o[d0] = __builtin_amdgcn_mfma_f32_32x32x16_bf16(pa1, PK(1), o[d0], 0, 0, 0);
    o[d0] = __builtin_amdgcn_mfma_f32_32x32x16_bf16(pa2, PK(2), o[d0], 0, 0, 0);
    o[d0] = __builtin_amdgcn_mfma_f32_32x32x16_bf16(pa3, PK(3), o[d0], 0, 0, 0);
    #undef PK
  }
}
struct Job { const bf16* Q; const bf16* K; const bf16* V; bf16* O; float* lse; const float* lutg; int NT, i0, kq0, dsh, cls; };
template <int MODE, int THRL> __device__ __forceinline__ void attn_unit(const Job& J, char* shm, const int wid_in) {
  int wid = wid_in; asm volatile("" : "+s"(wid));
  constexpr int QP = MODE == 0 ? 1024 : 256, KP = 256;
  const int lane = lane_id_asm(), tid = wid * 64 + lane, r32 = lane & 31, hi = lane >> 5;
  const bf16* Qw = J.Q + (long)(wid * QBLK) * QP;
  const bf16* Kh = J.K; const bf16* Vh = J.V;
  const unsigned lds0 = (unsigned)(uintptr_t)shm;
  float* wsf = (float*)(shm + LDS_WS) + wid * 64;
  const bf16* ksrc = Kh + (long)lane * KP + wid * 8;
  const bf16* vsrc = Vh + (long)(16 * (wid & 3) + (lane >> 2)) * KP + (wid >> 2) * 32 + (lane & 3) * 8;
  const unsigned kdst = lds0 + LDS_K + wid * 1024, vdst = lds0 + LDS_V + wid * 1024;
  #define DMA_K(t, slot) glds16(ksrc + (long)(t) * KVBLK * KP, (unsigned)__builtin_amdgcn_readfirstlane(kdst + (slot)))
  #define DMA_V(t, slot) glds16(vsrc + (long)(t) * KVBLK * KP, (unsigned)__builtin_amdgcn_readfirstlane(vdst + (slot)))
  const int vb0 = (int)(lds0 + LDS_V) + ((lane >> 4) & 1) * 32 + (lane & 3) * 8 + (4 * hi + ((lane & 15) >> 2)) * 64;
  const char* Kbase = shm + LDS_K; bf16x8 kf[8];
  const lds_cptr shm3 = (lds_cptr)shm; const lds_cptr kp0 = shm3 + LDS_K + hi * 1024 + r32 * 16; const lds_cptr vp0 = shm3 + LDS_V + ((lane >> 4) & 1) * 32 + (lane & 3) * 8 + (4 * hi + ((lane & 15) >> 2)) * 64;
  const int NT = J.NT;
  if (MODE == 1) {
    __attribute__((address_space(3))) float* lut = (__attribute__((address_space(3))) float*)(shm3 + LDS_LUT);
    lut[tid] = J.lutg[tid]; if (tid < LUT_N - 512) lut[512 + tid] = J.lutg[512 + tid];
  }
  DMA_K(0, 0); DMA_V(0, 0); DMA_K(1, SLOTB);
  bf16x8 qr[4];
  #pragma unroll
  for (int d0 = 0; d0 < 4; ++d0) qr[d0] = *reinterpret_cast<const bf16x8*>(&Qw[(long)r32 * QP + d0 * 16 + hi * 8]);
  float mhat = 0.f, l_reg = 0.f; f32x16 o[2]; o[0] = f32x16{}; o[1] = f32x16{}; f32x16 negm = f32x16{}; asm volatile("" : "+v"(negm));
  const int qrel = wid * QBLK + r32;
  const __attribute__((address_space(3))) float* lutq = (const __attribute__((address_space(3))) float*)(shm3 + LDS_LUT) + (J.kq0 - qrel + 383 + 4 * hi);
  #define CMASK(P0, P1, t) do { if (MODE == 1) { const __attribute__((address_space(3))) float* lp_ = lutq + 64 * (t); \
      _Pragma("unroll") for (int r = 0; r < 16; ++r) { const int ko_ = (r & 3) + 8 * (r >> 2); P0[r] += lp_[ko_]; P1[r] += lp_[ko_ + 32]; } } } while (0)
  bool resc = false;
  #define START(P0, P1) do { const float rm = rowmax(P0, P1); resc = false; \
    { const float dl = MODE == 1 ? max2f(rm, MFLOOR) : rm; mhat = fadd_s(mhat, dl); \
      _Pragma("unroll") for (int r = 0; r < 16; ++r) { P0[r] = fsub_s(P0[r], dl); P1[r] = fsub_s(P1[r], dl); } \
      _Pragma("unroll") for (int r = 0; r < 16; ++r) negm[r] = -mhat; asm volatile("" : "+v"(negm)); } \
    _Pragma("unroll") for (int r = 0; r < 16; ++r) P0[r] = __builtin_amdgcn_exp2f(P0[r]); } while (0)
  #define RESC() do { if (resc) { asm volatile("s_waitcnt lgkmcnt(0)" ::: "memory"); \
      _Pragma("unroll") for (int d_ = 0; d_ < 2; ++d_) _Pragma("unroll") for (int r = 0; r < 16; ++r) o[d_][r] *= wsf[crow(r, hi)]; } } while (0)
  f32x16 pA0, pA1, pB0, pB1;
  int sl_prev = 0, sl_cur = 0, sl_next = SLOTB;
  #define ROT() do { sl_prev = sl_cur; sl_cur = sl_next; sl_next = (sl_next == (NSLOT - 1) * SLOTB) ? 0 : sl_next + SLOTB; } while (0)
  DMA_K(2, 2 * SLOTB);
  WAIT_BAR(3);
  qkt(pA0, pA1, Kbase, qr, negm, r32, hi); asm volatile("s_nop 15\n\ts_nop 7" : "+v"(pA0), "+v"(pA1)); CMASK(pA0, pA1, 0);
  START(pA0, pA1);
  _Pragma("unroll") for (int r = 0; r < 16; ++r) pA1[r] = __builtin_amdgcn_exp2f(pA1[r]);
  WAIT_BAR(0);
  DMA_K(3, 0); DMA_V(1, SLOTB);
  ROT();
  kload8(kf, kp0 + sl_cur);
  WAIT_BAR(2);
  s16x4 vlo[8], vhi[8]; u32x4 pw0, pw1, pw2, pw3;
  #define PKW(P, B) cvtpk_s(P[B], P[B + 1])
  #define PAF(k) __builtin_bit_cast(bf16x8, pw##k)
  #define VFR(i) (bf16x8){vlo[i][0], vlo[i][1], vlo[i][2], vlo[i][3], vhi[i][0], vhi[i][1], vhi[i][2], vhi[i][3]}
  #define PIN(x) asm volatile("" : "+v"(x))
  #define MX3(a, b, c) __builtin_fmaxf(__builtin_fmaxf((a), (b)), (c))
  #define GAPA(MF, A0, A1, A2, A3, W0, W1, PW) do { MF; sacc += A0; sacc += A1; sacc += A2; sacc += A3; PIN(sacc); W0; W1; PIN(PW); SBAR(); } while (0)
  #define EX(v) __builtin_amdgcn_exp2f(v)
  #define GAPB(MF, X, B) do { MF; X[B] = EX(X[B]); X[B + 1] = EX(X[B + 1]); X[B + 2] = EX(X[B + 2]); X[B + 3] = EX(X[B + 3]); PIN(X); SBAR(); } while (0)
  #define VRD(i) do { vlo[i] = vtr(vp_ + (((i) >> 2) * 4096 + ((i) & 3) * 1024)); vhi[i] = vtr(vp_ + (((i) >> 2) * 4096 + ((i) & 3) * 1024 + 512)); } while (0)
  #define KRD(G, j) do { if (G) { kload2(kf, kp0 + sl_next, j); SBAR(); } } while (0)
  #define STEP(C0, C1, P0, P1, t, GK, GV, GL) do { SBAR(); \
    const lds_cptr vp_ = vp0 + sl_prev; \
    VRD(0); SBAR(); float sacc = (P0[0] + P0[1]); \
    GAPA(C0 = __builtin_amdgcn_mfma_f32_32x32x16_bf16(kf[0], qr[0], negm, 0, 0, 0), P0[2], P0[3], P0[4], P0[5],     pw0[0] = PKW(P0, 0), pw0[1] = PKW(P0, 2), pw0); \
    VRD(4); SBAR(); GAPA(C1 = __builtin_amdgcn_mfma_f32_32x32x16_bf16(kf[1], qr[0], negm, 0, 0, 0), P0[6], P0[7], P0[8], P0[9],     pw0[2] = PKW(P0, 4), pw0[3] = PKW(P0, 6), pw0); \
    VRD(1); SBAR(); GAPA(C0 = __builtin_amdgcn_mfma_f32_32x32x16_bf16(kf[2], qr[1], C0, 0, 0, 0),   P0[10], P0[11], P0[12], P0[13], pw1[0] = PKW(P0, 8), pw1[1] = PKW(P0, 10), pw1); \
    VRD(5); SBAR(); GAPA(C1 = __builtin_amdgcn_mfma_f32_32x32x16_bf16(kf[3], qr[1], C1, 0, 0, 0),   P0[14], P0[15], P1[0], P1[1],   pw1[2] = PKW(P0, 12), pw1[3] = PKW(P0, 14), pw1); \
    VRD(2); SBAR(); GAPA(C0 = __builtin_amdgcn_mfma_f32_32x32x16_bf16(kf[4], qr[2], C0, 0, 0, 0),   P1[2], P1[3], P1[4], P1[5],     pw2[0] = PKW(P1, 0), pw2[1] = PKW(P1, 2), pw2); \
    VRD(6); SBAR(); GAPA(C1 = __builtin_amdgcn_mfma_f32_32x32x16_bf16(kf[5], qr[2], C1, 0, 0, 0),   P1[6], P1[7], P1[8], P1[9],     pw2[2] = PKW(P1, 4), pw2[3] = PKW(P1, 6), pw2); \
    VRD(3); SBAR(); GAPA(C0 = __builtin_amdgcn_mfma_f32_32x32x16_bf16(kf[6], qr[3], C0, 0, 0, 0),   P1[10], P1[11], P1[12], P1[13], pw3[0] = PKW(P1, 8), pw3[1] = PKW(P1, 10), pw3); \
    VRD(7); SBAR(); GAPA(C1 = __builtin_amdgcn_mfma_f32_32x32x16_bf16(kf[7], qr[3], C1, 0, 0, 0),   P1[14], P1[15], 0.f, 0.f,       pw3[2] = PKW(P1, 12), pw3[3] = PKW(P1, 14), pw3); \
    l_reg += sacc; \
    if (GK) { DMA_K((t) + 3, sl_cur); } if (GV) { DMA_V((t) + 1, sl_next); } \
    CMASK(C0, C1, t); \
    { float a = MX3(C0[0], C0[1], C1[0]), b = MX3(C0[2], C0[3], C1[1]); a = MX3(a, C1[2], C1[3]); \
      _Pragma("unroll") for (int r = 4; r < 16; r += 4) { a = MX3(a, C0[r], C0[r + 1]); b = MX3(b, C0[r + 2], C0[r + 3]); a = MX3(a, C1[r], C1[r + 1]); b = MX3(b, C1[r + 2], C1[r + 3]); } \
      float rm = __builtin_fmaxf(a, b); { auto rr = __builtin_amdgcn_permlane32_swap(__float_as_uint(rm), __float_as_uint(rm), false, false); rm = __builtin_fmaxf(__uint_as_float(rr[0]), __uint_as_float(rr[1])); } \
      resc = false; \
      if (__builtin_expect(__any(rm > (float)THRL), 0)) { const float dl = __builtin_fmaxf(rm, 0.f); mhat += dl; \
        _Pragma("unroll") for (int r = 0; r < 16; ++r) { C0[r] -= dl; C1[r] -= dl; } \
        _Pragma("unroll") for (int r = 0; r < 16; ++r) negm[r] = -mhat; asm volatile("" : "+v"(negm)); \
        const float f = __builtin_amdgcn_exp2f(-dl); l_reg *= f; if (hi == 0) wsf[r32] = f; resc = true; } } \
    SBAR(); \
    GAPB(o[0] = __builtin_amdgcn_mfma_f32_32x32x16_bf16(PAF(0), VFR(0), o[0], 0, 0, 0), C0, 0); \
    GAPB(o[1] = __builtin_amdgcn_mfma_f32_32x32x16_bf16(PAF(0), VFR(4), o[1], 0, 0, 0), C0, 4); \
    KRD(GL, 0); GAPB(o[0] = __builtin_amdgcn_mfma_f32_32x32x16_bf16(PAF(1), VFR(1), o[0], 0, 0, 0), C0, 8); \
    KRD(GL, 1); GAPB(o[1] = __builtin_amdgcn_mfma_f32_32x32x16_bf16(PAF(1), VFR(5), o[1], 0, 0, 0), C0, 12); \
    KRD(GL, 2); GAPB(o[0] = __builtin_amdgcn_mfma_f32_32x32x16_bf16(PAF(2), VFR(2), o[0], 0, 0, 0), C1, 0); \
    KRD(GL, 3); GAPB(o[1] = __builtin_amdgcn_mfma_f32_32x32x16_bf16(PAF(2), VFR(6), o[1], 0, 0, 0), C1, 4); \
    GAPB(o[0] = __builtin_amdgcn_mfma_f32_32x32x16_bf16(PAF(3), VFR(3), o[0], 0, 0, 0), C1, 8); \
    GAPB(o[1] = __builtin_amdgcn_mfma_f32_32x32x16_bf16(PAF(3), VFR(7), o[1], 0, 0, 0), C1, 12); \
    } while (0)
  int t = 1;
  for (; t + 5 < NT; t += 2) {
    STEP(pB0, pB1, pA0, pA1, t, true, true, true);     WAIT_BAR(2); RESC(); ROT();
    STEP(pA0, pA1, pB0, pB1, t + 1, true, true, true); WAIT_BAR(2); RESC(); ROT();
  }
  #define ENDW(tt) do { if ((tt) + 3 < NT) { WAIT_BAR(2); } else if ((tt) + 2 < NT) { WAIT_BAR(1); } else { WAIT_BAR(0); } } while (0)
  for (; t + 1 < NT; t += 2) {
    STEP(pB0, pB1, pA0, pA1, t, (t + 3 < NT), (t + 1 < NT), (t + 1 < NT));       ENDW(t);     RESC(); ROT();
    STEP(pA0, pA1, pB0, pB1, t + 1, (t + 4 < NT), (t + 2 < NT), (t + 2 < NT));   ENDW(t + 1); RESC(); ROT();
  }
  STEP(pB0, pB1, pA0, pA1, NT - 1, false, false, false); RESC();
  { float sacc = pB0[0] + pB0[1]; _Pragma("unroll") for (int r = 2; r < 16; ++r) sacc += pB0[r]; _Pragma("unroll") for (int r = 0; r < 16; ++r) sacc += pB1[r]; l_reg += sacc;
    pw0 = (u32x4){PKW(pB0, 0), PKW(pB0, 2), PKW(pB0, 4), PKW(pB0, 6)}; pw1 = (u32x4){PKW(pB0, 8), PKW(pB0, 10), PKW(pB0, 12), PKW(pB0, 14)}; pw2 = (u32x4){PKW(pB1, 0), PKW(pB1, 2), PKW(pB1, 4), PKW(pB1, 6)}; pw3 = (u32x4){PKW(pB1, 8), PKW(pB1, 10), PKW(pB1, 12), PKW(pB1, 14)};
    SBAR(); pv(o, vb0 + sl_cur, PAF(0), PAF(1), PAF(2), PAF(3)); }
  #undef PKW
  #undef PAF
  #undef VFR
  #undef PIN
  #undef MX3
  #undef GAPA
  #undef GAPB
  #undef EX
  #undef VRD
  #undef KRD
  #undef STEP
  #undef ENDW
  { auto rr = __builtin_amdgcn_permlane32_swap(__float_as_uint(l_reg), __float_as_uint(l_reg), false, false); l_reg = __uint_as_float(rr[0]) + __uint_as_float(rr[1]); }
  if (hi == 0) wsf[32 + r32] = l_reg; asm volatile("s_waitcnt lgkmcnt(0)" ::: "memory");
  float rli[16];
  #pragma unroll
  for (int r = 0; r < 16; ++r) rli[r] = __builtin_amdgcn_rcpf(wsf[32 + crow(r, hi)]);
  { bf16* stg = (bf16*)(shm + LDS_OST) + wid * 2048;
    #pragma unroll
    for (int r = 0; r < 16; ++r) { const int orow = crow(r, hi);
      #pragma unroll
      for (int d0 = 0; d0 < 2; ++d0) stg[orow * 64 + d0 * 32 + r32] = __float2bfloat16(o[d0][r] * rli[r]); }
    asm volatile("s_waitcnt lgkmcnt(0)" ::: "memory");
    if (MODE == 0) {
      bf16* Ow = J.O + (long)(wid * QBLK) * 1024;
      #pragma unroll
      for (int i = 0; i < 4; ++i) { const int row = i * 8 + (lane >> 3), ch = lane & 7; const u32x4 v = *(const u32x4*)(stg + row * 64 + ch * 8); *(u32x4*)(Ow + (long)row * 1024 + ch * 8) = v; }
    } else {
      #pragma unroll
      for (int i = 0; i < 4; ++i) { const int row = i * 8 + (lane >> 3), ch = lane & 7; const u32x4 v = *(const u32x4*)(stg + row * 64 + ch * 8);
        const long tok = ((long)(J.i0 + wid * QBLK + row) << J.dsh) + J.cls; *(u32x4*)(J.O + tok * 256 + ch * 8) = v; }
      if (hi == 0) { const long tok = ((long)(J.i0 + qrel) << J.dsh) + J.cls; J.lse[tok * 4] = mhat + __builtin_amdgcn_logf(l_reg); }
    } }
  asm volatile("s_waitcnt lgkmcnt(0)\n\ts_barrier" ::: "memory");
  #undef DMA_K
  #undef DMA_V
  #undef CMASK
  #undef START
  #undef RESC
  #undef ROT
}
#undef SBAR
#undef WAIT_BAR
}

constexpr size_t MiB = 1u << 20;
constexpr size_t WS_CTL = 0, CTL_ZERO_BYTES = 1 * MiB;
constexpr size_t WS_MOD = 1 * MiB;
constexpr size_t WS_ROPE = WS_MOD + 512 * 1024;
constexpr size_t WS_BLUT = WS_ROPE + 8192;
constexpr size_t WS_RC0 = WS_BLUT + 12 * 768 * 4;
constexpr size_t WS_HIST = WS_RC0 + 4096;
constexpr size_t WS_TILEE = WS_HIST + 32768;
constexpr size_t WS_TOPE = 2 * MiB;
constexpr size_t WS_TOPW = WS_TOPE + 512 * 1024;
constexpr size_t WS_SLOT = WS_TOPW + 512 * 1024;
constexpr size_t WS_ROWW = WS_SLOT + 512 * 1024;
constexpr size_t WS_LSE = 5 * MiB;
constexpr size_t WS_WRHI = 7 * MiB;
constexpr size_t WS_WRLO = 8 * MiB;
constexpr size_t WS_WIN = 9 * MiB;
constexpr size_t WS_WBRA = 32 * MiB;
constexpr size_t WS_WBRB = 33 * MiB;
constexpr size_t WS_WOUT = 37 * MiB;
constexpr size_t WS_WGU = 41 * MiB;
constexpr size_t WS_WDN = 297 * MiB;
constexpr size_t WS_X = 425 * MiB;
constexpr size_t WS_H = 553 * MiB;
constexpr size_t WS_R = 617 * MiB;
constexpr size_t WS_AQKV = WS_R;
constexpr size_t WS_QB = WS_R + 144 * MiB;
constexpr size_t WS_KB = WS_R + 208 * MiB;
constexpr size_t WS_VB = WS_R + 224 * MiB;
constexpr size_t WS_GATE = WS_R + 240 * MiB;
constexpr size_t WS_OAG = WS_R + 368 * MiB;
constexpr size_t WS_OA = WS_R + 416 * MiB;
constexpr size_t WS_MERGED = WS_R + 432 * MiB;
constexpr size_t WS_XS = WS_R;
constexpr size_t WS_ACT = WS_R + 136 * MiB;
constexpr size_t WS_Y = WS_R + 272 * MiB;
constexpr size_t WS_OB = WS_R + 496 * MiB;
constexpr size_t WS_END = WS_R + 560 * MiB;
constexpr int CW_BAR = 4096;

constexpr int RING_BYTES = 133120;
constexpr int LDSCTL_OFF = RING_BYTES;
constexpr int LDS_BYTES = 147456;
constexpr int NWAVES = 8;

#define GAS __attribute__((address_space(1)))
#define LAS __attribute__((address_space(3)))
typedef unsigned short bf16;
typedef unsigned v4u __attribute__((ext_vector_type(4)));
typedef unsigned v2u __attribute__((ext_vector_type(2)));
typedef float f32x4 __attribute__((ext_vector_type(4)));
typedef float f32x16 __attribute__((ext_vector_type(16)));
typedef int i32x4 __attribute__((ext_vector_type(4)));
typedef short bf16x8 __attribute__((ext_vector_type(8)));
typedef GAS unsigned gu32;
#define RLX_AGENT __ATOMIC_RELAXED, __HIP_MEMORY_SCOPE_AGENT
#define LDS_WAIT() asm volatile("s_waitcnt lgkmcnt(0)" ::: "memory")
__device__ __forceinline__ unsigned f2bf(float f) { unsigned u = __builtin_bit_cast(unsigned, f); return (u + 0x7fffu + ((u >> 16) & 1u)) >> 16; }
__device__ __forceinline__ unsigned pk2(float lo, float hi) { return f2bf(lo) | (f2bf(hi) << 16); }
__device__ __forceinline__ float bfl(unsigned w) { return __uint_as_float(w << 16); }
__device__ __forceinline__ float bfh(unsigned w) { return __uint_as_float(w & 0xffff0000u); }

#define XB_TMO      128
#define XB_XCNT(j)  (256  + 64 * (j))
#define XB_XSUB(j)  (1280 + 64 * (j))
#define XB_XGEN(j)  (2304 + 64 * (j))
#define XB_TOP      3328
#define XB_TOPGEN   3392
#define XCD_BAR_WORDS 3456
#define XB_SPIN_CAP (1u << 18)
__device__ __forceinline__ unsigned xb_ld(unsigned* p)              { return __hip_atomic_load(p, __ATOMIC_RELAXED, __HIP_MEMORY_SCOPE_AGENT); }
__device__ __forceinline__ unsigned xb_add(unsigned* p, unsigned v) { return __hip_atomic_fetch_add(p, v, __ATOMIC_RELAXED, __HIP_MEMORY_SCOPE_AGENT); }
__device__ __forceinline__ unsigned xb_xcc_id() { return (unsigned)__builtin_amdgcn_s_getreg((3 << 11) | 20) & 0xFu; }
#define XB_SPIN(cond, bar) do { unsigned _sp = 0; while (cond) { __builtin_amdgcn_s_sleep(1); \
    if ((++_sp & 255u) == 0u) { if (xb_ld(&(bar)[XB_TMO])) break; if (_sp > XB_SPIN_CAP) { atomicAdd(&(bar)[XB_TMO], 1u); break; } } } } while (0)
struct XcdBarrier { unsigned* bar; unsigned x; volatile LAS unsigned* st; };
__device__ __forceinline__ XcdBarrier xcd_barrier_post(unsigned* bar, volatile LAS unsigned* st) {
    XcdBarrier b; b.bar = bar; b.x = xb_xcc_id(); b.st = st;
    if (threadIdx.x == 0) (void)xb_add(&bar[XB_XCNT(b.x)], 1u);
    return b;
}
__device__ __forceinline__ void xcd_barrier_complete(unsigned* bar, unsigned x, unsigned& nloc, unsigned& nx) {
    const unsigned G = gridDim.x * gridDim.y * gridDim.z;
    unsigned sum, cnt, mine, sp = 0u;
    for (;;) {
        sum = 0u; cnt = 0u; mine = 0u;
#pragma unroll
        for (unsigned j = 0; j < 16; ++j) { const unsigned c = xb_ld(&bar[XB_XCNT(j)]); sum += c; cnt += (c > 0u) ? 1u : 0u; mine = (j == x) ? c : mine; }
        if (sum == G) break;
        __builtin_amdgcn_s_sleep(1);
        if ((++sp & 255u) == 0u) { if (xb_ld(&bar[XB_TMO])) break; if (sp > XB_SPIN_CAP) { atomicAdd(&bar[XB_TMO], 1u); break; } }
    }
    nloc = mine > 0u ? mine : 1u; nx = cnt > 0u ? cnt : 1u;
}
__device__ __forceinline__ void xcd_barrier(const XcdBarrier& b) {
    asm volatile("s_waitcnt vmcnt(0)" ::: "memory");
    __syncthreads();
    if (threadIdx.x == 0) {
        unsigned* bar = b.bar;
        __builtin_amdgcn_s_waitcnt(0);
        unsigned nloc = b.st[0], nx = b.st[1];
        if (nloc == 0u) { xcd_barrier_complete(bar, b.x, nloc, nx); b.st[0] = nloc; b.st[1] = nx; }
        const unsigned old = xb_add(&bar[XB_XSUB(b.x)], 1u);
        const unsigned gen = old / nloc;
        if (old + 1u == (gen + 1u) * nloc) {
            __builtin_amdgcn_fence(__ATOMIC_RELEASE, "agent");
            asm volatile("s_waitcnt vmcnt(0)" ::: "memory");
            const unsigned og = xb_add(&bar[XB_TOP], 1u);
            const unsigned tg = og / nx;
            if (og + 1u == (tg + 1u) * nx) xb_add(&bar[XB_TOPGEN], 1u);
            else XB_SPIN(xb_ld(&bar[XB_TOPGEN]) == tg, bar);
            __builtin_amdgcn_fence(__ATOMIC_ACQUIRE, "agent");
            xb_add(&bar[XB_XGEN(b.x)], 1u);
            asm volatile("s_waitcnt vmcnt(0)" ::: "memory");
        } else {
            XB_SPIN(xb_ld(&bar[XB_XGEN(b.x)]) == gen, bar);
            __builtin_amdgcn_fence(__ATOMIC_ACQUIRE, "agent");
            asm volatile("s_waitcnt vmcnt(0)" ::: "memory");
        }
    }
    __syncthreads();
}

__device__ __forceinline__ float wave_sum(float v) {
    v = xsum<1>(v); v = xsum<2>(v); v = xsum<4>(v); v = xsum<8>(v); v = xsum<16>(v); v = xsum<32>(v);
    return v;
}
__device__ __forceinline__ void cvt_item(const float* W, int ldw, int K, int srcA, int srcB, bf16* WT, int dst_row0, int k0, LAS float* scr, int lane, bool ident = false) {
    const int kq = lane >> 4, nq = lane & 15; const int scol = (nq < 8 ? srcA + 4 * nq : srcB + 4 * (nq - 8));
    f32x4 v[16];
#pragma unroll
    for (int i = 0; i < 16; ++i) v[i] = *(const GAS f32x4*)(W + (size_t)(k0 + 4 * i + kq) * ldw + scol);
#pragma unroll
    for (int i = 0; i < 16; ++i)
#pragma unroll
        for (int e = 0; e < 4; ++e) scr[(4 * i + kq) * 65 + 4 * nq + e] = v[i][e];
    LDS_WAIT(); asm volatile("" ::: "memory");
    const int c = lane & 7, rr = lane >> 3;
#pragma unroll
    for (int j = 0; j < 8; ++j) { const int rho = rr + 8 * j; const int sc = (rho & 32) + (ident ? (rho & 31) : pg8::perm32(rho & 31)); const LAS float* s = scr + (8 * c) * 65 + sc;
        v4u o; o.x = pk2(s[0 * 65], s[1 * 65]); o.y = pk2(s[2 * 65], s[3 * 65]); o.z = pk2(s[4 * 65], s[5 * 65]); o.w = pk2(s[6 * 65], s[7 * 65]);
        *(GAS v4u*)(WT + (size_t)(dst_row0 + rho) * K + k0 + 8 * c) = o; }
    LDS_WAIT(); asm volatile("" ::: "memory");
}
__device__ __forceinline__ void cvt_item_f8(const float* W, int ldw, int K, int srcA, int srcB, unsigned char* WT, int dst_row0, int k0, LAS float* scr, int lane, bool ident = false) {
    const int kq = lane >> 4, nq = lane & 15; const int scol = (nq < 8 ? srcA + 4 * nq : srcB + 4 * (nq - 8));
    f32x4 v[16];
#pragma unroll
    for (int i = 0; i < 16; ++i) v[i] = *(const GAS f32x4*)(W + (size_t)(k0 + 4 * i + kq) * ldw + scol);
#pragma unroll
    for (int i = 0; i < 16; ++i)
#pragma unroll
        for (int e = 0; e < 4; ++e) scr[(4 * i + kq) * 65 + 4 * nq + e] = v[i][e] * pg8::W8_SCALE;
    LDS_WAIT(); asm volatile("" ::: "memory");
    const int c = lane & 7, rr = lane >> 3;
#pragma unroll
    for (int j = 0; j < 8; ++j) { const int rho = rr + 8 * j; const int sc = (rho & 32) + (ident ? (rho & 31) : pg8::perm32(rho & 31)); const LAS float* s = scr + (8 * c) * 65 + sc;
        unsigned w0 = 0, w1 = 0;
        w0 = __builtin_amdgcn_cvt_pk_fp8_f32(s[0 * 65], s[1 * 65], w0, false); w0 = __builtin_amdgcn_cvt_pk_fp8_f32(s[2 * 65], s[3 * 65], w0, true);
        w1 = __builtin_amdgcn_cvt_pk_fp8_f32(s[4 * 65], s[5 * 65], w1, false); w1 = __builtin_amdgcn_cvt_pk_fp8_f32(s[6 * 65], s[7 * 65], w1, true);
        v2u o; o.x = w0; o.y = w1; *(GAS v2u*)(WT + (size_t)(dst_row0 + rho) * K + k0 + 8 * c) = o; }
    LDS_WAIT(); asm volatile("" ::: "memory");
}
__device__ __forceinline__ int win_src(int X) { const int pn = X >> 3, bj = (X >> 2) & 1, wc = X & 3; return (pn >= 9 && pn < 14) ? pn * 256 + 64 * wc + 32 * bj : 32 * X; }
__device__ __forceinline__ int wgu_src(int X) { const int pn = X >> 3, bj = (X >> 2) & 1, wc = X & 3; return bj * 1024 + 128 * pn + 32 * wc; }

__device__ __forceinline__ void norm_row_bf16(const float* xrow, const float* g, const float* sc, const float* sh, bf16* orow, int lane) {
    const GAS f32x4* xr = (const GAS f32x4*)xrow + lane;
    f32x4 v[4]; float s = 0.f;
#pragma unroll
    for (int j = 0; j < 4; ++j) { v[j] = xr[64 * j]; s += (v[j].x * v[j].x + v[j].y * v[j].y) + (v[j].z * v[j].z + v[j].w * v[j].w); }
    const float rs = rsqrtf(wave_sum(s) * (1.0f / D) + EPS);
#pragma unroll
    for (int j = 0; j < 4; ++j) { const int c = 256 * j + 4 * lane;
        const f32x4 gg = *(const GAS f32x4*)(g + c), s1 = *(const GAS f32x4*)(sc + c), s0 = *(const GAS f32x4*)(sh + c);
        const f32x4 y = (v[j] * rs * gg) * (s1 + 1.0f) + s0;
        v2u o; o.x = pk2(y.x, y.y); o.y = pk2(y.z, y.w); *(GAS v2u*)(orow + c) = o; }
}

__device__ __forceinline__ void norm_rows2_bf16(const float* xrow, const float* g, const float* sc, const float* sh, bf16* orow, int lane) {
    const GAS f32x4* xr = (const GAS f32x4*)xrow + lane;
    f32x4 v[2][4]; float s0 = 0.f, s1 = 0.f;
#pragma unroll
    for (int j = 0; j < 4; ++j) { v[0][j] = xr[64 * j]; v[1][j] = xr[256 + 64 * j]; }
#pragma unroll
    for (int j = 0; j < 4; ++j) { s0 += (v[0][j].x * v[0][j].x + v[0][j].y * v[0][j].y) + (v[0][j].z * v[0][j].z + v[0][j].w * v[0][j].w); s1 += (v[1][j].x * v[1][j].x + v[1][j].y * v[1][j].y) + (v[1][j].z * v[1][j].z + v[1][j].w * v[1][j].w); }
    const float rs0 = rsqrtf(wave_sum(s0) * (1.0f / D) + EPS), rs1 = rsqrtf(wave_sum(s1) * (1.0f / D) + EPS);
#pragma unroll
    for (int j = 0; j < 4; ++j) { const int c = 256 * j + 4 * lane;
        const f32x4 gg = *(const GAS f32x4*)(g + c), a1 = *(const GAS f32x4*)(sc + c) + 1.0f, a0 = *(const GAS f32x4*)(sh + c);
        const f32x4 y0 = (v[0][j] * rs0 * gg) * a1 + a0, y1 = (v[1][j] * rs1 * gg) * a1 + a0;
        v2u o0; o0.x = pk2(y0.x, y0.y); o0.y = pk2(y0.z, y0.w); *(GAS v2u*)(orow + c) = o0;
        v2u o1; o1.x = pk2(y1.x, y1.y); o1.y = pk2(y1.z, y1.w); *(GAS v2u*)(orow + D + c) = o1; }
}

__device__ __forceinline__ void norm_rows2_f8(const float* xrow, const float* g, const float* sc, const float* sh, unsigned char* orow, int lane) {
    const GAS f32x4* xr = (const GAS f32x4*)xrow + lane;
    f32x4 v[2][4]; float s0 = 0.f, s1 = 0.f;
#pragma unroll
    for (int j = 0; j < 4; ++j) { v[0][j] = xr[64 * j]; v[1][j] = xr[256 + 64 * j]; }
#pragma unroll
    for (int j = 0; j < 4; ++j) { s0 += (v[0][j].x * v[0][j].x + v[0][j].y * v[0][j].y) + (v[0][j].z * v[0][j].z + v[0][j].w * v[0][j].w); s1 += (v[1][j].x * v[1][j].x + v[1][j].y * v[1][j].y) + (v[1][j].z * v[1][j].z + v[1][j].w * v[1][j].w); }
    const float rs0 = rsqrtf(wave_sum(s0) * (1.0f / D) + EPS), rs1 = rsqrtf(wave_sum(s1) * (1.0f / D) + EPS);
#pragma unroll
    for (int j = 0; j < 4; ++j) { const int c = 256 * j + 4 * lane;
        const f32x4 gg = *(const GAS f32x4*)(g + c), a1 = *(const GAS f32x4*)(sc + c) + 1.0f, a0 = *(const GAS f32x4*)(sh + c);
        const f32x4 y0 = (v[0][j] * rs0 * gg) * a1 + a0, y1 = (v[1][j] * rs1 * gg) * a1 + a0;
        unsigned w0 = 0, w1 = 0;
        w0 = __builtin_amdgcn_cvt_pk_fp8_f32(y0.x, y0.y, w0, false); w0 = __builtin_amdgcn_cvt_pk_fp8_f32(y0.z, y0.w, w0, true);
        w1 = __builtin_amdgcn_cvt_pk_fp8_f32(y1.x, y1.y, w1, false); w1 = __builtin_amdgcn_cvt_pk_fp8_f32(y1.z, y1.w, w1, true);
        *(GAS unsigned*)(orow + c) = w0; *(GAS unsigned*)(orow + D + c) = w1; }
}

struct Args { const float* in[20]; float* out; unsigned char* ws; int ph_lo, ph_hi, li, pad; };
constexpr int N_PHASES = 2 + 10 * DEPTH;

typedef const __attribute__((address_space(4))) Args* kargs_t;
__device__ __forceinline__ kargs_t kargs_opaque() { kargs_t p = (kargs_t)__builtin_amdgcn_kernarg_segment_ptr(); asm volatile("" : "+s"(p)); return p; }
#define PH_BEGIN() kargs_t ap = kargs_opaque(); unsigned char* ws = ap->ws; (void)ws; \
    int wave = wave_s; asm volatile("" : "+s"(wave)); const int lane = lane_id_asm(); const int tid = wave * 64 + lane; (void)lane; (void)tid; \
    int bx = blockIdx.x; asm volatile("" : "+s"(bx)); int G = gridDim.x; asm volatile("" : "+s"(G)); const int vcu = (G % 8 == 0) ? (bx % 8) * (G / 8) + bx / 8 : bx; (void)vcu; \
    const int gw = vcu * NWAVES + wave, NGW = G * NWAVES; (void)gw; (void)NGW; const int gtid = vcu * (NWAVES * 64) + tid, NGT = G * NWAVES * 64; (void)gtid; (void)NGT
#define INP(k) (ap->in[k])
#define x_in INP(0)
#define c_in INP(1)
#define w_ada INP(2)
#define b_ada INP(3)
#define norm1_g INP(4)
#define w_in INP(5)
#define q_norm_g INP(6)
#define k_norm_g INP(7)
#define rel_bias INP(8)
#define w_br_a INP(9)
#define w_br_b INP(10)
#define w_out INP(11)
#define norm2_g INP(12)
#define w_router INP(13)
#define b_router INP(14)
#define w_gate_up INP(15)
#define b_gate_up INP(16)
#define w_down INP(17)
#define b_down INP(18)
#define final_g INP(19)
#define MOD ((float*)(ws + WS_MOD))
#define ROPE ((float*)(ws + WS_ROPE))
#define BLUT ((float*)(ws + WS_BLUT))
#define RC0 ((float*)(ws + WS_RC0))
#define HIST ((int*)(ws + WS_HIST))
#define TILEE ((int*)(ws + WS_TILEE))
#define TOPE ((int*)(ws + WS_TOPE))
#define TOPW ((float*)(ws + WS_TOPW))
#define SLOT ((int*)(ws + WS_SLOT))
#define ROWW ((float*)(ws + WS_ROWW))
#define LSE ((float*)(ws + WS_LSE))
#define WRHI ((bf16*)(ws + WS_WRHI))
#define WRLO ((bf16*)(ws + WS_WRLO))
#define WIN ((unsigned char*)(ws + WS_WIN))
#define WBRA ((bf16*)(ws + WS_WBRA))
#define WBRB ((bf16*)(ws + WS_WBRB))
#define WOUT ((bf16*)(ws + WS_WOUT))
#define WGU ((unsigned char*)(ws + WS_WGU))
#define WDN ((unsigned char*)(ws + WS_WDN))
#define X ((float*)(ws + WS_X))
#define H ((bf16*)(ws + WS_H))
#define AQKV ((bf16*)(ws + WS_AQKV))
#define QB ((bf16*)(ws + WS_QB))
#define KB ((bf16*)(ws + WS_KB))
#define VB ((bf16*)(ws + WS_VB))
#define GATE ((bf16*)(ws + WS_GATE))
#define OAG ((bf16*)(ws + WS_OAG))
#define OA ((bf16*)(ws + WS_OA))
#define MERGED ((bf16*)(ws + WS_MERGED))
#define OB ((bf16*)(ws + WS_OB))
#define XS ((unsigned char*)(ws + WS_XS))
#define ACT ((unsigned char*)(ws + WS_ACT))
#define YB ((bf16*)(ws + WS_Y))
__global__ void __launch_bounds__(NWAVES * 64, 2) mk_fwd(Args args) {
    extern __shared__ __attribute__((aligned(16))) unsigned char lds[];
    LAS unsigned char* L = (LAS unsigned char*)lds;
    volatile LAS unsigned* MISC = (volatile LAS unsigned*)(L + LDSCTL_OFF);
    gu32* ctl = (gu32*)(args.ws + WS_CTL);
    const int wave_s = __builtin_amdgcn_readfirstlane(threadIdx.x >> 6);
    for (int u = threadIdx.x; u < (LDS_BYTES - LDSCTL_OFF) / 4; u += NWAVES * 64) ((LAS unsigned*)(L + LDSCTL_OFF))[u] = 0u;
    __syncthreads();
    XcdBarrier bar; bar.bar = (unsigned*)(ctl + CW_BAR) + args.li * XCD_BAR_WORDS; bar.x = 0; bar.st = nullptr;
    if (!MK_PER_PHASE) bar = xcd_barrier_post((unsigned*)(ctl + CW_BAR) + args.li * XCD_BAR_WORDS, MISC + 8);
    const int lo = args.ph_lo, hi = args.ph_hi;
#define IN(k) (lo <= (k) && (k) < hi)
#define KIND(q) ((PH_KIND_MASK >> (q)) & 1)
#define SEAM(k) do { if (IN(k) && IN((k) + 1)) xcd_barrier(bar); } while (0)

    for (int rep0 = 0; rep0 < 1 + PROBE_P0; ++rep0) {
    if (KIND(0) && IN(0)) { PH_BEGIN();
        {
            LAS float* cact = (LAS float*)L;
            LAS float* part = (LAS float*)(L + 32768);
            for (int i = tid; i < NB * D; i += NWAVES * 64) { const float cv = c_in[i]; cact[i] = cv / (1.0f + __expf(-cv)); }
            __syncthreads();
            for (int vb = bx; vb < 256; vb += G) {
                const int gc = vb * 48 + lane;
                const int l = gc / 6144, col = gc % 6144;
                float a[NB];
#pragma unroll
                for (int b = 0; b < NB; ++b) a[b] = 0.f;
                if (lane < 48) {
                    const float* wp = w_ada + (size_t)l * D * 6144 + col;
                    for (int k = wave * 128; k < wave * 128 + 128; ++k) { const float w = wp[(size_t)k * 6144];
#pragma unroll
                        for (int b = 0; b < NB; ++b) a[b] += cact[b * D + k] * w; }
                }
#pragma unroll
                for (int b = 0; b < NB; ++b) part[(wave * NB + b) * 64 + lane] = a[b];
                __syncthreads();
                if (tid < NB * 48) { const int b = tid / 48, cl = tid % 48; const int gc2 = vb * 48 + cl; const int l2 = gc2 / 6144, col2 = gc2 % 6144;
                    float s = b_ada[l2 * 6144 + col2];
#pragma unroll
                    for (int w = 0; w < NWAVES; ++w) s += part[(w * NB + b) * 64 + cl];
                    MOD[((size_t)l2 * NB + b) * 6144 + col2] = s; }
                __syncthreads();
            }
        }
        for (int i = gtid; i < 1024 + 12 * 768; i += NGT) {
            if (i < 1024) { const int p = i >> 4, f = i & 15; const double inv = pow(10000.0, -(double)f / 16.0); const double ang = (double)p * inv; ROPE[i] = (float)cos(ang); ROPE[1024 + i] = (float)sin(ang); }
            else { const int j = i - 1024; const int hh = j / 768, di = j % 768; const int delta = di - 383; const int g = hh >> 2; const int dil = g == 0 ? 1 : (g == 1 ? 4 : 16);
                float val = -INFINITY;
                if (delta >= -64 && delta <= 64) { const int rel = delta * dil; const int n = rel < 0 ? -rel : rel; int bk = rel > 0 ? 16 : 0;
                    if (n < 8) bk += n; else { int lg = 8 + (int)(logf((float)n / 8.0f) / logf(128.0f) * 8.0f); if (lg > 15) lg = 15; bk += lg; }
                    val = rel_bias[bk * 12 + hh] * LOG2E; }
                BLUT[j] = val; }
        }
        {
            LAS float* scr = (LAS float*)(L + wave * 16640);
            __syncthreads();
            constexpr int I_IN = 16 * 92, I_BRA = 4 * 16, I_BRB = 16 * 16, I_OUT = 16 * 16, I_GU = 16 * 32, I_DN = 16 * 16;
            constexpr int PER_L = I_IN + I_BRA + I_BRB + I_OUT;
            constexpr int NITEMS = DEPTH * PER_L + DEPTH * NE * (I_GU + I_DN);
            for (int it = gw; it < NITEMS; it += NGW) {
                int r = it;
                if (r < DEPTH * PER_L) {
                    const int l = r / PER_L; r %= PER_L;
                    if (r < I_IN) { const int kb = r / 92, g64 = r % 92; cvt_item_f8(w_in + (size_t)l * D * N_IN, N_IN, D, win_src(2 * g64), win_src(2 * g64 + 1), WIN + (size_t)l * N_IN * D, 64 * g64, 64 * kb, scr, lane, (g64 >> 2) >= 9 && (g64 >> 2) < 14); continue; } r -= I_IN;
                    if (r < I_BRA) { const int kb = r / 16, g64 = r % 16; cvt_item(w_br_a + (size_t)l * 256 * D, D, 256, 64 * g64, 64 * g64 + 32, WBRA + (size_t)l * D * 256, 64 * g64, 64 * kb, scr, lane); continue; } r -= I_BRA;
                    if (r < I_BRB) { const int kb = r / 16, g64 = r % 16; cvt_item(w_br_b + (size_t)l * D * D, D, D, 64 * g64, 64 * g64 + 32, WBRB + (size_t)l * D * D, 64 * g64, 64 * kb, scr, lane); continue; } r -= I_BRB;
                    { const int kb = r / 16, g64 = r % 16; cvt_item(w_out + (size_t)l * D * D, D, D, 64 * g64, 64 * g64 + 32, WOUT + (size_t)l * D * D, 64 * g64, 64 * kb, scr, lane); continue; }
                }
                r -= DEPTH * PER_L;
                if (r < DEPTH * NE * I_GU) { const int le = r / I_GU; r %= I_GU; const int kb = r / 32, g64 = r % 32;
                    cvt_item_f8(w_gate_up + (size_t)le * D * 2048, 2048, D, wgu_src(2 * g64), wgu_src(2 * g64 + 1), WGU + (size_t)le * 2048 * D, 64 * g64, 64 * kb, scr, lane); continue; }
                r -= DEPTH * NE * I_GU;
                { const int le = r / I_DN; r %= I_DN; const int kb = r / 16, g64 = r % 16;
                    cvt_item_f8(w_down + (size_t)le * D * D, D, D, 64 * g64, 64 * g64 + 32, WDN + (size_t)le * D * D, 64 * g64, 64 * kb, scr, lane); }
            }
        }
    }
    SEAM(0);
    }
    if (KIND(1) && IN(1)) { PH_BEGIN();
        for (int m = 2 * gw; m < T; m += 2 * NGW) { const int b = m >> 12; const float* md = MOD + (size_t)b * 6144;
            norm_rows2_f8(x_in + (size_t)m * D, norm1_g, md + 1024, md, (unsigned char*)H + (size_t)m * D, lane); }
        for (int i = gtid; i < DEPTH * NB * NE * D; i += NGT) { const int k = i & 1023, e = (i >> 10) & 31, b = (i >> 15) & 7, l = i >> 18;
            const float v = norm2_g[l * D + k] * (1.0f + MOD[((size_t)l * NB + b) * 6144 + 4 * 1024 + k]) * w_router[((size_t)l * D + k) * NE + e];
            const unsigned hb = f2bf(v); const float lv = v - __uint_as_float(hb << 16);
            WRHI[i] = (bf16)hb; WRLO[i] = (bf16)f2bf(lv); }
        for (int i = gw; i < DEPTH * NB * NE; i += NGW) { const int e = i & 31, b = (i >> 5) & 7, l = i >> 8; float s = 0.f;
            for (int k = lane; k < D; k += 64) s += MOD[((size_t)l * NB + b) * 6144 + 3 * 1024 + k] * w_router[((size_t)l * D + k) * NE + e];
            s = wave_sum(s); if (lane == 0) RC0[i] = s + b_router[l * NE + e]; }
    }
    SEAM(1);

    for (int li = (PROBE_MASK ? -1 : 0); li < DEPTH; ++li) {
        const int l = li < 0 ? 0 : li; const bool virt = li < 0;
        const int P = 2 + 10 * l;
#define VK(q) (!virt || ((PROBE_MASK >> (q)) & 1))
        if (KIND(2) && IN(P + 0) && VK(2)) { PH_BEGIN();
            pg8::Gemm g{H, (const bf16*)(WIN + (size_t)l * N_IN * D), D / 2}; pg8::StaticOrder S; S.init(T, N_IN, G, bx);
            pg8::EpiIn E{AQKV, QB, KB, VB, GATE, q_norm_g + l * 64, k_norm_g + l * 64, ROPE, pg8::W8_INV};
            pg8::gemm_phase_f8<pg8::EpiIn, pg8::StaticOrder>(L, g, S, E, wave);
        }
        if (VK(2)) SEAM(P + 0);
        if (KIND(3) && IN(P + 1) && VK(3)) { PH_BEGIN();
            namespace ab = attn_body;
            for (int j = 0; j < 8; ++j) {
                const int uidx = vcu * 8 + j; if (uidx >= 2048) break;
                const int pair = uidx >> 6, idx = uidx & 63; const int b = pair >> 2, kvh = pair & 3, hq = idx >> 4, qb = idx & 15; const int h = kvh * 4 + hq;
                ab::Job J; J.Q = (const ab::bf16*)QB + ((size_t)b * SEQ + qb * 256) * 1024 + h * 64; J.K = (const ab::bf16*)KB + (size_t)b * SEQ * 256 + kvh * 64; J.V = (const ab::bf16*)VB + (size_t)b * SEQ * 256 + kvh * 64;
                J.O = (ab::bf16*)OB + ((size_t)b * SEQ + qb * 256) * 1024 + h * 64; J.lse = nullptr; J.lutg = nullptr; J.NT = 64; J.i0 = 0; J.kq0 = 0; J.dsh = 0; J.cls = 0;
                ab::attn_unit<0, 8>(J, (char*)lds, wave);
            }
            for (int j = 0; j < 6; ++j) {
                const int uidx = vcu * 6 + j; if (uidx >= 1536) break;
                const int g = uidx / 512, r = uidx % 512; const int b = r >> 6, hs = (r >> 4) & 3, combo = r & 15;
                const int dsh = 2 * g; const int Lc = SEQ >> dsh; const int nqb = Lc >> 8;
                const int cls = combo / nqb, qb = combo % nqb; const int i0 = qb * 256;
                int t0 = (i0 >> 6) - 1; const int ntile = Lc >> 6; const int NT = ntile >= 6 ? 6 : 4; if (t0 < 0) t0 = 0; if (t0 > ntile - NT) t0 = ntile - NT;
                const size_t cbase = (size_t)b * SEQ + (size_t)cls * Lc;
                const ab::bf16* aq = (const ab::bf16*)AQKV + (size_t)(g * 3 + 0) * T * 256; const ab::bf16* ak = (const ab::bf16*)AQKV + (size_t)(g * 3 + 1) * T * 256; const ab::bf16* av = (const ab::bf16*)AQKV + (size_t)(g * 3 + 2) * T * 256;
                ab::Job J; J.Q = aq + (cbase + i0) * 256 + hs * 64; J.K = ak + (cbase + t0 * 64) * 256 + hs * 64; J.V = av + (cbase + t0 * 64) * 256 + hs * 64;
                J.O = (ab::bf16*)OAG + (size_t)g * T * 256 + (size_t)b * SEQ * 256 + hs * 64; J.lse = LSE + (size_t)g * T * 4 + (size_t)b * SEQ * 4 + hs; J.lutg = BLUT + (g * 4 + hs) * 768;
                J.NT = NT; J.i0 = i0; J.kq0 = t0 * 64 - i0; J.dsh = dsh; J.cls = cls;
                ab::attn_unit<1, 8>(J, (char*)lds, wave);
            }
        }
        if (VK(3)) SEAM(P + 1);
        if (KIND(4) && IN(P + 2) && VK(4)) { PH_BEGIN();
            for (int i = gtid; i < T * 32; i += NGT) { const int t = i >> 5, ch = i & 31, hs = ch >> 3;
                const float l0 = LSE[(size_t)t * 4 + hs], l1 = LSE[(size_t)T * 4 + (size_t)t * 4 + hs], l2 = LSE[(size_t)2 * T * 4 + (size_t)t * 4 + hs];
                const float mx = fmaxf(l0, fmaxf(l1, l2)); float w0 = exp2f(l0 - mx), w1 = exp2f(l1 - mx), w2 = exp2f(l2 - mx); const float inv = 1.0f / (w0 + w1 + w2); w0 *= inv; w1 *= inv; w2 *= inv;
                const v4u a = *(const GAS v4u*)(OAG + (size_t)t * 256 + ch * 8), bq = *(const GAS v4u*)(OAG + (size_t)T * 256 + (size_t)t * 256 + ch * 8), cq = *(const GAS v4u*)(OAG + (size_t)2 * T * 256 + (size_t)t * 256 + ch * 8);
                v4u o;
                o.x = pk2(w0 * bfl(a.x) + w1 * bfl(bq.x) + w2 * bfl(cq.x), w0 * bfh(a.x) + w1 * bfh(bq.x) + w2 * bfh(cq.x));
                o.y = pk2(w0 * bfl(a.y) + w1 * bfl(bq.y) + w2 * bfl(cq.y), w0 * bfh(a.y) + w1 * bfh(bq.y) + w2 * bfh(cq.y));
                o.z = pk2(w0 * bfl(a.z) + w1 * bfl(bq.z) + w2 * bfl(cq.z), w0 * bfh(a.z) + w1 * bfh(bq.z) + w2 * bfh(cq.z));
                o.w = pk2(w0 * bfl(a.w) + w1 * bfl(bq.w) + w2 * bfl(cq.w), w0 * bfh(a.w) + w1 * bfh(bq.w) + w2 * bfh(cq.w));
                *(GAS v4u*)(OA + (size_t)t * 256 + ch * 8) = o; }
        }
        if (VK(4)) SEAM(P + 2);
        if (KIND(5) && IN(P + 3) && VK(5)) { PH_BEGIN();
            pg8::StaticOrder S; S.init(T, D, G, bx);
            { pg8::Gemm g{OA, WBRA + (size_t)l * D * 256, 256}; pg8::EpiMergeA E{GATE, MERGED}; pg8::gemm_phase<pg8::EpiMergeA, pg8::StaticOrder>(L, g, S, E, wave); }
            { pg8::Gemm g{OB, WBRB + (size_t)l * D * D, D}; pg8::EpiMergeB E{GATE, MERGED}; pg8::gemm_phase<pg8::EpiMergeB, pg8::StaticOrder>(L, g, S, E, wave); }
        }
        if (VK(5)) SEAM(P + 3);
        if (KIND(6) && IN(P + 4) && VK(6)) { PH_BEGIN();
            pg8::Gemm g{MERGED, WOUT + (size_t)l * D * D, D}; pg8::StaticOrder S; S.init(T, D, G, bx);
            pg8::EpiOut E{l == 0 ? x_in : X, X, MOD + (size_t)l * NB * 6144 + 2 * 1024};
            pg8::gemm_phase<pg8::EpiOut, pg8::StaticOrder>(L, g, S, E, wave);
        }
        if (VK(6)) SEAM(P + 4);
        if (KIND(7) && IN(P + 5) && VK(7)) { PH_BEGIN();
            LAS int* hist = (LAS int*)(L + LDSCTL_OFF + 256);
            for (int vb = bx; vb < 256; vb += G) {
                if (tid < NE) hist[tid] = 0;
                __syncthreads();
                {
                    const int tt = vb + 256 * wave; const int r0 = tt * 16; const int b = r0 >> 12; const int i = lane & 15, kb = lane >> 4;
                    const float* xp = X + (size_t)(r0 + i) * D + 8 * kb;
                    const bf16* bh = WRHI + ((size_t)(l * NB + b) * NE + i) * D + 8 * kb; const bf16* bl = WRLO + ((size_t)(l * NB + b) * NE + i) * D + 8 * kb;
                    f32x4 acc0 = (f32x4){0.f, 0.f, 0.f, 0.f}, acc1 = acc0; float ss = 0.f;
#pragma unroll 4
                    for (int s = 0; s < 32; ++s) {
                        const f32x4 x0 = *(const GAS f32x4*)(xp + 32 * s), x1 = *(const GAS f32x4*)(xp + 32 * s + 4);
                        const bf16x8 wh0 = *(const GAS bf16x8*)(bh + 32 * s), wh1 = *(const GAS bf16x8*)(bh + 16 * D + 32 * s), wl0 = *(const GAS bf16x8*)(bl + 32 * s), wl1 = *(const GAS bf16x8*)(bl + 16 * D + 32 * s);
                        ss += (x0.x * x0.x + x0.y * x0.y) + (x0.z * x0.z + x0.w * x0.w) + (x1.x * x1.x + x1.y * x1.y) + (x1.z * x1.z + x1.w * x1.w);
                        v4u ah, al;
                        { const unsigned h0 = f2bf(x0.x), h1 = f2bf(x0.y), h2 = f2bf(x0.z), h3 = f2bf(x0.w), h4 = f2bf(x1.x), h5 = f2bf(x1.y), h6 = f2bf(x1.z), h7 = f2bf(x1.w);
                          ah.x = h0 | (h1 << 16); ah.y = h2 | (h3 << 16); ah.z = h4 | (h5 << 16); ah.w = h6 | (h7 << 16);
                          al.x = pk2(x0.x - __uint_as_float(h0 << 16), x0.y - __uint_as_float(h1 << 16)); al.y = pk2(x0.z - __uint_as_float(h2 << 16), x0.w - __uint_as_float(h3 << 16));
                          al.z = pk2(x1.x - __uint_as_float(h4 << 16), x1.y - __uint_as_float(h5 << 16)); al.w = pk2(x1.z - __uint_as_float(h6 << 16), x1.w - __uint_as_float(h7 << 16)); }
                        const bf16x8 ahv = __builtin_bit_cast(bf16x8, ah), alv = __builtin_bit_cast(bf16x8, al);
                        acc0 = __builtin_amdgcn_mfma_f32_16x16x32_bf16(wh0, ahv, acc0, 0, 0, 0); acc1 = __builtin_amdgcn_mfma_f32_16x16x32_bf16(wh1, ahv, acc1, 0, 0, 0);
                        acc0 = __builtin_amdgcn_mfma_f32_16x16x32_bf16(wl0, ahv, acc0, 0, 0, 0); acc1 = __builtin_amdgcn_mfma_f32_16x16x32_bf16(wl1, ahv, acc1, 0, 0, 0);
                        acc0 = __builtin_amdgcn_mfma_f32_16x16x32_bf16(wh0, alv, acc0, 0, 0, 0); acc1 = __builtin_amdgcn_mfma_f32_16x16x32_bf16(wh1, alv, acc1, 0, 0, 0);
                    }
                    ss = xsum<16>(ss); ss = xsum<32>(ss);
                    const float rs = rsqrtf(ss * (1.0f / D) + EPS);
                    float v[8]; const float* rc = RC0 + (l * NB + b) * NE;
#pragma unroll
                    for (int r = 0; r < 4; ++r) { v[r] = rs * acc0[r] + rc[4 * kb + r]; v[4 + r] = rs * acc1[r] + rc[16 + 4 * kb + r]; }
                    float tv[4]; int ti[4];
#pragma unroll
                    for (int k = 0; k < 4; ++k) { float best = v[0]; int br = 0;
#pragma unroll
                        for (int r = 1; r < 8; ++r) if (v[r] > best) { best = v[r]; br = r; }
#pragma unroll
                        for (int r = 0; r < 8; ++r) v[r] = (r == br) ? -INFINITY : v[r];
                        tv[k] = best; ti[k] = (br & 3) + 16 * (br >> 2) + 4 * kb; }
#pragma unroll
                    for (int round = 0; round < 2; ++round) {
                        float bv[8]; int bi[8];
#pragma unroll
                        for (int k = 0; k < 4; ++k) { bv[k] = tv[k]; bi[k] = ti[k];
                            if (round == 0) { bv[4 + k] = __int_as_float(__builtin_amdgcn_ds_swizzle(__float_as_int(tv[k]), 0x1f | (16 << 10))); bi[4 + k] = __builtin_amdgcn_ds_swizzle(ti[k], 0x1f | (16 << 10)); }
                            else { bv[4 + k] = xget32(tv[k], lane >> 5); bi[4 + k] = xget32(ti[k], lane >> 5); } }
#pragma unroll
                        for (int k = 0; k < 4; ++k) { float best = bv[0]; int bq = 0;
#pragma unroll
                            for (int r = 1; r < 8; ++r) if (bv[r] > best || (bv[r] == best && bi[r] < bi[bq])) { best = bv[r]; bq = r; }
                            int sel = bi[0];
#pragma unroll
                            for (int r = 0; r < 8; ++r) { if (r == bq) sel = bi[r]; }
#pragma unroll
                            for (int r = 0; r < 8; ++r) bv[r] = (r == bq) ? -INFINITY : bv[r];
                            tv[k] = best; ti[k] = sel; }
                    }
                    if (kb == 0) {
                        const float e1 = __expf(tv[1] - tv[0]), e2 = __expf(tv[2] - tv[0]), e3 = __expf(tv[3] - tv[0]); const float inv = 1.0f / (1.0f + e1 + e2 + e3);
                        const int tok = r0 + i;
                        *(GAS i32x4*)(TOPE + (size_t)tok * 4) = (i32x4){ti[0], ti[1], ti[2], ti[3]};
                        *(GAS f32x4*)(TOPW + (size_t)tok * 4) = (f32x4){inv, e1 * inv, e2 * inv, e3 * inv};
#pragma unroll
                        for (int k = 0; k < 4; ++k) atomicAdd((int*)&hist[ti[k]], 1);
                    }
                }
                __syncthreads();
                if (tid < NE) HIST[vb * NE + tid] = hist[tid];
                __syncthreads();
            }
            for (int m = 2 * gw; m < T; m += 2 * NGW) { const int b = m >> 12; const float* md = MOD + ((size_t)l * NB + b) * 6144;
                norm_rows2_f8(X + (size_t)m * D, norm2_g + l * D, md + 4 * 1024, md + 3 * 1024, (unsigned char*)H + (size_t)m * D, lane); }
        }
        if (VK(7)) SEAM(P + 5);
        if (KIND(8) && IN(P + 6) && VK(8)) { PH_BEGIN();
            LAS int* sm = (LAS int*)L;
            for (int vb = bx; vb < 256; vb += G) {
                { const int e = tid & 31, seg = tid >> 5; int tot = 0, bef = 0;
                    for (int q = seg * 16; q < seg * 16 + 16; ++q) { const int hv = HIST[q * NE + e]; tot += hv; if (q < vb) bef += hv; }
                    sm[tid] = tot; sm[512 + tid] = bef; }
                __syncthreads();
                if (tid < NE) { int tot = 0, bef = 0;
                    for (int s = 0; s < 16; ++s) { tot += sm[s * 32 + tid]; bef += sm[512 + s * 32 + tid]; }
                    sm[1024 + tid] = bef; sm[1056 + tid] = (tot + 255) & ~255; }
                __syncthreads();
                if (tid == 0) { int run = 0; for (int e = 0; e < NE; ++e) { const int pd = sm[1056 + e]; sm[1056 + e] = run; sm[1024 + e] += run;
                        if (vb == 0) { for (int q = run >> 8; q < (run + pd) >> 8; ++q) TILEE[q] = e; }
                        run += pd; }
                    if (vb == 0) TILEE[1000] = run >> 8; }
                __syncthreads();
                if (tid < 128) { const int tt = vb + 256 * (tid >> 4); const int tok = tt * 16 + (tid & 15);
                    const i32x4 te = *(const GAS i32x4*)(TOPE + (size_t)tok * 4); const f32x4 tw = *(const GAS f32x4*)(TOPW + (size_t)tok * 4);
                    const int s0 = atomicAdd((int*)&sm[1024 + te.x], 1), s1 = atomicAdd((int*)&sm[1024 + te.y], 1), s2 = atomicAdd((int*)&sm[1024 + te.z], 1), s3 = atomicAdd((int*)&sm[1024 + te.w], 1);
                    *(GAS i32x4*)(SLOT + (size_t)tok * 4) = (i32x4){s0, s1, s2, s3};
                    ROWW[s0] = tw.x; ROWW[s1] = tw.y; ROWW[s2] = tw.z; ROWW[s3] = tw.w;
                    sm[2048 + tid * 4 + 0] = s0; sm[2048 + tid * 4 + 1] = s1; sm[2048 + tid * 4 + 2] = s2; sm[2048 + tid * 4 + 3] = s3; }
                __syncthreads();
                for (int p = wave; p < 512; p += NWAVES) { const int q = p >> 2; const int tt = vb + 256 * (q >> 4); const int tok = tt * 16 + (q & 15); const int slot = sm[2048 + p];
                    const GAS v4u* src = (const GAS v4u*)((unsigned char*)H + (size_t)tok * D); GAS v4u* dst = (GAS v4u*)(XS + (size_t)slot * D);
                    dst[lane] = src[lane]; }
                __syncthreads();
            }
        }
        if (VK(8)) SEAM(P + 6);
        if (KIND(9) && IN(P + 7) && VK(9)) { PH_BEGIN();
            const int nmt = __builtin_amdgcn_readfirstlane(__hip_atomic_load(TILEE + 1000, __ATOMIC_RELAXED, __HIP_MEMORY_SCOPE_AGENT));
            pg8::Gemm g{(const bf16*)XS, (const bf16*)(WGU + (size_t)l * NE * 2048 * D), D / 2}; pg8::MoeOrder S{TILEE, nmt * 8, 8, G, vcu};
            pg8::EpiGU8 E{b_gate_up + (size_t)l * NE * 2048, ACT};
            pg8::gemm_phase_f8<pg8::EpiGU8, pg8::MoeOrder>(L, g, S, E, wave);
        }
        if (VK(9)) SEAM(P + 7);
        if (KIND(10) && IN(P + 8) && VK(10)) { PH_BEGIN();
            const int nmt = __builtin_amdgcn_readfirstlane(__hip_atomic_load(TILEE + 1000, __ATOMIC_RELAXED, __HIP_MEMORY_SCOPE_AGENT));
            pg8::Gemm g{(const bf16*)ACT, (const bf16*)(WDN + (size_t)l * NE * D * D), D / 2}; pg8::MoeOrder S{TILEE, nmt * 4, 4, G, vcu};
            pg8::EpiDN8 E{b_down + (size_t)l * NE * D, ROWW, YB};
            pg8::gemm_phase_f8<pg8::EpiDN8, pg8::MoeOrder>(L, g, S, E, wave);
        }
        if (VK(10)) SEAM(P + 8);
        if (KIND(11) && IN(P + 9) && VK(11)) { PH_BEGIN();
            const bool lastl = (l == DEPTH - 1);
            float* Xw = virt ? (float*)(ws + WS_R) : X; bf16* Hw = virt ? (bf16*)(ws + WS_R + 128 * MiB) : H;
            for (int m0 = 2 * gw; m0 < T; m0 += 2 * NGW) { const int b = m0 >> 12;
                i32x4 sl[2];
#pragma unroll
                for (int q = 0; q < 2; ++q) { const int* sp = SLOT + (size_t)(m0 + q) * 4;
                    sl[q].x = __hip_atomic_load(sp + 0, RLX_AGENT); sl[q].y = __hip_atomic_load(sp + 1, RLX_AGENT); sl[q].z = __hip_atomic_load(sp + 2, RLX_AGENT); sl[q].w = __hip_atomic_load(sp + 3, RLX_AGENT); }
                const float* g2 = MOD + ((size_t)l * NB + b) * 6144 + 5 * 1024;
                f32x4 v[2][4]; v2u yy[2][4][4];
#pragma unroll
                for (int q = 0; q < 2; ++q)
#pragma unroll
                    for (int j = 0; j < 4; ++j) { const int c = 256 * j + 4 * lane;
                        v[q][j] = *(const GAS f32x4*)(X + (size_t)(m0 + q) * D + c);
                        yy[q][j][0] = *(const GAS v2u*)(YB + (size_t)sl[q].x * D + c); yy[q][j][1] = *(const GAS v2u*)(YB + (size_t)sl[q].y * D + c);
                        yy[q][j][2] = *(const GAS v2u*)(YB + (size_t)sl[q].z * D + c); yy[q][j][3] = *(const GAS v2u*)(YB + (size_t)sl[q].w * D + c); }
                float s[2] = {0.f, 0.f};
#pragma unroll
                for (int q = 0; q < 2; ++q)
#pragma unroll
                    for (int j = 0; j < 4; ++j) { const int c = 256 * j + 4 * lane; const v2u y0 = yy[q][j][0], y1 = yy[q][j][1], y2 = yy[q][j][2], y3 = yy[q][j][3];
                        f32x4 ys; ys.x = (bfl(y0.x) + bfl(y1.x)) + (bfl(y2.x) + bfl(y3.x)); ys.y = (bfh(y0.x) + bfh(y1.x)) + (bfh(y2.x) + bfh(y3.x));
                        ys.z = (bfl(y0.y) + bfl(y1.y)) + (bfl(y2.y) + bfl(y3.y)); ys.w = (bfh(y0.y) + bfh(y1.y)) + (bfh(y2.y) + bfh(y3.y));
                        const f32x4 gg = *(const GAS f32x4*)(g2 + c);
                        v[q][j] = v[q][j] + gg * ys;
                        if (!lastl) *(GAS f32x4*)(Xw + (size_t)(m0 + q) * D + c) = v[q][j];
                        s[q] += (v[q][j].x * v[q][j].x + v[q][j].y * v[q][j].y) + (v[q][j].z * v[q][j].z + v[q][j].w * v[q][j].w); }
                const float rs0 = rsqrtf(wave_sum(s[0]) * (1.0f / D) + EPS), rs1 = rsqrtf(wave_sum(s[1]) * (1.0f / D) + EPS);
                if (!lastl) { const float* md = MOD + ((size_t)(l + 1) * NB + b) * 6144; const float* gn = norm1_g + (l + 1) * D;
#pragma unroll
                    for (int j = 0; j < 4; ++j) { const int c = 256 * j + 4 * lane;
                        const f32x4 gg = *(const GAS f32x4*)(gn + c), a1 = *(const GAS f32x4*)(md + 1024 + c) + 1.0f, a0 = *(const GAS f32x4*)(md + c);
                        const f32x4 y0 = (v[0][j] * rs0 * gg) * a1 + a0, y1 = (v[1][j] * rs1 * gg) * a1 + a0;
                        unsigned w0 = 0, w1 = 0;
                        w0 = __builtin_amdgcn_cvt_pk_fp8_f32(y0.x, y0.y, w0, false); w0 = __builtin_amdgcn_cvt_pk_fp8_f32(y0.z, y0.w, w0, true);
                        w1 = __builtin_amdgcn_cvt_pk_fp8_f32(y1.x, y1.y, w1, false); w1 = __builtin_amdgcn_cvt_pk_fp8_f32(y1.z, y1.w, w1, true);
                        *(GAS unsigned*)((unsigned char*)Hw + (size_t)m0 * D + c) = w0; *(GAS unsigned*)((unsigned char*)Hw + (size_t)(m0 + 1) * D + c) = w1; }
                } else {
#pragma unroll
                    for (int j = 0; j < 4; ++j) { const int c = 256 * j + 4 * lane; const f32x4 gg = *(const GAS f32x4*)(final_g + c);
                        *(GAS f32x4*)(ap->out + (size_t)m0 * D + c) = v[0][j] * rs0 * gg; *(GAS f32x4*)(ap->out + (size_t)(m0 + 1) * D + c) = v[1][j] * rs1 * gg; }
                }
            }
        }
        if (VK(11)) SEAM(P + 9);
        if (virt) { PH_BEGIN();
            for (int m = 2 * gw; m < T; m += 2 * NGW) { const int b = m >> 12; const float* md = MOD + (size_t)b * 6144; norm_rows2_f8(x_in + (size_t)m * D, norm1_g, md + 1024, md, (unsigned char*)H + (size_t)m * D, lane); }
            xcd_barrier(bar); }
    }
#undef IN
#undef SEAM
}

extern "C" void kernel_launch(void* const* d_in, const int* in_sizes, int n_in, void* d_out, int out_size, void* d_ws, size_t ws_size, hipStream_t stream) {
    static int grid = 0;
    if (grid == 0) {
        if (n_in != 20 || in_sizes[0] != T * D || out_size != T * D || ws_size < WS_END) { fprintf(stderr, "kernel_launch: unexpected shapes (n_in %d, in0 %d, out %d, ws %zu < %zu); nothing launched\n", n_in, n_in > 0 ? in_sizes[0] : -1, out_size, ws_size, (size_t)WS_END); grid = -1; return; }
        int dev = 0, cus = 0, per_cu = 0;
        if (hipGetDevice(&dev) != hipSuccess || hipDeviceGetAttribute(&cus, hipDeviceAttributeMultiprocessorCount, dev) != hipSuccess) { grid = -1; return; }
        if (hipFuncSetAttribute((const void*)mk_fwd, hipFuncAttributeMaxDynamicSharedMemorySize, LDS_BYTES) != hipSuccess) { fprintf(stderr, "kernel_launch: hipFuncSetAttribute failed\n"); grid = -1; return; }
        if (hipOccupancyMaxActiveBlocksPerMultiprocessor(&per_cu, (const void*)mk_fwd, NWAVES * 64, LDS_BYTES) != hipSuccess || per_cu < 1)
            fprintf(stderr, "kernel_launch: note: occupancy query reports %d workgroups per CU\n", per_cu);
        (void)hipGetLastError();
        grid = cus < 256 ? cus : 256;
        if (grid != 256) fprintf(stderr, "kernel_launch: %d CUs; this kernel's unit deals assume 256\n", grid);
    }
    if (grid < 0) return;
    if (hipMemsetAsync((char*)d_ws + WS_CTL, 0, CTL_ZERO_BYTES, stream) != hipSuccess) { fprintf(stderr, "kernel_launch: memset failed\n"); return; }
    Args a{};
    for (int i = 0; i < 20; ++i) a.in[i] = (const float*)d_in[i];
    a.out = (float*)d_out; a.ws = (unsigned char*)d_ws; a.pad = 0;
#if MK_PER_PHASE
    for (int p = 0; p < N_PHASES; ++p) { a.ph_lo = p; a.ph_hi = p + 1; a.li = 0; hipLaunchKernelGGL(mk_fwd, dim3(grid), dim3(NWAVES * 64), LDS_BYTES, stream, a); }
#else
    a.ph_lo = 0; a.ph_hi = N_PHASES; a.li = 0;
    hipLaunchKernelGGL(mk_fwd, dim3(grid), dim3(NWAVES * 64), LDS_BYTES, stream, a);
#endif
    const hipError_t le = hipPeekAtLastError();
    if (le != hipSuccess) fprintf(stderr, "kernel_launch: launch failed: %s\n", hipGetErrorName(le));
}
```

```cpp
#include <hip/hip_runtime.h>
#include <hip/hip_bf16.h>
#include <cstdio>
#include <cstdint>
#include <cmath>

#ifndef PH_KIND_MASK
#define PH_KIND_MASK 0xFFF
#endif
#ifndef PROBE_MASK
#define PROBE_MASK 0
#endif
#ifndef PROBE_P0
#define PROBE_P0 0
#endif
#ifndef MK_PER_PHASE
#define MK_PER_PHASE 0
#endif

constexpr int NB = 8, SEQ = 4096, T = NB * SEQ, D = 1024, DEPTH = 2;
constexpr int N_IN = 5888, NE = 32, TOPK = 4;
constexpr int NASSIGN = T * TOPK;
constexpr int MAX_MT = NASSIGN / 256 + NE;
constexpr int CAP_ROWS = MAX_MT * 256;
constexpr float C2 = 0.125f * 1.4426950408889634f;
constexpr float LOG2E = 1.4426950408889634f;
constexpr float EPS = 1e-6f;

__device__ __forceinline__ int lane_id_asm() { int l; asm volatile("v_mbcnt_lo_u32_b32 %0, -1, 0\n\tv_mbcnt_hi_u32_b32 %0, -1, %0" : "=v"(l)); return l; }

template <int M> __device__ __forceinline__ float xsum(float v) {
    if constexpr (M < 32) return v + __int_as_float(__builtin_amdgcn_ds_swizzle(__float_as_int(v), 0x1f | (M << 10)));
    else { auto rr = __builtin_amdgcn_permlane32_swap(__float_as_uint(v), __float_as_uint(v), false, false); return __uint_as_float(rr[0]) + __uint_as_float(rr[1]); }
}
template <class Tv> __device__ __forceinline__ Tv xget32(Tv v, int hf) {
    auto rr = __builtin_amdgcn_permlane32_swap(__builtin_bit_cast(unsigned, v), __builtin_bit_cast(unsigned, v), false, false); return __builtin_bit_cast(Tv, hf ? rr[0] : rr[1]);
}

namespace pg8 {
#define PG8_LAS __attribute__((address_space(3)))
typedef unsigned short bf16_t;
typedef short bf16x8 __attribute__((ext_vector_type(8)));
typedef float f32x4 __attribute__((ext_vector_type(4)));
typedef unsigned u32x4 __attribute__((ext_vector_type(4)));
typedef unsigned u32x2 __attribute__((ext_vector_type(2)));
constexpr int BM = 256, BK = 64, HALF = 128, HTB = HALF * BK * 2, STAGE_BYTES = 8 * HTB, NXCD = 8, WGM = 8;

__host__ __device__ __forceinline__ int lds_byte(int r, int c) { const int st = (r >> 4) * 2 + (c >> 5), rr = r & 15, cc = c & 31, ob = rr * 64 + cc * 2; return st * 1024 + (ob ^ (((ob >> 9) & 1) << 5)); }
__host__ __device__ __forceinline__ void stage_rc(int b, int& R, int& C) { const int st = b / 1024, sb = b % 1024, swz = sb ^ (((sb >> 9) & 1) << 5); R = (st >> 1) * 16 + swz / 64; C = (st & 1) * 32 + (swz % 64) / 2; }
__host__ __device__ __forceinline__ int perm32(int rho) { const int n = rho >> 4, i = rho & 15; return 8 * (i >> 2) + 4 * n + (i & 3); }

struct Unit { int pm, pn; };
struct Gemm { const bf16_t* A; const bf16_t* Bt; int K; };

struct StaticOrder {
    int nM, nN, nwg, G, c;
    __device__ void init(int M, int N, int G_, int c_) { nM = M / BM; nN = N / BM; nwg = nM * nN; G = G_; c = c_; }
    __device__ bool next(int i, Unit& u) const {
        const long L = (long)i * G + c; if (L >= nwg) return false;
        int wgid = (int)L; { const int q = nwg / NXCD, r = nwg % NXCD, xcd = wgid % NXCD, off = wgid / NXCD; wgid = (xcd < r ? xcd * (q + 1) : r * (q + 1) + (xcd - r) * q) + off; }
        const int nig = WGM * nN, gid = wgid / nig, fm = gid * WGM, gsz = (nM - fm) < WGM ? (nM - fm) : WGM;
        u.pm = fm + ((wgid % nig) % gsz); u.pn = (wgid % nig) / gsz; return true;
    }
};
struct MoeOrder {
    const int* tile_e; int n_units, nN, G, vcu;
    __device__ bool next(int i, Unit& u) const {
        const long L = (long)i * G + vcu; if (L >= n_units) return false;
        const int mt = (int)L / nN, pl = (int)L % nN; const int e = __builtin_amdgcn_readfirstlane(__hip_atomic_load(tile_e + mt, __ATOMIC_RELAXED, __HIP_MEMORY_SCOPE_AGENT));
        u.pm = mt; u.pn = e * nN + pl; return true;
    }
};

__device__ __forceinline__ unsigned cvt_pk_bf16(float lo, float hi) { unsigned r; asm volatile("v_cvt_pk_bf16_f32 %0, %1, %2" : "=v"(r) : "v"(lo), "v"(hi)); return r; }
__device__ __forceinline__ float bf_lo(unsigned w) { return __uint_as_float(w << 16); }
__device__ __forceinline__ float bf_hi(unsigned w) { return __uint_as_float(w & 0xffff0000u); }
__device__ __forceinline__ float sigmoid_f(float x) { return __builtin_amdgcn_rcpf(1.0f + __builtin_amdgcn_exp2f(-LOG2E * x)); }

template <class Epi, class Sched>
__device__ __forceinline__ void gemm_phase(PG8_LAS unsigned char* lds, const Gemm g, const Sched& S, const Epi& E, const int wid_in) {
    int wid = wid_in; asm volatile("" : "+s"(wid));
    const int lane = lane_id_asm(), tid = wid * 64 + lane, wr = wid >> 2, wc = wid & 3, fr = lane & 15, fq = lane >> 4;
    int K_o = g.K; asm volatile("" : "+s"(K_o)); const int K = K_o, nt = K / BK;
    unsigned voff[2];
#pragma unroll
    for (int i = 0; i < 2; ++i) { int R, C; stage_rc(tid * 16 + i * 8192, R, C); voff[i] = (unsigned)(R * K + C) * 2u; }
    const size_t kstep = (size_t)(BK * 2);
    const size_t hstep = (size_t)HALF * K * 2;
    const size_t tstep = 2 * hstep;
    const unsigned ldsw = (unsigned)wid * 1024u;
    const int aoff = lds_byte(wr * 64 + fr, fq * 8), boff = lds_byte(wc * 32 + fr, fq * 8);
#define PG8_SA(b, h) (((b) * 2 + (h)) * HTB)
#define PG8_SB(b, h) ((4 + (b) * 2 + (h)) * HTB)
#define PG8_STAGE(bufoff, gbase) do { _Pragma("unroll") for (int _i = 0; _i < 2; ++_i) \
        __builtin_amdgcn_global_load_lds((const unsigned*)((const char*)(gbase) + voff[_i]), (PG8_LAS unsigned*)(lds + (bufoff) + ldsw + _i * 8192), 16, 0, 0); } while (0)
#define PG8_LDA(dst, b, h) do { _Pragma("unroll") for (int m = 0; m < 4; ++m) _Pragma("unroll") for (int k = 0; k < 2; ++k) dst[m][k] = *(const PG8_LAS bf16x8*)(lds + PG8_SA(b, h) + aoff + m * 2048 + k * 1024); } while (0)
#define PG8_LDB(dst, b, h) do { _Pragma("unroll") for (int n = 0; n < 2; ++n) _Pragma("unroll") for (int k = 0; k < 2; ++k) dst[n][k] = *(const PG8_LAS bf16x8*)(lds + PG8_SB(b, h) + boff + n * 2048 + k * 1024); } while (0)
#define PG8_MMA(ai, bj, At, Bt) do { __builtin_amdgcn_s_setprio(1); _Pragma("unroll") for (int m = 0; m < 4; ++m) _Pragma("unroll") for (int n = 0; n < 2; ++n) _Pragma("unroll") for (int k = 0; k < 2; ++k) \
        acc[ai][bj][m][n] = __builtin_amdgcn_mfma_f32_16x16x32_bf16(Bt[n][k], At[m][k], acc[ai][bj][m][n], 0, 0, 0); __builtin_amdgcn_s_setprio(0); } while (0)
#define PG8_WAIT_V(n) asm volatile("s_waitcnt vmcnt(" #n ")" ::: "memory")
#define PG8_WAIT_L(n) asm volatile("s_waitcnt lgkmcnt(" #n ")" ::: "memory")
#define PG8_BAR __builtin_amdgcn_s_barrier()
#define PG8_SCHED __builtin_amdgcn_sched_barrier(0)
    Unit cur, nxt; int ui = 0;
    if (!S.next(0, cur)) return;
    f32x4 acc[2][2][4][2];
#pragma unroll
    for (int a = 0; a < 2; ++a)
#pragma unroll
        for (int b = 0; b < 2; ++b)
#pragma unroll
            for (int m = 0; m < 4; ++m)
#pragma unroll
                for (int n = 0; n < 2; ++n) acc[a][b][m][n] = (f32x4){0.f, 0.f, 0.f, 0.f};
    bf16x8 At[4][2], B0[2][2], B1[2][2];
    const char* cA = (const char*)g.A + (size_t)cur.pm * tstep; const char* cB = (const char*)g.Bt + (size_t)cur.pn * tstep;
    PG8_STAGE(PG8_SB(0, 0), cB); PG8_STAGE(PG8_SB(0, 1), cB + hstep); PG8_STAGE(PG8_SA(0, 0), cA); PG8_STAGE(PG8_SA(0, 1), cA + hstep);
    if (wr == 1) PG8_BAR;
    PG8_WAIT_V(2); PG8_BAR;
    PG8_STAGE(PG8_SB(1, 0), cB + kstep); PG8_STAGE(PG8_SA(1, 0), cA + kstep); PG8_STAGE(PG8_SB(1, 1), cB + hstep + kstep);
    PG8_WAIT_V(6); PG8_BAR;
    for (;;) {
        const bool has_next = S.next(ui + 1, nxt);
        const char* nA = has_next ? (const char*)g.A + (size_t)nxt.pm * tstep : cA; const char* nB = has_next ? (const char*)g.Bt + (size_t)nxt.pn * tstep : cB;
        for (int t = 0; t < nt; t += 2) {
            const bool last = (t == nt - 2);
            const char* a1 = cA + (size_t)(t + 1) * kstep;
            const char* a2 = last ? nA : cA + (size_t)(t + 2) * kstep; const char* b2 = last ? nB : cB + (size_t)(t + 2) * kstep;
            const char* a3 = a2 + kstep; const char* b3 = b2 + kstep;
            PG8_LDB(B0, 0, 0); PG8_LDB(B1, 0, 1); PG8_SCHED; PG8_LDA(At, 0, 0); PG8_STAGE(PG8_SA(1, 1), a1 + hstep);
            PG8_WAIT_V(8); PG8_WAIT_L(0); PG8_BAR; PG8_MMA(0, 0, At, B0); PG8_MMA(0, 1, At, B1); PG8_BAR; PG8_SCHED;
            PG8_LDA(At, 0, 1); PG8_STAGE(PG8_SB(0, 0), b2); PG8_STAGE(PG8_SB(0, 1), b2 + hstep); PG8_STAGE(PG8_SA(0, 0), a2);
            PG8_WAIT_V(8); PG8_WAIT_L(0); PG8_BAR; PG8_MMA(1, 0, At, B0); PG8_MMA(1, 1, At, B1); PG8_BAR; PG8_SCHED;
            PG8_LDB(B0, 1, 0); PG8_LDB(B1, 1, 1); PG8_SCHED; PG8_LDA(At, 1, 0); PG8_STAGE(PG8_SA(0, 1), a2 + hstep);
            PG8_WAIT_V(8); PG8_WAIT_L(0); PG8_BAR; PG8_MMA(0, 0, At, B0); PG8_MMA(0, 1, At, B1); PG8_BAR; PG8_SCHED;
            PG8_LDA(At, 1, 1); PG8_STAGE(PG8_SB(1, 0), b3); PG8_STAGE(PG8_SB(1, 1), b3 + hstep); PG8_STAGE(PG8_SA(1, 0), a3);
            PG8_WAIT_V(8); PG8_WAIT_L(0); PG8_BAR; PG8_MMA(1, 0, At, B0); PG8_MMA(1, 1, At, B1); PG8_BAR; PG8_SCHED;
        }
        if (wr == 0) PG8_BAR;
        E(acc, cur, wr, wc, fr, fq);
        if (!has_next) break;
#pragma unroll
        for (int a = 0; a < 2; ++a)
#pragma unroll
            for (int b = 0; b < 2; ++b)
#pragma unroll
                for (int m = 0; m < 4; ++m)
#pragma unroll
                    for (int n = 0; n < 2; ++n) acc[a][b][m][n] = (f32x4){0.f, 0.f, 0.f, 0.f};
        cur = nxt; cA = nA; cB = nB; ++ui;
        if (wr == 1) PG8_BAR;
    }
    PG8_WAIT_V(0);
    PG8_BAR;
#undef PG8_SA
#undef PG8_SB
#undef PG8_STAGE
#undef PG8_LDA
#undef PG8_LDB
#undef PG8_MMA
#undef PG8_WAIT_V
#undef PG8_WAIT_L
#undef PG8_BAR
#undef PG8_SCHED
}

typedef int i32x4_t __attribute__((ext_vector_type(4)));
template <class Epi, class Sched>
__device__ __forceinline__ void gemm_phase_f8(PG8_LAS unsigned char* lds, const Gemm g, const Sched& S, const Epi& E, const int wid_in) {
    int wid = wid_in; asm volatile("" : "+s"(wid));
    const int lane = lane_id_asm(), tid = wid * 64 + lane, wr = wid >> 2, wc = wid & 3, fr = lane & 15, fq = lane >> 4;
    int K_o = g.K; asm volatile("" : "+s"(K_o)); const int K = K_o, nt = K / BK;
    unsigned voff[2];
#pragma unroll
    for (int i = 0; i < 2; ++i) { int R, C; stage_rc(tid * 16 + i * 8192, R, C); voff[i] = (unsigned)(R * K + C) * 2u; }
    const size_t kstep = (size_t)(BK * 2);
    const size_t hstep = (size_t)HALF * K * 2;
    const size_t tstep = 2 * hstep;
    const unsigned ldsw = (unsigned)wid * 1024u;
    const int aoff = lds_byte(wr * 64 + fr, fq * 16), boff = lds_byte(wc * 32 + fr, fq * 16);
#define PG8_SA(b, h) (((b) * 2 + (h)) * HTB)
#define PG8_SB(b, h) ((4 + (b) * 2 + (h)) * HTB)
#define PG8_STAGE(bufoff, gbase) do { _Pragma("unroll") for (int _i = 0; _i < 2; ++_i) \
        __builtin_amdgcn_global_load_lds((const unsigned*)((const char*)(gbase) + voff[_i]), (PG8_LAS unsigned*)(lds + (bufoff) + ldsw + _i * 8192), 16, 0, 0); } while (0)
#define PG8_LDA(dst, b, h) do { _Pragma("unroll") for (int m = 0; m < 4; ++m) _Pragma("unroll") for (int k = 0; k < 2; ++k) dst[m][k] = *(const PG8_LAS bf16x8*)(lds + PG8_SA(b, h) + aoff + m * 2048 + k * 16); } while (0)
#define PG8_LDB(dst, b, h) do { _Pragma("unroll") for (int n = 0; n < 2; ++n) _Pragma("unroll") for (int k = 0; k < 2; ++k) dst[n][k] = *(const PG8_LAS bf16x8*)(lds + PG8_SB(b, h) + boff + n * 2048 + k * 16); } while (0)
#define PG8_F8(x) __builtin_shufflevector(__builtin_bit_cast(i32x4_t, (x)[0]), __builtin_bit_cast(i32x4_t, (x)[1]), 0, 1, 2, 3, 4, 5, 6, 7)
#define PG8_MMA(ai, bj, At, Bt) do { __builtin_amdgcn_s_setprio(1); asm volatile("s_nop 1" ::: ); _Pragma("unroll") for (int m = 0; m < 4; ++m) _Pragma("unroll") for (int n = 0; n < 2; ++n) \
        asm volatile("v_mfma_f32_16x16x128_f8f6f4 %0, %1, %2, %0" : "+v"(acc[ai][bj][m][n]) : "v"(PG8_F8(Bt[n])), "v"(PG8_F8(At[m]))); __builtin_amdgcn_s_setprio(0); } while (0)
#define PG8_ACC_SETTLE asm volatile("s_nop 15\n\ts_nop 15" ::: "memory")
#define PG8_WAIT_V(n) asm volatile("s_waitcnt vmcnt(" #n ")" ::: "memory")
#define PG8_WAIT_L(n) asm volatile("s_waitcnt lgkmcnt(" #n ")" ::: "memory")
#define PG8_BAR __builtin_amdgcn_s_barrier()
#define PG8_SCHED __builtin_amdgcn_sched_barrier(0)
    Unit cur, nxt; int ui = 0;
    if (!S.next(0, cur)) return;
    f32x4 acc[2][2][4][2];
#pragma unroll
    for (int a = 0; a < 2; ++a)
#pragma unroll
        for (int b = 0; b < 2; ++b)
#pragma unroll
            for (int m = 0; m < 4; ++m)
#pragma unroll
                for (int n = 0; n < 2; ++n) acc[a][b][m][n] = (f32x4){0.f, 0.f, 0.f, 0.f};
    bf16x8 At[4][2], B0[2][2], B1[2][2];
    const char* cA = (const char*)g.A + (size_t)cur.pm * tstep; const char* cB = (const char*)g.Bt + (size_t)cur.pn * tstep;
    PG8_STAGE(PG8_SB(0, 0), cB); PG8_STAGE(PG8_SB(0, 1), cB + hstep); PG8_STAGE(PG8_SA(0, 0), cA); PG8_STAGE(PG8_SA(0, 1), cA + hstep);
    if (wr == 1) PG8_BAR;
    PG8_WAIT_V(2); PG8_BAR;
    PG8_STAGE(PG8_SB(1, 0), cB + kstep); PG8_STAGE(PG8_SA(1, 0), cA + kstep); PG8_STAGE(PG8_SB(1, 1), cB + hstep + kstep);
    PG8_WAIT_V(6); PG8_BAR;
    for (;;) {
        const bool has_next = S.next(ui + 1, nxt);
        const char* nA = has_next ? (const char*)g.A + (size_t)nxt.pm * tstep : cA; const char* nB = has_next ? (const char*)g.Bt + (size_t)nxt.pn * tstep : cB;
        for (int t = 0; t < nt; t += 2) {
            const bool last = (t == nt - 2);
            const char* a1 = cA + (size_t)(t + 1) * kstep;
            const char* a2 = last ? nA : cA + (size_t)(t + 2) * kstep; const char* b2 = last ? nB : cB + (size_t)(t + 2) * kstep;
            const char* a3 = a2 + kstep; const char* b3 = b2 + kstep;
            PG8_LDB(B0, 0, 0); PG8_LDB(B1, 0, 1); PG8_SCHED; PG8_LDA(At, 0, 0); PG8_STAGE(PG8_SA(1, 1), a1 + hstep);
            PG8_WAIT_V(8); PG8_WAIT_L(0); PG8_BAR; PG8_MMA(0, 0, At, B0); PG8_MMA(0, 1, At, B1); PG8_BAR; PG8_SCHED;
            PG8_LDA(At, 0, 1); PG8_STAGE(PG8_SB(0, 0), b2); PG8_STAGE(PG8_SB(0, 1), b2 + hstep); PG8_STAGE(PG8_SA(0, 0), a2);
            PG8_WAIT_V(8); PG8_WAIT_L(0); PG8_BAR; PG8_MMA(1, 0, At, B0); PG8_MMA(1, 1, At, B1); PG8_BAR; PG8_SCHED;
            PG8_LDB(B0, 1, 0); PG8_LDB(B1, 1, 1); PG8_SCHED; PG8_LDA(At, 1, 0); PG8_STAGE(PG8_SA(0, 1), a2 + hstep);
            PG8_WAIT_V(8); PG8_WAIT_L(0); PG8_BAR; PG8_MMA(0, 0, At, B0); PG8_MMA(0, 1, At, B1); PG8_BAR; PG8_SCHED;
            PG8_LDA(At, 1, 1); PG8_STAGE(PG8_SB(1, 0), b3); PG8_STAGE(PG8_SB(1, 1), b3 + hstep); PG8_STAGE(PG8_SA(1, 0), a3);
            PG8_WAIT_V(8); PG8_WAIT_L(0); PG8_BAR; PG8_MMA(1, 0, At, B0); PG8_MMA(1, 1, At, B1); PG8_BAR; PG8_SCHED;
        }
        if (wr == 0) PG8_BAR;
        PG8_ACC_SETTLE;
        E(acc, cur, wr, wc, fr, fq);
        if (!has_next) break;
#pragma unroll
        for (int a = 0; a < 2; ++a)
#pragma unroll
            for (int b = 0; b < 2; ++b)
#pragma unroll
                for (int m = 0; m < 4; ++m)
#pragma unroll
                    for (int n = 0; n < 2; ++n) acc[a][b][m][n] = (f32x4){0.f, 0.f, 0.f, 0.f};
        cur = nxt; cA = nA; cB = nB; ++ui;
        if (wr == 1) PG8_BAR;
    }
    PG8_WAIT_V(0);
    PG8_BAR;
#undef PG8_SA
#undef PG8_SB
#undef PG8_STAGE
#undef PG8_LDA
#undef PG8_LDB
#undef PG8_MMA
#undef PG8_F8
#undef PG8_ACC_SETTLE
#undef PG8_WAIT_V
#undef PG8_WAIT_L
#undef PG8_BAR
#undef PG8_SCHED
}

#define EPI_ROWS(...) _Pragma("unroll") for (int ai = 0; ai < 2; ++ai) _Pragma("unroll") for (int m = 0; m < 4; ++m) { const int row = u.pm * BM + ai * HALF + wr * 64 + m * 16 + fr; __VA_ARGS__ }
__device__ __forceinline__ u32x4 pack8(const f32x4 a, const f32x4 b) { u32x4 w; w.x = cvt_pk_bf16(a[0], a[1]); w.y = cvt_pk_bf16(a[2], a[3]); w.z = cvt_pk_bf16(b[0], b[1]); w.w = cvt_pk_bf16(b[2], b[3]); return w; }

__device__ __forceinline__ u32x2 pack8_f8(const f32x4 a, const f32x4 b) { unsigned w0 = 0, w1 = 0;
    w0 = __builtin_amdgcn_cvt_pk_fp8_f32(a[0], a[1], w0, false); w0 = __builtin_amdgcn_cvt_pk_fp8_f32(a[2], a[3], w0, true);
    w1 = __builtin_amdgcn_cvt_pk_fp8_f32(b[0], b[1], w1, false); w1 = __builtin_amdgcn_cvt_pk_fp8_f32(b[2], b[3], w1, true); u32x2 r; r.x = w0; r.y = w1; return r; }
constexpr float W8_SCALE = 64.0f, W8_INV = 1.0f / 64.0f;
struct EpiIn {
    bf16_t* aqkv; bf16_t* qb; bf16_t* kb; bf16_t* vb; bf16_t* gate; const float* qg; const float* kg; const float* rope; float asc;
    __device__ __forceinline__ void operator()(const f32x4 (&acc)[2][2][4][2], const Unit& u, int wr, int wc, int fr, int fq) const {
        const int pn = u.pn;
        if (pn >= 9 && pn < 14) {
            const bool isq = pn < 13; const int head = isq ? (pn - 9) * 4 + wc : wc; bf16_t* dst = isq ? qb : kb; const int pitch = isq ? 1024 : 256;
            const float* gvec = isq ? qg : kg; const float osc = isq ? C2 : 1.0f;
            f32x4 gv[2][2];
#pragma unroll
            for (int bj = 0; bj < 2; ++bj)
#pragma unroll
                for (int n = 0; n < 2; ++n) gv[bj][n] = *(const f32x4*)(gvec + 32 * bj + 16 * n + 4 * fq);
            EPI_ROWS(
                float ss = 0.f;
                _Pragma("unroll") for (int bj = 0; bj < 2; ++bj) _Pragma("unroll") for (int n = 0; n < 2; ++n) { const f32x4 x = acc[ai][bj][m][n] * asc; ss += (x[0] * x[0] + x[1] * x[1]) + (x[2] * x[2] + x[3] * x[3]); }
                ss = xsum<16>(ss); ss = xsum<32>(ss);
                const float sc = rsqrtf(ss * (1.0f / 64.0f) + EPS) * osc * asc;
                const int t = row & (SEQ - 1);
                _Pragma("unroll") for (int bj = 0; bj < 2; ++bj) {
                    const int pos = bj == 0 ? (t >> 6) : (t & 63);
                    const f32x4 cs = *(const f32x4*)(rope + pos * 16 + 4 * fq); const f32x4 sn = *(const f32x4*)(rope + 1024 + pos * 16 + 4 * fq);
                    const f32x4 y0 = acc[ai][bj][m][0] * sc * gv[bj][0]; const f32x4 y1 = acc[ai][bj][m][1] * sc * gv[bj][1];
                    const f32x4 o0 = y0 * cs - y1 * sn; const f32x4 o1 = y1 * cs + y0 * sn;
                    bf16_t* p = dst + (size_t)row * pitch + head * 64 + 32 * bj + 4 * fq;
                    u32x2 w0; w0.x = cvt_pk_bf16(o0[0], o0[1]); w0.y = cvt_pk_bf16(o0[2], o0[3]);
                    u32x2 w1; w1.x = cvt_pk_bf16(o1[0], o1[1]); w1.y = cvt_pk_bf16(o1[2], o1[3]);
                    *(u32x2*)p = w0; *(u32x2*)(p + 16) = w1;
                }
            )
        } else {
            bf16_t* dst; int pitch, colt, dsh = 0; float sc = asc; bool sig = false, fold = false;
            if (pn < 9) { dst = aqkv + (size_t)pn * T * 256; pitch = 256; colt = 0; fold = true; dsh = 2 * (pn / 3); if (pn % 3 == 0) sc = C2 * asc; }
            else if (pn == 14) { dst = vb; pitch = 256; colt = 0; }
            else { dst = gate; pitch = 2048; colt = (pn - 15) * 256; sig = true; }
            const int col0 = colt + wc * 32 + 8 * fq;
            EPI_ROWS(
                int drow = row;
                if (fold) { const int t = row & (SEQ - 1); drow = (row & ~(SEQ - 1)) | ((t & ((1 << dsh) - 1)) << (12 - dsh)) | (t >> dsh); }
                bf16_t* rowp = dst + (size_t)drow * pitch + col0;
                _Pragma("unroll") for (int bj = 0; bj < 2; ++bj) {
                    f32x4 v0 = acc[ai][bj][m][0], v1 = acc[ai][bj][m][1];
                    if (sig) { _Pragma("unroll") for (int j = 0; j < 4; ++j) { v0[j] = sigmoid_f(v0[j] * asc); v1[j] = sigmoid_f(v1[j] * asc); } }
                    else { v0 = v0 * sc; v1 = v1 * sc; }
                    *(u32x4*)(rowp + bj * HALF) = pack8(v0, v1);
                }
            )
        }
    }
};
struct EpiMergeA {
    const bf16_t* gate; bf16_t* merged;
    __device__ __forceinline__ void operator()(const f32x4 (&acc)[2][2][4][2], const Unit& u, int wr, int wc, int fr, int fq) const {
        const int col0 = u.pn * BM + wc * 32 + 8 * fq;
        EPI_ROWS(
            _Pragma("unroll") for (int bj = 0; bj < 2; ++bj) {
                const u32x4 gw = *(const u32x4*)(gate + (size_t)row * 2048 + col0 + bj * HALF);
                f32x4 v0 = acc[ai][bj][m][0], v1 = acc[ai][bj][m][1];
                v0 = v0 * W8_INV; v1 = v1 * W8_INV;
                v0[0] *= bf_lo(gw.x); v0[1] *= bf_hi(gw.x); v0[2] *= bf_lo(gw.y); v0[3] *= bf_hi(gw.y);
                v1[0] *= bf_lo(gw.z); v1[1] *= bf_hi(gw.z); v1[2] *= bf_lo(gw.w); v1[3] *= bf_hi(gw.w);
                *(u32x4*)(merged + (size_t)row * 1024 + col0 + bj * HALF) = pack8(v0, v1);
            }
        )
    }
};
template <bool F8> struct EpiMergeB {
    const bf16_t* gate; const bf16_t* merged; unsigned char* m8;
    __device__ __forceinline__ void operator()(const f32x4 (&acc)[2][2][4][2], const Unit& u, int wr, int wc, int fr, int fq) const {
        const int col0 = u.pn * BM + wc * 32 + 8 * fq;
        EPI_ROWS(
            _Pragma("unroll") for (int bj = 0; bj < 2; ++bj) {
                const u32x4 gw = *(const u32x4*)(gate + (size_t)row * 2048 + 1024 + col0 + bj * HALF);
                const bf16_t* mp = merged + (size_t)row * 1024 + col0 + bj * HALF;
                const u32x4 mw = *(const u32x4*)mp;
                f32x4 v0 = acc[ai][bj][m][0] * (F8 ? W8_INV : 1.0f), v1 = acc[ai][bj][m][1] * (F8 ? W8_INV : 1.0f);
                v0[0] = v0[0] * bf_lo(gw.x) + bf_lo(mw.x); v0[1] = v0[1] * bf_hi(gw.x) + bf_hi(mw.x); v0[2] = v0[2] * bf_lo(gw.y) + bf_lo(mw.y); v0[3] = v0[3] * bf_hi(gw.y) + bf_hi(mw.y);
                v1[0] = v1[0] * bf_lo(gw.z) + bf_lo(mw.z); v1[1] = v1[1] * bf_hi(gw.z) + bf_hi(mw.z); v1[2] = v1[2] * bf_lo(gw.w) + bf_lo(mw.w); v1[3] = v1[3] * bf_hi(gw.w) + bf_hi(mw.w);
                *(u32x2*)(m8 + (size_t)row * 1024 + col0 + bj * HALF) = pack8_f8(v0, v1);
            }
        )
    }
};
struct EpiOut {
    const float* xin; float* xout; const float* g1;
    __device__ __forceinline__ void operator()(const f32x4 (&acc)[2][2][4][2], const Unit& u, int wr, int wc, int fr, int fq) const {
        const int col0 = u.pn * BM + wc * 32 + 8 * fq; const int b = (u.pm * BM) >> 12;
        f32x4 gv[2][2];
#pragma unroll
        for (int bj = 0; bj < 2; ++bj)
#pragma unroll
            for (int n = 0; n < 2; ++n) gv[bj][n] = *(const f32x4*)(g1 + (size_t)b * 6144 + col0 + bj * HALF + 4 * n);
        EPI_ROWS(
            _Pragma("unroll") for (int bj = 0; bj < 2; ++bj) {
                const size_t off = (size_t)row * 1024 + col0 + bj * HALF;
                const f32x4 x0 = *(const f32x4*)(xin + off), x1 = *(const f32x4*)(xin + off + 4);
                *(f32x4*)(xout + off) = x0 + gv[bj][0] * (acc[ai][bj][m][0] * W8_INV); *(f32x4*)(xout + off + 4) = x1 + gv[bj][1] * (acc[ai][bj][m][1] * W8_INV);
            }
        )
    }
};
struct EpiGU {
    const float* bgu; bf16_t* act;
    __device__ __forceinline__ void operator()(const f32x4 (&acc)[2][2][4][2], const Unit& u, int wr, int wc, int fr, int fq) const {
        const int e = u.pn >> 3, pl = u.pn & 7; const int c0 = pl * 128 + wc * 32 + 8 * fq;
        const float* bp = bgu + (size_t)e * 2048 + c0;
        const f32x4 bg0 = *(const f32x4*)bp, bg1 = *(const f32x4*)(bp + 4), bl0 = *(const f32x4*)(bp + 1024), bl1 = *(const f32x4*)(bp + 1028);
        EPI_ROWS(
            f32x4 o[2];
            _Pragma("unroll") for (int n = 0; n < 2; ++n) {
                const f32x4 gl = acc[ai][0][m][n] + (n == 0 ? bg0 : bg1); const f32x4 ln = acc[ai][1][m][n] + (n == 0 ? bl0 : bl1);
                _Pragma("unroll") for (int j = 0; j < 4; ++j) { const float xg = fminf(gl[j], 7.0f); const float xl = fminf(fmaxf(ln[j], -7.0f), 7.0f); o[n][j] = xg * sigmoid_f(1.702f * xg) * (xl + 1.0f); }
            }
            *(u32x4*)(act + (size_t)row * 1024 + c0) = pack8(o[0], o[1]);
        )
    }
};
struct EpiGU8 {
    const float* bgu; unsigned char* act;
    __device__ __forceinline__ void operator()(const f32x4 (&acc)[2][2][4][2], const Unit& u, int wr, int wc, int fr, int fq) const {
        const int e = u.pn >> 3, pl = u.pn & 7; const int c0 = pl * 128 + wc * 32 + 8 * fq;
        const float* bp = bgu + (size_t)e * 2048 + c0;
        const f32x4 bg0 = *(const f32x4*)bp, bg1 = *(const f32x4*)(bp + 4), bl0 = *(const f32x4*)(bp + 1024), bl1 = *(const f32x4*)(bp + 1028);
        EPI_ROWS(
            f32x4 o[2];
            _Pragma("unroll") for (int n = 0; n < 2; ++n) {
                const f32x4 gl = acc[ai][0][m][n] * W8_INV + (n == 0 ? bg0 : bg1); const f32x4 ln = acc[ai][1][m][n] * W8_INV + (n == 0 ? bl0 : bl1);
                _Pragma("unroll") for (int j = 0; j < 4; ++j) { const float xg = fminf(gl[j], 7.0f); const float xl = fminf(fmaxf(ln[j], -7.0f), 7.0f); o[n][j] = xg * sigmoid_f(1.702f * xg) * (xl + 1.0f); }
            }
            *(u32x2*)(act + (size_t)row * 1024 + c0) = pack8_f8(o[0], o[1]);
        )
    }
};
struct EpiDN8 {
    const float* bdn; const float* roww; bf16_t* y;
    __device__ __forceinline__ void operator()(const f32x4 (&acc)[2][2][4][2], const Unit& u, int wr, int wc, int fr, int fq) const {
        const int e = u.pn >> 2, pl = u.pn & 3; const int col0 = pl * BM + wc * 32 + 8 * fq;
        f32x4 bv[2][2];
#pragma unroll
        for (int bj = 0; bj < 2; ++bj)
#pragma unroll
            for (int n = 0; n < 2; ++n) bv[bj][n] = *(const f32x4*)(bdn + (size_t)e * 1024 + col0 + bj * HALF + 4 * n);
        EPI_ROWS(
            const float w = roww[row];
            _Pragma("unroll") for (int bj = 0; bj < 2; ++bj)
                *(u32x4*)(y + (size_t)row * 1024 + col0 + bj * HALF) = pack8((acc[ai][bj][m][0] * W8_INV + bv[bj][0]) * w, (acc[ai][bj][m][1] * W8_INV + bv[bj][1]) * w);
        )
    }
};
struct EpiDN {
    const float* bdn; const float* roww; bf16_t* y;
    __device__ __forceinline__ void operator()(const f32x4 (&acc)[2][2][4][2], const Unit& u, int wr, int wc, int fr, int fq) const {
        const int e = u.pn >> 2, pl = u.pn & 3; const int col0 = pl * BM + wc * 32 + 8 * fq;
        f32x4 bv[2][2];
#pragma unroll
        for (int bj = 0; bj < 2; ++bj)
#pragma unroll
            for (int n = 0; n < 2; ++n) bv[bj][n] = *(const f32x4*)(bdn + (size_t)e * 1024 + col0 + bj * HALF + 4 * n);
        EPI_ROWS(
            const float w = roww[row];
            _Pragma("unroll") for (int bj = 0; bj < 2; ++bj)
                *(u32x4*)(y + (size_t)row * 1024 + col0 + bj * HALF) = pack8((acc[ai][bj][m][0] + bv[bj][0]) * w, (acc[ai][bj][m][1] + bv[bj][1]) * w);
        )
    }
};
}

namespace attn_body {
using bf16 = __hip_bfloat16;
using bf16x8 = __attribute__((ext_vector_type(8))) short;
using s16x4 = __attribute__((ext_vector_type(4))) short;
using f32x16 = __attribute__((ext_vector_type(16))) float;
using u32x4 = __attribute__((ext_vector_type(4))) unsigned;
constexpr int D = 64, NW = 8, QBLK = 32, QB = QBLK * NW, KVBLK = 64;
__device__ __forceinline__ int crow(int r, int hi) { return (r & 3) + 8 * (r >> 2) + 4 * hi; }
#define SBAR() __builtin_amdgcn_sched_barrier(0)
constexpr int NSLOT = 3, SLOTB = 8192;
constexpr int LDS_K = 0, LDS_V = NSLOT * SLOTB, LDS_WS = 2 * NSLOT * SLOTB, LDS_OST = LDS_WS + NW * 64 * 4, LDS_LUT = LDS_OST + NW * 4096, LUT_N = 768, LDS_BYTES = LDS_LUT + LUT_N * 4;
constexpr bool OB_F8 = true;
constexpr float MFLOOR = -1024.0f;
__device__ __forceinline__ void glds16(const void* gsrc, unsigned lds_dst) { unsigned keep;
  asm volatile("s_mov_b32 %0, m0\n\ts_mov_b32 m0, %2\n\ts_nop 0\n\tglobal_load_lds_dwordx4 %1, off\n\ts_mov_b32 m0, %0" : "=&s"(keep) : "v"(gsrc), "s"(lds_dst) : "memory"); }
__device__ __forceinline__ float max3f(float a, float b, float c) { float r; asm("v_max3_f32 %0, %1, %2, %3" : "=v"(r) : "v"(a), "v"(b), "v"(c)); return r; }
__device__ __forceinline__ float max2f(float a, float b) { float r; asm("v_max_f32_e32 %0, %1, %2" : "=v"(r) : "v"(a), "v"(b)); return r; }
__device__ __forceinline__ float fadd_s(float a, float b) { float r; asm("v_add_f32_e32 %0, %1, %2" : "=v"(r) : "v"(a), "v"(b)); return r; }
__device__ __forceinline__ float fsub_s(float a, float b) { float r; asm("v_sub_f32_e32 %0, %1, %2" : "=v"(r) : "v"(a), "v"(b)); return r; }
typedef float f32x2_t __attribute__((ext_vector_type(2))); typedef __bf16 bf16x2_t __attribute__((ext_vector_type(2)));
__device__ __forceinline__ unsigned cvtpk_s(float lo, float hi) { f32x2_t v = {lo, hi}; bf16x2_t b = __builtin_convertvector(v, bf16x2_t); return __builtin_bit_cast(unsigned, b); }
#define WAIT_BAR(N) asm volatile("s_waitcnt vmcnt(" #N ") lgkmcnt(0)\n\ts_barrier" ::: "memory")

__device__ __forceinline__ void qkt(f32x16& p0, f32x16& p1, const char* Kslot, const bf16x8* qr, const f32x16& negm, int r32, int hi) {
  const char* kb = Kslot + hi * 1024 + r32 * 16;
  #pragma unroll
  for (int d0 = 0; d0 < 4; ++d0) {
    const bf16x8 b0 = *reinterpret_cast<const bf16x8*>(kb + d0 * 2048);
    const bf16x8 b1 = *reinterpret_cast<const bf16x8*>(kb + d0 * 2048 + 512);
    if (d0 == 0) { p0 = __builtin_amdgcn_mfma_f32_32x32x16_bf16(b0, qr[0], negm, 0, 0, 0); p1 = __builtin_amdgcn_mfma_f32_32x32x16_bf16(b1, qr[0], negm, 0, 0, 0); }
    else { p0 = __builtin_amdgcn_mfma_f32_32x32x16_bf16(b0, qr[d0], p0, 0, 0, 0); p1 = __builtin_amdgcn_mfma_f32_32x32x16_bf16(b1, qr[d0], p1, 0, 0, 0); } }
}
typedef __attribute__((address_space(3))) const char* lds_cptr;
typedef short v4i16_t __attribute__((ext_vector_type(4)));
__device__ __forceinline__ void kload8(bf16x8* kf, lds_cptr kp) {
  kf[0] = *(const __attribute__((address_space(3))) bf16x8*)(kp);        kf[1] = *(const __attribute__((address_space(3))) bf16x8*)(kp + 512);
  kf[2] = *(const __attribute__((address_space(3))) bf16x8*)(kp + 2048); kf[3] = *(const __attribute__((address_space(3))) bf16x8*)(kp + 2560);
  kf[4] = *(const __attribute__((address_space(3))) bf16x8*)(kp + 4096); kf[5] = *(const __attribute__((address_space(3))) bf16x8*)(kp + 4608);
  kf[6] = *(const __attribute__((address_space(3))) bf16x8*)(kp + 6144); kf[7] = *(const __attribute__((address_space(3))) bf16x8*)(kp + 6656);
}
__device__ __forceinline__ void kload2(bf16x8* kf, lds_cptr kp, int j) { kf[2 * j] = *(const __attribute__((address_space(3))) bf16x8*)(kp + j * 2048); kf[2 * j + 1] = *(const __attribute__((address_space(3))) bf16x8*)(kp + j * 2048 + 512); }
__device__ __forceinline__ s16x4 vtr(lds_cptr p) { return __builtin_bit_cast(s16x4, __builtin_amdgcn_ds_read_tr16_b64_v4i16((__attribute__((address_space(3))) v4i16_t*)p)); }
__device__ __forceinline__ float rowmax(const f32x16& p0, const f32x16& p1) {
  float a = max3f(p0[0], p0[1], p1[0]), b = max3f(p0[2], p0[3], p1[1]); a = max3f(a, p1[2], p1[3]);
  #pragma unroll
  for (int r = 4; r < 16; r += 4) { a = max3f(a, p0[r], p0[r + 1]); b = max3f(b, p0[r + 2], p0[r + 3]); a = max3f(a, p1[r], p1[r + 1]); b = max3f(b, p1[r + 2], p1[r + 3]); }
  const float m = max2f(a, b);
  auto rr = __builtin_amdgcn_permlane32_swap(__float_as_uint(m), __float_as_uint(m), false, false);
  return max2f(__uint_as_float(rr[0]), __uint_as_float(rr[1]));
}
__device__ __forceinline__ void pv(f32x16* o, int vb, bf16x8 pa0, bf16x8 pa1, bf16x8 pa2, bf16x8 pa3) {
  #pragma unroll
  for (int d0 = 0; d0 < 2; ++d0) { s16x4 lo[4], hi[4];
    #pragma unroll
    for (int ks = 0; ks < 4; ++ks) {
      asm volatile("ds_read_b64_tr_b16 %0,%1 offset:%c2" : "=&v"(lo[ks]) : "v"(vb), "i"(d0 * 4096 + ks * 1024) : "memory");
      asm volatile("ds_read_b64_tr_b16 %0,%1 offset:%c2" : "=&v"(hi[ks]) : "v"(vb), "i"(d0 * 4096 + ks * 1024 + 512) : "memory"); }
    asm volatile("s_waitcnt lgkmcnt(0)" ::: "memory"); SBAR();
    #define PK(k) (bf16x8){lo[k][0], lo[k][1], lo[k][2], lo[k][3], hi[k][0], hi[k][1], hi[k][2], hi[k][3]}
    o[d0] = __builtin_amdgcn_mfma_f32_32x32x16_bf16(pa0, PK(0), o[d0], 0, 0, 0);
    o[d0] = __builtin_amdgcn_mfma_f32_32x32x16_bf16(pa1, PK(1), o[d0], 0, 0, 0);
    o[d0] = __builtin_amdgcn_mfma_f32_32x32x16_bf16(pa2, PK(2), o[d0], 0, 0, 0);
    o[d0] = __builtin_amdgcn_mfma_f32_32x32x16_bf16(pa3, PK(3), o[d0], 0, 0, 0);
    #undef PK
  }
}
struct Job { const bf16* Q; const bf16* K; const bf16* V; bf16* O; float* lse; const float* lutg; int NT, i0, kq0, dsh, cls; };
template <int MODE, int THRL> __device__ __forceinline__ void attn_unit(const Job& J, char* shm, const int wid_in) {
  int wid = wid_in; asm volatile("" : "+s"(wid));
  constexpr int QP = MODE == 0 ? 1024 : 256, KP = 256;
  const int lane = lane_id_asm(), tid = wid * 64 + lane, r32 = lane & 31, hi = lane >> 5;
  const bf16* Qw = J.Q + (long)(wid * QBLK) * QP;
  const bf16* Kh = J.K; const bf16* Vh = J.V;
  const unsigned lds0 = (unsigned)(uintptr_t)shm;
  float* wsf = (float*)(shm + LDS_WS) + wid * 64;
  const bf16* ksrc = Kh + (long)lane * KP + wid * 8;
  const bf16* vsrc = Vh + (long)(16 * (wid & 3) + (lane >> 2)) * KP + (wid >> 2) * 32 + (lane & 3) * 8;
  const unsigned kdst = lds0 + LDS_K + wid * 1024, vdst = lds0 + LDS_V + wid * 1024;
  #define DMA_K(t, slot) glds16(ksrc + (long)(t) * KVBLK * KP, (unsigned)__builtin_amdgcn_readfirstlane(kdst + (slot)))
  #define DMA_V(t, slot) glds16(vsrc + (long)(t) * KVBLK * KP, (unsigned)__builtin_amdgcn_readfirstlane(vdst + (slot)))
  const int vb0 = (int)(lds0 + LDS_V) + ((lane >> 4) & 1) * 32 + (lane & 3) * 8 + (4 * hi + ((lane & 15) >> 2)) * 64;
  const char* Kbase = shm + LDS_K; bf16x8 kf[8];
  const lds_cptr shm3 = (lds_cptr)shm; const lds_cptr kp0 = shm3 + LDS_K + hi * 1024 + r32 * 16; const lds_cptr vp0 = shm3 + LDS_V + ((lane >> 4) & 1) * 32 + (lane & 3) * 8 + (4 * hi + ((lane & 15) >> 2)) * 64;
  const int NT = J.NT;
  if (MODE == 1) {
    __attribute__((address_space(3))) float* lut = (__attribute__((address_space(3))) float*)(shm3 + LDS_LUT);
    lut[tid] = J.lutg[tid]; if (tid < LUT_N - 512) lut[512 + tid] = J.lutg[512 + tid];
  }
  DMA_K(0, 0); DMA_V(0, 0); DMA_K(1, SLOTB);
  bf16x8 qr[4];
  #pragma unroll
  for (int d0 = 0; d0 < 4; ++d0) qr[d0] = *reinterpret_cast<const bf16x8*>(&Qw[(long)r32 * QP + d0 * 16 + hi * 8]);
  float mhat = 0.f, l_reg = 0.f; f32x16 o[2]; o[0] = f32x16{}; o[1] = f32x16{}; f32x16 negm = f32x16{}; asm volatile("" : "+v"(negm));
  const int qrel = wid * QBLK + r32;
  const __attribute__((address_space(3))) float* lutq = (const __attribute__((address_space(3))) float*)(shm3 + LDS_LUT) + (J.kq0 - qrel + 383 + 4 * hi);
  #define CMASK(P0, P1, t) do { if (MODE == 1) { const __attribute__((address_space(3))) float* lp_ = lutq + 64 * (t); \
      _Pragma("unroll") for (int r = 0; r < 16; ++r) { const int ko_ = (r & 3) + 8 * (r >> 2); P0[r] += lp_[ko_]; P1[r] += lp_[ko_ + 32]; } } } while (0)
  bool resc = false;
  #define START(P0, P1) do { const float rm = rowmax(P0, P1); resc = false; \
    { const float dl = MODE == 1 ? max2f(rm, MFLOOR) : rm; mhat = fadd_s(mhat, dl); \
      _Pragma("unroll") for (int r = 0; r < 16; ++r) { P0[r] = fsub_s(P0[r], dl); P1[r] = fsub_s(P1[r], dl); } \
      _Pragma("unroll") for (int r = 0; r < 16; ++r) negm[r] = -mhat; asm volatile("" : "+v"(negm)); } \
    _Pragma("unroll") for (int r = 0; r < 16; ++r) P0[r] = __builtin_amdgcn_exp2f(P0[r]); } while (0)
  #define RESC() do { if (resc) { asm volatile("s_waitcnt lgkmcnt(0)" ::: "memory"); \
      _Pragma("unroll") for (int d_ = 0; d_ < 2; ++d_) _Pragma("unroll") for (int r = 0; r < 16; ++r) o[d_][r] *= wsf[crow(r, hi)]; } } while (0)
  f32x16 pA0, pA1, pB0, pB1;
  int sl_prev = 0, sl_cur = 0, sl_next = SLOTB;
  #define ROT() do { sl_prev = sl_cur; sl_cur = sl_next; sl_next = (sl_next == (NSLOT - 1) * SLOTB) ? 0 : sl_next + SLOTB; } while (0)
  DMA_K(2, 2 * SLOTB);
  WAIT_BAR(3);
  qkt(pA0, pA1, Kbase, qr, negm, r32, hi); asm volatile("s_nop 15\n\ts_nop 7" : "+v"(pA0), "+v"(pA1)); CMASK(pA0, pA1, 0);
  START(pA0, pA1);
  _Pragma("unroll") for (int r = 0; r < 16; ++r) pA1[r] = __builtin_amdgcn_exp2f(pA1[r]);
  WAIT_BAR(0);
  DMA_K(3, 0); DMA_V(1, SLOTB);
  ROT();
  kload8(kf, kp0 + sl_cur);
  WAIT_BAR(2);
  s16x4 vlo[8], vhi[8]; u32x4 pw0, pw1, pw2, pw3;
  #define PKW(P, B) cvtpk_s(P[B], P[B + 1])
  #define PAF(k) __builtin_bit_cast(bf16x8, pw##k)
  #define VFR(i) (bf16x8){vlo[i][0], vlo[i][1], vlo[i][2], vlo[i][3], vhi[i][0], vhi[i][1], vhi[i][2], vhi[i][3]}
  #define PIN(x) asm volatile("" : "+v"(x))
  #define MX3(a, b, c) __builtin_fmaxf(__builtin_fmaxf((a), (b)), (c))
  #define GAPA(MF, A0, A1, A2, A3, W0, W1, PW) do { MF; sacc += A0; sacc += A1; sacc += A2; sacc += A3; PIN(sacc); W0; W1; PIN(PW); SBAR(); } while (0)
  #define EX(v) __builtin_amdgcn_exp2f(v)
  #define GAPB(MF, X, B) do { MF; X[B] = EX(X[B]); X[B + 1] = EX(X[B + 1]); X[B + 2] = EX(X[B + 2]); X[B + 3] = EX(X[B + 3]); PIN(X); SBAR(); } while (0)
  #define VRD(i) do { vlo[i] = vtr(vp_ + (((i) >> 2) * 4096 + ((i) & 3) * 1024)); vhi[i] = vtr(vp_ + (((i) >> 2) * 4096 + ((i) & 3) * 1024 + 512)); } while (0)
  #define KRD(G, j) do { if (G) { kload2(kf, kp0 + sl_next, j); SBAR(); } } while (0)
  #define STEP(C0, C1, P0, P1, t, GK, GV, GL) do { SBAR(); \
    const lds_cptr vp_ = vp0 + sl_prev; \
    VRD(0); SBAR(); float sacc = (P0[0] + P0[1]); \
    GAPA(C0 = __builtin_amdgcn_mfma_f32_32x32x16_bf16(kf[0], qr[0], negm, 0, 0, 0), P0[2], P0[3], P0[4], P0[5],     pw0[0] = PKW(P0, 0), pw0[1] = PKW(P0, 2), pw0); \
    VRD(4); SBAR(); GAPA(C1 = __builtin_amdgcn_mfma_f32_32x32x16_bf16(kf[1], qr[0], negm, 0, 0, 0), P0[6], P0[7], P0[8], P0[9],     pw0[2] = PKW(P0, 4), pw0[3] = PKW(P0, 6), pw0); \
    VRD(1); SBAR(); GAPA(C0 = __builtin_amdgcn_mfma_f32_32x32x16_bf16(kf[2], qr[1], C0, 0, 0, 0),   P0[10], P0[11], P0[12], P0[13], pw1[0] = PKW(P0, 8), pw1[1] = PKW(P0, 10), pw1); \
    VRD(5); SBAR(); GAPA(C1 = __builtin_amdgcn_mfma_f32_32x32x16_bf16(kf[3], qr[1], C1, 0, 0, 0),   P0[14], P0[15], P1[0], P1[1],   pw1[2] = PKW(P0, 12), pw1[3] = PKW(P0, 14), pw1); \
    VRD(2); SBAR(); GAPA(C0 = __builtin_amdgcn_mfma_f32_32x32x16_bf16(kf[4], qr[2], C0, 0, 0, 0),   P1[2], P1[3], P1[4], P1[5],     pw2[0] = PKW(P1, 0), pw2[1] = PKW(P1, 2), pw2); \
    VRD(6); SBAR(); GAPA(C1 = __builtin_amdgcn_mfma_f32_32x32x16_bf16(kf[5], qr[2], C1, 0, 0, 0),   P1[6], P1[7], P1[8], P1[9],     pw2[2] = PKW(P1, 4), pw2[3] = PKW(P1, 6), pw2); \
    VRD(3); SBAR(); GAPA(C0 = __builtin_amdgcn_mfma_f32_32x32x16_bf16(kf[6], qr[3], C0, 0, 0, 0),   P1[10], P1[11], P1[12], P1[13], pw3[0] = PKW(P1, 8), pw3[1] = PKW(P1, 10), pw3); \
    VRD(7); SBAR(); GAPA(C1 = __builtin_amdgcn_mfma_f32_32x32x16_bf16(kf[7], qr[3], C1, 0, 0, 0),   P1[14], P1[15], 0.f, 0.f,       pw3[2] = PKW(P1, 12), pw3[3] = PKW(P1, 14), pw3); \
    l_reg += sacc; \
    if (GK) { DMA_K((t) + 3, sl_cur); } if (GV) { DMA_V((t) + 1, sl_next); } \
    CMASK(C0, C1, t); \
    { float a = MX3(C0[0], C0[1], C1[0]), b = MX3(C0[2], C0[3], C1[1]); a = MX3(a, C1[2], C1[3]); \
      _Pragma("unroll") for (int r = 4; r < 16; r += 4) { a = MX3(a, C0[r], C0[r + 1]); b = MX3(b, C0[r + 2], C0[r + 3]); a = MX3(a, C1[r], C1[r + 1]); b = MX3(b, C1[r + 2], C1[r + 3]); } \
      float rm = __builtin_fmaxf(a, b); { auto rr = __builtin_amdgcn_permlane32_swap(__float_as_uint(rm), __float_as_uint(rm), false, false); rm = __builtin_fmaxf(__uint_as_float(rr[0]), __uint_as_float(rr[1])); } \
      resc = false; \
      if (__builtin_expect(__any(rm > (float)THRL), 0)) { const float dl = __builtin_fmaxf(rm, 0.f); mhat += dl; \
        _Pragma("unroll") for (int r = 0; r < 16; ++r) { C0[r] -= dl; C1[r] -= dl; } \
        _Pragma("unroll") for (int r = 0; r < 16; ++r) negm[r] = -mhat; asm volatile("" : "+v"(negm)); \
        const float f = __builtin_amdgcn_exp2f(-dl); l_reg *= f; if (hi == 0) wsf[r32] = f; resc = true; } } \
    SBAR(); \
    GAPB(o[0] = __builtin_amdgcn_mfma_f32_32x32x16_bf16(PAF(0), VFR(0), o[0], 0, 0, 0), C0, 0); \
    GAPB(o[1] = __builtin_amdgcn_mfma_f32_32x32x16_bf16(PAF(0), VFR(4), o[1], 0, 0, 0), C0, 4); \
    KRD(GL, 0); GAPB(o[0] = __builtin_amdgcn_mfma_f32_32x32x16_bf16(PAF(1), VFR(1), o[0], 0, 0, 0), C0, 8); \
    KRD(GL, 1); GAPB(o[1] = __builtin_amdgcn_mfma_f32_32x32x16_bf16(PAF(1), VFR(5), o[1], 0, 0, 0), C0, 12); \
    KRD(GL, 2); GAPB(o[0] = __builtin_amdgcn_mfma_f32_32x32x16_bf16(PAF(2), VFR(2), o[0], 0, 0, 0), C1, 0); \
    KRD(GL, 3); GAPB(o[1] = __builtin_amdgcn_mfma_f32_32x32x16_bf16(PAF(2), VFR(6), o[1], 0, 0, 0), C1, 4); \
    GAPB(o[0] = __builtin_amdgcn_mfma_f32_32x32x16_bf16(PAF(3), VFR(3), o[0], 0, 0, 0), C1, 8); \
    GAPB(o[1] = __builtin_amdgcn_mfma_f32_32x32x16_bf16(PAF(3), VFR(7), o[1], 0, 0, 0), C1, 12); \
    } while (0)
  int t = 1;
  for (; t + 5 < NT; t += 2) {
    STEP(pB0, pB1, pA0, pA1, t, true, true, true);     WAIT_BAR(2); RESC(); ROT();
    STEP(pA0, pA1, pB0, pB1, t + 1, true, true, true); WAIT_BAR(2); RESC(); ROT();
  }
  #define ENDW(tt) do { if ((tt) + 3 < NT) { WAIT_BAR(2); } else if ((tt) + 2 < NT) { WAIT_BAR(1); } else { WAIT_BAR(0); } } while (0)
  for (; t + 1 < NT; t += 2) {
    STEP(pB0, pB1, pA0, pA1, t, (t + 3 < NT), (t + 1 < NT), (t + 1 < NT));       ENDW(t);     RESC(); ROT();
    STEP(pA0, pA1, pB0, pB1, t + 1, (t + 4 < NT), (t + 2 < NT), (t + 2 < NT));   ENDW(t + 1); RESC(); ROT();
  }
  STEP(pB0, pB1, pA0, pA1, NT - 1, false, false, false); RESC();
  { float sacc = pB0[0] + pB0[1]; _Pragma("unroll") for (int r = 2; r < 16; ++r) sacc += pB0[r]; _Pragma("unroll") for (int r = 0; r < 16; ++r) sacc += pB1[r]; l_reg += sacc;
    pw0 = (u32x4){PKW(pB0, 0), PKW(pB0, 2), PKW(pB0, 4), PKW(pB0, 6)}; pw1 = (u32x4){PKW(pB0, 8), PKW(pB0, 10), PKW(pB0, 12), PKW(pB0, 14)}; pw2 = (u32x4){PKW(pB1, 0), PKW(pB1, 2), PKW(pB1, 4), PKW(pB1, 6)}; pw3 = (u32x4){PKW(pB1, 8), PKW(pB1, 10), PKW(pB1, 12), PKW(pB1, 14)};
    SBAR(); pv(o, vb0 + sl_cur, PAF(0), PAF(1), PAF(2), PAF(3)); }
  #undef PKW
  #undef PAF
  #undef VFR
  #undef PIN
  #undef MX3
  #undef GAPA
  #undef GAPB
  #undef EX
  #undef VRD
  #undef KRD
  #undef STEP
  #undef ENDW
  { auto rr = __builtin_amdgcn_permlane32_swap(__float_as_uint(l_reg), __float_as_uint(l_reg), false, false); l_reg = __uint_as_float(rr[0]) + __uint_as_float(rr[1]); }
  if (hi == 0) wsf[32 + r32] = l_reg; asm volatile("s_waitcnt lgkmcnt(0)" ::: "memory");
  float rli[16];
  #pragma unroll
  for (int r = 0; r < 16; ++r) rli[r] = __builtin_amdgcn_rcpf(wsf[32 + crow(r, hi)]);
  if (MODE == 0 && OB_F8) {
    unsigned char* stg8 = (unsigned char*)(shm + LDS_OST) + wid * 4096;
    #pragma unroll
    for (int r = 0; r < 16; ++r) { const int orow = crow(r, hi);
      #pragma unroll
      for (int d0 = 0; d0 < 2; ++d0) { const float ov = o[d0][r] * rli[r]; stg8[orow * 64 + d0 * 32 + r32] = (unsigned char)(__builtin_amdgcn_cvt_pk_fp8_f32(ov, ov, 0, false) & 0xff); } }
    asm volatile("s_waitcnt lgkmcnt(0)" ::: "memory");
    unsigned char* Ow = (unsigned char*)J.O + (long)(wid * QBLK) * 1024;
    #pragma unroll
    for (int i = 0; i < 2; ++i) { const int row = i * 16 + (lane >> 2), ch = lane & 3; const u32x4 v = *(const u32x4*)(stg8 + row * 64 + ch * 16); *(u32x4*)(Ow + (long)row * 1024 + ch * 16) = v; }
  } else {
    bf16* stg = (bf16*)(shm + LDS_OST) + wid * 2048;
    #pragma unroll
    for (int r = 0; r < 16; ++r) { const int orow = crow(r, hi);
      #pragma unroll
      for (int d0 = 0; d0 < 2; ++d0) stg[orow * 64 + d0 * 32 + r32] = __float2bfloat16(o[d0][r] * rli[r]); }
    asm volatile("s_waitcnt lgkmcnt(0)" ::: "memory");
    if (MODE == 0) {
      bf16* Ow = J.O + (long)(wid * QBLK) * 1024;
      #pragma unroll
      for (int i = 0; i < 4; ++i) { const int row = i * 8 + (lane >> 3), ch = lane & 7; const u32x4 v = *(const u32x4*)(stg + row * 64 + ch * 8); *(u32x4*)(Ow + (long)row * 1024 + ch * 8) = v; }
    } else {
      #pragma unroll
      for (int i = 0; i < 4; ++i) { const int row = i * 8 + (lane >> 3), ch = lane & 7; const u32x4 v = *(const u32x4*)(stg + row * 64 + ch * 8);
        const long tok = ((long)(J.i0 + wid * QBLK + row) << J.dsh) + J.cls; *(u32x4*)(J.O + tok * 256 + ch * 8) = v; }
      if (hi == 0) { const long tok = ((long)(J.i0 + qrel) << J.dsh) + J.cls; J.lse[tok * 4] = mhat + __builtin_amdgcn_logf(l_reg); }
    } }
  asm volatile("s_waitcnt lgkmcnt(0)\n\ts_barrier" ::: "memory");
  #undef DMA_K
  #undef DMA_V
  #undef CMASK
  #undef START
  #undef RESC
  #undef ROT
}
#undef SBAR
#undef WAIT_BAR
}

constexpr size_t MiB = 1u << 20;
constexpr size_t WS_CTL = 0, CTL_ZERO_BYTES = 1 * MiB;
constexpr size_t WS_MOD = 1 * MiB;
constexpr size_t WS_ROPE = WS_MOD + 512 * 1024;
constexpr size_t WS_BLUT = WS_ROPE + 8192;
constexpr size_t WS_RC0 = WS_BLUT + 12 * 768 * 4;
constexpr size_t WS_HIST = WS_RC0 + 4096;
constexpr size_t WS_TILEE = WS_HIST + 32768;
constexpr size_t WS_TOPE = 2 * MiB;
constexpr size_t WS_TOPW = WS_TOPE + 512 * 1024;
constexpr size_t WS_SLOT = WS_TOPW + 512 * 1024;
constexpr size_t WS_ROWW = WS_SLOT + 512 * 1024;
constexpr size_t WS_LSE = 5 * MiB;
constexpr size_t WS_WRHI = 7 * MiB;
constexpr size_t WS_WRLO = 8 * MiB;
constexpr size_t WS_WIN = 9 * MiB;
constexpr size_t WS_WBRA = 32 * MiB;
constexpr size_t WS_WBRB = 33 * MiB;
constexpr size_t WS_WOUT = 37 * MiB;
constexpr size_t WS_WGU = 41 * MiB;
constexpr size_t WS_WDN = 297 * MiB;
constexpr size_t WS_X = 425 * MiB;
constexpr size_t WS_H = 553 * MiB;
constexpr size_t WS_R = 617 * MiB;
constexpr size_t WS_AQKV = WS_R;
constexpr size_t WS_QB = WS_R + 144 * MiB;
constexpr size_t WS_KB = WS_R + 208 * MiB;
constexpr size_t WS_VB = WS_R + 224 * MiB;
constexpr size_t WS_GATE = WS_R + 240 * MiB;
constexpr size_t WS_OAG = WS_R + 368 * MiB;
constexpr size_t WS_OA = WS_R + 416 * MiB;
constexpr size_t WS_MERGED = WS_R + 432 * MiB;
constexpr size_t WS_XS = WS_R;
constexpr size_t WS_ACT = WS_R + 136 * MiB;
constexpr size_t WS_Y = WS_R + 272 * MiB;
constexpr size_t WS_OB = WS_R + 496 * MiB;
constexpr size_t WS_M8 = WS_R + 560 * MiB;
constexpr size_t WS_END = WS_R + 592 * MiB;
constexpr int CW_BAR = 4096;

constexpr int RING_BYTES = 133120;
constexpr int LDSCTL_OFF = RING_BYTES;
constexpr int LDS_BYTES = 147456;
constexpr int NWAVES = 8;

#define GAS __attribute__((address_space(1)))
#define LAS __attribute__((address_space(3)))
typedef unsigned short bf16;
typedef unsigned v4u __attribute__((ext_vector_type(4)));
typedef unsigned v2u __attribute__((ext_vector_type(2)));
typedef float f32x4 __attribute__((ext_vector_type(4)));
typedef float f32x16 __attribute__((ext_vector_type(16)));
typedef int i32x4 __attribute__((ext_vector_type(4)));
typedef short bf16x8 __attribute__((ext_vector_type(8)));
typedef GAS unsigned gu32;
#define RLX_AGENT __ATOMIC_RELAXED, __HIP_MEMORY_SCOPE_AGENT
#define LDS_WAIT() asm volatile("s_waitcnt lgkmcnt(0)" ::: "memory")
__device__ __forceinline__ unsigned f2bf(float f) { unsigned u = __builtin_bit_cast(unsigned, f); return (u + 0x7fffu + ((u >> 16) & 1u)) >> 16; }
__device__ __forceinline__ unsigned pk2(float lo, float hi) { return f2bf(lo) | (f2bf(hi) << 16); }
__device__ __forceinline__ float bfl(unsigned w) { return __uint_as_float(w << 16); }
__device__ __forceinline__ float bfh(unsigned w) { return __uint_as_float(w & 0xffff0000u); }

#define XB_TMO      128
#define XB_XCNT(j)  (256  + 64 * (j))
#define XB_XSUB(j)  (1280 + 64 * (j))
#define XB_XGEN(j)  (2304 + 64 * (j))
#define XB_TOP      3328
#define XB_TOPGEN   3392
#define XCD_BAR_WORDS 3456
#define XB_SPIN_CAP (1u << 18)
__device__ __forceinline__ unsigned xb_ld(unsigned* p)              { return __hip_atomic_load(p, __ATOMIC_RELAXED, __HIP_MEMORY_SCOPE_AGENT); }
__device__ __forceinline__ unsigned xb_add(unsigned* p, unsigned v) { return __hip_atomic_fetch_add(p, v, __ATOMIC_RELAXED, __HIP_MEMORY_SCOPE_AGENT); }
__device__ __forceinline__ unsigned xb_xcc_id() { return (unsigned)__builtin_amdgcn_s_getreg((3 << 11) | 20) & 0xFu; }
#define XB_SPIN(cond, bar) do { unsigned _sp = 0; while (cond) { __builtin_amdgcn_s_sleep(1); \
    if ((++_sp & 255u) == 0u) { if (xb_ld(&(bar)[XB_TMO])) break; if (_sp > XB_SPIN_CAP) { atomicAdd(&(bar)[XB_TMO], 1u); break; } } } } while (0)
struct XcdBarrier { unsigned* bar; unsigned x; volatile LAS unsigned* st; };
__device__ __forceinline__ XcdBarrier xcd_barrier_post(unsigned* bar, volatile LAS unsigned* st) {
    XcdBarrier b; b.bar = bar; b.x = xb_xcc_id(); b.st = st;
    if (threadIdx.x == 0) (void)xb_add(&bar[XB_XCNT(b.x)], 1u);
    return b;
}
__device__ __forceinline__ void xcd_barrier_complete(unsigned* bar, unsigned x, unsigned& nloc, unsigned& nx) {
    const unsigned G = gridDim.x * gridDim.y * gridDim.z;
    unsigned sum, cnt, mine, sp = 0u;
    for (;;) {
        sum = 0u; cnt = 0u; mine = 0u;
#pragma unroll
        for (unsigned j = 0; j < 16; ++j) { const unsigned c = xb_ld(&bar[XB_XCNT(j)]); sum += c; cnt += (c > 0u) ? 1u : 0u; mine = (j == x) ? c : mine; }
        if (sum == G) break;
        __builtin_amdgcn_s_sleep(1);
        if ((++sp & 255u) == 0u) { if (xb_ld(&bar[XB_TMO])) break; if (sp > XB_SPIN_CAP) { atomicAdd(&bar[XB_TMO], 1u); break; } }
    }
    nloc = mine > 0u ? mine : 1u; nx = cnt > 0u ? cnt : 1u;
}
__device__ __forceinline__ void xcd_barrier(const XcdBarrier& b) {
    asm volatile("s_waitcnt vmcnt(0)" ::: "memory");
    __syncthreads();
    if (threadIdx.x == 0) {
        unsigned* bar = b.bar;
        __builtin_amdgcn_s_waitcnt(0);
        unsigned nloc = b.st[0], nx = b.st[1];
        if (nloc == 0u) { xcd_barrier_complete(bar, b.x, nloc, nx); b.st[0] = nloc; b.st[1] = nx; }
        const unsigned old = xb_add(&bar[XB_XSUB(b.x)], 1u);
        const unsigned gen = old / nloc;
        if (old + 1u == (gen + 1u) * nloc) {
            __builtin_amdgcn_fence(__ATOMIC_RELEASE, "agent");
            asm volatile("s_waitcnt vmcnt(0)" ::: "memory");
            const unsigned og = xb_add(&bar[XB_TOP], 1u);
            const unsigned tg = og / nx;
            if (og + 1u == (tg + 1u) * nx) xb_add(&bar[XB_TOPGEN], 1u);
            else XB_SPIN(xb_ld(&bar[XB_TOPGEN]) == tg, bar);
            __builtin_amdgcn_fence(__ATOMIC_ACQUIRE, "agent");
            xb_add(&bar[XB_XGEN(b.x)], 1u);
            asm volatile("s_waitcnt vmcnt(0)" ::: "memory");
        } else {
            XB_SPIN(xb_ld(&bar[XB_XGEN(b.x)]) == gen, bar);
            __builtin_amdgcn_fence(__ATOMIC_ACQUIRE, "agent");
            asm volatile("s_waitcnt vmcnt(0)" ::: "memory");
        }
    }
    __syncthreads();
}

__device__ __forceinline__ float wave_sum(float v) {
    v = xsum<1>(v); v = xsum<2>(v); v = xsum<4>(v); v = xsum<8>(v); v = xsum<16>(v); v = xsum<32>(v);
    return v;
}
__device__ __forceinline__ void cvt_item(const float* W, int ldw, int K, int srcA, int srcB, bf16* WT, int dst_row0, int k0, LAS float* scr, int lane, bool ident = false) {
    const int kq = lane >> 4, nq = lane & 15; const int scol = (nq < 8 ? srcA + 4 * nq : srcB + 4 * (nq - 8));
    f32x4 v[16];
#pragma unroll
    for (int i = 0; i < 16; ++i) v[i] = *(const GAS f32x4*)(W + (size_t)(k0 + 4 * i + kq) * ldw + scol);
#pragma unroll
    for (int i = 0; i < 16; ++i)
#pragma unroll
        for (int e = 0; e < 4; ++e) scr[(4 * i + kq) * 65 + 4 * nq + e] = v[i][e];
    LDS_WAIT(); asm volatile("" ::: "memory");
    const int c = lane & 7, rr = lane >> 3;
#pragma unroll
    for (int j = 0; j < 8; ++j) { const int rho = rr + 8 * j; const int sc = (rho & 32) + (ident ? (rho & 31) : pg8::perm32(rho & 31)); const LAS float* s = scr + (8 * c) * 65 + sc;
        v4u o; o.x = pk2(s[0 * 65], s[1 * 65]); o.y = pk2(s[2 * 65], s[3 * 65]); o.z = pk2(s[4 * 65], s[5 * 65]); o.w = pk2(s[6 * 65], s[7 * 65]);
        *(GAS v4u*)(WT + (size_t)(dst_row0 + rho) * K + k0 + 8 * c) = o; }
    LDS_WAIT(); asm volatile("" ::: "memory");
}
__device__ __forceinline__ void cvt_item_f8(const float* W, int ldw, int K, int srcA, int srcB, unsigned char* WT, int dst_row0, int k0, LAS float* scr, int lane, bool ident = false) {
    const int kq = lane >> 4, nq = lane & 15; const int scol = (nq < 8 ? srcA + 4 * nq : srcB + 4 * (nq - 8));
    f32x4 v[16];
#pragma unroll
    for (int i = 0; i < 16; ++i) v[i] = *(const GAS f32x4*)(W + (size_t)(k0 + 4 * i + kq) * ldw + scol);
#pragma unroll
    for (int i = 0; i < 16; ++i)
#pragma unroll
        for (int e = 0; e < 4; ++e) scr[(4 * i + kq) * 65 + 4 * nq + e] = v[i][e] * pg8::W8_SCALE;
    LDS_WAIT(); asm volatile("" ::: "memory");
    const int c = lane & 7, rr = lane >> 3;
#pragma unroll
    for (int j = 0; j < 8; ++j) { const int rho = rr + 8 * j; const int sc = (rho & 32) + (ident ? (rho & 31) : pg8::perm32(rho & 31)); const LAS float* s = scr + (8 * c) * 65 + sc;
        unsigned w0 = 0, w1 = 0;
        w0 = __builtin_amdgcn_cvt_pk_fp8_f32(s[0 * 65], s[1 * 65], w0, false); w0 = __builtin_amdgcn_cvt_pk_fp8_f32(s[2 * 65], s[3 * 65], w0, true);
        w1 = __builtin_amdgcn_cvt_pk_fp8_f32(s[4 * 65], s[5 * 65], w1, false); w1 = __builtin_amdgcn_cvt_pk_fp8_f32(s[6 * 65], s[7 * 65], w1, true);
        v2u o; o.x = w0; o.y = w1; *(GAS v2u*)(WT + (size_t)(dst_row0 + rho) * K + k0 + 8 * c) = o; }
    LDS_WAIT(); asm volatile("" ::: "memory");
}
__device__ __forceinline__ int win_src(int X) { const int pn = X >> 3, bj = (X >> 2) & 1, wc = X & 3; return (pn >= 9 && pn < 14) ? pn * 256 + 64 * wc + 32 * bj : 32 * X; }
__device__ __forceinline__ int wgu_src(int X) { const int pn = X >> 3, bj = (X >> 2) & 1, wc = X & 3; return bj * 1024 + 128 * pn + 32 * wc; }

__device__ __forceinline__ void norm_row_bf16(const float* xrow, const float* g, const float* sc, const float* sh, bf16* orow, int lane) {
    const GAS f32x4* xr = (const GAS f32x4*)xrow + lane;
    f32x4 v[4]; float s = 0.f;
#pragma unroll
    for (int j = 0; j < 4; ++j) { v[j] = xr[64 * j]; s += (v[j].x * v[j].x + v[j].y * v[j].y) + (v[j].z * v[j].z + v[j].w * v[j].w); }
    const float rs = rsqrtf(wave_sum(s) * (1.0f / D) + EPS);
#pragma unroll
    for (int j = 0; j < 4; ++j) { const int c = 256 * j + 4 * lane;
        const f32x4 gg = *(const GAS f32x4*)(g + c), s1 = *(const GAS f32x4*)(sc + c), s0 = *(const GAS f32x4*)(sh + c);
        const f32x4 y = (v[j] * rs * gg) * (s1 + 1.0f) + s0;
        v2u o; o.x = pk2(y.x, y.y); o.y = pk2(y.z, y.w); *(GAS v2u*)(orow + c) = o; }
}

__device__ __forceinline__ void norm_rows2_bf16(const float* xrow, const float* g, const float* sc, const float* sh, bf16* orow, int lane) {
    const GAS f32x4* xr = (const GAS f32x4*)xrow + lane;
    f32x4 v[2][4]; float s0 = 0.f, s1 = 0.f;
#pragma unroll
    for (int j = 0; j < 4; ++j) { v[0][j] = xr[64 * j]; v[1][j] = xr[256 + 64 * j]; }
#pragma unroll
    for (int j = 0; j < 4; ++j) { s0 += (v[0][j].x * v[0][j].x + v[0][j].y * v[0][j].y) + (v[0][j].z * v[0][j].z + v[0][j].w * v[0][j].w); s1 += (v[1][j].x * v[1][j].x + v[1][j].y * v[1][j].y) + (v[1][j].z * v[1][j].z + v[1][j].w * v[1][j].w); }
    const float rs0 = rsqrtf(wave_sum(s0) * (1.0f / D) + EPS), rs1 = rsqrtf(wave_sum(s1) * (1.0f / D) + EPS);
#pragma unroll
    for (int j = 0; j < 4; ++j) { const int c = 256 * j + 4 * lane;
        const f32x4 gg = *(const GAS f32x4*)(g + c), a1 = *(const GAS f32x4*)(sc + c) + 1.0f, a0 = *(const GAS f32x4*)(sh + c);
        const f32x4 y0 = (v[0][j] * rs0 * gg) * a1 + a0, y1 = (v[1][j] * rs1 * gg) * a1 + a0;
        v2u o0; o0.x = pk2(y0.x, y0.y); o0.y = pk2(y0.z, y0.w); *(GAS v2u*)(orow + c) = o0;
        v2u o1; o1.x = pk2(y1.x, y1.y); o1.y = pk2(y1.z, y1.w); *(GAS v2u*)(orow + D + c) = o1; }
}

__device__ __forceinline__ void norm_rows2_f8(const float* xrow, const float* g, const float* sc, const float* sh, unsigned char* orow, int lane) {
    const GAS f32x4* xr = (const GAS f32x4*)xrow + lane;
    f32x4 v[2][4]; float s0 = 0.f, s1 = 0.f;
#pragma unroll
    for (int j = 0; j < 4; ++j) { v[0][j] = xr[64 * j]; v[1][j] = xr[256 + 64 * j]; }
#pragma unroll
    for (int j = 0; j < 4; ++j) { s0 += (v[0][j].x * v[0][j].x + v[0][j].y * v[0][j].y) + (v[0][j].z * v[0][j].z + v[0][j].w * v[0][j].w); s1 += (v[1][j].x * v[1][j].x + v[1][j].y * v[1][j].y) + (v[1][j].z * v[1][j].z + v[1][j].w * v[1][j].w); }
    const float rs0 = rsqrtf(wave_sum(s0) * (1.0f / D) + EPS), rs1 = rsqrtf(wave_sum(s1) * (1.0f / D) + EPS);
#pragma unroll
    for (int j = 0; j < 4; ++j) { const int c = 256 * j + 4 * lane;
        const f32x4 gg = *(const GAS f32x4*)(g + c), a1 = *(const GAS f32x4*)(sc + c) + 1.0f, a0 = *(const GAS f32x4*)(sh + c);
        const f32x4 y0 = (v[0][j] * rs0 * gg) * a1 + a0, y1 = (v[1][j] * rs1 * gg) * a1 + a0;
        unsigned w0 = 0, w1 = 0;
        w0 = __builtin_amdgcn_cvt_pk_fp8_f32(y0.x, y0.y, w0, false); w0 = __builtin_amdgcn_cvt_pk_fp8_f32(y0.z, y0.w, w0, true);
        w1 = __builtin_amdgcn_cvt_pk_fp8_f32(y1.x, y1.y, w1, false); w1 = __builtin_amdgcn_cvt_pk_fp8_f32(y1.z, y1.w, w1, true);
        *(GAS unsigned*)(orow + c) = w0; *(GAS unsigned*)(orow + D + c) = w1; }
}

struct Args { const float* in[20]; float* out; unsigned char* ws; int ph_lo, ph_hi, li, pad; };
constexpr int N_PHASES = 2 + 10 * DEPTH;

typedef const __attribute__((address_space(4))) Args* kargs_t;
__device__ __forceinline__ kargs_t kargs_opaque() { kargs_t p = (kargs_t)__builtin_amdgcn_kernarg_segment_ptr(); asm volatile("" : "+s"(p)); return p; }
#define PH_BEGIN() kargs_t ap = kargs_opaque(); unsigned char* ws = ap->ws; (void)ws; \
    int wave = wave_s; asm volatile("" : "+s"(wave)); const int lane = lane_id_asm(); const int tid = wave * 64 + lane; (void)lane; (void)tid; \
    int bx = blockIdx.x; asm volatile("" : "+s"(bx)); int G = gridDim.x; asm volatile("" : "+s"(G)); const int vcu = (G % 8 == 0) ? (bx % 8) * (G / 8) + bx / 8 : bx; (void)vcu; \
    const int gw = vcu * NWAVES + wave, NGW = G * NWAVES; (void)gw; (void)NGW; const int gtid = vcu * (NWAVES * 64) + tid, NGT = G * NWAVES * 64; (void)gtid; (void)NGT
#define INP(k) (ap->in[k])
#define x_in INP(0)
#define c_in INP(1)
#define w_ada INP(2)
#define b_ada INP(3)
#define norm1_g INP(4)
#define w_in INP(5)
#define q_norm_g INP(6)
#define k_norm_g INP(7)
#define rel_bias INP(8)
#define w_br_a INP(9)
#define w_br_b INP(10)
#define w_out INP(11)
#define norm2_g INP(12)
#define w_router INP(13)
#define b_router INP(14)
#define w_gate_up INP(15)
#define b_gate_up INP(16)
#define w_down INP(17)
#define b_down INP(18)
#define final_g INP(19)
#define MOD ((float*)(ws + WS_MOD))
#define ROPE ((float*)(ws + WS_ROPE))
#define BLUT ((float*)(ws + WS_BLUT))
#define RC0 ((float*)(ws + WS_RC0))
#define HIST ((int*)(ws + WS_HIST))
#define TILEE ((int*)(ws + WS_TILEE))
#define TOPE ((int*)(ws + WS_TOPE))
#define TOPW ((float*)(ws + WS_TOPW))
#define SLOT ((int*)(ws + WS_SLOT))
#define ROWW ((float*)(ws + WS_ROWW))
#define LSE ((float*)(ws + WS_LSE))
#define WRHI ((bf16*)(ws + WS_WRHI))
#define WRLO ((bf16*)(ws + WS_WRLO))
#define WIN ((unsigned char*)(ws + WS_WIN))
#define WBRA ((unsigned char*)(ws + WS_WBRA))
#define WBRB ((unsigned char*)(ws + WS_WBRB))
#define WOUT ((unsigned char*)(ws + WS_WOUT))
#define WGU ((unsigned char*)(ws + WS_WGU))
#define WDN ((unsigned char*)(ws + WS_WDN))
#define X ((float*)(ws + WS_X))
#define H ((bf16*)(ws + WS_H))
#define AQKV ((bf16*)(ws + WS_AQKV))
#define QB ((bf16*)(ws + WS_QB))
#define KB ((bf16*)(ws + WS_KB))
#define VB ((bf16*)(ws + WS_VB))
#define GATE ((bf16*)(ws + WS_GATE))
#define OAG ((bf16*)(ws + WS_OAG))
#define OA ((unsigned char*)(ws + WS_OA))
#define MERGED ((bf16*)(ws + WS_MERGED))
#define OB ((unsigned char*)(ws + WS_OB))
#define M8 ((unsigned char*)(ws + WS_M8))
#define XS ((unsigned char*)(ws + WS_XS))
#define ACT ((unsigned char*)(ws + WS_ACT))
#define YB ((bf16*)(ws + WS_Y))
__global__ void __launch_bounds__(NWAVES * 64, 2) mk_fwd(Args args) {
    extern __shared__ __attribute__((aligned(16))) unsigned char lds[];
    LAS unsigned char* L = (LAS unsigned char*)lds;
    volatile LAS unsigned* MISC = (volatile LAS unsigned*)(L + LDSCTL_OFF);
    gu32* ctl = (gu32*)(args.ws + WS_CTL);
    const int wave_s = __builtin_amdgcn_readfirstlane(threadIdx.x >> 6);
    for (int u = threadIdx.x; u < (LDS_BYTES - LDSCTL_OFF) / 4; u += NWAVES * 64) ((LAS unsigned*)(L + LDSCTL_OFF))[u] = 0u;
    __syncthreads();
    XcdBarrier bar; bar.bar = (unsigned*)(ctl + CW_BAR) + args.li * XCD_BAR_WORDS; bar.x = 0; bar.st = nullptr;
    if (!MK_PER_PHASE) bar = xcd_barrier_post((unsigned*)(ctl + CW_BAR) + args.li * XCD_BAR_WORDS, MISC + 8);
    const int lo = args.ph_lo, hi = args.ph_hi;
#define IN(k) (lo <= (k) && (k) < hi)
#define KIND(q) ((PH_KIND_MASK >> (q)) & 1)
#define SEAM(k) do { if (IN(k) && IN((k) + 1)) xcd_barrier(bar); } while (0)

    for (int rep0 = 0; rep0 < 1 + PROBE_P0; ++rep0) {
    if (KIND(0) && IN(0)) { PH_BEGIN();
        {
            LAS float* cact = (LAS float*)L;
            LAS float* part = (LAS float*)(L + 32768);
            for (int i = tid; i < NB * D; i += NWAVES * 64) { const float cv = c_in[i]; cact[i] = cv / (1.0f + __expf(-cv)); }
            __syncthreads();
            for (int vb = bx; vb < 256; vb += G) {
                const int gc = vb * 48 + lane;
                const int l = gc / 6144, col = gc % 6144;
                float a[NB];
#pragma unroll
                for (int b = 0; b < NB; ++b) a[b] = 0.f;
                if (lane < 48) {
                    const float* wp = w_ada + (size_t)l * D * 6144 + col;
                    for (int k = wave * 128; k < wave * 128 + 128; ++k) { const float w = wp[(size_t)k * 6144];
#pragma unroll
                        for (int b = 0; b < NB; ++b) a[b] += cact[b * D + k] * w; }
                }
#pragma unroll
                for (int b = 0; b < NB; ++b) part[(wave * NB + b) * 64 + lane] = a[b];
                __syncthreads();
                if (tid < NB * 48) { const int b = tid / 48, cl = tid % 48; const int gc2 = vb * 48 + cl; const int l2 = gc2 / 6144, col2 = gc2 % 6144;
                    float s = b_ada[l2 * 6144 + col2];
#pragma unroll
                    for (int w = 0; w < NWAVES; ++w) s += part[(w * NB + b) * 64 + cl];
                    MOD[((size_t)l2 * NB + b) * 6144 + col2] = s; }
                __syncthreads();
            }
        }
        for (int i = gtid; i < 1024 + 12 * 768; i += NGT) {
            if (i < 1024) { const int p = i >> 4, f = i & 15; const double inv = pow(10000.0, -(double)f / 16.0); const double ang = (double)p * inv; ROPE[i] = (float)cos(ang); ROPE[1024 + i] = (float)sin(ang); }
            else { const int j = i - 1024; const int hh = j / 768, di = j % 768; const int delta = di - 383; const int g = hh >> 2; const int dil = g == 0 ? 1 : (g == 1 ? 4 : 16);
                float val = -INFINITY;
                if (delta >= -64 && delta <= 64) { const int rel = delta * dil; const int n = rel < 0 ? -rel : rel; int bk = rel > 0 ? 16 : 0;
                    if (n < 8) bk += n; else { int lg = 8 + (int)(logf((float)n / 8.0f) / logf(128.0f) * 8.0f); if (lg > 15) lg = 15; bk += lg; }
                    val = rel_bias[bk * 12 + hh] * LOG2E; }
                BLUT[j] = val; }
        }
        {
            LAS float* scr = (LAS float*)(L + wave * 16640);
            __syncthreads();
            constexpr int I_IN = 16 * 92, I_BRA = 4 * 16, I_BRB = 16 * 16, I_OUT = 16 * 16, I_GU = 16 * 32, I_DN = 16 * 16;
            constexpr int PER_L = I_IN + I_BRA + I_BRB + I_OUT;
            constexpr int NITEMS = DEPTH * PER_L + DEPTH * NE * (I_GU + I_DN);
            for (int it = gw; it < NITEMS; it += NGW) {
                int r = it;
                if (r < DEPTH * PER_L) {
                    const int l = r / PER_L; r %= PER_L;
                    if (r < I_IN) { const int kb = r / 92, g64 = r % 92; cvt_item_f8(w_in + (size_t)l * D * N_IN, N_IN, D, win_src(2 * g64), win_src(2 * g64 + 1), WIN + (size_t)l * N_IN * D, 64 * g64, 64 * kb, scr, lane, (g64 >> 2) >= 9 && (g64 >> 2) < 14); continue; } r -= I_IN;
                    if (r < I_BRA) { const int kb = r / 16, g64 = r % 16; cvt_item_f8(w_br_a + (size_t)l * 256 * D, D, 256, 64 * g64, 64 * g64 + 32, WBRA + (size_t)l * D * 256, 64 * g64, 64 * kb, scr, lane); continue; } r -= I_BRA;
                    if (r < I_BRB) { const int kb = r / 16, g64 = r % 16; cvt_item_f8(w_br_b + (size_t)l * D * D, D, D, 64 * g64, 64 * g64 + 32, WBRB + (size_t)l * D * D, 64 * g64, 64 * kb, scr, lane); continue; } r -= I_BRB;
                    { const int kb = r / 16, g64 = r % 16; cvt_item_f8(w_out + (size_t)l * D * D, D, D, 64 * g64, 64 * g64 + 32, WOUT + (size_t)l * D * D, 64 * g64, 64 * kb, scr, lane); continue; }
                }
                r -= DEPTH * PER_L;
                if (r < DEPTH * NE * I_GU) { const int le = r / I_GU; r %= I_GU; const int kb = r / 32, g64 = r % 32;
                    cvt_item_f8(w_gate_up + (size_t)le * D * 2048, 2048, D, wgu_src(2 * g64), wgu_src(2 * g64 + 1), WGU + (size_t)le * 2048 * D, 64 * g64, 64 * kb, scr, lane); continue; }
                r -= DEPTH * NE * I_GU;
                { const int le = r / I_DN; r %= I_DN; const int kb = r / 16, g64 = r % 16;
                    cvt_item_f8(w_down + (size_t)le * D * D, D, D, 64 * g64, 64 * g64 + 32, WDN + (size_t)le * D * D, 64 * g64, 64 * kb, scr, lane); }
            }
        }
    }
    SEAM(0);
    }
    if (KIND(1) && IN(1)) { PH_BEGIN();
        for (int m = 2 * gw; m < T; m += 2 * NGW) { const int b = m >> 12; const float* md = MOD + (size_t)b * 6144;
            norm_rows2_f8(x_in + (size_t)m * D, norm1_g, md + 1024, md, (unsigned char*)H + (size_t)m * D, lane); }
        for (int i = gtid; i < DEPTH * NB * NE * D; i += NGT) { const int k = i & 1023, e = (i >> 10) & 31, b = (i >> 15) & 7, l = i >> 18;
            const float v = norm2_g[l * D + k] * (1.0f + MOD[((size_t)l * NB + b) * 6144 + 4 * 1024 + k]) * w_router[((size_t)l * D + k) * NE + e];
            const unsigned hb = f2bf(v); const float lv = v - __uint_as_float(hb << 16);
            WRHI[i] = (bf16)hb; WRLO[i] = (bf16)f2bf(lv); }
        for (int i = gw; i < DEPTH * NB * NE; i += NGW) { const int e = i & 31, b = (i >> 5) & 7, l = i >> 8; float s = 0.f;
            for (int k = lane; k < D; k += 64) s += MOD[((size_t)l * NB + b) * 6144 + 3 * 1024 + k] * w_router[((size_t)l * D + k) * NE + e];
            s = wave_sum(s); if (lane == 0) RC0[i] = s + b_router[l * NE + e]; }
    }
    SEAM(1);

    for (int li = (PROBE_MASK ? -1 : 0); li < DEPTH; ++li) {
        const int l = li < 0 ? 0 : li; const bool virt = li < 0;
        const int P = 2 + 10 * l;
#define VK(q) (!virt || ((PROBE_MASK >> (q)) & 1))
        if (KIND(2) && IN(P + 0) && VK(2)) { PH_BEGIN();
            pg8::Gemm g{H, (const bf16*)(WIN + (size_t)l * N_IN * D), D / 2}; pg8::StaticOrder S; S.init(T, N_IN, G, bx);
            pg8::EpiIn E{AQKV, QB, KB, VB, GATE, q_norm_g + l * 64, k_norm_g + l * 64, ROPE, pg8::W8_INV};
            pg8::gemm_phase_f8<pg8::EpiIn, pg8::StaticOrder>(L, g, S, E, wave);
        }
        if (VK(2)) SEAM(P + 0);
        if (KIND(3) && IN(P + 1) && VK(3)) { PH_BEGIN();
            namespace ab = attn_body;
            for (int j = 0; j < 8; ++j) {
                const int uidx = vcu * 8 + j; if (uidx >= 2048) break;
                const int pair = uidx >> 6, idx = uidx & 63; const int b = pair >> 2, kvh = pair & 3, hq = idx >> 4, qb = idx & 15; const int h = kvh * 4 + hq;
                ab::Job J; J.Q = (const ab::bf16*)QB + ((size_t)b * SEQ + qb * 256) * 1024 + h * 64; J.K = (const ab::bf16*)KB + (size_t)b * SEQ * 256 + kvh * 64; J.V = (const ab::bf16*)VB + (size_t)b * SEQ * 256 + kvh * 64;
                J.O = (ab::bf16*)(OB + ((size_t)b * SEQ + qb * 256) * 1024 + h * 64)  ; J.lse = nullptr; J.lutg = nullptr; J.NT = 64; J.i0 = 0; J.kq0 = 0; J.dsh = 0; J.cls = 0;
                ab::attn_unit<0, 8>(J, (char*)lds, wave);
            }
            for (int j = 0; j < 6; ++j) {
                const int uidx = vcu * 6 + j; if (uidx >= 1536) break;
                const int g = uidx / 512, r = uidx % 512; const int b = r >> 6, hs = (r >> 4) & 3, combo = r & 15;
                const int dsh = 2 * g; const int Lc = SEQ >> dsh; const int nqb = Lc >> 8;
                const int cls = combo / nqb, qb = combo % nqb; const int i0 = qb * 256;
                int t0 = (i0 >> 6) - 1; const int ntile = Lc >> 6; const int NT = ntile >= 6 ? 6 : 4; if (t0 < 0) t0 = 0; if (t0 > ntile - NT) t0 = ntile - NT;
                const size_t cbase = (size_t)b * SEQ + (size_t)cls * Lc;
                const ab::bf16* aq = (const ab::bf16*)AQKV + (size_t)(g * 3 + 0) * T * 256; const ab::bf16* ak = (const ab::bf16*)AQKV + (size_t)(g * 3 + 1) * T * 256; const ab::bf16* av = (const ab::bf16*)AQKV + (size_t)(g * 3 + 2) * T * 256;
                ab::Job J; J.Q = aq + (cbase + i0) * 256 + hs * 64; J.K = ak + (cbase + t0 * 64) * 256 + hs * 64; J.V = av + (cbase + t0 * 64) * 256 + hs * 64;
                J.O = (ab::bf16*)OAG + (size_t)g * T * 256 + (size_t)b * SEQ * 256 + hs * 64; J.lse = LSE + (size_t)g * T * 4 + (size_t)b * SEQ * 4 + hs; J.lutg = BLUT + (g * 4 + hs) * 768;
                J.NT = NT; J.i0 = i0; J.kq0 = t0 * 64 - i0; J.dsh = dsh; J.cls = cls;
                ab::attn_unit<1, 8>(J, (char*)lds, wave);
            }
        }
        if (VK(3)) SEAM(P + 1);
        if (KIND(4) && IN(P + 2) && VK(4)) { PH_BEGIN();
            for (int i = gtid; i < T * 32; i += NGT) { const int t = i >> 5, ch = i & 31, hs = ch >> 3;
                const float l0 = LSE[(size_t)t * 4 + hs], l1 = LSE[(size_t)T * 4 + (size_t)t * 4 + hs], l2 = LSE[(size_t)2 * T * 4 + (size_t)t * 4 + hs];
                const float mx = fmaxf(l0, fmaxf(l1, l2)); float w0 = exp2f(l0 - mx), w1 = exp2f(l1 - mx), w2 = exp2f(l2 - mx); const float inv = 1.0f / (w0 + w1 + w2); w0 *= inv; w1 *= inv; w2 *= inv;
                const v4u a = *(const GAS v4u*)(OAG + (size_t)t * 256 + ch * 8), bq = *(const GAS v4u*)(OAG + (size_t)T * 256 + (size_t)t * 256 + ch * 8), cq = *(const GAS v4u*)(OAG + (size_t)2 * T * 256 + (size_t)t * 256 + ch * 8);
                unsigned o0 = 0, o1 = 0;
                o0 = __builtin_amdgcn_cvt_pk_fp8_f32(w0 * bfl(a.x) + w1 * bfl(bq.x) + w2 * bfl(cq.x), w0 * bfh(a.x) + w1 * bfh(bq.x) + w2 * bfh(cq.x), o0, false);
                o0 = __builtin_amdgcn_cvt_pk_fp8_f32(w0 * bfl(a.y) + w1 * bfl(bq.y) + w2 * bfl(cq.y), w0 * bfh(a.y) + w1 * bfh(bq.y) + w2 * bfh(cq.y), o0, true);
                o1 = __builtin_amdgcn_cvt_pk_fp8_f32(w0 * bfl(a.z) + w1 * bfl(bq.z) + w2 * bfl(cq.z), w0 * bfh(a.z) + w1 * bfh(bq.z) + w2 * bfh(cq.z), o1, false);
                o1 = __builtin_amdgcn_cvt_pk_fp8_f32(w0 * bfl(a.w) + w1 * bfl(bq.w) + w2 * bfl(cq.w), w0 * bfh(a.w) + w1 * bfh(bq.w) + w2 * bfh(cq.w), o1, true);
                v2u o; o.x = o0; o.y = o1; *(GAS v2u*)(OA + (size_t)t * 256 + ch * 8) = o; }
        }
        if (VK(4)) SEAM(P + 2);
        if (KIND(5) && IN(P + 3) && VK(5)) { PH_BEGIN();
            pg8::StaticOrder S; S.init(T, D, G, bx);
            { pg8::Gemm g{(const bf16*)OA, (const bf16*)(WBRA + (size_t)l * D * 256), 128}; pg8::EpiMergeA E{GATE, MERGED}; pg8::gemm_phase_f8<pg8::EpiMergeA, pg8::StaticOrder>(L, g, S, E, wave); }
            { pg8::Gemm g{(const bf16*)OB, (const bf16*)(WBRB + (size_t)l * D * D), D / 2}; pg8::EpiMergeB<true> E{GATE, MERGED, M8}; pg8::gemm_phase_f8<pg8::EpiMergeB<true>, pg8::StaticOrder>(L, g, S, E, wave); }
        }
        if (VK(5)) SEAM(P + 3);
        if (KIND(6) && IN(P + 4) && VK(6)) { PH_BEGIN();
            pg8::Gemm g{(const bf16*)M8, (const bf16*)(WOUT + (size_t)l * D * D), D / 2}; pg8::StaticOrder S; S.init(T, D, G, bx);
            pg8::EpiOut E{l == 0 ? x_in : X, X, MOD + (size_t)l * NB * 6144 + 2 * 1024};
            pg8::gemm_phase_f8<pg8::EpiOut, pg8::StaticOrder>(L, g, S, E, wave);
        }
        if (VK(6)) SEAM(P + 4);
        if (KIND(7) && IN(P + 5) && VK(7)) { PH_BEGIN();
            LAS int* hist = (LAS int*)(L + LDSCTL_OFF + 256);
            for (int vb = bx; vb < 256; vb += G) {
                if (tid < NE) hist[tid] = 0;
                __syncthreads();
                {
                    const int tt = vb + 256 * wave; const int r0 = tt * 16; const int b = r0 >> 12; const int i = lane & 15, kb = lane >> 4;
                    const float* xp = X + (size_t)(r0 + i) * D + 8 * kb;
                    const bf16* bh = WRHI + ((size_t)(l * NB + b) * NE + i) * D + 8 * kb; const bf16* bl = WRLO + ((size_t)(l * NB + b) * NE + i) * D + 8 * kb;
                    f32x4 acc0 = (f32x4){0.f, 0.f, 0.f, 0.f}, acc1 = acc0; float ss = 0.f;
#pragma unroll 4
                    for (int s = 0; s < 32; ++s) {
                        const f32x4 x0 = *(const GAS f32x4*)(xp + 32 * s), x1 = *(const GAS f32x4*)(xp + 32 * s + 4);
                        const bf16x8 wh0 = *(const GAS bf16x8*)(bh + 32 * s), wh1 = *(const GAS bf16x8*)(bh + 16 * D + 32 * s), wl0 = *(const GAS bf16x8*)(bl + 32 * s), wl1 = *(const GAS bf16x8*)(bl + 16 * D + 32 * s);
                        ss += (x0.x * x0.x + x0.y * x0.y) + (x0.z * x0.z + x0.w * x0.w) + (x1.x * x1.x + x1.y * x1.y) + (x1.z * x1.z + x1.w * x1.w);
                        v4u ah, al;
                        { const unsigned h0 = f2bf(x0.x), h1 = f2bf(x0.y), h2 = f2bf(x0.z), h3 = f2bf(x0.w), h4 = f2bf(x1.x), h5 = f2bf(x1.y), h6 = f2bf(x1.z), h7 = f2bf(x1.w);
                          ah.x = h0 | (h1 << 16); ah.y = h2 | (h3 << 16); ah.z = h4 | (h5 << 16); ah.w = h6 | (h7 << 16);
                          al.x = pk2(x0.x - __uint_as_float(h0 << 16), x0.y - __uint_as_float(h1 << 16)); al.y = pk2(x0.z - __uint_as_float(h2 << 16), x0.w - __uint_as_float(h3 << 16));
                          al.z = pk2(x1.x - __uint_as_float(h4 << 16), x1.y - __uint_as_float(h5 << 16)); al.w = pk2(x1.z - __uint_as_float(h6 << 16), x1.w - __uint_as_float(h7 << 16)); }
                        const bf16x8 ahv = __builtin_bit_cast(bf16x8, ah), alv = __builtin_bit_cast(bf16x8, al);
                        acc0 = __builtin_amdgcn_mfma_f32_16x16x32_bf16(wh0, ahv, acc0, 0, 0, 0); acc1 = __builtin_amdgcn_mfma_f32_16x16x32_bf16(wh1, ahv, acc1, 0, 0, 0);
                        acc0 = __builtin_amdgcn_mfma_f32_16x16x32_bf16(wl0, ahv, acc0, 0, 0, 0); acc1 = __builtin_amdgcn_mfma_f32_16x16x32_bf16(wl1, ahv, acc1, 0, 0, 0);
                        acc0 = __builtin_amdgcn_mfma_f32_16x16x32_bf16(wh0, alv, acc0, 0, 0, 0); acc1 = __builtin_amdgcn_mfma_f32_16x16x32_bf16(wh1, alv, acc1, 0, 0, 0);
                    }
                    ss = xsum<16>(ss); ss = xsum<32>(ss);
                    const float rs = rsqrtf(ss * (1.0f / D) + EPS);
                    float v[8]; const float* rc = RC0 + (l * NB + b) * NE;
#pragma unroll
                    for (int r = 0; r < 4; ++r) { v[r] = rs * acc0[r] + rc[4 * kb + r]; v[4 + r] = rs * acc1[r] + rc[16 + 4 * kb + r]; }
                    float tv[4]; int ti[4];
#pragma unroll
                    for (int k = 0; k < 4; ++k) { float best = v[0]; int br = 0;
#pragma unroll
                        for (int r = 1; r < 8; ++r) if (v[r] > best) { best = v[r]; br = r; }
#pragma unroll
                        for (int r = 0; r < 8; ++r) v[r] = (r == br) ? -INFINITY : v[r];
                        tv[k] = best; ti[k] = (br & 3) + 16 * (br >> 2) + 4 * kb; }
#pragma unroll
                    for (int round = 0; round < 2; ++round) {
                        float bv[8]; int bi[8];
#pragma unroll
                        for (int k = 0; k < 4; ++k) { bv[k] = tv[k]; bi[k] = ti[k];
                            if (round == 0) { bv[4 + k] = __int_as_float(__builtin_amdgcn_ds_swizzle(__float_as_int(tv[k]), 0x1f | (16 << 10))); bi[4 + k] = __builtin_amdgcn_ds_swizzle(ti[k], 0x1f | (16 << 10)); }
                            else { bv[4 + k] = xget32(tv[k], lane >> 5); bi[4 + k] = xget32(ti[k], lane >> 5); } }
#pragma unroll
                        for (int k = 0; k < 4; ++k) { float best = bv[0]; int bq = 0;
#pragma unroll
                            for (int r = 1; r < 8; ++r) if (bv[r] > best || (bv[r] == best && bi[r] < bi[bq])) { best = bv[r]; bq = r; }
                            int sel = bi[0];
#pragma unroll
                            for (int r = 0; r < 8; ++r) { if (r == bq) sel = bi[r]; }
#pragma unroll
                            for (int r = 0; r < 8; ++r) bv[r] = (r == bq) ? -INFINITY : bv[r];
                            tv[k] = best; ti[k] = sel; }
                    }
                    if (kb == 0) {
                        const float e1 = __expf(tv[1] - tv[0]), e2 = __expf(tv[2] - tv[0]), e3 = __expf(tv[3] - tv[0]); const float inv = 1.0f / (1.0f + e1 + e2 + e3);
                        const int tok = r0 + i;
                        *(GAS i32x4*)(TOPE + (size_t)tok * 4) = (i32x4){ti[0], ti[1], ti[2], ti[3]};
                        *(GAS f32x4*)(TOPW + (size_t)tok * 4) = (f32x4){inv, e1 * inv, e2 * inv, e3 * inv};
#pragma unroll
                        for (int k = 0; k < 4; ++k) atomicAdd((int*)&hist[ti[k]], 1);
                    }
                }
                __syncthreads();
                if (tid < NE) HIST[vb * NE + tid] = hist[tid];
                __syncthreads();
            }
            for (int m = 2 * gw; m < T; m += 2 * NGW) { const int b = m >> 12; const float* md = MOD + ((size_t)l * NB + b) * 6144;
                norm_rows2_f8(X + (size_t)m * D, norm2_g + l * D, md + 4 * 1024, md + 3 * 1024, (unsigned char*)H + (size_t)m * D, lane); }
        }
        if (VK(7)) SEAM(P + 5);
        if (KIND(8) && IN(P + 6) && VK(8)) { PH_BEGIN();
            LAS int* sm = (LAS int*)L;
            for (int vb = bx; vb < 256; vb += G) {
                { const int e = tid & 31, seg = tid >> 5; int tot = 0, bef = 0;
                    for (int q = seg * 16; q < seg * 16 + 16; ++q) { const int hv = HIST[q * NE + e]; tot += hv; if (q < vb) bef += hv; }
                    sm[tid] = tot; sm[512 + tid] = bef; }
                __syncthreads();
                if (tid < NE) { int tot = 0, bef = 0;
                    for (int s = 0; s < 16; ++s) { tot += sm[s * 32 + tid]; bef += sm[512 + s * 32 + tid]; }
                    sm[1024 + tid] = bef; sm[1056 + tid] = (tot + 255) & ~255; }
                __syncthreads();
                if (tid == 0) { int run = 0; for (int e = 0; e < NE; ++e) { const int pd = sm[1056 + e]; sm[1056 + e] = run; sm[1024 + e] += run;
                        if (vb == 0) { for (int q = run >> 8; q < (run + pd) >> 8; ++q) TILEE[q] = e; }
                        run += pd; }
                    if (vb == 0) TILEE[1000] = run >> 8; }
                __syncthreads();
                if (tid < 128) { const int tt = vb + 256 * (tid >> 4); const int tok = tt * 16 + (tid & 15);
                    const i32x4 te = *(const GAS i32x4*)(TOPE + (size_t)tok * 4); const f32x4 tw = *(const GAS f32x4*)(TOPW + (size_t)tok * 4);
                    const int s0 = atomicAdd((int*)&sm[1024 + te.x], 1), s1 = atomicAdd((int*)&sm[1024 + te.y], 1), s2 = atomicAdd((int*)&sm[1024 + te.z], 1), s3 = atomicAdd((int*)&sm[1024 + te.w], 1);
                    *(GAS i32x4*)(SLOT + (size_t)tok * 4) = (i32x4){s0, s1, s2, s3};
                    ROWW[s0] = tw.x; ROWW[s1] = tw.y; ROWW[s2] = tw.z; ROWW[s3] = tw.w;
                    sm[2048 + tid * 4 + 0] = s0; sm[2048 + tid * 4 + 1] = s1; sm[2048 + tid * 4 + 2] = s2; sm[2048 + tid * 4 + 3] = s3; }
                __syncthreads();
                for (int p = wave; p < 512; p += NWAVES) { const int q = p >> 2; const int tt = vb + 256 * (q >> 4); const int tok = tt * 16 + (q & 15); const int slot = sm[2048 + p];
                    const GAS v4u* src = (const GAS v4u*)((unsigned char*)H + (size_t)tok * D); GAS v4u* dst = (GAS v4u*)(XS + (size_t)slot * D);
                    dst[lane] = src[lane]; }
                __syncthreads();
            }
        }
        if (VK(8)) SEAM(P + 6);
        if (KIND(9) && IN(P + 7) && VK(9)) { PH_BEGIN();
            const int nmt = __builtin_amdgcn_readfirstlane(__hip_atomic_load(TILEE + 1000, __ATOMIC_RELAXED, __HIP_MEMORY_SCOPE_AGENT));
            pg8::Gemm g{(const bf16*)XS, (const bf16*)(WGU + (size_t)l * NE * 2048 * D), D / 2}; pg8::MoeOrder S{TILEE, nmt * 8, 8, G, vcu};
            pg8::EpiGU8 E{b_gate_up + (size_t)l * NE * 2048, ACT};
            pg8::gemm_phase_f8<pg8::EpiGU8, pg8::MoeOrder>(L, g, S, E, wave);
        }
        if (VK(9)) SEAM(P + 7);
        if (KIND(10) && IN(P + 8) && VK(10)) { PH_BEGIN();
            const int nmt = __builtin_amdgcn_readfirstlane(__hip_atomic_load(TILEE + 1000, __ATOMIC_RELAXED, __HIP_MEMORY_SCOPE_AGENT));
            pg8::Gemm g{(const bf16*)ACT, (const bf16*)(WDN + (size_t)l * NE * D * D), D / 2}; pg8::MoeOrder S{TILEE, nmt * 4, 4, G, vcu};
            pg8::EpiDN8 E{b_down + (size_t)l * NE * D, ROWW, YB};
            pg8::gemm_phase_f8<pg8::EpiDN8, pg8::MoeOrder>(L, g, S, E, wave);
        }
        if (VK(10)) SEAM(P + 8);
        if (KIND(11) && IN(P + 9) && VK(11)) { PH_BEGIN();
            const bool lastl = (l == DEPTH - 1);
            float* Xw = virt ? (float*)(ws + WS_R) : X; bf16* Hw = virt ? (bf16*)(ws + WS_R + 128 * MiB) : H;
            for (int m0 = 2 * gw; m0 < T; m0 += 2 * NGW) { const int b = m0 >> 12;
                i32x4 sl[2];
#pragma unroll
                for (int q = 0; q < 2; ++q) { const int* sp = SLOT + (size_t)(m0 + q) * 4;
                    sl[q].x = __hip_atomic_load(sp + 0, RLX_AGENT); sl[q].y = __hip_atomic_load(sp + 1, RLX_AGENT); sl[q].z = __hip_atomic_load(sp + 2, RLX_AGENT); sl[q].w = __hip_atomic_load(sp + 3, RLX_AGENT); }
                const float* g2 = MOD + ((size_t)l * NB + b) * 6144 + 5 * 1024;
                f32x4 v[2][4]; v2u yy[2][4][4];
#pragma unroll
                for (int q = 0; q < 2; ++q)
#pragma unroll
                    for (int j = 0; j < 4; ++j) { const int c = 256 * j + 4 * lane;
                        v[q][j] = *(const GAS f32x4*)(X + (size_t)(m0 + q) * D + c);
                        yy[q][j][0] = *(const GAS v2u*)(YB + (size_t)sl[q].x * D + c); yy[q][j][1] = *(const GAS v2u*)(YB + (size_t)sl[q].y * D + c);
                        yy[q][j][2] = *(const GAS v2u*)(YB + (size_t)sl[q].z * D + c); yy[q][j][3] = *(const GAS v2u*)(YB + (size_t)sl[q].w * D + c); }
                float s[2] = {0.f, 0.f};
#pragma unroll
                for (int q = 0; q < 2; ++q)
#pragma unroll
                    for (int j = 0; j < 4; ++j) { const int c = 256 * j + 4 * lane; const v2u y0 = yy[q][j][0], y1 = yy[q][j][1], y2 = yy[q][j][2], y3 = yy[q][j][3];
                        f32x4 ys; ys.x = (bfl(y0.x) + bfl(y1.x)) + (bfl(y2.x) + bfl(y3.x)); ys.y = (bfh(y0.x) + bfh(y1.x)) + (bfh(y2.x) + bfh(y3.x));
                        ys.z = (bfl(y0.y) + bfl(y1.y)) + (bfl(y2.y) + bfl(y3.y)); ys.w = (bfh(y0.y) + bfh(y1.y)) + (bfh(y2.y) + bfh(y3.y));
                        const f32x4 gg = *(const GAS f32x4*)(g2 + c);
                        v[q][j] = v[q][j] + gg * ys;
                        if (!lastl) *(GAS f32x4*)(Xw + (size_t)(m0 + q) * D + c) = v[q][j];
                        s[q] += (v[q][j].x * v[q][j].x + v[q][j].y * v[q][j].y) + (v[q][j].z * v[q][j].z + v[q][j].w * v[q][j].w); }
                const float rs0 = rsqrtf(wave_sum(s[0]) * (1.0f / D) + EPS), rs1 = rsqrtf(wave_sum(s[1]) * (1.0f / D) + EPS);
                if (!lastl) { const float* md = MOD + ((size_t)(l + 1) * NB + b) * 6144; const float* gn = norm1_g + (l + 1) * D;
#pragma unroll
                    for (int j = 0; j < 4; ++j) { const int c = 256 * j + 4 * lane;
                        const f32x4 gg = *(const GAS f32x4*)(gn + c), a1 = *(const GAS f32x4*)(md + 1024 + c) + 1.0f, a0 = *(const GAS f32x4*)(md + c);
                        const f32x4 y0 = (v[0][j] * rs0 * gg) * a1 + a0, y1 = (v[1][j] * rs1 * gg) * a1 + a0;
                        unsigned w0 = 0, w1 = 0;
                        w0 = __builtin_amdgcn_cvt_pk_fp8_f32(y0.x, y0.y, w0, false); w0 = __builtin_amdgcn_cvt_pk_fp8_f32(y0.z, y0.w, w0, true);
                        w1 = __builtin_amdgcn_cvt_pk_fp8_f32(y1.x, y1.y, w1, false); w1 = __builtin_amdgcn_cvt_pk_fp8_f32(y1.z, y1.w, w1, true);
                        *(GAS unsigned*)((unsigned char*)Hw + (size_t)m0 * D + c) = w0; *(GAS unsigned*)((unsigned char*)Hw + (size_t)(m0 + 1) * D + c) = w1; }
                } else {
#pragma unroll
                    for (int j = 0; j < 4; ++j) { const int c = 256 * j + 4 * lane; const f32x4 gg = *(const GAS f32x4*)(final_g + c);
                        *(GAS f32x4*)(ap->out + (size_t)m0 * D + c) = v[0][j] * rs0 * gg; *(GAS f32x4*)(ap->out + (size_t)(m0 + 1) * D + c) = v[1][j] * rs1 * gg; }
                }
            }
        }
        if (VK(11)) SEAM(P + 9);
        if (virt) { PH_BEGIN();
            for (int m = 2 * gw; m < T; m += 2 * NGW) { const int b = m >> 12; const float* md = MOD + (size_t)b * 6144; norm_rows2_f8(x_in + (size_t)m * D, norm1_g, md + 1024, md, (unsigned char*)H + (size_t)m * D, lane); }
            xcd_barrier(bar); }
    }
#undef IN
#undef SEAM
}

extern "C" void kernel_launch(void* const* d_in, const int* in_sizes, int n_in, void* d_out, int out_size, void* d_ws, size_t ws_size, hipStream_t stream) {
    static int grid = 0;
    if (grid == 0) {
        if (n_in != 20 || in_sizes[0] != T * D || out_size != T * D || ws_size < WS_END) { fprintf(stderr, "kernel_launch: unexpected shapes (n_in %d, in0 %d, out %d, ws %zu < %zu); nothing launched\n", n_in, n_in > 0 ? in_sizes[0] : -1, out_size, ws_size, (size_t)WS_END); grid = -1; return; }
        int dev = 0, cus = 0, per_cu = 0;
        if (hipGetDevice(&dev) != hipSuccess || hipDeviceGetAttribute(&cus, hipDeviceAttributeMultiprocessorCount, dev) != hipSuccess) { grid = -1; return; }
        if (hipFuncSetAttribute((const void*)mk_fwd, hipFuncAttributeMaxDynamicSharedMemorySize, LDS_BYTES) != hipSuccess) { fprintf(stderr, "kernel_launch: hipFuncSetAttribute failed\n"); grid = -1; return; }
        if (hipOccupancyMaxActiveBlocksPerMultiprocessor(&per_cu, (const void*)mk_fwd, NWAVES * 64, LDS_BYTES) != hipSuccess || per_cu < 1)
            fprintf(stderr, "kernel_launch: note: occupancy query reports %d workgroups per CU\n", per_cu);
        (void)hipGetLastError();
        grid = cus < 256 ? cus : 256;
        if (grid != 256) fprintf(stderr, "kernel_launch: %d CUs; this kernel's unit deals assume 256\n", grid);
    }
    if (grid < 0) return;
    if (hipMemsetAsync((char*)d_ws + WS_CTL, 0, CTL_ZERO_BYTES, stream) != hipSuccess) { fprintf(stderr, "kernel_launch: memset failed\n"); return; }
    Args a{};
    for (int i = 0; i < 20; ++i) a.in[i] = (const float*)d_in[i];
    a.out = (float*)d_out; a.ws = (unsigned char*)d_ws; a.pad = 0;
#if MK_PER_PHASE
    for (int p = 0; p < N_PHASES; ++p) { a.ph_lo = p; a.ph_hi = p + 1; a.li = 0; hipLaunchKernelGGL(mk_fwd, dim3(grid), dim3(NWAVES * 64), LDS_BYTES, stream, a); }
#else
    a.ph_lo = 0; a.ph_hi = N_PHASES; a.li = 0;
    hipLaunchKernelGGL(mk_fwd, dim3(grid), dim3(NWAVES * 64), LDS_BYTES, stream, a);
#endif
    const hipError_t le = hipPeekAtLastError();
    if (le != hipSuccess) fprintf(stderr, "kernel_launch: launch failed: %s\n", hipGetErrorName(le));
}
```

```cpp
#include <hip/hip_runtime.h>
#include <hip/hip_bf16.h>
#include <cstdio>
#include <cstdint>
#include <cmath>

#ifndef PH_KIND_MASK
#define PH_KIND_MASK 0xFFF
#endif
#ifndef PROBE_MASK
#define PROBE_MASK 0
#endif
#ifndef PROBE_P0
#define PROBE_P0 0
#endif
#ifndef MK_PER_PHASE
#define MK_PER_PHASE 0
#endif

constexpr int NB = 8, SEQ = 4096, T = NB * SEQ, D = 1024, DEPTH = 2;
constexpr int N_IN = 5888, NE = 32, TOPK = 4;
constexpr int NASSIGN = T * TOPK;
constexpr int MAX_MT = NASSIGN / 256 + NE;
constexpr int CAP_ROWS = MAX_MT * 256;
constexpr float C2 = 0.125f * 1.4426950408889634f;
constexpr float LOG2E = 1.4426950408889634f;
constexpr float EPS = 1e-6f;

__device__ __forceinline__ int lane_id_asm() { int l; asm volatile("v_mbcnt_lo_u32_b32 %0, -1, 0\n\tv_mbcnt_hi_u32_b32 %0, -1, %0" : "=v"(l)); return l; }

template <int M> __device__ __forceinline__ float xsum(float v) {
    if constexpr (M < 32) return v + __int_as_float(__builtin_amdgcn_ds_swizzle(__float_as_int(v), 0x1f | (M << 10)));
    else { auto rr = __builtin_amdgcn_permlane32_swap(__float_as_uint(v), __float_as_uint(v), false, false); return __uint_as_float(rr[0]) + __uint_as_float(rr[1]); }
}
template <class Tv> __device__ __forceinline__ Tv xget32(Tv v, int hf) {
    auto rr = __builtin_amdgcn_permlane32_swap(__builtin_bit_cast(unsigned, v), __builtin_bit_cast(unsigned, v), false, false); return __builtin_bit_cast(Tv, hf ? rr[0] : rr[1]);
}

namespace pg8 {
#define PG8_LAS __attribute__((address_space(3)))
typedef unsigned short bf16_t;
typedef short bf16x8 __attribute__((ext_vector_type(8)));
typedef float f32x4 __attribute__((ext_vector_type(4)));
typedef unsigned u32x4 __attribute__((ext_vector_type(4)));
typedef unsigned u32x2 __attribute__((ext_vector_type(2)));
constexpr int BM = 256, BK = 64, HALF = 128, HTB = HALF * BK * 2, STAGE_BYTES = 8 * HTB, NXCD = 8, WGM = 8;

__host__ __device__ __forceinline__ int lds_byte(int r, int c) { const int st = (r >> 4) * 2 + (c >> 5), rr = r & 15, cc = c & 31, ob = rr * 64 + cc * 2; return st * 1024 + (ob ^ (((ob >> 9) & 1) << 5)); }
__host__ __device__ __forceinline__ void stage_rc(int b, int& R, int& C) { const int st = b / 1024, sb = b % 1024, swz = sb ^ (((sb >> 9) & 1) << 5); R = (st >> 1) * 16 + swz / 64; C = (st & 1) * 32 + (swz % 64) / 2; }
__host__ __device__ __forceinline__ int perm32(int rho) { const int n = rho >> 4, i = rho & 15; return 8 * (i >> 2) + 4 * n + (i & 3); }

struct Unit { int pm, pn; };
struct Gemm { const bf16_t* A; const bf16_t* Bt; int K; };

struct StaticOrder {
    int nM, nN, nwg, G, c;
    __device__ void init(int M, int N, int G_, int c_) { nM = M / BM; nN = N / BM; nwg = nM * nN; G = G_; c = c_; }
    __device__ bool next(int i, Unit& u) const {
        const long L = (long)i * G + c; if (L >= nwg) return false;
        int wgid = (int)L; { const int q = nwg / NXCD, r = nwg % NXCD, xcd = wgid % NXCD, off = wgid / NXCD; wgid = (xcd < r ? xcd * (q + 1) : r * (q + 1) + (xcd - r) * q) + off; }
        const int nig = WGM * nN, gid = wgid / nig, fm = gid * WGM, gsz = (nM - fm) < WGM ? (nM - fm) : WGM;
        u.pm = fm + ((wgid % nig) % gsz); u.pn = (wgid % nig) / gsz; return true;
    }
};
struct MoeOrder {
    const int* tile_e; int n_units, nN, G, vcu;
    __device__ bool next(int i, Unit& u) const {
        const long L = (long)i * G + vcu; if (L >= n_units) return false;
        const int mt = (int)L / nN, pl = (int)L % nN; const int e = __builtin_amdgcn_readfirstlane(__hip_atomic_load(tile_e + mt, __ATOMIC_RELAXED, __HIP_MEMORY_SCOPE_AGENT));
        u.pm = mt; u.pn = e * nN + pl; return true;
    }
};

__device__ __forceinline__ unsigned cvt_pk_bf16(float lo, float hi) { unsigned r; asm volatile("v_cvt_pk_bf16_f32 %0, %1, %2" : "=v"(r) : "v"(lo), "v"(hi)); return r; }
__device__ __forceinline__ float bf_lo(unsigned w) { return __uint_as_float(w << 16); }
__device__ __forceinline__ float bf_hi(unsigned w) { return __uint_as_float(w & 0xffff0000u); }
__device__ __forceinline__ float sigmoid_f(float x) { return __builtin_amdgcn_rcpf(1.0f + __builtin_amdgcn_exp2f(-LOG2E * x)); }

template <class Epi, class Sched>
__device__ __forceinline__ void gemm_phase(PG8_LAS unsigned char* lds, const Gemm g, const Sched& S, const Epi& E, const int wid_in) {
    int wid = wid_in; asm volatile("" : "+s"(wid));
    const int lane = lane_id_asm(), tid = wid * 64 + lane, wr = wid >> 2, wc = wid & 3, fr = lane & 15, fq = lane >> 4;
    int K_o = g.K; asm volatile("" : "+s"(K_o)); const int K = K_o, nt = K / BK;
    unsigned voff[2];
#pragma unroll
    for (int i = 0; i < 2; ++i) { int R, C; stage_rc(tid * 16 + i * 8192, R, C); voff[i] = (unsigned)(R * K + C) * 2u; }
    const size_t kstep = (size_t)(BK * 2);
    const size_t hstep = (size_t)HALF * K * 2;
    const size_t tstep = 2 * hstep;
    const unsigned ldsw = (unsigned)wid * 1024u;
    const int aoff = lds_byte(wr * 64 + fr, fq * 8), boff = lds_byte(wc * 32 + fr, fq * 8);
#define PG8_SA(b, h) (((b) * 2 + (h)) * HTB)
#define PG8_SB(b, h) ((4 + (b) * 2 + (h)) * HTB)
#define PG8_STAGE(bufoff, gbase) do { _Pragma("unroll") for (int _i = 0; _i < 2; ++_i) \
        __builtin_amdgcn_global_load_lds((const unsigned*)((const char*)(gbase) + voff[_i]), (PG8_LAS unsigned*)(lds + (bufoff) + ldsw + _i * 8192), 16, 0, 0); } while (0)
#define PG8_LDA(dst, b, h) do { _Pragma("unroll") for (int m = 0; m < 4; ++m) _Pragma("unroll") for (int k = 0; k < 2; ++k) dst[m][k] = *(const PG8_LAS bf16x8*)(lds + PG8_SA(b, h) + aoff + m * 2048 + k * 1024); } while (0)
#define PG8_LDB(dst, b, h) do { _Pragma("unroll") for (int n = 0; n < 2; ++n) _Pragma("unroll") for (int k = 0; k < 2; ++k) dst[n][k] = *(const PG8_LAS bf16x8*)(lds + PG8_SB(b, h) + boff + n * 2048 + k * 1024); } while (0)
#define PG8_MMA(ai, bj, At, Bt) do { __builtin_amdgcn_s_setprio(1); _Pragma("unroll") for (int m = 0; m < 4; ++m) _Pragma("unroll") for (int n = 0; n < 2; ++n) _Pragma("unroll") for (int k = 0; k < 2; ++k) \
        acc[ai][bj][m][n] = __builtin_amdgcn_mfma_f32_16x16x32_bf16(Bt[n][k], At[m][k], acc[ai][bj][m][n], 0, 0, 0); __builtin_amdgcn_s_setprio(0); } while (0)
#define PG8_WAIT_V(n) asm volatile("s_waitcnt vmcnt(" #n ")" ::: "memory")
#define PG8_WAIT_L(n) asm volatile("s_waitcnt lgkmcnt(" #n ")" ::: "memory")
#define PG8_BAR __builtin_amdgcn_s_barrier()
#define PG8_SCHED __builtin_amdgcn_sched_barrier(0)
    Unit cur, nxt; int ui = 0;
    if (!S.next(0, cur)) return;
    f32x4 acc[2][2][4][2];
#pragma unroll
    for (int a = 0; a < 2; ++a)
#pragma unroll
        for (int b = 0; b < 2; ++b)
#pragma unroll
            for (int m = 0; m < 4; ++m)
#pragma unroll
                for (int n = 0; n < 2; ++n) acc[a][b][m][n] = (f32x4){0.f, 0.f, 0.f, 0.f};
    bf16x8 At[4][2], B0[2][2], B1[2][2];
    const char* cA = (const char*)g.A + (size_t)cur.pm * tstep; const char* cB = (const char*)g.Bt + (size_t)cur.pn * tstep;
    PG8_STAGE(PG8_SB(0, 0), cB); PG8_STAGE(PG8_SB(0, 1), cB + hstep); PG8_STAGE(PG8_SA(0, 0), cA); PG8_STAGE(PG8_SA(0, 1), cA + hstep);
    if (wr == 1) PG8_BAR;
    PG8_WAIT_V(2); PG8_BAR;
    PG8_STAGE(PG8_SB(1, 0), cB + kstep); PG8_STAGE(PG8_SA(1, 0), cA + kstep); PG8_STAGE(PG8_SB(1, 1), cB + hstep + kstep);
    PG8_WAIT_V(6); PG8_BAR;
    for (;;) {
        const bool has_next = S.next(ui + 1, nxt);
        const char* nA = has_next ? (const char*)g.A + (size_t)nxt.pm * tstep : cA; const char* nB = has_next ? (const char*)g.Bt + (size_t)nxt.pn * tstep : cB;
        for (int t = 0; t < nt; t += 2) {
            const bool last = (t == nt - 2);
            const char* a1 = cA + (size_t)(t + 1) * kstep;
            const char* a2 = last ? nA : cA + (size_t)(t + 2) * kstep; const char* b2 = last ? nB : cB + (size_t)(t + 2) * kstep;
            const char* a3 = a2 + kstep; const char* b3 = b2 + kstep;
            PG8_LDB(B0, 0, 0); PG8_LDB(B1, 0, 1); PG8_SCHED; PG8_LDA(At, 0, 0); PG8_STAGE(PG8_SA(1, 1), a1 + hstep);
            PG8_WAIT_V(8); PG8_WAIT_L(0); PG8_BAR; PG8_MMA(0, 0, At, B0); PG8_MMA(0, 1, At, B1); PG8_BAR; PG8_SCHED;
            PG8_LDA(At, 0, 1); PG8_STAGE(PG8_SB(0, 0), b2); PG8_STAGE(PG8_SB(0, 1), b2 + hstep); PG8_STAGE(PG8_SA(0, 0), a2);
            PG8_WAIT_V(8); PG8_WAIT_L(0); PG8_BAR; PG8_MMA(1, 0, At, B0); PG8_MMA(1, 1, At, B1); PG8_BAR; PG8_SCHED;
            PG8_LDB(B0, 1, 0); PG8_LDB(B1, 1, 1); PG8_SCHED; PG8_LDA(At, 1, 0); PG8_STAGE(PG8_SA(0, 1), a2 + hstep);
            PG8_WAIT_V(8); PG8_WAIT_L(0); PG8_BAR; PG8_MMA(0, 0, At, B0); PG8_MMA(0, 1, At, B1); PG8_BAR; PG8_SCHED;
            PG8_LDA(At, 1, 1); PG8_STAGE(PG8_SB(1, 0), b3); PG8_STAGE(PG8_SB(1, 1), b3 + hstep); PG8_STAGE(PG8_SA(1, 0), a3);
            PG8_WAIT_V(8); PG8_WAIT_L(0); PG8_BAR; PG8_MMA(1, 0, At, B0); PG8_MMA(1, 1, At, B1); PG8_BAR; PG8_SCHED;
        }
        if (wr == 0) PG8_BAR;
        E(acc, cur, wr, wc, fr, fq);
        if (!has_next) break;
#pragma unroll
        for (int a = 0; a < 2; ++a)
#pragma unroll
            for (int b = 0; b < 2; ++b)
#pragma unroll
                for (int m = 0; m < 4; ++m)
#pragma unroll
                    for (int n = 0; n < 2; ++n) acc[a][b][m][n] = (f32x4){0.f, 0.f, 0.f, 0.f};
        cur = nxt; cA = nA; cB = nB; ++ui;
        if (wr == 1) PG8_BAR;
    }
    PG8_WAIT_V(0);
    PG8_BAR;
#undef PG8_SA
#undef PG8_SB
#undef PG8_STAGE
#undef PG8_LDA
#undef PG8_LDB
#undef PG8_MMA
#undef PG8_WAIT_V
#undef PG8_WAIT_L
#undef PG8_BAR
#undef PG8_SCHED
}

typedef int i32x4_t __attribute__((ext_vector_type(4)));
template <class Epi, class Sched>
__device__ __forceinline__ void gemm_phase_f8(PG8_LAS unsigned char* lds, const Gemm g, const Sched& S, const Epi& E, const int wid_in) {
    int wid = wid_in; asm volatile("" : "+s"(wid));
    const int lane = lane_id_asm(), tid = wid * 64 + lane, wr = wid >> 2, wc = wid & 3, fr = lane & 15, fq = lane >> 4;
    int K_o = g.K; asm volatile("" : "+s"(K_o)); const int K = K_o, nt = K / BK;
    unsigned voff[2];
#pragma unroll
    for (int i = 0; i < 2; ++i) { int R, C; stage_rc(tid * 16 + i * 8192, R, C); voff[i] = (unsigned)(R * K + C) * 2u; }
    const size_t kstep = (size_t)(BK * 2);
    const size_t hstep = (size_t)HALF * K * 2;
    const size_t tstep = 2 * hstep;
    const unsigned ldsw = (unsigned)wid * 1024u;
    const int aoff = lds_byte(wr * 64 + fr, fq * 16), boff = lds_byte(wc * 32 + fr, fq * 16);
#define PG8_SA(b, h) (((b) * 2 + (h)) * HTB)
#define PG8_SB(b, h) ((4 + (b) * 2 + (h)) * HTB)
#define PG8_STAGE(bufoff, gbase) do { _Pragma("unroll") for (int _i = 0; _i < 2; ++_i) \
        __builtin_amdgcn_global_load_lds((const unsigned*)((const char*)(gbase) + voff[_i]), (PG8_LAS unsigned*)(lds + (bufoff) + ldsw + _i * 8192), 16, 0, 0); } while (0)
#define PG8_LDA(dst, b, h) do { _Pragma("unroll") for (int m = 0; m < 4; ++m) _Pragma("unroll") for (int k = 0; k < 2; ++k) dst[m][k] = *(const PG8_LAS bf16x8*)(lds + PG8_SA(b, h) + aoff + m * 2048 + k * 16); } while (0)
#define PG8_LDB(dst, b, h) do { _Pragma("unroll") for (int n = 0; n < 2; ++n) _Pragma("unroll") for (int k = 0; k < 2; ++k) dst[n][k] = *(const PG8_LAS bf16x8*)(lds + PG8_SB(b, h) + boff + n * 2048 + k * 16); } while (0)
#define PG8_F8(x) __builtin_shufflevector(__builtin_bit_cast(i32x4_t, (x)[0]), __builtin_bit_cast(i32x4_t, (x)[1]), 0, 1, 2, 3, 4, 5, 6, 7)
#define PG8_MMA(ai, bj, At, Bt) do { __builtin_amdgcn_s_setprio(1); asm volatile("s_nop 1" ::: ); _Pragma("unroll") for (int m = 0; m < 4; ++m) _Pragma("unroll") for (int n = 0; n < 2; ++n) \
        asm volatile("v_mfma_f32_16x16x128_f8f6f4 %0, %1, %2, %0" : "+v"(acc[ai][bj][m][n]) : "v"(PG8_F8(Bt[n])), "v"(PG8_F8(At[m]))); __builtin_amdgcn_s_setprio(0); } while (0)
#define PG8_ACC_SETTLE asm volatile("s_nop 15\n\ts_nop 15" ::: "memory")
#define PG8_WAIT_V(n) asm volatile("s_waitcnt vmcnt(" #n ")" ::: "memory")
#define PG8_WAIT_L(n) asm volatile("s_waitcnt lgkmcnt(" #n ")" ::: "memory")
#define PG8_BAR __builtin_amdgcn_s_barrier()
#define PG8_SCHED __builtin_amdgcn_sched_barrier(0)
    Unit cur, nxt; int ui = 0;
    if (!S.next(0, cur)) return;
    f32x4 acc[2][2][4][2];
#pragma unroll
    for (int a = 0; a < 2; ++a)
#pragma unroll
        for (int b = 0; b < 2; ++b)
#pragma unroll
            for (int m = 0; m < 4; ++m)
#pragma unroll
                for (int n = 0; n < 2; ++n) acc[a][b][m][n] = (f32x4){0.f, 0.f, 0.f, 0.f};
    bf16x8 At[4][2], B0[2][2], B1[2][2];
    const char* cA = (const char*)g.A + (size_t)cur.pm * tstep; const char* cB = (const char*)g.Bt + (size_t)cur.pn * tstep;
    PG8_STAGE(PG8_SB(0, 0), cB); PG8_STAGE(PG8_SB(0, 1), cB + hstep); PG8_STAGE(PG8_SA(0, 0), cA); PG8_STAGE(PG8_SA(0, 1), cA + hstep);
    if (wr == 1) PG8_BAR;
    PG8_WAIT_V(2); PG8_BAR;
    PG8_STAGE(PG8_SB(1, 0), cB + kstep); PG8_STAGE(PG8_SA(1, 0), cA + kstep); PG8_STAGE(PG8_SB(1, 1), cB + hstep + kstep);
    PG8_WAIT_V(6); PG8_BAR;
    for (;;) {
        const bool has_next = S.next(ui + 1, nxt);
        const char* nA = has_next ? (const char*)g.A + (size_t)nxt.pm * tstep : cA; const char* nB = has_next ? (const char*)g.Bt + (size_t)nxt.pn * tstep : cB;
        for (int t = 0; t < nt; t += 2) {
            const bool last = (t == nt - 2);
            const char* a1 = cA + (size_t)(t + 1) * kstep;
            const char* a2 = last ? nA : cA + (size_t)(t + 2) * kstep; const char* b2 = last ? nB : cB + (size_t)(t + 2) * kstep;
            const char* a3 = a2 + kstep; const char* b3 = b2 + kstep;
            PG8_LDB(B0, 0, 0); PG8_LDB(B1, 0, 1); PG8_SCHED; PG8_LDA(At, 0, 0); PG8_STAGE(PG8_SA(1, 1), a1 + hstep);
            PG8_WAIT_V(8); PG8_WAIT_L(0); PG8_BAR; PG8_MMA(0, 0, At, B0); PG8_MMA(0, 1, At, B1); PG8_BAR; PG8_SCHED;
            PG8_LDA(At, 0, 1); PG8_STAGE(PG8_SB(0, 0), b2); PG8_STAGE(PG8_SB(0, 1), b2 + hstep); PG8_STAGE(PG8_SA(0, 0), a2);
            PG8_WAIT_V(8); PG8_WAIT_L(0); PG8_BAR; PG8_MMA(1, 0, At, B0); PG8_MMA(1, 1, At, B1); PG8_BAR; PG8_SCHED;
            PG8_LDB(B0, 1, 0); PG8_LDB(B1, 1, 1); PG8_SCHED; PG8_LDA(At, 1, 0); PG8_STAGE(PG8_SA(0, 1), a2 + hstep);
            PG8_WAIT_V(8); PG8_WAIT_L(0); PG8_BAR; PG8_MMA(0, 0, At, B0); PG8_MMA(0, 1, At, B1); PG8_BAR; PG8_SCHED;
            PG8_LDA(At, 1, 1); PG8_STAGE(PG8_SB(1, 0), b3); PG8_STAGE(PG8_SB(1, 1), b3 + hstep); PG8_STAGE(PG8_SA(1, 0), a3);
            PG8_WAIT_V(8); PG8_WAIT_L(0); PG8_BAR; PG8_MMA(1, 0, At, B0); PG8_MMA(1, 1, At, B1); PG8_BAR; PG8_SCHED;
        }
        if (wr == 0) PG8_BAR;
        PG8_ACC_SETTLE;
        E(acc, cur, wr, wc, fr, fq);
        if (!has_next) break;
#pragma unroll
        for (int a = 0; a < 2; ++a)
#pragma unroll
            for (int b = 0; b < 2; ++b)
#pragma unroll
                for (int m = 0; m < 4; ++m)
#pragma unroll
                    for (int n = 0; n < 2; ++n) acc[a][b][m][n] = (f32x4){0.f, 0.f, 0.f, 0.f};
        cur = nxt; cA = nA; cB = nB; ++ui;
        if (wr == 1) PG8_BAR;
    }
    PG8_WAIT_V(0);
    PG8_BAR;
#undef PG8_SA
#undef PG8_SB
#undef PG8_STAGE
#undef PG8_LDA
#undef PG8_LDB
#undef PG8_MMA
#undef PG8_F8
#undef PG8_ACC_SETTLE
#undef PG8_WAIT_V
#undef PG8_WAIT_L
#undef PG8_BAR
#undef PG8_SCHED
}

#define EPI_ROWS(...) _Pragma("unroll") for (int ai = 0; ai < 2; ++ai) _Pragma("unroll") for (int m = 0; m < 4; ++m) { const int row = u.pm * BM + ai * HALF + wr * 64 + m * 16 + fr; __VA_ARGS__ }
__device__ __forceinline__ u32x4 pack8(const f32x4 a, const f32x4 b) { u32x4 w; w.x = cvt_pk_bf16(a[0], a[1]); w.y = cvt_pk_bf16(a[2], a[3]); w.z = cvt_pk_bf16(b[0], b[1]); w.w = cvt_pk_bf16(b[2], b[3]); return w; }

__device__ __forceinline__ u32x2 pack8_f8(const f32x4 a, const f32x4 b) { unsigned w0 = 0, w1 = 0;
    w0 = __builtin_amdgcn_cvt_pk_fp8_f32(a[0], a[1], w0, false); w0 = __builtin_amdgcn_cvt_pk_fp8_f32(a[2], a[3], w0, true);
    w1 = __builtin_amdgcn_cvt_pk_fp8_f32(b[0], b[1], w1, false); w1 = __builtin_amdgcn_cvt_pk_fp8_f32(b[2], b[3], w1, true); u32x2 r; r.x = w0; r.y = w1; return r; }
constexpr float W8_SCALE = 64.0f, W8_INV = 1.0f / 64.0f;
struct EpiIn {
    bf16_t* aqkv; bf16_t* qb; bf16_t* kb; bf16_t* vb; bf16_t* gate; const float* qg; const float* kg; const float* rope; float asc;
    __device__ __forceinline__ void operator()(const f32x4 (&acc)[2][2][4][2], const Unit& u, int wr, int wc, int fr, int fq) const {
        const int pn = u.pn;
        if (pn >= 9 && pn < 14) {
            const bool isq = pn < 13; const int head = isq ? (pn - 9) * 4 + wc : wc; bf16_t* dst = isq ? qb : kb; const int pitch = isq ? 1024 : 256;
            const float* gvec = isq ? qg : kg; const float osc = isq ? C2 : 1.0f;
            f32x4 gv[2][2];
#pragma unroll
            for (int bj = 0; bj < 2; ++bj)
#pragma unroll
                for (int n = 0; n < 2; ++n) gv[bj][n] = *(const f32x4*)(gvec + 32 * bj + 16 * n + 4 * fq);
            EPI_ROWS(
                float ss = 0.f;
                _Pragma("unroll") for (int bj = 0; bj < 2; ++bj) _Pragma("unroll") for (int n = 0; n < 2; ++n) { const f32x4 x = acc[ai][bj][m][n] * asc; ss += (x[0] * x[0] + x[1] * x[1]) + (x[2] * x[2] + x[3] * x[3]); }
                ss = xsum<16>(ss); ss = xsum<32>(ss);
                const float sc = rsqrtf(ss * (1.0f / 64.0f) + EPS) * osc * asc;
                const int t = row & (SEQ - 1);
                _Pragma("unroll") for (int bj = 0; bj < 2; ++bj) {
                    const int pos = bj == 0 ? (t >> 6) : (t & 63);
                    const f32x4 cs = *(const f32x4*)(rope + pos * 16 + 4 * fq); const f32x4 sn = *(const f32x4*)(rope + 1024 + pos * 16 + 4 * fq);
                    const f32x4 y0 = acc[ai][bj][m][0] * sc * gv[bj][0]; const f32x4 y1 = acc[ai][bj][m][1] * sc * gv[bj][1];
                    const f32x4 o0 = y0 * cs - y1 * sn; const f32x4 o1 = y1 * cs + y0 * sn;
                    bf16_t* p = dst + (size_t)row * pitch + head * 64 + 32 * bj + 4 * fq;
                    u32x2 w0; w0.x = cvt_pk_bf16(o0[0], o0[1]); w0.y = cvt_pk_bf16(o0[2], o0[3]);
                    u32x2 w1; w1.x = cvt_pk_bf16(o1[0], o1[1]); w1.y = cvt_pk_bf16(o1[2], o1[3]);
                    *(u32x2*)p = w0; *(u32x2*)(p + 16) = w1;
                }
            )
        } else {
            bf16_t* dst; int pitch, colt, dsh = 0; float sc = asc; bool sig = false, fold = false;
            if (pn < 9) { dst = aqkv + (size_t)pn * T * 256; pitch = 256; colt = 0; fold = true; dsh = 2 * (pn / 3); if (pn % 3 == 0) sc = C2 * asc; }
            else if (pn == 14) { dst = vb; pitch = 256; colt = 0; }
            else { dst = gate; pitch = 2048; colt = (pn - 15) * 256; sig = true; }
            const int col0 = colt + wc * 32 + 8 * fq;
            EPI_ROWS(
                int drow = row;
                if (fold) { const int t = row & (SEQ - 1); drow = (row & ~(SEQ - 1)) | ((t & ((1 << dsh) - 1)) << (12 - dsh)) | (t >> dsh); }
                bf16_t* rowp = dst + (size_t)drow * pitch + col0;
                _Pragma("unroll") for (int bj = 0; bj < 2; ++bj) {
                    f32x4 v0 = acc[ai][bj][m][0], v1 = acc[ai][bj][m][1];
                    if (sig) { _Pragma("unroll") for (int j = 0; j < 4; ++j) { v0[j] = sigmoid_f(v0[j] * asc); v1[j] = sigmoid_f(v1[j] * asc); } }
                    else { v0 = v0 * sc; v1 = v1 * sc; }
                    *(u32x4*)(rowp + bj * HALF) = pack8(v0, v1);
                }
            )
        }
    }
};
struct EpiMergeA {
    const bf16_t* gate; bf16_t* merged;
    __device__ __forceinline__ void operator()(const f32x4 (&acc)[2][2][4][2], const Unit& u, int wr, int wc, int fr, int fq) const {
        const int col0 = u.pn * BM + wc * 32 + 8 * fq;
        EPI_ROWS(
            _Pragma("unroll") for (int bj = 0; bj < 2; ++bj) {
                const u32x4 gw = *(const u32x4*)(gate + (size_t)row * 2048 + col0 + bj * HALF);
                f32x4 v0 = acc[ai][bj][m][0], v1 = acc[ai][bj][m][1];
                v0 = v0 * W8_INV; v1 = v1 * W8_INV;
                v0[0] *= bf_lo(gw.x); v0[1] *= bf_hi(gw.x); v0[2] *= bf_lo(gw.y); v0[3] *= bf_hi(gw.y);
                v1[0] *= bf_lo(gw.z); v1[1] *= bf_hi(gw.z); v1[2] *= bf_lo(gw.w); v1[3] *= bf_hi(gw.w);
                *(u32x4*)(merged + (size_t)row * 1024 + col0 + bj * HALF) = pack8(v0, v1);
            }
        )
    }
};
template <bool F8> struct EpiMergeB {
    const bf16_t* gate; const bf16_t* merged; unsigned char* m8;
    __device__ __forceinline__ void operator()(const f32x4 (&acc)[2][2][4][2], const Unit& u, int wr, int wc, int fr, int fq) const {
        const int col0 = u.pn * BM + wc * 32 + 8 * fq;
        EPI_ROWS(
            _Pragma("unroll") for (int bj = 0; bj < 2; ++bj) {
                const u32x4 gw = *(const u32x4*)(gate + (size_t)row * 2048 + 1024 + col0 + bj * HALF);
                const bf16_t* mp = merged + (size_t)row * 1024 + col0 + bj * HALF;
                const u32x4 mw = *(const u32x4*)mp;
                f32x4 v0 = acc[ai][bj][m][0] * (F8 ? W8_INV : 1.0f), v1 = acc[ai][bj][m][1] * (F8 ? W8_INV : 1.0f);
                v0[0] = v0[0] * bf_lo(gw.x) + bf_lo(mw.x); v0[1] = v0[1] * bf_hi(gw.x) + bf_hi(mw.x); v0[2] = v0[2] * bf_lo(gw.y) + bf_lo(mw.y); v0[3] = v0[3] * bf_hi(gw.y) + bf_hi(mw.y);
                v1[0] = v1[0] * bf_lo(gw.z) + bf_lo(mw.z); v1[1] = v1[1] * bf_hi(gw.z) + bf_hi(mw.z); v1[2] = v1[2] * bf_lo(gw.w) + bf_lo(mw.w); v1[3] = v1[3] * bf_hi(gw.w) + bf_hi(mw.w);
                *(u32x2*)(m8 + (size_t)row * 1024 + col0 + bj * HALF) = pack8_f8(v0, v1);
            }
        )
    }
};
struct EpiOut {
    const float* xin; float* xout; const float* g1;
    __device__ __forceinline__ void operator()(const f32x4 (&acc)[2][2][4][2], const Unit& u, int wr, int wc, int fr, int fq) const {
        const int col0 = u.pn * BM + wc * 32 + 8 * fq; const int b = (u.pm * BM) >> 12;
        f32x4 gv[2][2];
#pragma unroll
        for (int bj = 0; bj < 2; ++bj)
#pragma unroll
            for (int n = 0; n < 2; ++n) gv[bj][n] = *(const f32x4*)(g1 + (size_t)b * 6144 + col0 + bj * HALF + 4 * n);
        EPI_ROWS(
            _Pragma("unroll") for (int bj = 0; bj < 2; ++bj) {
                const size_t off = (size_t)row * 1024 + col0 + bj * HALF;
                const f32x4 x0 = *(const f32x4*)(xin + off), x1 = *(const f32x4*)(xin + off + 4);
                *(f32x4*)(xout + off) = x0 + gv[bj][0] * (acc[ai][bj][m][0] * W8_INV); *(f32x4*)(xout + off + 4) = x1 + gv[bj][1] * (acc[ai][bj][m][1] * W8_INV);
            }
        )
    }
};
struct EpiGU {
    const float* bgu; bf16_t* act;
    __device__ __forceinline__ void operator()(const f32x4 (&acc)[2][2][4][2], const Unit& u, int wr, int wc, int fr, int fq) const {
        const int e = u.pn >> 3, pl = u.pn & 7; const int c0 = pl * 128 + wc * 32 + 8 * fq;
        const float* bp = bgu + (size_t)e * 2048 + c0;
        const f32x4 bg0 = *(const f32x4*)bp, bg1 = *(const f32x4*)(bp + 4), bl0 = *(const f32x4*)(bp + 1024), bl1 = *(const f32x4*)(bp + 1028);
        EPI_ROWS(
            f32x4 o[2];
            _Pragma("unroll") for (int n = 0; n < 2; ++n) {
                const f32x4 gl = acc[ai][0][m][n] + (n == 0 ? bg0 : bg1); const f32x4 ln = acc[ai][1][m][n] + (n == 0 ? bl0 : bl1);
                _Pragma("unroll") for (int j = 0; j < 4; ++j) { const float xg = fminf(gl[j], 7.0f); const float xl = fminf(fmaxf(ln[j], -7.0f), 7.0f); o[n][j] = xg * sigmoid_f(1.702f * xg) * (xl + 1.0f); }
            }
            *(u32x4*)(act + (size_t)row * 1024 + c0) = pack8(o[0], o[1]);
        )
    }
};
struct EpiGU8 {
    const float* bgu; unsigned char* act;
    __device__ __forceinline__ void operator()(const f32x4 (&acc)[2][2][4][2], const Unit& u, int wr, int wc, int fr, int fq) const {
        const int e = u.pn >> 3, pl = u.pn & 7; const int c0 = pl * 128 + wc * 32 + 8 * fq;
        const float* bp = bgu + (size_t)e * 2048 + c0;
        const f32x4 bg0 = *(const f32x4*)bp, bg1 = *(const f32x4*)(bp + 4), bl0 = *(const f32x4*)(bp + 1024), bl1 = *(const f32x4*)(bp + 1028);
        EPI_ROWS(
            f32x4 o[2];
            _Pragma("unroll") for (int n = 0; n < 2; ++n) {
                const f32x4 gl = acc[ai][0][m][n] * W8_INV + (n == 0 ? bg0 : bg1); const f32x4 ln = acc[ai][1][m][n] * W8_INV + (n == 0 ? bl0 : bl1);
                _Pragma("unroll") for (int j = 0; j < 4; ++j) { const float xg = fminf(gl[j], 7.0f); const float xl = fminf(fmaxf(ln[j], -7.0f), 7.0f); o[n][j] = xg * sigmoid_f(1.702f * xg) * (xl + 1.0f); }
            }
            *(u32x2*)(act + (size_t)row * 1024 + c0) = pack8_f8(o[0], o[1]);
        )
    }
};
struct EpiDN8 {
    const float* bdn; const float* roww; bf16_t* y;
    __device__ __forceinline__ void operator()(const f32x4 (&acc)[2][2][4][2], const Unit& u, int wr, int wc, int fr, int fq) const {
        const int e = u.pn >> 2, pl = u.pn & 3; const int col0 = pl * BM + wc * 32 + 8 * fq;
        f32x4 bv[2][2];
#pragma unroll
        for (int bj = 0; bj < 2; ++bj)
#pragma unroll
            for (int n = 0; n < 2; ++n) bv[bj][n] = *(const f32x4*)(bdn + (size_t)e * 1024 + col0 + bj * HALF + 4 * n);
        EPI_ROWS(
            const float w = roww[row];
            _Pragma("unroll") for (int bj = 0; bj < 2; ++bj)
                *(u32x4*)(y + (size_t)row * 1024 + col0 + bj * HALF) = pack8((acc[ai][bj][m][0] * W8_INV + bv[bj][0]) * w, (acc[ai][bj][m][1] * W8_INV + bv[bj][1]) * w);
        )
    }
};
struct EpiDN {
    const float* bdn; const float* roww; bf16_t* y;
    __device__ __forceinline__ void operator()(const f32x4 (&acc)[2][2][4][2], const Unit& u, int wr, int wc, int fr, int fq) const {
        const int e = u.pn >> 2, pl = u.pn & 3; const int col0 = pl * BM + wc * 32 + 8 * fq;
        f32x4 bv[2][2];
#pragma unroll
        for (int bj = 0; bj < 2; ++bj)
#pragma unroll
            for (int n = 0; n < 2; ++n) bv[bj][n] = *(const f32x4*)(bdn + (size_t)e * 1024 + col0 + bj * HALF + 4 * n);
        EPI_ROWS(
            const float w = roww[row];
            _Pragma("unroll") for (int bj = 0; bj < 2; ++bj)
                *(u32x4*)(y + (size_t)row * 1024 + col0 + bj * HALF) = pack8((acc[ai][bj][m][0] + bv[bj][0]) * w, (acc[ai][bj][m][1] + bv[bj][1]) * w);
        )
    }
};
}

namespace attn_body {
using bf16 = __hip_bfloat16;
using bf16x8 = __attribute__((ext_vector_type(8))) short;
using s16x4 = __attribute__((ext_vector_type(4))) short;
using f32x16 = __attribute__((ext_vector_type(16))) float;
using u32x4 = __attribute__((ext_vector_type(4))) unsigned;
constexpr int D = 64, NW = 8, QBLK = 32, QB = QBLK * NW, KVBLK = 64;
__device__ __forceinline__ int crow(int r, int hi) { return (r & 3) + 8 * (r >> 2) + 4 * hi; }
#define SBAR() __builtin_amdgcn_sched_barrier(0)
constexpr int NSLOT = 3, SLOTB = 8192;
constexpr int LDS_K = 0, LDS_V = NSLOT * SLOTB, LDS_WS = 2 * NSLOT * SLOTB, LDS_OST = LDS_WS + NW * 64 * 4, LDS_LUT = LDS_OST + NW * 4096, LUT_N = 768, LDS_BYTES = LDS_LUT + LUT_N * 4;
constexpr bool OB_F8 = true;
constexpr float MFLOOR = -1024.0f;
__device__ __forceinline__ void glds16(const void* gsrc, unsigned lds_dst) { unsigned keep;
  asm volatile("s_mov_b32 %0, m0\n\ts_mov_b32 m0, %2\n\ts_nop 0\n\tglobal_load_lds_dwordx4 %1, off\n\ts_mov_b32 m0, %0" : "=&s"(keep) : "v"(gsrc), "s"(lds_dst) : "memory"); }
__device__ __forceinline__ float max3f(float a, float b, float c) { float r; asm("v_max3_f32 %0, %1, %2, %3" : "=v"(r) : "v"(a), "v"(b), "v"(c)); return r; }
__device__ __forceinline__ float max2f(float a, float b) { float r; asm("v_max_f32_e32 %0, %1, %2" : "=v"(r) : "v"(a), "v"(b)); return r; }
__device__ __forceinline__ float fadd_s(float a, float b) { float r; asm("v_add_f32_e32 %0, %1, %2" : "=v"(r) : "v"(a), "v"(b)); return r; }
__device__ __forceinline__ float fsub_s(float a, float b) { float r; asm("v_sub_f32_e32 %0, %1, %2" : "=v"(r) : "v"(a), "v"(b)); return r; }
typedef float f32x2_t __attribute__((ext_vector_type(2))); typedef __bf16 bf16x2_t __attribute__((ext_vector_type(2)));
__device__ __forceinline__ unsigned cvtpk_s(float lo, float hi) { f32x2_t v = {lo, hi}; bf16x2_t b = __builtin_convertvector(v, bf16x2_t); return __builtin_bit_cast(unsigned, b); }
#define WAIT_BAR(N) asm volatile("s_waitcnt vmcnt(" #N ") lgkmcnt(0)\n\ts_barrier" ::: "memory")

__device__ __forceinline__ void qkt(f32x16& p0, f32x16& p1, const char* Kslot, const bf16x8* qr, const f32x16& negm, int r32, int hi) {
  const char* kb = Kslot + hi * 1024 + r32 * 16;
  #pragma unroll
  for (int d0 = 0; d0 < 4; ++d0) {
    const bf16x8 b0 = *reinterpret_cast<const bf16x8*>(kb + d0 * 2048);
    const bf16x8 b1 = *reinterpret_cast<const bf16x8*>(kb + d0 * 2048 + 512);
    if (d0 == 0) { p0 = __builtin_amdgcn_mfma_f32_32x32x16_bf16(b0, qr[0], negm, 0, 0, 0); p1 = __builtin_amdgcn_mfma_f32_32x32x16_bf16(b1, qr[0], negm, 0, 0, 0); }
    else { p0 = __builtin_amdgcn_mfma_f32_32x32x16_bf16(b0, qr[d0], p0, 0, 0, 0); p1 = __builtin_amdgcn_mfma_f32_32x32x16_bf16(b1, qr[d0], p1, 0, 0, 0); } }
}
typedef __attribute__((address_space(3))) const char* lds_cptr;
typedef short v4i16_t __attribute__((ext_vector_type(4)));
__device__ __forceinline__ void kload8(bf16x8* kf, lds_cptr kp) {
  kf[0] = *(const __attribute__((address_space(3))) bf16x8*)(kp);        kf[1] = *(const __attribute__((address_space(3))) bf16x8*)(kp + 512);
  kf[2] = *(const __attribute__((address_space(3))) bf16x8*)(kp + 2048); kf[3] = *(const __attribute__((address_space(3))) bf16x8*)(kp + 2560);
  kf[4] = *(const __attribute__((address_space(3))) bf16x8*)(kp + 4096); kf[5] = *(const __attribute__((address_space(3))) bf16x8*)(kp + 4608);
  kf[6] = *(const __attribute__((address_space(3))) bf16x8*)(kp + 6144); kf[7] = *(const __attribute__((address_space(3))) bf16x8*)(kp + 6656);
}
__device__ __forceinline__ void kload2(bf16x8* kf, lds_cptr kp, int j) { kf[2 * j] = *(const __attribute__((address_space(3))) bf16x8*)(kp + j * 2048); kf[2 * j + 1] = *(const __attribute__((address_space(3))) bf16x8*)(kp + j * 2048 + 512); }
__device__ __forceinline__ s16x4 vtr(lds_cptr p) { return __builtin_bit_cast(s16x4, __builtin_amdgcn_ds_read_tr16_b64_v4i16((__attribute__((address_space(3))) v4i16_t*)p)); }
__device__ __forceinline__ float rowmax(const f32x16& p0, const f32x16& p1) {
  float a = max3f(p0[0], p0[1], p1[0]), b = max3f(p0[2], p0[3], p1[1]); a = max3f(a, p1[2], p1[3]);
  #pragma unroll
  for (int r = 4; r < 16; r += 4) { a = max3f(a, p0[r], p0[r + 1]); b = max3f(b, p0[r + 2], p0[r + 3]); a = max3f(a, p1[r], p1[r + 1]); b = max3f(b, p1[r + 2], p1[r + 3]); }
  const float m = max2f(a, b);
  auto rr = __builtin_amdgcn_permlane32_swap(__float_as_uint(m), __float_as_uint(m), false, false);
  return max2f(__uint_as_float(rr[0]), __uint_as_float(rr[1]));
}
__device__ __forceinline__ void pv(f32x16* o, int vb, bf16x8 pa0, bf16x8 pa1, bf16x8 pa2, bf16x8 pa3) {
  #pragma unroll
  for (int d0 = 0; d0 < 2; ++d0) { s16x4 lo[4], hi[4];
    #pragma unroll
    for (int ks = 0; ks < 4; ++ks) {
      asm volatile("ds_read_b64_tr_b16 %0,%1 offset:%c2" : "=&v"(lo[ks]) : "v"(vb), "i"(d0 * 4096 + ks * 1024) : "memory");
      asm volatile("ds_read_b64_tr_b16 %0,%1 offset:%c2" : "=&v"(hi[ks]) : "v"(vb), "i"(d0 * 4096 + ks * 1024 + 512) : "memory"); }
    asm volatile("s_waitcnt lgkmcnt(0)" ::: "memory"); SBAR();
    #define PK(k) (bf16x8){lo[k][0], lo[k][1], lo[k][2], lo[k][3], hi[k][0], hi[k][1], hi[k][2], hi[k][3]}
    o[d0] = __builtin_amdgcn_mfma_f32_32x32x16_bf16(pa0, PK(0), o[d0], 0, 0, 0);
    o[d0] = __builtin_amdgcn_mfma_f32_32x32x16_bf16(pa1, PK(1), o[d0], 0, 0, 0);
    o[d0] = __builtin_amdgcn_mfma_f32_32x32x16_bf16(pa2, PK(2), o[d0], 0, 0, 0);
    o[d0] = __builtin_amdgcn_mfma_f32_32x32x16_bf16(pa3, PK(3), o[d0], 0, 0, 0);
    #undef PK
  }
}
struct Job { const bf16* Q; const bf16* K; const bf16* V; bf16* O; float* lse; const float* lutg; int NT, i0, kq0, dsh, cls; };
template <int MODE, int THRL, bool NOMAX = false> __device__ __forceinline__ void attn_unit(const Job& J, char* shm, const int wid_in) {
  int wid = wid_in; asm volatile("" : "+s"(wid));
  constexpr int QP = MODE == 0 ? 1024 : 256, KP = 256;
  const int lane = lane_id_asm(), tid = wid * 64 + lane, r32 = lane & 31, hi = lane >> 5;
  const bf16* Qw = J.Q + (long)(wid * QBLK) * QP;
  const bf16* Kh = J.K; const bf16* Vh = J.V;
  const unsigned lds0 = (unsigned)(uintptr_t)shm;
  float* wsf = (float*)(shm + LDS_WS) + wid * 64;
  const bf16* ksrc = Kh + (long)lane * KP + wid * 8;
  const bf16* vsrc = Vh + (long)(16 * (wid & 3) + (lane >> 2)) * KP + (wid >> 2) * 32 + (lane & 3) * 8;
  const unsigned kdst = lds0 + LDS_K + wid * 1024, vdst = lds0 + LDS_V + wid * 1024;
  #define DMA_K(t, slot) glds16(ksrc + (long)(t) * KVBLK * KP, (unsigned)__builtin_amdgcn_readfirstlane(kdst + (slot)))
  #define DMA_V(t, slot) glds16(vsrc + (long)(t) * KVBLK * KP, (unsigned)__builtin_amdgcn_readfirstlane(vdst + (slot)))
  const int vb0 = (int)(lds0 + LDS_V) + ((lane >> 4) & 1) * 32 + (lane & 3) * 8 + (4 * hi + ((lane & 15) >> 2)) * 64;
  const char* Kbase = shm + LDS_K; bf16x8 kf[8];
  const lds_cptr shm3 = (lds_cptr)shm; const lds_cptr kp0 = shm3 + LDS_K + hi * 1024 + r32 * 16; const lds_cptr vp0 = shm3 + LDS_V + ((lane >> 4) & 1) * 32 + (lane & 3) * 8 + (4 * hi + ((lane & 15) >> 2)) * 64;
  const int NT = J.NT;
  if (MODE == 1) {
    __attribute__((address_space(3))) float* lut = (__attribute__((address_space(3))) float*)(shm3 + LDS_LUT);
    lut[tid] = J.lutg[tid]; if (tid < LUT_N - 512) lut[512 + tid] = J.lutg[512 + tid];
  }
  DMA_K(0, 0); DMA_V(0, 0); DMA_K(1, SLOTB);
  bf16x8 qr[4];
  #pragma unroll
  for (int d0 = 0; d0 < 4; ++d0) qr[d0] = *reinterpret_cast<const bf16x8*>(&Qw[(long)r32 * QP + d0 * 16 + hi * 8]);
  float mhat = 0.f, l_reg = 0.f; f32x16 o[2]; o[0] = f32x16{}; o[1] = f32x16{}; f32x16 negm = f32x16{}; if (!NOMAX) asm volatile("" : "+v"(negm));
  const int qrel = wid * QBLK + r32;
  const __attribute__((address_space(3))) float* lutq = (const __attribute__((address_space(3))) float*)(shm3 + LDS_LUT) + (J.kq0 - qrel + 383 + 4 * hi);
  #define CMASK(P0, P1, t) do { if (MODE == 1) { const __attribute__((address_space(3))) float* lp_ = lutq + 64 * (t); \
      _Pragma("unroll") for (int r = 0; r < 16; ++r) { const int ko_ = (r & 3) + 8 * (r >> 2); P0[r] += lp_[ko_]; P1[r] += lp_[ko_ + 32]; } } } while (0)
  bool resc = false;
  #define START(P0, P1) do { resc = false; if (!NOMAX) { const float rm = rowmax(P0, P1); \
    const float dl = MODE == 1 ? max2f(rm, MFLOOR) : rm; mhat = fadd_s(mhat, dl); \
      _Pragma("unroll") for (int r = 0; r < 16; ++r) { P0[r] = fsub_s(P0[r], dl); P1[r] = fsub_s(P1[r], dl); } \
      _Pragma("unroll") for (int r = 0; r < 16; ++r) negm[r] = -mhat; asm volatile("" : "+v"(negm)); } \
    _Pragma("unroll") for (int r = 0; r < 16; ++r) P0[r] = __builtin_amdgcn_exp2f(P0[r]); } while (0)
  #define RESC() do { if (resc) { asm volatile("s_waitcnt lgkmcnt(0)" ::: "memory"); \
      _Pragma("unroll") for (int d_ = 0; d_ < 2; ++d_) _Pragma("unroll") for (int r = 0; r < 16; ++r) o[d_][r] *= wsf[crow(r, hi)]; } } while (0)
  f32x16 pA0, pA1, pB0, pB1;
  int sl_prev = 0, sl_cur = 0, sl_next = SLOTB;
  #define ROT() do { sl_prev = sl_cur; sl_cur = sl_next; sl_next = (sl_next == (NSLOT - 1) * SLOTB) ? 0 : sl_next + SLOTB; } while (0)
  DMA_K(2, 2 * SLOTB);
  WAIT_BAR(3);
  qkt(pA0, pA1, Kbase, qr, negm, r32, hi); asm volatile("s_nop 15\n\ts_nop 7" : "+v"(pA0), "+v"(pA1)); CMASK(pA0, pA1, 0);
  START(pA0, pA1);
  _Pragma("unroll") for (int r = 0; r < 16; ++r) pA1[r] = __builtin_amdgcn_exp2f(pA1[r]);
  WAIT_BAR(0);
  DMA_K(3, 0); DMA_V(1, SLOTB);
  ROT();
  kload8(kf, kp0 + sl_cur);
  WAIT_BAR(2);
  s16x4 vlo[8], vhi[8]; u32x4 pw0, pw1, pw2, pw3;
  #define PKW(P, B) cvtpk_s(P[B], P[B + 1])
  #define PAF(k) __builtin_bit_cast(bf16x8, pw##k)
  #define VFR(i) (bf16x8){vlo[i][0], vlo[i][1], vlo[i][2], vlo[i][3], vhi[i][0], vhi[i][1], vhi[i][2], vhi[i][3]}
  #define PIN(x) asm volatile("" : "+v"(x))
  #define MX3(a, b, c) __builtin_fmaxf(__builtin_fmaxf((a), (b)), (c))
  #define GAPA(MF, A0, A1, A2, A3, W0, W1, PW) do { MF; sacc += A0; sacc += A1; sacc += A2; sacc += A3; PIN(sacc); W0; W1; PIN(PW); SBAR(); } while (0)
  #define EX(v) __builtin_amdgcn_exp2f(v)
  #define GAPB(MF, X, B) do { MF; X[B] = EX(X[B]); X[B + 1] = EX(X[B + 1]); X[B + 2] = EX(X[B + 2]); X[B + 3] = EX(X[B + 3]); PIN(X); SBAR(); } while (0)
  #define VRD(i) do { vlo[i] = vtr(vp_ + (((i) >> 2) * 4096 + ((i) & 3) * 1024)); vhi[i] = vtr(vp_ + (((i) >> 2) * 4096 + ((i) & 3) * 1024 + 512)); } while (0)
  #define KRD(G, j) do { if (G) { kload2(kf, kp0 + sl_next, j); SBAR(); } } while (0)
  #define STEP(C0, C1, P0, P1, t, GK, GV, GL) do { SBAR(); \
    const lds_cptr vp_ = vp0 + sl_prev; \
    VRD(0); SBAR(); float sacc = (P0[0] + P0[1]); \
    GAPA(C0 = __builtin_amdgcn_mfma_f32_32x32x16_bf16(kf[0], qr[0], negm, 0, 0, 0), P0[2], P0[3], P0[4], P0[5],     pw0[0] = PKW(P0, 0), pw0[1] = PKW(P0, 2), pw0); \
    VRD(4); SBAR(); GAPA(C1 = __builtin_amdgcn_mfma_f32_32x32x16_bf16(kf[1], qr[0], negm, 0, 0, 0), P0[6], P0[7], P0[8], P0[9],     pw0[2] = PKW(P0, 4), pw0[3] = PKW(P0, 6), pw0); \
    VRD(1); SBAR(); GAPA(C0 = __builtin_amdgcn_mfma_f32_32x32x16_bf16(kf[2], qr[1], C0, 0, 0, 0),   P0[10], P0[11], P0[12], P0[13], pw1[0] = PKW(P0, 8), pw1[1] = PKW(P0, 10), pw1); \
    VRD(5); SBAR(); GAPA(C1 = __builtin_amdgcn_mfma_f32_32x32x16_bf16(kf[3], qr[1], C1, 0, 0, 0),   P0[14], P0[15], P1[0], P1[1],   pw1[2] = PKW(P0, 12), pw1[3] = PKW(P0, 14), pw1); \
    VRD(2); SBAR(); GAPA(C0 = __builtin_amdgcn_mfma_f32_32x32x16_bf16(kf[4], qr[2], C0, 0, 0, 0),   P1[2], P1[3], P1[4], P1[5],     pw2[0] = PKW(P1, 0), pw2[1] = PKW(P1, 2), pw2); \
    VRD(6); SBAR(); GAPA(C1 = __builtin_amdgcn_mfma_f32_32x32x16_bf16(kf[5], qr[2], C1, 0, 0, 0),   P1[6], P1[7], P1[8], P1[9],     pw2[2] = PKW(P1, 4), pw2[3] = PKW(P1, 6), pw2); \
    VRD(3); SBAR(); GAPA(C0 = __builtin_amdgcn_mfma_f32_32x32x16_bf16(kf[6], qr[3], C0, 0, 0, 0),   P1[10], P1[11], P1[12], P1[13], pw3[0] = PKW(P1, 8), pw3[1] = PKW(P1, 10), pw3); \
    VRD(7); SBAR(); GAPA(C1 = __builtin_amdgcn_mfma_f32_32x32x16_bf16(kf[7], qr[3], C1, 0, 0, 0),   P1[14], P1[15], 0.f, 0.f,       pw3[2] = PKW(P1, 12), pw3[3] = PKW(P1, 14), pw3); \
    l_reg += sacc; \
    if (GK) { DMA_K((t) + 3, sl_cur); } if (GV) { DMA_V((t) + 1, sl_next); } \
    CMASK(C0, C1, t); \
    if (!NOMAX) { float a = MX3(C0[0], C0[1], C1[0]), b = MX3(C0[2], C0[3], C1[1]); a = MX3(a, C1[2], C1[3]); \
      _Pragma("unroll") for (int r = 4; r < 16; r += 4) { a = MX3(a, C0[r], C0[r + 1]); b = MX3(b, C0[r + 2], C0[r + 3]); a = MX3(a, C1[r], C1[r + 1]); b = MX3(b, C1[r + 2], C1[r + 3]); } \
      float rm = __builtin_fmaxf(a, b); { auto rr = __builtin_amdgcn_permlane32_swap(__float_as_uint(rm), __float_as_uint(rm), false, false); rm = __builtin_fmaxf(__uint_as_float(rr[0]), __uint_as_float(rr[1])); } \
      resc = false; \
      if (__builtin_expect(__any(rm > (float)THRL), 0)) { const float dl = __builtin_fmaxf(rm, 0.f); mhat += dl; \
        _Pragma("unroll") for (int r = 0; r < 16; ++r) { C0[r] -= dl; C1[r] -= dl; } \
        _Pragma("unroll") for (int r = 0; r < 16; ++r) negm[r] = -mhat; asm volatile("" : "+v"(negm)); \
        const float f = __builtin_amdgcn_exp2f(-dl); l_reg *= f; if (hi == 0) wsf[r32] = f; resc = true; } } \
    SBAR(); \
    GAPB(o[0] = __builtin_amdgcn_mfma_f32_32x32x16_bf16(PAF(0), VFR(0), o[0], 0, 0, 0), C0, 0); \
    GAPB(o[1] = __builtin_amdgcn_mfma_f32_32x32x16_bf16(PAF(0), VFR(4), o[1], 0, 0, 0), C0, 4); \
    KRD(GL, 0); GAPB(o[0] = __builtin_amdgcn_mfma_f32_32x32x16_bf16(PAF(1), VFR(1), o[0], 0, 0, 0), C0, 8); \
    KRD(GL, 1); GAPB(o[1] = __builtin_amdgcn_mfma_f32_32x32x16_bf16(PAF(1), VFR(5), o[1], 0, 0, 0), C0, 12); \
    KRD(GL, 2); GAPB(o[0] = __builtin_amdgcn_mfma_f32_32x32x16_bf16(PAF(2), VFR(2), o[0], 0, 0, 0), C1, 0); \
    KRD(GL, 3); GAPB(o[1] = __builtin_amdgcn_mfma_f32_32x32x16_bf16(PAF(2), VFR(6), o[1], 0, 0, 0), C1, 4); \
    GAPB(o[0] = __builtin_amdgcn_mfma_f32_32x32x16_bf16(PAF(3), VFR(3), o[0], 0, 0, 0), C1, 8); \
    GAPB(o[1] = __builtin_amdgcn_mfma_f32_32x32x16_bf16(PAF(3), VFR(7), o[1], 0, 0, 0), C1, 12); \
    } while (0)
  int t = 1;
  for (; t + 5 < NT; t += 2) {
    STEP(pB0, pB1, pA0, pA1, t, true, true, true);     WAIT_BAR(2); RESC(); ROT();
    STEP(pA0, pA1, pB0, pB1, t + 1, true, true, true); WAIT_BAR(2); RESC(); ROT();
  }
  #define ENDW(tt) do { if ((tt) + 3 < NT) { WAIT_BAR(2); } else if ((tt) + 2 < NT) { WAIT_BAR(1); } else { WAIT_BAR(0); } } while (0)
  for (; t + 1 < NT; t += 2) {
    STEP(pB0, pB1, pA0, pA1, t, (t + 3 < NT), (t + 1 < NT), (t + 1 < NT));       ENDW(t);     RESC(); ROT();
    STEP(pA0, pA1, pB0, pB1, t + 1, (t + 4 < NT), (t + 2 < NT), (t + 2 < NT));   ENDW(t + 1); RESC(); ROT();
  }
  STEP(pB0, pB1, pA0, pA1, NT - 1, false, false, false); RESC();
  { float sacc = pB0[0] + pB0[1]; _Pragma("unroll") for (int r = 2; r < 16; ++r) sacc += pB0[r]; _Pragma("unroll") for (int r = 0; r < 16; ++r) sacc += pB1[r]; l_reg += sacc;
    pw0 = (u32x4){PKW(pB0, 0), PKW(pB0, 2), PKW(pB0, 4), PKW(pB0, 6)}; pw1 = (u32x4){PKW(pB0, 8), PKW(pB0, 10), PKW(pB0, 12), PKW(pB0, 14)}; pw2 = (u32x4){PKW(pB1, 0), PKW(pB1, 2), PKW(pB1, 4), PKW(pB1, 6)}; pw3 = (u32x4){PKW(pB1, 8), PKW(pB1, 10), PKW(pB1, 12), PKW(pB1, 14)};
    SBAR(); pv(o, vb0 + sl_cur, PAF(0), PAF(1), PAF(2), PAF(3)); }
  #undef PKW
  #undef PAF
  #undef VFR
  #undef PIN
  #undef MX3
  #undef GAPA
  #undef GAPB
  #undef EX
  #undef VRD
  #undef KRD
  #undef STEP
  #undef ENDW
  { auto rr = __builtin_amdgcn_permlane32_swap(__float_as_uint(l_reg), __float_as_uint(l_reg), false, false); l_reg = __uint_as_float(rr[0]) + __uint_as_float(rr[1]); }
  if (hi == 0) wsf[32 + r32] = l_reg; asm volatile("s_waitcnt lgkmcnt(0)" ::: "memory");
  float rli[16];
  #pragma unroll
  for (int r = 0; r < 16; ++r) rli[r] = __builtin_amdgcn_rcpf(wsf[32 + crow(r, hi)]);
  if (MODE == 0 && OB_F8) {
    unsigned char* stg8 = (unsigned char*)(shm + LDS_OST) + wid * 4096;
    #pragma unroll
    for (int r = 0; r < 16; ++r) { const int orow = crow(r, hi);
      #pragma unroll
      for (int d0 = 0; d0 < 2; ++d0) { const float ov = o[d0][r] * rli[r]; stg8[orow * 64 + d0 * 32 + r32] = (unsigned char)(__builtin_amdgcn_cvt_pk_fp8_f32(ov, ov, 0, false) & 0xff); } }
    asm volatile("s_waitcnt lgkmcnt(0)" ::: "memory");
    unsigned char* Ow = (unsigned char*)J.O + (long)(wid * QBLK) * 1024;
    #pragma unroll
    for (int i = 0; i < 2; ++i) { const int row = i * 16 + (lane >> 2), ch = lane & 3; const u32x4 v = *(const u32x4*)(stg8 + row * 64 + ch * 16); *(u32x4*)(Ow + (long)row * 1024 + ch * 16) = v; }
  } else {
    bf16* stg = (bf16*)(shm + LDS_OST) + wid * 2048;
    #pragma unroll
    for (int r = 0; r < 16; ++r) { const int orow = crow(r, hi);
      #pragma unroll
      for (int d0 = 0; d0 < 2; ++d0) stg[orow * 64 + d0 * 32 + r32] = __float2bfloat16(o[d0][r] * rli[r]); }
    asm volatile("s_waitcnt lgkmcnt(0)" ::: "memory");
    if (MODE == 0) {
      bf16* Ow = J.O + (long)(wid * QBLK) * 1024;
      #pragma unroll
      for (int i = 0; i < 4; ++i) { const int row = i * 8 + (lane >> 3), ch = lane & 7; const u32x4 v = *(const u32x4*)(stg + row * 64 + ch * 8); *(u32x4*)(Ow + (long)row * 1024 + ch * 8) = v; }
    } else {
      #pragma unroll
      for (int i = 0; i < 4; ++i) { const int row = i * 8 + (lane >> 3), ch = lane & 7; const u32x4 v = *(const u32x4*)(stg + row * 64 + ch * 8);
        const long tok = ((long)(J.i0 + wid * QBLK + row) << J.dsh) + J.cls; *(u32x4*)(J.O + tok * 256 + ch * 8) = v; }
      if (hi == 0) { const long tok = ((long)(J.i0 + qrel) << J.dsh) + J.cls; J.lse[tok * 4] = mhat + __builtin_amdgcn_logf(l_reg); }
    } }
  asm volatile("s_waitcnt lgkmcnt(0)\n\ts_barrier" ::: "memory");
  #undef DMA_K
  #undef DMA_V
  #undef CMASK
  #undef START
  #undef RESC
  #undef ROT
}
#undef SBAR
#undef WAIT_BAR
}

constexpr size_t MiB = 1u << 20;
constexpr size_t WS_CTL = 0, CTL_ZERO_BYTES = 1 * MiB;
constexpr size_t WS_MOD = 1 * MiB;
constexpr size_t WS_ROPE = WS_MOD + 512 * 1024;
constexpr size_t WS_BLUT = WS_ROPE + 8192;
constexpr size_t WS_RC0 = WS_BLUT + 12 * 768 * 4;
constexpr size_t WS_HIST = WS_RC0 + 4096;
constexpr size_t WS_TILEE = WS_HIST + 32768;
constexpr size_t WS_TOPE = 2 * MiB;
constexpr size_t WS_TOPW = WS_TOPE + 512 * 1024;
constexpr size_t WS_SLOT = WS_TOPW + 512 * 1024;
constexpr size_t WS_ROWW = WS_SLOT + 512 * 1024;
constexpr size_t WS_LSE = 5 * MiB;
constexpr size_t WS_WRHI = 7 * MiB;
constexpr size_t WS_WRLO = 8 * MiB;
constexpr size_t WS_WIN = 9 * MiB;
constexpr size_t WS_WBRA = 32 * MiB;
constexpr size_t WS_WBRB = 33 * MiB;
constexpr size_t WS_WOUT = 37 * MiB;
constexpr size_t WS_WGU = 41 * MiB;
constexpr size_t WS_WDN = 297 * MiB;
constexpr size_t WS_X = 425 * MiB;
constexpr size_t WS_H = 553 * MiB;
constexpr size_t WS_R = 617 * MiB;
constexpr size_t WS_AQKV = WS_R;
constexpr size_t WS_QB = WS_R + 144 * MiB;
constexpr size_t WS_KB = WS_R + 208 * MiB;
constexpr size_t WS_VB = WS_R + 224 * MiB;
constexpr size_t WS_GATE = WS_R + 240 * MiB;
constexpr size_t WS_OAG = WS_R + 368 * MiB;
constexpr size_t WS_OA = WS_R + 416 * MiB;
constexpr size_t WS_MERGED = WS_R + 432 * MiB;
constexpr size_t WS_XS = WS_R;
constexpr size_t WS_ACT = WS_R + 136 * MiB;
constexpr size_t WS_Y = WS_R + 272 * MiB;
constexpr size_t WS_OB = WS_R + 496 * MiB;
constexpr size_t WS_M8 = WS_R + 560 * MiB;
constexpr size_t WS_END = WS_R + 592 * MiB;
constexpr int CW_BAR = 4096;

constexpr int RING_BYTES = 133120;
constexpr int LDSCTL_OFF = RING_BYTES;
constexpr int LDS_BYTES = 147456;
constexpr int NWAVES = 8;

#define GAS __attribute__((address_space(1)))
#define LAS __attribute__((address_space(3)))
typedef unsigned short bf16;
typedef unsigned v4u __attribute__((ext_vector_type(4)));
typedef unsigned v2u __attribute__((ext_vector_type(2)));
typedef float f32x4 __attribute__((ext_vector_type(4)));
typedef float f32x16 __attribute__((ext_vector_type(16)));
typedef int i32x4 __attribute__((ext_vector_type(4)));
typedef short bf16x8 __attribute__((ext_vector_type(8)));
typedef GAS unsigned gu32;
#define RLX_AGENT __ATOMIC_RELAXED, __HIP_MEMORY_SCOPE_AGENT
#define LDS_WAIT() asm volatile("s_waitcnt lgkmcnt(0)" ::: "memory")
__device__ __forceinline__ unsigned f2bf(float f) { unsigned u = __builtin_bit_cast(unsigned, f); return (u + 0x7fffu + ((u >> 16) & 1u)) >> 16; }
__device__ __forceinline__ unsigned pk2(float lo, float hi) { return f2bf(lo) | (f2bf(hi) << 16); }
__device__ __forceinline__ float bfl(unsigned w) { return __uint_as_float(w << 16); }
__device__ __forceinline__ float bfh(unsigned w) { return __uint_as_float(w & 0xffff0000u); }

#define XB_TMO      128
#define XB_XCNT(j)  (256  + 64 * (j))
#define XB_XSUB(j)  (1280 + 64 * (j))
#define XB_XGEN(j)  (2304 + 64 * (j))
#define XB_TOP      3328
#define XB_TOPGEN   3392
#define XCD_BAR_WORDS 3456
#define XB_SPIN_CAP (1u << 18)
__device__ __forceinline__ unsigned xb_ld(unsigned* p)              { return __hip_atomic_load(p, __ATOMIC_RELAXED, __HIP_MEMORY_SCOPE_AGENT); }
__device__ __forceinline__ unsigned xb_add(unsigned* p, unsigned v) { return __hip_atomic_fetch_add(p, v, __ATOMIC_RELAXED, __HIP_MEMORY_SCOPE_AGENT); }
__device__ __forceinline__ unsigned xb_xcc_id() { return (unsigned)__builtin_amdgcn_s_getreg((3 << 11) | 20) & 0xFu; }
#define XB_SPIN(cond, bar) do { unsigned _sp = 0; while (cond) { __builtin_amdgcn_s_sleep(1); \
    if ((++_sp & 255u) == 0u) { if (xb_ld(&(bar)[XB_TMO])) break; if (_sp > XB_SPIN_CAP) { atomicAdd(&(bar)[XB_TMO], 1u); break; } } } } while (0)
struct XcdBarrier { unsigned* bar; unsigned x; volatile LAS unsigned* st; };
__device__ __forceinline__ XcdBarrier xcd_barrier_post(unsigned* bar, volatile LAS unsigned* st) {
    XcdBarrier b; b.bar = bar; b.x = xb_xcc_id(); b.st = st;
    if (threadIdx.x == 0) (void)xb_add(&bar[XB_XCNT(b.x)], 1u);
    return b;
}
__device__ __forceinline__ void xcd_barrier_complete(unsigned* bar, unsigned x, unsigned& nloc, unsigned& nx) {
    const unsigned G = gridDim.x * gridDim.y * gridDim.z;
    unsigned sum, cnt, mine, sp = 0u;
    for (;;) {
        sum = 0u; cnt = 0u; mine = 0u;
#pragma unroll
        for (unsigned j = 0; j < 16; ++j) { const unsigned c = xb_ld(&bar[XB_XCNT(j)]); sum += c; cnt += (c > 0u) ? 1u : 0u; mine = (j == x) ? c : mine; }
        if (sum == G) break;
        __builtin_amdgcn_s_sleep(1);
        if ((++sp & 255u) == 0u) { if (xb_ld(&bar[XB_TMO])) break; if (sp > XB_SPIN_CAP) { atomicAdd(&bar[XB_TMO], 1u); break; } }
    }
    nloc = mine > 0u ? mine : 1u; nx = cnt > 0u ? cnt : 1u;
}
__device__ __forceinline__ void xcd_barrier(const XcdBarrier& b) {
    asm volatile("s_waitcnt vmcnt(0)" ::: "memory");
    __syncthreads();
    if (threadIdx.x == 0) {
        unsigned* bar = b.bar;
        __builtin_amdgcn_s_waitcnt(0);
        unsigned nloc = b.st[0], nx = b.st[1];
        if (nloc == 0u) { xcd_barrier_complete(bar, b.x, nloc, nx); b.st[0] = nloc; b.st[1] = nx; }
        const unsigned old = xb_add(&bar[XB_XSUB(b.x)], 1u);
        const unsigned gen = old / nloc;
        if (old + 1u == (gen + 1u) * nloc) {
            __builtin_amdgcn_fence(__ATOMIC_RELEASE, "agent");
            asm volatile("s_waitcnt vmcnt(0)" ::: "memory");
            const unsigned og = xb_add(&bar[XB_TOP], 1u);
            const unsigned tg = og / nx;
            if (og + 1u == (tg + 1u) * nx) xb_add(&bar[XB_TOPGEN], 1u);
            else XB_SPIN(xb_ld(&bar[XB_TOPGEN]) == tg, bar);
            __builtin_amdgcn_fence(__ATOMIC_ACQUIRE, "agent");
            xb_add(&bar[XB_XGEN(b.x)], 1u);
            asm volatile("s_waitcnt vmcnt(0)" ::: "memory");
        } else {
            XB_SPIN(xb_ld(&bar[XB_XGEN(b.x)]) == gen, bar);
            __builtin_amdgcn_fence(__ATOMIC_ACQUIRE, "agent");
            asm volatile("s_waitcnt vmcnt(0)" ::: "memory");
        }
    }
    __syncthreads();
}

__device__ __forceinline__ float wave_sum(float v) {
    v = xsum<1>(v); v = xsum<2>(v); v = xsum<4>(v); v = xsum<8>(v); v = xsum<16>(v); v = xsum<32>(v);
    return v;
}
__device__ __forceinline__ void cvt_item(const float* W, int ldw, int K, int srcA, int srcB, bf16* WT, int dst_row0, int k0, LAS float* scr, int lane, bool ident = false) {
    const int kq = lane >> 4, nq = lane & 15; const int scol = (nq < 8 ? srcA + 4 * nq : srcB + 4 * (nq - 8));
    f32x4 v[16];
#pragma unroll
    for (int i = 0; i < 16; ++i) v[i] = *(const GAS f32x4*)(W + (size_t)(k0 + 4 * i + kq) * ldw + scol);
#pragma unroll
    for (int i = 0; i < 16; ++i)
#pragma unroll
        for (int e = 0; e < 4; ++e) scr[(4 * i + kq) * 65 + 4 * nq + e] = v[i][e];
    LDS_WAIT(); asm volatile("" ::: "memory");
    const int c = lane & 7, rr = lane >> 3;
#pragma unroll
    for (int j = 0; j < 8; ++j) { const int rho = rr + 8 * j; const int sc = (rho & 32) + (ident ? (rho & 31) : pg8::perm32(rho & 31)); const LAS float* s = scr + (8 * c) * 65 + sc;
        v4u o; o.x = pk2(s[0 * 65], s[1 * 65]); o.y = pk2(s[2 * 65], s[3 * 65]); o.z = pk2(s[4 * 65], s[5 * 65]); o.w = pk2(s[6 * 65], s[7 * 65]);
        *(GAS v4u*)(WT + (size_t)(dst_row0 + rho) * K + k0 + 8 * c) = o; }
    LDS_WAIT(); asm volatile("" ::: "memory");
}
__device__ __forceinline__ void cvt_item_f8(const float* W, int ldw, int K, int srcA, int srcB, unsigned char* WT, int dst_row0, int k0, LAS float* scr, int lane, bool ident = false) {
    const int kq = lane >> 4, nq = lane & 15; const int scol = (nq < 8 ? srcA + 4 * nq : srcB + 4 * (nq - 8));
    f32x4 v[16];
#pragma unroll
    for (int i = 0; i < 16; ++i) v[i] = *(const GAS f32x4*)(W + (size_t)(k0 + 4 * i + kq) * ldw + scol);
#pragma unroll
    for (int i = 0; i < 16; ++i)
#pragma unroll
        for (int e = 0; e < 4; ++e) scr[(4 * i + kq) * 65 + 4 * nq + e] = v[i][e] * pg8::W8_SCALE;
    LDS_WAIT(); asm volatile("" ::: "memory");
    const int c = lane & 7, rr = lane >> 3;
#pragma unroll
    for (int j = 0; j < 8; ++j) { const int rho = rr + 8 * j; const int sc = (rho & 32) + (ident ? (rho & 31) : pg8::perm32(rho & 31)); const LAS float* s = scr + (8 * c) * 65 + sc;
        unsigned w0 = 0, w1 = 0;
        w0 = __builtin_amdgcn_cvt_pk_fp8_f32(s[0 * 65], s[1 * 65], w0, false); w0 = __builtin_amdgcn_cvt_pk_fp8_f32(s[2 * 65], s[3 * 65], w0, true);
        w1 = __builtin_amdgcn_cvt_pk_fp8_f32(s[4 * 65], s[5 * 65], w1, false); w1 = __builtin_amdgcn_cvt_pk_fp8_f32(s[6 * 65], s[7 * 65], w1, true);
        v2u o; o.x = w0; o.y = w1; *(GAS v2u*)(WT + (size_t)(dst_row0 + rho) * K + k0 + 8 * c) = o; }
    LDS_WAIT(); asm volatile("" ::: "memory");
}
__device__ __forceinline__ int win_src(int X) { const int pn = X >> 3, bj = (X >> 2) & 1, wc = X & 3; return (pn >= 9 && pn < 14) ? pn * 256 + 64 * wc + 32 * bj : 32 * X; }
__device__ __forceinline__ int wgu_src(int X) { const int pn = X >> 3, bj = (X >> 2) & 1, wc = X & 3; return bj * 1024 + 128 * pn + 32 * wc; }

__device__ __forceinline__ void norm_row_bf16(const float* xrow, const float* g, const float* sc, const float* sh, bf16* orow, int lane) {
    const GAS f32x4* xr = (const GAS f32x4*)xrow + lane;
    f32x4 v[4]; float s = 0.f;
#pragma unroll
    for (int j = 0; j < 4; ++j) { v[j] = xr[64 * j]; s += (v[j].x * v[j].x + v[j].y * v[j].y) + (v[j].z * v[j].z + v[j].w * v[j].w); }
    const float rs = rsqrtf(wave_sum(s) * (1.0f / D) + EPS);
#pragma unroll
    for (int j = 0; j < 4; ++j) { const int c = 256 * j + 4 * lane;
        const f32x4 gg = *(const GAS f32x4*)(g + c), s1 = *(const GAS f32x4*)(sc + c), s0 = *(const GAS f32x4*)(sh + c);
        const f32x4 y = (v[j] * rs * gg) * (s1 + 1.0f) + s0;
        v2u o; o.x = pk2(y.x, y.y); o.y = pk2(y.z, y.w); *(GAS v2u*)(orow + c) = o; }
}

__device__ __forceinline__ void norm_rows2_bf16(const float* xrow, const float* g, const float* sc, const float* sh, bf16* orow, int lane) {
    const GAS f32x4* xr = (const GAS f32x4*)xrow + lane;
    f32x4 v[2][4]; float s0 = 0.f, s1 = 0.f;
#pragma unroll
    for (int j = 0; j < 4; ++j) { v[0][j] = xr[64 * j]; v[1][j] = xr[256 + 64 * j]; }
#pragma unroll
    for (int j = 0; j < 4; ++j) { s0 += (v[0][j].x * v[0][j].x + v[0][j].y * v[0][j].y) + (v[0][j].z * v[0][j].z + v[0][j].w * v[0][j].w); s1 += (v[1][j].x * v[1][j].x + v[1][j].y * v[1][j].y) + (v[1][j].z * v[1][j].z + v[1][j].w * v[1][j].w); }
    const float rs0 = rsqrtf(wave_sum(s0) * (1.0f / D) + EPS), rs1 = rsqrtf(wave_sum(s1) * (1.0f / D) + EPS);
#pragma unroll
    for (int j = 0; j < 4; ++j) { const int c = 256 * j + 4 * lane;
        const f32x4 gg = *(const GAS f32x4*)(g + c), a1 = *(const GAS f32x4*)(sc + c) + 1.0f, a0 = *(const GAS f32x4*)(sh + c);
        const f32x4 y0 = (v[0][j] * rs0 * gg) * a1 + a0, y1 = (v[1][j] * rs1 * gg) * a1 + a0;
        v2u o0; o0.x = pk2(y0.x, y0.y); o0.y = pk2(y0.z, y0.w); *(GAS v2u*)(orow + c) = o0;
        v2u o1; o1.x = pk2(y1.x, y1.y); o1.y = pk2(y1.z, y1.w); *(GAS v2u*)(orow + D + c) = o1; }
}

__device__ __forceinline__ void norm_rows2_f8(const float* xrow, const float* g, const float* sc, const float* sh, unsigned char* orow, int lane) {
    const GAS f32x4* xr = (const GAS f32x4*)xrow + lane;
    f32x4 v[2][4]; float s0 = 0.f, s1 = 0.f;
#pragma unroll
    for (int j = 0; j < 4; ++j) { v[0][j] = xr[64 * j]; v[1][j] = xr[256 + 64 * j]; }
#pragma unroll
    for (int j = 0; j < 4; ++j) { s0 += (v[0][j].x * v[0][j].x + v[0][j].y * v[0][j].y) + (v[0][j].z * v[0][j].z + v[0][j].w * v[0][j].w); s1 += (v[1][j].x * v[1][j].x + v[1][j].y * v[1][j].y) + (v[1][j].z * v[1][j].z + v[1][j].w * v[1][j].w); }
    const float rs0 = rsqrtf(wave_sum(s0) * (1.0f / D) + EPS), rs1 = rsqrtf(wave_sum(s1) * (1.0f / D) + EPS);
#pragma unroll
    for (int j = 0; j < 4; ++j) { const int c = 256 * j + 4 * lane;
        const f32x4 gg = *(const GAS f32x4*)(g + c), a1 = *(const GAS f32x4*)(sc + c) + 1.0f, a0 = *(const GAS f32x4*)(sh + c);
        const f32x4 y0 = (v[0][j] * rs0 * gg) * a1 + a0, y1 = (v[1][j] * rs1 * gg) * a1 + a0;
        unsigned w0 = 0, w1 = 0;
        w0 = __builtin_amdgcn_cvt_pk_fp8_f32(y0.x, y0.y, w0, false); w0 = __builtin_amdgcn_cvt_pk_fp8_f32(y0.z, y0.w, w0, true);
        w1 = __builtin_amdgcn_cvt_pk_fp8_f32(y1.x, y1.y, w1, false); w1 = __builtin_amdgcn_cvt_pk_fp8_f32(y1.z, y1.w, w1, true);
        *(GAS unsigned*)(orow + c) = w0; *(GAS unsigned*)(orow + D + c) = w1; }
}

struct Args { const float* in[20]; float* out; unsigned char* ws; int ph_lo, ph_hi, li, pad; };
constexpr int N_PHASES = 2 + 10 * DEPTH;

typedef const __attribute__((address_space(4))) Args* kargs_t;
__device__ __forceinline__ kargs_t kargs_opaque() { kargs_t p = (kargs_t)__builtin_amdgcn_kernarg_segment_ptr(); asm volatile("" : "+s"(p)); return p; }
#define PH_BEGIN() kargs_t ap = kargs_opaque(); unsigned char* ws = ap->ws; (void)ws; \
    int wave = wave_s; asm volatile("" : "+s"(wave)); const int lane = lane_id_asm(); const int tid = wave * 64 + lane; (void)lane; (void)tid; \
    int bx = blockIdx.x; asm volatile("" : "+s"(bx)); int G = gridDim.x; asm volatile("" : "+s"(G)); const int vcu = (G % 8 == 0) ? (bx % 8) * (G / 8) + bx / 8 : bx; (void)vcu; \
    const int gw = vcu * NWAVES + wave, NGW = G * NWAVES; (void)gw; (void)NGW; const int gtid = vcu * (NWAVES * 64) + tid, NGT = G * NWAVES * 64; (void)gtid; (void)NGT
#define INP(k) (ap->in[k])
#define x_in INP(0)
#define c_in INP(1)
#define w_ada INP(2)
#define b_ada INP(3)
#define norm1_g INP(4)
#define w_in INP(5)
#define q_norm_g INP(6)
#define k_norm_g INP(7)
#define rel_bias INP(8)
#define w_br_a INP(9)
#define w_br_b INP(10)
#define w_out INP(11)
#define norm2_g INP(12)
#define w_router INP(13)
#define b_router INP(14)
#define w_gate_up INP(15)
#define b_gate_up INP(16)
#define w_down INP(17)
#define b_down INP(18)
#define final_g INP(19)
#define MOD ((float*)(ws + WS_MOD))
#define ROPE ((float*)(ws + WS_ROPE))
#define BLUT ((float*)(ws + WS_BLUT))
#define RC0 ((float*)(ws + WS_RC0))
#define HIST ((int*)(ws + WS_HIST))
#define TILEE ((int*)(ws + WS_TILEE))
#define TOPE ((int*)(ws + WS_TOPE))
#define TOPW ((float*)(ws + WS_TOPW))
#define SLOT ((int*)(ws + WS_SLOT))
#define ROWW ((float*)(ws + WS_ROWW))
#define LSE ((float*)(ws + WS_LSE))
#define WRHI ((bf16*)(ws + WS_WRHI))
#define WRLO ((bf16*)(ws + WS_WRLO))
#define WIN ((unsigned char*)(ws + WS_WIN))
#define WBRA ((unsigned char*)(ws + WS_WBRA))
#define WBRB ((unsigned char*)(ws + WS_WBRB))
#define WOUT ((unsigned char*)(ws + WS_WOUT))
#define WGU ((unsigned char*)(ws + WS_WGU))
#define WDN ((unsigned char*)(ws + WS_WDN))
#define X ((float*)(ws + WS_X))
#define H ((bf16*)(ws + WS_H))
#define AQKV ((bf16*)(ws + WS_AQKV))
#define QB ((bf16*)(ws + WS_QB))
#define KB ((bf16*)(ws + WS_KB))
#define VB ((bf16*)(ws + WS_VB))
#define GATE ((bf16*)(ws + WS_GATE))
#define OAG ((bf16*)(ws + WS_OAG))
#define OA ((unsigned char*)(ws + WS_OA))
#define MERGED ((bf16*)(ws + WS_MERGED))
#define OB ((unsigned char*)(ws + WS_OB))
#define M8 ((unsigned char*)(ws + WS_M8))
#define XS ((unsigned char*)(ws + WS_XS))
#define ACT ((unsigned char*)(ws + WS_ACT))
#define YB ((bf16*)(ws + WS_Y))
__global__ void __launch_bounds__(NWAVES * 64, 2) mk_fwd(Args args) {
    extern __shared__ __attribute__((aligned(16))) unsigned char lds[];
    LAS unsigned char* L = (LAS unsigned char*)lds;
    volatile LAS unsigned* MISC = (volatile LAS unsigned*)(L + LDSCTL_OFF);
    gu32* ctl = (gu32*)(args.ws + WS_CTL);
    const int wave_s = __builtin_amdgcn_readfirstlane(threadIdx.x >> 6);
    for (int u = threadIdx.x; u < (LDS_BYTES - LDSCTL_OFF) / 4; u += NWAVES * 64) ((LAS unsigned*)(L + LDSCTL_OFF))[u] = 0u;
    __syncthreads();
    XcdBarrier bar; bar.bar = (unsigned*)(ctl + CW_BAR) + args.li * XCD_BAR_WORDS; bar.x = 0; bar.st = nullptr;
    if (!MK_PER_PHASE) bar = xcd_barrier_post((unsigned*)(ctl + CW_BAR) + args.li * XCD_BAR_WORDS, MISC + 8);
    const int lo = args.ph_lo, hi = args.ph_hi;
#define IN(k) (lo <= (k) && (k) < hi)
#define KIND(q) ((PH_KIND_MASK >> (q)) & 1)
#define SEAM(k) do { if (IN(k) && IN((k) + 1)) xcd_barrier(bar); } while (0)

    for (int rep0 = 0; rep0 < 1 + PROBE_P0; ++rep0) {
    if (KIND(0) && IN(0)) { PH_BEGIN();
        {
            LAS float* cact = (LAS float*)L;
            LAS float* part = (LAS float*)(L + 32768);
            for (int i = tid; i < NB * D; i += NWAVES * 64) { const float cv = c_in[i]; cact[i] = cv / (1.0f + __expf(-cv)); }
            __syncthreads();
            for (int vb = bx; vb < 256; vb += G) {
                const int gc = vb * 48 + lane;
                const int l = gc / 6144, col = gc % 6144;
                float a[NB];
#pragma unroll
                for (int b = 0; b < NB; ++b) a[b] = 0.f;
                if (lane < 48) {
                    const float* wp = w_ada + (size_t)l * D * 6144 + col;
                    for (int k = wave * 128; k < wave * 128 + 128; ++k) { const float w = wp[(size_t)k * 6144];
#pragma unroll
                        for (int b = 0; b < NB; ++b) a[b] += cact[b * D + k] * w; }
                }
#pragma unroll
                for (int b = 0; b < NB; ++b) part[(wave * NB + b) * 64 + lane] = a[b];
                __syncthreads();
                if (tid < NB * 48) { const int b = tid / 48, cl = tid % 48; const int gc2 = vb * 48 + cl; const int l2 = gc2 / 6144, col2 = gc2 % 6144;
                    float s = b_ada[l2 * 6144 + col2];
#pragma unroll
                    for (int w = 0; w < NWAVES; ++w) s += part[(w * NB + b) * 64 + cl];
                    MOD[((size_t)l2 * NB + b) * 6144 + col2] = s; }
                __syncthreads();
            }
        }
        for (int i = gtid; i < 1024 + 12 * 768; i += NGT) {
            if (i < 1024) { const int p = i >> 4, f = i & 15; const double inv = pow(10000.0, -(double)f / 16.0); const double ang = (double)p * inv; ROPE[i] = (float)cos(ang); ROPE[1024 + i] = (float)sin(ang); }
            else { const int j = i - 1024; const int hh = j / 768, di = j % 768; const int delta = di - 383; const int g = hh >> 2; const int dil = g == 0 ? 1 : (g == 1 ? 4 : 16);
                float val = -INFINITY;
                if (delta >= -64 && delta <= 64) { const int rel = delta * dil; const int n = rel < 0 ? -rel : rel; int bk = rel > 0 ? 16 : 0;
                    if (n < 8) bk += n; else { int lg = 8 + (int)(logf((float)n / 8.0f) / logf(128.0f) * 8.0f); if (lg > 15) lg = 15; bk += lg; }
                    val = rel_bias[bk * 12 + hh] * LOG2E; }
                BLUT[j] = val; }
        }
        {
            LAS float* scr = (LAS float*)(L + wave * 16640);
            __syncthreads();
            constexpr int I_IN = 16 * 92, I_BRA = 4 * 16, I_BRB = 16 * 16, I_OUT = 16 * 16, I_GU = 16 * 32, I_DN = 16 * 16;
            constexpr int PER_L = I_IN + I_BRA + I_BRB + I_OUT;
            constexpr int NITEMS = DEPTH * PER_L + DEPTH * NE * (I_GU + I_DN);
            for (int it = gw; it < NITEMS; it += NGW) {
                int r = it;
                if (r < DEPTH * PER_L) {
                    const int l = r / PER_L; r %= PER_L;
                    if (r < I_IN) { const int kb = r / 92, g64 = r % 92; cvt_item_f8(w_in + (size_t)l * D * N_IN, N_IN, D, win_src(2 * g64), win_src(2 * g64 + 1), WIN + (size_t)l * N_IN * D, 64 * g64, 64 * kb, scr, lane, (g64 >> 2) >= 9 && (g64 >> 2) < 14); continue; } r -= I_IN;
                    if (r < I_BRA) { const int kb = r / 16, g64 = r % 16; cvt_item_f8(w_br_a + (size_t)l * 256 * D, D, 256, 64 * g64, 64 * g64 + 32, WBRA + (size_t)l * D * 256, 64 * g64, 64 * kb, scr, lane); continue; } r -= I_BRA;
                    if (r < I_BRB) { const int kb = r / 16, g64 = r % 16; cvt_item_f8(w_br_b + (size_t)l * D * D, D, D, 64 * g64, 64 * g64 + 32, WBRB + (size_t)l * D * D, 64 * g64, 64 * kb, scr, lane); continue; } r -= I_BRB;
                    { const int kb = r / 16, g64 = r % 16; cvt_item_f8(w_out + (size_t)l * D * D, D, D, 64 * g64, 64 * g64 + 32, WOUT + (size_t)l * D * D, 64 * g64, 64 * kb, scr, lane); continue; }
                }
                r -= DEPTH * PER_L;
                if (r < DEPTH * NE * I_GU) { const int le = r / I_GU; r %= I_GU; const int kb = r / 32, g64 = r % 32;
                    cvt_item_f8(w_gate_up + (size_t)le * D * 2048, 2048, D, wgu_src(2 * g64), wgu_src(2 * g64 + 1), WGU + (size_t)le * 2048 * D, 64 * g64, 64 * kb, scr, lane); continue; }
                r -= DEPTH * NE * I_GU;
                { const int le = r / I_DN; r %= I_DN; const int kb = r / 16, g64 = r % 16;
                    cvt_item_f8(w_down + (size_t)le * D * D, D, D, 64 * g64, 64 * g64 + 32, WDN + (size_t)le * D * D, 64 * g64, 64 * kb, scr, lane); }
            }
        }
    }
    SEAM(0);
    }
    if (KIND(1) && IN(1)) { PH_BEGIN();
        for (int m = 2 * gw; m < T; m += 2 * NGW) { const int b = m >> 12; const float* md = MOD + (size_t)b * 6144;
            norm_rows2_f8(x_in + (size_t)m * D, norm1_g, md + 1024, md, (unsigned char*)H + (size_t)m * D, lane); }
        for (int i = gtid; i < DEPTH * NB * NE * D; i += NGT) { const int k = i & 1023, e = (i >> 10) & 31, b = (i >> 15) & 7, l = i >> 18;
            const float v = norm2_g[l * D + k] * (1.0f + MOD[((size_t)l * NB + b) * 6144 + 4 * 1024 + k]) * w_router[((size_t)l * D + k) * NE + e];
            const unsigned hb = f2bf(v); const float lv = v - __uint_as_float(hb << 16);
            WRHI[i] = (bf16)hb; WRLO[i] = (bf16)f2bf(lv); }
        for (int i = gw; i < DEPTH * NB * NE; i += NGW) { const int e = i & 31, b = (i >> 5) & 7, l = i >> 8; float s = 0.f;
            for (int k = lane; k < D; k += 64) s += MOD[((size_t)l * NB + b) * 6144 + 3 * 1024 + k] * w_router[((size_t)l * D + k) * NE + e];
            s = wave_sum(s); if (lane == 0) RC0[i] = s + b_router[l * NE + e]; }
    }
    SEAM(1);

    for (int li = (PROBE_MASK ? -1 : 0); li < DEPTH; ++li) {
        const int l = li < 0 ? 0 : li; const bool virt = li < 0;
        const int P = 2 + 10 * l;
#define VK(q) (!virt || ((PROBE_MASK >> (q)) & 1))
        if (KIND(2) && IN(P + 0) && VK(2)) { PH_BEGIN();
            pg8::Gemm g{H, (const bf16*)(WIN + (size_t)l * N_IN * D), D / 2}; pg8::StaticOrder S; S.init(T, N_IN, G, bx);
            pg8::EpiIn E{AQKV, QB, KB, VB, GATE, q_norm_g + l * 64, k_norm_g + l * 64, ROPE, pg8::W8_INV};
            pg8::gemm_phase_f8<pg8::EpiIn, pg8::StaticOrder>(L, g, S, E, wave);
        }
        if (VK(2)) SEAM(P + 0);
        if (KIND(3) && IN(P + 1) && VK(3)) { PH_BEGIN();
            namespace ab = attn_body;
            bool nomax;
            { float gq = fabsf(q_norm_g[l * 64 + lane]), gk = fabsf(k_norm_g[l * 64 + lane]);
              gq = fmaxf(gq, __int_as_float(__builtin_amdgcn_ds_swizzle(__float_as_int(gq), 0x1f | (1 << 10)))); gk = fmaxf(gk, __int_as_float(__builtin_amdgcn_ds_swizzle(__float_as_int(gk), 0x1f | (1 << 10))));
              gq = fmaxf(gq, __int_as_float(__builtin_amdgcn_ds_swizzle(__float_as_int(gq), 0x1f | (2 << 10)))); gk = fmaxf(gk, __int_as_float(__builtin_amdgcn_ds_swizzle(__float_as_int(gk), 0x1f | (2 << 10))));
              gq = fmaxf(gq, __int_as_float(__builtin_amdgcn_ds_swizzle(__float_as_int(gq), 0x1f | (4 << 10)))); gk = fmaxf(gk, __int_as_float(__builtin_amdgcn_ds_swizzle(__float_as_int(gk), 0x1f | (4 << 10))));
              gq = fmaxf(gq, __int_as_float(__builtin_amdgcn_ds_swizzle(__float_as_int(gq), 0x1f | (8 << 10)))); gk = fmaxf(gk, __int_as_float(__builtin_amdgcn_ds_swizzle(__float_as_int(gk), 0x1f | (8 << 10))));
              gq = fmaxf(gq, __int_as_float(__builtin_amdgcn_ds_swizzle(__float_as_int(gq), 0x1f | (16 << 10)))); gk = fmaxf(gk, __int_as_float(__builtin_amdgcn_ds_swizzle(__float_as_int(gk), 0x1f | (16 << 10))));
              gq = fmaxf(gq, xget32(gq, lane >> 5)); gk = fmaxf(gk, xget32(gk, lane >> 5));
              const float bound = 64.0f * gq * gk * C2 * 1.01f; nomax = __builtin_amdgcn_readfirstlane((int)(bound <= 40.0f)) != 0; }
            for (int j = 0; j < 8; ++j) {
                const int uidx = vcu * 8 + j; if (uidx >= 2048) break;
                const int pair = uidx >> 6, idx = uidx & 63; const int b = pair >> 2, kvh = pair & 3, hq = idx >> 4, qb = idx & 15; const int h = kvh * 4 + hq;
                ab::Job J; J.Q = (const ab::bf16*)QB + ((size_t)b * SEQ + qb * 256) * 1024 + h * 64; J.K = (const ab::bf16*)KB + (size_t)b * SEQ * 256 + kvh * 64; J.V = (const ab::bf16*)VB + (size_t)b * SEQ * 256 + kvh * 64;
                J.O = (ab::bf16*)(OB + ((size_t)b * SEQ + qb * 256) * 1024 + h * 64)  ; J.lse = nullptr; J.lutg = nullptr; J.NT = 64; J.i0 = 0; J.kq0 = 0; J.dsh = 0; J.cls = 0;
                if (nomax) ab::attn_unit<0, 8, true>(J, (char*)lds, wave); else ab::attn_unit<0, 8, false>(J, (char*)lds, wave);
            }
            for (int j = 0; j < 6; ++j) {
                const int uidx = vcu * 6 + j; if (uidx >= 1536) break;
                const int g = uidx / 512, r = uidx % 512; const int b = r >> 6, hs = (r >> 4) & 3, combo = r & 15;
                const int dsh = 2 * g; const int Lc = SEQ >> dsh; const int nqb = Lc >> 8;
                const int cls = combo / nqb, qb = combo % nqb; const int i0 = qb * 256;
                int t0 = (i0 >> 6) - 1; const int ntile = Lc >> 6; const int NT = ntile >= 6 ? 6 : 4; if (t0 < 0) t0 = 0; if (t0 > ntile - NT) t0 = ntile - NT;
                const size_t cbase = (size_t)b * SEQ + (size_t)cls * Lc;
                const ab::bf16* aq = (const ab::bf16*)AQKV + (size_t)(g * 3 + 0) * T * 256; const ab::bf16* ak = (const ab::bf16*)AQKV + (size_t)(g * 3 + 1) * T * 256; const ab::bf16* av = (const ab::bf16*)AQKV + (size_t)(g * 3 + 2) * T * 256;
                ab::Job J; J.Q = aq + (cbase + i0) * 256 + hs * 64; J.K = ak + (cbase + t0 * 64) * 256 + hs * 64; J.V = av + (cbase + t0 * 64) * 256 + hs * 64;
                J.O = (ab::bf16*)OAG + (size_t)g * T * 256 + (size_t)b * SEQ * 256 + hs * 64; J.lse = LSE + (size_t)g * T * 4 + (size_t)b * SEQ * 4 + hs; J.lutg = BLUT + (g * 4 + hs) * 768;
                J.NT = NT; J.i0 = i0; J.kq0 = t0 * 64 - i0; J.dsh = dsh; J.cls = cls;
                ab::attn_unit<1, 8>(J, (char*)lds, wave);
            }
        }
        if (VK(3)) SEAM(P + 1);
        if (KIND(4) && IN(P + 2) && VK(4)) { PH_BEGIN();
            for (int i = gtid; i < T * 32; i += NGT) { const int t = i >> 5, ch = i & 31, hs = ch >> 3;
                const float l0 = LSE[(size_t)t * 4 + hs], l1 = LSE[(size_t)T * 4 + (size_t)t * 4 + hs], l2 = LSE[(size_t)2 * T * 4 + (size_t)t * 4 + hs];
                const float mx = fmaxf(l0, fmaxf(l1, l2)); float w0 = exp2f(l0 - mx), w1 = exp2f(l1 - mx), w2 = exp2f(l2 - mx); const float inv = 1.0f / (w0 + w1 + w2); w0 *= inv; w1 *= inv; w2 *= inv;
                const v4u a = *(const GAS v4u*)(OAG + (size_t)t * 256 + ch * 8), bq = *(const GAS v4u*)(OAG + (size_t)T * 256 + (size_t)t * 256 + ch * 8), cq = *(const GAS v4u*)(OAG + (size_t)2 * T * 256 + (size_t)t * 256 + ch * 8);
                unsigned o0 = 0, o1 = 0;
                o0 = __builtin_amdgcn_cvt_pk_fp8_f32(w0 * bfl(a.x) + w1 * bfl(bq.x) + w2 * bfl(cq.x), w0 * bfh(a.x) + w1 * bfh(bq.x) + w2 * bfh(cq.x), o0, false);
                o0 = __builtin_amdgcn_cvt_pk_fp8_f32(w0 * bfl(a.y) + w1 * bfl(bq.y) + w2 * bfl(cq.y), w0 * bfh(a.y) + w1 * bfh(bq.y) + w2 * bfh(cq.y), o0, true);
                o1 = __builtin_amdgcn_cvt_pk_fp8_f32(w0 * bfl(a.z) + w1 * bfl(bq.z) + w2 * bfl(cq.z), w0 * bfh(a.z) + w1 * bfh(bq.z) + w2 * bfh(cq.z), o1, false);
                o1 = __builtin_amdgcn_cvt_pk_fp8_f32(w0 * bfl(a.w) + w1 * bfl(bq.w) + w2 * bfl(cq.w), w0 * bfh(a.w) + w1 * bfh(bq.w) + w2 * bfh(cq.w), o1, true);
                v2u o; o.x = o0; o.y = o1; *(GAS v2u*)(OA + (size_t)t * 256 + ch * 8) = o; }
        }
        if (VK(4)) SEAM(P + 2);
        if (KIND(5) && IN(P + 3) && VK(5)) { PH_BEGIN();
            pg8::StaticOrder S; S.init(T, D, G, bx);
            { pg8::Gemm g{(const bf16*)OA, (const bf16*)(WBRA + (size_t)l * D * 256), 128}; pg8::EpiMergeA E{GATE, MERGED}; pg8::gemm_phase_f8<pg8::EpiMergeA, pg8::StaticOrder>(L, g, S, E, wave); }
            { pg8::Gemm g{(const bf16*)OB, (const bf16*)(WBRB + (size_t)l * D * D), D / 2}; pg8::EpiMergeB<true> E{GATE, MERGED, M8}; pg8::gemm_phase_f8<pg8::EpiMergeB<true>, pg8::StaticOrder>(L, g, S, E, wave); }
        }
        if (VK(5)) SEAM(P + 3);
        if (KIND(6) && IN(P + 4) && VK(6)) { PH_BEGIN();
            pg8::Gemm g{(const bf16*)M8, (const bf16*)(WOUT + (size_t)l * D * D), D / 2}; pg8::StaticOrder S; S.init(T, D, G, bx);
            pg8::EpiOut E{l == 0 ? x_in : X, X, MOD + (size_t)l * NB * 6144 + 2 * 1024};
            pg8::gemm_phase_f8<pg8::EpiOut, pg8::StaticOrder>(L, g, S, E, wave);
        }
        if (VK(6)) SEAM(P + 4);
        if (KIND(7) && IN(P + 5) && VK(7)) { PH_BEGIN();
            LAS int* hist = (LAS int*)(L + LDSCTL_OFF + 256);
            for (int vb = bx; vb < 256; vb += G) {
                if (tid < NE) hist[tid] = 0;
                __syncthreads();
                {
                    const int tt = vb + 256 * wave; const int r0 = tt * 16; const int b = r0 >> 12; const int i = lane & 15, kb = lane >> 4;
                    const float* xp = X + (size_t)(r0 + i) * D + 8 * kb;
                    const bf16* bh = WRHI + ((size_t)(l * NB + b) * NE + i) * D + 8 * kb; const bf16* bl = WRLO + ((size_t)(l * NB + b) * NE + i) * D + 8 * kb;
                    f32x4 acc0 = (f32x4){0.f, 0.f, 0.f, 0.f}, acc1 = acc0; float ss = 0.f;
#pragma unroll 4
                    for (int s = 0; s < 32; ++s) {
                        const f32x4 x0 = *(const GAS f32x4*)(xp + 32 * s), x1 = *(const GAS f32x4*)(xp + 32 * s + 4);
                        const bf16x8 wh0 = *(const GAS bf16x8*)(bh + 32 * s), wh1 = *(const GAS bf16x8*)(bh + 16 * D + 32 * s), wl0 = *(const GAS bf16x8*)(bl + 32 * s), wl1 = *(const GAS bf16x8*)(bl + 16 * D + 32 * s);
                        ss += (x0.x * x0.x + x0.y * x0.y) + (x0.z * x0.z + x0.w * x0.w) + (x1.x * x1.x + x1.y * x1.y) + (x1.z * x1.z + x1.w * x1.w);
                        v4u ah, al;
                        { const unsigned h0 = f2bf(x0.x), h1 = f2bf(x0.y), h2 = f2bf(x0.z), h3 = f2bf(x0.w), h4 = f2bf(x1.x), h5 = f2bf(x1.y), h6 = f2bf(x1.z), h7 = f2bf(x1.w);
                          ah.x = h0 | (h1 << 16); ah.y = h2 | (h3 << 16); ah.z = h4 | (h5 << 16); ah.w = h6 | (h7 << 16);
                          al.x = pk2(x0.x - __uint_as_float(h0 << 16), x0.y - __uint_as_float(h1 << 16)); al.y = pk2(x0.z - __uint_as_float(h2 << 16), x0.w - __uint_as_float(h3 << 16));
                          al.z = pk2(x1.x - __uint_as_float(h4 << 16), x1.y - __uint_as_float(h5 << 16)); al.w = pk2(x1.z - __uint_as_float(h6 << 16), x1.w - __uint_as_float(h7 << 16)); }
                        const bf16x8 ahv = __builtin_bit_cast(bf16x8, ah), alv = __builtin_bit_cast(bf16x8, al);
                        acc0 = __builtin_amdgcn_mfma_f32_16x16x32_bf16(wh0, ahv, acc0, 0, 0, 0); acc1 = __builtin_amdgcn_mfma_f32_16x16x32_bf16(wh1, ahv, acc1, 0, 0, 0);
                        acc0 = __builtin_amdgcn_mfma_f32_16x16x32_bf16(wl0, ahv, acc0, 0, 0, 0); acc1 = __builtin_amdgcn_mfma_f32_16x16x32_bf16(wl1, ahv, acc1, 0, 0, 0);
                        acc0 = __builtin_amdgcn_mfma_f32_16x16x32_bf16(wh0, alv, acc0, 0, 0, 0); acc1 = __builtin_amdgcn_mfma_f32_16x16x32_bf16(wh1, alv, acc1, 0, 0, 0);
                    }
                    ss = xsum<16>(ss); ss = xsum<32>(ss);
                    const float rs = rsqrtf(ss * (1.0f / D) + EPS);
                    float v[8]; const float* rc = RC0 + (l * NB + b) * NE;
#pragma unroll
                    for (int r = 0; r < 4; ++r) { v[r] = rs * acc0[r] + rc[4 * kb + r]; v[4 + r] = rs * acc1[r] + rc[16 + 4 * kb + r]; }
                    float tv[4]; int ti[4];
#pragma unroll
                    for (int k = 0; k < 4; ++k) { float best = v[0]; int br = 0;
#pragma unroll
                        for (int r = 1; r < 8; ++r) if (v[r] > best) { best = v[r]; br = r; }
#pragma unroll
                        for (int r = 0; r < 8; ++r) v[r] = (r == br) ? -INFINITY : v[r];
                        tv[k] = best; ti[k] = (br & 3) + 16 * (br >> 2) + 4 * kb; }
#pragma unroll
                    for (int round = 0; round < 2; ++round) {
                        float bv[8]; int bi[8];
#pragma unroll
                        for (int k = 0; k < 4; ++k) { bv[k] = tv[k]; bi[k] = ti[k];
                            if (round == 0) { bv[4 + k] = __int_as_float(__builtin_amdgcn_ds_swizzle(__float_as_int(tv[k]), 0x1f | (16 << 10))); bi[4 + k] = __builtin_amdgcn_ds_swizzle(ti[k], 0x1f | (16 << 10)); }
                            else { bv[4 + k] = xget32(tv[k], lane >> 5); bi[4 + k] = xget32(ti[k], lane >> 5); } }
#pragma unroll
                        for (int k = 0; k < 4; ++k) { float best = bv[0]; int bq = 0;
#pragma unroll
                            for (int r = 1; r < 8; ++r) if (bv[r] > best || (bv[r] == best && bi[r] < bi[bq])) { best = bv[r]; bq = r; }
                            int sel = bi[0];
#pragma unroll
                            for (int r = 0; r < 8; ++r) { if (r == bq) sel = bi[r]; }
#pragma unroll
                            for (int r = 0; r < 8; ++r) bv[r] = (r == bq) ? -INFINITY : bv[r];
                            tv[k] = best; ti[k] = sel; }
                    }
                    if (kb == 0) {
                        const float e1 = __expf(tv[1] - tv[0]), e2 = __expf(tv[2] - tv[0]), e3 = __expf(tv[3] - tv[0]); const float inv = 1.0f / (1.0f + e1 + e2 + e3);
                        const int tok = r0 + i;
                        *(GAS i32x4*)(TOPE + (size_t)tok * 4) = (i32x4){ti[0], ti[1], ti[2], ti[3]};
                        *(GAS f32x4*)(TOPW + (size_t)tok * 4) = (f32x4){inv, e1 * inv, e2 * inv, e3 * inv};
#pragma unroll
                        for (int k = 0; k < 4; ++k) atomicAdd((int*)&hist[ti[k]], 1);
                    }
                }
                __syncthreads();
                if (tid < NE) HIST[vb * NE + tid] = hist[tid];
                __syncthreads();
            }
            for (int m = 2 * gw; m < T; m += 2 * NGW) { const int b = m >> 12; const float* md = MOD + ((size_t)l * NB + b) * 6144;
                norm_rows2_f8(X + (size_t)m * D, norm2_g + l * D, md + 4 * 1024, md + 3 * 1024, (unsigned char*)H + (size_t)m * D, lane); }
        }
        if (VK(7)) SEAM(P + 5);
        if (KIND(8) && IN(P + 6) && VK(8)) { PH_BEGIN();
            LAS int* sm = (LAS int*)L;
            for (int vb = bx; vb < 256; vb += G) {
                { const int e = tid & 31, seg = tid >> 5; int tot = 0, bef = 0;
                    for (int q = seg * 16; q < seg * 16 + 16; ++q) { const int hv = HIST[q * NE + e]; tot += hv; if (q < vb) bef += hv; }
                    sm[tid] = tot; sm[512 + tid] = bef; }
                __syncthreads();
                if (tid < NE) { int tot = 0, bef = 0;
                    for (int s = 0; s < 16; ++s) { tot += sm[s * 32 + tid]; bef += sm[512 + s * 32 + tid]; }
                    sm[1024 + tid] = bef; sm[1056 + tid] = (tot + 255) & ~255; }
                __syncthreads();
                if (tid == 0) { int run = 0; for (int e = 0; e < NE; ++e) { const int pd = sm[1056 + e]; sm[1056 + e] = run; sm[1024 + e] += run;
                        if (vb == 0) { for (int q = run >> 8; q < (run + pd) >> 8; ++q) TILEE[q] = e; }
                        run += pd; }
                    if (vb == 0) TILEE[1000] = run >> 8; }
                __syncthreads();
                if (tid < 128) { const int tt = vb + 256 * (tid >> 4); const int tok = tt * 16 + (tid & 15);
                    const i32x4 te = *(const GAS i32x4*)(TOPE + (size_t)tok * 4); const f32x4 tw = *(const GAS f32x4*)(TOPW + (size_t)tok * 4);
                    const int s0 = atomicAdd((int*)&sm[1024 + te.x], 1), s1 = atomicAdd((int*)&sm[1024 + te.y], 1), s2 = atomicAdd((int*)&sm[1024 + te.z], 1), s3 = atomicAdd((int*)&sm[1024 + te.w], 1);
                    *(GAS i32x4*)(SLOT + (size_t)tok * 4) = (i32x4){s0, s1, s2, s3};
                    ROWW[s0] = tw.x; ROWW[s1] = tw.y; ROWW[s2] = tw.z; ROWW[s3] = tw.w;
                    sm[2048 + tid * 4 + 0] = s0; sm[2048 + tid * 4 + 1] = s1; sm[2048 + tid * 4 + 2] = s2; sm[2048 + tid * 4 + 3] = s3; }
                __syncthreads();
                for (int p = wave; p < 512; p += NWAVES) { const int q = p >> 2; const int tt = vb + 256 * (q >> 4); const int tok = tt * 16 + (q & 15); const int slot = sm[2048 + p];
                    const GAS v4u* src = (const GAS v4u*)((unsigned char*)H + (size_t)tok * D); GAS v4u* dst = (GAS v4u*)(XS + (size_t)slot * D);
                    dst[lane] = src[lane]; }
                __syncthreads();
            }
        }
        if (VK(8)) SEAM(P + 6);
        if (KIND(9) && IN(P + 7) && VK(9)) { PH_BEGIN();
            const int nmt = __builtin_amdgcn_readfirstlane(__hip_atomic_load(TILEE + 1000, __ATOMIC_RELAXED, __HIP_MEMORY_SCOPE_AGENT));
            pg8::Gemm g{(const bf16*)XS, (const bf16*)(WGU + (size_t)l * NE * 2048 * D), D / 2}; pg8::MoeOrder S{TILEE, nmt * 8, 8, G, vcu};
            pg8::EpiGU8 E{b_gate_up + (size_t)l * NE * 2048, ACT};
            pg8::gemm_phase_f8<pg8::EpiGU8, pg8::MoeOrder>(L, g, S, E, wave);
        }
        if (VK(9)) SEAM(P + 7);
        if (KIND(10) && IN(P + 8) && VK(10)) { PH_BEGIN();
            const int nmt = __builtin_amdgcn_readfirstlane(__hip_atomic_load(TILEE + 1000, __ATOMIC_RELAXED, __HIP_MEMORY_SCOPE_AGENT));
            pg8::Gemm g{(const bf16*)ACT, (const bf16*)(WDN + (size_t)l * NE * D * D), D / 2}; pg8::MoeOrder S{TILEE, nmt * 4, 4, G, vcu};
            pg8::EpiDN8 E{b_down + (size_t)l * NE * D, ROWW, YB};
            pg8::gemm_phase_f8<pg8::EpiDN8, pg8::MoeOrder>(L, g, S, E, wave);
        }
        if (VK(10)) SEAM(P + 8);
        if (KIND(11) && IN(P + 9) && VK(11)) { PH_BEGIN();
            const bool lastl = (l == DEPTH - 1);
            float* Xw = virt ? (float*)(ws + WS_R) : X; bf16* Hw = virt ? (bf16*)(ws + WS_R + 128 * MiB) : H;
            for (int m0 = 2 * gw; m0 < T; m0 += 2 * NGW) { const int b = m0 >> 12;
                i32x4 sl[2];
#pragma unroll
                for (int q = 0; q < 2; ++q) { const int* sp = SLOT + (size_t)(m0 + q) * 4;
                    sl[q].x = __hip_atomic_load(sp + 0, RLX_AGENT); sl[q].y = __hip_atomic_load(sp + 1, RLX_AGENT); sl[q].z = __hip_atomic_load(sp + 2, RLX_AGENT); sl[q].w = __hip_atomic_load(sp + 3, RLX_AGENT); }
                const float* g2 = MOD + ((size_t)l * NB + b) * 6144 + 5 * 1024;
                f32x4 v[2][4]; v2u yy[2][4][4];
#pragma unroll
                for (int q = 0; q < 2; ++q)
#pragma unroll
                    for (int j = 0; j < 4; ++j) { const int c = 256 * j + 4 * lane;
                        v[q][j] = *(const GAS f32x4*)(X + (size_t)(m0 + q) * D + c);
                        yy[q][j][0] = *(const GAS v2u*)(YB + (size_t)sl[q].x * D + c); yy[q][j][1] = *(const GAS v2u*)(YB + (size_t)sl[q].y * D + c);
                        yy[q][j][2] = *(const GAS v2u*)(YB + (size_t)sl[q].z * D + c); yy[q][j][3] = *(const GAS v2u*)(YB + (size_t)sl[q].w * D + c); }
                float s[2] = {0.f, 0.f};
#pragma unroll
                for (int q = 0; q < 2; ++q)
#pragma unroll
                    for (int j = 0; j < 4; ++j) { const int c = 256 * j + 4 * lane; const v2u y0 = yy[q][j][0], y1 = yy[q][j][1], y2 = yy[q][j][2], y3 = yy[q][j][3];
                        f32x4 ys; ys.x = (bfl(y0.x) + bfl(y1.x)) + (bfl(y2.x) + bfl(y3.x)); ys.y = (bfh(y0.x) + bfh(y1.x)) + (bfh(y2.x) + bfh(y3.x));
                        ys.z = (bfl(y0.y) + bfl(y1.y)) + (bfl(y2.y) + bfl(y3.y)); ys.w = (bfh(y0.y) + bfh(y1.y)) + (bfh(y2.y) + bfh(y3.y));
                        const f32x4 gg = *(const GAS f32x4*)(g2 + c);
                        v[q][j] = v[q][j] + gg * ys;
                        if (!lastl) *(GAS f32x4*)(Xw + (size_t)(m0 + q) * D + c) = v[q][j];
                        s[q] += (v[q][j].x * v[q][j].x + v[q][j].y * v[q][j].y) + (v[q][j].z * v[q][j].z + v[q][j].w * v[q][j].w); }
                const float rs0 = rsqrtf(wave_sum(s[0]) * (1.0f / D) + EPS), rs1 = rsqrtf(wave_sum(s[1]) * (1.0f / D) + EPS);
                if (!lastl) { const float* md = MOD + ((size_t)(l + 1) * NB + b) * 6144; const float* gn = norm1_g + (l + 1) * D;
#pragma unroll
                    for (int j = 0; j < 4; ++j) { const int c = 256 * j + 4 * lane;
                        const f32x4 gg = *(const GAS f32x4*)(gn + c), a1 = *(const GAS f32x4*)(md + 1024 + c) + 1.0f, a0 = *(const GAS f32x4*)(md + c);
                        const f32x4 y0 = (v[0][j] * rs0 * gg) * a1 + a0, y1 = (v[1][j] * rs1 * gg) * a1 + a0;
                        unsigned w0 = 0, w1 = 0;
                        w0 = __builtin_amdgcn_cvt_pk_fp8_f32(y0.x, y0.y, w0, false); w0 = __builtin_amdgcn_cvt_pk_fp8_f32(y0.z, y0.w, w0, true);
                        w1 = __builtin_amdgcn_cvt_pk_fp8_f32(y1.x, y1.y, w1, false); w1 = __builtin_amdgcn_cvt_pk_fp8_f32(y1.z, y1.w, w1, true);
                        *(GAS unsigned*)((unsigned char*)Hw + (size_t)m0 * D + c) = w0; *(GAS unsigned*)((unsigned char*)Hw + (size_t)(m0 + 1) * D + c) = w1; }
                } else {
#pragma unroll
                    for (int j = 0; j < 4; ++j) { const int c = 256 * j + 4 * lane; const f32x4 gg = *(const GAS f32x4*)(final_g + c);
                        *(GAS f32x4*)(ap->out + (size_t)m0 * D + c) = v[0][j] * rs0 * gg; *(GAS f32x4*)(ap->out + (size_t)(m0 + 1) * D + c) = v[1][j] * rs1 * gg; }
                }
            }
        }
        if (VK(11)) SEAM(P + 9);
        if (virt) { PH_BEGIN();
            for (int m = 2 * gw; m < T; m += 2 * NGW) { const int b = m >> 12; const float* md = MOD + (size_t)b * 6144; norm_rows2_f8(x_in + (size_t)m * D, norm1_g, md + 1024, md, (unsigned char*)H + (size_t)m * D, lane); }
            xcd_barrier(bar); }
    }
#undef IN
#undef SEAM
}

extern "C" void kernel_launch(void* const* d_in, const int* in_sizes, int n_in, void* d_out, int out_size, void* d_ws, size_t ws_size, hipStream_t stream) {
    static int grid = 0;
    if (grid == 0) {
        if (n_in != 20 || in_sizes[0] != T * D || out_size != T * D || ws_size < WS_END) { fprintf(stderr, "kernel_launch: unexpected shapes (n_in %d, in0 %d, out %d, ws %zu < %zu); nothing launched\n", n_in, n_in > 0 ? in_sizes[0] : -1, out_size, ws_size, (size_t)WS_END); grid = -1; return; }
        int dev = 0, cus = 0, per_cu = 0;
        if (hipGetDevice(&dev) != hipSuccess || hipDeviceGetAttribute(&cus, hipDeviceAttributeMultiprocessorCount, dev) != hipSuccess) { grid = -1; return; }
        if (hipFuncSetAttribute((const void*)mk_fwd, hipFuncAttributeMaxDynamicSharedMemorySize, LDS_BYTES) != hipSuccess) { fprintf(stderr, "kernel_launch: hipFuncSetAttribute failed\n"); grid = -1; return; }
        if (hipOccupancyMaxActiveBlocksPerMultiprocessor(&per_cu, (const void*)mk_fwd, NWAVES * 64, LDS_BYTES) != hipSuccess || per_cu < 1)
            fprintf(stderr, "kernel_launch: note: occupancy query reports %d workgroups per CU\n", per_cu);
        (void)hipGetLastError();
        grid = cus < 256 ? cus : 256;
        if (grid != 256) fprintf(stderr, "kernel_launch: %d CUs; this kernel's unit deals assume 256\n", grid);
    }
    if (grid < 0) return;
    if (hipMemsetAsync((char*)d_ws + WS_CTL, 0, CTL_ZERO_BYTES, stream) != hipSuccess) { fprintf(stderr, "kernel_launch: memset failed\n"); return; }
    Args a{};
    for (int i = 0; i < 20; ++i) a.in[i] = (const float*)d_in[i];
    a.out = (float*)d_out; a.ws = (unsigned char*)d_ws; a.pad = 0;
#if MK_PER_PHASE
    for (int p = 0; p < N_PHASES; ++p) { a.ph_lo = p; a.ph_hi = p + 1; a.li = 0; hipLaunchKernelGGL(mk_fwd, dim3(grid), dim3(NWAVES * 64), LDS_BYTES, stream, a); }
#else
    a.ph_lo = 0; a.ph_hi = N_PHASES; a.li = 0;
    hipLaunchKernelGGL(mk_fwd, dim3(grid), dim3(NWAVES * 64), LDS_BYTES, stream, a);
#endif
    const hipError_t le = hipPeekAtLastError();
    if (le != hipSuccess) fprintf(stderr, "kernel_launch: launch failed: %s\n", hipGetErrorName(le));
}
```

```cpp
#include <hip/hip_runtime.h>
#include <hip/hip_bf16.h>
#include <cstdio>
#include <cstdint>
#include <cmath>

#ifndef PH_KIND_MASK
#define PH_KIND_MASK 0xFFF
#endif
#ifndef PROBE_MASK
#define PROBE_MASK 0
#endif
#ifndef PROBE_P0
#define PROBE_P0 0
#endif
#ifndef MK_PER_PHASE
#define MK_PER_PHASE 0
#endif

constexpr int NB = 8, SEQ = 4096, T = NB * SEQ, D = 1024, DEPTH = 2;
constexpr int N_IN = 5888, NE = 32, TOPK = 4;
constexpr int NASSIGN = T * TOPK;
constexpr int MAX_MT = NASSIGN / 256 + NE;
constexpr int CAP_ROWS = MAX_MT * 256;
constexpr float C2 = 0.125f * 1.4426950408889634f;
constexpr float LOG2E = 1.4426950408889634f;
constexpr float EPS = 1e-6f;

__device__ __forceinline__ int lane_id_asm() { int l; asm volatile("v_mbcnt_lo_u32_b32 %0, -1, 0\n\tv_mbcnt_hi_u32_b32 %0, -1, %0" : "=v"(l)); return l; }

template <int M> __device__ __forceinline__ float xsum(float v) {
    if constexpr (M < 32) return v + __int_as_float(__builtin_amdgcn_ds_swizzle(__float_as_int(v), 0x1f | (M << 10)));
    else { auto rr = __builtin_amdgcn_permlane32_swap(__float_as_uint(v), __float_as_uint(v), false, false); return __uint_as_float(rr[0]) + __uint_as_float(rr[1]); }
}
template <class Tv> __device__ __forceinline__ Tv xget32(Tv v, int hf) {
    auto rr = __builtin_amdgcn_permlane32_swap(__builtin_bit_cast(unsigned, v), __builtin_bit_cast(unsigned, v), false, false); return __builtin_bit_cast(Tv, hf ? rr[0] : rr[1]);
}

namespace pg8 {
#define PG8_LAS __attribute__((address_space(3)))
typedef unsigned short bf16_t;
typedef short bf16x8 __attribute__((ext_vector_type(8)));
typedef float f32x4 __attribute__((ext_vector_type(4)));
typedef unsigned u32x4 __attribute__((ext_vector_type(4)));
typedef unsigned u32x2 __attribute__((ext_vector_type(2)));
constexpr int BM = 256, BK = 64, HALF = 128, HTB = HALF * BK * 2, STAGE_BYTES = 8 * HTB, NXCD = 8, WGM = 8;

__host__ __device__ __forceinline__ int lds_byte(int r, int c) { const int st = (r >> 4) * 2 + (c >> 5), rr = r & 15, cc = c & 31, ob = rr * 64 + cc * 2; return st * 1024 + (ob ^ (((ob >> 9) & 1) << 5)); }
__host__ __device__ __forceinline__ void stage_rc(int b, int& R, int& C) { const int st = b / 1024, sb = b % 1024, swz = sb ^ (((sb >> 9) & 1) << 5); R = (st >> 1) * 16 + swz / 64; C = (st & 1) * 32 + (swz % 64) / 2; }
__host__ __device__ __forceinline__ int perm32(int rho) { const int n = rho >> 4, i = rho & 15; return 8 * (i >> 2) + 4 * n + (i & 3); }

struct Unit { int pm, pn; };
struct Gemm { const bf16_t* A; const bf16_t* Bt; int K; };

struct StaticOrder {
    int nM, nN, nwg, G, c;
    __device__ void init(int M, int N, int G_, int c_) { nM = M / BM; nN = N / BM; nwg = nM * nN; G = G_; c = c_; }
    __device__ bool next(int i, Unit& u) const {
        const long L = (long)i * G + c; if (L >= nwg) return false;
        int wgid = (int)L; { const int q = nwg / NXCD, r = nwg % NXCD, xcd = wgid % NXCD, off = wgid / NXCD; wgid = (xcd < r ? xcd * (q + 1) : r * (q + 1) + (xcd - r) * q) + off; }
        const int nig = WGM * nN, gid = wgid / nig, fm = gid * WGM, gsz = (nM - fm) < WGM ? (nM - fm) : WGM;
        u.pm = fm + ((wgid % nig) % gsz); u.pn = (wgid % nig) / gsz; return true;
    }
};
struct MoeOrder {
    const int* tile_e; int n_units, nN, G, vcu;
    __device__ bool next(int i, Unit& u) const {
        const long L = (long)i * G + vcu; if (L >= n_units) return false;
        const int mt = (int)L / nN, pl = (int)L % nN; const int e = __builtin_amdgcn_readfirstlane(__hip_atomic_load(tile_e + mt, __ATOMIC_RELAXED, __HIP_MEMORY_SCOPE_AGENT));
        u.pm = mt; u.pn = e * nN + pl; return true;
    }
};

__device__ __forceinline__ unsigned cvt_pk_bf16(float lo, float hi) { unsigned r; asm volatile("v_cvt_pk_bf16_f32 %0, %1, %2" : "=v"(r) : "v"(lo), "v"(hi)); return r; }
__device__ __forceinline__ float bf_lo(unsigned w) { return __uint_as_float(w << 16); }
__device__ __forceinline__ float bf_hi(unsigned w) { return __uint_as_float(w & 0xffff0000u); }
__device__ __forceinline__ float sigmoid_f(float x) { return __builtin_amdgcn_rcpf(1.0f + __builtin_amdgcn_exp2f(-LOG2E * x)); }

template <class Epi, class Sched>
__device__ __forceinline__ void gemm_phase(PG8_LAS unsigned char* lds, const Gemm g, const Sched& S, const Epi& E, const int wid_in) {
    int wid = wid_in; asm volatile("" : "+s"(wid));
    const int lane = lane_id_asm(), tid = wid * 64 + lane, wr = wid >> 2, wc = wid & 3, fr = lane & 15, fq = lane >> 4;
    int K_o = g.K; asm volatile("" : "+s"(K_o)); const int K = K_o, nt = K / BK;
    unsigned voff[2];
#pragma unroll
    for (int i = 0; i < 2; ++i) { int R, C; stage_rc(tid * 16 + i * 8192, R, C); voff[i] = (unsigned)(R * K + C) * 2u; }
    const size_t kstep = (size_t)(BK * 2);
    const size_t hstep = (size_t)HALF * K * 2;
    const size_t tstep = 2 * hstep;
    const unsigned ldsw = (unsigned)wid * 1024u;
    const int aoff = lds_byte(wr * 64 + fr, fq * 8), boff = lds_byte(wc * 32 + fr, fq * 8);
#define PG8_SA(b, h) (((b) * 2 + (h)) * HTB)
#define PG8_SB(b, h) ((4 + (b) * 2 + (h)) * HTB)
#define PG8_STAGE(bufoff, gbase) do { _Pragma("unroll") for (int _i = 0; _i < 2; ++_i) \
        __builtin_amdgcn_global_load_lds((const unsigned*)((const char*)(gbase) + voff[_i]), (PG8_LAS unsigned*)(lds + (bufoff) + ldsw + _i * 8192), 16, 0, 0); } while (0)
#define PG8_LDA(dst, b, h) do { _Pragma("unroll") for (int m = 0; m < 4; ++m) _Pragma("unroll") for (int k = 0; k < 2; ++k) dst[m][k] = *(const PG8_LAS bf16x8*)(lds + PG8_SA(b, h) + aoff + m * 2048 + k * 1024); } while (0)
#define PG8_LDB(dst, b, h) do { _Pragma("unroll") for (int n = 0; n < 2; ++n) _Pragma("unroll") for (int k = 0; k < 2; ++k) dst[n][k] = *(const PG8_LAS bf16x8*)(lds + PG8_SB(b, h) + boff + n * 2048 + k * 1024); } while (0)
#define PG8_MMA(ai, bj, At, Bt) do { __builtin_amdgcn_s_setprio(1); _Pragma("unroll") for (int m = 0; m < 4; ++m) _Pragma("unroll") for (int n = 0; n < 2; ++n) _Pragma("unroll") for (int k = 0; k < 2; ++k) \
        acc[ai][bj][m][n] = __builtin_amdgcn_mfma_f32_16x16x32_bf16(Bt[n][k], At[m][k], acc[ai][bj][m][n], 0, 0, 0); __builtin_amdgcn_s_setprio(0); } while (0)
#define PG8_WAIT_V(n) asm volatile("s_waitcnt vmcnt(" #n ")" ::: "memory")
#define PG8_WAIT_L(n) asm volatile("s_waitcnt lgkmcnt(" #n ")" ::: "memory")
#define PG8_BAR __builtin_amdgcn_s_barrier()
#define PG8_SCHED __builtin_amdgcn_sched_barrier(0)
    Unit cur, nxt; int ui = 0;
    if (!S.next(0, cur)) return;
    f32x4 acc[2][2][4][2];
#pragma unroll
    for (int a = 0; a < 2; ++a)
#pragma unroll
        for (int b = 0; b < 2; ++b)
#pragma unroll
            for (int m = 0; m < 4; ++m)
#pragma unroll
                for (int n = 0; n < 2; ++n) acc[a][b][m][n] = (f32x4){0.f, 0.f, 0.f, 0.f};
    bf16x8 At[4][2], B0[2][2], B1[2][2];
    const char* cA = (const char*)g.A + (size_t)cur.pm * tstep; const char* cB = (const char*)g.Bt + (size_t)cur.pn * tstep;
    PG8_STAGE(PG8_SB(0, 0), cB); PG8_STAGE(PG8_SB(0, 1), cB + hstep); PG8_STAGE(PG8_SA(0, 0), cA); PG8_STAGE(PG8_SA(0, 1), cA + hstep);
    if (wr == 1) PG8_BAR;
    PG8_WAIT_V(2); PG8_BAR;
    PG8_STAGE(PG8_SB(1, 0), cB + kstep); PG8_STAGE(PG8_SA(1, 0), cA + kstep); PG8_STAGE(PG8_SB(1, 1), cB + hstep + kstep);
    PG8_WAIT_V(6); PG8_BAR;
    for (;;) {
        const bool has_next = S.next(ui + 1, nxt);
        const char* nA = has_next ? (const char*)g.A + (size_t)nxt.pm * tstep : cA; const char* nB = has_next ? (const char*)g.Bt + (size_t)nxt.pn * tstep : cB;
        for (int t = 0; t < nt; t += 2) {
            const bool last = (t == nt - 2);
            const char* a1 = cA + (size_t)(t + 1) * kstep;
            const char* a2 = last ? nA : cA + (size_t)(t + 2) * kstep; const char* b2 = last ? nB : cB + (size_t)(t + 2) * kstep;
            const char* a3 = a2 + kstep; const char* b3 = b2 + kstep;
            PG8_LDB(B0, 0, 0); PG8_LDB(B1, 0, 1); PG8_SCHED; PG8_LDA(At, 0, 0); PG8_STAGE(PG8_SA(1, 1), a1 + hstep);
            PG8_WAIT_V(8); PG8_WAIT_L(0); PG8_BAR; PG8_MMA(0, 0, At, B0); PG8_MMA(0, 1, At, B1); PG8_BAR; PG8_SCHED;
            PG8_LDA(At, 0, 1); PG8_STAGE(PG8_SB(0, 0), b2); PG8_STAGE(PG8_SB(0, 1), b2 + hstep); PG8_STAGE(PG8_SA(0, 0), a2);
            PG8_WAIT_V(8); PG8_WAIT_L(0); PG8_BAR; PG8_MMA(1, 0, At, B0); PG8_MMA(1, 1, At, B1); PG8_BAR; PG8_SCHED;
            PG8_LDB(B0, 1, 0); PG8_LDB(B1, 1, 1); PG8_SCHED; PG8_LDA(At, 1, 0); PG8_STAGE(PG8_SA(0, 1), a2 + hstep);
            PG8_WAIT_V(8); PG8_WAIT_L(0); PG8_BAR; PG8_MMA(0, 0, At, B0); PG8_MMA(0, 1, At, B1); PG8_BAR; PG8_SCHED;
            PG8_LDA(At, 1, 1); PG8_STAGE(PG8_SB(1, 0), b3); PG8_STAGE(PG8_SB(1, 1), b3 + hstep); PG8_STAGE(PG8_SA(1, 0), a3);
            PG8_WAIT_V(8); PG8_WAIT_L(0); PG8_BAR; PG8_MMA(1, 0, At, B0); PG8_MMA(1, 1, At, B1); PG8_BAR; PG8_SCHED;
        }
        if (wr == 0) PG8_BAR;
        E(acc, cur, wr, wc, fr, fq);
        if (!has_next) break;
#pragma unroll
        for (int a = 0; a < 2; ++a)
#pragma unroll
            for (int b = 0; b < 2; ++b)
#pragma unroll
                for (int m = 0; m < 4; ++m)
#pragma unroll
                    for (int n = 0; n < 2; ++n) acc[a][b][m][n] = (f32x4){0.f, 0.f, 0.f, 0.f};
        cur = nxt; cA = nA; cB = nB; ++ui;
        if (wr == 1) PG8_BAR;
    }
    PG8_WAIT_V(0);
    PG8_BAR;
#undef PG8_SA
#undef PG8_SB
#undef PG8_STAGE
#undef PG8_LDA
#undef PG8_LDB
#undef PG8_MMA
#undef PG8_WAIT_V
#undef PG8_WAIT_L
#undef PG8_BAR
#undef PG8_SCHED
}

typedef int i32x4_t __attribute__((ext_vector_type(4)));
template <class Epi, class Sched>
__device__ __forceinline__ void gemm_phase_f8(PG8_LAS unsigned char* lds, const Gemm g, const Sched& S, const Epi& E, const int wid_in) {
    int wid = wid_in; asm volatile("" : "+s"(wid));
    const int lane = lane_id_asm(), tid = wid * 64 + lane, wr = wid >> 2, wc = wid & 3, fr = lane & 15, fq = lane >> 4;
    int K_o = g.K; asm volatile("" : "+s"(K_o)); const int K = K_o, nt = K / BK;
    unsigned voff[2];
#pragma unroll
    for (int i = 0; i < 2; ++i) { int R, C; stage_rc(tid * 16 + i * 8192, R, C); voff[i] = (unsigned)(R * K + C) * 2u; }
    const size_t kstep = (size_t)(BK * 2);
    const size_t hstep = (size_t)HALF * K * 2;
    const size_t tstep = 2 * hstep;
    const unsigned ldsw = (unsigned)wid * 1024u;
    const int aoff = lds_byte(wr * 64 + fr, fq * 16), boff = lds_byte(wc * 32 + fr, fq * 16);
#define PG8_SA(b, h) (((b) * 2 + (h)) * HTB)
#define PG8_SB(b, h) ((4 + (b) * 2 + (h)) * HTB)
#define PG8_STAGE(bufoff, gbase) do { _Pragma("unroll") for (int _i = 0; _i < 2; ++_i) \
        __builtin_amdgcn_global_load_lds((const unsigned*)((const char*)(gbase) + voff[_i]), (PG8_LAS unsigned*)(lds + (bufoff) + ldsw + _i * 8192), 16, 0, 0); } while (0)
#define PG8_LDA(dst, b, h) do { _Pragma("unroll") for (int m = 0; m < 4; ++m) _Pragma("unroll") for (int k = 0; k < 2; ++k) dst[m][k] = *(const PG8_LAS bf16x8*)(lds + PG8_SA(b, h) + aoff + m * 2048 + k * 16); } while (0)
#define PG8_LDB(dst, b, h) do { _Pragma("unroll") for (int n = 0; n < 2; ++n) _Pragma("unroll") for (int k = 0; k < 2; ++k) dst[n][k] = *(const PG8_LAS bf16x8*)(lds + PG8_SB(b, h) + boff + n * 2048 + k * 16); } while (0)
#define PG8_F8(x) __builtin_shufflevector(__builtin_bit_cast(i32x4_t, (x)[0]), __builtin_bit_cast(i32x4_t, (x)[1]), 0, 1, 2, 3, 4, 5, 6, 7)
#define PG8_MMA(ai, bj, At, Bt) do { __builtin_amdgcn_s_setprio(1); asm volatile("s_nop 1" ::: ); _Pragma("unroll") for (int m = 0; m < 4; ++m) _Pragma("unroll") for (int n = 0; n < 2; ++n) \
        asm volatile("v_mfma_f32_16x16x128_f8f6f4 %0, %1, %2, %0" : "+v"(acc[ai][bj][m][n]) : "v"(PG8_F8(Bt[n])), "v"(PG8_F8(At[m]))); __builtin_amdgcn_s_setprio(0); } while (0)
#define PG8_ACC_SETTLE asm volatile("s_nop 15\n\ts_nop 15" ::: "memory")
#define PG8_WAIT_V(n) asm volatile("s_waitcnt vmcnt(" #n ")" ::: "memory")
#define PG8_WAIT_L(n) asm volatile("s_waitcnt lgkmcnt(" #n ")" ::: "memory")
#define PG8_BAR __builtin_amdgcn_s_barrier()
#define PG8_SCHED __builtin_amdgcn_sched_barrier(0)
    Unit cur, nxt; int ui = 0;
    if (!S.next(0, cur)) return;
    f32x4 acc[2][2][4][2];
#pragma unroll
    for (int a = 0; a < 2; ++a)
#pragma unroll
        for (int b = 0; b < 2; ++b)
#pragma unroll
            for (int m = 0; m < 4; ++m)
#pragma unroll
                for (int n = 0; n < 2; ++n) acc[a][b][m][n] = (f32x4){0.f, 0.f, 0.f, 0.f};
    bf16x8 At[4][2], B0[2][2], B1[2][2];
    const char* cA = (const char*)g.A + (size_t)cur.pm * tstep; const char* cB = (const char*)g.Bt + (size_t)cur.pn * tstep;
    PG8_STAGE(PG8_SB(0, 0), cB); PG8_STAGE(PG8_SB(0, 1), cB + hstep); PG8_STAGE(PG8_SA(0, 0), cA); PG8_STAGE(PG8_SA(0, 1), cA + hstep);
    if (wr == 1) PG8_BAR;
    PG8_WAIT_V(2); PG8_BAR;
    PG8_STAGE(PG8_SB(1, 0), cB + kstep); PG8_STAGE(PG8_SA(1, 0), cA + kstep); PG8_STAGE(PG8_SB(1, 1), cB + hstep + kstep);
    PG8_WAIT_V(6); PG8_BAR;
    for (;;) {
        const bool has_next = S.next(ui + 1, nxt);
        const char* nA = has_next ? (const char*)g.A + (size_t)nxt.pm * tstep : cA; const char* nB = has_next ? (const char*)g.Bt + (size_t)nxt.pn * tstep : cB;
        for (int t = 0; t < nt; t += 2) {
            const bool last = (t == nt - 2);
            const char* a1 = cA + (size_t)(t + 1) * kstep;
            const char* a2 = last ? nA : cA + (size_t)(t + 2) * kstep; const char* b2 = last ? nB : cB + (size_t)(t + 2) * kstep;
            const char* a3 = a2 + kstep; const char* b3 = b2 + kstep;
            PG8_LDB(B0, 0, 0); PG8_LDB(B1, 0, 1); PG8_SCHED; PG8_LDA(At, 0, 0); PG8_STAGE(PG8_SA(1, 1), a1 + hstep);
            PG8_WAIT_V(8); PG8_WAIT_L(0); PG8_BAR; PG8_MMA(0, 0, At, B0); PG8_MMA(0, 1, At, B1); PG8_BAR; PG8_SCHED;
            PG8_LDA(At, 0, 1); PG8_STAGE(PG8_SB(0, 0), b2); PG8_STAGE(PG8_SB(0, 1), b2 + hstep); PG8_STAGE(PG8_SA(0, 0), a2);
            PG8_WAIT_V(8); PG8_WAIT_L(0); PG8_BAR; PG8_MMA(1, 0, At, B0); PG8_MMA(1, 1, At, B1); PG8_BAR; PG8_SCHED;
            PG8_LDB(B0, 1, 0); PG8_LDB(B1, 1, 1); PG8_SCHED; PG8_LDA(At, 1, 0); PG8_STAGE(PG8_SA(0, 1), a2 + hstep);
            PG8_WAIT_V(8); PG8_WAIT_L(0); PG8_BAR; PG8_MMA(0, 0, At, B0); PG8_MMA(0, 1, At, B1); PG8_BAR; PG8_SCHED;
            PG8_LDA(At, 1, 1); PG8_STAGE(PG8_SB(1, 0), b3); PG8_STAGE(PG8_SB(1, 1), b3 + hstep); PG8_STAGE(PG8_SA(1, 0), a3);
            PG8_WAIT_V(8); PG8_WAIT_L(0); PG8_BAR; PG8_MMA(1, 0, At, B0); PG8_MMA(1, 1, At, B1); PG8_BAR; PG8_SCHED;
        }
        if (wr == 0) PG8_BAR;
        PG8_ACC_SETTLE;
        E(acc, cur, wr, wc, fr, fq);
        if (!has_next) break;
#pragma unroll
        for (int a = 0; a < 2; ++a)
#pragma unroll
            for (int b = 0; b < 2; ++b)
#pragma unroll
                for (int m = 0; m < 4; ++m)
#pragma unroll
                    for (int n = 0; n < 2; ++n) acc[a][b][m][n] = (f32x4){0.f, 0.f, 0.f, 0.f};
        cur = nxt; cA = nA; cB = nB; ++ui;
        if (wr == 1) PG8_BAR;
    }
    PG8_WAIT_V(0);
    PG8_BAR;
#undef PG8_SA
#undef PG8_SB
#undef PG8_STAGE
#undef PG8_LDA
#undef PG8_LDB
#undef PG8_MMA
#undef PG8_F8
#undef PG8_ACC_SETTLE
#undef PG8_WAIT_V
#undef PG8_WAIT_L
#undef PG8_BAR
#undef PG8_SCHED
}

#define EPI_ROWS(...) _Pragma("unroll") for (int ai = 0; ai < 2; ++ai) _Pragma("unroll") for (int m = 0; m < 4; ++m) { const int row = u.pm * BM + ai * HALF + wr * 64 + m * 16 + fr; __VA_ARGS__ }
__device__ __forceinline__ u32x4 pack8(const f32x4 a, const f32x4 b) { u32x4 w; w.x = cvt_pk_bf16(a[0], a[1]); w.y = cvt_pk_bf16(a[2], a[3]); w.z = cvt_pk_bf16(b[0], b[1]); w.w = cvt_pk_bf16(b[2], b[3]); return w; }

__device__ __forceinline__ u32x2 pack8_f8(const f32x4 a, const f32x4 b) { unsigned w0 = 0, w1 = 0;
    w0 = __builtin_amdgcn_cvt_pk_fp8_f32(a[0], a[1], w0, false); w0 = __builtin_amdgcn_cvt_pk_fp8_f32(a[2], a[3], w0, true);
    w1 = __builtin_amdgcn_cvt_pk_fp8_f32(b[0], b[1], w1, false); w1 = __builtin_amdgcn_cvt_pk_fp8_f32(b[2], b[3], w1, true); u32x2 r; r.x = w0; r.y = w1; return r; }
constexpr float W8_SCALE = 64.0f, W8_INV = 1.0f / 64.0f;
struct EpiIn {
    bf16_t* aqkv; bf16_t* qb; bf16_t* kb; bf16_t* vb; bf16_t* gate; const float* qg; const float* kg; const float* rope; float asc; bool f8attn;
    __device__ __forceinline__ void operator()(const f32x4 (&acc)[2][2][4][2], const Unit& u, int wr, int wc, int fr, int fq) const {
        const int pn = u.pn;
        if (pn >= 9 && pn < 14) {
            const bool isq = pn < 13; const int head = isq ? (pn - 9) * 4 + wc : wc; bf16_t* dst = isq ? qb : kb; const int pitch = isq ? 1024 : 256;
            const float* gvec = isq ? qg : kg; const float osc = isq ? C2 : 1.0f;
            f32x4 gv[2][2];
#pragma unroll
            for (int bj = 0; bj < 2; ++bj)
#pragma unroll
                for (int n = 0; n < 2; ++n) gv[bj][n] = *(const f32x4*)(gvec + 32 * bj + 16 * n + 4 * fq);
            EPI_ROWS(
                float ss = 0.f;
                _Pragma("unroll") for (int bj = 0; bj < 2; ++bj) _Pragma("unroll") for (int n = 0; n < 2; ++n) { const f32x4 x = acc[ai][bj][m][n] * asc; ss += (x[0] * x[0] + x[1] * x[1]) + (x[2] * x[2] + x[3] * x[3]); }
                ss = xsum<16>(ss); ss = xsum<32>(ss);
                const float sc = rsqrtf(ss * (1.0f / 64.0f) + EPS) * osc * asc;
                const int t = row & (SEQ - 1);
                _Pragma("unroll") for (int bj = 0; bj < 2; ++bj) {
                    const int pos = bj == 0 ? (t >> 6) : (t & 63);
                    const f32x4 cs = *(const f32x4*)(rope + pos * 16 + 4 * fq); const f32x4 sn = *(const f32x4*)(rope + 1024 + pos * 16 + 4 * fq);
                    const f32x4 y0 = acc[ai][bj][m][0] * sc * gv[bj][0]; const f32x4 y1 = acc[ai][bj][m][1] * sc * gv[bj][1];
                    const f32x4 o0 = y0 * cs - y1 * sn; const f32x4 o1 = y1 * cs + y0 * sn;
                    if (f8attn) { unsigned char* p8 = (unsigned char*)dst + (size_t)row * pitch + head * 64 + 32 * bj + 4 * fq;
                        unsigned a = 0, b = 0; a = __builtin_amdgcn_cvt_pk_fp8_f32(o0[0], o0[1], a, false); a = __builtin_amdgcn_cvt_pk_fp8_f32(o0[2], o0[3], a, true);
                        b = __builtin_amdgcn_cvt_pk_fp8_f32(o1[0], o1[1], b, false); b = __builtin_amdgcn_cvt_pk_fp8_f32(o1[2], o1[3], b, true);
                        *(unsigned*)p8 = a; *(unsigned*)(p8 + 16) = b;
                    } else {
                    bf16_t* p = dst + (size_t)row * pitch + head * 64 + 32 * bj + 4 * fq;
                    u32x2 w0; w0.x = cvt_pk_bf16(o0[0], o0[1]); w0.y = cvt_pk_bf16(o0[2], o0[3]);
                    u32x2 w1; w1.x = cvt_pk_bf16(o1[0], o1[1]); w1.y = cvt_pk_bf16(o1[2], o1[3]);
                    *(u32x2*)p = w0; *(u32x2*)(p + 16) = w1; }
                }
            )
        } else if (pn == 14 && f8attn) {
            unsigned char* vt = (unsigned char*)vb;
            EPI_ROWS(
                const int b = row >> 12; const int t = row & (SEQ - 1); const int kk = t & 63;
                const int pos = 32 * ((kk >> 2) & 1) + (kk & 3) + 4 * ((kk >> 3) & 3) + 16 * (kk >> 5);
                _Pragma("unroll") for (int bj = 0; bj < 2; ++bj) {
                    const int kvh = bj * 2 + (wc >> 1); const int d0 = (wc & 1) * 32 + 8 * fq;
                    unsigned char* p = vt + ((size_t)((b * 4 + kvh) * 64 + d0) << 12) + (t & ~63) + pos;
                    const f32x4 v0 = acc[ai][bj][m][0] * asc; const f32x4 v1 = acc[ai][bj][m][1] * asc;
                    unsigned a = 0, c = 0; a = __builtin_amdgcn_cvt_pk_fp8_f32(v0[0], v0[1], a, false); a = __builtin_amdgcn_cvt_pk_fp8_f32(v0[2], v0[3], a, true);
                    c = __builtin_amdgcn_cvt_pk_fp8_f32(v1[0], v1[1], c, false); c = __builtin_amdgcn_cvt_pk_fp8_f32(v1[2], v1[3], c, true);
                    p[0 << 12] = (unsigned char)a; p[1 << 12] = (unsigned char)(a >> 8); p[2 << 12] = (unsigned char)(a >> 16); p[3 << 12] = (unsigned char)(a >> 24);
                    p[4 << 12] = (unsigned char)c; p[5 << 12] = (unsigned char)(c >> 8); p[6 << 12] = (unsigned char)(c >> 16); p[7 << 12] = (unsigned char)(c >> 24);
                }
            )
        } else {
            bf16_t* dst; int pitch, colt, dsh = 0; float sc = asc; bool sig = false, fold = false;
            if (pn < 9) { dst = aqkv + (size_t)pn * T * 256; pitch = 256; colt = 0; fold = true; dsh = 2 * (pn / 3); if (pn % 3 == 0) sc = C2 * asc; }
            else if (pn == 14) { dst = vb; pitch = 256; colt = 0; }
            else { dst = gate; pitch = 2048; colt = (pn - 15) * 256; sig = true; }
            const int col0 = colt + wc * 32 + 8 * fq;
            EPI_ROWS(
                int drow = row;
                if (fold) { const int t = row & (SEQ - 1); drow = (row & ~(SEQ - 1)) | ((t & ((1 << dsh) - 1)) << (12 - dsh)) | (t >> dsh); }
                bf16_t* rowp = dst + (size_t)drow * pitch + col0;
                _Pragma("unroll") for (int bj = 0; bj < 2; ++bj) {
                    f32x4 v0 = acc[ai][bj][m][0], v1 = acc[ai][bj][m][1];
                    if (sig) { _Pragma("unroll") for (int j = 0; j < 4; ++j) { v0[j] = sigmoid_f(v0[j] * asc); v1[j] = sigmoid_f(v1[j] * asc); } }
                    else { v0 = v0 * sc; v1 = v1 * sc; }
                    *(u32x4*)(rowp + bj * HALF) = pack8(v0, v1);
                }
            )
        }
    }
};
struct EpiMergeA {
    const bf16_t* gate; bf16_t* merged;
    __device__ __forceinline__ void operator()(const f32x4 (&acc)[2][2][4][2], const Unit& u, int wr, int wc, int fr, int fq) const {
        const int col0 = u.pn * BM + wc * 32 + 8 * fq;
        EPI_ROWS(
            _Pragma("unroll") for (int bj = 0; bj < 2; ++bj) {
                const u32x4 gw = *(const u32x4*)(gate + (size_t)row * 2048 + col0 + bj * HALF);
                f32x4 v0 = acc[ai][bj][m][0], v1 = acc[ai][bj][m][1];
                v0 = v0 * W8_INV; v1 = v1 * W8_INV;
                v0[0] *= bf_lo(gw.x); v0[1] *= bf_hi(gw.x); v0[2] *= bf_lo(gw.y); v0[3] *= bf_hi(gw.y);
                v1[0] *= bf_lo(gw.z); v1[1] *= bf_hi(gw.z); v1[2] *= bf_lo(gw.w); v1[3] *= bf_hi(gw.w);
                *(u32x4*)(merged + (size_t)row * 1024 + col0 + bj * HALF) = pack8(v0, v1);
            }
        )
    }
};
template <bool F8> struct EpiMergeB {
    const bf16_t* gate; const bf16_t* merged; unsigned char* m8;
    __device__ __forceinline__ void operator()(const f32x4 (&acc)[2][2][4][2], const Unit& u, int wr, int wc, int fr, int fq) const {
        const int col0 = u.pn * BM + wc * 32 + 8 * fq;
        EPI_ROWS(
            _Pragma("unroll") for (int bj = 0; bj < 2; ++bj) {
                const u32x4 gw = *(const u32x4*)(gate + (size_t)row * 2048 + 1024 + col0 + bj * HALF);
                const bf16_t* mp = merged + (size_t)row * 1024 + col0 + bj * HALF;
                const u32x4 mw = *(const u32x4*)mp;
                f32x4 v0 = acc[ai][bj][m][0] * (F8 ? W8_INV : 1.0f), v1 = acc[ai][bj][m][1] * (F8 ? W8_INV : 1.0f);
                v0[0] = v0[0] * bf_lo(gw.x) + bf_lo(mw.x); v0[1] = v0[1] * bf_hi(gw.x) + bf_hi(mw.x); v0[2] = v0[2] * bf_lo(gw.y) + bf_lo(mw.y); v0[3] = v0[3] * bf_hi(gw.y) + bf_hi(mw.y);
                v1[0] = v1[0] * bf_lo(gw.z) + bf_lo(mw.z); v1[1] = v1[1] * bf_hi(gw.z) + bf_hi(mw.z); v1[2] = v1[2] * bf_lo(gw.w) + bf_lo(mw.w); v1[3] = v1[3] * bf_hi(gw.w) + bf_hi(mw.w);
                *(u32x2*)(m8 + (size_t)row * 1024 + col0 + bj * HALF) = pack8_f8(v0, v1);
            }
        )
    }
};
struct EpiOut {
    const float* xin; float* xout; const float* g1;
    __device__ __forceinline__ void operator()(const f32x4 (&acc)[2][2][4][2], const Unit& u, int wr, int wc, int fr, int fq) const {
        const int col0 = u.pn * BM + wc * 32 + 8 * fq; const int b = (u.pm * BM) >> 12;
        f32x4 gv[2][2];
#pragma unroll
        for (int bj = 0; bj < 2; ++bj)
#pragma unroll
            for (int n = 0; n < 2; ++n) gv[bj][n] = *(const f32x4*)(g1 + (size_t)b * 6144 + col0 + bj * HALF + 4 * n);
        EPI_ROWS(
            _Pragma("unroll") for (int bj = 0; bj < 2; ++bj) {
                const size_t off = (size_t)row * 1024 + col0 + bj * HALF;
                const f32x4 x0 = *(const f32x4*)(xin + off), x1 = *(const f32x4*)(xin + off + 4);
                *(f32x4*)(xout + off) = x0 + gv[bj][0] * (acc[ai][bj][m][0] * W8_INV); *(f32x4*)(xout + off + 4) = x1 + gv[bj][1] * (acc[ai][bj][m][1] * W8_INV);
            }
        )
    }
};
struct EpiGU {
    const float* bgu; bf16_t* act;
    __device__ __forceinline__ void operator()(const f32x4 (&acc)[2][2][4][2], const Unit& u, int wr, int wc, int fr, int fq) const {
        const int e = u.pn >> 3, pl = u.pn & 7; const int c0 = pl * 128 + wc * 32 + 8 * fq;
        const float* bp = bgu + (size_t)e * 2048 + c0;
        const f32x4 bg0 = *(const f32x4*)bp, bg1 = *(const f32x4*)(bp + 4), bl0 = *(const f32x4*)(bp + 1024), bl1 = *(const f32x4*)(bp + 1028);
        EPI_ROWS(
            f32x4 o[2];
            _Pragma("unroll") for (int n = 0; n < 2; ++n) {
                const f32x4 gl = acc[ai][0][m][n] + (n == 0 ? bg0 : bg1); const f32x4 ln = acc[ai][1][m][n] + (n == 0 ? bl0 : bl1);
                _Pragma("unroll") for (int j = 0; j < 4; ++j) { const float xg = fminf(gl[j], 7.0f); const float xl = fminf(fmaxf(ln[j], -7.0f), 7.0f); o[n][j] = xg * sigmoid_f(1.702f * xg) * (xl + 1.0f); }
            }
            *(u32x4*)(act + (size_t)row * 1024 + c0) = pack8(o[0], o[1]);
        )
    }
};
struct EpiGU8 {
    const float* bgu; unsigned char* act;
    __device__ __forceinline__ void operator()(const f32x4 (&acc)[2][2][4][2], const Unit& u, int wr, int wc, int fr, int fq) const {
        const int e = u.pn >> 3, pl = u.pn & 7; const int c0 = pl * 128 + wc * 32 + 8 * fq;
        const float* bp = bgu + (size_t)e * 2048 + c0;
        const f32x4 bg0 = *(const f32x4*)bp, bg1 = *(const f32x4*)(bp + 4), bl0 = *(const f32x4*)(bp + 1024), bl1 = *(const f32x4*)(bp + 1028);
        EPI_ROWS(
            f32x4 o[2];
            _Pragma("unroll") for (int n = 0; n < 2; ++n) {
                const f32x4 gl = acc[ai][0][m][n] * W8_INV + (n == 0 ? bg0 : bg1); const f32x4 ln = acc[ai][1][m][n] * W8_INV + (n == 0 ? bl0 : bl1);
                _Pragma("unroll") for (int j = 0; j < 4; ++j) { const float xg = fminf(gl[j], 7.0f); const float xl = fminf(fmaxf(ln[j], -7.0f), 7.0f); o[n][j] = xg * sigmoid_f(1.702f * xg) * (xl + 1.0f); }
            }
            *(u32x2*)(act + (size_t)row * 1024 + c0) = pack8_f8(o[0], o[1]);
        )
    }
};
struct EpiDN8 {
    const float* bdn; const float* roww; bf16_t* y;
    __device__ __forceinline__ void operator()(const f32x4 (&acc)[2][2][4][2], const Unit& u, int wr, int wc, int fr, int fq) const {
        const int e = u.pn >> 2, pl = u.pn & 3; const int col0 = pl * BM + wc * 32 + 8 * fq;
        f32x4 bv[2][2];
#pragma unroll
        for (int bj = 0; bj < 2; ++bj)
#pragma unroll
            for (int n = 0; n < 2; ++n) bv[bj][n] = *(const f32x4*)(bdn + (size_t)e * 1024 + col0 + bj * HALF + 4 * n);
        EPI_ROWS(
            const float w = roww[row];
            _Pragma("unroll") for (int bj = 0; bj < 2; ++bj)
                *(u32x4*)(y + (size_t)row * 1024 + col0 + bj * HALF) = pack8((acc[ai][bj][m][0] * W8_INV + bv[bj][0]) * w, (acc[ai][bj][m][1] * W8_INV + bv[bj][1]) * w);
        )
    }
};
struct EpiDN {
    const float* bdn; const float* roww; bf16_t* y;
    __device__ __forceinline__ void operator()(const f32x4 (&acc)[2][2][4][2], const Unit& u, int wr, int wc, int fr, int fq) const {
        const int e = u.pn >> 2, pl = u.pn & 3; const int col0 = pl * BM + wc * 32 + 8 * fq;
        f32x4 bv[2][2];
#pragma unroll
        for (int bj = 0; bj < 2; ++bj)
#pragma unroll
            for (int n = 0; n < 2; ++n) bv[bj][n] = *(const f32x4*)(bdn + (size_t)e * 1024 + col0 + bj * HALF + 4 * n);
        EPI_ROWS(
            const float w = roww[row];
            _Pragma("unroll") for (int bj = 0; bj < 2; ++bj)
                *(u32x4*)(y + (size_t)row * 1024 + col0 + bj * HALF) = pack8((acc[ai][bj][m][0] + bv[bj][0]) * w, (acc[ai][bj][m][1] + bv[bj][1]) * w);
        )
    }
};
}

namespace attn_body {
using bf16 = __hip_bfloat16;
using bf16x8 = __attribute__((ext_vector_type(8))) short;
using s16x4 = __attribute__((ext_vector_type(4))) short;
using f32x16 = __attribute__((ext_vector_type(16))) float;
using u32x4 = __attribute__((ext_vector_type(4))) unsigned;
constexpr int D = 64, NW = 8, QBLK = 32, QB = QBLK * NW, KVBLK = 64;
__device__ __forceinline__ int crow(int r, int hi) { return (r & 3) + 8 * (r >> 2) + 4 * hi; }
#define SBAR() __builtin_amdgcn_sched_barrier(0)
constexpr int NSLOT = 3, SLOTB = 8192;
constexpr int LDS_K = 0, LDS_V = NSLOT * SLOTB, LDS_WS = 2 * NSLOT * SLOTB, LDS_OST = LDS_WS + NW * 64 * 4, LDS_LUT = LDS_OST + NW * 4096, LUT_N = 768, LDS_BYTES = LDS_LUT + LUT_N * 4;
constexpr bool OB_F8 = true;
constexpr float MFLOOR = -1024.0f;
__device__ __forceinline__ void glds16(const void* gsrc, unsigned lds_dst) { unsigned keep;
  asm volatile("s_mov_b32 %0, m0\n\ts_mov_b32 m0, %2\n\ts_nop 0\n\tglobal_load_lds_dwordx4 %1, off\n\ts_mov_b32 m0, %0" : "=&s"(keep) : "v"(gsrc), "s"(lds_dst) : "memory"); }
__device__ __forceinline__ float max3f(float a, float b, float c) { float r; asm("v_max3_f32 %0, %1, %2, %3" : "=v"(r) : "v"(a), "v"(b), "v"(c)); return r; }
__device__ __forceinline__ float max2f(float a, float b) { float r; asm("v_max_f32_e32 %0, %1, %2" : "=v"(r) : "v"(a), "v"(b)); return r; }
__device__ __forceinline__ float fadd_s(float a, float b) { float r; asm("v_add_f32_e32 %0, %1, %2" : "=v"(r) : "v"(a), "v"(b)); return r; }
__device__ __forceinline__ float fsub_s(float a, float b) { float r; asm("v_sub_f32_e32 %0, %1, %2" : "=v"(r) : "v"(a), "v"(b)); return r; }
typedef float f32x2_t __attribute__((ext_vector_type(2))); typedef __bf16 bf16x2_t __attribute__((ext_vector_type(2)));
__device__ __forceinline__ unsigned cvtpk_s(float lo, float hi) { f32x2_t v = {lo, hi}; bf16x2_t b = __builtin_convertvector(v, bf16x2_t); return __builtin_bit_cast(unsigned, b); }
#define WAIT_BAR(N) asm volatile("s_waitcnt vmcnt(" #N ") lgkmcnt(0)\n\ts_barrier" ::: "memory")

__device__ __forceinline__ void qkt(f32x16& p0, f32x16& p1, const char* Kslot, const bf16x8* qr, const f32x16& negm, int r32, int hi) {
  const char* kb = Kslot + hi * 1024 + r32 * 16;
  #pragma unroll
  for (int d0 = 0; d0 < 4; ++d0) {
    const bf16x8 b0 = *reinterpret_cast<const bf16x8*>(kb + d0 * 2048);
    const bf16x8 b1 = *reinterpret_cast<const bf16x8*>(kb + d0 * 2048 + 512);
    if (d0 == 0) { p0 = __builtin_amdgcn_mfma_f32_32x32x16_bf16(b0, qr[0], negm, 0, 0, 0); p1 = __builtin_amdgcn_mfma_f32_32x32x16_bf16(b1, qr[0], negm, 0, 0, 0); }
    else { p0 = __builtin_amdgcn_mfma_f32_32x32x16_bf16(b0, qr[d0], p0, 0, 0, 0); p1 = __builtin_amdgcn_mfma_f32_32x32x16_bf16(b1, qr[d0], p1, 0, 0, 0); } }
}
typedef __attribute__((address_space(3))) const char* lds_cptr;
typedef short v4i16_t __attribute__((ext_vector_type(4)));
__device__ __forceinline__ void kload8(bf16x8* kf, lds_cptr kp) {
  kf[0] = *(const __attribute__((address_space(3))) bf16x8*)(kp);        kf[1] = *(const __attribute__((address_space(3))) bf16x8*)(kp + 512);
  kf[2] = *(const __attribute__((address_space(3))) bf16x8*)(kp + 2048); kf[3] = *(const __attribute__((address_space(3))) bf16x8*)(kp + 2560);
  kf[4] = *(const __attribute__((address_space(3))) bf16x8*)(kp + 4096); kf[5] = *(const __attribute__((address_space(3))) bf16x8*)(kp + 4608);
  kf[6] = *(const __attribute__((address_space(3))) bf16x8*)(kp + 6144); kf[7] = *(const __attribute__((address_space(3))) bf16x8*)(kp + 6656);
}
__device__ __forceinline__ void kload2(bf16x8* kf, lds_cptr kp, int j) { kf[2 * j] = *(const __attribute__((address_space(3))) bf16x8*)(kp + j * 2048); kf[2 * j + 1] = *(const __attribute__((address_space(3))) bf16x8*)(kp + j * 2048 + 512); }
__device__ __forceinline__ s16x4 vtr(lds_cptr p) { return __builtin_bit_cast(s16x4, __builtin_amdgcn_ds_read_tr16_b64_v4i16((__attribute__((address_space(3))) v4i16_t*)p)); }
__device__ __forceinline__ float rowmax(const f32x16& p0, const f32x16& p1) {
  float a = max3f(p0[0], p0[1], p1[0]), b = max3f(p0[2], p0[3], p1[1]); a = max3f(a, p1[2], p1[3]);
  #pragma unroll
  for (int r = 4; r < 16; r += 4) { a = max3f(a, p0[r], p0[r + 1]); b = max3f(b, p0[r + 2], p0[r + 3]); a = max3f(a, p1[r], p1[r + 1]); b = max3f(b, p1[r + 2], p1[r + 3]); }
  const float m = max2f(a, b);
  auto rr = __builtin_amdgcn_permlane32_swap(__float_as_uint(m), __float_as_uint(m), false, false);
  return max2f(__uint_as_float(rr[0]), __uint_as_float(rr[1]));
}
__device__ __forceinline__ void pv(f32x16* o, int vb, bf16x8 pa0, bf16x8 pa1, bf16x8 pa2, bf16x8 pa3) {
  #pragma unroll
  for (int d0 = 0; d0 < 2; ++d0) { s16x4 lo[4], hi[4];
    #pragma unroll
    for (int ks = 0; ks < 4; ++ks) {
      asm volatile("ds_read_b64_tr_b16 %0,%1 offset:%c2" : "=&v"(lo[ks]) : "v"(vb), "i"(d0 * 4096 + ks * 1024) : "memory");
      asm volatile("ds_read_b64_tr_b16 %0,%1 offset:%c2" : "=&v"(hi[ks]) : "v"(vb), "i"(d0 * 4096 + ks * 1024 + 512) : "memory"); }
    asm volatile("s_waitcnt lgkmcnt(0)" ::: "memory"); SBAR();
    #define PK(k) (bf16x8){lo[k][0], lo[k][1], lo[k][2], lo[k][3], hi[k][0], hi[k][1], hi[k][2], hi[k][3]}
    o[d0] = __builtin_amdgcn_mfma_f32_32x32x16_bf16(pa0, PK(0), o[d0], 0, 0, 0);
    o[d0] = __builtin_amdgcn_mfma_f32_32x32x16_bf16(pa1, PK(1), o[d0], 0, 0, 0);
    o[d0] = __builtin_amdgcn_mfma_f32_32x32x16_bf16(pa2, PK(2), o[d0], 0, 0, 0);
    o[d0] = __builtin_amdgcn_mfma_f32_32x32x16_bf16(pa3, PK(3), o[d0], 0, 0, 0);
    #undef PK
  }
}
struct Job { const bf16* Q; const bf16* K; const bf16* V; bf16* O; float* lse; const float* lutg; int NT, i0, kq0, dsh, cls; };
template <int MODE, int THRL, bool NOMAX = false> __device__ __forceinline__ void attn_unit(const Job& J, char* shm, const int wid_in) {
  int wid = wid_in; asm volatile("" : "+s"(wid));
  constexpr int QP = MODE == 0 ? 1024 : 256, KP = 256;
  const int lane = lane_id_asm(), tid = wid * 64 + lane, r32 = lane & 31, hi = lane >> 5;
  const bf16* Qw = J.Q + (long)(wid * QBLK) * QP;
  const bf16* Kh = J.K; const bf16* Vh = J.V;
  const unsigned lds0 = (unsigned)(uintptr_t)shm;
  float* wsf = (float*)(shm + LDS_WS) + wid * 64;
  const bf16* ksrc = Kh + (long)lane * KP + wid * 8;
  const bf16* vsrc = Vh + (long)(16 * (wid & 3) + (lane >> 2)) * KP + (wid >> 2) * 32 + (lane & 3) * 8;
  const unsigned kdst = lds0 + LDS_K + wid * 1024, vdst = lds0 + LDS_V + wid * 1024;
  #define DMA_K(t, slot) glds16(ksrc + (long)(t) * KVBLK * KP, (unsigned)__builtin_amdgcn_readfirstlane(kdst + (slot)))
  #define DMA_V(t, slot) glds16(vsrc + (long)(t) * KVBLK * KP, (unsigned)__builtin_amdgcn_readfirstlane(vdst + (slot)))
  const int vb0 = (int)(lds0 + LDS_V) + ((lane >> 4) & 1) * 32 + (lane & 3) * 8 + (4 * hi + ((lane & 15) >> 2)) * 64;
  const char* Kbase = shm + LDS_K; bf16x8 kf[8];
  const lds_cptr shm3 = (lds_cptr)shm; const lds_cptr kp0 = shm3 + LDS_K + hi * 1024 + r32 * 16; const lds_cptr vp0 = shm3 + LDS_V + ((lane >> 4) & 1) * 32 + (lane & 3) * 8 + (4 * hi + ((lane & 15) >> 2)) * 64;
  const int NT = J.NT;
  if (MODE == 1) {
    __attribute__((address_space(3))) float* lut = (__attribute__((address_space(3))) float*)(shm3 + LDS_LUT);
    lut[tid] = J.lutg[tid]; if (tid < LUT_N - 512) lut[512 + tid] = J.lutg[512 + tid];
  }
  DMA_K(0, 0); DMA_V(0, 0); DMA_K(1, SLOTB);
  bf16x8 qr[4];
  #pragma unroll
  for (int d0 = 0; d0 < 4; ++d0) qr[d0] = *reinterpret_cast<const bf16x8*>(&Qw[(long)r32 * QP + d0 * 16 + hi * 8]);
  float mhat = 0.f, l_reg = 0.f; f32x16 o[2]; o[0] = f32x16{}; o[1] = f32x16{}; f32x16 negm = f32x16{}; if (!NOMAX) asm volatile("" : "+v"(negm));
  const int qrel = wid * QBLK + r32;
  const __attribute__((address_space(3))) float* lutq = (const __attribute__((address_space(3))) float*)(shm3 + LDS_LUT) + (J.kq0 - qrel + 383 + 4 * hi);
  #define CMASK(P0, P1, t) do { if (MODE == 1) { const __attribute__((address_space(3))) float* lp_ = lutq + 64 * (t); \
      _Pragma("unroll") for (int r = 0; r < 16; ++r) { const int ko_ = (r & 3) + 8 * (r >> 2); P0[r] += lp_[ko_]; P1[r] += lp_[ko_ + 32]; } } } while (0)
  bool resc = false;
  #define START(P0, P1) do { resc = false; if (!NOMAX) { const float rm = rowmax(P0, P1); \
    const float dl = MODE == 1 ? max2f(rm, MFLOOR) : rm; mhat = fadd_s(mhat, dl); \
      _Pragma("unroll") for (int r = 0; r < 16; ++r) { P0[r] = fsub_s(P0[r], dl); P1[r] = fsub_s(P1[r], dl); } \
      _Pragma("unroll") for (int r = 0; r < 16; ++r) negm[r] = -mhat; asm volatile("" : "+v"(negm)); } \
    _Pragma("unroll") for (int r = 0; r < 16; ++r) P0[r] = __builtin_amdgcn_exp2f(P0[r]); } while (0)
  #define RESC() do { if (resc) { asm volatile("s_waitcnt lgkmcnt(0)" ::: "memory"); \
      _Pragma("unroll") for (int d_ = 0; d_ < 2; ++d_) _Pragma("unroll") for (int r = 0; r < 16; ++r) o[d_][r] *= wsf[crow(r, hi)]; } } while (0)
  f32x16 pA0, pA1, pB0, pB1;
  int sl_prev = 0, sl_cur = 0, sl_next = SLOTB;
  #define ROT() do { sl_prev = sl_cur; sl_cur = sl_next; sl_next = (sl_next == (NSLOT - 1) * SLOTB) ? 0 : sl_next + SLOTB; } while (0)
  DMA_K(2, 2 * SLOTB);
  WAIT_BAR(3);
  qkt(pA0, pA1, Kbase, qr, negm, r32, hi); asm volatile("s_nop 15\n\ts_nop 7" : "+v"(pA0), "+v"(pA1)); CMASK(pA0, pA1, 0);
  START(pA0, pA1);
  _Pragma("unroll") for (int r = 0; r < 16; ++r) pA1[r] = __builtin_amdgcn_exp2f(pA1[r]);
  WAIT_BAR(0);
  DMA_K(3, 0); DMA_V(1, SLOTB);
  ROT();
  kload8(kf, kp0 + sl_cur);
  WAIT_BAR(2);
  s16x4 vlo[8], vhi[8]; u32x4 pw0, pw1, pw2, pw3;
  #define PKW(P, B) cvtpk_s(P[B], P[B + 1])
  #define PAF(k) __builtin_bit_cast(bf16x8, pw##k)
  #define VFR(i) (bf16x8){vlo[i][0], vlo[i][1], vlo[i][2], vlo[i][3], vhi[i][0], vhi[i][1], vhi[i][2], vhi[i][3]}
  #define PIN(x) asm volatile("" : "+v"(x))
  #define MX3(a, b, c) __builtin_fmaxf(__builtin_fmaxf((a), (b)), (c))
  #define GAPA(MF, A0, A1, A2, A3, W0, W1, PW) do { MF; sacc += A0; sacc += A1; sacc += A2; sacc += A3; PIN(sacc); W0; W1; PIN(PW); SBAR(); } while (0)
  #define EX(v) __builtin_amdgcn_exp2f(v)
  #define GAPB(MF, X, B) do { MF; X[B] = EX(X[B]); X[B + 1] = EX(X[B + 1]); X[B + 2] = EX(X[B + 2]); X[B + 3] = EX(X[B + 3]); PIN(X); SBAR(); } while (0)
  #define VRD(i) do { vlo[i] = vtr(vp_ + (((i) >> 2) * 4096 + ((i) & 3) * 1024)); vhi[i] = vtr(vp_ + (((i) >> 2) * 4096 + ((i) & 3) * 1024 + 512)); } while (0)
  #define KRD(G, j) do { if (G) { kload2(kf, kp0 + sl_next, j); SBAR(); } } while (0)
  #define STEP(C0, C1, P0, P1, t, GK, GV, GL) do { SBAR(); \
    const lds_cptr vp_ = vp0 + sl_prev; \
    VRD(0); SBAR(); float sacc = (P0[0] + P0[1]); \
    GAPA(C0 = __builtin_amdgcn_mfma_f32_32x32x16_bf16(kf[0], qr[0], negm, 0, 0, 0), P0[2], P0[3], P0[4], P0[5],     pw0[0] = PKW(P0, 0), pw0[1] = PKW(P0, 2), pw0); \
    VRD(4); SBAR(); GAPA(C1 = __builtin_amdgcn_mfma_f32_32x32x16_bf16(kf[1], qr[0], negm, 0, 0, 0), P0[6], P0[7], P0[8], P0[9],     pw0[2] = PKW(P0, 4), pw0[3] = PKW(P0, 6), pw0); \
    VRD(1); SBAR(); GAPA(C0 = __builtin_amdgcn_mfma_f32_32x32x16_bf16(kf[2], qr[1], C0, 0, 0, 0),   P0[10], P0[11], P0[12], P0[13], pw1[0] = PKW(P0, 8), pw1[1] = PKW(P0, 10), pw1); \
    VRD(5); SBAR(); GAPA(C1 = __builtin_amdgcn_mfma_f32_32x32x16_bf16(kf[3], qr[1], C1, 0, 0, 0),   P0[14], P0[15], P1[0], P1[1],   pw1[2] = PKW(P0, 12), pw1[3] = PKW(P0, 14), pw1); \
    VRD(2); SBAR(); GAPA(C0 = __builtin_amdgcn_mfma_f32_32x32x16_bf16(kf[4], qr[2], C0, 0, 0, 0),   P1[2], P1[3], P1[4], P1[5],     pw2[0] = PKW(P1, 0), pw2[1] = PKW(P1, 2), pw2); \
    VRD(6); SBAR(); GAPA(C1 = __builtin_amdgcn_mfma_f32_32x32x16_bf16(kf[5], qr[2], C1, 0, 0, 0),   P1[6], P1[7], P1[8], P1[9],     pw2[2] = PKW(P1, 4), pw2[3] = PKW(P1, 6), pw2); \
    VRD(3); SBAR(); GAPA(C0 = __builtin_amdgcn_mfma_f32_32x32x16_bf16(kf[6], qr[3], C0, 0, 0, 0),   P1[10], P1[11], P1[12], P1[13], pw3[0] = PKW(P1, 8), pw3[1] = PKW(P1, 10), pw3); \
    VRD(7); SBAR(); GAPA(C1 = __builtin_amdgcn_mfma_f32_32x32x16_bf16(kf[7], qr[3], C1, 0, 0, 0),   P1[14], P1[15], 0.f, 0.f,       pw3[2] = PKW(P1, 12), pw3[3] = PKW(P1, 14), pw3); \
    l_reg += sacc; \
    if (GK) { DMA_K((t) + 3, sl_cur); } if (GV) { DMA_V((t) + 1, sl_next); } \
    CMASK(C0, C1, t); \
    if (!NOMAX) { float a = MX3(C0[0], C0[1], C1[0]), b = MX3(C0[2], C0[3], C1[1]); a = MX3(a, C1[2], C1[3]); \
      _Pragma("unroll") for (int r = 4; r < 16; r += 4) { a = MX3(a, C0[r], C0[r + 1]); b = MX3(b, C0[r + 2], C0[r + 3]); a = MX3(a, C1[r], C1[r + 1]); b = MX3(b, C1[r + 2], C1[r + 3]); } \
      float rm = __builtin_fmaxf(a, b); { auto rr = __builtin_amdgcn_permlane32_swap(__float_as_uint(rm), __float_as_uint(rm), false, false); rm = __builtin_fmaxf(__uint_as_float(rr[0]), __uint_as_float(rr[1])); } \
      resc = false; \
      if (__builtin_expect(__any(rm > (float)THRL), 0)) { const float dl = __builtin_fmaxf(rm, 0.f); mhat += dl; \
        _Pragma("unroll") for (int r = 0; r < 16; ++r) { C0[r] -= dl; C1[r] -= dl; } \
        _Pragma("unroll") for (int r = 0; r < 16; ++r) negm[r] = -mhat; asm volatile("" : "+v"(negm)); \
        const float f = __builtin_amdgcn_exp2f(-dl); l_reg *= f; if (hi == 0) wsf[r32] = f; resc = true; } } \
    SBAR(); \
    GAPB(o[0] = __builtin_amdgcn_mfma_f32_32x32x16_bf16(PAF(0), VFR(0), o[0], 0, 0, 0), C0, 0); \
    GAPB(o[1] = __builtin_amdgcn_mfma_f32_32x32x16_bf16(PAF(0), VFR(4), o[1], 0, 0, 0), C0, 4); \
    KRD(GL, 0); GAPB(o[0] = __builtin_amdgcn_mfma_f32_32x32x16_bf16(PAF(1), VFR(1), o[0], 0, 0, 0), C0, 8); \
    KRD(GL, 1); GAPB(o[1] = __builtin_amdgcn_mfma_f32_32x32x16_bf16(PAF(1), VFR(5), o[1], 0, 0, 0), C0, 12); \
    KRD(GL, 2); GAPB(o[0] = __builtin_amdgcn_mfma_f32_32x32x16_bf16(PAF(2), VFR(2), o[0], 0, 0, 0), C1, 0); \
    KRD(GL, 3); GAPB(o[1] = __builtin_amdgcn_mfma_f32_32x32x16_bf16(PAF(2), VFR(6), o[1], 0, 0, 0), C1, 4); \
    GAPB(o[0] = __builtin_amdgcn_mfma_f32_32x32x16_bf16(PAF(3), VFR(3), o[0], 0, 0, 0), C1, 8); \
    GAPB(o[1] = __builtin_amdgcn_mfma_f32_32x32x16_bf16(PAF(3), VFR(7), o[1], 0, 0, 0), C1, 12); \
    } while (0)
  int t = 1;
  for (; t + 5 < NT; t += 2) {
    STEP(pB0, pB1, pA0, pA1, t, true, true, true);     WAIT_BAR(2); RESC(); ROT();
    STEP(pA0, pA1, pB0, pB1, t + 1, true, true, true); WAIT_BAR(2); RESC(); ROT();
  }
  #define ENDW(tt) do { if ((tt) + 3 < NT) { WAIT_BAR(2); } else if ((tt) + 2 < NT) { WAIT_BAR(1); } else { WAIT_BAR(0); } } while (0)
  for (; t + 1 < NT; t += 2) {
    STEP(pB0, pB1, pA0, pA1, t, (t + 3 < NT), (t + 1 < NT), (t + 1 < NT));       ENDW(t);     RESC(); ROT();
    STEP(pA0, pA1, pB0, pB1, t + 1, (t + 4 < NT), (t + 2 < NT), (t + 2 < NT));   ENDW(t + 1); RESC(); ROT();
  }
  STEP(pB0, pB1, pA0, pA1, NT - 1, false, false, false); RESC();
  { float sacc = pB0[0] + pB0[1]; _Pragma("unroll") for (int r = 2; r < 16; ++r) sacc += pB0[r]; _Pragma("unroll") for (int r = 0; r < 16; ++r) sacc += pB1[r]; l_reg += sacc;
    pw0 = (u32x4){PKW(pB0, 0), PKW(pB0, 2), PKW(pB0, 4), PKW(pB0, 6)}; pw1 = (u32x4){PKW(pB0, 8), PKW(pB0, 10), PKW(pB0, 12), PKW(pB0, 14)}; pw2 = (u32x4){PKW(pB1, 0), PKW(pB1, 2), PKW(pB1, 4), PKW(pB1, 6)}; pw3 = (u32x4){PKW(pB1, 8), PKW(pB1, 10), PKW(pB1, 12), PKW(pB1, 14)};
    SBAR(); pv(o, vb0 + sl_cur, PAF(0), PAF(1), PAF(2), PAF(3)); }
  #undef PKW
  #undef PAF
  #undef VFR
  #undef PIN
  #undef MX3
  #undef GAPA
  #undef GAPB
  #undef EX
  #undef VRD
  #undef KRD
  #undef STEP
  #undef ENDW
  { auto rr = __builtin_amdgcn_permlane32_swap(__float_as_uint(l_reg), __float_as_uint(l_reg), false, false); l_reg = __uint_as_float(rr[0]) + __uint_as_float(rr[1]); }
  if (hi == 0) wsf[32 + r32] = l_reg; asm volatile("s_waitcnt lgkmcnt(0)" ::: "memory");
  float rli[16];
  #pragma unroll
  for (int r = 0; r < 16; ++r) rli[r] = __builtin_amdgcn_rcpf(wsf[32 + crow(r, hi)]);
  if (MODE == 0 && OB_F8) {
    unsigned char* stg8 = (unsigned char*)(shm + LDS_OST) + wid * 4096;
    #pragma unroll
    for (int r = 0; r < 16; ++r) { const int orow = crow(r, hi);
      #pragma unroll
      for (int d0 = 0; d0 < 2; ++d0) { const float ov = o[d0][r] * rli[r]; stg8[orow * 64 + d0 * 32 + r32] = (unsigned char)(__builtin_amdgcn_cvt_pk_fp8_f32(ov, ov, 0, false) & 0xff); } }
    asm volatile("s_waitcnt lgkmcnt(0)" ::: "memory");
    unsigned char* Ow = (unsigned char*)J.O + (long)(wid * QBLK) * 1024;
    #pragma unroll
    for (int i = 0; i < 2; ++i) { const int row = i * 16 + (lane >> 2), ch = lane & 3; const u32x4 v = *(const u32x4*)(stg8 + row * 64 + ch * 16); *(u32x4*)(Ow + (long)row * 1024 + ch * 16) = v; }
  } else {
    bf16* stg = (bf16*)(shm + LDS_OST) + wid * 2048;
    #pragma unroll
    for (int r = 0; r < 16; ++r) { const int orow = crow(r, hi);
      #pragma unroll
      for (int d0 = 0; d0 < 2; ++d0) stg[orow * 64 + d0 * 32 + r32] = __float2bfloat16(o[d0][r] * rli[r]); }
    asm volatile("s_waitcnt lgkmcnt(0)" ::: "memory");
    if (MODE == 0) {
      bf16* Ow = J.O + (long)(wid * QBLK) * 1024;
      #pragma unroll
      for (int i = 0; i < 4; ++i) { const int row = i * 8 + (lane >> 3), ch = lane & 7; const u32x4 v = *(const u32x4*)(stg + row * 64 + ch * 8); *(u32x4*)(Ow + (long)row * 1024 + ch * 8) = v; }
    } else {
      #pragma unroll
      for (int i = 0; i < 4; ++i) { const int row = i * 8 + (lane >> 3), ch = lane & 7; const u32x4 v = *(const u32x4*)(stg + row * 64 + ch * 8);
        const long tok = ((long)(J.i0 + wid * QBLK + row) << J.dsh) + J.cls; *(u32x4*)(J.O + tok * 256 + ch * 8) = v; }
      if (hi == 0) { const long tok = ((long)(J.i0 + qrel) << J.dsh) + J.cls; J.lse[tok * 4] = mhat + __builtin_amdgcn_logf(l_reg); }
    } }
  asm volatile("s_waitcnt lgkmcnt(0)\n\ts_barrier" ::: "memory");
  #undef DMA_K
  #undef DMA_V
  #undef CMASK
  #undef START
  #undef RESC
  #undef ROT
}
#undef SBAR
#undef WAIT_BAR
}


namespace attn8 {
typedef int i32x8 __attribute__((ext_vector_type(8)));
typedef int i32x4 __attribute__((ext_vector_type(4)));
typedef float f32x16 __attribute__((ext_vector_type(16)));
typedef unsigned u32x4 __attribute__((ext_vector_type(4)));
constexpr int SLOT = 4096, NSL = 3;
constexpr int L_K = 0, L_V = NSL * SLOT, L_WS = 2 * NSL * SLOT, L_OST = L_WS + 8 * 256, L_BYTES = L_OST + 8 * 4096;
struct Job { const unsigned char* Q; const unsigned char* K; const unsigned char* VT; unsigned char* O; };
__device__ __forceinline__ void glds16(const void* gsrc, unsigned lds_dst) { unsigned keep;
  asm volatile("s_mov_b32 %0, m0\n\ts_mov_b32 m0, %2\n\ts_nop 0\n\tglobal_load_lds_dwordx4 %1, off\n\ts_mov_b32 m0, %0" : "=&s"(keep) : "v"(gsrc), "s"(lds_dst) : "memory"); }
__device__ __forceinline__ int crow(int r, int hi) { return (r & 3) + 8 * (r >> 2) + 4 * hi; }
#define A8_WAITBAR(N) asm volatile("s_waitcnt vmcnt(" #N ") lgkmcnt(0)\n\ts_barrier" ::: "memory")
template <int NT> __device__ __forceinline__ void attn_unit_f8(const Job& J, char* shm, const int wid_in) {
  int wid = wid_in; asm volatile("" : "+s"(wid));
  const int lane = lane_id_asm(), r32 = lane & 31, hi = lane >> 5;
  const unsigned lds0 = (unsigned)(uintptr_t)shm;
  typedef __attribute__((address_space(3))) const char* lds_cptr;
  const lds_cptr shm3 = (lds_cptr)shm;
  const bool kwave = wid < 4;
  const int w4 = wid & 3; const int drow = 16 * w4 + (lane >> 2); const int cl = (lane & 3) ^ ((drow >> 2) & 3);
  const unsigned char* dsrc = kwave ? J.K + (long)drow * 256 + 16 * cl : J.VT + (long)drow * 4096 + 16 * cl;
  const long dstep = kwave ? 64 * 256 : 64;
  const unsigned ddst = lds0 + (kwave ? L_K : L_V) + w4 * 1024;
  #define A8_DMA(t, slot) glds16(dsrc + (long)(t) * dstep, (unsigned)__builtin_amdgcn_readfirstlane(ddst + (slot)))
  const int sw = (r32 >> 2) & 3; const int foff0 = r32 * 64 + 16 * ((2 * hi) ^ sw), foff1 = r32 * 64 + 16 * ((2 * hi + 1) ^ sw);
  #define A8_FRAG(base, half) __builtin_shufflevector(*(const __attribute__((address_space(3))) i32x4*)((base) + (half) * 2048 + foff0), *(const __attribute__((address_space(3))) i32x4*)((base) + (half) * 2048 + foff1), 0, 1, 2, 3, 4, 5, 6, 7)
  const unsigned char* qp = J.Q + (long)(wid * 32 + r32) * 1024 + 32 * hi;
  const i32x8 qf = __builtin_shufflevector(*(const i32x4*)qp, *(const i32x4*)(qp + 16), 0, 1, 2, 3, 4, 5, 6, 7);
  if (kwave) { A8_DMA(0, 0); A8_DMA(1, SLOT); A8_DMA(2, 2 * SLOT); } else { A8_DMA(0, 0); A8_DMA(1, SLOT); }
  f32x16 o0 = f32x16{}, o1 = f32x16{}, o2 = f32x16{}; const f32x16 zero = f32x16{};
  i32x8 ones; _Pragma("unroll") for (int w = 0; w < 8; ++w) ones[w] = 0x38383838;
  f32x16 SA0, SA1, SB0, SB1;
  A8_WAITBAR(2);
  { const i32x8 k0 = A8_FRAG(shm3 + L_K, 0), k1 = A8_FRAG(shm3 + L_K, 1);
    SA0 = __builtin_amdgcn_mfma_scale_f32_32x32x64_f8f6f4(k0, qf, zero, 0, 0, 0, 0, 0, 0); SA1 = __builtin_amdgcn_mfma_scale_f32_32x32x64_f8f6f4(k1, qf, zero, 0, 0, 0, 0, 0, 0); }
  int s_t = 0, s_t1 = SLOT, s_t2 = 2 * SLOT;
  #define A8_SB() __builtin_amdgcn_sched_barrier(0)
  #define A8_ITER(C0, C1, N0, N1, t) do { \
    if (kwave ? ((t) + 2 < NT) : ((t) + 1 < NT)) { A8_WAITBAR(1); } else { A8_WAITBAR(0); } \
    if (kwave) { if ((t) + 3 < NT) A8_DMA((t) + 3, s_t); } else { if ((t) + 2 < NT) A8_DMA((t) + 2, s_t2); } \
    A8_SB(); \
    if ((t) + 1 < NT) { const i32x8 k0 = A8_FRAG(shm3 + L_K + s_t1, 0), k1 = A8_FRAG(shm3 + L_K + s_t1, 1); \
      N0 = __builtin_amdgcn_mfma_scale_f32_32x32x64_f8f6f4(k0, qf, zero, 0, 0, 0, 0, 0, 0); N1 = __builtin_amdgcn_mfma_scale_f32_32x32x64_f8f6f4(k1, qf, zero, 0, 0, 0, 0, 0, 0); } \
    const i32x8 v0 = A8_FRAG(shm3 + L_V + s_t, 0), v1 = A8_FRAG(shm3 + L_V + s_t, 1); \
    A8_SB();     \
    _Pragma("unroll") for (int r = 0; r < 16; ++r) { C0[r] = __builtin_amdgcn_exp2f(C0[r]); C1[r] = __builtin_amdgcn_exp2f(C1[r]); } \
    i32x8 pf; \
    _Pragma("unroll") for (int w = 0; w < 4; ++w) { unsigned a = 0, b = 0; \
      a = __builtin_amdgcn_cvt_pk_bf8_f32(C0[4 * w], C0[4 * w + 1], a, false); a = __builtin_amdgcn_cvt_pk_bf8_f32(C0[4 * w + 2], C0[4 * w + 3], a, true); \
      b = __builtin_amdgcn_cvt_pk_bf8_f32(C1[4 * w], C1[4 * w + 1], b, false); b = __builtin_amdgcn_cvt_pk_bf8_f32(C1[4 * w + 2], C1[4 * w + 3], b, true); \
      pf[w] = (int)a; pf[4 + w] = (int)b; } \
    A8_SB(); \
    o0 = __builtin_amdgcn_mfma_scale_f32_32x32x64_f8f6f4(pf, v0, o0, 1, 0, 0, 0, 0, 0); o1 = __builtin_amdgcn_mfma_scale_f32_32x32x64_f8f6f4(pf, v1, o1, 1, 0, 0, 0, 0, 0); \
    o2 = __builtin_amdgcn_mfma_scale_f32_32x32x64_f8f6f4(pf, ones, o2, 1, 0, 0, 0, 0, 0);     \
    { const int tmp_ = s_t; s_t = s_t1; s_t1 = s_t2; s_t2 = tmp_; } \
  } while (0)
#pragma unroll 1
  for (int t = 0; t < NT; t += 2) {
    A8_ITER(SA0, SA1, SB0, SB1, t);
    A8_ITER(SB0, SB1, SA0, SA1, t + 1);
  }
  #undef A8_ITER
  #undef A8_SB
  #undef A8_FRAG
  #undef A8_DMA
  float rli[16];
  #pragma unroll
  for (int r = 0; r < 16; ++r) rli[r] = __builtin_amdgcn_rcpf(o2[r]);
  unsigned char* stg8 = (unsigned char*)(shm + L_OST) + wid * 4096;
  #pragma unroll
  for (int r = 0; r < 16; ++r) { const int orow = crow(r, hi);
    const float a = o0[r] * rli[r], b = o1[r] * rli[r];
    stg8[orow * 64 + r32] = (unsigned char)(__builtin_amdgcn_cvt_pk_fp8_f32(a, a, 0, false) & 0xff); stg8[orow * 64 + 32 + r32] = (unsigned char)(__builtin_amdgcn_cvt_pk_fp8_f32(b, b, 0, false) & 0xff); }
  asm volatile("s_waitcnt lgkmcnt(0)" ::: "memory");
  unsigned char* Ow = J.O + (long)(wid * 32) * 1024;
  #pragma unroll
  for (int i = 0; i < 2; ++i) { const int row = i * 16 + (lane >> 2), ch = lane & 3; const u32x4 v = *(const u32x4*)(stg8 + row * 64 + ch * 16); *(u32x4*)(Ow + (long)row * 1024 + ch * 16) = v; }
  asm volatile("s_waitcnt lgkmcnt(0)\n\ts_barrier" ::: "memory");
}
#undef A8_WAITBAR
}

constexpr size_t MiB = 1u << 20;
constexpr size_t WS_CTL = 0, CTL_ZERO_BYTES = 1 * MiB;
constexpr size_t WS_MOD = 1 * MiB;
constexpr size_t WS_ROPE = WS_MOD + 512 * 1024;
constexpr size_t WS_BLUT = WS_ROPE + 8192;
constexpr size_t WS_RC0 = WS_BLUT + 12 * 768 * 4;
constexpr size_t WS_HIST = WS_RC0 + 4096;
constexpr size_t WS_TILEE = WS_HIST + 32768;
constexpr size_t WS_TOPE = 2 * MiB;
constexpr size_t WS_TOPW = WS_TOPE + 512 * 1024;
constexpr size_t WS_SLOT = WS_TOPW + 512 * 1024;
constexpr size_t WS_ROWW = WS_SLOT + 512 * 1024;
constexpr size_t WS_LSE = 5 * MiB;
constexpr size_t WS_WRHI = 7 * MiB;
constexpr size_t WS_WRLO = 8 * MiB;
constexpr size_t WS_WIN = 9 * MiB;
constexpr size_t WS_WBRA = 32 * MiB;
constexpr size_t WS_WBRB = 33 * MiB;
constexpr size_t WS_WOUT = 37 * MiB;
constexpr size_t WS_WGU = 41 * MiB;
constexpr size_t WS_WDN = 297 * MiB;
constexpr size_t WS_X = 425 * MiB;
constexpr size_t WS_H = 553 * MiB;
constexpr size_t WS_R = 617 * MiB;
constexpr size_t WS_AQKV = WS_R;
constexpr size_t WS_QB = WS_R + 144 * MiB;
constexpr size_t WS_KB = WS_R + 208 * MiB;
constexpr size_t WS_VB = WS_R + 224 * MiB;
constexpr size_t WS_GATE = WS_R + 240 * MiB;
constexpr size_t WS_OAG = WS_R + 368 * MiB;
constexpr size_t WS_OA = WS_R + 416 * MiB;
constexpr size_t WS_MERGED = WS_R + 432 * MiB;
constexpr size_t WS_XS = WS_R;
constexpr size_t WS_ACT = WS_R + 136 * MiB;
constexpr size_t WS_Y = WS_R + 272 * MiB;
constexpr size_t WS_OB = WS_R + 496 * MiB;
constexpr size_t WS_M8 = WS_R + 560 * MiB;
constexpr size_t WS_END = WS_R + 592 * MiB;
constexpr int CW_BAR = 4096;

constexpr int RING_BYTES = 133120;
constexpr int LDSCTL_OFF = RING_BYTES;
constexpr int LDS_BYTES = 147456;
constexpr int NWAVES = 8;

#define GAS __attribute__((address_space(1)))
#define LAS __attribute__((address_space(3)))
typedef unsigned short bf16;
typedef unsigned v4u __attribute__((ext_vector_type(4)));
typedef unsigned v2u __attribute__((ext_vector_type(2)));
typedef float f32x4 __attribute__((ext_vector_type(4)));
typedef float f32x16 __attribute__((ext_vector_type(16)));
typedef int i32x4 __attribute__((ext_vector_type(4)));
typedef short bf16x8 __attribute__((ext_vector_type(8)));
typedef GAS unsigned gu32;
#define RLX_AGENT __ATOMIC_RELAXED, __HIP_MEMORY_SCOPE_AGENT
#define LDS_WAIT() asm volatile("s_waitcnt lgkmcnt(0)" ::: "memory")
__device__ __forceinline__ unsigned f2bf(float f) { unsigned u = __builtin_bit_cast(unsigned, f); return (u + 0x7fffu + ((u >> 16) & 1u)) >> 16; }
__device__ __forceinline__ unsigned pk2(float lo, float hi) { return f2bf(lo) | (f2bf(hi) << 16); }
__device__ __forceinline__ float bfl(unsigned w) { return __uint_as_float(w << 16); }
__device__ __forceinline__ float bfh(unsigned w) { return __uint_as_float(w & 0xffff0000u); }

#define XB_TMO      128
#define XB_XCNT(j)  (256  + 64 * (j))
#define XB_XSUB(j)  (1280 + 64 * (j))
#define XB_XGEN(j)  (2304 + 64 * (j))
#define XB_TOP      3328
#define XB_TOPGEN   3392
#define XCD_BAR_WORDS 3456
#define XB_SPIN_CAP (1u << 18)
__device__ __forceinline__ unsigned xb_ld(unsigned* p)              { return __hip_atomic_load(p, __ATOMIC_RELAXED, __HIP_MEMORY_SCOPE_AGENT); }
__device__ __forceinline__ unsigned xb_add(unsigned* p, unsigned v) { return __hip_atomic_fetch_add(p, v, __ATOMIC_RELAXED, __HIP_MEMORY_SCOPE_AGENT); }
__device__ __forceinline__ unsigned xb_xcc_id() { return (unsigned)__builtin_amdgcn_s_getreg((3 << 11) | 20) & 0xFu; }
#define XB_SPIN(cond, bar) do { unsigned _sp = 0; while (cond) { __builtin_amdgcn_s_sleep(1); \
    if ((++_sp & 255u) == 0u) { if (xb_ld(&(bar)[XB_TMO])) break; if (_sp > XB_SPIN_CAP) { atomicAdd(&(bar)[XB_TMO], 1u); break; } } } } while (0)
struct XcdBarrier { unsigned* bar; unsigned x; volatile LAS unsigned* st; };
__device__ __forceinline__ XcdBarrier xcd_barrier_post(unsigned* bar, volatile LAS unsigned* st) {
    XcdBarrier b; b.bar = bar; b.x = xb_xcc_id(); b.st = st;
    if (threadIdx.x == 0) (void)xb_add(&bar[XB_XCNT(b.x)], 1u);
    return b;
}
__device__ __forceinline__ void xcd_barrier_complete(unsigned* bar, unsigned x, unsigned& nloc, unsigned& nx) {
    const unsigned G = gridDim.x * gridDim.y * gridDim.z;
    unsigned sum, cnt, mine, sp = 0u;
    for (;;) {
        sum = 0u; cnt = 0u; mine = 0u;
#pragma unroll
        for (unsigned j = 0; j < 16; ++j) { const unsigned c = xb_ld(&bar[XB_XCNT(j)]); sum += c; cnt += (c > 0u) ? 1u : 0u; mine = (j == x) ? c : mine; }
        if (sum == G) break;
        __builtin_amdgcn_s_sleep(1);
        if ((++sp & 255u) == 0u) { if (xb_ld(&bar[XB_TMO])) break; if (sp > XB_SPIN_CAP) { atomicAdd(&bar[XB_TMO], 1u); break; } }
    }
    nloc = mine > 0u ? mine : 1u; nx = cnt > 0u ? cnt : 1u;
}
__device__ __forceinline__ void xcd_barrier(const XcdBarrier& b) {
    asm volatile("s_waitcnt vmcnt(0)" ::: "memory");
    __syncthreads();
    if (threadIdx.x == 0) {
        unsigned* bar = b.bar;
        __builtin_amdgcn_s_waitcnt(0);
        unsigned nloc = b.st[0], nx = b.st[1];
        if (nloc == 0u) { xcd_barrier_complete(bar, b.x, nloc, nx); b.st[0] = nloc; b.st[1] = nx; }
        const unsigned old = xb_add(&bar[XB_XSUB(b.x)], 1u);
        const unsigned gen = old / nloc;
        if (old + 1u == (gen + 1u) * nloc) {
            __builtin_amdgcn_fence(__ATOMIC_RELEASE, "agent");
            asm volatile("s_waitcnt vmcnt(0)" ::: "memory");
            const unsigned og = xb_add(&bar[XB_TOP], 1u);
            const unsigned tg = og / nx;
            if (og + 1u == (tg + 1u) * nx) xb_add(&bar[XB_TOPGEN], 1u);
            else XB_SPIN(xb_ld(&bar[XB_TOPGEN]) == tg, bar);
            __builtin_amdgcn_fence(__ATOMIC_ACQUIRE, "agent");
            xb_add(&bar[XB_XGEN(b.x)], 1u);
            asm volatile("s_waitcnt vmcnt(0)" ::: "memory");
        } else {
            XB_SPIN(xb_ld(&bar[XB_XGEN(b.x)]) == gen, bar);
            __builtin_amdgcn_fence(__ATOMIC_ACQUIRE, "agent");
            asm volatile("s_waitcnt vmcnt(0)" ::: "memory");
        }
    }
    __syncthreads();
}

__device__ __forceinline__ float wave_sum(float v) {
    v = xsum<1>(v); v = xsum<2>(v); v = xsum<4>(v); v = xsum<8>(v); v = xsum<16>(v); v = xsum<32>(v);
    return v;
}
__device__ __forceinline__ void cvt_item(const float* W, int ldw, int K, int srcA, int srcB, bf16* WT, int dst_row0, int k0, LAS float* scr, int lane, bool ident = false) {
    const int kq = lane >> 4, nq = lane & 15; const int scol = (nq < 8 ? srcA + 4 * nq : srcB + 4 * (nq - 8));
    f32x4 v[16];
#pragma unroll
    for (int i = 0; i < 16; ++i) v[i] = *(const GAS f32x4*)(W + (size_t)(k0 + 4 * i + kq) * ldw + scol);
#pragma unroll
    for (int i = 0; i < 16; ++i)
#pragma unroll
        for (int e = 0; e < 4; ++e) scr[(4 * i + kq) * 65 + 4 * nq + e] = v[i][e];
    LDS_WAIT(); asm volatile("" ::: "memory");
    const int c = lane & 7, rr = lane >> 3;
#pragma unroll
    for (int j = 0; j < 8; ++j) { const int rho = rr + 8 * j; const int sc = (rho & 32) + (ident ? (rho & 31) : pg8::perm32(rho & 31)); const LAS float* s = scr + (8 * c) * 65 + sc;
        v4u o; o.x = pk2(s[0 * 65], s[1 * 65]); o.y = pk2(s[2 * 65], s[3 * 65]); o.z = pk2(s[4 * 65], s[5 * 65]); o.w = pk2(s[6 * 65], s[7 * 65]);
        *(GAS v4u*)(WT + (size_t)(dst_row0 + rho) * K + k0 + 8 * c) = o; }
    LDS_WAIT(); asm volatile("" ::: "memory");
}
__device__ __forceinline__ void cvt_item_f8(const float* W, int ldw, int K, int srcA, int srcB, unsigned char* WT, int dst_row0, int k0, LAS float* scr, int lane, bool ident = false) {
    const int kq = lane >> 4, nq = lane & 15; const int scol = (nq < 8 ? srcA + 4 * nq : srcB + 4 * (nq - 8));
    f32x4 v[16];
#pragma unroll
    for (int i = 0; i < 16; ++i) v[i] = *(const GAS f32x4*)(W + (size_t)(k0 + 4 * i + kq) * ldw + scol);
#pragma unroll
    for (int i = 0; i < 16; ++i)
#pragma unroll
        for (int e = 0; e < 4; ++e) scr[(4 * i + kq) * 65 + 4 * nq + e] = v[i][e] * pg8::W8_SCALE;
    LDS_WAIT(); asm volatile("" ::: "memory");
    const int c = lane & 7, rr = lane >> 3;
#pragma unroll
    for (int j = 0; j < 8; ++j) { const int rho = rr + 8 * j; const int sc = (rho & 32) + (ident ? (rho & 31) : pg8::perm32(rho & 31)); const LAS float* s = scr + (8 * c) * 65 + sc;
        unsigned w0 = 0, w1 = 0;
        w0 = __builtin_amdgcn_cvt_pk_fp8_f32(s[0 * 65], s[1 * 65], w0, false); w0 = __builtin_amdgcn_cvt_pk_fp8_f32(s[2 * 65], s[3 * 65], w0, true);
        w1 = __builtin_amdgcn_cvt_pk_fp8_f32(s[4 * 65], s[5 * 65], w1, false); w1 = __builtin_amdgcn_cvt_pk_fp8_f32(s[6 * 65], s[7 * 65], w1, true);
        v2u o; o.x = w0; o.y = w1; *(GAS v2u*)(WT + (size_t)(dst_row0 + rho) * K + k0 + 8 * c) = o; }
    LDS_WAIT(); asm volatile("" ::: "memory");
}
__device__ __forceinline__ int win_src(int X) { const int pn = X >> 3, bj = (X >> 2) & 1, wc = X & 3; return (pn >= 9 && pn < 14) ? pn * 256 + 64 * wc + 32 * bj : 32 * X; }
__device__ __forceinline__ int wgu_src(int X) { const int pn = X >> 3, bj = (X >> 2) & 1, wc = X & 3; return bj * 1024 + 128 * pn + 32 * wc; }

__device__ __forceinline__ void norm_row_bf16(const float* xrow, const float* g, const float* sc, const float* sh, bf16* orow, int lane) {
    const GAS f32x4* xr = (const GAS f32x4*)xrow + lane;
    f32x4 v[4]; float s = 0.f;
#pragma unroll
    for (int j = 0; j < 4; ++j) { v[j] = xr[64 * j]; s += (v[j].x * v[j].x + v[j].y * v[j].y) + (v[j].z * v[j].z + v[j].w * v[j].w); }
    const float rs = rsqrtf(wave_sum(s) * (1.0f / D) + EPS);
#pragma unroll
    for (int j = 0; j < 4; ++j) { const int c = 256 * j + 4 * lane;
        const f32x4 gg = *(const GAS f32x4*)(g + c), s1 = *(const GAS f32x4*)(sc + c), s0 = *(const GAS f32x4*)(sh + c);
        const f32x4 y = (v[j] * rs * gg) * (s1 + 1.0f) + s0;
        v2u o; o.x = pk2(y.x, y.y); o.y = pk2(y.z, y.w); *(GAS v2u*)(orow + c) = o; }
}

__device__ __forceinline__ void norm_rows2_bf16(const float* xrow, const float* g, const float* sc, const float* sh, bf16* orow, int lane) {
    const GAS f32x4* xr = (const GAS f32x4*)xrow + lane;
    f32x4 v[2][4]; float s0 = 0.f, s1 = 0.f;
#pragma unroll
    for (int j = 0; j < 4; ++j) { v[0][j] = xr[64 * j]; v[1][j] = xr[256 + 64 * j]; }
#pragma unroll
    for (int j = 0; j < 4; ++j) { s0 += (v[0][j].x * v[0][j].x + v[0][j].y * v[0][j].y) + (v[0][j].z * v[0][j].z + v[0][j].w * v[0][j].w); s1 += (v[1][j].x * v[1][j].x + v[1][j].y * v[1][j].y) + (v[1][j].z * v[1][j].z + v[1][j].w * v[1][j].w); }
    const float rs0 = rsqrtf(wave_sum(s0) * (1.0f / D) + EPS), rs1 = rsqrtf(wave_sum(s1) * (1.0f / D) + EPS);
#pragma unroll
    for (int j = 0; j < 4; ++j) { const int c = 256 * j + 4 * lane;
        const f32x4 gg = *(const GAS f32x4*)(g + c), a1 = *(const GAS f32x4*)(sc + c) + 1.0f, a0 = *(const GAS f32x4*)(sh + c);
        const f32x4 y0 = (v[0][j] * rs0 * gg) * a1 + a0, y1 = (v[1][j] * rs1 * gg) * a1 + a0;
        v2u o0; o0.x = pk2(y0.x, y0.y); o0.y = pk2(y0.z, y0.w); *(GAS v2u*)(orow + c) = o0;
        v2u o1; o1.x = pk2(y1.x, y1.y); o1.y = pk2(y1.z, y1.w); *(GAS v2u*)(orow + D + c) = o1; }
}

__device__ __forceinline__ void norm_rows2_f8(const float* xrow, const float* g, const float* sc, const float* sh, unsigned char* orow, int lane) {
    const GAS f32x4* xr = (const GAS f32x4*)xrow + lane;
    f32x4 v[2][4]; float s0 = 0.f, s1 = 0.f;
#pragma unroll
    for (int j = 0; j < 4; ++j) { v[0][j] = xr[64 * j]; v[1][j] = xr[256 + 64 * j]; }
#pragma unroll
    for (int j = 0; j < 4; ++j) { s0 += (v[0][j].x * v[0][j].x + v[0][j].y * v[0][j].y) + (v[0][j].z * v[0][j].z + v[0][j].w * v[0][j].w); s1 += (v[1][j].x * v[1][j].x + v[1][j].y * v[1][j].y) + (v[1][j].z * v[1][j].z + v[1][j].w * v[1][j].w); }
    const float rs0 = rsqrtf(wave_sum(s0) * (1.0f / D) + EPS), rs1 = rsqrtf(wave_sum(s1) * (1.0f / D) + EPS);
#pragma unroll
    for (int j = 0; j < 4; ++j) { const int c = 256 * j + 4 * lane;
        const f32x4 gg = *(const GAS f32x4*)(g + c), a1 = *(const GAS f32x4*)(sc + c) + 1.0f, a0 = *(const GAS f32x4*)(sh + c);
        const f32x4 y0 = (v[0][j] * rs0 * gg) * a1 + a0, y1 = (v[1][j] * rs1 * gg) * a1 + a0;
        unsigned w0 = 0, w1 = 0;
        w0 = __builtin_amdgcn_cvt_pk_fp8_f32(y0.x, y0.y, w0, false); w0 = __builtin_amdgcn_cvt_pk_fp8_f32(y0.z, y0.w, w0, true);
        w1 = __builtin_amdgcn_cvt_pk_fp8_f32(y1.x, y1.y, w1, false); w1 = __builtin_amdgcn_cvt_pk_fp8_f32(y1.z, y1.w, w1, true);
        *(GAS unsigned*)(orow + c) = w0; *(GAS unsigned*)(orow + D + c) = w1; }
}

__device__ __forceinline__ bool gqa_bound_ok(const float* qg, const float* kg, int lane) {
    float gq = fabsf(qg[lane]), gk = fabsf(kg[lane]);
#define MK_MAXSTEP(m) gq = fmaxf(gq, __int_as_float(__builtin_amdgcn_ds_swizzle(__float_as_int(gq), 0x1f | ((m) << 10)))); gk = fmaxf(gk, __int_as_float(__builtin_amdgcn_ds_swizzle(__float_as_int(gk), 0x1f | ((m) << 10))))
    MK_MAXSTEP(1); MK_MAXSTEP(2); MK_MAXSTEP(4); MK_MAXSTEP(8); MK_MAXSTEP(16);
#undef MK_MAXSTEP
    gq = fmaxf(gq, xget32(gq, lane >> 5)); gk = fmaxf(gk, xget32(gk, lane >> 5));
    const float bound = 64.0f * gq * gk * C2 * 1.01f; return __builtin_amdgcn_readfirstlane((int)(bound <= 14.0f)) != 0;
}

struct Args { const float* in[20]; float* out; unsigned char* ws; int ph_lo, ph_hi, li, pad; };
constexpr int N_PHASES = 2 + 10 * DEPTH;

typedef const __attribute__((address_space(4))) Args* kargs_t;
__device__ __forceinline__ kargs_t kargs_opaque() { kargs_t p = (kargs_t)__builtin_amdgcn_kernarg_segment_ptr(); asm volatile("" : "+s"(p)); return p; }
#define PH_BEGIN() kargs_t ap = kargs_opaque(); unsigned char* ws = ap->ws; (void)ws; \
    int wave = wave_s; asm volatile("" : "+s"(wave)); const int lane = lane_id_asm(); const int tid = wave * 64 + lane; (void)lane; (void)tid; \
    int bx = blockIdx.x; asm volatile("" : "+s"(bx)); int G = gridDim.x; asm volatile("" : "+s"(G)); const int vcu = (G % 8 == 0) ? (bx % 8) * (G / 8) + bx / 8 : bx; (void)vcu; \
    const int gw = vcu * NWAVES + wave, NGW = G * NWAVES; (void)gw; (void)NGW; const int gtid = vcu * (NWAVES * 64) + tid, NGT = G * NWAVES * 64; (void)gtid; (void)NGT
#define INP(k) (ap->in[k])
#define x_in INP(0)
#define c_in INP(1)
#define w_ada INP(2)
#define b_ada INP(3)
#define norm1_g INP(4)
#define w_in INP(5)
#define q_norm_g INP(6)
#define k_norm_g INP(7)
#define rel_bias INP(8)
#define w_br_a INP(9)
#define w_br_b INP(10)
#define w_out INP(11)
#define norm2_g INP(12)
#define w_router INP(13)
#define b_router INP(14)
#define w_gate_up INP(15)
#define b_gate_up INP(16)
#define w_down INP(17)
#define b_down INP(18)
#define final_g INP(19)
#define MOD ((float*)(ws + WS_MOD))
#define ROPE ((float*)(ws + WS_ROPE))
#define BLUT ((float*)(ws + WS_BLUT))
#define RC0 ((float*)(ws + WS_RC0))
#define HIST ((int*)(ws + WS_HIST))
#define TILEE ((int*)(ws + WS_TILEE))
#define TOPE ((int*)(ws + WS_TOPE))
#define TOPW ((float*)(ws + WS_TOPW))
#define SLOT ((int*)(ws + WS_SLOT))
#define ROWW ((float*)(ws + WS_ROWW))
#define LSE ((float*)(ws + WS_LSE))
#define WRHI ((bf16*)(ws + WS_WRHI))
#define WRLO ((bf16*)(ws + WS_WRLO))
#define WIN ((unsigned char*)(ws + WS_WIN))
#define WBRA ((unsigned char*)(ws + WS_WBRA))
#define WBRB ((unsigned char*)(ws + WS_WBRB))
#define WOUT ((unsigned char*)(ws + WS_WOUT))
#define WGU ((unsigned char*)(ws + WS_WGU))
#define WDN ((unsigned char*)(ws + WS_WDN))
#define X ((float*)(ws + WS_X))
#define H ((bf16*)(ws + WS_H))
#define AQKV ((bf16*)(ws + WS_AQKV))
#define QB ((bf16*)(ws + WS_QB))
#define KB ((bf16*)(ws + WS_KB))
#define VB ((bf16*)(ws + WS_VB))
#define GATE ((bf16*)(ws + WS_GATE))
#define OAG ((bf16*)(ws + WS_OAG))
#define OA ((unsigned char*)(ws + WS_OA))
#define MERGED ((bf16*)(ws + WS_MERGED))
#define OB ((unsigned char*)(ws + WS_OB))
#define M8 ((unsigned char*)(ws + WS_M8))
#define XS ((unsigned char*)(ws + WS_XS))
#define ACT ((unsigned char*)(ws + WS_ACT))
#define YB ((bf16*)(ws + WS_Y))
__global__ void __launch_bounds__(NWAVES * 64, 2) mk_fwd(Args args) {
    extern __shared__ __attribute__((aligned(16))) unsigned char lds[];
    LAS unsigned char* L = (LAS unsigned char*)lds;
    volatile LAS unsigned* MISC = (volatile LAS unsigned*)(L + LDSCTL_OFF);
    gu32* ctl = (gu32*)(args.ws + WS_CTL);
    const int wave_s = __builtin_amdgcn_readfirstlane(threadIdx.x >> 6);
    for (int u = threadIdx.x; u < (LDS_BYTES - LDSCTL_OFF) / 4; u += NWAVES * 64) ((LAS unsigned*)(L + LDSCTL_OFF))[u] = 0u;
    __syncthreads();
    XcdBarrier bar; bar.bar = (unsigned*)(ctl + CW_BAR) + args.li * XCD_BAR_WORDS; bar.x = 0; bar.st = nullptr;
    if (!MK_PER_PHASE) bar = xcd_barrier_post((unsigned*)(ctl + CW_BAR) + args.li * XCD_BAR_WORDS, MISC + 8);
    const int lo = args.ph_lo, hi = args.ph_hi;
#define IN(k) (lo <= (k) && (k) < hi)
#define KIND(q) ((PH_KIND_MASK >> (q)) & 1)
#define SEAM(k) do { if (IN(k) && IN((k) + 1)) xcd_barrier(bar); } while (0)

    for (int rep0 = 0; rep0 < 1 + PROBE_P0; ++rep0) {
    if (KIND(0) && IN(0)) { PH_BEGIN();
        {
            LAS float* cact = (LAS float*)L;
            LAS float* part = (LAS float*)(L + 32768);
            for (int i = tid; i < NB * D; i += NWAVES * 64) { const float cv = c_in[i]; cact[i] = cv / (1.0f + __expf(-cv)); }
            __syncthreads();
            for (int vb = bx; vb < 256; vb += G) {
                const int gc = vb * 48 + lane;
                const int l = gc / 6144, col = gc % 6144;
                float a[NB];
#pragma unroll
                for (int b = 0; b < NB; ++b) a[b] = 0.f;
                if (lane < 48) {
                    const float* wp = w_ada + (size_t)l * D * 6144 + col;
                    for (int k = wave * 128; k < wave * 128 + 128; ++k) { const float w = wp[(size_t)k * 6144];
#pragma unroll
                        for (int b = 0; b < NB; ++b) a[b] += cact[b * D + k] * w; }
                }
#pragma unroll
                for (int b = 0; b < NB; ++b) part[(wave * NB + b) * 64 + lane] = a[b];
                __syncthreads();
                if (tid < NB * 48) { const int b = tid / 48, cl = tid % 48; const int gc2 = vb * 48 + cl; const int l2 = gc2 / 6144, col2 = gc2 % 6144;
                    float s = b_ada[l2 * 6144 + col2];
#pragma unroll
                    for (int w = 0; w < NWAVES; ++w) s += part[(w * NB + b) * 64 + cl];
                    MOD[((size_t)l2 * NB + b) * 6144 + col2] = s; }
                __syncthreads();
            }
        }
        for (int i = gtid; i < 1024 + 12 * 768; i += NGT) {
            if (i < 1024) { const int p = i >> 4, f = i & 15; const double inv = pow(10000.0, -(double)f / 16.0); const double ang = (double)p * inv; ROPE[i] = (float)cos(ang); ROPE[1024 + i] = (float)sin(ang); }
            else { const int j = i - 1024; const int hh = j / 768, di = j % 768; const int delta = di - 383; const int g = hh >> 2; const int dil = g == 0 ? 1 : (g == 1 ? 4 : 16);
                float val = -INFINITY;
                if (delta >= -64 && delta <= 64) { const int rel = delta * dil; const int n = rel < 0 ? -rel : rel; int bk = rel > 0 ? 16 : 0;
                    if (n < 8) bk += n; else { int lg = 8 + (int)(logf((float)n / 8.0f) / logf(128.0f) * 8.0f); if (lg > 15) lg = 15; bk += lg; }
                    val = rel_bias[bk * 12 + hh] * LOG2E; }
                BLUT[j] = val; }
        }
        {
            LAS float* scr = (LAS float*)(L + wave * 16640);
            __syncthreads();
            constexpr int I_IN = 16 * 92, I_BRA = 4 * 16, I_BRB = 16 * 16, I_OUT = 16 * 16, I_GU = 16 * 32, I_DN = 16 * 16;
            constexpr int PER_L = I_IN + I_BRA + I_BRB + I_OUT;
            constexpr int NITEMS = DEPTH * PER_L + DEPTH * NE * (I_GU + I_DN);
            for (int it = gw; it < NITEMS; it += NGW) {
                int r = it;
                if (r < DEPTH * PER_L) {
                    const int l = r / PER_L; r %= PER_L;
                    if (r < I_IN) { const int kb = r / 92, g64 = r % 92; cvt_item_f8(w_in + (size_t)l * D * N_IN, N_IN, D, win_src(2 * g64), win_src(2 * g64 + 1), WIN + (size_t)l * N_IN * D, 64 * g64, 64 * kb, scr, lane, (g64 >> 2) >= 9 && (g64 >> 2) < 14); continue; } r -= I_IN;
                    if (r < I_BRA) { const int kb = r / 16, g64 = r % 16; cvt_item_f8(w_br_a + (size_t)l * 256 * D, D, 256, 64 * g64, 64 * g64 + 32, WBRA + (size_t)l * D * 256, 64 * g64, 64 * kb, scr, lane); continue; } r -= I_BRA;
                    if (r < I_BRB) { const int kb = r / 16, g64 = r % 16; cvt_item_f8(w_br_b + (size_t)l * D * D, D, D, 64 * g64, 64 * g64 + 32, WBRB + (size_t)l * D * D, 64 * g64, 64 * kb, scr, lane); continue; } r -= I_BRB;
                    { const int kb = r / 16, g64 = r % 16; cvt_item_f8(w_out + (size_t)l * D * D, D, D, 64 * g64, 64 * g64 + 32, WOUT + (size_t)l * D * D, 64 * g64, 64 * kb, scr, lane); continue; }
                }
                r -= DEPTH * PER_L;
                if (r < DEPTH * NE * I_GU) { const int le = r / I_GU; r %= I_GU; const int kb = r / 32, g64 = r % 32;
                    cvt_item_f8(w_gate_up + (size_t)le * D * 2048, 2048, D, wgu_src(2 * g64), wgu_src(2 * g64 + 1), WGU + (size_t)le * 2048 * D, 64 * g64, 64 * kb, scr, lane); continue; }
                r -= DEPTH * NE * I_GU;
                { const int le = r / I_DN; r %= I_DN; const int kb = r / 16, g64 = r % 16;
                    cvt_item_f8(w_down + (size_t)le * D * D, D, D, 64 * g64, 64 * g64 + 32, WDN + (size_t)le * D * D, 64 * g64, 64 * kb, scr, lane); }
            }
        }
    }
    SEAM(0);
    }
    if (KIND(1) && IN(1)) { PH_BEGIN();
        for (int m = 2 * gw; m < T; m += 2 * NGW) { const int b = m >> 12; const float* md = MOD + (size_t)b * 6144;
            norm_rows2_f8(x_in + (size_t)m * D, norm1_g, md + 1024, md, (unsigned char*)H + (size_t)m * D, lane); }
        for (int i = gtid; i < DEPTH * NB * NE * D; i += NGT) { const int k = i & 1023, e = (i >> 10) & 31, b = (i >> 15) & 7, l = i >> 18;
            const float v = norm2_g[l * D + k] * (1.0f + MOD[((size_t)l * NB + b) * 6144 + 4 * 1024 + k]) * w_router[((size_t)l * D + k) * NE + e];
            const unsigned hb = f2bf(v); const float lv = v - __uint_as_float(hb << 16);
            WRHI[i] = (bf16)hb; WRLO[i] = (bf16)f2bf(lv); }
        for (int i = gw; i < DEPTH * NB * NE; i += NGW) { const int e = i & 31, b = (i >> 5) & 7, l = i >> 8; float s = 0.f;
            for (int k = lane; k < D; k += 64) s += MOD[((size_t)l * NB + b) * 6144 + 3 * 1024 + k] * w_router[((size_t)l * D + k) * NE + e];
            s = wave_sum(s); if (lane == 0) RC0[i] = s + b_router[l * NE + e]; }
    }
    SEAM(1);

    for (int li = (PROBE_MASK ? -1 : 0); li < DEPTH; ++li) {
        const int l = li < 0 ? 0 : li; const bool virt = li < 0;
        const int P = 2 + 10 * l;
#define VK(q) (!virt || ((PROBE_MASK >> (q)) & 1))
        if (KIND(2) && IN(P + 0) && VK(2)) { PH_BEGIN();
            pg8::Gemm g{H, (const bf16*)(WIN + (size_t)l * N_IN * D), D / 2}; pg8::StaticOrder S; S.init(T, N_IN, G, bx);
            const bool f8attn = gqa_bound_ok(q_norm_g + l * 64, k_norm_g + l * 64, lane);
            pg8::EpiIn E{AQKV, QB, KB, VB, GATE, q_norm_g + l * 64, k_norm_g + l * 64, ROPE, pg8::W8_INV, f8attn};
            pg8::gemm_phase_f8<pg8::EpiIn, pg8::StaticOrder>(L, g, S, E, wave);
        }
        if (VK(2)) SEAM(P + 0);
        if (KIND(3) && IN(P + 1) && VK(3)) { PH_BEGIN();
            namespace ab = attn_body;
            const bool nomax = gqa_bound_ok(q_norm_g + l * 64, k_norm_g + l * 64, lane);
            for (int j = 0; j < 8; ++j) {
                const int uidx = vcu * 8 + j; if (uidx >= 2048) break;
                const int pair = uidx >> 6, idx = uidx & 63; const int b = pair >> 2, kvh = pair & 3, hq = idx >> 4, qb = idx & 15; const int h = kvh * 4 + hq;
                ab::Job J; J.Q = (const ab::bf16*)QB + ((size_t)b * SEQ + qb * 256) * 1024 + h * 64; J.K = (const ab::bf16*)KB + (size_t)b * SEQ * 256 + kvh * 64; J.V = (const ab::bf16*)VB + (size_t)b * SEQ * 256 + kvh * 64;
                J.O = (ab::bf16*)(OB + ((size_t)b * SEQ + qb * 256) * 1024 + h * 64)  ; J.lse = nullptr; J.lutg = nullptr; J.NT = 64; J.i0 = 0; J.kq0 = 0; J.dsh = 0; J.cls = 0;
                if (nomax) { attn8::Job J8; J8.Q = (const unsigned char*)QB + ((size_t)b * SEQ + qb * 256) * 1024 + h * 64; J8.K = (const unsigned char*)KB + (size_t)b * SEQ * 256 + kvh * 64;
                    J8.VT = (const unsigned char*)VB + ((size_t)((b * 4 + kvh) * 64) << 12); J8.O = OB + ((size_t)b * SEQ + qb * 256) * 1024 + h * 64;
                    attn8::attn_unit_f8<64>(J8, (char*)lds, wave); }
                else ab::attn_unit<0, 8, false>(J, (char*)lds, wave);
            }
            for (int j = 0; j < 6; ++j) {
                const int uidx = vcu * 6 + j; if (uidx >= 1536) break;
                const int g = uidx / 512, r = uidx % 512; const int b = r >> 6, hs = (r >> 4) & 3, combo = r & 15;
                const int dsh = 2 * g; const int Lc = SEQ >> dsh; const int nqb = Lc >> 8;
                const int cls = combo / nqb, qb = combo % nqb; const int i0 = qb * 256;
                int t0 = (i0 >> 6) - 1; const int ntile = Lc >> 6; const int NT = ntile >= 6 ? 6 : 4; if (t0 < 0) t0 = 0; if (t0 > ntile - NT) t0 = ntile - NT;
                const size_t cbase = (size_t)b * SEQ + (size_t)cls * Lc;
                const ab::bf16* aq = (const ab::bf16*)AQKV + (size_t)(g * 3 + 0) * T * 256; const ab::bf16* ak = (const ab::bf16*)AQKV + (size_t)(g * 3 + 1) * T * 256; const ab::bf16* av = (const ab::bf16*)AQKV + (size_t)(g * 3 + 2) * T * 256;
                ab::Job J; J.Q = aq + (cbase + i0) * 256 + hs * 64; J.K = ak + (cbase + t0 * 64) * 256 + hs * 64; J.V = av + (cbase + t0 * 64) * 256 + hs * 64;
                J.O = (ab::bf16*)OAG + (size_t)g * T * 256 + (size_t)b * SEQ * 256 + hs * 64; J.lse = LSE + (size_t)g * T * 4 + (size_t)b * SEQ * 4 + hs; J.lutg = BLUT + (g * 4 + hs) * 768;
                J.NT = NT; J.i0 = i0; J.kq0 = t0 * 64 - i0; J.dsh = dsh; J.cls = cls;
                ab::attn_unit<1, 8>(J, (char*)lds, wave);
            }
        }
        if (VK(3)) SEAM(P + 1);
        if (KIND(4) && IN(P + 2) && VK(4)) { PH_BEGIN();
            for (int i = gtid; i < T * 32; i += NGT) { const int t = i >> 5, ch = i & 31, hs = ch >> 3;
                const float l0 = LSE[(size_t)t * 4 + hs], l1 = LSE[(size_t)T * 4 + (size_t)t * 4 + hs], l2 = LSE[(size_t)2 * T * 4 + (size_t)t * 4 + hs];
                const float mx = fmaxf(l0, fmaxf(l1, l2)); float w0 = exp2f(l0 - mx), w1 = exp2f(l1 - mx), w2 = exp2f(l2 - mx); const float inv = 1.0f / (w0 + w1 + w2); w0 *= inv; w1 *= inv; w2 *= inv;
                const v4u a = *(const GAS v4u*)(OAG + (size_t)t * 256 + ch * 8), bq = *(const GAS v4u*)(OAG + (size_t)T * 256 + (size_t)t * 256 + ch * 8), cq = *(const GAS v4u*)(OAG + (size_t)2 * T * 256 + (size_t)t * 256 + ch * 8);
                unsigned o0 = 0, o1 = 0;
                o0 = __builtin_amdgcn_cvt_pk_fp8_f32(w0 * bfl(a.x) + w1 * bfl(bq.x) + w2 * bfl(cq.x), w0 * bfh(a.x) + w1 * bfh(bq.x) + w2 * bfh(cq.x), o0, false);
                o0 = __builtin_amdgcn_cvt_pk_fp8_f32(w0 * bfl(a.y) + w1 * bfl(bq.y) + w2 * bfl(cq.y), w0 * bfh(a.y) + w1 * bfh(bq.y) + w2 * bfh(cq.y), o0, true);
                o1 = __builtin_amdgcn_cvt_pk_fp8_f32(w0 * bfl(a.z) + w1 * bfl(bq.z) + w2 * bfl(cq.z), w0 * bfh(a.z) + w1 * bfh(bq.z) + w2 * bfh(cq.z), o1, false);
                o1 = __builtin_amdgcn_cvt_pk_fp8_f32(w0 * bfl(a.w) + w1 * bfl(bq.w) + w2 * bfl(cq.w), w0 * bfh(a.w) + w1 * bfh(bq.w) + w2 * bfh(cq.w), o1, true);
                v2u o; o.x = o0; o.y = o1; *(GAS v2u*)(OA + (size_t)t * 256 + ch * 8) = o; }
        }
        if (VK(4)) SEAM(P + 2);
        if (KIND(5) && IN(P + 3) && VK(5)) { PH_BEGIN();
            pg8::StaticOrder S; S.init(T, D, G, bx);
            { pg8::Gemm g{(const bf16*)OA, (const bf16*)(WBRA + (size_t)l * D * 256), 128}; pg8::EpiMergeA E{GATE, MERGED}; pg8::gemm_phase_f8<pg8::EpiMergeA, pg8::StaticOrder>(L, g, S, E, wave); }
            { pg8::Gemm g{(const bf16*)OB, (const bf16*)(WBRB + (size_t)l * D * D), D / 2}; pg8::EpiMergeB<true> E{GATE, MERGED, M8}; pg8::gemm_phase_f8<pg8::EpiMergeB<true>, pg8::StaticOrder>(L, g, S, E, wave); }
        }
        if (VK(5)) SEAM(P + 3);
        if (KIND(6) && IN(P + 4) && VK(6)) { PH_BEGIN();
            pg8::Gemm g{(const bf16*)M8, (const bf16*)(WOUT + (size_t)l * D * D), D / 2}; pg8::StaticOrder S; S.init(T, D, G, bx);
            pg8::EpiOut E{l == 0 ? x_in : X, X, MOD + (size_t)l * NB * 6144 + 2 * 1024};
            pg8::gemm_phase_f8<pg8::EpiOut, pg8::StaticOrder>(L, g, S, E, wave);
        }
        if (VK(6)) SEAM(P + 4);
        if (KIND(7) && IN(P + 5) && VK(7)) { PH_BEGIN();
            LAS int* hist = (LAS int*)(L + LDSCTL_OFF + 256);
            for (int vb = bx; vb < 256; vb += G) {
                if (tid < NE) hist[tid] = 0;
                __syncthreads();
                {
                    const int tt = vb + 256 * wave; const int r0 = tt * 16; const int b = r0 >> 12; const int i = lane & 15, kb = lane >> 4;
                    const float* xp = X + (size_t)(r0 + i) * D + 8 * kb;
                    const bf16* bh = WRHI + ((size_t)(l * NB + b) * NE + i) * D + 8 * kb; const bf16* bl = WRLO + ((size_t)(l * NB + b) * NE + i) * D + 8 * kb;
                    f32x4 acc0 = (f32x4){0.f, 0.f, 0.f, 0.f}, acc1 = acc0; float ss = 0.f;
#pragma unroll 4
                    for (int s = 0; s < 32; ++s) {
                        const f32x4 x0 = *(const GAS f32x4*)(xp + 32 * s), x1 = *(const GAS f32x4*)(xp + 32 * s + 4);
                        const bf16x8 wh0 = *(const GAS bf16x8*)(bh + 32 * s), wh1 = *(const GAS bf16x8*)(bh + 16 * D + 32 * s), wl0 = *(const GAS bf16x8*)(bl + 32 * s), wl1 = *(const GAS bf16x8*)(bl + 16 * D + 32 * s);
                        ss += (x0.x * x0.x + x0.y * x0.y) + (x0.z * x0.z + x0.w * x0.w) + (x1.x * x1.x + x1.y * x1.y) + (x1.z * x1.z + x1.w * x1.w);
                        v4u ah, al;
                        { const unsigned h0 = f2bf(x0.x), h1 = f2bf(x0.y), h2 = f2bf(x0.z), h3 = f2bf(x0.w), h4 = f2bf(x1.x), h5 = f2bf(x1.y), h6 = f2bf(x1.z), h7 = f2bf(x1.w);
                          ah.x = h0 | (h1 << 16); ah.y = h2 | (h3 << 16); ah.z = h4 | (h5 << 16); ah.w = h6 | (h7 << 16);
                          al.x = pk2(x0.x - __uint_as_float(h0 << 16), x0.y - __uint_as_float(h1 << 16)); al.y = pk2(x0.z - __uint_as_float(h2 << 16), x0.w - __uint_as_float(h3 << 16));
                          al.z = pk2(x1.x - __uint_as_float(h4 << 16), x1.y - __uint_as_float(h5 << 16)); al.w = pk2(x1.z - __uint_as_float(h6 << 16), x1.w - __uint_as_float(h7 << 16)); }
                        const bf16x8 ahv = __builtin_bit_cast(bf16x8, ah), alv = __builtin_bit_cast(bf16x8, al);
                        acc0 = __builtin_amdgcn_mfma_f32_16x16x32_bf16(wh0, ahv, acc0, 0, 0, 0); acc1 = __builtin_amdgcn_mfma_f32_16x16x32_bf16(wh1, ahv, acc1, 0, 0, 0);
                        acc0 = __builtin_amdgcn_mfma_f32_16x16x32_bf16(wl0, ahv, acc0, 0, 0, 0); acc1 = __builtin_amdgcn_mfma_f32_16x16x32_bf16(wl1, ahv, acc1, 0, 0, 0);
                        acc0 = __builtin_amdgcn_mfma_f32_16x16x32_bf16(wh0, alv, acc0, 0, 0, 0); acc1 = __builtin_amdgcn_mfma_f32_16x16x32_bf16(wh1, alv, acc1, 0, 0, 0);
                    }
                    ss = xsum<16>(ss); ss = xsum<32>(ss);
                    const float rs = rsqrtf(ss * (1.0f / D) + EPS);
                    float v[8]; const float* rc = RC0 + (l * NB + b) * NE;
#pragma unroll
                    for (int r = 0; r < 4; ++r) { v[r] = rs * acc0[r] + rc[4 * kb + r]; v[4 + r] = rs * acc1[r] + rc[16 + 4 * kb + r]; }
                    float tv[4]; int ti[4];
#pragma unroll
                    for (int k = 0; k < 4; ++k) { float best = v[0]; int br = 0;
#pragma unroll
                        for (int r = 1; r < 8; ++r) if (v[r] > best) { best = v[r]; br = r; }
#pragma unroll
                        for (int r = 0; r < 8; ++r) v[r] = (r == br) ? -INFINITY : v[r];
                        tv[k] = best; ti[k] = (br & 3) + 16 * (br >> 2) + 4 * kb; }
#pragma unroll
                    for (int round = 0; round < 2; ++round) {
                        float bv[8]; int bi[8];
#pragma unroll
                        for (int k = 0; k < 4; ++k) { bv[k] = tv[k]; bi[k] = ti[k];
                            if (round == 0) { bv[4 + k] = __int_as_float(__builtin_amdgcn_ds_swizzle(__float_as_int(tv[k]), 0x1f | (16 << 10))); bi[4 + k] = __builtin_amdgcn_ds_swizzle(ti[k], 0x1f | (16 << 10)); }
                            else { bv[4 + k] = xget32(tv[k], lane >> 5); bi[4 + k] = xget32(ti[k], lane >> 5); } }
#pragma unroll
                        for (int k = 0; k < 4; ++k) { float best = bv[0]; int bq = 0;
#pragma unroll
                            for (int r = 1; r < 8; ++r) if (bv[r] > best || (bv[r] == best && bi[r] < bi[bq])) { best = bv[r]; bq = r; }
                            int sel = bi[0];
#pragma unroll
                            for (int r = 0; r < 8; ++r) { if (r == bq) sel = bi[r]; }
#pragma unroll
                            for (int r = 0; r < 8; ++r) bv[r] = (r == bq) ? -INFINITY : bv[r];
                            tv[k] = best; ti[k] = sel; }
                    }
                    if (kb == 0) {
                        const float e1 = __expf(tv[1] - tv[0]), e2 = __expf(tv[2] - tv[0]), e3 = __expf(tv[3] - tv[0]); const float inv = 1.0f / (1.0f + e1 + e2 + e3);
                        const int tok = r0 + i;
                        *(GAS i32x4*)(TOPE + (size_t)tok * 4) = (i32x4){ti[0], ti[1], ti[2], ti[3]};
                        *(GAS f32x4*)(TOPW + (size_t)tok * 4) = (f32x4){inv, e1 * inv, e2 * inv, e3 * inv};
#pragma unroll
                        for (int k = 0; k < 4; ++k) atomicAdd((int*)&hist[ti[k]], 1);
                    }
                }
                __syncthreads();
                if (tid < NE) HIST[vb * NE + tid] = hist[tid];
                __syncthreads();
            }
            for (int m = 2 * gw; m < T; m += 2 * NGW) { const int b = m >> 12; const float* md = MOD + ((size_t)l * NB + b) * 6144;
                norm_rows2_f8(X + (size_t)m * D, norm2_g + l * D, md + 4 * 1024, md + 3 * 1024, (unsigned char*)H + (size_t)m * D, lane); }
        }
        if (VK(7)) SEAM(P + 5);
        if (KIND(8) && IN(P + 6) && VK(8)) { PH_BEGIN();
            LAS int* sm = (LAS int*)L;
            for (int vb = bx; vb < 256; vb += G) {
                { const int e = tid & 31, seg = tid >> 5; int tot = 0, bef = 0;
                    for (int q = seg * 16; q < seg * 16 + 16; ++q) { const int hv = HIST[q * NE + e]; tot += hv; if (q < vb) bef += hv; }
                    sm[tid] = tot; sm[512 + tid] = bef; }
                __syncthreads();
                if (tid < NE) { int tot = 0, bef = 0;
                    for (int s = 0; s < 16; ++s) { tot += sm[s * 32 + tid]; bef += sm[512 + s * 32 + tid]; }
                    sm[1024 + tid] = bef; sm[1056 + tid] = (tot + 255) & ~255; }
                __syncthreads();
                if (tid == 0) { int run = 0; for (int e = 0; e < NE; ++e) { const int pd = sm[1056 + e]; sm[1056 + e] = run; sm[1024 + e] += run;
                        if (vb == 0) { for (int q = run >> 8; q < (run + pd) >> 8; ++q) TILEE[q] = e; }
                        run += pd; }
                    if (vb == 0) TILEE[1000] = run >> 8; }
                __syncthreads();
                if (tid < 128) { const int tt = vb + 256 * (tid >> 4); const int tok = tt * 16 + (tid & 15);
                    const i32x4 te = *(const GAS i32x4*)(TOPE + (size_t)tok * 4); const f32x4 tw = *(const GAS f32x4*)(TOPW + (size_t)tok * 4);
                    const int s0 = atomicAdd((int*)&sm[1024 + te.x], 1), s1 = atomicAdd((int*)&sm[1024 + te.y], 1), s2 = atomicAdd((int*)&sm[1024 + te.z], 1), s3 = atomicAdd((int*)&sm[1024 + te.w], 1);
                    *(GAS i32x4*)(SLOT + (size_t)tok * 4) = (i32x4){s0, s1, s2, s3};
                    ROWW[s0] = tw.x; ROWW[s1] = tw.y; ROWW[s2] = tw.z; ROWW[s3] = tw.w;
                    sm[2048 + tid * 4 + 0] = s0; sm[2048 + tid * 4 + 1] = s1; sm[2048 + tid * 4 + 2] = s2; sm[2048 + tid * 4 + 3] = s3; }
                __syncthreads();
                for (int p = wave; p < 512; p += NWAVES) { const int q = p >> 2; const int tt = vb + 256 * (q >> 4); const int tok = tt * 16 + (q & 15); const int slot = sm[2048 + p];
                    const GAS v4u* src = (const GAS v4u*)((unsigned char*)H + (size_t)tok * D); GAS v4u* dst = (GAS v4u*)(XS + (size_t)slot * D);
                    dst[lane] = src[lane]; }
                __syncthreads();
            }
        }
        if (VK(8)) SEAM(P + 6);
        if (KIND(9) && IN(P + 7) && VK(9)) { PH_BEGIN();
            const int nmt = __builtin_amdgcn_readfirstlane(__hip_atomic_load(TILEE + 1000, __ATOMIC_RELAXED, __HIP_MEMORY_SCOPE_AGENT));
            pg8::Gemm g{(const bf16*)XS, (const bf16*)(WGU + (size_t)l * NE * 2048 * D), D / 2}; pg8::MoeOrder S{TILEE, nmt * 8, 8, G, vcu};
            pg8::EpiGU8 E{b_gate_up + (size_t)l * NE * 2048, ACT};
            pg8::gemm_phase_f8<pg8::EpiGU8, pg8::MoeOrder>(L, g, S, E, wave);
        }
        if (VK(9)) SEAM(P + 7);
        if (KIND(10) && IN(P + 8) && VK(10)) { PH_BEGIN();
            const int nmt = __builtin_amdgcn_readfirstlane(__hip_atomic_load(TILEE + 1000, __ATOMIC_RELAXED, __HIP_MEMORY_SCOPE_AGENT));
            pg8::Gemm g{(const bf16*)ACT, (const bf16*)(WDN + (size_t)l * NE * D * D), D / 2}; pg8::MoeOrder S{TILEE, nmt * 4, 4, G, vcu};
            pg8::EpiDN8 E{b_down + (size_t)l * NE * D, ROWW, YB};
            pg8::gemm_phase_f8<pg8::EpiDN8, pg8::MoeOrder>(L, g, S, E, wave);
        }
        if (VK(10)) SEAM(P + 8);
        if (KIND(11) && IN(P + 9) && VK(11)) { PH_BEGIN();
            const bool lastl = (l == DEPTH - 1);
            float* Xw = virt ? (float*)(ws + WS_R) : X; bf16* Hw = virt ? (bf16*)(ws + WS_R + 128 * MiB) : H;
            for (int m0 = 2 * gw; m0 < T; m0 += 2 * NGW) { const int b = m0 >> 12;
                i32x4 sl[2];
#pragma unroll
                for (int q = 0; q < 2; ++q) { const int* sp = SLOT + (size_t)(m0 + q) * 4;
                    sl[q].x = __hip_atomic_load(sp + 0, RLX_AGENT); sl[q].y = __hip_atomic_load(sp + 1, RLX_AGENT); sl[q].z = __hip_atomic_load(sp + 2, RLX_AGENT); sl[q].w = __hip_atomic_load(sp + 3, RLX_AGENT); }
                const float* g2 = MOD + ((size_t)l * NB + b) * 6144 + 5 * 1024;
                f32x4 v[2][4]; v2u yy[2][4][4];
#pragma unroll
                for (int q = 0; q < 2; ++q)
#pragma unroll
                    for (int j = 0; j < 4; ++j) { const int c = 256 * j + 4 * lane;
                        v[q][j] = *(const GAS f32x4*)(X + (size_t)(m0 + q) * D + c);
                        yy[q][j][0] = *(const GAS v2u*)(YB + (size_t)sl[q].x * D + c); yy[q][j][1] = *(const GAS v2u*)(YB + (size_t)sl[q].y * D + c);
                        yy[q][j][2] = *(const GAS v2u*)(YB + (size_t)sl[q].z * D + c); yy[q][j][3] = *(const GAS v2u*)(YB + (size_t)sl[q].w * D + c); }
                float s[2] = {0.f, 0.f};
#pragma unroll
                for (int q = 0; q < 2; ++q)
#pragma unroll
                    for (int j = 0; j < 4; ++j) { const int c = 256 * j + 4 * lane; const v2u y0 = yy[q][j][0], y1 = yy[q][j][1], y2 = yy[q][j][2], y3 = yy[q][j][3];
                        f32x4 ys; ys.x = (bfl(y0.x) + bfl(y1.x)) + (bfl(y2.x) + bfl(y3.x)); ys.y = (bfh(y0.x) + bfh(y1.x)) + (bfh(y2.x) + bfh(y3.x));
                        ys.z = (bfl(y0.y) + bfl(y1.y)) + (bfl(y2.y) + bfl(y3.y)); ys.w = (bfh(y0.y) + bfh(y1.y)) + (bfh(y2.y) + bfh(y3.y));
                        const f32x4 gg = *(const GAS f32x4*)(g2 + c);
                        v[q][j] = v[q][j] + gg * ys;
                        if (!lastl) *(GAS f32x4*)(Xw + (size_t)(m0 + q) * D + c) = v[q][j];
                        s[q] += (v[q][j].x * v[q][j].x + v[q][j].y * v[q][j].y) + (v[q][j].z * v[q][j].z + v[q][j].w * v[q][j].w); }
                const float rs0 = rsqrtf(wave_sum(s[0]) * (1.0f / D) + EPS), rs1 = rsqrtf(wave_sum(s[1]) * (1.0f / D) + EPS);
                if (!lastl) { const float* md = MOD + ((size_t)(l + 1) * NB + b) * 6144; const float* gn = norm1_g + (l + 1) * D;
#pragma unroll
                    for (int j = 0; j < 4; ++j) { const int c = 256 * j + 4 * lane;
                        const f32x4 gg = *(const GAS f32x4*)(gn + c), a1 = *(const GAS f32x4*)(md + 1024 + c) + 1.0f, a0 = *(const GAS f32x4*)(md + c);
                        const f32x4 y0 = (v[0][j] * rs0 * gg) * a1 + a0, y1 = (v[1][j] * rs1 * gg) * a1 + a0;
                        unsigned w0 = 0, w1 = 0;
                        w0 = __builtin_amdgcn_cvt_pk_fp8_f32(y0.x, y0.y, w0, false); w0 = __builtin_amdgcn_cvt_pk_fp8_f32(y0.z, y0.w, w0, true);
                        w1 = __builtin_amdgcn_cvt_pk_fp8_f32(y1.x, y1.y, w1, false); w1 = __builtin_amdgcn_cvt_pk_fp8_f32(y1.z, y1.w, w1, true);
                        *(GAS unsigned*)((unsigned char*)Hw + (size_t)m0 * D + c) = w0; *(GAS unsigned*)((unsigned char*)Hw + (size_t)(m0 + 1) * D + c) = w1; }
                } else {
#pragma unroll
                    for (int j = 0; j < 4; ++j) { const int c = 256 * j + 4 * lane; const f32x4 gg = *(const GAS f32x4*)(final_g + c);
                        *(GAS f32x4*)(ap->out + (size_t)m0 * D + c) = v[0][j] * rs0 * gg; *(GAS f32x4*)(ap->out + (size_t)(m0 + 1) * D + c) = v[1][j] * rs1 * gg; }
                }
            }
        }
        if (VK(11)) SEAM(P + 9);
        if (virt) { PH_BEGIN();
            for (int m = 2 * gw; m < T; m += 2 * NGW) { const int b = m >> 12; const float* md = MOD + (size_t)b * 6144; norm_rows2_f8(x_in + (size_t)m * D, norm1_g, md + 1024, md, (unsigned char*)H + (size_t)m * D, lane); }
            xcd_barrier(bar); }
    }
#undef IN
#undef SEAM
}

extern "C" void kernel_launch(void* const* d_in, const int* in_sizes, int n_in, void* d_out, int out_size, void* d_ws, size_t ws_size, hipStream_t stream) {
    static int grid = 0;
    if (grid == 0) {
        if (n_in != 20 || in_sizes[0] != T * D || out_size != T * D || ws_size < WS_END) { fprintf(stderr, "kernel_launch: unexpected shapes (n_in %d, in0 %d, out %d, ws %zu < %zu); nothing launched\n", n_in, n_in > 0 ? in_sizes[0] : -1, out_size, ws_size, (size_t)WS_END); grid = -1; return; }
        int dev = 0, cus = 0, per_cu = 0;
        if (hipGetDevice(&dev) != hipSuccess || hipDeviceGetAttribute(&cus, hipDeviceAttributeMultiprocessorCount, dev) != hipSuccess) { grid = -1; return; }
        if (hipFuncSetAttribute((const void*)mk_fwd, hipFuncAttributeMaxDynamicSharedMemorySize, LDS_BYTES) != hipSuccess) { fprintf(stderr, "kernel_launch: hipFuncSetAttribute failed\n"); grid = -1; return; }
        if (hipOccupancyMaxActiveBlocksPerMultiprocessor(&per_cu, (const void*)mk_fwd, NWAVES * 64, LDS_BYTES) != hipSuccess || per_cu < 1)
            fprintf(stderr, "kernel_launch: note: occupancy query reports %d workgroups per CU\n", per_cu);
        (void)hipGetLastError();
        grid = cus < 256 ? cus : 256;
        if (grid != 256) fprintf(stderr, "kernel_launch: %d CUs; this kernel's unit deals assume 256\n", grid);
    }
    if (grid < 0) return;
    if (hipMemsetAsync((char*)d_ws + WS_CTL, 0, CTL_ZERO_BYTES, stream) != hipSuccess) { fprintf(stderr, "kernel_launch: memset failed\n"); return; }
    Args a{};
    for (int i = 0; i < 20; ++i) a.in[i] = (const float*)d_in[i];
    a.out = (float*)d_out; a.ws = (unsigned char*)d_ws; a.pad = 0;
#if MK_PER_PHASE
    for (int p = 0; p < N_PHASES; ++p) { a.ph_lo = p; a.ph_hi = p + 1; a.li = 0; hipLaunchKernelGGL(mk_fwd, dim3(grid), dim3(NWAVES * 64), LDS_BYTES, stream, a); }
#else
    a.ph_lo = 0; a.ph_hi = N_PHASES; a.li = 0;
    hipLaunchKernelGGL(mk_fwd, dim3(grid), dim3(NWAVES * 64), LDS_BYTES, stream, a);
#endif
    const hipError_t le = hipPeekAtLastError();
    if (le != hipSuccess) fprintf(stderr, "kernel_launch: launch failed: %s\n", hipGetErrorName(le));
}
```

```cpp
#include <hip/hip_runtime.h>
#include <hip/hip_bf16.h>
#include <cstdio>
#include <cstdint>
#include <cmath>

#ifndef PH_KIND_MASK
#define PH_KIND_MASK 0xFFF
#endif
#ifndef PROBE_MASK
#define PROBE_MASK 0
#endif
#ifndef PROBE_P0
#define PROBE_P0 0
#endif
#ifndef MK_PER_PHASE
#define MK_PER_PHASE 0
#endif

constexpr int NB = 8, SEQ = 4096, T = NB * SEQ, D = 1024, DEPTH = 2;
constexpr int N_IN = 5888, NE = 32, TOPK = 4;
constexpr int NASSIGN = T * TOPK;
constexpr int MAX_MT = NASSIGN / 256 + NE;
constexpr int CAP_ROWS = MAX_MT * 256;
constexpr float C2 = 0.125f * 1.4426950408889634f;
constexpr float LOG2E = 1.4426950408889634f;
constexpr float EPS = 1e-6f;

__device__ __forceinline__ int lane_id_asm() { int l; asm volatile("v_mbcnt_lo_u32_b32 %0, -1, 0\n\tv_mbcnt_hi_u32_b32 %0, -1, %0" : "=v"(l)); return l; }

template <int M> __device__ __forceinline__ float xsum(float v) {
    if constexpr (M < 32) return v + __int_as_float(__builtin_amdgcn_ds_swizzle(__float_as_int(v), 0x1f | (M << 10)));
    else { auto rr = __builtin_amdgcn_permlane32_swap(__float_as_uint(v), __float_as_uint(v), false, false); return __uint_as_float(rr[0]) + __uint_as_float(rr[1]); }
}
template <class Tv> __device__ __forceinline__ Tv xget32(Tv v, int hf) {
    auto rr = __builtin_amdgcn_permlane32_swap(__builtin_bit_cast(unsigned, v), __builtin_bit_cast(unsigned, v), false, false); return __builtin_bit_cast(Tv, hf ? rr[0] : rr[1]);
}

namespace pg8 {
#define PG8_LAS __attribute__((address_space(3)))
typedef unsigned short bf16_t;
typedef short bf16x8 __attribute__((ext_vector_type(8)));
typedef float f32x4 __attribute__((ext_vector_type(4)));
typedef unsigned u32x4 __attribute__((ext_vector_type(4)));
typedef unsigned u32x2 __attribute__((ext_vector_type(2)));
constexpr int BM = 256, BK = 64, HALF = 128, HTB = HALF * BK * 2, STAGE_BYTES = 8 * HTB, NXCD = 8, WGM = 8;

__host__ __device__ __forceinline__ int lds_byte(int r, int c) { const int st = (r >> 4) * 2 + (c >> 5), rr = r & 15, cc = c & 31, ob = rr * 64 + cc * 2; return st * 1024 + (ob ^ (((ob >> 9) & 1) << 5)); }
__host__ __device__ __forceinline__ void stage_rc(int b, int& R, int& C) { const int st = b / 1024, sb = b % 1024, swz = sb ^ (((sb >> 9) & 1) << 5); R = (st >> 1) * 16 + swz / 64; C = (st & 1) * 32 + (swz % 64) / 2; }
__host__ __device__ __forceinline__ int perm32(int rho) { const int n = rho >> 4, i = rho & 15; return 8 * (i >> 2) + 4 * n + (i & 3); }

struct Unit { int pm, pn; };
struct Gemm { const bf16_t* A; const bf16_t* Bt; int K; };

struct StaticOrder {
    int nM, nN, nwg, G, c;
    __device__ void init(int M, int N, int G_, int c_) { nM = M / BM; nN = N / BM; nwg = nM * nN; G = G_; c = c_; }
    __device__ bool next(int i, Unit& u) const {
        const long L = (long)i * G + c; if (L >= nwg) return false;
        int wgid = (int)L; { const int q = nwg / NXCD, r = nwg % NXCD, xcd = wgid % NXCD, off = wgid / NXCD; wgid = (xcd < r ? xcd * (q + 1) : r * (q + 1) + (xcd - r) * q) + off; }
        const int nig = WGM * nN, gid = wgid / nig, fm = gid * WGM, gsz = (nM - fm) < WGM ? (nM - fm) : WGM;
        u.pm = fm + ((wgid % nig) % gsz); u.pn = (wgid % nig) / gsz; return true;
    }
};
struct MoeOrder {
    const int* tile_e; int n_units, nN, G, vcu;
    __device__ bool next(int i, Unit& u) const {
        const long L = (long)i * G + vcu; if (L >= n_units) return false;
        const int mt = (int)L / nN, pl = (int)L % nN; const int e = __builtin_amdgcn_readfirstlane(__hip_atomic_load(tile_e + mt, __ATOMIC_RELAXED, __HIP_MEMORY_SCOPE_AGENT));
        u.pm = mt; u.pn = e * nN + pl; return true;
    }
};

__device__ __forceinline__ unsigned cvt_pk_bf16(float lo, float hi) { unsigned r; asm volatile("v_cvt_pk_bf16_f32 %0, %1, %2" : "=v"(r) : "v"(lo), "v"(hi)); return r; }
__device__ __forceinline__ float bf_lo(unsigned w) { return __uint_as_float(w << 16); }
__device__ __forceinline__ float bf_hi(unsigned w) { return __uint_as_float(w & 0xffff0000u); }
__device__ __forceinline__ float sigmoid_f(float x) { return __builtin_amdgcn_rcpf(1.0f + __builtin_amdgcn_exp2f(-LOG2E * x)); }

template <class Epi, class Sched>
__device__ __forceinline__ void gemm_phase(PG8_LAS unsigned char* lds, const Gemm g, const Sched& S, const Epi& E, const int wid_in) {
    int wid = wid_in; asm volatile("" : "+s"(wid));
    const int lane = lane_id_asm(), tid = wid * 64 + lane, wr = wid >> 2, wc = wid & 3, fr = lane & 15, fq = lane >> 4;
    int K_o = g.K; asm volatile("" : "+s"(K_o)); const int K = K_o, nt = K / BK;
    unsigned voff[2];
#pragma unroll
    for (int i = 0; i < 2; ++i) { int R, C; stage_rc(tid * 16 + i * 8192, R, C); voff[i] = (unsigned)(R * K + C) * 2u; }
    const size_t kstep = (size_t)(BK * 2);
    const size_t hstep = (size_t)HALF * K * 2;
    const size_t tstep = 2 * hstep;
    const unsigned ldsw = (unsigned)wid * 1024u;
    const int aoff = lds_byte(wr * 64 + fr, fq * 8), boff = lds_byte(wc * 32 + fr, fq * 8);
#define PG8_SA(b, h) (((b) * 2 + (h)) * HTB)
#define PG8_SB(b, h) ((4 + (b) * 2 + (h)) * HTB)
#define PG8_STAGE(bufoff, gbase) do { _Pragma("unroll") for (int _i = 0; _i < 2; ++_i) \
        __builtin_amdgcn_global_load_lds((const unsigned*)((const char*)(gbase) + voff[_i]), (PG8_LAS unsigned*)(lds + (bufoff) + ldsw + _i * 8192), 16, 0, 0); } while (0)
#define PG8_LDA(dst, b, h) do { _Pragma("unroll") for (int m = 0; m < 4; ++m) _Pragma("unroll") for (int k = 0; k < 2; ++k) dst[m][k] = *(const PG8_LAS bf16x8*)(lds + PG8_SA(b, h) + aoff + m * 2048 + k * 1024); } while (0)
#define PG8_LDB(dst, b, h) do { _Pragma("unroll") for (int n = 0; n < 2; ++n) _Pragma("unroll") for (int k = 0; k < 2; ++k) dst[n][k] = *(const PG8_LAS bf16x8*)(lds + PG8_SB(b, h) + boff + n * 2048 + k * 1024); } while (0)
#define PG8_MMA(ai, bj, At, Bt) do { __builtin_amdgcn_s_setprio(1); _Pragma("unroll") for (int m = 0; m < 4; ++m) _Pragma("unroll") for (int n = 0; n < 2; ++n) _Pragma("unroll") for (int k = 0; k < 2; ++k) \
        acc[ai][bj][m][n] = __builtin_amdgcn_mfma_f32_16x16x32_bf16(Bt[n][k], At[m][k], acc[ai][bj][m][n], 0, 0, 0); __builtin_amdgcn_s_setprio(0); } while (0)
#define PG8_WAIT_V(n) asm volatile("s_waitcnt vmcnt(" #n ")" ::: "memory")
#define PG8_WAIT_L(n) asm volatile("s_waitcnt lgkmcnt(" #n ")" ::: "memory")
#define PG8_BAR __builtin_amdgcn_s_barrier()
#define PG8_SCHED __builtin_amdgcn_sched_barrier(0)
    Unit cur, nxt; int ui = 0;
    if (!S.next(0, cur)) return;
    f32x4 acc[2][2][4][2];
#pragma unroll
    for (int a = 0; a < 2; ++a)
#pragma unroll
        for (int b = 0; b < 2; ++b)
#pragma unroll
            for (int m = 0; m < 4; ++m)
#pragma unroll
                for (int n = 0; n < 2; ++n) acc[a][b][m][n] = (f32x4){0.f, 0.f, 0.f, 0.f};
    bf16x8 At[4][2], B0[2][2], B1[2][2];
    const char* cA = (const char*)g.A + (size_t)cur.pm * tstep; const char* cB = (const char*)g.Bt + (size_t)cur.pn * tstep;
    PG8_STAGE(PG8_SB(0, 0), cB); PG8_STAGE(PG8_SB(0, 1), cB + hstep); PG8_STAGE(PG8_SA(0, 0), cA); PG8_STAGE(PG8_SA(0, 1), cA + hstep);
    if (wr == 1) PG8_BAR;
    PG8_WAIT_V(2); PG8_BAR;
    PG8_STAGE(PG8_SB(1, 0), cB + kstep); PG8_STAGE(PG8_SA(1, 0), cA + kstep); PG8_STAGE(PG8_SB(1, 1), cB + hstep + kstep);
    PG8_WAIT_V(6); PG8_BAR;
    for (;;) {
        const bool has_next = S.next(ui + 1, nxt);
        const char* nA = has_next ? (const char*)g.A + (size_t)nxt.pm * tstep : cA; const char* nB = has_next ? (const char*)g.Bt + (size_t)nxt.pn * tstep : cB;
        for (int t = 0; t < nt; t += 2) {
            const bool last = (t == nt - 2);
            const char* a1 = cA + (size_t)(t + 1) * kstep;
            const char* a2 = last ? nA : cA + (size_t)(t + 2) * kstep; const char* b2 = last ? nB : cB + (size_t)(t + 2) * kstep;
            const char* a3 = a2 + kstep; const char* b3 = b2 + kstep;
            PG8_LDB(B0, 0, 0); PG8_LDB(B1, 0, 1); PG8_SCHED; PG8_LDA(At, 0, 0); PG8_STAGE(PG8_SA(1, 1), a1 + hstep);
            PG8_WAIT_V(8); PG8_WAIT_L(0); PG8_BAR; PG8_MMA(0, 0, At, B0); PG8_MMA(0, 1, At, B1); PG8_BAR; PG8_SCHED;
            PG8_LDA(At, 0, 1); PG8_STAGE(PG8_SB(0, 0), b2); PG8_STAGE(PG8_SB(0, 1), b2 + hstep); PG8_STAGE(PG8_SA(0, 0), a2);
            PG8_WAIT_V(8); PG8_WAIT_L(0); PG8_BAR; PG8_MMA(1, 0, At, B0); PG8_MMA(1, 1, At, B1); PG8_BAR; PG8_SCHED;
            PG8_LDB(B0, 1, 0); PG8_LDB(B1, 1, 1); PG8_SCHED; PG8_LDA(At, 1, 0); PG8_STAGE(PG8_SA(0, 1), a2 + hstep);
            PG8_WAIT_V(8); PG8_WAIT_L(0); PG8_BAR; PG8_MMA(0, 0, At, B0); PG8_MMA(0, 1, At, B1); PG8_BAR; PG8_SCHED;
            PG8_LDA(At, 1, 1); PG8_STAGE(PG8_SB(1, 0), b3); PG8_STAGE(PG8_SB(1, 1), b3 + hstep); PG8_STAGE(PG8_SA(1, 0), a3);
            PG8_WAIT_V(8); PG8_WAIT_L(0); PG8_BAR; PG8_MMA(1, 0, At, B0); PG8_MMA(1, 1, At, B1); PG8_BAR; PG8_SCHED;
        }
        if (wr == 0) PG8_BAR;
        E(acc, cur, wr, wc, fr, fq);
        if (!has_next) break;
#pragma unroll
        for (int a = 0; a < 2; ++a)
#pragma unroll
            for (int b = 0; b < 2; ++b)
#pragma unroll
                for (int m = 0; m < 4; ++m)
#pragma unroll
                    for (int n = 0; n < 2; ++n) acc[a][b][m][n] = (f32x4){0.f, 0.f, 0.f, 0.f};
        cur = nxt; cA = nA; cB = nB; ++ui;
        if (wr == 1) PG8_BAR;
    }
    PG8_WAIT_V(0);
    PG8_BAR;
#undef PG8_SA
#undef PG8_SB
#undef PG8_STAGE
#undef PG8_LDA
#undef PG8_LDB
#undef PG8_MMA
#undef PG8_WAIT_V
#undef PG8_WAIT_L
#undef PG8_BAR
#undef PG8_SCHED
}

typedef int i32x4_t __attribute__((ext_vector_type(4)));
template <class Epi, class Sched>
__device__ __forceinline__ void gemm_phase_f8(PG8_LAS unsigned char* lds, const Gemm g, const Sched& S, const Epi& E, const int wid_in) {
    int wid = wid_in; asm volatile("" : "+s"(wid));
    const int lane = lane_id_asm(), tid = wid * 64 + lane, wr = wid >> 2, wc = wid & 3, fr = lane & 15, fq = lane >> 4;
    int K_o = g.K; asm volatile("" : "+s"(K_o)); const int K = K_o, nt = K / BK;
    unsigned voff[2];
#pragma unroll
    for (int i = 0; i < 2; ++i) { int R, C; stage_rc(tid * 16 + i * 8192, R, C); voff[i] = (unsigned)(R * K + C) * 2u; }
    const size_t kstep = (size_t)(BK * 2);
    const size_t hstep = (size_t)HALF * K * 2;
    const size_t tstep = 2 * hstep;
    const unsigned ldsw = (unsigned)wid * 1024u;
    const int aoff = lds_byte(wr * 64 + fr, fq * 16), boff = lds_byte(wc * 32 + fr, fq * 16);
#define PG8_SA(b, h) (((b) * 2 + (h)) * HTB)
#define PG8_SB(b, h) ((4 + (b) * 2 + (h)) * HTB)
#define PG8_STAGE(bufoff, gbase) do { _Pragma("unroll") for (int _i = 0; _i < 2; ++_i) \
        __builtin_amdgcn_global_load_lds((const unsigned*)((const char*)(gbase) + voff[_i]), (PG8_LAS unsigned*)(lds + (bufoff) + ldsw + _i * 8192), 16, 0, 0); } while (0)
#define PG8_LDA(dst, b, h) do { _Pragma("unroll") for (int m = 0; m < 4; ++m) _Pragma("unroll") for (int k = 0; k < 2; ++k) dst[m][k] = *(const PG8_LAS bf16x8*)(lds + PG8_SA(b, h) + aoff + m * 2048 + k * 16); } while (0)
#define PG8_LDB(dst, b, h) do { _Pragma("unroll") for (int n = 0; n < 2; ++n) _Pragma("unroll") for (int k = 0; k < 2; ++k) dst[n][k] = *(const PG8_LAS bf16x8*)(lds + PG8_SB(b, h) + boff + n * 2048 + k * 16); } while (0)
#define PG8_F8(x) __builtin_shufflevector(__builtin_bit_cast(i32x4_t, (x)[0]), __builtin_bit_cast(i32x4_t, (x)[1]), 0, 1, 2, 3, 4, 5, 6, 7)
#define PG8_MMA(ai, bj, At, Bt) do { __builtin_amdgcn_s_setprio(1); asm volatile("s_nop 1" ::: ); _Pragma("unroll") for (int m = 0; m < 4; ++m) _Pragma("unroll") for (int n = 0; n < 2; ++n) \
        asm volatile("v_mfma_f32_16x16x128_f8f6f4 %0, %1, %2, %0" : "+v"(acc[ai][bj][m][n]) : "v"(PG8_F8(Bt[n])), "v"(PG8_F8(At[m]))); __builtin_amdgcn_s_setprio(0); } while (0)
#define PG8_ACC_SETTLE asm volatile("s_nop 15\n\ts_nop 15" ::: "memory")
#define PG8_WAIT_V(n) asm volatile("s_waitcnt vmcnt(" #n ")" ::: "memory")
#define PG8_WAIT_L(n) asm volatile("s_waitcnt lgkmcnt(" #n ")" ::: "memory")
#define PG8_BAR __builtin_amdgcn_s_barrier()
#define PG8_SCHED __builtin_amdgcn_sched_barrier(0)
    Unit cur, nxt; int ui = 0;
    if (!S.next(0, cur)) return;
    f32x4 acc[2][2][4][2];
#pragma unroll
    for (int a = 0; a < 2; ++a)
#pragma unroll
        for (int b = 0; b < 2; ++b)
#pragma unroll
            for (int m = 0; m < 4; ++m)
#pragma unroll
                for (int n = 0; n < 2; ++n) acc[a][b][m][n] = (f32x4){0.f, 0.f, 0.f, 0.f};
    bf16x8 At[4][2], B0[2][2], B1[2][2];
    const char* cA = (const char*)g.A + (size_t)cur.pm * tstep; const char* cB = (const char*)g.Bt + (size_t)cur.pn * tstep;
    PG8_STAGE(PG8_SB(0, 0), cB); PG8_STAGE(PG8_SB(0, 1), cB + hstep); PG8_STAGE(PG8_SA(0, 0), cA); PG8_STAGE(PG8_SA(0, 1), cA + hstep);
    if (wr == 1) PG8_BAR;
    PG8_WAIT_V(2); PG8_BAR;
    PG8_STAGE(PG8_SB(1, 0), cB + kstep); PG8_STAGE(PG8_SA(1, 0), cA + kstep); PG8_STAGE(PG8_SB(1, 1), cB + hstep + kstep);
    PG8_WAIT_V(6); PG8_BAR;
    for (;;) {
        const bool has_next = S.next(ui + 1, nxt);
        const char* nA = has_next ? (const char*)g.A + (size_t)nxt.pm * tstep : cA; const char* nB = has_next ? (const char*)g.Bt + (size_t)nxt.pn * tstep : cB;
        for (int t = 0; t < nt; t += 2) {
            const bool last = (t == nt - 2);
            const char* a1 = cA + (size_t)(t + 1) * kstep;
            const char* a2 = last ? nA : cA + (size_t)(t + 2) * kstep; const char* b2 = last ? nB : cB + (size_t)(t + 2) * kstep;
            const char* a3 = a2 + kstep; const char* b3 = b2 + kstep;
            PG8_LDB(B0, 0, 0); PG8_LDB(B1, 0, 1); PG8_SCHED; PG8_LDA(At, 0, 0); PG8_STAGE(PG8_SA(1, 1), a1 + hstep);
            PG8_WAIT_V(8); PG8_WAIT_L(0); PG8_BAR; PG8_MMA(0, 0, At, B0); PG8_MMA(0, 1, At, B1); PG8_BAR; PG8_SCHED;
            PG8_LDA(At, 0, 1); PG8_STAGE(PG8_SB(0, 0), b2); PG8_STAGE(PG8_SB(0, 1), b2 + hstep); PG8_STAGE(PG8_SA(0, 0), a2);
            PG8_WAIT_V(8); PG8_WAIT_L(0); PG8_BAR; PG8_MMA(1, 0, At, B0); PG8_MMA(1, 1, At, B1); PG8_BAR; PG8_SCHED;
            PG8_LDB(B0, 1, 0); PG8_LDB(B1, 1, 1); PG8_SCHED; PG8_LDA(At, 1, 0); PG8_STAGE(PG8_SA(0, 1), a2 + hstep);
            PG8_WAIT_V(8); PG8_WAIT_L(0); PG8_BAR; PG8_MMA(0, 0, At, B0); PG8_MMA(0, 1, At, B1); PG8_BAR; PG8_SCHED;
            PG8_LDA(At, 1, 1); PG8_STAGE(PG8_SB(1, 0), b3); PG8_STAGE(PG8_SB(1, 1), b3 + hstep); PG8_STAGE(PG8_SA(1, 0), a3);
            PG8_WAIT_V(8); PG8_WAIT_L(0); PG8_BAR; PG8_MMA(1, 0, At, B0); PG8_MMA(1, 1, At, B1); PG8_BAR; PG8_SCHED;
        }
        if (wr == 0) PG8_BAR;
        PG8_ACC_SETTLE;
        E(acc, cur, wr, wc, fr, fq);
        if (!has_next) break;
#pragma unroll
        for (int a = 0; a < 2; ++a)
#pragma unroll
            for (int b = 0; b < 2; ++b)
#pragma unroll
                for (int m = 0; m < 4; ++m)
#pragma unroll
                    for (int n = 0; n < 2; ++n) acc[a][b][m][n] = (f32x4){0.f, 0.f, 0.f, 0.f};
        cur = nxt; cA = nA; cB = nB; ++ui;
        if (wr == 1) PG8_BAR;
    }
    PG8_WAIT_V(0);
    PG8_BAR;
#undef PG8_SA
#undef PG8_SB
#undef PG8_STAGE
#undef PG8_LDA
#undef PG8_LDB
#undef PG8_MMA
#undef PG8_F8
#undef PG8_ACC_SETTLE
#undef PG8_WAIT_V
#undef PG8_WAIT_L
#undef PG8_BAR
#undef PG8_SCHED
}

#define EPI_ROWS(...) _Pragma("unroll") for (int ai = 0; ai < 2; ++ai) _Pragma("unroll") for (int m = 0; m < 4; ++m) { const int row = u.pm * BM + ai * HALF + wr * 64 + m * 16 + fr; __VA_ARGS__ }
__device__ __forceinline__ u32x4 pack8(const f32x4 a, const f32x4 b) { u32x4 w; w.x = cvt_pk_bf16(a[0], a[1]); w.y = cvt_pk_bf16(a[2], a[3]); w.z = cvt_pk_bf16(b[0], b[1]); w.w = cvt_pk_bf16(b[2], b[3]); return w; }

__device__ __forceinline__ u32x2 pack8_f8(const f32x4 a, const f32x4 b) { unsigned w0 = 0, w1 = 0;
    w0 = __builtin_amdgcn_cvt_pk_fp8_f32(a[0], a[1], w0, false); w0 = __builtin_amdgcn_cvt_pk_fp8_f32(a[2], a[3], w0, true);
    w1 = __builtin_amdgcn_cvt_pk_fp8_f32(b[0], b[1], w1, false); w1 = __builtin_amdgcn_cvt_pk_fp8_f32(b[2], b[3], w1, true); u32x2 r; r.x = w0; r.y = w1; return r; }
constexpr float W8_SCALE = 64.0f, W8_INV = 1.0f / 64.0f;
struct EpiIn {
    bf16_t* aqkv; bf16_t* qb; bf16_t* kb; bf16_t* vb; bf16_t* gate; const float* qg; const float* kg; const float* rope; float asc; bool f8attn;
    __device__ __forceinline__ void operator()(const f32x4 (&acc)[2][2][4][2], const Unit& u, int wr, int wc, int fr, int fq) const {
        const int pn = u.pn;
        if (pn >= 9 && pn < 14) {
            const bool isq = pn < 13; const int head = isq ? (pn - 9) * 4 + wc : wc; bf16_t* dst = isq ? qb : kb; const int pitch = isq ? 1024 : 256;
            const float* gvec = isq ? qg : kg; const float osc = isq ? C2 : 1.0f;
            f32x4 gv[2][2];
#pragma unroll
            for (int bj = 0; bj < 2; ++bj)
#pragma unroll
                for (int n = 0; n < 2; ++n) gv[bj][n] = *(const f32x4*)(gvec + 32 * bj + 16 * n + 4 * fq);
            EPI_ROWS(
                float ss = 0.f;
                _Pragma("unroll") for (int bj = 0; bj < 2; ++bj) _Pragma("unroll") for (int n = 0; n < 2; ++n) { const f32x4 x = acc[ai][bj][m][n] * asc; ss += (x[0] * x[0] + x[1] * x[1]) + (x[2] * x[2] + x[3] * x[3]); }
                ss = xsum<16>(ss); ss = xsum<32>(ss);
                const float sc = rsqrtf(ss * (1.0f / 64.0f) + EPS) * osc * asc;
                const int t = row & (SEQ - 1);
                _Pragma("unroll") for (int bj = 0; bj < 2; ++bj) {
                    const int pos = bj == 0 ? (t >> 6) : (t & 63);
                    const f32x4 cs = *(const f32x4*)(rope + pos * 16 + 4 * fq); const f32x4 sn = *(const f32x4*)(rope + 1024 + pos * 16 + 4 * fq);
                    const f32x4 y0 = acc[ai][bj][m][0] * sc * gv[bj][0]; const f32x4 y1 = acc[ai][bj][m][1] * sc * gv[bj][1];
                    const f32x4 o0 = y0 * cs - y1 * sn; const f32x4 o1 = y1 * cs + y0 * sn;
                    if (f8attn) { unsigned char* p8 = (unsigned char*)dst + (size_t)row * pitch + head * 64 + 32 * bj + 4 * fq;
                        unsigned a = 0, b = 0; a = __builtin_amdgcn_cvt_pk_fp8_f32(o0[0], o0[1], a, false); a = __builtin_amdgcn_cvt_pk_fp8_f32(o0[2], o0[3], a, true);
                        b = __builtin_amdgcn_cvt_pk_fp8_f32(o1[0], o1[1], b, false); b = __builtin_amdgcn_cvt_pk_fp8_f32(o1[2], o1[3], b, true);
                        *(unsigned*)p8 = a; *(unsigned*)(p8 + 16) = b;
                    } else {
                    bf16_t* p = dst + (size_t)row * pitch + head * 64 + 32 * bj + 4 * fq;
                    u32x2 w0; w0.x = cvt_pk_bf16(o0[0], o0[1]); w0.y = cvt_pk_bf16(o0[2], o0[3]);
                    u32x2 w1; w1.x = cvt_pk_bf16(o1[0], o1[1]); w1.y = cvt_pk_bf16(o1[2], o1[3]);
                    *(u32x2*)p = w0; *(u32x2*)(p + 16) = w1; }
                }
            )
        } else if (pn == 14 && f8attn) {
            unsigned char* vt = (unsigned char*)vb;
            EPI_ROWS(
                const int b = row >> 12; const int t = row & (SEQ - 1); const int kk = t & 63;
                const int pos = 32 * ((kk >> 2) & 1) + (kk & 3) + 4 * ((kk >> 3) & 3) + 16 * (kk >> 5);
                _Pragma("unroll") for (int bj = 0; bj < 2; ++bj) {
                    const int kvh = bj * 2 + (wc >> 1); const int d0 = (wc & 1) * 32 + 8 * fq;
                    unsigned char* p = vt + ((size_t)((b * 4 + kvh) * 64 + d0) << 12) + (t & ~63) + pos;
                    const f32x4 v0 = acc[ai][bj][m][0] * asc; const f32x4 v1 = acc[ai][bj][m][1] * asc;
                    unsigned a = 0, c = 0; a = __builtin_amdgcn_cvt_pk_fp8_f32(v0[0], v0[1], a, false); a = __builtin_amdgcn_cvt_pk_fp8_f32(v0[2], v0[3], a, true);
                    c = __builtin_amdgcn_cvt_pk_fp8_f32(v1[0], v1[1], c, false); c = __builtin_amdgcn_cvt_pk_fp8_f32(v1[2], v1[3], c, true);
                    p[0 << 12] = (unsigned char)a; p[1 << 12] = (unsigned char)(a >> 8); p[2 << 12] = (unsigned char)(a >> 16); p[3 << 12] = (unsigned char)(a >> 24);
                    p[4 << 12] = (unsigned char)c; p[5 << 12] = (unsigned char)(c >> 8); p[6 << 12] = (unsigned char)(c >> 16); p[7 << 12] = (unsigned char)(c >> 24);
                }
            )
        } else {
            bf16_t* dst; int pitch, colt, dsh = 0; float sc = asc; bool sig = false, fold = false;
            if (pn < 9) { dst = aqkv + (size_t)pn * T * 256; pitch = 256; colt = 0; fold = true; dsh = 2 * (pn / 3); if (pn % 3 == 0) sc = C2 * asc; }
            else if (pn == 14) { dst = vb; pitch = 256; colt = 0; }
            else { dst = gate; pitch = 2048; colt = (pn - 15) * 256; sig = true; }
            const int col0 = colt + wc * 32 + 8 * fq;
            EPI_ROWS(
                int drow = row;
                if (fold) { const int t = row & (SEQ - 1); drow = (row & ~(SEQ - 1)) | ((t & ((1 << dsh) - 1)) << (12 - dsh)) | (t >> dsh); }
                bf16_t* rowp = dst + (size_t)drow * pitch + col0;
                _Pragma("unroll") for (int bj = 0; bj < 2; ++bj) {
                    f32x4 v0 = acc[ai][bj][m][0], v1 = acc[ai][bj][m][1];
                    if (sig) { _Pragma("unroll") for (int j = 0; j < 4; ++j) { v0[j] = sigmoid_f(v0[j] * asc); v1[j] = sigmoid_f(v1[j] * asc); } }
                    else { v0 = v0 * sc; v1 = v1 * sc; }
                    *(u32x4*)(rowp + bj * HALF) = pack8(v0, v1);
                }
            )
        }
    }
};
struct EpiMergeA {
    const bf16_t* gate; bf16_t* merged;
    __device__ __forceinline__ void operator()(const f32x4 (&acc)[2][2][4][2], const Unit& u, int wr, int wc, int fr, int fq) const {
        const int col0 = u.pn * BM + wc * 32 + 8 * fq;
        EPI_ROWS(
            _Pragma("unroll") for (int bj = 0; bj < 2; ++bj) {
                const u32x4 gw = *(const u32x4*)(gate + (size_t)row * 2048 + col0 + bj * HALF);
                f32x4 v0 = acc[ai][bj][m][0], v1 = acc[ai][bj][m][1];
                v0 = v0 * W8_INV; v1 = v1 * W8_INV;
                v0[0] *= bf_lo(gw.x); v0[1] *= bf_hi(gw.x); v0[2] *= bf_lo(gw.y); v0[3] *= bf_hi(gw.y);
                v1[0] *= bf_lo(gw.z); v1[1] *= bf_hi(gw.z); v1[2] *= bf_lo(gw.w); v1[3] *= bf_hi(gw.w);
                *(u32x4*)(merged + (size_t)row * 1024 + col0 + bj * HALF) = pack8(v0, v1);
            }
        )
    }
};
template <bool F8> struct EpiMergeB {
    const bf16_t* gate; const bf16_t* merged; unsigned char* m8;
    __device__ __forceinline__ void operator()(const f32x4 (&acc)[2][2][4][2], const Unit& u, int wr, int wc, int fr, int fq) const {
        const int col0 = u.pn * BM + wc * 32 + 8 * fq;
        EPI_ROWS(
            _Pragma("unroll") for (int bj = 0; bj < 2; ++bj) {
                const u32x4 gw = *(const u32x4*)(gate + (size_t)row * 2048 + 1024 + col0 + bj * HALF);
                const bf16_t* mp = merged + (size_t)row * 1024 + col0 + bj * HALF;
                const u32x4 mw = *(const u32x4*)mp;
                f32x4 v0 = acc[ai][bj][m][0] * (F8 ? W8_INV : 1.0f), v1 = acc[ai][bj][m][1] * (F8 ? W8_INV : 1.0f);
                v0[0] = v0[0] * bf_lo(gw.x) + bf_lo(mw.x); v0[1] = v0[1] * bf_hi(gw.x) + bf_hi(mw.x); v0[2] = v0[2] * bf_lo(gw.y) + bf_lo(mw.y); v0[3] = v0[3] * bf_hi(gw.y) + bf_hi(mw.y);
                v1[0] = v1[0] * bf_lo(gw.z) + bf_lo(mw.z); v1[1] = v1[1] * bf_hi(gw.z) + bf_hi(mw.z); v1[2] = v1[2] * bf_lo(gw.w) + bf_lo(mw.w); v1[3] = v1[3] * bf_hi(gw.w) + bf_hi(mw.w);
                *(u32x2*)(m8 + (size_t)row * 1024 + col0 + bj * HALF) = pack8_f8(v0, v1);
            }
        )
    }
};
struct EpiOut {
    const float* xin; float* xout; const float* g1;
    __device__ __forceinline__ void operator()(const f32x4 (&acc)[2][2][4][2], const Unit& u, int wr, int wc, int fr, int fq) const {
        const int col0 = u.pn * BM + wc * 32 + 8 * fq; const int b = (u.pm * BM) >> 12;
        f32x4 gv[2][2];
#pragma unroll
        for (int bj = 0; bj < 2; ++bj)
#pragma unroll
            for (int n = 0; n < 2; ++n) gv[bj][n] = *(const f32x4*)(g1 + (size_t)b * 6144 + col0 + bj * HALF + 4 * n);
        EPI_ROWS(
            _Pragma("unroll") for (int bj = 0; bj < 2; ++bj) {
                const size_t off = (size_t)row * 1024 + col0 + bj * HALF;
                const f32x4 x0 = *(const f32x4*)(xin + off), x1 = *(const f32x4*)(xin + off + 4);
                *(f32x4*)(xout + off) = x0 + gv[bj][0] * (acc[ai][bj][m][0] * W8_INV); *(f32x4*)(xout + off + 4) = x1 + gv[bj][1] * (acc[ai][bj][m][1] * W8_INV);
            }
        )
    }
};
struct EpiGU {
    const float* bgu; bf16_t* act;
    __device__ __forceinline__ void operator()(const f32x4 (&acc)[2][2][4][2], const Unit& u, int wr, int wc, int fr, int fq) const {
        const int e = u.pn >> 3, pl = u.pn & 7; const int c0 = pl * 128 + wc * 32 + 8 * fq;
        const float* bp = bgu + (size_t)e * 2048 + c0;
        const f32x4 bg0 = *(const f32x4*)bp, bg1 = *(const f32x4*)(bp + 4), bl0 = *(const f32x4*)(bp + 1024), bl1 = *(const f32x4*)(bp + 1028);
        EPI_ROWS(
            f32x4 o[2];
            _Pragma("unroll") for (int n = 0; n < 2; ++n) {
                const f32x4 gl = acc[ai][0][m][n] + (n == 0 ? bg0 : bg1); const f32x4 ln = acc[ai][1][m][n] + (n == 0 ? bl0 : bl1);
                _Pragma("unroll") for (int j = 0; j < 4; ++j) { const float xg = fminf(gl[j], 7.0f); const float xl = fminf(fmaxf(ln[j], -7.0f), 7.0f); o[n][j] = xg * sigmoid_f(1.702f * xg) * (xl + 1.0f); }
            }
            *(u32x4*)(act + (size_t)row * 1024 + c0) = pack8(o[0], o[1]);
        )
    }
};
struct EpiGU8 {
    const float* bgu; unsigned char* act;
    __device__ __forceinline__ void operator()(const f32x4 (&acc)[2][2][4][2], const Unit& u, int wr, int wc, int fr, int fq) const {
        const int e = u.pn >> 3, pl = u.pn & 7; const int c0 = pl * 128 + wc * 32 + 8 * fq;
        const float* bp = bgu + (size_t)e * 2048 + c0;
        const f32x4 bg0 = *(const f32x4*)bp, bg1 = *(const f32x4*)(bp + 4), bl0 = *(const f32x4*)(bp + 1024), bl1 = *(const f32x4*)(bp + 1028);
        EPI_ROWS(
            f32x4 o[2];
            _Pragma("unroll") for (int n = 0; n < 2; ++n) {
                const f32x4 gl = acc[ai][0][m][n] * W8_INV + (n == 0 ? bg0 : bg1); const f32x4 ln = acc[ai][1][m][n] * W8_INV + (n == 0 ? bl0 : bl1);
                _Pragma("unroll") for (int j = 0; j < 4; ++j) { const float xg = fminf(gl[j], 7.0f); const float xl = fminf(fmaxf(ln[j], -7.0f), 7.0f); o[n][j] = xg * sigmoid_f(1.702f * xg) * (xl + 1.0f); }
            }
            *(u32x2*)(act + (size_t)row * 1024 + c0) = pack8_f8(o[0], o[1]);
        )
    }
};
struct EpiDN8 {
    const float* bdn; const float* roww; bf16_t* y;
    __device__ __forceinline__ void operator()(const f32x4 (&acc)[2][2][4][2], const Unit& u, int wr, int wc, int fr, int fq) const {
        const int e = u.pn >> 2, pl = u.pn & 3; const int col0 = pl * BM + wc * 32 + 8 * fq;
        f32x4 bv[2][2];
#pragma unroll
        for (int bj = 0; bj < 2; ++bj)
#pragma unroll
            for (int n = 0; n < 2; ++n) bv[bj][n] = *(const f32x4*)(bdn + (size_t)e * 1024 + col0 + bj * HALF + 4 * n);
        EPI_ROWS(
            const float w = roww[row];
            _Pragma("unroll") for (int bj = 0; bj < 2; ++bj)
                *(u32x4*)(y + (size_t)row * 1024 + col0 + bj * HALF) = pack8((acc[ai][bj][m][0] * W8_INV + bv[bj][0]) * w, (acc[ai][bj][m][1] * W8_INV + bv[bj][1]) * w);
        )
    }
};
struct EpiDN {
    const float* bdn; const float* roww; bf16_t* y;
    __device__ __forceinline__ void operator()(const f32x4 (&acc)[2][2][4][2], const Unit& u, int wr, int wc, int fr, int fq) const {
        const int e = u.pn >> 2, pl = u.pn & 3; const int col0 = pl * BM + wc * 32 + 8 * fq;
        f32x4 bv[2][2];
#pragma unroll
        for (int bj = 0; bj < 2; ++bj)
#pragma unroll
            for (int n = 0; n < 2; ++n) bv[bj][n] = *(const f32x4*)(bdn + (size_t)e * 1024 + col0 + bj * HALF + 4 * n);
        EPI_ROWS(
            const float w = roww[row];
            _Pragma("unroll") for (int bj = 0; bj < 2; ++bj)
                *(u32x4*)(y + (size_t)row * 1024 + col0 + bj * HALF) = pack8((acc[ai][bj][m][0] + bv[bj][0]) * w, (acc[ai][bj][m][1] + bv[bj][1]) * w);
        )
    }
};
}

namespace attn_body {
using bf16 = __hip_bfloat16;
using bf16x8 = __attribute__((ext_vector_type(8))) short;
using s16x4 = __attribute__((ext_vector_type(4))) short;
using f32x16 = __attribute__((ext_vector_type(16))) float;
using u32x4 = __attribute__((ext_vector_type(4))) unsigned;
constexpr int D = 64, NW = 8, QBLK = 32, QB = QBLK * NW, KVBLK = 64;
__device__ __forceinline__ int crow(int r, int hi) { return (r & 3) + 8 * (r >> 2) + 4 * hi; }
#define SBAR() __builtin_amdgcn_sched_barrier(0)
constexpr int NSLOT = 3, SLOTB = 8192;
constexpr int LDS_K = 0, LDS_V = NSLOT * SLOTB, LDS_WS = 2 * NSLOT * SLOTB, LDS_OST = LDS_WS + NW * 64 * 4, LDS_LUT = LDS_OST + NW * 4096, LUT_N = 768, LDS_BYTES = LDS_LUT + LUT_N * 4;
constexpr bool OB_F8 = true;
constexpr float MFLOOR = -1024.0f;
__device__ __forceinline__ void glds16(const void* gsrc, unsigned lds_dst) { unsigned keep;
  asm volatile("s_mov_b32 %0, m0\n\ts_mov_b32 m0, %2\n\ts_nop 0\n\tglobal_load_lds_dwordx4 %1, off\n\ts_mov_b32 m0, %0" : "=&s"(keep) : "v"(gsrc), "s"(lds_dst) : "memory"); }
__device__ __forceinline__ float max3f(float a, float b, float c) { float r; asm("v_max3_f32 %0, %1, %2, %3" : "=v"(r) : "v"(a), "v"(b), "v"(c)); return r; }
__device__ __forceinline__ float max2f(float a, float b) { float r; asm("v_max_f32_e32 %0, %1, %2" : "=v"(r) : "v"(a), "v"(b)); return r; }
__device__ __forceinline__ float fadd_s(float a, float b) { float r; asm("v_add_f32_e32 %0, %1, %2" : "=v"(r) : "v"(a), "v"(b)); return r; }
__device__ __forceinline__ float fsub_s(float a, float b) { float r; asm("v_sub_f32_e32 %0, %1, %2" : "=v"(r) : "v"(a), "v"(b)); return r; }
typedef float f32x2_t __attribute__((ext_vector_type(2))); typedef __bf16 bf16x2_t __attribute__((ext_vector_type(2)));
__device__ __forceinline__ unsigned cvtpk_s(float lo, float hi) { f32x2_t v = {lo, hi}; bf16x2_t b = __builtin_convertvector(v, bf16x2_t); return __builtin_bit_cast(unsigned, b); }
#define WAIT_BAR(N) asm volatile("s_waitcnt vmcnt(" #N ") lgkmcnt(0)\n\ts_barrier" ::: "memory")

__device__ __forceinline__ void qkt(f32x16& p0, f32x16& p1, const char* Kslot, const bf16x8* qr, const f32x16& negm, int r32, int hi) {
  const char* kb = Kslot + hi * 1024 + r32 * 16;
  #pragma unroll
  for (int d0 = 0; d0 < 4; ++d0) {
    const bf16x8 b0 = *reinterpret_cast<const bf16x8*>(kb + d0 * 2048);
    const bf16x8 b1 = *reinterpret_cast<const bf16x8*>(kb + d0 * 2048 + 512);
    if (d0 == 0) { p0 = __builtin_amdgcn_mfma_f32_32x32x16_bf16(b0, qr[0], negm, 0, 0, 0); p1 = __builtin_amdgcn_mfma_f32_32x32x16_bf16(b1, qr[0], negm, 0, 0, 0); }
    else { p0 = __builtin_amdgcn_mfma_f32_32x32x16_bf16(b0, qr[d0], p0, 0, 0, 0); p1 = __builtin_amdgcn_mfma_f32_32x32x16_bf16(b1, qr[d0], p1, 0, 0, 0); } }
}
typedef __attribute__((address_space(3))) const char* lds_cptr;
typedef short v4i16_t __attribute__((ext_vector_type(4)));
__device__ __forceinline__ void kload8(bf16x8* kf, lds_cptr kp) {
  kf[0] = *(const __attribute__((address_space(3))) bf16x8*)(kp);        kf[1] = *(const __attribute__((address_space(3))) bf16x8*)(kp + 512);
  kf[2] = *(const __attribute__((address_space(3))) bf16x8*)(kp + 2048); kf[3] = *(const __attribute__((address_space(3))) bf16x8*)(kp + 2560);
  kf[4] = *(const __attribute__((address_space(3))) bf16x8*)(kp + 4096); kf[5] = *(const __attribute__((address_space(3))) bf16x8*)(kp + 4608);
  kf[6] = *(const __attribute__((address_space(3))) bf16x8*)(kp + 6144); kf[7] = *(const __attribute__((address_space(3))) bf16x8*)(kp + 6656);
}
__device__ __forceinline__ void kload2(bf16x8* kf, lds_cptr kp, int j) { kf[2 * j] = *(const __attribute__((address_space(3))) bf16x8*)(kp + j * 2048); kf[2 * j + 1] = *(const __attribute__((address_space(3))) bf16x8*)(kp + j * 2048 + 512); }
__device__ __forceinline__ s16x4 vtr(lds_cptr p) { return __builtin_bit_cast(s16x4, __builtin_amdgcn_ds_read_tr16_b64_v4i16((__attribute__((address_space(3))) v4i16_t*)p)); }
__device__ __forceinline__ float rowmax(const f32x16& p0, const f32x16& p1) {
  float a = max3f(p0[0], p0[1], p1[0]), b = max3f(p0[2], p0[3], p1[1]); a = max3f(a, p1[2], p1[3]);
  #pragma unroll
  for (int r = 4; r < 16; r += 4) { a = max3f(a, p0[r], p0[r + 1]); b = max3f(b, p0[r + 2], p0[r + 3]); a = max3f(a, p1[r], p1[r + 1]); b = max3f(b, p1[r + 2], p1[r + 3]); }
  const float m = max2f(a, b);
  auto rr = __builtin_amdgcn_permlane32_swap(__float_as_uint(m), __float_as_uint(m), false, false);
  return max2f(__uint_as_float(rr[0]), __uint_as_float(rr[1]));
}
__device__ __forceinline__ void pv(f32x16* o, int vb, bf16x8 pa0, bf16x8 pa1, bf16x8 pa2, bf16x8 pa3) {
  #pragma unroll
  for (int d0 = 0; d0 < 2; ++d0) { s16x4 lo[4], hi[4];
    #pragma unroll
    for (int ks = 0; ks < 4; ++ks) {
      asm volatile("ds_read_b64_tr_b16 %0,%1 offset:%c2" : "=&v"(lo[ks]) : "v"(vb), "i"(d0 * 4096 + ks * 1024) : "memory");
      asm volatile("ds_read_b64_tr_b16 %0,%1 offset:%c2" : "=&v"(hi[ks]) : "v"(vb), "i"(d0 * 4096 + ks * 1024 + 512) : "memory"); }
    asm volatile("s_waitcnt lgkmcnt(0)" ::: "memory"); SBAR();
    #define PK(k) (bf16x8){lo[k][0], lo[k][1], lo[k][2], lo[k][3], hi[k][0], hi[k][1], hi[k][2], hi[k][3]}
    o[d0] = __builtin_amdgcn_mfma_f32_32x32x16_bf16(pa0, PK(0), o[d0], 0, 0, 0);
    o[d0] = __builtin_amdgcn_mfma_f32_32x32x16_bf16(pa1, PK(1), o[d0], 0, 0, 0);
    o[d0] = __builtin_amdgcn_mfma_f32_32x32x16_bf16(pa2, PK(2), o[d0], 0, 0, 0);
    o[d0] = __builtin_amdgcn_mfma_f32_32x32x16_bf16(pa3, PK(3), o[d0], 0, 0, 0);
    #undef PK
  }
}
struct Job { const bf16* Q; const bf16* K; const bf16* V; bf16* O; float* lse; const float* lutg; int NT, i0, kq0, dsh, cls; };
template <int MODE, int THRL, bool NOMAX = false> __device__ __forceinline__ void attn_unit(const Job& J, char* shm, const int wid_in) {
  int wid = wid_in; asm volatile("" : "+s"(wid));
  constexpr int QP = MODE == 0 ? 1024 : 256, KP = 256;
  const int lane = lane_id_asm(), tid = wid * 64 + lane, r32 = lane & 31, hi = lane >> 5;
  const bf16* Qw = J.Q + (long)(wid * QBLK) * QP;
  const bf16* Kh = J.K; const bf16* Vh = J.V;
  const unsigned lds0 = (unsigned)(uintptr_t)shm;
  float* wsf = (float*)(shm + LDS_WS) + wid * 64;
  const bf16* ksrc = Kh + (long)lane * KP + wid * 8;
  const bf16* vsrc = Vh + (long)(16 * (wid & 3) + (lane >> 2)) * KP + (wid >> 2) * 32 + (lane & 3) * 8;
  const unsigned kdst = lds0 + LDS_K + wid * 1024, vdst = lds0 + LDS_V + wid * 1024;
  #define DMA_K(t, slot) glds16(ksrc + (long)(t) * KVBLK * KP, (unsigned)__builtin_amdgcn_readfirstlane(kdst + (slot)))
  #define DMA_V(t, slot) glds16(vsrc + (long)(t) * KVBLK * KP, (unsigned)__builtin_amdgcn_readfirstlane(vdst + (slot)))
  const int vb0 = (int)(lds0 + LDS_V) + ((lane >> 4) & 1) * 32 + (lane & 3) * 8 + (4 * hi + ((lane & 15) >> 2)) * 64;
  const char* Kbase = shm + LDS_K; bf16x8 kf[8];
  const lds_cptr shm3 = (lds_cptr)shm; const lds_cptr kp0 = shm3 + LDS_K + hi * 1024 + r32 * 16; const lds_cptr vp0 = shm3 + LDS_V + ((lane >> 4) & 1) * 32 + (lane & 3) * 8 + (4 * hi + ((lane & 15) >> 2)) * 64;
  const int NT = J.NT;
  if (MODE == 1) {
    __attribute__((address_space(3))) float* lut = (__attribute__((address_space(3))) float*)(shm3 + LDS_LUT);
    lut[tid] = J.lutg[tid]; if (tid < LUT_N - 512) lut[512 + tid] = J.lutg[512 + tid];
  }
  DMA_K(0, 0); DMA_V(0, 0); DMA_K(1, SLOTB);
  bf16x8 qr[4];
  #pragma unroll
  for (int d0 = 0; d0 < 4; ++d0) qr[d0] = *reinterpret_cast<const bf16x8*>(&Qw[(long)r32 * QP + d0 * 16 + hi * 8]);
  float mhat = 0.f, l_reg = 0.f; f32x16 o[2]; o[0] = f32x16{}; o[1] = f32x16{}; f32x16 negm = f32x16{}; if (!NOMAX) asm volatile("" : "+v"(negm));
  const int qrel = wid * QBLK + r32;
  const __attribute__((address_space(3))) float* lutq = (const __attribute__((address_space(3))) float*)(shm3 + LDS_LUT) + (J.kq0 - qrel + 383 + 4 * hi);
  #define CMASK(P0, P1, t) do { if (MODE == 1) { const __attribute__((address_space(3))) float* lp_ = lutq + 64 * (t); \
      _Pragma("unroll") for (int r = 0; r < 16; ++r) { const int ko_ = (r & 3) + 8 * (r >> 2); P0[r] += lp_[ko_]; P1[r] += lp_[ko_ + 32]; } } } while (0)
  bool resc = false;
  #define START(P0, P1) do { resc = false; if (!NOMAX) { const float rm = rowmax(P0, P1); \
    const float dl = MODE == 1 ? max2f(rm, MFLOOR) : rm; mhat = fadd_s(mhat, dl); \
      _Pragma("unroll") for (int r = 0; r < 16; ++r) { P0[r] = fsub_s(P0[r], dl); P1[r] = fsub_s(P1[r], dl); } \
      _Pragma("unroll") for (int r = 0; r < 16; ++r) negm[r] = -mhat; asm volatile("" : "+v"(negm)); } \
    _Pragma("unroll") for (int r = 0; r < 16; ++r) P0[r] = __builtin_amdgcn_exp2f(P0[r]); } while (0)
  #define RESC() do { if (resc) { asm volatile("s_waitcnt lgkmcnt(0)" ::: "memory"); \
      _Pragma("unroll") for (int d_ = 0; d_ < 2; ++d_) _Pragma("unroll") for (int r = 0; r < 16; ++r) o[d_][r] *= wsf[crow(r, hi)]; } } while (0)
  f32x16 pA0, pA1, pB0, pB1;
  int sl_prev = 0, sl_cur = 0, sl_next = SLOTB;
  #define ROT() do { sl_prev = sl_cur; sl_cur = sl_next; sl_next = (sl_next == (NSLOT - 1) * SLOTB) ? 0 : sl_next + SLOTB; } while (0)
  DMA_K(2, 2 * SLOTB);
  WAIT_BAR(3);
  qkt(pA0, pA1, Kbase, qr, negm, r32, hi); asm volatile("s_nop 15\n\ts_nop 7" : "+v"(pA0), "+v"(pA1)); CMASK(pA0, pA1, 0);
  START(pA0, pA1);
  _Pragma("unroll") for (int r = 0; r < 16; ++r) pA1[r] = __builtin_amdgcn_exp2f(pA1[r]);
  WAIT_BAR(0);
  DMA_K(3, 0); DMA_V(1, SLOTB);
  ROT();
  kload8(kf, kp0 + sl_cur);
  WAIT_BAR(2);
  s16x4 vlo[8], vhi[8]; u32x4 pw0, pw1, pw2, pw3;
  #define PKW(P, B) cvtpk_s(P[B], P[B + 1])
  #define PAF(k) __builtin_bit_cast(bf16x8, pw##k)
  #define VFR(i) (bf16x8){vlo[i][0], vlo[i][1], vlo[i][2], vlo[i][3], vhi[i][0], vhi[i][1], vhi[i][2], vhi[i][3]}
  #define PIN(x) asm volatile("" : "+v"(x))
  #define MX3(a, b, c) __builtin_fmaxf(__builtin_fmaxf((a), (b)), (c))
  #define GAPA(MF, A0, A1, A2, A3, W0, W1, PW) do { MF; sacc += A0; sacc += A1; sacc += A2; sacc += A3; PIN(sacc); W0; W1; PIN(PW); SBAR(); } while (0)
  #define EX(v) __builtin_amdgcn_exp2f(v)
  #define GAPB(MF, X, B) do { MF; X[B] = EX(X[B]); X[B + 1] = EX(X[B + 1]); X[B + 2] = EX(X[B + 2]); X[B + 3] = EX(X[B + 3]); PIN(X); SBAR(); } while (0)
  #define VRD(i) do { vlo[i] = vtr(vp_ + (((i) >> 2) * 4096 + ((i) & 3) * 1024)); vhi[i] = vtr(vp_ + (((i) >> 2) * 4096 + ((i) & 3) * 1024 + 512)); } while (0)
  #define KRD(G, j) do { if (G) { kload2(kf, kp0 + sl_next, j); SBAR(); } } while (0)
  #define STEP(C0, C1, P0, P1, t, GK, GV, GL) do { SBAR(); \
    const lds_cptr vp_ = vp0 + sl_prev; \
    VRD(0); SBAR(); float sacc = (P0[0] + P0[1]); \
    GAPA(C0 = __builtin_amdgcn_mfma_f32_32x32x16_bf16(kf[0], qr[0], negm, 0, 0, 0), P0[2], P0[3], P0[4], P0[5],     pw0[0] = PKW(P0, 0), pw0[1] = PKW(P0, 2), pw0); \
    VRD(4); SBAR(); GAPA(C1 = __builtin_amdgcn_mfma_f32_32x32x16_bf16(kf[1], qr[0], negm, 0, 0, 0), P0[6], P0[7], P0[8], P0[9],     pw0[2] = PKW(P0, 4), pw0[3] = PKW(P0, 6), pw0); \
    VRD(1); SBAR(); GAPA(C0 = __builtin_amdgcn_mfma_f32_32x32x16_bf16(kf[2], qr[1], C0, 0, 0, 0),   P0[10], P0[11], P0[12], P0[13], pw1[0] = PKW(P0, 8), pw1[1] = PKW(P0, 10), pw1); \
    VRD(5); SBAR(); GAPA(C1 = __builtin_amdgcn_mfma_f32_32x32x16_bf16(kf[3], qr[1], C1, 0, 0, 0),   P0[14], P0[15], P1[0], P1[1],   pw1[2] = PKW(P0, 12), pw1[3] = PKW(P0, 14), pw1); \
    VRD(2); SBAR(); GAPA(C0 = __builtin_amdgcn_mfma_f32_32x32x16_bf16(kf[4], qr[2], C0, 0, 0, 0),   P1[2], P1[3], P1[4], P1[5],     pw2[0] = PKW(P1, 0), pw2[1] = PKW(P1, 2), pw2); \
    VRD(6); SBAR(); GAPA(C1 = __builtin_amdgcn_mfma_f32_32x32x16_bf16(kf[5], qr[2], C1, 0, 0, 0),   P1[6], P1[7], P1[8], P1[9],     pw2[2] = PKW(P1, 4), pw2[3] = PKW(P1, 6), pw2); \
    VRD(3); SBAR(); GAPA(C0 = __builtin_amdgcn_mfma_f32_32x32x16_bf16(kf[6], qr[3], C0, 0, 0, 0),   P1[10], P1[11], P1[12], P1[13], pw3[0] = PKW(P1, 8), pw3[1] = PKW(P1, 10), pw3); \
    VRD(7); SBAR(); GAPA(C1 = __builtin_amdgcn_mfma_f32_32x32x16_bf16(kf[7], qr[3], C1, 0, 0, 0),   P1[14], P1[15], 0.f, 0.f,       pw3[2] = PKW(P1, 12), pw3[3] = PKW(P1, 14), pw3); \
    l_reg += sacc; \
    if (GK) { DMA_K((t) + 3, sl_cur); } if (GV) { DMA_V((t) + 1, sl_next); } \
    CMASK(C0, C1, t); \
    if (!NOMAX) { float a = MX3(C0[0], C0[1], C1[0]), b = MX3(C0[2], C0[3], C1[1]); a = MX3(a, C1[2], C1[3]); \
      _Pragma("unroll") for (int r = 4; r < 16; r += 4) { a = MX3(a, C0[r], C0[r + 1]); b = MX3(b, C0[r + 2], C0[r + 3]); a = MX3(a, C1[r], C1[r + 1]); b = MX3(b, C1[r + 2], C1[r + 3]); } \
      float rm = __builtin_fmaxf(a, b); { auto rr = __builtin_amdgcn_permlane32_swap(__float_as_uint(rm), __float_as_uint(rm), false, false); rm = __builtin_fmaxf(__uint_as_float(rr[0]), __uint_as_float(rr[1])); } \
      resc = false; \
      if (__builtin_expect(__any(rm > (float)THRL), 0)) { const float dl = __builtin_fmaxf(rm, 0.f); mhat += dl; \
        _Pragma("unroll") for (int r = 0; r < 16; ++r) { C0[r] -= dl; C1[r] -= dl; } \
        _Pragma("unroll") for (int r = 0; r < 16; ++r) negm[r] = -mhat; asm volatile("" : "+v"(negm)); \
        const float f = __builtin_amdgcn_exp2f(-dl); l_reg *= f; if (hi == 0) wsf[r32] = f; resc = true; } } \
    SBAR(); \
    GAPB(o[0] = __builtin_amdgcn_mfma_f32_32x32x16_bf16(PAF(0), VFR(0), o[0], 0, 0, 0), C0, 0); \
    GAPB(o[1] = __builtin_amdgcn_mfma_f32_32x32x16_bf16(PAF(0), VFR(4), o[1], 0, 0, 0), C0, 4); \
    KRD(GL, 0); GAPB(o[0] = __builtin_amdgcn_mfma_f32_32x32x16_bf16(PAF(1), VFR(1), o[0], 0, 0, 0), C0, 8); \
    KRD(GL, 1); GAPB(o[1] = __builtin_amdgcn_mfma_f32_32x32x16_bf16(PAF(1), VFR(5), o[1], 0, 0, 0), C0, 12); \
    KRD(GL, 2); GAPB(o[0] = __builtin_amdgcn_mfma_f32_32x32x16_bf16(PAF(2), VFR(2), o[0], 0, 0, 0), C1, 0); \
    KRD(GL, 3); GAPB(o[1] = __builtin_amdgcn_mfma_f32_32x32x16_bf16(PAF(2), VFR(6), o[1], 0, 0, 0), C1, 4); \
    GAPB(o[0] = __builtin_amdgcn_mfma_f32_32x32x16_bf16(PAF(3), VFR(3), o[0], 0, 0, 0), C1, 8); \
    GAPB(o[1] = __builtin_amdgcn_mfma_f32_32x32x16_bf16(PAF(3), VFR(7), o[1], 0, 0, 0), C1, 12); \
    } while (0)
  int t = 1;
  for (; t + 5 < NT; t += 2) {
    STEP(pB0, pB1, pA0, pA1, t, true, true, true);     WAIT_BAR(2); RESC(); ROT();
    STEP(pA0, pA1, pB0, pB1, t + 1, true, true, true); WAIT_BAR(2); RESC(); ROT();
  }
  #define ENDW(tt) do { if ((tt) + 3 < NT) { WAIT_BAR(2); } else if ((tt) + 2 < NT) { WAIT_BAR(1); } else { WAIT_BAR(0); } } while (0)
  for (; t + 1 < NT; t += 2) {
    STEP(pB0, pB1, pA0, pA1, t, (t + 3 < NT), (t + 1 < NT), (t + 1 < NT));       ENDW(t);     RESC(); ROT();
    STEP(pA0, pA1, pB0, pB1, t + 1, (t + 4 < NT), (t + 2 < NT), (t + 2 < NT));   ENDW(t + 1); RESC(); ROT();
  }
  STEP(pB0, pB1, pA0, pA1, NT - 1, false, false, false); RESC();
  { float sacc = pB0[0] + pB0[1]; _Pragma("unroll") for (int r = 2; r < 16; ++r) sacc += pB0[r]; _Pragma("unroll") for (int r = 0; r < 16; ++r) sacc += pB1[r]; l_reg += sacc;
    pw0 = (u32x4){PKW(pB0, 0), PKW(pB0, 2), PKW(pB0, 4), PKW(pB0, 6)}; pw1 = (u32x4){PKW(pB0, 8), PKW(pB0, 10), PKW(pB0, 12), PKW(pB0, 14)}; pw2 = (u32x4){PKW(pB1, 0), PKW(pB1, 2), PKW(pB1, 4), PKW(pB1, 6)}; pw3 = (u32x4){PKW(pB1, 8), PKW(pB1, 10), PKW(pB1, 12), PKW(pB1, 14)};
    SBAR(); pv(o, vb0 + sl_cur, PAF(0), PAF(1), PAF(2), PAF(3)); }
  #undef PKW
  #undef PAF
  #undef VFR
  #undef PIN
  #undef MX3
  #undef GAPA
  #undef GAPB
  #undef EX
  #undef VRD
  #undef KRD
  #undef STEP
  #undef ENDW
  { auto rr = __builtin_amdgcn_permlane32_swap(__float_as_uint(l_reg), __float_as_uint(l_reg), false, false); l_reg = __uint_as_float(rr[0]) + __uint_as_float(rr[1]); }
  if (hi == 0) wsf[32 + r32] = l_reg; asm volatile("s_waitcnt lgkmcnt(0)" ::: "memory");
  float rli[16];
  #pragma unroll
  for (int r = 0; r < 16; ++r) rli[r] = __builtin_amdgcn_rcpf(wsf[32 + crow(r, hi)]);
  if (MODE == 0 && OB_F8) {
    unsigned char* stg8 = (unsigned char*)(shm + LDS_OST) + wid * 4096;
    #pragma unroll
    for (int r = 0; r < 16; ++r) { const int orow = crow(r, hi);
      #pragma unroll
      for (int d0 = 0; d0 < 2; ++d0) { const float ov = o[d0][r] * rli[r]; stg8[orow * 64 + d0 * 32 + r32] = (unsigned char)(__builtin_amdgcn_cvt_pk_fp8_f32(ov, ov, 0, false) & 0xff); } }
    asm volatile("s_waitcnt lgkmcnt(0)" ::: "memory");
    unsigned char* Ow = (unsigned char*)J.O + (long)(wid * QBLK) * 1024;
    #pragma unroll
    for (int i = 0; i < 2; ++i) { const int row = i * 16 + (lane >> 2), ch = lane & 3; const u32x4 v = *(const u32x4*)(stg8 + row * 64 + ch * 16); *(u32x4*)(Ow + (long)row * 1024 + ch * 16) = v; }
  } else {
    bf16* stg = (bf16*)(shm + LDS_OST) + wid * 2048;
    #pragma unroll
    for (int r = 0; r < 16; ++r) { const int orow = crow(r, hi);
      #pragma unroll
      for (int d0 = 0; d0 < 2; ++d0) stg[orow * 64 + d0 * 32 + r32] = __float2bfloat16(o[d0][r] * rli[r]); }
    asm volatile("s_waitcnt lgkmcnt(0)" ::: "memory");
    if (MODE == 0) {
      bf16* Ow = J.O + (long)(wid * QBLK) * 1024;
      #pragma unroll
      for (int i = 0; i < 4; ++i) { const int row = i * 8 + (lane >> 3), ch = lane & 7; const u32x4 v = *(const u32x4*)(stg + row * 64 + ch * 8); *(u32x4*)(Ow + (long)row * 1024 + ch * 8) = v; }
    } else {
      #pragma unroll
      for (int i = 0; i < 4; ++i) { const int row = i * 8 + (lane >> 3), ch = lane & 7; const u32x4 v = *(const u32x4*)(stg + row * 64 + ch * 8);
        const long tok = ((long)(J.i0 + wid * QBLK + row) << J.dsh) + J.cls; *(u32x4*)(J.O + tok * 256 + ch * 8) = v; }
      if (hi == 0) { const long tok = ((long)(J.i0 + qrel) << J.dsh) + J.cls; J.lse[tok * 4] = mhat + __builtin_amdgcn_logf(l_reg); }
    } }
  asm volatile("s_waitcnt lgkmcnt(0)\n\ts_barrier" ::: "memory");
  #undef DMA_K
  #undef DMA_V
  #undef CMASK
  #undef START
  #undef RESC
  #undef ROT
}
#undef SBAR
#undef WAIT_BAR
}


namespace attn8 {
typedef int i32x8 __attribute__((ext_vector_type(8)));
typedef int i32x4 __attribute__((ext_vector_type(4)));
typedef float f32x16 __attribute__((ext_vector_type(16)));
typedef unsigned u32x4 __attribute__((ext_vector_type(4)));
constexpr int SLOT = 4096, NSL = 3;
constexpr int L_K = 0, L_V = NSL * SLOT, L_WS = 2 * NSL * SLOT, L_OST = L_WS + 8 * 256, L_BYTES = L_OST + 8 * 4096;
struct Job { const unsigned char* Q; const unsigned char* K; const unsigned char* VT; unsigned char* O; };
__device__ __forceinline__ void glds16(const void* gsrc, unsigned lds_dst) { unsigned keep;
  asm volatile("s_mov_b32 %0, m0\n\ts_mov_b32 m0, %2\n\ts_nop 0\n\tglobal_load_lds_dwordx4 %1, off\n\ts_mov_b32 m0, %0" : "=&s"(keep) : "v"(gsrc), "s"(lds_dst) : "memory"); }
__device__ __forceinline__ int crow(int r, int hi) { return (r & 3) + 8 * (r >> 2) + 4 * hi; }
#define A8_WAITBAR(N) asm volatile("s_waitcnt vmcnt(" #N ") lgkmcnt(0)\n\ts_barrier" ::: "memory")
template <int NT> __device__ __forceinline__ void attn_unit_f8(const Job& J, char* shm, const int wid_in) {
  int wid = wid_in; asm volatile("" : "+s"(wid));
  const int lane = lane_id_asm(), r32 = lane & 31, hi = lane >> 5;
  const unsigned lds0 = (unsigned)(uintptr_t)shm;
  typedef __attribute__((address_space(3))) const char* lds_cptr;
  const lds_cptr shm3 = (lds_cptr)shm;
  const bool kwave = wid < 4;
  const int w4 = wid & 3; const int drow = 16 * w4 + (lane >> 2); const int cl = (lane & 3) ^ ((drow >> 2) & 3);
  const unsigned char* dsrc = kwave ? J.K + (long)drow * 256 + 16 * cl : J.VT + (long)drow * 4096 + 16 * cl;
  const long dstep = kwave ? 64 * 256 : 64;
  const unsigned ddst = lds0 + (kwave ? L_K : L_V) + w4 * 1024;
  #define A8_DMA(t, slot) glds16(dsrc + (long)(t) * dstep, (unsigned)__builtin_amdgcn_readfirstlane(ddst + (slot)))
  const int sw = (r32 >> 2) & 3; const int foff0 = r32 * 64 + 16 * ((2 * hi) ^ sw), foff1 = r32 * 64 + 16 * ((2 * hi + 1) ^ sw);
  #define A8_FRAG(base, half) __builtin_shufflevector(*(const __attribute__((address_space(3))) i32x4*)((base) + (half) * 2048 + foff0), *(const __attribute__((address_space(3))) i32x4*)((base) + (half) * 2048 + foff1), 0, 1, 2, 3, 4, 5, 6, 7)
  const unsigned char* qp = J.Q + (long)(wid * 32 + r32) * 1024 + 32 * hi;
  const i32x8 qf = __builtin_shufflevector(*(const i32x4*)qp, *(const i32x4*)(qp + 16), 0, 1, 2, 3, 4, 5, 6, 7);
  A8_DMA(0, 0); A8_DMA(1, SLOT); A8_DMA(2, 2 * SLOT);
  f32x16 o0 = f32x16{}, o1 = f32x16{}, o2 = f32x16{}; const f32x16 zero = f32x16{};
  i32x8 ones; _Pragma("unroll") for (int w = 0; w < 8; ++w) ones[w] = 0x38383838;
  f32x16 SA0, SA1, SB0, SB1; i32x8 KA0, KA1, KB0, KB1, VA0, VA1, VB0, VB1;
  A8_WAITBAR(2);
  { const i32x8 k0 = A8_FRAG(shm3 + L_K, 0), k1 = A8_FRAG(shm3 + L_K, 1);
    SA0 = __builtin_amdgcn_mfma_scale_f32_32x32x64_f8f6f4(k0, qf, zero, 0, 0, 0, 0, 0, 0); SA1 = __builtin_amdgcn_mfma_scale_f32_32x32x64_f8f6f4(k1, qf, zero, 0, 0, 0, 0, 0, 0); }
  VA0 = A8_FRAG(shm3 + L_V, 0); VA1 = A8_FRAG(shm3 + L_V, 1);
  A8_WAITBAR(1);
  if (kwave) A8_DMA(3, 0);
  KA0 = A8_FRAG(shm3 + L_K + SLOT, 0); KA1 = A8_FRAG(shm3 + L_K + SLOT, 1);
  int s_t = 0, s_t1 = SLOT, s_t2 = 2 * SLOT;
  #define A8_SB() __builtin_amdgcn_sched_barrier(0)
  #define A8_ITER(C0, C1, N0, N1, KC0, KC1, KN0, KN1, VC0, VC1, VN0, VN1, t, W, DK, DV, RK, RV, QK) do { \
    if (W) { A8_WAITBAR(1); } else { A8_WAITBAR(0); } \
    if (kwave) { if (DK) A8_DMA((t) + 4, s_t1); } else { if (DV) A8_DMA((t) + 3, s_t); } \
    if (RK) { KN0 = A8_FRAG(shm3 + L_K + s_t2, 0); KN1 = A8_FRAG(shm3 + L_K + s_t2, 1); } \
    if (RV) { VN0 = A8_FRAG(shm3 + L_V + s_t1, 0); VN1 = A8_FRAG(shm3 + L_V + s_t1, 1); } \
    if (QK) { N0 = __builtin_amdgcn_mfma_scale_f32_32x32x64_f8f6f4(KC0, qf, zero, 0, 0, 0, 0, 0, 0); N1 = __builtin_amdgcn_mfma_scale_f32_32x32x64_f8f6f4(KC1, qf, zero, 0, 0, 0, 0, 0, 0); } \
    A8_SB();     \
    _Pragma("unroll") for (int r = 0; r < 16; ++r) { C0[r] = __builtin_amdgcn_exp2f(C0[r]); C1[r] = __builtin_amdgcn_exp2f(C1[r]); } \
    i32x8 pf; \
    _Pragma("unroll") for (int w = 0; w < 4; ++w) { unsigned a = 0, b = 0; \
      a = __builtin_amdgcn_cvt_pk_bf8_f32(C0[4 * w], C0[4 * w + 1], a, false); a = __builtin_amdgcn_cvt_pk_bf8_f32(C0[4 * w + 2], C0[4 * w + 3], a, true); \
      b = __builtin_amdgcn_cvt_pk_bf8_f32(C1[4 * w], C1[4 * w + 1], b, false); b = __builtin_amdgcn_cvt_pk_bf8_f32(C1[4 * w + 2], C1[4 * w + 3], b, true); \
      pf[w] = (int)a; pf[4 + w] = (int)b; } \
    A8_SB(); \
    o0 = __builtin_amdgcn_mfma_scale_f32_32x32x64_f8f6f4(pf, VC0, o0, 1, 0, 0, 0, 0, 0); o1 = __builtin_amdgcn_mfma_scale_f32_32x32x64_f8f6f4(pf, VC1, o1, 1, 0, 0, 0, 0, 0); \
    o2 = __builtin_amdgcn_mfma_scale_f32_32x32x64_f8f6f4(pf, ones, o2, 1, 0, 0, 0, 0, 0);     \
    { const int tmp_ = s_t; s_t = s_t1; s_t1 = s_t2; s_t2 = tmp_; } \
    A8_SB(); \
  } while (0)
  #define A8_EVEN(t, W, DK, DV, RK, RV, QK) A8_ITER(SA0, SA1, SB0, SB1, KA0, KA1, KB0, KB1, VA0, VA1, VB0, VB1, t, W, DK, DV, RK, RV, QK)
  #define A8_ODD(t, W, DK, DV, RK, RV, QK)  A8_ITER(SB0, SB1, SA0, SA1, KB0, KB1, KA0, KA1, VB0, VB1, VA0, VA1, t, W, DK, DV, RK, RV, QK)
#pragma unroll 1
  for (int t = 0; t < NT - 4; t += 2) {
    A8_EVEN(t, true, true, true, true, true, true);
    A8_ODD(t + 1, true, true, true, true, true, true);
  }
  A8_EVEN(NT - 4, true, false, true, true, true, true);
  A8_ODD(NT - 3, false, false, false, true, true, true);
  A8_EVEN(NT - 2, false, false, false, false, true, true);
  A8_ODD(NT - 1, false, false, false, false, false, false);
  #undef A8_EVEN
  #undef A8_ODD
  #undef A8_ITER
  #undef A8_SB
  #undef A8_FRAG
  #undef A8_DMA
  float rli[16];
  #pragma unroll
  for (int r = 0; r < 16; ++r) rli[r] = __builtin_amdgcn_rcpf(o2[r]);
  unsigned char* stg8 = (unsigned char*)(shm + L_OST) + wid * 4096;
  #pragma unroll
  for (int r = 0; r < 16; ++r) { const int orow = crow(r, hi);
    const float a = o0[r] * rli[r], b = o1[r] * rli[r];
    stg8[orow * 64 + r32] = (unsigned char)(__builtin_amdgcn_cvt_pk_fp8_f32(a, a, 0, false) & 0xff); stg8[orow * 64 + 32 + r32] = (unsigned char)(__builtin_amdgcn_cvt_pk_fp8_f32(b, b, 0, false) & 0xff); }
  asm volatile("s_waitcnt lgkmcnt(0)" ::: "memory");
  unsigned char* Ow = J.O + (long)(wid * 32) * 1024;
  #pragma unroll
  for (int i = 0; i < 2; ++i) { const int row = i * 16 + (lane >> 2), ch = lane & 3; const u32x4 v = *(const u32x4*)(stg8 + row * 64 + ch * 16); *(u32x4*)(Ow + (long)row * 1024 + ch * 16) = v; }
  asm volatile("s_waitcnt lgkmcnt(0)\n\ts_barrier" ::: "memory");
}
#undef A8_WAITBAR
}

constexpr size_t MiB = 1u << 20;
constexpr size_t WS_CTL = 0, CTL_ZERO_BYTES = 1 * MiB;
constexpr size_t WS_MOD = 1 * MiB;
constexpr size_t WS_ROPE = WS_MOD + 512 * 1024;
constexpr size_t WS_BLUT = WS_ROPE + 8192;
constexpr size_t WS_RC0 = WS_BLUT + 12 * 768 * 4;
constexpr size_t WS_HIST = WS_RC0 + 4096;
constexpr size_t WS_TILEE = WS_HIST + 32768;
constexpr size_t WS_TOPE = 2 * MiB;
constexpr size_t WS_TOPW = WS_TOPE + 512 * 1024;
constexpr size_t WS_SLOT = WS_TOPW + 512 * 1024;
constexpr size_t WS_ROWW = WS_SLOT + 512 * 1024;
constexpr size_t WS_LSE = 5 * MiB;
constexpr size_t WS_WRHI = 7 * MiB;
constexpr size_t WS_WRLO = 8 * MiB;
constexpr size_t WS_WIN = 9 * MiB;
constexpr size_t WS_WBRA = 32 * MiB;
constexpr size_t WS_WBRB = 33 * MiB;
constexpr size_t WS_WOUT = 37 * MiB;
constexpr size_t WS_WGU = 41 * MiB;
constexpr size_t WS_WDN = 297 * MiB;
constexpr size_t WS_X = 425 * MiB;
constexpr size_t WS_H = 553 * MiB;
constexpr size_t WS_R = 617 * MiB;
constexpr size_t WS_AQKV = WS_R;
constexpr size_t WS_QB = WS_R + 144 * MiB;
constexpr size_t WS_KB = WS_R + 208 * MiB;
constexpr size_t WS_VB = WS_R + 224 * MiB;
constexpr size_t WS_GATE = WS_R + 240 * MiB;
constexpr size_t WS_OAG = WS_R + 368 * MiB;
constexpr size_t WS_OA = WS_R + 416 * MiB;
constexpr size_t WS_MERGED = WS_R + 432 * MiB;
constexpr size_t WS_XS = WS_R;
constexpr size_t WS_ACT = WS_R + 136 * MiB;
constexpr size_t WS_Y = WS_R + 272 * MiB;
constexpr size_t WS_OB = WS_R + 496 * MiB;
constexpr size_t WS_M8 = WS_R + 560 * MiB;
constexpr size_t WS_END = WS_R + 592 * MiB;
constexpr int CW_BAR = 4096;

constexpr int RING_BYTES = 133120;
constexpr int LDSCTL_OFF = RING_BYTES;
constexpr int LDS_BYTES = 147456;
constexpr int NWAVES = 8;

#define GAS __attribute__((address_space(1)))
#define LAS __attribute__((address_space(3)))
typedef unsigned short bf16;
typedef unsigned v4u __attribute__((ext_vector_type(4)));
typedef unsigned v2u __attribute__((ext_vector_type(2)));
typedef float f32x4 __attribute__((ext_vector_type(4)));
typedef float f32x16 __attribute__((ext_vector_type(16)));
typedef int i32x4 __attribute__((ext_vector_type(4)));
typedef short bf16x8 __attribute__((ext_vector_type(8)));
typedef GAS unsigned gu32;
#define RLX_AGENT __ATOMIC_RELAXED, __HIP_MEMORY_SCOPE_AGENT
#define LDS_WAIT() asm volatile("s_waitcnt lgkmcnt(0)" ::: "memory")
__device__ __forceinline__ unsigned f2bf(float f) { unsigned u = __builtin_bit_cast(unsigned, f); return (u + 0x7fffu + ((u >> 16) & 1u)) >> 16; }
__device__ __forceinline__ unsigned pk2(float lo, float hi) { return f2bf(lo) | (f2bf(hi) << 16); }
__device__ __forceinline__ float bfl(unsigned w) { return __uint_as_float(w << 16); }
__device__ __forceinline__ float bfh(unsigned w) { return __uint_as_float(w & 0xffff0000u); }

#define XB_TMO      128
#define XB_XCNT(j)  (256  + 64 * (j))
#define XB_XSUB(j)  (1280 + 64 * (j))
#define XB_XGEN(j)  (2304 + 64 * (j))
#define XB_TOP      3328
#define XB_TOPGEN   3392
#define XCD_BAR_WORDS 3456
#define XB_SPIN_CAP (1u << 18)
__device__ __forceinline__ unsigned xb_ld(unsigned* p)              { return __hip_atomic_load(p, __ATOMIC_RELAXED, __HIP_MEMORY_SCOPE_AGENT); }
__device__ __forceinline__ unsigned xb_add(unsigned* p, unsigned v) { return __hip_atomic_fetch_add(p, v, __ATOMIC_RELAXED, __HIP_MEMORY_SCOPE_AGENT); }
__device__ __forceinline__ unsigned xb_xcc_id() { return (unsigned)__builtin_amdgcn_s_getreg((3 << 11) | 20) & 0xFu; }
#define XB_SPIN(cond, bar) do { unsigned _sp = 0; while (cond) { __builtin_amdgcn_s_sleep(1); \
    if ((++_sp & 255u) == 0u) { if (xb_ld(&(bar)[XB_TMO])) break; if (_sp > XB_SPIN_CAP) { atomicAdd(&(bar)[XB_TMO], 1u); break; } } } } while (0)
struct XcdBarrier { unsigned* bar; unsigned x; volatile LAS unsigned* st; };
__device__ __forceinline__ XcdBarrier xcd_barrier_post(unsigned* bar, volatile LAS unsigned* st) {
    XcdBarrier b; b.bar = bar; b.x = xb_xcc_id(); b.st = st;
    if (threadIdx.x == 0) (void)xb_add(&bar[XB_XCNT(b.x)], 1u);
    return b;
}
__device__ __forceinline__ void xcd_barrier_complete(unsigned* bar, unsigned x, unsigned& nloc, unsigned& nx) {
    const unsigned G = gridDim.x * gridDim.y * gridDim.z;
    unsigned sum, cnt, mine, sp = 0u;
    for (;;) {
        sum = 0u; cnt = 0u; mine = 0u;
#pragma unroll
        for (unsigned j = 0; j < 16; ++j) { const unsigned c = xb_ld(&bar[XB_XCNT(j)]); sum += c; cnt += (c > 0u) ? 1u : 0u; mine = (j == x) ? c : mine; }
        if (sum == G) break;
        __builtin_amdgcn_s_sleep(1);
        if ((++sp & 255u) == 0u) { if (xb_ld(&bar[XB_TMO])) break; if (sp > XB_SPIN_CAP) { atomicAdd(&bar[XB_TMO], 1u); break; } }
    }
    nloc = mine > 0u ? mine : 1u; nx = cnt > 0u ? cnt : 1u;
}
__device__ __forceinline__ void xcd_barrier(const XcdBarrier& b) {
    asm volatile("s_waitcnt vmcnt(0)" ::: "memory");
    __syncthreads();
    if (threadIdx.x == 0) {
        unsigned* bar = b.bar;
        __builtin_amdgcn_s_waitcnt(0);
        unsigned nloc = b.st[0], nx = b.st[1];
        if (nloc == 0u) { xcd_barrier_complete(bar, b.x, nloc, nx); b.st[0] = nloc; b.st[1] = nx; }
        const unsigned old = xb_add(&bar[XB_XSUB(b.x)], 1u);
        const unsigned gen = old / nloc;
        if (old + 1u == (gen + 1u) * nloc) {
            __builtin_amdgcn_fence(__ATOMIC_RELEASE, "agent");
            asm volatile("s_waitcnt vmcnt(0)" ::: "memory");
            const unsigned og = xb_add(&bar[XB_TOP], 1u);
            const unsigned tg = og / nx;
            if (og + 1u == (tg + 1u) * nx) xb_add(&bar[XB_TOPGEN], 1u);
            else XB_SPIN(xb_ld(&bar[XB_TOPGEN]) == tg, bar);
            __builtin_amdgcn_fence(__ATOMIC_ACQUIRE, "agent");
            xb_add(&bar[XB_XGEN(b.x)], 1u);
            asm volatile("s_waitcnt vmcnt(0)" ::: "memory");
        } else {
            XB_SPIN(xb_ld(&bar[XB_XGEN(b.x)]) == gen, bar);
            __builtin_amdgcn_fence(__ATOMIC_ACQUIRE, "agent");
            asm volatile("s_waitcnt vmcnt(0)" ::: "memory");
        }
    }
    __syncthreads();
}

__device__ __forceinline__ float wave_sum(float v) {
    v = xsum<1>(v); v = xsum<2>(v); v = xsum<4>(v); v = xsum<8>(v); v = xsum<16>(v); v = xsum<32>(v);
    return v;
}
__device__ __forceinline__ void cvt_item(const float* W, int ldw, int K, int srcA, int srcB, bf16* WT, int dst_row0, int k0, LAS float* scr, int lane, bool ident = false) {
    const int kq = lane >> 4, nq = lane & 15; const int scol = (nq < 8 ? srcA + 4 * nq : srcB + 4 * (nq - 8));
    f32x4 v[16];
#pragma unroll
    for (int i = 0; i < 16; ++i) v[i] = *(const GAS f32x4*)(W + (size_t)(k0 + 4 * i + kq) * ldw + scol);
#pragma unroll
    for (int i = 0; i < 16; ++i)
#pragma unroll
        for (int e = 0; e < 4; ++e) scr[(4 * i + kq) * 65 + 4 * nq + e] = v[i][e];
    LDS_WAIT(); asm volatile("" ::: "memory");
    const int c = lane & 7, rr = lane >> 3;
#pragma unroll
    for (int j = 0; j < 8; ++j) { const int rho = rr + 8 * j; const int sc = (rho & 32) + (ident ? (rho & 31) : pg8::perm32(rho & 31)); const LAS float* s = scr + (8 * c) * 65 + sc;
        v4u o; o.x = pk2(s[0 * 65], s[1 * 65]); o.y = pk2(s[2 * 65], s[3 * 65]); o.z = pk2(s[4 * 65], s[5 * 65]); o.w = pk2(s[6 * 65], s[7 * 65]);
        *(GAS v4u*)(WT + (size_t)(dst_row0 + rho) * K + k0 + 8 * c) = o; }
    LDS_WAIT(); asm volatile("" ::: "memory");
}
__device__ __forceinline__ void cvt_item_f8(const float* W, int ldw, int K, int srcA, int srcB, unsigned char* WT, int dst_row0, int k0, LAS float* scr, int lane, bool ident = false) {
    const int kq = lane >> 4, nq = lane & 15; const int scol = (nq < 8 ? srcA + 4 * nq : srcB + 4 * (nq - 8));
    f32x4 v[16];
#pragma unroll
    for (int i = 0; i < 16; ++i) v[i] = *(const GAS f32x4*)(W + (size_t)(k0 + 4 * i + kq) * ldw + scol);
#pragma unroll
    for (int i = 0; i < 16; ++i)
#pragma unroll
        for (int e = 0; e < 4; ++e) scr[(4 * i + kq) * 65 + 4 * nq + e] = v[i][e] * pg8::W8_SCALE;
    LDS_WAIT(); asm volatile("" ::: "memory");
    const int c = lane & 7, rr = lane >> 3;
#pragma unroll
    for (int j = 0; j < 8; ++j) { const int rho = rr + 8 * j; const int sc = (rho & 32) + (ident ? (rho & 31) : pg8::perm32(rho & 31)); const LAS float* s = scr + (8 * c) * 65 + sc;
        unsigned w0 = 0, w1 = 0;
        w0 = __builtin_amdgcn_cvt_pk_fp8_f32(s[0 * 65], s[1 * 65], w0, false); w0 = __builtin_amdgcn_cvt_pk_fp8_f32(s[2 * 65], s[3 * 65], w0, true);
        w1 = __builtin_amdgcn_cvt_pk_fp8_f32(s[4 * 65], s[5 * 65], w1, false); w1 = __builtin_amdgcn_cvt_pk_fp8_f32(s[6 * 65], s[7 * 65], w1, true);
        v2u o; o.x = w0; o.y = w1; *(GAS v2u*)(WT + (size_t)(dst_row0 + rho) * K + k0 + 8 * c) = o; }
    LDS_WAIT(); asm volatile("" ::: "memory");
}
__device__ __forceinline__ int win_src(int X) { const int pn = X >> 3, bj = (X >> 2) & 1, wc = X & 3; return (pn >= 9 && pn < 14) ? pn * 256 + 64 * wc + 32 * bj : 32 * X; }
__device__ __forceinline__ int wgu_src(int X) { const int pn = X >> 3, bj = (X >> 2) & 1, wc = X & 3; return bj * 1024 + 128 * pn + 32 * wc; }

__device__ __forceinline__ void norm_row_bf16(const float* xrow, const float* g, const float* sc, const float* sh, bf16* orow, int lane) {
    const GAS f32x4* xr = (const GAS f32x4*)xrow + lane;
    f32x4 v[4]; float s = 0.f;
#pragma unroll
    for (int j = 0; j < 4; ++j) { v[j] = xr[64 * j]; s += (v[j].x * v[j].x + v[j].y * v[j].y) + (v[j].z * v[j].z + v[j].w * v[j].w); }
    const float rs = rsqrtf(wave_sum(s) * (1.0f / D) + EPS);
#pragma unroll
    for (int j = 0; j < 4; ++j) { const int c = 256 * j + 4 * lane;
        const f32x4 gg = *(const GAS f32x4*)(g + c), s1 = *(const GAS f32x4*)(sc + c), s0 = *(const GAS f32x4*)(sh + c);
        const f32x4 y = (v[j] * rs * gg) * (s1 + 1.0f) + s0;
        v2u o; o.x = pk2(y.x, y.y); o.y = pk2(y.z, y.w); *(GAS v2u*)(orow + c) = o; }
}

__device__ __forceinline__ void norm_rows2_bf16(const float* xrow, const float* g, const float* sc, const float* sh, bf16* orow, int lane) {
    const GAS f32x4* xr = (const GAS f32x4*)xrow + lane;
    f32x4 v[2][4]; float s0 = 0.f, s1 = 0.f;
#pragma unroll
    for (int j = 0; j < 4; ++j) { v[0][j] = xr[64 * j]; v[1][j] = xr[256 + 64 * j]; }
#pragma unroll
    for (int j = 0; j < 4; ++j) { s0 += (v[0][j].x * v[0][j].x + v[0][j].y * v[0][j].y) + (v[0][j].z * v[0][j].z + v[0][j].w * v[0][j].w); s1 += (v[1][j].x * v[1][j].x + v[1][j].y * v[1][j].y) + (v[1][j].z * v[1][j].z + v[1][j].w * v[1][j].w); }
    const float rs0 = rsqrtf(wave_sum(s0) * (1.0f / D) + EPS), rs1 = rsqrtf(wave_sum(s1) * (1.0f / D) + EPS);
#pragma unroll
    for (int j = 0; j < 4; ++j) { const int c = 256 * j + 4 * lane;
        const f32x4 gg = *(const GAS f32x4*)(g + c), a1 = *(const GAS f32x4*)(sc + c) + 1.0f, a0 = *(const GAS f32x4*)(sh + c);
        const f32x4 y0 = (v[0][j] * rs0 * gg) * a1 + a0, y1 = (v[1][j] * rs1 * gg) * a1 + a0;
        v2u o0; o0.x = pk2(y0.x, y0.y); o0.y = pk2(y0.z, y0.w); *(GAS v2u*)(orow + c) = o0;
        v2u o1; o1.x = pk2(y1.x, y1.y); o1.y = pk2(y1.z, y1.w); *(GAS v2u*)(orow + D + c) = o1; }
}

__device__ __forceinline__ void norm_rows2_f8(const float* xrow, const float* g, const float* sc, const float* sh, unsigned char* orow, int lane) {
    const GAS f32x4* xr = (const GAS f32x4*)xrow + lane;
    f32x4 v[2][4]; float s0 = 0.f, s1 = 0.f;
#pragma unroll
    for (int j = 0; j < 4; ++j) { v[0][j] = xr[64 * j]; v[1][j] = xr[256 + 64 * j]; }
#pragma unroll
    for (int j = 0; j < 4; ++j) { s0 += (v[0][j].x * v[0][j].x + v[0][j].y * v[0][j].y) + (v[0][j].z * v[0][j].z + v[0][j].w * v[0][j].w); s1 += (v[1][j].x * v[1][j].x + v[1][j].y * v[1][j].y) + (v[1][j].z * v[1][j].z + v[1][j].w * v[1][j].w); }
    const float rs0 = rsqrtf(wave_sum(s0) * (1.0f / D) + EPS), rs1 = rsqrtf(wave_sum(s1) * (1.0f / D) + EPS);
#pragma unroll
    for (int j = 0; j < 4; ++j) { const int c = 256 * j + 4 * lane;
        const f32x4 gg = *(const GAS f32x4*)(g + c), a1 = *(const GAS f32x4*)(sc + c) + 1.0f, a0 = *(const GAS f32x4*)(sh + c);
        const f32x4 y0 = (v[0][j] * rs0 * gg) * a1 + a0, y1 = (v[1][j] * rs1 * gg) * a1 + a0;
        unsigned w0 = 0, w1 = 0;
        w0 = __builtin_amdgcn_cvt_pk_fp8_f32(y0.x, y0.y, w0, false); w0 = __builtin_amdgcn_cvt_pk_fp8_f32(y0.z, y0.w, w0, true);
        w1 = __builtin_amdgcn_cvt_pk_fp8_f32(y1.x, y1.y, w1, false); w1 = __builtin_amdgcn_cvt_pk_fp8_f32(y1.z, y1.w, w1, true);
        *(GAS unsigned*)(orow + c) = w0; *(GAS unsigned*)(orow + D + c) = w1; }
}

__device__ __forceinline__ bool gqa_bound_ok(const float* qg, const float* kg, int lane) {
    float gq = fabsf(qg[lane]), gk = fabsf(kg[lane]);
#define MK_MAXSTEP(m) gq = fmaxf(gq, __int_as_float(__builtin_amdgcn_ds_swizzle(__float_as_int(gq), 0x1f | ((m) << 10)))); gk = fmaxf(gk, __int_as_float(__builtin_amdgcn_ds_swizzle(__float_as_int(gk), 0x1f | ((m) << 10))))
    MK_MAXSTEP(1); MK_MAXSTEP(2); MK_MAXSTEP(4); MK_MAXSTEP(8); MK_MAXSTEP(16);
#undef MK_MAXSTEP
    gq = fmaxf(gq, xget32(gq, lane >> 5)); gk = fmaxf(gk, xget32(gk, lane >> 5));
    const float bound = 64.0f * gq * gk * C2 * 1.01f; return __builtin_amdgcn_readfirstlane((int)(bound <= 14.0f)) != 0;
}

struct Args { const float* in[20]; float* out; unsigned char* ws; int ph_lo, ph_hi, li, pad; };
constexpr int N_PHASES = 2 + 10 * DEPTH;

typedef const __attribute__((address_space(4))) Args* kargs_t;
__device__ __forceinline__ kargs_t kargs_opaque() { kargs_t p = (kargs_t)__builtin_amdgcn_kernarg_segment_ptr(); asm volatile("" : "+s"(p)); return p; }
#define PH_BEGIN() kargs_t ap = kargs_opaque(); unsigned char* ws = ap->ws; (void)ws; \
    int wave = wave_s; asm volatile("" : "+s"(wave)); const int lane = lane_id_asm(); const int tid = wave * 64 + lane; (void)lane; (void)tid; \
    int bx = blockIdx.x; asm volatile("" : "+s"(bx)); int G = gridDim.x; asm volatile("" : "+s"(G)); const int vcu = (G % 8 == 0) ? (bx % 8) * (G / 8) + bx / 8 : bx; (void)vcu; \
    const int gw = vcu * NWAVES + wave, NGW = G * NWAVES; (void)gw; (void)NGW; const int gtid = vcu * (NWAVES * 64) + tid, NGT = G * NWAVES * 64; (void)gtid; (void)NGT
#define INP(k) (ap->in[k])
#define x_in INP(0)
#define c_in INP(1)
#define w_ada INP(2)
#define b_ada INP(3)
#define norm1_g INP(4)
#define w_in INP(5)
#define q_norm_g INP(6)
#define k_norm_g INP(7)
#define rel_bias INP(8)
#define w_br_a INP(9)
#define w_br_b INP(10)
#define w_out INP(11)
#define norm2_g INP(12)
#define w_router INP(13)
#define b_router INP(14)
#define w_gate_up INP(15)
#define b_gate_up INP(16)
#define w_down INP(17)
#define b_down INP(18)
#define final_g INP(19)
#define MOD ((float*)(ws + WS_MOD))
#define ROPE ((float*)(ws + WS_ROPE))
#define BLUT ((float*)(ws + WS_BLUT))
#define RC0 ((float*)(ws + WS_RC0))
#define HIST ((int*)(ws + WS_HIST))
#define TILEE ((int*)(ws + WS_TILEE))
#define TOPE ((int*)(ws + WS_TOPE))
#define TOPW ((float*)(ws + WS_TOPW))
#define SLOT ((int*)(ws + WS_SLOT))
#define ROWW ((float*)(ws + WS_ROWW))
#define LSE ((float*)(ws + WS_LSE))
#define WRHI ((bf16*)(ws + WS_WRHI))
#define WRLO ((bf16*)(ws + WS_WRLO))
#define WIN ((unsigned char*)(ws + WS_WIN))
#define WBRA ((unsigned char*)(ws + WS_WBRA))
#define WBRB ((unsigned char*)(ws + WS_WBRB))
#define WOUT ((unsigned char*)(ws + WS_WOUT))
#define WGU ((unsigned char*)(ws + WS_WGU))
#define WDN ((unsigned char*)(ws + WS_WDN))
#define X ((float*)(ws + WS_X))
#define H ((bf16*)(ws + WS_H))
#define AQKV ((bf16*)(ws + WS_AQKV))
#define QB ((bf16*)(ws + WS_QB))
#define KB ((bf16*)(ws + WS_KB))
#define VB ((bf16*)(ws + WS_VB))
#define GATE ((bf16*)(ws + WS_GATE))
#define OAG ((bf16*)(ws + WS_OAG))
#define OA ((unsigned char*)(ws + WS_OA))
#define MERGED ((bf16*)(ws + WS_MERGED))
#define OB ((unsigned char*)(ws + WS_OB))
#define M8 ((unsigned char*)(ws + WS_M8))
#define XS ((unsigned char*)(ws + WS_XS))
#define ACT ((unsigned char*)(ws + WS_ACT))
#define YB ((bf16*)(ws + WS_Y))
__global__ void __launch_bounds__(NWAVES * 64, 2) mk_fwd(Args args) {
    extern __shared__ __attribute__((aligned(16))) unsigned char lds[];
    LAS unsigned char* L = (LAS unsigned char*)lds;
    volatile LAS unsigned* MISC = (volatile LAS unsigned*)(L + LDSCTL_OFF);
    gu32* ctl = (gu32*)(args.ws + WS_CTL);
    const int wave_s = __builtin_amdgcn_readfirstlane(threadIdx.x >> 6);
    for (int u = threadIdx.x; u < (LDS_BYTES - LDSCTL_OFF) / 4; u += NWAVES * 64) ((LAS unsigned*)(L + LDSCTL_OFF))[u] = 0u;
    __syncthreads();
    XcdBarrier bar; bar.bar = (unsigned*)(ctl + CW_BAR) + args.li * XCD_BAR_WORDS; bar.x = 0; bar.st = nullptr;
    if (!MK_PER_PHASE) bar = xcd_barrier_post((unsigned*)(ctl + CW_BAR) + args.li * XCD_BAR_WORDS, MISC + 8);
    const int lo = args.ph_lo, hi = args.ph_hi;
#define IN(k) (lo <= (k) && (k) < hi)
#define KIND(q) ((PH_KIND_MASK >> (q)) & 1)
#define SEAM(k) do { if (IN(k) && IN((k) + 1)) xcd_barrier(bar); } while (0)

    for (int rep0 = 0; rep0 < 1 + PROBE_P0; ++rep0) {
    if (KIND(0) && IN(0)) { PH_BEGIN();
        {
            LAS float* cact = (LAS float*)L;
            LAS float* part = (LAS float*)(L + 32768);
            for (int i = tid; i < NB * D; i += NWAVES * 64) { const float cv = c_in[i]; cact[i] = cv / (1.0f + __expf(-cv)); }
            __syncthreads();
            for (int vb = bx; vb < 256; vb += G) {
                const int gc = vb * 48 + lane;
                const int l = gc / 6144, col = gc % 6144;
                float a[NB];
#pragma unroll
                for (int b = 0; b < NB; ++b) a[b] = 0.f;
                if (lane < 48) {
                    const float* wp = w_ada + (size_t)l * D * 6144 + col;
                    for (int k = wave * 128; k < wave * 128 + 128; ++k) { const float w = wp[(size_t)k * 6144];
#pragma unroll
                        for (int b = 0; b < NB; ++b) a[b] += cact[b * D + k] * w; }
                }
#pragma unroll
                for (int b = 0; b < NB; ++b) part[(wave * NB + b) * 64 + lane] = a[b];
                __syncthreads();
                if (tid < NB * 48) { const int b = tid / 48, cl = tid % 48; const int gc2 = vb * 48 + cl; const int l2 = gc2 / 6144, col2 = gc2 % 6144;
                    float s = b_ada[l2 * 6144 + col2];
#pragma unroll
                    for (int w = 0; w < NWAVES; ++w) s += part[(w * NB + b) * 64 + cl];
                    MOD[((size_t)l2 * NB + b) * 6144 + col2] = s; }
                __syncthreads();
            }
        }
        for (int i = gtid; i < 1024 + 12 * 768; i += NGT) {
            if (i < 1024) { const int p = i >> 4, f = i & 15; const double inv = pow(10000.0, -(double)f / 16.0); const double ang = (double)p * inv; ROPE[i] = (float)cos(ang); ROPE[1024 + i] = (float)sin(ang); }
            else { const int j = i - 1024; const int hh = j / 768, di = j % 768; const int delta = di - 383; const int g = hh >> 2; const int dil = g == 0 ? 1 : (g == 1 ? 4 : 16);
                float val = -INFINITY;
                if (delta >= -64 && delta <= 64) { const int rel = delta * dil; const int n = rel < 0 ? -rel : rel; int bk = rel > 0 ? 16 : 0;
                    if (n < 8) bk += n; else { int lg = 8 + (int)(logf((float)n / 8.0f) / logf(128.0f) * 8.0f); if (lg > 15) lg = 15; bk += lg; }
                    val = rel_bias[bk * 12 + hh] * LOG2E; }
                BLUT[j] = val; }
        }
        {
            LAS float* scr = (LAS float*)(L + wave * 16640);
            __syncthreads();
            constexpr int I_IN = 16 * 92, I_BRA = 4 * 16, I_BRB = 16 * 16, I_OUT = 16 * 16, I_GU = 16 * 32, I_DN = 16 * 16;
            constexpr int PER_L = I_IN + I_BRA + I_BRB + I_OUT;
            constexpr int NITEMS = DEPTH * PER_L + DEPTH * NE * (I_GU + I_DN);
            for (int it = gw; it < NITEMS; it += NGW) {
                int r = it;
                if (r < DEPTH * PER_L) {
                    const int l = r / PER_L; r %= PER_L;
                    if (r < I_IN) { const int kb = r / 92, g64 = r % 92; cvt_item_f8(w_in + (size_t)l * D * N_IN, N_IN, D, win_src(2 * g64), win_src(2 * g64 + 1), WIN + (size_t)l * N_IN * D, 64 * g64, 64 * kb, scr, lane, (g64 >> 2) >= 9 && (g64 >> 2) < 14); continue; } r -= I_IN;
                    if (r < I_BRA) { const int kb = r / 16, g64 = r % 16; cvt_item_f8(w_br_a + (size_t)l * 256 * D, D, 256, 64 * g64, 64 * g64 + 32, WBRA + (size_t)l * D * 256, 64 * g64, 64 * kb, scr, lane); continue; } r -= I_BRA;
                    if (r < I_BRB) { const int kb = r / 16, g64 = r % 16; cvt_item_f8(w_br_b + (size_t)l * D * D, D, D, 64 * g64, 64 * g64 + 32, WBRB + (size_t)l * D * D, 64 * g64, 64 * kb, scr, lane); continue; } r -= I_BRB;
                    { const int kb = r / 16, g64 = r % 16; cvt_item_f8(w_out + (size_t)l * D * D, D, D, 64 * g64, 64 * g64 + 32, WOUT + (size_t)l * D * D, 64 * g64, 64 * kb, scr, lane); continue; }
                }
                r -= DEPTH * PER_L;
                if (r < DEPTH * NE * I_GU) { const int le = r / I_GU; r %= I_GU; const int kb = r / 32, g64 = r % 32;
                    cvt_item_f8(w_gate_up + (size_t)le * D * 2048, 2048, D, wgu_src(2 * g64), wgu_src(2 * g64 + 1), WGU + (size_t)le * 2048 * D, 64 * g64, 64 * kb, scr, lane); continue; }
                r -= DEPTH * NE * I_GU;
                { const int le = r / I_DN; r %= I_DN; const int kb = r / 16, g64 = r % 16;
                    cvt_item_f8(w_down + (size_t)le * D * D, D, D, 64 * g64, 64 * g64 + 32, WDN + (size_t)le * D * D, 64 * g64, 64 * kb, scr, lane); }
            }
        }
    }
    SEAM(0);
    }
    if (KIND(1) && IN(1)) { PH_BEGIN();
        for (int m = 2 * gw; m < T; m += 2 * NGW) { const int b = m >> 12; const float* md = MOD + (size_t)b * 6144;
            norm_rows2_f8(x_in + (size_t)m * D, norm1_g, md + 1024, md, (unsigned char*)H + (size_t)m * D, lane); }
        for (int i = gtid; i < DEPTH * NB * NE * D; i += NGT) { const int k = i & 1023, e = (i >> 10) & 31, b = (i >> 15) & 7, l = i >> 18;
            const float v = norm2_g[l * D + k] * (1.0f + MOD[((size_t)l * NB + b) * 6144 + 4 * 1024 + k]) * w_router[((size_t)l * D + k) * NE + e];
            const unsigned hb = f2bf(v); const float lv = v - __uint_as_float(hb << 16);
            WRHI[i] = (bf16)hb; WRLO[i] = (bf16)f2bf(lv); }
        for (int i = gw; i < DEPTH * NB * NE; i += NGW) { const int e = i & 31, b = (i >> 5) & 7, l = i >> 8; float s = 0.f;
            for (int k = lane; k < D; k += 64) s += MOD[((size_t)l * NB + b) * 6144 + 3 * 1024 + k] * w_router[((size_t)l * D + k) * NE + e];
            s = wave_sum(s); if (lane == 0) RC0[i] = s + b_router[l * NE + e]; }
    }
    SEAM(1);

    for (int li = (PROBE_MASK ? -1 : 0); li < DEPTH; ++li) {
        const int l = li < 0 ? 0 : li; const bool virt = li < 0;
        const int P = 2 + 10 * l;
#define VK(q) (!virt || ((PROBE_MASK >> (q)) & 1))
        if (KIND(2) && IN(P + 0) && VK(2)) { PH_BEGIN();
            pg8::Gemm g{H, (const bf16*)(WIN + (size_t)l * N_IN * D), D / 2}; pg8::StaticOrder S; S.init(T, N_IN, G, bx);
            const bool f8attn = gqa_bound_ok(q_norm_g + l * 64, k_norm_g + l * 64, lane);
            pg8::EpiIn E{AQKV, QB, KB, VB, GATE, q_norm_g + l * 64, k_norm_g + l * 64, ROPE, pg8::W8_INV, f8attn};
            pg8::gemm_phase_f8<pg8::EpiIn, pg8::StaticOrder>(L, g, S, E, wave);
        }
        if (VK(2)) SEAM(P + 0);
        if (KIND(3) && IN(P + 1) && VK(3)) { PH_BEGIN();
            namespace ab = attn_body;
            const bool nomax = gqa_bound_ok(q_norm_g + l * 64, k_norm_g + l * 64, lane);
            for (int j = 0; j < 8; ++j) {
                const int uidx = vcu * 8 + j; if (uidx >= 2048) break;
                const int pair = uidx >> 6, idx = uidx & 63; const int b = pair >> 2, kvh = pair & 3, hq = idx >> 4, qb = idx & 15; const int h = kvh * 4 + hq;
                ab::Job J; J.Q = (const ab::bf16*)QB + ((size_t)b * SEQ + qb * 256) * 1024 + h * 64; J.K = (const ab::bf16*)KB + (size_t)b * SEQ * 256 + kvh * 64; J.V = (const ab::bf16*)VB + (size_t)b * SEQ * 256 + kvh * 64;
                J.O = (ab::bf16*)(OB + ((size_t)b * SEQ + qb * 256) * 1024 + h * 64)  ; J.lse = nullptr; J.lutg = nullptr; J.NT = 64; J.i0 = 0; J.kq0 = 0; J.dsh = 0; J.cls = 0;
                if (nomax) { attn8::Job J8; J8.Q = (const unsigned char*)QB + ((size_t)b * SEQ + qb * 256) * 1024 + h * 64; J8.K = (const unsigned char*)KB + (size_t)b * SEQ * 256 + kvh * 64;
                    J8.VT = (const unsigned char*)VB + ((size_t)((b * 4 + kvh) * 64) << 12); J8.O = OB + ((size_t)b * SEQ + qb * 256) * 1024 + h * 64;
                    attn8::attn_unit_f8<64>(J8, (char*)lds, wave); }
                else ab::attn_unit<0, 8, false>(J, (char*)lds, wave);
            }
            for (int j = 0; j < 6; ++j) {
                const int uidx = vcu * 6 + j; if (uidx >= 1536) break;
                const int g = uidx / 512, r = uidx % 512; const int b = r >> 6, hs = (r >> 4) & 3, combo = r & 15;
                const int dsh = 2 * g; const int Lc = SEQ >> dsh; const int nqb = Lc >> 8;
                const int cls = combo / nqb, qb = combo % nqb; const int i0 = qb * 256;
                int t0 = (i0 >> 6) - 1; const int ntile = Lc >> 6; const int NT = ntile >= 6 ? 6 : 4; if (t0 < 0) t0 = 0; if (t0 > ntile - NT) t0 = ntile - NT;
                const size_t cbase = (size_t)b * SEQ + (size_t)cls * Lc;
                const ab::bf16* aq = (const ab::bf16*)AQKV + (size_t)(g * 3 + 0) * T * 256; const ab::bf16* ak = (const ab::bf16*)AQKV + (size_t)(g * 3 + 1) * T * 256; const ab::bf16* av = (const ab::bf16*)AQKV + (size_t)(g * 3 + 2) * T * 256;
                ab::Job J; J.Q = aq + (cbase + i0) * 256 + hs * 64; J.K = ak + (cbase + t0 * 64) * 256 + hs * 64; J.V = av + (cbase + t0 * 64) * 256 + hs * 64;
                J.O = (ab::bf16*)OAG + (size_t)g * T * 256 + (size_t)b * SEQ * 256 + hs * 64; J.lse = LSE + (size_t)g * T * 4 + (size_t)b * SEQ * 4 + hs; J.lutg = BLUT + (g * 4 + hs) * 768;
                J.NT = NT; J.i0 = i0; J.kq0 = t0 * 64 - i0; J.dsh = dsh; J.cls = cls;
                ab::attn_unit<1, 8>(J, (char*)lds, wave);
            }
        }
        if (VK(3)) SEAM(P + 1);
        if (KIND(4) && IN(P + 2) && VK(4)) { PH_BEGIN();
            for (int i = gtid; i < T * 32; i += NGT) { const int t = i >> 5, ch = i & 31, hs = ch >> 3;
                const float l0 = LSE[(size_t)t * 4 + hs], l1 = LSE[(size_t)T * 4 + (size_t)t * 4 + hs], l2 = LSE[(size_t)2 * T * 4 + (size_t)t * 4 + hs];
                const float mx = fmaxf(l0, fmaxf(l1, l2)); float w0 = exp2f(l0 - mx), w1 = exp2f(l1 - mx), w2 = exp2f(l2 - mx); const float inv = 1.0f / (w0 + w1 + w2); w0 *= inv; w1 *= inv; w2 *= inv;
                const v4u a = *(const GAS v4u*)(OAG + (size_t)t * 256 + ch * 8), bq = *(const GAS v4u*)(OAG + (size_t)T * 256 + (size_t)t * 256 + ch * 8), cq = *(const GAS v4u*)(OAG + (size_t)2 * T * 256 + (size_t)t * 256 + ch * 8);
                unsigned o0 = 0, o1 = 0;
                o0 = __builtin_amdgcn_cvt_pk_fp8_f32(w0 * bfl(a.x) + w1 * bfl(bq.x) + w2 * bfl(cq.x), w0 * bfh(a.x) + w1 * bfh(bq.x) + w2 * bfh(cq.x), o0, false);
                o0 = __builtin_amdgcn_cvt_pk_fp8_f32(w0 * bfl(a.y) + w1 * bfl(bq.y) + w2 * bfl(cq.y), w0 * bfh(a.y) + w1 * bfh(bq.y) + w2 * bfh(cq.y), o0, true);
                o1 = __builtin_amdgcn_cvt_pk_fp8_f32(w0 * bfl(a.z) + w1 * bfl(bq.z) + w2 * bfl(cq.z), w0 * bfh(a.z) + w1 * bfh(bq.z) + w2 * bfh(cq.z), o1, false);
                o1 = __builtin_amdgcn_cvt_pk_fp8_f32(w0 * bfl(a.w) + w1 * bfl(bq.w) + w2 * bfl(cq.w), w0 * bfh(a.w) + w1 * bfh(bq.w) + w2 * bfh(cq.w), o1, true);
                v2u o; o.x = o0; o.y = o1; *(GAS v2u*)(OA + (size_t)t * 256 + ch * 8) = o; }
        }
        if (VK(4)) SEAM(P + 2);
        if (KIND(5) && IN(P + 3) && VK(5)) { PH_BEGIN();
            pg8::StaticOrder S; S.init(T, D, G, bx);
            { pg8::Gemm g{(const bf16*)OA, (const bf16*)(WBRA + (size_t)l * D * 256), 128}; pg8::EpiMergeA E{GATE, MERGED}; pg8::gemm_phase_f8<pg8::EpiMergeA, pg8::StaticOrder>(L, g, S, E, wave); }
            { pg8::Gemm g{(const bf16*)OB, (const bf16*)(WBRB + (size_t)l * D * D), D / 2}; pg8::EpiMergeB<true> E{GATE, MERGED, M8}; pg8::gemm_phase_f8<pg8::EpiMergeB<true>, pg8::StaticOrder>(L, g, S, E, wave); }
        }
        if (VK(5)) SEAM(P + 3);
        if (KIND(6) && IN(P + 4) && VK(6)) { PH_BEGIN();
            pg8::Gemm g{(const bf16*)M8, (const bf16*)(WOUT + (size_t)l * D * D), D / 2}; pg8::StaticOrder S; S.init(T, D, G, bx);
            pg8::EpiOut E{l == 0 ? x_in : X, X, MOD + (size_t)l * NB * 6144 + 2 * 1024};
            pg8::gemm_phase_f8<pg8::EpiOut, pg8::StaticOrder>(L, g, S, E, wave);
        }
        if (VK(6)) SEAM(P + 4);
        if (KIND(7) && IN(P + 5) && VK(7)) { PH_BEGIN();
            LAS int* hist = (LAS int*)(L + LDSCTL_OFF + 256);
            for (int vb = bx; vb < 256; vb += G) {
                if (tid < NE) hist[tid] = 0;
                __syncthreads();
                {
                    const int tt = vb + 256 * wave; const int r0 = tt * 16; const int b = r0 >> 12; const int i = lane & 15, kb = lane >> 4;
                    const float* xp = X + (size_t)(r0 + i) * D + 8 * kb;
                    const bf16* bh = WRHI + ((size_t)(l * NB + b) * NE + i) * D + 8 * kb; const bf16* bl = WRLO + ((size_t)(l * NB + b) * NE + i) * D + 8 * kb;
                    f32x4 acc0 = (f32x4){0.f, 0.f, 0.f, 0.f}, acc1 = acc0; float ss = 0.f;
#pragma unroll 4
                    for (int s = 0; s < 32; ++s) {
                        const f32x4 x0 = *(const GAS f32x4*)(xp + 32 * s), x1 = *(const GAS f32x4*)(xp + 32 * s + 4);
                        const bf16x8 wh0 = *(const GAS bf16x8*)(bh + 32 * s), wh1 = *(const GAS bf16x8*)(bh + 16 * D + 32 * s), wl0 = *(const GAS bf16x8*)(bl + 32 * s), wl1 = *(const GAS bf16x8*)(bl + 16 * D + 32 * s);
                        ss += (x0.x * x0.x + x0.y * x0.y) + (x0.z * x0.z + x0.w * x0.w) + (x1.x * x1.x + x1.y * x1.y) + (x1.z * x1.z + x1.w * x1.w);
                        v4u ah, al;
                        { const unsigned h0 = f2bf(x0.x), h1 = f2bf(x0.y), h2 = f2bf(x0.z), h3 = f2bf(x0.w), h4 = f2bf(x1.x), h5 = f2bf(x1.y), h6 = f2bf(x1.z), h7 = f2bf(x1.w);
                          ah.x = h0 | (h1 << 16); ah.y = h2 | (h3 << 16); ah.z = h4 | (h5 << 16); ah.w = h6 | (h7 << 16);
                          al.x = pk2(x0.x - __uint_as_float(h0 << 16), x0.y - __uint_as_float(h1 << 16)); al.y = pk2(x0.z - __uint_as_float(h2 << 16), x0.w - __uint_as_float(h3 << 16));
                          al.z = pk2(x1.x - __uint_as_float(h4 << 16), x1.y - __uint_as_float(h5 << 16)); al.w = pk2(x1.z - __uint_as_float(h6 << 16), x1.w - __uint_as_float(h7 << 16)); }
                        const bf16x8 ahv = __builtin_bit_cast(bf16x8, ah), alv = __builtin_bit_cast(bf16x8, al);
                        acc0 = __builtin_amdgcn_mfma_f32_16x16x32_bf16(wh0, ahv, acc0, 0, 0, 0); acc1 = __builtin_amdgcn_mfma_f32_16x16x32_bf16(wh1, ahv, acc1, 0, 0, 0);
                        acc0 = __builtin_amdgcn_mfma_f32_16x16x32_bf16(wl0, ahv, acc0, 0, 0, 0); acc1 = __builtin_amdgcn_mfma_f32_16x16x32_bf16(wl1, ahv, acc1, 0, 0, 0);
                        acc0 = __builtin_amdgcn_mfma_f32_16x16x32_bf16(wh0, alv, acc0, 0, 0, 0); acc1 = __builtin_amdgcn_mfma_f32_16x16x32_bf16(wh1, alv, acc1, 0, 0, 0);
                    }
                    ss = xsum<16>(ss); ss = xsum<32>(ss);
                    const float rs = rsqrtf(ss * (1.0f / D) + EPS);
                    float v[8]; const float* rc = RC0 + (l * NB + b) * NE;
#pragma unroll
                    for (int r = 0; r < 4; ++r) { v[r] = rs * acc0[r] + rc[4 * kb + r]; v[4 + r] = rs * acc1[r] + rc[16 + 4 * kb + r]; }
                    float tv[4]; int ti[4];
#pragma unroll
                    for (int k = 0; k < 4; ++k) { float best = v[0]; int br = 0;
#pragma unroll
                        for (int r = 1; r < 8; ++r) if (v[r] > best) { best = v[r]; br = r; }
#pragma unroll
                        for (int r = 0; r < 8; ++r) v[r] = (r == br) ? -INFINITY : v[r];
                        tv[k] = best; ti[k] = (br & 3) + 16 * (br >> 2) + 4 * kb; }
#pragma unroll
                    for (int round = 0; round < 2; ++round) {
                        float bv[8]; int bi[8];
#pragma unroll
                        for (int k = 0; k < 4; ++k) { bv[k] = tv[k]; bi[k] = ti[k];
                            if (round == 0) { bv[4 + k] = __int_as_float(__builtin_amdgcn_ds_swizzle(__float_as_int(tv[k]), 0x1f | (16 << 10))); bi[4 + k] = __builtin_amdgcn_ds_swizzle(ti[k], 0x1f | (16 << 10)); }
                            else { bv[4 + k] = xget32(tv[k], lane >> 5); bi[4 + k] = xget32(ti[k], lane >> 5); } }
#pragma unroll
                        for (int k = 0; k < 4; ++k) { float best = bv[0]; int bq = 0;
#pragma unroll
                            for (int r = 1; r < 8; ++r) if (bv[r] > best || (bv[r] == best && bi[r] < bi[bq])) { best = bv[r]; bq = r; }
                            int sel = bi[0];
#pragma unroll
                            for (int r = 0; r < 8; ++r) { if (r == bq) sel = bi[r]; }
#pragma unroll
                            for (int r = 0; r < 8; ++r) bv[r] = (r == bq) ? -INFINITY : bv[r];
                            tv[k] = best; ti[k] = sel; }
                    }
                    if (kb == 0) {
                        const float e1 = __expf(tv[1] - tv[0]), e2 = __expf(tv[2] - tv[0]), e3 = __expf(tv[3] - tv[0]); const float inv = 1.0f / (1.0f + e1 + e2 + e3);
                        const int tok = r0 + i;
                        *(GAS i32x4*)(TOPE + (size_t)tok * 4) = (i32x4){ti[0], ti[1], ti[2], ti[3]};
                        *(GAS f32x4*)(TOPW + (size_t)tok * 4) = (f32x4){inv, e1 * inv, e2 * inv, e3 * inv};
#pragma unroll
                        for (int k = 0; k < 4; ++k) atomicAdd((int*)&hist[ti[k]], 1);
                    }
                }
                __syncthreads();
                if (tid < NE) HIST[vb * NE + tid] = hist[tid];
                __syncthreads();
            }
            for (int m = 2 * gw; m < T; m += 2 * NGW) { const int b = m >> 12; const float* md = MOD + ((size_t)l * NB + b) * 6144;
                norm_rows2_f8(X + (size_t)m * D, norm2_g + l * D, md + 4 * 1024, md + 3 * 1024, (unsigned char*)H + (size_t)m * D, lane); }
        }
        if (VK(7)) SEAM(P + 5);
        if (KIND(8) && IN(P + 6) && VK(8)) { PH_BEGIN();
            LAS int* sm = (LAS int*)L;
            for (int vb = bx; vb < 256; vb += G) {
                { const int e = tid & 31, seg = tid >> 5; int tot = 0, bef = 0;
                    for (int q = seg * 16; q < seg * 16 + 16; ++q) { const int hv = HIST[q * NE + e]; tot += hv; if (q < vb) bef += hv; }
                    sm[tid] = tot; sm[512 + tid] = bef; }
                __syncthreads();
                if (tid < NE) { int tot = 0, bef = 0;
                    for (int s = 0; s < 16; ++s) { tot += sm[s * 32 + tid]; bef += sm[512 + s * 32 + tid]; }
                    sm[1024 + tid] = bef; sm[1056 + tid] = (tot + 255) & ~255; }
                __syncthreads();
                if (tid == 0) { int run = 0; for (int e = 0; e < NE; ++e) { const int pd = sm[1056 + e]; sm[1056 + e] = run; sm[1024 + e] += run;
                        if (vb == 0) { for (int q = run >> 8; q < (run + pd) >> 8; ++q) TILEE[q] = e; }
                        run += pd; }
                    if (vb == 0) TILEE[1000] = run >> 8; }
                __syncthreads();
                if (tid < 128) { const int tt = vb + 256 * (tid >> 4); const int tok = tt * 16 + (tid & 15);
                    const i32x4 te = *(const GAS i32x4*)(TOPE + (size_t)tok * 4); const f32x4 tw = *(const GAS f32x4*)(TOPW + (size_t)tok * 4);
                    const int s0 = atomicAdd((int*)&sm[1024 + te.x], 1), s1 = atomicAdd((int*)&sm[1024 + te.y], 1), s2 = atomicAdd((int*)&sm[1024 + te.z], 1), s3 = atomicAdd((int*)&sm[1024 + te.w], 1);
                    *(GAS i32x4*)(SLOT + (size_t)tok * 4) = (i32x4){s0, s1, s2, s3};
                    ROWW[s0] = tw.x; ROWW[s1] = tw.y; ROWW[s2] = tw.z; ROWW[s3] = tw.w;
                    sm[2048 + tid * 4 + 0] = s0; sm[2048 + tid * 4 + 1] = s1; sm[2048 + tid * 4 + 2] = s2; sm[2048 + tid * 4 + 3] = s3; }
                __syncthreads();
                for (int p = wave; p < 512; p += NWAVES) { const int q = p >> 2; const int tt = vb + 256 * (q >> 4); const int tok = tt * 16 + (q & 15); const int slot = sm[2048 + p];
                    const GAS v4u* src = (const GAS v4u*)((unsigned char*)H + (size_t)tok * D); GAS v4u* dst = (GAS v4u*)(XS + (size_t)slot * D);
                    dst[lane] = src[lane]; }
                __syncthreads();
            }
        }
        if (VK(8)) SEAM(P + 6);
        if (KIND(9) && IN(P + 7) && VK(9)) { PH_BEGIN();
            const int nmt = __builtin_amdgcn_readfirstlane(__hip_atomic_load(TILEE + 1000, __ATOMIC_RELAXED, __HIP_MEMORY_SCOPE_AGENT));
            pg8::Gemm g{(const bf16*)XS, (const bf16*)(WGU + (size_t)l * NE * 2048 * D), D / 2}; pg8::MoeOrder S{TILEE, nmt * 8, 8, G, vcu};
            pg8::EpiGU8 E{b_gate_up + (size_t)l * NE * 2048, ACT};
            pg8::gemm_phase_f8<pg8::EpiGU8, pg8::MoeOrder>(L, g, S, E, wave);
        }
        if (VK(9)) SEAM(P + 7);
        if (KIND(10) && IN(P + 8) && VK(10)) { PH_BEGIN();
            const int nmt = __builtin_amdgcn_readfirstlane(__hip_atomic_load(TILEE + 1000, __ATOMIC_RELAXED, __HIP_MEMORY_SCOPE_AGENT));
            pg8::Gemm g{(const bf16*)ACT, (const bf16*)(WDN + (size_t)l * NE * D * D), D / 2}; pg8::MoeOrder S{TILEE, nmt * 4, 4, G, vcu};
            pg8::EpiDN8 E{b_down + (size_t)l * NE * D, ROWW, YB};
            pg8::gemm_phase_f8<pg8::EpiDN8, pg8::MoeOrder>(L, g, S, E, wave);
        }
        if (VK(10)) SEAM(P + 8);
        if (KIND(11) && IN(P + 9) && VK(11)) { PH_BEGIN();
            const bool lastl = (l == DEPTH - 1);
            float* Xw = virt ? (float*)(ws + WS_R) : X; bf16* Hw = virt ? (bf16*)(ws + WS_R + 128 * MiB) : H;
            for (int m0 = 2 * gw; m0 < T; m0 += 2 * NGW) { const int b = m0 >> 12;
                i32x4 sl[2];
#pragma unroll
                for (int q = 0; q < 2; ++q) { const int* sp = SLOT + (size_t)(m0 + q) * 4;
                    sl[q].x = __hip_atomic_load(sp + 0, RLX_AGENT); sl[q].y = __hip_atomic_load(sp + 1, RLX_AGENT); sl[q].z = __hip_atomic_load(sp + 2, RLX_AGENT); sl[q].w = __hip_atomic_load(sp + 3, RLX_AGENT); }
                const float* g2 = MOD + ((size_t)l * NB + b) * 6144 + 5 * 1024;
                f32x4 v[2][4]; v2u yy[2][4][4];
#pragma unroll
                for (int q = 0; q < 2; ++q)
#pragma unroll
                    for (int j = 0; j < 4; ++j) { const int c = 256 * j + 4 * lane;
                        v[q][j] = *(const GAS f32x4*)(X + (size_t)(m0 + q) * D + c);
                        yy[q][j][0] = *(const GAS v2u*)(YB + (size_t)sl[q].x * D + c); yy[q][j][1] = *(const GAS v2u*)(YB + (size_t)sl[q].y * D + c);
                        yy[q][j][2] = *(const GAS v2u*)(YB + (size_t)sl[q].z * D + c); yy[q][j][3] = *(const GAS v2u*)(YB + (size_t)sl[q].w * D + c); }
                float s[2] = {0.f, 0.f};
#pragma unroll
                for (int q = 0; q < 2; ++q)
#pragma unroll
                    for (int j = 0; j < 4; ++j) { const int c = 256 * j + 4 * lane; const v2u y0 = yy[q][j][0], y1 = yy[q][j][1], y2 = yy[q][j][2], y3 = yy[q][j][3];
                        f32x4 ys; ys.x = (bfl(y0.x) + bfl(y1.x)) + (bfl(y2.x) + bfl(y3.x)); ys.y = (bfh(y0.x) + bfh(y1.x)) + (bfh(y2.x) + bfh(y3.x));
                        ys.z = (bfl(y0.y) + bfl(y1.y)) + (bfl(y2.y) + bfl(y3.y)); ys.w = (bfh(y0.y) + bfh(y1.y)) + (bfh(y2.y) + bfh(y3.y));
                        const f32x4 gg = *(const GAS f32x4*)(g2 + c);
                        v[q][j] = v[q][j] + gg * ys;
                        if (!lastl) *(GAS f32x4*)(Xw + (size_t)(m0 + q) * D + c) = v[q][j];
                        s[q] += (v[q][j].x * v[q][j].x + v[q][j].y * v[q][j].y) + (v[q][j].z * v[q][j].z + v[q][j].w * v[q][j].w); }
                const float rs0 = rsqrtf(wave_sum(s[0]) * (1.0f / D) + EPS), rs1 = rsqrtf(wave_sum(s[1]) * (1.0f / D) + EPS);
                if (!lastl) { const float* md = MOD + ((size_t)(l + 1) * NB + b) * 6144; const float* gn = norm1_g + (l + 1) * D;
#pragma unroll
                    for (int j = 0; j < 4; ++j) { const int c = 256 * j + 4 * lane;
                        const f32x4 gg = *(const GAS f32x4*)(gn + c), a1 = *(const GAS f32x4*)(md + 1024 + c) + 1.0f, a0 = *(const GAS f32x4*)(md + c);
                        const f32x4 y0 = (v[0][j] * rs0 * gg) * a1 + a0, y1 = (v[1][j] * rs1 * gg) * a1 + a0;
                        unsigned w0 = 0, w1 = 0;
                        w0 = __builtin_amdgcn_cvt_pk_fp8_f32(y0.x, y0.y, w0, false); w0 = __builtin_amdgcn_cvt_pk_fp8_f32(y0.z, y0.w, w0, true);
                        w1 = __builtin_amdgcn_cvt_pk_fp8_f32(y1.x, y1.y, w1, false); w1 = __builtin_amdgcn_cvt_pk_fp8_f32(y1.z, y1.w, w1, true);
                        *(GAS unsigned*)((unsigned char*)Hw + (size_t)m0 * D + c) = w0; *(GAS unsigned*)((unsigned char*)Hw + (size_t)(m0 + 1) * D + c) = w1; }
                } else {
#pragma unroll
                    for (int j = 0; j < 4; ++j) { const int c = 256 * j + 4 * lane; const f32x4 gg = *(const GAS f32x4*)(final_g + c);
                        *(GAS f32x4*)(ap->out + (size_t)m0 * D + c) = v[0][j] * rs0 * gg; *(GAS f32x4*)(ap->out + (size_t)(m0 + 1) * D + c) = v[1][j] * rs1 * gg; }
                }
            }
        }
        if (VK(11)) SEAM(P + 9);
        if (virt) { PH_BEGIN();
            for (int m = 2 * gw; m < T; m += 2 * NGW) { const int b = m >> 12; const float* md = MOD + (size_t)b * 6144; norm_rows2_f8(x_in + (size_t)m * D, norm1_g, md + 1024, md, (unsigned char*)H + (size_t)m * D, lane); }
            xcd_barrier(bar); }
    }
#undef IN
#undef SEAM
}

extern "C" void kernel_launch(void* const* d_in, const int* in_sizes, int n_in, void* d_out, int out_size, void* d_ws, size_t ws_size, hipStream_t stream) {
    static int grid = 0;
    if (grid == 0) {
        if (n_in != 20 || in_sizes[0] != T * D || out_size != T * D || ws_size < WS_END) { fprintf(stderr, "kernel_launch: unexpected shapes (n_in %d, in0 %d, out %d, ws %zu < %zu); nothing launched\n", n_in, n_in > 0 ? in_sizes[0] : -1, out_size, ws_size, (size_t)WS_END); grid = -1; return; }
        int dev = 0, cus = 0, per_cu = 0;
        if (hipGetDevice(&dev) != hipSuccess || hipDeviceGetAttribute(&cus, hipDeviceAttributeMultiprocessorCount, dev) != hipSuccess) { grid = -1; return; }
        if (hipFuncSetAttribute((const void*)mk_fwd, hipFuncAttributeMaxDynamicSharedMemorySize, LDS_BYTES) != hipSuccess) { fprintf(stderr, "kernel_launch: hipFuncSetAttribute failed\n"); grid = -1; return; }
        if (hipOccupancyMaxActiveBlocksPerMultiprocessor(&per_cu, (const void*)mk_fwd, NWAVES * 64, LDS_BYTES) != hipSuccess || per_cu < 1)
            fprintf(stderr, "kernel_launch: note: occupancy query reports %d workgroups per CU\n", per_cu);
        (void)hipGetLastError();
        grid = cus < 256 ? cus : 256;
        if (grid != 256) fprintf(stderr, "kernel_launch: %d CUs; this kernel's unit deals assume 256\n", grid);
    }
    if (grid < 0) return;
    if (hipMemsetAsync((char*)d_ws + WS_CTL, 0, CTL_ZERO_BYTES, stream) != hipSuccess) { fprintf(stderr, "kernel_launch: memset failed\n"); return; }
    Args a{};
    for (int i = 0; i < 20; ++i) a.in[i] = (const float*)d_in[i];
    a.out = (float*)d_out; a.ws = (unsigned char*)d_ws; a.pad = 0;
#if MK_PER_PHASE
    for (int p = 0; p < N_PHASES; ++p) { a.ph_lo = p; a.ph_hi = p + 1; a.li = 0; hipLaunchKernelGGL(mk_fwd, dim3(grid), dim3(NWAVES * 64), LDS_BYTES, stream, a); }
#else
    a.ph_lo = 0; a.ph_hi = N_PHASES; a.li = 0;
    hipLaunchKernelGGL(mk_fwd, dim3(grid), dim3(NWAVES * 64), LDS_BYTES, stream, a);
#endif
    const hipError_t le = hipPeekAtLastError();
    if (le != hipSuccess) fprintf(stderr, "kernel_launch: launch failed: %s\n", hipGetErrorName(le));
}
```

```cpp
#include <hip/hip_runtime.h>
#include <hip/hip_bf16.h>
#include <cstdio>
#include <cstdint>
#include <cmath>

#ifndef PH_KIND_MASK
#define PH_KIND_MASK 0xFFF
#endif
#ifndef PROBE_MASK
#define PROBE_MASK 0
#endif
#ifndef PROBE_P0
#define PROBE_P0 0
#endif
#ifndef MK_PER_PHASE
#define MK_PER_PHASE 0
#endif

constexpr int NB = 8, SEQ = 4096, T = NB * SEQ, D = 1024, DEPTH = 2;
constexpr int N_IN = 5888, NE = 32, TOPK = 4;
constexpr int NASSIGN = T * TOPK;
constexpr int MAX_MT = NASSIGN / 256 + NE;
constexpr int CAP_ROWS = MAX_MT * 256;
constexpr float C2 = 0.125f * 1.4426950408889634f;
constexpr float LOG2E = 1.4426950408889634f;
constexpr float EPS = 1e-6f;

__device__ __forceinline__ int lane_id_asm() { int l; asm volatile("v_mbcnt_lo_u32_b32 %0, -1, 0\n\tv_mbcnt_hi_u32_b32 %0, -1, %0" : "=v"(l)); return l; }

template <int M> __device__ __forceinline__ float xsum(float v) {
    if constexpr (M < 32) return v + __int_as_float(__builtin_amdgcn_ds_swizzle(__float_as_int(v), 0x1f | (M << 10)));
    else { auto rr = __builtin_amdgcn_permlane32_swap(__float_as_uint(v), __float_as_uint(v), false, false); return __uint_as_float(rr[0]) + __uint_as_float(rr[1]); }
}
template <class Tv> __device__ __forceinline__ Tv xget32(Tv v, int hf) {
    auto rr = __builtin_amdgcn_permlane32_swap(__builtin_bit_cast(unsigned, v), __builtin_bit_cast(unsigned, v), false, false); return __builtin_bit_cast(Tv, hf ? rr[0] : rr[1]);
}

namespace pg8 {
#define PG8_LAS __attribute__((address_space(3)))
typedef unsigned short bf16_t;
typedef short bf16x8 __attribute__((ext_vector_type(8)));
typedef float f32x4 __attribute__((ext_vector_type(4)));
typedef unsigned u32x4 __attribute__((ext_vector_type(4)));
typedef unsigned u32x2 __attribute__((ext_vector_type(2)));
constexpr int BM = 256, BK = 64, HALF = 128, HTB = HALF * BK * 2, STAGE_BYTES = 8 * HTB, NXCD = 8, WGM = 8;

__host__ __device__ __forceinline__ int lds_byte(int r, int c) { const int st = (r >> 4) * 2 + (c >> 5), rr = r & 15, cc = c & 31, ob = rr * 64 + cc * 2; return st * 1024 + (ob ^ (((ob >> 9) & 1) << 5)); }
__host__ __device__ __forceinline__ void stage_rc(int b, int& R, int& C) { const int st = b / 1024, sb = b % 1024, swz = sb ^ (((sb >> 9) & 1) << 5); R = (st >> 1) * 16 + swz / 64; C = (st & 1) * 32 + (swz % 64) / 2; }
__host__ __device__ __forceinline__ int perm32(int rho) { const int n = rho >> 4, i = rho & 15; return 8 * (i >> 2) + 4 * n + (i & 3); }

struct Unit { int pm, pn; };
struct Gemm { const bf16_t* A; const bf16_t* Bt; int K; };

struct StaticOrder {
    int nM, nN, nwg, G, c;
    __device__ void init(int M, int N, int G_, int c_) { nM = M / BM; nN = N / BM; nwg = nM * nN; G = G_; c = c_; }
    __device__ bool next(int i, Unit& u) const {
        const long L = (long)i * G + c; if (L >= nwg) return false;
        int wgid = (int)L; { const int q = nwg / NXCD, r = nwg % NXCD, xcd = wgid % NXCD, off = wgid / NXCD; wgid = (xcd < r ? xcd * (q + 1) : r * (q + 1) + (xcd - r) * q) + off; }
        const int nig = WGM * nN, gid = wgid / nig, fm = gid * WGM, gsz = (nM - fm) < WGM ? (nM - fm) : WGM;
        u.pm = fm + ((wgid % nig) % gsz); u.pn = (wgid % nig) / gsz; return true;
    }
};
struct MoeOrder {
    const int* tile_e; int n_units, nN, G, vcu;
    __device__ bool next(int i, Unit& u) const {
        const long L = (long)i * G + vcu; if (L >= n_units) return false;
        const int mt = (int)L / nN, pl = (int)L % nN; const int e = __builtin_amdgcn_readfirstlane(__hip_atomic_load(tile_e + mt, __ATOMIC_RELAXED, __HIP_MEMORY_SCOPE_AGENT));
        u.pm = mt; u.pn = e * nN + pl; return true;
    }
};

__device__ __forceinline__ unsigned cvt_pk_bf16(float lo, float hi) { unsigned r; asm volatile("v_cvt_pk_bf16_f32 %0, %1, %2" : "=v"(r) : "v"(lo), "v"(hi)); return r; }
__device__ __forceinline__ float bf_lo(unsigned w) { return __uint_as_float(w << 16); }
__device__ __forceinline__ float bf_hi(unsigned w) { return __uint_as_float(w & 0xffff0000u); }
__device__ __forceinline__ float sigmoid_f(float x) { return __builtin_amdgcn_rcpf(1.0f + __builtin_amdgcn_exp2f(-LOG2E * x)); }

template <class Epi, class Sched>
__device__ __forceinline__ void gemm_phase(PG8_LAS unsigned char* lds, const Gemm g, const Sched& S, const Epi& E, const int wid_in) {
    int wid = wid_in; asm volatile("" : "+s"(wid));
    const int lane = lane_id_asm(), tid = wid * 64 + lane, wr = wid >> 2, wc = wid & 3, fr = lane & 15, fq = lane >> 4;
    int K_o = g.K; asm volatile("" : "+s"(K_o)); const int K = K_o, nt = K / BK;
    unsigned voff[2];
#pragma unroll
    for (int i = 0; i < 2; ++i) { int R, C; stage_rc(tid * 16 + i * 8192, R, C); voff[i] = (unsigned)(R * K + C) * 2u; }
    const size_t kstep = (size_t)(BK * 2);
    const size_t hstep = (size_t)HALF * K * 2;
    const size_t tstep = 2 * hstep;
    const unsigned ldsw = (unsigned)wid * 1024u;
    const int aoff = lds_byte(wr * 64 + fr, fq * 8), boff = lds_byte(wc * 32 + fr, fq * 8);
#define PG8_SA(b, h) (((b) * 2 + (h)) * HTB)
#define PG8_SB(b, h) ((4 + (b) * 2 + (h)) * HTB)
#define PG8_STAGE(bufoff, gbase) do { _Pragma("unroll") for (int _i = 0; _i < 2; ++_i) \
        __builtin_amdgcn_global_load_lds((const unsigned*)((const char*)(gbase) + voff[_i]), (PG8_LAS unsigned*)(lds + (bufoff) + ldsw + _i * 8192), 16, 0, 0); } while (0)
#define PG8_LDA(dst, b, h) do { _Pragma("unroll") for (int m = 0; m < 4; ++m) _Pragma("unroll") for (int k = 0; k < 2; ++k) dst[m][k] = *(const PG8_LAS bf16x8*)(lds + PG8_SA(b, h) + aoff + m * 2048 + k * 1024); } while (0)
#define PG8_LDB(dst, b, h) do { _Pragma("unroll") for (int n = 0; n < 2; ++n) _Pragma("unroll") for (int k = 0; k < 2; ++k) dst[n][k] = *(const PG8_LAS bf16x8*)(lds + PG8_SB(b, h) + boff + n * 2048 + k * 1024); } while (0)
#define PG8_MMA(ai, bj, At, Bt) do { __builtin_amdgcn_s_setprio(1); _Pragma("unroll") for (int m = 0; m < 4; ++m) _Pragma("unroll") for (int n = 0; n < 2; ++n) _Pragma("unroll") for (int k = 0; k < 2; ++k) \
        acc[ai][bj][m][n] = __builtin_amdgcn_mfma_f32_16x16x32_bf16(Bt[n][k], At[m][k], acc[ai][bj][m][n], 0, 0, 0); __builtin_amdgcn_s_setprio(0); } while (0)
#define PG8_WAIT_V(n) asm volatile("s_waitcnt vmcnt(" #n ")" ::: "memory")
#define PG8_WAIT_L(n) asm volatile("s_waitcnt lgkmcnt(" #n ")" ::: "memory")
#define PG8_BAR __builtin_amdgcn_s_barrier()
#define PG8_SCHED __builtin_amdgcn_sched_barrier(0)
    Unit cur, nxt; int ui = 0;
    if (!S.next(0, cur)) return;
    f32x4 acc[2][2][4][2];
#pragma unroll
    for (int a = 0; a < 2; ++a)
#pragma unroll
        for (int b = 0; b < 2; ++b)
#pragma unroll
            for (int m = 0; m < 4; ++m)
#pragma unroll
                for (int n = 0; n < 2; ++n) acc[a][b][m][n] = (f32x4){0.f, 0.f, 0.f, 0.f};
    bf16x8 At[4][2], B0[2][2], B1[2][2];
    const char* cA = (const char*)g.A + (size_t)cur.pm * tstep; const char* cB = (const char*)g.Bt + (size_t)cur.pn * tstep;
    PG8_STAGE(PG8_SB(0, 0), cB); PG8_STAGE(PG8_SB(0, 1), cB + hstep); PG8_STAGE(PG8_SA(0, 0), cA); PG8_STAGE(PG8_SA(0, 1), cA + hstep);
    if (wr == 1) PG8_BAR;
    PG8_WAIT_V(2); PG8_BAR;
    PG8_STAGE(PG8_SB(1, 0), cB + kstep); PG8_STAGE(PG8_SA(1, 0), cA + kstep); PG8_STAGE(PG8_SB(1, 1), cB + hstep + kstep);
    PG8_WAIT_V(6); PG8_BAR;
    for (;;) {
        const bool has_next = S.next(ui + 1, nxt);
        const char* nA = has_next ? (const char*)g.A + (size_t)nxt.pm * tstep : cA; const char* nB = has_next ? (const char*)g.Bt + (size_t)nxt.pn * tstep : cB;
        for (int t = 0; t < nt; t += 2) {
            const bool last = (t == nt - 2);
            const char* a1 = cA + (size_t)(t + 1) * kstep;
            const char* a2 = last ? nA : cA + (size_t)(t + 2) * kstep; const char* b2 = last ? nB : cB + (size_t)(t + 2) * kstep;
            const char* a3 = a2 + kstep; const char* b3 = b2 + kstep;
            PG8_LDB(B0, 0, 0); PG8_LDB(B1, 0, 1); PG8_SCHED; PG8_LDA(At, 0, 0); PG8_STAGE(PG8_SA(1, 1), a1 + hstep);
            PG8_WAIT_V(8); PG8_WAIT_L(0); PG8_BAR; PG8_MMA(0, 0, At, B0); PG8_MMA(0, 1, At, B1); PG8_BAR; PG8_SCHED;
            PG8_LDA(At, 0, 1); PG8_STAGE(PG8_SB(0, 0), b2); PG8_STAGE(PG8_SB(0, 1), b2 + hstep); PG8_STAGE(PG8_SA(0, 0), a2);
            PG8_WAIT_V(8); PG8_WAIT_L(0); PG8_BAR; PG8_MMA(1, 0, At, B0); PG8_MMA(1, 1, At, B1); PG8_BAR; PG8_SCHED;
            PG8_LDB(B0, 1, 0); PG8_LDB(B1, 1, 1); PG8_SCHED; PG8_LDA(At, 1, 0); PG8_STAGE(PG8_SA(0, 1), a2 + hstep);
            PG8_WAIT_V(8); PG8_WAIT_L(0); PG8_BAR; PG8_MMA(0, 0, At, B0); PG8_MMA(0, 1, At, B1); PG8_BAR; PG8_SCHED;
            PG8_LDA(At, 1, 1); PG8_STAGE(PG8_SB(1, 0), b3); PG8_STAGE(PG8_SB(1, 1), b3 + hstep); PG8_STAGE(PG8_SA(1, 0), a3);
            PG8_WAIT_V(8); PG8_WAIT_L(0); PG8_BAR; PG8_MMA(1, 0, At, B0); PG8_MMA(1, 1, At, B1); PG8_BAR; PG8_SCHED;
        }
        if (wr == 0) PG8_BAR;
        E(acc, cur, wr, wc, fr, fq);
        if (!has_next) break;
#pragma unroll
        for (int a = 0; a < 2; ++a)
#pragma unroll
            for (int b = 0; b < 2; ++b)
#pragma unroll
                for (int m = 0; m < 4; ++m)
#pragma unroll
                    for (int n = 0; n < 2; ++n) acc[a][b][m][n] = (f32x4){0.f, 0.f, 0.f, 0.f};
        cur = nxt; cA = nA; cB = nB; ++ui;
        if (wr == 1) PG8_BAR;
    }
    PG8_WAIT_V(0);
    PG8_BAR;
#undef PG8_SA
#undef PG8_SB
#undef PG8_STAGE
#undef PG8_LDA
#undef PG8_LDB
#undef PG8_MMA
#undef PG8_WAIT_V
#undef PG8_WAIT_L
#undef PG8_BAR
#undef PG8_SCHED
}

typedef int i32x4_t __attribute__((ext_vector_type(4)));
template <class Epi, class Sched>
__device__ __forceinline__ void gemm_phase_f8(PG8_LAS unsigned char* lds, const Gemm g, const Sched& S, const Epi& E, const int wid_in) {
    int wid = wid_in; asm volatile("" : "+s"(wid));
    const int lane = lane_id_asm(), tid = wid * 64 + lane, wr = wid >> 2, wc = wid & 3, fr = lane & 15, fq = lane >> 4;
    int K_o = g.K; asm volatile("" : "+s"(K_o)); const int K = K_o, nt = K / BK;
    unsigned voff[2];
#pragma unroll
    for (int i = 0; i < 2; ++i) { int R, C; stage_rc(tid * 16 + i * 8192, R, C); voff[i] = (unsigned)(R * K + C) * 2u; }
    const size_t kstep = (size_t)(BK * 2);
    const size_t hstep = (size_t)HALF * K * 2;
    const size_t tstep = 2 * hstep;
    const unsigned ldsw = (unsigned)wid * 1024u;
    const int aoff = lds_byte(wr * 64 + fr, fq * 16), boff = lds_byte(wc * 32 + fr, fq * 16);
#define PG8_SA(b, h) (((b) * 2 + (h)) * HTB)
#define PG8_SB(b, h) ((4 + (b) * 2 + (h)) * HTB)
#define PG8_STAGE(bufoff, gbase) do { _Pragma("unroll") for (int _i = 0; _i < 2; ++_i) \
        __builtin_amdgcn_global_load_lds((const unsigned*)((const char*)(gbase) + voff[_i]), (PG8_LAS unsigned*)(lds + (bufoff) + ldsw + _i * 8192), 16, 0, 0); } while (0)
#define PG8_LDA(dst, b, h) do { _Pragma("unroll") for (int m = 0; m < 4; ++m) _Pragma("unroll") for (int k = 0; k < 2; ++k) dst[m][k] = *(const PG8_LAS bf16x8*)(lds + PG8_SA(b, h) + aoff + m * 2048 + k * 16); } while (0)
#define PG8_LDB(dst, b, h) do { _Pragma("unroll") for (int n = 0; n < 2; ++n) _Pragma("unroll") for (int k = 0; k < 2; ++k) dst[n][k] = *(const PG8_LAS bf16x8*)(lds + PG8_SB(b, h) + boff + n * 2048 + k * 16); } while (0)
#define PG8_F8(x) __builtin_shufflevector(__builtin_bit_cast(i32x4_t, (x)[0]), __builtin_bit_cast(i32x4_t, (x)[1]), 0, 1, 2, 3, 4, 5, 6, 7)
#define PG8_MMA(ai, bj, At, Bt) do { __builtin_amdgcn_s_setprio(1); asm volatile("s_nop 1" ::: ); _Pragma("unroll") for (int m = 0; m < 4; ++m) _Pragma("unroll") for (int n = 0; n < 2; ++n) \
        asm volatile("v_mfma_f32_16x16x128_f8f6f4 %0, %1, %2, %0" : "+v"(acc[ai][bj][m][n]) : "v"(PG8_F8(Bt[n])), "v"(PG8_F8(At[m]))); __builtin_amdgcn_s_setprio(0); } while (0)
#define PG8_ACC_SETTLE asm volatile("s_nop 15\n\ts_nop 15" ::: "memory")
#define PG8_WAIT_V(n) asm volatile("s_waitcnt vmcnt(" #n ")" ::: "memory")
#define PG8_WAIT_L(n) asm volatile("s_waitcnt lgkmcnt(" #n ")" ::: "memory")
#define PG8_BAR __builtin_amdgcn_s_barrier()
#define PG8_SCHED __builtin_amdgcn_sched_barrier(0)
    Unit cur, nxt; int ui = 0;
    if (!S.next(0, cur)) return;
    f32x4 acc[2][2][4][2];
#pragma unroll
    for (int a = 0; a < 2; ++a)
#pragma unroll
        for (int b = 0; b < 2; ++b)
#pragma unroll
            for (int m = 0; m < 4; ++m)
#pragma unroll
                for (int n = 0; n < 2; ++n) acc[a][b][m][n] = (f32x4){0.f, 0.f, 0.f, 0.f};
    bf16x8 At[4][2], B0[2][2], B1[2][2];
    const char* cA = (const char*)g.A + (size_t)cur.pm * tstep; const char* cB = (const char*)g.Bt + (size_t)cur.pn * tstep;
    PG8_STAGE(PG8_SB(0, 0), cB); PG8_STAGE(PG8_SB(0, 1), cB + hstep); PG8_STAGE(PG8_SA(0, 0), cA); PG8_STAGE(PG8_SA(0, 1), cA + hstep);
    if (wr == 1) PG8_BAR;
    PG8_WAIT_V(2); PG8_BAR;
    PG8_STAGE(PG8_SB(1, 0), cB + kstep); PG8_STAGE(PG8_SA(1, 0), cA + kstep); PG8_STAGE(PG8_SB(1, 1), cB + hstep + kstep);
    PG8_WAIT_V(6); PG8_BAR;
    for (;;) {
        const bool has_next = S.next(ui + 1, nxt);
        const char* nA = has_next ? (const char*)g.A + (size_t)nxt.pm * tstep : cA; const char* nB = has_next ? (const char*)g.Bt + (size_t)nxt.pn * tstep : cB;
        for (int t = 0; t < nt; t += 2) {
            const bool last = (t == nt - 2);
            const char* a1 = cA + (size_t)(t + 1) * kstep;
            const char* a2 = last ? nA : cA + (size_t)(t + 2) * kstep; const char* b2 = last ? nB : cB + (size_t)(t + 2) * kstep;
            const char* a3 = a2 + kstep; const char* b3 = b2 + kstep;
            PG8_LDB(B0, 0, 0); PG8_LDB(B1, 0, 1); PG8_SCHED; PG8_LDA(At, 0, 0); PG8_STAGE(PG8_SA(1, 1), a1 + hstep);
            PG8_WAIT_V(8); PG8_WAIT_L(0); PG8_BAR; PG8_MMA(0, 0, At, B0); PG8_MMA(0, 1, At, B1); PG8_BAR; PG8_SCHED;
            PG8_LDA(At, 0, 1); PG8_STAGE(PG8_SB(0, 0), b2); PG8_STAGE(PG8_SB(0, 1), b2 + hstep); PG8_STAGE(PG8_SA(0, 0), a2);
            PG8_WAIT_V(8); PG8_WAIT_L(0); PG8_BAR; PG8_MMA(1, 0, At, B0); PG8_MMA(1, 1, At, B1); PG8_BAR; PG8_SCHED;
            PG8_LDB(B0, 1, 0); PG8_LDB(B1, 1, 1); PG8_SCHED; PG8_LDA(At, 1, 0); PG8_STAGE(PG8_SA(0, 1), a2 + hstep);
            PG8_WAIT_V(8); PG8_WAIT_L(0); PG8_BAR; PG8_MMA(0, 0, At, B0); PG8_MMA(0, 1, At, B1); PG8_BAR; PG8_SCHED;
            PG8_LDA(At, 1, 1); PG8_STAGE(PG8_SB(1, 0), b3); PG8_STAGE(PG8_SB(1, 1), b3 + hstep); PG8_STAGE(PG8_SA(1, 0), a3);
            PG8_WAIT_V(8); PG8_WAIT_L(0); PG8_BAR; PG8_MMA(1, 0, At, B0); PG8_MMA(1, 1, At, B1); PG8_BAR; PG8_SCHED;
        }
        if (wr == 0) PG8_BAR;
        PG8_ACC_SETTLE;
        E(acc, cur, wr, wc, fr, fq);
        if (!has_next) break;
#pragma unroll
        for (int a = 0; a < 2; ++a)
#pragma unroll
            for (int b = 0; b < 2; ++b)
#pragma unroll
                for (int m = 0; m < 4; ++m)
#pragma unroll
                    for (int n = 0; n < 2; ++n) acc[a][b][m][n] = (f32x4){0.f, 0.f, 0.f, 0.f};
        cur = nxt; cA = nA; cB = nB; ++ui;
        if (wr == 1) PG8_BAR;
    }
    PG8_WAIT_V(0);
    PG8_BAR;
#undef PG8_SA
#undef PG8_SB
#undef PG8_STAGE
#undef PG8_LDA
#undef PG8_LDB
#undef PG8_MMA
#undef PG8_F8
#undef PG8_ACC_SETTLE
#undef PG8_WAIT_V
#undef PG8_WAIT_L
#undef PG8_BAR
#undef PG8_SCHED
}

#define EPI_ROWS(...) _Pragma("unroll") for (int ai = 0; ai < 2; ++ai) _Pragma("unroll") for (int m = 0; m < 4; ++m) { const int row = u.pm * BM + ai * HALF + wr * 64 + m * 16 + fr; __VA_ARGS__ }
__device__ __forceinline__ u32x4 pack8(const f32x4 a, const f32x4 b) { u32x4 w; w.x = cvt_pk_bf16(a[0], a[1]); w.y = cvt_pk_bf16(a[2], a[3]); w.z = cvt_pk_bf16(b[0], b[1]); w.w = cvt_pk_bf16(b[2], b[3]); return w; }

__device__ __forceinline__ u32x2 pack8_f8(const f32x4 a, const f32x4 b) { unsigned w0 = 0, w1 = 0;
    w0 = __builtin_amdgcn_cvt_pk_fp8_f32(a[0], a[1], w0, false); w0 = __builtin_amdgcn_cvt_pk_fp8_f32(a[2], a[3], w0, true);
    w1 = __builtin_amdgcn_cvt_pk_fp8_f32(b[0], b[1], w1, false); w1 = __builtin_amdgcn_cvt_pk_fp8_f32(b[2], b[3], w1, true); u32x2 r; r.x = w0; r.y = w1; return r; }
constexpr float W8_SCALE = 64.0f, W8_INV = 1.0f / 64.0f;
struct EpiIn {
    bf16_t* aqkv; bf16_t* qb; bf16_t* kb; bf16_t* vb; bf16_t* gate; const float* qg; const float* kg; const float* rope; float asc; bool f8attn;
    __device__ __forceinline__ void operator()(const f32x4 (&acc)[2][2][4][2], const Unit& u, int wr, int wc, int fr, int fq) const {
        const int pn = u.pn;
        if (pn >= 9 && pn < 14) {
            const bool isq = pn < 13; const int head = isq ? (pn - 9) * 4 + wc : wc; bf16_t* dst = isq ? qb : kb; const int pitch = isq ? 1024 : 256;
            const float* gvec = isq ? qg : kg; const float osc = isq ? C2 : 1.0f;
            f32x4 gv[2][2];
#pragma unroll
            for (int bj = 0; bj < 2; ++bj)
#pragma unroll
                for (int n = 0; n < 2; ++n) gv[bj][n] = *(const f32x4*)(gvec + 32 * bj + 16 * n + 4 * fq);
            EPI_ROWS(
                float ss = 0.f;
                _Pragma("unroll") for (int bj = 0; bj < 2; ++bj) _Pragma("unroll") for (int n = 0; n < 2; ++n) { const f32x4 x = acc[ai][bj][m][n] * asc; ss += (x[0] * x[0] + x[1] * x[1]) + (x[2] * x[2] + x[3] * x[3]); }
                ss = xsum<16>(ss); ss = xsum<32>(ss);
                const float sc = rsqrtf(ss * (1.0f / 64.0f) + EPS) * osc * asc;
                const int t = row & (SEQ - 1);
                _Pragma("unroll") for (int bj = 0; bj < 2; ++bj) {
                    const int pos = bj == 0 ? (t >> 6) : (t & 63);
                    const f32x4 cs = *(const f32x4*)(rope + pos * 16 + 4 * fq); const f32x4 sn = *(const f32x4*)(rope + 1024 + pos * 16 + 4 * fq);
                    const f32x4 y0 = acc[ai][bj][m][0] * sc * gv[bj][0]; const f32x4 y1 = acc[ai][bj][m][1] * sc * gv[bj][1];
                    const f32x4 o0 = y0 * cs - y1 * sn; const f32x4 o1 = y1 * cs + y0 * sn;
                    if (f8attn) { unsigned char* p8 = (unsigned char*)dst + (size_t)row * pitch + head * 64 + 32 * bj + 4 * fq;
                        unsigned a = 0, b = 0; a = __builtin_amdgcn_cvt_pk_fp8_f32(o0[0], o0[1], a, false); a = __builtin_amdgcn_cvt_pk_fp8_f32(o0[2], o0[3], a, true);
                        b = __builtin_amdgcn_cvt_pk_fp8_f32(o1[0], o1[1], b, false); b = __builtin_amdgcn_cvt_pk_fp8_f32(o1[2], o1[3], b, true);
                        *(unsigned*)p8 = a; *(unsigned*)(p8 + 16) = b;
                    } else {
                    bf16_t* p = dst + (size_t)row * pitch + head * 64 + 32 * bj + 4 * fq;
                    u32x2 w0; w0.x = cvt_pk_bf16(o0[0], o0[1]); w0.y = cvt_pk_bf16(o0[2], o0[3]);
                    u32x2 w1; w1.x = cvt_pk_bf16(o1[0], o1[1]); w1.y = cvt_pk_bf16(o1[2], o1[3]);
                    *(u32x2*)p = w0; *(u32x2*)(p + 16) = w1; }
                }
            )
        } else if (pn == 14 && f8attn) {
            unsigned char* vt = (unsigned char*)vb;
            EPI_ROWS(
                const int b = row >> 12; const int t = row & (SEQ - 1); const int kk = t & 63;
                const int pos = 32 * ((kk >> 2) & 1) + (kk & 3) + 4 * ((kk >> 3) & 3) + 16 * (kk >> 5);
                _Pragma("unroll") for (int bj = 0; bj < 2; ++bj) {
                    const int kvh = bj * 2 + (wc >> 1); const int d0 = (wc & 1) * 32 + 8 * fq;
                    unsigned char* p = vt + ((size_t)((b * 4 + kvh) * 64 + d0) << 12) + (t & ~63) + pos;
                    const f32x4 v0 = acc[ai][bj][m][0] * asc; const f32x4 v1 = acc[ai][bj][m][1] * asc;
                    unsigned a = 0, c = 0; a = __builtin_amdgcn_cvt_pk_fp8_f32(v0[0], v0[1], a, false); a = __builtin_amdgcn_cvt_pk_fp8_f32(v0[2], v0[3], a, true);
                    c = __builtin_amdgcn_cvt_pk_fp8_f32(v1[0], v1[1], c, false); c = __builtin_amdgcn_cvt_pk_fp8_f32(v1[2], v1[3], c, true);
                    p[0 << 12] = (unsigned char)a; p[1 << 12] = (unsigned char)(a >> 8); p[2 << 12] = (unsigned char)(a >> 16); p[3 << 12] = (unsigned char)(a >> 24);
                    p[4 << 12] = (unsigned char)c; p[5 << 12] = (unsigned char)(c >> 8); p[6 << 12] = (unsigned char)(c >> 16); p[7 << 12] = (unsigned char)(c >> 24);
                }
            )
        } else {
            bf16_t* dst; int pitch, colt, dsh = 0; float sc = asc; bool sig = false, fold = false;
            if (pn < 9) { dst = aqkv + (size_t)pn * T * 256; pitch = 256; colt = 0; fold = true; dsh = 2 * (pn / 3); if (pn % 3 == 0) sc = C2 * asc; }
            else if (pn == 14) { dst = vb; pitch = 256; colt = 0; }
            else { dst = gate; pitch = 2048; colt = (pn - 15) * 256; sig = true; }
            const int col0 = colt + wc * 32 + 8 * fq;
            EPI_ROWS(
                int drow = row;
                if (fold) { const int t = row & (SEQ - 1); drow = (row & ~(SEQ - 1)) | ((t & ((1 << dsh) - 1)) << (12 - dsh)) | (t >> dsh); }
                bf16_t* rowp = dst + (size_t)drow * pitch + col0;
                _Pragma("unroll") for (int bj = 0; bj < 2; ++bj) {
                    f32x4 v0 = acc[ai][bj][m][0], v1 = acc[ai][bj][m][1];
                    if (sig) { _Pragma("unroll") for (int j = 0; j < 4; ++j) { v0[j] = sigmoid_f(v0[j] * asc); v1[j] = sigmoid_f(v1[j] * asc); } }
                    else { v0 = v0 * sc; v1 = v1 * sc; }
                    *(u32x4*)(rowp + bj * HALF) = pack8(v0, v1);
                }
            )
        }
    }
};
struct EpiMergeA {
    const bf16_t* gate; bf16_t* merged;
    __device__ __forceinline__ void operator()(const f32x4 (&acc)[2][2][4][2], const Unit& u, int wr, int wc, int fr, int fq) const {
        const int col0 = u.pn * BM + wc * 32 + 8 * fq;
        EPI_ROWS(
            _Pragma("unroll") for (int bj = 0; bj < 2; ++bj) {
                const u32x4 gw = *(const u32x4*)(gate + (size_t)row * 2048 + col0 + bj * HALF);
                f32x4 v0 = acc[ai][bj][m][0], v1 = acc[ai][bj][m][1];
                v0 = v0 * W8_INV; v1 = v1 * W8_INV;
                v0[0] *= bf_lo(gw.x); v0[1] *= bf_hi(gw.x); v0[2] *= bf_lo(gw.y); v0[3] *= bf_hi(gw.y);
                v1[0] *= bf_lo(gw.z); v1[1] *= bf_hi(gw.z); v1[2] *= bf_lo(gw.w); v1[3] *= bf_hi(gw.w);
                *(u32x4*)(merged + (size_t)row * 1024 + col0 + bj * HALF) = pack8(v0, v1);
            }
        )
    }
};
template <bool F8> struct EpiMergeB {
    const bf16_t* gate; const bf16_t* merged; unsigned char* m8;
    __device__ __forceinline__ void operator()(const f32x4 (&acc)[2][2][4][2], const Unit& u, int wr, int wc, int fr, int fq) const {
        const int col0 = u.pn * BM + wc * 32 + 8 * fq;
        EPI_ROWS(
            _Pragma("unroll") for (int bj = 0; bj < 2; ++bj) {
                const u32x4 gw = *(const u32x4*)(gate + (size_t)row * 2048 + 1024 + col0 + bj * HALF);
                const bf16_t* mp = merged + (size_t)row * 1024 + col0 + bj * HALF;
                const u32x4 mw = *(const u32x4*)mp;
                f32x4 v0 = acc[ai][bj][m][0] * (F8 ? W8_INV : 1.0f), v1 = acc[ai][bj][m][1] * (F8 ? W8_INV : 1.0f);
                v0[0] = v0[0] * bf_lo(gw.x) + bf_lo(mw.x); v0[1] = v0[1] * bf_hi(gw.x) + bf_hi(mw.x); v0[2] = v0[2] * bf_lo(gw.y) + bf_lo(mw.y); v0[3] = v0[3] * bf_hi(gw.y) + bf_hi(mw.y);
                v1[0] = v1[0] * bf_lo(gw.z) + bf_lo(mw.z); v1[1] = v1[1] * bf_hi(gw.z) + bf_hi(mw.z); v1[2] = v1[2] * bf_lo(gw.w) + bf_lo(mw.w); v1[3] = v1[3] * bf_hi(gw.w) + bf_hi(mw.w);
                *(u32x2*)(m8 + (size_t)row * 1024 + col0 + bj * HALF) = pack8_f8(v0, v1);
            }
        )
    }
};
struct EpiOut {
    const float* xin; float* xout; const float* g1;
    __device__ __forceinline__ void operator()(const f32x4 (&acc)[2][2][4][2], const Unit& u, int wr, int wc, int fr, int fq) const {
        const int col0 = u.pn * BM + wc * 32 + 8 * fq; const int b = (u.pm * BM) >> 12;
        f32x4 gv[2][2];
#pragma unroll
        for (int bj = 0; bj < 2; ++bj)
#pragma unroll
            for (int n = 0; n < 2; ++n) gv[bj][n] = *(const f32x4*)(g1 + (size_t)b * 6144 + col0 + bj * HALF + 4 * n);
        EPI_ROWS(
            _Pragma("unroll") for (int bj = 0; bj < 2; ++bj) {
                const size_t off = (size_t)row * 1024 + col0 + bj * HALF;
                const f32x4 x0 = *(const f32x4*)(xin + off), x1 = *(const f32x4*)(xin + off + 4);
                *(f32x4*)(xout + off) = x0 + gv[bj][0] * (acc[ai][bj][m][0] * W8_INV); *(f32x4*)(xout + off + 4) = x1 + gv[bj][1] * (acc[ai][bj][m][1] * W8_INV);
            }
        )
    }
};
struct EpiGU {
    const float* bgu; bf16_t* act;
    __device__ __forceinline__ void operator()(const f32x4 (&acc)[2][2][4][2], const Unit& u, int wr, int wc, int fr, int fq) const {
        const int e = u.pn >> 3, pl = u.pn & 7; const int c0 = pl * 128 + wc * 32 + 8 * fq;
        const float* bp = bgu + (size_t)e * 2048 + c0;
        const f32x4 bg0 = *(const f32x4*)bp, bg1 = *(const f32x4*)(bp + 4), bl0 = *(const f32x4*)(bp + 1024), bl1 = *(const f32x4*)(bp + 1028);
        EPI_ROWS(
            f32x4 o[2];
            _Pragma("unroll") for (int n = 0; n < 2; ++n) {
                const f32x4 gl = acc[ai][0][m][n] + (n == 0 ? bg0 : bg1); const f32x4 ln = acc[ai][1][m][n] + (n == 0 ? bl0 : bl1);
                _Pragma("unroll") for (int j = 0; j < 4; ++j) { const float xg = fminf(gl[j], 7.0f); const float xl = fminf(fmaxf(ln[j], -7.0f), 7.0f); o[n][j] = xg * sigmoid_f(1.702f * xg) * (xl + 1.0f); }
            }
            *(u32x4*)(act + (size_t)row * 1024 + c0) = pack8(o[0], o[1]);
        )
    }
};
struct EpiGU8 {
    const float* bgu; unsigned char* act;
    __device__ __forceinline__ void operator()(const f32x4 (&acc)[2][2][4][2], const Unit& u, int wr, int wc, int fr, int fq) const {
        const int e = u.pn >> 3, pl = u.pn & 7; const int c0 = pl * 128 + wc * 32 + 8 * fq;
        const float* bp = bgu + (size_t)e * 2048 + c0;
        const f32x4 bg0 = *(const f32x4*)bp, bg1 = *(const f32x4*)(bp + 4), bl0 = *(const f32x4*)(bp + 1024), bl1 = *(const f32x4*)(bp + 1028);
        EPI_ROWS(
            f32x4 o[2];
            _Pragma("unroll") for (int n = 0; n < 2; ++n) {
                const f32x4 gl = acc[ai][0][m][n] * W8_INV + (n == 0 ? bg0 : bg1); const f32x4 ln = acc[ai][1][m][n] * W8_INV + (n == 0 ? bl0 : bl1);
                _Pragma("unroll") for (int j = 0; j < 4; ++j) { const float xg = fminf(gl[j], 7.0f); const float xl = fminf(fmaxf(ln[j], -7.0f), 7.0f); o[n][j] = xg * sigmoid_f(1.702f * xg) * (xl + 1.0f); }
            }
            *(u32x2*)(act + (size_t)row * 1024 + c0) = pack8_f8(o[0], o[1]);
        )
    }
};
struct EpiDN8 {
    const float* bdn; const float* roww; bf16_t* y;
    __device__ __forceinline__ void operator()(const f32x4 (&acc)[2][2][4][2], const Unit& u, int wr, int wc, int fr, int fq) const {
        const int e = u.pn >> 2, pl = u.pn & 3; const int col0 = pl * BM + wc * 32 + 8 * fq;
        f32x4 bv[2][2];
#pragma unroll
        for (int bj = 0; bj < 2; ++bj)
#pragma unroll
            for (int n = 0; n < 2; ++n) bv[bj][n] = *(const f32x4*)(bdn + (size_t)e * 1024 + col0 + bj * HALF + 4 * n);
        EPI_ROWS(
            const float w = roww[row];
            _Pragma("unroll") for (int bj = 0; bj < 2; ++bj)
                *(u32x4*)(y + (size_t)row * 1024 + col0 + bj * HALF) = pack8((acc[ai][bj][m][0] * W8_INV + bv[bj][0]) * w, (acc[ai][bj][m][1] * W8_INV + bv[bj][1]) * w);
        )
    }
};
struct EpiDN {
    const float* bdn; const float* roww; bf16_t* y;
    __device__ __forceinline__ void operator()(const f32x4 (&acc)[2][2][4][2], const Unit& u, int wr, int wc, int fr, int fq) const {
        const int e = u.pn >> 2, pl = u.pn & 3; const int col0 = pl * BM + wc * 32 + 8 * fq;
        f32x4 bv[2][2];
#pragma unroll
        for (int bj = 0; bj < 2; ++bj)
#pragma unroll
            for (int n = 0; n < 2; ++n) bv[bj][n] = *(const f32x4*)(bdn + (size_t)e * 1024 + col0 + bj * HALF + 4 * n);
        EPI_ROWS(
            const float w = roww[row];
            _Pragma("unroll") for (int bj = 0; bj < 2; ++bj)
                *(u32x4*)(y + (size_t)row * 1024 + col0 + bj * HALF) = pack8((acc[ai][bj][m][0] + bv[bj][0]) * w, (acc[ai][bj][m][1] + bv[bj][1]) * w);
        )
    }
};
}

namespace attn_body {
using bf16 = __hip_bfloat16;
using bf16x8 = __attribute__((ext_vector_type(8))) short;
using s16x4 = __attribute__((ext_vector_type(4))) short;
using f32x16 = __attribute__((ext_vector_type(16))) float;
using u32x4 = __attribute__((ext_vector_type(4))) unsigned;
constexpr int D = 64, NW = 8, QBLK = 32, QB = QBLK * NW, KVBLK = 64;
__device__ __forceinline__ int crow(int r, int hi) { return (r & 3) + 8 * (r >> 2) + 4 * hi; }
#define SBAR() __builtin_amdgcn_sched_barrier(0)
constexpr int NSLOT = 3, SLOTB = 8192;
constexpr int LDS_K = 0, LDS_V = NSLOT * SLOTB, LDS_WS = 2 * NSLOT * SLOTB, LDS_OST = LDS_WS + NW * 64 * 4, LDS_LUT = LDS_OST + NW * 4096, LUT_N = 768, LDS_BYTES = LDS_LUT + LUT_N * 4;
constexpr bool OB_F8 = true;
constexpr float MFLOOR = -1024.0f;
__device__ __forceinline__ void glds16(const void* gsrc, unsigned lds_dst) { unsigned keep;
  asm volatile("s_mov_b32 %0, m0\n\ts_mov_b32 m0, %2\n\ts_nop 0\n\tglobal_load_lds_dwordx4 %1, off\n\ts_mov_b32 m0, %0" : "=&s"(keep) : "v"(gsrc), "s"(lds_dst) : "memory"); }
__device__ __forceinline__ float max3f(float a, float b, float c) { float r; asm("v_max3_f32 %0, %1, %2, %3" : "=v"(r) : "v"(a), "v"(b), "v"(c)); return r; }
__device__ __forceinline__ float max2f(float a, float b) { float r; asm("v_max_f32_e32 %0, %1, %2" : "=v"(r) : "v"(a), "v"(b)); return r; }
__device__ __forceinline__ float fadd_s(float a, float b) { float r; asm("v_add_f32_e32 %0, %1, %2" : "=v"(r) : "v"(a), "v"(b)); return r; }
__device__ __forceinline__ float fsub_s(float a, float b) { float r; asm("v_sub_f32_e32 %0, %1, %2" : "=v"(r) : "v"(a), "v"(b)); return r; }
typedef float f32x2_t __attribute__((ext_vector_type(2))); typedef __bf16 bf16x2_t __attribute__((ext_vector_type(2)));
__device__ __forceinline__ unsigned cvtpk_s(float lo, float hi) { f32x2_t v = {lo, hi}; bf16x2_t b = __builtin_convertvector(v, bf16x2_t); return __builtin_bit_cast(unsigned, b); }
#define WAIT_BAR(N) asm volatile("s_waitcnt vmcnt(" #N ") lgkmcnt(0)\n\ts_barrier" ::: "memory")

__device__ __forceinline__ void qkt(f32x16& p0, f32x16& p1, const char* Kslot, const bf16x8* qr, const f32x16& negm, int r32, int hi) {
  const char* kb = Kslot + hi * 1024 + r32 * 16;
  #pragma unroll
  for (int d0 = 0; d0 < 4; ++d0) {
    const bf16x8 b0 = *reinterpret_cast<const bf16x8*>(kb + d0 * 2048);
    const bf16x8 b1 = *reinterpret_cast<const bf16x8*>(kb + d0 * 2048 + 512);
    if (d0 == 0) { p0 = __builtin_amdgcn_mfma_f32_32x32x16_bf16(b0, qr[0], negm, 0, 0, 0); p1 = __builtin_amdgcn_mfma_f32_32x32x16_bf16(b1, qr[0], negm, 0, 0, 0); }
    else { p0 = __builtin_amdgcn_mfma_f32_32x32x16_bf16(b0, qr[d0], p0, 0, 0, 0); p1 = __builtin_amdgcn_mfma_f32_32x32x16_bf16(b1, qr[d0], p1, 0, 0, 0); } }
}
typedef __attribute__((address_space(3))) const char* lds_cptr;
typedef short v4i16_t __attribute__((ext_vector_type(4)));
__device__ __forceinline__ void kload8(bf16x8* kf, lds_cptr kp) {
  kf[0] = *(const __attribute__((address_space(3))) bf16x8*)(kp);        kf[1] = *(const __attribute__((address_space(3))) bf16x8*)(kp + 512);
  kf[2] = *(const __attribute__((address_space(3))) bf16x8*)(kp + 2048); kf[3] = *(const __attribute__((address_space(3))) bf16x8*)(kp + 2560);
  kf[4] = *(const __attribute__((address_space(3))) bf16x8*)(kp + 4096); kf[5] = *(const __attribute__((address_space(3))) bf16x8*)(kp + 4608);
  kf[6] = *(const __attribute__((address_space(3))) bf16x8*)(kp + 6144); kf[7] = *(const __attribute__((address_space(3))) bf16x8*)(kp + 6656);
}
__device__ __forceinline__ void kload2(bf16x8* kf, lds_cptr kp, int j) { kf[2 * j] = *(const __attribute__((address_space(3))) bf16x8*)(kp + j * 2048); kf[2 * j + 1] = *(const __attribute__((address_space(3))) bf16x8*)(kp + j * 2048 + 512); }
__device__ __forceinline__ s16x4 vtr(lds_cptr p) { return __builtin_bit_cast(s16x4, __builtin_amdgcn_ds_read_tr16_b64_v4i16((__attribute__((address_space(3))) v4i16_t*)p)); }
__device__ __forceinline__ float rowmax(const f32x16& p0, const f32x16& p1) {
  float a = max3f(p0[0], p0[1], p1[0]), b = max3f(p0[2], p0[3], p1[1]); a = max3f(a, p1[2], p1[3]);
  #pragma unroll
  for (int r = 4; r < 16; r += 4) { a = max3f(a, p0[r], p0[r + 1]); b = max3f(b, p0[r + 2], p0[r + 3]); a = max3f(a, p1[r], p1[r + 1]); b = max3f(b, p1[r + 2], p1[r + 3]); }
  const float m = max2f(a, b);
  auto rr = __builtin_amdgcn_permlane32_swap(__float_as_uint(m), __float_as_uint(m), false, false);
  return max2f(__uint_as_float(rr[0]), __uint_as_float(rr[1]));
}
__device__ __forceinline__ void pv(f32x16* o, int vb, bf16x8 pa0, bf16x8 pa1, bf16x8 pa2, bf16x8 pa3) {
  #pragma unroll
  for (int d0 = 0; d0 < 2; ++d0) { s16x4 lo[4], hi[4];
    #pragma unroll
    for (int ks = 0; ks < 4; ++ks) {
      asm volatile("ds_read_b64_tr_b16 %0,%1 offset:%c2" : "=&v"(lo[ks]) : "v"(vb), "i"(d0 * 4096 + ks * 1024) : "memory");
      asm volatile("ds_read_b64_tr_b16 %0,%1 offset:%c2" : "=&v"(hi[ks]) : "v"(vb), "i"(d0 * 4096 + ks * 1024 + 512) : "memory"); }
    asm volatile("s_waitcnt lgkmcnt(0)" ::: "memory"); SBAR();
    #define PK(k) (bf16x8){lo[k][0], lo[k][1], lo[k][2], lo[k][3], hi[k][0], hi[k][1], hi[k][2], hi[k][3]}
    o[d0] = __builtin_amdgcn_mfma_f32_32x32x16_bf16(pa0, PK(0), o[d0], 0, 0, 0);
    o[d0] = __builtin_amdgcn_mfma_f32_32x32x16_bf16(pa1, PK(1), o[d0], 0, 0, 0);
    o[d0] = __builtin_amdgcn_mfma_f32_32x32x16_bf16(pa2, PK(2), o[d0], 0, 0, 0);
    o[d0] = __builtin_amdgcn_mfma_f32_32x32x16_bf16(pa3, PK(3), o[d0], 0, 0, 0);
    #undef PK
  }
}
struct Job { const bf16* Q; const bf16* K; const bf16* V; bf16* O; float* lse; const float* lutg; int NT, i0, kq0, dsh, cls; };
template <int MODE, int THRL, bool NOMAX = false> __device__ __forceinline__ void attn_unit(const Job& J, char* shm, const int wid_in) {
  int wid = wid_in; asm volatile("" : "+s"(wid));
  constexpr int QP = MODE == 0 ? 1024 : 256, KP = 256;
  const int lane = lane_id_asm(), tid = wid * 64 + lane, r32 = lane & 31, hi = lane >> 5;
  const bf16* Qw = J.Q + (long)(wid * QBLK) * QP;
  const bf16* Kh = J.K; const bf16* Vh = J.V;
  const unsigned lds0 = (unsigned)(uintptr_t)shm;
  float* wsf = (float*)(shm + LDS_WS) + wid * 64;
  const bf16* ksrc = Kh + (long)lane * KP + wid * 8;
  const bf16* vsrc = Vh + (long)(16 * (wid & 3) + (lane >> 2)) * KP + (wid >> 2) * 32 + (lane & 3) * 8;
  const unsigned kdst = lds0 + LDS_K + wid * 1024, vdst = lds0 + LDS_V + wid * 1024;
  #define DMA_K(t, slot) glds16(ksrc + (long)(t) * KVBLK * KP, (unsigned)__builtin_amdgcn_readfirstlane(kdst + (slot)))
  #define DMA_V(t, slot) glds16(vsrc + (long)(t) * KVBLK * KP, (unsigned)__builtin_amdgcn_readfirstlane(vdst + (slot)))
  const int vb0 = (int)(lds0 + LDS_V) + ((lane >> 4) & 1) * 32 + (lane & 3) * 8 + (4 * hi + ((lane & 15) >> 2)) * 64;
  const char* Kbase = shm + LDS_K; bf16x8 kf[8];
  const lds_cptr shm3 = (lds_cptr)shm; const lds_cptr kp0 = shm3 + LDS_K + hi * 1024 + r32 * 16; const lds_cptr vp0 = shm3 + LDS_V + ((lane >> 4) & 1) * 32 + (lane & 3) * 8 + (4 * hi + ((lane & 15) >> 2)) * 64;
  const int NT = J.NT;
  if (MODE == 1) {
    __attribute__((address_space(3))) float* lut = (__attribute__((address_space(3))) float*)(shm3 + LDS_LUT);
    lut[tid] = J.lutg[tid]; if (tid < LUT_N - 512) lut[512 + tid] = J.lutg[512 + tid];
  }
  DMA_K(0, 0); DMA_V(0, 0); DMA_K(1, SLOTB);
  bf16x8 qr[4];
  #pragma unroll
  for (int d0 = 0; d0 < 4; ++d0) qr[d0] = *reinterpret_cast<const bf16x8*>(&Qw[(long)r32 * QP + d0 * 16 + hi * 8]);
  float mhat = 0.f, l_reg = 0.f; f32x16 o[2]; o[0] = f32x16{}; o[1] = f32x16{}; f32x16 negm = f32x16{}; if (!NOMAX) asm volatile("" : "+v"(negm));
  const int qrel = wid * QBLK + r32;
  const __attribute__((address_space(3))) float* lutq = (const __attribute__((address_space(3))) float*)(shm3 + LDS_LUT) + (J.kq0 - qrel + 383 + 4 * hi);
  #define CMASK(P0, P1, t) do { if (MODE == 1) { const __attribute__((address_space(3))) float* lp_ = lutq + 64 * (t); \
      _Pragma("unroll") for (int r = 0; r < 16; ++r) { const int ko_ = (r & 3) + 8 * (r >> 2); P0[r] += lp_[ko_]; P1[r] += lp_[ko_ + 32]; } } } while (0)
  bool resc = false;
  #define START(P0, P1) do { resc = false; if (!NOMAX) { const float rm = rowmax(P0, P1); \
    const float dl = MODE == 1 ? max2f(rm, MFLOOR) : rm; mhat = fadd_s(mhat, dl); \
      _Pragma("unroll") for (int r = 0; r < 16; ++r) { P0[r] = fsub_s(P0[r], dl); P1[r] = fsub_s(P1[r], dl); } \
      _Pragma("unroll") for (int r = 0; r < 16; ++r) negm[r] = -mhat; asm volatile("" : "+v"(negm)); } \
    _Pragma("unroll") for (int r = 0; r < 16; ++r) P0[r] = __builtin_amdgcn_exp2f(P0[r]); } while (0)
  #define RESC() do { if (resc) { asm volatile("s_waitcnt lgkmcnt(0)" ::: "memory"); \
      _Pragma("unroll") for (int d_ = 0; d_ < 2; ++d_) _Pragma("unroll") for (int r = 0; r < 16; ++r) o[d_][r] *= wsf[crow(r, hi)]; } } while (0)
  f32x16 pA0, pA1, pB0, pB1;
  int sl_prev = 0, sl_cur = 0, sl_next = SLOTB;
  #define ROT() do { sl_prev = sl_cur; sl_cur = sl_next; sl_next = (sl_next == (NSLOT - 1) * SLOTB) ? 0 : sl_next + SLOTB; } while (0)
  DMA_K(2, 2 * SLOTB);
  WAIT_BAR(3);
  qkt(pA0, pA1, Kbase, qr, negm, r32, hi); asm volatile("s_nop 15\n\ts_nop 7" : "+v"(pA0), "+v"(pA1)); CMASK(pA0, pA1, 0);
  START(pA0, pA1);
  _Pragma("unroll") for (int r = 0; r < 16; ++r) pA1[r] = __builtin_amdgcn_exp2f(pA1[r]);
  WAIT_BAR(0);
  DMA_K(3, 0); DMA_V(1, SLOTB);
  ROT();
  kload8(kf, kp0 + sl_cur);
  WAIT_BAR(2);
  s16x4 vlo[8], vhi[8]; u32x4 pw0, pw1, pw2, pw3;
  #define PKW(P, B) cvtpk_s(P[B], P[B + 1])
  #define PAF(k) __builtin_bit_cast(bf16x8, pw##k)
  #define VFR(i) (bf16x8){vlo[i][0], vlo[i][1], vlo[i][2], vlo[i][3], vhi[i][0], vhi[i][1], vhi[i][2], vhi[i][3]}
  #define PIN(x) asm volatile("" : "+v"(x))
  #define MX3(a, b, c) __builtin_fmaxf(__builtin_fmaxf((a), (b)), (c))
  #define GAPA(MF, A0, A1, A2, A3, W0, W1, PW) do { MF; sacc += A0; sacc += A1; sacc += A2; sacc += A3; PIN(sacc); W0; W1; PIN(PW); SBAR(); } while (0)
  #define EX(v) __builtin_amdgcn_exp2f(v)
  #define GAPB(MF, X, B) do { MF; X[B] = EX(X[B]); X[B + 1] = EX(X[B + 1]); X[B + 2] = EX(X[B + 2]); X[B + 3] = EX(X[B + 3]); PIN(X); SBAR(); } while (0)
  #define VRD(i) do { vlo[i] = vtr(vp_ + (((i) >> 2) * 4096 + ((i) & 3) * 1024)); vhi[i] = vtr(vp_ + (((i) >> 2) * 4096 + ((i) & 3) * 1024 + 512)); } while (0)
  #define KRD(G, j) do { if (G) { kload2(kf, kp0 + sl_next, j); SBAR(); } } while (0)
  #define STEP(C0, C1, P0, P1, t, GK, GV, GL) do { SBAR(); \
    const lds_cptr vp_ = vp0 + sl_prev; \
    VRD(0); SBAR(); float sacc = (P0[0] + P0[1]); \
    GAPA(C0 = __builtin_amdgcn_mfma_f32_32x32x16_bf16(kf[0], qr[0], negm, 0, 0, 0), P0[2], P0[3], P0[4], P0[5],     pw0[0] = PKW(P0, 0), pw0[1] = PKW(P0, 2), pw0); \
    VRD(4); SBAR(); GAPA(C1 = __builtin_amdgcn_mfma_f32_32x32x16_bf16(kf[1], qr[0], negm, 0, 0, 0), P0[6], P0[7], P0[8], P0[9],     pw0[2] = PKW(P0, 4), pw0[3] = PKW(P0, 6), pw0); \
    VRD(1); SBAR(); GAPA(C0 = __builtin_amdgcn_mfma_f32_32x32x16_bf16(kf[2], qr[1], C0, 0, 0, 0),   P0[10], P0[11], P0[12], P0[13], pw1[0] = PKW(P0, 8), pw1[1] = PKW(P0, 10), pw1); \
    VRD(5); SBAR(); GAPA(C1 = __builtin_amdgcn_mfma_f32_32x32x16_bf16(kf[3], qr[1], C1, 0, 0, 0),   P0[14], P0[15], P1[0], P1[1],   pw1[2] = PKW(P0, 12), pw1[3] = PKW(P0, 14), pw1); \
    VRD(2); SBAR(); GAPA(C0 = __builtin_amdgcn_mfma_f32_32x32x16_bf16(kf[4], qr[2], C0, 0, 0, 0),   P1[2], P1[3], P1[4], P1[5],     pw2[0] = PKW(P1, 0), pw2[1] = PKW(P1, 2), pw2); \
    VRD(6); SBAR(); GAPA(C1 = __builtin_amdgcn_mfma_f32_32x32x16_bf16(kf[5], qr[2], C1, 0, 0, 0),   P1[6], P1[7], P1[8], P1[9],     pw2[2] = PKW(P1, 4), pw2[3] = PKW(P1, 6), pw2); \
    VRD(3); SBAR(); GAPA(C0 = __builtin_amdgcn_mfma_f32_32x32x16_bf16(kf[6], qr[3], C0, 0, 0, 0),   P1[10], P1[11], P1[12], P1[13], pw3[0] = PKW(P1, 8), pw3[1] = PKW(P1, 10), pw3); \
    VRD(7); SBAR(); GAPA(C1 = __builtin_amdgcn_mfma_f32_32x32x16_bf16(kf[7], qr[3], C1, 0, 0, 0),   P1[14], P1[15], 0.f, 0.f,       pw3[2] = PKW(P1, 12), pw3[3] = PKW(P1, 14), pw3); \
    l_reg += sacc; \
    if (GK) { DMA_K((t) + 3, sl_cur); } if (GV) { DMA_V((t) + 1, sl_next); } \
    CMASK(C0, C1, t); \
    if (!NOMAX) { float a = MX3(C0[0], C0[1], C1[0]), b = MX3(C0[2], C0[3], C1[1]); a = MX3(a, C1[2], C1[3]); \
      _Pragma("unroll") for (int r = 4; r < 16; r += 4) { a = MX3(a, C0[r], C0[r + 1]); b = MX3(b, C0[r + 2], C0[r + 3]); a = MX3(a, C1[r], C1[r + 1]); b = MX3(b, C1[r + 2], C1[r + 3]); } \
      float rm = __builtin_fmaxf(a, b); { auto rr = __builtin_amdgcn_permlane32_swap(__float_as_uint(rm), __float_as_uint(rm), false, false); rm = __builtin_fmaxf(__uint_as_float(rr[0]), __uint_as_float(rr[1])); } \
      resc = false; \
      if (__builtin_expect(__any(rm > (float)THRL), 0)) { const float dl = __builtin_fmaxf(rm, 0.f); mhat += dl; \
        _Pragma("unroll") for (int r = 0; r < 16; ++r) { C0[r] -= dl; C1[r] -= dl; } \
        _Pragma("unroll") for (int r = 0; r < 16; ++r) negm[r] = -mhat; asm volatile("" : "+v"(negm)); \
        const float f = __builtin_amdgcn_exp2f(-dl); l_reg *= f; if (hi == 0) wsf[r32] = f; resc = true; } } \
    SBAR(); \
    GAPB(o[0] = __builtin_amdgcn_mfma_f32_32x32x16_bf16(PAF(0), VFR(0), o[0], 0, 0, 0), C0, 0); \
    GAPB(o[1] = __builtin_amdgcn_mfma_f32_32x32x16_bf16(PAF(0), VFR(4), o[1], 0, 0, 0), C0, 4); \
    KRD(GL, 0); GAPB(o[0] = __builtin_amdgcn_mfma_f32_32x32x16_bf16(PAF(1), VFR(1), o[0], 0, 0, 0), C0, 8); \
    KRD(GL, 1); GAPB(o[1] = __builtin_amdgcn_mfma_f32_32x32x16_bf16(PAF(1), VFR(5), o[1], 0, 0, 0), C0, 12); \
    KRD(GL, 2); GAPB(o[0] = __builtin_amdgcn_mfma_f32_32x32x16_bf16(PAF(2), VFR(2), o[0], 0, 0, 0), C1, 0); \
    KRD(GL, 3); GAPB(o[1] = __builtin_amdgcn_mfma_f32_32x32x16_bf16(PAF(2), VFR(6), o[1], 0, 0, 0), C1, 4); \
    GAPB(o[0] = __builtin_amdgcn_mfma_f32_32x32x16_bf16(PAF(3), VFR(3), o[0], 0, 0, 0), C1, 8); \
    GAPB(o[1] = __builtin_amdgcn_mfma_f32_32x32x16_bf16(PAF(3), VFR(7), o[1], 0, 0, 0), C1, 12); \
    } while (0)
  int t = 1;
  for (; t + 5 < NT; t += 2) {
    STEP(pB0, pB1, pA0, pA1, t, true, true, true);     WAIT_BAR(2); RESC(); ROT();
    STEP(pA0, pA1, pB0, pB1, t + 1, true, true, true); WAIT_BAR(2); RESC(); ROT();
  }
  #define ENDW(tt) do { if ((tt) + 3 < NT) { WAIT_BAR(2); } else if ((tt) + 2 < NT) { WAIT_BAR(1); } else { WAIT_BAR(0); } } while (0)
  for (; t + 1 < NT; t += 2) {
    STEP(pB0, pB1, pA0, pA1, t, (t + 3 < NT), (t + 1 < NT), (t + 1 < NT));       ENDW(t);     RESC(); ROT();
    STEP(pA0, pA1, pB0, pB1, t + 1, (t + 4 < NT), (t + 2 < NT), (t + 2 < NT));   ENDW(t + 1); RESC(); ROT();
  }
  STEP(pB0, pB1, pA0, pA1, NT - 1, false, false, false); RESC();
  { float sacc = pB0[0] + pB0[1]; _Pragma("unroll") for (int r = 2; r < 16; ++r) sacc += pB0[r]; _Pragma("unroll") for (int r = 0; r < 16; ++r) sacc += pB1[r]; l_reg += sacc;
    pw0 = (u32x4){PKW(pB0, 0), PKW(pB0, 2), PKW(pB0, 4), PKW(pB0, 6)}; pw1 = (u32x4){PKW(pB0, 8), PKW(pB0, 10), PKW(pB0, 12), PKW(pB0, 14)}; pw2 = (u32x4){PKW(pB1, 0), PKW(pB1, 2), PKW(pB1, 4), PKW(pB1, 6)}; pw3 = (u32x4){PKW(pB1, 8), PKW(pB1, 10), PKW(pB1, 12), PKW(pB1, 14)};
    SBAR(); pv(o, vb0 + sl_cur, PAF(0), PAF(1), PAF(2), PAF(3)); }
  #undef PKW
  #undef PAF
  #undef VFR
  #undef PIN
  #undef MX3
  #undef GAPA
  #undef GAPB
  #undef EX
  #undef VRD
  #undef KRD
  #undef STEP
  #undef ENDW
  { auto rr = __builtin_amdgcn_permlane32_swap(__float_as_uint(l_reg), __float_as_uint(l_reg), false, false); l_reg = __uint_as_float(rr[0]) + __uint_as_float(rr[1]); }
  if (hi == 0) wsf[32 + r32] = l_reg; asm volatile("s_waitcnt lgkmcnt(0)" ::: "memory");
  float rli[16];
  #pragma unroll
  for (int r = 0; r < 16; ++r) rli[r] = __builtin_amdgcn_rcpf(wsf[32 + crow(r, hi)]);
  if (MODE == 0 && OB_F8) {
    unsigned char* stg8 = (unsigned char*)(shm + LDS_OST) + wid * 4096;
    #pragma unroll
    for (int r = 0; r < 16; ++r) { const int orow = crow(r, hi);
      #pragma unroll
      for (int d0 = 0; d0 < 2; ++d0) { const float ov = o[d0][r] * rli[r]; stg8[orow * 64 + d0 * 32 + r32] = (unsigned char)(__builtin_amdgcn_cvt_pk_fp8_f32(ov, ov, 0, false) & 0xff); } }
    asm volatile("s_waitcnt lgkmcnt(0)" ::: "memory");
    unsigned char* Ow = (unsigned char*)J.O + (long)(wid * QBLK) * 1024;
    #pragma unroll
    for (int i = 0; i < 2; ++i) { const int row = i * 16 + (lane >> 2), ch = lane & 3; const u32x4 v = *(const u32x4*)(stg8 + row * 64 + ch * 16); *(u32x4*)(Ow + (long)row * 1024 + ch * 16) = v; }
  } else {
    bf16* stg = (bf16*)(shm + LDS_OST) + wid * 2048;
    #pragma unroll
    for (int r = 0; r < 16; ++r) { const int orow = crow(r, hi);
      #pragma unroll
      for (int d0 = 0; d0 < 2; ++d0) stg[orow * 64 + d0 * 32 + r32] = __float2bfloat16(o[d0][r] * rli[r]); }
    asm volatile("s_waitcnt lgkmcnt(0)" ::: "memory");
    if (MODE == 0) {
      bf16* Ow = J.O + (long)(wid * QBLK) * 1024;
      #pragma unroll
      for (int i = 0; i < 4; ++i) { const int row = i * 8 + (lane >> 3), ch = lane & 7; const u32x4 v = *(const u32x4*)(stg + row * 64 + ch * 8); *(u32x4*)(Ow + (long)row * 1024 + ch * 8) = v; }
    } else {
      #pragma unroll
      for (int i = 0; i < 4; ++i) { const int row = i * 8 + (lane >> 3), ch = lane & 7; const u32x4 v = *(const u32x4*)(stg + row * 64 + ch * 8);
        const long tok = ((long)(J.i0 + wid * QBLK + row) << J.dsh) + J.cls; *(u32x4*)(J.O + tok * 256 + ch * 8) = v; }
      if (hi == 0) { const long tok = ((long)(J.i0 + qrel) << J.dsh) + J.cls; J.lse[tok * 4] = mhat + __builtin_amdgcn_logf(l_reg); }
    } }
  asm volatile("s_waitcnt lgkmcnt(0)\n\ts_barrier" ::: "memory");
  #undef DMA_K
  #undef DMA_V
  #undef CMASK
  #undef START
  #undef RESC
  #undef ROT
}
#undef SBAR
#undef WAIT_BAR
}


namespace attn8 {
typedef int i32x8 __attribute__((ext_vector_type(8)));
typedef int i32x4 __attribute__((ext_vector_type(4)));
typedef float f32x16 __attribute__((ext_vector_type(16)));
typedef unsigned u32x4 __attribute__((ext_vector_type(4)));
constexpr int SLOT = 4096, RING = 8, NSL = RING;
constexpr int L_K = 0, L_V = NSL * SLOT, L_WS = 2 * NSL * SLOT, L_OST = L_WS + 8 * 256, L_BYTES = L_OST + 8 * 4096;
struct Job { const unsigned char* Q; const unsigned char* K; const unsigned char* VT; unsigned char* O; };
__device__ __forceinline__ void glds16(const void* gsrc, unsigned lds_dst) { unsigned keep;
  asm volatile("s_mov_b32 %0, m0\n\ts_mov_b32 m0, %2\n\ts_nop 0\n\tglobal_load_lds_dwordx4 %1, off\n\ts_mov_b32 m0, %0" : "=&s"(keep) : "v"(gsrc), "s"(lds_dst) : "memory"); }
__device__ __forceinline__ int crow(int r, int hi) { return (r & 3) + 8 * (r >> 2) + 4 * hi; }
#define A8_WAITBAR(N) asm volatile("s_waitcnt vmcnt(" #N ") lgkmcnt(0)\n\ts_barrier" ::: "memory")
#define A8_WAITBAR_N(N) asm volatile("s_waitcnt vmcnt(%0) lgkmcnt(0)\n\ts_barrier" :: "n"(N) : "memory")
template <int NT> __device__ __forceinline__ void attn_unit_f8(const Job& J, char* shm, const int wid_in) {
  int wid = wid_in; asm volatile("" : "+s"(wid));
  const int lane = lane_id_asm(), r32 = lane & 31, hi = lane >> 5;
  const unsigned lds0 = (unsigned)(uintptr_t)shm;
  typedef __attribute__((address_space(3))) const char* lds_cptr;
  const lds_cptr shm3 = (lds_cptr)shm;
  const bool kwave = wid < 4;
  const int w4 = wid & 3; const int drow = 16 * w4 + (lane >> 2); const int cl = (lane & 3) ^ ((drow >> 2) & 3);
  const unsigned char* dsrc = kwave ? J.K + (long)drow * 256 + 16 * cl : J.VT + (long)drow * 4096 + 16 * cl;
  const long dstep = kwave ? 64 * 256 : 64;
  const unsigned ddst = lds0 + (kwave ? L_K : L_V) + w4 * 1024;
  #define A8_DMA(t, slot) glds16(dsrc + (long)(t) * dstep, (unsigned)__builtin_amdgcn_readfirstlane(ddst + (slot)))
  const int sw = (r32 >> 2) & 3; const int foff0 = r32 * 64 + 16 * ((2 * hi) ^ sw), foff1 = r32 * 64 + 16 * ((2 * hi + 1) ^ sw);
  #define A8_FRAG(base, half) __builtin_shufflevector(*(const __attribute__((address_space(3))) i32x4*)((base) + (half) * 2048 + foff0), *(const __attribute__((address_space(3))) i32x4*)((base) + (half) * 2048 + foff1), 0, 1, 2, 3, 4, 5, 6, 7)
  const unsigned char* qp = J.Q + (long)(wid * 32 + r32) * 1024 + 32 * hi;
  const i32x8 qf = __builtin_shufflevector(*(const i32x4*)qp, *(const i32x4*)(qp + 16), 0, 1, 2, 3, 4, 5, 6, 7);
  if (kwave) { _Pragma("unroll") for (int i = 0; i < RING; ++i) A8_DMA(i, i * SLOT); } else { _Pragma("unroll") for (int i = 0; i < RING - 2; ++i) A8_DMA(i, i * SLOT); }
  f32x16 o0 = f32x16{}, o1 = f32x16{}, o2 = f32x16{}; const f32x16 zero = f32x16{};
  i32x8 ones; _Pragma("unroll") for (int w = 0; w < 8; ++w) ones[w] = 0x38383838;
  asm volatile("" : "+v"(ones));
  f32x16 SA0, SA1, SB0, SB1; i32x8 PA, PB;
  A8_WAITBAR_N(RING - 1);
  { const i32x8 k0 = A8_FRAG(shm3 + L_K, 0), k1 = A8_FRAG(shm3 + L_K, 1);
    SA0 = __builtin_amdgcn_mfma_scale_f32_32x32x64_f8f6f4(k0, qf, zero, 0, 0, 0, 0, 0, 0); SA1 = __builtin_amdgcn_mfma_scale_f32_32x32x64_f8f6f4(k1, qf, zero, 0, 0, 0, 0, 0, 0); }
  #define A8_SB() __builtin_amdgcn_sched_barrier(0)
  #define A8_SLOTOF(i) ((((i) + RING) & (RING - 1)) * SLOT)
  #define A8_EXP8(X, B) do { _Pragma("unroll") for (int r = 0; r < 8; ++r) X[(B) + r] = __builtin_amdgcn_exp2f(X[(B) + r]); asm volatile("" : "+v"(X)); } while (0)
  #define A8_CVT4(P, WB, X) do { _Pragma("unroll") for (int w = 0; w < 4; ++w) { unsigned a_ = (unsigned)P[(WB) + w];     \
      a_ = __builtin_amdgcn_cvt_pk_bf8_f32(X[4 * w], X[4 * w + 1], a_, false); a_ = __builtin_amdgcn_cvt_pk_bf8_f32(X[4 * w + 2], X[4 * w + 3], a_, true); P[(WB) + w] = (int)a_; } asm volatile("" : "+v"(P)); } while (0)
  #define A8_STEP(C0, C1, N0, N1, PP, PN, t, WK, WV, DK, DV, QK, PV, EX) do { \
    if (kwave) { A8_WAITBAR_N(WK); } else { A8_WAITBAR_N(WV); } \
    if (kwave) { if (DK) A8_DMA((t) + RING, A8_SLOTOF(t)); } else { if (DV) A8_DMA((t) - 2 + RING, A8_SLOTOF((t) - 2)); } \
    i32x8 k0_ = ones, k1_ = ones, v0_ = ones, v1_ = ones; \
    if (QK) { k0_ = A8_FRAG(shm3 + L_K + A8_SLOTOF((t) + 1), 0); k1_ = A8_FRAG(shm3 + L_K + A8_SLOTOF((t) + 1), 1); } \
    if (PV) { v0_ = A8_FRAG(shm3 + L_V + A8_SLOTOF((t) - 1), 0); v1_ = A8_FRAG(shm3 + L_V + A8_SLOTOF((t) - 1), 1); } \
    A8_SB(); \
    if (EX) A8_EXP8(C0, 0); A8_SB(); \
    if (QK) N0 = __builtin_amdgcn_mfma_scale_f32_32x32x64_f8f6f4(k0_, qf, zero, 0, 0, 0, 0, 0, 0); if (EX) A8_EXP8(C0, 8); A8_SB(); \
    if (QK) N1 = __builtin_amdgcn_mfma_scale_f32_32x32x64_f8f6f4(k1_, qf, zero, 0, 0, 0, 0, 0, 0); if (EX) A8_EXP8(C1, 0); A8_SB(); \
    if (PV) o0 = __builtin_amdgcn_mfma_scale_f32_32x32x64_f8f6f4(PP, v0_, o0, 1, 0, 0, 0, 0, 0); if (EX) A8_EXP8(C1, 8); A8_SB(); \
    if (PV) o1 = __builtin_amdgcn_mfma_scale_f32_32x32x64_f8f6f4(PP, v1_, o1, 1, 0, 0, 0, 0, 0); if (EX) A8_CVT4(PN, 0, C0); A8_SB(); \
    if (PV) o2 = __builtin_amdgcn_mfma_scale_f32_32x32x64_f8f6f4(PP, ones, o2, 1, 0, 0, 0, 0, 0); if (EX) A8_CVT4(PN, 4, C1); A8_SB();     \
  } while (0)
  #define A8_EVEN(t, WK, WV, DK, DV, QK, PV, EX) A8_STEP(SA0, SA1, SB0, SB1, PB, PA, t, WK, WV, DK, DV, QK, PV, EX)
  #define A8_ODD(t, WK, WV, DK, DV, QK, PV, EX)  A8_STEP(SB0, SB1, SA0, SA1, PA, PB, t, WK, WV, DK, DV, QK, PV, EX)
  PA = ones; PB = ones;
  static_assert(RING == 8 && NT % 2 == 0 && NT >= 2 * RING, "the peeled tail below is written for RING = 8");
  A8_EVEN(0, 6, 6, true, true, true, false, true);
#pragma unroll 1
  for (int t = 1; t < NT - 9; t += 2) {
    A8_ODD(t, 6, 6, true, true, true, true, true);
    A8_EVEN(t + 1, 6, 6, true, true, true, true, true);
  }
  A8_ODD(NT - 9, 6, 6, true, true, true, true, true);
  A8_EVEN(NT - 8, 6, 6, false, true, true, true, true);
  A8_ODD(NT - 7, 5, 6, false, true, true, true, true);
  A8_EVEN(NT - 6, 4, 6, false, false, true, true, true);
  A8_ODD(NT - 5, 3, 5, false, false, true, true, true);
  A8_EVEN(NT - 4, 2, 4, false, false, true, true, true);
  A8_ODD(NT - 3, 1, 3, false, false, true, true, true);
  A8_EVEN(NT - 2, 0, 2, false, false, true, true, true);
  A8_ODD(NT - 1, 0, 1, false, false, false, true, true);
  A8_EVEN(NT, 0, 0, false, false, false, true, false);
  #undef A8_EVEN
  #undef A8_ODD
  #undef A8_STEP
  #undef A8_EXP8
  #undef A8_CVT4
  #undef A8_SB
  #undef A8_SLOTOF
  #undef A8_FRAG
  #undef A8_DMA
  float rli[16];
  #pragma unroll
  for (int r = 0; r < 16; ++r) rli[r] = __builtin_amdgcn_rcpf(o2[r]);
  unsigned char* stg8 = (unsigned char*)(shm + L_OST) + wid * 4096;
  #pragma unroll
  for (int r = 0; r < 16; ++r) { const int orow = crow(r, hi);
    const float a = o0[r] * rli[r], b = o1[r] * rli[r];
    stg8[orow * 64 + r32] = (unsigned char)(__builtin_amdgcn_cvt_pk_fp8_f32(a, a, 0, false) & 0xff); stg8[orow * 64 + 32 + r32] = (unsigned char)(__builtin_amdgcn_cvt_pk_fp8_f32(b, b, 0, false) & 0xff); }
  asm volatile("s_waitcnt lgkmcnt(0)" ::: "memory");
  unsigned char* Ow = J.O + (long)(wid * 32) * 1024;
  #pragma unroll
  for (int i = 0; i < 2; ++i) { const int row = i * 16 + (lane >> 2), ch = lane & 3; const u32x4 v = *(const u32x4*)(stg8 + row * 64 + ch * 16); *(u32x4*)(Ow + (long)row * 1024 + ch * 16) = v; }
  asm volatile("s_waitcnt lgkmcnt(0)\n\ts_barrier" ::: "memory");
}
#undef A8_WAITBAR
#undef A8_WAITBAR_N
}

constexpr size_t MiB = 1u << 20;
constexpr size_t WS_CTL = 0, CTL_ZERO_BYTES = 1 * MiB;
constexpr size_t WS_MOD = 1 * MiB;
constexpr size_t WS_ROPE = WS_MOD + 512 * 1024;
constexpr size_t WS_BLUT = WS_ROPE + 8192;
constexpr size_t WS_RC0 = WS_BLUT + 12 * 768 * 4;
constexpr size_t WS_HIST = WS_RC0 + 4096;
constexpr size_t WS_TILEE = WS_HIST + 32768;
constexpr size_t WS_TOPE = 2 * MiB;
constexpr size_t WS_TOPW = WS_TOPE + 512 * 1024;
constexpr size_t WS_SLOT = WS_TOPW + 512 * 1024;
constexpr size_t WS_ROWW = WS_SLOT + 512 * 1024;
constexpr size_t WS_LSE = 5 * MiB;
constexpr size_t WS_WRHI = 7 * MiB;
constexpr size_t WS_WRLO = 8 * MiB;
constexpr size_t WS_WIN = 9 * MiB;
constexpr size_t WS_WBRA = 32 * MiB;
constexpr size_t WS_WBRB = 33 * MiB;
constexpr size_t WS_WOUT = 37 * MiB;
constexpr size_t WS_WGU = 41 * MiB;
constexpr size_t WS_WDN = 297 * MiB;
constexpr size_t WS_X = 425 * MiB;
constexpr size_t WS_H = 553 * MiB;
constexpr size_t WS_R = 617 * MiB;
constexpr size_t WS_AQKV = WS_R;
constexpr size_t WS_QB = WS_R + 144 * MiB;
constexpr size_t WS_KB = WS_R + 208 * MiB;
constexpr size_t WS_VB = WS_R + 224 * MiB;
constexpr size_t WS_GATE = WS_R + 240 * MiB;
constexpr size_t WS_OAG = WS_R + 368 * MiB;
constexpr size_t WS_OA = WS_R + 416 * MiB;
constexpr size_t WS_MERGED = WS_R + 432 * MiB;
constexpr size_t WS_XS = WS_R;
constexpr size_t WS_ACT = WS_R + 136 * MiB;
constexpr size_t WS_Y = WS_R + 272 * MiB;
constexpr size_t WS_OB = WS_R + 496 * MiB;
constexpr size_t WS_M8 = WS_R + 560 * MiB;
constexpr size_t WS_END = WS_R + 592 * MiB;
constexpr int CW_BAR = 4096;

constexpr int RING_BYTES = 133120;
constexpr int LDSCTL_OFF = RING_BYTES;
constexpr int LDS_BYTES = 147456;
constexpr int NWAVES = 8;

#define GAS __attribute__((address_space(1)))
#define LAS __attribute__((address_space(3)))
typedef unsigned short bf16;
typedef unsigned v4u __attribute__((ext_vector_type(4)));
typedef unsigned v2u __attribute__((ext_vector_type(2)));
typedef float f32x4 __attribute__((ext_vector_type(4)));
typedef float f32x16 __attribute__((ext_vector_type(16)));
typedef int i32x4 __attribute__((ext_vector_type(4)));
typedef short bf16x8 __attribute__((ext_vector_type(8)));
typedef GAS unsigned gu32;
#define RLX_AGENT __ATOMIC_RELAXED, __HIP_MEMORY_SCOPE_AGENT
#define LDS_WAIT() asm volatile("s_waitcnt lgkmcnt(0)" ::: "memory")
__device__ __forceinline__ unsigned f2bf(float f) { unsigned u = __builtin_bit_cast(unsigned, f); return (u + 0x7fffu + ((u >> 16) & 1u)) >> 16; }
__device__ __forceinline__ unsigned pk2(float lo, float hi) { return f2bf(lo) | (f2bf(hi) << 16); }
__device__ __forceinline__ float bfl(unsigned w) { return __uint_as_float(w << 16); }
__device__ __forceinline__ float bfh(unsigned w) { return __uint_as_float(w & 0xffff0000u); }

#define XB_TMO      128
#define XB_XCNT(j)  (256  + 64 * (j))
#define XB_XSUB(j)  (1280 + 64 * (j))
#define XB_XGEN(j)  (2304 + 64 * (j))
#define XB_TOP      3328
#define XB_TOPGEN   3392
#define XCD_BAR_WORDS 3456
#define XB_SPIN_CAP (1u << 18)
__device__ __forceinline__ unsigned xb_ld(unsigned* p)              { return __hip_atomic_load(p, __ATOMIC_RELAXED, __HIP_MEMORY_SCOPE_AGENT); }
__device__ __forceinline__ unsigned xb_add(unsigned* p, unsigned v) { return __hip_atomic_fetch_add(p, v, __ATOMIC_RELAXED, __HIP_MEMORY_SCOPE_AGENT); }
__device__ __forceinline__ unsigned xb_xcc_id() { return (unsigned)__builtin_amdgcn_s_getreg((3 << 11) | 20) & 0xFu; }
#define XB_SPIN(cond, bar) do { unsigned _sp = 0; while (cond) { __builtin_amdgcn_s_sleep(1); \
    if ((++_sp & 255u) == 0u) { if (xb_ld(&(bar)[XB_TMO])) break; if (_sp > XB_SPIN_CAP) { atomicAdd(&(bar)[XB_TMO], 1u); break; } } } } while (0)
struct XcdBarrier { unsigned* bar; unsigned x; volatile LAS unsigned* st; };
__device__ __forceinline__ XcdBarrier xcd_barrier_post(unsigned* bar, volatile LAS unsigned* st) {
    XcdBarrier b; b.bar = bar; b.x = xb_xcc_id(); b.st = st;
    if (threadIdx.x == 0) (void)xb_add(&bar[XB_XCNT(b.x)], 1u);
    return b;
}
__device__ __forceinline__ void xcd_barrier_complete(unsigned* bar, unsigned x, unsigned& nloc, unsigned& nx) {
    const unsigned G = gridDim.x * gridDim.y * gridDim.z;
    unsigned sum, cnt, mine, sp = 0u;
    for (;;) {
        sum = 0u; cnt = 0u; mine = 0u;
#pragma unroll
        for (unsigned j = 0; j < 16; ++j) { const unsigned c = xb_ld(&bar[XB_XCNT(j)]); sum += c; cnt += (c > 0u) ? 1u : 0u; mine = (j == x) ? c : mine; }
        if (sum == G) break;
        __builtin_amdgcn_s_sleep(1);
        if ((++sp & 255u) == 0u) { if (xb_ld(&bar[XB_TMO])) break; if (sp > XB_SPIN_CAP) { atomicAdd(&bar[XB_TMO], 1u); break; } }
    }
    nloc = mine > 0u ? mine : 1u; nx = cnt > 0u ? cnt : 1u;
}
__device__ __forceinline__ void xcd_barrier(const XcdBarrier& b) {
    asm volatile("s_waitcnt vmcnt(0)" ::: "memory");
    __syncthreads();
    if (threadIdx.x == 0) {
        unsigned* bar = b.bar;
        __builtin_amdgcn_s_waitcnt(0);
        unsigned nloc = b.st[0], nx = b.st[1];
        if (nloc == 0u) { xcd_barrier_complete(bar, b.x, nloc, nx); b.st[0] = nloc; b.st[1] = nx; }
        const unsigned old = xb_add(&bar[XB_XSUB(b.x)], 1u);
        const unsigned gen = old / nloc;
        if (old + 1u == (gen + 1u) * nloc) {
            __builtin_amdgcn_fence(__ATOMIC_RELEASE, "agent");
            asm volatile("s_waitcnt vmcnt(0)" ::: "memory");
            const unsigned og = xb_add(&bar[XB_TOP], 1u);
            const unsigned tg = og / nx;
            if (og + 1u == (tg + 1u) * nx) xb_add(&bar[XB_TOPGEN], 1u);
            else XB_SPIN(xb_ld(&bar[XB_TOPGEN]) == tg, bar);
            __builtin_amdgcn_fence(__ATOMIC_ACQUIRE, "agent");
            xb_add(&bar[XB_XGEN(b.x)], 1u);
            asm volatile("s_waitcnt vmcnt(0)" ::: "memory");
        } else {
            XB_SPIN(xb_ld(&bar[XB_XGEN(b.x)]) == gen, bar);
            __builtin_amdgcn_fence(__ATOMIC_ACQUIRE, "agent");
            asm volatile("s_waitcnt vmcnt(0)" ::: "memory");
        }
    }
    __syncthreads();
}

__device__ __forceinline__ float wave_sum(float v) {
    v = xsum<1>(v); v = xsum<2>(v); v = xsum<4>(v); v = xsum<8>(v); v = xsum<16>(v); v = xsum<32>(v);
    return v;
}
__device__ __forceinline__ void cvt_item(const float* W, int ldw, int K, int srcA, int srcB, bf16* WT, int dst_row0, int k0, LAS float* scr, int lane, bool ident = false) {
    const int kq = lane >> 4, nq = lane & 15; const int scol = (nq < 8 ? srcA + 4 * nq : srcB + 4 * (nq - 8));
    f32x4 v[16];
#pragma unroll
    for (int i = 0; i < 16; ++i) v[i] = *(const GAS f32x4*)(W + (size_t)(k0 + 4 * i + kq) * ldw + scol);
#pragma unroll
    for (int i = 0; i < 16; ++i)
#pragma unroll
        for (int e = 0; e < 4; ++e) scr[(4 * i + kq) * 65 + 4 * nq + e] = v[i][e];
    LDS_WAIT(); asm volatile("" ::: "memory");
    const int c = lane & 7, rr = lane >> 3;
#pragma unroll
    for (int j = 0; j < 8; ++j) { const int rho = rr + 8 * j; const int sc = (rho & 32) + (ident ? (rho & 31) : pg8::perm32(rho & 31)); const LAS float* s = scr + (8 * c) * 65 + sc;
        v4u o; o.x = pk2(s[0 * 65], s[1 * 65]); o.y = pk2(s[2 * 65], s[3 * 65]); o.z = pk2(s[4 * 65], s[5 * 65]); o.w = pk2(s[6 * 65], s[7 * 65]);
        *(GAS v4u*)(WT + (size_t)(dst_row0 + rho) * K + k0 + 8 * c) = o; }
    LDS_WAIT(); asm volatile("" ::: "memory");
}
__device__ __forceinline__ void cvt_item_f8(const float* W, int ldw, int K, int srcA, int srcB, unsigned char* WT, int dst_row0, int k0, LAS float* scr, int lane, bool ident = false) {
    const int kq = lane >> 4, nq = lane & 15; const int scol = (nq < 8 ? srcA + 4 * nq : srcB + 4 * (nq - 8));
    f32x4 v[16];
#pragma unroll
    for (int i = 0; i < 16; ++i) v[i] = *(const GAS f32x4*)(W + (size_t)(k0 + 4 * i + kq) * ldw + scol);
#pragma unroll
    for (int i = 0; i < 16; ++i)
#pragma unroll
        for (int e = 0; e < 4; ++e) scr[(4 * i + kq) * 65 + 4 * nq + e] = v[i][e] * pg8::W8_SCALE;
    LDS_WAIT(); asm volatile("" ::: "memory");
    const int c = lane & 7, rr = lane >> 3;
#pragma unroll
    for (int j = 0; j < 8; ++j) { const int rho = rr + 8 * j; const int sc = (rho & 32) + (ident ? (rho & 31) : pg8::perm32(rho & 31)); const LAS float* s = scr + (8 * c) * 65 + sc;
        unsigned w0 = 0, w1 = 0;
        w0 = __builtin_amdgcn_cvt_pk_fp8_f32(s[0 * 65], s[1 * 65], w0, false); w0 = __builtin_amdgcn_cvt_pk_fp8_f32(s[2 * 65], s[3 * 65], w0, true);
        w1 = __builtin_amdgcn_cvt_pk_fp8_f32(s[4 * 65], s[5 * 65], w1, false); w1 = __builtin_amdgcn_cvt_pk_fp8_f32(s[6 * 65], s[7 * 65], w1, true);
        v2u o; o.x = w0; o.y = w1; *(GAS v2u*)(WT + (size_t)(dst_row0 + rho) * K + k0 + 8 * c) = o; }
    LDS_WAIT(); asm volatile("" ::: "memory");
}
__device__ __forceinline__ int win_src(int X) { const int pn = X >> 3, bj = (X >> 2) & 1, wc = X & 3; return (pn >= 9 && pn < 14) ? pn * 256 + 64 * wc + 32 * bj : 32 * X; }
__device__ __forceinline__ int wgu_src(int X) { const int pn = X >> 3, bj = (X >> 2) & 1, wc = X & 3; return bj * 1024 + 128 * pn + 32 * wc; }

__device__ __forceinline__ void norm_row_bf16(const float* xrow, const float* g, const float* sc, const float* sh, bf16* orow, int lane) {
    const GAS f32x4* xr = (const GAS f32x4*)xrow + lane;
    f32x4 v[4]; float s = 0.f;
#pragma unroll
    for (int j = 0; j < 4; ++j) { v[j] = xr[64 * j]; s += (v[j].x * v[j].x + v[j].y * v[j].y) + (v[j].z * v[j].z + v[j].w * v[j].w); }
    const float rs = rsqrtf(wave_sum(s) * (1.0f / D) + EPS);
#pragma unroll
    for (int j = 0; j < 4; ++j) { const int c = 256 * j + 4 * lane;
        const f32x4 gg = *(const GAS f32x4*)(g + c), s1 = *(const GAS f32x4*)(sc + c), s0 = *(const GAS f32x4*)(sh + c);
        const f32x4 y = (v[j] * rs * gg) * (s1 + 1.0f) + s0;
        v2u o; o.x = pk2(y.x, y.y); o.y = pk2(y.z, y.w); *(GAS v2u*)(orow + c) = o; }
}

__device__ __forceinline__ void norm_rows2_bf16(const float* xrow, const float* g, const float* sc, const float* sh, bf16* orow, int lane) {
    const GAS f32x4* xr = (const GAS f32x4*)xrow + lane;
    f32x4 v[2][4]; float s0 = 0.f, s1 = 0.f;
#pragma unroll
    for (int j = 0; j < 4; ++j) { v[0][j] = xr[64 * j]; v[1][j] = xr[256 + 64 * j]; }
#pragma unroll
    for (int j = 0; j < 4; ++j) { s0 += (v[0][j].x * v[0][j].x + v[0][j].y * v[0][j].y) + (v[0][j].z * v[0][j].z + v[0][j].w * v[0][j].w); s1 += (v[1][j].x * v[1][j].x + v[1][j].y * v[1][j].y) + (v[1][j].z * v[1][j].z + v[1][j].w * v[1][j].w); }
    const float rs0 = rsqrtf(wave_sum(s0) * (1.0f / D) + EPS), rs1 = rsqrtf(wave_sum(s1) * (1.0f / D) + EPS);
#pragma unroll
    for (int j = 0; j < 4; ++j) { const int c = 256 * j + 4 * lane;
        const f32x4 gg = *(const GAS f32x4*)(g + c), a1 = *(const GAS f32x4*)(sc + c) + 1.0f, a0 = *(const GAS f32x4*)(sh + c);
        const f32x4 y0 = (v[0][j] * rs0 * gg) * a1 + a0, y1 = (v[1][j] * rs1 * gg) * a1 + a0;
        v2u o0; o0.x = pk2(y0.x, y0.y); o0.y = pk2(y0.z, y0.w); *(GAS v2u*)(orow + c) = o0;
        v2u o1; o1.x = pk2(y1.x, y1.y); o1.y = pk2(y1.z, y1.w); *(GAS v2u*)(orow + D + c) = o1; }
}

__device__ __forceinline__ void norm_rows2_f8(const float* xrow, const float* g, const float* sc, const float* sh, unsigned char* orow, int lane) {
    const GAS f32x4* xr = (const GAS f32x4*)xrow + lane;
    f32x4 v[2][4]; float s0 = 0.f, s1 = 0.f;
#pragma unroll
    for (int j = 0; j < 4; ++j) { v[0][j] = xr[64 * j]; v[1][j] = xr[256 + 64 * j]; }
#pragma unroll
    for (int j = 0; j < 4; ++j) { s0 += (v[0][j].x * v[0][j].x + v[0][j].y * v[0][j].y) + (v[0][j].z * v[0][j].z + v[0][j].w * v[0][j].w); s1 += (v[1][j].x * v[1][j].x + v[1][j].y * v[1][j].y) + (v[1][j].z * v[1][j].z + v[1][j].w * v[1][j].w); }
    const float rs0 = rsqrtf(wave_sum(s0) * (1.0f / D) + EPS), rs1 = rsqrtf(wave_sum(s1) * (1.0f / D) + EPS);
#pragma unroll
    for (int j = 0; j < 4; ++j) { const int c = 256 * j + 4 * lane;
        const f32x4 gg = *(const GAS f32x4*)(g + c), a1 = *(const GAS f32x4*)(sc + c) + 1.0f, a0 = *(const GAS f32x4*)(sh + c);
        const f32x4 y0 = (v[0][j] * rs0 * gg) * a1 + a0, y1 = (v[1][j] * rs1 * gg) * a1 + a0;
        unsigned w0 = 0, w1 = 0;
        w0 = __builtin_amdgcn_cvt_pk_fp8_f32(y0.x, y0.y, w0, false); w0 = __builtin_amdgcn_cvt_pk_fp8_f32(y0.z, y0.w, w0, true);
        w1 = __builtin_amdgcn_cvt_pk_fp8_f32(y1.x, y1.y, w1, false); w1 = __builtin_amdgcn_cvt_pk_fp8_f32(y1.z, y1.w, w1, true);
        *(GAS unsigned*)(orow + c) = w0; *(GAS unsigned*)(orow + D + c) = w1; }
}

__device__ __forceinline__ bool gqa_bound_ok(const float* qg, const float* kg, int lane) {
    float gq = fabsf(qg[lane]), gk = fabsf(kg[lane]);
#define MK_MAXSTEP(m) gq = fmaxf(gq, __int_as_float(__builtin_amdgcn_ds_swizzle(__float_as_int(gq), 0x1f | ((m) << 10)))); gk = fmaxf(gk, __int_as_float(__builtin_amdgcn_ds_swizzle(__float_as_int(gk), 0x1f | ((m) << 10))))
    MK_MAXSTEP(1); MK_MAXSTEP(2); MK_MAXSTEP(4); MK_MAXSTEP(8); MK_MAXSTEP(16);
#undef MK_MAXSTEP
    gq = fmaxf(gq, xget32(gq, lane >> 5)); gk = fmaxf(gk, xget32(gk, lane >> 5));
    const float bound = 64.0f * gq * gk * C2 * 1.01f; return __builtin_amdgcn_readfirstlane((int)(bound <= 14.0f)) != 0;
}

struct Args { const float* in[20]; float* out; unsigned char* ws; int ph_lo, ph_hi, li, pad; };
constexpr int N_PHASES = 2 + 10 * DEPTH;

typedef const __attribute__((address_space(4))) Args* kargs_t;
__device__ __forceinline__ kargs_t kargs_opaque() { kargs_t p = (kargs_t)__builtin_amdgcn_kernarg_segment_ptr(); asm volatile("" : "+s"(p)); return p; }
#define PH_BEGIN() kargs_t ap = kargs_opaque(); unsigned char* ws = ap->ws; (void)ws; \
    int wave = wave_s; asm volatile("" : "+s"(wave)); const int lane = lane_id_asm(); const int tid = wave * 64 + lane; (void)lane; (void)tid; \
    int bx = blockIdx.x; asm volatile("" : "+s"(bx)); int G = gridDim.x; asm volatile("" : "+s"(G)); const int vcu = (G % 8 == 0) ? (bx % 8) * (G / 8) + bx / 8 : bx; (void)vcu; \
    const int gw = vcu * NWAVES + wave, NGW = G * NWAVES; (void)gw; (void)NGW; const int gtid = vcu * (NWAVES * 64) + tid, NGT = G * NWAVES * 64; (void)gtid; (void)NGT
#define INP(k) (ap->in[k])
#define x_in INP(0)
#define c_in INP(1)
#define w_ada INP(2)
#define b_ada INP(3)
#define norm1_g INP(4)
#define w_in INP(5)
#define q_norm_g INP(6)
#define k_norm_g INP(7)
#define rel_bias INP(8)
#define w_br_a INP(9)
#define w_br_b INP(10)
#define w_out INP(11)
#define norm2_g INP(12)
#define w_router INP(13)
#define b_router INP(14)
#define w_gate_up INP(15)
#define b_gate_up INP(16)
#define w_down INP(17)
#define b_down INP(18)
#define final_g INP(19)
#define MOD ((float*)(ws + WS_MOD))
#define ROPE ((float*)(ws + WS_ROPE))
#define BLUT ((float*)(ws + WS_BLUT))
#define RC0 ((float*)(ws + WS_RC0))
#define HIST ((int*)(ws + WS_HIST))
#define TILEE ((int*)(ws + WS_TILEE))
#define TOPE ((int*)(ws + WS_TOPE))
#define TOPW ((float*)(ws + WS_TOPW))
#define SLOT ((int*)(ws + WS_SLOT))
#define ROWW ((float*)(ws + WS_ROWW))
#define LSE ((float*)(ws + WS_LSE))
#define WRHI ((bf16*)(ws + WS_WRHI))
#define WRLO ((bf16*)(ws + WS_WRLO))
#define WIN ((unsigned char*)(ws + WS_WIN))
#define WBRA ((unsigned char*)(ws + WS_WBRA))
#define WBRB ((unsigned char*)(ws + WS_WBRB))
#define WOUT ((unsigned char*)(ws + WS_WOUT))
#define WGU ((unsigned char*)(ws + WS_WGU))
#define WDN ((unsigned char*)(ws + WS_WDN))
#define X ((float*)(ws + WS_X))
#define H ((bf16*)(ws + WS_H))
#define AQKV ((bf16*)(ws + WS_AQKV))
#define QB ((bf16*)(ws + WS_QB))
#define KB ((bf16*)(ws + WS_KB))
#define VB ((bf16*)(ws + WS_VB))
#define GATE ((bf16*)(ws + WS_GATE))
#define OAG ((bf16*)(ws + WS_OAG))
#define OA ((unsigned char*)(ws + WS_OA))
#define MERGED ((bf16*)(ws + WS_MERGED))
#define OB ((unsigned char*)(ws + WS_OB))
#define M8 ((unsigned char*)(ws + WS_M8))
#define XS ((unsigned char*)(ws + WS_XS))
#define ACT ((unsigned char*)(ws + WS_ACT))
#define YB ((bf16*)(ws + WS_Y))
__global__ void __launch_bounds__(NWAVES * 64, 2) mk_fwd(Args args) {
    extern __shared__ __attribute__((aligned(16))) unsigned char lds[];
    LAS unsigned char* L = (LAS unsigned char*)lds;
    volatile LAS unsigned* MISC = (volatile LAS unsigned*)(L + LDSCTL_OFF);
    gu32* ctl = (gu32*)(args.ws + WS_CTL);
    const int wave_s = __builtin_amdgcn_readfirstlane(threadIdx.x >> 6);
    for (int u = threadIdx.x; u < (LDS_BYTES - LDSCTL_OFF) / 4; u += NWAVES * 64) ((LAS unsigned*)(L + LDSCTL_OFF))[u] = 0u;
    __syncthreads();
    XcdBarrier bar; bar.bar = (unsigned*)(ctl + CW_BAR) + args.li * XCD_BAR_WORDS; bar.x = 0; bar.st = nullptr;
    if (!MK_PER_PHASE) bar = xcd_barrier_post((unsigned*)(ctl + CW_BAR) + args.li * XCD_BAR_WORDS, MISC + 8);
    const int lo = args.ph_lo, hi = args.ph_hi;
#define IN(k) (lo <= (k) && (k) < hi)
#define KIND(q) ((PH_KIND_MASK >> (q)) & 1)
#define SEAM(k) do { if (IN(k) && IN((k) + 1)) xcd_barrier(bar); } while (0)

    for (int rep0 = 0; rep0 < 1 + PROBE_P0; ++rep0) {
    if (KIND(0) && IN(0)) { PH_BEGIN();
        {
            LAS float* cact = (LAS float*)L;
            LAS float* part = (LAS float*)(L + 32768);
            for (int i = tid; i < NB * D; i += NWAVES * 64) { const float cv = c_in[i]; cact[i] = cv / (1.0f + __expf(-cv)); }
            __syncthreads();
            for (int vb = bx; vb < 256; vb += G) {
                const int gc = vb * 48 + lane;
                const int l = gc / 6144, col = gc % 6144;
                float a[NB];
#pragma unroll
                for (int b = 0; b < NB; ++b) a[b] = 0.f;
                if (lane < 48) {
                    const float* wp = w_ada + (size_t)l * D * 6144 + col;
                    for (int k = wave * 128; k < wave * 128 + 128; ++k) { const float w = wp[(size_t)k * 6144];
#pragma unroll
                        for (int b = 0; b < NB; ++b) a[b] += cact[b * D + k] * w; }
                }
#pragma unroll
                for (int b = 0; b < NB; ++b) part[(wave * NB + b) * 64 + lane] = a[b];
                __syncthreads();
                if (tid < NB * 48) { const int b = tid / 48, cl = tid % 48; const int gc2 = vb * 48 + cl; const int l2 = gc2 / 6144, col2 = gc2 % 6144;
                    float s = b_ada[l2 * 6144 + col2];
#pragma unroll
                    for (int w = 0; w < NWAVES; ++w) s += part[(w * NB + b) * 64 + cl];
                    MOD[((size_t)l2 * NB + b) * 6144 + col2] = s; }
                __syncthreads();
            }
        }
        for (int i = gtid; i < 1024 + 12 * 768; i += NGT) {
            if (i < 1024) { const int p = i >> 4, f = i & 15; const double inv = pow(10000.0, -(double)f / 16.0); const double ang = (double)p * inv; ROPE[i] = (float)cos(ang); ROPE[1024 + i] = (float)sin(ang); }
            else { const int j = i - 1024; const int hh = j / 768, di = j % 768; const int delta = di - 383; const int g = hh >> 2; const int dil = g == 0 ? 1 : (g == 1 ? 4 : 16);
                float val = -INFINITY;
                if (delta >= -64 && delta <= 64) { const int rel = delta * dil; const int n = rel < 0 ? -rel : rel; int bk = rel > 0 ? 16 : 0;
                    if (n < 8) bk += n; else { int lg = 8 + (int)(logf((float)n / 8.0f) / logf(128.0f) * 8.0f); if (lg > 15) lg = 15; bk += lg; }
                    val = rel_bias[bk * 12 + hh] * LOG2E; }
                BLUT[j] = val; }
        }
        {
            LAS float* scr = (LAS float*)(L + wave * 16640);
            __syncthreads();
            constexpr int I_IN = 16 * 92, I_BRA = 4 * 16, I_BRB = 16 * 16, I_OUT = 16 * 16, I_GU = 16 * 32, I_DN = 16 * 16;
            constexpr int PER_L = I_IN + I_BRA + I_BRB + I_OUT;
            constexpr int NITEMS = DEPTH * PER_L + DEPTH * NE * (I_GU + I_DN);
            for (int it = gw; it < NITEMS; it += NGW) {
                int r = it;
                if (r < DEPTH * PER_L) {
                    const int l = r / PER_L; r %= PER_L;
                    if (r < I_IN) { const int kb = r / 92, g64 = r % 92; cvt_item_f8(w_in + (size_t)l * D * N_IN, N_IN, D, win_src(2 * g64), win_src(2 * g64 + 1), WIN + (size_t)l * N_IN * D, 64 * g64, 64 * kb, scr, lane, (g64 >> 2) >= 9 && (g64 >> 2) < 14); continue; } r -= I_IN;
                    if (r < I_BRA) { const int kb = r / 16, g64 = r % 16; cvt_item_f8(w_br_a + (size_t)l * 256 * D, D, 256, 64 * g64, 64 * g64 + 32, WBRA + (size_t)l * D * 256, 64 * g64, 64 * kb, scr, lane); continue; } r -= I_BRA;
                    if (r < I_BRB) { const int kb = r / 16, g64 = r % 16; cvt_item_f8(w_br_b + (size_t)l * D * D, D, D, 64 * g64, 64 * g64 + 32, WBRB + (size_t)l * D * D, 64 * g64, 64 * kb, scr, lane); continue; } r -= I_BRB;
                    { const int kb = r / 16, g64 = r % 16; cvt_item_f8(w_out + (size_t)l * D * D, D, D, 64 * g64, 64 * g64 + 32, WOUT + (size_t)l * D * D, 64 * g64, 64 * kb, scr, lane); continue; }
                }
                r -= DEPTH * PER_L;
                if (r < DEPTH * NE * I_GU) { const int le = r / I_GU; r %= I_GU; const int kb = r / 32, g64 = r % 32;
                    cvt_item_f8(w_gate_up + (size_t)le * D * 2048, 2048, D, wgu_src(2 * g64), wgu_src(2 * g64 + 1), WGU + (size_t)le * 2048 * D, 64 * g64, 64 * kb, scr, lane); continue; }
                r -= DEPTH * NE * I_GU;
                { const int le = r / I_DN; r %= I_DN; const int kb = r / 16, g64 = r % 16;
                    cvt_item_f8(w_down + (size_t)le * D * D, D, D, 64 * g64, 64 * g64 + 32, WDN + (size_t)le * D * D, 64 * g64, 64 * kb, scr, lane); }
            }
        }
    }
    SEAM(0);
    }
    if (KIND(1) && IN(1)) { PH_BEGIN();
        for (int m = 2 * gw; m < T; m += 2 * NGW) { const int b = m >> 12; const float* md = MOD + (size_t)b * 6144;
            norm_rows2_f8(x_in + (size_t)m * D, norm1_g, md + 1024, md, (unsigned char*)H + (size_t)m * D, lane); }
        for (int i = gtid; i < DEPTH * NB * NE * D; i += NGT) { const int k = i & 1023, e = (i >> 10) & 31, b = (i >> 15) & 7, l = i >> 18;
            const float v = norm2_g[l * D + k] * (1.0f + MOD[((size_t)l * NB + b) * 6144 + 4 * 1024 + k]) * w_router[((size_t)l * D + k) * NE + e];
            const unsigned hb = f2bf(v); const float lv = v - __uint_as_float(hb << 16);
            WRHI[i] = (bf16)hb; WRLO[i] = (bf16)f2bf(lv); }
        for (int i = gw; i < DEPTH * NB * NE; i += NGW) { const int e = i & 31, b = (i >> 5) & 7, l = i >> 8; float s = 0.f;
            for (int k = lane; k < D; k += 64) s += MOD[((size_t)l * NB + b) * 6144 + 3 * 1024 + k] * w_router[((size_t)l * D + k) * NE + e];
            s = wave_sum(s); if (lane == 0) RC0[i] = s + b_router[l * NE + e]; }
    }
    SEAM(1);

    for (int li = (PROBE_MASK ? -1 : 0); li < DEPTH; ++li) {
        const int l = li < 0 ? 0 : li; const bool virt = li < 0;
        const int P = 2 + 10 * l;
#define VK(q) (!virt || ((PROBE_MASK >> (q)) & 1))
        if (KIND(2) && IN(P + 0) && VK(2)) { PH_BEGIN();
            pg8::Gemm g{H, (const bf16*)(WIN + (size_t)l * N_IN * D), D / 2}; pg8::StaticOrder S; S.init(T, N_IN, G, bx);
            const bool f8attn = gqa_bound_ok(q_norm_g + l * 64, k_norm_g + l * 64, lane);
            pg8::EpiIn E{AQKV, QB, KB, VB, GATE, q_norm_g + l * 64, k_norm_g + l * 64, ROPE, pg8::W8_INV, f8attn};
            pg8::gemm_phase_f8<pg8::EpiIn, pg8::StaticOrder>(L, g, S, E, wave);
        }
        if (VK(2)) SEAM(P + 0);
        if (KIND(3) && IN(P + 1) && VK(3)) { PH_BEGIN();
            namespace ab = attn_body;
            const bool nomax = gqa_bound_ok(q_norm_g + l * 64, k_norm_g + l * 64, lane);
            for (int j = 0; j < 8; ++j) {
                const int uidx = vcu * 8 + j; if (uidx >= 2048) break;
                const int pair = uidx >> 6, idx = uidx & 63; const int b = pair >> 2, kvh = pair & 3, hq = idx >> 4, qb = idx & 15; const int h = kvh * 4 + hq;
                ab::Job J; J.Q = (const ab::bf16*)QB + ((size_t)b * SEQ + qb * 256) * 1024 + h * 64; J.K = (const ab::bf16*)KB + (size_t)b * SEQ * 256 + kvh * 64; J.V = (const ab::bf16*)VB + (size_t)b * SEQ * 256 + kvh * 64;
                J.O = (ab::bf16*)(OB + ((size_t)b * SEQ + qb * 256) * 1024 + h * 64)  ; J.lse = nullptr; J.lutg = nullptr; J.NT = 64; J.i0 = 0; J.kq0 = 0; J.dsh = 0; J.cls = 0;
                if (nomax) { attn8::Job J8; J8.Q = (const unsigned char*)QB + ((size_t)b * SEQ + qb * 256) * 1024 + h * 64; J8.K = (const unsigned char*)KB + (size_t)b * SEQ * 256 + kvh * 64;
                    J8.VT = (const unsigned char*)VB + ((size_t)((b * 4 + kvh) * 64) << 12); J8.O = OB + ((size_t)b * SEQ + qb * 256) * 1024 + h * 64;
                    attn8::attn_unit_f8<64>(J8, (char*)lds, wave); }
                else ab::attn_unit<0, 8, false>(J, (char*)lds, wave);
            }
            for (int j = 0; j < 6; ++j) {
                const int uidx = vcu * 6 + j; if (uidx >= 1536) break;
                const int g = uidx / 512, r = uidx % 512; const int b = r >> 6, hs = (r >> 4) & 3, combo = r & 15;
                const int dsh = 2 * g; const int Lc = SEQ >> dsh; const int nqb = Lc >> 8;
                const int cls = combo / nqb, qb = combo % nqb; const int i0 = qb * 256;
                int t0 = (i0 >> 6) - 1; const int ntile = Lc >> 6; const int NT = ntile >= 6 ? 6 : 4; if (t0 < 0) t0 = 0; if (t0 > ntile - NT) t0 = ntile - NT;
                const size_t cbase = (size_t)b * SEQ + (size_t)cls * Lc;
                const ab::bf16* aq = (const ab::bf16*)AQKV + (size_t)(g * 3 + 0) * T * 256; const ab::bf16* ak = (const ab::bf16*)AQKV + (size_t)(g * 3 + 1) * T * 256; const ab::bf16* av = (const ab::bf16*)AQKV + (size_t)(g * 3 + 2) * T * 256;
                ab::Job J; J.Q = aq + (cbase + i0) * 256 + hs * 64; J.K = ak + (cbase + t0 * 64) * 256 + hs * 64; J.V = av + (cbase + t0 * 64) * 256 + hs * 64;
                J.O = (ab::bf16*)OAG + (size_t)g * T * 256 + (size_t)b * SEQ * 256 + hs * 64; J.lse = LSE + (size_t)g * T * 4 + (size_t)b * SEQ * 4 + hs; J.lutg = BLUT + (g * 4 + hs) * 768;
                J.NT = NT; J.i0 = i0; J.kq0 = t0 * 64 - i0; J.dsh = dsh; J.cls = cls;
                ab::attn_unit<1, 8>(J, (char*)lds, wave);
            }
        }
        if (VK(3)) SEAM(P + 1);
        if (KIND(4) && IN(P + 2) && VK(4)) { PH_BEGIN();
            for (int i = gtid; i < T * 32; i += NGT) { const int t = i >> 5, ch = i & 31, hs = ch >> 3;
                const float l0 = LSE[(size_t)t * 4 + hs], l1 = LSE[(size_t)T * 4 + (size_t)t * 4 + hs], l2 = LSE[(size_t)2 * T * 4 + (size_t)t * 4 + hs];
                const float mx = fmaxf(l0, fmaxf(l1, l2)); float w0 = exp2f(l0 - mx), w1 = exp2f(l1 - mx), w2 = exp2f(l2 - mx); const float inv = 1.0f / (w0 + w1 + w2); w0 *= inv; w1 *= inv; w2 *= inv;
                const v4u a = *(const GAS v4u*)(OAG + (size_t)t * 256 + ch * 8), bq = *(const GAS v4u*)(OAG + (size_t)T * 256 + (size_t)t * 256 + ch * 8), cq = *(const GAS v4u*)(OAG + (size_t)2 * T * 256 + (size_t)t * 256 + ch * 8);
                unsigned o0 = 0, o1 = 0;
                o0 = __builtin_amdgcn_cvt_pk_fp8_f32(w0 * bfl(a.x) + w1 * bfl(bq.x) + w2 * bfl(cq.x), w0 * bfh(a.x) + w1 * bfh(bq.x) + w2 * bfh(cq.x), o0, false);
                o0 = __builtin_amdgcn_cvt_pk_fp8_f32(w0 * bfl(a.y) + w1 * bfl(bq.y) + w2 * bfl(cq.y), w0 * bfh(a.y) + w1 * bfh(bq.y) + w2 * bfh(cq.y), o0, true);
                o1 = __builtin_amdgcn_cvt_pk_fp8_f32(w0 * bfl(a.z) + w1 * bfl(bq.z) + w2 * bfl(cq.z), w0 * bfh(a.z) + w1 * bfh(bq.z) + w2 * bfh(cq.z), o1, false);
                o1 = __builtin_amdgcn_cvt_pk_fp8_f32(w0 * bfl(a.w) + w1 * bfl(bq.w) + w2 * bfl(cq.w), w0 * bfh(a.w) + w1 * bfh(bq.w) + w2 * bfh(cq.w), o1, true);
                v2u o; o.x = o0; o.y = o1; *(GAS v2u*)(OA + (size_t)t * 256 + ch * 8) = o; }
        }
        if (VK(4)) SEAM(P + 2);
        if (KIND(5) && IN(P + 3) && VK(5)) { PH_BEGIN();
            pg8::StaticOrder S; S.init(T, D, G, bx);
            { pg8::Gemm g{(const bf16*)OA, (const bf16*)(WBRA + (size_t)l * D * 256), 128}; pg8::EpiMergeA E{GATE, MERGED}; pg8::gemm_phase_f8<pg8::EpiMergeA, pg8::StaticOrder>(L, g, S, E, wave); }
            { pg8::Gemm g{(const bf16*)OB, (const bf16*)(WBRB + (size_t)l * D * D), D / 2}; pg8::EpiMergeB<true> E{GATE, MERGED, M8}; pg8::gemm_phase_f8<pg8::EpiMergeB<true>, pg8::StaticOrder>(L, g, S, E, wave); }
        }
        if (VK(5)) SEAM(P + 3);
        if (KIND(6) && IN(P + 4) && VK(6)) { PH_BEGIN();
            pg8::Gemm g{(const bf16*)M8, (const bf16*)(WOUT + (size_t)l * D * D), D / 2}; pg8::StaticOrder S; S.init(T, D, G, bx);
            pg8::EpiOut E{l == 0 ? x_in : X, X, MOD + (size_t)l * NB * 6144 + 2 * 1024};
            pg8::gemm_phase_f8<pg8::EpiOut, pg8::StaticOrder>(L, g, S, E, wave);
        }
        if (VK(6)) SEAM(P + 4);
        if (KIND(7) && IN(P + 5) && VK(7)) { PH_BEGIN();
            LAS int* hist = (LAS int*)(L + LDSCTL_OFF + 256);
            for (int vb = bx; vb < 256; vb += G) {
                if (tid < NE) hist[tid] = 0;
                __syncthreads();
                {
                    const int tt = vb + 256 * wave; const int r0 = tt * 16; const int b = r0 >> 12; const int i = lane & 15, kb = lane >> 4;
                    const float* xp = X + (size_t)(r0 + i) * D + 8 * kb;
                    const bf16* bh = WRHI + ((size_t)(l * NB + b) * NE + i) * D + 8 * kb; const bf16* bl = WRLO + ((size_t)(l * NB + b) * NE + i) * D + 8 * kb;
                    f32x4 acc0 = (f32x4){0.f, 0.f, 0.f, 0.f}, acc1 = acc0; float ss = 0.f;
#pragma unroll 4
                    for (int s = 0; s < 32; ++s) {
                        const f32x4 x0 = *(const GAS f32x4*)(xp + 32 * s), x1 = *(const GAS f32x4*)(xp + 32 * s + 4);
                        const bf16x8 wh0 = *(const GAS bf16x8*)(bh + 32 * s), wh1 = *(const GAS bf16x8*)(bh + 16 * D + 32 * s), wl0 = *(const GAS bf16x8*)(bl + 32 * s), wl1 = *(const GAS bf16x8*)(bl + 16 * D + 32 * s);
                        ss += (x0.x * x0.x + x0.y * x0.y) + (x0.z * x0.z + x0.w * x0.w) + (x1.x * x1.x + x1.y * x1.y) + (x1.z * x1.z + x1.w * x1.w);
                        v4u ah, al;
                        { const unsigned h0 = f2bf(x0.x), h1 = f2bf(x0.y), h2 = f2bf(x0.z), h3 = f2bf(x0.w), h4 = f2bf(x1.x), h5 = f2bf(x1.y), h6 = f2bf(x1.z), h7 = f2bf(x1.w);
                          ah.x = h0 | (h1 << 16); ah.y = h2 | (h3 << 16); ah.z = h4 | (h5 << 16); ah.w = h6 | (h7 << 16);
                          al.x = pk2(x0.x - __uint_as_float(h0 << 16), x0.y - __uint_as_float(h1 << 16)); al.y = pk2(x0.z - __uint_as_float(h2 << 16), x0.w - __uint_as_float(h3 << 16));
                          al.z = pk2(x1.x - __uint_as_float(h4 << 16), x1.y - __uint_as_float(h5 << 16)); al.w = pk2(x1.z - __uint_as_float(h6 << 16), x1.w - __uint_as_float(h7 << 16)); }
                        const bf16x8 ahv = __builtin_bit_cast(bf16x8, ah), alv = __builtin_bit_cast(bf16x8, al);
                        acc0 = __builtin_amdgcn_mfma_f32_16x16x32_bf16(wh0, ahv, acc0, 0, 0, 0); acc1 = __builtin_amdgcn_mfma_f32_16x16x32_bf16(wh1, ahv, acc1, 0, 0, 0);
                        acc0 = __builtin_amdgcn_mfma_f32_16x16x32_bf16(wl0, ahv, acc0, 0, 0, 0); acc1 = __builtin_amdgcn_mfma_f32_16x16x32_bf16(wl1, ahv, acc1, 0, 0, 0);
                        acc0 = __builtin_amdgcn_mfma_f32_16x16x32_bf16(wh0, alv, acc0, 0, 0, 0); acc1 = __builtin_amdgcn_mfma_f32_16x16x32_bf16(wh1, alv, acc1, 0, 0, 0);
                    }
                    ss = xsum<16>(ss); ss = xsum<32>(ss);
                    const float rs = rsqrtf(ss * (1.0f / D) + EPS);
                    float v[8]; const float* rc = RC0 + (l * NB + b) * NE;
#pragma unroll
                    for (int r = 0; r < 4; ++r) { v[r] = rs * acc0[r] + rc[4 * kb + r]; v[4 + r] = rs * acc1[r] + rc[16 + 4 * kb + r]; }
                    float tv[4]; int ti[4];
#pragma unroll
                    for (int k = 0; k < 4; ++k) { float best = v[0]; int br = 0;
#pragma unroll
                        for (int r = 1; r < 8; ++r) if (v[r] > best) { best = v[r]; br = r; }
#pragma unroll
                        for (int r = 0; r < 8; ++r) v[r] = (r == br) ? -INFINITY : v[r];
                        tv[k] = best; ti[k] = (br & 3) + 16 * (br >> 2) + 4 * kb; }
#pragma unroll
                    for (int round = 0; round < 2; ++round) {
                        float bv[8]; int bi[8];
#pragma unroll
                        for (int k = 0; k < 4; ++k) { bv[k] = tv[k]; bi[k] = ti[k];
                            if (round == 0) { bv[4 + k] = __int_as_float(__builtin_amdgcn_ds_swizzle(__float_as_int(tv[k]), 0x1f | (16 << 10))); bi[4 + k] = __builtin_amdgcn_ds_swizzle(ti[k], 0x1f | (16 << 10)); }
                            else { bv[4 + k] = xget32(tv[k], lane >> 5); bi[4 + k] = xget32(ti[k], lane >> 5); } }
#pragma unroll
                        for (int k = 0; k < 4; ++k) { float best = bv[0]; int bq = 0;
#pragma unroll
                            for (int r = 1; r < 8; ++r) if (bv[r] > best || (bv[r] == best && bi[r] < bi[bq])) { best = bv[r]; bq = r; }
                            int sel = bi[0];
#pragma unroll
                            for (int r = 0; r < 8; ++r) { if (r == bq) sel = bi[r]; }
#pragma unroll
                            for (int r = 0; r < 8; ++r) bv[r] = (r == bq) ? -INFINITY : bv[r];
                            tv[k] = best; ti[k] = sel; }
                    }
                    if (kb == 0) {
                        const float e1 = __expf(tv[1] - tv[0]), e2 = __expf(tv[2] - tv[0]), e3 = __expf(tv[3] - tv[0]); const float inv = 1.0f / (1.0f + e1 + e2 + e3);
                        const int tok = r0 + i;
                        *(GAS i32x4*)(TOPE + (size_t)tok * 4) = (i32x4){ti[0], ti[1], ti[2], ti[3]};
                        *(GAS f32x4*)(TOPW + (size_t)tok * 4) = (f32x4){inv, e1 * inv, e2 * inv, e3 * inv};
#pragma unroll
                        for (int k = 0; k < 4; ++k) atomicAdd((int*)&hist[ti[k]], 1);
                    }
                }
                __syncthreads();
                if (tid < NE) HIST[vb * NE + tid] = hist[tid];
                __syncthreads();
            }
            for (int m = 2 * gw; m < T; m += 2 * NGW) { const int b = m >> 12; const float* md = MOD + ((size_t)l * NB + b) * 6144;
                norm_rows2_f8(X + (size_t)m * D, norm2_g + l * D, md + 4 * 1024, md + 3 * 1024, (unsigned char*)H + (size_t)m * D, lane); }
        }
        if (VK(7)) SEAM(P + 5);
        if (KIND(8) && IN(P + 6) && VK(8)) { PH_BEGIN();
            LAS int* sm = (LAS int*)L;
            for (int vb = bx; vb < 256; vb += G) {
                { const int e = tid & 31, seg = tid >> 5; int tot = 0, bef = 0;
                    for (int q = seg * 16; q < seg * 16 + 16; ++q) { const int hv = HIST[q * NE + e]; tot += hv; if (q < vb) bef += hv; }
                    sm[tid] = tot; sm[512 + tid] = bef; }
                __syncthreads();
                if (tid < NE) { int tot = 0, bef = 0;
                    for (int s = 0; s < 16; ++s) { tot += sm[s * 32 + tid]; bef += sm[512 + s * 32 + tid]; }
                    sm[1024 + tid] = bef; sm[1056 + tid] = (tot + 255) & ~255; }
                __syncthreads();
                if (tid == 0) { int run = 0; for (int e = 0; e < NE; ++e) { const int pd = sm[1056 + e]; sm[1056 + e] = run; sm[1024 + e] += run;
                        if (vb == 0) { for (int q = run >> 8; q < (run + pd) >> 8; ++q) TILEE[q] = e; }
                        run += pd; }
                    if (vb == 0) TILEE[1000] = run >> 8; }
                __syncthreads();
                if (tid < 128) { const int tt = vb + 256 * (tid >> 4); const int tok = tt * 16 + (tid & 15);
                    const i32x4 te = *(const GAS i32x4*)(TOPE + (size_t)tok * 4); const f32x4 tw = *(const GAS f32x4*)(TOPW + (size_t)tok * 4);
                    const int s0 = atomicAdd((int*)&sm[1024 + te.x], 1), s1 = atomicAdd((int*)&sm[1024 + te.y], 1), s2 = atomicAdd((int*)&sm[1024 + te.z], 1), s3 = atomicAdd((int*)&sm[1024 + te.w], 1);
                    *(GAS i32x4*)(SLOT + (size_t)tok * 4) = (i32x4){s0, s1, s2, s3};
                    ROWW[s0] = tw.x; ROWW[s1] = tw.y; ROWW[s2] = tw.z; ROWW[s3] = tw.w;
                    sm[2048 + tid * 4 + 0] = s0; sm[2048 + tid * 4 + 1] = s1; sm[2048 + tid * 4 + 2] = s2; sm[2048 + tid * 4 + 3] = s3; }
                __syncthreads();
                for (int p = wave; p < 512; p += NWAVES) { const int q = p >> 2; const int tt = vb + 256 * (q >> 4); const int tok = tt * 16 + (q & 15); const int slot = sm[2048 + p];
                    const GAS v4u* src = (const GAS v4u*)((unsigned char*)H + (size_t)tok * D); GAS v4u* dst = (GAS v4u*)(XS + (size_t)slot * D);
                    dst[lane] = src[lane]; }
                __syncthreads();
            }
        }
        if (VK(8)) SEAM(P + 6);
        if (KIND(9) && IN(P + 7) && VK(9)) { PH_BEGIN();
            const int nmt = __builtin_amdgcn_readfirstlane(__hip_atomic_load(TILEE + 1000, __ATOMIC_RELAXED, __HIP_MEMORY_SCOPE_AGENT));
            pg8::Gemm g{(const bf16*)XS, (const bf16*)(WGU + (size_t)l * NE * 2048 * D), D / 2}; pg8::MoeOrder S{TILEE, nmt * 8, 8, G, vcu};
            pg8::EpiGU8 E{b_gate_up + (size_t)l * NE * 2048, ACT};
            pg8::gemm_phase_f8<pg8::EpiGU8, pg8::MoeOrder>(L, g, S, E, wave);
        }
        if (VK(9)) SEAM(P + 7);
        if (KIND(10) && IN(P + 8) && VK(10)) { PH_BEGIN();
            const int nmt = __builtin_amdgcn_readfirstlane(__hip_atomic_load(TILEE + 1000, __ATOMIC_RELAXED, __HIP_MEMORY_SCOPE_AGENT));
            pg8::Gemm g{(const bf16*)ACT, (const bf16*)(WDN + (size_t)l * NE * D * D), D / 2}; pg8::MoeOrder S{TILEE, nmt * 4, 4, G, vcu};
            pg8::EpiDN8 E{b_down + (size_t)l * NE * D, ROWW, YB};
            pg8::gemm_phase_f8<pg8::EpiDN8, pg8::MoeOrder>(L, g, S, E, wave);
        }
        if (VK(10)) SEAM(P + 8);
        if (KIND(11) && IN(P + 9) && VK(11)) { PH_BEGIN();
            const bool lastl = (l == DEPTH - 1);
            float* Xw = virt ? (float*)(ws + WS_R) : X; bf16* Hw = virt ? (bf16*)(ws + WS_R + 128 * MiB) : H;
            for (int m0 = 2 * gw; m0 < T; m0 += 2 * NGW) { const int b = m0 >> 12;
                i32x4 sl[2];
#pragma unroll
                for (int q = 0; q < 2; ++q) { const int* sp = SLOT + (size_t)(m0 + q) * 4;
                    sl[q].x = __hip_atomic_load(sp + 0, RLX_AGENT); sl[q].y = __hip_atomic_load(sp + 1, RLX_AGENT); sl[q].z = __hip_atomic_load(sp + 2, RLX_AGENT); sl[q].w = __hip_atomic_load(sp + 3, RLX_AGENT); }
                const float* g2 = MOD + ((size_t)l * NB + b) * 6144 + 5 * 1024;
                f32x4 v[2][4]; v2u yy[2][4][4];
#pragma unroll
                for (int q = 0; q < 2; ++q)
#pragma unroll
                    for (int j = 0; j < 4; ++j) { const int c = 256 * j + 4 * lane;
                        v[q][j] = *(const GAS f32x4*)(X + (size_t)(m0 + q) * D + c);
                        yy[q][j][0] = *(const GAS v2u*)(YB + (size_t)sl[q].x * D + c); yy[q][j][1] = *(const GAS v2u*)(YB + (size_t)sl[q].y * D + c);
                        yy[q][j][2] = *(const GAS v2u*)(YB + (size_t)sl[q].z * D + c); yy[q][j][3] = *(const GAS v2u*)(YB + (size_t)sl[q].w * D + c); }
                float s[2] = {0.f, 0.f};
#pragma unroll
                for (int q = 0; q < 2; ++q)
#pragma unroll
                    for (int j = 0; j < 4; ++j) { const int c = 256 * j + 4 * lane; const v2u y0 = yy[q][j][0], y1 = yy[q][j][1], y2 = yy[q][j][2], y3 = yy[q][j][3];
                        f32x4 ys; ys.x = (bfl(y0.x) + bfl(y1.x)) + (bfl(y2.x) + bfl(y3.x)); ys.y = (bfh(y0.x) + bfh(y1.x)) + (bfh(y2.x) + bfh(y3.x));
                        ys.z = (bfl(y0.y) + bfl(y1.y)) + (bfl(y2.y) + bfl(y3.y)); ys.w = (bfh(y0.y) + bfh(y1.y)) + (bfh(y2.y) + bfh(y3.y));
                        const f32x4 gg = *(const GAS f32x4*)(g2 + c);
                        v[q][j] = v[q][j] + gg * ys;
                        if (!lastl) *(GAS f32x4*)(Xw + (size_t)(m0 + q) * D + c) = v[q][j];
                        s[q] += (v[q][j].x * v[q][j].x + v[q][j].y * v[q][j].y) + (v[q][j].z * v[q][j].z + v[q][j].w * v[q][j].w); }
                const float rs0 = rsqrtf(wave_sum(s[0]) * (1.0f / D) + EPS), rs1 = rsqrtf(wave_sum(s[1]) * (1.0f / D) + EPS);
                if (!lastl) { const float* md = MOD + ((size_t)(l + 1) * NB + b) * 6144; const float* gn = norm1_g + (l + 1) * D;
#pragma unroll
                    for (int j = 0; j < 4; ++j) { const int c = 256 * j + 4 * lane;
                        const f32x4 gg = *(const GAS f32x4*)(gn + c), a1 = *(const GAS f32x4*)(md + 1024 + c) + 1.0f, a0 = *(const GAS f32x4*)(md + c);
                        const f32x4 y0 = (v[0][j] * rs0 * gg) * a1 + a0, y1 = (v[1][j] * rs1 * gg) * a1 + a0;
                        unsigned w0 = 0, w1 = 0;
                        w0 = __builtin_amdgcn_cvt_pk_fp8_f32(y0.x, y0.y, w0, false); w0 = __builtin_amdgcn_cvt_pk_fp8_f32(y0.z, y0.w, w0, true);
                        w1 = __builtin_amdgcn_cvt_pk_fp8_f32(y1.x, y1.y, w1, false); w1 = __builtin_amdgcn_cvt_pk_fp8_f32(y1.z, y1.w, w1, true);
                        *(GAS unsigned*)((unsigned char*)Hw + (size_t)m0 * D + c) = w0; *(GAS unsigned*)((unsigned char*)Hw + (size_t)(m0 + 1) * D + c) = w1; }
                } else {
#pragma unroll
                    for (int j = 0; j < 4; ++j) { const int c = 256 * j + 4 * lane; const f32x4 gg = *(const GAS f32x4*)(final_g + c);
                        *(GAS f32x4*)(ap->out + (size_t)m0 * D + c) = v[0][j] * rs0 * gg; *(GAS f32x4*)(ap->out + (size_t)(m0 + 1) * D + c) = v[1][j] * rs1 * gg; }
                }
            }
        }
        if (VK(11)) SEAM(P + 9);
        if (virt) { PH_BEGIN();
            for (int m = 2 * gw; m < T; m += 2 * NGW) { const int b = m >> 12; const float* md = MOD + (size_t)b * 6144; norm_rows2_f8(x_in + (size_t)m * D, norm1_g, md + 1024, md, (unsigned char*)H + (size_t)m * D, lane); }
            xcd_barrier(bar); }
    }
#undef IN
#undef SEAM
}

extern "C" void kernel_launch(void* const* d_in, const int* in_sizes, int n_in, void* d_out, int out_size, void* d_ws, size_t ws_size, hipStream_t stream) {
    static int grid = 0;
    if (grid == 0) {
        if (n_in != 20 || in_sizes[0] != T * D || out_size != T * D || ws_size < WS_END) { fprintf(stderr, "kernel_launch: unexpected shapes (n_in %d, in0 %d, out %d, ws %zu < %zu); nothing launched\n", n_in, n_in > 0 ? in_sizes[0] : -1, out_size, ws_size, (size_t)WS_END); grid = -1; return; }
        int dev = 0, cus = 0, per_cu = 0;
        if (hipGetDevice(&dev) != hipSuccess || hipDeviceGetAttribute(&cus, hipDeviceAttributeMultiprocessorCount, dev) != hipSuccess) { grid = -1; return; }
        if (hipFuncSetAttribute((const void*)mk_fwd, hipFuncAttributeMaxDynamicSharedMemorySize, LDS_BYTES) != hipSuccess) { fprintf(stderr, "kernel_launch: hipFuncSetAttribute failed\n"); grid = -1; return; }
        if (hipOccupancyMaxActiveBlocksPerMultiprocessor(&per_cu, (const void*)mk_fwd, NWAVES * 64, LDS_BYTES) != hipSuccess || per_cu < 1)
            fprintf(stderr, "kernel_launch: note: occupancy query reports %d workgroups per CU\n", per_cu);
        (void)hipGetLastError();
        grid = cus < 256 ? cus : 256;
        if (grid != 256) fprintf(stderr, "kernel_launch: %d CUs; this kernel's unit deals assume 256\n", grid);
    }
    if (grid < 0) return;
    if (hipMemsetAsync((char*)d_ws + WS_CTL, 0, CTL_ZERO_BYTES, stream) != hipSuccess) { fprintf(stderr, "kernel_launch: memset failed\n"); return; }
    Args a{};
    for (int i = 0; i < 20; ++i) a.in[i] = (const float*)d_in[i];
    a.out = (float*)d_out; a.ws = (unsigned char*)d_ws; a.pad = 0;
#if MK_PER_PHASE
    for (int p = 0; p < N_PHASES; ++p) { a.ph_lo = p; a.ph_hi = p + 1; a.li = 0; hipLaunchKernelGGL(mk_fwd, dim3(grid), dim3(NWAVES * 64), LDS_BYTES, stream, a); }
#else
    a.ph_lo = 0; a.ph_hi = N_PHASES; a.li = 0;
    hipLaunchKernelGGL(mk_fwd, dim3(grid), dim3(NWAVES * 64), LDS_BYTES, stream, a);
#endif
    const hipError_t le = hipPeekAtLastError();
    if (le != hipSuccess) fprintf(stderr, "kernel_launch: launch failed: %s\n", hipGetErrorName(le));
}
```

```cpp
#include <hip/hip_runtime.h>
#include <hip/hip_bf16.h>
#include <cstdio>
#include <cstdint>
#include <cmath>

#ifndef PH_KIND_MASK
#define PH_KIND_MASK 0xFFF
#endif
#ifndef PROBE_MASK
#define PROBE_MASK 0
#endif
#ifndef PROBE_P0
#define PROBE_P0 0
#endif
#ifndef MK_PER_PHASE
#define MK_PER_PHASE 0
#endif

constexpr int NB = 8, SEQ = 4096, T = NB * SEQ, D = 1024, DEPTH = 2;
constexpr int N_IN = 5888, NE = 32, TOPK = 4;
constexpr int NASSIGN = T * TOPK;
constexpr int MAX_MT = NASSIGN / 256 + NE;
constexpr int CAP_ROWS = MAX_MT * 256;
constexpr float C2 = 0.125f * 1.4426950408889634f;
constexpr float LOG2E = 1.4426950408889634f;
constexpr float EPS = 1e-6f;

__device__ __forceinline__ int lane_id_asm() { int l; asm volatile("v_mbcnt_lo_u32_b32 %0, -1, 0\n\tv_mbcnt_hi_u32_b32 %0, -1, %0" : "=v"(l)); return l; }

template <int M> __device__ __forceinline__ float xsum(float v) {
    if constexpr (M < 32) return v + __int_as_float(__builtin_amdgcn_ds_swizzle(__float_as_int(v), 0x1f | (M << 10)));
    else { auto rr = __builtin_amdgcn_permlane32_swap(__float_as_uint(v), __float_as_uint(v), false, false); return __uint_as_float(rr[0]) + __uint_as_float(rr[1]); }
}
template <class Tv> __device__ __forceinline__ Tv xget32(Tv v, int hf) {
    auto rr = __builtin_amdgcn_permlane32_swap(__builtin_bit_cast(unsigned, v), __builtin_bit_cast(unsigned, v), false, false); return __builtin_bit_cast(Tv, hf ? rr[0] : rr[1]);
}

namespace pg8 {
#define PG8_LAS __attribute__((address_space(3)))
typedef unsigned short bf16_t;
typedef short bf16x8 __attribute__((ext_vector_type(8)));
typedef float f32x4 __attribute__((ext_vector_type(4)));
typedef unsigned u32x4 __attribute__((ext_vector_type(4)));
typedef unsigned u32x2 __attribute__((ext_vector_type(2)));
constexpr int BM = 256, BK = 64, HALF = 128, HTB = HALF * BK * 2, STAGE_BYTES = 8 * HTB, NXCD = 8, WGM = 8;

__host__ __device__ __forceinline__ int lds_byte(int r, int c) { const int st = (r >> 4) * 2 + (c >> 5), rr = r & 15, cc = c & 31, ob = rr * 64 + cc * 2; return st * 1024 + (ob ^ (((ob >> 9) & 1) << 5)); }
__host__ __device__ __forceinline__ void stage_rc(int b, int& R, int& C) { const int st = b / 1024, sb = b % 1024, swz = sb ^ (((sb >> 9) & 1) << 5); R = (st >> 1) * 16 + swz / 64; C = (st & 1) * 32 + (swz % 64) / 2; }
__host__ __device__ __forceinline__ int perm32(int rho) { const int n = rho >> 4, i = rho & 15; return 8 * (i >> 2) + 4 * n + (i & 3); }

struct Unit { int pm, pn; };
struct Gemm { const bf16_t* A; const bf16_t* Bt; int K; };

struct StaticOrder {
    int nM, nN, nwg, G, c;
    __device__ void init(int M, int N, int G_, int c_) { nM = M / BM; nN = N / BM; nwg = nM * nN; G = G_; c = c_; }
    __device__ bool next(int i, Unit& u) const {
        const long L = (long)i * G + c; if (L >= nwg) return false;
        int wgid = (int)L; { const int q = nwg / NXCD, r = nwg % NXCD, xcd = wgid % NXCD, off = wgid / NXCD; wgid = (xcd < r ? xcd * (q + 1) : r * (q + 1) + (xcd - r) * q) + off; }
        const int nig = WGM * nN, gid = wgid / nig, fm = gid * WGM, gsz = (nM - fm) < WGM ? (nM - fm) : WGM;
        u.pm = fm + ((wgid % nig) % gsz); u.pn = (wgid % nig) / gsz; return true;
    }
};
struct MoeOrder {
    const int* tile_e; int n_units, nN, G, vcu;
    __device__ bool next(int i, Unit& u) const {
        const long L = (long)i * G + vcu; if (L >= n_units) return false;
        const int mt = (int)L / nN, pl = (int)L % nN; const int e = __builtin_amdgcn_readfirstlane(__hip_atomic_load(tile_e + mt, __ATOMIC_RELAXED, __HIP_MEMORY_SCOPE_AGENT));
        u.pm = mt; u.pn = e * nN + pl; return true;
    }
};

__device__ __forceinline__ unsigned cvt_pk_bf16(float lo, float hi) { unsigned r; asm volatile("v_cvt_pk_bf16_f32 %0, %1, %2" : "=v"(r) : "v"(lo), "v"(hi)); return r; }
__device__ __forceinline__ float bf_lo(unsigned w) { return __uint_as_float(w << 16); }
__device__ __forceinline__ float bf_hi(unsigned w) { return __uint_as_float(w & 0xffff0000u); }
__device__ __forceinline__ float sigmoid_f(float x) { return __builtin_amdgcn_rcpf(1.0f + __builtin_amdgcn_exp2f(-LOG2E * x)); }

template <class Epi, class Sched>
__device__ __forceinline__ void gemm_phase(PG8_LAS unsigned char* lds, const Gemm g, const Sched& S, const Epi& E, const int wid_in) {
    int wid = wid_in; asm volatile("" : "+s"(wid));
    const int lane = lane_id_asm(), tid = wid * 64 + lane, wr = wid >> 2, wc = wid & 3, fr = lane & 15, fq = lane >> 4;
    int K_o = g.K; asm volatile("" : "+s"(K_o)); const int K = K_o, nt = K / BK;
    unsigned voff[2];
#pragma unroll
    for (int i = 0; i < 2; ++i) { int R, C; stage_rc(tid * 16 + i * 8192, R, C); voff[i] = (unsigned)(R * K + C) * 2u; }
    const size_t kstep = (size_t)(BK * 2);
    const size_t hstep = (size_t)HALF * K * 2;
    const size_t tstep = 2 * hstep;
    const unsigned ldsw = (unsigned)wid * 1024u;
    const int aoff = lds_byte(wr * 64 + fr, fq * 8), boff = lds_byte(wc * 32 + fr, fq * 8);
#define PG8_SA(b, h) (((b) * 2 + (h)) * HTB)
#define PG8_SB(b, h) ((4 + (b) * 2 + (h)) * HTB)
#define PG8_STAGE(bufoff, gbase) do { _Pragma("unroll") for (int _i = 0; _i < 2; ++_i) \
        __builtin_amdgcn_global_load_lds((const unsigned*)((const char*)(gbase) + voff[_i]), (PG8_LAS unsigned*)(lds + (bufoff) + ldsw + _i * 8192), 16, 0, 0); } while (0)
#define PG8_LDA(dst, b, h) do { _Pragma("unroll") for (int m = 0; m < 4; ++m) _Pragma("unroll") for (int k = 0; k < 2; ++k) dst[m][k] = *(const PG8_LAS bf16x8*)(lds + PG8_SA(b, h) + aoff + m * 2048 + k * 1024); } while (0)
#define PG8_LDB(dst, b, h) do { _Pragma("unroll") for (int n = 0; n < 2; ++n) _Pragma("unroll") for (int k = 0; k < 2; ++k) dst[n][k] = *(const PG8_LAS bf16x8*)(lds + PG8_SB(b, h) + boff + n * 2048 + k * 1024); } while (0)
#define PG8_MMA(ai, bj, At, Bt) do { __builtin_amdgcn_s_setprio(1); _Pragma("unroll") for (int m = 0; m < 4; ++m) _Pragma("unroll") for (int n = 0; n < 2; ++n) _Pragma("unroll") for (int k = 0; k < 2; ++k) \
        acc[ai][bj][m][n] = __builtin_amdgcn_mfma_f32_16x16x32_bf16(Bt[n][k], At[m][k], acc[ai][bj][m][n], 0, 0, 0); __builtin_amdgcn_s_setprio(0); } while (0)
#define PG8_WAIT_V(n) asm volatile("s_waitcnt vmcnt(" #n ")" ::: "memory")
#define PG8_WAIT_L(n) asm volatile("s_waitcnt lgkmcnt(" #n ")" ::: "memory")
#define PG8_BAR __builtin_amdgcn_s_barrier()
#define PG8_SCHED __builtin_amdgcn_sched_barrier(0)
    Unit cur, nxt; int ui = 0;
    if (!S.next(0, cur)) return;
    f32x4 acc[2][2][4][2];
#pragma unroll
    for (int a = 0; a < 2; ++a)
#pragma unroll
        for (int b = 0; b < 2; ++b)
#pragma unroll
            for (int m = 0; m < 4; ++m)
#pragma unroll
                for (int n = 0; n < 2; ++n) acc[a][b][m][n] = (f32x4){0.f, 0.f, 0.f, 0.f};
    bf16x8 At[4][2], B0[2][2], B1[2][2];
    const char* cA = (const char*)g.A + (size_t)cur.pm * tstep; const char* cB = (const char*)g.Bt + (size_t)cur.pn * tstep;
    PG8_STAGE(PG8_SB(0, 0), cB); PG8_STAGE(PG8_SB(0, 1), cB + hstep); PG8_STAGE(PG8_SA(0, 0), cA); PG8_STAGE(PG8_SA(0, 1), cA + hstep);
    if (wr == 1) PG8_BAR;
    PG8_WAIT_V(2); PG8_BAR;
    PG8_STAGE(PG8_SB(1, 0), cB + kstep); PG8_STAGE(PG8_SA(1, 0), cA + kstep); PG8_STAGE(PG8_SB(1, 1), cB + hstep + kstep);
    PG8_WAIT_V(6); PG8_BAR;
    for (;;) {
        const bool has_next = S.next(ui + 1, nxt);
        const char* nA = has_next ? (const char*)g.A + (size_t)nxt.pm * tstep : cA; const char* nB = has_next ? (const char*)g.Bt + (size_t)nxt.pn * tstep : cB;
        for (int t = 0; t < nt; t += 2) {
            const bool last = (t == nt - 2);
            const char* a1 = cA + (size_t)(t + 1) * kstep;
            const char* a2 = last ? nA : cA + (size_t)(t + 2) * kstep; const char* b2 = last ? nB : cB + (size_t)(t + 2) * kstep;
            const char* a3 = a2 + kstep; const char* b3 = b2 + kstep;
            PG8_LDB(B0, 0, 0); PG8_LDB(B1, 0, 1); PG8_SCHED; PG8_LDA(At, 0, 0); PG8_STAGE(PG8_SA(1, 1), a1 + hstep);
            PG8_WAIT_V(8); PG8_WAIT_L(0); PG8_BAR; PG8_MMA(0, 0, At, B0); PG8_MMA(0, 1, At, B1); PG8_BAR; PG8_SCHED;
            PG8_LDA(At, 0, 1); PG8_STAGE(PG8_SB(0, 0), b2); PG8_STAGE(PG8_SB(0, 1), b2 + hstep); PG8_STAGE(PG8_SA(0, 0), a2);
            PG8_WAIT_V(8); PG8_WAIT_L(0); PG8_BAR; PG8_MMA(1, 0, At, B0); PG8_MMA(1, 1, At, B1); PG8_BAR; PG8_SCHED;
            PG8_LDB(B0, 1, 0); PG8_LDB(B1, 1, 1); PG8_SCHED; PG8_LDA(At, 1, 0); PG8_STAGE(PG8_SA(0, 1), a2 + hstep);
            PG8_WAIT_V(8); PG8_WAIT_L(0); PG8_BAR; PG8_MMA(0, 0, At, B0); PG8_MMA(0, 1, At, B1); PG8_BAR; PG8_SCHED;
            PG8_LDA(At, 1, 1); PG8_STAGE(PG8_SB(1, 0), b3); PG8_STAGE(PG8_SB(1, 1), b3 + hstep); PG8_STAGE(PG8_SA(1, 0), a3);
            PG8_WAIT_V(8); PG8_WAIT_L(0); PG8_BAR; PG8_MMA(1, 0, At, B0); PG8_MMA(1, 1, At, B1); PG8_BAR; PG8_SCHED;
        }
        if (wr == 0) PG8_BAR;
        E(acc, cur, wr, wc, fr, fq);
        if (!has_next) break;
#pragma unroll
        for (int a = 0; a < 2; ++a)
#pragma unroll
            for (int b = 0; b < 2; ++b)
#pragma unroll
                for (int m = 0; m < 4; ++m)
#pragma unroll
                    for (int n = 0; n < 2; ++n) acc[a][b][m][n] = (f32x4){0.f, 0.f, 0.f, 0.f};
        cur = nxt; cA = nA; cB = nB; ++ui;
        if (wr == 1) PG8_BAR;
    }
    PG8_WAIT_V(0);
    PG8_BAR;
#undef PG8_SA
#undef PG8_SB
#undef PG8_STAGE
#undef PG8_LDA
#undef PG8_LDB
#undef PG8_MMA
#undef PG8_WAIT_V
#undef PG8_WAIT_L
#undef PG8_BAR
#undef PG8_SCHED
}

typedef int i32x4_t __attribute__((ext_vector_type(4)));
template <class Epi, class Sched>
__device__ __forceinline__ void gemm_phase_f8(PG8_LAS unsigned char* lds, const Gemm g, const Sched& S, const Epi& E, const int wid_in) {
    int wid = wid_in; asm volatile("" : "+s"(wid));
    const int lane = lane_id_asm(), tid = wid * 64 + lane, wr = wid >> 2, wc = wid & 3, fr = lane & 15, fq = lane >> 4;
    int K_o = g.K; asm volatile("" : "+s"(K_o)); const int K = K_o, nt = K / BK;
    unsigned voff[2];
#pragma unroll
    for (int i = 0; i < 2; ++i) { int R, C; stage_rc(tid * 16 + i * 8192, R, C); voff[i] = (unsigned)(R * K + C) * 2u; }
    const size_t kstep = (size_t)(BK * 2);
    const size_t hstep = (size_t)HALF * K * 2;
    const size_t tstep = 2 * hstep;
    const unsigned ldsw = (unsigned)wid * 1024u;
    const int aoff = lds_byte(wr * 64 + fr, fq * 16), boff = lds_byte(wc * 32 + fr, fq * 16);
#define PG8_SA(b, h) (((b) * 2 + (h)) * HTB)
#define PG8_SB(b, h) ((4 + (b) * 2 + (h)) * HTB)
#define PG8_STAGE(bufoff, gbase) do { _Pragma("unroll") for (int _i = 0; _i < 2; ++_i) \
        __builtin_amdgcn_global_load_lds((const unsigned*)((const char*)(gbase) + voff[_i]), (PG8_LAS unsigned*)(lds + (bufoff) + ldsw + _i * 8192), 16, 0, 0); } while (0)
#define PG8_LDA(dst, b, h) do { _Pragma("unroll") for (int m = 0; m < 4; ++m) _Pragma("unroll") for (int k = 0; k < 2; ++k) dst[m][k] = *(const PG8_LAS bf16x8*)(lds + PG8_SA(b, h) + aoff + m * 2048 + k * 16); } while (0)
#define PG8_LDB(dst, b, h) do { _Pragma("unroll") for (int n = 0; n < 2; ++n) _Pragma("unroll") for (int k = 0; k < 2; ++k) dst[n][k] = *(const PG8_LAS bf16x8*)(lds + PG8_SB(b, h) + boff + n * 2048 + k * 16); } while (0)
#define PG8_F8(x) __builtin_shufflevector(__builtin_bit_cast(i32x4_t, (x)[0]), __builtin_bit_cast(i32x4_t, (x)[1]), 0, 1, 2, 3, 4, 5, 6, 7)
#define PG8_MMA(ai, bj, At, Bt) do { __builtin_amdgcn_s_setprio(1); asm volatile("s_nop 1" ::: ); _Pragma("unroll") for (int m = 0; m < 4; ++m) _Pragma("unroll") for (int n = 0; n < 2; ++n) \
        asm volatile("v_mfma_f32_16x16x128_f8f6f4 %0, %1, %2, %0" : "+v"(acc[ai][bj][m][n]) : "v"(PG8_F8(Bt[n])), "v"(PG8_F8(At[m]))); __builtin_amdgcn_s_setprio(0); } while (0)
#define PG8_ACC_SETTLE asm volatile("s_nop 15\n\ts_nop 15" ::: "memory")
#define PG8_WAIT_V(n) asm volatile("s_waitcnt vmcnt(" #n ")" ::: "memory")
#define PG8_WAIT_L(n) asm volatile("s_waitcnt lgkmcnt(" #n ")" ::: "memory")
#define PG8_BAR __builtin_amdgcn_s_barrier()
#define PG8_SCHED __builtin_amdgcn_sched_barrier(0)
    Unit cur, nxt; int ui = 0;
    if (!S.next(0, cur)) return;
    f32x4 acc[2][2][4][2];
#pragma unroll
    for (int a = 0; a < 2; ++a)
#pragma unroll
        for (int b = 0; b < 2; ++b)
#pragma unroll
            for (int m = 0; m < 4; ++m)
#pragma unroll
                for (int n = 0; n < 2; ++n) acc[a][b][m][n] = (f32x4){0.f, 0.f, 0.f, 0.f};
    bf16x8 At[4][2], B0[2][2], B1[2][2];
    const char* cA = (const char*)g.A + (size_t)cur.pm * tstep; const char* cB = (const char*)g.Bt + (size_t)cur.pn * tstep;
    PG8_STAGE(PG8_SB(0, 0), cB); PG8_STAGE(PG8_SB(0, 1), cB + hstep); PG8_STAGE(PG8_SA(0, 0), cA); PG8_STAGE(PG8_SA(0, 1), cA + hstep);
    if (wr == 1) PG8_BAR;
    PG8_WAIT_V(2); PG8_BAR;
    PG8_STAGE(PG8_SB(1, 0), cB + kstep); PG8_STAGE(PG8_SA(1, 0), cA + kstep); PG8_STAGE(PG8_SB(1, 1), cB + hstep + kstep);
    PG8_WAIT_V(6); PG8_BAR;
    for (;;) {
        const bool has_next = S.next(ui + 1, nxt);
        const char* nA = has_next ? (const char*)g.A + (size_t)nxt.pm * tstep : cA; const char* nB = has_next ? (const char*)g.Bt + (size_t)nxt.pn * tstep : cB;
        for (int t = 0; t < nt; t += 2) {
            const bool last = (t == nt - 2);
            const char* a1 = cA + (size_t)(t + 1) * kstep;
            const char* a2 = last ? nA : cA + (size_t)(t + 2) * kstep; const char* b2 = last ? nB : cB + (size_t)(t + 2) * kstep;
            const char* a3 = a2 + kstep; const char* b3 = b2 + kstep;
            PG8_LDB(B0, 0, 0); PG8_LDB(B1, 0, 1); PG8_SCHED; PG8_LDA(At, 0, 0); PG8_STAGE(PG8_SA(1, 1), a1 + hstep);
            PG8_WAIT_V(8); PG8_WAIT_L(0); PG8_BAR; PG8_MMA(0, 0, At, B0); PG8_MMA(0, 1, At, B1); PG8_BAR; PG8_SCHED;
            PG8_LDA(At, 0, 1); PG8_STAGE(PG8_SB(0, 0), b2); PG8_STAGE(PG8_SB(0, 1), b2 + hstep); PG8_STAGE(PG8_SA(0, 0), a2);
            PG8_WAIT_V(8); PG8_WAIT_L(0); PG8_BAR; PG8_MMA(1, 0, At, B0); PG8_MMA(1, 1, At, B1); PG8_BAR; PG8_SCHED;
            PG8_LDB(B0, 1, 0); PG8_LDB(B1, 1, 1); PG8_SCHED; PG8_LDA(At, 1, 0); PG8_STAGE(PG8_SA(0, 1), a2 + hstep);
            PG8_WAIT_V(8); PG8_WAIT_L(0); PG8_BAR; PG8_MMA(0, 0, At, B0); PG8_MMA(0, 1, At, B1); PG8_BAR; PG8_SCHED;
            PG8_LDA(At, 1, 1); PG8_STAGE(PG8_SB(1, 0), b3); PG8_STAGE(PG8_SB(1, 1), b3 + hstep); PG8_STAGE(PG8_SA(1, 0), a3);
            PG8_WAIT_V(8); PG8_WAIT_L(0); PG8_BAR; PG8_MMA(1, 0, At, B0); PG8_MMA(1, 1, At, B1); PG8_BAR; PG8_SCHED;
        }
        if (wr == 0) PG8_BAR;
        PG8_ACC_SETTLE;
        E(acc, cur, wr, wc, fr, fq);
        if (!has_next) break;
#pragma unroll
        for (int a = 0; a < 2; ++a)
#pragma unroll
            for (int b = 0; b < 2; ++b)
#pragma unroll
                for (int m = 0; m < 4; ++m)
#pragma unroll
                    for (int n = 0; n < 2; ++n) acc[a][b][m][n] = (f32x4){0.f, 0.f, 0.f, 0.f};
        cur = nxt; cA = nA; cB = nB; ++ui;
        if (wr == 1) PG8_BAR;
    }
    PG8_WAIT_V(0);
    PG8_BAR;
#undef PG8_SA
#undef PG8_SB
#undef PG8_STAGE
#undef PG8_LDA
#undef PG8_LDB
#undef PG8_MMA
#undef PG8_F8
#undef PG8_ACC_SETTLE
#undef PG8_WAIT_V
#undef PG8_WAIT_L
#undef PG8_BAR
#undef PG8_SCHED
}

#define EPI_ROWS(...) _Pragma("unroll") for (int ai = 0; ai < 2; ++ai) _Pragma("unroll") for (int m = 0; m < 4; ++m) { const int row = u.pm * BM + ai * HALF + wr * 64 + m * 16 + fr; __VA_ARGS__ }
__device__ __forceinline__ u32x4 pack8(const f32x4 a, const f32x4 b) { u32x4 w; w.x = cvt_pk_bf16(a[0], a[1]); w.y = cvt_pk_bf16(a[2], a[3]); w.z = cvt_pk_bf16(b[0], b[1]); w.w = cvt_pk_bf16(b[2], b[3]); return w; }

__device__ __forceinline__ u32x2 pack8_f8(const f32x4 a, const f32x4 b) { unsigned w0 = 0, w1 = 0;
    w0 = __builtin_amdgcn_cvt_pk_fp8_f32(a[0], a[1], w0, false); w0 = __builtin_amdgcn_cvt_pk_fp8_f32(a[2], a[3], w0, true);
    w1 = __builtin_amdgcn_cvt_pk_fp8_f32(b[0], b[1], w1, false); w1 = __builtin_amdgcn_cvt_pk_fp8_f32(b[2], b[3], w1, true); u32x2 r; r.x = w0; r.y = w1; return r; }
constexpr float W8_SCALE = 64.0f, W8_INV = 1.0f / 64.0f;
struct EpiIn {
    bf16_t* aqkv; bf16_t* qb; bf16_t* kb; bf16_t* vb; bf16_t* gate; const float* qg; const float* kg; const float* rope; float asc; bool f8attn;
    __device__ __forceinline__ void operator()(const f32x4 (&acc)[2][2][4][2], const Unit& u, int wr, int wc, int fr, int fq) const {
        const int pn = u.pn;
        if (pn >= 9 && pn < 14) {
            const bool isq = pn < 13; const int head = isq ? (pn - 9) * 4 + wc : wc; bf16_t* dst = isq ? qb : kb; const int pitch = isq ? 1024 : 256;
            const float* gvec = isq ? qg : kg; const float osc = isq ? C2 : 1.0f;
            f32x4 gv[2][2];
#pragma unroll
            for (int bj = 0; bj < 2; ++bj)
#pragma unroll
                for (int n = 0; n < 2; ++n) gv[bj][n] = *(const f32x4*)(gvec + 32 * bj + 16 * n + 4 * fq);
            EPI_ROWS(
                float ss = 0.f;
                _Pragma("unroll") for (int bj = 0; bj < 2; ++bj) _Pragma("unroll") for (int n = 0; n < 2; ++n) { const f32x4 x = acc[ai][bj][m][n] * asc; ss += (x[0] * x[0] + x[1] * x[1]) + (x[2] * x[2] + x[3] * x[3]); }
                ss = xsum<16>(ss); ss = xsum<32>(ss);
                const float sc = rsqrtf(ss * (1.0f / 64.0f) + EPS) * osc * asc;
                const int t = row & (SEQ - 1);
                _Pragma("unroll") for (int bj = 0; bj < 2; ++bj) {
                    const int pos = bj == 0 ? (t >> 6) : (t & 63);
                    const f32x4 cs = *(const f32x4*)(rope + pos * 16 + 4 * fq); const f32x4 sn = *(const f32x4*)(rope + 1024 + pos * 16 + 4 * fq);
                    const f32x4 y0 = acc[ai][bj][m][0] * sc * gv[bj][0]; const f32x4 y1 = acc[ai][bj][m][1] * sc * gv[bj][1];
                    const f32x4 o0 = y0 * cs - y1 * sn; const f32x4 o1 = y1 * cs + y0 * sn;
                    if (f8attn) { unsigned char* p8 = (unsigned char*)dst + (size_t)row * pitch + head * 64 + 32 * bj + 4 * fq;
                        unsigned a = 0, b = 0; a = __builtin_amdgcn_cvt_pk_fp8_f32(o0[0], o0[1], a, false); a = __builtin_amdgcn_cvt_pk_fp8_f32(o0[2], o0[3], a, true);
                        b = __builtin_amdgcn_cvt_pk_fp8_f32(o1[0], o1[1], b, false); b = __builtin_amdgcn_cvt_pk_fp8_f32(o1[2], o1[3], b, true);
                        *(unsigned*)p8 = a; *(unsigned*)(p8 + 16) = b;
                    } else {
                    bf16_t* p = dst + (size_t)row * pitch + head * 64 + 32 * bj + 4 * fq;
                    u32x2 w0; w0.x = cvt_pk_bf16(o0[0], o0[1]); w0.y = cvt_pk_bf16(o0[2], o0[3]);
                    u32x2 w1; w1.x = cvt_pk_bf16(o1[0], o1[1]); w1.y = cvt_pk_bf16(o1[2], o1[3]);
                    *(u32x2*)p = w0; *(u32x2*)(p + 16) = w1; }
                }
            )
        } else if (pn == 14 && f8attn) {
            unsigned char* vt = (unsigned char*)vb;
            EPI_ROWS(
                const int b = row >> 12; const int t = row & (SEQ - 1); const int kk = t & 63;
                const int pos = 32 * ((kk >> 2) & 1) + (kk & 3) + 4 * ((kk >> 3) & 3) + 16 * (kk >> 5);
                _Pragma("unroll") for (int bj = 0; bj < 2; ++bj) {
                    const int kvh = bj * 2 + (wc >> 1); const int d0 = (wc & 1) * 32 + 8 * fq;
                    unsigned char* p = vt + ((size_t)((b * 4 + kvh) * 64 + d0) << 12) + (t & ~63) + pos;
                    const f32x4 v0 = acc[ai][bj][m][0] * asc; const f32x4 v1 = acc[ai][bj][m][1] * asc;
                    unsigned a = 0, c = 0; a = __builtin_amdgcn_cvt_pk_fp8_f32(v0[0], v0[1], a, false); a = __builtin_amdgcn_cvt_pk_fp8_f32(v0[2], v0[3], a, true);
                    c = __builtin_amdgcn_cvt_pk_fp8_f32(v1[0], v1[1], c, false); c = __builtin_amdgcn_cvt_pk_fp8_f32(v1[2], v1[3], c, true);
                    p[0 << 12] = (unsigned char)a; p[1 << 12] = (unsigned char)(a >> 8); p[2 << 12] = (unsigned char)(a >> 16); p[3 << 12] = (unsigned char)(a >> 24);
                    p[4 << 12] = (unsigned char)c; p[5 << 12] = (unsigned char)(c >> 8); p[6 << 12] = (unsigned char)(c >> 16); p[7 << 12] = (unsigned char)(c >> 24);
                }
            )
        } else {
            bf16_t* dst; int pitch, colt, dsh = 0; float sc = asc; bool sig = false, fold = false;
            if (pn < 9) { dst = aqkv + (size_t)pn * T * 256; pitch = 256; colt = 0; fold = true; dsh = 2 * (pn / 3); if (pn % 3 == 0) sc = C2 * asc; }
            else if (pn == 14) { dst = vb; pitch = 256; colt = 0; }
            else { dst = gate; pitch = 2048; colt = (pn - 15) * 256; sig = true; }
            const int col0 = colt + wc * 32 + 8 * fq;
            EPI_ROWS(
                int drow = row;
                if (fold) { const int t = row & (SEQ - 1); drow = (row & ~(SEQ - 1)) | ((t & ((1 << dsh) - 1)) << (12 - dsh)) | (t >> dsh); }
                bf16_t* rowp = dst + (size_t)drow * pitch + col0;
                _Pragma("unroll") for (int bj = 0; bj < 2; ++bj) {
                    f32x4 v0 = acc[ai][bj][m][0], v1 = acc[ai][bj][m][1];
                    if (sig) { _Pragma("unroll") for (int j = 0; j < 4; ++j) { v0[j] = sigmoid_f(v0[j] * asc); v1[j] = sigmoid_f(v1[j] * asc); } }
                    else { v0 = v0 * sc; v1 = v1 * sc; }
                    *(u32x4*)(rowp + bj * HALF) = pack8(v0, v1);
                }
            )
        }
    }
};
struct EpiMergeA {
    const bf16_t* gate; bf16_t* merged;
    __device__ __forceinline__ void operator()(const f32x4 (&acc)[2][2][4][2], const Unit& u, int wr, int wc, int fr, int fq) const {
        const int col0 = u.pn * BM + wc * 32 + 8 * fq;
        EPI_ROWS(
            _Pragma("unroll") for (int bj = 0; bj < 2; ++bj) {
                const u32x4 gw = *(const u32x4*)(gate + (size_t)row * 2048 + col0 + bj * HALF);
                f32x4 v0 = acc[ai][bj][m][0], v1 = acc[ai][bj][m][1];
                v0 = v0 * W8_INV; v1 = v1 * W8_INV;
                v0[0] *= bf_lo(gw.x); v0[1] *= bf_hi(gw.x); v0[2] *= bf_lo(gw.y); v0[3] *= bf_hi(gw.y);
                v1[0] *= bf_lo(gw.z); v1[1] *= bf_hi(gw.z); v1[2] *= bf_lo(gw.w); v1[3] *= bf_hi(gw.w);
                *(u32x4*)(merged + (size_t)row * 1024 + col0 + bj * HALF) = pack8(v0, v1);
            }
        )
    }
};
template <bool F8> struct EpiMergeB {
    const bf16_t* gate; const bf16_t* merged; unsigned char* m8;
    __device__ __forceinline__ void operator()(const f32x4 (&acc)[2][2][4][2], const Unit& u, int wr, int wc, int fr, int fq) const {
        const int col0 = u.pn * BM + wc * 32 + 8 * fq;
        EPI_ROWS(
            _Pragma("unroll") for (int bj = 0; bj < 2; ++bj) {
                const u32x4 gw = *(const u32x4*)(gate + (size_t)row * 2048 + 1024 + col0 + bj * HALF);
                const bf16_t* mp = merged + (size_t)row * 1024 + col0 + bj * HALF;
                const u32x4 mw = *(const u32x4*)mp;
                f32x4 v0 = acc[ai][bj][m][0] * (F8 ? W8_INV : 1.0f), v1 = acc[ai][bj][m][1] * (F8 ? W8_INV : 1.0f);
                v0[0] = v0[0] * bf_lo(gw.x) + bf_lo(mw.x); v0[1] = v0[1] * bf_hi(gw.x) + bf_hi(mw.x); v0[2] = v0[2] * bf_lo(gw.y) + bf_lo(mw.y); v0[3] = v0[3] * bf_hi(gw.y) + bf_hi(mw.y);
                v1[0] = v1[0] * bf_lo(gw.z) + bf_lo(mw.z); v1[1] = v1[1] * bf_hi(gw.z) + bf_hi(mw.z); v1[2] = v1[2] * bf_lo(gw.w) + bf_lo(mw.w); v1[3] = v1[3] * bf_hi(gw.w) + bf_hi(mw.w);
                *(u32x2*)(m8 + (size_t)row * 1024 + col0 + bj * HALF) = pack8_f8(v0, v1);
            }
        )
    }
};
struct EpiOut {
    const float* xin; float* xout; const float* g1;
    __device__ __forceinline__ void operator()(const f32x4 (&acc)[2][2][4][2], const Unit& u, int wr, int wc, int fr, int fq) const {
        const int col0 = u.pn * BM + wc * 32 + 8 * fq; const int b = (u.pm * BM) >> 12;
        f32x4 gv[2][2];
#pragma unroll
        for (int bj = 0; bj < 2; ++bj)
#pragma unroll
            for (int n = 0; n < 2; ++n) gv[bj][n] = *(const f32x4*)(g1 + (size_t)b * 6144 + col0 + bj * HALF + 4 * n);
        EPI_ROWS(
            _Pragma("unroll") for (int bj = 0; bj < 2; ++bj) {
                const size_t off = (size_t)row * 1024 + col0 + bj * HALF;
                const f32x4 x0 = *(const f32x4*)(xin + off), x1 = *(const f32x4*)(xin + off + 4);
                *(f32x4*)(xout + off) = x0 + gv[bj][0] * (acc[ai][bj][m][0] * W8_INV); *(f32x4*)(xout + off + 4) = x1 + gv[bj][1] * (acc[ai][bj][m][1] * W8_INV);
            }
        )
    }
};
struct EpiGU {
    const float* bgu; bf16_t* act;
    __device__ __forceinline__ void operator()(const f32x4 (&acc)[2][2][4][2], const Unit& u, int wr, int wc, int fr, int fq) const {
        const int e = u.pn >> 3, pl = u.pn & 7; const int c0 = pl * 128 + wc * 32 + 8 * fq;
        const float* bp = bgu + (size_t)e * 2048 + c0;
        const f32x4 bg0 = *(const f32x4*)bp, bg1 = *(const f32x4*)(bp + 4), bl0 = *(const f32x4*)(bp + 1024), bl1 = *(const f32x4*)(bp + 1028);
        EPI_ROWS(
            f32x4 o[2];
            _Pragma("unroll") for (int n = 0; n < 2; ++n) {
                const f32x4 gl = acc[ai][0][m][n] + (n == 0 ? bg0 : bg1); const f32x4 ln = acc[ai][1][m][n] + (n == 0 ? bl0 : bl1);
                _Pragma("unroll") for (int j = 0; j < 4; ++j) { const float xg = fminf(gl[j], 7.0f); const float xl = fminf(fmaxf(ln[j], -7.0f), 7.0f); o[n][j] = xg * sigmoid_f(1.702f * xg) * (xl + 1.0f); }
            }
            *(u32x4*)(act + (size_t)row * 1024 + c0) = pack8(o[0], o[1]);
        )
    }
};
struct EpiGU8 {
    const float* bgu; unsigned char* act;
    __device__ __forceinline__ void operator()(const f32x4 (&acc)[2][2][4][2], const Unit& u, int wr, int wc, int fr, int fq) const {
        const int e = u.pn >> 3, pl = u.pn & 7; const int c0 = pl * 128 + wc * 32 + 8 * fq;
        const float* bp = bgu + (size_t)e * 2048 + c0;
        const f32x4 bg0 = *(const f32x4*)bp, bg1 = *(const f32x4*)(bp + 4), bl0 = *(const f32x4*)(bp + 1024), bl1 = *(const f32x4*)(bp + 1028);
        EPI_ROWS(
            f32x4 o[2];
            _Pragma("unroll") for (int n = 0; n < 2; ++n) {
                const f32x4 gl = acc[ai][0][m][n] * W8_INV + (n == 0 ? bg0 : bg1); const f32x4 ln = acc[ai][1][m][n] * W8_INV + (n == 0 ? bl0 : bl1);
                _Pragma("unroll") for (int j = 0; j < 4; ++j) { const float xg = fminf(gl[j], 7.0f); const float xl = fminf(fmaxf(ln[j], -7.0f), 7.0f); o[n][j] = xg * sigmoid_f(1.702f * xg) * (xl + 1.0f); }
            }
            *(u32x2*)(act + (size_t)row * 1024 + c0) = pack8_f8(o[0], o[1]);
        )
    }
};
struct EpiDN8 {
    const float* bdn; const float* roww; bf16_t* y;
    __device__ __forceinline__ void operator()(const f32x4 (&acc)[2][2][4][2], const Unit& u, int wr, int wc, int fr, int fq) const {
        const int e = u.pn >> 2, pl = u.pn & 3; const int col0 = pl * BM + wc * 32 + 8 * fq;
        f32x4 bv[2][2];
#pragma unroll
        for (int bj = 0; bj < 2; ++bj)
#pragma unroll
            for (int n = 0; n < 2; ++n) bv[bj][n] = *(const f32x4*)(bdn + (size_t)e * 1024 + col0 + bj * HALF + 4 * n);
        EPI_ROWS(
            const float w = roww[row];
            _Pragma("unroll") for (int bj = 0; bj < 2; ++bj)
                *(u32x4*)(y + (size_t)row * 1024 + col0 + bj * HALF) = pack8((acc[ai][bj][m][0] * W8_INV + bv[bj][0]) * w, (acc[ai][bj][m][1] * W8_INV + bv[bj][1]) * w);
        )
    }
};
struct EpiDN {
    const float* bdn; const float* roww; bf16_t* y;
    __device__ __forceinline__ void operator()(const f32x4 (&acc)[2][2][4][2], const Unit& u, int wr, int wc, int fr, int fq) const {
        const int e = u.pn >> 2, pl = u.pn & 3; const int col0 = pl * BM + wc * 32 + 8 * fq;
        f32x4 bv[2][2];
#pragma unroll
        for (int bj = 0; bj < 2; ++bj)
#pragma unroll
            for (int n = 0; n < 2; ++n) bv[bj][n] = *(const f32x4*)(bdn + (size_t)e * 1024 + col0 + bj * HALF + 4 * n);
        EPI_ROWS(
            const float w = roww[row];
            _Pragma("unroll") for (int bj = 0; bj < 2; ++bj)
                *(u32x4*)(y + (size_t)row * 1024 + col0 + bj * HALF) = pack8((acc[ai][bj][m][0] + bv[bj][0]) * w, (acc[ai][bj][m][1] + bv[bj][1]) * w);
        )
    }
};
}

namespace attn_body {
using bf16 = __hip_bfloat16;
using bf16x8 = __attribute__((ext_vector_type(8))) short;
using s16x4 = __attribute__((ext_vector_type(4))) short;
using f32x16 = __attribute__((ext_vector_type(16))) float;
using u32x4 = __attribute__((ext_vector_type(4))) unsigned;
constexpr int D = 64, NW = 8, QBLK = 32, QB = QBLK * NW, KVBLK = 64;
__device__ __forceinline__ int crow(int r, int hi) { return (r & 3) + 8 * (r >> 2) + 4 * hi; }
#define SBAR() __builtin_amdgcn_sched_barrier(0)
constexpr int NSLOT = 3, SLOTB = 8192;
constexpr int LDS_K = 0, LDS_V = NSLOT * SLOTB, LDS_WS = 2 * NSLOT * SLOTB, LDS_OST = LDS_WS + NW * 64 * 4, LDS_LUT = LDS_OST + NW * 4096, LUT_N = 768, LDS_BYTES = LDS_LUT + LUT_N * 4;
constexpr bool OB_F8 = true;
constexpr float MFLOOR = -1024.0f;
__device__ __forceinline__ void glds16(const void* gsrc, unsigned lds_dst) { unsigned keep;
  asm volatile("s_mov_b32 %0, m0\n\ts_mov_b32 m0, %2\n\ts_nop 0\n\tglobal_load_lds_dwordx4 %1, off\n\ts_mov_b32 m0, %0" : "=&s"(keep) : "v"(gsrc), "s"(lds_dst) : "memory"); }
__device__ __forceinline__ float max3f(float a, float b, float c) { float r; asm("v_max3_f32 %0, %1, %2, %3" : "=v"(r) : "v"(a), "v"(b), "v"(c)); return r; }
__device__ __forceinline__ float max2f(float a, float b) { float r; asm("v_max_f32_e32 %0, %1, %2" : "=v"(r) : "v"(a), "v"(b)); return r; }
__device__ __forceinline__ float fadd_s(float a, float b) { float r; asm("v_add_f32_e32 %0, %1, %2" : "=v"(r) : "v"(a), "v"(b)); return r; }
__device__ __forceinline__ float fsub_s(float a, float b) { float r; asm("v_sub_f32_e32 %0, %1, %2" : "=v"(r) : "v"(a), "v"(b)); return r; }
typedef float f32x2_t __attribute__((ext_vector_type(2))); typedef __bf16 bf16x2_t __attribute__((ext_vector_type(2)));
__device__ __forceinline__ unsigned cvtpk_s(float lo, float hi) { f32x2_t v = {lo, hi}; bf16x2_t b = __builtin_convertvector(v, bf16x2_t); return __builtin_bit_cast(unsigned, b); }
#define WAIT_BAR(N) asm volatile("s_waitcnt vmcnt(" #N ") lgkmcnt(0)\n\ts_barrier" ::: "memory")

__device__ __forceinline__ void qkt(f32x16& p0, f32x16& p1, const char* Kslot, const bf16x8* qr, const f32x16& negm, int r32, int hi) {
  const char* kb = Kslot + hi * 1024 + r32 * 16;
  #pragma unroll
  for (int d0 = 0; d0 < 4; ++d0) {
    const bf16x8 b0 = *reinterpret_cast<const bf16x8*>(kb + d0 * 2048);
    const bf16x8 b1 = *reinterpret_cast<const bf16x8*>(kb + d0 * 2048 + 512);
    if (d0 == 0) { p0 = __builtin_amdgcn_mfma_f32_32x32x16_bf16(b0, qr[0], negm, 0, 0, 0); p1 = __builtin_amdgcn_mfma_f32_32x32x16_bf16(b1, qr[0], negm, 0, 0, 0); }
    else { p0 = __builtin_amdgcn_mfma_f32_32x32x16_bf16(b0, qr[d0], p0, 0, 0, 0); p1 = __builtin_amdgcn_mfma_f32_32x32x16_bf16(b1, qr[d0], p1, 0, 0, 0); } }
}
typedef __attribute__((address_space(3))) const char* lds_cptr;
typedef short v4i16_t __attribute__((ext_vector_type(4)));
__device__ __forceinline__ void kload8(bf16x8* kf, lds_cptr kp) {
  kf[0] = *(const __attribute__((address_space(3))) bf16x8*)(kp);        kf[1] = *(const __attribute__((address_space(3))) bf16x8*)(kp + 512);
  kf[2] = *(const __attribute__((address_space(3))) bf16x8*)(kp + 2048); kf[3] = *(const __attribute__((address_space(3))) bf16x8*)(kp + 2560);
  kf[4] = *(const __attribute__((address_space(3))) bf16x8*)(kp + 4096); kf[5] = *(const __attribute__((address_space(3))) bf16x8*)(kp + 4608);
  kf[6] = *(const __attribute__((address_space(3))) bf16x8*)(kp + 6144); kf[7] = *(const __attribute__((address_space(3))) bf16x8*)(kp + 6656);
}
__device__ __forceinline__ void kload2(bf16x8* kf, lds_cptr kp, int j) { kf[2 * j] = *(const __attribute__((address_space(3))) bf16x8*)(kp + j * 2048); kf[2 * j + 1] = *(const __attribute__((address_space(3))) bf16x8*)(kp + j * 2048 + 512); }
__device__ __forceinline__ s16x4 vtr(lds_cptr p) { return __builtin_bit_cast(s16x4, __builtin_amdgcn_ds_read_tr16_b64_v4i16((__attribute__((address_space(3))) v4i16_t*)p)); }
__device__ __forceinline__ float rowmax(const f32x16& p0, const f32x16& p1) {
  float a = max3f(p0[0], p0[1], p1[0]), b = max3f(p0[2], p0[3], p1[1]); a = max3f(a, p1[2], p1[3]);
  #pragma unroll
  for (int r = 4; r < 16; r += 4) { a = max3f(a, p0[r], p0[r + 1]); b = max3f(b, p0[r + 2], p0[r + 3]); a = max3f(a, p1[r], p1[r + 1]); b = max3f(b, p1[r + 2], p1[r + 3]); }
  const float m = max2f(a, b);
  auto rr = __builtin_amdgcn_permlane32_swap(__float_as_uint(m), __float_as_uint(m), false, false);
  return max2f(__uint_as_float(rr[0]), __uint_as_float(rr[1]));
}
__device__ __forceinline__ void pv(f32x16* o, int vb, bf16x8 pa0, bf16x8 pa1, bf16x8 pa2, bf16x8 pa3) {
  #pragma unroll
  for (int d0 = 0; d0 < 2; ++d0) { s16x4 lo[4], hi[4];
    #pragma unroll
    for (int ks = 0; ks < 4; ++ks) {
      asm volatile("ds_read_b64_tr_b16 %0,%1 offset:%c2" : "=&v"(lo[ks]) : "v"(vb), "i"(d0 * 4096 + ks * 1024) : "memory");
      asm volatile("ds_read_b64_tr_b16 %0,%1 offset:%c2" : "=&v"(hi[ks]) : "v"(vb), "i"(d0 * 4096 + ks * 1024 + 512) : "memory"); }
    asm volatile("s_waitcnt lgkmcnt(0)" ::: "memory"); SBAR();
    #define PK(k) (bf16x8){lo[k][0], lo[k][1], lo[k][2], lo[k][3], hi[k][0], hi[k][1], hi[k][2], hi[k][3]}
    o[d0] = __builtin_amdgcn_mfma_f32_32x32x16_bf16(pa0, PK(0), o[d0], 0, 0, 0);
    o[d0] = __builtin_amdgcn_mfma_f32_32x32x16_bf16(pa1, PK(1), o[d0], 0, 0, 0);
    o[d0] = __builtin_amdgcn_mfma_f32_32x32x16_bf16(pa2, PK(2), o[d0], 0, 0, 0);
    o[d0] = __builtin_amdgcn_mfma_f32_32x32x16_bf16(pa3, PK(3), o[d0], 0, 0, 0);
    #undef PK
  }
}
struct Job { const bf16* Q; const bf16* K; const bf16* V; bf16* O; float* lse; const float* lutg; int NT, i0, kq0, dsh, cls; };
template <int MODE, int THRL, bool NOMAX = false> __device__ __forceinline__ void attn_unit(const Job& J, char* shm, const int wid_in) {
  int wid = wid_in; asm volatile("" : "+s"(wid));
  constexpr int QP = MODE == 0 ? 1024 : 256, KP = 256;
  const int lane = lane_id_asm(), tid = wid * 64 + lane, r32 = lane & 31, hi = lane >> 5;
  const bf16* Qw = J.Q + (long)(wid * QBLK) * QP;
  const bf16* Kh = J.K; const bf16* Vh = J.V;
  const unsigned lds0 = (unsigned)(uintptr_t)shm;
  float* wsf = (float*)(shm + LDS_WS) + wid * 64;
  const bf16* ksrc = Kh + (long)lane * KP + wid * 8;
  const bf16* vsrc = Vh + (long)(16 * (wid & 3) + (lane >> 2)) * KP + (wid >> 2) * 32 + (lane & 3) * 8;
  const unsigned kdst = lds0 + LDS_K + wid * 1024, vdst = lds0 + LDS_V + wid * 1024;
  #define DMA_K(t, slot) glds16(ksrc + (long)(t) * KVBLK * KP, (unsigned)__builtin_amdgcn_readfirstlane(kdst + (slot)))
  #define DMA_V(t, slot) glds16(vsrc + (long)(t) * KVBLK * KP, (unsigned)__builtin_amdgcn_readfirstlane(vdst + (slot)))
  const int vb0 = (int)(lds0 + LDS_V) + ((lane >> 4) & 1) * 32 + (lane & 3) * 8 + (4 * hi + ((lane & 15) >> 2)) * 64;
  const char* Kbase = shm + LDS_K; bf16x8 kf[8];
  const lds_cptr shm3 = (lds_cptr)shm; const lds_cptr kp0 = shm3 + LDS_K + hi * 1024 + r32 * 16; const lds_cptr vp0 = shm3 + LDS_V + ((lane >> 4) & 1) * 32 + (lane & 3) * 8 + (4 * hi + ((lane & 15) >> 2)) * 64;
  const int NT = J.NT;
  if (MODE == 1) {
    __attribute__((address_space(3))) float* lut = (__attribute__((address_space(3))) float*)(shm3 + LDS_LUT);
    lut[tid] = J.lutg[tid]; if (tid < LUT_N - 512) lut[512 + tid] = J.lutg[512 + tid];
  }
  DMA_K(0, 0); DMA_V(0, 0); DMA_K(1, SLOTB);
  bf16x8 qr[4];
  #pragma unroll
  for (int d0 = 0; d0 < 4; ++d0) qr[d0] = *reinterpret_cast<const bf16x8*>(&Qw[(long)r32 * QP + d0 * 16 + hi * 8]);
  float mhat = 0.f, l_reg = 0.f; f32x16 o[2]; o[0] = f32x16{}; o[1] = f32x16{}; f32x16 negm = f32x16{}; if (!NOMAX) asm volatile("" : "+v"(negm));
  const int qrel = wid * QBLK + r32;
  const __attribute__((address_space(3))) float* lutq = (const __attribute__((address_space(3))) float*)(shm3 + LDS_LUT) + (J.kq0 - qrel + 383 + 4 * hi);
  #define CMASK(P0, P1, t) do { if (MODE == 1) { const __attribute__((address_space(3))) float* lp_ = lutq + 64 * (t); \
      _Pragma("unroll") for (int r = 0; r < 16; ++r) { const int ko_ = (r & 3) + 8 * (r >> 2); P0[r] += lp_[ko_]; P1[r] += lp_[ko_ + 32]; } } } while (0)
  bool resc = false;
  #define START(P0, P1) do { resc = false; if (!NOMAX) { const float rm = rowmax(P0, P1); \
    const float dl = MODE == 1 ? max2f(rm, MFLOOR) : rm; mhat = fadd_s(mhat, dl); \
      _Pragma("unroll") for (int r = 0; r < 16; ++r) { P0[r] = fsub_s(P0[r], dl); P1[r] = fsub_s(P1[r], dl); } \
      _Pragma("unroll") for (int r = 0; r < 16; ++r) negm[r] = -mhat; asm volatile("" : "+v"(negm)); } \
    _Pragma("unroll") for (int r = 0; r < 16; ++r) P0[r] = __builtin_amdgcn_exp2f(P0[r]); } while (0)
  #define RESC() do { if (resc) { asm volatile("s_waitcnt lgkmcnt(0)" ::: "memory"); \
      _Pragma("unroll") for (int d_ = 0; d_ < 2; ++d_) _Pragma("unroll") for (int r = 0; r < 16; ++r) o[d_][r] *= wsf[crow(r, hi)]; } } while (0)
  f32x16 pA0, pA1, pB0, pB1;
  int sl_prev = 0, sl_cur = 0, sl_next = SLOTB;
  #define ROT() do { sl_prev = sl_cur; sl_cur = sl_next; sl_next = (sl_next == (NSLOT - 1) * SLOTB) ? 0 : sl_next + SLOTB; } while (0)
  DMA_K(2, 2 * SLOTB);
  WAIT_BAR(3);
  qkt(pA0, pA1, Kbase, qr, negm, r32, hi); asm volatile("s_nop 15\n\ts_nop 7" : "+v"(pA0), "+v"(pA1)); CMASK(pA0, pA1, 0);
  START(pA0, pA1);
  _Pragma("unroll") for (int r = 0; r < 16; ++r) pA1[r] = __builtin_amdgcn_exp2f(pA1[r]);
  WAIT_BAR(0);
  DMA_K(3, 0); DMA_V(1, SLOTB);
  ROT();
  kload8(kf, kp0 + sl_cur);
  WAIT_BAR(2);
  s16x4 vlo[8], vhi[8]; u32x4 pw0, pw1, pw2, pw3;
  #define PKW(P, B) cvtpk_s(P[B], P[B + 1])
  #define PAF(k) __builtin_bit_cast(bf16x8, pw##k)
  #define VFR(i) (bf16x8){vlo[i][0], vlo[i][1], vlo[i][2], vlo[i][3], vhi[i][0], vhi[i][1], vhi[i][2], vhi[i][3]}
  #define PIN(x) asm volatile("" : "+v"(x))
  #define MX3(a, b, c) __builtin_fmaxf(__builtin_fmaxf((a), (b)), (c))
  #define GAPA(MF, A0, A1, A2, A3, W0, W1, PW) do { MF; sacc += A0; sacc += A1; sacc += A2; sacc += A3; PIN(sacc); W0; W1; PIN(PW); SBAR(); } while (0)
  #define EX(v) __builtin_amdgcn_exp2f(v)
  #define GAPB(MF, X, B) do { MF; X[B] = EX(X[B]); X[B + 1] = EX(X[B + 1]); X[B + 2] = EX(X[B + 2]); X[B + 3] = EX(X[B + 3]); PIN(X); SBAR(); } while (0)
  #define VRD(i) do { vlo[i] = vtr(vp_ + (((i) >> 2) * 4096 + ((i) & 3) * 1024)); vhi[i] = vtr(vp_ + (((i) >> 2) * 4096 + ((i) & 3) * 1024 + 512)); } while (0)
  #define KRD(G, j) do { if (G) { kload2(kf, kp0 + sl_next, j); SBAR(); } } while (0)
  #define STEP(C0, C1, P0, P1, t, GK, GV, GL) do { SBAR(); \
    const lds_cptr vp_ = vp0 + sl_prev; \
    VRD(0); SBAR(); float sacc = (P0[0] + P0[1]); \
    GAPA(C0 = __builtin_amdgcn_mfma_f32_32x32x16_bf16(kf[0], qr[0], negm, 0, 0, 0), P0[2], P0[3], P0[4], P0[5],     pw0[0] = PKW(P0, 0), pw0[1] = PKW(P0, 2), pw0); \
    VRD(4); SBAR(); GAPA(C1 = __builtin_amdgcn_mfma_f32_32x32x16_bf16(kf[1], qr[0], negm, 0, 0, 0), P0[6], P0[7], P0[8], P0[9],     pw0[2] = PKW(P0, 4), pw0[3] = PKW(P0, 6), pw0); \
    VRD(1); SBAR(); GAPA(C0 = __builtin_amdgcn_mfma_f32_32x32x16_bf16(kf[2], qr[1], C0, 0, 0, 0),   P0[10], P0[11], P0[12], P0[13], pw1[0] = PKW(P0, 8), pw1[1] = PKW(P0, 10), pw1); \
    VRD(5); SBAR(); GAPA(C1 = __builtin_amdgcn_mfma_f32_32x32x16_bf16(kf[3], qr[1], C1, 0, 0, 0),   P0[14], P0[15], P1[0], P1[1],   pw1[2] = PKW(P0, 12), pw1[3] = PKW(P0, 14), pw1); \
    VRD(2); SBAR(); GAPA(C0 = __builtin_amdgcn_mfma_f32_32x32x16_bf16(kf[4], qr[2], C0, 0, 0, 0),   P1[2], P1[3], P1[4], P1[5],     pw2[0] = PKW(P1, 0), pw2[1] = PKW(P1, 2), pw2); \
    VRD(6); SBAR(); GAPA(C1 = __builtin_amdgcn_mfma_f32_32x32x16_bf16(kf[5], qr[2], C1, 0, 0, 0),   P1[6], P1[7], P1[8], P1[9],     pw2[2] = PKW(P1, 4), pw2[3] = PKW(P1, 6), pw2); \
    VRD(3); SBAR(); GAPA(C0 = __builtin_amdgcn_mfma_f32_32x32x16_bf16(kf[6], qr[3], C0, 0, 0, 0),   P1[10], P1[11], P1[12], P1[13], pw3[0] = PKW(P1, 8), pw3[1] = PKW(P1, 10), pw3); \
    VRD(7); SBAR(); GAPA(C1 = __builtin_amdgcn_mfma_f32_32x32x16_bf16(kf[7], qr[3], C1, 0, 0, 0),   P1[14], P1[15], 0.f, 0.f,       pw3[2] = PKW(P1, 12), pw3[3] = PKW(P1, 14), pw3); \
    l_reg += sacc; \
    if (GK) { DMA_K((t) + 3, sl_cur); } if (GV) { DMA_V((t) + 1, sl_next); } \
    CMASK(C0, C1, t); \
    if (!NOMAX) { float a = MX3(C0[0], C0[1], C1[0]), b = MX3(C0[2], C0[3], C1[1]); a = MX3(a, C1[2], C1[3]); \
      _Pragma("unroll") for (int r = 4; r < 16; r += 4) { a = MX3(a, C0[r], C0[r + 1]); b = MX3(b, C0[r + 2], C0[r + 3]); a = MX3(a, C1[r], C1[r + 1]); b = MX3(b, C1[r + 2], C1[r + 3]); } \
      float rm = __builtin_fmaxf(a, b); { auto rr = __builtin_amdgcn_permlane32_swap(__float_as_uint(rm), __float_as_uint(rm), false, false); rm = __builtin_fmaxf(__uint_as_float(rr[0]), __uint_as_float(rr[1])); } \
      resc = false; \
      if (__builtin_expect(__any(rm > (float)THRL), 0)) { const float dl = __builtin_fmaxf(rm, 0.f); mhat += dl; \
        _Pragma("unroll") for (int r = 0; r < 16; ++r) { C0[r] -= dl; C1[r] -= dl; } \
        _Pragma("unroll") for (int r = 0; r < 16; ++r) negm[r] = -mhat; asm volatile("" : "+v"(negm)); \
        const float f = __builtin_amdgcn_exp2f(-dl); l_reg *= f; if (hi == 0) wsf[r32] = f; resc = true; } } \
    SBAR(); \
    GAPB(o[0] = __builtin_amdgcn_mfma_f32_32x32x16_bf16(PAF(0), VFR(0), o[0], 0, 0, 0), C0, 0); \
    GAPB(o[1] = __builtin_amdgcn_mfma_f32_32x32x16_bf16(PAF(0), VFR(4), o[1], 0, 0, 0), C0, 4); \
    KRD(GL, 0); GAPB(o[0] = __builtin_amdgcn_mfma_f32_32x32x16_bf16(PAF(1), VFR(1), o[0], 0, 0, 0), C0, 8); \
    KRD(GL, 1); GAPB(o[1] = __builtin_amdgcn_mfma_f32_32x32x16_bf16(PAF(1), VFR(5), o[1], 0, 0, 0), C0, 12); \
    KRD(GL, 2); GAPB(o[0] = __builtin_amdgcn_mfma_f32_32x32x16_bf16(PAF(2), VFR(2), o[0], 0, 0, 0), C1, 0); \
    KRD(GL, 3); GAPB(o[1] = __builtin_amdgcn_mfma_f32_32x32x16_bf16(PAF(2), VFR(6), o[1], 0, 0, 0), C1, 4); \
    GAPB(o[0] = __builtin_amdgcn_mfma_f32_32x32x16_bf16(PAF(3), VFR(3), o[0], 0, 0, 0), C1, 8); \
    GAPB(o[1] = __builtin_amdgcn_mfma_f32_32x32x16_bf16(PAF(3), VFR(7), o[1], 0, 0, 0), C1, 12); \
    } while (0)
  int t = 1;
  for (; t + 5 < NT; t += 2) {
    STEP(pB0, pB1, pA0, pA1, t, true, true, true);     WAIT_BAR(2); RESC(); ROT();
    STEP(pA0, pA1, pB0, pB1, t + 1, true, true, true); WAIT_BAR(2); RESC(); ROT();
  }
  #define ENDW(tt) do { if ((tt) + 3 < NT) { WAIT_BAR(2); } else if ((tt) + 2 < NT) { WAIT_BAR(1); } else { WAIT_BAR(0); } } while (0)
  for (; t + 1 < NT; t += 2) {
    STEP(pB0, pB1, pA0, pA1, t, (t + 3 < NT), (t + 1 < NT), (t + 1 < NT));       ENDW(t);     RESC(); ROT();
    STEP(pA0, pA1, pB0, pB1, t + 1, (t + 4 < NT), (t + 2 < NT), (t + 2 < NT));   ENDW(t + 1); RESC(); ROT();
  }
  STEP(pB0, pB1, pA0, pA1, NT - 1, false, false, false); RESC();
  { float sacc = pB0[0] + pB0[1]; _Pragma("unroll") for (int r = 2; r < 16; ++r) sacc += pB0[r]; _Pragma("unroll") for (int r = 0; r < 16; ++r) sacc += pB1[r]; l_reg += sacc;
    pw0 = (u32x4){PKW(pB0, 0), PKW(pB0, 2), PKW(pB0, 4), PKW(pB0, 6)}; pw1 = (u32x4){PKW(pB0, 8), PKW(pB0, 10), PKW(pB0, 12), PKW(pB0, 14)}; pw2 = (u32x4){PKW(pB1, 0), PKW(pB1, 2), PKW(pB1, 4), PKW(pB1, 6)}; pw3 = (u32x4){PKW(pB1, 8), PKW(pB1, 10), PKW(pB1, 12), PKW(pB1, 14)};
    SBAR(); pv(o, vb0 + sl_cur, PAF(0), PAF(1), PAF(2), PAF(3)); }
  #undef PKW
  #undef PAF
  #undef VFR
  #undef PIN
  #undef MX3
  #undef GAPA
  #undef GAPB
  #undef EX
  #undef VRD
  #undef KRD
  #undef STEP
  #undef ENDW
  { auto rr = __builtin_amdgcn_permlane32_swap(__float_as_uint(l_reg), __float_as_uint(l_reg), false, false); l_reg = __uint_as_float(rr[0]) + __uint_as_float(rr[1]); }
  if (hi == 0) wsf[32 + r32] = l_reg; asm volatile("s_waitcnt lgkmcnt(0)" ::: "memory");
  float rli[16];
  #pragma unroll
  for (int r = 0; r < 16; ++r) rli[r] = __builtin_amdgcn_rcpf(wsf[32 + crow(r, hi)]);
  if (MODE == 0 && OB_F8) {
    unsigned char* stg8 = (unsigned char*)(shm + LDS_OST) + wid * 4096;
    #pragma unroll
    for (int r = 0; r < 16; ++r) { const int orow = crow(r, hi);
      #pragma unroll
      for (int d0 = 0; d0 < 2; ++d0) { const float ov = o[d0][r] * rli[r]; stg8[orow * 64 + d0 * 32 + r32] = (unsigned char)(__builtin_amdgcn_cvt_pk_fp8_f32(ov, ov, 0, false) & 0xff); } }
    asm volatile("s_waitcnt lgkmcnt(0)" ::: "memory");
    unsigned char* Ow = (unsigned char*)J.O + (long)(wid * QBLK) * 1024;
    #pragma unroll
    for (int i = 0; i < 2; ++i) { const int row = i * 16 + (lane >> 2), ch = lane & 3; const u32x4 v = *(const u32x4*)(stg8 + row * 64 + ch * 16); *(u32x4*)(Ow + (long)row * 1024 + ch * 16) = v; }
  } else {
    bf16* stg = (bf16*)(shm + LDS_OST) + wid * 2048;
    #pragma unroll
    for (int r = 0; r < 16; ++r) { const int orow = crow(r, hi);
      #pragma unroll
      for (int d0 = 0; d0 < 2; ++d0) stg[orow * 64 + d0 * 32 + r32] = __float2bfloat16(o[d0][r] * rli[r]); }
    asm volatile("s_waitcnt lgkmcnt(0)" ::: "memory");
    if (MODE == 0) {
      bf16* Ow = J.O + (long)(wid * QBLK) * 1024;
      #pragma unroll
      for (int i = 0; i < 4; ++i) { const int row = i * 8 + (lane >> 3), ch = lane & 7; const u32x4 v = *(const u32x4*)(stg + row * 64 + ch * 8); *(u32x4*)(Ow + (long)row * 1024 + ch * 8) = v; }
    } else {
      #pragma unroll
      for (int i = 0; i < 4; ++i) { const int row = i * 8 + (lane >> 3), ch = lane & 7; const u32x4 v = *(const u32x4*)(stg + row * 64 + ch * 8);
        const long tok = ((long)(J.i0 + wid * QBLK + row) << J.dsh) + J.cls; *(u32x4*)(J.O + tok * 256 + ch * 8) = v; }
      if (hi == 0) { const long tok = ((long)(J.i0 + qrel) << J.dsh) + J.cls; J.lse[tok * 4] = mhat + __builtin_amdgcn_logf(l_reg); }
    } }
  asm volatile("s_waitcnt lgkmcnt(0)\n\ts_barrier" ::: "memory");
  #undef DMA_K
  #undef DMA_V
  #undef CMASK
  #undef START
  #undef RESC
  #undef ROT
}
#undef SBAR
#undef WAIT_BAR
}


namespace attn8 {
typedef int i32x8 __attribute__((ext_vector_type(8)));
typedef int i32x4 __attribute__((ext_vector_type(4)));
typedef float f32x16 __attribute__((ext_vector_type(16)));
typedef unsigned u32x4 __attribute__((ext_vector_type(4)));
constexpr int SLOT = 4096, RING = 8, NSL = RING;
constexpr int L_K = 0, L_V = NSL * SLOT, L_WS = 2 * NSL * SLOT, L_OST = L_WS + 8 * 256, L_BYTES = L_OST + 8 * 4096;
struct Job { const unsigned char* Q; const unsigned char* K; const unsigned char* VT; unsigned char* O; };
__device__ __forceinline__ void glds16(const void* gsrc, unsigned lds_dst) { unsigned keep;
  asm volatile("s_mov_b32 %0, m0\n\ts_mov_b32 m0, %2\n\ts_nop 0\n\tglobal_load_lds_dwordx4 %1, off\n\ts_mov_b32 m0, %0" : "=&s"(keep) : "v"(gsrc), "s"(lds_dst) : "memory"); }
__device__ __forceinline__ int crow(int r, int hi) { return (r & 3) + 8 * (r >> 2) + 4 * hi; }
#define A8_WAITBAR(N) asm volatile("s_waitcnt vmcnt(" #N ") lgkmcnt(0)\n\ts_barrier" ::: "memory")
#define A8_WAITBAR_N(N) asm volatile("s_waitcnt vmcnt(%0) lgkmcnt(0)\n\ts_barrier" :: "n"(N) : "memory")
template <int NT> __device__ __forceinline__ void attn_unit_f8(const Job& J, char* shm, const int wid_in) {
  int wid = wid_in; asm volatile("" : "+s"(wid));
  const int lane = lane_id_asm(), r32 = lane & 31, hi = lane >> 5;
  const unsigned lds0 = (unsigned)(uintptr_t)shm;
  typedef __attribute__((address_space(3))) const char* lds_cptr;
  const lds_cptr shm3 = (lds_cptr)shm;
  const bool kwave = wid < 4;
  const int w4 = wid & 3; const int drow = 16 * w4 + (lane >> 2); const int cl = (lane & 3) ^ ((drow >> 2) & 3);
  const unsigned char* dsrc = kwave ? J.K + (long)drow * 256 + 16 * cl : J.VT + (long)drow * 4096 + 16 * cl;
  const long dstep = kwave ? 64 * 256 : 64;
  const unsigned ddst = lds0 + (kwave ? L_K : L_V) + w4 * 1024;
  #define A8_DMA(t, slot) glds16(dsrc + (long)(t) * dstep, (unsigned)__builtin_amdgcn_readfirstlane(ddst + (slot)))
  const int sw = (r32 >> 2) & 3; const int foff0 = r32 * 64 + 16 * ((2 * hi) ^ sw), foff1 = r32 * 64 + 16 * ((2 * hi + 1) ^ sw);
  #define A8_FRAG(base, half) __builtin_shufflevector(*(const __attribute__((address_space(3))) i32x4*)((base) + (half) * 2048 + foff0), *(const __attribute__((address_space(3))) i32x4*)((base) + (half) * 2048 + foff1), 0, 1, 2, 3, 4, 5, 6, 7)
  const unsigned char* qp = J.Q + (long)(wid * 32 + r32) * 1024 + 32 * hi;
  const i32x8 qf = __builtin_shufflevector(*(const i32x4*)qp, *(const i32x4*)(qp + 16), 0, 1, 2, 3, 4, 5, 6, 7);
  if (kwave) { _Pragma("unroll") for (int i = 0; i < RING; ++i) A8_DMA(i, i * SLOT); } else { _Pragma("unroll") for (int i = 0; i < RING - 2; ++i) A8_DMA(i, i * SLOT); }
  f32x16 o0 = f32x16{}, o1 = f32x16{}, o2 = f32x16{}; const f32x16 zero = f32x16{};
  i32x8 ones; _Pragma("unroll") for (int w = 0; w < 8; ++w) ones[w] = 0x38383838;
  asm volatile("" : "+v"(ones));
  f32x16 SA0, SA1, SB0, SB1; i32x8 PA, PB;
  A8_WAITBAR_N(RING - 1);
  { const i32x8 k0 = A8_FRAG(shm3 + L_K, 0), k1 = A8_FRAG(shm3 + L_K, 1);
    SA0 = __builtin_amdgcn_mfma_scale_f32_32x32x64_f8f6f4(k0, qf, zero, 0, 0, 0, 0, 0, 0); SA1 = __builtin_amdgcn_mfma_scale_f32_32x32x64_f8f6f4(k1, qf, zero, 0, 0, 0, 0, 0, 0); }
  #define A8_SB() __builtin_amdgcn_sched_barrier(0)
  #define A8_SLOTOF(i) ((((i) + RING) & (RING - 1)) * SLOT)
  #define A8_EXP8(X, B) do { _Pragma("unroll") for (int r = 0; r < 8; ++r) X[(B) + r] = __builtin_amdgcn_exp2f(X[(B) + r]); asm volatile("" : "+v"(X)); } while (0)
  #define A8_CVT4(P, WB, X) do { _Pragma("unroll") for (int w = 0; w < 4; ++w) { unsigned a_ = (unsigned)P[(WB) + w];     \
      a_ = __builtin_amdgcn_cvt_pk_bf8_f32(X[4 * w], X[4 * w + 1], a_, false); a_ = __builtin_amdgcn_cvt_pk_bf8_f32(X[4 * w + 2], X[4 * w + 3], a_, true); P[(WB) + w] = (int)a_; } asm volatile("" : "+v"(P)); } while (0)
  #define A8_STEP(C0, C1, N0, N1, PP, PN, t, WK, WV, DK, DV, QK, PV, EX) do { \
    if (kwave) { A8_WAITBAR_N(WK); } else { A8_WAITBAR_N(WV); } \
    if (kwave) { if (DK) A8_DMA((t) + RING, A8_SLOTOF(t)); } else { if (DV) A8_DMA((t) - 2 + RING, A8_SLOTOF((t) - 2)); } \
    i32x8 k0_ = ones, k1_ = ones, v0_ = ones, v1_ = ones; \
    if (QK) { k0_ = A8_FRAG(shm3 + L_K + A8_SLOTOF((t) + 1), 0); k1_ = A8_FRAG(shm3 + L_K + A8_SLOTOF((t) + 1), 1); } \
    if (PV) { v0_ = A8_FRAG(shm3 + L_V + A8_SLOTOF((t) - 1), 0); v1_ = A8_FRAG(shm3 + L_V + A8_SLOTOF((t) - 1), 1); } \
    A8_SB(); \
    if (EX) A8_EXP8(C0, 0); A8_SB(); \
    if (QK) N0 = __builtin_amdgcn_mfma_scale_f32_32x32x64_f8f6f4(k0_, qf, zero, 0, 0, 0, 0, 0, 0); if (EX) A8_EXP8(C0, 8); A8_SB(); \
    if (QK) N1 = __builtin_amdgcn_mfma_scale_f32_32x32x64_f8f6f4(k1_, qf, zero, 0, 0, 0, 0, 0, 0); if (EX) A8_EXP8(C1, 0); A8_SB(); \
    if (PV) o0 = __builtin_amdgcn_mfma_scale_f32_32x32x64_f8f6f4(PP, v0_, o0, 1, 0, 0, 0, 0, 0); if (EX) A8_EXP8(C1, 8); A8_SB(); \
    if (PV) o1 = __builtin_amdgcn_mfma_scale_f32_32x32x64_f8f6f4(PP, v1_, o1, 1, 0, 0, 0, 0, 0); if (EX) A8_CVT4(PN, 0, C0); A8_SB(); \
    if (PV) o2 = __builtin_amdgcn_mfma_scale_f32_32x32x64_f8f6f4(PP, ones, o2, 1, 0, 0, 0, 0, 0); if (EX) A8_CVT4(PN, 4, C1); A8_SB();     \
  } while (0)
  #define A8_EVEN(t, WK, WV, DK, DV, QK, PV, EX) A8_STEP(SA0, SA1, SB0, SB1, PB, PA, t, WK, WV, DK, DV, QK, PV, EX)
  #define A8_ODD(t, WK, WV, DK, DV, QK, PV, EX)  A8_STEP(SB0, SB1, SA0, SA1, PA, PB, t, WK, WV, DK, DV, QK, PV, EX)
  PA = ones; PB = ones;
  static_assert(RING == 8 && NT % 2 == 0 && NT >= 2 * RING, "the peeled tail below is written for RING = 8");
  A8_EVEN(0, 6, 6, true, true, true, false, true);
#pragma unroll 1
  for (int t = 1; t < NT - 9; t += 2) {
    A8_ODD(t, 6, 6, true, true, true, true, true);
    A8_EVEN(t + 1, 6, 6, true, true, true, true, true);
  }
  A8_ODD(NT - 9, 6, 6, true, true, true, true, true);
  A8_EVEN(NT - 8, 6, 6, false, true, true, true, true);
  A8_ODD(NT - 7, 5, 6, false, true, true, true, true);
  A8_EVEN(NT - 6, 4, 6, false, false, true, true, true);
  A8_ODD(NT - 5, 3, 5, false, false, true, true, true);
  A8_EVEN(NT - 4, 2, 4, false, false, true, true, true);
  A8_ODD(NT - 3, 1, 3, false, false, true, true, true);
  A8_EVEN(NT - 2, 0, 2, false, false, true, true, true);
  A8_ODD(NT - 1, 0, 1, false, false, false, true, true);
  A8_EVEN(NT, 0, 0, false, false, false, true, false);
  #undef A8_EVEN
  #undef A8_ODD
  #undef A8_STEP
  #undef A8_EXP8
  #undef A8_CVT4
  #undef A8_SB
  #undef A8_SLOTOF
  #undef A8_FRAG
  #undef A8_DMA
  float rli[16];
  #pragma unroll
  for (int r = 0; r < 16; ++r) rli[r] = __builtin_amdgcn_rcpf(o2[r]);
  unsigned char* stg8 = (unsigned char*)(shm + L_OST) + wid * 4096;
  #pragma unroll
  for (int r = 0; r < 16; ++r) { const int orow = crow(r, hi);
    const float a = o0[r] * rli[r], b = o1[r] * rli[r];
    stg8[orow * 64 + r32] = (unsigned char)(__builtin_amdgcn_cvt_pk_fp8_f32(a, a, 0, false) & 0xff); stg8[orow * 64 + 32 + r32] = (unsigned char)(__builtin_amdgcn_cvt_pk_fp8_f32(b, b, 0, false) & 0xff); }
  asm volatile("s_waitcnt lgkmcnt(0)" ::: "memory");
  unsigned char* Ow = J.O + (long)(wid * 32) * 1024;
  #pragma unroll
  for (int i = 0; i < 2; ++i) { const int row = i * 16 + (lane >> 2), ch = lane & 3; const u32x4 v = *(const u32x4*)(stg8 + row * 64 + ch * 16); *(u32x4*)(Ow + (long)row * 1024 + ch * 16) = v; }
  asm volatile("s_waitcnt lgkmcnt(0)\n\ts_barrier" ::: "memory");
}
#undef A8_WAITBAR
#undef A8_WAITBAR_N
}

constexpr size_t MiB = 1u << 20;
constexpr size_t WS_CTL = 0, CTL_ZERO_BYTES = 1 * MiB;
constexpr size_t WS_MOD = 1 * MiB;
constexpr size_t WS_ROPE = WS_MOD + 512 * 1024;
constexpr size_t WS_BLUT = WS_ROPE + 8192;
constexpr size_t WS_RC0 = WS_BLUT + 12 * 768 * 4;
constexpr size_t WS_HIST = WS_RC0 + 4096;
constexpr size_t WS_TILEE = WS_HIST + 32768;
constexpr size_t WS_TOPE = 2 * MiB;
constexpr size_t WS_TOPW = WS_TOPE + 512 * 1024;
constexpr size_t WS_SLOT = WS_TOPW + 512 * 1024;
constexpr size_t WS_ROWW = WS_SLOT + 512 * 1024;
constexpr size_t WS_LSE = 5 * MiB;
constexpr size_t WS_WRHI = 7 * MiB;
constexpr size_t WS_WRLO = 8 * MiB;
constexpr size_t WS_WIN = 9 * MiB;
constexpr size_t WS_WBRA = 32 * MiB;
constexpr size_t WS_WBRB = 33 * MiB;
constexpr size_t WS_WOUT = 37 * MiB;
constexpr size_t WS_WGU = 41 * MiB;
constexpr size_t WS_WDN = 297 * MiB;
constexpr size_t WS_X = 425 * MiB;
constexpr size_t WS_H = 553 * MiB;
constexpr size_t WS_R = 617 * MiB;
constexpr size_t WS_AQKV = WS_R;
constexpr size_t WS_QB = WS_R + 144 * MiB;
constexpr size_t WS_KB = WS_R + 208 * MiB;
constexpr size_t WS_VB = WS_R + 224 * MiB;
constexpr size_t WS_GATE = WS_R + 240 * MiB;
constexpr size_t WS_OAG = WS_R + 368 * MiB;
constexpr size_t WS_OA = WS_R + 416 * MiB;
constexpr size_t WS_MERGED = WS_R + 432 * MiB;
constexpr size_t WS_XS = WS_R;
constexpr size_t WS_ACT = WS_R + 136 * MiB;
constexpr size_t WS_Y = WS_R + 272 * MiB;
constexpr size_t WS_OB = WS_R + 496 * MiB;
constexpr size_t WS_M8 = WS_R + 560 * MiB;
constexpr size_t WS_END = WS_R + 592 * MiB;
constexpr int CW_BAR = 4096;

constexpr int RING_BYTES = 133120;
constexpr int LDSCTL_OFF = RING_BYTES;
constexpr int LDS_BYTES = 147456;
constexpr int NWAVES = 8;

#define GAS __attribute__((address_space(1)))
#define LAS __attribute__((address_space(3)))
typedef unsigned short bf16;
typedef unsigned v4u __attribute__((ext_vector_type(4)));
typedef unsigned v2u __attribute__((ext_vector_type(2)));
typedef float f32x4 __attribute__((ext_vector_type(4)));
typedef float f32x16 __attribute__((ext_vector_type(16)));
typedef int i32x4 __attribute__((ext_vector_type(4)));
typedef short bf16x8 __attribute__((ext_vector_type(8)));
typedef GAS unsigned gu32;
#define RLX_AGENT __ATOMIC_RELAXED, __HIP_MEMORY_SCOPE_AGENT
#define LDS_WAIT() asm volatile("s_waitcnt lgkmcnt(0)" ::: "memory")
__device__ __forceinline__ unsigned f2bf(float f) { unsigned u = __builtin_bit_cast(unsigned, f); return (u + 0x7fffu + ((u >> 16) & 1u)) >> 16; }
__device__ __forceinline__ unsigned pk2(float lo, float hi) { return f2bf(lo) | (f2bf(hi) << 16); }
__device__ __forceinline__ float bfl(unsigned w) { return __uint_as_float(w << 16); }
__device__ __forceinline__ float bfh(unsigned w) { return __uint_as_float(w & 0xffff0000u); }

#define XB_TMO      128
#define XB_XCNT(j)  (256  + 64 * (j))
#define XB_XSUB(j)  (1280 + 64 * (j))
#define XB_XGEN(j)  (2304 + 64 * (j))
#define XB_TOP      3328
#define XB_TOPGEN   3392
#define XCD_BAR_WORDS 3456
#define XB_SPIN_CAP (1u << 18)
__device__ __forceinline__ unsigned xb_ld(unsigned* p)              { return __hip_atomic_load(p, __ATOMIC_RELAXED, __HIP_MEMORY_SCOPE_AGENT); }
__device__ __forceinline__ unsigned xb_add(unsigned* p, unsigned v) { return __hip_atomic_fetch_add(p, v, __ATOMIC_RELAXED, __HIP_MEMORY_SCOPE_AGENT); }
__device__ __forceinline__ unsigned xb_xcc_id() { return (unsigned)__builtin_amdgcn_s_getreg((3 << 11) | 20) & 0xFu; }
#define XB_SPIN(cond, bar) do { unsigned _sp = 0; while (cond) { __builtin_amdgcn_s_sleep(1); \
    if ((++_sp & 255u) == 0u) { if (xb_ld(&(bar)[XB_TMO])) break; if (_sp > XB_SPIN_CAP) { atomicAdd(&(bar)[XB_TMO], 1u); break; } } } } while (0)
struct XcdBarrier { unsigned* bar; unsigned x; volatile LAS unsigned* st; };
__device__ __forceinline__ XcdBarrier xcd_barrier_post(unsigned* bar, volatile LAS unsigned* st) {
    XcdBarrier b; b.bar = bar; b.x = xb_xcc_id(); b.st = st;
    if (threadIdx.x == 0) (void)xb_add(&bar[XB_XCNT(b.x)], 1u);
    return b;
}
__device__ __forceinline__ void xcd_barrier_complete(unsigned* bar, unsigned x, unsigned& nloc, unsigned& nx) {
    const unsigned G = gridDim.x * gridDim.y * gridDim.z;
    unsigned sum, cnt, mine, sp = 0u;
    for (;;) {
        sum = 0u; cnt = 0u; mine = 0u;
#pragma unroll
        for (unsigned j = 0; j < 16; ++j) { const unsigned c = xb_ld(&bar[XB_XCNT(j)]); sum += c; cnt += (c > 0u) ? 1u : 0u; mine = (j == x) ? c : mine; }
        if (sum == G) break;
        __builtin_amdgcn_s_sleep(1);
        if ((++sp & 255u) == 0u) { if (xb_ld(&bar[XB_TMO])) break; if (sp > XB_SPIN_CAP) { atomicAdd(&bar[XB_TMO], 1u); break; } }
    }
    nloc = mine > 0u ? mine : 1u; nx = cnt > 0u ? cnt : 1u;
}
__device__ __forceinline__ void xcd_barrier(const XcdBarrier& b) {
    asm volatile("s_waitcnt vmcnt(0)" ::: "memory");
    __syncthreads();
    if (threadIdx.x == 0) {
        unsigned* bar = b.bar;
        __builtin_amdgcn_s_waitcnt(0);
        unsigned nloc = b.st[0], nx = b.st[1];
        if (nloc == 0u) { xcd_barrier_complete(bar, b.x, nloc, nx); b.st[0] = nloc; b.st[1] = nx; }
        const unsigned old = xb_add(&bar[XB_XSUB(b.x)], 1u);
        const unsigned gen = old / nloc;
        if (old + 1u == (gen + 1u) * nloc) {
            __builtin_amdgcn_fence(__ATOMIC_RELEASE, "agent");
            asm volatile("s_waitcnt vmcnt(0)" ::: "memory");
            const unsigned og = xb_add(&bar[XB_TOP], 1u);
            const unsigned tg = og / nx;
            if (og + 1u == (tg + 1u) * nx) xb_add(&bar[XB_TOPGEN], 1u);
            else XB_SPIN(xb_ld(&bar[XB_TOPGEN]) == tg, bar);
            __builtin_amdgcn_fence(__ATOMIC_ACQUIRE, "agent");
            xb_add(&bar[XB_XGEN(b.x)], 1u);
            asm volatile("s_waitcnt vmcnt(0)" ::: "memory");
        } else {
            XB_SPIN(xb_ld(&bar[XB_XGEN(b.x)]) == gen, bar);
            __builtin_amdgcn_fence(__ATOMIC_ACQUIRE, "agent");
            asm volatile("s_waitcnt vmcnt(0)" ::: "memory");
        }
    }
    __syncthreads();
}

__device__ __forceinline__ float wave_sum(float v) {
    v = xsum<1>(v); v = xsum<2>(v); v = xsum<4>(v); v = xsum<8>(v); v = xsum<16>(v); v = xsum<32>(v);
    return v;
}
__device__ __forceinline__ void cvt_item(const float* W, int ldw, int K, int srcA, int srcB, bf16* WT, int dst_row0, int k0, LAS float* scr, int lane, bool ident = false) {
    const int kq = lane >> 4, nq = lane & 15; const int scol = (nq < 8 ? srcA + 4 * nq : srcB + 4 * (nq - 8));
    f32x4 v[16];
#pragma unroll
    for (int i = 0; i < 16; ++i) v[i] = __builtin_nontemporal_load((const GAS f32x4*)(W + (size_t)(k0 + 4 * i + kq) * ldw + scol));
#pragma unroll
    for (int i = 0; i < 16; ++i)
#pragma unroll
        for (int e = 0; e < 4; ++e) scr[(4 * i + kq) * 65 + 4 * nq + e] = v[i][e];
    LDS_WAIT(); asm volatile("" ::: "memory");
    const int c = lane & 7, rr = lane >> 3;
#pragma unroll
    for (int j = 0; j < 8; ++j) { const int rho = rr + 8 * j; const int sc = (rho & 32) + (ident ? (rho & 31) : pg8::perm32(rho & 31)); const LAS float* s = scr + (8 * c) * 65 + sc;
        v4u o; o.x = pk2(s[0 * 65], s[1 * 65]); o.y = pk2(s[2 * 65], s[3 * 65]); o.z = pk2(s[4 * 65], s[5 * 65]); o.w = pk2(s[6 * 65], s[7 * 65]);
        *(GAS v4u*)(WT + (size_t)(dst_row0 + rho) * K + k0 + 8 * c) = o; }
    LDS_WAIT(); asm volatile("" ::: "memory");
}
__device__ __forceinline__ void cvt_item_f8(const float* W, int ldw, int K, int srcA, int srcB, unsigned char* WT, int dst_row0, int k0, LAS float* scr, int lane, bool ident = false) {
    const int kq = lane >> 4, nq = lane & 15; const int scol = (nq < 8 ? srcA + 4 * nq : srcB + 4 * (nq - 8));
    f32x4 v[16];
#pragma unroll
    for (int i = 0; i < 16; ++i) v[i] = __builtin_nontemporal_load((const GAS f32x4*)(W + (size_t)(k0 + 4 * i + kq) * ldw + scol));
#pragma unroll
    for (int i = 0; i < 16; ++i)
#pragma unroll
        for (int e = 0; e < 4; ++e) scr[(4 * i + kq) * 65 + 4 * nq + e] = v[i][e] * pg8::W8_SCALE;
    LDS_WAIT(); asm volatile("" ::: "memory");
    const int c = lane & 7, rr = lane >> 3;
#pragma unroll
    for (int j = 0; j < 8; ++j) { const int rho = rr + 8 * j; const int sc = (rho & 32) + (ident ? (rho & 31) : pg8::perm32(rho & 31)); const LAS float* s = scr + (8 * c) * 65 + sc;
        unsigned w0 = 0, w1 = 0;
        w0 = __builtin_amdgcn_cvt_pk_fp8_f32(s[0 * 65], s[1 * 65], w0, false); w0 = __builtin_amdgcn_cvt_pk_fp8_f32(s[2 * 65], s[3 * 65], w0, true);
        w1 = __builtin_amdgcn_cvt_pk_fp8_f32(s[4 * 65], s[5 * 65], w1, false); w1 = __builtin_amdgcn_cvt_pk_fp8_f32(s[6 * 65], s[7 * 65], w1, true);
        v2u o; o.x = w0; o.y = w1; *(GAS v2u*)(WT + (size_t)(dst_row0 + rho) * K + k0 + 8 * c) = o; }
    LDS_WAIT(); asm volatile("" ::: "memory");
}
__device__ __forceinline__ int win_src(int X) { const int pn = X >> 3, bj = (X >> 2) & 1, wc = X & 3; return (pn >= 9 && pn < 14) ? pn * 256 + 64 * wc + 32 * bj : 32 * X; }
__device__ __forceinline__ int wgu_src(int X) { const int pn = X >> 3, bj = (X >> 2) & 1, wc = X & 3; return bj * 1024 + 128 * pn + 32 * wc; }

__device__ __forceinline__ void norm_row_bf16(const float* xrow, const float* g, const float* sc, const float* sh, bf16* orow, int lane) {
    const GAS f32x4* xr = (const GAS f32x4*)xrow + lane;
    f32x4 v[4]; float s = 0.f;
#pragma unroll
    for (int j = 0; j < 4; ++j) { v[j] = xr[64 * j]; s += (v[j].x * v[j].x + v[j].y * v[j].y) + (v[j].z * v[j].z + v[j].w * v[j].w); }
    const float rs = rsqrtf(wave_sum(s) * (1.0f / D) + EPS);
#pragma unroll
    for (int j = 0; j < 4; ++j) { const int c = 256 * j + 4 * lane;
        const f32x4 gg = *(const GAS f32x4*)(g + c), s1 = *(const GAS f32x4*)(sc + c), s0 = *(const GAS f32x4*)(sh + c);
        const f32x4 y = (v[j] * rs * gg) * (s1 + 1.0f) + s0;
        v2u o; o.x = pk2(y.x, y.y); o.y = pk2(y.z, y.w); *(GAS v2u*)(orow + c) = o; }
}

__device__ __forceinline__ void norm_rows2_bf16(const float* xrow, const float* g, const float* sc, const float* sh, bf16* orow, int lane) {
    const GAS f32x4* xr = (const GAS f32x4*)xrow + lane;
    f32x4 v[2][4]; float s0 = 0.f, s1 = 0.f;
#pragma unroll
    for (int j = 0; j < 4; ++j) { v[0][j] = xr[64 * j]; v[1][j] = xr[256 + 64 * j]; }
#pragma unroll
    for (int j = 0; j < 4; ++j) { s0 += (v[0][j].x * v[0][j].x + v[0][j].y * v[0][j].y) + (v[0][j].z * v[0][j].z + v[0][j].w * v[0][j].w); s1 += (v[1][j].x * v[1][j].x + v[1][j].y * v[1][j].y) + (v[1][j].z * v[1][j].z + v[1][j].w * v[1][j].w); }
    const float rs0 = rsqrtf(wave_sum(s0) * (1.0f / D) + EPS), rs1 = rsqrtf(wave_sum(s1) * (1.0f / D) + EPS);
#pragma unroll
    for (int j = 0; j < 4; ++j) { const int c = 256 * j + 4 * lane;
        const f32x4 gg = *(const GAS f32x4*)(g + c), a1 = *(const GAS f32x4*)(sc + c) + 1.0f, a0 = *(const GAS f32x4*)(sh + c);
        const f32x4 y0 = (v[0][j] * rs0 * gg) * a1 + a0, y1 = (v[1][j] * rs1 * gg) * a1 + a0;
        v2u o0; o0.x = pk2(y0.x, y0.y); o0.y = pk2(y0.z, y0.w); *(GAS v2u*)(orow + c) = o0;
        v2u o1; o1.x = pk2(y1.x, y1.y); o1.y = pk2(y1.z, y1.w); *(GAS v2u*)(orow + D + c) = o1; }
}

__device__ __forceinline__ void norm_rows2_f8(const float* xrow, const float* g, const float* sc, const float* sh, unsigned char* orow, int lane) {
    const GAS f32x4* xr = (const GAS f32x4*)xrow + lane;
    f32x4 v[2][4]; float s0 = 0.f, s1 = 0.f;
#pragma unroll
    for (int j = 0; j < 4; ++j) { v[0][j] = xr[64 * j]; v[1][j] = xr[256 + 64 * j]; }
#pragma unroll
    for (int j = 0; j < 4; ++j) { s0 += (v[0][j].x * v[0][j].x + v[0][j].y * v[0][j].y) + (v[0][j].z * v[0][j].z + v[0][j].w * v[0][j].w); s1 += (v[1][j].x * v[1][j].x + v[1][j].y * v[1][j].y) + (v[1][j].z * v[1][j].z + v[1][j].w * v[1][j].w); }
    const float rs0 = rsqrtf(wave_sum(s0) * (1.0f / D) + EPS), rs1 = rsqrtf(wave_sum(s1) * (1.0f / D) + EPS);
#pragma unroll
    for (int j = 0; j < 4; ++j) { const int c = 256 * j + 4 * lane;
        const f32x4 gg = *(const GAS f32x4*)(g + c), a1 = *(const GAS f32x4*)(sc + c) + 1.0f, a0 = *(const GAS f32x4*)(sh + c);
        const f32x4 y0 = (v[0][j] * rs0 * gg) * a1 + a0, y1 = (v[1][j] * rs1 * gg) * a1 + a0;
        unsigned w0 = 0, w1 = 0;
        w0 = __builtin_amdgcn_cvt_pk_fp8_f32(y0.x, y0.y, w0, false); w0 = __builtin_amdgcn_cvt_pk_fp8_f32(y0.z, y0.w, w0, true);
        w1 = __builtin_amdgcn_cvt_pk_fp8_f32(y1.x, y1.y, w1, false); w1 = __builtin_amdgcn_cvt_pk_fp8_f32(y1.z, y1.w, w1, true);
        *(GAS unsigned*)(orow + c) = w0; *(GAS unsigned*)(orow + D + c) = w1; }
}

__device__ __forceinline__ bool gqa_bound_ok(const float* qg, const float* kg, int lane) {
    float gq = fabsf(qg[lane]), gk = fabsf(kg[lane]);
#define MK_MAXSTEP(m) gq = fmaxf(gq, __int_as_float(__builtin_amdgcn_ds_swizzle(__float_as_int(gq), 0x1f | ((m) << 10)))); gk = fmaxf(gk, __int_as_float(__builtin_amdgcn_ds_swizzle(__float_as_int(gk), 0x1f | ((m) << 10))))
    MK_MAXSTEP(1); MK_MAXSTEP(2); MK_MAXSTEP(4); MK_MAXSTEP(8); MK_MAXSTEP(16);
#undef MK_MAXSTEP
    gq = fmaxf(gq, xget32(gq, lane >> 5)); gk = fmaxf(gk, xget32(gk, lane >> 5));
    const float bound = 64.0f * gq * gk * C2 * 1.01f; return __builtin_amdgcn_readfirstlane((int)(bound <= 14.0f)) != 0;
}

struct Args { const float* in[20]; float* out; unsigned char* ws; int ph_lo, ph_hi, li, pad; };
constexpr int N_PHASES = 2 + 10 * DEPTH;

typedef const __attribute__((address_space(4))) Args* kargs_t;
__device__ __forceinline__ kargs_t kargs_opaque() { kargs_t p = (kargs_t)__builtin_amdgcn_kernarg_segment_ptr(); asm volatile("" : "+s"(p)); return p; }
#define PH_BEGIN() kargs_t ap = kargs_opaque(); unsigned char* ws = ap->ws; (void)ws; \
    int wave = wave_s; asm volatile("" : "+s"(wave)); const int lane = lane_id_asm(); const int tid = wave * 64 + lane; (void)lane; (void)tid; \
    int bx = blockIdx.x; asm volatile("" : "+s"(bx)); int G = gridDim.x; asm volatile("" : "+s"(G)); const int vcu = (G % 8 == 0) ? (bx % 8) * (G / 8) + bx / 8 : bx; (void)vcu; \
    const int gw = vcu * NWAVES + wave, NGW = G * NWAVES; (void)gw; (void)NGW; const int gtid = vcu * (NWAVES * 64) + tid, NGT = G * NWAVES * 64; (void)gtid; (void)NGT
#define INP(k) (ap->in[k])
#define x_in INP(0)
#define c_in INP(1)
#define w_ada INP(2)
#define b_ada INP(3)
#define norm1_g INP(4)
#define w_in INP(5)
#define q_norm_g INP(6)
#define k_norm_g INP(7)
#define rel_bias INP(8)
#define w_br_a INP(9)
#define w_br_b INP(10)
#define w_out INP(11)
#define norm2_g INP(12)
#define w_router INP(13)
#define b_router INP(14)
#define w_gate_up INP(15)
#define b_gate_up INP(16)
#define w_down INP(17)
#define b_down INP(18)
#define final_g INP(19)
#define MOD ((float*)(ws + WS_MOD))
#define ROPE ((float*)(ws + WS_ROPE))
#define BLUT ((float*)(ws + WS_BLUT))
#define RC0 ((float*)(ws + WS_RC0))
#define HIST ((int*)(ws + WS_HIST))
#define TILEE ((int*)(ws + WS_TILEE))
#define TOPE ((int*)(ws + WS_TOPE))
#define TOPW ((float*)(ws + WS_TOPW))
#define SLOT ((int*)(ws + WS_SLOT))
#define ROWW ((float*)(ws + WS_ROWW))
#define LSE ((float*)(ws + WS_LSE))
#define WRHI ((bf16*)(ws + WS_WRHI))
#define WRLO ((bf16*)(ws + WS_WRLO))
#define WIN ((unsigned char*)(ws + WS_WIN))
#define WBRA ((unsigned char*)(ws + WS_WBRA))
#define WBRB ((unsigned char*)(ws + WS_WBRB))
#define WOUT ((unsigned char*)(ws + WS_WOUT))
#define WGU ((unsigned char*)(ws + WS_WGU))
#define WDN ((unsigned char*)(ws + WS_WDN))
#define X ((float*)(ws + WS_X))
#define H ((bf16*)(ws + WS_H))
#define AQKV ((bf16*)(ws + WS_AQKV))
#define QB ((bf16*)(ws + WS_QB))
#define KB ((bf16*)(ws + WS_KB))
#define VB ((bf16*)(ws + WS_VB))
#define GATE ((bf16*)(ws + WS_GATE))
#define OAG ((bf16*)(ws + WS_OAG))
#define OA ((unsigned char*)(ws + WS_OA))
#define MERGED ((bf16*)(ws + WS_MERGED))
#define OB ((unsigned char*)(ws + WS_OB))
#define M8 ((unsigned char*)(ws + WS_M8))
#define XS ((unsigned char*)(ws + WS_XS))
#define ACT ((unsigned char*)(ws + WS_ACT))
#define YB ((bf16*)(ws + WS_Y))
__global__ void __launch_bounds__(NWAVES * 64, 2) mk_fwd(Args args) {
    extern __shared__ __attribute__((aligned(16))) unsigned char lds[];
    LAS unsigned char* L = (LAS unsigned char*)lds;
    volatile LAS unsigned* MISC = (volatile LAS unsigned*)(L + LDSCTL_OFF);
    gu32* ctl = (gu32*)(args.ws + WS_CTL);
    const int wave_s = __builtin_amdgcn_readfirstlane(threadIdx.x >> 6);
    for (int u = threadIdx.x; u < (LDS_BYTES - LDSCTL_OFF) / 4; u += NWAVES * 64) ((LAS unsigned*)(L + LDSCTL_OFF))[u] = 0u;
    __syncthreads();
    XcdBarrier bar; bar.bar = (unsigned*)(ctl + CW_BAR) + args.li * XCD_BAR_WORDS; bar.x = 0; bar.st = nullptr;
    if (!MK_PER_PHASE) bar = xcd_barrier_post((unsigned*)(ctl + CW_BAR) + args.li * XCD_BAR_WORDS, MISC + 8);
    const int lo = args.ph_lo, hi = args.ph_hi;
#define IN(k) (lo <= (k) && (k) < hi)
#define KIND(q) ((PH_KIND_MASK >> (q)) & 1)
#define SEAM(k) do { if (IN(k) && IN((k) + 1)) xcd_barrier(bar); } while (0)

    for (int rep0 = 0; rep0 < 1 + PROBE_P0; ++rep0) {
    if (KIND(0) && IN(0)) { PH_BEGIN();
        {
            LAS float* cact = (LAS float*)L;
            LAS float* part = (LAS float*)(L + 32768);
            for (int i = tid; i < NB * D; i += NWAVES * 64) { const float cv = c_in[i]; cact[i] = cv / (1.0f + __expf(-cv)); }
            __syncthreads();
            for (int vb = bx; vb < 256; vb += G) {
                const int gc = vb * 48 + lane;
                const int l = gc / 6144, col = gc % 6144;
                float a[NB];
#pragma unroll
                for (int b = 0; b < NB; ++b) a[b] = 0.f;
                if (lane < 48) {
                    const float* wp = w_ada + (size_t)l * D * 6144 + col;
                    for (int k = wave * 128; k < wave * 128 + 128; ++k) { const float w = wp[(size_t)k * 6144];
#pragma unroll
                        for (int b = 0; b < NB; ++b) a[b] += cact[b * D + k] * w; }
                }
#pragma unroll
                for (int b = 0; b < NB; ++b) part[(wave * NB + b) * 64 + lane] = a[b];
                __syncthreads();
                if (tid < NB * 48) { const int b = tid / 48, cl = tid % 48; const int gc2 = vb * 48 + cl; const int l2 = gc2 / 6144, col2 = gc2 % 6144;
                    float s = b_ada[l2 * 6144 + col2];
#pragma unroll
                    for (int w = 0; w < NWAVES; ++w) s += part[(w * NB + b) * 64 + cl];
                    MOD[((size_t)l2 * NB + b) * 6144 + col2] = s; }
                __syncthreads();
            }
        }
        for (int i = gtid; i < 1024 + 12 * 768; i += NGT) {
            if (i < 1024) { const int p = i >> 4, f = i & 15; const double inv = pow(10000.0, -(double)f / 16.0); const double ang = (double)p * inv; ROPE[i] = (float)cos(ang); ROPE[1024 + i] = (float)sin(ang); }
            else { const int j = i - 1024; const int hh = j / 768, di = j % 768; const int delta = di - 383; const int g = hh >> 2; const int dil = g == 0 ? 1 : (g == 1 ? 4 : 16);
                float val = -INFINITY;
                if (delta >= -64 && delta <= 64) { const int rel = delta * dil; const int n = rel < 0 ? -rel : rel; int bk = rel > 0 ? 16 : 0;
                    if (n < 8) bk += n; else { int lg = 8 + (int)(logf((float)n / 8.0f) / logf(128.0f) * 8.0f); if (lg > 15) lg = 15; bk += lg; }
                    val = rel_bias[bk * 12 + hh] * LOG2E; }
                BLUT[j] = val; }
        }
        {
            LAS float* scr = (LAS float*)(L + wave * 16640);
            __syncthreads();
            constexpr int I_IN = 16 * 92, I_BRA = 4 * 16, I_BRB = 16 * 16, I_OUT = 16 * 16, I_GU = 16 * 32, I_DN = 16 * 16;
            constexpr int PER_L = I_IN + I_BRA + I_BRB + I_OUT;
            constexpr int NITEMS = DEPTH * PER_L + DEPTH * NE * (I_GU + I_DN);
            for (int it = gw; it < NITEMS; it += NGW) {
                int r = it;
                if (r < DEPTH * PER_L) {
                    const int l = r / PER_L; r %= PER_L;
                    if (r < I_IN) { const int kb = r / 92, g64 = r % 92; cvt_item_f8(w_in + (size_t)l * D * N_IN, N_IN, D, win_src(2 * g64), win_src(2 * g64 + 1), WIN + (size_t)l * N_IN * D, 64 * g64, 64 * kb, scr, lane, (g64 >> 2) >= 9 && (g64 >> 2) < 14); continue; } r -= I_IN;
                    if (r < I_BRA) { const int kb = r / 16, g64 = r % 16; cvt_item_f8(w_br_a + (size_t)l * 256 * D, D, 256, 64 * g64, 64 * g64 + 32, WBRA + (size_t)l * D * 256, 64 * g64, 64 * kb, scr, lane); continue; } r -= I_BRA;
                    if (r < I_BRB) { const int kb = r / 16, g64 = r % 16; cvt_item_f8(w_br_b + (size_t)l * D * D, D, D, 64 * g64, 64 * g64 + 32, WBRB + (size_t)l * D * D, 64 * g64, 64 * kb, scr, lane); continue; } r -= I_BRB;
                    { const int kb = r / 16, g64 = r % 16; cvt_item_f8(w_out + (size_t)l * D * D, D, D, 64 * g64, 64 * g64 + 32, WOUT + (size_t)l * D * D, 64 * g64, 64 * kb, scr, lane); continue; }
                }
                r -= DEPTH * PER_L;
                if (r < DEPTH * NE * I_GU) { const int le = r / I_GU; r %= I_GU; const int kb = r / 32, g64 = r % 32;
                    cvt_item_f8(w_gate_up + (size_t)le * D * 2048, 2048, D, wgu_src(2 * g64), wgu_src(2 * g64 + 1), WGU + (size_t)le * 2048 * D, 64 * g64, 64 * kb, scr, lane); continue; }
                r -= DEPTH * NE * I_GU;
                { const int le = r / I_DN; r %= I_DN; const int kb = r / 16, g64 = r % 16;
                    cvt_item_f8(w_down + (size_t)le * D * D, D, D, 64 * g64, 64 * g64 + 32, WDN + (size_t)le * D * D, 64 * g64, 64 * kb, scr, lane); }
            }
        }
    }
    SEAM(0);
    }
    if (KIND(1) && IN(1)) { PH_BEGIN();
        for (int m = 2 * gw; m < T; m += 2 * NGW) { const int b = m >> 12; const float* md = MOD + (size_t)b * 6144;
            norm_rows2_f8(x_in + (size_t)m * D, norm1_g, md + 1024, md, (unsigned char*)H + (size_t)m * D, lane); }
        for (int i = gtid; i < DEPTH * NB * NE * D; i += NGT) { const int k = i & 1023, e = (i >> 10) & 31, b = (i >> 15) & 7, l = i >> 18;
            const float v = norm2_g[l * D + k] * (1.0f + MOD[((size_t)l * NB + b) * 6144 + 4 * 1024 + k]) * w_router[((size_t)l * D + k) * NE + e];
            const unsigned hb = f2bf(v); const float lv = v - __uint_as_float(hb << 16);
            WRHI[i] = (bf16)hb; WRLO[i] = (bf16)f2bf(lv); }
        for (int i = gw; i < DEPTH * NB * NE; i += NGW) { const int e = i & 31, b = (i >> 5) & 7, l = i >> 8; float s = 0.f;
            for (int k = lane; k < D; k += 64) s += MOD[((size_t)l * NB + b) * 6144 + 3 * 1024 + k] * w_router[((size_t)l * D + k) * NE + e];
            s = wave_sum(s); if (lane == 0) RC0[i] = s + b_router[l * NE + e]; }
    }
    SEAM(1);

    for (int li = (PROBE_MASK ? -1 : 0); li < DEPTH; ++li) {
        const int l = li < 0 ? 0 : li; const bool virt = li < 0;
        const int P = 2 + 10 * l;
#define VK(q) (!virt || ((PROBE_MASK >> (q)) & 1))
        if (KIND(2) && IN(P + 0) && VK(2)) { PH_BEGIN();
            pg8::Gemm g{H, (const bf16*)(WIN + (size_t)l * N_IN * D), D / 2}; pg8::StaticOrder S; S.init(T, N_IN, G, bx);
            const bool f8attn = gqa_bound_ok(q_norm_g + l * 64, k_norm_g + l * 64, lane);
            pg8::EpiIn E{AQKV, QB, KB, VB, GATE, q_norm_g + l * 64, k_norm_g + l * 64, ROPE, pg8::W8_INV, f8attn};
            pg8::gemm_phase_f8<pg8::EpiIn, pg8::StaticOrder>(L, g, S, E, wave);
        }
        if (VK(2)) SEAM(P + 0);
        if (KIND(3) && IN(P + 1) && VK(3)) { PH_BEGIN();
            namespace ab = attn_body;
            const bool nomax = gqa_bound_ok(q_norm_g + l * 64, k_norm_g + l * 64, lane);
            for (int j = 0; j < 8; ++j) {
                const int uidx = vcu * 8 + j; if (uidx >= 2048) break;
                const int pair = uidx >> 6, idx = uidx & 63; const int b = pair >> 2, kvh = pair & 3, hq = idx >> 4, qb = idx & 15; const int h = kvh * 4 + hq;
                ab::Job J; J.Q = (const ab::bf16*)QB + ((size_t)b * SEQ + qb * 256) * 1024 + h * 64; J.K = (const ab::bf16*)KB + (size_t)b * SEQ * 256 + kvh * 64; J.V = (const ab::bf16*)VB + (size_t)b * SEQ * 256 + kvh * 64;
                J.O = (ab::bf16*)(OB + ((size_t)b * SEQ + qb * 256) * 1024 + h * 64)  ; J.lse = nullptr; J.lutg = nullptr; J.NT = 64; J.i0 = 0; J.kq0 = 0; J.dsh = 0; J.cls = 0;
                if (nomax) { attn8::Job J8; J8.Q = (const unsigned char*)QB + ((size_t)b * SEQ + qb * 256) * 1024 + h * 64; J8.K = (const unsigned char*)KB + (size_t)b * SEQ * 256 + kvh * 64;
                    J8.VT = (const unsigned char*)VB + ((size_t)((b * 4 + kvh) * 64) << 12); J8.O = OB + ((size_t)b * SEQ + qb * 256) * 1024 + h * 64;
                    attn8::attn_unit_f8<64>(J8, (char*)lds, wave); }
                else ab::attn_unit<0, 8, false>(J, (char*)lds, wave);
            }
            for (int j = 0; j < 6; ++j) {
                const int uidx = vcu * 6 + j; if (uidx >= 1536) break;
                const int g = uidx / 512, r = uidx % 512; const int b = r >> 6, hs = (r >> 4) & 3, combo = r & 15;
                const int dsh = 2 * g; const int Lc = SEQ >> dsh; const int nqb = Lc >> 8;
                const int cls = combo / nqb, qb = combo % nqb; const int i0 = qb * 256;
                int t0 = (i0 >> 6) - 1; const int ntile = Lc >> 6; const int NT = ntile >= 6 ? 6 : 4; if (t0 < 0) t0 = 0; if (t0 > ntile - NT) t0 = ntile - NT;
                const size_t cbase = (size_t)b * SEQ + (size_t)cls * Lc;
                const ab::bf16* aq = (const ab::bf16*)AQKV + (size_t)(g * 3 + 0) * T * 256; const ab::bf16* ak = (const ab::bf16*)AQKV + (size_t)(g * 3 + 1) * T * 256; const ab::bf16* av = (const ab::bf16*)AQKV + (size_t)(g * 3 + 2) * T * 256;
                ab::Job J; J.Q = aq + (cbase + i0) * 256 + hs * 64; J.K = ak + (cbase + t0 * 64) * 256 + hs * 64; J.V = av + (cbase + t0 * 64) * 256 + hs * 64;
                J.O = (ab::bf16*)OAG + (size_t)g * T * 256 + (size_t)b * SEQ * 256 + hs * 64; J.lse = LSE + (size_t)g * T * 4 + (size_t)b * SEQ * 4 + hs; J.lutg = BLUT + (g * 4 + hs) * 768;
                J.NT = NT; J.i0 = i0; J.kq0 = t0 * 64 - i0; J.dsh = dsh; J.cls = cls;
                ab::attn_unit<1, 8>(J, (char*)lds, wave);
            }
        }
        if (VK(3)) SEAM(P + 1);
        if (KIND(4) && IN(P + 2) && VK(4)) { PH_BEGIN();
            for (int i = gtid; i < T * 32; i += NGT) { const int t = i >> 5, ch = i & 31, hs = ch >> 3;
                const float l0 = LSE[(size_t)t * 4 + hs], l1 = LSE[(size_t)T * 4 + (size_t)t * 4 + hs], l2 = LSE[(size_t)2 * T * 4 + (size_t)t * 4 + hs];
                const float mx = fmaxf(l0, fmaxf(l1, l2)); float w0 = exp2f(l0 - mx), w1 = exp2f(l1 - mx), w2 = exp2f(l2 - mx); const float inv = 1.0f / (w0 + w1 + w2); w0 *= inv; w1 *= inv; w2 *= inv;
                const v4u a = *(const GAS v4u*)(OAG + (size_t)t * 256 + ch * 8), bq = *(const GAS v4u*)(OAG + (size_t)T * 256 + (size_t)t * 256 + ch * 8), cq = *(const GAS v4u*)(OAG + (size_t)2 * T * 256 + (size_t)t * 256 + ch * 8);
                unsigned o0 = 0, o1 = 0;
                o0 = __builtin_amdgcn_cvt_pk_fp8_f32(w0 * bfl(a.x) + w1 * bfl(bq.x) + w2 * bfl(cq.x), w0 * bfh(a.x) + w1 * bfh(bq.x) + w2 * bfh(cq.x), o0, false);
                o0 = __builtin_amdgcn_cvt_pk_fp8_f32(w0 * bfl(a.y) + w1 * bfl(bq.y) + w2 * bfl(cq.y), w0 * bfh(a.y) + w1 * bfh(bq.y) + w2 * bfh(cq.y), o0, true);
                o1 = __builtin_amdgcn_cvt_pk_fp8_f32(w0 * bfl(a.z) + w1 * bfl(bq.z) + w2 * bfl(cq.z), w0 * bfh(a.z) + w1 * bfh(bq.z) + w2 * bfh(cq.z), o1, false);
                o1 = __builtin_amdgcn_cvt_pk_fp8_f32(w0 * bfl(a.w) + w1 * bfl(bq.w) + w2 * bfl(cq.w), w0 * bfh(a.w) + w1 * bfh(bq.w) + w2 * bfh(cq.w), o1, true);
                v2u o; o.x = o0; o.y = o1; *(GAS v2u*)(OA + (size_t)t * 256 + ch * 8) = o; }
        }
        if (VK(4)) SEAM(P + 2);
        if (KIND(5) && IN(P + 3) && VK(5)) { PH_BEGIN();
            pg8::StaticOrder S; S.init(T, D, G, bx);
            { pg8::Gemm g{(const bf16*)OA, (const bf16*)(WBRA + (size_t)l * D * 256), 128}; pg8::EpiMergeA E{GATE, MERGED}; pg8::gemm_phase_f8<pg8::EpiMergeA, pg8::StaticOrder>(L, g, S, E, wave); }
            { pg8::Gemm g{(const bf16*)OB, (const bf16*)(WBRB + (size_t)l * D * D), D / 2}; pg8::EpiMergeB<true> E{GATE, MERGED, M8}; pg8::gemm_phase_f8<pg8::EpiMergeB<true>, pg8::StaticOrder>(L, g, S, E, wave); }
        }
        if (VK(5)) SEAM(P + 3);
        if (KIND(6) && IN(P + 4) && VK(6)) { PH_BEGIN();
            pg8::Gemm g{(const bf16*)M8, (const bf16*)(WOUT + (size_t)l * D * D), D / 2}; pg8::StaticOrder S; S.init(T, D, G, bx);
            pg8::EpiOut E{l == 0 ? x_in : X, X, MOD + (size_t)l * NB * 6144 + 2 * 1024};
            pg8::gemm_phase_f8<pg8::EpiOut, pg8::StaticOrder>(L, g, S, E, wave);
        }
        if (VK(6)) SEAM(P + 4);
        if (KIND(7) && IN(P + 5) && VK(7)) { PH_BEGIN();
            LAS int* hist = (LAS int*)(L + LDSCTL_OFF + 256);
            for (int vb = bx; vb < 256; vb += G) {
                if (tid < NE) hist[tid] = 0;
                __syncthreads();
                {
                    const int tt = vb + 256 * wave; const int r0 = tt * 16; const int b = r0 >> 12; const int i = lane & 15, kb = lane >> 4;
                    const float* xp = X + (size_t)(r0 + i) * D + 8 * kb;
                    const bf16* bh = WRHI + ((size_t)(l * NB + b) * NE + i) * D + 8 * kb; const bf16* bl = WRLO + ((size_t)(l * NB + b) * NE + i) * D + 8 * kb;
                    f32x4 acc0 = (f32x4){0.f, 0.f, 0.f, 0.f}, acc1 = acc0; float ss = 0.f;
#pragma unroll 4
                    for (int s = 0; s < 32; ++s) {
                        const f32x4 x0 = *(const GAS f32x4*)(xp + 32 * s), x1 = *(const GAS f32x4*)(xp + 32 * s + 4);
                        const bf16x8 wh0 = *(const GAS bf16x8*)(bh + 32 * s), wh1 = *(const GAS bf16x8*)(bh + 16 * D + 32 * s), wl0 = *(const GAS bf16x8*)(bl + 32 * s), wl1 = *(const GAS bf16x8*)(bl + 16 * D + 32 * s);
                        ss += (x0.x * x0.x + x0.y * x0.y) + (x0.z * x0.z + x0.w * x0.w) + (x1.x * x1.x + x1.y * x1.y) + (x1.z * x1.z + x1.w * x1.w);
                        v4u ah, al;
                        { const unsigned h0 = f2bf(x0.x), h1 = f2bf(x0.y), h2 = f2bf(x0.z), h3 = f2bf(x0.w), h4 = f2bf(x1.x), h5 = f2bf(x1.y), h6 = f2bf(x1.z), h7 = f2bf(x1.w);
                          ah.x = h0 | (h1 << 16); ah.y = h2 | (h3 << 16); ah.z = h4 | (h5 << 16); ah.w = h6 | (h7 << 16);
                          al.x = pk2(x0.x - __uint_as_float(h0 << 16), x0.y - __uint_as_float(h1 << 16)); al.y = pk2(x0.z - __uint_as_float(h2 << 16), x0.w - __uint_as_float(h3 << 16));
                          al.z = pk2(x1.x - __uint_as_float(h4 << 16), x1.y - __uint_as_float(h5 << 16)); al.w = pk2(x1.z - __uint_as_float(h6 << 16), x1.w - __uint_as_float(h7 << 16)); }
                        const bf16x8 ahv = __builtin_bit_cast(bf16x8, ah), alv = __builtin_bit_cast(bf16x8, al);
                        acc0 = __builtin_amdgcn_mfma_f32_16x16x32_bf16(wh0, ahv, acc0, 0, 0, 0); acc1 = __builtin_amdgcn_mfma_f32_16x16x32_bf16(wh1, ahv, acc1, 0, 0, 0);
                        acc0 = __builtin_amdgcn_mfma_f32_16x16x32_bf16(wl0, ahv, acc0, 0, 0, 0); acc1 = __builtin_amdgcn_mfma_f32_16x16x32_bf16(wl1, ahv, acc1, 0, 0, 0);
                        acc0 = __builtin_amdgcn_mfma_f32_16x16x32_bf16(wh0, alv, acc0, 0, 0, 0); acc1 = __builtin_amdgcn_mfma_f32_16x16x32_bf16(wh1, alv, acc1, 0, 0, 0);
                    }
                    ss = xsum<16>(ss); ss = xsum<32>(ss);
                    const float rs = rsqrtf(ss * (1.0f / D) + EPS);
                    float v[8]; const float* rc = RC0 + (l * NB + b) * NE;
#pragma unroll
                    for (int r = 0; r < 4; ++r) { v[r] = rs * acc0[r] + rc[4 * kb + r]; v[4 + r] = rs * acc1[r] + rc[16 + 4 * kb + r]; }
                    float tv[4]; int ti[4];
#pragma unroll
                    for (int k = 0; k < 4; ++k) { float best = v[0]; int br = 0;
#pragma unroll
                        for (int r = 1; r < 8; ++r) if (v[r] > best) { best = v[r]; br = r; }
#pragma unroll
                        for (int r = 0; r < 8; ++r) v[r] = (r == br) ? -INFINITY : v[r];
                        tv[k] = best; ti[k] = (br & 3) + 16 * (br >> 2) + 4 * kb; }
#pragma unroll
                    for (int round = 0; round < 2; ++round) {
                        float bv[8]; int bi[8];
#pragma unroll
                        for (int k = 0; k < 4; ++k) { bv[k] = tv[k]; bi[k] = ti[k];
                            if (round == 0) { bv[4 + k] = __int_as_float(__builtin_amdgcn_ds_swizzle(__float_as_int(tv[k]), 0x1f | (16 << 10))); bi[4 + k] = __builtin_amdgcn_ds_swizzle(ti[k], 0x1f | (16 << 10)); }
                            else { bv[4 + k] = xget32(tv[k], lane >> 5); bi[4 + k] = xget32(ti[k], lane >> 5); } }
#pragma unroll
                        for (int k = 0; k < 4; ++k) { float best = bv[0]; int bq = 0;
#pragma unroll
                            for (int r = 1; r < 8; ++r) if (bv[r] > best || (bv[r] == best && bi[r] < bi[bq])) { best = bv[r]; bq = r; }
                            int sel = bi[0];
#pragma unroll
                            for (int r = 0; r < 8; ++r) { if (r == bq) sel = bi[r]; }
#pragma unroll
                            for (int r = 0; r < 8; ++r) bv[r] = (r == bq) ? -INFINITY : bv[r];
                            tv[k] = best; ti[k] = sel; }
                    }
                    if (kb == 0) {
                        const float e1 = __expf(tv[1] - tv[0]), e2 = __expf(tv[2] - tv[0]), e3 = __expf(tv[3] - tv[0]); const float inv = 1.0f / (1.0f + e1 + e2 + e3);
                        const int tok = r0 + i;
                        *(GAS i32x4*)(TOPE + (size_t)tok * 4) = (i32x4){ti[0], ti[1], ti[2], ti[3]};
                        *(GAS f32x4*)(TOPW + (size_t)tok * 4) = (f32x4){inv, e1 * inv, e2 * inv, e3 * inv};
#pragma unroll
                        for (int k = 0; k < 4; ++k) atomicAdd((int*)&hist[ti[k]], 1);
                    }
                }
                __syncthreads();
                if (tid < NE) HIST[vb * NE + tid] = hist[tid];
                __syncthreads();
            }
            for (int m = 2 * gw; m < T; m += 2 * NGW) { const int b = m >> 12; const float* md = MOD + ((size_t)l * NB + b) * 6144;
                norm_rows2_f8(X + (size_t)m * D, norm2_g + l * D, md + 4 * 1024, md + 3 * 1024, (unsigned char*)H + (size_t)m * D, lane); }
        }
        if (VK(7)) SEAM(P + 5);
        if (KIND(8) && IN(P + 6) && VK(8)) { PH_BEGIN();
            LAS int* sm = (LAS int*)L;
            for (int vb = bx; vb < 256; vb += G) {
                { const int e = tid & 31, seg = tid >> 5; int tot = 0, bef = 0;
                    for (int q = seg * 16; q < seg * 16 + 16; ++q) { const int hv = HIST[q * NE + e]; tot += hv; if (q < vb) bef += hv; }
                    sm[tid] = tot; sm[512 + tid] = bef; }
                __syncthreads();
                if (tid < NE) { int tot = 0, bef = 0;
                    for (int s = 0; s < 16; ++s) { tot += sm[s * 32 + tid]; bef += sm[512 + s * 32 + tid]; }
                    sm[1024 + tid] = bef; sm[1056 + tid] = (tot + 255) & ~255; }
                __syncthreads();
                if (tid == 0) { int run = 0; for (int e = 0; e < NE; ++e) { const int pd = sm[1056 + e]; sm[1056 + e] = run; sm[1024 + e] += run;
                        if (vb == 0) { for (int q = run >> 8; q < (run + pd) >> 8; ++q) TILEE[q] = e; }
                        run += pd; }
                    if (vb == 0) TILEE[1000] = run >> 8; }
                __syncthreads();
                if (tid < 128) { const int tt = vb + 256 * (tid >> 4); const int tok = tt * 16 + (tid & 15);
                    const i32x4 te = *(const GAS i32x4*)(TOPE + (size_t)tok * 4); const f32x4 tw = *(const GAS f32x4*)(TOPW + (size_t)tok * 4);
                    const int s0 = atomicAdd((int*)&sm[1024 + te.x], 1), s1 = atomicAdd((int*)&sm[1024 + te.y], 1), s2 = atomicAdd((int*)&sm[1024 + te.z], 1), s3 = atomicAdd((int*)&sm[1024 + te.w], 1);
                    *(GAS i32x4*)(SLOT + (size_t)tok * 4) = (i32x4){s0, s1, s2, s3};
                    ROWW[s0] = tw.x; ROWW[s1] = tw.y; ROWW[s2] = tw.z; ROWW[s3] = tw.w;
                    sm[2048 + tid * 4 + 0] = s0; sm[2048 + tid * 4 + 1] = s1; sm[2048 + tid * 4 + 2] = s2; sm[2048 + tid * 4 + 3] = s3; }
                __syncthreads();
                for (int p = wave; p < 512; p += NWAVES) { const int q = p >> 2; const int tt = vb + 256 * (q >> 4); const int tok = tt * 16 + (q & 15); const int slot = sm[2048 + p];
                    const GAS v4u* src = (const GAS v4u*)((unsigned char*)H + (size_t)tok * D); GAS v4u* dst = (GAS v4u*)(XS + (size_t)slot * D);
                    dst[lane] = src[lane]; }
                __syncthreads();
            }
        }
        if (VK(8)) SEAM(P + 6);
        if (KIND(9) && IN(P + 7) && VK(9)) { PH_BEGIN();
            const int nmt = __builtin_amdgcn_readfirstlane(__hip_atomic_load(TILEE + 1000, __ATOMIC_RELAXED, __HIP_MEMORY_SCOPE_AGENT));
            pg8::Gemm g{(const bf16*)XS, (const bf16*)(WGU + (size_t)l * NE * 2048 * D), D / 2}; pg8::MoeOrder S{TILEE, nmt * 8, 8, G, vcu};
            pg8::EpiGU8 E{b_gate_up + (size_t)l * NE * 2048, ACT};
            pg8::gemm_phase_f8<pg8::EpiGU8, pg8::MoeOrder>(L, g, S, E, wave);
        }
        if (VK(9)) SEAM(P + 7);
        if (KIND(10) && IN(P + 8) && VK(10)) { PH_BEGIN();
            const int nmt = __builtin_amdgcn_readfirstlane(__hip_atomic_load(TILEE + 1000, __ATOMIC_RELAXED, __HIP_MEMORY_SCOPE_AGENT));
            pg8::Gemm g{(const bf16*)ACT, (const bf16*)(WDN + (size_t)l * NE * D * D), D / 2}; pg8::MoeOrder S{TILEE, nmt * 4, 4, G, vcu};
            pg8::EpiDN8 E{b_down + (size_t)l * NE * D, ROWW, YB};
            pg8::gemm_phase_f8<pg8::EpiDN8, pg8::MoeOrder>(L, g, S, E, wave);
        }
        if (VK(10)) SEAM(P + 8);
        if (KIND(11) && IN(P + 9) && VK(11)) { PH_BEGIN();
            const bool lastl = (l == DEPTH - 1);
            float* Xw = virt ? (float*)(ws + WS_R) : X; bf16* Hw = virt ? (bf16*)(ws + WS_R + 128 * MiB) : H;
            for (int m0 = 2 * gw; m0 < T; m0 += 2 * NGW) { const int b = m0 >> 12;
                i32x4 sl[2];
#pragma unroll
                for (int q = 0; q < 2; ++q) { const int* sp = SLOT + (size_t)(m0 + q) * 4;
                    sl[q].x = __hip_atomic_load(sp + 0, RLX_AGENT); sl[q].y = __hip_atomic_load(sp + 1, RLX_AGENT); sl[q].z = __hip_atomic_load(sp + 2, RLX_AGENT); sl[q].w = __hip_atomic_load(sp + 3, RLX_AGENT); }
                const float* g2 = MOD + ((size_t)l * NB + b) * 6144 + 5 * 1024;
                f32x4 v[2][4]; v2u yy[2][4][4];
#pragma unroll
                for (int q = 0; q < 2; ++q)
#pragma unroll
                    for (int j = 0; j < 4; ++j) { const int c = 256 * j + 4 * lane;
                        v[q][j] = *(const GAS f32x4*)(X + (size_t)(m0 + q) * D + c);
                        yy[q][j][0] = *(const GAS v2u*)(YB + (size_t)sl[q].x * D + c); yy[q][j][1] = *(const GAS v2u*)(YB + (size_t)sl[q].y * D + c);
                        yy[q][j][2] = *(const GAS v2u*)(YB + (size_t)sl[q].z * D + c); yy[q][j][3] = *(const GAS v2u*)(YB + (size_t)sl[q].w * D + c); }
                float s[2] = {0.f, 0.f};
#pragma unroll
                for (int q = 0; q < 2; ++q)
#pragma unroll
                    for (int j = 0; j < 4; ++j) { const int c = 256 * j + 4 * lane; const v2u y0 = yy[q][j][0], y1 = yy[q][j][1], y2 = yy[q][j][2], y3 = yy[q][j][3];
                        f32x4 ys; ys.x = (bfl(y0.x) + bfl(y1.x)) + (bfl(y2.x) + bfl(y3.x)); ys.y = (bfh(y0.x) + bfh(y1.x)) + (bfh(y2.x) + bfh(y3.x));
                        ys.z = (bfl(y0.y) + bfl(y1.y)) + (bfl(y2.y) + bfl(y3.y)); ys.w = (bfh(y0.y) + bfh(y1.y)) + (bfh(y2.y) + bfh(y3.y));
                        const f32x4 gg = *(const GAS f32x4*)(g2 + c);
                        v[q][j] = v[q][j] + gg * ys;
                        if (!lastl) *(GAS f32x4*)(Xw + (size_t)(m0 + q) * D + c) = v[q][j];
                        s[q] += (v[q][j].x * v[q][j].x + v[q][j].y * v[q][j].y) + (v[q][j].z * v[q][j].z + v[q][j].w * v[q][j].w); }
                const float rs0 = rsqrtf(wave_sum(s[0]) * (1.0f / D) + EPS), rs1 = rsqrtf(wave_sum(s[1]) * (1.0f / D) + EPS);
                if (!lastl) { const float* md = MOD + ((size_t)(l + 1) * NB + b) * 6144; const float* gn = norm1_g + (l + 1) * D;
#pragma unroll
                    for (int j = 0; j < 4; ++j) { const int c = 256 * j + 4 * lane;
                        const f32x4 gg = *(const GAS f32x4*)(gn + c), a1 = *(const GAS f32x4*)(md + 1024 + c) + 1.0f, a0 = *(const GAS f32x4*)(md + c);
                        const f32x4 y0 = (v[0][j] * rs0 * gg) * a1 + a0, y1 = (v[1][j] * rs1 * gg) * a1 + a0;
                        unsigned w0 = 0, w1 = 0;
                        w0 = __builtin_amdgcn_cvt_pk_fp8_f32(y0.x, y0.y, w0, false); w0 = __builtin_amdgcn_cvt_pk_fp8_f32(y0.z, y0.w, w0, true);
                        w1 = __builtin_amdgcn_cvt_pk_fp8_f32(y1.x, y1.y, w1, false); w1 = __builtin_amdgcn_cvt_pk_fp8_f32(y1.z, y1.w, w1, true);
                        *(GAS unsigned*)((unsigned char*)Hw + (size_t)m0 * D + c) = w0; *(GAS unsigned*)((unsigned char*)Hw + (size_t)(m0 + 1) * D + c) = w1; }
                } else {
#pragma unroll
                    for (int j = 0; j < 4; ++j) { const int c = 256 * j + 4 * lane; const f32x4 gg = *(const GAS f32x4*)(final_g + c);
                        *(GAS f32x4*)(ap->out + (size_t)m0 * D + c) = v[0][j] * rs0 * gg; *(GAS f32x4*)(ap->out + (size_t)(m0 + 1) * D + c) = v[1][j] * rs1 * gg; }
                }
            }
        }
        if (VK(11)) SEAM(P + 9);
        if (virt) { PH_BEGIN();
            for (int m = 2 * gw; m < T; m += 2 * NGW) { const int b = m >> 12; const float* md = MOD + (size_t)b * 6144; norm_rows2_f8(x_in + (size_t)m * D, norm1_g, md + 1024, md, (unsigned char*)H + (size_t)m * D, lane); }
            xcd_barrier(bar); }
    }
#undef IN
#undef SEAM
}

extern "C" void kernel_launch(void* const* d_in, const int* in_sizes, int n_in, void* d_out, int out_size, void* d_ws, size_t ws_size, hipStream_t stream) {
    static int grid = 0;
    if (grid == 0) {
        if (n_in != 20 || in_sizes[0] != T * D || out_size != T * D || ws_size < WS_END) { fprintf(stderr, "kernel_launch: unexpected shapes (n_in %d, in0 %d, out %d, ws %zu < %zu); nothing launched\n", n_in, n_in > 0 ? in_sizes[0] : -1, out_size, ws_size, (size_t)WS_END); grid = -1; return; }
        int dev = 0, cus = 0, per_cu = 0;
        if (hipGetDevice(&dev) != hipSuccess || hipDeviceGetAttribute(&cus, hipDeviceAttributeMultiprocessorCount, dev) != hipSuccess) { grid = -1; return; }
        if (hipFuncSetAttribute((const void*)mk_fwd, hipFuncAttributeMaxDynamicSharedMemorySize, LDS_BYTES) != hipSuccess) { fprintf(stderr, "kernel_launch: hipFuncSetAttribute failed\n"); grid = -1; return; }
        if (hipOccupancyMaxActiveBlocksPerMultiprocessor(&per_cu, (const void*)mk_fwd, NWAVES * 64, LDS_BYTES) != hipSuccess || per_cu < 1)
            fprintf(stderr, "kernel_launch: note: occupancy query reports %d workgroups per CU\n", per_cu);
        (void)hipGetLastError();
        grid = cus < 256 ? cus : 256;
        if (grid != 256) fprintf(stderr, "kernel_launch: %d CUs; this kernel's unit deals assume 256\n", grid);
    }
    if (grid < 0) return;
    if (hipMemsetAsync((char*)d_ws + WS_CTL, 0, CTL_ZERO_BYTES, stream) != hipSuccess) { fprintf(stderr, "kernel_launch: memset failed\n"); return; }
    Args a{};
    for (int i = 0; i < 20; ++i) a.in[i] = (const float*)d_in[i];
    a.out = (float*)d_out; a.ws = (unsigned char*)d_ws; a.pad = 0;
#if MK_PER_PHASE
    for (int p = 0; p < N_PHASES; ++p) { a.ph_lo = p; a.ph_hi = p + 1; a.li = 0; hipLaunchKernelGGL(mk_fwd, dim3(grid), dim3(NWAVES * 64), LDS_BYTES, stream, a); }
#else
    a.ph_lo = 0; a.ph_hi = N_PHASES; a.li = 0;
    hipLaunchKernelGGL(mk_fwd, dim3(grid), dim3(NWAVES * 64), LDS_BYTES, stream, a);
#endif
    const hipError_t le = hipPeekAtLastError();
    if (le != hipSuccess) fprintf(stderr, "kernel_launch: launch failed: %s\n", hipGetErrorName(le));
}
```

```cpp
#include <hip/hip_runtime.h>
#include <hip/hip_bf16.h>
#include <cstdio>
#include <cstdint>
#include <cmath>

#ifndef PH_KIND_MASK
#define PH_KIND_MASK 0xFFF
#endif
#ifndef PROBE_MASK
#define PROBE_MASK 0
#endif
#ifndef PROBE_P0
#define PROBE_P0 0
#endif
#ifndef MK_PER_PHASE
#define MK_PER_PHASE 0
#endif

constexpr int NB = 8, SEQ = 4096, T = NB * SEQ, D = 1024, DEPTH = 2;
constexpr int N_IN = 5888, NE = 32, TOPK = 4;
constexpr int NASSIGN = T * TOPK;
constexpr int MAX_MT = NASSIGN / 256 + NE;
constexpr int CAP_ROWS = MAX_MT * 256;
constexpr float C2 = 0.125f * 1.4426950408889634f;
constexpr float LOG2E = 1.4426950408889634f;
constexpr float EPS = 1e-6f;

__device__ __forceinline__ int lane_id_asm() { int l; asm volatile("v_mbcnt_lo_u32_b32 %0, -1, 0\n\tv_mbcnt_hi_u32_b32 %0, -1, %0" : "=v"(l)); return l; }

template <int M> __device__ __forceinline__ float xsum(float v) {
    if constexpr (M < 32) return v + __int_as_float(__builtin_amdgcn_ds_swizzle(__float_as_int(v), 0x1f | (M << 10)));
    else { auto rr = __builtin_amdgcn_permlane32_swap(__float_as_uint(v), __float_as_uint(v), false, false); return __uint_as_float(rr[0]) + __uint_as_float(rr[1]); }
}
template <class Tv> __device__ __forceinline__ Tv xget32(Tv v, int hf) {
    auto rr = __builtin_amdgcn_permlane32_swap(__builtin_bit_cast(unsigned, v), __builtin_bit_cast(unsigned, v), false, false); return __builtin_bit_cast(Tv, hf ? rr[0] : rr[1]);
}

namespace pg8 {
#define PG8_LAS __attribute__((address_space(3)))
typedef unsigned short bf16_t;
typedef short bf16x8 __attribute__((ext_vector_type(8)));
typedef float f32x4 __attribute__((ext_vector_type(4)));
typedef unsigned u32x4 __attribute__((ext_vector_type(4)));
typedef unsigned u32x2 __attribute__((ext_vector_type(2)));
constexpr int BM = 256, BK = 64, HALF = 128, HTB = HALF * BK * 2, STAGE_BYTES = 8 * HTB, NXCD = 8, WGM = 8;

__host__ __device__ __forceinline__ int lds_byte(int r, int c) { const int st = (r >> 4) * 2 + (c >> 5), rr = r & 15, cc = c & 31, ob = rr * 64 + cc * 2; return st * 1024 + (ob ^ (((ob >> 9) & 1) << 5)); }
__host__ __device__ __forceinline__ void stage_rc(int b, int& R, int& C) { const int st = b / 1024, sb = b % 1024, swz = sb ^ (((sb >> 9) & 1) << 5); R = (st >> 1) * 16 + swz / 64; C = (st & 1) * 32 + (swz % 64) / 2; }
__host__ __device__ __forceinline__ int perm32(int rho) { const int n = rho >> 4, i = rho & 15; return 8 * (i >> 2) + 4 * n + (i & 3); }

struct Unit { int pm, pn; };
struct Gemm { const bf16_t* A; const bf16_t* Bt; int K; };

struct StaticOrder {
    int nM, nN, nwg, G, c;
    __device__ void init(int M, int N, int G_, int c_) { nM = M / BM; nN = N / BM; nwg = nM * nN; G = G_; c = c_; }
    __device__ bool next(int i, Unit& u) const {
        const long L = (long)i * G + c; if (L >= nwg) return false;
        int wgid = (int)L; { const int q = nwg / NXCD, r = nwg % NXCD, xcd = wgid % NXCD, off = wgid / NXCD; wgid = (xcd < r ? xcd * (q + 1) : r * (q + 1) + (xcd - r) * q) + off; }
        const int nig = WGM * nN, gid = wgid / nig, fm = gid * WGM, gsz = (nM - fm) < WGM ? (nM - fm) : WGM;
        u.pm = fm + ((wgid % nig) % gsz); u.pn = (wgid % nig) / gsz; return true;
    }
};
struct MoeOrder {
    const int* tile_e; int n_units, nN, G, vcu;
    __device__ bool next(int i, Unit& u) const {
        const long L = (long)i * G + vcu; if (L >= n_units) return false;
        const int mt = (int)L / nN, pl = (int)L % nN; const int e = __builtin_amdgcn_readfirstlane(__hip_atomic_load(tile_e + mt, __ATOMIC_RELAXED, __HIP_MEMORY_SCOPE_AGENT));
        u.pm = mt; u.pn = e * nN + pl; return true;
    }
};

__device__ __forceinline__ unsigned cvt_pk_bf16(float lo, float hi) { unsigned r; asm volatile("v_cvt_pk_bf16_f32 %0, %1, %2" : "=v"(r) : "v"(lo), "v"(hi)); return r; }
__device__ __forceinline__ float bf_lo(unsigned w) { return __uint_as_float(w << 16); }
__device__ __forceinline__ float bf_hi(unsigned w) { return __uint_as_float(w & 0xffff0000u); }
__device__ __forceinline__ float sigmoid_f(float x) { return __builtin_amdgcn_rcpf(1.0f + __builtin_amdgcn_exp2f(-LOG2E * x)); }

template <class Epi, class Sched>
__device__ __forceinline__ void gemm_phase(PG8_LAS unsigned char* lds, const Gemm g, const Sched& S, const Epi& E, const int wid_in) {
    int wid = wid_in; asm volatile("" : "+s"(wid));
    const int lane = lane_id_asm(), tid = wid * 64 + lane, wr = wid >> 2, wc = wid & 3, fr = lane & 15, fq = lane >> 4;
    int K_o = g.K; asm volatile("" : "+s"(K_o)); const int K = K_o, nt = K / BK;
    unsigned voff[2];
#pragma unroll
    for (int i = 0; i < 2; ++i) { int R, C; stage_rc(tid * 16 + i * 8192, R, C); voff[i] = (unsigned)(R * K + C) * 2u; }
    const size_t kstep = (size_t)(BK * 2);
    const size_t hstep = (size_t)HALF * K * 2;
    const size_t tstep = 2 * hstep;
    const unsigned ldsw = (unsigned)wid * 1024u;
    const int aoff = lds_byte(wr * 64 + fr, fq * 8), boff = lds_byte(wc * 32 + fr, fq * 8);
#define PG8_SA(b, h) (((b) * 2 + (h)) * HTB)
#define PG8_SB(b, h) ((4 + (b) * 2 + (h)) * HTB)
#define PG8_STAGE(bufoff, gbase) do { _Pragma("unroll") for (int _i = 0; _i < 2; ++_i) \
        __builtin_amdgcn_global_load_lds((const unsigned*)((const char*)(gbase) + voff[_i]), (PG8_LAS unsigned*)(lds + (bufoff) + ldsw + _i * 8192), 16, 0, 0); } while (0)
#define PG8_LDA(dst, b, h) do { _Pragma("unroll") for (int m = 0; m < 4; ++m) _Pragma("unroll") for (int k = 0; k < 2; ++k) dst[m][k] = *(const PG8_LAS bf16x8*)(lds + PG8_SA(b, h) + aoff + m * 2048 + k * 1024); } while (0)
#define PG8_LDB(dst, b, h) do { _Pragma("unroll") for (int n = 0; n < 2; ++n) _Pragma("unroll") for (int k = 0; k < 2; ++k) dst[n][k] = *(const PG8_LAS bf16x8*)(lds + PG8_SB(b, h) + boff + n * 2048 + k * 1024); } while (0)
#define PG8_MMA(ai, bj, At, Bt) do { __builtin_amdgcn_s_setprio(1); _Pragma("unroll") for (int m = 0; m < 4; ++m) _Pragma("unroll") for (int n = 0; n < 2; ++n) _Pragma("unroll") for (int k = 0; k < 2; ++k) \
        acc[ai][bj][m][n] = __builtin_amdgcn_mfma_f32_16x16x32_bf16(Bt[n][k], At[m][k], acc[ai][bj][m][n], 0, 0, 0); __builtin_amdgcn_s_setprio(0); } while (0)
#define PG8_WAIT_V(n) asm volatile("s_waitcnt vmcnt(" #n ")" ::: "memory")
#define PG8_WAIT_L(n) asm volatile("s_waitcnt lgkmcnt(" #n ")" ::: "memory")
#define PG8_BAR __builtin_amdgcn_s_barrier()
#define PG8_SCHED __builtin_amdgcn_sched_barrier(0)
    Unit cur, nxt; int ui = 0;
    if (!S.next(0, cur)) return;
    f32x4 acc[2][2][4][2];
#pragma unroll
    for (int a = 0; a < 2; ++a)
#pragma unroll
        for (int b = 0; b < 2; ++b)
#pragma unroll
            for (int m = 0; m < 4; ++m)
#pragma unroll
                for (int n = 0; n < 2; ++n) acc[a][b][m][n] = (f32x4){0.f, 0.f, 0.f, 0.f};
    bf16x8 At[4][2], B0[2][2], B1[2][2];
    const char* cA = (const char*)g.A + (size_t)cur.pm * tstep; const char* cB = (const char*)g.Bt + (size_t)cur.pn * tstep;
    PG8_STAGE(PG8_SB(0, 0), cB); PG8_STAGE(PG8_SB(0, 1), cB + hstep); PG8_STAGE(PG8_SA(0, 0), cA); PG8_STAGE(PG8_SA(0, 1), cA + hstep);
    if (wr == 1) PG8_BAR;
    PG8_WAIT_V(2); PG8_BAR;
    PG8_STAGE(PG8_SB(1, 0), cB + kstep); PG8_STAGE(PG8_SA(1, 0), cA + kstep); PG8_STAGE(PG8_SB(1, 1), cB + hstep + kstep);
    PG8_WAIT_V(6); PG8_BAR;
    for (;;) {
        const bool has_next = S.next(ui + 1, nxt);
        const char* nA = has_next ? (const char*)g.A + (size_t)nxt.pm * tstep : cA; const char* nB = has_next ? (const char*)g.Bt + (size_t)nxt.pn * tstep : cB;
        for (int t = 0; t < nt; t += 2) {
            const bool last = (t == nt - 2);
            const char* a1 = cA + (size_t)(t + 1) * kstep;
            const char* a2 = last ? nA : cA + (size_t)(t + 2) * kstep; const char* b2 = last ? nB : cB + (size_t)(t + 2) * kstep;
            const char* a3 = a2 + kstep; const char* b3 = b2 + kstep;
            PG8_LDB(B0, 0, 0); PG8_LDB(B1, 0, 1); PG8_SCHED; PG8_LDA(At, 0, 0); PG8_STAGE(PG8_SA(1, 1), a1 + hstep);
            PG8_WAIT_V(8); PG8_WAIT_L(0); PG8_BAR; PG8_MMA(0, 0, At, B0); PG8_MMA(0, 1, At, B1); PG8_BAR; PG8_SCHED;
            PG8_LDA(At, 0, 1); PG8_STAGE(PG8_SB(0, 0), b2); PG8_STAGE(PG8_SB(0, 1), b2 + hstep); PG8_STAGE(PG8_SA(0, 0), a2);
            PG8_WAIT_V(8); PG8_WAIT_L(0); PG8_BAR; PG8_MMA(1, 0, At, B0); PG8_MMA(1, 1, At, B1); PG8_BAR; PG8_SCHED;
            PG8_LDB(B0, 1, 0); PG8_LDB(B1, 1, 1); PG8_SCHED; PG8_LDA(At, 1, 0); PG8_STAGE(PG8_SA(0, 1), a2 + hstep);
            PG8_WAIT_V(8); PG8_WAIT_L(0); PG8_BAR; PG8_MMA(0, 0, At, B0); PG8_MMA(0, 1, At, B1); PG8_BAR; PG8_SCHED;
            PG8_LDA(At, 1, 1); PG8_STAGE(PG8_SB(1, 0), b3); PG8_STAGE(PG8_SB(1, 1), b3 + hstep); PG8_STAGE(PG8_SA(1, 0), a3);
            PG8_WAIT_V(8); PG8_WAIT_L(0); PG8_BAR; PG8_MMA(1, 0, At, B0); PG8_MMA(1, 1, At, B1); PG8_BAR; PG8_SCHED;
        }
        if (wr == 0) PG8_BAR;
        E(acc, cur, wr, wc, fr, fq);
        if (!has_next) break;
#pragma unroll
        for (int a = 0; a < 2; ++a)
#pragma unroll
            for (int b = 0; b < 2; ++b)
#pragma unroll
                for (int m = 0; m < 4; ++m)
#pragma unroll
                    for (int n = 0; n < 2; ++n) acc[a][b][m][n] = (f32x4){0.f, 0.f, 0.f, 0.f};
        cur = nxt; cA = nA; cB = nB; ++ui;
        if (wr == 1) PG8_BAR;
    }
    PG8_WAIT_V(0);
    PG8_BAR;
#undef PG8_SA
#undef PG8_SB
#undef PG8_STAGE
#undef PG8_LDA
#undef PG8_LDB
#undef PG8_MMA
#undef PG8_WAIT_V
#undef PG8_WAIT_L
#undef PG8_BAR
#undef PG8_SCHED
}

typedef int i32x4_t __attribute__((ext_vector_type(4)));
template <class Epi, class Sched>
__device__ __forceinline__ void gemm_phase_f8(PG8_LAS unsigned char* lds, const Gemm g, const Sched& S, const Epi& E, const int wid_in) {
    int wid = wid_in; asm volatile("" : "+s"(wid));
    const int lane = lane_id_asm(), tid = wid * 64 + lane, wr = wid >> 2, wc = wid & 3, fr = lane & 15, fq = lane >> 4;
    int K_o = g.K; asm volatile("" : "+s"(K_o)); const int K = K_o, nt = K / BK;
    unsigned voff[2];
#pragma unroll
    for (int i = 0; i < 2; ++i) { int R, C; stage_rc(tid * 16 + i * 8192, R, C); voff[i] = (unsigned)(R * K + C) * 2u; }
    const size_t kstep = (size_t)(BK * 2);
    const size_t hstep = (size_t)HALF * K * 2;
    const size_t tstep = 2 * hstep;
    const unsigned ldsw = (unsigned)wid * 1024u;
    const int aoff = lds_byte(wr * 64 + fr, fq * 16), boff = lds_byte(wc * 32 + fr, fq * 16);
#define PG8_SA(b, h) (((b) * 2 + (h)) * HTB)
#define PG8_SB(b, h) ((4 + (b) * 2 + (h)) * HTB)
#define PG8_STAGE(bufoff, gbase) do { _Pragma("unroll") for (int _i = 0; _i < 2; ++_i) \
        __builtin_amdgcn_global_load_lds((const unsigned*)((const char*)(gbase) + voff[_i]), (PG8_LAS unsigned*)(lds + (bufoff) + ldsw + _i * 8192), 16, 0, 0); } while (0)
#define PG8_LDA(dst, b, h) do { _Pragma("unroll") for (int m = 0; m < 4; ++m) _Pragma("unroll") for (int k = 0; k < 2; ++k) dst[m][k] = *(const PG8_LAS bf16x8*)(lds + PG8_SA(b, h) + aoff + m * 2048 + k * 16); } while (0)
#define PG8_LDB(dst, b, h) do { _Pragma("unroll") for (int n = 0; n < 2; ++n) _Pragma("unroll") for (int k = 0; k < 2; ++k) dst[n][k] = *(const PG8_LAS bf16x8*)(lds + PG8_SB(b, h) + boff + n * 2048 + k * 16); } while (0)
#define PG8_F8(x) __builtin_shufflevector(__builtin_bit_cast(i32x4_t, (x)[0]), __builtin_bit_cast(i32x4_t, (x)[1]), 0, 1, 2, 3, 4, 5, 6, 7)
#define PG8_MMA(ai, bj, At, Bt) do { __builtin_amdgcn_s_setprio(1); asm volatile("s_nop 1" ::: ); _Pragma("unroll") for (int m = 0; m < 4; ++m) _Pragma("unroll") for (int n = 0; n < 2; ++n) \
        asm volatile("v_mfma_f32_16x16x128_f8f6f4 %0, %1, %2, %0" : "+v"(acc[ai][bj][m][n]) : "v"(PG8_F8(Bt[n])), "v"(PG8_F8(At[m]))); __builtin_amdgcn_s_setprio(0); } while (0)
#define PG8_ACC_SETTLE asm volatile("s_nop 15\n\ts_nop 15" ::: "memory")
#define PG8_WAIT_V(n) asm volatile("s_waitcnt vmcnt(" #n ")" ::: "memory")
#define PG8_WAIT_L(n) asm volatile("s_waitcnt lgkmcnt(" #n ")" ::: "memory")
#define PG8_BAR __builtin_amdgcn_s_barrier()
#define PG8_SCHED __builtin_amdgcn_sched_barrier(0)
    Unit cur, nxt; int ui = 0;
    if (!S.next(0, cur)) return;
    f32x4 acc[2][2][4][2];
#pragma unroll
    for (int a = 0; a < 2; ++a)
#pragma unroll
        for (int b = 0; b < 2; ++b)
#pragma unroll
            for (int m = 0; m < 4; ++m)
#pragma unroll
                for (int n = 0; n < 2; ++n) acc[a][b][m][n] = (f32x4){0.f, 0.f, 0.f, 0.f};
    bf16x8 At[4][2], B0[2][2], B1[2][2];
    const char* cA = (const char*)g.A + (size_t)cur.pm * tstep; const char* cB = (const char*)g.Bt + (size_t)cur.pn * tstep;
    PG8_STAGE(PG8_SB(0, 0), cB); PG8_STAGE(PG8_SB(0, 1), cB + hstep); PG8_STAGE(PG8_SA(0, 0), cA); PG8_STAGE(PG8_SA(0, 1), cA + hstep);
    if (wr == 1) PG8_BAR;
    PG8_WAIT_V(2); PG8_BAR;
    PG8_STAGE(PG8_SB(1, 0), cB + kstep); PG8_STAGE(PG8_SA(1, 0), cA + kstep); PG8_STAGE(PG8_SB(1, 1), cB + hstep + kstep);
    PG8_WAIT_V(6); PG8_BAR;
    for (;;) {
        const bool has_next = S.next(ui + 1, nxt);
        const char* nA = has_next ? (const char*)g.A + (size_t)nxt.pm * tstep : cA; const char* nB = has_next ? (const char*)g.Bt + (size_t)nxt.pn * tstep : cB;
        for (int t = 0; t < nt; t += 2) {
            const bool last = (t == nt - 2);
            const char* a1 = cA + (size_t)(t + 1) * kstep;
            const char* a2 = last ? nA : cA + (size_t)(t + 2) * kstep; const char* b2 = last ? nB : cB + (size_t)(t + 2) * kstep;
            const char* a3 = a2 + kstep; const char* b3 = b2 + kstep;
            PG8_LDB(B0, 0, 0); PG8_LDB(B1, 0, 1); PG8_SCHED; PG8_LDA(At, 0, 0); PG8_STAGE(PG8_SA(1, 1), a1 + hstep);
            PG8_WAIT_V(8); PG8_WAIT_L(0); PG8_BAR; PG8_MMA(0, 0, At, B0); PG8_MMA(0, 1, At, B1); PG8_BAR; PG8_SCHED;
            PG8_LDA(At, 0, 1); PG8_STAGE(PG8_SB(0, 0), b2); PG8_STAGE(PG8_SB(0, 1), b2 + hstep); PG8_STAGE(PG8_SA(0, 0), a2);
            PG8_WAIT_V(8); PG8_WAIT_L(0); PG8_BAR; PG8_MMA(1, 0, At, B0); PG8_MMA(1, 1, At, B1); PG8_BAR; PG8_SCHED;
            PG8_LDB(B0, 1, 0); PG8_LDB(B1, 1, 1); PG8_SCHED; PG8_LDA(At, 1, 0); PG8_STAGE(PG8_SA(0, 1), a2 + hstep);
            PG8_WAIT_V(8); PG8_WAIT_L(0); PG8_BAR; PG8_MMA(0, 0, At, B0); PG8_MMA(0, 1, At, B1); PG8_BAR; PG8_SCHED;
            PG8_LDA(At, 1, 1); PG8_STAGE(PG8_SB(1, 0), b3); PG8_STAGE(PG8_SB(1, 1), b3 + hstep); PG8_STAGE(PG8_SA(1, 0), a3);
            PG8_WAIT_V(8); PG8_WAIT_L(0); PG8_BAR; PG8_MMA(1, 0, At, B0); PG8_MMA(1, 1, At, B1); PG8_BAR; PG8_SCHED;
        }
        if (wr == 0) PG8_BAR;
        PG8_ACC_SETTLE;
        E(acc, cur, wr, wc, fr, fq);
        if (!has_next) break;
#pragma unroll
        for (int a = 0; a < 2; ++a)
#pragma unroll
            for (int b = 0; b < 2; ++b)
#pragma unroll
                for (int m = 0; m < 4; ++m)
#pragma unroll
                    for (int n = 0; n < 2; ++n) acc[a][b][m][n] = (f32x4){0.f, 0.f, 0.f, 0.f};
        cur = nxt; cA = nA; cB = nB; ++ui;
        if (wr == 1) PG8_BAR;
    }
    PG8_WAIT_V(0);
    PG8_BAR;
#undef PG8_SA
#undef PG8_SB
#undef PG8_STAGE
#undef PG8_LDA
#undef PG8_LDB
#undef PG8_MMA
#undef PG8_F8
#undef PG8_ACC_SETTLE
#undef PG8_WAIT_V
#undef PG8_WAIT_L
#undef PG8_BAR
#undef PG8_SCHED
}

#define EPI_ROWS(...) _Pragma("unroll") for (int ai = 0; ai < 2; ++ai) _Pragma("unroll") for (int m = 0; m < 4; ++m) { const int row = u.pm * BM + ai * HALF + wr * 64 + m * 16 + fr; __VA_ARGS__ }
__device__ __forceinline__ u32x4 pack8(const f32x4 a, const f32x4 b) { u32x4 w; w.x = cvt_pk_bf16(a[0], a[1]); w.y = cvt_pk_bf16(a[2], a[3]); w.z = cvt_pk_bf16(b[0], b[1]); w.w = cvt_pk_bf16(b[2], b[3]); return w; }

__device__ __forceinline__ u32x2 pack8_f8(const f32x4 a, const f32x4 b) { unsigned w0 = 0, w1 = 0;
    w0 = __builtin_amdgcn_cvt_pk_fp8_f32(a[0], a[1], w0, false); w0 = __builtin_amdgcn_cvt_pk_fp8_f32(a[2], a[3], w0, true);
    w1 = __builtin_amdgcn_cvt_pk_fp8_f32(b[0], b[1], w1, false); w1 = __builtin_amdgcn_cvt_pk_fp8_f32(b[2], b[3], w1, true); u32x2 r; r.x = w0; r.y = w1; return r; }
constexpr float W8_SCALE = 64.0f, W8_INV = 1.0f / 64.0f;
struct EpiIn {
    bf16_t* aqkv; bf16_t* qb; bf16_t* kb; bf16_t* vb; bf16_t* gate; const float* qg; const float* kg; const float* rope; float asc; bool f8attn;
    __device__ __forceinline__ void operator()(const f32x4 (&acc)[2][2][4][2], const Unit& u, int wr, int wc, int fr, int fq) const {
        const int pn = u.pn;
        if (pn >= 9 && pn < 14) {
            const bool isq = pn < 13; const int head = isq ? (pn - 9) * 4 + wc : wc; bf16_t* dst = isq ? qb : kb; const int pitch = isq ? 1024 : 256;
            const float* gvec = isq ? qg : kg; const float osc = isq ? C2 : 1.0f;
            f32x4 gv[2][2];
#pragma unroll
            for (int bj = 0; bj < 2; ++bj)
#pragma unroll
                for (int n = 0; n < 2; ++n) gv[bj][n] = *(const f32x4*)(gvec + 32 * bj + 16 * n + 4 * fq);
            EPI_ROWS(
                float ss = 0.f;
                _Pragma("unroll") for (int bj = 0; bj < 2; ++bj) _Pragma("unroll") for (int n = 0; n < 2; ++n) { const f32x4 x = acc[ai][bj][m][n] * asc; ss += (x[0] * x[0] + x[1] * x[1]) + (x[2] * x[2] + x[3] * x[3]); }
                ss = xsum<16>(ss); ss = xsum<32>(ss);
                const float sc = rsqrtf(ss * (1.0f / 64.0f) + EPS) * osc * asc;
                const int t = row & (SEQ - 1);
                _Pragma("unroll") for (int bj = 0; bj < 2; ++bj) {
                    const int pos = bj == 0 ? (t >> 6) : (t & 63);
                    const f32x4 cs = *(const f32x4*)(rope + pos * 16 + 4 * fq); const f32x4 sn = *(const f32x4*)(rope + 1024 + pos * 16 + 4 * fq);
                    const f32x4 y0 = acc[ai][bj][m][0] * sc * gv[bj][0]; const f32x4 y1 = acc[ai][bj][m][1] * sc * gv[bj][1];
                    const f32x4 o0 = y0 * cs - y1 * sn; const f32x4 o1 = y1 * cs + y0 * sn;
                    if (f8attn) { unsigned char* p8 = (unsigned char*)dst + (size_t)row * pitch + head * 64 + 32 * bj + 4 * fq;
                        unsigned a = 0, b = 0; a = __builtin_amdgcn_cvt_pk_fp8_f32(o0[0], o0[1], a, false); a = __builtin_amdgcn_cvt_pk_fp8_f32(o0[2], o0[3], a, true);
                        b = __builtin_amdgcn_cvt_pk_fp8_f32(o1[0], o1[1], b, false); b = __builtin_amdgcn_cvt_pk_fp8_f32(o1[2], o1[3], b, true);
                        *(unsigned*)p8 = a; *(unsigned*)(p8 + 16) = b;
                    } else {
                    bf16_t* p = dst + (size_t)row * pitch + head * 64 + 32 * bj + 4 * fq;
                    u32x2 w0; w0.x = cvt_pk_bf16(o0[0], o0[1]); w0.y = cvt_pk_bf16(o0[2], o0[3]);
                    u32x2 w1; w1.x = cvt_pk_bf16(o1[0], o1[1]); w1.y = cvt_pk_bf16(o1[2], o1[3]);
                    *(u32x2*)p = w0; *(u32x2*)(p + 16) = w1; }
                }
            )
        } else if (pn == 14 && f8attn) {
            unsigned char* vt = (unsigned char*)vb;
            EPI_ROWS(
                const int b = row >> 12; const int t = row & (SEQ - 1); const int kk = t & 63;
                const int pos = 32 * ((kk >> 2) & 1) + (kk & 3) + 4 * ((kk >> 3) & 3) + 16 * (kk >> 5);
                _Pragma("unroll") for (int bj = 0; bj < 2; ++bj) {
                    const int kvh = bj * 2 + (wc >> 1); const int d0 = (wc & 1) * 32 + 8 * fq;
                    unsigned char* p = vt + ((size_t)((b * 4 + kvh) * 64 + d0) << 12) + (t & ~63) + pos;
                    const f32x4 v0 = acc[ai][bj][m][0] * asc; const f32x4 v1 = acc[ai][bj][m][1] * asc;
                    unsigned a = 0, c = 0; a = __builtin_amdgcn_cvt_pk_fp8_f32(v0[0], v0[1], a, false); a = __builtin_amdgcn_cvt_pk_fp8_f32(v0[2], v0[3], a, true);
                    c = __builtin_amdgcn_cvt_pk_fp8_f32(v1[0], v1[1], c, false); c = __builtin_amdgcn_cvt_pk_fp8_f32(v1[2], v1[3], c, true);
                    p[0 << 12] = (unsigned char)a; p[1 << 12] = (unsigned char)(a >> 8); p[2 << 12] = (unsigned char)(a >> 16); p[3 << 12] = (unsigned char)(a >> 24);
                    p[4 << 12] = (unsigned char)c; p[5 << 12] = (unsigned char)(c >> 8); p[6 << 12] = (unsigned char)(c >> 16); p[7 << 12] = (unsigned char)(c >> 24);
                }
            )
        } else {
            bf16_t* dst; int pitch, colt, dsh = 0; float sc = asc; bool sig = false, fold = false;
            if (pn < 9) { dst = aqkv + (size_t)pn * T * 256; pitch = 256; colt = 0; fold = true; dsh = 2 * (pn / 3); if (pn % 3 == 0) sc = C2 * asc; }
            else if (pn == 14) { dst = vb; pitch = 256; colt = 0; }
            else { dst = gate; pitch = 2048; colt = (pn - 15) * 256; sig = true; }
            const int col0 = colt + wc * 32 + 8 * fq;
            EPI_ROWS(
                int drow = row;
                if (fold) { const int t = row & (SEQ - 1); drow = (row & ~(SEQ - 1)) | ((t & ((1 << dsh) - 1)) << (12 - dsh)) | (t >> dsh); }
                bf16_t* rowp = dst + (size_t)drow * pitch + col0;
                _Pragma("unroll") for (int bj = 0; bj < 2; ++bj) {
                    f32x4 v0 = acc[ai][bj][m][0], v1 = acc[ai][bj][m][1];
                    if (sig) { _Pragma("unroll") for (int j = 0; j < 4; ++j) { v0[j] = sigmoid_f(v0[j] * asc); v1[j] = sigmoid_f(v1[j] * asc); } }
                    else { v0 = v0 * sc; v1 = v1 * sc; }
                    *(u32x4*)(rowp + bj * HALF) = pack8(v0, v1);
                }
            )
        }
    }
};
struct EpiMergeA {
    const bf16_t* gate; bf16_t* merged;
    __device__ __forceinline__ void operator()(const f32x4 (&acc)[2][2][4][2], const Unit& u, int wr, int wc, int fr, int fq) const {
        const int col0 = u.pn * BM + wc * 32 + 8 * fq;
        EPI_ROWS(
            _Pragma("unroll") for (int bj = 0; bj < 2; ++bj) {
                const u32x4 gw = *(const u32x4*)(gate + (size_t)row * 2048 + col0 + bj * HALF);
                f32x4 v0 = acc[ai][bj][m][0], v1 = acc[ai][bj][m][1];
                v0 = v0 * W8_INV; v1 = v1 * W8_INV;
                v0[0] *= bf_lo(gw.x); v0[1] *= bf_hi(gw.x); v0[2] *= bf_lo(gw.y); v0[3] *= bf_hi(gw.y);
                v1[0] *= bf_lo(gw.z); v1[1] *= bf_hi(gw.z); v1[2] *= bf_lo(gw.w); v1[3] *= bf_hi(gw.w);
                *(u32x4*)(merged + (size_t)row * 1024 + col0 + bj * HALF) = pack8(v0, v1);
            }
        )
    }
};
template <bool F8> struct EpiMergeB {
    const bf16_t* gate; const bf16_t* merged; unsigned char* m8;
    __device__ __forceinline__ void operator()(const f32x4 (&acc)[2][2][4][2], const Unit& u, int wr, int wc, int fr, int fq) const {
        const int col0 = u.pn * BM + wc * 32 + 8 * fq;
        EPI_ROWS(
            _Pragma("unroll") for (int bj = 0; bj < 2; ++bj) {
                const u32x4 gw = *(const u32x4*)(gate + (size_t)row * 2048 + 1024 + col0 + bj * HALF);
                const bf16_t* mp = merged + (size_t)row * 1024 + col0 + bj * HALF;
                const u32x4 mw = *(const u32x4*)mp;
                f32x4 v0 = acc[ai][bj][m][0] * (F8 ? W8_INV : 1.0f), v1 = acc[ai][bj][m][1] * (F8 ? W8_INV : 1.0f);
                v0[0] = v0[0] * bf_lo(gw.x) + bf_lo(mw.x); v0[1] = v0[1] * bf_hi(gw.x) + bf_hi(mw.x); v0[2] = v0[2] * bf_lo(gw.y) + bf_lo(mw.y); v0[3] = v0[3] * bf_hi(gw.y) + bf_hi(mw.y);
                v1[0] = v1[0] * bf_lo(gw.z) + bf_lo(mw.z); v1[1] = v1[1] * bf_hi(gw.z) + bf_hi(mw.z); v1[2] = v1[2] * bf_lo(gw.w) + bf_lo(mw.w); v1[3] = v1[3] * bf_hi(gw.w) + bf_hi(mw.w);
                *(u32x2*)(m8 + (size_t)row * 1024 + col0 + bj * HALF) = pack8_f8(v0, v1);
            }
        )
    }
};
struct EpiOut {
    const float* xin; float* xout; const float* g1;
    __device__ __forceinline__ void operator()(const f32x4 (&acc)[2][2][4][2], const Unit& u, int wr, int wc, int fr, int fq) const {
        const int col0 = u.pn * BM + wc * 32 + 8 * fq; const int b = (u.pm * BM) >> 12;
        f32x4 gv[2][2];
#pragma unroll
        for (int bj = 0; bj < 2; ++bj)
#pragma unroll
            for (int n = 0; n < 2; ++n) gv[bj][n] = *(const f32x4*)(g1 + (size_t)b * 6144 + col0 + bj * HALF + 4 * n);
        EPI_ROWS(
            _Pragma("unroll") for (int bj = 0; bj < 2; ++bj) {
                const size_t off = (size_t)row * 1024 + col0 + bj * HALF;
                const f32x4 x0 = *(const f32x4*)(xin + off), x1 = *(const f32x4*)(xin + off + 4);
                *(f32x4*)(xout + off) = x0 + gv[bj][0] * (acc[ai][bj][m][0] * W8_INV); *(f32x4*)(xout + off + 4) = x1 + gv[bj][1] * (acc[ai][bj][m][1] * W8_INV);
            }
        )
    }
};
struct EpiGU {
    const float* bgu; bf16_t* act;
    __device__ __forceinline__ void operator()(const f32x4 (&acc)[2][2][4][2], const Unit& u, int wr, int wc, int fr, int fq) const {
        const int e = u.pn >> 3, pl = u.pn & 7; const int c0 = pl * 128 + wc * 32 + 8 * fq;
        const float* bp = bgu + (size_t)e * 2048 + c0;
        const f32x4 bg0 = *(const f32x4*)bp, bg1 = *(const f32x4*)(bp + 4), bl0 = *(const f32x4*)(bp + 1024), bl1 = *(const f32x4*)(bp + 1028);
        EPI_ROWS(
            f32x4 o[2];
            _Pragma("unroll") for (int n = 0; n < 2; ++n) {
                const f32x4 gl = acc[ai][0][m][n] + (n == 0 ? bg0 : bg1); const f32x4 ln = acc[ai][1][m][n] + (n == 0 ? bl0 : bl1);
                _Pragma("unroll") for (int j = 0; j < 4; ++j) { const float xg = fminf(gl[j], 7.0f); const float xl = fminf(fmaxf(ln[j], -7.0f), 7.0f); o[n][j] = xg * sigmoid_f(1.702f * xg) * (xl + 1.0f); }
            }
            *(u32x4*)(act + (size_t)row * 1024 + c0) = pack8(o[0], o[1]);
        )
    }
};
struct EpiGU8 {
    const float* bgu; unsigned char* act;
    __device__ __forceinline__ void operator()(const f32x4 (&acc)[2][2][4][2], const Unit& u, int wr, int wc, int fr, int fq) const {
        const int e = u.pn >> 3, pl = u.pn & 7; const int c0 = pl * 128 + wc * 32 + 8 * fq;
        const float* bp = bgu + (size_t)e * 2048 + c0;
        const f32x4 bg0 = *(const f32x4*)bp, bg1 = *(const f32x4*)(bp + 4), bl0 = *(const f32x4*)(bp + 1024), bl1 = *(const f32x4*)(bp + 1028);
        EPI_ROWS(
            f32x4 o[2];
            _Pragma("unroll") for (int n = 0; n < 2; ++n) {
                const f32x4 gl = acc[ai][0][m][n] * W8_INV + (n == 0 ? bg0 : bg1); const f32x4 ln = acc[ai][1][m][n] * W8_INV + (n == 0 ? bl0 : bl1);
                _Pragma("unroll") for (int j = 0; j < 4; ++j) { const float xg = fminf(gl[j], 7.0f); const float xl = fminf(fmaxf(ln[j], -7.0f), 7.0f); o[n][j] = xg * sigmoid_f(1.702f * xg) * (xl + 1.0f); }
            }
            *(u32x2*)(act + (size_t)row * 1024 + c0) = pack8_f8(o[0], o[1]);
        )
    }
};
struct EpiDN8 {
    const float* bdn; const float* roww; unsigned char* y;
    __device__ __forceinline__ void operator()(const f32x4 (&acc)[2][2][4][2], const Unit& u, int wr, int wc, int fr, int fq) const {
        const int e = u.pn >> 2, pl = u.pn & 3; const int col0 = pl * BM + wc * 32 + 8 * fq;
        f32x4 bv[2][2];
#pragma unroll
        for (int bj = 0; bj < 2; ++bj)
#pragma unroll
            for (int n = 0; n < 2; ++n) bv[bj][n] = *(const f32x4*)(bdn + (size_t)e * 1024 + col0 + bj * HALF + 4 * n);
        EPI_ROWS(
            const float w = roww[row];
            _Pragma("unroll") for (int bj = 0; bj < 2; ++bj)
                *(u32x2*)(y + (size_t)row * 1024 + col0 + bj * HALF) = pack8_f8((acc[ai][bj][m][0] * W8_INV + bv[bj][0]) * w, (acc[ai][bj][m][1] * W8_INV + bv[bj][1]) * w);
        )
    }
};
struct EpiDN {
    const float* bdn; const float* roww; bf16_t* y;
    __device__ __forceinline__ void operator()(const f32x4 (&acc)[2][2][4][2], const Unit& u, int wr, int wc, int fr, int fq) const {
        const int e = u.pn >> 2, pl = u.pn & 3; const int col0 = pl * BM + wc * 32 + 8 * fq;
        f32x4 bv[2][2];
#pragma unroll
        for (int bj = 0; bj < 2; ++bj)
#pragma unroll
            for (int n = 0; n < 2; ++n) bv[bj][n] = *(const f32x4*)(bdn + (size_t)e * 1024 + col0 + bj * HALF + 4 * n);
        EPI_ROWS(
            const float w = roww[row];
            _Pragma("unroll") for (int bj = 0; bj < 2; ++bj)
                *(u32x4*)(y + (size_t)row * 1024 + col0 + bj * HALF) = pack8((acc[ai][bj][m][0] + bv[bj][0]) * w, (acc[ai][bj][m][1] + bv[bj][1]) * w);
        )
    }
};
}

namespace attn_body {
using bf16 = __hip_bfloat16;
using bf16x8 = __attribute__((ext_vector_type(8))) short;
using s16x4 = __attribute__((ext_vector_type(4))) short;
using f32x16 = __attribute__((ext_vector_type(16))) float;
using u32x4 = __attribute__((ext_vector_type(4))) unsigned;
constexpr int D = 64, NW = 8, QBLK = 32, QB = QBLK * NW, KVBLK = 64;
__device__ __forceinline__ int crow(int r, int hi) { return (r & 3) + 8 * (r >> 2) + 4 * hi; }
#define SBAR() __builtin_amdgcn_sched_barrier(0)
constexpr int NSLOT = 3, SLOTB = 8192;
constexpr int LDS_K = 0, LDS_V = NSLOT * SLOTB, LDS_WS = 2 * NSLOT * SLOTB, LDS_OST = LDS_WS + NW * 64 * 4, LDS_LUT = LDS_OST + NW * 4096, LUT_N = 768, LDS_BYTES = LDS_LUT + LUT_N * 4;
constexpr bool OB_F8 = true;
constexpr float MFLOOR = -1024.0f;
__device__ __forceinline__ void glds16(const void* gsrc, unsigned lds_dst) { unsigned keep;
  asm volatile("s_mov_b32 %0, m0\n\ts_mov_b32 m0, %2\n\ts_nop 0\n\tglobal_load_lds_dwordx4 %1, off\n\ts_mov_b32 m0, %0" : "=&s"(keep) : "v"(gsrc), "s"(lds_dst) : "memory"); }
__device__ __forceinline__ float max3f(float a, float b, float c) { float r; asm("v_max3_f32 %0, %1, %2, %3" : "=v"(r) : "v"(a), "v"(b), "v"(c)); return r; }
__device__ __forceinline__ float max2f(float a, float b) { float r; asm("v_max_f32_e32 %0, %1, %2" : "=v"(r) : "v"(a), "v"(b)); return r; }
__device__ __forceinline__ float fadd_s(float a, float b) { float r; asm("v_add_f32_e32 %0, %1, %2" : "=v"(r) : "v"(a), "v"(b)); return r; }
__device__ __forceinline__ float fsub_s(float a, float b) { float r; asm("v_sub_f32_e32 %0, %1, %2" : "=v"(r) : "v"(a), "v"(b)); return r; }
typedef float f32x2_t __attribute__((ext_vector_type(2))); typedef __bf16 bf16x2_t __attribute__((ext_vector_type(2)));
__device__ __forceinline__ unsigned cvtpk_s(float lo, float hi) { f32x2_t v = {lo, hi}; bf16x2_t b = __builtin_convertvector(v, bf16x2_t); return __builtin_bit_cast(unsigned, b); }
#define WAIT_BAR(N) asm volatile("s_waitcnt vmcnt(" #N ") lgkmcnt(0)\n\ts_barrier" ::: "memory")

__device__ __forceinline__ void qkt(f32x16& p0, f32x16& p1, const char* Kslot, const bf16x8* qr, const f32x16& negm, int r32, int hi) {
  const char* kb = Kslot + hi * 1024 + r32 * 16;
  #pragma unroll
  for (int d0 = 0; d0 < 4; ++d0) {
    const bf16x8 b0 = *reinterpret_cast<const bf16x8*>(kb + d0 * 2048);
    const bf16x8 b1 = *reinterpret_cast<const bf16x8*>(kb + d0 * 2048 + 512);
    if (d0 == 0) { p0 = __builtin_amdgcn_mfma_f32_32x32x16_bf16(b0, qr[0], negm, 0, 0, 0); p1 = __builtin_amdgcn_mfma_f32_32x32x16_bf16(b1, qr[0], negm, 0, 0, 0); }
    else { p0 = __builtin_amdgcn_mfma_f32_32x32x16_bf16(b0, qr[d0], p0, 0, 0, 0); p1 = __builtin_amdgcn_mfma_f32_32x32x16_bf16(b1, qr[d0], p1, 0, 0, 0); } }
}
typedef __attribute__((address_space(3))) const char* lds_cptr;
typedef short v4i16_t __attribute__((ext_vector_type(4)));
__device__ __forceinline__ void kload8(bf16x8* kf, lds_cptr kp) {
  kf[0] = *(const __attribute__((address_space(3))) bf16x8*)(kp);        kf[1] = *(const __attribute__((address_space(3))) bf16x8*)(kp + 512);
  kf[2] = *(const __attribute__((address_space(3))) bf16x8*)(kp + 2048); kf[3] = *(const __attribute__((address_space(3))) bf16x8*)(kp + 2560);
  kf[4] = *(const __attribute__((address_space(3))) bf16x8*)(kp + 4096); kf[5] = *(const __attribute__((address_space(3))) bf16x8*)(kp + 4608);
  kf[6] = *(const __attribute__((address_space(3))) bf16x8*)(kp + 6144); kf[7] = *(const __attribute__((address_space(3))) bf16x8*)(kp + 6656);
}
__device__ __forceinline__ void kload2(bf16x8* kf, lds_cptr kp, int j) { kf[2 * j] = *(const __attribute__((address_space(3))) bf16x8*)(kp + j * 2048); kf[2 * j + 1] = *(const __attribute__((address_space(3))) bf16x8*)(kp + j * 2048 + 512); }
__device__ __forceinline__ s16x4 vtr(lds_cptr p) { return __builtin_bit_cast(s16x4, __builtin_amdgcn_ds_read_tr16_b64_v4i16((__attribute__((address_space(3))) v4i16_t*)p)); }
__device__ __forceinline__ float rowmax(const f32x16& p0, const f32x16& p1) {
  float a = max3f(p0[0], p0[1], p1[0]), b = max3f(p0[2], p0[3], p1[1]); a = max3f(a, p1[2], p1[3]);
  #pragma unroll
  for (int r = 4; r < 16; r += 4) { a = max3f(a, p0[r], p0[r + 1]); b = max3f(b, p0[r + 2], p0[r + 3]); a = max3f(a, p1[r], p1[r + 1]); b = max3f(b, p1[r + 2], p1[r + 3]); }
  const float m = max2f(a, b);
  auto rr = __builtin_amdgcn_permlane32_swap(__float_as_uint(m), __float_as_uint(m), false, false);
  return max2f(__uint_as_float(rr[0]), __uint_as_float(rr[1]));
}
__device__ __forceinline__ void pv(f32x16* o, int vb, bf16x8 pa0, bf16x8 pa1, bf16x8 pa2, bf16x8 pa3) {
  #pragma unroll
  for (int d0 = 0; d0 < 2; ++d0) { s16x4 lo[4], hi[4];
    #pragma unroll
    for (int ks = 0; ks < 4; ++ks) {
      asm volatile("ds_read_b64_tr_b16 %0,%1 offset:%c2" : "=&v"(lo[ks]) : "v"(vb), "i"(d0 * 4096 + ks * 1024) : "memory");
      asm volatile("ds_read_b64_tr_b16 %0,%1 offset:%c2" : "=&v"(hi[ks]) : "v"(vb), "i"(d0 * 4096 + ks * 1024 + 512) : "memory"); }
    asm volatile("s_waitcnt lgkmcnt(0)" ::: "memory"); SBAR();
    #define PK(k) (bf16x8){lo[k][0], lo[k][1], lo[k][2], lo[k][3], hi[k][0], hi[k][1], hi[k][2], hi[k][3]}
    o[d0] = __builtin_amdgcn_mfma_f32_32x32x16_bf16(pa0, PK(0), o[d0], 0, 0, 0);
    o[d0] = __builtin_amdgcn_mfma_f32_32x32x16_bf16(pa1, PK(1), o[d0], 0, 0, 0);
    o[d0] = __builtin_amdgcn_mfma_f32_32x32x16_bf16(pa2, PK(2), o[d0], 0, 0, 0);
    o[d0] = __builtin_amdgcn_mfma_f32_32x32x16_bf16(pa3, PK(3), o[d0], 0, 0, 0);
    #undef PK
  }
}
struct Job { const bf16* Q; const bf16* K; const bf16* V; bf16* O; float* lse; const float* lutg; int NT, i0, kq0, dsh, cls; };
template <int MODE, int THRL, bool NOMAX = false> __device__ __forceinline__ void attn_unit(const Job& J, char* shm, const int wid_in) {
  int wid = wid_in; asm volatile("" : "+s"(wid));
  constexpr int QP = MODE == 0 ? 1024 : 256, KP = 256;
  const int lane = lane_id_asm(), tid = wid * 64 + lane, r32 = lane & 31, hi = lane >> 5;
  const bf16* Qw = J.Q + (long)(wid * QBLK) * QP;
  const bf16* Kh = J.K; const bf16* Vh = J.V;
  const unsigned lds0 = (unsigned)(uintptr_t)shm;
  float* wsf = (float*)(shm + LDS_WS) + wid * 64;
  const bf16* ksrc = Kh + (long)lane * KP + wid * 8;
  const bf16* vsrc = Vh + (long)(16 * (wid & 3) + (lane >> 2)) * KP + (wid >> 2) * 32 + (lane & 3) * 8;
  const unsigned kdst = lds0 + LDS_K + wid * 1024, vdst = lds0 + LDS_V + wid * 1024;
  #define DMA_K(t, slot) glds16(ksrc + (long)(t) * KVBLK * KP, (unsigned)__builtin_amdgcn_readfirstlane(kdst + (slot)))
  #define DMA_V(t, slot) glds16(vsrc + (long)(t) * KVBLK * KP, (unsigned)__builtin_amdgcn_readfirstlane(vdst + (slot)))
  const int vb0 = (int)(lds0 + LDS_V) + ((lane >> 4) & 1) * 32 + (lane & 3) * 8 + (4 * hi + ((lane & 15) >> 2)) * 64;
  const char* Kbase = shm + LDS_K; bf16x8 kf[8];
  const lds_cptr shm3 = (lds_cptr)shm; const lds_cptr kp0 = shm3 + LDS_K + hi * 1024 + r32 * 16; const lds_cptr vp0 = shm3 + LDS_V + ((lane >> 4) & 1) * 32 + (lane & 3) * 8 + (4 * hi + ((lane & 15) >> 2)) * 64;
  const int NT = J.NT;
  if (MODE == 1) {
    __attribute__((address_space(3))) float* lut = (__attribute__((address_space(3))) float*)(shm3 + LDS_LUT);
    lut[tid] = J.lutg[tid]; if (tid < LUT_N - 512) lut[512 + tid] = J.lutg[512 + tid];
  }
  DMA_K(0, 0); DMA_V(0, 0); DMA_K(1, SLOTB);
  bf16x8 qr[4];
  #pragma unroll
  for (int d0 = 0; d0 < 4; ++d0) qr[d0] = *reinterpret_cast<const bf16x8*>(&Qw[(long)r32 * QP + d0 * 16 + hi * 8]);
  float mhat = 0.f, l_reg = 0.f; f32x16 o[2]; o[0] = f32x16{}; o[1] = f32x16{}; f32x16 negm = f32x16{}; if (!NOMAX) asm volatile("" : "+v"(negm));
  const int qrel = wid * QBLK + r32;
  const __attribute__((address_space(3))) float* lutq = (const __attribute__((address_space(3))) float*)(shm3 + LDS_LUT) + (J.kq0 - qrel + 383 + 4 * hi);
  #define CMASK(P0, P1, t) do { if (MODE == 1) { const __attribute__((address_space(3))) float* lp_ = lutq + 64 * (t); \
      _Pragma("unroll") for (int r = 0; r < 16; ++r) { const int ko_ = (r & 3) + 8 * (r >> 2); P0[r] += lp_[ko_]; P1[r] += lp_[ko_ + 32]; } } } while (0)
  bool resc = false;
  #define START(P0, P1) do { resc = false; if (!NOMAX) { const float rm = rowmax(P0, P1); \
    const float dl = MODE == 1 ? max2f(rm, MFLOOR) : rm; mhat = fadd_s(mhat, dl); \
      _Pragma("unroll") for (int r = 0; r < 16; ++r) { P0[r] = fsub_s(P0[r], dl); P1[r] = fsub_s(P1[r], dl); } \
      _Pragma("unroll") for (int r = 0; r < 16; ++r) negm[r] = -mhat; asm volatile("" : "+v"(negm)); } \
    _Pragma("unroll") for (int r = 0; r < 16; ++r) P0[r] = __builtin_amdgcn_exp2f(P0[r]); } while (0)
  #define RESC() do { if (resc) { asm volatile("s_waitcnt lgkmcnt(0)" ::: "memory"); \
      _Pragma("unroll") for (int d_ = 0; d_ < 2; ++d_) _Pragma("unroll") for (int r = 0; r < 16; ++r) o[d_][r] *= wsf[crow(r, hi)]; } } while (0)
  f32x16 pA0, pA1, pB0, pB1;
  int sl_prev = 0, sl_cur = 0, sl_next = SLOTB;
  #define ROT() do { sl_prev = sl_cur; sl_cur = sl_next; sl_next = (sl_next == (NSLOT - 1) * SLOTB) ? 0 : sl_next + SLOTB; } while (0)
  DMA_K(2, 2 * SLOTB);
  WAIT_BAR(3);
  qkt(pA0, pA1, Kbase, qr, negm, r32, hi); asm volatile("s_nop 15\n\ts_nop 7" : "+v"(pA0), "+v"(pA1)); CMASK(pA0, pA1, 0);
  START(pA0, pA1);
  _Pragma("unroll") for (int r = 0; r < 16; ++r) pA1[r] = __builtin_amdgcn_exp2f(pA1[r]);
  WAIT_BAR(0);
  DMA_K(3, 0); DMA_V(1, SLOTB);
  ROT();
  kload8(kf, kp0 + sl_cur);
  WAIT_BAR(2);
  s16x4 vlo[8], vhi[8]; u32x4 pw0, pw1, pw2, pw3;
  #define PKW(P, B) cvtpk_s(P[B], P[B + 1])
  #define PAF(k) __builtin_bit_cast(bf16x8, pw##k)
  #define VFR(i) (bf16x8){vlo[i][0], vlo[i][1], vlo[i][2], vlo[i][3], vhi[i][0], vhi[i][1], vhi[i][2], vhi[i][3]}
  #define PIN(x) asm volatile("" : "+v"(x))
  #define MX3(a, b, c) __builtin_fmaxf(__builtin_fmaxf((a), (b)), (c))
  #define GAPA(MF, A0, A1, A2, A3, W0, W1, PW) do { MF; sacc += A0; sacc += A1; sacc += A2; sacc += A3; PIN(sacc); W0; W1; PIN(PW); SBAR(); } while (0)
  #define EX(v) __builtin_amdgcn_exp2f(v)
  #define GAPB(MF, X, B) do { MF; X[B] = EX(X[B]); X[B + 1] = EX(X[B + 1]); X[B + 2] = EX(X[B + 2]); X[B + 3] = EX(X[B + 3]); PIN(X); SBAR(); } while (0)
  #define VRD(i) do { vlo[i] = vtr(vp_ + (((i) >> 2) * 4096 + ((i) & 3) * 1024)); vhi[i] = vtr(vp_ + (((i) >> 2) * 4096 + ((i) & 3) * 1024 + 512)); } while (0)
  #define KRD(G, j) do { if (G) { kload2(kf, kp0 + sl_next, j); SBAR(); } } while (0)
  #define STEP(C0, C1, P0, P1, t, GK, GV, GL) do { SBAR(); \
    const lds_cptr vp_ = vp0 + sl_prev; \
    VRD(0); SBAR(); float sacc = (P0[0] + P0[1]); \
    GAPA(C0 = __builtin_amdgcn_mfma_f32_32x32x16_bf16(kf[0], qr[0], negm, 0, 0, 0), P0[2], P0[3], P0[4], P0[5],     pw0[0] = PKW(P0, 0), pw0[1] = PKW(P0, 2), pw0); \
    VRD(4); SBAR(); GAPA(C1 = __builtin_amdgcn_mfma_f32_32x32x16_bf16(kf[1], qr[0], negm, 0, 0, 0), P0[6], P0[7], P0[8], P0[9],     pw0[2] = PKW(P0, 4), pw0[3] = PKW(P0, 6), pw0); \
    VRD(1); SBAR(); GAPA(C0 = __builtin_amdgcn_mfma_f32_32x32x16_bf16(kf[2], qr[1], C0, 0, 0, 0),   P0[10], P0[11], P0[12], P0[13], pw1[0] = PKW(P0, 8), pw1[1] = PKW(P0, 10), pw1); \
    VRD(5); SBAR(); GAPA(C1 = __builtin_amdgcn_mfma_f32_32x32x16_bf16(kf[3], qr[1], C1, 0, 0, 0),   P0[14], P0[15], P1[0], P1[1],   pw1[2] = PKW(P0, 12), pw1[3] = PKW(P0, 14), pw1); \
    VRD(2); SBAR(); GAPA(C0 = __builtin_amdgcn_mfma_f32_32x32x16_bf16(kf[4], qr[2], C0, 0, 0, 0),   P1[2], P1[3], P1[4], P1[5],     pw2[0] = PKW(P1, 0), pw2[1] = PKW(P1, 2), pw2); \
    VRD(6); SBAR(); GAPA(C1 = __builtin_amdgcn_mfma_f32_32x32x16_bf16(kf[5], qr[2], C1, 0, 0, 0),   P1[6], P1[7], P1[8], P1[9],     pw2[2] = PKW(P1, 4), pw2[3] = PKW(P1, 6), pw2); \
    VRD(3); SBAR(); GAPA(C0 = __builtin_amdgcn_mfma_f32_32x32x16_bf16(kf[6], qr[3], C0, 0, 0, 0),   P1[10], P1[11], P1[12], P1[13], pw3[0] = PKW(P1, 8), pw3[1] = PKW(P1, 10), pw3); \
    VRD(7); SBAR(); GAPA(C1 = __builtin_amdgcn_mfma_f32_32x32x16_bf16(kf[7], qr[3], C1, 0, 0, 0),   P1[14], P1[15], 0.f, 0.f,       pw3[2] = PKW(P1, 12), pw3[3] = PKW(P1, 14), pw3); \
    l_reg += sacc; \
    if (GK) { DMA_K((t) + 3, sl_cur); } if (GV) { DMA_V((t) + 1, sl_next); } \
    CMASK(C0, C1, t); \
    if (!NOMAX) { float a = MX3(C0[0], C0[1], C1[0]), b = MX3(C0[2], C0[3], C1[1]); a = MX3(a, C1[2], C1[3]); \
      _Pragma("unroll") for (int r = 4; r < 16; r += 4) { a = MX3(a, C0[r], C0[r + 1]); b = MX3(b, C0[r + 2], C0[r + 3]); a = MX3(a, C1[r], C1[r + 1]); b = MX3(b, C1[r + 2], C1[r + 3]); } \
      float rm = __builtin_fmaxf(a, b); { auto rr = __builtin_amdgcn_permlane32_swap(__float_as_uint(rm), __float_as_uint(rm), false, false); rm = __builtin_fmaxf(__uint_as_float(rr[0]), __uint_as_float(rr[1])); } \
      resc = false; \
      if (__builtin_expect(__any(rm > (float)THRL), 0)) { const float dl = __builtin_fmaxf(rm, 0.f); mhat += dl; \
        _Pragma("unroll") for (int r = 0; r < 16; ++r) { C0[r] -= dl; C1[r] -= dl; } \
        _Pragma("unroll") for (int r = 0; r < 16; ++r) negm[r] = -mhat; asm volatile("" : "+v"(negm)); \
        const float f = __builtin_amdgcn_exp2f(-dl); l_reg *= f; if (hi == 0) wsf[r32] = f; resc = true; } } \
    SBAR(); \
    GAPB(o[0] = __builtin_amdgcn_mfma_f32_32x32x16_bf16(PAF(0), VFR(0), o[0], 0, 0, 0), C0, 0); \
    GAPB(o[1] = __builtin_amdgcn_mfma_f32_32x32x16_bf16(PAF(0), VFR(4), o[1], 0, 0, 0), C0, 4); \
    KRD(GL, 0); GAPB(o[0] = __builtin_amdgcn_mfma_f32_32x32x16_bf16(PAF(1), VFR(1), o[0], 0, 0, 0), C0, 8); \
    KRD(GL, 1); GAPB(o[1] = __builtin_amdgcn_mfma_f32_32x32x16_bf16(PAF(1), VFR(5), o[1], 0, 0, 0), C0, 12); \
    KRD(GL, 2); GAPB(o[0] = __builtin_amdgcn_mfma_f32_32x32x16_bf16(PAF(2), VFR(2), o[0], 0, 0, 0), C1, 0); \
    KRD(GL, 3); GAPB(o[1] = __builtin_amdgcn_mfma_f32_32x32x16_bf16(PAF(2), VFR(6), o[1], 0, 0, 0), C1, 4); \
    GAPB(o[0] = __builtin_amdgcn_mfma_f32_32x32x16_bf16(PAF(3), VFR(3), o[0], 0, 0, 0), C1, 8); \
    GAPB(o[1] = __builtin_amdgcn_mfma_f32_32x32x16_bf16(PAF(3), VFR(7), o[1], 0, 0, 0), C1, 12); \
    } while (0)
  int t = 1;
  for (; t + 5 < NT; t += 2) {
    STEP(pB0, pB1, pA0, pA1, t, true, true, true);     WAIT_BAR(2); RESC(); ROT();
    STEP(pA0, pA1, pB0, pB1, t + 1, true, true, true); WAIT_BAR(2); RESC(); ROT();
  }
  #define ENDW(tt) do { if ((tt) + 3 < NT) { WAIT_BAR(2); } else if ((tt) + 2 < NT) { WAIT_BAR(1); } else { WAIT_BAR(0); } } while (0)
  for (; t + 1 < NT; t += 2) {
    STEP(pB0, pB1, pA0, pA1, t, (t + 3 < NT), (t + 1 < NT), (t + 1 < NT));       ENDW(t);     RESC(); ROT();
    STEP(pA0, pA1, pB0, pB1, t + 1, (t + 4 < NT), (t + 2 < NT), (t + 2 < NT));   ENDW(t + 1); RESC(); ROT();
  }
  STEP(pB0, pB1, pA0, pA1, NT - 1, false, false, false); RESC();
  { float sacc = pB0[0] + pB0[1]; _Pragma("unroll") for (int r = 2; r < 16; ++r) sacc += pB0[r]; _Pragma("unroll") for (int r = 0; r < 16; ++r) sacc += pB1[r]; l_reg += sacc;
    pw0 = (u32x4){PKW(pB0, 0), PKW(pB0, 2), PKW(pB0, 4), PKW(pB0, 6)}; pw1 = (u32x4){PKW(pB0, 8), PKW(pB0, 10), PKW(pB0, 12), PKW(pB0, 14)}; pw2 = (u32x4){PKW(pB1, 0), PKW(pB1, 2), PKW(pB1, 4), PKW(pB1, 6)}; pw3 = (u32x4){PKW(pB1, 8), PKW(pB1, 10), PKW(pB1, 12), PKW(pB1, 14)};
    SBAR(); pv(o, vb0 + sl_cur, PAF(0), PAF(1), PAF(2), PAF(3)); }
  #undef PKW
  #undef PAF
  #undef VFR
  #undef PIN
  #undef MX3
  #undef GAPA
  #undef GAPB
  #undef EX
  #undef VRD
  #undef KRD
  #undef STEP
  #undef ENDW
  { auto rr = __builtin_amdgcn_permlane32_swap(__float_as_uint(l_reg), __float_as_uint(l_reg), false, false); l_reg = __uint_as_float(rr[0]) + __uint_as_float(rr[1]); }
  if (hi == 0) wsf[32 + r32] = l_reg; asm volatile("s_waitcnt lgkmcnt(0)" ::: "memory");
  float rli[16];
  #pragma unroll
  for (int r = 0; r < 16; ++r) rli[r] = __builtin_amdgcn_rcpf(wsf[32 + crow(r, hi)]);
  if (MODE == 0 && OB_F8) {
    unsigned char* stg8 = (unsigned char*)(shm + LDS_OST) + wid * 4096;
    #pragma unroll
    for (int r = 0; r < 16; ++r) { const int orow = crow(r, hi);
      #pragma unroll
      for (int d0 = 0; d0 < 2; ++d0) { const float ov = o[d0][r] * rli[r]; stg8[orow * 64 + d0 * 32 + r32] = (unsigned char)(__builtin_amdgcn_cvt_pk_fp8_f32(ov, ov, 0, false) & 0xff); } }
    asm volatile("s_waitcnt lgkmcnt(0)" ::: "memory");
    unsigned char* Ow = (unsigned char*)J.O + (long)(wid * QBLK) * 1024;
    #pragma unroll
    for (int i = 0; i < 2; ++i) { const int row = i * 16 + (lane >> 2), ch = lane & 3; const u32x4 v = *(const u32x4*)(stg8 + row * 64 + ch * 16); *(u32x4*)(Ow + (long)row * 1024 + ch * 16) = v; }
  } else {
    bf16* stg = (bf16*)(shm + LDS_OST) + wid * 2048;
    #pragma unroll
    for (int r = 0; r < 16; ++r) { const int orow = crow(r, hi);
      #pragma unroll
      for (int d0 = 0; d0 < 2; ++d0) stg[orow * 64 + d0 * 32 + r32] = __float2bfloat16(o[d0][r] * rli[r]); }
    asm volatile("s_waitcnt lgkmcnt(0)" ::: "memory");
    if (MODE == 0) {
      bf16* Ow = J.O + (long)(wid * QBLK) * 1024;
      #pragma unroll
      for (int i = 0; i < 4; ++i) { const int row = i * 8 + (lane >> 3), ch = lane & 7; const u32x4 v = *(const u32x4*)(stg + row * 64 + ch * 8); *(u32x4*)(Ow + (long)row * 1024 + ch * 8) = v; }
    } else {
      #pragma unroll
      for (int i = 0; i < 4; ++i) { const int row = i * 8 + (lane >> 3), ch = lane & 7; const u32x4 v = *(const u32x4*)(stg + row * 64 + ch * 8);
        const long tok = ((long)(J.i0 + wid * QBLK + row) << J.dsh) + J.cls; *(u32x4*)(J.O + tok * 256 + ch * 8) = v; }
      if (hi == 0) { const long tok = ((long)(J.i0 + qrel) << J.dsh) + J.cls; J.lse[tok * 4] = mhat + __builtin_amdgcn_logf(l_reg); }
    } }
  asm volatile("s_waitcnt lgkmcnt(0)\n\ts_barrier" ::: "memory");
  #undef DMA_K
  #undef DMA_V
  #undef CMASK
  #undef START
  #undef RESC
  #undef ROT
}
#undef SBAR
#undef WAIT_BAR
}


namespace attn8 {
typedef int i32x8 __attribute__((ext_vector_type(8)));
typedef int i32x4 __attribute__((ext_vector_type(4)));
typedef float f32x16 __attribute__((ext_vector_type(16)));
typedef unsigned u32x4 __attribute__((ext_vector_type(4)));
constexpr int SLOT = 4096, RING = 8, NSL = RING;
constexpr int L_K = 0, L_V = NSL * SLOT, L_WS = 2 * NSL * SLOT, L_OST = L_WS + 8 * 256, L_BYTES = L_OST + 8 * 4096;
struct Job { const unsigned char* Q; const unsigned char* K; const unsigned char* VT; unsigned char* O; };
__device__ __forceinline__ void glds16(const void* gsrc, unsigned lds_dst) { unsigned keep;
  asm volatile("s_mov_b32 %0, m0\n\ts_mov_b32 m0, %2\n\ts_nop 0\n\tglobal_load_lds_dwordx4 %1, off\n\ts_mov_b32 m0, %0" : "=&s"(keep) : "v"(gsrc), "s"(lds_dst) : "memory"); }
__device__ __forceinline__ int crow(int r, int hi) { return (r & 3) + 8 * (r >> 2) + 4 * hi; }
#define A8_WAITBAR(N) asm volatile("s_waitcnt vmcnt(" #N ") lgkmcnt(0)\n\ts_barrier" ::: "memory")
#define A8_WAITBAR_N(N) asm volatile("s_waitcnt vmcnt(%0) lgkmcnt(0)\n\ts_barrier" :: "n"(N) : "memory")
template <int NT> __device__ __forceinline__ void attn_unit_f8(const Job& J, char* shm, const int wid_in) {
  int wid = wid_in; asm volatile("" : "+s"(wid));
  const int lane = lane_id_asm(), r32 = lane & 31, hi = lane >> 5;
  const unsigned lds0 = (unsigned)(uintptr_t)shm;
  typedef __attribute__((address_space(3))) const char* lds_cptr;
  const lds_cptr shm3 = (lds_cptr)shm;
  const bool kwave = wid < 4;
  const int w4 = wid & 3; const int drow = 16 * w4 + (lane >> 2); const int cl = (lane & 3) ^ ((drow >> 2) & 3);
  const unsigned char* dsrc = kwave ? J.K + (long)drow * 256 + 16 * cl : J.VT + (long)drow * 4096 + 16 * cl;
  const long dstep = kwave ? 64 * 256 : 64;
  const unsigned ddst = lds0 + (kwave ? L_K : L_V) + w4 * 1024;
  #define A8_DMA(t, slot) glds16(dsrc + (long)(t) * dstep, (unsigned)__builtin_amdgcn_readfirstlane(ddst + (slot)))
  const int sw = (r32 >> 2) & 3; const int foff0 = r32 * 64 + 16 * ((2 * hi) ^ sw), foff1 = r32 * 64 + 16 * ((2 * hi + 1) ^ sw);
  #define A8_FRAG(base, half) __builtin_shufflevector(*(const __attribute__((address_space(3))) i32x4*)((base) + (half) * 2048 + foff0), *(const __attribute__((address_space(3))) i32x4*)((base) + (half) * 2048 + foff1), 0, 1, 2, 3, 4, 5, 6, 7)
  const unsigned char* qp = J.Q + (long)(wid * 32 + r32) * 1024 + 32 * hi;
  const i32x8 qf = __builtin_shufflevector(*(const i32x4*)qp, *(const i32x4*)(qp + 16), 0, 1, 2, 3, 4, 5, 6, 7);
  if (kwave) { _Pragma("unroll") for (int i = 0; i < RING; ++i) A8_DMA(i, i * SLOT); } else { _Pragma("unroll") for (int i = 0; i < RING - 2; ++i) A8_DMA(i, i * SLOT); }
  f32x16 o0 = f32x16{}, o1 = f32x16{}, o2 = f32x16{}; const f32x16 zero = f32x16{};
  i32x8 ones; _Pragma("unroll") for (int w = 0; w < 8; ++w) ones[w] = 0x38383838;
  asm volatile("" : "+v"(ones));
  f32x16 SA0, SA1, SB0, SB1; i32x8 PA, PB;
  A8_WAITBAR_N(RING - 1);
  { const i32x8 k0 = A8_FRAG(shm3 + L_K, 0), k1 = A8_FRAG(shm3 + L_K, 1);
    SA0 = __builtin_amdgcn_mfma_scale_f32_32x32x64_f8f6f4(k0, qf, zero, 0, 0, 0, 0, 0, 0); SA1 = __builtin_amdgcn_mfma_scale_f32_32x32x64_f8f6f4(k1, qf, zero, 0, 0, 0, 0, 0, 0); }
  #define A8_SB() __builtin_amdgcn_sched_barrier(0)
  #define A8_SLOTOF(i) ((((i) + RING) & (RING - 1)) * SLOT)
  #define A8_EXP8(X, B) do { _Pragma("unroll") for (int r = 0; r < 8; ++r) X[(B) + r] = __builtin_amdgcn_exp2f(X[(B) + r]); asm volatile("" : "+v"(X)); } while (0)
  #define A8_CVT4(P, WB, X) do { _Pragma("unroll") for (int w = 0; w < 4; ++w) { unsigned a_ = (unsigned)P[(WB) + w];     \
      a_ = __builtin_amdgcn_cvt_pk_bf8_f32(X[4 * w], X[4 * w + 1], a_, false); a_ = __builtin_amdgcn_cvt_pk_bf8_f32(X[4 * w + 2], X[4 * w + 3], a_, true); P[(WB) + w] = (int)a_; } asm volatile("" : "+v"(P)); } while (0)
  #define A8_STEP(C0, C1, N0, N1, PP, PN, t, WK, WV, DK, DV, QK, PV, EX) do { \
    if (kwave) { A8_WAITBAR_N(WK); } else { A8_WAITBAR_N(WV); } \
    if (kwave) { if (DK) A8_DMA((t) + RING, A8_SLOTOF(t)); } else { if (DV) A8_DMA((t) - 2 + RING, A8_SLOTOF((t) - 2)); } \
    i32x8 k0_ = ones, k1_ = ones, v0_ = ones, v1_ = ones; \
    if (QK) { k0_ = A8_FRAG(shm3 + L_K + A8_SLOTOF((t) + 1), 0); k1_ = A8_FRAG(shm3 + L_K + A8_SLOTOF((t) + 1), 1); } \
    if (PV) { v0_ = A8_FRAG(shm3 + L_V + A8_SLOTOF((t) - 1), 0); v1_ = A8_FRAG(shm3 + L_V + A8_SLOTOF((t) - 1), 1); } \
    A8_SB(); \
    if (EX) A8_EXP8(C0, 0); A8_SB(); \
    if (QK) N0 = __builtin_amdgcn_mfma_scale_f32_32x32x64_f8f6f4(k0_, qf, zero, 0, 0, 0, 0, 0, 0); if (EX) A8_EXP8(C0, 8); A8_SB(); \
    if (QK) N1 = __builtin_amdgcn_mfma_scale_f32_32x32x64_f8f6f4(k1_, qf, zero, 0, 0, 0, 0, 0, 0); if (EX) A8_EXP8(C1, 0); A8_SB(); \
    if (PV) o0 = __builtin_amdgcn_mfma_scale_f32_32x32x64_f8f6f4(PP, v0_, o0, 1, 0, 0, 0, 0, 0); if (EX) A8_EXP8(C1, 8); A8_SB(); \
    if (PV) o1 = __builtin_amdgcn_mfma_scale_f32_32x32x64_f8f6f4(PP, v1_, o1, 1, 0, 0, 0, 0, 0); if (EX) A8_CVT4(PN, 0, C0); A8_SB(); \
    if (PV) o2 = __builtin_amdgcn_mfma_scale_f32_32x32x64_f8f6f4(PP, ones, o2, 1, 0, 0, 0, 0, 0); if (EX) A8_CVT4(PN, 4, C1); A8_SB();     \
  } while (0)
  #define A8_EVEN(t, WK, WV, DK, DV, QK, PV, EX) A8_STEP(SA0, SA1, SB0, SB1, PB, PA, t, WK, WV, DK, DV, QK, PV, EX)
  #define A8_ODD(t, WK, WV, DK, DV, QK, PV, EX)  A8_STEP(SB0, SB1, SA0, SA1, PA, PB, t, WK, WV, DK, DV, QK, PV, EX)
  PA = ones; PB = ones;
  static_assert(RING == 8 && NT % 2 == 0 && NT >= 2 * RING, "the peeled tail below is written for RING = 8");
  A8_EVEN(0, 6, 6, true, true, true, false, true);
#pragma unroll 1
  for (int t = 1; t < NT - 9; t += 2) {
    A8_ODD(t, 6, 6, true, true, true, true, true);
    A8_EVEN(t + 1, 6, 6, true, true, true, true, true);
  }
  A8_ODD(NT - 9, 6, 6, true, true, true, true, true);
  A8_EVEN(NT - 8, 6, 6, false, true, true, true, true);
  A8_ODD(NT - 7, 5, 6, false, true, true, true, true);
  A8_EVEN(NT - 6, 4, 6, false, false, true, true, true);
  A8_ODD(NT - 5, 3, 5, false, false, true, true, true);
  A8_EVEN(NT - 4, 2, 4, false, false, true, true, true);
  A8_ODD(NT - 3, 1, 3, false, false, true, true, true);
  A8_EVEN(NT - 2, 0, 2, false, false, true, true, true);
  A8_ODD(NT - 1, 0, 1, false, false, false, true, true);
  A8_EVEN(NT, 0, 0, false, false, false, true, false);
  #undef A8_EVEN
  #undef A8_ODD
  #undef A8_STEP
  #undef A8_EXP8
  #undef A8_CVT4
  #undef A8_SB
  #undef A8_SLOTOF
  #undef A8_FRAG
  #undef A8_DMA
  float rli[16];
  #pragma unroll
  for (int r = 0; r < 16; ++r) rli[r] = __builtin_amdgcn_rcpf(o2[r]);
  unsigned char* stg8 = (unsigned char*)(shm + L_OST) + wid * 4096;
  #pragma unroll
  for (int r = 0; r < 16; ++r) { const int orow = crow(r, hi);
    const float a = o0[r] * rli[r], b = o1[r] * rli[r];
    stg8[orow * 64 + r32] = (unsigned char)(__builtin_amdgcn_cvt_pk_fp8_f32(a, a, 0, false) & 0xff); stg8[orow * 64 + 32 + r32] = (unsigned char)(__builtin_amdgcn_cvt_pk_fp8_f32(b, b, 0, false) & 0xff); }
  asm volatile("s_waitcnt lgkmcnt(0)" ::: "memory");
  unsigned char* Ow = J.O + (long)(wid * 32) * 1024;
  #pragma unroll
  for (int i = 0; i < 2; ++i) { const int row = i * 16 + (lane >> 2), ch = lane & 3; const u32x4 v = *(const u32x4*)(stg8 + row * 64 + ch * 16); *(u32x4*)(Ow + (long)row * 1024 + ch * 16) = v; }
  asm volatile("s_waitcnt lgkmcnt(0)\n\ts_barrier" ::: "memory");
}
#undef A8_WAITBAR
#undef A8_WAITBAR_N
}

constexpr size_t MiB = 1u << 20;
constexpr size_t WS_CTL = 0, CTL_ZERO_BYTES = 1 * MiB;
constexpr size_t WS_MOD = 1 * MiB;
constexpr size_t WS_ROPE = WS_MOD + 512 * 1024;
constexpr size_t WS_BLUT = WS_ROPE + 8192;
constexpr size_t WS_RC0 = WS_BLUT + 12 * 768 * 4;
constexpr size_t WS_HIST = WS_RC0 + 4096;
constexpr size_t WS_TILEE = WS_HIST + 32768;
constexpr size_t WS_TOPE = 2 * MiB;
constexpr size_t WS_TOPW = WS_TOPE + 512 * 1024;
constexpr size_t WS_SLOT = WS_TOPW + 512 * 1024;
constexpr size_t WS_ROWW = WS_SLOT + 512 * 1024;
constexpr size_t WS_LSE = 5 * MiB;
constexpr size_t WS_WRHI = 7 * MiB;
constexpr size_t WS_WRLO = 8 * MiB;
constexpr size_t WS_WIN = 9 * MiB;
constexpr size_t WS_WBRA = 32 * MiB;
constexpr size_t WS_WBRB = 33 * MiB;
constexpr size_t WS_WOUT = 37 * MiB;
constexpr size_t WS_WGU = 41 * MiB;
constexpr size_t WS_WDN = 297 * MiB;
constexpr size_t WS_X = 425 * MiB;
constexpr size_t WS_H = 553 * MiB;
constexpr size_t WS_R = 617 * MiB;
constexpr size_t WS_AQKV = WS_R;
constexpr size_t WS_QB = WS_R + 144 * MiB;
constexpr size_t WS_KB = WS_R + 208 * MiB;
constexpr size_t WS_VB = WS_R + 224 * MiB;
constexpr size_t WS_GATE = WS_R + 240 * MiB;
constexpr size_t WS_OAG = WS_R + 368 * MiB;
constexpr size_t WS_OA = WS_R + 416 * MiB;
constexpr size_t WS_MERGED = WS_R + 432 * MiB;
constexpr size_t WS_XS = WS_R;
constexpr size_t WS_ACT = WS_R + 136 * MiB;
constexpr size_t WS_Y = WS_R + 272 * MiB;
constexpr size_t WS_OB = WS_R + 496 * MiB;
constexpr size_t WS_M8 = WS_R + 560 * MiB;
constexpr size_t WS_END = WS_R + 592 * MiB;
constexpr int CW_BAR = 4096;

constexpr int RING_BYTES = 133120;
constexpr int LDSCTL_OFF = RING_BYTES;
constexpr int LDS_BYTES = 147456;
constexpr int NWAVES = 8;

#define GAS __attribute__((address_space(1)))
#define LAS __attribute__((address_space(3)))
typedef unsigned short bf16;
typedef unsigned v4u __attribute__((ext_vector_type(4)));
typedef unsigned v2u __attribute__((ext_vector_type(2)));
typedef float f32x4 __attribute__((ext_vector_type(4)));
typedef float f32x16 __attribute__((ext_vector_type(16)));
typedef int i32x4 __attribute__((ext_vector_type(4)));
typedef short bf16x8 __attribute__((ext_vector_type(8)));
typedef GAS unsigned gu32;
#define RLX_AGENT __ATOMIC_RELAXED, __HIP_MEMORY_SCOPE_AGENT
#define LDS_WAIT() asm volatile("s_waitcnt lgkmcnt(0)" ::: "memory")
__device__ __forceinline__ unsigned f2bf(float f) { unsigned u = __builtin_bit_cast(unsigned, f); return (u + 0x7fffu + ((u >> 16) & 1u)) >> 16; }
__device__ __forceinline__ unsigned pk2(float lo, float hi) { return f2bf(lo) | (f2bf(hi) << 16); }
__device__ __forceinline__ float bfl(unsigned w) { return __uint_as_float(w << 16); }
__device__ __forceinline__ float bfh(unsigned w) { return __uint_as_float(w & 0xffff0000u); }

#define XB_TMO      128
#define XB_XCNT(j)  (256  + 64 * (j))
#define XB_XSUB(j)  (1280 + 64 * (j))
#define XB_XGEN(j)  (2304 + 64 * (j))
#define XB_TOP      3328
#define XB_TOPGEN   3392
#define XCD_BAR_WORDS 3456
#define XB_SPIN_CAP (1u << 18)
__device__ __forceinline__ unsigned xb_ld(unsigned* p)              { return __hip_atomic_load(p, __ATOMIC_RELAXED, __HIP_MEMORY_SCOPE_AGENT); }
__device__ __forceinline__ unsigned xb_add(unsigned* p, unsigned v) { return __hip_atomic_fetch_add(p, v, __ATOMIC_RELAXED, __HIP_MEMORY_SCOPE_AGENT); }
__device__ __forceinline__ unsigned xb_xcc_id() { return (unsigned)__builtin_amdgcn_s_getreg((3 << 11) | 20) & 0xFu; }
#define XB_SPIN(cond, bar) do { unsigned _sp = 0; while (cond) { __builtin_amdgcn_s_sleep(1); \
    if ((++_sp & 255u) == 0u) { if (xb_ld(&(bar)[XB_TMO])) break; if (_sp > XB_SPIN_CAP) { atomicAdd(&(bar)[XB_TMO], 1u); break; } } } } while (0)
struct XcdBarrier { unsigned* bar; unsigned x; volatile LAS unsigned* st; };
__device__ __forceinline__ XcdBarrier xcd_barrier_post(unsigned* bar, volatile LAS unsigned* st) {
    XcdBarrier b; b.bar = bar; b.x = xb_xcc_id(); b.st = st;
    if (threadIdx.x == 0) (void)xb_add(&bar[XB_XCNT(b.x)], 1u);
    return b;
}
__device__ __forceinline__ void xcd_barrier_complete(unsigned* bar, unsigned x, unsigned& nloc, unsigned& nx) {
    const unsigned G = gridDim.x * gridDim.y * gridDim.z;
    unsigned sum, cnt, mine, sp = 0u;
    for (;;) {
        sum = 0u; cnt = 0u; mine = 0u;
#pragma unroll
        for (unsigned j = 0; j < 16; ++j) { const unsigned c = xb_ld(&bar[XB_XCNT(j)]); sum += c; cnt += (c > 0u) ? 1u : 0u; mine = (j == x) ? c : mine; }
        if (sum == G) break;
        __builtin_amdgcn_s_sleep(1);
        if ((++sp & 255u) == 0u) { if (xb_ld(&bar[XB_TMO])) break; if (sp > XB_SPIN_CAP) { atomicAdd(&bar[XB_TMO], 1u); break; } }
    }
    nloc = mine > 0u ? mine : 1u; nx = cnt > 0u ? cnt : 1u;
}
__device__ __forceinline__ void xcd_barrier(const XcdBarrier& b) {
    asm volatile("s_waitcnt vmcnt(0)" ::: "memory");
    __syncthreads();
    if (threadIdx.x == 0) {
        unsigned* bar = b.bar;
        __builtin_amdgcn_s_waitcnt(0);
        unsigned nloc = b.st[0], nx = b.st[1];
        if (nloc == 0u) { xcd_barrier_complete(bar, b.x, nloc, nx); b.st[0] = nloc; b.st[1] = nx; }
        const unsigned old = xb_add(&bar[XB_XSUB(b.x)], 1u);
        const unsigned gen = old / nloc;
        if (old + 1u == (gen + 1u) * nloc) {
            __builtin_amdgcn_fence(__ATOMIC_RELEASE, "agent");
            asm volatile("s_waitcnt vmcnt(0)" ::: "memory");
            const unsigned og = xb_add(&bar[XB_TOP], 1u);
            const unsigned tg = og / nx;
            if (og + 1u == (tg + 1u) * nx) xb_add(&bar[XB_TOPGEN], 1u);
            else XB_SPIN(xb_ld(&bar[XB_TOPGEN]) == tg, bar);
            __builtin_amdgcn_fence(__ATOMIC_ACQUIRE, "agent");
            xb_add(&bar[XB_XGEN(b.x)], 1u);
            asm volatile("s_waitcnt vmcnt(0)" ::: "memory");
        } else {
            XB_SPIN(xb_ld(&bar[XB_XGEN(b.x)]) == gen, bar);
            __builtin_amdgcn_fence(__ATOMIC_ACQUIRE, "agent");
            asm volatile("s_waitcnt vmcnt(0)" ::: "memory");
        }
    }
    __syncthreads();
}

__device__ __forceinline__ float wave_sum(float v) {
    v = xsum<1>(v); v = xsum<2>(v); v = xsum<4>(v); v = xsum<8>(v); v = xsum<16>(v); v = xsum<32>(v);
    return v;
}
__device__ __forceinline__ void cvt_item(const float* W, int ldw, int K, int srcA, int srcB, bf16* WT, int dst_row0, int k0, LAS float* scr, int lane, bool ident = false) {
    const int kq = lane >> 4, nq = lane & 15; const int scol = (nq < 8 ? srcA + 4 * nq : srcB + 4 * (nq - 8));
    f32x4 v[16];
#pragma unroll
    for (int i = 0; i < 16; ++i) v[i] = __builtin_nontemporal_load((const GAS f32x4*)(W + (size_t)(k0 + 4 * i + kq) * ldw + scol));
#pragma unroll
    for (int i = 0; i < 16; ++i)
#pragma unroll
        for (int e = 0; e < 4; ++e) scr[(4 * i + kq) * 65 + 4 * nq + e] = v[i][e];
    LDS_WAIT(); asm volatile("" ::: "memory");
    const int c = lane & 7, rr = lane >> 3;
#pragma unroll
    for (int j = 0; j < 8; ++j) { const int rho = rr + 8 * j; const int sc = (rho & 32) + (ident ? (rho & 31) : pg8::perm32(rho & 31)); const LAS float* s = scr + (8 * c) * 65 + sc;
        v4u o; o.x = pk2(s[0 * 65], s[1 * 65]); o.y = pk2(s[2 * 65], s[3 * 65]); o.z = pk2(s[4 * 65], s[5 * 65]); o.w = pk2(s[6 * 65], s[7 * 65]);
        *(GAS v4u*)(WT + (size_t)(dst_row0 + rho) * K + k0 + 8 * c) = o; }
    LDS_WAIT(); asm volatile("" ::: "memory");
}
__device__ __forceinline__ void cvt_item_f8(const float* W, int ldw, int K, int srcA, int srcB, unsigned char* WT, int dst_row0, int k0, LAS float* scr, int lane, bool ident = false) {
    const int kq = lane >> 4, nq = lane & 15; const int scol = (nq < 8 ? srcA + 4 * nq : srcB + 4 * (nq - 8));
    f32x4 v[16];
#pragma unroll
    for (int i = 0; i < 16; ++i) v[i] = __builtin_nontemporal_load((const GAS f32x4*)(W + (size_t)(k0 + 4 * i + kq) * ldw + scol));
#pragma unroll
    for (int i = 0; i < 16; ++i)
#pragma unroll
        for (int e = 0; e < 4; ++e) scr[(4 * i + kq) * 65 + 4 * nq + e] = v[i][e] * pg8::W8_SCALE;
    LDS_WAIT(); asm volatile("" ::: "memory");
    const int c = lane & 7, rr = lane >> 3;
#pragma unroll
    for (int j = 0; j < 8; ++j) { const int rho = rr + 8 * j; const int sc = (rho & 32) + (ident ? (rho & 31) : pg8::perm32(rho & 31)); const LAS float* s = scr + (8 * c) * 65 + sc;
        unsigned w0 = 0, w1 = 0;
        w0 = __builtin_amdgcn_cvt_pk_fp8_f32(s[0 * 65], s[1 * 65], w0, false); w0 = __builtin_amdgcn_cvt_pk_fp8_f32(s[2 * 65], s[3 * 65], w0, true);
        w1 = __builtin_amdgcn_cvt_pk_fp8_f32(s[4 * 65], s[5 * 65], w1, false); w1 = __builtin_amdgcn_cvt_pk_fp8_f32(s[6 * 65], s[7 * 65], w1, true);
        v2u o; o.x = w0; o.y = w1; *(GAS v2u*)(WT + (size_t)(dst_row0 + rho) * K + k0 + 8 * c) = o; }
    LDS_WAIT(); asm volatile("" ::: "memory");
}
__device__ __forceinline__ int win_src(int X) { const int pn = X >> 3, bj = (X >> 2) & 1, wc = X & 3; return (pn >= 9 && pn < 14) ? pn * 256 + 64 * wc + 32 * bj : 32 * X; }
__device__ __forceinline__ int wgu_src(int X) { const int pn = X >> 3, bj = (X >> 2) & 1, wc = X & 3; return bj * 1024 + 128 * pn + 32 * wc; }

__device__ __forceinline__ void norm_row_bf16(const float* xrow, const float* g, const float* sc, const float* sh, bf16* orow, int lane) {
    const GAS f32x4* xr = (const GAS f32x4*)xrow + lane;
    f32x4 v[4]; float s = 0.f;
#pragma unroll
    for (int j = 0; j < 4; ++j) { v[j] = xr[64 * j]; s += (v[j].x * v[j].x + v[j].y * v[j].y) + (v[j].z * v[j].z + v[j].w * v[j].w); }
    const float rs = rsqrtf(wave_sum(s) * (1.0f / D) + EPS);
#pragma unroll
    for (int j = 0; j < 4; ++j) { const int c = 256 * j + 4 * lane;
        const f32x4 gg = *(const GAS f32x4*)(g + c), s1 = *(const GAS f32x4*)(sc + c), s0 = *(const GAS f32x4*)(sh + c);
        const f32x4 y = (v[j] * rs * gg) * (s1 + 1.0f) + s0;
        v2u o; o.x = pk2(y.x, y.y); o.y = pk2(y.z, y.w); *(GAS v2u*)(orow + c) = o; }
}

__device__ __forceinline__ void norm_rows2_bf16(const float* xrow, const float* g, const float* sc, const float* sh, bf16* orow, int lane) {
    const GAS f32x4* xr = (const GAS f32x4*)xrow + lane;
    f32x4 v[2][4]; float s0 = 0.f, s1 = 0.f;
#pragma unroll
    for (int j = 0; j < 4; ++j) { v[0][j] = xr[64 * j]; v[1][j] = xr[256 + 64 * j]; }
#pragma unroll
    for (int j = 0; j < 4; ++j) { s0 += (v[0][j].x * v[0][j].x + v[0][j].y * v[0][j].y) + (v[0][j].z * v[0][j].z + v[0][j].w * v[0][j].w); s1 += (v[1][j].x * v[1][j].x + v[1][j].y * v[1][j].y) + (v[1][j].z * v[1][j].z + v[1][j].w * v[1][j].w); }
    const float rs0 = rsqrtf(wave_sum(s0) * (1.0f / D) + EPS), rs1 = rsqrtf(wave_sum(s1) * (1.0f / D) + EPS);
#pragma unroll
    for (int j = 0; j < 4; ++j) { const int c = 256 * j + 4 * lane;
        const f32x4 gg = *(const GAS f32x4*)(g + c), a1 = *(const GAS f32x4*)(sc + c) + 1.0f, a0 = *(const GAS f32x4*)(sh + c);
        const f32x4 y0 = (v[0][j] * rs0 * gg) * a1 + a0, y1 = (v[1][j] * rs1 * gg) * a1 + a0;
        v2u o0; o0.x = pk2(y0.x, y0.y); o0.y = pk2(y0.z, y0.w); *(GAS v2u*)(orow + c) = o0;
        v2u o1; o1.x = pk2(y1.x, y1.y); o1.y = pk2(y1.z, y1.w); *(GAS v2u*)(orow + D + c) = o1; }
}

__device__ __forceinline__ void norm_rows2_f8(const float* xrow, const float* g, const float* sc, const float* sh, unsigned char* orow, int lane) {
    const GAS f32x4* xr = (const GAS f32x4*)xrow + lane;
    f32x4 v[2][4]; float s0 = 0.f, s1 = 0.f;
#pragma unroll
    for (int j = 0; j < 4; ++j) { v[0][j] = xr[64 * j]; v[1][j] = xr[256 + 64 * j]; }
#pragma unroll
    for (int j = 0; j < 4; ++j) { s0 += (v[0][j].x * v[0][j].x + v[0][j].y * v[0][j].y) + (v[0][j].z * v[0][j].z + v[0][j].w * v[0][j].w); s1 += (v[1][j].x * v[1][j].x + v[1][j].y * v[1][j].y) + (v[1][j].z * v[1][j].z + v[1][j].w * v[1][j].w); }
    const float rs0 = rsqrtf(wave_sum(s0) * (1.0f / D) + EPS), rs1 = rsqrtf(wave_sum(s1) * (1.0f / D) + EPS);
#pragma unroll
    for (int j = 0; j < 4; ++j) { const int c = 256 * j + 4 * lane;
        const f32x4 gg = *(const GAS f32x4*)(g + c), a1 = *(const GAS f32x4*)(sc + c) + 1.0f, a0 = *(const GAS f32x4*)(sh + c);
        const f32x4 y0 = (v[0][j] * rs0 * gg) * a1 + a0, y1 = (v[1][j] * rs1 * gg) * a1 + a0;
        unsigned w0 = 0, w1 = 0;
        w0 = __builtin_amdgcn_cvt_pk_fp8_f32(y0.x, y0.y, w0, false); w0 = __builtin_amdgcn_cvt_pk_fp8_f32(y0.z, y0.w, w0, true);
        w1 = __builtin_amdgcn_cvt_pk_fp8_f32(y1.x, y1.y, w1, false); w1 = __builtin_amdgcn_cvt_pk_fp8_f32(y1.z, y1.w, w1, true);
        *(GAS unsigned*)(orow + c) = w0; *(GAS unsigned*)(orow + D + c) = w1; }
}

__device__ __forceinline__ bool gqa_bound_ok(const float* qg, const float* kg, int lane) {
    float gq = fabsf(qg[lane]), gk = fabsf(kg[lane]);
#define MK_MAXSTEP(m) gq = fmaxf(gq, __int_as_float(__builtin_amdgcn_ds_swizzle(__float_as_int(gq), 0x1f | ((m) << 10)))); gk = fmaxf(gk, __int_as_float(__builtin_amdgcn_ds_swizzle(__float_as_int(gk), 0x1f | ((m) << 10))))
    MK_MAXSTEP(1); MK_MAXSTEP(2); MK_MAXSTEP(4); MK_MAXSTEP(8); MK_MAXSTEP(16);
#undef MK_MAXSTEP
    gq = fmaxf(gq, xget32(gq, lane >> 5)); gk = fmaxf(gk, xget32(gk, lane >> 5));
    const float bound = 64.0f * gq * gk * C2 * 1.01f; return __builtin_amdgcn_readfirstlane((int)(bound <= 14.0f)) != 0;
}

struct Args { const float* in[20]; float* out; unsigned char* ws; int ph_lo, ph_hi, li, pad; };
constexpr int N_PHASES = 2 + 10 * DEPTH;

typedef const __attribute__((address_space(4))) Args* kargs_t;
__device__ __forceinline__ kargs_t kargs_opaque() { kargs_t p = (kargs_t)__builtin_amdgcn_kernarg_segment_ptr(); asm volatile("" : "+s"(p)); return p; }
#define PH_BEGIN() kargs_t ap = kargs_opaque(); unsigned char* ws = ap->ws; (void)ws; \
    int wave = wave_s; asm volatile("" : "+s"(wave)); const int lane = lane_id_asm(); const int tid = wave * 64 + lane; (void)lane; (void)tid; \
    int bx = blockIdx.x; asm volatile("" : "+s"(bx)); int G = gridDim.x; asm volatile("" : "+s"(G)); const int vcu = (G % 8 == 0) ? (bx % 8) * (G / 8) + bx / 8 : bx; (void)vcu; \
    const int gw = vcu * NWAVES + wave, NGW = G * NWAVES; (void)gw; (void)NGW; const int gtid = vcu * (NWAVES * 64) + tid, NGT = G * NWAVES * 64; (void)gtid; (void)NGT
#define INP(k) (ap->in[k])
#define x_in INP(0)
#define c_in INP(1)
#define w_ada INP(2)
#define b_ada INP(3)
#define norm1_g INP(4)
#define w_in INP(5)
#define q_norm_g INP(6)
#define k_norm_g INP(7)
#define rel_bias INP(8)
#define w_br_a INP(9)
#define w_br_b INP(10)
#define w_out INP(11)
#define norm2_g INP(12)
#define w_router INP(13)
#define b_router INP(14)
#define w_gate_up INP(15)
#define b_gate_up INP(16)
#define w_down INP(17)
#define b_down INP(18)
#define final_g INP(19)
#define MOD ((float*)(ws + WS_MOD))
#define ROPE ((float*)(ws + WS_ROPE))
#define BLUT ((float*)(ws + WS_BLUT))
#define RC0 ((float*)(ws + WS_RC0))
#define HIST ((int*)(ws + WS_HIST))
#define TILEE ((int*)(ws + WS_TILEE))
#define TOPE ((int*)(ws + WS_TOPE))
#define TOPW ((float*)(ws + WS_TOPW))
#define SLOT ((int*)(ws + WS_SLOT))
#define ROWW ((float*)(ws + WS_ROWW))
#define LSE ((float*)(ws + WS_LSE))
#define WRHI ((bf16*)(ws + WS_WRHI))
#define WRLO ((bf16*)(ws + WS_WRLO))
#define WIN ((unsigned char*)(ws + WS_WIN))
#define WBRA ((unsigned char*)(ws + WS_WBRA))
#define WBRB ((unsigned char*)(ws + WS_WBRB))
#define WOUT ((unsigned char*)(ws + WS_WOUT))
#define WGU ((unsigned char*)(ws + WS_WGU))
#define WDN ((unsigned char*)(ws + WS_WDN))
#define X ((float*)(ws + WS_X))
#define H ((bf16*)(ws + WS_H))
#define AQKV ((bf16*)(ws + WS_AQKV))
#define QB ((bf16*)(ws + WS_QB))
#define KB ((bf16*)(ws + WS_KB))
#define VB ((bf16*)(ws + WS_VB))
#define GATE ((bf16*)(ws + WS_GATE))
#define OAG ((bf16*)(ws + WS_OAG))
#define OA ((unsigned char*)(ws + WS_OA))
#define MERGED ((bf16*)(ws + WS_MERGED))
#define OB ((unsigned char*)(ws + WS_OB))
#define M8 ((unsigned char*)(ws + WS_M8))
#define XS ((unsigned char*)(ws + WS_XS))
#define ACT ((unsigned char*)(ws + WS_ACT))
#define YB ((unsigned char*)(ws + WS_Y))
__global__ void __launch_bounds__(NWAVES * 64, 2) mk_fwd(Args args) {
    extern __shared__ __attribute__((aligned(16))) unsigned char lds[];
    LAS unsigned char* L = (LAS unsigned char*)lds;
    volatile LAS unsigned* MISC = (volatile LAS unsigned*)(L + LDSCTL_OFF);
    gu32* ctl = (gu32*)(args.ws + WS_CTL);
    const int wave_s = __builtin_amdgcn_readfirstlane(threadIdx.x >> 6);
    for (int u = threadIdx.x; u < (LDS_BYTES - LDSCTL_OFF) / 4; u += NWAVES * 64) ((LAS unsigned*)(L + LDSCTL_OFF))[u] = 0u;
    __syncthreads();
    XcdBarrier bar; bar.bar = (unsigned*)(ctl + CW_BAR) + args.li * XCD_BAR_WORDS; bar.x = 0; bar.st = nullptr;
    if (!MK_PER_PHASE) bar = xcd_barrier_post((unsigned*)(ctl + CW_BAR) + args.li * XCD_BAR_WORDS, MISC + 8);
    const int lo = args.ph_lo, hi = args.ph_hi;
#define IN(k) (lo <= (k) && (k) < hi)
#define KIND(q) ((PH_KIND_MASK >> (q)) & 1)
#define SEAM(k) do { if (IN(k) && IN((k) + 1)) xcd_barrier(bar); } while (0)

    for (int rep0 = 0; rep0 < 1 + PROBE_P0; ++rep0) {
    if (KIND(0) && IN(0)) { PH_BEGIN();
        {
            LAS float* cact = (LAS float*)L;
            LAS float* part = (LAS float*)(L + 32768);
            for (int i = tid; i < NB * D; i += NWAVES * 64) { const float cv = c_in[i]; cact[i] = cv / (1.0f + __expf(-cv)); }
            __syncthreads();
            for (int vb = bx; vb < 256; vb += G) {
                const int gc = vb * 48 + lane;
                const int l = gc / 6144, col = gc % 6144;
                float a[NB];
#pragma unroll
                for (int b = 0; b < NB; ++b) a[b] = 0.f;
                if (lane < 48) {
                    const float* wp = w_ada + (size_t)l * D * 6144 + col;
                    for (int k = wave * 128; k < wave * 128 + 128; ++k) { const float w = wp[(size_t)k * 6144];
#pragma unroll
                        for (int b = 0; b < NB; ++b) a[b] += cact[b * D + k] * w; }
                }
#pragma unroll
                for (int b = 0; b < NB; ++b) part[(wave * NB + b) * 64 + lane] = a[b];
                __syncthreads();
                if (tid < NB * 48) { const int b = tid / 48, cl = tid % 48; const int gc2 = vb * 48 + cl; const int l2 = gc2 / 6144, col2 = gc2 % 6144;
                    float s = b_ada[l2 * 6144 + col2];
#pragma unroll
                    for (int w = 0; w < NWAVES; ++w) s += part[(w * NB + b) * 64 + cl];
                    MOD[((size_t)l2 * NB + b) * 6144 + col2] = s; }
                __syncthreads();
            }
        }
        for (int i = gtid; i < 1024 + 12 * 768; i += NGT) {
            if (i < 1024) { const int p = i >> 4, f = i & 15; const double inv = pow(10000.0, -(double)f / 16.0); const double ang = (double)p * inv; ROPE[i] = (float)cos(ang); ROPE[1024 + i] = (float)sin(ang); }
            else { const int j = i - 1024; const int hh = j / 768, di = j % 768; const int delta = di - 383; const int g = hh >> 2; const int dil = g == 0 ? 1 : (g == 1 ? 4 : 16);
                float val = -INFINITY;
                if (delta >= -64 && delta <= 64) { const int rel = delta * dil; const int n = rel < 0 ? -rel : rel; int bk = rel > 0 ? 16 : 0;
                    if (n < 8) bk += n; else { int lg = 8 + (int)(logf((float)n / 8.0f) / logf(128.0f) * 8.0f); if (lg > 15) lg = 15; bk += lg; }
                    val = rel_bias[bk * 12 + hh] * LOG2E; }
                BLUT[j] = val; }
        }
        {
            LAS float* scr = (LAS float*)(L + wave * 16640);
            __syncthreads();
            constexpr int I_IN = 16 * 92, I_BRA = 4 * 16, I_BRB = 16 * 16, I_OUT = 16 * 16, I_GU = 16 * 32, I_DN = 16 * 16;
            constexpr int PER_L = I_IN + I_BRA + I_BRB + I_OUT;
            constexpr int NITEMS = DEPTH * PER_L + DEPTH * NE * (I_GU + I_DN);
            for (int it = gw; it < NITEMS; it += NGW) {
                int r = it;
                if (r < DEPTH * PER_L) {
                    const int l = r / PER_L; r %= PER_L;
                    if (r < I_IN) { const int kb = r / 92, g64 = r % 92; cvt_item_f8(w_in + (size_t)l * D * N_IN, N_IN, D, win_src(2 * g64), win_src(2 * g64 + 1), WIN + (size_t)l * N_IN * D, 64 * g64, 64 * kb, scr, lane, (g64 >> 2) >= 9 && (g64 >> 2) < 14); continue; } r -= I_IN;
                    if (r < I_BRA) { const int kb = r / 16, g64 = r % 16; cvt_item_f8(w_br_a + (size_t)l * 256 * D, D, 256, 64 * g64, 64 * g64 + 32, WBRA + (size_t)l * D * 256, 64 * g64, 64 * kb, scr, lane); continue; } r -= I_BRA;
                    if (r < I_BRB) { const int kb = r / 16, g64 = r % 16; cvt_item_f8(w_br_b + (size_t)l * D * D, D, D, 64 * g64, 64 * g64 + 32, WBRB + (size_t)l * D * D, 64 * g64, 64 * kb, scr, lane); continue; } r -= I_BRB;
                    { const int kb = r / 16, g64 = r % 16; cvt_item_f8(w_out + (size_t)l * D * D, D, D, 64 * g64, 64 * g64 + 32, WOUT + (size_t)l * D * D, 64 * g64, 64 * kb, scr, lane); continue; }
                }
                r -= DEPTH * PER_L;
                if (r < DEPTH * NE * I_GU) { const int le = r / I_GU; r %= I_GU; const int kb = r / 32, g64 = r % 32;
                    cvt_item_f8(w_gate_up + (size_t)le * D * 2048, 2048, D, wgu_src(2 * g64), wgu_src(2 * g64 + 1), WGU + (size_t)le * 2048 * D, 64 * g64, 64 * kb, scr, lane); continue; }
                r -= DEPTH * NE * I_GU;
                { const int le = r / I_DN; r %= I_DN; const int kb = r / 16, g64 = r % 16;
                    cvt_item_f8(w_down + (size_t)le * D * D, D, D, 64 * g64, 64 * g64 + 32, WDN + (size_t)le * D * D, 64 * g64, 64 * kb, scr, lane); }
            }
        }
    }
    SEAM(0);
    }
    if (KIND(1) && IN(1)) { PH_BEGIN();
        for (int m = 2 * gw; m < T; m += 2 * NGW) { const int b = m >> 12; const float* md = MOD + (size_t)b * 6144;
            norm_rows2_f8(x_in + (size_t)m * D, norm1_g, md + 1024, md, (unsigned char*)H + (size_t)m * D, lane); }
        for (int i = gtid; i < DEPTH * NB * NE * D; i += NGT) { const int k = i & 1023, e = (i >> 10) & 31, b = (i >> 15) & 7, l = i >> 18;
            const float v = norm2_g[l * D + k] * (1.0f + MOD[((size_t)l * NB + b) * 6144 + 4 * 1024 + k]) * w_router[((size_t)l * D + k) * NE + e];
            const unsigned hb = f2bf(v); const float lv = v - __uint_as_float(hb << 16);
            WRHI[i] = (bf16)hb; WRLO[i] = (bf16)f2bf(lv); }
        for (int i = gw; i < DEPTH * NB * NE; i += NGW) { const int e = i & 31, b = (i >> 5) & 7, l = i >> 8; float s = 0.f;
            for (int k = lane; k < D; k += 64) s += MOD[((size_t)l * NB + b) * 6144 + 3 * 1024 + k] * w_router[((size_t)l * D + k) * NE + e];
            s = wave_sum(s); if (lane == 0) RC0[i] = s + b_router[l * NE + e]; }
    }
    SEAM(1);

    for (int li = (PROBE_MASK ? -1 : 0); li < DEPTH; ++li) {
        const int l = li < 0 ? 0 : li; const bool virt = li < 0;
        const int P = 2 + 10 * l;
#define VK(q) (!virt || ((PROBE_MASK >> (q)) & 1))
        if (KIND(2) && IN(P + 0) && VK(2)) { PH_BEGIN();
            pg8::Gemm g{H, (const bf16*)(WIN + (size_t)l * N_IN * D), D / 2}; pg8::StaticOrder S; S.init(T, N_IN, G, bx);
            const bool f8attn = gqa_bound_ok(q_norm_g + l * 64, k_norm_g + l * 64, lane);
            pg8::EpiIn E{AQKV, QB, KB, VB, GATE, q_norm_g + l * 64, k_norm_g + l * 64, ROPE, pg8::W8_INV, f8attn};
            pg8::gemm_phase_f8<pg8::EpiIn, pg8::StaticOrder>(L, g, S, E, wave);
        }
        if (VK(2)) SEAM(P + 0);
        if (KIND(3) && IN(P + 1) && VK(3)) { PH_BEGIN();
            namespace ab = attn_body;
            const bool nomax = gqa_bound_ok(q_norm_g + l * 64, k_norm_g + l * 64, lane);
            for (int j = 0; j < 8; ++j) {
                const int uidx = vcu * 8 + j; if (uidx >= 2048) break;
                const int pair = uidx >> 6, idx = uidx & 63; const int b = pair >> 2, kvh = pair & 3, hq = idx >> 4, qb = idx & 15; const int h = kvh * 4 + hq;
                ab::Job J; J.Q = (const ab::bf16*)QB + ((size_t)b * SEQ + qb * 256) * 1024 + h * 64; J.K = (const ab::bf16*)KB + (size_t)b * SEQ * 256 + kvh * 64; J.V = (const ab::bf16*)VB + (size_t)b * SEQ * 256 + kvh * 64;
                J.O = (ab::bf16*)(OB + ((size_t)b * SEQ + qb * 256) * 1024 + h * 64)  ; J.lse = nullptr; J.lutg = nullptr; J.NT = 64; J.i0 = 0; J.kq0 = 0; J.dsh = 0; J.cls = 0;
                if (nomax) { attn8::Job J8; J8.Q = (const unsigned char*)QB + ((size_t)b * SEQ + qb * 256) * 1024 + h * 64; J8.K = (const unsigned char*)KB + (size_t)b * SEQ * 256 + kvh * 64;
                    J8.VT = (const unsigned char*)VB + ((size_t)((b * 4 + kvh) * 64) << 12); J8.O = OB + ((size_t)b * SEQ + qb * 256) * 1024 + h * 64;
                    attn8::attn_unit_f8<64>(J8, (char*)lds, wave); }
                else ab::attn_unit<0, 8, false>(J, (char*)lds, wave);
            }
            for (int j = 0; j < 6; ++j) {
                const int uidx = vcu * 6 + j; if (uidx >= 1536) break;
                const int g = uidx / 512, r = uidx % 512; const int b = r >> 6, hs = (r >> 4) & 3, combo = r & 15;
                const int dsh = 2 * g; const int Lc = SEQ >> dsh; const int nqb = Lc >> 8;
                const int cls = combo / nqb, qb = combo % nqb; const int i0 = qb * 256;
                int t0 = (i0 >> 6) - 1; const int ntile = Lc >> 6; const int NT = ntile >= 6 ? 6 : 4; if (t0 < 0) t0 = 0; if (t0 > ntile - NT) t0 = ntile - NT;
                const size_t cbase = (size_t)b * SEQ + (size_t)cls * Lc;
                const ab::bf16* aq = (const ab::bf16*)AQKV + (size_t)(g * 3 + 0) * T * 256; const ab::bf16* ak = (const ab::bf16*)AQKV + (size_t)(g * 3 + 1) * T * 256; const ab::bf16* av = (const ab::bf16*)AQKV + (size_t)(g * 3 + 2) * T * 256;
                ab::Job J; J.Q = aq + (cbase + i0) * 256 + hs * 64; J.K = ak + (cbase + t0 * 64) * 256 + hs * 64; J.V = av + (cbase + t0 * 64) * 256 + hs * 64;
                J.O = (ab::bf16*)OAG + (size_t)g * T * 256 + (size_t)b * SEQ * 256 + hs * 64; J.lse = LSE + (size_t)g * T * 4 + (size_t)b * SEQ * 4 + hs; J.lutg = BLUT + (g * 4 + hs) * 768;
                J.NT = NT; J.i0 = i0; J.kq0 = t0 * 64 - i0; J.dsh = dsh; J.cls = cls;
                ab::attn_unit<1, 8>(J, (char*)lds, wave);
            }
        }
        if (VK(3)) SEAM(P + 1);
        if (KIND(4) && IN(P + 2) && VK(4)) { PH_BEGIN();
            for (int i = gtid; i < T * 32; i += NGT) { const int t = i >> 5, ch = i & 31, hs = ch >> 3;
                const float l0 = LSE[(size_t)t * 4 + hs], l1 = LSE[(size_t)T * 4 + (size_t)t * 4 + hs], l2 = LSE[(size_t)2 * T * 4 + (size_t)t * 4 + hs];
                const float mx = fmaxf(l0, fmaxf(l1, l2)); float w0 = exp2f(l0 - mx), w1 = exp2f(l1 - mx), w2 = exp2f(l2 - mx); const float inv = 1.0f / (w0 + w1 + w2); w0 *= inv; w1 *= inv; w2 *= inv;
                const v4u a = *(const GAS v4u*)(OAG + (size_t)t * 256 + ch * 8), bq = *(const GAS v4u*)(OAG + (size_t)T * 256 + (size_t)t * 256 + ch * 8), cq = *(const GAS v4u*)(OAG + (size_t)2 * T * 256 + (size_t)t * 256 + ch * 8);
                unsigned o0 = 0, o1 = 0;
                o0 = __builtin_amdgcn_cvt_pk_fp8_f32(w0 * bfl(a.x) + w1 * bfl(bq.x) + w2 * bfl(cq.x), w0 * bfh(a.x) + w1 * bfh(bq.x) + w2 * bfh(cq.x), o0, false);
                o0 = __builtin_amdgcn_cvt_pk_fp8_f32(w0 * bfl(a.y) + w1 * bfl(bq.y) + w2 * bfl(cq.y), w0 * bfh(a.y) + w1 * bfh(bq.y) + w2 * bfh(cq.y), o0, true);
                o1 = __builtin_amdgcn_cvt_pk_fp8_f32(w0 * bfl(a.z) + w1 * bfl(bq.z) + w2 * bfl(cq.z), w0 * bfh(a.z) + w1 * bfh(bq.z) + w2 * bfh(cq.z), o1, false);
                o1 = __builtin_amdgcn_cvt_pk_fp8_f32(w0 * bfl(a.w) + w1 * bfl(bq.w) + w2 * bfl(cq.w), w0 * bfh(a.w) + w1 * bfh(bq.w) + w2 * bfh(cq.w), o1, true);
                v2u o; o.x = o0; o.y = o1; *(GAS v2u*)(OA + (size_t)t * 256 + ch * 8) = o; }
        }
        if (VK(4)) SEAM(P + 2);
        if (KIND(5) && IN(P + 3) && VK(5)) { PH_BEGIN();
            pg8::StaticOrder S; S.init(T, D, G, bx);
            { pg8::Gemm g{(const bf16*)OA, (const bf16*)(WBRA + (size_t)l * D * 256), 128}; pg8::EpiMergeA E{GATE, MERGED}; pg8::gemm_phase_f8<pg8::EpiMergeA, pg8::StaticOrder>(L, g, S, E, wave); }
            { pg8::Gemm g{(const bf16*)OB, (const bf16*)(WBRB + (size_t)l * D * D), D / 2}; pg8::EpiMergeB<true> E{GATE, MERGED, M8}; pg8::gemm_phase_f8<pg8::EpiMergeB<true>, pg8::StaticOrder>(L, g, S, E, wave); }
        }
        if (VK(5)) SEAM(P + 3);
        if (KIND(6) && IN(P + 4) && VK(6)) { PH_BEGIN();
            pg8::Gemm g{(const bf16*)M8, (const bf16*)(WOUT + (size_t)l * D * D), D / 2}; pg8::StaticOrder S; S.init(T, D, G, bx);
            pg8::EpiOut E{l == 0 ? x_in : X, X, MOD + (size_t)l * NB * 6144 + 2 * 1024};
            pg8::gemm_phase_f8<pg8::EpiOut, pg8::StaticOrder>(L, g, S, E, wave);
        }
        if (VK(6)) SEAM(P + 4);
        if (KIND(7) && IN(P + 5) && VK(7)) { PH_BEGIN();
            LAS int* hist = (LAS int*)(L + LDSCTL_OFF + 256);
            for (int vb = bx; vb < 256; vb += G) {
                if (tid < NE) hist[tid] = 0;
                __syncthreads();
                {
                    const int tt = vb + 256 * wave; const int r0 = tt * 16; const int b = r0 >> 12; const int i = lane & 15, kb = lane >> 4;
                    const float* xp = X + (size_t)(r0 + i) * D + 8 * kb;
                    const bf16* bh = WRHI + ((size_t)(l * NB + b) * NE + i) * D + 8 * kb; const bf16* bl = WRLO + ((size_t)(l * NB + b) * NE + i) * D + 8 * kb;
                    f32x4 acc0 = (f32x4){0.f, 0.f, 0.f, 0.f}, acc1 = acc0; float ss = 0.f;
#pragma unroll 8
                    for (int s = 0; s < 32; ++s) {
                        const f32x4 x0 = *(const GAS f32x4*)(xp + 32 * s), x1 = *(const GAS f32x4*)(xp + 32 * s + 4);
                        const bf16x8 wh0 = *(const GAS bf16x8*)(bh + 32 * s), wh1 = *(const GAS bf16x8*)(bh + 16 * D + 32 * s), wl0 = *(const GAS bf16x8*)(bl + 32 * s), wl1 = *(const GAS bf16x8*)(bl + 16 * D + 32 * s);
                        ss += (x0.x * x0.x + x0.y * x0.y) + (x0.z * x0.z + x0.w * x0.w) + (x1.x * x1.x + x1.y * x1.y) + (x1.z * x1.z + x1.w * x1.w);
                        v4u ah, al;
                        ah.x = pg8::cvt_pk_bf16(x0.x, x0.y); ah.y = pg8::cvt_pk_bf16(x0.z, x0.w); ah.z = pg8::cvt_pk_bf16(x1.x, x1.y); ah.w = pg8::cvt_pk_bf16(x1.z, x1.w);
                        al.x = pg8::cvt_pk_bf16(x0.x - bfl(ah.x), x0.y - bfh(ah.x)); al.y = pg8::cvt_pk_bf16(x0.z - bfl(ah.y), x0.w - bfh(ah.y));
                        al.z = pg8::cvt_pk_bf16(x1.x - bfl(ah.z), x1.y - bfh(ah.z)); al.w = pg8::cvt_pk_bf16(x1.z - bfl(ah.w), x1.w - bfh(ah.w));
                        const bf16x8 ahv = __builtin_bit_cast(bf16x8, ah), alv = __builtin_bit_cast(bf16x8, al);
                        acc0 = __builtin_amdgcn_mfma_f32_16x16x32_bf16(wh0, ahv, acc0, 0, 0, 0); acc1 = __builtin_amdgcn_mfma_f32_16x16x32_bf16(wh1, ahv, acc1, 0, 0, 0);
                        acc0 = __builtin_amdgcn_mfma_f32_16x16x32_bf16(wl0, ahv, acc0, 0, 0, 0); acc1 = __builtin_amdgcn_mfma_f32_16x16x32_bf16(wl1, ahv, acc1, 0, 0, 0);
                        acc0 = __builtin_amdgcn_mfma_f32_16x16x32_bf16(wh0, alv, acc0, 0, 0, 0); acc1 = __builtin_amdgcn_mfma_f32_16x16x32_bf16(wh1, alv, acc1, 0, 0, 0);
                    }
                    ss = xsum<16>(ss); ss = xsum<32>(ss);
                    const float rs = rsqrtf(ss * (1.0f / D) + EPS);
                    float v[8]; const float* rc = RC0 + (l * NB + b) * NE;
#pragma unroll
                    for (int r = 0; r < 4; ++r) { v[r] = rs * acc0[r] + rc[4 * kb + r]; v[4 + r] = rs * acc1[r] + rc[16 + 4 * kb + r]; }
                    float tv[4]; int ti[4];
#pragma unroll
                    for (int k = 0; k < 4; ++k) { float best = v[0]; int br = 0;
#pragma unroll
                        for (int r = 1; r < 8; ++r) if (v[r] > best) { best = v[r]; br = r; }
#pragma unroll
                        for (int r = 0; r < 8; ++r) v[r] = (r == br) ? -INFINITY : v[r];
                        tv[k] = best; ti[k] = (br & 3) + 16 * (br >> 2) + 4 * kb; }
#pragma unroll
                    for (int round = 0; round < 2; ++round) {
                        float bv[8]; int bi[8];
#pragma unroll
                        for (int k = 0; k < 4; ++k) { bv[k] = tv[k]; bi[k] = ti[k];
                            if (round == 0) { bv[4 + k] = __int_as_float(__builtin_amdgcn_ds_swizzle(__float_as_int(tv[k]), 0x1f | (16 << 10))); bi[4 + k] = __builtin_amdgcn_ds_swizzle(ti[k], 0x1f | (16 << 10)); }
                            else { bv[4 + k] = xget32(tv[k], lane >> 5); bi[4 + k] = xget32(ti[k], lane >> 5); } }
#pragma unroll
                        for (int k = 0; k < 4; ++k) { float best = bv[0]; int bq = 0;
#pragma unroll
                            for (int r = 1; r < 8; ++r) if (bv[r] > best || (bv[r] == best && bi[r] < bi[bq])) { best = bv[r]; bq = r; }
                            int sel = bi[0];
#pragma unroll
                            for (int r = 0; r < 8; ++r) { if (r == bq) sel = bi[r]; }
#pragma unroll
                            for (int r = 0; r < 8; ++r) bv[r] = (r == bq) ? -INFINITY : bv[r];
                            tv[k] = best; ti[k] = sel; }
                    }
                    if (kb == 0) {
                        const float e1 = __expf(tv[1] - tv[0]), e2 = __expf(tv[2] - tv[0]), e3 = __expf(tv[3] - tv[0]); const float inv = 1.0f / (1.0f + e1 + e2 + e3);
                        const int tok = r0 + i;
                        *(GAS i32x4*)(TOPE + (size_t)tok * 4) = (i32x4){ti[0], ti[1], ti[2], ti[3]};
                        *(GAS f32x4*)(TOPW + (size_t)tok * 4) = (f32x4){inv, e1 * inv, e2 * inv, e3 * inv};
#pragma unroll
                        for (int k = 0; k < 4; ++k) atomicAdd((int*)&hist[ti[k]], 1);
                    }
                }
                __syncthreads();
                if (tid < NE) HIST[vb * NE + tid] = hist[tid];
                __syncthreads();
            }
            for (int m = 2 * gw; m < T; m += 2 * NGW) { const int b = m >> 12; const float* md = MOD + ((size_t)l * NB + b) * 6144;
                norm_rows2_f8(X + (size_t)m * D, norm2_g + l * D, md + 4 * 1024, md + 3 * 1024, (unsigned char*)H + (size_t)m * D, lane); }
        }
        if (VK(7)) SEAM(P + 5);
        if (KIND(8) && IN(P + 6) && VK(8)) { PH_BEGIN();
            LAS int* sm = (LAS int*)L;
            for (int vb = bx; vb < 256; vb += G) {
                { const int e = tid & 31, seg = tid >> 5; int tot = 0, bef = 0;
                    for (int q = seg * 16; q < seg * 16 + 16; ++q) { const int hv = HIST[q * NE + e]; tot += hv; if (q < vb) bef += hv; }
                    sm[tid] = tot; sm[512 + tid] = bef; }
                __syncthreads();
                if (tid < NE) { int tot = 0, bef = 0;
                    for (int s = 0; s < 16; ++s) { tot += sm[s * 32 + tid]; bef += sm[512 + s * 32 + tid]; }
                    sm[1024 + tid] = bef; sm[1056 + tid] = (tot + 255) & ~255; }
                __syncthreads();
                if (tid == 0) { int run = 0; for (int e = 0; e < NE; ++e) { const int pd = sm[1056 + e]; sm[1056 + e] = run; sm[1024 + e] += run;
                        if (vb == 0) { for (int q = run >> 8; q < (run + pd) >> 8; ++q) TILEE[q] = e; }
                        run += pd; }
                    if (vb == 0) TILEE[1000] = run >> 8; }
                __syncthreads();
                if (tid < 128) { const int tt = vb + 256 * (tid >> 4); const int tok = tt * 16 + (tid & 15);
                    const i32x4 te = *(const GAS i32x4*)(TOPE + (size_t)tok * 4); const f32x4 tw = *(const GAS f32x4*)(TOPW + (size_t)tok * 4);
                    const int s0 = atomicAdd((int*)&sm[1024 + te.x], 1), s1 = atomicAdd((int*)&sm[1024 + te.y], 1), s2 = atomicAdd((int*)&sm[1024 + te.z], 1), s3 = atomicAdd((int*)&sm[1024 + te.w], 1);
                    *(GAS i32x4*)(SLOT + (size_t)tok * 4) = (i32x4){s0, s1, s2, s3};
                    ROWW[s0] = tw.x; ROWW[s1] = tw.y; ROWW[s2] = tw.z; ROWW[s3] = tw.w;
                    sm[2048 + tid * 4 + 0] = s0; sm[2048 + tid * 4 + 1] = s1; sm[2048 + tid * 4 + 2] = s2; sm[2048 + tid * 4 + 3] = s3; }
                __syncthreads();
                for (int p = wave; p < 512; p += NWAVES) { const int q = p >> 2; const int tt = vb + 256 * (q >> 4); const int tok = tt * 16 + (q & 15); const int slot = sm[2048 + p];
                    const GAS v4u* src = (const GAS v4u*)((unsigned char*)H + (size_t)tok * D); GAS v4u* dst = (GAS v4u*)(XS + (size_t)slot * D);
                    dst[lane] = src[lane]; }
                __syncthreads();
            }
        }
        if (VK(8)) SEAM(P + 6);
        if (KIND(9) && IN(P + 7) && VK(9)) { PH_BEGIN();
            const int nmt = __builtin_amdgcn_readfirstlane(__hip_atomic_load(TILEE + 1000, __ATOMIC_RELAXED, __HIP_MEMORY_SCOPE_AGENT));
            pg8::Gemm g{(const bf16*)XS, (const bf16*)(WGU + (size_t)l * NE * 2048 * D), D / 2}; pg8::MoeOrder S{TILEE, nmt * 8, 8, G, vcu};
            pg8::EpiGU8 E{b_gate_up + (size_t)l * NE * 2048, ACT};
            pg8::gemm_phase_f8<pg8::EpiGU8, pg8::MoeOrder>(L, g, S, E, wave);
        }
        if (VK(9)) SEAM(P + 7);
        if (KIND(10) && IN(P + 8) && VK(10)) { PH_BEGIN();
            const int nmt = __builtin_amdgcn_readfirstlane(__hip_atomic_load(TILEE + 1000, __ATOMIC_RELAXED, __HIP_MEMORY_SCOPE_AGENT));
            pg8::Gemm g{(const bf16*)ACT, (const bf16*)(WDN + (size_t)l * NE * D * D), D / 2}; pg8::MoeOrder S{TILEE, nmt * 4, 4, G, vcu};
            pg8::EpiDN8 E{b_down + (size_t)l * NE * D, ROWW, YB};
            pg8::gemm_phase_f8<pg8::EpiDN8, pg8::MoeOrder>(L, g, S, E, wave);
        }
        if (VK(10)) SEAM(P + 8);
        if (KIND(11) && IN(P + 9) && VK(11)) { PH_BEGIN();
            const bool lastl = (l == DEPTH - 1);
            float* Xw = virt ? (float*)(ws + WS_R) : X; bf16* Hw = virt ? (bf16*)(ws + WS_R + 128 * MiB) : H;
            for (int m0 = 2 * gw; m0 < T; m0 += 2 * NGW) { const int b = m0 >> 12;
                i32x4 sl[2];
#pragma unroll
                for (int q = 0; q < 2; ++q) { const int* sp = SLOT + (size_t)(m0 + q) * 4;
                    sl[q].x = __hip_atomic_load(sp + 0, RLX_AGENT); sl[q].y = __hip_atomic_load(sp + 1, RLX_AGENT); sl[q].z = __hip_atomic_load(sp + 2, RLX_AGENT); sl[q].w = __hip_atomic_load(sp + 3, RLX_AGENT); }
                const int c = 16 * lane;
                const float* g2 = MOD + ((size_t)l * NB + b) * 6144 + 5 * 1024;
                f32x4 v[2][4]; v4u yy[2][4];
#pragma unroll
                for (int q = 0; q < 2; ++q) {
#pragma unroll
                    for (int j = 0; j < 4; ++j) v[q][j] = *(const GAS f32x4*)(X + (size_t)(m0 + q) * D + c + 4 * j);
                    yy[q][0] = *(const GAS v4u*)(YB + (size_t)sl[q].x * D + c); yy[q][1] = *(const GAS v4u*)(YB + (size_t)sl[q].y * D + c);
                    yy[q][2] = *(const GAS v4u*)(YB + (size_t)sl[q].z * D + c); yy[q][3] = *(const GAS v4u*)(YB + (size_t)sl[q].w * D + c); }
                float s[2] = {0.f, 0.f};
#pragma unroll
                for (int q = 0; q < 2; ++q)
#pragma unroll
                    for (int j = 0; j < 4; ++j) { f32x4 ys = (f32x4){0.f, 0.f, 0.f, 0.f};
#pragma unroll
                        for (int k = 0; k < 4; ++k) { const unsigned w = yy[q][k][j];
                            const auto lo = __builtin_amdgcn_cvt_pk_f32_fp8((int)w, false), hi2 = __builtin_amdgcn_cvt_pk_f32_fp8((int)w, true);
                            ys.x += lo[0]; ys.y += lo[1]; ys.z += hi2[0]; ys.w += hi2[1]; }
                        const f32x4 gg = *(const GAS f32x4*)(g2 + c + 4 * j);
                        v[q][j] = v[q][j] + gg * ys;
                        if (!lastl) *(GAS f32x4*)(Xw + (size_t)(m0 + q) * D + c + 4 * j) = v[q][j];
                        s[q] += (v[q][j].x * v[q][j].x + v[q][j].y * v[q][j].y) + (v[q][j].z * v[q][j].z + v[q][j].w * v[q][j].w); }
                const float rs0 = rsqrtf(wave_sum(s[0]) * (1.0f / D) + EPS), rs1 = rsqrtf(wave_sum(s[1]) * (1.0f / D) + EPS);
                if (!lastl) { const float* md = MOD + ((size_t)(l + 1) * NB + b) * 6144; const float* gn = norm1_g + (l + 1) * D;
                    v4u h0, h1;
#pragma unroll
                    for (int j = 0; j < 4; ++j) {
                        const f32x4 gg = *(const GAS f32x4*)(gn + c + 4 * j), a1 = *(const GAS f32x4*)(md + 1024 + c + 4 * j) + 1.0f, a0 = *(const GAS f32x4*)(md + c + 4 * j);
                        const f32x4 y0 = (v[0][j] * rs0 * gg) * a1 + a0, y1 = (v[1][j] * rs1 * gg) * a1 + a0;
                        unsigned w0 = 0, w1 = 0;
                        w0 = __builtin_amdgcn_cvt_pk_fp8_f32(y0.x, y0.y, w0, false); w0 = __builtin_amdgcn_cvt_pk_fp8_f32(y0.z, y0.w, w0, true);
                        w1 = __builtin_amdgcn_cvt_pk_fp8_f32(y1.x, y1.y, w1, false); w1 = __builtin_amdgcn_cvt_pk_fp8_f32(y1.z, y1.w, w1, true);
                        h0[j] = w0; h1[j] = w1; }
                    *(GAS v4u*)((unsigned char*)Hw + (size_t)m0 * D + c) = h0; *(GAS v4u*)((unsigned char*)Hw + (size_t)(m0 + 1) * D + c) = h1;
                } else {
#pragma unroll
                    for (int j = 0; j < 4; ++j) { const f32x4 gg = *(const GAS f32x4*)(final_g + c + 4 * j);
                        *(GAS f32x4*)(ap->out + (size_t)m0 * D + c + 4 * j) = v[0][j] * rs0 * gg; *(GAS f32x4*)(ap->out + (size_t)(m0 + 1) * D + c + 4 * j) = v[1][j] * rs1 * gg; }
                }
            }
        }
        if (VK(11)) SEAM(P + 9);
        if (virt) { PH_BEGIN();
            for (int m = 2 * gw; m < T; m += 2 * NGW) { const int b = m >> 12; const float* md = MOD + (size_t)b * 6144; norm_rows2_f8(x_in + (size_t)m * D, norm1_g, md + 1024, md, (unsigned char*)H + (size_t)m * D, lane); }
            xcd_barrier(bar); }
    }
#undef IN
#undef SEAM
}

extern "C" void kernel_launch(void* const* d_in, const int* in_sizes, int n_in, void* d_out, int out_size, void* d_ws, size_t ws_size, hipStream_t stream) {
    static int grid = 0;
    if (grid == 0) {
        if (n_in != 20 || in_sizes[0] != T * D || out_size != T * D || ws_size < WS_END) { fprintf(stderr, "kernel_launch: unexpected shapes (n_in %d, in0 %d, out %d, ws %zu < %zu); nothing launched\n", n_in, n_in > 0 ? in_sizes[0] : -1, out_size, ws_size, (size_t)WS_END); grid = -1; return; }
        int dev = 0, cus = 0, per_cu = 0;
        if (hipGetDevice(&dev) != hipSuccess || hipDeviceGetAttribute(&cus, hipDeviceAttributeMultiprocessorCount, dev) != hipSuccess) { grid = -1; return; }
        if (hipFuncSetAttribute((const void*)mk_fwd, hipFuncAttributeMaxDynamicSharedMemorySize, LDS_BYTES) != hipSuccess) { fprintf(stderr, "kernel_launch: hipFuncSetAttribute failed\n"); grid = -1; return; }
        if (hipOccupancyMaxActiveBlocksPerMultiprocessor(&per_cu, (const void*)mk_fwd, NWAVES * 64, LDS_BYTES) != hipSuccess || per_cu < 1)
            fprintf(stderr, "kernel_launch: note: occupancy query reports %d workgroups per CU\n", per_cu);
        (void)hipGetLastError();
        grid = cus < 256 ? cus : 256;
        if (grid != 256) fprintf(stderr, "kernel_launch: %d CUs; this kernel's unit deals assume 256\n", grid);
    }
    if (grid < 0) return;
    if (hipMemsetAsync((char*)d_ws + WS_CTL, 0, CTL_ZERO_BYTES, stream) != hipSuccess) { fprintf(stderr, "kernel_launch: memset failed\n"); return; }
    Args a{};
    for (int i = 0; i < 20; ++i) a.in[i] = (const float*)d_in[i];
    a.out = (float*)d_out; a.ws = (unsigned char*)d_ws; a.pad = 0;
#if MK_PER_PHASE
    for (int p = 0; p < N_PHASES; ++p) { a.ph_lo = p; a.ph_hi = p + 1; a.li = 0; hipLaunchKernelGGL(mk_fwd, dim3(grid), dim3(NWAVES * 64), LDS_BYTES, stream, a); }
#else
    a.ph_lo = 0; a.ph_hi = N_PHASES; a.li = 0;
    hipLaunchKernelGGL(mk_fwd, dim3(grid), dim3(NWAVES * 64), LDS_BYTES, stream, a);
#endif
    const hipError_t le = hipPeekAtLastError();
    if (le != hipSuccess) fprintf(stderr, "kernel_launch: launch failed: %s\n", hipGetErrorName(le));
}
```

```cpp
#include <hip/hip_runtime.h>
#include <hip/hip_bf16.h>
#include <cstdio>
#include <cstdint>
#include <cmath>

#ifndef PH_KIND_MASK
#define PH_KIND_MASK 0xFFF
#endif
#ifndef PROBE_MASK
#define PROBE_MASK 0
#endif
#ifndef PROBE_P0
#define PROBE_P0 0
#endif
#ifndef MK_PER_PHASE
#define MK_PER_PHASE 0
#endif

constexpr int NB = 8, SEQ = 4096, T = NB * SEQ, D = 1024, DEPTH = 2;
constexpr int N_IN = 5888, NE = 32, TOPK = 4;
constexpr int NASSIGN = T * TOPK;
constexpr int MAX_MT = NASSIGN / 256 + NE;
constexpr int CAP_ROWS = MAX_MT * 256;
constexpr float C2 = 0.125f * 1.4426950408889634f;
constexpr float LOG2E = 1.4426950408889634f;
constexpr float EPS = 1e-6f;

__device__ __forceinline__ int lane_id_asm() { int l; asm volatile("v_mbcnt_lo_u32_b32 %0, -1, 0\n\tv_mbcnt_hi_u32_b32 %0, -1, %0" : "=v"(l)); return l; }

template <int M> __device__ __forceinline__ float xsum(float v) {
    if constexpr (M < 32) return v + __int_as_float(__builtin_amdgcn_ds_swizzle(__float_as_int(v), 0x1f | (M << 10)));
    else { auto rr = __builtin_amdgcn_permlane32_swap(__float_as_uint(v), __float_as_uint(v), false, false); return __uint_as_float(rr[0]) + __uint_as_float(rr[1]); }
}
template <class Tv> __device__ __forceinline__ Tv xget32(Tv v, int hf) {
    auto rr = __builtin_amdgcn_permlane32_swap(__builtin_bit_cast(unsigned, v), __builtin_bit_cast(unsigned, v), false, false); return __builtin_bit_cast(Tv, hf ? rr[0] : rr[1]);
}

namespace pg8 {
#define PG8_LAS __attribute__((address_space(3)))
typedef unsigned short bf16_t;
typedef short bf16x8 __attribute__((ext_vector_type(8)));
typedef float f32x4 __attribute__((ext_vector_type(4)));
typedef unsigned u32x4 __attribute__((ext_vector_type(4)));
typedef unsigned u32x2 __attribute__((ext_vector_type(2)));
constexpr int BM = 256, BK = 64, HALF = 128, HTB = HALF * BK * 2, STAGE_BYTES = 8 * HTB, NXCD = 8, WGM = 8;

__host__ __device__ __forceinline__ int lds_byte(int r, int c) { const int st = (r >> 4) * 2 + (c >> 5), rr = r & 15, cc = c & 31, ob = rr * 64 + cc * 2; return st * 1024 + (ob ^ (((ob >> 9) & 1) << 5)); }
__host__ __device__ __forceinline__ void stage_rc(int b, int& R, int& C) { const int st = b / 1024, sb = b % 1024, swz = sb ^ (((sb >> 9) & 1) << 5); R = (st >> 1) * 16 + swz / 64; C = (st & 1) * 32 + (swz % 64) / 2; }
__host__ __device__ __forceinline__ int perm32(int rho) { const int n = rho >> 4, i = rho & 15; return 8 * (i >> 2) + 4 * n + (i & 3); }

struct Unit { int pm, pn; };
struct Gemm { const bf16_t* A; const bf16_t* Bt; int K; };

struct StaticOrder {
    int nM, nN, nwg, G, c;
    __device__ void init(int M, int N, int G_, int c_) { nM = M / BM; nN = N / BM; nwg = nM * nN; G = G_; c = c_; }
    __device__ bool next(int i, Unit& u) const {
        const long L = (long)i * G + c; if (L >= nwg) return false;
        int wgid = (int)L; { const int q = nwg / NXCD, r = nwg % NXCD, xcd = wgid % NXCD, off = wgid / NXCD; wgid = (xcd < r ? xcd * (q + 1) : r * (q + 1) + (xcd - r) * q) + off; }
        const int nig = WGM * nN, gid = wgid / nig, fm = gid * WGM, gsz = (nM - fm) < WGM ? (nM - fm) : WGM;
        u.pm = fm + ((wgid % nig) % gsz); u.pn = (wgid % nig) / gsz; return true;
    }
};
struct MoeOrder {
    const int* tile_e; int n_units, nN, G, vcu;
    __device__ bool next(int i, Unit& u) const {
        const long L = (long)i * G + vcu; if (L >= n_units) return false;
        const int mt = (int)L / nN, pl = (int)L % nN; const int e = __builtin_amdgcn_readfirstlane(__hip_atomic_load(tile_e + mt, __ATOMIC_RELAXED, __HIP_MEMORY_SCOPE_AGENT));
        u.pm = mt; u.pn = e * nN + pl; return true;
    }
};

__device__ __forceinline__ unsigned cvt_pk_bf16(float lo, float hi) { unsigned r; asm volatile("v_cvt_pk_bf16_f32 %0, %1, %2" : "=v"(r) : "v"(lo), "v"(hi)); return r; }
__device__ __forceinline__ float bf_lo(unsigned w) { return __uint_as_float(w << 16); }
__device__ __forceinline__ float bf_hi(unsigned w) { return __uint_as_float(w & 0xffff0000u); }
__device__ __forceinline__ float sigmoid_f(float x) { return __builtin_amdgcn_rcpf(1.0f + __builtin_amdgcn_exp2f(-LOG2E * x)); }

template <class Epi, class Sched>
__device__ __forceinline__ void gemm_phase(PG8_LAS unsigned char* lds, const Gemm g, const Sched& S, const Epi& E, const int wid_in) {
    int wid = wid_in; asm volatile("" : "+s"(wid));
    const int lane = lane_id_asm(), tid = wid * 64 + lane, wr = wid >> 2, wc = wid & 3, fr = lane & 15, fq = lane >> 4;
    int K_o = g.K; asm volatile("" : "+s"(K_o)); const int K = K_o, nt = K / BK;
    unsigned voff[2];
#pragma unroll
    for (int i = 0; i < 2; ++i) { int R, C; stage_rc(tid * 16 + i * 8192, R, C); voff[i] = (unsigned)(R * K + C) * 2u; }
    const size_t kstep = (size_t)(BK * 2);
    const size_t hstep = (size_t)HALF * K * 2;
    const size_t tstep = 2 * hstep;
    const unsigned ldsw = (unsigned)wid * 1024u;
    const int aoff = lds_byte(wr * 64 + fr, fq * 8), boff = lds_byte(wc * 32 + fr, fq * 8);
#define PG8_SA(b, h) (((b) * 2 + (h)) * HTB)
#define PG8_SB(b, h) ((4 + (b) * 2 + (h)) * HTB)
#define PG8_STAGE(bufoff, gbase) do { _Pragma("unroll") for (int _i = 0; _i < 2; ++_i) \
        __builtin_amdgcn_global_load_lds((const unsigned*)((const char*)(gbase) + voff[_i]), (PG8_LAS unsigned*)(lds + (bufoff) + ldsw + _i * 8192), 16, 0, 0); } while (0)
#define PG8_LDA(dst, b, h) do { _Pragma("unroll") for (int m = 0; m < 4; ++m) _Pragma("unroll") for (int k = 0; k < 2; ++k) dst[m][k] = *(const PG8_LAS bf16x8*)(lds + PG8_SA(b, h) + aoff + m * 2048 + k * 1024); } while (0)
#define PG8_LDB(dst, b, h) do { _Pragma("unroll") for (int n = 0; n < 2; ++n) _Pragma("unroll") for (int k = 0; k < 2; ++k) dst[n][k] = *(const PG8_LAS bf16x8*)(lds + PG8_SB(b, h) + boff + n * 2048 + k * 1024); } while (0)
#define PG8_MMA(ai, bj, At, Bt) do { __builtin_amdgcn_s_setprio(1); _Pragma("unroll") for (int m = 0; m < 4; ++m) _Pragma("unroll") for (int n = 0; n < 2; ++n) _Pragma("unroll") for (int k = 0; k < 2; ++k) \
        acc[ai][bj][m][n] = __builtin_amdgcn_mfma_f32_16x16x32_bf16(Bt[n][k], At[m][k], acc[ai][bj][m][n], 0, 0, 0); __builtin_amdgcn_s_setprio(0); } while (0)
#define PG8_WAIT_V(n) asm volatile("s_waitcnt vmcnt(" #n ")" ::: "memory")
#define PG8_WAIT_L(n) asm volatile("s_waitcnt lgkmcnt(" #n ")" ::: "memory")
#define PG8_BAR __builtin_amdgcn_s_barrier()
#define PG8_SCHED __builtin_amdgcn_sched_barrier(0)
    Unit cur, nxt; int ui = 0;
    if (!S.next(0, cur)) return;
    f32x4 acc[2][2][4][2];
#pragma unroll
    for (int a = 0; a < 2; ++a)
#pragma unroll
        for (int b = 0; b < 2; ++b)
#pragma unroll
            for (int m = 0; m < 4; ++m)
#pragma unroll
                for (int n = 0; n < 2; ++n) acc[a][b][m][n] = (f32x4){0.f, 0.f, 0.f, 0.f};
    bf16x8 At[4][2], B0[2][2], B1[2][2];
    const char* cA = (const char*)g.A + (size_t)cur.pm * tstep; const char* cB = (const char*)g.Bt + (size_t)cur.pn * tstep;
    PG8_STAGE(PG8_SB(0, 0), cB); PG8_STAGE(PG8_SB(0, 1), cB + hstep); PG8_STAGE(PG8_SA(0, 0), cA); PG8_STAGE(PG8_SA(0, 1), cA + hstep);
    if (wr == 1) PG8_BAR;
    PG8_WAIT_V(2); PG8_BAR;
    PG8_STAGE(PG8_SB(1, 0), cB + kstep); PG8_STAGE(PG8_SA(1, 0), cA + kstep); PG8_STAGE(PG8_SB(1, 1), cB + hstep + kstep);
    PG8_WAIT_V(6); PG8_BAR;
    for (;;) {
        const bool has_next = S.next(ui + 1, nxt);
        const char* nA = has_next ? (const char*)g.A + (size_t)nxt.pm * tstep : cA; const char* nB = has_next ? (const char*)g.Bt + (size_t)nxt.pn * tstep : cB;
        for (int t = 0; t < nt; t += 2) {
            const bool last = (t == nt - 2);
            const char* a1 = cA + (size_t)(t + 1) * kstep;
            const char* a2 = last ? nA : cA + (size_t)(t + 2) * kstep; const char* b2 = last ? nB : cB + (size_t)(t + 2) * kstep;
            const char* a3 = a2 + kstep; const char* b3 = b2 + kstep;
            PG8_LDB(B0, 0, 0); PG8_LDB(B1, 0, 1); PG8_SCHED; PG8_LDA(At, 0, 0); PG8_STAGE(PG8_SA(1, 1), a1 + hstep);
            PG8_WAIT_V(8); PG8_WAIT_L(0); PG8_BAR; PG8_MMA(0, 0, At, B0); PG8_MMA(0, 1, At, B1); PG8_BAR; PG8_SCHED;
            PG8_LDA(At, 0, 1); PG8_STAGE(PG8_SB(0, 0), b2); PG8_STAGE(PG8_SB(0, 1), b2 + hstep); PG8_STAGE(PG8_SA(0, 0), a2);
            PG8_WAIT_V(8); PG8_WAIT_L(0); PG8_BAR; PG8_MMA(1, 0, At, B0); PG8_MMA(1, 1, At, B1); PG8_BAR; PG8_SCHED;
            PG8_LDB(B0, 1, 0); PG8_LDB(B1, 1, 1); PG8_SCHED; PG8_LDA(At, 1, 0); PG8_STAGE(PG8_SA(0, 1), a2 + hstep);
            PG8_WAIT_V(8); PG8_WAIT_L(0); PG8_BAR; PG8_MMA(0, 0, At, B0); PG8_MMA(0, 1, At, B1); PG8_BAR; PG8_SCHED;
            PG8_LDA(At, 1, 1); PG8_STAGE(PG8_SB(1, 0), b3); PG8_STAGE(PG8_SB(1, 1), b3 + hstep); PG8_STAGE(PG8_SA(1, 0), a3);
            PG8_WAIT_V(8); PG8_WAIT_L(0); PG8_BAR; PG8_MMA(1, 0, At, B0); PG8_MMA(1, 1, At, B1); PG8_BAR; PG8_SCHED;
        }
        if (wr == 0) PG8_BAR;
        E(acc, cur, wr, wc, fr, fq);
        if (!has_next) break;
#pragma unroll
        for (int a = 0; a < 2; ++a)
#pragma unroll
            for (int b = 0; b < 2; ++b)
#pragma unroll
                for (int m = 0; m < 4; ++m)
#pragma unroll
                    for (int n = 0; n < 2; ++n) acc[a][b][m][n] = (f32x4){0.f, 0.f, 0.f, 0.f};
        cur = nxt; cA = nA; cB = nB; ++ui;
        if (wr == 1) PG8_BAR;
    }
    PG8_WAIT_V(0);
    PG8_BAR;
#undef PG8_SA
#undef PG8_SB
#undef PG8_STAGE
#undef PG8_LDA
#undef PG8_LDB
#undef PG8_MMA
#undef PG8_WAIT_V
#undef PG8_WAIT_L
#undef PG8_BAR
#undef PG8_SCHED
}

typedef int i32x4_t __attribute__((ext_vector_type(4)));
template <class Epi, class Sched>
__device__ __forceinline__ void gemm_phase_f8(PG8_LAS unsigned char* lds, const Gemm g, const Sched& S, const Epi& E, const int wid_in) {
    int wid = wid_in; asm volatile("" : "+s"(wid));
    const int lane = lane_id_asm(), tid = wid * 64 + lane, wr = wid >> 2, wc = wid & 3, fr = lane & 15, fq = lane >> 4;
    int K_o = g.K; asm volatile("" : "+s"(K_o)); const int K = K_o, nt = K / BK;
    unsigned voff[2];
#pragma unroll
    for (int i = 0; i < 2; ++i) { int R, C; stage_rc(tid * 16 + i * 8192, R, C); voff[i] = (unsigned)(R * K + C) * 2u; }
    const size_t kstep = (size_t)(BK * 2);
    const size_t hstep = (size_t)HALF * K * 2;
    const size_t tstep = 2 * hstep;
    const unsigned ldsw = (unsigned)wid * 1024u;
    const int aoff = lds_byte(wr * 64 + fr, fq * 16), boff = lds_byte(wc * 32 + fr, fq * 16);
#define PG8_SA(b, h) (((b) * 2 + (h)) * HTB)
#define PG8_SB(b, h) ((4 + (b) * 2 + (h)) * HTB)
#define PG8_STAGE(bufoff, gbase) do { _Pragma("unroll") for (int _i = 0; _i < 2; ++_i) \
        __builtin_amdgcn_global_load_lds((const unsigned*)((const char*)(gbase) + voff[_i]), (PG8_LAS unsigned*)(lds + (bufoff) + ldsw + _i * 8192), 16, 0, 0); } while (0)
#define PG8_LDA(dst, b, h) do { _Pragma("unroll") for (int m = 0; m < 4; ++m) _Pragma("unroll") for (int k = 0; k < 2; ++k) dst[m][k] = *(const PG8_LAS bf16x8*)(lds + PG8_SA(b, h) + aoff + m * 2048 + k * 16); } while (0)
#define PG8_LDB(dst, b, h) do { _Pragma("unroll") for (int n = 0; n < 2; ++n) _Pragma("unroll") for (int k = 0; k < 2; ++k) dst[n][k] = *(const PG8_LAS bf16x8*)(lds + PG8_SB(b, h) + boff + n * 2048 + k * 16); } while (0)
#define PG8_F8(x) __builtin_shufflevector(__builtin_bit_cast(i32x4_t, (x)[0]), __builtin_bit_cast(i32x4_t, (x)[1]), 0, 1, 2, 3, 4, 5, 6, 7)
#define PG8_MMA(ai, bj, At, Bt) do { __builtin_amdgcn_s_setprio(1); asm volatile("s_nop 1" ::: ); _Pragma("unroll") for (int m = 0; m < 4; ++m) _Pragma("unroll") for (int n = 0; n < 2; ++n) \
        asm volatile("v_mfma_f32_16x16x128_f8f6f4 %0, %1, %2, %0" : "+v"(acc[ai][bj][m][n]) : "v"(PG8_F8(Bt[n])), "v"(PG8_F8(At[m]))); __builtin_amdgcn_s_setprio(0); } while (0)
#define PG8_ACC_SETTLE asm volatile("s_nop 15\n\ts_nop 15" ::: "memory")
#define PG8_WAIT_V(n) asm volatile("s_waitcnt vmcnt(" #n ")" ::: "memory")
#define PG8_WAIT_L(n) asm volatile("s_waitcnt lgkmcnt(" #n ")" ::: "memory")
#define PG8_BAR __builtin_amdgcn_s_barrier()
#define PG8_SCHED __builtin_amdgcn_sched_barrier(0)
    Unit cur, nxt; int ui = 0; int sprev = 0;
    if (!S.next(0, cur)) return;
    f32x4 acc[2][2][4][2];
#pragma unroll
    for (int a = 0; a < 2; ++a)
#pragma unroll
        for (int b = 0; b < 2; ++b)
#pragma unroll
            for (int m = 0; m < 4; ++m)
#pragma unroll
                for (int n = 0; n < 2; ++n) acc[a][b][m][n] = (f32x4){0.f, 0.f, 0.f, 0.f};
    bf16x8 At[4][2], B0[2][2], B1[2][2];
    const char* cA = (const char*)g.A + (size_t)cur.pm * tstep; const char* cB = (const char*)g.Bt + (size_t)cur.pn * tstep;
    PG8_STAGE(PG8_SB(0, 0), cB); PG8_STAGE(PG8_SB(0, 1), cB + hstep); PG8_STAGE(PG8_SA(0, 0), cA); PG8_STAGE(PG8_SA(0, 1), cA + hstep);
    if (wr == 1) PG8_BAR;
    PG8_WAIT_V(2); PG8_BAR;
    PG8_STAGE(PG8_SB(1, 0), cB + kstep); PG8_STAGE(PG8_SA(1, 0), cA + kstep); PG8_STAGE(PG8_SB(1, 1), cB + hstep + kstep);
    PG8_WAIT_V(6); PG8_BAR;
    for (;;) {
        const bool has_next = S.next(ui + 1, nxt);
        const char* nA = has_next ? (const char*)g.A + (size_t)nxt.pm * tstep : cA; const char* nB = has_next ? (const char*)g.Bt + (size_t)nxt.pn * tstep : cB;
#define PG8_WAITSEL do { if (!first) { PG8_WAIT_V(8); } else if (sprev == 8) { PG8_WAIT_V(16); } else if (sprev == 16) { PG8_WAIT_V(24); } else { PG8_WAIT_V(40); } } while (0)
        for (int t = 0; t < nt; t += 2) {
            const bool last = (t == nt - 2);
            const bool first = (t == 0) && (sprev != 0);
            const char* a1 = cA + (size_t)(t + 1) * kstep;
            const char* a2 = last ? nA : cA + (size_t)(t + 2) * kstep; const char* b2 = last ? nB : cB + (size_t)(t + 2) * kstep;
            const char* a3 = a2 + kstep; const char* b3 = b2 + kstep;
            PG8_LDB(B0, 0, 0); PG8_LDB(B1, 0, 1); PG8_SCHED; PG8_LDA(At, 0, 0); if (!first) PG8_STAGE(PG8_SA(1, 1), a1 + hstep);
            PG8_WAITSEL; PG8_WAIT_L(0); PG8_BAR; PG8_MMA(0, 0, At, B0); PG8_MMA(0, 1, At, B1); PG8_BAR; PG8_SCHED;
            PG8_LDA(At, 0, 1); PG8_STAGE(PG8_SB(0, 0), b2); PG8_STAGE(PG8_SB(0, 1), b2 + hstep); PG8_STAGE(PG8_SA(0, 0), a2);
            PG8_WAITSEL; PG8_WAIT_L(0); PG8_BAR; PG8_MMA(1, 0, At, B0); PG8_MMA(1, 1, At, B1); PG8_BAR; PG8_SCHED;
            PG8_LDB(B0, 1, 0); PG8_LDB(B1, 1, 1); PG8_SCHED; PG8_LDA(At, 1, 0); PG8_STAGE(PG8_SA(0, 1), a2 + hstep);
            PG8_WAITSEL; PG8_WAIT_L(0); PG8_BAR; PG8_MMA(0, 0, At, B0); PG8_MMA(0, 1, At, B1); PG8_BAR; PG8_SCHED;
            PG8_LDA(At, 1, 1); PG8_STAGE(PG8_SB(1, 0), b3); PG8_STAGE(PG8_SB(1, 1), b3 + hstep); PG8_STAGE(PG8_SA(1, 0), a3);
            PG8_WAIT_V(8); PG8_WAIT_L(0); PG8_BAR; PG8_MMA(1, 0, At, B0); PG8_MMA(1, 1, At, B1); PG8_BAR; PG8_SCHED;
        }
#undef PG8_WAITSEL
        if (wr == 0) PG8_BAR;
        sprev = has_next ? E.nst(cur) : 0;
        if (sprev != 0) PG8_STAGE(PG8_SA(1, 1), nA + kstep + hstep);
        PG8_ACC_SETTLE;
        E(acc, cur, wr, wc, fr, fq);
        if (!has_next) break;
#pragma unroll
        for (int a = 0; a < 2; ++a)
#pragma unroll
            for (int b = 0; b < 2; ++b)
#pragma unroll
                for (int m = 0; m < 4; ++m)
#pragma unroll
                    for (int n = 0; n < 2; ++n) acc[a][b][m][n] = (f32x4){0.f, 0.f, 0.f, 0.f};
        cur = nxt; cA = nA; cB = nB; ++ui;
        if (wr == 1) PG8_BAR;
    }
    PG8_WAIT_V(0);
    PG8_BAR;
#undef PG8_SA
#undef PG8_SB
#undef PG8_STAGE
#undef PG8_LDA
#undef PG8_LDB
#undef PG8_MMA
#undef PG8_F8
#undef PG8_ACC_SETTLE
#undef PG8_WAIT_V
#undef PG8_WAIT_L
#undef PG8_BAR
#undef PG8_SCHED
}

#define EPI_ROWS(...) _Pragma("unroll") for (int ai = 0; ai < 2; ++ai) _Pragma("unroll") for (int m = 0; m < 4; ++m) { const int row = u.pm * BM + ai * HALF + wr * 64 + m * 16 + fr; __VA_ARGS__ }
__device__ __forceinline__ u32x4 pack8(const f32x4 a, const f32x4 b) { u32x4 w; w.x = cvt_pk_bf16(a[0], a[1]); w.y = cvt_pk_bf16(a[2], a[3]); w.z = cvt_pk_bf16(b[0], b[1]); w.w = cvt_pk_bf16(b[2], b[3]); return w; }

__device__ __forceinline__ u32x2 pack8_f8(const f32x4 a, const f32x4 b) { unsigned w0 = 0, w1 = 0;
    w0 = __builtin_amdgcn_cvt_pk_fp8_f32(a[0], a[1], w0, false); w0 = __builtin_amdgcn_cvt_pk_fp8_f32(a[2], a[3], w0, true);
    w1 = __builtin_amdgcn_cvt_pk_fp8_f32(b[0], b[1], w1, false); w1 = __builtin_amdgcn_cvt_pk_fp8_f32(b[2], b[3], w1, true); u32x2 r; r.x = w0; r.y = w1; return r; }
constexpr float W8_SCALE = 64.0f, W8_INV = 1.0f / 64.0f;
struct EpiIn {
    __device__ __forceinline__ int nst(const Unit& u) const { const int pn = u.pn; if (pn >= 9 && pn < 14) return 32; if (pn == 14 && f8attn) return 0; return 16; }
    bf16_t* aqkv; bf16_t* qb; bf16_t* kb; bf16_t* vb; bf16_t* gate; const float* qg; const float* kg; const float* rope; float asc; bool f8attn;
    __device__ __forceinline__ void operator()(const f32x4 (&acc)[2][2][4][2], const Unit& u, int wr, int wc, int fr, int fq) const {
        const int pn = u.pn;
        if (pn >= 9 && pn < 14) {
            const bool isq = pn < 13; const int head = isq ? (pn - 9) * 4 + wc : wc; bf16_t* dst = isq ? qb : kb; const int pitch = isq ? 1024 : 256;
            const float* gvec = isq ? qg : kg; const float osc = isq ? C2 : 1.0f;
            f32x4 gv[2][2];
#pragma unroll
            for (int bj = 0; bj < 2; ++bj)
#pragma unroll
                for (int n = 0; n < 2; ++n) gv[bj][n] = *(const f32x4*)(gvec + 32 * bj + 16 * n + 4 * fq);
            EPI_ROWS(
                float ss = 0.f;
                _Pragma("unroll") for (int bj = 0; bj < 2; ++bj) _Pragma("unroll") for (int n = 0; n < 2; ++n) { const f32x4 x = acc[ai][bj][m][n] * asc; ss += (x[0] * x[0] + x[1] * x[1]) + (x[2] * x[2] + x[3] * x[3]); }
                ss = xsum<16>(ss); ss = xsum<32>(ss);
                const float sc = rsqrtf(ss * (1.0f / 64.0f) + EPS) * osc * asc;
                const int t = row & (SEQ - 1);
                _Pragma("unroll") for (int bj = 0; bj < 2; ++bj) {
                    const int pos = bj == 0 ? (t >> 6) : (t & 63);
                    const f32x4 cs = *(const f32x4*)(rope + pos * 16 + 4 * fq); const f32x4 sn = *(const f32x4*)(rope + 1024 + pos * 16 + 4 * fq);
                    const f32x4 y0 = acc[ai][bj][m][0] * sc * gv[bj][0]; const f32x4 y1 = acc[ai][bj][m][1] * sc * gv[bj][1];
                    const f32x4 o0 = y0 * cs - y1 * sn; const f32x4 o1 = y1 * cs + y0 * sn;
                    if (f8attn) { unsigned char* p8 = (unsigned char*)dst + (size_t)row * pitch + head * 64 + 32 * bj + 4 * fq;
                        unsigned a = 0, b = 0; a = __builtin_amdgcn_cvt_pk_fp8_f32(o0[0], o0[1], a, false); a = __builtin_amdgcn_cvt_pk_fp8_f32(o0[2], o0[3], a, true);
                        b = __builtin_amdgcn_cvt_pk_fp8_f32(o1[0], o1[1], b, false); b = __builtin_amdgcn_cvt_pk_fp8_f32(o1[2], o1[3], b, true);
                        *(unsigned*)p8 = a; *(unsigned*)(p8 + 16) = b;
                    } else {
                    bf16_t* p = dst + (size_t)row * pitch + head * 64 + 32 * bj + 4 * fq;
                    u32x2 w0; w0.x = cvt_pk_bf16(o0[0], o0[1]); w0.y = cvt_pk_bf16(o0[2], o0[3]);
                    u32x2 w1; w1.x = cvt_pk_bf16(o1[0], o1[1]); w1.y = cvt_pk_bf16(o1[2], o1[3]);
                    *(u32x2*)p = w0; *(u32x2*)(p + 16) = w1; }
                }
            )
        } else if (pn == 14 && f8attn) {
            unsigned char* vt = (unsigned char*)vb;
            EPI_ROWS(
                const int b = row >> 12; const int t = row & (SEQ - 1); const int kk = t & 63;
                const int pos = 32 * ((kk >> 2) & 1) + (kk & 3) + 4 * ((kk >> 3) & 3) + 16 * (kk >> 5);
                _Pragma("unroll") for (int bj = 0; bj < 2; ++bj) {
                    const int kvh = bj * 2 + (wc >> 1); const int d0 = (wc & 1) * 32 + 8 * fq;
                    unsigned char* p = vt + ((size_t)((b * 4 + kvh) * 64 + d0) << 12) + (t & ~63) + pos;
                    const f32x4 v0 = acc[ai][bj][m][0] * asc; const f32x4 v1 = acc[ai][bj][m][1] * asc;
                    unsigned a = 0, c = 0; a = __builtin_amdgcn_cvt_pk_fp8_f32(v0[0], v0[1], a, false); a = __builtin_amdgcn_cvt_pk_fp8_f32(v0[2], v0[3], a, true);
                    c = __builtin_amdgcn_cvt_pk_fp8_f32(v1[0], v1[1], c, false); c = __builtin_amdgcn_cvt_pk_fp8_f32(v1[2], v1[3], c, true);
                    p[0 << 12] = (unsigned char)a; p[1 << 12] = (unsigned char)(a >> 8); p[2 << 12] = (unsigned char)(a >> 16); p[3 << 12] = (unsigned char)(a >> 24);
                    p[4 << 12] = (unsigned char)c; p[5 << 12] = (unsigned char)(c >> 8); p[6 << 12] = (unsigned char)(c >> 16); p[7 << 12] = (unsigned char)(c >> 24);
                }
            )
        } else {
            bf16_t* dst; int pitch, colt, dsh = 0; float sc = asc; bool sig = false, fold = false;
            if (pn < 9) { dst = aqkv + (size_t)pn * T * 256; pitch = 256; colt = 0; fold = true; dsh = 2 * (pn / 3); if (pn % 3 == 0) sc = C2 * asc; }
            else if (pn == 14) { dst = vb; pitch = 256; colt = 0; }
            else { dst = gate; pitch = 2048; colt = (pn - 15) * 256; sig = true; }
            const int col0 = colt + wc * 32 + 8 * fq;
            EPI_ROWS(
                int drow = row;
                if (fold) { const int t = row & (SEQ - 1); drow = (row & ~(SEQ - 1)) | ((t & ((1 << dsh) - 1)) << (12 - dsh)) | (t >> dsh); }
                bf16_t* rowp = dst + (size_t)drow * pitch + col0;
                _Pragma("unroll") for (int bj = 0; bj < 2; ++bj) {
                    f32x4 v0 = acc[ai][bj][m][0], v1 = acc[ai][bj][m][1];
                    if (sig) { _Pragma("unroll") for (int j = 0; j < 4; ++j) { v0[j] = sigmoid_f(v0[j] * asc); v1[j] = sigmoid_f(v1[j] * asc); } }
                    else { v0 = v0 * sc; v1 = v1 * sc; }
                    *(u32x4*)(rowp + bj * HALF) = pack8(v0, v1);
                }
            )
        }
    }
};
struct EpiMergeA {
    __device__ __forceinline__ int nst(const Unit&) const { return 16; }
    const bf16_t* gate; bf16_t* merged;
    __device__ __forceinline__ void operator()(const f32x4 (&acc)[2][2][4][2], const Unit& u, int wr, int wc, int fr, int fq) const {
        const int col0 = u.pn * BM + wc * 32 + 8 * fq;
        EPI_ROWS(
            _Pragma("unroll") for (int bj = 0; bj < 2; ++bj) {
                const u32x4 gw = *(const u32x4*)(gate + (size_t)row * 2048 + col0 + bj * HALF);
                f32x4 v0 = acc[ai][bj][m][0], v1 = acc[ai][bj][m][1];
                v0 = v0 * W8_INV; v1 = v1 * W8_INV;
                v0[0] *= bf_lo(gw.x); v0[1] *= bf_hi(gw.x); v0[2] *= bf_lo(gw.y); v0[3] *= bf_hi(gw.y);
                v1[0] *= bf_lo(gw.z); v1[1] *= bf_hi(gw.z); v1[2] *= bf_lo(gw.w); v1[3] *= bf_hi(gw.w);
                *(u32x4*)(merged + (size_t)row * 1024 + col0 + bj * HALF) = pack8(v0, v1);
            }
        )
    }
};
template <bool F8> struct EpiMergeB {
    __device__ __forceinline__ int nst(const Unit&) const { return 16; }
    const bf16_t* gate; const bf16_t* merged; unsigned char* m8;
    __device__ __forceinline__ void operator()(const f32x4 (&acc)[2][2][4][2], const Unit& u, int wr, int wc, int fr, int fq) const {
        const int col0 = u.pn * BM + wc * 32 + 8 * fq;
        EPI_ROWS(
            _Pragma("unroll") for (int bj = 0; bj < 2; ++bj) {
                const u32x4 gw = *(const u32x4*)(gate + (size_t)row * 2048 + 1024 + col0 + bj * HALF);
                const bf16_t* mp = merged + (size_t)row * 1024 + col0 + bj * HALF;
                const u32x4 mw = *(const u32x4*)mp;
                f32x4 v0 = acc[ai][bj][m][0] * (F8 ? W8_INV : 1.0f), v1 = acc[ai][bj][m][1] * (F8 ? W8_INV : 1.0f);
                v0[0] = v0[0] * bf_lo(gw.x) + bf_lo(mw.x); v0[1] = v0[1] * bf_hi(gw.x) + bf_hi(mw.x); v0[2] = v0[2] * bf_lo(gw.y) + bf_lo(mw.y); v0[3] = v0[3] * bf_hi(gw.y) + bf_hi(mw.y);
                v1[0] = v1[0] * bf_lo(gw.z) + bf_lo(mw.z); v1[1] = v1[1] * bf_hi(gw.z) + bf_hi(mw.z); v1[2] = v1[2] * bf_lo(gw.w) + bf_lo(mw.w); v1[3] = v1[3] * bf_hi(gw.w) + bf_hi(mw.w);
                *(u32x2*)(m8 + (size_t)row * 1024 + col0 + bj * HALF) = pack8_f8(v0, v1);
            }
        )
    }
};
struct EpiOut {
    __device__ __forceinline__ int nst(const Unit&) const { return 32; }
    const float* xin; float* xout; const float* g1;
    __device__ __forceinline__ void operator()(const f32x4 (&acc)[2][2][4][2], const Unit& u, int wr, int wc, int fr, int fq) const {
        const int col0 = u.pn * BM + wc * 32 + 8 * fq; const int b = (u.pm * BM) >> 12;
        f32x4 gv[2][2];
#pragma unroll
        for (int bj = 0; bj < 2; ++bj)
#pragma unroll
            for (int n = 0; n < 2; ++n) gv[bj][n] = *(const f32x4*)(g1 + (size_t)b * 6144 + col0 + bj * HALF + 4 * n);
        EPI_ROWS(
            _Pragma("unroll") for (int bj = 0; bj < 2; ++bj) {
                const size_t off = (size_t)row * 1024 + col0 + bj * HALF;
                const f32x4 x0 = *(const f32x4*)(xin + off), x1 = *(const f32x4*)(xin + off + 4);
                *(f32x4*)(xout + off) = x0 + gv[bj][0] * (acc[ai][bj][m][0] * W8_INV); *(f32x4*)(xout + off + 4) = x1 + gv[bj][1] * (acc[ai][bj][m][1] * W8_INV);
            }
        )
    }
};
struct EpiGU {
    const float* bgu; bf16_t* act;
    __device__ __forceinline__ void operator()(const f32x4 (&acc)[2][2][4][2], const Unit& u, int wr, int wc, int fr, int fq) const {
        const int e = u.pn >> 3, pl = u.pn & 7; const int c0 = pl * 128 + wc * 32 + 8 * fq;
        const float* bp = bgu + (size_t)e * 2048 + c0;
        const f32x4 bg0 = *(const f32x4*)bp, bg1 = *(const f32x4*)(bp + 4), bl0 = *(const f32x4*)(bp + 1024), bl1 = *(const f32x4*)(bp + 1028);
        EPI_ROWS(
            f32x4 o[2];
            _Pragma("unroll") for (int n = 0; n < 2; ++n) {
                const f32x4 gl = acc[ai][0][m][n] + (n == 0 ? bg0 : bg1); const f32x4 ln = acc[ai][1][m][n] + (n == 0 ? bl0 : bl1);
                _Pragma("unroll") for (int j = 0; j < 4; ++j) { const float xg = fminf(gl[j], 7.0f); const float xl = fminf(fmaxf(ln[j], -7.0f), 7.0f); o[n][j] = xg * sigmoid_f(1.702f * xg) * (xl + 1.0f); }
            }
            *(u32x4*)(act + (size_t)row * 1024 + c0) = pack8(o[0], o[1]);
        )
    }
};
struct EpiGU8 {
    __device__ __forceinline__ int nst(const Unit&) const { return 8; }
    const float* bgu; unsigned char* act;
    __device__ __forceinline__ void operator()(const f32x4 (&acc)[2][2][4][2], const Unit& u, int wr, int wc, int fr, int fq) const {
        const int e = u.pn >> 3, pl = u.pn & 7; const int c0 = pl * 128 + wc * 32 + 8 * fq;
        const float* bp = bgu + (size_t)e * 2048 + c0;
        const f32x4 bg0 = *(const f32x4*)bp, bg1 = *(const f32x4*)(bp + 4), bl0 = *(const f32x4*)(bp + 1024), bl1 = *(const f32x4*)(bp + 1028);
        EPI_ROWS(
            f32x4 o[2];
            _Pragma("unroll") for (int n = 0; n < 2; ++n) {
                const f32x4 gl = acc[ai][0][m][n] * W8_INV + (n == 0 ? bg0 : bg1); const f32x4 ln = acc[ai][1][m][n] * W8_INV + (n == 0 ? bl0 : bl1);
                _Pragma("unroll") for (int j = 0; j < 4; ++j) { const float xg = fminf(gl[j], 7.0f); const float xl = fminf(fmaxf(ln[j], -7.0f), 7.0f); o[n][j] = xg * sigmoid_f(1.702f * xg) * (xl + 1.0f); }
            }
            *(u32x2*)(act + (size_t)row * 1024 + c0) = pack8_f8(o[0], o[1]);
        )
    }
};
struct EpiDN8 {
    __device__ __forceinline__ int nst(const Unit&) const { return 16; }
    const float* bdn; const float* roww; unsigned char* y;
    __device__ __forceinline__ void operator()(const f32x4 (&acc)[2][2][4][2], const Unit& u, int wr, int wc, int fr, int fq) const {
        const int e = u.pn >> 2, pl = u.pn & 3; const int col0 = pl * BM + wc * 32 + 8 * fq;
        f32x4 bv[2][2];
#pragma unroll
        for (int bj = 0; bj < 2; ++bj)
#pragma unroll
            for (int n = 0; n < 2; ++n) bv[bj][n] = *(const f32x4*)(bdn + (size_t)e * 1024 + col0 + bj * HALF + 4 * n);
        EPI_ROWS(
            const float w = roww[row];
            _Pragma("unroll") for (int bj = 0; bj < 2; ++bj)
                *(u32x2*)(y + (size_t)row * 1024 + col0 + bj * HALF) = pack8_f8((acc[ai][bj][m][0] * W8_INV + bv[bj][0]) * w, (acc[ai][bj][m][1] * W8_INV + bv[bj][1]) * w);
        )
    }
};
struct EpiDN {
    const float* bdn; const float* roww; bf16_t* y;
    __device__ __forceinline__ void operator()(const f32x4 (&acc)[2][2][4][2], const Unit& u, int wr, int wc, int fr, int fq) const {
        const int e = u.pn >> 2, pl = u.pn & 3; const int col0 = pl * BM + wc * 32 + 8 * fq;
        f32x4 bv[2][2];
#pragma unroll
        for (int bj = 0; bj < 2; ++bj)
#pragma unroll
            for (int n = 0; n < 2; ++n) bv[bj][n] = *(const f32x4*)(bdn + (size_t)e * 1024 + col0 + bj * HALF + 4 * n);
        EPI_ROWS(
            const float w = roww[row];
            _Pragma("unroll") for (int bj = 0; bj < 2; ++bj)
                *(u32x4*)(y + (size_t)row * 1024 + col0 + bj * HALF) = pack8((acc[ai][bj][m][0] + bv[bj][0]) * w, (acc[ai][bj][m][1] + bv[bj][1]) * w);
        )
    }
};
}

namespace attn_body {
using bf16 = __hip_bfloat16;
using bf16x8 = __attribute__((ext_vector_type(8))) short;
using s16x4 = __attribute__((ext_vector_type(4))) short;
using f32x16 = __attribute__((ext_vector_type(16))) float;
using u32x4 = __attribute__((ext_vector_type(4))) unsigned;
constexpr int D = 64, NW = 8, QBLK = 32, QB = QBLK * NW, KVBLK = 64;
__device__ __forceinline__ int crow(int r, int hi) { return (r & 3) + 8 * (r >> 2) + 4 * hi; }
#define SBAR() __builtin_amdgcn_sched_barrier(0)
constexpr int NSLOT = 3, SLOTB = 8192;
constexpr int LDS_K = 0, LDS_V = NSLOT * SLOTB, LDS_WS = 2 * NSLOT * SLOTB, LDS_OST = LDS_WS + NW * 64 * 4, LDS_LUT = LDS_OST + NW * 4096, LUT_N = 768, LDS_BYTES = LDS_LUT + LUT_N * 4;
constexpr bool OB_F8 = true;
constexpr float MFLOOR = -1024.0f;
__device__ __forceinline__ void glds16(const void* gsrc, unsigned lds_dst) { unsigned keep;
  asm volatile("s_mov_b32 %0, m0\n\ts_mov_b32 m0, %2\n\ts_nop 0\n\tglobal_load_lds_dwordx4 %1, off\n\ts_mov_b32 m0, %0" : "=&s"(keep) : "v"(gsrc), "s"(lds_dst) : "memory"); }
__device__ __forceinline__ float max3f(float a, float b, float c) { float r; asm("v_max3_f32 %0, %1, %2, %3" : "=v"(r) : "v"(a), "v"(b), "v"(c)); return r; }
__device__ __forceinline__ float max2f(float a, float b) { float r; asm("v_max_f32_e32 %0, %1, %2" : "=v"(r) : "v"(a), "v"(b)); return r; }
__device__ __forceinline__ float fadd_s(float a, float b) { float r; asm("v_add_f32_e32 %0, %1, %2" : "=v"(r) : "v"(a), "v"(b)); return r; }
__device__ __forceinline__ float fsub_s(float a, float b) { float r; asm("v_sub_f32_e32 %0, %1, %2" : "=v"(r) : "v"(a), "v"(b)); return r; }
typedef float f32x2_t __attribute__((ext_vector_type(2))); typedef __bf16 bf16x2_t __attribute__((ext_vector_type(2)));
__device__ __forceinline__ unsigned cvtpk_s(float lo, float hi) { f32x2_t v = {lo, hi}; bf16x2_t b = __builtin_convertvector(v, bf16x2_t); return __builtin_bit_cast(unsigned, b); }
#define WAIT_BAR(N) asm volatile("s_waitcnt vmcnt(" #N ") lgkmcnt(0)\n\ts_barrier" ::: "memory")

__device__ __forceinline__ void qkt(f32x16& p0, f32x16& p1, const char* Kslot, const bf16x8* qr, const f32x16& negm, int r32, int hi) {
  const char* kb = Kslot + hi * 1024 + r32 * 16;
  #pragma unroll
  for (int d0 = 0; d0 < 4; ++d0) {
    const bf16x8 b0 = *reinterpret_cast<const bf16x8*>(kb + d0 * 2048);
    const bf16x8 b1 = *reinterpret_cast<const bf16x8*>(kb + d0 * 2048 + 512);
    if (d0 == 0) { p0 = __builtin_amdgcn_mfma_f32_32x32x16_bf16(b0, qr[0], negm, 0, 0, 0); p1 = __builtin_amdgcn_mfma_f32_32x32x16_bf16(b1, qr[0], negm, 0, 0, 0); }
    else { p0 = __builtin_amdgcn_mfma_f32_32x32x16_bf16(b0, qr[d0], p0, 0, 0, 0); p1 = __builtin_amdgcn_mfma_f32_32x32x16_bf16(b1, qr[d0], p1, 0, 0, 0); } }
}
typedef __attribute__((address_space(3))) const char* lds_cptr;
typedef short v4i16_t __attribute__((ext_vector_type(4)));
__device__ __forceinline__ void kload8(bf16x8* kf, lds_cptr kp) {
  kf[0] = *(const __attribute__((address_space(3))) bf16x8*)(kp);        kf[1] = *(const __attribute__((address_space(3))) bf16x8*)(kp + 512);
  kf[2] = *(const __attribute__((address_space(3))) bf16x8*)(kp + 2048); kf[3] = *(const __attribute__((address_space(3))) bf16x8*)(kp + 2560);
  kf[4] = *(const __attribute__((address_space(3))) bf16x8*)(kp + 4096); kf[5] = *(const __attribute__((address_space(3))) bf16x8*)(kp + 4608);
  kf[6] = *(const __attribute__((address_space(3))) bf16x8*)(kp + 6144); kf[7] = *(const __attribute__((address_space(3))) bf16x8*)(kp + 6656);
}
__device__ __forceinline__ void kload2(bf16x8* kf, lds_cptr kp, int j) { kf[2 * j] = *(const __attribute__((address_space(3))) bf16x8*)(kp + j * 2048); kf[2 * j + 1] = *(const __attribute__((address_space(3))) bf16x8*)(kp + j * 2048 + 512); }
__device__ __forceinline__ s16x4 vtr(lds_cptr p) { return __builtin_bit_cast(s16x4, __builtin_amdgcn_ds_read_tr16_b64_v4i16((__attribute__((address_space(3))) v4i16_t*)p)); }
__device__ __forceinline__ float rowmax(const f32x16& p0, const f32x16& p1) {
  float a = max3f(p0[0], p0[1], p1[0]), b = max3f(p0[2], p0[3], p1[1]); a = max3f(a, p1[2], p1[3]);
  #pragma unroll
  for (int r = 4; r < 16; r += 4) { a = max3f(a, p0[r], p0[r + 1]); b = max3f(b, p0[r + 2], p0[r + 3]); a = max3f(a, p1[r], p1[r + 1]); b = max3f(b, p1[r + 2], p1[r + 3]); }
  const float m = max2f(a, b);
  auto rr = __builtin_amdgcn_permlane32_swap(__float_as_uint(m), __float_as_uint(m), false, false);
  return max2f(__uint_as_float(rr[0]), __uint_as_float(rr[1]));
}
__device__ __forceinline__ void pv(f32x16* o, int vb, bf16x8 pa0, bf16x8 pa1, bf16x8 pa2, bf16x8 pa3) {
  #pragma unroll
  for (int d0 = 0; d0 < 2; ++d0) { s16x4 lo[4], hi[4];
    #pragma unroll
    for (int ks = 0; ks < 4; ++ks) {
      asm volatile("ds_read_b64_tr_b16 %0,%1 offset:%c2" : "=&v"(lo[ks]) : "v"(vb), "i"(d0 * 4096 + ks * 1024) : "memory");
      asm volatile("ds_read_b64_tr_b16 %0,%1 offset:%c2" : "=&v"(hi[ks]) : "v"(vb), "i"(d0 * 4096 + ks * 1024 + 512) : "memory"); }
    asm volatile("s_waitcnt lgkmcnt(0)" ::: "memory"); SBAR();
    #define PK(k) (bf16x8){lo[k][0], lo[k][1], lo[k][2], lo[k][3], hi[k][0], hi[k][1], hi[k][2], hi[k][3]}
    o[d0] = __builtin_amdgcn_mfma_f32_32x32x16_bf16(pa0, PK(0), o[d0], 0, 0, 0);
    o[d0] = __builtin_amdgcn_mfma_f32_32x32x16_bf16(pa1, PK(1), o[d0], 0, 0, 0);
    o[d0] = __builtin_amdgcn_mfma_f32_32x32x16_bf16(pa2, PK(2), o[d0], 0, 0, 0);
    o[d0] = __builtin_amdgcn_mfma_f32_32x32x16_bf16(pa3, PK(3), o[d0], 0, 0, 0);
    #undef PK
  }
}
struct Job { const bf16* Q; const bf16* K; const bf16* V; bf16* O; float* lse; const float* lutg; int NT, i0, kq0, dsh, cls; };
template <int MODE, int THRL, bool NOMAX = false> __device__ __forceinline__ void attn_unit(const Job& J, char* shm, const int wid_in) {
  int wid = wid_in; asm volatile("" : "+s"(wid));
  constexpr int QP = MODE == 0 ? 1024 : 256, KP = 256;
  const int lane = lane_id_asm(), tid = wid * 64 + lane, r32 = lane & 31, hi = lane >> 5;
  const bf16* Qw = J.Q + (long)(wid * QBLK) * QP;
  const bf16* Kh = J.K; const bf16* Vh = J.V;
  const unsigned lds0 = (unsigned)(uintptr_t)shm;
  float* wsf = (float*)(shm + LDS_WS) + wid * 64;
  const bf16* ksrc = Kh + (long)lane * KP + wid * 8;
  const bf16* vsrc = Vh + (long)(16 * (wid & 3) + (lane >> 2)) * KP + (wid >> 2) * 32 + (lane & 3) * 8;
  const unsigned kdst = lds0 + LDS_K + wid * 1024, vdst = lds0 + LDS_V + wid * 1024;
  #define DMA_K(t, slot) glds16(ksrc + (long)(t) * KVBLK * KP, (unsigned)__builtin_amdgcn_readfirstlane(kdst + (slot)))
  #define DMA_V(t, slot) glds16(vsrc + (long)(t) * KVBLK * KP, (unsigned)__builtin_amdgcn_readfirstlane(vdst + (slot)))
  const int vb0 = (int)(lds0 + LDS_V) + ((lane >> 4) & 1) * 32 + (lane & 3) * 8 + (4 * hi + ((lane & 15) >> 2)) * 64;
  const char* Kbase = shm + LDS_K; bf16x8 kf[8];
  const lds_cptr shm3 = (lds_cptr)shm; const lds_cptr kp0 = shm3 + LDS_K + hi * 1024 + r32 * 16; const lds_cptr vp0 = shm3 + LDS_V + ((lane >> 4) & 1) * 32 + (lane & 3) * 8 + (4 * hi + ((lane & 15) >> 2)) * 64;
  const int NT = J.NT;
  if (MODE == 1) {
    __attribute__((address_space(3))) float* lut = (__attribute__((address_space(3))) float*)(shm3 + LDS_LUT);
    lut[tid] = J.lutg[tid]; if (tid < LUT_N - 512) lut[512 + tid] = J.lutg[512 + tid];
  }
  DMA_K(0, 0); DMA_V(0, 0); DMA_K(1, SLOTB);
  bf16x8 qr[4];
  #pragma unroll
  for (int d0 = 0; d0 < 4; ++d0) qr[d0] = *reinterpret_cast<const bf16x8*>(&Qw[(long)r32 * QP + d0 * 16 + hi * 8]);
  float mhat = 0.f, l_reg = 0.f; f32x16 o[2]; o[0] = f32x16{}; o[1] = f32x16{}; f32x16 negm = f32x16{}; if (!NOMAX) asm volatile("" : "+v"(negm));
  const int qrel = wid * QBLK + r32;
  const __attribute__((address_space(3))) float* lutq = (const __attribute__((address_space(3))) float*)(shm3 + LDS_LUT) + (J.kq0 - qrel + 383 + 4 * hi);
  #define CMASK(P0, P1, t) do { if (MODE == 1) { const __attribute__((address_space(3))) float* lp_ = lutq + 64 * (t); \
      _Pragma("unroll") for (int r = 0; r < 16; ++r) { const int ko_ = (r & 3) + 8 * (r >> 2); P0[r] += lp_[ko_]; P1[r] += lp_[ko_ + 32]; } } } while (0)
  bool resc = false;
  #define START(P0, P1) do { resc = false; if (!NOMAX) { const float rm = rowmax(P0, P1); \
    const float dl = MODE == 1 ? max2f(rm, MFLOOR) : rm; mhat = fadd_s(mhat, dl); \
      _Pragma("unroll") for (int r = 0; r < 16; ++r) { P0[r] = fsub_s(P0[r], dl); P1[r] = fsub_s(P1[r], dl); } \
      _Pragma("unroll") for (int r = 0; r < 16; ++r) negm[r] = -mhat; asm volatile("" : "+v"(negm)); } \
    _Pragma("unroll") for (int r = 0; r < 16; ++r) P0[r] = __builtin_amdgcn_exp2f(P0[r]); } while (0)
  #define RESC() do { if (resc) { asm volatile("s_waitcnt lgkmcnt(0)" ::: "memory"); \
      _Pragma("unroll") for (int d_ = 0; d_ < 2; ++d_) _Pragma("unroll") for (int r = 0; r < 16; ++r) o[d_][r] *= wsf[crow(r, hi)]; } } while (0)
  f32x16 pA0, pA1, pB0, pB1;
  int sl_prev = 0, sl_cur = 0, sl_next = SLOTB;
  #define ROT() do { sl_prev = sl_cur; sl_cur = sl_next; sl_next = (sl_next == (NSLOT - 1) * SLOTB) ? 0 : sl_next + SLOTB; } while (0)
  DMA_K(2, 2 * SLOTB);
  WAIT_BAR(3);
  qkt(pA0, pA1, Kbase, qr, negm, r32, hi); asm volatile("s_nop 15\n\ts_nop 7" : "+v"(pA0), "+v"(pA1)); CMASK(pA0, pA1, 0);
  START(pA0, pA1);
  _Pragma("unroll") for (int r = 0; r < 16; ++r) pA1[r] = __builtin_amdgcn_exp2f(pA1[r]);
  WAIT_BAR(0);
  DMA_K(3, 0); DMA_V(1, SLOTB);
  ROT();
  kload8(kf, kp0 + sl_cur);
  WAIT_BAR(2);
  s16x4 vlo[8], vhi[8]; u32x4 pw0, pw1, pw2, pw3;
  #define PKW(P, B) cvtpk_s(P[B], P[B + 1])
  #define PAF(k) __builtin_bit_cast(bf16x8, pw##k)
  #define VFR(i) (bf16x8){vlo[i][0], vlo[i][1], vlo[i][2], vlo[i][3], vhi[i][0], vhi[i][1], vhi[i][2], vhi[i][3]}
  #define PIN(x) asm volatile("" : "+v"(x))
  #define MX3(a, b, c) __builtin_fmaxf(__builtin_fmaxf((a), (b)), (c))
  #define GAPA(MF, A0, A1, A2, A3, W0, W1, PW) do { MF; sacc += A0; sacc += A1; sacc += A2; sacc += A3; PIN(sacc); W0; W1; PIN(PW); SBAR(); } while (0)
  #define EX(v) __builtin_amdgcn_exp2f(v)
  #define GAPB(MF, X, B) do { MF; X[B] = EX(X[B]); X[B + 1] = EX(X[B + 1]); X[B + 2] = EX(X[B + 2]); X[B + 3] = EX(X[B + 3]); PIN(X); SBAR(); } while (0)
  #define VRD(i) do { vlo[i] = vtr(vp_ + (((i) >> 2) * 4096 + ((i) & 3) * 1024)); vhi[i] = vtr(vp_ + (((i) >> 2) * 4096 + ((i) & 3) * 1024 + 512)); } while (0)
  #define KRD(G, j) do { if (G) { kload2(kf, kp0 + sl_next, j); SBAR(); } } while (0)
  #define STEP(C0, C1, P0, P1, t, GK, GV, GL) do { SBAR(); \
    const lds_cptr vp_ = vp0 + sl_prev; \
    VRD(0); SBAR(); float sacc = (P0[0] + P0[1]); \
    GAPA(C0 = __builtin_amdgcn_mfma_f32_32x32x16_bf16(kf[0], qr[0], negm, 0, 0, 0), P0[2], P0[3], P0[4], P0[5],     pw0[0] = PKW(P0, 0), pw0[1] = PKW(P0, 2), pw0); \
    VRD(4); SBAR(); GAPA(C1 = __builtin_amdgcn_mfma_f32_32x32x16_bf16(kf[1], qr[0], negm, 0, 0, 0), P0[6], P0[7], P0[8], P0[9],     pw0[2] = PKW(P0, 4), pw0[3] = PKW(P0, 6), pw0); \
    VRD(1); SBAR(); GAPA(C0 = __builtin_amdgcn_mfma_f32_32x32x16_bf16(kf[2], qr[1], C0, 0, 0, 0),   P0[10], P0[11], P0[12], P0[13], pw1[0] = PKW(P0, 8), pw1[1] = PKW(P0, 10), pw1); \
    VRD(5); SBAR(); GAPA(C1 = __builtin_amdgcn_mfma_f32_32x32x16_bf16(kf[3], qr[1], C1, 0, 0, 0),   P0[14], P0[15], P1[0], P1[1],   pw1[2] = PKW(P0, 12), pw1[3] = PKW(P0, 14), pw1); \
    VRD(2); SBAR(); GAPA(C0 = __builtin_amdgcn_mfma_f32_32x32x16_bf16(kf[4], qr[2], C0, 0, 0, 0),   P1[2], P1[3], P1[4], P1[5],     pw2[0] = PKW(P1, 0), pw2[1] = PKW(P1, 2), pw2); \
    VRD(6); SBAR(); GAPA(C1 = __builtin_amdgcn_mfma_f32_32x32x16_bf16(kf[5], qr[2], C1, 0, 0, 0),   P1[6], P1[7], P1[8], P1[9],     pw2[2] = PKW(P1, 4), pw2[3] = PKW(P1, 6), pw2); \
    VRD(3); SBAR(); GAPA(C0 = __builtin_amdgcn_mfma_f32_32x32x16_bf16(kf[6], qr[3], C0, 0, 0, 0),   P1[10], P1[11], P1[12], P1[13], pw3[0] = PKW(P1, 8), pw3[1] = PKW(P1, 10), pw3); \
    VRD(7); SBAR(); GAPA(C1 = __builtin_amdgcn_mfma_f32_32x32x16_bf16(kf[7], qr[3], C1, 0, 0, 0),   P1[14], P1[15], 0.f, 0.f,       pw3[2] = PKW(P1, 12), pw3[3] = PKW(P1, 14), pw3); \
    l_reg += sacc; \
    if (GK) { DMA_K((t) + 3, sl_cur); } if (GV) { DMA_V((t) + 1, sl_next); } \
    CMASK(C0, C1, t); \
    if (!NOMAX) { float a = MX3(C0[0], C0[1], C1[0]), b = MX3(C0[2], C0[3], C1[1]); a = MX3(a, C1[2], C1[3]); \
      _Pragma("unroll") for (int r = 4; r < 16; r += 4) { a = MX3(a, C0[r], C0[r + 1]); b = MX3(b, C0[r + 2], C0[r + 3]); a = MX3(a, C1[r], C1[r + 1]); b = MX3(b, C1[r + 2], C1[r + 3]); } \
      float rm = __builtin_fmaxf(a, b); { auto rr = __builtin_amdgcn_permlane32_swap(__float_as_uint(rm), __float_as_uint(rm), false, false); rm = __builtin_fmaxf(__uint_as_float(rr[0]), __uint_as_float(rr[1])); } \
      resc = false; \
      if (__builtin_expect(__any(rm > (float)THRL), 0)) { const float dl = __builtin_fmaxf(rm, 0.f); mhat += dl; \
        _Pragma("unroll") for (int r = 0; r < 16; ++r) { C0[r] -= dl; C1[r] -= dl; } \
        _Pragma("unroll") for (int r = 0; r < 16; ++r) negm[r] = -mhat; asm volatile("" : "+v"(negm)); \
        const float f = __builtin_amdgcn_exp2f(-dl); l_reg *= f; if (hi == 0) wsf[r32] = f; resc = true; } } \
    SBAR(); \
    GAPB(o[0] = __builtin_amdgcn_mfma_f32_32x32x16_bf16(PAF(0), VFR(0), o[0], 0, 0, 0), C0, 0); \
    GAPB(o[1] = __builtin_amdgcn_mfma_f32_32x32x16_bf16(PAF(0), VFR(4), o[1], 0, 0, 0), C0, 4); \
    KRD(GL, 0); GAPB(o[0] = __builtin_amdgcn_mfma_f32_32x32x16_bf16(PAF(1), VFR(1), o[0], 0, 0, 0), C0, 8); \
    KRD(GL, 1); GAPB(o[1] = __builtin_amdgcn_mfma_f32_32x32x16_bf16(PAF(1), VFR(5), o[1], 0, 0, 0), C0, 12); \
    KRD(GL, 2); GAPB(o[0] = __builtin_amdgcn_mfma_f32_32x32x16_bf16(PAF(2), VFR(2), o[0], 0, 0, 0), C1, 0); \
    KRD(GL, 3); GAPB(o[1] = __builtin_amdgcn_mfma_f32_32x32x16_bf16(PAF(2), VFR(6), o[1], 0, 0, 0), C1, 4); \
    GAPB(o[0] = __builtin_amdgcn_mfma_f32_32x32x16_bf16(PAF(3), VFR(3), o[0], 0, 0, 0), C1, 8); \
    GAPB(o[1] = __builtin_amdgcn_mfma_f32_32x32x16_bf16(PAF(3), VFR(7), o[1], 0, 0, 0), C1, 12); \
    } while (0)
  int t = 1;
  for (; t + 5 < NT; t += 2) {
    STEP(pB0, pB1, pA0, pA1, t, true, true, true);     WAIT_BAR(2); RESC(); ROT();
    STEP(pA0, pA1, pB0, pB1, t + 1, true, true, true); WAIT_BAR(2); RESC(); ROT();
  }
  #define ENDW(tt) do { if ((tt) + 3 < NT) { WAIT_BAR(2); } else if ((tt) + 2 < NT) { WAIT_BAR(1); } else { WAIT_BAR(0); } } while (0)
  for (; t + 1 < NT; t += 2) {
    STEP(pB0, pB1, pA0, pA1, t, (t + 3 < NT), (t + 1 < NT), (t + 1 < NT));       ENDW(t);     RESC(); ROT();
    STEP(pA0, pA1, pB0, pB1, t + 1, (t + 4 < NT), (t + 2 < NT), (t + 2 < NT));   ENDW(t + 1); RESC(); ROT();
  }
  STEP(pB0, pB1, pA0, pA1, NT - 1, false, false, false); RESC();
  { float sacc = pB0[0] + pB0[1]; _Pragma("unroll") for (int r = 2; r < 16; ++r) sacc += pB0[r]; _Pragma("unroll") for (int r = 0; r < 16; ++r) sacc += pB1[r]; l_reg += sacc;
    pw0 = (u32x4){PKW(pB0, 0), PKW(pB0, 2), PKW(pB0, 4), PKW(pB0, 6)}; pw1 = (u32x4){PKW(pB0, 8), PKW(pB0, 10), PKW(pB0, 12), PKW(pB0, 14)}; pw2 = (u32x4){PKW(pB1, 0), PKW(pB1, 2), PKW(pB1, 4), PKW(pB1, 6)}; pw3 = (u32x4){PKW(pB1, 8), PKW(pB1, 10), PKW(pB1, 12), PKW(pB1, 14)};
    SBAR(); pv(o, vb0 + sl_cur, PAF(0), PAF(1), PAF(2), PAF(3)); }
  #undef PKW
  #undef PAF
  #undef VFR
  #undef PIN
  #undef MX3
  #undef GAPA
  #undef GAPB
  #undef EX
  #undef VRD
  #undef KRD
  #undef STEP
  #undef ENDW
  { auto rr = __builtin_amdgcn_permlane32_swap(__float_as_uint(l_reg), __float_as_uint(l_reg), false, false); l_reg = __uint_as_float(rr[0]) + __uint_as_float(rr[1]); }
  if (hi == 0) wsf[32 + r32] = l_reg; asm volatile("s_waitcnt lgkmcnt(0)" ::: "memory");
  float rli[16];
  #pragma unroll
  for (int r = 0; r < 16; ++r) rli[r] = __builtin_amdgcn_rcpf(wsf[32 + crow(r, hi)]);
  if (MODE == 0 && OB_F8) {
    unsigned char* stg8 = (unsigned char*)(shm + LDS_OST) + wid * 4096;
    #pragma unroll
    for (int r = 0; r < 16; ++r) { const int orow = crow(r, hi);
      #pragma unroll
      for (int d0 = 0; d0 < 2; ++d0) { const float ov = o[d0][r] * rli[r]; stg8[orow * 64 + d0 * 32 + r32] = (unsigned char)(__builtin_amdgcn_cvt_pk_fp8_f32(ov, ov, 0, false) & 0xff); } }
    asm volatile("s_waitcnt lgkmcnt(0)" ::: "memory");
    unsigned char* Ow = (unsigned char*)J.O + (long)(wid * QBLK) * 1024;
    #pragma unroll
    for (int i = 0; i < 2; ++i) { const int row = i * 16 + (lane >> 2), ch = lane & 3; const u32x4 v = *(const u32x4*)(stg8 + row * 64 + ch * 16); *(u32x4*)(Ow + (long)row * 1024 + ch * 16) = v; }
  } else {
    bf16* stg = (bf16*)(shm + LDS_OST) + wid * 2048;
    #pragma unroll
    for (int r = 0; r < 16; ++r) { const int orow = crow(r, hi);
      #pragma unroll
      for (int d0 = 0; d0 < 2; ++d0) stg[orow * 64 + d0 * 32 + r32] = __float2bfloat16(o[d0][r] * rli[r]); }
    asm volatile("s_waitcnt lgkmcnt(0)" ::: "memory");
    if (MODE == 0) {
      bf16* Ow = J.O + (long)(wid * QBLK) * 1024;
      #pragma unroll
      for (int i = 0; i < 4; ++i) { const int row = i * 8 + (lane >> 3), ch = lane & 7; const u32x4 v = *(const u32x4*)(stg + row * 64 + ch * 8); *(u32x4*)(Ow + (long)row * 1024 + ch * 8) = v; }
    } else {
      #pragma unroll
      for (int i = 0; i < 4; ++i) { const int row = i * 8 + (lane >> 3), ch = lane & 7; const u32x4 v = *(const u32x4*)(stg + row * 64 + ch * 8);
        const long tok = ((long)(J.i0 + wid * QBLK + row) << J.dsh) + J.cls; *(u32x4*)(J.O + tok * 256 + ch * 8) = v; }
      if (hi == 0) { const long tok = ((long)(J.i0 + qrel) << J.dsh) + J.cls; J.lse[tok * 4] = mhat + __builtin_amdgcn_logf(l_reg); }
    } }
  asm volatile("s_waitcnt lgkmcnt(0)\n\ts_barrier" ::: "memory");
  #undef DMA_K
  #undef DMA_V
  #undef CMASK
  #undef START
  #undef RESC
  #undef ROT
}
#undef SBAR
#undef WAIT_BAR
}


namespace attn8 {
typedef int i32x8 __attribute__((ext_vector_type(8)));
typedef int i32x4 __attribute__((ext_vector_type(4)));
typedef float f32x16 __attribute__((ext_vector_type(16)));
typedef unsigned u32x4 __attribute__((ext_vector_type(4)));
constexpr int SLOT = 4096, RING = 8, NSL = RING;
constexpr int L_K = 0, L_V = NSL * SLOT, L_WS = 2 * NSL * SLOT, L_OST = L_WS + 8 * 256, L_BYTES = L_OST + 8 * 4096;
struct Job { const unsigned char* Q; const unsigned char* K; const unsigned char* VT; unsigned char* O; };
__device__ __forceinline__ void glds16(const void* gsrc, unsigned lds_dst) { unsigned keep;
  asm volatile("s_mov_b32 %0, m0\n\ts_mov_b32 m0, %2\n\ts_nop 0\n\tglobal_load_lds_dwordx4 %1, off\n\ts_mov_b32 m0, %0" : "=&s"(keep) : "v"(gsrc), "s"(lds_dst) : "memory"); }
__device__ __forceinline__ int crow(int r, int hi) { return (r & 3) + 8 * (r >> 2) + 4 * hi; }
#define A8_WAITBAR(N) asm volatile("s_waitcnt vmcnt(" #N ") lgkmcnt(0)\n\ts_barrier" ::: "memory")
#define A8_WAITBAR_N(N) asm volatile("s_waitcnt vmcnt(%0) lgkmcnt(0)\n\ts_barrier" :: "n"(N) : "memory")
template <int NT> __device__ __forceinline__ void attn_unit_f8(const Job& J, char* shm, const int wid_in) {
  int wid = wid_in; asm volatile("" : "+s"(wid));
  const int lane = lane_id_asm(), r32 = lane & 31, hi = lane >> 5;
  const unsigned lds0 = (unsigned)(uintptr_t)shm;
  typedef __attribute__((address_space(3))) const char* lds_cptr;
  const lds_cptr shm3 = (lds_cptr)shm;
  const bool kwave = wid < 4;
  const int w4 = wid & 3; const int drow = 16 * w4 + (lane >> 2); const int cl = (lane & 3) ^ ((drow >> 2) & 3);
  const unsigned char* dsrc = kwave ? J.K + (long)drow * 256 + 16 * cl : J.VT + (long)drow * 4096 + 16 * cl;
  const long dstep = kwave ? 64 * 256 : 64;
  const unsigned ddst = lds0 + (kwave ? L_K : L_V) + w4 * 1024;
  #define A8_DMA(t, slot) glds16(dsrc + (long)(t) * dstep, (unsigned)__builtin_amdgcn_readfirstlane(ddst + (slot)))
  const int sw = (r32 >> 2) & 3; const int foff0 = r32 * 64 + 16 * ((2 * hi) ^ sw), foff1 = r32 * 64 + 16 * ((2 * hi + 1) ^ sw);
  #define A8_FRAG(base, half) __builtin_shufflevector(*(const __attribute__((address_space(3))) i32x4*)((base) + (half) * 2048 + foff0), *(const __attribute__((address_space(3))) i32x4*)((base) + (half) * 2048 + foff1), 0, 1, 2, 3, 4, 5, 6, 7)
  const unsigned char* qp = J.Q + (long)(wid * 32 + r32) * 1024 + 32 * hi;
  const i32x8 qf = __builtin_shufflevector(*(const i32x4*)qp, *(const i32x4*)(qp + 16), 0, 1, 2, 3, 4, 5, 6, 7);
  if (kwave) { _Pragma("unroll") for (int i = 0; i < RING; ++i) A8_DMA(i, i * SLOT); } else { _Pragma("unroll") for (int i = 0; i < RING - 2; ++i) A8_DMA(i, i * SLOT); }
  f32x16 o0 = f32x16{}, o1 = f32x16{}, o2 = f32x16{}; const f32x16 zero = f32x16{};
  i32x8 ones; _Pragma("unroll") for (int w = 0; w < 8; ++w) ones[w] = 0x38383838;
  asm volatile("" : "+v"(ones));
  f32x16 SA0, SA1, SB0, SB1; i32x8 PA, PB;
  A8_WAITBAR_N(RING - 1);
  { const i32x8 k0 = A8_FRAG(shm3 + L_K, 0), k1 = A8_FRAG(shm3 + L_K, 1);
    SA0 = __builtin_amdgcn_mfma_scale_f32_32x32x64_f8f6f4(k0, qf, zero, 0, 0, 0, 0, 0, 0); SA1 = __builtin_amdgcn_mfma_scale_f32_32x32x64_f8f6f4(k1, qf, zero, 0, 0, 0, 0, 0, 0); }
  #define A8_SB() __builtin_amdgcn_sched_barrier(0)
  #define A8_SLOTOF(i) ((((i) + RING) & (RING - 1)) * SLOT)
  #define A8_EXP8(X, B) do { _Pragma("unroll") for (int r = 0; r < 8; ++r) X[(B) + r] = __builtin_amdgcn_exp2f(X[(B) + r]); asm volatile("" : "+v"(X)); } while (0)
  #define A8_CVT4(P, WB, X) do { _Pragma("unroll") for (int w = 0; w < 4; ++w) { unsigned a_ = (unsigned)P[(WB) + w];     \
      a_ = __builtin_amdgcn_cvt_pk_bf8_f32(X[4 * w], X[4 * w + 1], a_, false); a_ = __builtin_amdgcn_cvt_pk_bf8_f32(X[4 * w + 2], X[4 * w + 3], a_, true); P[(WB) + w] = (int)a_; } asm volatile("" : "+v"(P)); } while (0)
  #define A8_STEP(C0, C1, N0, N1, PP, PN, t, WK, WV, DK, DV, QK, PV, EX) do { \
    if (kwave) { A8_WAITBAR_N(WK); } else { A8_WAITBAR_N(WV); } \
    if (kwave) { if (DK) A8_DMA((t) + RING, A8_SLOTOF(t)); } else { if (DV) A8_DMA((t) - 2 + RING, A8_SLOTOF((t) - 2)); } \
    i32x8 k0_ = ones, k1_ = ones, v0_ = ones, v1_ = ones; \
    if (QK) { k0_ = A8_FRAG(shm3 + L_K + A8_SLOTOF((t) + 1), 0); k1_ = A8_FRAG(shm3 + L_K + A8_SLOTOF((t) + 1), 1); } \
    if (PV) { v0_ = A8_FRAG(shm3 + L_V + A8_SLOTOF((t) - 1), 0); v1_ = A8_FRAG(shm3 + L_V + A8_SLOTOF((t) - 1), 1); } \
    A8_SB(); \
    if (EX) A8_EXP8(C0, 0); A8_SB(); \
    if (QK) N0 = __builtin_amdgcn_mfma_scale_f32_32x32x64_f8f6f4(k0_, qf, zero, 0, 0, 0, 0, 0, 0); if (EX) A8_EXP8(C0, 8); A8_SB(); \
    if (QK) N1 = __builtin_amdgcn_mfma_scale_f32_32x32x64_f8f6f4(k1_, qf, zero, 0, 0, 0, 0, 0, 0); if (EX) A8_EXP8(C1, 0); A8_SB(); \
    if (PV) o0 = __builtin_amdgcn_mfma_scale_f32_32x32x64_f8f6f4(PP, v0_, o0, 1, 0, 0, 0, 0, 0); if (EX) A8_EXP8(C1, 8); A8_SB(); \
    if (PV) o1 = __builtin_amdgcn_mfma_scale_f32_32x32x64_f8f6f4(PP, v1_, o1, 1, 0, 0, 0, 0, 0); if (EX) A8_CVT4(PN, 0, C0); A8_SB(); \
    if (PV) o2 = __builtin_amdgcn_mfma_scale_f32_32x32x64_f8f6f4(PP, ones, o2, 1, 0, 0, 0, 0, 0); if (EX) A8_CVT4(PN, 4, C1); A8_SB();     \
  } while (0)
  #define A8_EVEN(t, WK, WV, DK, DV, QK, PV, EX) A8_STEP(SA0, SA1, SB0, SB1, PB, PA, t, WK, WV, DK, DV, QK, PV, EX)
  #define A8_ODD(t, WK, WV, DK, DV, QK, PV, EX)  A8_STEP(SB0, SB1, SA0, SA1, PA, PB, t, WK, WV, DK, DV, QK, PV, EX)
  PA = ones; PB = ones;
  static_assert(RING == 8 && NT % 2 == 0 && NT >= 2 * RING, "the peeled tail below is written for RING = 8");
  A8_EVEN(0, 6, 6, true, true, true, false, true);
#pragma unroll 1
  for (int t = 1; t < NT - 9; t += 2) {
    A8_ODD(t, 6, 6, true, true, true, true, true);
    A8_EVEN(t + 1, 6, 6, true, true, true, true, true);
  }
  A8_ODD(NT - 9, 6, 6, true, true, true, true, true);
  A8_EVEN(NT - 8, 6, 6, false, true, true, true, true);
  A8_ODD(NT - 7, 5, 6, false, true, true, true, true);
  A8_EVEN(NT - 6, 4, 6, false, false, true, true, true);
  A8_ODD(NT - 5, 3, 5, false, false, true, true, true);
  A8_EVEN(NT - 4, 2, 4, false, false, true, true, true);
  A8_ODD(NT - 3, 1, 3, false, false, true, true, true);
  A8_EVEN(NT - 2, 0, 2, false, false, true, true, true);
  A8_ODD(NT - 1, 0, 1, false, false, false, true, true);
  A8_EVEN(NT, 0, 0, false, false, false, true, false);
  #undef A8_EVEN
  #undef A8_ODD
  #undef A8_STEP
  #undef A8_EXP8
  #undef A8_CVT4
  #undef A8_SB
  #undef A8_SLOTOF
  #undef A8_FRAG
  #undef A8_DMA
  float rli[16];
  #pragma unroll
  for (int r = 0; r < 16; ++r) rli[r] = __builtin_amdgcn_rcpf(o2[r]);
  unsigned char* stg8 = (unsigned char*)(shm + L_OST) + wid * 4096;
  #pragma unroll
  for (int r = 0; r < 16; ++r) { const int orow = crow(r, hi);
    const float a = o0[r] * rli[r], b = o1[r] * rli[r];
    stg8[orow * 64 + r32] = (unsigned char)(__builtin_amdgcn_cvt_pk_fp8_f32(a, a, 0, false) & 0xff); stg8[orow * 64 + 32 + r32] = (unsigned char)(__builtin_amdgcn_cvt_pk_fp8_f32(b, b, 0, false) & 0xff); }
  asm volatile("s_waitcnt lgkmcnt(0)" ::: "memory");
  unsigned char* Ow = J.O + (long)(wid * 32) * 1024;
  #pragma unroll
  for (int i = 0; i < 2; ++i) { const int row = i * 16 + (lane >> 2), ch = lane & 3; const u32x4 v = *(const u32x4*)(stg8 + row * 64 + ch * 16); *(u32x4*)(Ow + (long)row * 1024 + ch * 16) = v; }
  asm volatile("s_waitcnt lgkmcnt(0)\n\ts_barrier" ::: "memory");
}
#undef A8_WAITBAR
#undef A8_WAITBAR_N
}

constexpr size_t MiB = 1u << 20;
constexpr size_t WS_CTL = 0, CTL_ZERO_BYTES = 1 * MiB;
constexpr size_t WS_MOD = 1 * MiB;
constexpr size_t WS_ROPE = WS_MOD + 512 * 1024;
constexpr size_t WS_BLUT = WS_ROPE + 8192;
constexpr size_t WS_RC0 = WS_BLUT + 12 * 768 * 4;
constexpr size_t WS_HIST = WS_RC0 + 4096;
constexpr size_t WS_TILEE = WS_HIST + 32768;
constexpr size_t WS_TOPE = 2 * MiB;
constexpr size_t WS_TOPW = WS_TOPE + 512 * 1024;
constexpr size_t WS_SLOT = WS_TOPW + 512 * 1024;
constexpr size_t WS_ROWW = WS_SLOT + 512 * 1024;
constexpr size_t WS_LSE = 5 * MiB;
constexpr size_t WS_WRHI = 7 * MiB;
constexpr size_t WS_WRLO = 8 * MiB;
constexpr size_t WS_WIN = 9 * MiB;
constexpr size_t WS_WBRA = 32 * MiB;
constexpr size_t WS_WBRB = 33 * MiB;
constexpr size_t WS_WOUT = 37 * MiB;
constexpr size_t WS_WGU = 41 * MiB;
constexpr size_t WS_WDN = 297 * MiB;
constexpr size_t WS_X = 425 * MiB;
constexpr size_t WS_H = 553 * MiB;
constexpr size_t WS_R = 617 * MiB;
constexpr size_t WS_AQKV = WS_R;
constexpr size_t WS_QB = WS_R + 144 * MiB;
constexpr size_t WS_KB = WS_R + 208 * MiB;
constexpr size_t WS_VB = WS_R + 224 * MiB;
constexpr size_t WS_GATE = WS_R + 240 * MiB;
constexpr size_t WS_OAG = WS_R + 368 * MiB;
constexpr size_t WS_OA = WS_R + 416 * MiB;
constexpr size_t WS_MERGED = WS_R + 432 * MiB;
constexpr size_t WS_XS = WS_R;
constexpr size_t WS_ACT = WS_R + 136 * MiB;
constexpr size_t WS_Y = WS_R + 272 * MiB;
constexpr size_t WS_OB = WS_R + 496 * MiB;
constexpr size_t WS_M8 = WS_R + 560 * MiB;
constexpr size_t WS_END = WS_R + 592 * MiB;
constexpr int CW_BAR = 4096;

constexpr int RING_BYTES = 133120;
constexpr int LDSCTL_OFF = RING_BYTES;
constexpr int LDS_BYTES = 147456;
constexpr int NWAVES = 8;

#define GAS __attribute__((address_space(1)))
#define LAS __attribute__((address_space(3)))
typedef unsigned short bf16;
typedef unsigned v4u __attribute__((ext_vector_type(4)));
typedef unsigned v2u __attribute__((ext_vector_type(2)));
typedef float f32x4 __attribute__((ext_vector_type(4)));
typedef float f32x16 __attribute__((ext_vector_type(16)));
typedef int i32x4 __attribute__((ext_vector_type(4)));
typedef short bf16x8 __attribute__((ext_vector_type(8)));
typedef GAS unsigned gu32;
#define RLX_AGENT __ATOMIC_RELAXED, __HIP_MEMORY_SCOPE_AGENT
#define LDS_WAIT() asm volatile("s_waitcnt lgkmcnt(0)" ::: "memory")
__device__ __forceinline__ unsigned f2bf(float f) { unsigned u = __builtin_bit_cast(unsigned, f); return (u + 0x7fffu + ((u >> 16) & 1u)) >> 16; }
__device__ __forceinline__ unsigned pk2(float lo, float hi) { return f2bf(lo) | (f2bf(hi) << 16); }
__device__ __forceinline__ float bfl(unsigned w) { return __uint_as_float(w << 16); }
__device__ __forceinline__ float bfh(unsigned w) { return __uint_as_float(w & 0xffff0000u); }

#define XB_TMO      128
#define XB_XCNT(j)  (256  + 64 * (j))
#define XB_XSUB(j)  (1280 + 64 * (j))
#define XB_XGEN(j)  (2304 + 64 * (j))
#define XB_TOP      3328
#define XB_TOPGEN   3392
#define XCD_BAR_WORDS 3456
#define XB_SPIN_CAP (1u << 18)
__device__ __forceinline__ unsigned xb_ld(unsigned* p)              { return __hip_atomic_load(p, __ATOMIC_RELAXED, __HIP_MEMORY_SCOPE_AGENT); }
__device__ __forceinline__ unsigned xb_add(unsigned* p, unsigned v) { return __hip_atomic_fetch_add(p, v, __ATOMIC_RELAXED, __HIP_MEMORY_SCOPE_AGENT); }
__device__ __forceinline__ unsigned xb_xcc_id() { return (unsigned)__builtin_amdgcn_s_getreg((3 << 11) | 20) & 0xFu; }
#define XB_SPIN(cond, bar) do { unsigned _sp = 0; while (cond) { __builtin_amdgcn_s_sleep(1); \
    if ((++_sp & 255u) == 0u) { if (xb_ld(&(bar)[XB_TMO])) break; if (_sp > XB_SPIN_CAP) { atomicAdd(&(bar)[XB_TMO], 1u); break; } } } } while (0)
struct XcdBarrier { unsigned* bar; unsigned x; volatile LAS unsigned* st; };
__device__ __forceinline__ XcdBarrier xcd_barrier_post(unsigned* bar, volatile LAS unsigned* st) {
    XcdBarrier b; b.bar = bar; b.x = xb_xcc_id(); b.st = st;
    if (threadIdx.x == 0) (void)xb_add(&bar[XB_XCNT(b.x)], 1u);
    return b;
}
__device__ __forceinline__ void xcd_barrier_complete(unsigned* bar, unsigned x, unsigned& nloc, unsigned& nx) {
    const unsigned G = gridDim.x * gridDim.y * gridDim.z;
    unsigned sum, cnt, mine, sp = 0u;
    for (;;) {
        sum = 0u; cnt = 0u; mine = 0u;
#pragma unroll
        for (unsigned j = 0; j < 16; ++j) { const unsigned c = xb_ld(&bar[XB_XCNT(j)]); sum += c; cnt += (c > 0u) ? 1u : 0u; mine = (j == x) ? c : mine; }
        if (sum == G) break;
        __builtin_amdgcn_s_sleep(1);
        if ((++sp & 255u) == 0u) { if (xb_ld(&bar[XB_TMO])) break; if (sp > XB_SPIN_CAP) { atomicAdd(&bar[XB_TMO], 1u); break; } }
    }
    nloc = mine > 0u ? mine : 1u; nx = cnt > 0u ? cnt : 1u;
}
__device__ __forceinline__ void xcd_barrier(const XcdBarrier& b) {
    asm volatile("s_waitcnt vmcnt(0)" ::: "memory");
    __syncthreads();
    if (threadIdx.x == 0) {
        unsigned* bar = b.bar;
        __builtin_amdgcn_s_waitcnt(0);
        unsigned nloc = b.st[0], nx = b.st[1];
        if (nloc == 0u) { xcd_barrier_complete(bar, b.x, nloc, nx); b.st[0] = nloc; b.st[1] = nx; }
        const unsigned old = xb_add(&bar[XB_XSUB(b.x)], 1u);
        const unsigned gen = old / nloc;
        if (old + 1u == (gen + 1u) * nloc) {
            __builtin_amdgcn_fence(__ATOMIC_RELEASE, "agent");
            asm volatile("s_waitcnt vmcnt(0)" ::: "memory");
            const unsigned og = xb_add(&bar[XB_TOP], 1u);
            const unsigned tg = og / nx;
            if (og + 1u == (tg + 1u) * nx) xb_add(&bar[XB_TOPGEN], 1u);
            else XB_SPIN(xb_ld(&bar[XB_TOPGEN]) == tg, bar);
            __builtin_amdgcn_fence(__ATOMIC_ACQUIRE, "agent");
            xb_add(&bar[XB_XGEN(b.x)], 1u);
            asm volatile("s_waitcnt vmcnt(0)" ::: "memory");
        } else {
            XB_SPIN(xb_ld(&bar[XB_XGEN(b.x)]) == gen, bar);
            __builtin_amdgcn_fence(__ATOMIC_ACQUIRE, "agent");
            asm volatile("s_waitcnt vmcnt(0)" ::: "memory");
        }
    }
    __syncthreads();
}

__device__ __forceinline__ float wave_sum(float v) {
    v = xsum<1>(v); v = xsum<2>(v); v = xsum<4>(v); v = xsum<8>(v); v = xsum<16>(v); v = xsum<32>(v);
    return v;
}
__device__ __forceinline__ void cvt_item(const float* W, int ldw, int K, int srcA, int srcB, bf16* WT, int dst_row0, int k0, LAS float* scr, int lane, bool ident = false) {
    const int kq = lane >> 4, nq = lane & 15; const int scol = (nq < 8 ? srcA + 4 * nq : srcB + 4 * (nq - 8));
    f32x4 v[16];
#pragma unroll
    for (int i = 0; i < 16; ++i) v[i] = __builtin_nontemporal_load((const GAS f32x4*)(W + (size_t)(k0 + 4 * i + kq) * ldw + scol));
#pragma unroll
    for (int i = 0; i < 16; ++i)
#pragma unroll
        for (int e = 0; e < 4; ++e) scr[(4 * i + kq) * 65 + 4 * nq + e] = v[i][e];
    LDS_WAIT(); asm volatile("" ::: "memory");
    const int c = lane & 7, rr = lane >> 3;
#pragma unroll
    for (int j = 0; j < 8; ++j) { const int rho = rr + 8 * j; const int sc = (rho & 32) + (ident ? (rho & 31) : pg8::perm32(rho & 31)); const LAS float* s = scr + (8 * c) * 65 + sc;
        v4u o; o.x = pk2(s[0 * 65], s[1 * 65]); o.y = pk2(s[2 * 65], s[3 * 65]); o.z = pk2(s[4 * 65], s[5 * 65]); o.w = pk2(s[6 * 65], s[7 * 65]);
        *(GAS v4u*)(WT + (size_t)(dst_row0 + rho) * K + k0 + 8 * c) = o; }
    LDS_WAIT(); asm volatile("" ::: "memory");
}
__device__ __forceinline__ void cvt_item_f8(const float* W, int ldw, int K, int srcA, int srcB, unsigned char* WT, int dst_row0, int k0, LAS float* scr, int lane, bool ident = false) {
    const int kq = lane >> 4, nq = lane & 15; const int scol = (nq < 8 ? srcA + 4 * nq : srcB + 4 * (nq - 8));
    f32x4 v[16];
#pragma unroll
    for (int i = 0; i < 16; ++i) v[i] = __builtin_nontemporal_load((const GAS f32x4*)(W + (size_t)(k0 + 4 * i + kq) * ldw + scol));
#pragma unroll
    for (int i = 0; i < 16; ++i)
#pragma unroll
        for (int e = 0; e < 4; ++e) scr[(4 * i + kq) * 65 + 4 * nq + e] = v[i][e] * pg8::W8_SCALE;
    LDS_WAIT(); asm volatile("" ::: "memory");
    const int c = lane & 7, rr = lane >> 3;
#pragma unroll
    for (int j = 0; j < 8; ++j) { const int rho = rr + 8 * j; const int sc = (rho & 32) + (ident ? (rho & 31) : pg8::perm32(rho & 31)); const LAS float* s = scr + (8 * c) * 65 + sc;
        unsigned w0 = 0, w1 = 0;
        w0 = __builtin_amdgcn_cvt_pk_fp8_f32(s[0 * 65], s[1 * 65], w0, false); w0 = __builtin_amdgcn_cvt_pk_fp8_f32(s[2 * 65], s[3 * 65], w0, true);
        w1 = __builtin_amdgcn_cvt_pk_fp8_f32(s[4 * 65], s[5 * 65], w1, false); w1 = __builtin_amdgcn_cvt_pk_fp8_f32(s[6 * 65], s[7 * 65], w1, true);
        v2u o; o.x = w0; o.y = w1; *(GAS v2u*)(WT + (size_t)(dst_row0 + rho) * K + k0 + 8 * c) = o; }
    LDS_WAIT(); asm volatile("" ::: "memory");
}
__device__ __forceinline__ int win_src(int X) { const int pn = X >> 3, bj = (X >> 2) & 1, wc = X & 3; return (pn >= 9 && pn < 14) ? pn * 256 + 64 * wc + 32 * bj : 32 * X; }
__device__ __forceinline__ int wgu_src(int X) { const int pn = X >> 3, bj = (X >> 2) & 1, wc = X & 3; return bj * 1024 + 128 * pn + 32 * wc; }

__device__ __forceinline__ void norm_row_bf16(const float* xrow, const float* g, const float* sc, const float* sh, bf16* orow, int lane) {
    const GAS f32x4* xr = (const GAS f32x4*)xrow + lane;
    f32x4 v[4]; float s = 0.f;
#pragma unroll
    for (int j = 0; j < 4; ++j) { v[j] = xr[64 * j]; s += (v[j].x * v[j].x + v[j].y * v[j].y) + (v[j].z * v[j].z + v[j].w * v[j].w); }
    const float rs = rsqrtf(wave_sum(s) * (1.0f / D) + EPS);
#pragma unroll
    for (int j = 0; j < 4; ++j) { const int c = 256 * j + 4 * lane;
        const f32x4 gg = *(const GAS f32x4*)(g + c), s1 = *(const GAS f32x4*)(sc + c), s0 = *(const GAS f32x4*)(sh + c);
        const f32x4 y = (v[j] * rs * gg) * (s1 + 1.0f) + s0;
        v2u o; o.x = pk2(y.x, y.y); o.y = pk2(y.z, y.w); *(GAS v2u*)(orow + c) = o; }
}

__device__ __forceinline__ void norm_rows2_bf16(const float* xrow, const float* g, const float* sc, const float* sh, bf16* orow, int lane) {
    const GAS f32x4* xr = (const GAS f32x4*)xrow + lane;
    f32x4 v[2][4]; float s0 = 0.f, s1 = 0.f;
#pragma unroll
    for (int j = 0; j < 4; ++j) { v[0][j] = xr[64 * j]; v[1][j] = xr[256 + 64 * j]; }
#pragma unroll
    for (int j = 0; j < 4; ++j) { s0 += (v[0][j].x * v[0][j].x + v[0][j].y * v[0][j].y) + (v[0][j].z * v[0][j].z + v[0][j].w * v[0][j].w); s1 += (v[1][j].x * v[1][j].x + v[1][j].y * v[1][j].y) + (v[1][j].z * v[1][j].z + v[1][j].w * v[1][j].w); }
    const float rs0 = rsqrtf(wave_sum(s0) * (1.0f / D) + EPS), rs1 = rsqrtf(wave_sum(s1) * (1.0f / D) + EPS);
#pragma unroll
    for (int j = 0; j < 4; ++j) { const int c = 256 * j + 4 * lane;
        const f32x4 gg = *(const GAS f32x4*)(g + c), a1 = *(const GAS f32x4*)(sc + c) + 1.0f, a0 = *(const GAS f32x4*)(sh + c);
        const f32x4 y0 = (v[0][j] * rs0 * gg) * a1 + a0, y1 = (v[1][j] * rs1 * gg) * a1 + a0;
        v2u o0; o0.x = pk2(y0.x, y0.y); o0.y = pk2(y0.z, y0.w); *(GAS v2u*)(orow + c) = o0;
        v2u o1; o1.x = pk2(y1.x, y1.y); o1.y = pk2(y1.z, y1.w); *(GAS v2u*)(orow + D + c) = o1; }
}

__device__ __forceinline__ void norm_rows2_f8(const float* xrow, const float* g, const float* sc, const float* sh, unsigned char* orow, int lane) {
    const GAS f32x4* xr = (const GAS f32x4*)xrow + lane;
    f32x4 v[2][4]; float s0 = 0.f, s1 = 0.f;
#pragma unroll
    for (int j = 0; j < 4; ++j) { v[0][j] = xr[64 * j]; v[1][j] = xr[256 + 64 * j]; }
#pragma unroll
    for (int j = 0; j < 4; ++j) { s0 += (v[0][j].x * v[0][j].x + v[0][j].y * v[0][j].y) + (v[0][j].z * v[0][j].z + v[0][j].w * v[0][j].w); s1 += (v[1][j].x * v[1][j].x + v[1][j].y * v[1][j].y) + (v[1][j].z * v[1][j].z + v[1][j].w * v[1][j].w); }
    const float rs0 = rsqrtf(wave_sum(s0) * (1.0f / D) + EPS), rs1 = rsqrtf(wave_sum(s1) * (1.0f / D) + EPS);
#pragma unroll
    for (int j = 0; j < 4; ++j) { const int c = 256 * j + 4 * lane;
        const f32x4 gg = *(const GAS f32x4*)(g + c), a1 = *(const GAS f32x4*)(sc + c) + 1.0f, a0 = *(const GAS f32x4*)(sh + c);
        const f32x4 y0 = (v[0][j] * rs0 * gg) * a1 + a0, y1 = (v[1][j] * rs1 * gg) * a1 + a0;
        unsigned w0 = 0, w1 = 0;
        w0 = __builtin_amdgcn_cvt_pk_fp8_f32(y0.x, y0.y, w0, false); w0 = __builtin_amdgcn_cvt_pk_fp8_f32(y0.z, y0.w, w0, true);
        w1 = __builtin_amdgcn_cvt_pk_fp8_f32(y1.x, y1.y, w1, false); w1 = __builtin_amdgcn_cvt_pk_fp8_f32(y1.z, y1.w, w1, true);
        *(GAS unsigned*)(orow + c) = w0; *(GAS unsigned*)(orow + D + c) = w1; }
}

__device__ __forceinline__ bool gqa_bound_ok(const float* qg, const float* kg, int lane) {
    float gq = fabsf(qg[lane]), gk = fabsf(kg[lane]);
#define MK_MAXSTEP(m) gq = fmaxf(gq, __int_as_float(__builtin_amdgcn_ds_swizzle(__float_as_int(gq), 0x1f | ((m) << 10)))); gk = fmaxf(gk, __int_as_float(__builtin_amdgcn_ds_swizzle(__float_as_int(gk), 0x1f | ((m) << 10))))
    MK_MAXSTEP(1); MK_MAXSTEP(2); MK_MAXSTEP(4); MK_MAXSTEP(8); MK_MAXSTEP(16);
#undef MK_MAXSTEP
    gq = fmaxf(gq, xget32(gq, lane >> 5)); gk = fmaxf(gk, xget32(gk, lane >> 5));
    const float bound = 64.0f * gq * gk * C2 * 1.01f; return __builtin_amdgcn_readfirstlane((int)(bound <= 14.0f)) != 0;
}

struct Args { const float* in[20]; float* out; unsigned char* ws; int ph_lo, ph_hi, li, pad; };
constexpr int N_PHASES = 2 + 10 * DEPTH;

typedef const __attribute__((address_space(4))) Args* kargs_t;
__device__ __forceinline__ kargs_t kargs_opaque() { kargs_t p = (kargs_t)__builtin_amdgcn_kernarg_segment_ptr(); asm volatile("" : "+s"(p)); return p; }
#define PH_BEGIN() kargs_t ap = kargs_opaque(); unsigned char* ws = ap->ws; (void)ws; \
    int wave = wave_s; asm volatile("" : "+s"(wave)); const int lane = lane_id_asm(); const int tid = wave * 64 + lane; (void)lane; (void)tid; \
    int bx = blockIdx.x; asm volatile("" : "+s"(bx)); int G = gridDim.x; asm volatile("" : "+s"(G)); const int vcu = (G % 8 == 0) ? (bx % 8) * (G / 8) + bx / 8 : bx; (void)vcu; \
    const int gw = vcu * NWAVES + wave, NGW = G * NWAVES; (void)gw; (void)NGW; const int gtid = vcu * (NWAVES * 64) + tid, NGT = G * NWAVES * 64; (void)gtid; (void)NGT
#define INP(k) (ap->in[k])
#define x_in INP(0)
#define c_in INP(1)
#define w_ada INP(2)
#define b_ada INP(3)
#define norm1_g INP(4)
#define w_in INP(5)
#define q_norm_g INP(6)
#define k_norm_g INP(7)
#define rel_bias INP(8)
#define w_br_a INP(9)
#define w_br_b INP(10)
#define w_out INP(11)
#define norm2_g INP(12)
#define w_router INP(13)
#define b_router INP(14)
#define w_gate_up INP(15)
#define b_gate_up INP(16)
#define w_down INP(17)
#define b_down INP(18)
#define final_g INP(19)
#define MOD ((float*)(ws + WS_MOD))
#define ROPE ((float*)(ws + WS_ROPE))
#define BLUT ((float*)(ws + WS_BLUT))
#define RC0 ((float*)(ws + WS_RC0))
#define HIST ((int*)(ws + WS_HIST))
#define TILEE ((int*)(ws + WS_TILEE))
#define TOPE ((int*)(ws + WS_TOPE))
#define TOPW ((float*)(ws + WS_TOPW))
#define SLOT ((int*)(ws + WS_SLOT))
#define ROWW ((float*)(ws + WS_ROWW))
#define LSE ((float*)(ws + WS_LSE))
#define WRHI ((bf16*)(ws + WS_WRHI))
#define WRLO ((bf16*)(ws + WS_WRLO))
#define WIN ((unsigned char*)(ws + WS_WIN))
#define WBRA ((unsigned char*)(ws + WS_WBRA))
#define WBRB ((unsigned char*)(ws + WS_WBRB))
#define WOUT ((unsigned char*)(ws + WS_WOUT))
#define WGU ((unsigned char*)(ws + WS_WGU))
#define WDN ((unsigned char*)(ws + WS_WDN))
#define X ((float*)(ws + WS_X))
#define H ((bf16*)(ws + WS_H))
#define AQKV ((bf16*)(ws + WS_AQKV))
#define QB ((bf16*)(ws + WS_QB))
#define KB ((bf16*)(ws + WS_KB))
#define VB ((bf16*)(ws + WS_VB))
#define GATE ((bf16*)(ws + WS_GATE))
#define OAG ((bf16*)(ws + WS_OAG))
#define OA ((unsigned char*)(ws + WS_OA))
#define MERGED ((bf16*)(ws + WS_MERGED))
#define OB ((unsigned char*)(ws + WS_OB))
#define M8 ((unsigned char*)(ws + WS_M8))
#define XS ((unsigned char*)(ws + WS_XS))
#define ACT ((unsigned char*)(ws + WS_ACT))
#define YB ((unsigned char*)(ws + WS_Y))
__global__ void __launch_bounds__(NWAVES * 64, 2) mk_fwd(Args args) {
    extern __shared__ __attribute__((aligned(16))) unsigned char lds[];
    LAS unsigned char* L = (LAS unsigned char*)lds;
    volatile LAS unsigned* MISC = (volatile LAS unsigned*)(L + LDSCTL_OFF);
    gu32* ctl = (gu32*)(args.ws + WS_CTL);
    const int wave_s = __builtin_amdgcn_readfirstlane(threadIdx.x >> 6);
    for (int u = threadIdx.x; u < (LDS_BYTES - LDSCTL_OFF) / 4; u += NWAVES * 64) ((LAS unsigned*)(L + LDSCTL_OFF))[u] = 0u;
    __syncthreads();
    XcdBarrier bar; bar.bar = (unsigned*)(ctl + CW_BAR) + args.li * XCD_BAR_WORDS; bar.x = 0; bar.st = nullptr;
    if (!MK_PER_PHASE) bar = xcd_barrier_post((unsigned*)(ctl + CW_BAR) + args.li * XCD_BAR_WORDS, MISC + 8);
    const int lo = args.ph_lo, hi = args.ph_hi;
#define IN(k) (lo <= (k) && (k) < hi)
#define KIND(q) ((PH_KIND_MASK >> (q)) & 1)
#define SEAM(k) do { if (IN(k) && IN((k) + 1)) xcd_barrier(bar); } while (0)

    for (int rep0 = 0; rep0 < 1 + PROBE_P0; ++rep0) {
    if (KIND(0) && IN(0)) { PH_BEGIN();
        {
            LAS float* cact = (LAS float*)L;
            LAS float* part = (LAS float*)(L + 32768);
            for (int i = tid; i < NB * D; i += NWAVES * 64) { const float cv = c_in[i]; cact[i] = cv / (1.0f + __expf(-cv)); }
            __syncthreads();
            for (int vb = bx; vb < 256; vb += G) {
                const int gc = vb * 48 + lane;
                const int l = gc / 6144, col = gc % 6144;
                float a[NB];
#pragma unroll
                for (int b = 0; b < NB; ++b) a[b] = 0.f;
                if (lane < 48) {
                    const float* wp = w_ada + (size_t)l * D * 6144 + col;
                    for (int k = wave * 128; k < wave * 128 + 128; ++k) { const float w = wp[(size_t)k * 6144];
#pragma unroll
                        for (int b = 0; b < NB; ++b) a[b] += cact[b * D + k] * w; }
                }
#pragma unroll
                for (int b = 0; b < NB; ++b) part[(wave * NB + b) * 64 + lane] = a[b];
                __syncthreads();
                if (tid < NB * 48) { const int b = tid / 48, cl = tid % 48; const int gc2 = vb * 48 + cl; const int l2 = gc2 / 6144, col2 = gc2 % 6144;
                    float s = b_ada[l2 * 6144 + col2];
#pragma unroll
                    for (int w = 0; w < NWAVES; ++w) s += part[(w * NB + b) * 64 + cl];
                    MOD[((size_t)l2 * NB + b) * 6144 + col2] = s; }
                __syncthreads();
            }
        }
        for (int i = gtid; i < 1024 + 12 * 768; i += NGT) {
            if (i < 1024) { const int p = i >> 4, f = i & 15; const double inv = pow(10000.0, -(double)f / 16.0); const double ang = (double)p * inv; ROPE[i] = (float)cos(ang); ROPE[1024 + i] = (float)sin(ang); }
            else { const int j = i - 1024; const int hh = j / 768, di = j % 768; const int delta = di - 383; const int g = hh >> 2; const int dil = g == 0 ? 1 : (g == 1 ? 4 : 16);
                float val = -INFINITY;
                if (delta >= -64 && delta <= 64) { const int rel = delta * dil; const int n = rel < 0 ? -rel : rel; int bk = rel > 0 ? 16 : 0;
                    if (n < 8) bk += n; else { int lg = 8 + (int)(logf((float)n / 8.0f) / logf(128.0f) * 8.0f); if (lg > 15) lg = 15; bk += lg; }
                    val = rel_bias[bk * 12 + hh] * LOG2E; }
                BLUT[j] = val; }
        }
        {
            LAS float* scr = (LAS float*)(L + wave * 16640);
            __syncthreads();
            constexpr int I_IN = 16 * 92, I_BRA = 4 * 16, I_BRB = 16 * 16, I_OUT = 16 * 16, I_GU = 16 * 32, I_DN = 16 * 16;
            constexpr int PER_L = I_IN + I_BRA + I_BRB + I_OUT;
            constexpr int NITEMS = DEPTH * PER_L + DEPTH * NE * (I_GU + I_DN);
            for (int it = gw; it < NITEMS; it += NGW) {
                int r = it;
                if (r < DEPTH * PER_L) {
                    const int l = r / PER_L; r %= PER_L;
                    if (r < I_IN) { const int kb = r / 92, g64 = r % 92; cvt_item_f8(w_in + (size_t)l * D * N_IN, N_IN, D, win_src(2 * g64), win_src(2 * g64 + 1), WIN + (size_t)l * N_IN * D, 64 * g64, 64 * kb, scr, lane, (g64 >> 2) >= 9 && (g64 >> 2) < 14); continue; } r -= I_IN;
                    if (r < I_BRA) { const int kb = r / 16, g64 = r % 16; cvt_item_f8(w_br_a + (size_t)l * 256 * D, D, 256, 64 * g64, 64 * g64 + 32, WBRA + (size_t)l * D * 256, 64 * g64, 64 * kb, scr, lane); continue; } r -= I_BRA;
                    if (r < I_BRB) { const int kb = r / 16, g64 = r % 16; cvt_item_f8(w_br_b + (size_t)l * D * D, D, D, 64 * g64, 64 * g64 + 32, WBRB + (size_t)l * D * D, 64 * g64, 64 * kb, scr, lane); continue; } r -= I_BRB;
                    { const int kb = r / 16, g64 = r % 16; cvt_item_f8(w_out + (size_t)l * D * D, D, D, 64 * g64, 64 * g64 + 32, WOUT + (size_t)l * D * D, 64 * g64, 64 * kb, scr, lane); continue; }
                }
                r -= DEPTH * PER_L;
                if (r < DEPTH * NE * I_GU) { const int le = r / I_GU; r %= I_GU; const int kb = r / 32, g64 = r % 32;
                    cvt_item_f8(w_gate_up + (size_t)le * D * 2048, 2048, D, wgu_src(2 * g64), wgu_src(2 * g64 + 1), WGU + (size_t)le * 2048 * D, 64 * g64, 64 * kb, scr, lane); continue; }
                r -= DEPTH * NE * I_GU;
                { const int le = r / I_DN; r %= I_DN; const int kb = r / 16, g64 = r % 16;
                    cvt_item_f8(w_down + (size_t)le * D * D, D, D, 64 * g64, 64 * g64 + 32, WDN + (size_t)le * D * D, 64 * g64, 64 * kb, scr, lane); }
            }
        }
    }
    SEAM(0);
    }
    if (KIND(1) && IN(1)) { PH_BEGIN();
        for (int m = 2 * gw; m < T; m += 2 * NGW) { const int b = m >> 12; const float* md = MOD + (size_t)b * 6144;
            norm_rows2_f8(x_in + (size_t)m * D, norm1_g, md + 1024, md, (unsigned char*)H + (size_t)m * D, lane); }
        for (int i = gtid; i < DEPTH * NB * NE * D; i += NGT) { const int k = i & 1023, e = (i >> 10) & 31, b = (i >> 15) & 7, l = i >> 18;
            const float v = norm2_g[l * D + k] * (1.0f + MOD[((size_t)l * NB + b) * 6144 + 4 * 1024 + k]) * w_router[((size_t)l * D + k) * NE + e];
            const unsigned hb = f2bf(v); const float lv = v - __uint_as_float(hb << 16);
            WRHI[i] = (bf16)hb; WRLO[i] = (bf16)f2bf(lv); }
        for (int i = gw; i < DEPTH * NB * NE; i += NGW) { const int e = i & 31, b = (i >> 5) & 7, l = i >> 8; float s = 0.f;
            for (int k = lane; k < D; k += 64) s += MOD[((size_t)l * NB + b) * 6144 + 3 * 1024 + k] * w_router[((size_t)l * D + k) * NE + e];
            s = wave_sum(s); if (lane == 0) RC0[i] = s + b_router[l * NE + e]; }
    }
    SEAM(1);

    for (int li = (PROBE_MASK ? -1 : 0); li < DEPTH; ++li) {
        const int l = li < 0 ? 0 : li; const bool virt = li < 0;
        const int P = 2 + 10 * l;
#define VK(q) (!virt || ((PROBE_MASK >> (q)) & 1))
        if (KIND(2) && IN(P + 0) && VK(2)) { PH_BEGIN();
            pg8::Gemm g{H, (const bf16*)(WIN + (size_t)l * N_IN * D), D / 2}; pg8::StaticOrder S; S.init(T, N_IN, G, bx);
            const bool f8attn = gqa_bound_ok(q_norm_g + l * 64, k_norm_g + l * 64, lane);
            pg8::EpiIn E{AQKV, QB, KB, VB, GATE, q_norm_g + l * 64, k_norm_g + l * 64, ROPE, pg8::W8_INV, f8attn};
            pg8::gemm_phase_f8<pg8::EpiIn, pg8::StaticOrder>(L, g, S, E, wave);
        }
        if (VK(2)) SEAM(P + 0);
        if (KIND(3) && IN(P + 1) && VK(3)) { PH_BEGIN();
            namespace ab = attn_body;
            const bool nomax = gqa_bound_ok(q_norm_g + l * 64, k_norm_g + l * 64, lane);
            for (int j = 0; j < 8; ++j) {
                const int uidx = vcu * 8 + j; if (uidx >= 2048) break;
                const int pair = uidx >> 6, idx = uidx & 63; const int b = pair >> 2, kvh = pair & 3, hq = idx >> 4, qb = idx & 15; const int h = kvh * 4 + hq;
                ab::Job J; J.Q = (const ab::bf16*)QB + ((size_t)b * SEQ + qb * 256) * 1024 + h * 64; J.K = (const ab::bf16*)KB + (size_t)b * SEQ * 256 + kvh * 64; J.V = (const ab::bf16*)VB + (size_t)b * SEQ * 256 + kvh * 64;
                J.O = (ab::bf16*)(OB + ((size_t)b * SEQ + qb * 256) * 1024 + h * 64)  ; J.lse = nullptr; J.lutg = nullptr; J.NT = 64; J.i0 = 0; J.kq0 = 0; J.dsh = 0; J.cls = 0;
                if (nomax) { attn8::Job J8; J8.Q = (const unsigned char*)QB + ((size_t)b * SEQ + qb * 256) * 1024 + h * 64; J8.K = (const unsigned char*)KB + (size_t)b * SEQ * 256 + kvh * 64;
                    J8.VT = (const unsigned char*)VB + ((size_t)((b * 4 + kvh) * 64) << 12); J8.O = OB + ((size_t)b * SEQ + qb * 256) * 1024 + h * 64;
                    attn8::attn_unit_f8<64>(J8, (char*)lds, wave); }
                else ab::attn_unit<0, 8, false>(J, (char*)lds, wave);
            }
            for (int j = 0; j < 6; ++j) {
                const int uidx = vcu * 6 + j; if (uidx >= 1536) break;
                const int g = uidx / 512, r = uidx % 512; const int b = r >> 6, hs = (r >> 4) & 3, combo = r & 15;
                const int dsh = 2 * g; const int Lc = SEQ >> dsh; const int nqb = Lc >> 8;
                const int cls = combo / nqb, qb = combo % nqb; const int i0 = qb * 256;
                int t0 = (i0 >> 6) - 1; const int ntile = Lc >> 6; const int NT = ntile >= 6 ? 6 : 4; if (t0 < 0) t0 = 0; if (t0 > ntile - NT) t0 = ntile - NT;
                const size_t cbase = (size_t)b * SEQ + (size_t)cls * Lc;
                const ab::bf16* aq = (const ab::bf16*)AQKV + (size_t)(g * 3 + 0) * T * 256; const ab::bf16* ak = (const ab::bf16*)AQKV + (size_t)(g * 3 + 1) * T * 256; const ab::bf16* av = (const ab::bf16*)AQKV + (size_t)(g * 3 + 2) * T * 256;
                ab::Job J; J.Q = aq + (cbase + i0) * 256 + hs * 64; J.K = ak + (cbase + t0 * 64) * 256 + hs * 64; J.V = av + (cbase + t0 * 64) * 256 + hs * 64;
                J.O = (ab::bf16*)OAG + (size_t)g * T * 256 + (size_t)b * SEQ * 256 + hs * 64; J.lse = LSE + (size_t)g * T * 4 + (size_t)b * SEQ * 4 + hs; J.lutg = BLUT + (g * 4 + hs) * 768;
                J.NT = NT; J.i0 = i0; J.kq0 = t0 * 64 - i0; J.dsh = dsh; J.cls = cls;
                ab::attn_unit<1, 8>(J, (char*)lds, wave);
            }
        }
        if (VK(3)) SEAM(P + 1);
        if (KIND(4) && IN(P + 2) && VK(4)) { PH_BEGIN();
            for (int i = gtid; i < T * 32; i += NGT) { const int t = i >> 5, ch = i & 31, hs = ch >> 3;
                const float l0 = LSE[(size_t)t * 4 + hs], l1 = LSE[(size_t)T * 4 + (size_t)t * 4 + hs], l2 = LSE[(size_t)2 * T * 4 + (size_t)t * 4 + hs];
                const float mx = fmaxf(l0, fmaxf(l1, l2)); float w0 = exp2f(l0 - mx), w1 = exp2f(l1 - mx), w2 = exp2f(l2 - mx); const float inv = 1.0f / (w0 + w1 + w2); w0 *= inv; w1 *= inv; w2 *= inv;
                const v4u a = *(const GAS v4u*)(OAG + (size_t)t * 256 + ch * 8), bq = *(const GAS v4u*)(OAG + (size_t)T * 256 + (size_t)t * 256 + ch * 8), cq = *(const GAS v4u*)(OAG + (size_t)2 * T * 256 + (size_t)t * 256 + ch * 8);
                unsigned o0 = 0, o1 = 0;
                o0 = __builtin_amdgcn_cvt_pk_fp8_f32(w0 * bfl(a.x) + w1 * bfl(bq.x) + w2 * bfl(cq.x), w0 * bfh(a.x) + w1 * bfh(bq.x) + w2 * bfh(cq.x), o0, false);
                o0 = __builtin_amdgcn_cvt_pk_fp8_f32(w0 * bfl(a.y) + w1 * bfl(bq.y) + w2 * bfl(cq.y), w0 * bfh(a.y) + w1 * bfh(bq.y) + w2 * bfh(cq.y), o0, true);
                o1 = __builtin_amdgcn_cvt_pk_fp8_f32(w0 * bfl(a.z) + w1 * bfl(bq.z) + w2 * bfl(cq.z), w0 * bfh(a.z) + w1 * bfh(bq.z) + w2 * bfh(cq.z), o1, false);
                o1 = __builtin_amdgcn_cvt_pk_fp8_f32(w0 * bfl(a.w) + w1 * bfl(bq.w) + w2 * bfl(cq.w), w0 * bfh(a.w) + w1 * bfh(bq.w) + w2 * bfh(cq.w), o1, true);
                v2u o; o.x = o0; o.y = o1; *(GAS v2u*)(OA + (size_t)t * 256 + ch * 8) = o; }
        }
        if (VK(4)) SEAM(P + 2);
        if (KIND(5) && IN(P + 3) && VK(5)) { PH_BEGIN();
            pg8::StaticOrder S; S.init(T, D, G, bx);
            { pg8::Gemm g{(const bf16*)OA, (const bf16*)(WBRA + (size_t)l * D * 256), 128}; pg8::EpiMergeA E{GATE, MERGED}; pg8::gemm_phase_f8<pg8::EpiMergeA, pg8::StaticOrder>(L, g, S, E, wave); }
            { pg8::Gemm g{(const bf16*)OB, (const bf16*)(WBRB + (size_t)l * D * D), D / 2}; pg8::EpiMergeB<true> E{GATE, MERGED, M8}; pg8::gemm_phase_f8<pg8::EpiMergeB<true>, pg8::StaticOrder>(L, g, S, E, wave); }
        }
        if (VK(5)) SEAM(P + 3);
        if (KIND(6) && IN(P + 4) && VK(6)) { PH_BEGIN();
            pg8::Gemm g{(const bf16*)M8, (const bf16*)(WOUT + (size_t)l * D * D), D / 2}; pg8::StaticOrder S; S.init(T, D, G, bx);
            pg8::EpiOut E{l == 0 ? x_in : X, X, MOD + (size_t)l * NB * 6144 + 2 * 1024};
            pg8::gemm_phase_f8<pg8::EpiOut, pg8::StaticOrder>(L, g, S, E, wave);
        }
        if (VK(6)) SEAM(P + 4);
        if (KIND(7) && IN(P + 5) && VK(7)) { PH_BEGIN();
            LAS int* hist = (LAS int*)(L + LDSCTL_OFF + 256);
            for (int vb = bx; vb < 256; vb += G) {
                if (tid < NE) hist[tid] = 0;
                __syncthreads();
                {
                    const int tt = vb + 256 * wave; const int r0 = tt * 16; const int b = r0 >> 12; const int i = lane & 15, kb = lane >> 4;
                    const float* xp = X + (size_t)(r0 + i) * D + 8 * kb;
                    const bf16* bh = WRHI + ((size_t)(l * NB + b) * NE + i) * D + 8 * kb; const bf16* bl = WRLO + ((size_t)(l * NB + b) * NE + i) * D + 8 * kb;
                    f32x4 acc0 = (f32x4){0.f, 0.f, 0.f, 0.f}, acc1 = acc0; float ss = 0.f;
#pragma unroll 8
                    for (int s = 0; s < 32; ++s) {
                        const f32x4 x0 = *(const GAS f32x4*)(xp + 32 * s), x1 = *(const GAS f32x4*)(xp + 32 * s + 4);
                        const bf16x8 wh0 = *(const GAS bf16x8*)(bh + 32 * s), wh1 = *(const GAS bf16x8*)(bh + 16 * D + 32 * s), wl0 = *(const GAS bf16x8*)(bl + 32 * s), wl1 = *(const GAS bf16x8*)(bl + 16 * D + 32 * s);
                        ss += (x0.x * x0.x + x0.y * x0.y) + (x0.z * x0.z + x0.w * x0.w) + (x1.x * x1.x + x1.y * x1.y) + (x1.z * x1.z + x1.w * x1.w);
                        v4u ah, al;
                        ah.x = pg8::cvt_pk_bf16(x0.x, x0.y); ah.y = pg8::cvt_pk_bf16(x0.z, x0.w); ah.z = pg8::cvt_pk_bf16(x1.x, x1.y); ah.w = pg8::cvt_pk_bf16(x1.z, x1.w);
                        al.x = pg8::cvt_pk_bf16(x0.x - bfl(ah.x), x0.y - bfh(ah.x)); al.y = pg8::cvt_pk_bf16(x0.z - bfl(ah.y), x0.w - bfh(ah.y));
                        al.z = pg8::cvt_pk_bf16(x1.x - bfl(ah.z), x1.y - bfh(ah.z)); al.w = pg8::cvt_pk_bf16(x1.z - bfl(ah.w), x1.w - bfh(ah.w));
                        const bf16x8 ahv = __builtin_bit_cast(bf16x8, ah), alv = __builtin_bit_cast(bf16x8, al);
                        acc0 = __builtin_amdgcn_mfma_f32_16x16x32_bf16(wh0, ahv, acc0, 0, 0, 0); acc1 = __builtin_amdgcn_mfma_f32_16x16x32_bf16(wh1, ahv, acc1, 0, 0, 0);
                        acc0 = __builtin_amdgcn_mfma_f32_16x16x32_bf16(wl0, ahv, acc0, 0, 0, 0); acc1 = __builtin_amdgcn_mfma_f32_16x16x32_bf16(wl1, ahv, acc1, 0, 0, 0);
                        acc0 = __builtin_amdgcn_mfma_f32_16x16x32_bf16(wh0, alv, acc0, 0, 0, 0); acc1 = __builtin_amdgcn_mfma_f32_16x16x32_bf16(wh1, alv, acc1, 0, 0, 0);
                    }
                    ss = xsum<16>(ss); ss = xsum<32>(ss);
                    const float rs = rsqrtf(ss * (1.0f / D) + EPS);
                    float v[8]; const float* rc = RC0 + (l * NB + b) * NE;
#pragma unroll
                    for (int r = 0; r < 4; ++r) { v[r] = rs * acc0[r] + rc[4 * kb + r]; v[4 + r] = rs * acc1[r] + rc[16 + 4 * kb + r]; }
                    float tv[4]; int ti[4];
#pragma unroll
                    for (int k = 0; k < 4; ++k) { float best = v[0]; int br = 0;
#pragma unroll
                        for (int r = 1; r < 8; ++r) if (v[r] > best) { best = v[r]; br = r; }
#pragma unroll
                        for (int r = 0; r < 8; ++r) v[r] = (r == br) ? -INFINITY : v[r];
                        tv[k] = best; ti[k] = (br & 3) + 16 * (br >> 2) + 4 * kb; }
#pragma unroll
                    for (int round = 0; round < 2; ++round) {
                        float bv[8]; int bi[8];
#pragma unroll
                        for (int k = 0; k < 4; ++k) { bv[k] = tv[k]; bi[k] = ti[k];
                            if (round == 0) { bv[4 + k] = __int_as_float(__builtin_amdgcn_ds_swizzle(__float_as_int(tv[k]), 0x1f | (16 << 10))); bi[4 + k] = __builtin_amdgcn_ds_swizzle(ti[k], 0x1f | (16 << 10)); }
                            else { bv[4 + k] = xget32(tv[k], lane >> 5); bi[4 + k] = xget32(ti[k], lane >> 5); } }
#pragma unroll
                        for (int k = 0; k < 4; ++k) { float best = bv[0]; int bq = 0;
#pragma unroll
                            for (int r = 1; r < 8; ++r) if (bv[r] > best || (bv[r] == best && bi[r] < bi[bq])) { best = bv[r]; bq = r; }
                            int sel = bi[0];
#pragma unroll
                            for (int r = 0; r < 8; ++r) { if (r == bq) sel = bi[r]; }
#pragma unroll
                            for (int r = 0; r < 8; ++r) bv[r] = (r == bq) ? -INFINITY : bv[r];
                            tv[k] = best; ti[k] = sel; }
                    }
                    if (kb == 0) {
                        const float e1 = __expf(tv[1] - tv[0]), e2 = __expf(tv[2] - tv[0]), e3 = __expf(tv[3] - tv[0]); const float inv = 1.0f / (1.0f + e1 + e2 + e3);
                        const int tok = r0 + i;
                        *(GAS i32x4*)(TOPE + (size_t)tok * 4) = (i32x4){ti[0], ti[1], ti[2], ti[3]};
                        *(GAS f32x4*)(TOPW + (size_t)tok * 4) = (f32x4){inv, e1 * inv, e2 * inv, e3 * inv};
#pragma unroll
                        for (int k = 0; k < 4; ++k) atomicAdd((int*)&hist[ti[k]], 1);
                    }
                }
                __syncthreads();
                if (tid < NE) HIST[vb * NE + tid] = hist[tid];
                __syncthreads();
            }
            for (int m = 2 * gw; m < T; m += 2 * NGW) { const int b = m >> 12; const float* md = MOD + ((size_t)l * NB + b) * 6144;
                norm_rows2_f8(X + (size_t)m * D, norm2_g + l * D, md + 4 * 1024, md + 3 * 1024, (unsigned char*)H + (size_t)m * D, lane); }
        }
        if (VK(7)) SEAM(P + 5);
        if (KIND(8) && IN(P + 6) && VK(8)) { PH_BEGIN();
            LAS int* sm = (LAS int*)L;
            for (int vb = bx; vb < 256; vb += G) {
                { const int e = tid & 31, seg = tid >> 5; int tot = 0, bef = 0;
                    for (int q = seg * 16; q < seg * 16 + 16; ++q) { const int hv = HIST[q * NE + e]; tot += hv; if (q < vb) bef += hv; }
                    sm[tid] = tot; sm[512 + tid] = bef; }
                __syncthreads();
                if (tid < NE) { int tot = 0, bef = 0;
                    for (int s = 0; s < 16; ++s) { tot += sm[s * 32 + tid]; bef += sm[512 + s * 32 + tid]; }
                    sm[1024 + tid] = bef; sm[1056 + tid] = (tot + 255) & ~255; }
                __syncthreads();
                if (tid == 0) { int run = 0; for (int e = 0; e < NE; ++e) { const int pd = sm[1056 + e]; sm[1056 + e] = run; sm[1024 + e] += run;
                        if (vb == 0) { for (int q = run >> 8; q < (run + pd) >> 8; ++q) TILEE[q] = e; }
                        run += pd; }
                    if (vb == 0) TILEE[1000] = run >> 8; }
                __syncthreads();
                if (tid < 128) { const int tt = vb + 256 * (tid >> 4); const int tok = tt * 16 + (tid & 15);
                    const i32x4 te = *(const GAS i32x4*)(TOPE + (size_t)tok * 4); const f32x4 tw = *(const GAS f32x4*)(TOPW + (size_t)tok * 4);
                    const int s0 = atomicAdd((int*)&sm[1024 + te.x], 1), s1 = atomicAdd((int*)&sm[1024 + te.y], 1), s2 = atomicAdd((int*)&sm[1024 + te.z], 1), s3 = atomicAdd((int*)&sm[1024 + te.w], 1);
                    *(GAS i32x4*)(SLOT + (size_t)tok * 4) = (i32x4){s0, s1, s2, s3};
                    ROWW[s0] = tw.x; ROWW[s1] = tw.y; ROWW[s2] = tw.z; ROWW[s3] = tw.w;
                    sm[2048 + tid * 4 + 0] = s0; sm[2048 + tid * 4 + 1] = s1; sm[2048 + tid * 4 + 2] = s2; sm[2048 + tid * 4 + 3] = s3; }
                __syncthreads();
                for (int p = wave; p < 512; p += NWAVES) { const int q = p >> 2; const int tt = vb + 256 * (q >> 4); const int tok = tt * 16 + (q & 15); const int slot = sm[2048 + p];
                    const GAS v4u* src = (const GAS v4u*)((unsigned char*)H + (size_t)tok * D); GAS v4u* dst = (GAS v4u*)(XS + (size_t)slot * D);
                    dst[lane] = src[lane]; }
                __syncthreads();
            }
        }
        if (VK(8)) SEAM(P + 6);
        if (KIND(9) && IN(P + 7) && VK(9)) { PH_BEGIN();
            const int nmt = __builtin_amdgcn_readfirstlane(__hip_atomic_load(TILEE + 1000, __ATOMIC_RELAXED, __HIP_MEMORY_SCOPE_AGENT));
            pg8::Gemm g{(const bf16*)XS, (const bf16*)(WGU + (size_t)l * NE * 2048 * D), D / 2}; pg8::MoeOrder S{TILEE, nmt * 8, 8, G, vcu};
            pg8::EpiGU8 E{b_gate_up + (size_t)l * NE * 2048, ACT};
            pg8::gemm_phase_f8<pg8::EpiGU8, pg8::MoeOrder>(L, g, S, E, wave);
        }
        if (VK(9)) SEAM(P + 7);
        if (KIND(10) && IN(P + 8) && VK(10)) { PH_BEGIN();
            const int nmt = __builtin_amdgcn_readfirstlane(__hip_atomic_load(TILEE + 1000, __ATOMIC_RELAXED, __HIP_MEMORY_SCOPE_AGENT));
            pg8::Gemm g{(const bf16*)ACT, (const bf16*)(WDN + (size_t)l * NE * D * D), D / 2}; pg8::MoeOrder S{TILEE, nmt * 4, 4, G, vcu};
            pg8::EpiDN8 E{b_down + (size_t)l * NE * D, ROWW, YB};
            pg8::gemm_phase_f8<pg8::EpiDN8, pg8::MoeOrder>(L, g, S, E, wave);
        }
        if (VK(10)) SEAM(P + 8);
        if (KIND(11) && IN(P + 9) && VK(11)) { PH_BEGIN();
            const bool lastl = (l == DEPTH - 1);
            float* Xw = virt ? (float*)(ws + WS_R) : X; bf16* Hw = virt ? (bf16*)(ws + WS_R + 128 * MiB) : H;
            for (int m0 = 2 * gw; m0 < T; m0 += 2 * NGW) { const int b = m0 >> 12;
                i32x4 sl[2];
#pragma unroll
                for (int q = 0; q < 2; ++q) { const int* sp = SLOT + (size_t)(m0 + q) * 4;
                    sl[q].x = __hip_atomic_load(sp + 0, RLX_AGENT); sl[q].y = __hip_atomic_load(sp + 1, RLX_AGENT); sl[q].z = __hip_atomic_load(sp + 2, RLX_AGENT); sl[q].w = __hip_atomic_load(sp + 3, RLX_AGENT); }
                const int c = 16 * lane;
                const float* g2 = MOD + ((size_t)l * NB + b) * 6144 + 5 * 1024;
                f32x4 v[2][4]; v4u yy[2][4];
#pragma unroll
                for (int q = 0; q < 2; ++q) {
#pragma unroll
                    for (int j = 0; j < 4; ++j) v[q][j] = *(const GAS f32x4*)(X + (size_t)(m0 + q) * D + c + 4 * j);
                    yy[q][0] = *(const GAS v4u*)(YB + (size_t)sl[q].x * D + c); yy[q][1] = *(const GAS v4u*)(YB + (size_t)sl[q].y * D + c);
                    yy[q][2] = *(const GAS v4u*)(YB + (size_t)sl[q].z * D + c); yy[q][3] = *(const GAS v4u*)(YB + (size_t)sl[q].w * D + c); }
                float s[2] = {0.f, 0.f};
#pragma unroll
                for (int q = 0; q < 2; ++q)
#pragma unroll
                    for (int j = 0; j < 4; ++j) { f32x4 ys = (f32x4){0.f, 0.f, 0.f, 0.f};
#pragma unroll
                        for (int k = 0; k < 4; ++k) { const unsigned w = yy[q][k][j];
                            const auto lo = __builtin_amdgcn_cvt_pk_f32_fp8((int)w, false), hi2 = __builtin_amdgcn_cvt_pk_f32_fp8((int)w, true);
                            ys.x += lo[0]; ys.y += lo[1]; ys.z += hi2[0]; ys.w += hi2[1]; }
                        const f32x4 gg = *(const GAS f32x4*)(g2 + c + 4 * j);
                        v[q][j] = v[q][j] + gg * ys;
                        if (!lastl) *(GAS f32x4*)(Xw + (size_t)(m0 + q) * D + c + 4 * j) = v[q][j];
                        s[q] += (v[q][j].x * v[q][j].x + v[q][j].y * v[q][j].y) + (v[q][j].z * v[q][j].z + v[q][j].w * v[q][j].w); }
                const float rs0 = rsqrtf(wave_sum(s[0]) * (1.0f / D) + EPS), rs1 = rsqrtf(wave_sum(s[1]) * (1.0f / D) + EPS);
                if (!lastl) { const float* md = MOD + ((size_t)(l + 1) * NB + b) * 6144; const float* gn = norm1_g + (l + 1) * D;
                    v4u h0, h1;
#pragma unroll
                    for (int j = 0; j < 4; ++j) {
                        const f32x4 gg = *(const GAS f32x4*)(gn + c + 4 * j), a1 = *(const GAS f32x4*)(md + 1024 + c + 4 * j) + 1.0f, a0 = *(const GAS f32x4*)(md + c + 4 * j);
                        const f32x4 y0 = (v[0][j] * rs0 * gg) * a1 + a0, y1 = (v[1][j] * rs1 * gg) * a1 + a0;
                        unsigned w0 = 0, w1 = 0;
                        w0 = __builtin_amdgcn_cvt_pk_fp8_f32(y0.x, y0.y, w0, false); w0 = __builtin_amdgcn_cvt_pk_fp8_f32(y0.z, y0.w, w0, true);
                        w1 = __builtin_amdgcn_cvt_pk_fp8_f32(y1.x, y1.y, w1, false); w1 = __builtin_amdgcn_cvt_pk_fp8_f32(y1.z, y1.w, w1, true);
                        h0[j] = w0; h1[j] = w1; }
                    *(GAS v4u*)((unsigned char*)Hw + (size_t)m0 * D + c) = h0; *(GAS v4u*)((unsigned char*)Hw + (size_t)(m0 + 1) * D + c) = h1;
                } else {
#pragma unroll
                    for (int j = 0; j < 4; ++j) { const f32x4 gg = *(const GAS f32x4*)(final_g + c + 4 * j);
                        *(GAS f32x4*)(ap->out + (size_t)m0 * D + c + 4 * j) = v[0][j] * rs0 * gg; *(GAS f32x4*)(ap->out + (size_t)(m0 + 1) * D + c + 4 * j) = v[1][j] * rs1 * gg; }
                }
            }
        }
        if (VK(11)) SEAM(P + 9);
        if (virt) { PH_BEGIN();
            for (int m = 2 * gw; m < T; m += 2 * NGW) { const int b = m >> 12; const float* md = MOD + (size_t)b * 6144; norm_rows2_f8(x_in + (size_t)m * D, norm1_g, md + 1024, md, (unsigned char*)H + (size_t)m * D, lane); }
            xcd_barrier(bar); }
    }
#undef IN
#undef SEAM
}

extern "C" void kernel_launch(void* const* d_in, const int* in_sizes, int n_in, void* d_out, int out_size, void* d_ws, size_t ws_size, hipStream_t stream) {
    static int grid = 0;
    if (grid == 0) {
        if (n_in != 20 || in_sizes[0] != T * D || out_size != T * D || ws_size < WS_END) { fprintf(stderr, "kernel_launch: unexpected shapes (n_in %d, in0 %d, out %d, ws %zu < %zu); nothing launched\n", n_in, n_in > 0 ? in_sizes[0] : -1, out_size, ws_size, (size_t)WS_END); grid = -1; return; }
        int dev = 0, cus = 0, per_cu = 0;
        if (hipGetDevice(&dev) != hipSuccess || hipDeviceGetAttribute(&cus, hipDeviceAttributeMultiprocessorCount, dev) != hipSuccess) { grid = -1; return; }
        if (hipFuncSetAttribute((const void*)mk_fwd, hipFuncAttributeMaxDynamicSharedMemorySize, LDS_BYTES) != hipSuccess) { fprintf(stderr, "kernel_launch: hipFuncSetAttribute failed\n"); grid = -1; return; }
        if (hipOccupancyMaxActiveBlocksPerMultiprocessor(&per_cu, (const void*)mk_fwd, NWAVES * 64, LDS_BYTES) != hipSuccess || per_cu < 1)
            fprintf(stderr, "kernel_launch: note: occupancy query reports %d workgroups per CU\n", per_cu);
        (void)hipGetLastError();
        grid = cus < 256 ? cus : 256;
        if (grid != 256) fprintf(stderr, "kernel_launch: %d CUs; this kernel's unit deals assume 256\n", grid);
    }
    if (grid < 0) return;
    if (hipMemsetAsync((char*)d_ws + WS_CTL, 0, CTL_ZERO_BYTES, stream) != hipSuccess) { fprintf(stderr, "kernel_launch: memset failed\n"); return; }
    Args a{};
    for (int i = 0; i < 20; ++i) a.in[i] = (const float*)d_in[i];
    a.out = (float*)d_out; a.ws = (unsigned char*)d_ws; a.pad = 0;
#if MK_PER_PHASE
    for (int p = 0; p < N_PHASES; ++p) { a.ph_lo = p; a.ph_hi = p + 1; a.li = 0; hipLaunchKernelGGL(mk_fwd, dim3(grid), dim3(NWAVES * 64), LDS_BYTES, stream, a); }
#else
    a.ph_lo = 0; a.ph_hi = N_PHASES; a.li = 0;
    hipLaunchKernelGGL(mk_fwd, dim3(grid), dim3(NWAVES * 64), LDS_BYTES, stream, a);
#endif
    const hipError_t le = hipPeekAtLastError();
    if (le != hipSuccess) fprintf(stderr, "kernel_launch: launch failed: %s\n", hipGetErrorName(le));
}
```

```cpp
#include <hip/hip_runtime.h>
#include <hip/hip_bf16.h>
#include <cstdio>
#include <cstdint>
#include <cmath>

#ifndef PH_KIND_MASK
#define PH_KIND_MASK 0xFFF
#endif
#ifndef PROBE_MASK
#define PROBE_MASK 0
#endif
#ifndef PROBE_P0
#define PROBE_P0 0
#endif
#ifndef MK_PER_PHASE
#define MK_PER_PHASE 0
#endif

constexpr int NB = 8, SEQ = 4096, T = NB * SEQ, D = 1024, DEPTH = 2;
constexpr int N_IN = 5888, NE = 32, TOPK = 4;
constexpr int NASSIGN = T * TOPK;
constexpr int MAX_MT = NASSIGN / 256 + NE;
constexpr int CAP_ROWS = MAX_MT * 256;
constexpr float C2 = 0.125f * 1.4426950408889634f;
constexpr float LOG2E = 1.4426950408889634f;
constexpr float EPS = 1e-6f;

__device__ __forceinline__ int lane_id_asm() { int l; asm volatile("v_mbcnt_lo_u32_b32 %0, -1, 0\n\tv_mbcnt_hi_u32_b32 %0, -1, %0" : "=v"(l)); return l; }

template <int M> __device__ __forceinline__ float xsum(float v) {
    if constexpr (M < 32) return v + __int_as_float(__builtin_amdgcn_ds_swizzle(__float_as_int(v), 0x1f | (M << 10)));
    else { auto rr = __builtin_amdgcn_permlane32_swap(__float_as_uint(v), __float_as_uint(v), false, false); return __uint_as_float(rr[0]) + __uint_as_float(rr[1]); }
}
template <class Tv> __device__ __forceinline__ Tv xget32(Tv v, int hf) {
    auto rr = __builtin_amdgcn_permlane32_swap(__builtin_bit_cast(unsigned, v), __builtin_bit_cast(unsigned, v), false, false); return __builtin_bit_cast(Tv, hf ? rr[0] : rr[1]);
}

namespace pg8 {
#define PG8_LAS __attribute__((address_space(3)))
typedef unsigned short bf16_t;
typedef short bf16x8 __attribute__((ext_vector_type(8)));
typedef float f32x4 __attribute__((ext_vector_type(4)));
typedef unsigned u32x4 __attribute__((ext_vector_type(4)));
typedef unsigned u32x2 __attribute__((ext_vector_type(2)));
constexpr int BM = 256, BK = 64, HALF = 128, HTB = HALF * BK * 2, STAGE_BYTES = 8 * HTB, NXCD = 8, WGM = 8;

__host__ __device__ __forceinline__ int lds_byte(int r, int c) { const int st = (r >> 4) * 2 + (c >> 5), rr = r & 15, cc = c & 31, ob = rr * 64 + cc * 2; return st * 1024 + (ob ^ (((ob >> 9) & 1) << 5)); }
__host__ __device__ __forceinline__ void stage_rc(int b, int& R, int& C) { const int st = b / 1024, sb = b % 1024, swz = sb ^ (((sb >> 9) & 1) << 5); R = (st >> 1) * 16 + swz / 64; C = (st & 1) * 32 + (swz % 64) / 2; }
__host__ __device__ __forceinline__ int perm32(int rho) { const int n = rho >> 4, i = rho & 15; return 8 * (i >> 2) + 4 * n + (i & 3); }

struct Unit { int pm, pn; };
struct Gemm { const bf16_t* A; const bf16_t* Bt; int K; };

struct StaticOrder {
    int nM, nN, nwg, G, c;
    __device__ void init(int M, int N, int G_, int c_) { nM = M / BM; nN = N / BM; nwg = nM * nN; G = G_; c = c_; }
    __device__ bool next(int i, Unit& u) const {
        const long L = (long)i * G + c; if (L >= nwg) return false;
        int wgid = (int)L; { const int q = nwg / NXCD, r = nwg % NXCD, xcd = wgid % NXCD, off = wgid / NXCD; wgid = (xcd < r ? xcd * (q + 1) : r * (q + 1) + (xcd - r) * q) + off; }
        const int nig = WGM * nN, gid = wgid / nig, fm = gid * WGM, gsz = (nM - fm) < WGM ? (nM - fm) : WGM;
        u.pm = fm + ((wgid % nig) % gsz); u.pn = (wgid % nig) / gsz; return true;
    }
};
struct MoeOrder {
    const int* tile_e; int n_units, nN, G, vcu;
    __device__ bool next(int i, Unit& u) const {
        const long L = (long)i * G + vcu; if (L >= n_units) return false;
        const int mt = (int)L / nN, pl = (int)L % nN; const int e = __builtin_amdgcn_readfirstlane(__hip_atomic_load(tile_e + mt, __ATOMIC_RELAXED, __HIP_MEMORY_SCOPE_AGENT));
        u.pm = mt; u.pn = e * nN + pl; return true;
    }
};

__device__ __forceinline__ unsigned cvt_pk_bf16(float lo, float hi) { unsigned r; asm volatile("v_cvt_pk_bf16_f32 %0, %1, %2" : "=v"(r) : "v"(lo), "v"(hi)); return r; }
__device__ __forceinline__ float bf_lo(unsigned w) { return __uint_as_float(w << 16); }
__device__ __forceinline__ float bf_hi(unsigned w) { return __uint_as_float(w & 0xffff0000u); }
__device__ __forceinline__ float sigmoid_f(float x) { return __builtin_amdgcn_rcpf(1.0f + __builtin_amdgcn_exp2f(-LOG2E * x)); }

template <class Epi, class Sched>
__device__ __forceinline__ void gemm_phase(PG8_LAS unsigned char* lds, const Gemm g, const Sched& S, const Epi& E, const int wid_in) {
    int wid = wid_in; asm volatile("" : "+s"(wid));
    const int lane = lane_id_asm(), tid = wid * 64 + lane, wr = wid >> 2, wc = wid & 3, fr = lane & 15, fq = lane >> 4;
    int K_o = g.K; asm volatile("" : "+s"(K_o)); const int K = K_o, nt = K / BK;
    unsigned voff[2];
#pragma unroll
    for (int i = 0; i < 2; ++i) { int R, C; stage_rc(tid * 16 + i * 8192, R, C); voff[i] = (unsigned)(R * K + C) * 2u; }
    const size_t kstep = (size_t)(BK * 2);
    const size_t hstep = (size_t)HALF * K * 2;
    const size_t tstep = 2 * hstep;
    const unsigned ldsw = (unsigned)wid * 1024u;
    const int aoff = lds_byte(wr * 64 + fr, fq * 8), boff = lds_byte(wc * 32 + fr, fq * 8);
#define PG8_SA(b, h) (((b) * 2 + (h)) * HTB)
#define PG8_SB(b, h) ((4 + (b) * 2 + (h)) * HTB)
#define PG8_STAGE(bufoff, gbase) do { _Pragma("unroll") for (int _i = 0; _i < 2; ++_i) \
        __builtin_amdgcn_global_load_lds((const unsigned*)((const char*)(gbase) + voff[_i]), (PG8_LAS unsigned*)(lds + (bufoff) + ldsw + _i * 8192), 16, 0, 0); } while (0)
#define PG8_LDA(dst, b, h) do { _Pragma("unroll") for (int m = 0; m < 4; ++m) _Pragma("unroll") for (int k = 0; k < 2; ++k) dst[m][k] = *(const PG8_LAS bf16x8*)(lds + PG8_SA(b, h) + aoff + m * 2048 + k * 1024); } while (0)
#define PG8_LDB(dst, b, h) do { _Pragma("unroll") for (int n = 0; n < 2; ++n) _Pragma("unroll") for (int k = 0; k < 2; ++k) dst[n][k] = *(const PG8_LAS bf16x8*)(lds + PG8_SB(b, h) + boff + n * 2048 + k * 1024); } while (0)
#define PG8_MMA(ai, bj, At, Bt) do { __builtin_amdgcn_s_setprio(1); _Pragma("unroll") for (int m = 0; m < 4; ++m) _Pragma("unroll") for (int n = 0; n < 2; ++n) _Pragma("unroll") for (int k = 0; k < 2; ++k) \
        acc[ai][bj][m][n] = __builtin_amdgcn_mfma_f32_16x16x32_bf16(Bt[n][k], At[m][k], acc[ai][bj][m][n], 0, 0, 0); __builtin_amdgcn_s_setprio(0); } while (0)
#define PG8_WAIT_V(n) asm volatile("s_waitcnt vmcnt(" #n ")" ::: "memory")
#define PG8_WAIT_L(n) asm volatile("s_waitcnt lgkmcnt(" #n ")" ::: "memory")
#define PG8_BAR __builtin_amdgcn_s_barrier()
#define PG8_SCHED __builtin_amdgcn_sched_barrier(0)
    Unit cur, nxt; int ui = 0;
    if (!S.next(0, cur)) return;
    f32x4 acc[2][2][4][2];
#pragma unroll
    for (int a = 0; a < 2; ++a)
#pragma unroll
        for (int b = 0; b < 2; ++b)
#pragma unroll
            for (int m = 0; m < 4; ++m)
#pragma unroll
                for (int n = 0; n < 2; ++n) acc[a][b][m][n] = (f32x4){0.f, 0.f, 0.f, 0.f};
    bf16x8 At[4][2], B0[2][2], B1[2][2];
    const char* cA = (const char*)g.A + (size_t)cur.pm * tstep; const char* cB = (const char*)g.Bt + (size_t)cur.pn * tstep;
    PG8_STAGE(PG8_SB(0, 0), cB); PG8_STAGE(PG8_SB(0, 1), cB + hstep); PG8_STAGE(PG8_SA(0, 0), cA); PG8_STAGE(PG8_SA(0, 1), cA + hstep);
    if (wr == 1) PG8_BAR;
    PG8_WAIT_V(2); PG8_BAR;
    PG8_STAGE(PG8_SB(1, 0), cB + kstep); PG8_STAGE(PG8_SA(1, 0), cA + kstep); PG8_STAGE(PG8_SB(1, 1), cB + hstep + kstep);
    PG8_WAIT_V(6); PG8_BAR;
    for (;;) {
        const bool has_next = S.next(ui + 1, nxt);
        const char* nA = has_next ? (const char*)g.A + (size_t)nxt.pm * tstep : cA; const char* nB = has_next ? (const char*)g.Bt + (size_t)nxt.pn * tstep : cB;
        for (int t = 0; t < nt; t += 2) {
            const bool last = (t == nt - 2);
            const char* a1 = cA + (size_t)(t + 1) * kstep;
            const char* a2 = last ? nA : cA + (size_t)(t + 2) * kstep; const char* b2 = last ? nB : cB + (size_t)(t + 2) * kstep;
            const char* a3 = a2 + kstep; const char* b3 = b2 + kstep;
            PG8_LDB(B0, 0, 0); PG8_LDB(B1, 0, 1); PG8_SCHED; PG8_LDA(At, 0, 0); PG8_STAGE(PG8_SA(1, 1), a1 + hstep);
            PG8_WAIT_V(8); PG8_WAIT_L(0); PG8_BAR; PG8_MMA(0, 0, At, B0); PG8_MMA(0, 1, At, B1); PG8_BAR; PG8_SCHED;
            PG8_LDA(At, 0, 1); PG8_STAGE(PG8_SB(0, 0), b2); PG8_STAGE(PG8_SB(0, 1), b2 + hstep); PG8_STAGE(PG8_SA(0, 0), a2);
            PG8_WAIT_V(8); PG8_WAIT_L(0); PG8_BAR; PG8_MMA(1, 0, At, B0); PG8_MMA(1, 1, At, B1); PG8_BAR; PG8_SCHED;
            PG8_LDB(B0, 1, 0); PG8_LDB(B1, 1, 1); PG8_SCHED; PG8_LDA(At, 1, 0); PG8_STAGE(PG8_SA(0, 1), a2 + hstep);
            PG8_WAIT_V(8); PG8_WAIT_L(0); PG8_BAR; PG8_MMA(0, 0, At, B0); PG8_MMA(0, 1, At, B1); PG8_BAR; PG8_SCHED;
            PG8_LDA(At, 1, 1); PG8_STAGE(PG8_SB(1, 0), b3); PG8_STAGE(PG8_SB(1, 1), b3 + hstep); PG8_STAGE(PG8_SA(1, 0), a3);
            PG8_WAIT_V(8); PG8_WAIT_L(0); PG8_BAR; PG8_MMA(1, 0, At, B0); PG8_MMA(1, 1, At, B1); PG8_BAR; PG8_SCHED;
        }
        if (wr == 0) PG8_BAR;
        E(acc, cur, wr, wc, fr, fq);
        if (!has_next) break;
#pragma unroll
        for (int a = 0; a < 2; ++a)
#pragma unroll
            for (int b = 0; b < 2; ++b)
#pragma unroll
                for (int m = 0; m < 4; ++m)
#pragma unroll
                    for (int n = 0; n < 2; ++n) acc[a][b][m][n] = (f32x4){0.f, 0.f, 0.f, 0.f};
        cur = nxt; cA = nA; cB = nB; ++ui;
        if (wr == 1) PG8_BAR;
    }
    PG8_WAIT_V(0);
    PG8_BAR;
#undef PG8_SA
#undef PG8_SB
#undef PG8_STAGE
#undef PG8_LDA
#undef PG8_LDB
#undef PG8_MMA
#undef PG8_WAIT_V
#undef PG8_WAIT_L
#undef PG8_BAR
#undef PG8_SCHED
}

typedef int i32x4_t __attribute__((ext_vector_type(4)));
template <class Epi, class Sched>
__device__ __forceinline__ void gemm_phase_f8(PG8_LAS unsigned char* lds, const Gemm g, const Sched& S, const Epi& E, const int wid_in) {
    int wid = wid_in; asm volatile("" : "+s"(wid));
    const int lane = lane_id_asm(), tid = wid * 64 + lane, wr = wid >> 2, wc = wid & 3, fr = lane & 15, fq = lane >> 4;
    int K_o = g.K; asm volatile("" : "+s"(K_o)); const int K = K_o, nt = K / BK;
    unsigned voff[2];
#pragma unroll
    for (int i = 0; i < 2; ++i) { int R, C; stage_rc(tid * 16 + i * 8192, R, C); voff[i] = (unsigned)(R * K + C) * 2u; }
    const size_t kstep = (size_t)(BK * 2);
    const size_t hstep = (size_t)HALF * K * 2;
    const size_t tstep = 2 * hstep;
    const unsigned ldsw = (unsigned)wid * 1024u;
    const int aoff = lds_byte(wr * 64 + fr, fq * 16), boff = lds_byte(wc * 32 + fr, fq * 16);
#define PG8_SA(b, h) (((b) * 2 + (h)) * HTB)
#define PG8_SB(b, h) ((4 + (b) * 2 + (h)) * HTB)
#define PG8_STAGE(bufoff, gbase) do { _Pragma("unroll") for (int _i = 0; _i < 2; ++_i) \
        __builtin_amdgcn_global_load_lds((const unsigned*)((const char*)(gbase) + voff[_i]), (PG8_LAS unsigned*)(lds + (bufoff) + ldsw + _i * 8192), 16, 0, 0); } while (0)
#define PG8_LDA(dst, b, h) do { _Pragma("unroll") for (int m = 0; m < 4; ++m) _Pragma("unroll") for (int k = 0; k < 2; ++k) dst[m][k] = *(const PG8_LAS bf16x8*)(lds + PG8_SA(b, h) + aoff + m * 2048 + k * 16); } while (0)
#define PG8_LDB(dst, b, h) do { _Pragma("unroll") for (int n = 0; n < 2; ++n) _Pragma("unroll") for (int k = 0; k < 2; ++k) dst[n][k] = *(const PG8_LAS bf16x8*)(lds + PG8_SB(b, h) + boff + n * 2048 + k * 16); } while (0)
#define PG8_F8(x) __builtin_shufflevector(__builtin_bit_cast(i32x4_t, (x)[0]), __builtin_bit_cast(i32x4_t, (x)[1]), 0, 1, 2, 3, 4, 5, 6, 7)
#define PG8_MMA(ai, bj, At, Bt) do { __builtin_amdgcn_s_setprio(1); asm volatile("s_nop 1" ::: ); _Pragma("unroll") for (int m = 0; m < 4; ++m) _Pragma("unroll") for (int n = 0; n < 2; ++n) \
        asm volatile("v_mfma_f32_16x16x128_f8f6f4 %0, %1, %2, %0" : "+v"(acc[ai][bj][m][n]) : "v"(PG8_F8(Bt[n])), "v"(PG8_F8(At[m]))); __builtin_amdgcn_s_setprio(0); } while (0)
#define PG8_ACC_SETTLE asm volatile("s_nop 15\n\ts_nop 15" ::: "memory")
#define PG8_WAIT_V(n) asm volatile("s_waitcnt vmcnt(" #n ")" ::: "memory")
#define PG8_WAIT_L(n) asm volatile("s_waitcnt lgkmcnt(" #n ")" ::: "memory")
#define PG8_BAR __builtin_amdgcn_s_barrier()
#define PG8_SCHED __builtin_amdgcn_sched_barrier(0)
    Unit cur, nxt; int ui = 0; int sprev = 0;
    if (!S.next(0, cur)) return;
    f32x4 acc[2][2][4][2];
#pragma unroll
    for (int a = 0; a < 2; ++a)
#pragma unroll
        for (int b = 0; b < 2; ++b)
#pragma unroll
            for (int m = 0; m < 4; ++m)
#pragma unroll
                for (int n = 0; n < 2; ++n) acc[a][b][m][n] = (f32x4){0.f, 0.f, 0.f, 0.f};
    bf16x8 At[4][2], B0[2][2], B1[2][2];
    const char* cA = (const char*)g.A + (size_t)cur.pm * tstep; const char* cB = (const char*)g.Bt + (size_t)cur.pn * tstep;
    PG8_STAGE(PG8_SB(0, 0), cB); PG8_STAGE(PG8_SB(0, 1), cB + hstep); PG8_STAGE(PG8_SA(0, 0), cA); PG8_STAGE(PG8_SA(0, 1), cA + hstep);
    if (wr == 1) PG8_BAR;
    PG8_WAIT_V(2); PG8_BAR;
    PG8_STAGE(PG8_SB(1, 0), cB + kstep); PG8_STAGE(PG8_SA(1, 0), cA + kstep); PG8_STAGE(PG8_SB(1, 1), cB + hstep + kstep);
    PG8_WAIT_V(6); PG8_BAR;
    for (;;) {
        const bool has_next = S.next(ui + 1, nxt);
        const char* nA = has_next ? (const char*)g.A + (size_t)nxt.pm * tstep : cA; const char* nB = has_next ? (const char*)g.Bt + (size_t)nxt.pn * tstep : cB;
#define PG8_WAITSEL do { if (!first) { PG8_WAIT_V(8); } else if (sprev == 8) { PG8_WAIT_V(16); } else if (sprev == 16) { PG8_WAIT_V(24); } else { PG8_WAIT_V(40); } } while (0)
        for (int t = 0; t < nt; t += 2) {
            const bool last = (t == nt - 2);
            const bool first = (t == 0) && (sprev != 0);
            const char* a1 = cA + (size_t)(t + 1) * kstep;
            const char* a2 = last ? nA : cA + (size_t)(t + 2) * kstep; const char* b2 = last ? nB : cB + (size_t)(t + 2) * kstep;
            const char* a3 = a2 + kstep; const char* b3 = b2 + kstep;
            PG8_LDB(B0, 0, 0); PG8_LDB(B1, 0, 1); PG8_SCHED; PG8_LDA(At, 0, 0); if (!first) PG8_STAGE(PG8_SA(1, 1), a1 + hstep);
            PG8_WAITSEL; PG8_WAIT_L(0); PG8_BAR; PG8_MMA(0, 0, At, B0); PG8_MMA(0, 1, At, B1); PG8_BAR; PG8_SCHED;
            PG8_LDA(At, 0, 1); PG8_STAGE(PG8_SB(0, 0), b2); PG8_STAGE(PG8_SB(0, 1), b2 + hstep); PG8_STAGE(PG8_SA(0, 0), a2);
            PG8_WAITSEL; PG8_WAIT_L(0); PG8_BAR; PG8_MMA(1, 0, At, B0); PG8_MMA(1, 1, At, B1); PG8_BAR; PG8_SCHED;
            PG8_LDB(B0, 1, 0); PG8_LDB(B1, 1, 1); PG8_SCHED; PG8_LDA(At, 1, 0); PG8_STAGE(PG8_SA(0, 1), a2 + hstep);
            PG8_WAITSEL; PG8_WAIT_L(0); PG8_BAR; PG8_MMA(0, 0, At, B0); PG8_MMA(0, 1, At, B1); PG8_BAR; PG8_SCHED;
            PG8_LDA(At, 1, 1); PG8_STAGE(PG8_SB(1, 0), b3); PG8_STAGE(PG8_SB(1, 1), b3 + hstep); PG8_STAGE(PG8_SA(1, 0), a3);
            PG8_WAIT_V(8); PG8_WAIT_L(0); PG8_BAR; PG8_MMA(1, 0, At, B0); PG8_MMA(1, 1, At, B1); PG8_BAR; PG8_SCHED;
        }
#undef PG8_WAITSEL
        if (wr == 0) PG8_BAR;
        sprev = has_next ? E.nst(cur) : 0;
        if (sprev != 0) PG8_STAGE(PG8_SA(1, 1), nA + kstep + hstep);
        PG8_ACC_SETTLE;
        E(acc, cur, wr, wc, fr, fq);
        if (!has_next) break;
#pragma unroll
        for (int a = 0; a < 2; ++a)
#pragma unroll
            for (int b = 0; b < 2; ++b)
#pragma unroll
                for (int m = 0; m < 4; ++m)
#pragma unroll
                    for (int n = 0; n < 2; ++n) acc[a][b][m][n] = (f32x4){0.f, 0.f, 0.f, 0.f};
        cur = nxt; cA = nA; cB = nB; ++ui;
        if (wr == 1) PG8_BAR;
    }
    PG8_WAIT_V(0);
    PG8_BAR;
#undef PG8_SA
#undef PG8_SB
#undef PG8_STAGE
#undef PG8_LDA
#undef PG8_LDB
#undef PG8_MMA
#undef PG8_F8
#undef PG8_ACC_SETTLE
#undef PG8_WAIT_V
#undef PG8_WAIT_L
#undef PG8_BAR
#undef PG8_SCHED
}

#define EPI_ROWS(...) _Pragma("unroll") for (int ai = 0; ai < 2; ++ai) _Pragma("unroll") for (int m = 0; m < 4; ++m) { const int row = u.pm * BM + ai * HALF + wr * 64 + m * 16 + fr; __VA_ARGS__ }
__device__ __forceinline__ u32x4 pack8(const f32x4 a, const f32x4 b) { u32x4 w; w.x = cvt_pk_bf16(a[0], a[1]); w.y = cvt_pk_bf16(a[2], a[3]); w.z = cvt_pk_bf16(b[0], b[1]); w.w = cvt_pk_bf16(b[2], b[3]); return w; }

__device__ __forceinline__ u32x2 pack8_f8(const f32x4 a, const f32x4 b) { unsigned w0 = 0, w1 = 0;
    w0 = __builtin_amdgcn_cvt_pk_fp8_f32(a[0], a[1], w0, false); w0 = __builtin_amdgcn_cvt_pk_fp8_f32(a[2], a[3], w0, true);
    w1 = __builtin_amdgcn_cvt_pk_fp8_f32(b[0], b[1], w1, false); w1 = __builtin_amdgcn_cvt_pk_fp8_f32(b[2], b[3], w1, true); u32x2 r; r.x = w0; r.y = w1; return r; }
constexpr float W8_SCALE = 64.0f, W8_INV = 1.0f / 64.0f;
#define MK_QUAD(sidx, ctrl) { const unsigned as_ = (unsigned)__builtin_amdgcn_mov_dpp((int)a, ctrl, 0xf, 0xf, true), cs_ = (unsigned)__builtin_amdgcn_mov_dpp((int)c, ctrl, 0xf, 0xf, true); \
        const unsigned pr_ = ((q4 < 2 ? as_ : cs_) >> (16 * (q4 & 1))) & 0xffffu; lo |= (pr_ & 0xffu) << (8 * (sidx)); hi |= (pr_ >> 8) << (8 * (sidx)); }
struct EpiIn {
    __device__ __forceinline__ int nst(const Unit& u) const { const int pn = u.pn; if (pn >= 9 && pn < 14) return f8attn ? 8 : 32; if (pn == 14 && f8attn) return 32; return 16; }
    bf16_t* aqkv; bf16_t* qb; bf16_t* kb; bf16_t* vb; bf16_t* gate; const float* qg; const float* kg; const float* rope; float asc; bool f8attn;
    __device__ __forceinline__ void operator()(const f32x4 (&acc)[2][2][4][2], const Unit& u, int wr, int wc, int fr, int fq) const {
        const int pn = u.pn;
        if (pn >= 9 && pn < 14) {
            const bool isq = pn < 13; const int head = isq ? (pn - 9) * 4 + wc : wc; bf16_t* dst = isq ? qb : kb; const int pitch = isq ? 1024 : 256;
            const float* gvec = isq ? qg : kg; const float osc = isq ? C2 : 1.0f;
            f32x4 gv[2][2];
#pragma unroll
            for (int bj = 0; bj < 2; ++bj)
#pragma unroll
                for (int n = 0; n < 2; ++n) gv[bj][n] = *(const f32x4*)(gvec + 32 * bj + 16 * n + 4 * fq);
            f32x4 csr[2], snr[2], csc[4], snc[4];
#pragma unroll
            for (int ai = 0; ai < 2; ++ai) { const int pr = ((u.pm * BM + ai * HALF + wr * 64) & (SEQ - 1)) >> 6; csr[ai] = *(const f32x4*)(rope + pr * 16 + 4 * fq); snr[ai] = *(const f32x4*)(rope + 1024 + pr * 16 + 4 * fq); }
#pragma unroll
            for (int m = 0; m < 4; ++m) { const int pc = m * 16 + fr; csc[m] = *(const f32x4*)(rope + pc * 16 + 4 * fq); snc[m] = *(const f32x4*)(rope + 1024 + pc * 16 + 4 * fq); }
            EPI_ROWS(
                float ss = 0.f;
                _Pragma("unroll") for (int bj = 0; bj < 2; ++bj) _Pragma("unroll") for (int n = 0; n < 2; ++n) { const f32x4 x = acc[ai][bj][m][n] * asc; ss += (x[0] * x[0] + x[1] * x[1]) + (x[2] * x[2] + x[3] * x[3]); }
                ss = xsum<16>(ss); ss = xsum<32>(ss);
                const float sc = rsqrtf(ss * (1.0f / 64.0f) + EPS) * osc * asc;
                u32x4 w8;
                _Pragma("unroll") for (int bj = 0; bj < 2; ++bj) {
                    const f32x4 cs = bj == 0 ? csr[ai] : csc[m]; const f32x4 sn = bj == 0 ? snr[ai] : snc[m];
                    const f32x4 y0 = acc[ai][bj][m][0] * sc * gv[bj][0]; const f32x4 y1 = acc[ai][bj][m][1] * sc * gv[bj][1];
                    const f32x4 o0 = y0 * cs - y1 * sn; const f32x4 o1 = y1 * cs + y0 * sn;
                    if (f8attn) {
                        unsigned a = 0, b = 0; a = __builtin_amdgcn_cvt_pk_fp8_f32(o0[0], o0[1], a, false); a = __builtin_amdgcn_cvt_pk_fp8_f32(o0[2], o0[3], a, true);
                        b = __builtin_amdgcn_cvt_pk_fp8_f32(o1[0], o1[1], b, false); b = __builtin_amdgcn_cvt_pk_fp8_f32(o1[2], o1[3], b, true);
                        w8[2 * bj] = a; w8[2 * bj + 1] = b;
                    } else {
                    bf16_t* p = dst + (size_t)row * pitch + head * 64 + 32 * bj + 4 * fq;
                    u32x2 w0; w0.x = cvt_pk_bf16(o0[0], o0[1]); w0.y = cvt_pk_bf16(o0[2], o0[3]);
                    u32x2 w1; w1.x = cvt_pk_bf16(o1[0], o1[1]); w1.y = cvt_pk_bf16(o1[2], o1[3]);
                    *(u32x2*)p = w0; *(u32x2*)(p + 16) = w1; }
                }
                if (f8attn) *(u32x4*)((unsigned char*)dst + (size_t)row * pitch + head * 64 + 16 * fq) = w8;
            )
        } else if (pn == 14 && f8attn) {
            unsigned char* vt = (unsigned char*)vb;
            const int q4 = fr & 3;
            EPI_ROWS(
                const int b = row >> 12; const int t = row & (SEQ - 1); const int kk = t & 63;
                const int pos4 = 32 * ((kk >> 2) & 1) + 4 * ((kk >> 3) & 3) + 16 * (kk >> 5);
                _Pragma("unroll") for (int bj = 0; bj < 2; ++bj) {
                    const int kvh = bj * 2 + (wc >> 1); const int d0 = (wc & 1) * 32 + 8 * fq;
                    const f32x4 v0 = acc[ai][bj][m][0] * asc; const f32x4 v1 = acc[ai][bj][m][1] * asc;
                    unsigned a = 0, c = 0; a = __builtin_amdgcn_cvt_pk_fp8_f32(v0[0], v0[1], a, false); a = __builtin_amdgcn_cvt_pk_fp8_f32(v0[2], v0[3], a, true);
                    c = __builtin_amdgcn_cvt_pk_fp8_f32(v1[0], v1[1], c, false); c = __builtin_amdgcn_cvt_pk_fp8_f32(v1[2], v1[3], c, true);
                    unsigned lo = 0, hi = 0;
                    MK_QUAD(0, 0x00) MK_QUAD(1, 0x55) MK_QUAD(2, 0xAA) MK_QUAD(3, 0xFF)
                    unsigned char* p = vt + ((size_t)((b * 4 + kvh) * 64 + d0 + 2 * q4) << 12) + (t & ~63) + pos4;
                    *(unsigned*)p = lo; *(unsigned*)(p + 4096) = hi;
                }
            )
        } else {
            bf16_t* dst; int pitch, colt, dsh = 0; float sc = asc; bool sig = false, fold = false;
            if (pn < 9) { dst = aqkv + (size_t)pn * T * 256; pitch = 256; colt = 0; fold = true; dsh = 2 * (pn / 3); if (pn % 3 == 0) sc = C2 * asc; }
            else if (pn == 14) { dst = vb; pitch = 256; colt = 0; }
            else { dst = gate; pitch = 2048; colt = (pn - 15) * 256; sig = true; }
            const int col0 = colt + wc * 32 + 8 * fq;
            EPI_ROWS(
                int drow = row;
                if (fold) { const int t = row & (SEQ - 1); drow = (row & ~(SEQ - 1)) | ((t & ((1 << dsh) - 1)) << (12 - dsh)) | (t >> dsh); }
                bf16_t* rowp = dst + (size_t)drow * pitch + col0;
                _Pragma("unroll") for (int bj = 0; bj < 2; ++bj) {
                    f32x4 v0 = acc[ai][bj][m][0], v1 = acc[ai][bj][m][1];
                    if (sig) { _Pragma("unroll") for (int j = 0; j < 4; ++j) { v0[j] = sigmoid_f(v0[j] * asc); v1[j] = sigmoid_f(v1[j] * asc); } }
                    else { v0 = v0 * sc; v1 = v1 * sc; }
                    *(u32x4*)(rowp + bj * HALF) = pack8(v0, v1);
                }
            )
        }
    }
};
struct EpiMergeA {
    __device__ __forceinline__ int nst(const Unit&) const { return 16; }
    const bf16_t* gate; bf16_t* merged;
    __device__ __forceinline__ void operator()(const f32x4 (&acc)[2][2][4][2], const Unit& u, int wr, int wc, int fr, int fq) const {
        const int col0 = u.pn * BM + wc * 32 + 8 * fq;
#pragma unroll
        for (int ai = 0; ai < 2; ++ai) {
            u32x4 gwv[4][2];
#pragma unroll
            for (int m = 0; m < 4; ++m)
#pragma unroll
                for (int bj = 0; bj < 2; ++bj) gwv[m][bj] = *(const u32x4*)(gate + (size_t)(u.pm * BM + ai * HALF + wr * 64 + m * 16 + fr) * 2048 + col0 + bj * HALF);
            asm volatile("" ::: "memory");
#pragma unroll
            for (int m = 0; m < 4; ++m)
#pragma unroll
                for (int bj = 0; bj < 2; ++bj) { const int row = u.pm * BM + ai * HALF + wr * 64 + m * 16 + fr; const u32x4 gw = gwv[m][bj];
                    f32x4 v0 = acc[ai][bj][m][0] * W8_INV, v1 = acc[ai][bj][m][1] * W8_INV;
                    v0[0] *= bf_lo(gw.x); v0[1] *= bf_hi(gw.x); v0[2] *= bf_lo(gw.y); v0[3] *= bf_hi(gw.y);
                    v1[0] *= bf_lo(gw.z); v1[1] *= bf_hi(gw.z); v1[2] *= bf_lo(gw.w); v1[3] *= bf_hi(gw.w);
                    *(u32x4*)(merged + (size_t)row * 1024 + col0 + bj * HALF) = pack8(v0, v1); }
            asm volatile("" ::: "memory");
        }
    }
};
template <bool F8> struct EpiMergeB {
    __device__ __forceinline__ int nst(const Unit&) const { return 16; }
    const bf16_t* gate; const bf16_t* merged; unsigned char* m8;
    __device__ __forceinline__ void operator()(const f32x4 (&acc)[2][2][4][2], const Unit& u, int wr, int wc, int fr, int fq) const {
        const int col0 = u.pn * BM + wc * 32 + 8 * fq;
#pragma unroll
        for (int ai = 0; ai < 2; ++ai) {
            u32x4 gwv[4][2], mwv[4][2];
#pragma unroll
            for (int m = 0; m < 4; ++m)
#pragma unroll
                for (int bj = 0; bj < 2; ++bj) { const int row = u.pm * BM + ai * HALF + wr * 64 + m * 16 + fr;
                    gwv[m][bj] = *(const u32x4*)(gate + (size_t)row * 2048 + 1024 + col0 + bj * HALF); mwv[m][bj] = *(const u32x4*)(merged + (size_t)row * 1024 + col0 + bj * HALF); }
            asm volatile("" ::: "memory");
#pragma unroll
            for (int m = 0; m < 4; ++m)
#pragma unroll
                for (int bj = 0; bj < 2; ++bj) { const int row = u.pm * BM + ai * HALF + wr * 64 + m * 16 + fr; const u32x4 gw = gwv[m][bj], mw = mwv[m][bj];
                f32x4 v0 = acc[ai][bj][m][0] * (F8 ? W8_INV : 1.0f), v1 = acc[ai][bj][m][1] * (F8 ? W8_INV : 1.0f);
                v0[0] = v0[0] * bf_lo(gw.x) + bf_lo(mw.x); v0[1] = v0[1] * bf_hi(gw.x) + bf_hi(mw.x); v0[2] = v0[2] * bf_lo(gw.y) + bf_lo(mw.y); v0[3] = v0[3] * bf_hi(gw.y) + bf_hi(mw.y);
                v1[0] = v1[0] * bf_lo(gw.z) + bf_lo(mw.z); v1[1] = v1[1] * bf_hi(gw.z) + bf_hi(mw.z); v1[2] = v1[2] * bf_lo(gw.w) + bf_lo(mw.w); v1[3] = v1[3] * bf_hi(gw.w) + bf_hi(mw.w);
                *(u32x2*)(m8 + (size_t)row * 1024 + col0 + bj * HALF) = pack8_f8(v0, v1); }
            asm volatile("" ::: "memory");
        }
    }
};
struct EpiOut {
    __device__ __forceinline__ int nst(const Unit&) const { return 32; }
    const float* xin; float* xout; const float* g1;
    __device__ __forceinline__ void operator()(const f32x4 (&acc)[2][2][4][2], const Unit& u, int wr, int wc, int fr, int fq) const {
        const int col0 = u.pn * BM + wc * 32 + 8 * fq; const int b = (u.pm * BM) >> 12;
        f32x4 gv[2][2];
#pragma unroll
        for (int bj = 0; bj < 2; ++bj)
#pragma unroll
            for (int n = 0; n < 2; ++n) gv[bj][n] = *(const f32x4*)(g1 + (size_t)b * 6144 + col0 + bj * HALF + 4 * n);
#pragma unroll
        for (int ai = 0; ai < 2; ++ai) {
            f32x4 xv[4][2][2];
#pragma unroll
            for (int m = 0; m < 4; ++m)
#pragma unroll
                for (int bj = 0; bj < 2; ++bj) { const size_t off = (size_t)(u.pm * BM + ai * HALF + wr * 64 + m * 16 + fr) * 1024 + col0 + bj * HALF;
                    xv[m][bj][0] = *(const f32x4*)(xin + off); xv[m][bj][1] = *(const f32x4*)(xin + off + 4); }
            asm volatile("" ::: "memory");
#pragma unroll
            for (int m = 0; m < 4; ++m)
#pragma unroll
                for (int bj = 0; bj < 2; ++bj) { const size_t off = (size_t)(u.pm * BM + ai * HALF + wr * 64 + m * 16 + fr) * 1024 + col0 + bj * HALF;
                    *(f32x4*)(xout + off) = xv[m][bj][0] + gv[bj][0] * (acc[ai][bj][m][0] * W8_INV); *(f32x4*)(xout + off + 4) = xv[m][bj][1] + gv[bj][1] * (acc[ai][bj][m][1] * W8_INV); }
            asm volatile("" ::: "memory");
        }
    }
};
struct EpiGU {
    const float* bgu; bf16_t* act;
    __device__ __forceinline__ void operator()(const f32x4 (&acc)[2][2][4][2], const Unit& u, int wr, int wc, int fr, int fq) const {
        const int e = u.pn >> 3, pl = u.pn & 7; const int c0 = pl * 128 + wc * 32 + 8 * fq;
        const float* bp = bgu + (size_t)e * 2048 + c0;
        const f32x4 bg0 = *(const f32x4*)bp, bg1 = *(const f32x4*)(bp + 4), bl0 = *(const f32x4*)(bp + 1024), bl1 = *(const f32x4*)(bp + 1028);
        EPI_ROWS(
            f32x4 o[2];
            _Pragma("unroll") for (int n = 0; n < 2; ++n) {
                const f32x4 gl = acc[ai][0][m][n] + (n == 0 ? bg0 : bg1); const f32x4 ln = acc[ai][1][m][n] + (n == 0 ? bl0 : bl1);
                _Pragma("unroll") for (int j = 0; j < 4; ++j) { const float xg = fminf(gl[j], 7.0f); const float xl = fminf(fmaxf(ln[j], -7.0f), 7.0f); o[n][j] = xg * sigmoid_f(1.702f * xg) * (xl + 1.0f); }
            }
            *(u32x4*)(act + (size_t)row * 1024 + c0) = pack8(o[0], o[1]);
        )
    }
};
struct EpiGU8 {
    __device__ __forceinline__ int nst(const Unit&) const { return 8; }
    const float* bgu; unsigned char* act;
    __device__ __forceinline__ void operator()(const f32x4 (&acc)[2][2][4][2], const Unit& u, int wr, int wc, int fr, int fq) const {
        const int e = u.pn >> 3, pl = u.pn & 7; const int c0 = pl * 128 + wc * 32 + 8 * fq;
        const float* bp = bgu + (size_t)e * 2048 + c0;
        const f32x4 bg0 = *(const f32x4*)bp, bg1 = *(const f32x4*)(bp + 4), bl0 = *(const f32x4*)(bp + 1024), bl1 = *(const f32x4*)(bp + 1028);
        EPI_ROWS(
            f32x4 o[2];
            _Pragma("unroll") for (int n = 0; n < 2; ++n) {
                const f32x4 gl = acc[ai][0][m][n] * W8_INV + (n == 0 ? bg0 : bg1); const f32x4 ln = acc[ai][1][m][n] * W8_INV + (n == 0 ? bl0 : bl1);
                _Pragma("unroll") for (int j = 0; j < 4; ++j) { const float xg = fminf(gl[j], 7.0f); const float xl = fminf(fmaxf(ln[j], -7.0f), 7.0f); o[n][j] = xg * sigmoid_f(1.702f * xg) * (xl + 1.0f); }
            }
            *(u32x2*)(act + (size_t)row * 1024 + c0) = pack8_f8(o[0], o[1]);
        )
    }
};
struct EpiDN8 {
    __device__ __forceinline__ int nst(const Unit&) const { return 16; }
    const float* bdn; const float* roww; unsigned char* y;
    __device__ __forceinline__ void operator()(const f32x4 (&acc)[2][2][4][2], const Unit& u, int wr, int wc, int fr, int fq) const {
        const int e = u.pn >> 2, pl = u.pn & 3; const int col0 = pl * BM + wc * 32 + 8 * fq;
        f32x4 bv[2][2];
#pragma unroll
        for (int bj = 0; bj < 2; ++bj)
#pragma unroll
            for (int n = 0; n < 2; ++n) bv[bj][n] = *(const f32x4*)(bdn + (size_t)e * 1024 + col0 + bj * HALF + 4 * n);
        float wv[2][4];
#pragma unroll
        for (int ai = 0; ai < 2; ++ai)
#pragma unroll
            for (int m = 0; m < 4; ++m) wv[ai][m] = roww[u.pm * BM + ai * HALF + wr * 64 + m * 16 + fr];
        EPI_ROWS(
            const float w = wv[ai][m];
            _Pragma("unroll") for (int bj = 0; bj < 2; ++bj)
                *(u32x2*)(y + (size_t)row * 1024 + col0 + bj * HALF) = pack8_f8((acc[ai][bj][m][0] * W8_INV + bv[bj][0]) * w, (acc[ai][bj][m][1] * W8_INV + bv[bj][1]) * w);
        )
    }
};
struct EpiDN {
    const float* bdn; const float* roww; bf16_t* y;
    __device__ __forceinline__ void operator()(const f32x4 (&acc)[2][2][4][2], const Unit& u, int wr, int wc, int fr, int fq) const {
        const int e = u.pn >> 2, pl = u.pn & 3; const int col0 = pl * BM + wc * 32 + 8 * fq;
        f32x4 bv[2][2];
#pragma unroll
        for (int bj = 0; bj < 2; ++bj)
#pragma unroll
            for (int n = 0; n < 2; ++n) bv[bj][n] = *(const f32x4*)(bdn + (size_t)e * 1024 + col0 + bj * HALF + 4 * n);
        EPI_ROWS(
            const float w = roww[row];
            _Pragma("unroll") for (int bj = 0; bj < 2; ++bj)
                *(u32x4*)(y + (size_t)row * 1024 + col0 + bj * HALF) = pack8((acc[ai][bj][m][0] + bv[bj][0]) * w, (acc[ai][bj][m][1] + bv[bj][1]) * w);
        )
    }
};
}

namespace attn_body {
using bf16 = __hip_bfloat16;
using bf16x8 = __attribute__((ext_vector_type(8))) short;
using s16x4 = __attribute__((ext_vector_type(4))) short;
using f32x16 = __attribute__((ext_vector_type(16))) float;
using u32x4 = __attribute__((ext_vector_type(4))) unsigned;
constexpr int D = 64, NW = 8, QBLK = 32, QB = QBLK * NW, KVBLK = 64;
__device__ __forceinline__ int crow(int r, int hi) { return (r & 3) + 8 * (r >> 2) + 4 * hi; }
#define SBAR() __builtin_amdgcn_sched_barrier(0)
constexpr int NSLOT = 3, SLOTB = 8192;
constexpr int LDS_K = 0, LDS_V = NSLOT * SLOTB, LDS_WS = 2 * NSLOT * SLOTB, LDS_OST = LDS_WS + NW * 64 * 4, LDS_LUT = LDS_OST + NW * 4096, LUT_N = 768, LDS_BYTES = LDS_LUT + LUT_N * 4;
constexpr bool OB_F8 = true;
constexpr float MFLOOR = -1024.0f;
__device__ __forceinline__ void glds16(const void* gsrc, unsigned lds_dst) { unsigned keep;
  asm volatile("s_mov_b32 %0, m0\n\ts_mov_b32 m0, %2\n\ts_nop 0\n\tglobal_load_lds_dwordx4 %1, off\n\ts_mov_b32 m0, %0" : "=&s"(keep) : "v"(gsrc), "s"(lds_dst) : "memory"); }
__device__ __forceinline__ float max3f(float a, float b, float c) { float r; asm("v_max3_f32 %0, %1, %2, %3" : "=v"(r) : "v"(a), "v"(b), "v"(c)); return r; }
__device__ __forceinline__ float max2f(float a, float b) { float r; asm("v_max_f32_e32 %0, %1, %2" : "=v"(r) : "v"(a), "v"(b)); return r; }
__device__ __forceinline__ float fadd_s(float a, float b) { float r; asm("v_add_f32_e32 %0, %1, %2" : "=v"(r) : "v"(a), "v"(b)); return r; }
__device__ __forceinline__ float fsub_s(float a, float b) { float r; asm("v_sub_f32_e32 %0, %1, %2" : "=v"(r) : "v"(a), "v"(b)); return r; }
typedef float f32x2_t __attribute__((ext_vector_type(2))); typedef __bf16 bf16x2_t __attribute__((ext_vector_type(2)));
__device__ __forceinline__ unsigned cvtpk_s(float lo, float hi) { f32x2_t v = {lo, hi}; bf16x2_t b = __builtin_convertvector(v, bf16x2_t); return __builtin_bit_cast(unsigned, b); }
#define WAIT_BAR(N) asm volatile("s_waitcnt vmcnt(" #N ") lgkmcnt(0)\n\ts_barrier" ::: "memory")

__device__ __forceinline__ void qkt(f32x16& p0, f32x16& p1, const char* Kslot, const bf16x8* qr, const f32x16& negm, int r32, int hi) {
  const char* kb = Kslot + hi * 1024 + r32 * 16;
  #pragma unroll
  for (int d0 = 0; d0 < 4; ++d0) {
    const bf16x8 b0 = *reinterpret_cast<const bf16x8*>(kb + d0 * 2048);
    const bf16x8 b1 = *reinterpret_cast<const bf16x8*>(kb + d0 * 2048 + 512);
    if (d0 == 0) { p0 = __builtin_amdgcn_mfma_f32_32x32x16_bf16(b0, qr[0], negm, 0, 0, 0); p1 = __builtin_amdgcn_mfma_f32_32x32x16_bf16(b1, qr[0], negm, 0, 0, 0); }
    else { p0 = __builtin_amdgcn_mfma_f32_32x32x16_bf16(b0, qr[d0], p0, 0, 0, 0); p1 = __builtin_amdgcn_mfma_f32_32x32x16_bf16(b1, qr[d0], p1, 0, 0, 0); } }
}
typedef __attribute__((address_space(3))) const char* lds_cptr;
typedef short v4i16_t __attribute__((ext_vector_type(4)));
__device__ __forceinline__ void kload8(bf16x8* kf, lds_cptr kp) {
  kf[0] = *(const __attribute__((address_space(3))) bf16x8*)(kp);        kf[1] = *(const __attribute__((address_space(3))) bf16x8*)(kp + 512);
  kf[2] = *(const __attribute__((address_space(3))) bf16x8*)(kp + 2048); kf[3] = *(const __attribute__((address_space(3))) bf16x8*)(kp + 2560);
  kf[4] = *(const __attribute__((address_space(3))) bf16x8*)(kp + 4096); kf[5] = *(const __attribute__((address_space(3))) bf16x8*)(kp + 4608);
  kf[6] = *(const __attribute__((address_space(3))) bf16x8*)(kp + 6144); kf[7] = *(const __attribute__((address_space(3))) bf16x8*)(kp + 6656);
}
__device__ __forceinline__ void kload2(bf16x8* kf, lds_cptr kp, int j) { kf[2 * j] = *(const __attribute__((address_space(3))) bf16x8*)(kp + j * 2048); kf[2 * j + 1] = *(const __attribute__((address_space(3))) bf16x8*)(kp + j * 2048 + 512); }
__device__ __forceinline__ s16x4 vtr(lds_cptr p) { return __builtin_bit_cast(s16x4, __builtin_amdgcn_ds_read_tr16_b64_v4i16((__attribute__((address_space(3))) v4i16_t*)p)); }
__device__ __forceinline__ float rowmax(const f32x16& p0, const f32x16& p1) {
  float a = max3f(p0[0], p0[1], p1[0]), b = max3f(p0[2], p0[3], p1[1]); a = max3f(a, p1[2], p1[3]);
  #pragma unroll
  for (int r = 4; r < 16; r += 4) { a = max3f(a, p0[r], p0[r + 1]); b = max3f(b, p0[r + 2], p0[r + 3]); a = max3f(a, p1[r], p1[r + 1]); b = max3f(b, p1[r + 2], p1[r + 3]); }
  const float m = max2f(a, b);
  auto rr = __builtin_amdgcn_permlane32_swap(__float_as_uint(m), __float_as_uint(m), false, false);
  return max2f(__uint_as_float(rr[0]), __uint_as_float(rr[1]));
}
__device__ __forceinline__ void pv(f32x16* o, int vb, bf16x8 pa0, bf16x8 pa1, bf16x8 pa2, bf16x8 pa3) {
  #pragma unroll
  for (int d0 = 0; d0 < 2; ++d0) { s16x4 lo[4], hi[4];
    #pragma unroll
    for (int ks = 0; ks < 4; ++ks) {
      asm volatile("ds_read_b64_tr_b16 %0,%1 offset:%c2" : "=&v"(lo[ks]) : "v"(vb), "i"(d0 * 4096 + ks * 1024) : "memory");
      asm volatile("ds_read_b64_tr_b16 %0,%1 offset:%c2" : "=&v"(hi[ks]) : "v"(vb), "i"(d0 * 4096 + ks * 1024 + 512) : "memory"); }
    asm volatile("s_waitcnt lgkmcnt(0)" ::: "memory"); SBAR();
    #define PK(k) (bf16x8){lo[k][0], lo[k][1], lo[k][2], lo[k][3], hi[k][0], hi[k][1], hi[k][2], hi[k][3]}
    o[d0] = __builtin_amdgcn_mfma_f32_32x32x16_bf16(pa0, PK(0), o[d0], 0, 0, 0);
    o[d0] = __builtin_amdgcn_mfma_f32_32x32x16_bf16(pa1, PK(1), o[d0], 0, 0, 0);
    o[d0] = __builtin_amdgcn_mfma_f32_32x32x16_bf16(pa2, PK(2), o[d0], 0, 0, 0);
    o[d0] = __builtin_amdgcn_mfma_f32_32x32x16_bf16(pa3, PK(3), o[d0], 0, 0, 0);
    #undef PK
  }
}
struct Job { const bf16* Q; const bf16* K; const bf16* V; bf16* O; float* lse; const float* lutg; int NT, i0, kq0, dsh, cls; };
template <int MODE, int THRL, bool NOMAX = false> __device__ __forceinline__ void attn_unit(const Job& J, char* shm, const int wid_in) {
  int wid = wid_in; asm volatile("" : "+s"(wid));
  constexpr int QP = MODE == 0 ? 1024 : 256, KP = 256;
  const int lane = lane_id_asm(), tid = wid * 64 + lane, r32 = lane & 31, hi = lane >> 5;
  const bf16* Qw = J.Q + (long)(wid * QBLK) * QP;
  const bf16* Kh = J.K; const bf16* Vh = J.V;
  const unsigned lds0 = (unsigned)(uintptr_t)shm;
  float* wsf = (float*)(shm + LDS_WS) + wid * 64;
  const bf16* ksrc = Kh + (long)lane * KP + wid * 8;
  const bf16* vsrc = Vh + (long)(16 * (wid & 3) + (lane >> 2)) * KP + (wid >> 2) * 32 + (lane & 3) * 8;
  const unsigned kdst = lds0 + LDS_K + wid * 1024, vdst = lds0 + LDS_V + wid * 1024;
  #define DMA_K(t, slot) glds16(ksrc + (long)(t) * KVBLK * KP, (unsigned)__builtin_amdgcn_readfirstlane(kdst + (slot)))
  #define DMA_V(t, slot) glds16(vsrc + (long)(t) * KVBLK * KP, (unsigned)__builtin_amdgcn_readfirstlane(vdst + (slot)))
  const int vb0 = (int)(lds0 + LDS_V) + ((lane >> 4) & 1) * 32 + (lane & 3) * 8 + (4 * hi + ((lane & 15) >> 2)) * 64;
  const char* Kbase = shm + LDS_K; bf16x8 kf[8];
  const lds_cptr shm3 = (lds_cptr)shm; const lds_cptr kp0 = shm3 + LDS_K + hi * 1024 + r32 * 16; const lds_cptr vp0 = shm3 + LDS_V + ((lane >> 4) & 1) * 32 + (lane & 3) * 8 + (4 * hi + ((lane & 15) >> 2)) * 64;
  const int NT = J.NT;
  if (MODE == 1) {
    __attribute__((address_space(3))) float* lut = (__attribute__((address_space(3))) float*)(shm3 + LDS_LUT);
    lut[tid] = J.lutg[tid]; if (tid < LUT_N - 512) lut[512 + tid] = J.lutg[512 + tid];
  }
  DMA_K(0, 0); DMA_V(0, 0); DMA_K(1, SLOTB);
  bf16x8 qr[4];
  #pragma unroll
  for (int d0 = 0; d0 < 4; ++d0) qr[d0] = *reinterpret_cast<const bf16x8*>(&Qw[(long)r32 * QP + d0 * 16 + hi * 8]);
  float mhat = 0.f, l_reg = 0.f; f32x16 o[2]; o[0] = f32x16{}; o[1] = f32x16{}; f32x16 negm = f32x16{}; if (!NOMAX) asm volatile("" : "+v"(negm));
  const int qrel = wid * QBLK + r32;
  const __attribute__((address_space(3))) float* lutq = (const __attribute__((address_space(3))) float*)(shm3 + LDS_LUT) + (J.kq0 - qrel + 383 + 4 * hi);
  #define CMASK(P0, P1, t) do { if (MODE == 1) { const __attribute__((address_space(3))) float* lp_ = lutq + 64 * (t); \
      _Pragma("unroll") for (int r = 0; r < 16; ++r) { const int ko_ = (r & 3) + 8 * (r >> 2); P0[r] += lp_[ko_]; P1[r] += lp_[ko_ + 32]; } } } while (0)
  bool resc = false;
  #define START(P0, P1) do { resc = false; if (!NOMAX) { const float rm = rowmax(P0, P1); \
    const float dl = MODE == 1 ? max2f(rm, MFLOOR) : rm; mhat = fadd_s(mhat, dl); \
      _Pragma("unroll") for (int r = 0; r < 16; ++r) { P0[r] = fsub_s(P0[r], dl); P1[r] = fsub_s(P1[r], dl); } \
      _Pragma("unroll") for (int r = 0; r < 16; ++r) negm[r] = -mhat; asm volatile("" : "+v"(negm)); } \
    _Pragma("unroll") for (int r = 0; r < 16; ++r) P0[r] = __builtin_amdgcn_exp2f(P0[r]); } while (0)
  #define RESC() do { if (resc) { asm volatile("s_waitcnt lgkmcnt(0)" ::: "memory"); \
      _Pragma("unroll") for (int d_ = 0; d_ < 2; ++d_) _Pragma("unroll") for (int r = 0; r < 16; ++r) o[d_][r] *= wsf[crow(r, hi)]; } } while (0)
  f32x16 pA0, pA1, pB0, pB1;
  int sl_prev = 0, sl_cur = 0, sl_next = SLOTB;
  #define ROT() do { sl_prev = sl_cur; sl_cur = sl_next; sl_next = (sl_next == (NSLOT - 1) * SLOTB) ? 0 : sl_next + SLOTB; } while (0)
  DMA_K(2, 2 * SLOTB);
  WAIT_BAR(3);
  qkt(pA0, pA1, Kbase, qr, negm, r32, hi); asm volatile("s_nop 15\n\ts_nop 7" : "+v"(pA0), "+v"(pA1)); CMASK(pA0, pA1, 0);
  START(pA0, pA1);
  _Pragma("unroll") for (int r = 0; r < 16; ++r) pA1[r] = __builtin_amdgcn_exp2f(pA1[r]);
  WAIT_BAR(0);
  DMA_K(3, 0); DMA_V(1, SLOTB);
  ROT();
  kload8(kf, kp0 + sl_cur);
  WAIT_BAR(2);
  s16x4 vlo[8], vhi[8]; u32x4 pw0, pw1, pw2, pw3;
  #define PKW(P, B) cvtpk_s(P[B], P[B + 1])
  #define PAF(k) __builtin_bit_cast(bf16x8, pw##k)
  #define VFR(i) (bf16x8){vlo[i][0], vlo[i][1], vlo[i][2], vlo[i][3], vhi[i][0], vhi[i][1], vhi[i][2], vhi[i][3]}
  #define PIN(x) asm volatile("" : "+v"(x))
  #define MX3(a, b, c) __builtin_fmaxf(__builtin_fmaxf((a), (b)), (c))
  #define GAPA(MF, A0, A1, A2, A3, W0, W1, PW) do { MF; sacc += A0; sacc += A1; sacc += A2; sacc += A3; PIN(sacc); W0; W1; PIN(PW); SBAR(); } while (0)
  #define EX(v) __builtin_amdgcn_exp2f(v)
  #define GAPB(MF, X, B) do { MF; X[B] = EX(X[B]); X[B + 1] = EX(X[B + 1]); X[B + 2] = EX(X[B + 2]); X[B + 3] = EX(X[B + 3]); PIN(X); SBAR(); } while (0)
  #define VRD(i) do { vlo[i] = vtr(vp_ + (((i) >> 2) * 4096 + ((i) & 3) * 1024)); vhi[i] = vtr(vp_ + (((i) >> 2) * 4096 + ((i) & 3) * 1024 + 512)); } while (0)
  #define KRD(G, j) do { if (G) { kload2(kf, kp0 + sl_next, j); SBAR(); } } while (0)
  #define STEP(C0, C1, P0, P1, t, GK, GV, GL) do { SBAR(); \
    const lds_cptr vp_ = vp0 + sl_prev; \
    VRD(0); SBAR(); float sacc = (P0[0] + P0[1]); \
    GAPA(C0 = __builtin_amdgcn_mfma_f32_32x32x16_bf16(kf[0], qr[0], negm, 0, 0, 0), P0[2], P0[3], P0[4], P0[5],     pw0[0] = PKW(P0, 0), pw0[1] = PKW(P0, 2), pw0); \
    VRD(4); SBAR(); GAPA(C1 = __builtin_amdgcn_mfma_f32_32x32x16_bf16(kf[1], qr[0], negm, 0, 0, 0), P0[6], P0[7], P0[8], P0[9],     pw0[2] = PKW(P0, 4), pw0[3] = PKW(P0, 6), pw0); \
    VRD(1); SBAR(); GAPA(C0 = __builtin_amdgcn_mfma_f32_32x32x16_bf16(kf[2], qr[1], C0, 0, 0, 0),   P0[10], P0[11], P0[12], P0[13], pw1[0] = PKW(P0, 8), pw1[1] = PKW(P0, 10), pw1); \
    VRD(5); SBAR(); GAPA(C1 = __builtin_amdgcn_mfma_f32_32x32x16_bf16(kf[3], qr[1], C1, 0, 0, 0),   P0[14], P0[15], P1[0], P1[1],   pw1[2] = PKW(P0, 12), pw1[3] = PKW(P0, 14), pw1); \
    VRD(2); SBAR(); GAPA(C0 = __builtin_amdgcn_mfma_f32_32x32x16_bf16(kf[4], qr[2], C0, 0, 0, 0),   P1[2], P1[3], P1[4], P1[5],     pw2[0] = PKW(P1, 0), pw2[1] = PKW(P1, 2), pw2); \
    VRD(6); SBAR(); GAPA(C1 = __builtin_amdgcn_mfma_f32_32x32x16_bf16(kf[5], qr[2], C1, 0, 0, 0),   P1[6], P1[7], P1[8], P1[9],     pw2[2] = PKW(P1, 4), pw2[3] = PKW(P1, 6), pw2); \
    VRD(3); SBAR(); GAPA(C0 = __builtin_amdgcn_mfma_f32_32x32x16_bf16(kf[6], qr[3], C0, 0, 0, 0),   P1[10], P1[11], P1[12], P1[13], pw3[0] = PKW(P1, 8), pw3[1] = PKW(P1, 10), pw3); \
    VRD(7); SBAR(); GAPA(C1 = __builtin_amdgcn_mfma_f32_32x32x16_bf16(kf[7], qr[3], C1, 0, 0, 0),   P1[14], P1[15], 0.f, 0.f,       pw3[2] = PKW(P1, 12), pw3[3] = PKW(P1, 14), pw3); \
    l_reg += sacc; \
    if (GK) { DMA_K((t) + 3, sl_cur); } if (GV) { DMA_V((t) + 1, sl_next); } \
    CMASK(C0, C1, t); \
    if (!NOMAX) { float a = MX3(C0[0], C0[1], C1[0]), b = MX3(C0[2], C0[3], C1[1]); a = MX3(a, C1[2], C1[3]); \
      _Pragma("unroll") for (int r = 4; r < 16; r += 4) { a = MX3(a, C0[r], C0[r + 1]); b = MX3(b, C0[r + 2], C0[r + 3]); a = MX3(a, C1[r], C1[r + 1]); b = MX3(b, C1[r + 2], C1[r + 3]); } \
      float rm = __builtin_fmaxf(a, b); { auto rr = __builtin_amdgcn_permlane32_swap(__float_as_uint(rm), __float_as_uint(rm), false, false); rm = __builtin_fmaxf(__uint_as_float(rr[0]), __uint_as_float(rr[1])); } \
      resc = false; \
      if (__builtin_expect(__any(rm > (float)THRL), 0)) { const float dl = __builtin_fmaxf(rm, 0.f); mhat += dl; \
        _Pragma("unroll") for (int r = 0; r < 16; ++r) { C0[r] -= dl; C1[r] -= dl; } \
        _Pragma("unroll") for (int r = 0; r < 16; ++r) negm[r] = -mhat; asm volatile("" : "+v"(negm)); \
        const float f = __builtin_amdgcn_exp2f(-dl); l_reg *= f; if (hi == 0) wsf[r32] = f; resc = true; } } \
    SBAR(); \
    GAPB(o[0] = __builtin_amdgcn_mfma_f32_32x32x16_bf16(PAF(0), VFR(0), o[0], 0, 0, 0), C0, 0); \
    GAPB(o[1] = __builtin_amdgcn_mfma_f32_32x32x16_bf16(PAF(0), VFR(4), o[1], 0, 0, 0), C0, 4); \
    KRD(GL, 0); GAPB(o[0] = __builtin_amdgcn_mfma_f32_32x32x16_bf16(PAF(1), VFR(1), o[0], 0, 0, 0), C0, 8); \
    KRD(GL, 1); GAPB(o[1] = __builtin_amdgcn_mfma_f32_32x32x16_bf16(PAF(1), VFR(5), o[1], 0, 0, 0), C0, 12); \
    KRD(GL, 2); GAPB(o[0] = __builtin_amdgcn_mfma_f32_32x32x16_bf16(PAF(2), VFR(2), o[0], 0, 0, 0), C1, 0); \
    KRD(GL, 3); GAPB(o[1] = __builtin_amdgcn_mfma_f32_32x32x16_bf16(PAF(2), VFR(6), o[1], 0, 0, 0), C1, 4); \
    GAPB(o[0] = __builtin_amdgcn_mfma_f32_32x32x16_bf16(PAF(3), VFR(3), o[0], 0, 0, 0), C1, 8); \
    GAPB(o[1] = __builtin_amdgcn_mfma_f32_32x32x16_bf16(PAF(3), VFR(7), o[1], 0, 0, 0), C1, 12); \
    } while (0)
  int t = 1;
  for (; t + 5 < NT; t += 2) {
    STEP(pB0, pB1, pA0, pA1, t, true, true, true);     WAIT_BAR(2); RESC(); ROT();
    STEP(pA0, pA1, pB0, pB1, t + 1, true, true, true); WAIT_BAR(2); RESC(); ROT();
  }
  #define ENDW(tt) do { if ((tt) + 3 < NT) { WAIT_BAR(2); } else if ((tt) + 2 < NT) { WAIT_BAR(1); } else { WAIT_BAR(0); } } while (0)
  for (; t + 1 < NT; t += 2) {
    STEP(pB0, pB1, pA0, pA1, t, (t + 3 < NT), (t + 1 < NT), (t + 1 < NT));       ENDW(t);     RESC(); ROT();
    STEP(pA0, pA1, pB0, pB1, t + 1, (t + 4 < NT), (t + 2 < NT), (t + 2 < NT));   ENDW(t + 1); RESC(); ROT();
  }
  STEP(pB0, pB1, pA0, pA1, NT - 1, false, false, false); RESC();
  { float sacc = pB0[0] + pB0[1]; _Pragma("unroll") for (int r = 2; r < 16; ++r) sacc += pB0[r]; _Pragma("unroll") for (int r = 0; r < 16; ++r) sacc += pB1[r]; l_reg += sacc;
    pw0 = (u32x4){PKW(pB0, 0), PKW(pB0, 2), PKW(pB0, 4), PKW(pB0, 6)}; pw1 = (u32x4){PKW(pB0, 8), PKW(pB0, 10), PKW(pB0, 12), PKW(pB0, 14)}; pw2 = (u32x4){PKW(pB1, 0), PKW(pB1, 2), PKW(pB1, 4), PKW(pB1, 6)}; pw3 = (u32x4){PKW(pB1, 8), PKW(pB1, 10), PKW(pB1, 12), PKW(pB1, 14)};
    SBAR(); pv(o, vb0 + sl_cur, PAF(0), PAF(1), PAF(2), PAF(3)); }
  #undef PKW
  #undef PAF
  #undef VFR
  #undef PIN
  #undef MX3
  #undef GAPA
  #undef GAPB
  #undef EX
  #undef VRD
  #undef KRD
  #undef STEP
  #undef ENDW
  { auto rr = __builtin_amdgcn_permlane32_swap(__float_as_uint(l_reg), __float_as_uint(l_reg), false, false); l_reg = __uint_as_float(rr[0]) + __uint_as_float(rr[1]); }
  if (hi == 0) wsf[32 + r32] = l_reg; asm volatile("s_waitcnt lgkmcnt(0)" ::: "memory");
  float rli[16];
  #pragma unroll
  for (int r = 0; r < 16; ++r) rli[r] = __builtin_amdgcn_rcpf(wsf[32 + crow(r, hi)]);
  if (MODE == 0 && OB_F8) {
    unsigned char* stg8 = (unsigned char*)(shm + LDS_OST) + wid * 4096;
    #pragma unroll
    for (int r = 0; r < 16; ++r) { const int orow = crow(r, hi);
      #pragma unroll
      for (int d0 = 0; d0 < 2; ++d0) { const float ov = o[d0][r] * rli[r]; stg8[orow * 64 + d0 * 32 + r32] = (unsigned char)(__builtin_amdgcn_cvt_pk_fp8_f32(ov, ov, 0, false) & 0xff); } }
    asm volatile("s_waitcnt lgkmcnt(0)" ::: "memory");
    unsigned char* Ow = (unsigned char*)J.O + (long)(wid * QBLK) * 1024;
    #pragma unroll
    for (int i = 0; i < 2; ++i) { const int row = i * 16 + (lane >> 2), ch = lane & 3; const u32x4 v = *(const u32x4*)(stg8 + row * 64 + ch * 16); *(u32x4*)(Ow + (long)row * 1024 + ch * 16) = v; }
  } else {
    bf16* stg = (bf16*)(shm + LDS_OST) + wid * 2048;
    #pragma unroll
    for (int r = 0; r < 16; ++r) { const int orow = crow(r, hi);
      #pragma unroll
      for (int d0 = 0; d0 < 2; ++d0) stg[orow * 64 + d0 * 32 + r32] = __float2bfloat16(o[d0][r] * rli[r]); }
    asm volatile("s_waitcnt lgkmcnt(0)" ::: "memory");
    if (MODE == 0) {
      bf16* Ow = J.O + (long)(wid * QBLK) * 1024;
      #pragma unroll
      for (int i = 0; i < 4; ++i) { const int row = i * 8 + (lane >> 3), ch = lane & 7; const u32x4 v = *(const u32x4*)(stg + row * 64 + ch * 8); *(u32x4*)(Ow + (long)row * 1024 + ch * 8) = v; }
    } else {
      #pragma unroll
      for (int i = 0; i < 4; ++i) { const int row = i * 8 + (lane >> 3), ch = lane & 7; const u32x4 v = *(const u32x4*)(stg + row * 64 + ch * 8);
        const long tok = ((long)(J.i0 + wid * QBLK + row) << J.dsh) + J.cls; *(u32x4*)(J.O + tok * 256 + ch * 8) = v; }
      if (hi == 0) { const long tok = ((long)(J.i0 + qrel) << J.dsh) + J.cls; J.lse[tok * 4] = mhat + __builtin_amdgcn_logf(l_reg); }
    } }
  asm volatile("s_waitcnt lgkmcnt(0)\n\ts_barrier" ::: "memory");
  #undef DMA_K
  #undef DMA_V
  #undef CMASK
  #undef START
  #undef RESC
  #undef ROT
}
#undef SBAR
#undef WAIT_BAR
}


namespace attn8 {
typedef int i32x8 __attribute__((ext_vector_type(8)));
typedef int i32x4 __attribute__((ext_vector_type(4)));
typedef float f32x16 __attribute__((ext_vector_type(16)));
typedef unsigned u32x4 __attribute__((ext_vector_type(4)));
constexpr int SLOT = 4096, RING = 8, NSL = RING;
constexpr int L_K = 0, L_V = NSL * SLOT, L_WS = 2 * NSL * SLOT, L_OST = L_WS + 8 * 256, L_BYTES = L_OST + 8 * 4096;
struct Job { const unsigned char* Q; const unsigned char* K; const unsigned char* VT; unsigned char* O; };
__device__ __forceinline__ void glds16(const void* gsrc, unsigned lds_dst) { unsigned keep;
  asm volatile("s_mov_b32 %0, m0\n\ts_mov_b32 m0, %2\n\ts_nop 0\n\tglobal_load_lds_dwordx4 %1, off\n\ts_mov_b32 m0, %0" : "=&s"(keep) : "v"(gsrc), "s"(lds_dst) : "memory"); }
__device__ __forceinline__ int crow(int r, int hi) { return (r & 3) + 8 * (r >> 2) + 4 * hi; }
#define A8_WAITBAR(N) asm volatile("s_waitcnt vmcnt(" #N ") lgkmcnt(0)\n\ts_barrier" ::: "memory")
#define A8_WAITBAR_N(N) asm volatile("s_waitcnt vmcnt(%0) lgkmcnt(0)\n\ts_barrier" :: "n"(N) : "memory")
template <int NT> __device__ __forceinline__ void attn_unit_f8(const Job& J, char* shm, const int wid_in) {
  int wid = wid_in; asm volatile("" : "+s"(wid));
  const int lane = lane_id_asm(), r32 = lane & 31, hi = lane >> 5;
  const unsigned lds0 = (unsigned)(uintptr_t)shm;
  typedef __attribute__((address_space(3))) const char* lds_cptr;
  const lds_cptr shm3 = (lds_cptr)shm;
  const bool kwave = wid < 4;
  const int w4 = wid & 3; const int drow = 16 * w4 + (lane >> 2); const int cl = (lane & 3) ^ ((drow >> 2) & 3);
  const unsigned char* dsrc = kwave ? J.K + (long)drow * 256 + 16 * cl : J.VT + (long)drow * 4096 + 16 * cl;
  const long dstep = kwave ? 64 * 256 : 64;
  const unsigned ddst = lds0 + (kwave ? L_K : L_V) + w4 * 1024;
  #define A8_DMA(t, slot) glds16(dsrc + (long)(t) * dstep, (unsigned)__builtin_amdgcn_readfirstlane(ddst + (slot)))
  const int sw = (r32 >> 2) & 3; const int foff0 = r32 * 64 + 16 * ((2 * hi) ^ sw), foff1 = r32 * 64 + 16 * ((2 * hi + 1) ^ sw);
  #define A8_FRAG(base, half) __builtin_shufflevector(*(const __attribute__((address_space(3))) i32x4*)((base) + (half) * 2048 + foff0), *(const __attribute__((address_space(3))) i32x4*)((base) + (half) * 2048 + foff1), 0, 1, 2, 3, 4, 5, 6, 7)
  const unsigned char* qp = J.Q + (long)(wid * 32 + r32) * 1024 + 32 * hi;
  const i32x8 qf = __builtin_shufflevector(*(const i32x4*)qp, *(const i32x4*)(qp + 16), 0, 1, 2, 3, 4, 5, 6, 7);
  if (kwave) { _Pragma("unroll") for (int i = 0; i < RING; ++i) A8_DMA(i, i * SLOT); } else { _Pragma("unroll") for (int i = 0; i < RING - 2; ++i) A8_DMA(i, i * SLOT); }
  f32x16 o0 = f32x16{}, o1 = f32x16{}, o2 = f32x16{}; const f32x16 zero = f32x16{};
  i32x8 ones; _Pragma("unroll") for (int w = 0; w < 8; ++w) ones[w] = 0x38383838;
  asm volatile("" : "+v"(ones));
  f32x16 SA0, SA1, SB0, SB1; i32x8 PA, PB;
  A8_WAITBAR_N(RING - 1);
  { const i32x8 k0 = A8_FRAG(shm3 + L_K, 0), k1 = A8_FRAG(shm3 + L_K, 1);
    SA0 = __builtin_amdgcn_mfma_scale_f32_32x32x64_f8f6f4(k0, qf, zero, 0, 0, 0, 0, 0, 0); SA1 = __builtin_amdgcn_mfma_scale_f32_32x32x64_f8f6f4(k1, qf, zero, 0, 0, 0, 0, 0, 0); }
  #define A8_SB() __builtin_amdgcn_sched_barrier(0)
  #define A8_SLOTOF(i) ((((i) + RING) & (RING - 1)) * SLOT)
  #define A8_EXP8(X, B) do { _Pragma("unroll") for (int r = 0; r < 8; ++r) X[(B) + r] = __builtin_amdgcn_exp2f(X[(B) + r]); asm volatile("" : "+v"(X)); } while (0)
  #define A8_CVT4(P, WB, X) do { _Pragma("unroll") for (int w = 0; w < 4; ++w) { unsigned a_ = (unsigned)P[(WB) + w];     \
      a_ = __builtin_amdgcn_cvt_pk_bf8_f32(X[4 * w], X[4 * w + 1], a_, false); a_ = __builtin_amdgcn_cvt_pk_bf8_f32(X[4 * w + 2], X[4 * w + 3], a_, true); P[(WB) + w] = (int)a_; } asm volatile("" : "+v"(P)); } while (0)
  #define A8_STEP(C0, C1, N0, N1, PP, PN, t, WK, WV, DK, DV, QK, PV, EX) do { \
    if (kwave) { A8_WAITBAR_N(WK); } else { A8_WAITBAR_N(WV); } \
    if (kwave) { if (DK) A8_DMA((t) + RING, A8_SLOTOF(t)); } else { if (DV) A8_DMA((t) - 2 + RING, A8_SLOTOF((t) - 2)); } \
    i32x8 k0_ = ones, k1_ = ones, v0_ = ones, v1_ = ones; \
    if (QK) { k0_ = A8_FRAG(shm3 + L_K + A8_SLOTOF((t) + 1), 0); k1_ = A8_FRAG(shm3 + L_K + A8_SLOTOF((t) + 1), 1); } \
    if (PV) { v0_ = A8_FRAG(shm3 + L_V + A8_SLOTOF((t) - 1), 0); v1_ = A8_FRAG(shm3 + L_V + A8_SLOTOF((t) - 1), 1); } \
    A8_SB(); \
    if (EX) A8_EXP8(C0, 0); A8_SB(); \
    if (QK) N0 = __builtin_amdgcn_mfma_scale_f32_32x32x64_f8f6f4(k0_, qf, zero, 0, 0, 0, 0, 0, 0); if (EX) A8_EXP8(C0, 8); A8_SB(); \
    if (QK) N1 = __builtin_amdgcn_mfma_scale_f32_32x32x64_f8f6f4(k1_, qf, zero, 0, 0, 0, 0, 0, 0); if (EX) A8_EXP8(C1, 0); A8_SB(); \
    if (PV) o0 = __builtin_amdgcn_mfma_scale_f32_32x32x64_f8f6f4(PP, v0_, o0, 1, 0, 0, 0, 0, 0); if (EX) A8_EXP8(C1, 8); A8_SB(); \
    if (PV) o1 = __builtin_amdgcn_mfma_scale_f32_32x32x64_f8f6f4(PP, v1_, o1, 1, 0, 0, 0, 0, 0); if (EX) A8_CVT4(PN, 0, C0); A8_SB(); \
    if (PV) o2 = __builtin_amdgcn_mfma_scale_f32_32x32x64_f8f6f4(PP, ones, o2, 1, 0, 0, 0, 0, 0); if (EX) A8_CVT4(PN, 4, C1); A8_SB();     \
  } while (0)
  #define A8_EVEN(t, WK, WV, DK, DV, QK, PV, EX) A8_STEP(SA0, SA1, SB0, SB1, PB, PA, t, WK, WV, DK, DV, QK, PV, EX)
  #define A8_ODD(t, WK, WV, DK, DV, QK, PV, EX)  A8_STEP(SB0, SB1, SA0, SA1, PA, PB, t, WK, WV, DK, DV, QK, PV, EX)
  PA = ones; PB = ones;
  static_assert(RING == 8 && NT % 2 == 0 && NT >= 2 * RING, "the peeled tail below is written for RING = 8");
  A8_EVEN(0, 6, 6, true, true, true, false, true);
#pragma unroll 1
  for (int t = 1; t < NT - 9; t += 2) {
    A8_ODD(t, 6, 6, true, true, true, true, true);
    A8_EVEN(t + 1, 6, 6, true, true, true, true, true);
  }
  A8_ODD(NT - 9, 6, 6, true, true, true, true, true);
  A8_EVEN(NT - 8, 6, 6, false, true, true, true, true);
  A8_ODD(NT - 7, 5, 6, false, true, true, true, true);
  A8_EVEN(NT - 6, 4, 6, false, false, true, true, true);
  A8_ODD(NT - 5, 3, 5, false, false, true, true, true);
  A8_EVEN(NT - 4, 2, 4, false, false, true, true, true);
  A8_ODD(NT - 3, 1, 3, false, false, true, true, true);
  A8_EVEN(NT - 2, 0, 2, false, false, true, true, true);
  A8_ODD(NT - 1, 0, 1, false, false, false, true, true);
  A8_EVEN(NT, 0, 0, false, false, false, true, false);
  #undef A8_EVEN
  #undef A8_ODD
  #undef A8_STEP
  #undef A8_EXP8
  #undef A8_CVT4
  #undef A8_SB
  #undef A8_SLOTOF
  #undef A8_FRAG
  #undef A8_DMA
  float rli[16];
  #pragma unroll
  for (int r = 0; r < 16; ++r) rli[r] = __builtin_amdgcn_rcpf(o2[r]);
  unsigned char* stg8 = (unsigned char*)(shm + L_OST) + wid * 4096;
  #pragma unroll
  for (int r = 0; r < 16; ++r) { const int orow = crow(r, hi);
    const float a = o0[r] * rli[r], b = o1[r] * rli[r];
    stg8[orow * 64 + r32] = (unsigned char)(__builtin_amdgcn_cvt_pk_fp8_f32(a, a, 0, false) & 0xff); stg8[orow * 64 + 32 + r32] = (unsigned char)(__builtin_amdgcn_cvt_pk_fp8_f32(b, b, 0, false) & 0xff); }
  asm volatile("s_waitcnt lgkmcnt(0)" ::: "memory");
  unsigned char* Ow = J.O + (long)(wid * 32) * 1024;
  #pragma unroll
  for (int i = 0; i < 2; ++i) { const int row = i * 16 + (lane >> 2), ch = lane & 3; const u32x4 v = *(const u32x4*)(stg8 + row * 64 + ch * 16); *(u32x4*)(Ow + (long)row * 1024 + ch * 16) = v; }
  asm volatile("s_waitcnt lgkmcnt(0)\n\ts_barrier" ::: "memory");
}
#undef A8_WAITBAR
#undef A8_WAITBAR_N
}

constexpr size_t MiB = 1u << 20;
constexpr size_t WS_CTL = 0, CTL_ZERO_BYTES = 1 * MiB;
constexpr size_t WS_MOD = 1 * MiB;
constexpr size_t WS_ROPE = WS_MOD + 512 * 1024;
constexpr size_t WS_BLUT = WS_ROPE + 8192;
constexpr size_t WS_RC0 = WS_BLUT + 12 * 768 * 4;
constexpr size_t WS_HIST = WS_RC0 + 4096;
constexpr size_t WS_TILEE = WS_HIST + 32768;
constexpr size_t WS_TOPE = 2 * MiB;
constexpr size_t WS_TOPW = WS_TOPE + 512 * 1024;
constexpr size_t WS_SLOT = WS_TOPW + 512 * 1024;
constexpr size_t WS_ROWW = WS_SLOT + 512 * 1024;
constexpr size_t WS_LSE = 5 * MiB;
constexpr size_t WS_WRHI = 7 * MiB;
constexpr size_t WS_WRLO = 8 * MiB;
constexpr size_t WS_WIN = 9 * MiB;
constexpr size_t WS_WBRA = 32 * MiB;
constexpr size_t WS_WBRB = 33 * MiB;
constexpr size_t WS_WOUT = 37 * MiB;
constexpr size_t WS_WGU = 41 * MiB;
constexpr size_t WS_WDN = 297 * MiB;
constexpr size_t WS_X = 425 * MiB;
constexpr size_t WS_H = 553 * MiB;
constexpr size_t WS_R = 617 * MiB;
constexpr size_t WS_AQKV = WS_R;
constexpr size_t WS_QB = WS_R + 144 * MiB;
constexpr size_t WS_KB = WS_R + 208 * MiB;
constexpr size_t WS_VB = WS_R + 224 * MiB;
constexpr size_t WS_GATE = WS_R + 240 * MiB;
constexpr size_t WS_OAG = WS_R + 368 * MiB;
constexpr size_t WS_OA = WS_R + 416 * MiB;
constexpr size_t WS_MERGED = WS_R + 432 * MiB;
constexpr size_t WS_XS = WS_R;
constexpr size_t WS_ACT = WS_R + 136 * MiB;
constexpr size_t WS_Y = WS_R + 272 * MiB;
constexpr size_t WS_OB = WS_R + 496 * MiB;
constexpr size_t WS_M8 = WS_R + 560 * MiB;
constexpr size_t WS_END = WS_R + 592 * MiB;
constexpr int CW_BAR = 4096;

constexpr int RING_BYTES = 133120;
constexpr int LDSCTL_OFF = RING_BYTES;
constexpr int LDS_BYTES = 147456;
constexpr int NWAVES = 8;

#define GAS __attribute__((address_space(1)))
#define LAS __attribute__((address_space(3)))
typedef unsigned short bf16;
typedef unsigned v4u __attribute__((ext_vector_type(4)));
typedef unsigned v2u __attribute__((ext_vector_type(2)));
typedef float f32x4 __attribute__((ext_vector_type(4)));
typedef float f32x16 __attribute__((ext_vector_type(16)));
typedef int i32x4 __attribute__((ext_vector_type(4)));
typedef short bf16x8 __attribute__((ext_vector_type(8)));
typedef GAS unsigned gu32;
#define RLX_AGENT __ATOMIC_RELAXED, __HIP_MEMORY_SCOPE_AGENT
#define LDS_WAIT() asm volatile("s_waitcnt lgkmcnt(0)" ::: "memory")
__device__ __forceinline__ unsigned f2bf(float f) { unsigned u = __builtin_bit_cast(unsigned, f); return (u + 0x7fffu + ((u >> 16) & 1u)) >> 16; }
__device__ __forceinline__ unsigned pk2(float lo, float hi) { return f2bf(lo) | (f2bf(hi) << 16); }
__device__ __forceinline__ float bfl(unsigned w) { return __uint_as_float(w << 16); }
__device__ __forceinline__ float bfh(unsigned w) { return __uint_as_float(w & 0xffff0000u); }

#define XB_TMO      128
#define XB_XCNT(j)  (256  + 64 * (j))
#define XB_XSUB(j)  (1280 + 64 * (j))
#define XB_XGEN(j)  (2304 + 64 * (j))
#define XB_TOP      3328
#define XB_TOPGEN   3392
#define XCD_BAR_WORDS 3456
#define XB_SPIN_CAP (1u << 18)
__device__ __forceinline__ unsigned xb_ld(unsigned* p)              { return __hip_atomic_load(p, __ATOMIC_RELAXED, __HIP_MEMORY_SCOPE_AGENT); }
__device__ __forceinline__ unsigned xb_add(unsigned* p, unsigned v) { return __hip_atomic_fetch_add(p, v, __ATOMIC_RELAXED, __HIP_MEMORY_SCOPE_AGENT); }
__device__ __forceinline__ unsigned xb_xcc_id() { return (unsigned)__builtin_amdgcn_s_getreg((3 << 11) | 20) & 0xFu; }
#define XB_SPIN(cond, bar) do { unsigned _sp = 0; while (cond) { __builtin_amdgcn_s_sleep(1); \
    if ((++_sp & 255u) == 0u) { if (xb_ld(&(bar)[XB_TMO])) break; if (_sp > XB_SPIN_CAP) { atomicAdd(&(bar)[XB_TMO], 1u); break; } } } } while (0)
struct XcdBarrier { unsigned* bar; unsigned x; volatile LAS unsigned* st; };
__device__ __forceinline__ XcdBarrier xcd_barrier_post(unsigned* bar, volatile LAS unsigned* st) {
    XcdBarrier b; b.bar = bar; b.x = xb_xcc_id(); b.st = st;
    if (threadIdx.x == 0) (void)xb_add(&bar[XB_XCNT(b.x)], 1u);
    return b;
}
__device__ __forceinline__ void xcd_barrier_complete(unsigned* bar, unsigned x, unsigned& nloc, unsigned& nx) {
    const unsigned G = gridDim.x * gridDim.y * gridDim.z;
    unsigned sum, cnt, mine, sp = 0u;
    for (;;) {
        sum = 0u; cnt = 0u; mine = 0u;
#pragma unroll
        for (unsigned j = 0; j < 16; ++j) { const unsigned c = xb_ld(&bar[XB_XCNT(j)]); sum += c; cnt += (c > 0u) ? 1u : 0u; mine = (j == x) ? c : mine; }
        if (sum == G) break;
        __builtin_amdgcn_s_sleep(1);
        if ((++sp & 255u) == 0u) { if (xb_ld(&bar[XB_TMO])) break; if (sp > XB_SPIN_CAP) { atomicAdd(&bar[XB_TMO], 1u); break; } }
    }
    nloc = mine > 0u ? mine : 1u; nx = cnt > 0u ? cnt : 1u;
}
__device__ __forceinline__ void xcd_barrier(const XcdBarrier& b) {
    asm volatile("s_waitcnt vmcnt(0)" ::: "memory");
    __syncthreads();
    if (threadIdx.x == 0) {
        unsigned* bar = b.bar;
        __builtin_amdgcn_s_waitcnt(0);
        unsigned nloc = b.st[0], nx = b.st[1];
        if (nloc == 0u) { xcd_barrier_complete(bar, b.x, nloc, nx); b.st[0] = nloc; b.st[1] = nx; }
        const unsigned old = xb_add(&bar[XB_XSUB(b.x)], 1u);
        const unsigned gen = old / nloc;
        if (old + 1u == (gen + 1u) * nloc) {
            __builtin_amdgcn_fence(__ATOMIC_RELEASE, "agent");
            asm volatile("s_waitcnt vmcnt(0)" ::: "memory");
            const unsigned og = xb_add(&bar[XB_TOP], 1u);
            const unsigned tg = og / nx;
            if (og + 1u == (tg + 1u) * nx) xb_add(&bar[XB_TOPGEN], 1u);
            else XB_SPIN(xb_ld(&bar[XB_TOPGEN]) == tg, bar);
            __builtin_amdgcn_fence(__ATOMIC_ACQUIRE, "agent");
            xb_add(&bar[XB_XGEN(b.x)], 1u);
            asm volatile("s_waitcnt vmcnt(0)" ::: "memory");
        } else {
            XB_SPIN(xb_ld(&bar[XB_XGEN(b.x)]) == gen, bar);
            __builtin_amdgcn_fence(__ATOMIC_ACQUIRE, "agent");
            asm volatile("s_waitcnt vmcnt(0)" ::: "memory");
        }
    }
    __syncthreads();
}

__device__ __forceinline__ float wave_sum(float v) {
    v = xsum<1>(v); v = xsum<2>(v); v = xsum<4>(v); v = xsum<8>(v); v = xsum<16>(v); v = xsum<32>(v);
    return v;
}
__device__ __forceinline__ void cvt_item(const float* W, int ldw, int K, int srcA, int srcB, bf16* WT, int dst_row0, int k0, LAS float* scr, int lane, bool ident = false) {
    const int kq = lane >> 4, nq = lane & 15; const int scol = (nq < 8 ? srcA + 4 * nq : srcB + 4 * (nq - 8));
    f32x4 v[16];
#pragma unroll
    for (int i = 0; i < 16; ++i) v[i] = __builtin_nontemporal_load((const GAS f32x4*)(W + (size_t)(k0 + 4 * i + kq) * ldw + scol));
#pragma unroll
    for (int i = 0; i < 16; ++i)
#pragma unroll
        for (int e = 0; e < 4; ++e) scr[(4 * i + kq) * 65 + 4 * nq + e] = v[i][e];
    LDS_WAIT(); asm volatile("" ::: "memory");
    const int c = lane & 7, rr = lane >> 3;
#pragma unroll
    for (int j = 0; j < 8; ++j) { const int rho = rr + 8 * j; const int sc = (rho & 32) + (ident ? (rho & 31) : pg8::perm32(rho & 31)); const LAS float* s = scr + (8 * c) * 65 + sc;
        v4u o; o.x = pk2(s[0 * 65], s[1 * 65]); o.y = pk2(s[2 * 65], s[3 * 65]); o.z = pk2(s[4 * 65], s[5 * 65]); o.w = pk2(s[6 * 65], s[7 * 65]);
        *(GAS v4u*)(WT + (size_t)(dst_row0 + rho) * K + k0 + 8 * c) = o; }
    LDS_WAIT(); asm volatile("" ::: "memory");
}
__device__ __forceinline__ void cvt_item_f8(const float* W, int ldw, int K, int srcA, int srcB, unsigned char* WT, int dst_row0, int k0, LAS float* scr, int lane, bool ident = false) {
    const int kq = lane >> 4, nq = lane & 15; const int scol = (nq < 8 ? srcA + 4 * nq : srcB + 4 * (nq - 8));
    f32x4 v[16];
#pragma unroll
    for (int i = 0; i < 16; ++i) v[i] = __builtin_nontemporal_load((const GAS f32x4*)(W + (size_t)(k0 + 4 * i + kq) * ldw + scol));
#pragma unroll
    for (int i = 0; i < 16; ++i)
#pragma unroll
        for (int e = 0; e < 4; ++e) scr[(4 * i + kq) * 65 + 4 * nq + e] = v[i][e] * pg8::W8_SCALE;
    LDS_WAIT(); asm volatile("" ::: "memory");
    const int c = lane & 7, rr = lane >> 3;
#pragma unroll
    for (int j = 0; j < 8; ++j) { const int rho = rr + 8 * j; const int sc = (rho & 32) + (ident ? (rho & 31) : pg8::perm32(rho & 31)); const LAS float* s = scr + (8 * c) * 65 + sc;
        unsigned w0 = 0, w1 = 0;
        w0 = __builtin_amdgcn_cvt_pk_fp8_f32(s[0 * 65], s[1 * 65], w0, false); w0 = __builtin_amdgcn_cvt_pk_fp8_f32(s[2 * 65], s[3 * 65], w0, true);
        w1 = __builtin_amdgcn_cvt_pk_fp8_f32(s[4 * 65], s[5 * 65], w1, false); w1 = __builtin_amdgcn_cvt_pk_fp8_f32(s[6 * 65], s[7 * 65], w1, true);
        v2u o; o.x = w0; o.y = w1; *(GAS v2u*)(WT + (size_t)(dst_row0 + rho) * K + k0 + 8 * c) = o; }
    LDS_WAIT(); asm volatile("" ::: "memory");
}
__device__ __forceinline__ int win_src(int X) { const int pn = X >> 3, bj = (X >> 2) & 1, wc = X & 3; return (pn >= 9 && pn < 14) ? pn * 256 + 64 * wc + 32 * bj : 32 * X; }
__device__ __forceinline__ int wgu_src(int X) { const int pn = X >> 3, bj = (X >> 2) & 1, wc = X & 3; return bj * 1024 + 128 * pn + 32 * wc; }

__device__ __forceinline__ void norm_row_bf16(const float* xrow, const float* g, const float* sc, const float* sh, bf16* orow, int lane) {
    const GAS f32x4* xr = (const GAS f32x4*)xrow + lane;
    f32x4 v[4]; float s = 0.f;
#pragma unroll
    for (int j = 0; j < 4; ++j) { v[j] = xr[64 * j]; s += (v[j].x * v[j].x + v[j].y * v[j].y) + (v[j].z * v[j].z + v[j].w * v[j].w); }
    const float rs = rsqrtf(wave_sum(s) * (1.0f / D) + EPS);
#pragma unroll
    for (int j = 0; j < 4; ++j) { const int c = 256 * j + 4 * lane;
        const f32x4 gg = *(const GAS f32x4*)(g + c), s1 = *(const GAS f32x4*)(sc + c), s0 = *(const GAS f32x4*)(sh + c);
        const f32x4 y = (v[j] * rs * gg) * (s1 + 1.0f) + s0;
        v2u o; o.x = pk2(y.x, y.y); o.y = pk2(y.z, y.w); *(GAS v2u*)(orow + c) = o; }
}

__device__ __forceinline__ void norm_rows2_bf16(const float* xrow, const float* g, const float* sc, const float* sh, bf16* orow, int lane) {
    const GAS f32x4* xr = (const GAS f32x4*)xrow + lane;
    f32x4 v[2][4]; float s0 = 0.f, s1 = 0.f;
#pragma unroll
    for (int j = 0; j < 4; ++j) { v[0][j] = xr[64 * j]; v[1][j] = xr[256 + 64 * j]; }
#pragma unroll
    for (int j = 0; j < 4; ++j) { s0 += (v[0][j].x * v[0][j].x + v[0][j].y * v[0][j].y) + (v[0][j].z * v[0][j].z + v[0][j].w * v[0][j].w); s1 += (v[1][j].x * v[1][j].x + v[1][j].y * v[1][j].y) + (v[1][j].z * v[1][j].z + v[1][j].w * v[1][j].w); }
    const float rs0 = rsqrtf(wave_sum(s0) * (1.0f / D) + EPS), rs1 = rsqrtf(wave_sum(s1) * (1.0f / D) + EPS);
#pragma unroll
    for (int j = 0; j < 4; ++j) { const int c = 256 * j + 4 * lane;
        const f32x4 gg = *(const GAS f32x4*)(g + c), a1 = *(const GAS f32x4*)(sc + c) + 1.0f, a0 = *(const GAS f32x4*)(sh + c);
        const f32x4 y0 = (v[0][j] * rs0 * gg) * a1 + a0, y1 = (v[1][j] * rs1 * gg) * a1 + a0;
        v2u o0; o0.x = pk2(y0.x, y0.y); o0.y = pk2(y0.z, y0.w); *(GAS v2u*)(orow + c) = o0;
        v2u o1; o1.x = pk2(y1.x, y1.y); o1.y = pk2(y1.z, y1.w); *(GAS v2u*)(orow + D + c) = o1; }
}

__device__ __forceinline__ void norm_rows2_f8(const float* xrow, const float* g, const float* sc, const float* sh, unsigned char* orow, int lane) {
    const GAS f32x4* xr = (const GAS f32x4*)xrow + lane;
    f32x4 v[2][4]; float s0 = 0.f, s1 = 0.f;
#pragma unroll
    for (int j = 0; j < 4; ++j) { v[0][j] = xr[64 * j]; v[1][j] = xr[256 + 64 * j]; }
#pragma unroll
    for (int j = 0; j < 4; ++j) { s0 += (v[0][j].x * v[0][j].x + v[0][j].y * v[0][j].y) + (v[0][j].z * v[0][j].z + v[0][j].w * v[0][j].w); s1 += (v[1][j].x * v[1][j].x + v[1][j].y * v[1][j].y) + (v[1][j].z * v[1][j].z + v[1][j].w * v[1][j].w); }
    const float rs0 = rsqrtf(wave_sum(s0) * (1.0f / D) + EPS), rs1 = rsqrtf(wave_sum(s1) * (1.0f / D) + EPS);
#pragma unroll
    for (int j = 0; j < 4; ++j) { const int c = 256 * j + 4 * lane;
        const f32x4 gg = *(const GAS f32x4*)(g + c), a1 = *(const GAS f32x4*)(sc + c) + 1.0f, a0 = *(const GAS f32x4*)(sh + c);
        const f32x4 y0 = (v[0][j] * rs0 * gg) * a1 + a0, y1 = (v[1][j] * rs1 * gg) * a1 + a0;
        unsigned w0 = 0, w1 = 0;
        w0 = __builtin_amdgcn_cvt_pk_fp8_f32(y0.x, y0.y, w0, false); w0 = __builtin_amdgcn_cvt_pk_fp8_f32(y0.z, y0.w, w0, true);
        w1 = __builtin_amdgcn_cvt_pk_fp8_f32(y1.x, y1.y, w1, false); w1 = __builtin_amdgcn_cvt_pk_fp8_f32(y1.z, y1.w, w1, true);
        *(GAS unsigned*)(orow + c) = w0; *(GAS unsigned*)(orow + D + c) = w1; }
}

__device__ __forceinline__ bool gqa_bound_ok(const float* qg, const float* kg, int lane) {
    float gq = fabsf(qg[lane]), gk = fabsf(kg[lane]);
#define MK_MAXSTEP(m) gq = fmaxf(gq, __int_as_float(__builtin_amdgcn_ds_swizzle(__float_as_int(gq), 0x1f | ((m) << 10)))); gk = fmaxf(gk, __int_as_float(__builtin_amdgcn_ds_swizzle(__float_as_int(gk), 0x1f | ((m) << 10))))
    MK_MAXSTEP(1); MK_MAXSTEP(2); MK_MAXSTEP(4); MK_MAXSTEP(8); MK_MAXSTEP(16);
#undef MK_MAXSTEP
    gq = fmaxf(gq, xget32(gq, lane >> 5)); gk = fmaxf(gk, xget32(gk, lane >> 5));
    const float bound = 64.0f * gq * gk * C2 * 1.01f; return __builtin_amdgcn_readfirstlane((int)(bound <= 14.0f)) != 0;
}

struct Args { const float* in[20]; float* out; unsigned char* ws; int ph_lo, ph_hi, li, pad; };
constexpr int N_PHASES = 2 + 10 * DEPTH;

typedef const __attribute__((address_space(4))) Args* kargs_t;
__device__ __forceinline__ kargs_t kargs_opaque() { kargs_t p = (kargs_t)__builtin_amdgcn_kernarg_segment_ptr(); asm volatile("" : "+s"(p)); return p; }
#define PH_BEGIN() kargs_t ap = kargs_opaque(); unsigned char* ws = ap->ws; (void)ws; \
    int wave = wave_s; asm volatile("" : "+s"(wave)); const int lane = lane_id_asm(); const int tid = wave * 64 + lane; (void)lane; (void)tid; \
    int bx = blockIdx.x; asm volatile("" : "+s"(bx)); int G = gridDim.x; asm volatile("" : "+s"(G)); const int vcu = (G % 8 == 0) ? (bx % 8) * (G / 8) + bx / 8 : bx; (void)vcu; \
    const int gw = vcu * NWAVES + wave, NGW = G * NWAVES; (void)gw; (void)NGW; const int gtid = vcu * (NWAVES * 64) + tid, NGT = G * NWAVES * 64; (void)gtid; (void)NGT
#define INP(k) (ap->in[k])
#define x_in INP(0)
#define c_in INP(1)
#define w_ada INP(2)
#define b_ada INP(3)
#define norm1_g INP(4)
#define w_in INP(5)
#define q_norm_g INP(6)
#define k_norm_g INP(7)
#define rel_bias INP(8)
#define w_br_a INP(9)
#define w_br_b INP(10)
#define w_out INP(11)
#define norm2_g INP(12)
#define w_router INP(13)
#define b_router INP(14)
#define w_gate_up INP(15)
#define b_gate_up INP(16)
#define w_down INP(17)
#define b_down INP(18)
#define final_g INP(19)
#define MOD ((float*)(ws + WS_MOD))
#define ROPE ((float*)(ws + WS_ROPE))
#define BLUT ((float*)(ws + WS_BLUT))
#define RC0 ((float*)(ws + WS_RC0))
#define HIST ((int*)(ws + WS_HIST))
#define TILEE ((int*)(ws + WS_TILEE))
#define TOPE ((int*)(ws + WS_TOPE))
#define TOPW ((float*)(ws + WS_TOPW))
#define SLOT ((int*)(ws + WS_SLOT))
#define ROWW ((float*)(ws + WS_ROWW))
#define LSE ((float*)(ws + WS_LSE))
#define WRHI ((bf16*)(ws + WS_WRHI))
#define WRLO ((bf16*)(ws + WS_WRLO))
#define WIN ((unsigned char*)(ws + WS_WIN))
#define WBRA ((unsigned char*)(ws + WS_WBRA))
#define WBRB ((unsigned char*)(ws + WS_WBRB))
#define WOUT ((unsigned char*)(ws + WS_WOUT))
#define WGU ((unsigned char*)(ws + WS_WGU))
#define WDN ((unsigned char*)(ws + WS_WDN))
#define X ((float*)(ws + WS_X))
#define H ((bf16*)(ws + WS_H))
#define AQKV ((bf16*)(ws + WS_AQKV))
#define QB ((bf16*)(ws + WS_QB))
#define KB ((bf16*)(ws + WS_KB))
#define VB ((bf16*)(ws + WS_VB))
#define GATE ((bf16*)(ws + WS_GATE))
#define OAG ((bf16*)(ws + WS_OAG))
#define OA ((unsigned char*)(ws + WS_OA))
#define MERGED ((bf16*)(ws + WS_MERGED))
#define OB ((unsigned char*)(ws + WS_OB))
#define M8 ((unsigned char*)(ws + WS_M8))
#define XS ((unsigned char*)(ws + WS_XS))
#define ACT ((unsigned char*)(ws + WS_ACT))
#define YB ((unsigned char*)(ws + WS_Y))
__global__ void __launch_bounds__(NWAVES * 64, 2) mk_fwd(Args args) {
    extern __shared__ __attribute__((aligned(16))) unsigned char lds[];
    LAS unsigned char* L = (LAS unsigned char*)lds;
    volatile LAS unsigned* MISC = (volatile LAS unsigned*)(L + LDSCTL_OFF);
    gu32* ctl = (gu32*)(args.ws + WS_CTL);
    const int wave_s = __builtin_amdgcn_readfirstlane(threadIdx.x >> 6);
    for (int u = threadIdx.x; u < (LDS_BYTES - LDSCTL_OFF) / 4; u += NWAVES * 64) ((LAS unsigned*)(L + LDSCTL_OFF))[u] = 0u;
    __syncthreads();
    XcdBarrier bar; bar.bar = (unsigned*)(ctl + CW_BAR) + args.li * XCD_BAR_WORDS; bar.x = 0; bar.st = nullptr;
    if (!MK_PER_PHASE) bar = xcd_barrier_post((unsigned*)(ctl + CW_BAR) + args.li * XCD_BAR_WORDS, MISC + 8);
    const int lo = args.ph_lo, hi = args.ph_hi;
#define IN(k) (lo <= (k) && (k) < hi)
#define KIND(q) ((PH_KIND_MASK >> (q)) & 1)
#define SEAM(k) do { if (IN(k) && IN((k) + 1)) xcd_barrier(bar); } while (0)

    for (int rep0 = 0; rep0 < 1 + PROBE_P0; ++rep0) {
    if (KIND(0) && IN(0)) { PH_BEGIN();
        {
            LAS float* cact = (LAS float*)L;
            LAS float* part = (LAS float*)(L + 32768);
            for (int i = tid; i < NB * D; i += NWAVES * 64) { const float cv = c_in[i]; cact[i] = cv / (1.0f + __expf(-cv)); }
            __syncthreads();
            for (int vb = bx; vb < 256; vb += G) {
                const int gc = vb * 48 + lane;
                const int l = gc / 6144, col = gc % 6144;
                float a[NB];
#pragma unroll
                for (int b = 0; b < NB; ++b) a[b] = 0.f;
                if (lane < 48) {
                    const float* wp = w_ada + (size_t)l * D * 6144 + col;
                    for (int k = wave * 128; k < wave * 128 + 128; ++k) { const float w = wp[(size_t)k * 6144];
#pragma unroll
                        for (int b = 0; b < NB; ++b) a[b] += cact[b * D + k] * w; }
                }
#pragma unroll
                for (int b = 0; b < NB; ++b) part[(wave * NB + b) * 64 + lane] = a[b];
                __syncthreads();
                if (tid < NB * 48) { const int b = tid / 48, cl = tid % 48; const int gc2 = vb * 48 + cl; const int l2 = gc2 / 6144, col2 = gc2 % 6144;
                    float s = b_ada[l2 * 6144 + col2];
#pragma unroll
                    for (int w = 0; w < NWAVES; ++w) s += part[(w * NB + b) * 64 + cl];
                    MOD[((size_t)l2 * NB + b) * 6144 + col2] = s; }
                __syncthreads();
            }
        }
        for (int i = gtid; i < 1024 + 12 * 768; i += NGT) {
            if (i < 1024) { const int p = i >> 4, f = i & 15; const double inv = pow(10000.0, -(double)f / 16.0); const double ang = (double)p * inv; ROPE[i] = (float)cos(ang); ROPE[1024 + i] = (float)sin(ang); }
            else { const int j = i - 1024; const int hh = j / 768, di = j % 768; const int delta = di - 383; const int g = hh >> 2; const int dil = g == 0 ? 1 : (g == 1 ? 4 : 16);
                float val = -INFINITY;
                if (delta >= -64 && delta <= 64) { const int rel = delta * dil; const int n = rel < 0 ? -rel : rel; int bk = rel > 0 ? 16 : 0;
                    if (n < 8) bk += n; else { int lg = 8 + (int)(logf((float)n / 8.0f) / logf(128.0f) * 8.0f); if (lg > 15) lg = 15; bk += lg; }
                    val = rel_bias[bk * 12 + hh] * LOG2E; }
                BLUT[j] = val; }
        }
        {
            LAS float* scr = (LAS float*)(L + wave * 16640);
            __syncthreads();
            constexpr int I_IN = 16 * 92, I_BRA = 4 * 16, I_BRB = 16 * 16, I_OUT = 16 * 16, I_GU = 16 * 32, I_DN = 16 * 16;
            constexpr int PER_L = I_IN + I_BRA + I_BRB + I_OUT;
            constexpr int NITEMS = DEPTH * PER_L + DEPTH * NE * (I_GU + I_DN);
            for (int it = gw; it < NITEMS; it += NGW) {
                int r = it;
                if (r < DEPTH * PER_L) {
                    const int l = r / PER_L; r %= PER_L;
                    if (r < I_IN) { const int kb = r / 92, g64 = r % 92; cvt_item_f8(w_in + (size_t)l * D * N_IN, N_IN, D, win_src(2 * g64), win_src(2 * g64 + 1), WIN + (size_t)l * N_IN * D, 64 * g64, 64 * kb, scr, lane, (g64 >> 2) >= 9 && (g64 >> 2) < 14); continue; } r -= I_IN;
                    if (r < I_BRA) { const int kb = r / 16, g64 = r % 16; cvt_item_f8(w_br_a + (size_t)l * 256 * D, D, 256, 64 * g64, 64 * g64 + 32, WBRA + (size_t)l * D * 256, 64 * g64, 64 * kb, scr, lane); continue; } r -= I_BRA;
                    if (r < I_BRB) { const int kb = r / 16, g64 = r % 16; cvt_item_f8(w_br_b + (size_t)l * D * D, D, D, 64 * g64, 64 * g64 + 32, WBRB + (size_t)l * D * D, 64 * g64, 64 * kb, scr, lane); continue; } r -= I_BRB;
                    { const int kb = r / 16, g64 = r % 16; cvt_item_f8(w_out + (size_t)l * D * D, D, D, 64 * g64, 64 * g64 + 32, WOUT + (size_t)l * D * D, 64 * g64, 64 * kb, scr, lane); continue; }
                }
                r -= DEPTH * PER_L;
                if (r < DEPTH * NE * I_GU) { const int le = r / I_GU; r %= I_GU; const int kb = r / 32, g64 = r % 32;
                    cvt_item_f8(w_gate_up + (size_t)le * D * 2048, 2048, D, wgu_src(2 * g64), wgu_src(2 * g64 + 1), WGU + (size_t)le * 2048 * D, 64 * g64, 64 * kb, scr, lane); continue; }
                r -= DEPTH * NE * I_GU;
                { const int le = r / I_DN; r %= I_DN; const int kb = r / 16, g64 = r % 16;
                    cvt_item_f8(w_down + (size_t)le * D * D, D, D, 64 * g64, 64 * g64 + 32, WDN + (size_t)le * D * D, 64 * g64, 64 * kb, scr, lane); }
            }
        }
    }
    SEAM(0);
    }
    if (KIND(1) && IN(1)) { PH_BEGIN();
        for (int m = 2 * gw; m < T; m += 2 * NGW) { const int b = m >> 12; const float* md = MOD + (size_t)b * 6144;
            norm_rows2_f8(x_in + (size_t)m * D, norm1_g, md + 1024, md, (unsigned char*)H + (size_t)m * D, lane); }
        for (int i = gtid; i < DEPTH * NB * NE * D; i += NGT) { const int k = i & 1023, e = (i >> 10) & 31, b = (i >> 15) & 7, l = i >> 18;
            const float v = norm2_g[l * D + k] * (1.0f + MOD[((size_t)l * NB + b) * 6144 + 4 * 1024 + k]) * w_router[((size_t)l * D + k) * NE + e];
            const unsigned hb = f2bf(v); const float lv = v - __uint_as_float(hb << 16);
            WRHI[i] = (bf16)hb; WRLO[i] = (bf16)f2bf(lv); }
        for (int i = gw; i < DEPTH * NB * NE; i += NGW) { const int e = i & 31, b = (i >> 5) & 7, l = i >> 8; float s = 0.f;
            for (int k = lane; k < D; k += 64) s += MOD[((size_t)l * NB + b) * 6144 + 3 * 1024 + k] * w_router[((size_t)l * D + k) * NE + e];
            s = wave_sum(s); if (lane == 0) RC0[i] = s + b_router[l * NE + e]; }
    }
    SEAM(1);

    for (int li = (PROBE_MASK ? -1 : 0); li < DEPTH; ++li) {
        const int l = li < 0 ? 0 : li; const bool virt = li < 0;
        const int P = 2 + 10 * l;
#define VK(q) (!virt || ((PROBE_MASK >> (q)) & 1))
        if (KIND(2) && IN(P + 0) && VK(2)) { PH_BEGIN();
            pg8::Gemm g{H, (const bf16*)(WIN + (size_t)l * N_IN * D), D / 2}; pg8::StaticOrder S; S.init(T, N_IN, G, bx);
            const bool f8attn = gqa_bound_ok(q_norm_g + l * 64, k_norm_g + l * 64, lane);
            pg8::EpiIn E{AQKV, QB, KB, VB, GATE, q_norm_g + l * 64, k_norm_g + l * 64, ROPE, pg8::W8_INV, f8attn};
            pg8::gemm_phase_f8<pg8::EpiIn, pg8::StaticOrder>(L, g, S, E, wave);
        }
        if (VK(2)) SEAM(P + 0);
        if (KIND(3) && IN(P + 1) && VK(3)) { PH_BEGIN();
            namespace ab = attn_body;
            const bool nomax = gqa_bound_ok(q_norm_g + l * 64, k_norm_g + l * 64, lane);
            for (int j = 0; j < 8; ++j) {
                const int uidx = vcu * 8 + j; if (uidx >= 2048) break;
                const int pair = uidx >> 6, idx = uidx & 63; const int b = pair >> 2, kvh = pair & 3, hq = idx >> 4, qb = idx & 15; const int h = kvh * 4 + hq;
                ab::Job J; J.Q = (const ab::bf16*)QB + ((size_t)b * SEQ + qb * 256) * 1024 + h * 64; J.K = (const ab::bf16*)KB + (size_t)b * SEQ * 256 + kvh * 64; J.V = (const ab::bf16*)VB + (size_t)b * SEQ * 256 + kvh * 64;
                J.O = (ab::bf16*)(OB + ((size_t)b * SEQ + qb * 256) * 1024 + h * 64)  ; J.lse = nullptr; J.lutg = nullptr; J.NT = 64; J.i0 = 0; J.kq0 = 0; J.dsh = 0; J.cls = 0;
                if (nomax) { attn8::Job J8; J8.Q = (const unsigned char*)QB + ((size_t)b * SEQ + qb * 256) * 1024 + h * 64; J8.K = (const unsigned char*)KB + (size_t)b * SEQ * 256 + kvh * 64;
                    J8.VT = (const unsigned char*)VB + ((size_t)((b * 4 + kvh) * 64) << 12); J8.O = OB + ((size_t)b * SEQ + qb * 256) * 1024 + h * 64;
                    attn8::attn_unit_f8<64>(J8, (char*)lds, wave); }
                else ab::attn_unit<0, 8, false>(J, (char*)lds, wave);
            }
            for (int j = 0; j < 6; ++j) {
                const int uidx = vcu * 6 + j; if (uidx >= 1536) break;
                const int g = uidx / 512, r = uidx % 512; const int b = r >> 6, hs = (r >> 4) & 3, combo = r & 15;
                const int dsh = 2 * g; const int Lc = SEQ >> dsh; const int nqb = Lc >> 8;
                const int cls = combo / nqb, qb = combo % nqb; const int i0 = qb * 256;
                int t0 = (i0 >> 6) - 1; const int ntile = Lc >> 6; const int NT = ntile >= 6 ? 6 : 4; if (t0 < 0) t0 = 0; if (t0 > ntile - NT) t0 = ntile - NT;
                const size_t cbase = (size_t)b * SEQ + (size_t)cls * Lc;
                const ab::bf16* aq = (const ab::bf16*)AQKV + (size_t)(g * 3 + 0) * T * 256; const ab::bf16* ak = (const ab::bf16*)AQKV + (size_t)(g * 3 + 1) * T * 256; const ab::bf16* av = (const ab::bf16*)AQKV + (size_t)(g * 3 + 2) * T * 256;
                ab::Job J; J.Q = aq + (cbase + i0) * 256 + hs * 64; J.K = ak + (cbase + t0 * 64) * 256 + hs * 64; J.V = av + (cbase + t0 * 64) * 256 + hs * 64;
                J.O = (ab::bf16*)OAG + (size_t)g * T * 256 + (size_t)b * SEQ * 256 + hs * 64; J.lse = LSE + (size_t)g * T * 4 + (size_t)b * SEQ * 4 + hs; J.lutg = BLUT + (g * 4 + hs) * 768;
                J.NT = NT; J.i0 = i0; J.kq0 = t0 * 64 - i0; J.dsh = dsh; J.cls = cls;
                ab::attn_unit<1, 8>(J, (char*)lds, wave);
            }
        }
        if (VK(3)) SEAM(P + 1);
        if (KIND(4) && IN(P + 2) && VK(4)) { PH_BEGIN();
            for (int i = gtid; i < T * 32; i += NGT) { const int t = i >> 5, ch = i & 31, hs = ch >> 3;
                const float l0 = LSE[(size_t)t * 4 + hs], l1 = LSE[(size_t)T * 4 + (size_t)t * 4 + hs], l2 = LSE[(size_t)2 * T * 4 + (size_t)t * 4 + hs];
                const float mx = fmaxf(l0, fmaxf(l1, l2)); float w0 = exp2f(l0 - mx), w1 = exp2f(l1 - mx), w2 = exp2f(l2 - mx); const float inv = 1.0f / (w0 + w1 + w2); w0 *= inv; w1 *= inv; w2 *= inv;
                const v4u a = *(const GAS v4u*)(OAG + (size_t)t * 256 + ch * 8), bq = *(const GAS v4u*)(OAG + (size_t)T * 256 + (size_t)t * 256 + ch * 8), cq = *(const GAS v4u*)(OAG + (size_t)2 * T * 256 + (size_t)t * 256 + ch * 8);
                unsigned o0 = 0, o1 = 0;
                o0 = __builtin_amdgcn_cvt_pk_fp8_f32(w0 * bfl(a.x) + w1 * bfl(bq.x) + w2 * bfl(cq.x), w0 * bfh(a.x) + w1 * bfh(bq.x) + w2 * bfh(cq.x), o0, false);
                o0 = __builtin_amdgcn_cvt_pk_fp8_f32(w0 * bfl(a.y) + w1 * bfl(bq.y) + w2 * bfl(cq.y), w0 * bfh(a.y) + w1 * bfh(bq.y) + w2 * bfh(cq.y), o0, true);
                o1 = __builtin_amdgcn_cvt_pk_fp8_f32(w0 * bfl(a.z) + w1 * bfl(bq.z) + w2 * bfl(cq.z), w0 * bfh(a.z) + w1 * bfh(bq.z) + w2 * bfh(cq.z), o1, false);
                o1 = __builtin_amdgcn_cvt_pk_fp8_f32(w0 * bfl(a.w) + w1 * bfl(bq.w) + w2 * bfl(cq.w), w0 * bfh(a.w) + w1 * bfh(bq.w) + w2 * bfh(cq.w), o1, true);
                v2u o; o.x = o0; o.y = o1; *(GAS v2u*)(OA + (size_t)t * 256 + ch * 8) = o; }
        }
        if (VK(4)) SEAM(P + 2);
        if (KIND(5) && IN(P + 3) && VK(5)) { PH_BEGIN();
            pg8::StaticOrder S; S.init(T, D, G, bx);
            { pg8::Gemm g{(const bf16*)OA, (const bf16*)(WBRA + (size_t)l * D * 256), 128}; pg8::EpiMergeA E{GATE, MERGED}; pg8::gemm_phase_f8<pg8::EpiMergeA, pg8::StaticOrder>(L, g, S, E, wave); }
            { pg8::Gemm g{(const bf16*)OB, (const bf16*)(WBRB + (size_t)l * D * D), D / 2}; pg8::EpiMergeB<true> E{GATE, MERGED, M8}; pg8::gemm_phase_f8<pg8::EpiMergeB<true>, pg8::StaticOrder>(L, g, S, E, wave); }
        }
        if (VK(5)) SEAM(P + 3);
        if (KIND(6) && IN(P + 4) && VK(6)) { PH_BEGIN();
            pg8::Gemm g{(const bf16*)M8, (const bf16*)(WOUT + (size_t)l * D * D), D / 2}; pg8::StaticOrder S; S.init(T, D, G, bx);
            pg8::EpiOut E{l == 0 ? x_in : X, X, MOD + (size_t)l * NB * 6144 + 2 * 1024};
            pg8::gemm_phase_f8<pg8::EpiOut, pg8::StaticOrder>(L, g, S, E, wave);
        }
        if (VK(6)) SEAM(P + 4);
        if (KIND(7) && IN(P + 5) && VK(7)) { PH_BEGIN();
            LAS int* hist = (LAS int*)(L + LDSCTL_OFF + 256);
            for (int vb = bx; vb < 256; vb += G) {
                if (tid < NE) hist[tid] = 0;
                __syncthreads();
                {
                    const int tt = vb + 256 * wave; const int r0 = tt * 16; const int b = r0 >> 12; const int i = lane & 15, kb = lane >> 4;
                    const float* xp = X + (size_t)(r0 + i) * D + 8 * kb;
                    const bf16* bh = WRHI + ((size_t)(l * NB + b) * NE + i) * D + 8 * kb; const bf16* bl = WRLO + ((size_t)(l * NB + b) * NE + i) * D + 8 * kb;
                    f32x4 acc0 = (f32x4){0.f, 0.f, 0.f, 0.f}, acc1 = acc0; float ss = 0.f;
#pragma unroll 8
                    for (int s = 0; s < 32; ++s) {
                        const f32x4 x0 = *(const GAS f32x4*)(xp + 32 * s), x1 = *(const GAS f32x4*)(xp + 32 * s + 4);
                        const bf16x8 wh0 = *(const GAS bf16x8*)(bh + 32 * s), wh1 = *(const GAS bf16x8*)(bh + 16 * D + 32 * s), wl0 = *(const GAS bf16x8*)(bl + 32 * s), wl1 = *(const GAS bf16x8*)(bl + 16 * D + 32 * s);
                        ss += (x0.x * x0.x + x0.y * x0.y) + (x0.z * x0.z + x0.w * x0.w) + (x1.x * x1.x + x1.y * x1.y) + (x1.z * x1.z + x1.w * x1.w);
                        v4u ah, al;
                        ah.x = pg8::cvt_pk_bf16(x0.x, x0.y); ah.y = pg8::cvt_pk_bf16(x0.z, x0.w); ah.z = pg8::cvt_pk_bf16(x1.x, x1.y); ah.w = pg8::cvt_pk_bf16(x1.z, x1.w);
                        al.x = pg8::cvt_pk_bf16(x0.x - bfl(ah.x), x0.y - bfh(ah.x)); al.y = pg8::cvt_pk_bf16(x0.z - bfl(ah.y), x0.w - bfh(ah.y));
                        al.z = pg8::cvt_pk_bf16(x1.x - bfl(ah.z), x1.y - bfh(ah.z)); al.w = pg8::cvt_pk_bf16(x1.z - bfl(ah.w), x1.w - bfh(ah.w));
                        const bf16x8 ahv = __builtin_bit_cast(bf16x8, ah), alv = __builtin_bit_cast(bf16x8, al);
                        acc0 = __builtin_amdgcn_mfma_f32_16x16x32_bf16(wh0, ahv, acc0, 0, 0, 0); acc1 = __builtin_amdgcn_mfma_f32_16x16x32_bf16(wh1, ahv, acc1, 0, 0, 0);
                        acc0 = __builtin_amdgcn_mfma_f32_16x16x32_bf16(wl0, ahv, acc0, 0, 0, 0); acc1 = __builtin_amdgcn_mfma_f32_16x16x32_bf16(wl1, ahv, acc1, 0, 0, 0);
                        acc0 = __builtin_amdgcn_mfma_f32_16x16x32_bf16(wh0, alv, acc0, 0, 0, 0); acc1 = __builtin_amdgcn_mfma_f32_16x16x32_bf16(wh1, alv, acc1, 0, 0, 0);
                    }
                    ss = xsum<16>(ss); ss = xsum<32>(ss);
                    const float rs = rsqrtf(ss * (1.0f / D) + EPS);
                    float v[8]; const float* rc = RC0 + (l * NB + b) * NE;
#pragma unroll
                    for (int r = 0; r < 4; ++r) { v[r] = rs * acc0[r] + rc[4 * kb + r]; v[4 + r] = rs * acc1[r] + rc[16 + 4 * kb + r]; }
                    float tv[4]; int ti[4];
#pragma unroll
                    for (int k = 0; k < 4; ++k) { float best = v[0]; int br = 0;
#pragma unroll
                        for (int r = 1; r < 8; ++r) if (v[r] > best) { best = v[r]; br = r; }
#pragma unroll
                        for (int r = 0; r < 8; ++r) v[r] = (r == br) ? -INFINITY : v[r];
                        tv[k] = best; ti[k] = (br & 3) + 16 * (br >> 2) + 4 * kb; }
#pragma unroll
                    for (int round = 0; round < 2; ++round) {
                        float bv[8]; int bi[8];
#pragma unroll
                        for (int k = 0; k < 4; ++k) { bv[k] = tv[k]; bi[k] = ti[k];
                            if (round == 0) { bv[4 + k] = __int_as_float(__builtin_amdgcn_ds_swizzle(__float_as_int(tv[k]), 0x1f | (16 << 10))); bi[4 + k] = __builtin_amdgcn_ds_swizzle(ti[k], 0x1f | (16 << 10)); }
                            else { bv[4 + k] = xget32(tv[k], lane >> 5); bi[4 + k] = xget32(ti[k], lane >> 5); } }
#pragma unroll
                        for (int k = 0; k < 4; ++k) { float best = bv[0]; int bq = 0;
#pragma unroll
                            for (int r = 1; r < 8; ++r) if (bv[r] > best || (bv[r] == best && bi[r] < bi[bq])) { best = bv[r]; bq = r; }
                            int sel = bi[0];
#pragma unroll
                            for (int r = 0; r < 8; ++r) { if (r == bq) sel = bi[r]; }
#pragma unroll
                            for (int r = 0; r < 8; ++r) bv[r] = (r == bq) ? -INFINITY : bv[r];
                            tv[k] = best; ti[k] = sel; }
                    }
                    if (kb == 0) {
                        const float e1 = __expf(tv[1] - tv[0]), e2 = __expf(tv[2] - tv[0]), e3 = __expf(tv[3] - tv[0]); const float inv = 1.0f / (1.0f + e1 + e2 + e3);
                        const int tok = r0 + i;
                        *(GAS i32x4*)(TOPE + (size_t)tok * 4) = (i32x4){ti[0], ti[1], ti[2], ti[3]};
                        *(GAS f32x4*)(TOPW + (size_t)tok * 4) = (f32x4){inv, e1 * inv, e2 * inv, e3 * inv};
#pragma unroll
                        for (int k = 0; k < 4; ++k) atomicAdd((int*)&hist[ti[k]], 1);
                    }
                }
                __syncthreads();
                if (tid < NE) HIST[vb * NE + tid] = hist[tid];
                __syncthreads();
            }
            for (int m = 2 * gw; m < T; m += 2 * NGW) { const int b = m >> 12; const float* md = MOD + ((size_t)l * NB + b) * 6144;
                norm_rows2_f8(X + (size_t)m * D, norm2_g + l * D, md + 4 * 1024, md + 3 * 1024, (unsigned char*)H + (size_t)m * D, lane); }
        }
        if (VK(7)) SEAM(P + 5);
        if (KIND(8) && IN(P + 6) && VK(8)) { PH_BEGIN();
            LAS int* sm = (LAS int*)L;
            for (int vb = bx; vb < 256; vb += G) {
                { const int e = tid & 31, seg = tid >> 5; int tot = 0, bef = 0;
                    for (int q = seg * 16; q < seg * 16 + 16; ++q) { const int hv = HIST[q * NE + e]; tot += hv; if (q < vb) bef += hv; }
                    sm[tid] = tot; sm[512 + tid] = bef; }
                __syncthreads();
                if (tid < NE) { int tot = 0, bef = 0;
                    for (int s = 0; s < 16; ++s) { tot += sm[s * 32 + tid]; bef += sm[512 + s * 32 + tid]; }
                    sm[1024 + tid] = bef; sm[1056 + tid] = (tot + 255) & ~255; }
                __syncthreads();
                if (tid == 0) { int run = 0; for (int e = 0; e < NE; ++e) { const int pd = sm[1056 + e]; sm[1056 + e] = run; sm[1024 + e] += run;
                        if (vb == 0) { for (int q = run >> 8; q < (run + pd) >> 8; ++q) TILEE[q] = e; }
                        run += pd; }
                    if (vb == 0) TILEE[1000] = run >> 8; }
                __syncthreads();
                if (tid < 128) { const int tt = vb + 256 * (tid >> 4); const int tok = tt * 16 + (tid & 15);
                    const i32x4 te = *(const GAS i32x4*)(TOPE + (size_t)tok * 4); const f32x4 tw = *(const GAS f32x4*)(TOPW + (size_t)tok * 4);
                    const int s0 = atomicAdd((int*)&sm[1024 + te.x], 1), s1 = atomicAdd((int*)&sm[1024 + te.y], 1), s2 = atomicAdd((int*)&sm[1024 + te.z], 1), s3 = atomicAdd((int*)&sm[1024 + te.w], 1);
                    *(GAS i32x4*)(SLOT + (size_t)tok * 4) = (i32x4){s0, s1, s2, s3};
                    ROWW[s0] = tw.x; ROWW[s1] = tw.y; ROWW[s2] = tw.z; ROWW[s3] = tw.w;
                    sm[2048 + tid * 4 + 0] = s0; sm[2048 + tid * 4 + 1] = s1; sm[2048 + tid * 4 + 2] = s2; sm[2048 + tid * 4 + 3] = s3; }
                __syncthreads();
                for (int p = wave; p < 512; p += NWAVES) { const int q = p >> 2; const int tt = vb + 256 * (q >> 4); const int tok = tt * 16 + (q & 15); const int slot = sm[2048 + p];
                    const GAS v4u* src = (const GAS v4u*)((unsigned char*)H + (size_t)tok * D); GAS v4u* dst = (GAS v4u*)(XS + (size_t)slot * D);
                    dst[lane] = src[lane]; }
                __syncthreads();
            }
        }
        if (VK(8)) SEAM(P + 6);
        if (KIND(9) && IN(P + 7) && VK(9)) { PH_BEGIN();
            const int nmt = __builtin_amdgcn_readfirstlane(__hip_atomic_load(TILEE + 1000, __ATOMIC_RELAXED, __HIP_MEMORY_SCOPE_AGENT));
            pg8::Gemm g{(const bf16*)XS, (const bf16*)(WGU + (size_t)l * NE * 2048 * D), D / 2}; pg8::MoeOrder S{TILEE, nmt * 8, 8, G, vcu};
            pg8::EpiGU8 E{b_gate_up + (size_t)l * NE * 2048, ACT};
            pg8::gemm_phase_f8<pg8::EpiGU8, pg8::MoeOrder>(L, g, S, E, wave);
        }
        if (VK(9)) SEAM(P + 7);
        if (KIND(10) && IN(P + 8) && VK(10)) { PH_BEGIN();
            const int nmt = __builtin_amdgcn_readfirstlane(__hip_atomic_load(TILEE + 1000, __ATOMIC_RELAXED, __HIP_MEMORY_SCOPE_AGENT));
            pg8::Gemm g{(const bf16*)ACT, (const bf16*)(WDN + (size_t)l * NE * D * D), D / 2}; pg8::MoeOrder S{TILEE, nmt * 4, 4, G, vcu};
            pg8::EpiDN8 E{b_down + (size_t)l * NE * D, ROWW, YB};
            pg8::gemm_phase_f8<pg8::EpiDN8, pg8::MoeOrder>(L, g, S, E, wave);
        }
        if (VK(10)) SEAM(P + 8);
        if (KIND(11) && IN(P + 9) && VK(11)) { PH_BEGIN();
            const bool lastl = (l == DEPTH - 1);
            float* Xw = virt ? (float*)(ws + WS_R) : X; bf16* Hw = virt ? (bf16*)(ws + WS_R + 128 * MiB) : H;
            for (int m0 = 2 * gw; m0 < T; m0 += 2 * NGW) { const int b = m0 >> 12;
                i32x4 sl[2];
#pragma unroll
                for (int q = 0; q < 2; ++q) { const int* sp = SLOT + (size_t)(m0 + q) * 4;
                    sl[q].x = __hip_atomic_load(sp + 0, RLX_AGENT); sl[q].y = __hip_atomic_load(sp + 1, RLX_AGENT); sl[q].z = __hip_atomic_load(sp + 2, RLX_AGENT); sl[q].w = __hip_atomic_load(sp + 3, RLX_AGENT); }
                const int c = 16 * lane;
                const float* g2 = MOD + ((size_t)l * NB + b) * 6144 + 5 * 1024;
                f32x4 v[2][4]; v4u yy[2][4];
#pragma unroll
                for (int q = 0; q < 2; ++q) {
#pragma unroll
                    for (int j = 0; j < 4; ++j) v[q][j] = *(const GAS f32x4*)(X + (size_t)(m0 + q) * D + c + 4 * j);
                    yy[q][0] = *(const GAS v4u*)(YB + (size_t)sl[q].x * D + c); yy[q][1] = *(const GAS v4u*)(YB + (size_t)sl[q].y * D + c);
                    yy[q][2] = *(const GAS v4u*)(YB + (size_t)sl[q].z * D + c); yy[q][3] = *(const GAS v4u*)(YB + (size_t)sl[q].w * D + c); }
                float s[2] = {0.f, 0.f};
#pragma unroll
                for (int q = 0; q < 2; ++q)
#pragma unroll
                    for (int j = 0; j < 4; ++j) { f32x4 ys = (f32x4){0.f, 0.f, 0.f, 0.f};
#pragma unroll
                        for (int k = 0; k < 4; ++k) { const unsigned w = yy[q][k][j];
                            const auto lo = __builtin_amdgcn_cvt_pk_f32_fp8((int)w, false), hi2 = __builtin_amdgcn_cvt_pk_f32_fp8((int)w, true);
                            ys.x += lo[0]; ys.y += lo[1]; ys.z += hi2[0]; ys.w += hi2[1]; }
                        const f32x4 gg = *(const GAS f32x4*)(g2 + c + 4 * j);
                        v[q][j] = v[q][j] + gg * ys;
                        if (!lastl) *(GAS f32x4*)(Xw + (size_t)(m0 + q) * D + c + 4 * j) = v[q][j];
                        s[q] += (v[q][j].x * v[q][j].x + v[q][j].y * v[q][j].y) + (v[q][j].z * v[q][j].z + v[q][j].w * v[q][j].w); }
                const float rs0 = rsqrtf(wave_sum(s[0]) * (1.0f / D) + EPS), rs1 = rsqrtf(wave_sum(s[1]) * (1.0f / D) + EPS);
                if (!lastl) { const float* md = MOD + ((size_t)(l + 1) * NB + b) * 6144; const float* gn = norm1_g + (l + 1) * D;
                    v4u h0, h1;
#pragma unroll
                    for (int j = 0; j < 4; ++j) {
                        const f32x4 gg = *(const GAS f32x4*)(gn + c + 4 * j), a1 = *(const GAS f32x4*)(md + 1024 + c + 4 * j) + 1.0f, a0 = *(const GAS f32x4*)(md + c + 4 * j);
                        const f32x4 y0 = (v[0][j] * rs0 * gg) * a1 + a0, y1 = (v[1][j] * rs1 * gg) * a1 + a0;
                        unsigned w0 = 0, w1 = 0;
                        w0 = __builtin_amdgcn_cvt_pk_fp8_f32(y0.x, y0.y, w0, false); w0 = __builtin_amdgcn_cvt_pk_fp8_f32(y0.z, y0.w, w0, true);
                        w1 = __builtin_amdgcn_cvt_pk_fp8_f32(y1.x, y1.y, w1, false); w1 = __builtin_amdgcn_cvt_pk_fp8_f32(y1.z, y1.w, w1, true);
                        h0[j] = w0; h1[j] = w1; }
                    *(GAS v4u*)((unsigned char*)Hw + (size_t)m0 * D + c) = h0; *(GAS v4u*)((unsigned char*)Hw + (size_t)(m0 + 1) * D + c) = h1;
                } else {
#pragma unroll
                    for (int j = 0; j < 4; ++j) { const f32x4 gg = *(const GAS f32x4*)(final_g + c + 4 * j);
                        *(GAS f32x4*)(ap->out + (size_t)m0 * D + c + 4 * j) = v[0][j] * rs0 * gg; *(GAS f32x4*)(ap->out + (size_t)(m0 + 1) * D + c + 4 * j) = v[1][j] * rs1 * gg; }
                }
            }
        }
        if (VK(11)) SEAM(P + 9);
        if (virt) { PH_BEGIN();
            for (int m = 2 * gw; m < T; m += 2 * NGW) { const int b = m >> 12; const float* md = MOD + (size_t)b * 6144; norm_rows2_f8(x_in + (size_t)m * D, norm1_g, md + 1024, md, (unsigned char*)H + (size_t)m * D, lane); }
            xcd_barrier(bar); }
    }
#undef IN
#undef SEAM
}

extern "C" void kernel_launch(void* const* d_in, const int* in_sizes, int n_in, void* d_out, int out_size, void* d_ws, size_t ws_size, hipStream_t stream) {
    static int grid = 0;
    if (grid == 0) {
        if (n_in != 20 || in_sizes[0] != T * D || out_size != T * D || ws_size < WS_END) { fprintf(stderr, "kernel_launch: unexpected shapes (n_in %d, in0 %d, out %d, ws %zu < %zu); nothing launched\n", n_in, n_in > 0 ? in_sizes[0] : -1, out_size, ws_size, (size_t)WS_END); grid = -1; return; }
        int dev = 0, cus = 0, per_cu = 0;
        if (hipGetDevice(&dev) != hipSuccess || hipDeviceGetAttribute(&cus, hipDeviceAttributeMultiprocessorCount, dev) != hipSuccess) { grid = -1; return; }
        if (hipFuncSetAttribute((const void*)mk_fwd, hipFuncAttributeMaxDynamicSharedMemorySize, LDS_BYTES) != hipSuccess) { fprintf(stderr, "kernel_launch: hipFuncSetAttribute failed\n"); grid = -1; return; }
        if (hipOccupancyMaxActiveBlocksPerMultiprocessor(&per_cu, (const void*)mk_fwd, NWAVES * 64, LDS_BYTES) != hipSuccess || per_cu < 1)
            fprintf(stderr, "kernel_launch: note: occupancy query reports %d workgroups per CU\n", per_cu);
        (void)hipGetLastError();
        grid = cus < 256 ? cus : 256;
        if (grid != 256) fprintf(stderr, "kernel_launch: %d CUs; this kernel's unit deals assume 256\n", grid);
    }
    if (grid < 0) return;
    if (hipMemsetAsync((char*)d_ws + WS_CTL, 0, CTL_ZERO_BYTES, stream) != hipSuccess) { fprintf(stderr, "kernel_launch: memset failed\n"); return; }
    Args a{};
    for (int i = 0; i < 20; ++i) a.in[i] = (const float*)d_in[i];
    a.out = (float*)d_out; a.ws = (unsigned char*)d_ws; a.pad = 0;
#if MK_PER_PHASE
    for (int p = 0; p < N_PHASES; ++p) { a.ph_lo = p; a.ph_hi = p + 1; a.li = 0; hipLaunchKernelGGL(mk_fwd, dim3(grid), dim3(NWAVES * 64), LDS_BYTES, stream, a); }
#else
    a.ph_lo = 0; a.ph_hi = N_PHASES; a.li = 0;
    hipLaunchKernelGGL(mk_fwd, dim3(grid), dim3(NWAVES * 64), LDS_BYTES, stream, a);
#endif
    const hipError_t le = hipPeekAtLastError();
    if (le != hipSuccess) fprintf(stderr, "kernel_launch: launch failed: %s\n", hipGetErrorName(le));
}
```

```cpp
#include <hip/hip_runtime.h>
#include <hip/hip_bf16.h>
#include <cstdio>
#include <cstdint>
#include <cmath>

#ifndef PH_KIND_MASK
#define PH_KIND_MASK 0xFFF
#endif
#ifndef PROBE_MASK
#define PROBE_MASK 0
#endif
#ifndef PROBE_P0
#define PROBE_P0 0
#endif
#ifndef PROBE_SPIN_MASK
#define PROBE_SPIN_MASK 0
#endif
#ifndef MK_PER_PHASE
#define MK_PER_PHASE 0
#endif

constexpr int NB = 8, SEQ = 4096, T = NB * SEQ, D = 1024, DEPTH = 2;
constexpr int N_IN = 5888, NE = 32, TOPK = 4;
constexpr int NASSIGN = T * TOPK;
constexpr int MAX_MT = NASSIGN / 256 + NE;
constexpr int CAP_ROWS = MAX_MT * 256;
constexpr int GU_MAXU = 20;
constexpr float C2 = 0.125f * 1.4426950408889634f;
constexpr float LOG2E = 1.4426950408889634f;
constexpr float EPS = 1e-6f;

__device__ __forceinline__ int lane_id_asm() { int l; asm volatile("v_mbcnt_lo_u32_b32 %0, -1, 0\n\tv_mbcnt_hi_u32_b32 %0, -1, %0" : "=v"(l)); return l; }

template <int M> __device__ __forceinline__ float xsum(float v) {
    if constexpr (M < 32) return v + __int_as_float(__builtin_amdgcn_ds_swizzle(__float_as_int(v), 0x1f | (M << 10)));
    else { auto rr = __builtin_amdgcn_permlane32_swap(__float_as_uint(v), __float_as_uint(v), false, false); return __uint_as_float(rr[0]) + __uint_as_float(rr[1]); }
}
template <class Tv> __device__ __forceinline__ Tv xget32(Tv v, int hf) {
    auto rr = __builtin_amdgcn_permlane32_swap(__builtin_bit_cast(unsigned, v), __builtin_bit_cast(unsigned, v), false, false); return __builtin_bit_cast(Tv, hf ? rr[0] : rr[1]);
}

namespace pg8 {
#define PG8_LAS __attribute__((address_space(3)))
typedef unsigned short bf16_t;
typedef short bf16x8 __attribute__((ext_vector_type(8)));
typedef float f32x4 __attribute__((ext_vector_type(4)));
typedef unsigned u32x4 __attribute__((ext_vector_type(4)));
typedef unsigned u32x2 __attribute__((ext_vector_type(2)));
constexpr int BM = 256, BK = 64, HALF = 128, HTB = HALF * BK * 2, STAGE_BYTES = 8 * HTB, NXCD = 8, WGM = 8;

__host__ __device__ __forceinline__ int lds_byte(int r, int c) { const int st = (r >> 4) * 2 + (c >> 5), rr = r & 15, cc = c & 31, ob = rr * 64 + cc * 2; return st * 1024 + (ob ^ (((ob >> 9) & 1) << 5)); }
__host__ __device__ __forceinline__ void stage_rc(int b, int& R, int& C) { const int st = b / 1024, sb = b % 1024, swz = sb ^ (((sb >> 9) & 1) << 5); R = (st >> 1) * 16 + swz / 64; C = (st & 1) * 32 + (swz % 64) / 2; }
__host__ __device__ __forceinline__ int perm32(int rho) { const int n = rho >> 4, i = rho & 15; return 8 * (i >> 2) + 4 * n + (i & 3); }

struct Unit { int pm, pn; };
struct Gemm { const bf16_t* A; const bf16_t* Bt; int K; };

struct StaticOrder {
    int nM, nN, nwg, G, c;
    __device__ void init(int M, int N, int G_, int c_) { nM = M / BM; nN = N / BM; nwg = nM * nN; G = G_; c = c_; }
    __device__ __forceinline__ bool next(int i, Unit& u) const {
        const long L = (long)i * G + c; if (L >= nwg) return false;
        int wgid = (int)L; { const int q = nwg / NXCD, r = nwg % NXCD, xcd = wgid % NXCD, off = wgid / NXCD; wgid = (xcd < r ? xcd * (q + 1) : r * (q + 1) + (xcd - r) * q) + off; }
        const int nig = WGM * nN, gid = wgid / nig, fm = gid * WGM, gsz = (nM - fm) < WGM ? (nM - fm) : WGM;
        u.pm = fm + ((wgid % nig) % gsz); u.pn = (wgid % nig) / gsz; return true;
    }
};
struct MoeOrder {
    const PG8_LAS int* tile_e; int n_units, nN, G, vcu;
    __device__ __forceinline__ bool next(int i, Unit& u) const {
        const long L = (long)i * G + vcu; if (L >= n_units) return false;
        const int mt = (int)L / nN, pl = (int)L % nN; const int e = __builtin_amdgcn_readfirstlane(tile_e[mt]);
        u.pm = mt; u.pn = e * nN + pl; return true;
    }
};

__device__ __forceinline__ unsigned cvt_pk_bf16(float lo, float hi) { unsigned r; asm volatile("v_cvt_pk_bf16_f32 %0, %1, %2" : "=v"(r) : "v"(lo), "v"(hi)); return r; }
__device__ __forceinline__ float bf_lo(unsigned w) { return __uint_as_float(w << 16); }
__device__ __forceinline__ float bf_hi(unsigned w) { return __uint_as_float(w & 0xffff0000u); }
__device__ __forceinline__ float sigmoid_f(float x) { return __builtin_amdgcn_rcpf(1.0f + __builtin_amdgcn_exp2f(-LOG2E * x)); }

typedef int i32x4_t __attribute__((ext_vector_type(4)));
template <class Epi, class Sched, bool GATHER = false>
__device__ __forceinline__ void gemm_phase_f8(PG8_LAS unsigned char* lds, const Gemm g, const Sched& S, const Epi& E, const int wid_in, const PG8_LAS unsigned short* rt = nullptr) {
    int wid = wid_in; asm volatile("" : "+s"(wid));
    const int lane = lane_id_asm(), tid = wid * 64 + lane, wr = wid >> 2, wc = wid & 3, fr = lane & 15, fq = lane >> 4;
    int K_o = g.K; asm volatile("" : "+s"(K_o)); const int K = K_o, nt = K / BK;
    unsigned voff[2];
#pragma unroll
    for (int i = 0; i < 2; ++i) { int R, C; stage_rc(tid * 16 + i * 8192, R, C); voff[i] = (unsigned)(R * K + C) * 2u; }
    const size_t kstep = (size_t)(BK * 2);
    const size_t hstep = (size_t)HALF * K * 2;
    const size_t tstep = 2 * hstep;
    const unsigned ldsw = (unsigned)wid * 1024u;
    const int aoff = lds_byte(wr * 64 + fr, fq * 8), boff = lds_byte(wc * 32 + fr, fq * 8);
#define PG8_SA(b, h) (((b) * 2 + (h)) * HTB)
#define PG8_SB(b, h) ((4 + (b) * 2 + (h)) * HTB)
#define PG8_STAGE(bufoff, gbase) do { _Pragma("unroll") for (int _i = 0; _i < 2; ++_i) \
        __builtin_amdgcn_global_load_lds((const unsigned*)((const char*)(gbase) + voff[_i]), (PG8_LAS unsigned*)(lds + (bufoff) + ldsw + _i * 8192), 16, 0, 0); } while (0)
#define PG8_STAGE_A(bufoff, gbase, va, h, koff) do { if constexpr (GATHER) { _Pragma("unroll") for (int _i = 0; _i < 2; ++_i) \
        __builtin_amdgcn_global_load_lds((const unsigned*)((const char*)g.A + (size_t)((va)[h][_i] + (unsigned)(koff))), (PG8_LAS unsigned*)(lds + (bufoff) + ldsw + _i * 8192), 16, 0, 0); } else PG8_STAGE(bufoff, gbase); } while (0)
#define PG8_LOAD_VA(va, uidx) do { _Pragma("unroll") for (int _h = 0; _h < 2; ++_h) _Pragma("unroll") for (int _i = 0; _i < 2; ++_i) { int R, C; stage_rc(tid * 16 + _i * 8192, R, C); \
        (va)[_h][_i] = (unsigned)rt[(uidx) * 256 + _h * HALF + R] * (unsigned)(K * 2) + (unsigned)(C * 2); } } while (0)
#define PG8_LDA(dst, b, h) do { _Pragma("unroll") for (int m = 0; m < 4; ++m) _Pragma("unroll") for (int k = 0; k < 2; ++k) dst[m][k] = *(const PG8_LAS bf16x8*)(lds + PG8_SA(b, h) + aoff + m * 2048 + k * 1024); } while (0)
#define PG8_LDB(dst, b, h) do { _Pragma("unroll") for (int n = 0; n < 2; ++n) _Pragma("unroll") for (int k = 0; k < 2; ++k) dst[n][k] = *(const PG8_LAS bf16x8*)(lds + PG8_SB(b, h) + boff + n * 2048 + k * 1024); } while (0)
#define PG8_F8(x) __builtin_shufflevector(__builtin_bit_cast(i32x4_t, (x)[0]), __builtin_bit_cast(i32x4_t, (x)[1]), 0, 1, 2, 3, 4, 5, 6, 7)
#define PG8_MMA(ai, bj, At, Bt) do { __builtin_amdgcn_s_setprio(1); asm volatile("s_nop 1" ::: ); _Pragma("unroll") for (int m = 0; m < 4; ++m) _Pragma("unroll") for (int n = 0; n < 2; ++n) \
        asm volatile("v_mfma_f32_16x16x128_f8f6f4 %0, %1, %2, %0" : "+v"(acc[ai][bj][m][n]) : "v"(PG8_F8(Bt[n])), "v"(PG8_F8(At[m]))); __builtin_amdgcn_s_setprio(0); } while (0)
#define PG8_ACC_SETTLE asm volatile("s_nop 15\n\ts_nop 15" ::: "memory")
#define PG8_WAIT_V(n) asm volatile("s_waitcnt vmcnt(" #n ")" ::: "memory")
#define PG8_WAIT_L(n) asm volatile("s_waitcnt lgkmcnt(" #n ")" ::: "memory")
#define PG8_BAR __builtin_amdgcn_s_barrier()
#define PG8_SCHED __builtin_amdgcn_sched_barrier(0)
    Unit cur, nxt; int ui = 0; int sprev = 0;
    if (!S.next(0, cur)) return;
    f32x4 acc[2][2][4][2];
#pragma unroll
    for (int a = 0; a < 2; ++a)
#pragma unroll
        for (int b = 0; b < 2; ++b)
#pragma unroll
            for (int m = 0; m < 4; ++m)
#pragma unroll
                for (int n = 0; n < 2; ++n) acc[a][b][m][n] = (f32x4){0.f, 0.f, 0.f, 0.f};
    bf16x8 At[4][2], B0[2][2], B1[2][2];
    const char* cA = (const char*)g.A + (size_t)cur.pm * tstep; const char* cB = (const char*)g.Bt + (size_t)cur.pn * tstep;
    unsigned va_c[2][2] = {{0u, 0u}, {0u, 0u}}, va_n[2][2] = {{0u, 0u}, {0u, 0u}};
    if constexpr (GATHER) PG8_LOAD_VA(va_c, 0);
    PG8_STAGE(PG8_SB(0, 0), cB); PG8_STAGE(PG8_SB(0, 1), cB + hstep); PG8_STAGE_A(PG8_SA(0, 0), cA, va_c, 0, 0); PG8_STAGE_A(PG8_SA(0, 1), cA + hstep, va_c, 1, 0);
    if (wr == 1) PG8_BAR;
    PG8_WAIT_V(2); PG8_BAR;
    PG8_STAGE(PG8_SB(1, 0), cB + kstep); PG8_STAGE_A(PG8_SA(1, 0), cA + kstep, va_c, 0, kstep); PG8_STAGE(PG8_SB(1, 1), cB + hstep + kstep);
    PG8_WAIT_V(6); PG8_BAR;
    for (;;) {
        const bool has_next = S.next(ui + 1, nxt);
        const char* nA = has_next ? (const char*)g.A + (size_t)nxt.pm * tstep : cA; const char* nB = has_next ? (const char*)g.Bt + (size_t)nxt.pn * tstep : cB;
        if constexpr (GATHER) { if (has_next) PG8_LOAD_VA(va_n, ui + 1); }
#define PG8_WAITSEL do { if (!first) { PG8_WAIT_V(8); } else if (sprev == 4) { PG8_WAIT_V(12); } else if (sprev == 8) { PG8_WAIT_V(16); } else if (sprev == 16) { PG8_WAIT_V(24); } else { PG8_WAIT_V(40); } } while (0)
        for (int t = 0; t < nt; t += 2) {
            const bool last = (t == nt - 2);
            const bool first = (t == 0) && (sprev != 0);
            const char* a1 = cA + (size_t)(t + 1) * kstep;
            const char* a2 = last ? nA : cA + (size_t)(t + 2) * kstep; const char* b2 = last ? nB : cB + (size_t)(t + 2) * kstep;
            const char* a3 = a2 + kstep; const char* b3 = b2 + kstep;
            unsigned v2[2][2]; const unsigned k1 = (unsigned)(t + 1) * (unsigned)kstep, k2 = last ? 0u : (unsigned)(t + 2) * (unsigned)kstep;
            if constexpr (GATHER) {
#pragma unroll
                for (int h_ = 0; h_ < 2; ++h_)
#pragma unroll
                    for (int i_ = 0; i_ < 2; ++i_) v2[h_][i_] = last ? va_n[h_][i_] : va_c[h_][i_]; }
            PG8_LDB(B0, 0, 0); PG8_LDB(B1, 0, 1); PG8_SCHED; PG8_LDA(At, 0, 0); if (!first) PG8_STAGE_A(PG8_SA(1, 1), a1 + hstep, va_c, 1, k1);
            PG8_WAITSEL; PG8_WAIT_L(0); PG8_BAR; PG8_MMA(0, 0, At, B0); PG8_MMA(0, 1, At, B1); PG8_BAR; PG8_SCHED;
            PG8_LDA(At, 0, 1); PG8_STAGE(PG8_SB(0, 0), b2); PG8_STAGE(PG8_SB(0, 1), b2 + hstep); PG8_STAGE_A(PG8_SA(0, 0), a2, v2, 0, k2);
            PG8_WAITSEL; PG8_WAIT_L(0); PG8_BAR; PG8_MMA(1, 0, At, B0); PG8_MMA(1, 1, At, B1); PG8_BAR; PG8_SCHED;
            PG8_LDB(B0, 1, 0); PG8_LDB(B1, 1, 1); PG8_SCHED; PG8_LDA(At, 1, 0); PG8_STAGE_A(PG8_SA(0, 1), a2 + hstep, v2, 1, k2);
            PG8_WAITSEL; PG8_WAIT_L(0); PG8_BAR; PG8_MMA(0, 0, At, B0); PG8_MMA(0, 1, At, B1); PG8_BAR; PG8_SCHED;
            PG8_LDA(At, 1, 1); PG8_STAGE(PG8_SB(1, 0), b3); PG8_STAGE(PG8_SB(1, 1), b3 + hstep); PG8_STAGE_A(PG8_SA(1, 0), a3, v2, 0, k2 + (unsigned)kstep);
            PG8_WAIT_V(8); PG8_WAIT_L(0); PG8_BAR; PG8_MMA(1, 0, At, B0); PG8_MMA(1, 1, At, B1); PG8_BAR; PG8_SCHED;
        }
#undef PG8_WAITSEL
        if (wr == 0) PG8_BAR;
        sprev = has_next ? E.nst(cur) : 0;
        if (sprev != 0) PG8_STAGE_A(PG8_SA(1, 1), nA + kstep + hstep, va_n, 1, kstep);
        PG8_ACC_SETTLE;
        E(acc, cur, wr, wc, fr, fq);
        if (!has_next) break;
#pragma unroll
        for (int a = 0; a < 2; ++a)
#pragma unroll
            for (int b = 0; b < 2; ++b)
#pragma unroll
                for (int m = 0; m < 4; ++m)
#pragma unroll
                    for (int n = 0; n < 2; ++n) acc[a][b][m][n] = (f32x4){0.f, 0.f, 0.f, 0.f};
        cur = nxt; cA = nA; cB = nB; ++ui;
        if constexpr (GATHER) {
#pragma unroll
            for (int h_ = 0; h_ < 2; ++h_)
#pragma unroll
                for (int i_ = 0; i_ < 2; ++i_) va_c[h_][i_] = va_n[h_][i_]; }
        if (wr == 1) PG8_BAR;
    }
    PG8_WAIT_V(0);
    PG8_BAR;
#undef PG8_SA
#undef PG8_SB
#undef PG8_STAGE
#undef PG8_STAGE_A
#undef PG8_LOAD_VA
#undef PG8_LDA
#undef PG8_LDB
#undef PG8_MMA
#undef PG8_F8
#undef PG8_ACC_SETTLE
#undef PG8_WAIT_V
#undef PG8_WAIT_L
#undef PG8_BAR
#undef PG8_SCHED
}

#define EPI_ROWS(...) _Pragma("unroll") for (int ai = 0; ai < 2; ++ai) _Pragma("unroll") for (int m = 0; m < 4; ++m) { const int row = u.pm * BM + ai * HALF + wr * 64 + m * 16 + fr; __VA_ARGS__ }
__device__ __forceinline__ u32x4 pack8(const f32x4 a, const f32x4 b) { u32x4 w; w.x = cvt_pk_bf16(a[0], a[1]); w.y = cvt_pk_bf16(a[2], a[3]); w.z = cvt_pk_bf16(b[0], b[1]); w.w = cvt_pk_bf16(b[2], b[3]); return w; }

__device__ __forceinline__ u32x2 pack8_f8(const f32x4 a, const f32x4 b) { unsigned w0 = 0, w1 = 0;
    w0 = __builtin_amdgcn_cvt_pk_fp8_f32(a[0], a[1], w0, false); w0 = __builtin_amdgcn_cvt_pk_fp8_f32(a[2], a[3], w0, true);
    w1 = __builtin_amdgcn_cvt_pk_fp8_f32(b[0], b[1], w1, false); w1 = __builtin_amdgcn_cvt_pk_fp8_f32(b[2], b[3], w1, true); u32x2 r; r.x = w0; r.y = w1; return r; }
constexpr float W8_SCALE = 64.0f, W8_INV = 1.0f / 64.0f;
#define MK_QUAD(sidx, ctrl) { const unsigned as_ = (unsigned)__builtin_amdgcn_mov_dpp((int)a, ctrl, 0xf, 0xf, true), cs_ = (unsigned)__builtin_amdgcn_mov_dpp((int)c, ctrl, 0xf, 0xf, true); \
        const unsigned pr_ = ((q4 < 2 ? as_ : cs_) >> (16 * (q4 & 1))) & 0xffffu; lo |= (pr_ & 0xffu) << (8 * (sidx)); hi |= (pr_ >> 8) << (8 * (sidx)); }
__device__ __forceinline__ u32x4 widen16(const u32x2 a, const u32x2 b) {
    const auto r0 = __builtin_amdgcn_permlane16_swap(a.x, b.x, false, false), r1 = __builtin_amdgcn_permlane16_swap(a.y, b.y, false, false);
    u32x4 w; w.x = r0[0]; w.y = r1[0]; w.z = r0[1]; w.w = r1[1]; return w; }
typedef float f32x2 __attribute__((ext_vector_type(2)));
__device__ __forceinline__ f32x2 pk_fma(f32x2 a, f32x2 b, f32x2 c) { return __builtin_elementwise_fma(a, b, c); }
__device__ __forceinline__ f32x2 pk_mul(f32x2 a, f32x2 b) { return a * b; }
__device__ __forceinline__ f32x2 pk_add(f32x2 a, f32x2 b) { return a + b; }
struct EpiIn {
    __device__ __forceinline__ int nst(const Unit& u) const { const int pn = u.pn; if (pn >= 9 && pn < 14) return f8attn ? 8 : 32; if (pn == 14 && f8attn) return 32; return pn >= 15 ? 8 : 16; }
    bf16_t* aqkv; bf16_t* qb; bf16_t* kb; bf16_t* vb; bf16_t* gate; const float* qg; const float* kg; const float* rope; float asc; bool f8attn;
    __device__ __forceinline__ void operator()(const f32x4 (&acc)[2][2][4][2], const Unit& u, int wr, int wc, int fr_in, int fq_in) const {
        int fr = fr_in, fq = fq_in; asm volatile("" : "+v"(fr), "+v"(fq) :: "memory");
        const int pn = u.pn;
        if (pn >= 9 && pn < 14) {
            const bool isq = pn < 13; const int head = isq ? (pn - 9) * 4 + wc : wc; bf16_t* dst = isq ? qb : kb; const int pitch = isq ? 1024 : 256;
            const float* gvec = isq ? qg : kg; const float osc = isq ? C2 : 1.0f;
            f32x4 gv[2][2];
#pragma unroll
            for (int bj = 0; bj < 2; ++bj)
#pragma unroll
                for (int n = 0; n < 2; ++n) gv[bj][n] = *(const f32x4*)(gvec + 32 * bj + 16 * n + 4 * fq);
            f32x4 csr[2], snr[2], csc[4], snc[4];
#pragma unroll
            for (int ai = 0; ai < 2; ++ai) { const int pr = ((u.pm * BM + ai * HALF + wr * 64) & (SEQ - 1)) >> 6; csr[ai] = *(const f32x4*)(rope + pr * 16 + 4 * fq); snr[ai] = *(const f32x4*)(rope + 1024 + pr * 16 + 4 * fq); }
#pragma unroll
            for (int m = 0; m < 4; ++m) { const int pc = m * 16 + fr; csc[m] = *(const f32x4*)(rope + pc * 16 + 4 * fq); snc[m] = *(const f32x4*)(rope + 1024 + pc * 16 + 4 * fq); }
            EPI_ROWS(
                float ss = 0.f;
                _Pragma("unroll") for (int bj = 0; bj < 2; ++bj) _Pragma("unroll") for (int n = 0; n < 2; ++n) { const f32x4 x = acc[ai][bj][m][n] * asc; ss += (x[0] * x[0] + x[1] * x[1]) + (x[2] * x[2] + x[3] * x[3]); }
                ss = xsum<16>(ss); ss = xsum<32>(ss);
                const float sc = rsqrtf(ss * (1.0f / 64.0f) + EPS) * osc * asc;
                u32x4 w8;
                _Pragma("unroll") for (int bj = 0; bj < 2; ++bj) {
                    const f32x4 cs = bj == 0 ? csr[ai] : csc[m]; const f32x4 sn = bj == 0 ? snr[ai] : snc[m];
                    const f32x4 y0 = acc[ai][bj][m][0] * sc * gv[bj][0]; const f32x4 y1 = acc[ai][bj][m][1] * sc * gv[bj][1];
                    const f32x4 o0 = y0 * cs - y1 * sn; const f32x4 o1 = y1 * cs + y0 * sn;
                    if (f8attn) {
                        unsigned a = 0, b = 0; a = __builtin_amdgcn_cvt_pk_fp8_f32(o0[0], o0[1], a, false); a = __builtin_amdgcn_cvt_pk_fp8_f32(o0[2], o0[3], a, true);
                        b = __builtin_amdgcn_cvt_pk_fp8_f32(o1[0], o1[1], b, false); b = __builtin_amdgcn_cvt_pk_fp8_f32(o1[2], o1[3], b, true);
                        w8[2 * bj] = a; w8[2 * bj + 1] = b;
                    } else {
                    bf16_t* p = dst + (size_t)row * pitch + head * 64 + 32 * bj + 4 * fq;
                    u32x2 w0; w0.x = cvt_pk_bf16(o0[0], o0[1]); w0.y = cvt_pk_bf16(o0[2], o0[3]);
                    u32x2 w1; w1.x = cvt_pk_bf16(o1[0], o1[1]); w1.y = cvt_pk_bf16(o1[2], o1[3]);
                    *(u32x2*)p = w0; *(u32x2*)(p + 16) = w1; }
                }
                if (f8attn) *(u32x4*)((unsigned char*)dst + (size_t)row * pitch + head * 64 + 16 * fq) = w8;
            )
        } else if (pn == 14 && f8attn) {
            unsigned char* vt = (unsigned char*)vb;
            int q4 = fr & 3; asm volatile("" : "+v"(q4));
            EPI_ROWS(
                const int b = row >> 12; const int t = row & (SEQ - 1); const int kk = t & 63;
                const int pos4 = 32 * ((kk >> 2) & 1) + 4 * ((kk >> 3) & 3) + 16 * (kk >> 5);
                _Pragma("unroll") for (int bj = 0; bj < 2; ++bj) {
                    const int kvh = bj * 2 + (wc >> 1); const int d0 = (wc & 1) * 32 + 8 * fq;
                    const f32x4 v0 = acc[ai][bj][m][0] * asc; const f32x4 v1 = acc[ai][bj][m][1] * asc;
                    unsigned a = 0, c = 0; a = __builtin_amdgcn_cvt_pk_fp8_f32(v0[0], v0[1], a, false); a = __builtin_amdgcn_cvt_pk_fp8_f32(v0[2], v0[3], a, true);
                    c = __builtin_amdgcn_cvt_pk_fp8_f32(v1[0], v1[1], c, false); c = __builtin_amdgcn_cvt_pk_fp8_f32(v1[2], v1[3], c, true);
                    unsigned lo = 0, hi = 0;
                    MK_QUAD(0, 0x00) MK_QUAD(1, 0x55) MK_QUAD(2, 0xAA) MK_QUAD(3, 0xFF)
                    unsigned char* p = vt + ((size_t)((b * 4 + kvh) * 64 + d0 + 2 * q4) << 12) + (t & ~63) + pos4;
                    *(unsigned*)p = lo; *(unsigned*)(p + 4096) = hi;
                }
            )
        } else {
            bf16_t* dst; int pitch, colt, dsh = 0; float sc = asc; bool sig = false, fold = false;
            if (pn < 9) { dst = aqkv + (size_t)pn * T * 256; pitch = 256; colt = 0; fold = true; dsh = 2 * (pn / 3); if (pn % 3 == 0) sc = C2 * asc; }
            else if (pn == 14) { dst = vb; pitch = 256; colt = 0; }
            else { dst = gate; pitch = 2048; colt = (pn - 15) * 256; sig = true; }
            const int col0 = colt + wc * 32 + 8 * fq;
            f32x2 ks2 = {-LOG2E * asc, -LOG2E * asc}, one2 = {1.0f, 1.0f}; asm volatile("" : "+s"(ks2), "+s"(one2));
            if (sig) {
#pragma unroll
                for (int ai = 0; ai < 2; ++ai)
#pragma unroll
                    for (int mp = 0; mp < 2; ++mp)
#pragma unroll
                        for (int bj = 0; bj < 2; ++bj) { u32x2 ov[2];
#pragma unroll
                            for (int ms = 0; ms < 2; ++ms) { const int m = 2 * mp + ms; const f32x4 v0 = acc[ai][bj][m][0], v1 = acc[ai][bj][m][1]; unsigned w[2] = {0u, 0u};
#pragma unroll
                                for (int q = 0; q < 4; ++q) { const f32x4 a = q < 2 ? v0 : v1; const f32x2 t = pk_mul((f32x2){a[2 * (q & 1)], a[2 * (q & 1) + 1]}, ks2);
                                    const f32x2 d = pk_add((f32x2){__builtin_amdgcn_exp2f(t.x), __builtin_amdgcn_exp2f(t.y)}, one2); const float r0 = __builtin_amdgcn_rcpf(d.x), r1 = __builtin_amdgcn_rcpf(d.y);
                                    if (q & 1) w[q >> 1] = __builtin_amdgcn_cvt_pk_fp8_f32(r0, r1, w[q >> 1], true); else w[q >> 1] = __builtin_amdgcn_cvt_pk_fp8_f32(r0, r1, w[q >> 1], false); }
                                ov[ms].x = w[0]; ov[ms].y = w[1]; }
                            int fq1 = fq & 1; asm volatile("" : "+v"(fq1) :: "memory");
                            const int row = u.pm * BM + ai * HALF + wr * 64 + (2 * mp + fq1) * 16 + fr;
                            *(u32x4*)((unsigned char*)dst + (size_t)row * pitch + col0 + bj * HALF - 8 * fq1) = widen16(ov[0], ov[1]); }
            } else {
            EPI_ROWS(
                int drow = row;
                if (fold) { const int t = row & (SEQ - 1); drow = (row & ~(SEQ - 1)) | ((t & ((1 << dsh) - 1)) << (12 - dsh)) | (t >> dsh); }
                bf16_t* rowp = dst + (size_t)drow * pitch + col0;
                _Pragma("unroll") for (int bj = 0; bj < 2; ++bj) {
                    f32x4 v0 = acc[ai][bj][m][0], v1 = acc[ai][bj][m][1];
                    v0 = v0 * sc; v1 = v1 * sc; *(u32x4*)(rowp + bj * HALF) = pack8(v0, v1);
                }
            )
            }
        }
    }
};
struct EpiMergeA {
    __device__ __forceinline__ int nst(const Unit&) const { return 8; }
    const bf16_t* gate; bf16_t* merged;
    __device__ __forceinline__ void operator()(const f32x4 (&acc)[2][2][4][2], const Unit& u, int wr, int wc, int fr, int fq) const {
        const int col0 = u.pn * BM + wc * 32 + 8 * fq;
        f32x2 wi2 = {W8_INV, W8_INV}; asm volatile("" : "+s"(wi2));
        u32x2 gwv[2][4][2];
#pragma unroll
        for (int ai = 0; ai < 2; ++ai)
#pragma unroll
            for (int m = 0; m < 4; ++m)
#pragma unroll
                for (int bj = 0; bj < 2; ++bj) gwv[ai][m][bj] = *(const u32x2*)((const unsigned char*)gate + (size_t)(u.pm * BM + ai * HALF + wr * 64 + m * 16 + fr) * 2048 + col0 + bj * HALF);
        asm volatile("" ::: "memory");
#pragma unroll
        for (int ai = 0; ai < 2; ++ai)
#pragma unroll
            for (int mp = 0; mp < 2; ++mp)
#pragma unroll
                for (int bj = 0; bj < 2; ++bj) { u32x2 ov[2];
#pragma unroll
                    for (int ms = 0; ms < 2; ++ms) { const int m = 2 * mp + ms; const u32x2 gw = gwv[ai][m][bj];
                        const auto g01 = __builtin_amdgcn_cvt_pk_f32_fp8((int)gw.x, false), g23 = __builtin_amdgcn_cvt_pk_f32_fp8((int)gw.x, true), g45 = __builtin_amdgcn_cvt_pk_f32_fp8((int)gw.y, false), g67 = __builtin_amdgcn_cvt_pk_f32_fp8((int)gw.y, true);
                        const f32x4 a0 = acc[ai][bj][m][0], a1 = acc[ai][bj][m][1];
                        const f32x2 p0 = pk_mul(pk_mul((f32x2){a0[0], a0[1]}, wi2), (f32x2){g01[0], g01[1]}), p1 = pk_mul(pk_mul((f32x2){a0[2], a0[3]}, wi2), (f32x2){g23[0], g23[1]});
                        const f32x2 p2 = pk_mul(pk_mul((f32x2){a1[0], a1[1]}, wi2), (f32x2){g45[0], g45[1]}), p3 = pk_mul(pk_mul((f32x2){a1[2], a1[3]}, wi2), (f32x2){g67[0], g67[1]});
                        ov[ms] = pack8_f8((f32x4){p0.x, p0.y, p1.x, p1.y}, (f32x4){p2.x, p2.y, p3.x, p3.y}); }
                    const int row = u.pm * BM + ai * HALF + wr * 64 + (2 * mp + (fq & 1)) * 16 + fr;
                    *(u32x4*)((unsigned char*)merged + (size_t)row * 1024 + col0 + bj * HALF - 8 * (fq & 1)) = widen16(ov[0], ov[1]); }
        asm volatile("" ::: "memory");
    }
};
template <bool F8> struct EpiMergeB {
    __device__ __forceinline__ int nst(const Unit&) const { return 8; }
    const bf16_t* gate; const bf16_t* merged; unsigned char* m8;
    __device__ __forceinline__ void operator()(const f32x4 (&acc)[2][2][4][2], const Unit& u, int wr, int wc, int fr, int fq) const {
        const int col0 = u.pn * BM + wc * 32 + 8 * fq;
        f32x2 wi2 = {F8 ? W8_INV : 1.0f, F8 ? W8_INV : 1.0f}; asm volatile("" : "+s"(wi2));
        u32x2 gwv[2][4][2], mwv[2][4][2];
#pragma unroll
        for (int ai = 0; ai < 2; ++ai)
#pragma unroll
            for (int m = 0; m < 4; ++m)
#pragma unroll
                for (int bj = 0; bj < 2; ++bj) { const int row = u.pm * BM + ai * HALF + wr * 64 + m * 16 + fr;
                    gwv[ai][m][bj] = *(const u32x2*)((const unsigned char*)gate + (size_t)row * 2048 + 1024 + col0 + bj * HALF); mwv[ai][m][bj] = *(const u32x2*)((const unsigned char*)merged + (size_t)row * 1024 + col0 + bj * HALF); }
        asm volatile("" ::: "memory");
#pragma unroll
        for (int ai = 0; ai < 2; ++ai)
#pragma unroll
            for (int mp = 0; mp < 2; ++mp)
#pragma unroll
                for (int bj = 0; bj < 2; ++bj) { u32x2 ov[2];
#pragma unroll
                    for (int ms = 0; ms < 2; ++ms) { const int m = 2 * mp + ms; const u32x2 gw = gwv[ai][m][bj]; const u32x2 mw = mwv[ai][m][bj];
                        const auto m01 = __builtin_amdgcn_cvt_pk_f32_fp8((int)mw.x, false), m23 = __builtin_amdgcn_cvt_pk_f32_fp8((int)mw.x, true), m45 = __builtin_amdgcn_cvt_pk_f32_fp8((int)mw.y, false), m67 = __builtin_amdgcn_cvt_pk_f32_fp8((int)mw.y, true);
                        const auto g01 = __builtin_amdgcn_cvt_pk_f32_fp8((int)gw.x, false), g23 = __builtin_amdgcn_cvt_pk_f32_fp8((int)gw.x, true), g45 = __builtin_amdgcn_cvt_pk_f32_fp8((int)gw.y, false), g67 = __builtin_amdgcn_cvt_pk_f32_fp8((int)gw.y, true);
                        const f32x4 a0 = acc[ai][bj][m][0], a1 = acc[ai][bj][m][1];
                        const f32x2 p0 = pk_fma(pk_mul((f32x2){a0[0], a0[1]}, wi2), (f32x2){g01[0], g01[1]}, (f32x2){m01[0], m01[1]}), p1 = pk_fma(pk_mul((f32x2){a0[2], a0[3]}, wi2), (f32x2){g23[0], g23[1]}, (f32x2){m23[0], m23[1]});
                        const f32x2 p2 = pk_fma(pk_mul((f32x2){a1[0], a1[1]}, wi2), (f32x2){g45[0], g45[1]}, (f32x2){m45[0], m45[1]}), p3 = pk_fma(pk_mul((f32x2){a1[2], a1[3]}, wi2), (f32x2){g67[0], g67[1]}, (f32x2){m67[0], m67[1]});
                        ov[ms] = pack8_f8((f32x4){p0.x, p0.y, p1.x, p1.y}, (f32x4){p2.x, p2.y, p3.x, p3.y}); }
                    const int row = u.pm * BM + ai * HALF + wr * 64 + (2 * mp + (fq & 1)) * 16 + fr;
                    *(u32x4*)(m8 + (size_t)row * 1024 + col0 + bj * HALF - 8 * (fq & 1)) = widen16(ov[0], ov[1]); }
        asm volatile("" ::: "memory");
    }
};
struct EpiOut {
    __device__ __forceinline__ int nst(const Unit&) const { return 16; }
    const float* xin32; const bf16_t* xin16; bf16_t* xout; const float* g1;
    __device__ __forceinline__ void operator()(const f32x4 (&acc)[2][2][4][2], const Unit& u, int wr, int wc, int fr, int fq) const {
        const int col0 = u.pn * BM + wc * 32 + 8 * fq; const int b = (u.pm * BM) >> 12;
        float wi = W8_INV; asm volatile("" : "+s"(wi));
        f32x4 gv[2][2];
#pragma unroll
        for (int bj = 0; bj < 2; ++bj)
#pragma unroll
            for (int n = 0; n < 2; ++n) gv[bj][n] = *(const f32x4*)(g1 + (size_t)b * 6144 + col0 + bj * HALF + 4 * n) * wi;
        if (xin32) {
#pragma unroll
            for (int ai = 0; ai < 2; ++ai) {
                f32x4 xv[4][2][2];
#pragma unroll
                for (int m = 0; m < 4; ++m)
#pragma unroll
                    for (int bj = 0; bj < 2; ++bj) { const size_t off = (size_t)(u.pm * BM + ai * HALF + wr * 64 + m * 16 + fr) * 1024 + col0 + bj * HALF;
                        xv[m][bj][0] = *(const f32x4*)(xin32 + off); xv[m][bj][1] = *(const f32x4*)(xin32 + off + 4); }
                asm volatile("" ::: "memory");
#pragma unroll
                for (int m = 0; m < 4; ++m)
#pragma unroll
                    for (int bj = 0; bj < 2; ++bj) { const size_t off = (size_t)(u.pm * BM + ai * HALF + wr * 64 + m * 16 + fr) * 1024 + col0 + bj * HALF;
                        *(u32x4*)(xout + off) = pack8(__builtin_elementwise_fma(gv[bj][0], acc[ai][bj][m][0], xv[m][bj][0]), __builtin_elementwise_fma(gv[bj][1], acc[ai][bj][m][1], xv[m][bj][1])); }
                asm volatile("" ::: "memory");
            }
        } else {
            u32x4 xw[2][4][2];
#pragma unroll
            for (int ai = 0; ai < 2; ++ai)
#pragma unroll
                for (int m = 0; m < 4; ++m)
#pragma unroll
                    for (int bj = 0; bj < 2; ++bj) xw[ai][m][bj] = *(const u32x4*)(xin16 + (size_t)(u.pm * BM + ai * HALF + wr * 64 + m * 16 + fr) * 1024 + col0 + bj * HALF);
            asm volatile("" ::: "memory");
#pragma unroll
            for (int ai = 0; ai < 2; ++ai)
#pragma unroll
                for (int m = 0; m < 4; ++m)
#pragma unroll
                    for (int bj = 0; bj < 2; ++bj) { const size_t off = (size_t)(u.pm * BM + ai * HALF + wr * 64 + m * 16 + fr) * 1024 + col0 + bj * HALF; const u32x4 w = xw[ai][m][bj];
                        const f32x4 x0 = (f32x4){bf_lo(w.x), bf_hi(w.x), bf_lo(w.y), bf_hi(w.y)}, x1 = (f32x4){bf_lo(w.z), bf_hi(w.z), bf_lo(w.w), bf_hi(w.w)};
                        *(u32x4*)(xout + off) = pack8(__builtin_elementwise_fma(gv[bj][0], acc[ai][bj][m][0], x0), __builtin_elementwise_fma(gv[bj][1], acc[ai][bj][m][1], x1)); }
            asm volatile("" ::: "memory");
        }
    }
};
struct EpiGU8 {
    __device__ __forceinline__ int nst(const Unit&) const { return 4; }
    const float* bgu; unsigned char* act;
    __device__ __forceinline__ void operator()(const f32x4 (&acc)[2][2][4][2], const Unit& u, int wr, int wc, int fr, int fq) const {
        const int e = u.pn >> 3, pl = u.pn & 7; const int c0 = pl * 128 + wc * 32 + 8 * fq;
        const float* bp = bgu + (size_t)e * 2048 + c0;
        const f32x4 bg0 = *(const f32x4*)bp, bg1 = *(const f32x4*)(bp + 4), bl0 = *(const f32x4*)(bp + 1024), bl1 = *(const f32x4*)(bp + 1028);
        const f32x2 bg[4] = {{bg0[0], bg0[1]}, {bg0[2], bg0[3]}, {bg1[0], bg1[1]}, {bg1[2], bg1[3]}}, bl[4] = {{bl0[0], bl0[1]}, {bl0[2], bl0[3]}, {bl1[0], bl1[1]}, {bl1[2], bl1[3]}};
        f32x2 winv = {W8_INV, W8_INV}, kk = {-1.702f * LOG2E, -1.702f * LOG2E}, one2 = {1.0f, 1.0f};
        asm volatile("" : "+s"(winv), "+s"(kk), "+s"(one2));
#pragma unroll
        for (int ai = 0; ai < 2; ++ai)
#pragma unroll
            for (int mp = 0; mp < 2; ++mp) {
                u32x2 ov[2];
#pragma unroll
                for (int ms = 0; ms < 2; ++ms) { const int m = 2 * mp + ms; unsigned w[2] = {0u, 0u};
#pragma unroll
                    for (int q = 0; q < 4; ++q) {
                        const f32x4 ag = acc[ai][0][m][q >> 1], al = acc[ai][1][m][q >> 1];
                        const f32x2 gl = pk_fma((f32x2){ag[2 * (q & 1)], ag[2 * (q & 1) + 1]}, winv, bg[q]), ln = pk_fma((f32x2){al[2 * (q & 1)], al[2 * (q & 1) + 1]}, winv, bl[q]);
                        const f32x2 xg = {fminf(gl.x, 7.0f), fminf(gl.y, 7.0f)}, xl = {fminf(fmaxf(ln.x, -7.0f), 7.0f), fminf(fmaxf(ln.y, -7.0f), 7.0f)};
                        const f32x2 t = pk_mul(xg, kk); const f32x2 d = pk_add((f32x2){__builtin_amdgcn_exp2f(t.x), __builtin_amdgcn_exp2f(t.y)}, one2);
                        const f32x2 xs = pk_mul(xg, (f32x2){__builtin_amdgcn_rcpf(d.x), __builtin_amdgcn_rcpf(d.y)});
                        const f32x2 o = pk_fma(xs, xl, xs);
                        if (q & 1) w[q >> 1] = __builtin_amdgcn_cvt_pk_fp8_f32(o.x, o.y, w[q >> 1], true); else w[q >> 1] = __builtin_amdgcn_cvt_pk_fp8_f32(o.x, o.y, w[q >> 1], false);
                    }
                    ov[ms].x = w[0]; ov[ms].y = w[1]; }
                const int row = u.pm * BM + ai * HALF + wr * 64 + (2 * mp + (fq & 1)) * 16 + fr;
                __builtin_nontemporal_store(widen16(ov[0], ov[1]), (u32x4*)(act + (size_t)row * 1024 + c0 - 8 * (fq & 1)));
            }
    }
};
struct EpiDN8 {
    __device__ __forceinline__ int nst(const Unit&) const { return 8; }
    const float* bdn; const float* roww; const PG8_LAS int* ft; unsigned char* y;
    __device__ __forceinline__ void operator()(const f32x4 (&acc)[2][2][4][2], const Unit& u, int wr, int wc, int fr, int fq) const {
        const int e = u.pn >> 2, pl = u.pn & 3; const int col0 = pl * BM + wc * 32 + 8 * fq;
        float wi = W8_INV; asm volatile("" : "+s"(wi)); const f32x4 wiv = {wi, wi, wi, wi};
        f32x4 bv[2][2];
#pragma unroll
        for (int bj = 0; bj < 2; ++bj)
#pragma unroll
            for (int n = 0; n < 2; ++n) bv[bj][n] = *(const f32x4*)(bdn + (size_t)e * 1024 + col0 + bj * HALF + 4 * n);
        float wv[2][4];
#pragma unroll
        for (int ai = 0; ai < 2; ++ai)
#pragma unroll
            for (int m = 0; m < 4; ++m) wv[ai][m] = roww[(size_t)e * T + (u.pm - ft[e]) * BM + ai * HALF + wr * 64 + m * 16 + fr];
#pragma unroll
        for (int ai = 0; ai < 2; ++ai)
#pragma unroll
            for (int mp = 0; mp < 2; ++mp)
#pragma unroll
                for (int bj = 0; bj < 2; ++bj) { u32x2 ov[2];
#pragma unroll
                    for (int ms = 0; ms < 2; ++ms) { const int m = 2 * mp + ms; const float w = wv[ai][m];
                        ov[ms] = pack8_f8(__builtin_elementwise_fma(acc[ai][bj][m][0], wiv, bv[bj][0]) * w, __builtin_elementwise_fma(acc[ai][bj][m][1], wiv, bv[bj][1]) * w); }
                    const int row = u.pm * BM + ai * HALF + wr * 64 + (2 * mp + (fq & 1)) * 16 + fr;
                    __builtin_nontemporal_store(widen16(ov[0], ov[1]), (u32x4*)(y + (size_t)row * 1024 + col0 + bj * HALF - 8 * (fq & 1))); }
    }
};
}

namespace attn_body {
using bf16 = __hip_bfloat16;
using bf16x8 = __attribute__((ext_vector_type(8))) short;
using s16x4 = __attribute__((ext_vector_type(4))) short;
using f32x16 = __attribute__((ext_vector_type(16))) float;
using u32x4 = __attribute__((ext_vector_type(4))) unsigned;
constexpr int D = 64, NW = 8, QBLK = 32, QB = QBLK * NW, KVBLK = 64;
__device__ __forceinline__ int crow(int r, int hi) { return (r & 3) + 8 * (r >> 2) + 4 * hi; }
#define SBAR() __builtin_amdgcn_sched_barrier(0)
constexpr int NSLOT = 3, SLOTB = 8192;
constexpr int LDS_K = 0, LDS_V = NSLOT * SLOTB, LDS_WS = 2 * NSLOT * SLOTB, LDS_OST = LDS_WS + NW * 64 * 4, LDS_LUT = LDS_OST + NW * 4096, LUT_N = 768, LDS_BYTES = LDS_LUT + LUT_N * 4;
constexpr bool OB_F8 = true;
constexpr float MFLOOR = -1024.0f;
__device__ __forceinline__ void glds16(const void* gsrc, unsigned lds_dst) { unsigned keep;
  asm volatile("s_mov_b32 %0, m0\n\ts_mov_b32 m0, %2\n\ts_nop 0\n\tglobal_load_lds_dwordx4 %1, off\n\ts_mov_b32 m0, %0" : "=&s"(keep) : "v"(gsrc), "s"(lds_dst) : "memory"); }
__device__ __forceinline__ float max3f(float a, float b, float c) { float r; asm("v_max3_f32 %0, %1, %2, %3" : "=v"(r) : "v"(a), "v"(b), "v"(c)); return r; }
__device__ __forceinline__ float max2f(float a, float b) { float r; asm("v_max_f32_e32 %0, %1, %2" : "=v"(r) : "v"(a), "v"(b)); return r; }
__device__ __forceinline__ float fadd_s(float a, float b) { float r; asm("v_add_f32_e32 %0, %1, %2" : "=v"(r) : "v"(a), "v"(b)); return r; }
__device__ __forceinline__ float fsub_s(float a, float b) { float r; asm("v_sub_f32_e32 %0, %1, %2" : "=v"(r) : "v"(a), "v"(b)); return r; }
typedef float f32x2_t __attribute__((ext_vector_type(2))); typedef __bf16 bf16x2_t __attribute__((ext_vector_type(2)));
__device__ __forceinline__ unsigned cvtpk_s(float lo, float hi) { f32x2_t v = {lo, hi}; bf16x2_t b = __builtin_convertvector(v, bf16x2_t); return __builtin_bit_cast(unsigned, b); }
#define WAIT_BAR(N) asm volatile("s_waitcnt vmcnt(" #N ") lgkmcnt(0)\n\ts_barrier" ::: "memory")

__device__ __forceinline__ void qkt(f32x16& p0, f32x16& p1, const char* Kslot, const bf16x8* qr, const f32x16& negm, int r32, int hi) {
  const char* kb = Kslot + hi * 1024 + r32 * 16;
  #pragma unroll
  for (int d0 = 0; d0 < 4; ++d0) {
    const bf16x8 b0 = *reinterpret_cast<const bf16x8*>(kb + d0 * 2048);
    const bf16x8 b1 = *reinterpret_cast<const bf16x8*>(kb + d0 * 2048 + 512);
    if (d0 == 0) { p0 = __builtin_amdgcn_mfma_f32_32x32x16_bf16(b0, qr[0], negm, 0, 0, 0); p1 = __builtin_amdgcn_mfma_f32_32x32x16_bf16(b1, qr[0], negm, 0, 0, 0); }
    else { p0 = __builtin_amdgcn_mfma_f32_32x32x16_bf16(b0, qr[d0], p0, 0, 0, 0); p1 = __builtin_amdgcn_mfma_f32_32x32x16_bf16(b1, qr[d0], p1, 0, 0, 0); } }
}
typedef __attribute__((address_space(3))) const char* lds_cptr;
typedef short v4i16_t __attribute__((ext_vector_type(4)));
__device__ __forceinline__ void kload8(bf16x8* kf, lds_cptr kp) {
  kf[0] = *(const __attribute__((address_space(3))) bf16x8*)(kp);        kf[1] = *(const __attribute__((address_space(3))) bf16x8*)(kp + 512);
  kf[2] = *(const __attribute__((address_space(3))) bf16x8*)(kp + 2048); kf[3] = *(const __attribute__((address_space(3))) bf16x8*)(kp + 2560);
  kf[4] = *(const __attribute__((address_space(3))) bf16x8*)(kp + 4096); kf[5] = *(const __attribute__((address_space(3))) bf16x8*)(kp + 4608);
  kf[6] = *(const __attribute__((address_space(3))) bf16x8*)(kp + 6144); kf[7] = *(const __attribute__((address_space(3))) bf16x8*)(kp + 6656);
}
__device__ __forceinline__ void kload2(bf16x8* kf, lds_cptr kp, int j) { kf[2 * j] = *(const __attribute__((address_space(3))) bf16x8*)(kp + j * 2048); kf[2 * j + 1] = *(const __attribute__((address_space(3))) bf16x8*)(kp + j * 2048 + 512); }
__device__ __forceinline__ s16x4 vtr(lds_cptr p) { return __builtin_bit_cast(s16x4, __builtin_amdgcn_ds_read_tr16_b64_v4i16((__attribute__((address_space(3))) v4i16_t*)p)); }
__device__ __forceinline__ float rowmax(const f32x16& p0, const f32x16& p1) {
  float a = max3f(p0[0], p0[1], p1[0]), b = max3f(p0[2], p0[3], p1[1]); a = max3f(a, p1[2], p1[3]);
  #pragma unroll
  for (int r = 4; r < 16; r += 4) { a = max3f(a, p0[r], p0[r + 1]); b = max3f(b, p0[r + 2], p0[r + 3]); a = max3f(a, p1[r], p1[r + 1]); b = max3f(b, p1[r + 2], p1[r + 3]); }
  const float m = max2f(a, b);
  auto rr = __builtin_amdgcn_permlane32_swap(__float_as_uint(m), __float_as_uint(m), false, false);
  return max2f(__uint_as_float(rr[0]), __uint_as_float(rr[1]));
}
__device__ __forceinline__ void pv(f32x16* o, int vb, bf16x8 pa0, bf16x8 pa1, bf16x8 pa2, bf16x8 pa3) {
  #pragma unroll
  for (int d0 = 0; d0 < 2; ++d0) { s16x4 lo[4], hi[4];
    #pragma unroll
    for (int ks = 0; ks < 4; ++ks) {
      asm volatile("ds_read_b64_tr_b16 %0,%1 offset:%c2" : "=&v"(lo[ks]) : "v"(vb), "i"(d0 * 4096 + ks * 1024) : "memory");
      asm volatile("ds_read_b64_tr_b16 %0,%1 offset:%c2" : "=&v"(hi[ks]) : "v"(vb), "i"(d0 * 4096 + ks * 1024 + 512) : "memory"); }
    asm volatile("s_waitcnt lgkmcnt(0)" ::: "memory"); SBAR();
    #define PK(k) (bf16x8){lo[k][0], lo[k][1], lo[k][2], lo[k][3], hi[k][0], hi[k][1], hi[k][2], hi[k][3]}
    o[d0] = __builtin_amdgcn_mfma_f32_32x32x16_bf16(pa0, PK(0), o[d0], 0, 0, 0);
    o[d0] = __builtin_amdgcn_mfma_f32_32x32x16_bf16(pa1, PK(1), o[d0], 0, 0, 0);
    o[d0] = __builtin_amdgcn_mfma_f32_32x32x16_bf16(pa2, PK(2), o[d0], 0, 0, 0);
    o[d0] = __builtin_amdgcn_mfma_f32_32x32x16_bf16(pa3, PK(3), o[d0], 0, 0, 0);
    #undef PK
  }
}
struct Job { const bf16* Q; const bf16* K; const bf16* V; bf16* O; float* lse; const float* lutg; int NT, i0, kq0, dsh, cls; };
template <int MODE, int THRL, bool NOMAX = false> __device__ __forceinline__ void attn_unit(const Job& J, char* shm, const int wid_in) {
  int wid = wid_in; asm volatile("" : "+s"(wid));
  constexpr int QP = MODE == 0 ? 1024 : 256, KP = 256;
  const int lane = lane_id_asm(), tid = wid * 64 + lane, r32 = lane & 31, hi = lane >> 5;
  const bf16* Qw = J.Q + (long)(wid * QBLK) * QP;
  const bf16* Kh = J.K; const bf16* Vh = J.V;
  const unsigned lds0 = (unsigned)(uintptr_t)shm;
  float* wsf = (float*)(shm + LDS_WS) + wid * 64;
  const bf16* ksrc = Kh + (long)lane * KP + wid * 8;
  const bf16* vsrc = Vh + (long)(16 * (wid & 3) + (lane >> 2)) * KP + (wid >> 2) * 32 + (lane & 3) * 8;
  const unsigned kdst = lds0 + LDS_K + wid * 1024, vdst = lds0 + LDS_V + wid * 1024;
  #define DMA_K(t, slot) glds16(ksrc + (long)(t) * KVBLK * KP, (unsigned)__builtin_amdgcn_readfirstlane(kdst + (slot)))
  #define DMA_V(t, slot) glds16(vsrc + (long)(t) * KVBLK * KP, (unsigned)__builtin_amdgcn_readfirstlane(vdst + (slot)))
  const int vb0 = (int)(lds0 + LDS_V) + ((lane >> 4) & 1) * 32 + (lane & 3) * 8 + (4 * hi + ((lane & 15) >> 2)) * 64;
  const char* Kbase = shm + LDS_K; bf16x8 kf[8];
  const lds_cptr shm3 = (lds_cptr)shm; const lds_cptr kp0 = shm3 + LDS_K + hi * 1024 + r32 * 16; const lds_cptr vp0 = shm3 + LDS_V + ((lane >> 4) & 1) * 32 + (lane & 3) * 8 + (4 * hi + ((lane & 15) >> 2)) * 64;
  const int NT = J.NT;
  if (MODE == 1) {
    __attribute__((address_space(3))) float* lut = (__attribute__((address_space(3))) float*)(shm3 + LDS_LUT);
    lut[tid] = J.lutg[tid]; if (tid < LUT_N - 512) lut[512 + tid] = J.lutg[512 + tid];
  }
  DMA_K(0, 0); DMA_V(0, 0); DMA_K(1, SLOTB);
  bf16x8 qr[4];
  #pragma unroll
  for (int d0 = 0; d0 < 4; ++d0) qr[d0] = *reinterpret_cast<const bf16x8*>(&Qw[(long)r32 * QP + d0 * 16 + hi * 8]);
  float mhat = 0.f, l_reg = 0.f; f32x16 o[2]; o[0] = f32x16{}; o[1] = f32x16{}; f32x16 negm = f32x16{}; if (!NOMAX) asm volatile("" : "+v"(negm));
  const int qrel = wid * QBLK + r32;
  const __attribute__((address_space(3))) float* lutq = (const __attribute__((address_space(3))) float*)(shm3 + LDS_LUT) + (J.kq0 - qrel + 383 + 4 * hi);
  #define CMASK(P0, P1, t) do { if (MODE == 1) { const __attribute__((address_space(3))) float* lp_ = lutq + 64 * (t); \
      _Pragma("unroll") for (int r = 0; r < 16; ++r) { const int ko_ = (r & 3) + 8 * (r >> 2); P0[r] += lp_[ko_]; P1[r] += lp_[ko_ + 32]; } } } while (0)
  bool resc = false;
  #define START(P0, P1) do { resc = false; if (!NOMAX) { const float rm = rowmax(P0, P1); \
    const float dl = MODE == 1 ? max2f(rm, MFLOOR) : rm; mhat = fadd_s(mhat, dl); \
      _Pragma("unroll") for (int r = 0; r < 16; ++r) { P0[r] = fsub_s(P0[r], dl); P1[r] = fsub_s(P1[r], dl); } \
      _Pragma("unroll") for (int r = 0; r < 16; ++r) negm[r] = -mhat; asm volatile("" : "+v"(negm)); } \
    _Pragma("unroll") for (int r = 0; r < 16; ++r) P0[r] = __builtin_amdgcn_exp2f(P0[r]); } while (0)
  #define RESC() do { if (resc) { asm volatile("s_waitcnt lgkmcnt(0)" ::: "memory"); \
      _Pragma("unroll") for (int d_ = 0; d_ < 2; ++d_) _Pragma("unroll") for (int r = 0; r < 16; ++r) o[d_][r] *= wsf[crow(r, hi)]; } } while (0)
  f32x16 pA0, pA1, pB0, pB1;
  int sl_prev = 0, sl_cur = 0, sl_next = SLOTB;
  #define ROT() do { sl_prev = sl_cur; sl_cur = sl_next; sl_next = (sl_next == (NSLOT - 1) * SLOTB) ? 0 : sl_next + SLOTB; } while (0)
  DMA_K(2, 2 * SLOTB);
  WAIT_BAR(3);
  qkt(pA0, pA1, Kbase, qr, negm, r32, hi); asm volatile("s_nop 15\n\ts_nop 7" : "+v"(pA0), "+v"(pA1)); CMASK(pA0, pA1, 0);
  START(pA0, pA1);
  _Pragma("unroll") for (int r = 0; r < 16; ++r) pA1[r] = __builtin_amdgcn_exp2f(pA1[r]);
  WAIT_BAR(0);
  DMA_K(3, 0); DMA_V(1, SLOTB);
  ROT();
  kload8(kf, kp0 + sl_cur);
  WAIT_BAR(2);
  s16x4 vlo[8], vhi[8]; u32x4 pw0, pw1, pw2, pw3;
  #define PKW(P, B) cvtpk_s(P[B], P[B + 1])
  #define PAF(k) __builtin_bit_cast(bf16x8, pw##k)
  #define VFR(i) (bf16x8){vlo[i][0], vlo[i][1], vlo[i][2], vlo[i][3], vhi[i][0], vhi[i][1], vhi[i][2], vhi[i][3]}
  #define PIN(x) asm volatile("" : "+v"(x))
  #define MX3(a, b, c) __builtin_fmaxf(__builtin_fmaxf((a), (b)), (c))
  #define GAPA(MF, A0, A1, A2, A3, W0, W1, PW) do { MF; sacc += A0; sacc += A1; sacc += A2; sacc += A3; PIN(sacc); W0; W1; PIN(PW); SBAR(); } while (0)
  #define EX(v) __builtin_amdgcn_exp2f(v)
  #define GAPB(MF, X, B) do { MF; X[B] = EX(X[B]); X[B + 1] = EX(X[B + 1]); X[B + 2] = EX(X[B + 2]); X[B + 3] = EX(X[B + 3]); PIN(X); SBAR(); } while (0)
  #define VRD(i) do { vlo[i] = vtr(vp_ + (((i) >> 2) * 4096 + ((i) & 3) * 1024)); vhi[i] = vtr(vp_ + (((i) >> 2) * 4096 + ((i) & 3) * 1024 + 512)); } while (0)
  #define KRD(G, j) do { if (G) { kload2(kf, kp0 + sl_next, j); SBAR(); } } while (0)
  #define STEP(C0, C1, P0, P1, t, GK, GV, GL) do { SBAR(); \
    const lds_cptr vp_ = vp0 + sl_prev; \
    VRD(0); SBAR(); float sacc = (P0[0] + P0[1]); \
    GAPA(C0 = __builtin_amdgcn_mfma_f32_32x32x16_bf16(kf[0], qr[0], negm, 0, 0, 0), P0[2], P0[3], P0[4], P0[5],     pw0[0] = PKW(P0, 0), pw0[1] = PKW(P0, 2), pw0); \
    VRD(4); SBAR(); GAPA(C1 = __builtin_amdgcn_mfma_f32_32x32x16_bf16(kf[1], qr[0], negm, 0, 0, 0), P0[6], P0[7], P0[8], P0[9],     pw0[2] = PKW(P0, 4), pw0[3] = PKW(P0, 6), pw0); \
    VRD(1); SBAR(); GAPA(C0 = __builtin_amdgcn_mfma_f32_32x32x16_bf16(kf[2], qr[1], C0, 0, 0, 0),   P0[10], P0[11], P0[12], P0[13], pw1[0] = PKW(P0, 8), pw1[1] = PKW(P0, 10), pw1); \
    VRD(5); SBAR(); GAPA(C1 = __builtin_amdgcn_mfma_f32_32x32x16_bf16(kf[3], qr[1], C1, 0, 0, 0),   P0[14], P0[15], P1[0], P1[1],   pw1[2] = PKW(P0, 12), pw1[3] = PKW(P0, 14), pw1); \
    VRD(2); SBAR(); GAPA(C0 = __builtin_amdgcn_mfma_f32_32x32x16_bf16(kf[4], qr[2], C0, 0, 0, 0),   P1[2], P1[3], P1[4], P1[5],     pw2[0] = PKW(P1, 0), pw2[1] = PKW(P1, 2), pw2); \
    VRD(6); SBAR(); GAPA(C1 = __builtin_amdgcn_mfma_f32_32x32x16_bf16(kf[5], qr[2], C1, 0, 0, 0),   P1[6], P1[7], P1[8], P1[9],     pw2[2] = PKW(P1, 4), pw2[3] = PKW(P1, 6), pw2); \
    VRD(3); SBAR(); GAPA(C0 = __builtin_amdgcn_mfma_f32_32x32x16_bf16(kf[6], qr[3], C0, 0, 0, 0),   P1[10], P1[11], P1[12], P1[13], pw3[0] = PKW(P1, 8), pw3[1] = PKW(P1, 10), pw3); \
    VRD(7); SBAR(); GAPA(C1 = __builtin_amdgcn_mfma_f32_32x32x16_bf16(kf[7], qr[3], C1, 0, 0, 0),   P1[14], P1[15], 0.f, 0.f,       pw3[2] = PKW(P1, 12), pw3[3] = PKW(P1, 14), pw3); \
    l_reg += sacc; \
    if (GK) { DMA_K((t) + 3, sl_cur); } if (GV) { DMA_V((t) + 1, sl_next); } \
    CMASK(C0, C1, t); \
    if (!NOMAX) { float a = MX3(C0[0], C0[1], C1[0]), b = MX3(C0[2], C0[3], C1[1]); a = MX3(a, C1[2], C1[3]); \
      _Pragma("unroll") for (int r = 4; r < 16; r += 4) { a = MX3(a, C0[r], C0[r + 1]); b = MX3(b, C0[r + 2], C0[r + 3]); a = MX3(a, C1[r], C1[r + 1]); b = MX3(b, C1[r + 2], C1[r + 3]); } \
      float rm = __builtin_fmaxf(a, b); { auto rr = __builtin_amdgcn_permlane32_swap(__float_as_uint(rm), __float_as_uint(rm), false, false); rm = __builtin_fmaxf(__uint_as_float(rr[0]), __uint_as_float(rr[1])); } \
      resc = false; \
      if (__builtin_expect(__any(rm > (float)THRL), 0)) { const float dl = __builtin_fmaxf(rm, 0.f); mhat += dl; \
        _Pragma("unroll") for (int r = 0; r < 16; ++r) { C0[r] -= dl; C1[r] -= dl; } \
        _Pragma("unroll") for (int r = 0; r < 16; ++r) negm[r] = -mhat; asm volatile("" : "+v"(negm)); \
        const float f = __builtin_amdgcn_exp2f(-dl); l_reg *= f; if (hi == 0) wsf[r32] = f; resc = true; } } \
    SBAR(); \
    GAPB(o[0] = __builtin_amdgcn_mfma_f32_32x32x16_bf16(PAF(0), VFR(0), o[0], 0, 0, 0), C0, 0); \
    GAPB(o[1] = __builtin_amdgcn_mfma_f32_32x32x16_bf16(PAF(0), VFR(4), o[1], 0, 0, 0), C0, 4); \
    KRD(GL, 0); GAPB(o[0] = __builtin_amdgcn_mfma_f32_32x32x16_bf16(PAF(1), VFR(1), o[0], 0, 0, 0), C0, 8); \
    KRD(GL, 1); GAPB(o[1] = __builtin_amdgcn_mfma_f32_32x32x16_bf16(PAF(1), VFR(5), o[1], 0, 0, 0), C0, 12); \
    KRD(GL, 2); GAPB(o[0] = __builtin_amdgcn_mfma_f32_32x32x16_bf16(PAF(2), VFR(2), o[0], 0, 0, 0), C1, 0); \
    KRD(GL, 3); GAPB(o[1] = __builtin_amdgcn_mfma_f32_32x32x16_bf16(PAF(2), VFR(6), o[1], 0, 0, 0), C1, 4); \
    GAPB(o[0] = __builtin_amdgcn_mfma_f32_32x32x16_bf16(PAF(3), VFR(3), o[0], 0, 0, 0), C1, 8); \
    GAPB(o[1] = __builtin_amdgcn_mfma_f32_32x32x16_bf16(PAF(3), VFR(7), o[1], 0, 0, 0), C1, 12); \
    } while (0)
  int t = 1;
  for (; t + 5 < NT; t += 2) {
    STEP(pB0, pB1, pA0, pA1, t, true, true, true);     WAIT_BAR(2); RESC(); ROT();
    STEP(pA0, pA1, pB0, pB1, t + 1, true, true, true); WAIT_BAR(2); RESC(); ROT();
  }
  #define ENDW(tt) do { if ((tt) + 3 < NT) { WAIT_BAR(2); } else if ((tt) + 2 < NT) { WAIT_BAR(1); } else { WAIT_BAR(0); } } while (0)
  for (; t + 1 < NT; t += 2) {
    STEP(pB0, pB1, pA0, pA1, t, (t + 3 < NT), (t + 1 < NT), (t + 1 < NT));       ENDW(t);     RESC(); ROT();
    STEP(pA0, pA1, pB0, pB1, t + 1, (t + 4 < NT), (t + 2 < NT), (t + 2 < NT));   ENDW(t + 1); RESC(); ROT();
  }
  STEP(pB0, pB1, pA0, pA1, NT - 1, false, false, false); RESC();
  { float sacc = pB0[0] + pB0[1]; _Pragma("unroll") for (int r = 2; r < 16; ++r) sacc += pB0[r]; _Pragma("unroll") for (int r = 0; r < 16; ++r) sacc += pB1[r]; l_reg += sacc;
    pw0 = (u32x4){PKW(pB0, 0), PKW(pB0, 2), PKW(pB0, 4), PKW(pB0, 6)}; pw1 = (u32x4){PKW(pB0, 8), PKW(pB0, 10), PKW(pB0, 12), PKW(pB0, 14)}; pw2 = (u32x4){PKW(pB1, 0), PKW(pB1, 2), PKW(pB1, 4), PKW(pB1, 6)}; pw3 = (u32x4){PKW(pB1, 8), PKW(pB1, 10), PKW(pB1, 12), PKW(pB1, 14)};
    SBAR(); pv(o, vb0 + sl_cur, PAF(0), PAF(1), PAF(2), PAF(3)); }
  #undef PKW
  #undef PAF
  #undef VFR
  #undef PIN
  #undef MX3
  #undef GAPA
  #undef GAPB
  #undef EX
  #undef VRD
  #undef KRD
  #undef STEP
  #undef ENDW
  { auto rr = __builtin_amdgcn_permlane32_swap(__float_as_uint(l_reg), __float_as_uint(l_reg), false, false); l_reg = __uint_as_float(rr[0]) + __uint_as_float(rr[1]); }
  if (hi == 0) wsf[32 + r32] = l_reg; asm volatile("s_waitcnt lgkmcnt(0)" ::: "memory");
  float rli[16];
  #pragma unroll
  for (int r = 0; r < 16; ++r) rli[r] = __builtin_amdgcn_rcpf(wsf[32 + crow(r, hi)]);
  if (MODE == 0 && OB_F8) {
    unsigned char* stg8 = (unsigned char*)(shm + LDS_OST) + wid * 4096;
    #pragma unroll
    for (int r = 0; r < 16; ++r) { const int orow = crow(r, hi);
      #pragma unroll
      for (int d0 = 0; d0 < 2; ++d0) { const float ov = o[d0][r] * rli[r]; stg8[orow * 64 + d0 * 32 + r32] = (unsigned char)(__builtin_amdgcn_cvt_pk_fp8_f32(ov, ov, 0, false) & 0xff); } }
    asm volatile("s_waitcnt lgkmcnt(0)" ::: "memory");
    unsigned char* Ow = (unsigned char*)J.O + (long)(wid * QBLK) * 1024;
    #pragma unroll
    for (int i = 0; i < 2; ++i) { const int row = i * 16 + (lane >> 2), ch = lane & 3; const u32x4 v = *(const u32x4*)(stg8 + row * 64 + ch * 16); *(u32x4*)(Ow + (long)row * 1024 + ch * 16) = v; }
  } else {
    bf16* stg = (bf16*)(shm + LDS_OST) + wid * 2048;
    #pragma unroll
    for (int r = 0; r < 16; ++r) { const int orow = crow(r, hi);
      #pragma unroll
      for (int d0 = 0; d0 < 2; ++d0) stg[orow * 64 + d0 * 32 + r32] = __float2bfloat16(o[d0][r] * rli[r]); }
    asm volatile("s_waitcnt lgkmcnt(0)" ::: "memory");
    if (MODE == 0) {
      bf16* Ow = J.O + (long)(wid * QBLK) * 1024;
      #pragma unroll
      for (int i = 0; i < 4; ++i) { const int row = i * 8 + (lane >> 3), ch = lane & 7; const u32x4 v = *(const u32x4*)(stg + row * 64 + ch * 8); *(u32x4*)(Ow + (long)row * 1024 + ch * 8) = v; }
    } else {
      #pragma unroll
      for (int i = 0; i < 4; ++i) { const int row = i * 8 + (lane >> 3), ch = lane & 7; const u32x4 v = *(const u32x4*)(stg + row * 64 + ch * 8);
        const long tok = ((long)(J.i0 + wid * QBLK + row) << J.dsh) + J.cls; *(u32x4*)(J.O + tok * 256 + ch * 8) = v; }
      if (hi == 0) { const long tok = ((long)(J.i0 + qrel) << J.dsh) + J.cls; J.lse[tok * 4] = mhat + __builtin_amdgcn_logf(l_reg); }
    } }
  asm volatile("s_waitcnt lgkmcnt(0)\n\ts_barrier" ::: "memory");
  #undef DMA_K
  #undef DMA_V
  #undef CMASK
  #undef START
  #undef RESC
  #undef ROT
}
#undef SBAR
#undef WAIT_BAR
}


namespace attn8 {
typedef int i32x8 __attribute__((ext_vector_type(8)));
typedef int i32x4 __attribute__((ext_vector_type(4)));
typedef float f32x16 __attribute__((ext_vector_type(16)));
typedef unsigned u32x4 __attribute__((ext_vector_type(4)));
constexpr int SLOT = 4096, RING = 8, NSL = RING;
constexpr int L_K = 0, L_V = NSL * SLOT, L_WS = 2 * NSL * SLOT, L_OST = L_WS + 8 * 256, L_BYTES = L_OST + 8 * 4096;
struct Job { const unsigned char* Q; const unsigned char* K; const unsigned char* VT; unsigned char* O; };
__device__ __forceinline__ void glds16(const void* gsrc, unsigned lds_dst) { unsigned keep;
  asm volatile("s_mov_b32 %0, m0\n\ts_mov_b32 m0, %2\n\ts_nop 0\n\tglobal_load_lds_dwordx4 %1, off\n\ts_mov_b32 m0, %0" : "=&s"(keep) : "v"(gsrc), "s"(lds_dst) : "memory"); }
__device__ __forceinline__ int crow(int r, int hi) { return (r & 3) + 8 * (r >> 2) + 4 * hi; }
#define A8_WAITBAR(N) asm volatile("s_waitcnt vmcnt(" #N ") lgkmcnt(0)\n\ts_barrier" ::: "memory")
#define A8_WAITBAR_N(N) asm volatile("s_waitcnt vmcnt(%0) lgkmcnt(0)\n\ts_barrier" :: "n"(N) : "memory")
template <int NT> __device__ __forceinline__ void attn_unit_f8(const Job& J, char* shm, const int wid_in) {
  int wid = wid_in; asm volatile("" : "+s"(wid));
  const int lane = lane_id_asm(), r32 = lane & 31, hi = lane >> 5;
  const unsigned lds0 = (unsigned)(uintptr_t)shm;
  typedef __attribute__((address_space(3))) const char* lds_cptr;
  const lds_cptr shm3 = (lds_cptr)shm;
  const bool kwave = wid < 4;
  const int w4 = wid & 3; const int drow = 16 * w4 + (lane >> 2); const int cl = (lane & 3) ^ ((drow >> 2) & 3);
  const unsigned char* dsrc = kwave ? J.K + (long)drow * 256 + 16 * cl : J.VT + (long)drow * 4096 + 16 * cl;
  const long dstep = kwave ? 64 * 256 : 64;
  const unsigned ddst = lds0 + (kwave ? L_K : L_V) + w4 * 1024;
  #define A8_DMA(t, slot) glds16(dsrc + (long)(t) * dstep, (unsigned)__builtin_amdgcn_readfirstlane(ddst + (slot)))
  const int sw = (r32 >> 2) & 3; const int foff0 = r32 * 64 + 16 * ((2 * hi) ^ sw), foff1 = r32 * 64 + 16 * ((2 * hi + 1) ^ sw);
  #define A8_FRAG(base, half) __builtin_shufflevector(*(const __attribute__((address_space(3))) i32x4*)((base) + (half) * 2048 + foff0), *(const __attribute__((address_space(3))) i32x4*)((base) + (half) * 2048 + foff1), 0, 1, 2, 3, 4, 5, 6, 7)
  const unsigned char* qp = J.Q + (long)(wid * 32 + r32) * 1024 + 32 * hi;
  const i32x8 qf = __builtin_shufflevector(*(const i32x4*)qp, *(const i32x4*)(qp + 16), 0, 1, 2, 3, 4, 5, 6, 7);
  if (kwave) { _Pragma("unroll") for (int i = 0; i < RING; ++i) A8_DMA(i, i * SLOT); } else { _Pragma("unroll") for (int i = 0; i < RING - 2; ++i) A8_DMA(i, i * SLOT); }
  f32x16 o0 = f32x16{}, o1 = f32x16{}, o2 = f32x16{}; const f32x16 zero = f32x16{};
  int one_w = 0x38383838; asm volatile("" : "+v"(one_w));
  i32x8 ones; _Pragma("unroll") for (int w = 0; w < 8; ++w) ones[w] = one_w;
  asm volatile("" : "+v"(ones));
  f32x16 SA0, SA1, SB0, SB1; i32x8 PA, PB;
  A8_WAITBAR_N(RING - 1);
  { const i32x8 k0 = A8_FRAG(shm3 + L_K, 0), k1 = A8_FRAG(shm3 + L_K, 1);
    SA0 = __builtin_amdgcn_mfma_scale_f32_32x32x64_f8f6f4(k0, qf, zero, 0, 0, 0, 0, 0, 0); SA1 = __builtin_amdgcn_mfma_scale_f32_32x32x64_f8f6f4(k1, qf, zero, 0, 0, 0, 0, 0, 0); }
  #define A8_SB() __builtin_amdgcn_sched_barrier(0)
  #define A8_SLOTOF(i) ((((i) + RING) & (RING - 1)) * SLOT)
  #define A8_EXP8(X, B) do { _Pragma("unroll") for (int r = 0; r < 8; ++r) X[(B) + r] = __builtin_amdgcn_exp2f(X[(B) + r]); asm volatile("" : "+v"(X)); } while (0)
  #define A8_CVT4(P, WB, X) do { _Pragma("unroll") for (int w = 0; w < 4; ++w) { unsigned a_ = (unsigned)P[(WB) + w];     \
      a_ = __builtin_amdgcn_cvt_pk_bf8_f32(X[4 * w], X[4 * w + 1], a_, false); a_ = __builtin_amdgcn_cvt_pk_bf8_f32(X[4 * w + 2], X[4 * w + 3], a_, true); P[(WB) + w] = (int)a_; } asm volatile("" : "+v"(P)); } while (0)
  #define A8_STEP(C0, C1, N0, N1, PP, PN, t, WK, WV, DK, DV, QK, PV, EX) do { \
    if (kwave) { A8_WAITBAR_N(WK); } else { A8_WAITBAR_N(WV); } \
    if (kwave) { if (DK) A8_DMA((t) + RING, A8_SLOTOF(t)); } else { if (DV) A8_DMA((t) - 2 + RING, A8_SLOTOF((t) - 2)); } \
    i32x8 k0_ = ones, k1_ = ones, v0_ = ones, v1_ = ones; \
    if (QK) { k0_ = A8_FRAG(shm3 + L_K + A8_SLOTOF((t) + 1), 0); k1_ = A8_FRAG(shm3 + L_K + A8_SLOTOF((t) + 1), 1); } \
    if (PV) { v0_ = A8_FRAG(shm3 + L_V + A8_SLOTOF((t) - 1), 0); v1_ = A8_FRAG(shm3 + L_V + A8_SLOTOF((t) - 1), 1); } \
    A8_SB(); \
    if (EX) A8_EXP8(C0, 0); A8_SB(); \
    if (QK) { __builtin_amdgcn_s_setprio(1); N0 = __builtin_amdgcn_mfma_scale_f32_32x32x64_f8f6f4(k0_, qf, zero, 0, 0, 0, 0, 0, 0); __builtin_amdgcn_s_setprio(0); } if (EX) A8_EXP8(C0, 8); A8_SB(); \
    if (QK) { __builtin_amdgcn_s_setprio(1); N1 = __builtin_amdgcn_mfma_scale_f32_32x32x64_f8f6f4(k1_, qf, zero, 0, 0, 0, 0, 0, 0); __builtin_amdgcn_s_setprio(0); } if (EX) A8_EXP8(C1, 0); A8_SB(); \
    if (PV) { __builtin_amdgcn_s_setprio(1); o0 = __builtin_amdgcn_mfma_scale_f32_32x32x64_f8f6f4(PP, v0_, o0, 1, 0, 0, 0, 0, 0); __builtin_amdgcn_s_setprio(0); } if (EX) A8_EXP8(C1, 8); A8_SB(); \
    if (PV) { __builtin_amdgcn_s_setprio(1); o1 = __builtin_amdgcn_mfma_scale_f32_32x32x64_f8f6f4(PP, v1_, o1, 1, 0, 0, 0, 0, 0); __builtin_amdgcn_s_setprio(0); } if (EX) A8_CVT4(PN, 0, C0); A8_SB(); \
    if (PV) { __builtin_amdgcn_s_setprio(1); o2 = __builtin_amdgcn_mfma_scale_f32_32x32x64_f8f6f4(PP, ones, o2, 1, 0, 0, 0, 0, 0); __builtin_amdgcn_s_setprio(0); } if (EX) A8_CVT4(PN, 4, C1); A8_SB();     \
  } while (0)
  #define A8_EVEN(t, WK, WV, DK, DV, QK, PV, EX) A8_STEP(SA0, SA1, SB0, SB1, PB, PA, t, WK, WV, DK, DV, QK, PV, EX)
  #define A8_ODD(t, WK, WV, DK, DV, QK, PV, EX)  A8_STEP(SB0, SB1, SA0, SA1, PA, PB, t, WK, WV, DK, DV, QK, PV, EX)
  PA = ones; PB = ones;
  static_assert(RING == 8 && NT % 2 == 0 && NT >= 2 * RING, "the peeled tail below is written for RING = 8");
  A8_EVEN(0, 6, 6, true, true, true, false, true);
#pragma unroll 1
  for (int t = 1; t < NT - 9; t += 2) {
    A8_ODD(t, 6, 6, true, true, true, true, true);
    A8_EVEN(t + 1, 6, 6, true, true, true, true, true);
  }
  A8_ODD(NT - 9, 6, 6, true, true, true, true, true);
  A8_EVEN(NT - 8, 6, 6, false, true, true, true, true);
  A8_ODD(NT - 7, 5, 6, false, true, true, true, true);
  A8_EVEN(NT - 6, 4, 6, false, false, true, true, true);
  A8_ODD(NT - 5, 3, 5, false, false, true, true, true);
  A8_EVEN(NT - 4, 2, 4, false, false, true, true, true);
  A8_ODD(NT - 3, 1, 3, false, false, true, true, true);
  A8_EVEN(NT - 2, 0, 2, false, false, true, true, true);
  A8_ODD(NT - 1, 0, 1, false, false, false, true, true);
  A8_EVEN(NT, 0, 0, false, false, false, true, false);
  #undef A8_EVEN
  #undef A8_ODD
  #undef A8_STEP
  #undef A8_EXP8
  #undef A8_CVT4
  #undef A8_SB
  #undef A8_SLOTOF
  #undef A8_FRAG
  #undef A8_DMA
  float rli[16];
  #pragma unroll
  for (int r = 0; r < 16; ++r) rli[r] = __builtin_amdgcn_rcpf(o2[r]);
  unsigned char* stg8 = (unsigned char*)(shm + L_OST) + wid * 4096;
  #pragma unroll
  for (int r = 0; r < 16; ++r) { const int orow = crow(r, hi);
    const float a = o0[r] * rli[r], b = o1[r] * rli[r];
    stg8[orow * 64 + r32] = (unsigned char)(__builtin_amdgcn_cvt_pk_fp8_f32(a, a, 0, false) & 0xff); stg8[orow * 64 + 32 + r32] = (unsigned char)(__builtin_amdgcn_cvt_pk_fp8_f32(b, b, 0, false) & 0xff); }
  asm volatile("s_waitcnt lgkmcnt(0)" ::: "memory");
  unsigned char* Ow = J.O + (long)(wid * 32) * 1024;
  #pragma unroll
  for (int i = 0; i < 2; ++i) { const int row = i * 16 + (lane >> 2), ch = lane & 3; const u32x4 v = *(const u32x4*)(stg8 + row * 64 + ch * 16); *(u32x4*)(Ow + (long)row * 1024 + ch * 16) = v; }
  asm volatile("s_waitcnt lgkmcnt(0)\n\ts_barrier" ::: "memory");
}
#undef A8_WAITBAR
#undef A8_WAITBAR_N
}

constexpr size_t MiB = 1u << 20;
constexpr size_t WS_CTL = 0, CTL_ZERO_BYTES = 1 * MiB;
constexpr size_t WS_CNT = 512 * 1024;
constexpr size_t WS_MOD = 1 * MiB;
constexpr size_t WS_ROPE = WS_MOD + 512 * 1024;
constexpr size_t WS_BLUT = WS_ROPE + 8192;
constexpr size_t WS_RC0 = WS_BLUT + 12 * 768 * 4;
constexpr size_t WS_HIST = WS_RC0 + 4096;
constexpr size_t WS_TILEE = WS_HIST + 32768;
constexpr size_t WS_TOPE = 2 * MiB;
constexpr size_t WS_TOPW = WS_TOPE + 512 * 1024;
constexpr size_t WS_SLOT = WS_TOPW + 512 * 1024;
constexpr size_t WS_ROWW = WS_SLOT + 512 * 1024;
constexpr size_t WS_ROWTOK = 4 * MiB + 256 * 1024;
constexpr size_t WS_LSE = 5 * MiB;
constexpr size_t WS_WRHI = 7 * MiB;
constexpr size_t WS_WRLO = 8 * MiB;
constexpr size_t WS_WIN = 9 * MiB;
constexpr size_t WS_WBRA = 32 * MiB;
constexpr size_t WS_WBRB = 33 * MiB;
constexpr size_t WS_WOUT = 37 * MiB;
constexpr size_t WS_WGU = 41 * MiB;
constexpr size_t WS_WDN = 297 * MiB;
constexpr size_t WS_X = 425 * MiB;
constexpr size_t WS_H = 553 * MiB;
constexpr size_t WS_R = 617 * MiB;
constexpr size_t WS_AQKV = WS_R;
constexpr size_t WS_QB = WS_R + 144 * MiB;
constexpr size_t WS_KB = WS_R + 208 * MiB;
constexpr size_t WS_VB = WS_R + 224 * MiB;
constexpr size_t WS_GATE = WS_R + 240 * MiB;
constexpr size_t WS_OAG = WS_R + 368 * MiB;
constexpr size_t WS_OA = WS_R + 416 * MiB;
constexpr size_t WS_MERGED = WS_R + 432 * MiB;
constexpr size_t WS_XS = WS_R;
constexpr size_t WS_ACT = WS_R + 136 * MiB;
constexpr size_t WS_Y = WS_R + 272 * MiB;
constexpr size_t WS_OB = WS_R + 496 * MiB;
constexpr size_t WS_M8 = WS_R + 560 * MiB;
constexpr size_t WS_END = WS_R + 592 * MiB;
constexpr int CW_BAR = 4096;

constexpr int RING_BYTES = 133120;
constexpr int LDSCTL_OFF = RING_BYTES;
constexpr int LDS_BYTES = 147456;
constexpr int NWAVES = 8;

#define GAS __attribute__((address_space(1)))
#define LAS __attribute__((address_space(3)))
typedef unsigned short bf16;
typedef unsigned v4u __attribute__((ext_vector_type(4)));
typedef unsigned v2u __attribute__((ext_vector_type(2)));
typedef float f32x4 __attribute__((ext_vector_type(4)));
typedef float f32x16 __attribute__((ext_vector_type(16)));
typedef int i32x4 __attribute__((ext_vector_type(4)));
typedef short bf16x8 __attribute__((ext_vector_type(8)));
typedef GAS unsigned gu32;
#define RLX_AGENT __ATOMIC_RELAXED, __HIP_MEMORY_SCOPE_AGENT
#define LDS_WAIT() asm volatile("s_waitcnt lgkmcnt(0)" ::: "memory")
__device__ __forceinline__ unsigned f2bf(float f) { unsigned u = __builtin_bit_cast(unsigned, f); return (u + 0x7fffu + ((u >> 16) & 1u)) >> 16; }
__device__ __forceinline__ unsigned pk2(float lo, float hi) { return f2bf(lo) | (f2bf(hi) << 16); }
__device__ __forceinline__ float bfl(unsigned w) { return __uint_as_float(w << 16); }
__device__ __forceinline__ float bfh(unsigned w) { return __uint_as_float(w & 0xffff0000u); }

#define XB_TMO      128
#define XB_XCNT(j)  (256  + 64 * (j))
#define XB_XSUB(j)  (1280 + 64 * (j))
#define XB_XGEN(j)  (2304 + 64 * (j))
#define XB_TOP      3328
#define XB_TOPGEN   3392
#define XCD_BAR_WORDS 3456
#define XB_SPIN_CAP (1u << 18)
__device__ __forceinline__ unsigned xb_ld(unsigned* p)              { return __hip_atomic_load(p, __ATOMIC_RELAXED, __HIP_MEMORY_SCOPE_AGENT); }
__device__ __forceinline__ unsigned xb_add(unsigned* p, unsigned v) { return __hip_atomic_fetch_add(p, v, __ATOMIC_RELAXED, __HIP_MEMORY_SCOPE_AGENT); }
__device__ __forceinline__ unsigned xb_xcc_id() { return (unsigned)__builtin_amdgcn_s_getreg((3 << 11) | 20) & 0xFu; }
#define XB_SPIN(cond, bar) do { unsigned _sp = 0; while (cond) { __builtin_amdgcn_s_sleep(1); \
    if ((++_sp & 255u) == 0u) { if (xb_ld(&(bar)[XB_TMO])) break; if (_sp > XB_SPIN_CAP) { atomicAdd(&(bar)[XB_TMO], 1u); break; } } } } while (0)
struct XcdBarrier { unsigned* bar; unsigned x; volatile LAS unsigned* st; };
__device__ __forceinline__ XcdBarrier xcd_barrier_post(unsigned* bar, volatile LAS unsigned* st) {
    XcdBarrier b; b.bar = bar; b.x = xb_xcc_id(); b.st = st;
    if (threadIdx.x == 0) (void)xb_add(&bar[XB_XCNT(b.x)], 1u);
    return b;
}
__device__ __forceinline__ void xcd_barrier_complete(unsigned* bar, unsigned x, unsigned& nloc, unsigned& nx) {
    const unsigned G = gridDim.x * gridDim.y * gridDim.z;
    unsigned sum, cnt, mine, sp = 0u;
    for (;;) {
        sum = 0u; cnt = 0u; mine = 0u;
#pragma unroll
        for (unsigned j = 0; j < 16; ++j) { const unsigned c = xb_ld(&bar[XB_XCNT(j)]); sum += c; cnt += (c > 0u) ? 1u : 0u; mine = (j == x) ? c : mine; }
        if (sum == G) break;
        __builtin_amdgcn_s_sleep(1);
        if ((++sp & 255u) == 0u) { if (xb_ld(&bar[XB_TMO])) break; if (sp > XB_SPIN_CAP) { atomicAdd(&bar[XB_TMO], 1u); break; } }
    }
    nloc = mine > 0u ? mine : 1u; nx = cnt > 0u ? cnt : 1u;
}
__device__ __forceinline__ void xcd_barrier(const XcdBarrier& b) {
    asm volatile("s_waitcnt vmcnt(0)" ::: "memory");
    __syncthreads();
    if (threadIdx.x == 0) {
        unsigned* bar = b.bar;
        __builtin_amdgcn_s_waitcnt(0);
        unsigned nloc = b.st[0], nx = b.st[1];
        if (nloc == 0u) { xcd_barrier_complete(bar, b.x, nloc, nx); b.st[0] = nloc; b.st[1] = nx; }
        const unsigned old = xb_add(&bar[XB_XSUB(b.x)], 1u);
        const unsigned gen = old / nloc;
        if (old + 1u == (gen + 1u) * nloc) {
            __builtin_amdgcn_fence(__ATOMIC_RELEASE, "agent");
            asm volatile("s_waitcnt vmcnt(0)" ::: "memory");
            const unsigned og = xb_add(&bar[XB_TOP], 1u);
            const unsigned tg = og / nx;
            if (og + 1u == (tg + 1u) * nx) xb_add(&bar[XB_TOPGEN], 1u);
            else XB_SPIN(xb_ld(&bar[XB_TOPGEN]) == tg, bar);
            __builtin_amdgcn_fence(__ATOMIC_ACQUIRE, "agent");
            xb_add(&bar[XB_XGEN(b.x)], 1u);
            asm volatile("s_waitcnt vmcnt(0)" ::: "memory");
        } else {
            XB_SPIN(xb_ld(&bar[XB_XGEN(b.x)]) == gen, bar);
            __builtin_amdgcn_fence(__ATOMIC_ACQUIRE, "agent");
            asm volatile("s_waitcnt vmcnt(0)" ::: "memory");
        }
    }
    __syncthreads();
}

__device__ __forceinline__ float wave_sum(float v) {
    v = xsum<1>(v); v = xsum<2>(v); v = xsum<4>(v); v = xsum<8>(v); v = xsum<16>(v); v = xsum<32>(v);
    return v;
}
struct CvtItem { const float* W; unsigned char* WT; int ldw, K, srcA, srcB, dst_row0, k0; bool ident; };
__device__ __forceinline__ void cvt_load_f8(const CvtItem& I, int lane, f32x4 (&v)[16]) {
    const int kq = lane >> 4, nq = lane & 15; const int scol = (nq < 8 ? I.srcA + 4 * nq : I.srcB + 4 * (nq - 8));
#pragma unroll
    for (int i = 0; i < 16; ++i) v[i] = __builtin_nontemporal_load((const GAS f32x4*)(I.W + (size_t)(I.k0 + 4 * i + kq) * I.ldw + scol));
}
__device__ __forceinline__ void cvt_store_f8(const CvtItem& I, const f32x4 (&v)[16], LAS float* scr, int lane) {
    const int kq = lane >> 4, nq = lane & 15;
#pragma unroll
    for (int i = 0; i < 16; ++i)
#pragma unroll
        for (int e = 0; e < 4; ++e) scr[(4 * i + kq) * 65 + 4 * nq + e] = v[i][e] * pg8::W8_SCALE;
    LDS_WAIT(); asm volatile("" ::: "memory");
    const int c = lane & 7, rr = lane >> 3;
#pragma unroll
    for (int j = 0; j < 8; ++j) { const int rho = rr + 8 * j; const int sc = (rho & 32) + (I.ident ? (rho & 31) : pg8::perm32(rho & 31)); const LAS float* s = scr + (8 * c) * 65 + sc;
        unsigned w0 = 0, w1 = 0;
        w0 = __builtin_amdgcn_cvt_pk_fp8_f32(s[0 * 65], s[1 * 65], w0, false); w0 = __builtin_amdgcn_cvt_pk_fp8_f32(s[2 * 65], s[3 * 65], w0, true);
        w1 = __builtin_amdgcn_cvt_pk_fp8_f32(s[4 * 65], s[5 * 65], w1, false); w1 = __builtin_amdgcn_cvt_pk_fp8_f32(s[6 * 65], s[7 * 65], w1, true);
        v2u o; o.x = w0; o.y = w1; *(GAS v2u*)(I.WT + (size_t)(I.dst_row0 + rho) * I.K + I.k0 + 8 * c) = o; }
    LDS_WAIT(); asm volatile("" ::: "memory");
}
__device__ __forceinline__ int win_src(int X) { const int pn = X >> 3, bj = (X >> 2) & 1, wc = X & 3; return (pn >= 9 && pn < 14) ? pn * 256 + 64 * wc + 32 * bj : 32 * X; }
__device__ __forceinline__ int wgu_src(int X) { const int pn = X >> 3, bj = (X >> 2) & 1, wc = X & 3; return bj * 1024 + 128 * pn + 32 * wc; }

__device__ __forceinline__ void norm_rows2_f8(const float* xrow, const float* g, const float* sc, const float* sh, unsigned char* orow, int lane) {
    const float* xr = xrow + 16 * lane;
    f32x4 v[2][4]; float s0 = 0.f, s1 = 0.f;
#pragma unroll
    for (int j = 0; j < 4; ++j) { v[0][j] = *(const GAS f32x4*)(xr + 4 * j); v[1][j] = *(const GAS f32x4*)(xr + D + 4 * j); }
#pragma unroll
    for (int j = 0; j < 4; ++j) { s0 += (v[0][j].x * v[0][j].x + v[0][j].y * v[0][j].y) + (v[0][j].z * v[0][j].z + v[0][j].w * v[0][j].w); s1 += (v[1][j].x * v[1][j].x + v[1][j].y * v[1][j].y) + (v[1][j].z * v[1][j].z + v[1][j].w * v[1][j].w); }
    const float rs0 = rsqrtf(wave_sum(s0) * (1.0f / D) + EPS), rs1 = rsqrtf(wave_sum(s1) * (1.0f / D) + EPS);
    v4u h0, h1; const int c = 16 * lane;
#pragma unroll
    for (int j = 0; j < 4; ++j) {
        const f32x4 gg = *(const GAS f32x4*)(g + c + 4 * j), a1 = *(const GAS f32x4*)(sc + c + 4 * j) + 1.0f, a0 = *(const GAS f32x4*)(sh + c + 4 * j);
        const f32x4 y0 = (v[0][j] * rs0 * gg) * a1 + a0, y1 = (v[1][j] * rs1 * gg) * a1 + a0;
        unsigned w0 = 0, w1 = 0;
        w0 = __builtin_amdgcn_cvt_pk_fp8_f32(y0.x, y0.y, w0, false); w0 = __builtin_amdgcn_cvt_pk_fp8_f32(y0.z, y0.w, w0, true);
        w1 = __builtin_amdgcn_cvt_pk_fp8_f32(y1.x, y1.y, w1, false); w1 = __builtin_amdgcn_cvt_pk_fp8_f32(y1.z, y1.w, w1, true);
        h0[j] = w0; h1[j] = w1; }
    *(GAS v4u*)(orow + c) = h0; *(GAS v4u*)(orow + D + c) = h1;
}

__device__ __forceinline__ bool gqa_bound_ok(const float* qg, const float* kg, int lane) {
    float gq = fabsf(qg[lane]), gk = fabsf(kg[lane]);
#define MK_MAXSTEP(m) gq = fmaxf(gq, __int_as_float(__builtin_amdgcn_ds_swizzle(__float_as_int(gq), 0x1f | ((m) << 10)))); gk = fmaxf(gk, __int_as_float(__builtin_amdgcn_ds_swizzle(__float_as_int(gk), 0x1f | ((m) << 10))))
    MK_MAXSTEP(1); MK_MAXSTEP(2); MK_MAXSTEP(4); MK_MAXSTEP(8); MK_MAXSTEP(16);
#undef MK_MAXSTEP
    gq = fmaxf(gq, xget32(gq, lane >> 5)); gk = fmaxf(gk, xget32(gk, lane >> 5));
    const float bound = 64.0f * gq * gk * C2 * 1.01f; return __builtin_amdgcn_readfirstlane((int)(bound <= 14.0f)) != 0;
}

struct Args { const float* in[20]; float* out; unsigned char* ws; int ph_lo, ph_hi, li, pad; };
constexpr int N_PHASES = 2 + 10 * DEPTH;

typedef const __attribute__((address_space(4))) Args* kargs_t;
__device__ __forceinline__ kargs_t kargs_opaque() { kargs_t p = (kargs_t)__builtin_amdgcn_kernarg_segment_ptr(); asm volatile("" : "+s"(p)); return p; }
#define PH_BEGIN() kargs_t ap = kargs_opaque(); unsigned char* ws = ap->ws; (void)ws; \
    int wave = wave_s; asm volatile("" : "+s"(wave)); const int lane = lane_id_asm(); const int tid = wave * 64 + lane; (void)lane; (void)tid; \
    int bx = blockIdx.x; asm volatile("" : "+s"(bx)); int G = gridDim.x; asm volatile("" : "+s"(G)); const int vcu = (G % 8 == 0) ? (bx % 8) * (G / 8) + bx / 8 : bx; (void)vcu; \
    const int gw = vcu * NWAVES + wave, NGW = G * NWAVES; (void)gw; (void)NGW; const int gtid = vcu * (NWAVES * 64) + tid, NGT = G * NWAVES * 64; (void)gtid; (void)NGT
#define INP(k) (ap->in[k])
#define x_in INP(0)
#define c_in INP(1)
#define w_ada INP(2)
#define b_ada INP(3)
#define norm1_g INP(4)
#define w_in INP(5)
#define q_norm_g INP(6)
#define k_norm_g INP(7)
#define rel_bias INP(8)
#define w_br_a INP(9)
#define w_br_b INP(10)
#define w_out INP(11)
#define norm2_g INP(12)
#define w_router INP(13)
#define b_router INP(14)
#define w_gate_up INP(15)
#define b_gate_up INP(16)
#define w_down INP(17)
#define b_down INP(18)
#define final_g INP(19)
#define MOD ((float*)(ws + WS_MOD))
#define ROPE ((float*)(ws + WS_ROPE))
#define BLUT ((float*)(ws + WS_BLUT))
#define RC0 ((float*)(ws + WS_RC0))
#define HIST ((int*)(ws + WS_HIST))
#define TILEE ((int*)(ws + WS_TILEE))
#define TOPE ((int*)(ws + WS_TOPE))
#define TOPW ((float*)(ws + WS_TOPW))
#define SLOT ((int*)(ws + WS_SLOT))
#define ROWW ((float*)(ws + WS_ROWW))
#define ROWTOK ((int*)(ws + WS_ROWTOK))
#define CNT ((int*)(ws + WS_CNT))
#define ROWTOK2 ((int*)(ws + WS_XS))
#define ROWW2 ((float*)(ws + WS_XS + 4 * MiB))
#define LSE ((float*)(ws + WS_LSE))
#define WRHI ((bf16*)(ws + WS_WRHI))
#define WRLO ((bf16*)(ws + WS_WRLO))
#define WIN ((unsigned char*)(ws + WS_WIN))
#define WBRA ((unsigned char*)(ws + WS_WBRA))
#define WBRB ((unsigned char*)(ws + WS_WBRB))
#define WOUT ((unsigned char*)(ws + WS_WOUT))
#define WGU ((unsigned char*)(ws + WS_WGU))
#define WDN ((unsigned char*)(ws + WS_WDN))
#define X ((bf16*)(ws + WS_X))
#define H ((bf16*)(ws + WS_H))
#define H8 ((unsigned char*)(ws + WS_H))
#define AQKV ((bf16*)(ws + WS_AQKV))
#define QB ((bf16*)(ws + WS_QB))
#define KB ((bf16*)(ws + WS_KB))
#define VB ((bf16*)(ws + WS_VB))
#define GATE ((bf16*)(ws + WS_GATE))
#define OAG ((bf16*)(ws + WS_OAG))
#define OA ((unsigned char*)(ws + WS_OA))
#define MERGED ((bf16*)(ws + WS_MERGED))
#define OB ((unsigned char*)(ws + WS_OB))
#define M8 ((unsigned char*)(ws + WS_M8))
#define XS ((unsigned char*)(ws + WS_XS))
#define ACT ((unsigned char*)(ws + WS_ACT))
#define YB ((unsigned char*)(ws + WS_Y))
__global__ void __launch_bounds__(NWAVES * 64, 2) mk_fwd(Args args) {
    extern __shared__ __attribute__((aligned(16))) unsigned char lds[];
    LAS unsigned char* L = (LAS unsigned char*)lds;
    volatile LAS unsigned* MISC = (volatile LAS unsigned*)(L + LDSCTL_OFF);
    gu32* ctl = (gu32*)(args.ws + WS_CTL);
    const int wave_s = __builtin_amdgcn_readfirstlane(threadIdx.x >> 6);
    for (int u = threadIdx.x; u < (LDS_BYTES - LDSCTL_OFF) / 4; u += NWAVES * 64) ((LAS unsigned*)(L + LDSCTL_OFF))[u] = 0u;
    __syncthreads();
    XcdBarrier bar; bar.bar = (unsigned*)(ctl + CW_BAR) + args.li * XCD_BAR_WORDS; bar.x = 0; bar.st = nullptr;
    if (!MK_PER_PHASE) bar = xcd_barrier_post((unsigned*)(ctl + CW_BAR) + args.li * XCD_BAR_WORDS, MISC + 8);
    const int lo = args.ph_lo, hi = args.ph_hi;
    unsigned long long t_prev = PROBE_SPIN_MASK ? __builtin_amdgcn_s_memrealtime() : 0ull; (void)t_prev;
#define IN(k) (lo <= (k) && (k) < hi)
#define KIND(q) ((PH_KIND_MASK >> (q)) & 1)
#define SEAM(k) SEAMK(k, ((k) < 2 ? (k) : 2 + ((k) - 2) % 10))
#define SEAMK(k, kind) do { if (IN(k) && IN((k) + 1)) { xcd_barrier(bar); \
    if (PROBE_SPIN_MASK) { if (blockIdx.x == 0) { if (threadIdx.x == 0) { const unsigned long long tn_ = __builtin_amdgcn_s_memrealtime(); \
          if ((PROBE_SPIN_MASK >> (kind)) & 1) { const unsigned long long te_ = tn_ + 9ull * (tn_ - t_prev); while (__builtin_amdgcn_s_memrealtime() < te_) __builtin_amdgcn_s_sleep(8); } } \
        __syncthreads(); } t_prev = __builtin_amdgcn_s_memrealtime(); } } } while (0)

    for (int rep0 = 0; rep0 < 1 + PROBE_P0; ++rep0) {
    if (KIND(0) && IN(0)) { PH_BEGIN();
        {
            LAS float* cact = (LAS float*)L;
            LAS float* part = (LAS float*)(L + 32768);
            for (int i = tid; i < NB * D; i += NWAVES * 64) { const float cv = c_in[i]; cact[i] = cv / (1.0f + __expf(-cv)); }
            __syncthreads();
            for (int vb = bx; vb < 256; vb += G) {
                const int gc0 = vb * 48; const int l = gc0 / 6144, col0 = gc0 % 6144;
                const int kq = lane / 12, c4 = lane % 12;
                if (lane < 48) {
                    const float* wp = w_ada + (size_t)l * D * 6144 + col0 + 4 * c4 + (size_t)(wave * 128 + kq) * 6144;
                    f32x4 w[32];
#pragma unroll
                    for (int i = 0; i < 32; ++i) w[i] = *(const GAS f32x4*)(wp + (size_t)(4 * i) * 6144);
                    f32x4 a[NB];
#pragma unroll
                    for (int b = 0; b < NB; ++b) a[b] = (f32x4){0.f, 0.f, 0.f, 0.f};
#pragma unroll
                    for (int i = 0; i < 32; ++i) { const int k = wave * 128 + 4 * i + kq;
#pragma unroll
                        for (int b = 0; b < NB; ++b) a[b] += w[i] * cact[b * D + k]; }
#pragma unroll
                    for (int b = 0; b < NB; ++b) *(LAS f32x4*)(part + ((wave * 4 + kq) * NB + b) * 48 + 4 * c4) = a[b];
                }
                __syncthreads();
                if (tid < NB * 48) { const int b = tid / 48, cl = tid % 48;
                    float s = b_ada[l * 6144 + col0 + cl];
#pragma unroll 8
                    for (int q = 0; q < 32; ++q) s += part[(q * NB + b) * 48 + cl];
                    MOD[((size_t)l * NB + b) * 6144 + col0 + cl] = s; }
                __syncthreads();
            }
        }
        for (int i = gtid; i < 1024 + 12 * 768; i += NGT) {
            if (i < 1024) { const int p = i >> 4, f = i & 15; const double inv = pow(10000.0, -(double)f / 16.0); const double ang = (double)p * inv; ROPE[i] = (float)cos(ang); ROPE[1024 + i] = (float)sin(ang); }
            else { const int j = i - 1024; const int hh = j / 768, di = j % 768; const int delta = di - 383; const int g = hh >> 2; const int dil = g == 0 ? 1 : (g == 1 ? 4 : 16);
                float val = -INFINITY;
                if (delta >= -64 && delta <= 64) { const int rel = delta * dil; const int n = rel < 0 ? -rel : rel; int bk = rel > 0 ? 16 : 0;
                    if (n < 8) bk += n; else { int lg = 8 + (int)(logf((float)n / 8.0f) / logf(128.0f) * 8.0f); if (lg > 15) lg = 15; bk += lg; }
                    val = rel_bias[bk * 12 + hh] * LOG2E; }
                BLUT[j] = val; }
        }
        {
            LAS float* scr = (LAS float*)(L + wave * 16640);
            __syncthreads();
            constexpr int I_IN = 16 * 92, I_BRA = 4 * 16, I_BRB = 16 * 16, I_OUT = 16 * 16, I_GU = 16 * 32, I_DN = 16 * 16;
            constexpr int PER_L = I_IN + I_BRA + I_BRB + I_OUT;
            constexpr int NITEMS = DEPTH * PER_L + DEPTH * NE * (I_GU + I_DN);
#define CVT_DECODE(I, it_) do { int r = (it_); \
                if (r < DEPTH * PER_L) { const int l = r / PER_L; r %= PER_L; \
                    if (r < I_IN) { const int kb = r / 92, g64 = r % 92; I = CvtItem{w_in + (size_t)l * D * N_IN, WIN + (size_t)l * N_IN * D, N_IN, D, win_src(2 * g64), win_src(2 * g64 + 1), 64 * g64, 64 * kb, (g64 >> 2) >= 9 && (g64 >> 2) < 14}; break; } r -= I_IN; \
                    if (r < I_BRA) { const int kb = r / 16, g64 = r % 16; I = CvtItem{w_br_a + (size_t)l * 256 * D, WBRA + (size_t)l * D * 256, D, 256, 64 * g64, 64 * g64 + 32, 64 * g64, 64 * kb, false}; break; } r -= I_BRA; \
                    if (r < I_BRB) { const int kb = r / 16, g64 = r % 16; I = CvtItem{w_br_b + (size_t)l * D * D, WBRB + (size_t)l * D * D, D, D, 64 * g64, 64 * g64 + 32, 64 * g64, 64 * kb, false}; break; } r -= I_BRB; \
                    { const int kb = r / 16, g64 = r % 16; I = CvtItem{w_out + (size_t)l * D * D, WOUT + (size_t)l * D * D, D, D, 64 * g64, 64 * g64 + 32, 64 * g64, 64 * kb, false}; break; } } \
                r -= DEPTH * PER_L; \
                if (r < DEPTH * NE * I_GU) { const int le = r / I_GU; r %= I_GU; const int kb = r / 32, g64 = r % 32; \
                    I = CvtItem{w_gate_up + (size_t)le * D * 2048, WGU + (size_t)le * 2048 * D, 2048, D, wgu_src(2 * g64), wgu_src(2 * g64 + 1), 64 * g64, 64 * kb, false}; break; } \
                r -= DEPTH * NE * I_GU; \
                { const int le = r / I_DN; r %= I_DN; const int kb = r / 16, g64 = r % 16; I = CvtItem{w_down + (size_t)le * D * D, WDN + (size_t)le * D * D, D, D, 64 * g64, 64 * g64 + 32, 64 * g64, 64 * kb, false}; } } while (0)
            CvtItem ia, ib; f32x4 va[16], vb[16];
            int it = gw;
            if (it < NITEMS) { CVT_DECODE(ia, it); cvt_load_f8(ia, lane, va); }
            for (; it < NITEMS; it += 2 * NGW) {
                const bool h1 = it + NGW < NITEMS;
                if (h1) { CVT_DECODE(ib, it + NGW); cvt_load_f8(ib, lane, vb); }
                cvt_store_f8(ia, va, scr, lane);
                if (it + 2 * NGW < NITEMS) { CVT_DECODE(ia, it + 2 * NGW); cvt_load_f8(ia, lane, va); }
                if (h1) cvt_store_f8(ib, vb, scr, lane);
            }
#undef CVT_DECODE
        }
    }
    SEAM(0);
    }
    if (KIND(1) && IN(1)) { PH_BEGIN();
        for (int rg = gw; rg < T / 16; rg += NGW) { const int mb = rg * 16, b = mb >> 12, c = 16 * lane; const float* md = MOD + (size_t)b * 6144;
            f32x4 gna[4], a0v[4];
#pragma unroll
            for (int j = 0; j < 4; ++j) { gna[j] = *(const GAS f32x4*)(norm1_g + c + 4 * j) * (*(const GAS f32x4*)(md + 1024 + c + 4 * j) + 1.0f); a0v[j] = *(const GAS f32x4*)(md + c + 4 * j); }
            f32x4 xv[2][2][4];
#define N1_LOAD(buf, it) _Pragma("unroll") for (int q = 0; q < 2; ++q) _Pragma("unroll") for (int j = 0; j < 4; ++j) xv[buf][q][j] = __builtin_nontemporal_load((const GAS f32x4*)(x_in + (size_t)(mb + 2 * (it) + q) * D + c + 4 * j))
            N1_LOAD(0, 0);
#pragma unroll
            for (int it = 0; it < 8; ++it) { const int cb = it & 1;
                if (it < 7) { N1_LOAD(cb ^ 1, it + 1); }
                float s0 = 0.f, s1 = 0.f;
#pragma unroll
                for (int j = 0; j < 4; ++j) { const f32x4 u = xv[cb][0][j], w = xv[cb][1][j]; s0 += (u.x * u.x + u.y * u.y) + (u.z * u.z + u.w * u.w); s1 += (w.x * w.x + w.y * w.y) + (w.z * w.z + w.w * w.w); }
                const float rs0 = rsqrtf(wave_sum(s0) * (1.0f / D) + EPS), rs1 = rsqrtf(wave_sum(s1) * (1.0f / D) + EPS);
                v4u h0, h1;
#pragma unroll
                for (int j = 0; j < 4; ++j) { const f32x4 y0 = (xv[cb][0][j] * rs0) * gna[j] + a0v[j], y1 = (xv[cb][1][j] * rs1) * gna[j] + a0v[j];
                    unsigned w0 = 0, w1 = 0;
                    w0 = __builtin_amdgcn_cvt_pk_fp8_f32(y0.x, y0.y, w0, false); w0 = __builtin_amdgcn_cvt_pk_fp8_f32(y0.z, y0.w, w0, true);
                    w1 = __builtin_amdgcn_cvt_pk_fp8_f32(y1.x, y1.y, w1, false); w1 = __builtin_amdgcn_cvt_pk_fp8_f32(y1.z, y1.w, w1, true);
                    h0[j] = w0; h1[j] = w1; }
                *(GAS v4u*)(H8 + (size_t)(mb + 2 * it) * D + c) = h0; *(GAS v4u*)(H8 + (size_t)(mb + 2 * it + 1) * D + c) = h1;
            }
#undef N1_LOAD
        }
        for (int i = gtid; i < DEPTH * NB * NE * D; i += NGT) { const int k = i & 1023, e = (i >> 10) & 31, b = (i >> 15) & 7, l = i >> 18;
            const float v = norm2_g[l * D + k] * (1.0f + MOD[((size_t)l * NB + b) * 6144 + 4 * 1024 + k]) * w_router[((size_t)l * D + k) * NE + e];
            const unsigned hb = f2bf(v); const float lv = v - __uint_as_float(hb << 16);
            { const int s_ = 2 * (k >> 6) + ((k >> 3) & 1), kb_ = (k >> 4) & 3, j_ = k & 7, h_ = e >> 4, i_ = e & 15;
              const size_t o = (size_t)(l * NB + b) * 65536 + (size_t)((s_ * 2 + h_) * 2) * 512 + (kb_ * 16 + i_) * 8 + j_;
              WRHI[o] = (bf16)hb; WRHI[o + 512] = (bf16)f2bf(lv); } }
        for (int i = gw; i < DEPTH * NB * NE; i += NGW) { const int e = i & 31, b = (i >> 5) & 7, l = i >> 8; float s = 0.f;
            for (int k = lane; k < D; k += 64) s += MOD[((size_t)l * NB + b) * 6144 + 3 * 1024 + k] * w_router[((size_t)l * D + k) * NE + e];
            s = wave_sum(s); if (lane == 0) RC0[i] = s + b_router[l * NE + e]; }
    }
    SEAM(1);

    for (int li = (PROBE_MASK ? -1 : 0); li < DEPTH; ++li) {
        const int l = li < 0 ? 0 : li; const bool virt = li < 0;
        const int P = 2 + 10 * l;
#define VK(q) (!virt || ((PROBE_MASK >> (q)) & 1))
        if (KIND(2) && IN(P + 0) && VK(2)) { PH_BEGIN();
            pg8::Gemm g{H, (const bf16*)(WIN + (size_t)l * N_IN * D), D / 2}; pg8::StaticOrder S; S.init(T, N_IN, G, bx);
            const bool f8attn = gqa_bound_ok(q_norm_g + l * 64, k_norm_g + l * 64, lane);
            pg8::EpiIn E{AQKV, QB, KB, VB, GATE, q_norm_g + l * 64, k_norm_g + l * 64, ROPE, pg8::W8_INV, f8attn};
            pg8::gemm_phase_f8<pg8::EpiIn, pg8::StaticOrder>(L, g, S, E, wave);
        }
        if (VK(2)) SEAM(P + 0);
        if (KIND(3) && IN(P + 1) && VK(3)) { PH_BEGIN();
            namespace ab = attn_body;
            const bool nomax = gqa_bound_ok(q_norm_g + l * 64, k_norm_g + l * 64, lane);
            for (int j = 0; j < 8; ++j) {
                const int uidx = vcu * 8 + j; if (uidx >= 2048) break;
                const int pair = uidx >> 6, idx = uidx & 63; const int b = pair >> 2, kvh = pair & 3, hq = idx >> 4, qb = idx & 15; const int h = kvh * 4 + hq;
                ab::Job J; J.Q = (const ab::bf16*)QB + ((size_t)b * SEQ + qb * 256) * 1024 + h * 64; J.K = (const ab::bf16*)KB + (size_t)b * SEQ * 256 + kvh * 64; J.V = (const ab::bf16*)VB + (size_t)b * SEQ * 256 + kvh * 64;
                J.O = (ab::bf16*)(OB + ((size_t)b * SEQ + qb * 256) * 1024 + h * 64)  ; J.lse = nullptr; J.lutg = nullptr; J.NT = 64; J.i0 = 0; J.kq0 = 0; J.dsh = 0; J.cls = 0;
                if (nomax) { attn8::Job J8; J8.Q = (const unsigned char*)QB + ((size_t)b * SEQ + qb * 256) * 1024 + h * 64; J8.K = (const unsigned char*)KB + (size_t)b * SEQ * 256 + kvh * 64;
                    J8.VT = (const unsigned char*)VB + ((size_t)((b * 4 + kvh) * 64) << 12); J8.O = OB + ((size_t)b * SEQ + qb * 256) * 1024 + h * 64;
                    attn8::attn_unit_f8<64>(J8, (char*)lds, wave); }
                else ab::attn_unit<0, 8, false>(J, (char*)lds, wave);
            }
            for (int j = 0; j < 6; ++j) {
                const int uidx = vcu * 6 + j; if (uidx >= 1536) break;
                const int g = uidx / 512, r = uidx % 512; const int b = r >> 6, hs = (r >> 4) & 3, combo = r & 15;
                const int dsh = 2 * g; const int Lc = SEQ >> dsh; const int nqb = Lc >> 8;
                const int cls = combo / nqb, qb = combo % nqb; const int i0 = qb * 256;
                int t0 = (i0 >> 6) - 1; const int ntile = Lc >> 6; const int NT = ntile >= 6 ? 6 : 4; if (t0 < 0) t0 = 0; if (t0 > ntile - NT) t0 = ntile - NT;
                const size_t cbase = (size_t)b * SEQ + (size_t)cls * Lc;
                const ab::bf16* aq = (const ab::bf16*)AQKV + (size_t)(g * 3 + 0) * T * 256; const ab::bf16* ak = (const ab::bf16*)AQKV + (size_t)(g * 3 + 1) * T * 256; const ab::bf16* av = (const ab::bf16*)AQKV + (size_t)(g * 3 + 2) * T * 256;
                ab::Job J; J.Q = aq + (cbase + i0) * 256 + hs * 64; J.K = ak + (cbase + t0 * 64) * 256 + hs * 64; J.V = av + (cbase + t0 * 64) * 256 + hs * 64;
                J.O = (ab::bf16*)OAG + (size_t)g * T * 256 + (size_t)b * SEQ * 256 + hs * 64; J.lse = LSE + (size_t)g * T * 4 + (size_t)b * SEQ * 4 + hs; J.lutg = BLUT + (g * 4 + hs) * 768;
                J.NT = NT; J.i0 = i0; J.kq0 = t0 * 64 - i0; J.dsh = dsh; J.cls = cls;
                ab::attn_unit<1, 8>(J, (char*)lds, wave);
            }
        }
        if (VK(3)) SEAM(P + 1);
        if (KIND(5) && IN(P + 3) && VK(5)) { PH_BEGIN();
            pg8::StaticOrder S; S.init(T, D, G, bx);
#define LC_ITEM_W(u_) const float mx = fmaxf(l0[u_], fmaxf(l1[u_], l2[u_])); float w0 = exp2f(l0[u_] - mx), w1 = exp2f(l1[u_] - mx), w2 = exp2f(l2[u_] - mx); const float inv = 1.0f / (w0 + w1 + w2); w0 *= inv; w1 *= inv; w2 *= inv; \
                        unsigned o0 = 0, o1 = 0;     \
                        o0 = __builtin_amdgcn_cvt_pk_fp8_f32(w0 * bfl(a[u_].x) + w1 * bfl(bq[u_].x) + w2 * bfl(cq[u_].x), w0 * bfh(a[u_].x) + w1 * bfh(bq[u_].x) + w2 * bfh(cq[u_].x), o0, false); \
                        o0 = __builtin_amdgcn_cvt_pk_fp8_f32(w0 * bfl(a[u_].y) + w1 * bfl(bq[u_].y) + w2 * bfl(cq[u_].y), w0 * bfh(a[u_].y) + w1 * bfh(bq[u_].y) + w2 * bfh(cq[u_].y), o0, true); \
                        o1 = __builtin_amdgcn_cvt_pk_fp8_f32(w0 * bfl(a[u_].z) + w1 * bfl(bq[u_].z) + w2 * bfl(cq[u_].z), w0 * bfh(a[u_].z) + w1 * bfh(bq[u_].z) + w2 * bfh(cq[u_].z), o1, false); \
                        o1 = __builtin_amdgcn_cvt_pk_fp8_f32(w0 * bfl(a[u_].w) + w1 * bfl(bq[u_].w) + w2 * bfl(cq[u_].w), w0 * bfh(a[u_].w) + w1 * bfh(bq[u_].w) + w2 * bfh(cq[u_].w), o1, true); \
                        v2u o; o.x = o0; o.y = o1; *(GAS v2u*)(OA + (size_t)t * 256 + ch * 8) = o;
#define LC_LOAD(u_, i_) { const int t = (i_) >> 5, ch = (i_) & 31, hs = ch >> 3; l0[u_] = LSE[(size_t)t * 4 + hs]; l1[u_] = LSE[(size_t)T * 4 + (size_t)t * 4 + hs]; l2[u_] = LSE[(size_t)2 * T * 4 + (size_t)t * 4 + hs]; \
                        a[u_] = *(const GAS v4u*)(OAG + (size_t)t * 256 + ch * 8); bq[u_] = *(const GAS v4u*)(OAG + (size_t)T * 256 + (size_t)t * 256 + ch * 8); cq[u_] = *(const GAS v4u*)(OAG + (size_t)2 * T * 256 + (size_t)t * 256 + ch * 8); }
            { int prev_pm = -1; pg8::Unit uu;
              for (int iu = 0; S.next(iu, uu); ++iu) { if (uu.pm == prev_pm) continue; prev_pm = uu.pm;
                for (int j0 = tid; j0 < 256 * 32; j0 += 4 * NWAVES * 64) {
                    float l0[4], l1[4], l2[4]; v4u a[4], bq[4], cq[4];
#pragma unroll
                    for (int u = 0; u < 4; ++u) LC_LOAD(u, uu.pm * (256 * 32) + j0 + u * (NWAVES * 64))
#pragma unroll
                    for (int u = 0; u < 4; ++u) { const int i = uu.pm * (256 * 32) + j0 + u * (NWAVES * 64); const int t = i >> 5, ch = i & 31; LC_ITEM_W(u) }
                } }
              asm volatile("s_waitcnt vmcnt(0)" ::: "memory"); __syncthreads(); }
#undef LC_ITEM_W
#undef LC_LOAD
            { pg8::Gemm g{(const bf16*)OA, (const bf16*)(WBRA + (size_t)l * D * 256), 128}; pg8::EpiMergeA E{GATE, MERGED}; pg8::gemm_phase_f8<pg8::EpiMergeA, pg8::StaticOrder>(L, g, S, E, wave); }
            { pg8::Gemm g{(const bf16*)OB, (const bf16*)(WBRB + (size_t)l * D * D), D / 2}; pg8::EpiMergeB<true> E{GATE, MERGED, M8}; pg8::gemm_phase_f8<pg8::EpiMergeB<true>, pg8::StaticOrder>(L, g, S, E, wave); }
        }
        if (VK(5)) SEAM(P + 3);
        if (KIND(6) && IN(P + 4) && VK(6)) { PH_BEGIN();
            pg8::Gemm g{(const bf16*)M8, (const bf16*)(WOUT + (size_t)l * D * D), D / 2}; pg8::StaticOrder S; S.init(T, D, G, bx);
            pg8::EpiOut E{l == 0 ? x_in : nullptr, l == 0 ? nullptr : X, X, MOD + (size_t)l * NB * 6144 + 2 * 1024};
            pg8::gemm_phase_f8<pg8::EpiOut, pg8::StaticOrder>(L, g, S, E, wave);
        }
        if (VK(6)) SEAM(P + 4);
        if (KIND(7) && IN(P + 5) && VK(7)) { PH_BEGIN();
            LAS int* hist = (LAS int*)(L + LDSCTL_OFF + 256);
            for (int vb = bx; vb < 256; vb += G) {
                if (tid < NE) hist[tid] = 0;
                __syncthreads();
                {
                    const int tt = 8 * vb + wave; const int r0 = tt * 16; const int b = r0 >> 12; const int i = lane & 15, kb = lane >> 4;
                    const char* wsrc = (const char*)(WRHI + (size_t)(l * NB + b) * 65536) + lane * 16;
#pragma unroll
                    for (int j = 0; j < 16; ++j) __builtin_amdgcn_global_load_lds((const unsigned*)(wsrc + (wave * 16 + j) * 1024), (LAS unsigned*)(L + (wave * 16 + j) * 1024), 16, 0, 0);
                    LAS float* modl = (LAS float*)(L + LDSCTL_OFF + 1024);
                    if (tid < 256) { const float* md = MOD + ((size_t)l * NB + b) * 6144; const int k4 = tid * 4;
                        *(LAS f32x4*)(modl + k4) = *(const GAS f32x4*)(norm2_g + l * D + k4) * (*(const GAS f32x4*)(md + 4 * 1024 + k4) + 1.0f); *(LAS f32x4*)(modl + 1024 + k4) = *(const GAS f32x4*)(md + 3 * 1024 + k4); }
                    const bf16* xp = X + (size_t)(r0 + i) * D + 16 * kb;
                    v4u xw[32];
#pragma unroll
                    for (int s = 0; s < 32; ++s) xw[s] = *(const GAS v4u*)(xp + 64 * (s >> 1) + 8 * (s & 1));
                    asm volatile("s_waitcnt vmcnt(0)" ::: "memory");
                    __syncthreads();
                    f32x4 acc0 = (f32x4){0.f, 0.f, 0.f, 0.f}, acc1 = acc0; float ss = 0.f;
                    bf16x8 wq[2][4];
#define RT_LDW(buf, s_) _Pragma("unroll") for (int f = 0; f < 4; ++f) wq[buf][f] = *(const LAS bf16x8*)(L + (s_) * 4096 + f * 1024 + lane * 16)
                    RT_LDW(0, 0);
#pragma unroll
                    for (int s = 0; s < 32; ++s) {
                        if (s < 31) { RT_LDW((s + 1) & 1, s + 1); }
                        { const float a0 = bfl(xw[s].x), a1 = bfh(xw[s].x), a2 = bfl(xw[s].y), a3 = bfh(xw[s].y), a4 = bfl(xw[s].z), a5 = bfh(xw[s].z), a6 = bfl(xw[s].w), a7 = bfh(xw[s].w);
                          ss += (a0 * a0 + a1 * a1) + (a2 * a2 + a3 * a3) + (a4 * a4 + a5 * a5) + (a6 * a6 + a7 * a7); }
                        const bf16x8 ahv = __builtin_bit_cast(bf16x8, xw[s]);
                        acc0 = __builtin_amdgcn_mfma_f32_16x16x32_bf16(wq[s & 1][0], ahv, acc0, 0, 0, 0); acc1 = __builtin_amdgcn_mfma_f32_16x16x32_bf16(wq[s & 1][2], ahv, acc1, 0, 0, 0);
                        acc0 = __builtin_amdgcn_mfma_f32_16x16x32_bf16(wq[s & 1][1], ahv, acc0, 0, 0, 0); acc1 = __builtin_amdgcn_mfma_f32_16x16x32_bf16(wq[s & 1][3], ahv, acc1, 0, 0, 0);
                        __builtin_amdgcn_sched_barrier(0);
                    }
#undef RT_LDW
                    ss = xsum<16>(ss); ss = xsum<32>(ss);
                    const float rs = rsqrtf(ss * (1.0f / D) + EPS);
#pragma unroll
                    for (int sp = 0; sp < 16; ++sp) { const int cb0 = 64 * sp + 16 * kb; v4u o;
                        int mo = 16 * kb; asm volatile("" : "+v"(mo) : "v"(rs));
                        const LAS float* mq = modl + mo + 64 * sp;
#pragma unroll
                        for (int q4 = 0; q4 < 4; ++q4) { const f32x4 a1 = *(const LAS f32x4*)(mq + 4 * q4), a0 = *(const LAS f32x4*)(mq + 1024 + 4 * q4);
                            const v4u xq = xw[2 * sp + (q4 >> 1)]; unsigned u0 = (q4 & 1) ? xq.z : xq.x, u1 = (q4 & 1) ? xq.w : xq.y;
                            asm volatile("" : "+v"(u0), "+v"(u1));
                            const f32x4 y = ((f32x4){bfl(u0), bfh(u0), bfl(u1), bfh(u1)} * rs) * a1 + a0;
                            unsigned w = 0; w = __builtin_amdgcn_cvt_pk_fp8_f32(y.x, y.y, w, false); w = __builtin_amdgcn_cvt_pk_fp8_f32(y.z, y.w, w, true); o[q4] = w; }
                        *(GAS v4u*)(H8 + (size_t)(r0 + i) * D + cb0) = o; }
                    float v[8]; const float* rc = RC0 + (l * NB + b) * NE;
#pragma unroll
                    for (int r = 0; r < 4; ++r) { v[r] = rs * acc0[r] + rc[4 * kb + r]; v[4 + r] = rs * acc1[r] + rc[16 + 4 * kb + r]; }
                    float tv[4]; int ti[4];
#pragma unroll
                    for (int k = 0; k < 4; ++k) { float best = v[0]; int br = 0;
#pragma unroll
                        for (int r = 1; r < 8; ++r) if (v[r] > best) { best = v[r]; br = r; }
#pragma unroll
                        for (int r = 0; r < 8; ++r) v[r] = (r == br) ? -INFINITY : v[r];
                        tv[k] = best; ti[k] = (br & 3) + 16 * (br >> 2) + 4 * kb; }
#pragma unroll
                    for (int round = 0; round < 2; ++round) {
                        float bv[8]; int bi[8];
#pragma unroll
                        for (int k = 0; k < 4; ++k) { bv[k] = tv[k]; bi[k] = ti[k];
                            if (round == 0) { bv[4 + k] = __int_as_float(__builtin_amdgcn_ds_swizzle(__float_as_int(tv[k]), 0x1f | (16 << 10))); bi[4 + k] = __builtin_amdgcn_ds_swizzle(ti[k], 0x1f | (16 << 10)); }
                            else { bv[4 + k] = xget32(tv[k], lane >> 5); bi[4 + k] = xget32(ti[k], lane >> 5); } }
#pragma unroll
                        for (int k = 0; k < 4; ++k) { float best = bv[0]; int bq = 0, sel = bi[0];
#pragma unroll
                            for (int r = 1; r < 8; ++r) if (bv[r] > best || (bv[r] == best && bi[r] < sel)) { best = bv[r]; bq = r; sel = bi[r]; }
#pragma unroll
                            for (int r = 0; r < 8; ++r) bv[r] = (r == bq) ? -INFINITY : bv[r];
                            tv[k] = best; ti[k] = sel; }
                    }
                    float rw[4] = {0.f, 0.f, 0.f, 0.f};
                    if (kb == 0) {
                        const float e1 = __expf(tv[1] - tv[0]), e2 = __expf(tv[2] - tv[0]), e3 = __expf(tv[3] - tv[0]); const float inv = 1.0f / (1.0f + e1 + e2 + e3);
                        rw[0] = inv; rw[1] = e1 * inv; rw[2] = e2 * inv; rw[3] = e3 * inv;
#pragma unroll
                        for (int k = 0; k < 4; ++k) atomicAdd((int*)&hist[ti[k]], 1);
                    }
                    __syncthreads();
                    if (tid < NE) { const int hv = hist[tid]; hist[32 + tid] = hv ? __hip_atomic_fetch_add(CNT + l * NE + tid, hv, RLX_AGENT) : 0; hist[64 + tid] = 0; }
                    __syncthreads();
                    if (kb == 0) { const int tok = r0 + i; i32x4 sl;
#pragma unroll
                        for (int k = 0; k < 4; ++k) { const int e = ti[k]; const int idx = hist[32 + e] + atomicAdd((int*)&hist[64 + e], 1);
                            sl[k] = (e << 20) | idx; ROWTOK2[(size_t)e * T + idx] = tok; ROWW2[(size_t)e * T + idx] = rw[k]; }
                        *(GAS i32x4*)(SLOT + (size_t)tok * 4) = sl; }
                }
                __syncthreads();
            }
        }
        if (VK(7)) SEAM(P + 5);
        if (KIND(9) && IN(P + 7) && VK(9)) { PH_BEGIN();
            LAS int* et_l = (LAS int*)(L + LDSCTL_OFF + 256); LAS int* te_l = (LAS int*)(L + LDSCTL_OFF + 1024);
            if (tid < NE) et_l[tid] = __hip_atomic_load(CNT + l * NE + tid, RLX_AGENT);
            __syncthreads();
            if (tid < NE) { int ft = 0; for (int e = 0; e < tid; ++e) ft += (et_l[e] + 255) >> 8; et_l[32 + tid] = ft; if (tid == NE - 1) et_l[64] = ft + ((et_l[tid] + 255) >> 8); }
            __syncthreads();
            const int nmt = __builtin_amdgcn_readfirstlane(et_l[64]);
            for (int mt = tid; mt < nmt; mt += NWAVES * 64) { int e = 0;
#pragma unroll 8
                for (int q = 1; q < NE; ++q) if (et_l[32 + q] <= mt) e = q;
                te_l[mt] = e; }
            __syncthreads();
            LAS unsigned short* rt_l = (LAS unsigned short*)(L + LDSCTL_OFF + 4096);
            for (int q = tid; q < GU_MAXU * 256; q += NWAVES * 64) { const long Lu = (long)(q >> 8) * G + vcu;
                if (Lu < (long)nmt * 8) { const int mt = (int)(Lu >> 3), e = te_l[mt]; const int loc = (mt - et_l[32 + e]) * 256 + (q & 255); rt_l[q] = loc < et_l[e] ? (unsigned short)ROWTOK2[(size_t)e * T + loc] : (unsigned short)0; } }
            __syncthreads();
            pg8::Gemm g{(const bf16*)H8, (const bf16*)(WGU + (size_t)l * NE * 2048 * D), D / 2}; pg8::MoeOrder S{te_l, nmt * 8, 8, G, vcu};
            pg8::EpiGU8 E{b_gate_up + (size_t)l * NE * 2048, ACT};
            pg8::gemm_phase_f8<pg8::EpiGU8, pg8::MoeOrder, true>(L, g, S, E, wave, rt_l);
        }
        if (VK(9)) SEAM(P + 7);
        if (KIND(10) && IN(P + 8) && VK(10)) { PH_BEGIN();
            LAS int* et_l = (LAS int*)(L + LDSCTL_OFF + 256); LAS int* te_l = (LAS int*)(L + LDSCTL_OFF + 1024);
            if (tid < NE) et_l[tid] = __hip_atomic_load(CNT + l * NE + tid, RLX_AGENT);
            __syncthreads();
            if (tid < NE) { int ft = 0; for (int e = 0; e < tid; ++e) ft += (et_l[e] + 255) >> 8; et_l[32 + tid] = ft; if (tid == NE - 1) et_l[64] = ft + ((et_l[tid] + 255) >> 8); }
            __syncthreads();
            const int nmt = __builtin_amdgcn_readfirstlane(et_l[64]);
            for (int mt = tid; mt < nmt; mt += NWAVES * 64) { int e = 0;
#pragma unroll 8
                for (int q = 1; q < NE; ++q) if (et_l[32 + q] <= mt) e = q;
                te_l[mt] = e; }
            __syncthreads();
            pg8::Gemm g{(const bf16*)ACT, (const bf16*)(WDN + (size_t)l * NE * D * D), D / 2}; pg8::MoeOrder S{te_l, nmt * 4, 4, G, vcu};
            pg8::EpiDN8 E{b_down + (size_t)l * NE * D, ROWW2, et_l + 32, YB};
            pg8::gemm_phase_f8<pg8::EpiDN8, pg8::MoeOrder>(L, g, S, E, wave);
        }
        if (VK(10)) SEAM(P + 8);
        if (KIND(11) && IN(P + 9) && VK(11)) { PH_BEGIN();
            const bool lastl = (l == DEPTH - 1);
            bf16* Xw = virt ? (bf16*)(ws + WS_R) : X; bf16* Hw = virt ? (bf16*)(ws + WS_R + 128 * MiB) : H;
            int frow_v = 0;
            { const int cn = lane < NE ? __hip_atomic_load(CNT + l * NE + (lane & 31), RLX_AGENT) : 0; const int tiles = (cn + 255) >> 8; int run = 0;
#pragma unroll
              for (int e = 0; e < NE; ++e) { if (lane == e) frow_v = run * 256; run += __builtin_amdgcn_readlane(tiles, e); } }
            for (int rg = gw; rg < T / 16; rg += NGW) { const int mb = rg * 16, b = mb >> 12; const int c = 16 * lane;
                const int myslot = __hip_atomic_load(SLOT + (size_t)mb * 4 + lane, RLX_AGENT);
                f32x4 g2v[4], gna[4], a0v[4];
                { const float* g2 = MOD + ((size_t)l * NB + b) * 6144 + 5 * 1024; const float* md = MOD + ((size_t)(lastl ? l : l + 1) * NB + b) * 6144; const float* gn = lastl ? final_g : norm1_g + (l + 1) * D;
#pragma unroll
                  for (int j = 0; j < 4; ++j) { g2v[j] = *(const GAS f32x4*)(g2 + c + 4 * j); gna[j] = *(const GAS f32x4*)(gn + c + 4 * j); a0v[j] = (f32x4){0.f, 0.f, 0.f, 0.f};
                      if (!lastl) { gna[j] = gna[j] * (*(const GAS f32x4*)(md + 1024 + c + 4 * j) + 1.0f); a0v[j] = *(const GAS f32x4*)(md + c + 4 * j); } } }
                v4u xa[2][2][2], yy[2][2][4];
#define CMB_LOAD(buf, it) _Pragma("unroll") for (int q = 0; q < 2; ++q) { const size_t row_ = (size_t)(mb + 2 * (it) + q); xa[buf][q][0] = *(const GAS v4u*)(X + row_ * D + c); xa[buf][q][1] = *(const GAS v4u*)(X + row_ * D + c + 8); \
                    _Pragma("unroll") for (int k = 0; k < 4; ++k) { const int sv_ = __builtin_amdgcn_readlane(myslot, (2 * (it) + q) * 4 + k); const int sl_ = __builtin_amdgcn_readlane(frow_v, sv_ >> 20) + (sv_ & 0xFFFFF); yy[buf][q][k] = *(const GAS v4u*)(YB + (size_t)sl_ * D + c); } }
                CMB_LOAD(0, 0)
#pragma unroll
                for (int it = 0; it < 8; ++it) { const int cb = it & 1; const int m0 = mb + 2 * it;
                    if (it < 7) { CMB_LOAD(cb ^ 1, it + 1) }
                    f32x4 v[2][4];
#pragma unroll
                    for (int q = 0; q < 2; ++q) { const v4u wa = xa[cb][q][0], wb = xa[cb][q][1];
                        v[q][0] = (f32x4){bfl(wa.x), bfh(wa.x), bfl(wa.y), bfh(wa.y)}; v[q][1] = (f32x4){bfl(wa.z), bfh(wa.z), bfl(wa.w), bfh(wa.w)};
                        v[q][2] = (f32x4){bfl(wb.x), bfh(wb.x), bfl(wb.y), bfh(wb.y)}; v[q][3] = (f32x4){bfl(wb.z), bfh(wb.z), bfl(wb.w), bfh(wb.w)}; }
                    float s[2] = {0.f, 0.f};
#pragma unroll
                    for (int q = 0; q < 2; ++q)
#pragma unroll
                        for (int j = 0; j < 4; ++j) { f32x4 ys = (f32x4){0.f, 0.f, 0.f, 0.f};
#pragma unroll
                            for (int k = 0; k < 4; ++k) { const unsigned w = yy[cb][q][k][j];
                                const auto lo = __builtin_amdgcn_cvt_pk_f32_fp8((int)w, false), hi2 = __builtin_amdgcn_cvt_pk_f32_fp8((int)w, true);
                                ys.x += lo[0]; ys.y += lo[1]; ys.z += hi2[0]; ys.w += hi2[1]; }
                            v[q][j] = v[q][j] + g2v[j] * ys;
                            s[q] += (v[q][j].x * v[q][j].x + v[q][j].y * v[q][j].y) + (v[q][j].z * v[q][j].z + v[q][j].w * v[q][j].w); }
                    if (!lastl) {
#pragma unroll
                        for (int q = 0; q < 2; ++q) { v4u wa, wb; wa.x = pg8::cvt_pk_bf16(v[q][0].x, v[q][0].y); wa.y = pg8::cvt_pk_bf16(v[q][0].z, v[q][0].w); wa.z = pg8::cvt_pk_bf16(v[q][1].x, v[q][1].y); wa.w = pg8::cvt_pk_bf16(v[q][1].z, v[q][1].w);
                            wb.x = pg8::cvt_pk_bf16(v[q][2].x, v[q][2].y); wb.y = pg8::cvt_pk_bf16(v[q][2].z, v[q][2].w); wb.z = pg8::cvt_pk_bf16(v[q][3].x, v[q][3].y); wb.w = pg8::cvt_pk_bf16(v[q][3].z, v[q][3].w);
                            *(GAS v4u*)(Xw + (size_t)(m0 + q) * D + c) = wa; *(GAS v4u*)(Xw + (size_t)(m0 + q) * D + c + 8) = wb; } }
                    const float rs0 = rsqrtf(wave_sum(s[0]) * (1.0f / D) + EPS), rs1 = rsqrtf(wave_sum(s[1]) * (1.0f / D) + EPS);
                    if (!lastl) {
                        v4u h0, h1;
#pragma unroll
                        for (int j = 0; j < 4; ++j) {
                            const f32x4 y0 = (v[0][j] * rs0) * gna[j] + a0v[j], y1 = (v[1][j] * rs1) * gna[j] + a0v[j];
                            unsigned w0 = 0, w1 = 0;
                            w0 = __builtin_amdgcn_cvt_pk_fp8_f32(y0.x, y0.y, w0, false); w0 = __builtin_amdgcn_cvt_pk_fp8_f32(y0.z, y0.w, w0, true);
                            w1 = __builtin_amdgcn_cvt_pk_fp8_f32(y1.x, y1.y, w1, false); w1 = __builtin_amdgcn_cvt_pk_fp8_f32(y1.z, y1.w, w1, true);
                            h0[j] = w0; h1[j] = w1; }
                        *(GAS v4u*)((unsigned char*)Hw + (size_t)m0 * D + c) = h0; *(GAS v4u*)((unsigned char*)Hw + (size_t)(m0 + 1) * D + c) = h1;
                    } else {
#pragma unroll
                        for (int j = 0; j < 4; ++j) {
                            *(GAS f32x4*)(ap->out + (size_t)m0 * D + c + 4 * j) = v[0][j] * rs0 * gna[j]; *(GAS f32x4*)(ap->out + (size_t)(m0 + 1) * D + c + 4 * j) = v[1][j] * rs1 * gna[j]; }
                    }
                }
#undef CMB_LOAD
            }
        }
        if (VK(11)) SEAM(P + 9);
        if (virt) { PH_BEGIN();
            for (int m = 2 * gw; m < T; m += 2 * NGW) { const int b = m >> 12; const float* md = MOD + (size_t)b * 6144; norm_rows2_f8(x_in + (size_t)m * D, norm1_g, md + 1024, md, (unsigned char*)H + (size_t)m * D, lane); }
            xcd_barrier(bar); }
    }
#undef IN
#undef SEAM
}

extern "C" void kernel_launch(void* const* d_in, const int* in_sizes, int n_in, void* d_out, int out_size, void* d_ws, size_t ws_size, hipStream_t stream) {
    static int grid = 0;
    if (grid == 0) {
        if (n_in != 20 || in_sizes[0] != T * D || out_size != T * D || ws_size < WS_END) { fprintf(stderr, "kernel_launch: unexpected shapes (n_in %d, in0 %d, out %d, ws %zu < %zu); nothing launched\n", n_in, n_in > 0 ? in_sizes[0] : -1, out_size, ws_size, (size_t)WS_END); grid = -1; return; }
        int dev = 0, cus = 0, per_cu = 0;
        if (hipGetDevice(&dev) != hipSuccess || hipDeviceGetAttribute(&cus, hipDeviceAttributeMultiprocessorCount, dev) != hipSuccess) { grid = -1; return; }
        if (hipFuncSetAttribute((const void*)mk_fwd, hipFuncAttributeMaxDynamicSharedMemorySize, LDS_BYTES) != hipSuccess) { fprintf(stderr, "kernel_launch: hipFuncSetAttribute failed\n"); grid = -1; return; }
        if (hipOccupancyMaxActiveBlocksPerMultiprocessor(&per_cu, (const void*)mk_fwd, NWAVES * 64, LDS_BYTES) != hipSuccess || per_cu < 1)
            fprintf(stderr, "kernel_launch: note: occupancy query reports %d workgroups per CU\n", per_cu);
        (void)hipGetLastError();
        grid = cus < 256 ? cus : 256;
        if (grid != 256) fprintf(stderr, "kernel_launch: %d CUs; this kernel's unit deals assume 256\n", grid);
    }
    if (grid < 0) return;
    if (hipMemsetAsync((char*)d_ws + WS_CTL, 0, CTL_ZERO_BYTES, stream) != hipSuccess) { fprintf(stderr, "kernel_launch: memset failed\n"); return; }
    Args a{};
    for (int i = 0; i < 20; ++i) a.in[i] = (const float*)d_in[i];
    a.out = (float*)d_out; a.ws = (unsigned char*)d_ws; a.pad = 0;
#if MK_PER_PHASE
    for (int p = 0; p < N_PHASES; ++p) { a.ph_lo = p; a.ph_hi = p + 1; a.li = 0; hipLaunchKernelGGL(mk_fwd, dim3(grid), dim3(NWAVES * 64), LDS_BYTES, stream, a); }
#else
    a.ph_lo = 0; a.ph_hi = N_PHASES; a.li = 0;
    hipLaunchKernelGGL(mk_fwd, dim3(grid), dim3(NWAVES * 64), LDS_BYTES, stream, a);
#endif
    const hipError_t le = hipPeekAtLastError();
    if (le != hipSuccess) fprintf(stderr, "kernel_launch: launch failed: %s\n", hipGetErrorName(le));
}
```

```cpp
#include <hip/hip_runtime.h>
#include <hip/hip_bf16.h>
#include <cstdio>
#include <cstdint>
#include <cmath>

#ifndef PH_KIND_MASK
#define PH_KIND_MASK 0xFFF
#endif
#ifndef PROBE_MASK
#define PROBE_MASK 0
#endif
#ifndef PROBE_P0
#define PROBE_P0 0
#endif
#ifndef PROBE_SPIN_MASK
#define PROBE_SPIN_MASK 0
#endif
#ifndef MK_PER_PHASE
#define MK_PER_PHASE 0
#endif

constexpr int NB = 8, SEQ = 4096, T = NB * SEQ, D = 1024, DEPTH = 2;
constexpr int N_IN = 5888, NE = 32, TOPK = 4;
constexpr int NASSIGN = T * TOPK;
constexpr int MAX_MT = NASSIGN / 256 + NE;
constexpr int CAP_ROWS = MAX_MT * 256;
constexpr int GU_MAXU = 20;
constexpr float C2 = 0.125f * 1.4426950408889634f;
constexpr float LOG2E = 1.4426950408889634f;
constexpr float EPS = 1e-6f;

__device__ __forceinline__ int lane_id_asm() { int l; asm volatile("v_mbcnt_lo_u32_b32 %0, -1, 0\n\tv_mbcnt_hi_u32_b32 %0, -1, %0" : "=v"(l)); return l; }

template <int M> __device__ __forceinline__ float xsum(float v) {
    if constexpr (M < 32) return v + __int_as_float(__builtin_amdgcn_ds_swizzle(__float_as_int(v), 0x1f | (M << 10)));
    else { auto rr = __builtin_amdgcn_permlane32_swap(__float_as_uint(v), __float_as_uint(v), false, false); return __uint_as_float(rr[0]) + __uint_as_float(rr[1]); }
}
template <class Tv> __device__ __forceinline__ Tv xget32(Tv v, int hf) {
    auto rr = __builtin_amdgcn_permlane32_swap(__builtin_bit_cast(unsigned, v), __builtin_bit_cast(unsigned, v), false, false); return __builtin_bit_cast(Tv, hf ? rr[0] : rr[1]);
}

namespace pg8 {
#define PG8_LAS __attribute__((address_space(3)))
typedef unsigned short bf16_t;
typedef short bf16x8 __attribute__((ext_vector_type(8)));
typedef float f32x4 __attribute__((ext_vector_type(4)));
typedef unsigned u32x4 __attribute__((ext_vector_type(4)));
typedef unsigned u32x2 __attribute__((ext_vector_type(2)));
constexpr int BM = 256, BK = 64, HALF = 128, HTB = HALF * BK * 2, STAGE_BYTES = 8 * HTB, NXCD = 8, WGM = 8;

__host__ __device__ __forceinline__ int lds_byte(int r, int c) { const int st = (r >> 4) * 2 + (c >> 5), rr = r & 15, cc = c & 31, ob = rr * 64 + cc * 2; return st * 1024 + (ob ^ (((ob >> 9) & 1) << 5)); }
__host__ __device__ __forceinline__ void stage_rc(int b, int& R, int& C) { const int st = b / 1024, sb = b % 1024, swz = sb ^ (((sb >> 9) & 1) << 5); R = (st >> 1) * 16 + swz / 64; C = (st & 1) * 32 + (swz % 64) / 2; }
__host__ __device__ __forceinline__ int perm32(int rho) { const int n = rho >> 4, i = rho & 15; return 8 * (i >> 2) + 4 * n + (i & 3); }

struct Unit { int pm, pn; };
struct Gemm { const bf16_t* A; const bf16_t* Bt; int K; };

struct StaticOrder {
    int nM, nN, nwg, G, c;
    __device__ void init(int M, int N, int G_, int c_) { nM = M / BM; nN = N / BM; nwg = nM * nN; G = G_; c = c_; }
    __device__ __forceinline__ bool next(int i, Unit& u) const {
        const long L = (long)i * G + c; if (L >= nwg) return false;
        int wgid = (int)L; { const int q = nwg / NXCD, r = nwg % NXCD, xcd = wgid % NXCD, off = wgid / NXCD; wgid = (xcd < r ? xcd * (q + 1) : r * (q + 1) + (xcd - r) * q) + off; }
        const int nig = WGM * nN, gid = wgid / nig, fm = gid * WGM, gsz = (nM - fm) < WGM ? (nM - fm) : WGM;
        u.pm = fm + ((wgid % nig) % gsz); u.pn = (wgid % nig) / gsz; return true;
    }
};
struct MoeOrder {
    const PG8_LAS int* tile_e; int n_units, nN, G, vcu;
    __device__ __forceinline__ bool next(int i, Unit& u) const {
        const long L = (long)i * G + vcu; if (L >= n_units) return false;
        const int mt = (int)L / nN, pl = (int)L % nN; const int e = __builtin_amdgcn_readfirstlane(tile_e[mt]);
        u.pm = mt; u.pn = e * nN + pl; return true;
    }
};

__device__ __forceinline__ unsigned cvt_pk_bf16(float lo, float hi) { unsigned r; asm volatile("v_cvt_pk_bf16_f32 %0, %1, %2" : "=v"(r) : "v"(lo), "v"(hi)); return r; }
__device__ __forceinline__ float bf_lo(unsigned w) { return __uint_as_float(w << 16); }
__device__ __forceinline__ float bf_hi(unsigned w) { return __uint_as_float(w & 0xffff0000u); }
__device__ __forceinline__ float sigmoid_f(float x) { return __builtin_amdgcn_rcpf(1.0f + __builtin_amdgcn_exp2f(-LOG2E * x)); }

typedef int i32x4_t __attribute__((ext_vector_type(4)));
template <class Epi, class Sched, bool GATHER = false>
__device__ __forceinline__ void gemm_phase_f8(PG8_LAS unsigned char* lds, const Gemm g, const Sched& S, const Epi& E, const int wid_in, const PG8_LAS unsigned short* rt = nullptr) {
    int wid = wid_in; asm volatile("" : "+s"(wid));
    const int lane = lane_id_asm(), tid = wid * 64 + lane, wr = wid >> 2, wc = wid & 3, fr = lane & 15, fq = lane >> 4;
    int K_o = g.K; asm volatile("" : "+s"(K_o)); const int K = K_o, nt = K / BK;
    unsigned voff[2];
#pragma unroll
    for (int i = 0; i < 2; ++i) { int R, C; stage_rc(tid * 16 + i * 8192, R, C); voff[i] = (unsigned)(R * K + C) * 2u; }
    const size_t kstep = (size_t)(BK * 2);
    const size_t hstep = (size_t)HALF * K * 2;
    const size_t tstep = 2 * hstep;
    const unsigned ldsw = (unsigned)wid * 1024u;
    const int aoff = lds_byte(wr * 64 + fr, fq * 8), boff = lds_byte(wc * 32 + fr, fq * 8);
#define PG8_SA(b, h) (((b) * 2 + (h)) * HTB)
#define PG8_SB(b, h) ((4 + (b) * 2 + (h)) * HTB)
#define PG8_STAGE(bufoff, gbase) do { _Pragma("unroll") for (int _i = 0; _i < 2; ++_i) \
        __builtin_amdgcn_global_load_lds((const unsigned*)((const char*)(gbase) + voff[_i]), (PG8_LAS unsigned*)(lds + (bufoff) + ldsw + _i * 8192), 16, 0, 0); } while (0)
#define PG8_STAGE_A(bufoff, gbase, va, h, koff) do { if constexpr (GATHER) { _Pragma("unroll") for (int _i = 0; _i < 2; ++_i) \
        __builtin_amdgcn_global_load_lds((const unsigned*)((const char*)g.A + (size_t)((va)[h][_i] + (unsigned)(koff))), (PG8_LAS unsigned*)(lds + (bufoff) + ldsw + _i * 8192), 16, 0, 0); } else PG8_STAGE(bufoff, gbase); } while (0)
#define PG8_LOAD_VA(va, uidx) do { _Pragma("unroll") for (int _h = 0; _h < 2; ++_h) _Pragma("unroll") for (int _i = 0; _i < 2; ++_i) { int R, C; stage_rc(tid * 16 + _i * 8192, R, C); \
        (va)[_h][_i] = (unsigned)rt[(uidx) * 256 + _h * HALF + R] * (unsigned)(K * 2) + (unsigned)(C * 2); } } while (0)
#define PG8_LDA(dst, b, h) do { _Pragma("unroll") for (int m = 0; m < 4; ++m) _Pragma("unroll") for (int k = 0; k < 2; ++k) dst[m][k] = *(const PG8_LAS bf16x8*)(lds + PG8_SA(b, h) + aoff + m * 2048 + k * 1024); } while (0)
#define PG8_LDB(dst, b, h) do { _Pragma("unroll") for (int n = 0; n < 2; ++n) _Pragma("unroll") for (int k = 0; k < 2; ++k) dst[n][k] = *(const PG8_LAS bf16x8*)(lds + PG8_SB(b, h) + boff + n * 2048 + k * 1024); } while (0)
#define PG8_F8(x) __builtin_shufflevector(__builtin_bit_cast(i32x4_t, (x)[0]), __builtin_bit_cast(i32x4_t, (x)[1]), 0, 1, 2, 3, 4, 5, 6, 7)
#define PG8_MMA(ai, bj, At, Bt) do { __builtin_amdgcn_s_setprio(1); asm volatile("s_nop 1" ::: ); _Pragma("unroll") for (int m = 0; m < 4; ++m) _Pragma("unroll") for (int n = 0; n < 2; ++n) \
        asm volatile("v_mfma_f32_16x16x128_f8f6f4 %0, %1, %2, %0" : "+v"(acc[ai][bj][m][n]) : "v"(PG8_F8(Bt[n])), "v"(PG8_F8(At[m]))); __builtin_amdgcn_s_setprio(0); } while (0)
#define PG8_ACC_SETTLE asm volatile("s_nop 15\n\ts_nop 15" ::: "memory")
#define PG8_WAIT_V(n) asm volatile("s_waitcnt vmcnt(" #n ")" ::: "memory")
#define PG8_WAIT_L(n) asm volatile("s_waitcnt lgkmcnt(" #n ")" ::: "memory")
#define PG8_BAR __builtin_amdgcn_s_barrier()
#define PG8_SCHED __builtin_amdgcn_sched_barrier(0)
    Unit cur, nxt; int ui = 0; int sprev = 0;
    if (!S.next(0, cur)) return;
    f32x4 acc[2][2][4][2];
#pragma unroll
    for (int a = 0; a < 2; ++a)
#pragma unroll
        for (int b = 0; b < 2; ++b)
#pragma unroll
            for (int m = 0; m < 4; ++m)
#pragma unroll
                for (int n = 0; n < 2; ++n) acc[a][b][m][n] = (f32x4){0.f, 0.f, 0.f, 0.f};
    bf16x8 At[4][2], B0[2][2], B1[2][2];
    const char* cA = (const char*)g.A + (size_t)cur.pm * tstep; const char* cB = (const char*)g.Bt + (size_t)cur.pn * tstep;
    unsigned va_c[2][2] = {{0u, 0u}, {0u, 0u}}, va_n[2][2] = {{0u, 0u}, {0u, 0u}};
    if constexpr (GATHER) PG8_LOAD_VA(va_c, 0);
    PG8_STAGE(PG8_SB(0, 0), cB); PG8_STAGE(PG8_SB(0, 1), cB + hstep); PG8_STAGE_A(PG8_SA(0, 0), cA, va_c, 0, 0); PG8_STAGE_A(PG8_SA(0, 1), cA + hstep, va_c, 1, 0);
    if (wr == 1) PG8_BAR;
    PG8_WAIT_V(2); PG8_BAR;
    PG8_STAGE(PG8_SB(1, 0), cB + kstep); PG8_STAGE_A(PG8_SA(1, 0), cA + kstep, va_c, 0, kstep); PG8_STAGE(PG8_SB(1, 1), cB + hstep + kstep);
    PG8_WAIT_V(6); PG8_BAR;
    for (;;) {
        const bool has_next = S.next(ui + 1, nxt);
        const char* nA = has_next ? (const char*)g.A + (size_t)nxt.pm * tstep : cA; const char* nB = has_next ? (const char*)g.Bt + (size_t)nxt.pn * tstep : cB;
        if constexpr (GATHER) { if (has_next) PG8_LOAD_VA(va_n, ui + 1); }
#define PG8_WAITSEL do { if (!first) { PG8_WAIT_V(8); } else if (sprev == 4) { PG8_WAIT_V(12); } else if (sprev == 8) { PG8_WAIT_V(16); } else if (sprev == 16) { PG8_WAIT_V(24); } else { PG8_WAIT_V(40); } } while (0)
        for (int t = 0; t < nt; t += 2) {
            const bool last = (t == nt - 2);
            const bool first = (t == 0) && (sprev != 0);
            const char* a1 = cA + (size_t)(t + 1) * kstep;
            const char* a2 = last ? nA : cA + (size_t)(t + 2) * kstep; const char* b2 = last ? nB : cB + (size_t)(t + 2) * kstep;
            const char* a3 = a2 + kstep; const char* b3 = b2 + kstep;
            unsigned v2[2][2]; const unsigned k1 = (unsigned)(t + 1) * (unsigned)kstep, k2 = last ? 0u : (unsigned)(t + 2) * (unsigned)kstep;
            if constexpr (GATHER) {
#pragma unroll
                for (int h_ = 0; h_ < 2; ++h_)
#pragma unroll
                    for (int i_ = 0; i_ < 2; ++i_) v2[h_][i_] = last ? va_n[h_][i_] : va_c[h_][i_]; }
            PG8_LDB(B0, 0, 0); PG8_LDB(B1, 0, 1); PG8_SCHED; PG8_LDA(At, 0, 0); if (!first) PG8_STAGE_A(PG8_SA(1, 1), a1 + hstep, va_c, 1, k1);
            PG8_WAITSEL; PG8_WAIT_L(0); PG8_BAR; PG8_MMA(0, 0, At, B0); PG8_MMA(0, 1, At, B1); PG8_BAR; PG8_SCHED;
            PG8_LDA(At, 0, 1); PG8_STAGE(PG8_SB(0, 0), b2); PG8_STAGE(PG8_SB(0, 1), b2 + hstep); PG8_STAGE_A(PG8_SA(0, 0), a2, v2, 0, k2);
            PG8_WAITSEL; PG8_WAIT_L(0); PG8_BAR; PG8_MMA(1, 0, At, B0); PG8_MMA(1, 1, At, B1); PG8_BAR; PG8_SCHED;
            PG8_LDB(B0, 1, 0); PG8_LDB(B1, 1, 1); PG8_SCHED; PG8_LDA(At, 1, 0); PG8_STAGE_A(PG8_SA(0, 1), a2 + hstep, v2, 1, k2);
            PG8_WAITSEL; PG8_WAIT_L(0); PG8_BAR; PG8_MMA(0, 0, At, B0); PG8_MMA(0, 1, At, B1); PG8_BAR; PG8_SCHED;
            PG8_LDA(At, 1, 1); PG8_STAGE(PG8_SB(1, 0), b3); PG8_STAGE(PG8_SB(1, 1), b3 + hstep); PG8_STAGE_A(PG8_SA(1, 0), a3, v2, 0, k2 + (unsigned)kstep);
            PG8_WAIT_V(8); PG8_WAIT_L(0); PG8_BAR; PG8_MMA(1, 0, At, B0); PG8_MMA(1, 1, At, B1); PG8_BAR; PG8_SCHED;
        }
#undef PG8_WAITSEL
        if (wr == 0) PG8_BAR;
        sprev = has_next ? E.nst(cur) : 0;
        if (sprev != 0) PG8_STAGE_A(PG8_SA(1, 1), nA + kstep + hstep, va_n, 1, kstep);
        PG8_ACC_SETTLE;
        E(acc, cur, wr, wc, fr, fq);
        if (!has_next) break;
#pragma unroll
        for (int a = 0; a < 2; ++a)
#pragma unroll
            for (int b = 0; b < 2; ++b)
#pragma unroll
                for (int m = 0; m < 4; ++m)
#pragma unroll
                    for (int n = 0; n < 2; ++n) acc[a][b][m][n] = (f32x4){0.f, 0.f, 0.f, 0.f};
        cur = nxt; cA = nA; cB = nB; ++ui;
        if constexpr (GATHER) {
#pragma unroll
            for (int h_ = 0; h_ < 2; ++h_)
#pragma unroll
                for (int i_ = 0; i_ < 2; ++i_) va_c[h_][i_] = va_n[h_][i_]; }
        if (wr == 1) PG8_BAR;
    }
    PG8_WAIT_V(0);
    PG8_BAR;
#undef PG8_SA
#undef PG8_SB
#undef PG8_STAGE
#undef PG8_STAGE_A
#undef PG8_LOAD_VA
#undef PG8_LDA
#undef PG8_LDB
#undef PG8_MMA
#undef PG8_F8
#undef PG8_ACC_SETTLE
#undef PG8_WAIT_V
#undef PG8_WAIT_L
#undef PG8_BAR
#undef PG8_SCHED
}

#define EPI_ROWS(...) _Pragma("unroll") for (int ai = 0; ai < 2; ++ai) _Pragma("unroll") for (int m = 0; m < 4; ++m) { const int row = u.pm * BM + ai * HALF + wr * 64 + m * 16 + fr; __VA_ARGS__ }
__device__ __forceinline__ u32x4 pack8(const f32x4 a, const f32x4 b) { u32x4 w; w.x = cvt_pk_bf16(a[0], a[1]); w.y = cvt_pk_bf16(a[2], a[3]); w.z = cvt_pk_bf16(b[0], b[1]); w.w = cvt_pk_bf16(b[2], b[3]); return w; }

__device__ __forceinline__ u32x2 pack8_f8(const f32x4 a, const f32x4 b) { unsigned w0 = 0, w1 = 0;
    w0 = __builtin_amdgcn_cvt_pk_fp8_f32(a[0], a[1], w0, false); w0 = __builtin_amdgcn_cvt_pk_fp8_f32(a[2], a[3], w0, true);
    w1 = __builtin_amdgcn_cvt_pk_fp8_f32(b[0], b[1], w1, false); w1 = __builtin_amdgcn_cvt_pk_fp8_f32(b[2], b[3], w1, true); u32x2 r; r.x = w0; r.y = w1; return r; }
constexpr float W8_SCALE = 64.0f, W8_INV = 1.0f / 64.0f;
#define MK_QUAD(sidx, ctrl) { const unsigned as_ = (unsigned)__builtin_amdgcn_mov_dpp((int)a, ctrl, 0xf, 0xf, true), cs_ = (unsigned)__builtin_amdgcn_mov_dpp((int)c, ctrl, 0xf, 0xf, true); \
        const unsigned pr_ = ((q4 < 2 ? as_ : cs_) >> (16 * (q4 & 1))) & 0xffffu; lo |= (pr_ & 0xffu) << (8 * (sidx)); hi |= (pr_ >> 8) << (8 * (sidx)); }
__device__ __forceinline__ u32x4 widen16(const u32x2 a, const u32x2 b) {
    const auto r0 = __builtin_amdgcn_permlane16_swap(a.x, b.x, false, false), r1 = __builtin_amdgcn_permlane16_swap(a.y, b.y, false, false);
    u32x4 w; w.x = r0[0]; w.y = r1[0]; w.z = r0[1]; w.w = r1[1]; return w; }
typedef float f32x2 __attribute__((ext_vector_type(2)));
__device__ __forceinline__ f32x2 pk_fma(f32x2 a, f32x2 b, f32x2 c) { return __builtin_elementwise_fma(a, b, c); }
__device__ __forceinline__ f32x2 pk_mul(f32x2 a, f32x2 b) { return a * b; }
__device__ __forceinline__ f32x2 pk_add(f32x2 a, f32x2 b) { return a + b; }
struct EpiIn {
    __device__ __forceinline__ int nst(const Unit& u) const { const int pn = u.pn; if (pn >= 9 && pn < 14) return f8attn ? 8 : 32; if (pn == 14 && f8attn) return 32; return pn >= 15 ? 8 : 16; }
    bf16_t* aqkv; bf16_t* qb; bf16_t* kb; bf16_t* vb; bf16_t* gate; const float* qg; const float* kg; const float* rope; float asc; bool f8attn;
    __device__ __forceinline__ void operator()(const f32x4 (&acc)[2][2][4][2], const Unit& u, int wr, int wc, int fr_in, int fq_in) const {
        int fr = fr_in, fq = fq_in; asm volatile("" : "+v"(fr), "+v"(fq) :: "memory");
        const int pn = u.pn;
        if (pn >= 9 && pn < 14) {
            const bool isq = pn < 13; const int head = isq ? (pn - 9) * 4 + wc : wc; bf16_t* dst = isq ? qb : kb; const int pitch = isq ? 1024 : 256;
            const float* gvec = isq ? qg : kg; const float osc = isq ? C2 : 1.0f;
            f32x4 gv[2][2];
#pragma unroll
            for (int bj = 0; bj < 2; ++bj)
#pragma unroll
                for (int n = 0; n < 2; ++n) gv[bj][n] = *(const f32x4*)(gvec + 32 * bj + 16 * n + 4 * fq);
            f32x4 csr[2], snr[2], csc[4], snc[4];
#pragma unroll
            for (int ai = 0; ai < 2; ++ai) { const int pr = ((u.pm * BM + ai * HALF + wr * 64) & (SEQ - 1)) >> 6; csr[ai] = *(const f32x4*)(rope + pr * 16 + 4 * fq); snr[ai] = *(const f32x4*)(rope + 1024 + pr * 16 + 4 * fq); }
#pragma unroll
            for (int m = 0; m < 4; ++m) { const int pc = m * 16 + fr; csc[m] = *(const f32x4*)(rope + pc * 16 + 4 * fq); snc[m] = *(const f32x4*)(rope + 1024 + pc * 16 + 4 * fq); }
            EPI_ROWS(
                float ss = 0.f;
                _Pragma("unroll") for (int bj = 0; bj < 2; ++bj) _Pragma("unroll") for (int n = 0; n < 2; ++n) { const f32x4 x = acc[ai][bj][m][n] * asc; ss += (x[0] * x[0] + x[1] * x[1]) + (x[2] * x[2] + x[3] * x[3]); }
                ss = xsum<16>(ss); ss = xsum<32>(ss);
                const float sc = rsqrtf(ss * (1.0f / 64.0f) + EPS) * osc * asc;
                u32x4 w8;
                _Pragma("unroll") for (int bj = 0; bj < 2; ++bj) {
                    const f32x4 cs = bj == 0 ? csr[ai] : csc[m]; const f32x4 sn = bj == 0 ? snr[ai] : snc[m];
                    const f32x4 y0 = acc[ai][bj][m][0] * sc * gv[bj][0]; const f32x4 y1 = acc[ai][bj][m][1] * sc * gv[bj][1];
                    const f32x4 o0 = y0 * cs - y1 * sn; const f32x4 o1 = y1 * cs + y0 * sn;
                    if (f8attn) {
                        unsigned a = 0, b = 0; a = __builtin_amdgcn_cvt_pk_fp8_f32(o0[0], o0[1], a, false); a = __builtin_amdgcn_cvt_pk_fp8_f32(o0[2], o0[3], a, true);
                        b = __builtin_amdgcn_cvt_pk_fp8_f32(o1[0], o1[1], b, false); b = __builtin_amdgcn_cvt_pk_fp8_f32(o1[2], o1[3], b, true);
                        w8[2 * bj] = a; w8[2 * bj + 1] = b;
                    } else {
                    bf16_t* p = dst + (size_t)row * pitch + head * 64 + 32 * bj + 4 * fq;
                    u32x2 w0; w0.x = cvt_pk_bf16(o0[0], o0[1]); w0.y = cvt_pk_bf16(o0[2], o0[3]);
                    u32x2 w1; w1.x = cvt_pk_bf16(o1[0], o1[1]); w1.y = cvt_pk_bf16(o1[2], o1[3]);
                    *(u32x2*)p = w0; *(u32x2*)(p + 16) = w1; }
                }
                if (f8attn) *(u32x4*)((unsigned char*)dst + (size_t)row * pitch + head * 64 + 16 * fq) = w8;
            )
        } else if (pn == 14 && f8attn) {
            unsigned char* vt = (unsigned char*)vb;
            int q4 = fr & 3; asm volatile("" : "+v"(q4));
            EPI_ROWS(
                const int b = row >> 12; const int t = row & (SEQ - 1); const int kk = t & 63;
                const int pos4 = 32 * ((kk >> 2) & 1) + 4 * ((kk >> 3) & 3) + 16 * (kk >> 5);
                _Pragma("unroll") for (int bj = 0; bj < 2; ++bj) {
                    const int kvh = bj * 2 + (wc >> 1); const int d0 = (wc & 1) * 32 + 8 * fq;
                    const f32x4 v0 = acc[ai][bj][m][0] * asc; const f32x4 v1 = acc[ai][bj][m][1] * asc;
                    unsigned a = 0, c = 0; a = __builtin_amdgcn_cvt_pk_fp8_f32(v0[0], v0[1], a, false); a = __builtin_amdgcn_cvt_pk_fp8_f32(v0[2], v0[3], a, true);
                    c = __builtin_amdgcn_cvt_pk_fp8_f32(v1[0], v1[1], c, false); c = __builtin_amdgcn_cvt_pk_fp8_f32(v1[2], v1[3], c, true);
                    unsigned lo = 0, hi = 0;
                    MK_QUAD(0, 0x00) MK_QUAD(1, 0x55) MK_QUAD(2, 0xAA) MK_QUAD(3, 0xFF)
                    unsigned char* p = vt + ((size_t)((b * 4 + kvh) * 64 + d0 + 2 * q4) << 12) + (t & ~63) + pos4;
                    *(unsigned*)p = lo; *(unsigned*)(p + 4096) = hi;
                }
            )
        } else {
            bf16_t* dst; int pitch, colt, dsh = 0; float sc = asc; bool sig = false, fold = false;
            if (pn < 9) { dst = aqkv + (size_t)pn * T * 256; pitch = 256; colt = 0; fold = true; dsh = 2 * (pn / 3); if (pn % 3 == 0) sc = C2 * asc; }
            else if (pn == 14) { dst = vb; pitch = 256; colt = 0; }
            else { dst = gate; pitch = 2048; colt = (pn - 15) * 256; sig = true; }
            const int col0 = colt + wc * 32 + 8 * fq;
            f32x2 ks2 = {-LOG2E * asc, -LOG2E * asc}, one2 = {1.0f, 1.0f}; asm volatile("" : "+s"(ks2), "+s"(one2));
            if (sig) {
#pragma unroll
                for (int ai = 0; ai < 2; ++ai)
#pragma unroll
                    for (int mp = 0; mp < 2; ++mp)
#pragma unroll
                        for (int bj = 0; bj < 2; ++bj) { u32x2 ov[2];
#pragma unroll
                            for (int ms = 0; ms < 2; ++ms) { const int m = 2 * mp + ms; const f32x4 v0 = acc[ai][bj][m][0], v1 = acc[ai][bj][m][1]; unsigned w[2] = {0u, 0u};
#pragma unroll
                                for (int q = 0; q < 4; ++q) { const f32x4 a = q < 2 ? v0 : v1; const f32x2 t = pk_mul((f32x2){a[2 * (q & 1)], a[2 * (q & 1) + 1]}, ks2);
                                    const f32x2 d = pk_add((f32x2){__builtin_amdgcn_exp2f(t.x), __builtin_amdgcn_exp2f(t.y)}, one2); const float r0 = __builtin_amdgcn_rcpf(d.x), r1 = __builtin_amdgcn_rcpf(d.y);
                                    if (q & 1) w[q >> 1] = __builtin_amdgcn_cvt_pk_fp8_f32(r0, r1, w[q >> 1], true); else w[q >> 1] = __builtin_amdgcn_cvt_pk_fp8_f32(r0, r1, w[q >> 1], false); }
                                ov[ms].x = w[0]; ov[ms].y = w[1]; }
                            int fq1 = fq & 1; asm volatile("" : "+v"(fq1) :: "memory");
                            const int row = u.pm * BM + ai * HALF + wr * 64 + (2 * mp + fq1) * 16 + fr;
                            *(u32x4*)((unsigned char*)dst + (size_t)row * pitch + col0 + bj * HALF - 8 * fq1) = widen16(ov[0], ov[1]); }
            } else {
            EPI_ROWS(
                int drow = row;
                if (fold) { const int t = row & (SEQ - 1); drow = (row & ~(SEQ - 1)) | ((t & ((1 << dsh) - 1)) << (12 - dsh)) | (t >> dsh); }
                bf16_t* rowp = dst + (size_t)drow * pitch + col0;
                _Pragma("unroll") for (int bj = 0; bj < 2; ++bj) {
                    f32x4 v0 = acc[ai][bj][m][0], v1 = acc[ai][bj][m][1];
                    v0 = v0 * sc; v1 = v1 * sc; *(u32x4*)(rowp + bj * HALF) = pack8(v0, v1);
                }
            )
            }
        }
    }
};
struct EpiMergeA {
    __device__ __forceinline__ int nst(const Unit&) const { return 8; }
    const bf16_t* gate; bf16_t* merged;
    __device__ __forceinline__ void operator()(const f32x4 (&acc)[2][2][4][2], const Unit& u, int wr, int wc, int fr, int fq) const {
        const int col0 = u.pn * BM + wc * 32 + 8 * fq;
        f32x2 wi2 = {W8_INV, W8_INV}; asm volatile("" : "+s"(wi2));
        u32x2 gwv[2][4][2];
#pragma unroll
        for (int ai = 0; ai < 2; ++ai)
#pragma unroll
            for (int m = 0; m < 4; ++m)
#pragma unroll
                for (int bj = 0; bj < 2; ++bj) gwv[ai][m][bj] = *(const u32x2*)((const unsigned char*)gate + (size_t)(u.pm * BM + ai * HALF + wr * 64 + m * 16 + fr) * 2048 + col0 + bj * HALF);
        asm volatile("" ::: "memory");
#pragma unroll
        for (int ai = 0; ai < 2; ++ai)
#pragma unroll
            for (int mp = 0; mp < 2; ++mp)
#pragma unroll
                for (int bj = 0; bj < 2; ++bj) { u32x2 ov[2];
#pragma unroll
                    for (int ms = 0; ms < 2; ++ms) { const int m = 2 * mp + ms; const u32x2 gw = gwv[ai][m][bj];
                        const auto g01 = __builtin_amdgcn_cvt_pk_f32_fp8((int)gw.x, false), g23 = __builtin_amdgcn_cvt_pk_f32_fp8((int)gw.x, true), g45 = __builtin_amdgcn_cvt_pk_f32_fp8((int)gw.y, false), g67 = __builtin_amdgcn_cvt_pk_f32_fp8((int)gw.y, true);
                        const f32x4 a0 = acc[ai][bj][m][0], a1 = acc[ai][bj][m][1];
                        const f32x2 p0 = pk_mul(pk_mul((f32x2){a0[0], a0[1]}, wi2), (f32x2){g01[0], g01[1]}), p1 = pk_mul(pk_mul((f32x2){a0[2], a0[3]}, wi2), (f32x2){g23[0], g23[1]});
                        const f32x2 p2 = pk_mul(pk_mul((f32x2){a1[0], a1[1]}, wi2), (f32x2){g45[0], g45[1]}), p3 = pk_mul(pk_mul((f32x2){a1[2], a1[3]}, wi2), (f32x2){g67[0], g67[1]});
                        ov[ms] = pack8_f8((f32x4){p0.x, p0.y, p1.x, p1.y}, (f32x4){p2.x, p2.y, p3.x, p3.y}); }
                    const int row = u.pm * BM + ai * HALF + wr * 64 + (2 * mp + (fq & 1)) * 16 + fr;
                    *(u32x4*)((unsigned char*)merged + (size_t)row * 1024 + col0 + bj * HALF - 8 * (fq & 1)) = widen16(ov[0], ov[1]); }
        asm volatile("" ::: "memory");
    }
};
template <bool F8> struct EpiMergeB {
    __device__ __forceinline__ int nst(const Unit&) const { return 8; }
    const bf16_t* gate; const bf16_t* merged; unsigned char* m8;
    __device__ __forceinline__ void operator()(const f32x4 (&acc)[2][2][4][2], const Unit& u, int wr, int wc, int fr, int fq) const {
        const int col0 = u.pn * BM + wc * 32 + 8 * fq;
        f32x2 wi2 = {F8 ? W8_INV : 1.0f, F8 ? W8_INV : 1.0f}; asm volatile("" : "+s"(wi2));
        u32x2 gwv[2][4][2], mwv[2][4][2];
#pragma unroll
        for (int ai = 0; ai < 2; ++ai)
#pragma unroll
            for (int m = 0; m < 4; ++m)
#pragma unroll
                for (int bj = 0; bj < 2; ++bj) { const int row = u.pm * BM + ai * HALF + wr * 64 + m * 16 + fr;
                    gwv[ai][m][bj] = *(const u32x2*)((const unsigned char*)gate + (size_t)row * 2048 + 1024 + col0 + bj * HALF); mwv[ai][m][bj] = *(const u32x2*)((const unsigned char*)merged + (size_t)row * 1024 + col0 + bj * HALF); }
        asm volatile("" ::: "memory");
#pragma unroll
        for (int ai = 0; ai < 2; ++ai)
#pragma unroll
            for (int mp = 0; mp < 2; ++mp)
#pragma unroll
                for (int bj = 0; bj < 2; ++bj) { u32x2 ov[2];
#pragma unroll
                    for (int ms = 0; ms < 2; ++ms) { const int m = 2 * mp + ms; const u32x2 gw = gwv[ai][m][bj]; const u32x2 mw = mwv[ai][m][bj];
                        const auto m01 = __builtin_amdgcn_cvt_pk_f32_fp8((int)mw.x, false), m23 = __builtin_amdgcn_cvt_pk_f32_fp8((int)mw.x, true), m45 = __builtin_amdgcn_cvt_pk_f32_fp8((int)mw.y, false), m67 = __builtin_amdgcn_cvt_pk_f32_fp8((int)mw.y, true);
                        const auto g01 = __builtin_amdgcn_cvt_pk_f32_fp8((int)gw.x, false), g23 = __builtin_amdgcn_cvt_pk_f32_fp8((int)gw.x, true), g45 = __builtin_amdgcn_cvt_pk_f32_fp8((int)gw.y, false), g67 = __builtin_amdgcn_cvt_pk_f32_fp8((int)gw.y, true);
                        const f32x4 a0 = acc[ai][bj][m][0], a1 = acc[ai][bj][m][1];
                        const f32x2 p0 = pk_fma(pk_mul((f32x2){a0[0], a0[1]}, wi2), (f32x2){g01[0], g01[1]}, (f32x2){m01[0], m01[1]}), p1 = pk_fma(pk_mul((f32x2){a0[2], a0[3]}, wi2), (f32x2){g23[0], g23[1]}, (f32x2){m23[0], m23[1]});
                        const f32x2 p2 = pk_fma(pk_mul((f32x2){a1[0], a1[1]}, wi2), (f32x2){g45[0], g45[1]}, (f32x2){m45[0], m45[1]}), p3 = pk_fma(pk_mul((f32x2){a1[2], a1[3]}, wi2), (f32x2){g67[0], g67[1]}, (f32x2){m67[0], m67[1]});
                        ov[ms] = pack8_f8((f32x4){p0.x, p0.y, p1.x, p1.y}, (f32x4){p2.x, p2.y, p3.x, p3.y}); }
                    const int row = u.pm * BM + ai * HALF + wr * 64 + (2 * mp + (fq & 1)) * 16 + fr;
                    *(u32x4*)(m8 + (size_t)row * 1024 + col0 + bj * HALF - 8 * (fq & 1)) = widen16(ov[0], ov[1]); }
        asm volatile("" ::: "memory");
    }
};
struct EpiOut {
    __device__ __forceinline__ int nst(const Unit&) const { return 16; }
    const float* xin32; const bf16_t* xin16; bf16_t* xout; const float* g1;
    __device__ __forceinline__ void operator()(const f32x4 (&acc)[2][2][4][2], const Unit& u, int wr, int wc, int fr, int fq) const {
        const int col0 = u.pn * BM + wc * 32 + 8 * fq; const int b = (u.pm * BM) >> 12;
        float wi = W8_INV; asm volatile("" : "+s"(wi));
        f32x4 gv[2][2];
#pragma unroll
        for (int bj = 0; bj < 2; ++bj)
#pragma unroll
            for (int n = 0; n < 2; ++n) gv[bj][n] = *(const f32x4*)(g1 + (size_t)b * 6144 + col0 + bj * HALF + 4 * n) * wi;
        if (xin32) {
#pragma unroll
            for (int ai = 0; ai < 2; ++ai) {
                f32x4 xv[4][2][2];
#pragma unroll
                for (int m = 0; m < 4; ++m)
#pragma unroll
                    for (int bj = 0; bj < 2; ++bj) { const size_t off = (size_t)(u.pm * BM + ai * HALF + wr * 64 + m * 16 + fr) * 1024 + col0 + bj * HALF;
                        xv[m][bj][0] = __builtin_nontemporal_load((const f32x4*)(xin32 + off)); xv[m][bj][1] = __builtin_nontemporal_load((const f32x4*)(xin32 + off + 4)); }
                asm volatile("" ::: "memory");
#pragma unroll
                for (int m = 0; m < 4; ++m)
#pragma unroll
                    for (int bj = 0; bj < 2; ++bj) { const size_t off = (size_t)(u.pm * BM + ai * HALF + wr * 64 + m * 16 + fr) * 1024 + col0 + bj * HALF;
                        *(u32x4*)(xout + off) = pack8(__builtin_elementwise_fma(gv[bj][0], acc[ai][bj][m][0], xv[m][bj][0]), __builtin_elementwise_fma(gv[bj][1], acc[ai][bj][m][1], xv[m][bj][1])); }
                asm volatile("" ::: "memory");
            }
        } else {
            u32x4 xw[2][4][2];
#pragma unroll
            for (int ai = 0; ai < 2; ++ai)
#pragma unroll
                for (int m = 0; m < 4; ++m)
#pragma unroll
                    for (int bj = 0; bj < 2; ++bj) xw[ai][m][bj] = *(const u32x4*)(xin16 + (size_t)(u.pm * BM + ai * HALF + wr * 64 + m * 16 + fr) * 1024 + col0 + bj * HALF);
            asm volatile("" ::: "memory");
#pragma unroll
            for (int ai = 0; ai < 2; ++ai)
#pragma unroll
                for (int m = 0; m < 4; ++m)
#pragma unroll
                    for (int bj = 0; bj < 2; ++bj) { const size_t off = (size_t)(u.pm * BM + ai * HALF + wr * 64 + m * 16 + fr) * 1024 + col0 + bj * HALF; const u32x4 w = xw[ai][m][bj];
                        const f32x4 x0 = (f32x4){bf_lo(w.x), bf_hi(w.x), bf_lo(w.y), bf_hi(w.y)}, x1 = (f32x4){bf_lo(w.z), bf_hi(w.z), bf_lo(w.w), bf_hi(w.w)};
                        *(u32x4*)(xout + off) = pack8(__builtin_elementwise_fma(gv[bj][0], acc[ai][bj][m][0], x0), __builtin_elementwise_fma(gv[bj][1], acc[ai][bj][m][1], x1)); }
            asm volatile("" ::: "memory");
        }
    }
};
struct EpiGU8 {
    __device__ __forceinline__ int nst(const Unit&) const { return 4; }
    const float* bgu; unsigned char* act;
    __device__ __forceinline__ void operator()(const f32x4 (&acc)[2][2][4][2], const Unit& u, int wr, int wc, int fr, int fq) const {
        const int e = u.pn >> 3, pl = u.pn & 7; const int c0 = pl * 128 + wc * 32 + 8 * fq;
        const float* bp = bgu + (size_t)e * 2048 + c0;
        const f32x4 bg0 = *(const f32x4*)bp, bg1 = *(const f32x4*)(bp + 4), bl0 = *(const f32x4*)(bp + 1024), bl1 = *(const f32x4*)(bp + 1028);
        const f32x2 bg[4] = {{bg0[0], bg0[1]}, {bg0[2], bg0[3]}, {bg1[0], bg1[1]}, {bg1[2], bg1[3]}}, bl[4] = {{bl0[0], bl0[1]}, {bl0[2], bl0[3]}, {bl1[0], bl1[1]}, {bl1[2], bl1[3]}};
        f32x2 winv = {W8_INV, W8_INV}, kk = {-1.702f * LOG2E, -1.702f * LOG2E}, one2 = {1.0f, 1.0f};
        asm volatile("" : "+s"(winv), "+s"(kk), "+s"(one2));
#pragma unroll
        for (int ai = 0; ai < 2; ++ai)
#pragma unroll
            for (int mp = 0; mp < 2; ++mp) {
                u32x2 ov[2];
#pragma unroll
                for (int ms = 0; ms < 2; ++ms) { const int m = 2 * mp + ms; unsigned w[2] = {0u, 0u};
#pragma unroll
                    for (int q = 0; q < 4; ++q) {
                        const f32x4 ag = acc[ai][0][m][q >> 1], al = acc[ai][1][m][q >> 1];
                        const f32x2 gl = pk_fma((f32x2){ag[2 * (q & 1)], ag[2 * (q & 1) + 1]}, winv, bg[q]), ln = pk_fma((f32x2){al[2 * (q & 1)], al[2 * (q & 1) + 1]}, winv, bl[q]);
                        const f32x2 xg = {fminf(gl.x, 7.0f), fminf(gl.y, 7.0f)}, xl = {fminf(fmaxf(ln.x, -7.0f), 7.0f), fminf(fmaxf(ln.y, -7.0f), 7.0f)};
                        const f32x2 t = pk_mul(xg, kk); const f32x2 d = pk_add((f32x2){__builtin_amdgcn_exp2f(t.x), __builtin_amdgcn_exp2f(t.y)}, one2);
                        const f32x2 xs = pk_mul(xg, (f32x2){__builtin_amdgcn_rcpf(d.x), __builtin_amdgcn_rcpf(d.y)});
                        const f32x2 o = pk_fma(xs, xl, xs);
                        if (q & 1) w[q >> 1] = __builtin_amdgcn_cvt_pk_fp8_f32(o.x, o.y, w[q >> 1], true); else w[q >> 1] = __builtin_amdgcn_cvt_pk_fp8_f32(o.x, o.y, w[q >> 1], false);
                    }
                    ov[ms].x = w[0]; ov[ms].y = w[1]; }
                const int row = u.pm * BM + ai * HALF + wr * 64 + (2 * mp + (fq & 1)) * 16 + fr;
                *(u32x4*)(act + (size_t)row * 1024 + c0 - 8 * (fq & 1)) = widen16(ov[0], ov[1]);
            }
    }
};
struct EpiDN8 {
    __device__ __forceinline__ int nst(const Unit&) const { return 8; }
    const float* bdn; const float* roww; const PG8_LAS int* ft; unsigned char* y;
    __device__ __forceinline__ void operator()(const f32x4 (&acc)[2][2][4][2], const Unit& u, int wr, int wc, int fr, int fq) const {
        const int e = u.pn >> 2, pl = u.pn & 3; const int col0 = pl * BM + wc * 32 + 8 * fq;
        float wi = W8_INV; asm volatile("" : "+s"(wi)); const f32x4 wiv = {wi, wi, wi, wi};
        f32x4 bv[2][2];
#pragma unroll
        for (int bj = 0; bj < 2; ++bj)
#pragma unroll
            for (int n = 0; n < 2; ++n) bv[bj][n] = *(const f32x4*)(bdn + (size_t)e * 1024 + col0 + bj * HALF + 4 * n);
        float wv[2][4];
#pragma unroll
        for (int ai = 0; ai < 2; ++ai)
#pragma unroll
            for (int m = 0; m < 4; ++m) wv[ai][m] = roww[(size_t)e * T + (u.pm - ft[e]) * BM + ai * HALF + wr * 64 + m * 16 + fr];
#pragma unroll
        for (int ai = 0; ai < 2; ++ai)
#pragma unroll
            for (int mp = 0; mp < 2; ++mp)
#pragma unroll
                for (int bj = 0; bj < 2; ++bj) { u32x2 ov[2];
#pragma unroll
                    for (int ms = 0; ms < 2; ++ms) { const int m = 2 * mp + ms; const float w = wv[ai][m];
                        ov[ms] = pack8_f8(__builtin_elementwise_fma(acc[ai][bj][m][0], wiv, bv[bj][0]) * w, __builtin_elementwise_fma(acc[ai][bj][m][1], wiv, bv[bj][1]) * w); }
                    const int row = u.pm * BM + ai * HALF + wr * 64 + (2 * mp + (fq & 1)) * 16 + fr;
                    *(u32x4*)(y + (size_t)row * 1024 + col0 + bj * HALF - 8 * (fq & 1)) = widen16(ov[0], ov[1]); }
    }
};
}

namespace attn_body {
using bf16 = __hip_bfloat16;
using bf16x8 = __attribute__((ext_vector_type(8))) short;
using s16x4 = __attribute__((ext_vector_type(4))) short;
using f32x16 = __attribute__((ext_vector_type(16))) float;
using u32x4 = __attribute__((ext_vector_type(4))) unsigned;
constexpr int D = 64, NW = 8, QBLK = 32, QB = QBLK * NW, KVBLK = 64;
__device__ __forceinline__ int crow(int r, int hi) { return (r & 3) + 8 * (r >> 2) + 4 * hi; }
#define SBAR() __builtin_amdgcn_sched_barrier(0)
constexpr int NSLOT = 3, SLOTB = 8192;
constexpr int LDS_K = 0, LDS_V = NSLOT * SLOTB, LDS_WS = 2 * NSLOT * SLOTB, LDS_OST = LDS_WS + NW * 64 * 4, LDS_LUT = LDS_OST + NW * 4096, LUT_N = 768, LDS_BYTES = LDS_LUT + LUT_N * 4;
constexpr bool OB_F8 = true;
constexpr float MFLOOR = -1024.0f;
__device__ __forceinline__ void glds16(const void* gsrc, unsigned lds_dst) { unsigned keep;
  asm volatile("s_mov_b32 %0, m0\n\ts_mov_b32 m0, %2\n\ts_nop 0\n\tglobal_load_lds_dwordx4 %1, off\n\ts_mov_b32 m0, %0" : "=&s"(keep) : "v"(gsrc), "s"(lds_dst) : "memory"); }
__device__ __forceinline__ float max3f(float a, float b, float c) { float r; asm("v_max3_f32 %0, %1, %2, %3" : "=v"(r) : "v"(a), "v"(b), "v"(c)); return r; }
__device__ __forceinline__ float max2f(float a, float b) { float r; asm("v_max_f32_e32 %0, %1, %2" : "=v"(r) : "v"(a), "v"(b)); return r; }
__device__ __forceinline__ float fadd_s(float a, float b) { float r; asm("v_add_f32_e32 %0, %1, %2" : "=v"(r) : "v"(a), "v"(b)); return r; }
__device__ __forceinline__ float fsub_s(float a, float b) { float r; asm("v_sub_f32_e32 %0, %1, %2" : "=v"(r) : "v"(a), "v"(b)); return r; }
typedef float f32x2_t __attribute__((ext_vector_type(2))); typedef __bf16 bf16x2_t __attribute__((ext_vector_type(2)));
__device__ __forceinline__ unsigned cvtpk_s(float lo, float hi) { f32x2_t v = {lo, hi}; bf16x2_t b = __builtin_convertvector(v, bf16x2_t); return __builtin_bit_cast(unsigned, b); }
#define WAIT_BAR(N) asm volatile("s_waitcnt vmcnt(" #N ") lgkmcnt(0)\n\ts_barrier" ::: "memory")

__device__ __forceinline__ void qkt(f32x16& p0, f32x16& p1, const char* Kslot, const bf16x8* qr, const f32x16& negm, int r32, int hi) {
  const char* kb = Kslot + hi * 1024 + r32 * 16;
  #pragma unroll
  for (int d0 = 0; d0 < 4; ++d0) {
    const bf16x8 b0 = *reinterpret_cast<const bf16x8*>(kb + d0 * 2048);
    const bf16x8 b1 = *reinterpret_cast<const bf16x8*>(kb + d0 * 2048 + 512);
    if (d0 == 0) { p0 = __builtin_amdgcn_mfma_f32_32x32x16_bf16(b0, qr[0], negm, 0, 0, 0); p1 = __builtin_amdgcn_mfma_f32_32x32x16_bf16(b1, qr[0], negm, 0, 0, 0); }
    else { p0 = __builtin_amdgcn_mfma_f32_32x32x16_bf16(b0, qr[d0], p0, 0, 0, 0); p1 = __builtin_amdgcn_mfma_f32_32x32x16_bf16(b1, qr[d0], p1, 0, 0, 0); } }
}
typedef __attribute__((address_space(3))) const char* lds_cptr;
typedef short v4i16_t __attribute__((ext_vector_type(4)));
__device__ __forceinline__ void kload8(bf16x8* kf, lds_cptr kp) {
  kf[0] = *(const __attribute__((address_space(3))) bf16x8*)(kp);        kf[1] = *(const __attribute__((address_space(3))) bf16x8*)(kp + 512);
  kf[2] = *(const __attribute__((address_space(3))) bf16x8*)(kp + 2048); kf[3] = *(const __attribute__((address_space(3))) bf16x8*)(kp + 2560);
  kf[4] = *(const __attribute__((address_space(3))) bf16x8*)(kp + 4096); kf[5] = *(const __attribute__((address_space(3))) bf16x8*)(kp + 4608);
  kf[6] = *(const __attribute__((address_space(3))) bf16x8*)(kp + 6144); kf[7] = *(const __attribute__((address_space(3))) bf16x8*)(kp + 6656);
}
__device__ __forceinline__ void kload2(bf16x8* kf, lds_cptr kp, int j) { kf[2 * j] = *(const __attribute__((address_space(3))) bf16x8*)(kp + j * 2048); kf[2 * j + 1] = *(const __attribute__((address_space(3))) bf16x8*)(kp + j * 2048 + 512); }
__device__ __forceinline__ s16x4 vtr(lds_cptr p) { return __builtin_bit_cast(s16x4, __builtin_amdgcn_ds_read_tr16_b64_v4i16((__attribute__((address_space(3))) v4i16_t*)p)); }
__device__ __forceinline__ float rowmax(const f32x16& p0, const f32x16& p1) {
  float a = max3f(p0[0], p0[1], p1[0]), b = max3f(p0[2], p0[3], p1[1]); a = max3f(a, p1[2], p1[3]);
  #pragma unroll
  for (int r = 4; r < 16; r += 4) { a = max3f(a, p0[r], p0[r + 1]); b = max3f(b, p0[r + 2], p0[r + 3]); a = max3f(a, p1[r], p1[r + 1]); b = max3f(b, p1[r + 2], p1[r + 3]); }
  const float m = max2f(a, b);
  auto rr = __builtin_amdgcn_permlane32_swap(__float_as_uint(m), __float_as_uint(m), false, false);
  return max2f(__uint_as_float(rr[0]), __uint_as_float(rr[1]));
}
__device__ __forceinline__ void pv(f32x16* o, int vb, bf16x8 pa0, bf16x8 pa1, bf16x8 pa2, bf16x8 pa3) {
  #pragma unroll
  for (int d0 = 0; d0 < 2; ++d0) { s16x4 lo[4], hi[4];
    #pragma unroll
    for (int ks = 0; ks < 4; ++ks) {
      asm volatile("ds_read_b64_tr_b16 %0,%1 offset:%c2" : "=&v"(lo[ks]) : "v"(vb), "i"(d0 * 4096 + ks * 1024) : "memory");
      asm volatile("ds_read_b64_tr_b16 %0,%1 offset:%c2" : "=&v"(hi[ks]) : "v"(vb), "i"(d0 * 4096 + ks * 1024 + 512) : "memory"); }
    asm volatile("s_waitcnt lgkmcnt(0)" ::: "memory"); SBAR();
    #define PK(k) (bf16x8){lo[k][0], lo[k][1], lo[k][2], lo[k][3], hi[k][0], hi[k][1], hi[k][2], hi[k][3]}
    o[d0] = __builtin_amdgcn_mfma_f32_32x32x16_bf16(pa0, PK(0), o[d0], 0, 0, 0);
    o[d0] = __builtin_amdgcn_mfma_f32_32x32x16_bf16(pa1, PK(1), o[d0], 0, 0, 0);
    o[d0] = __builtin_amdgcn_mfma_f32_32x32x16_bf16(pa2, PK(2), o[d0], 0, 0, 0);
    o[d0] = __builtin_amdgcn_mfma_f32_32x32x16_bf16(pa3, PK(3), o[d0], 0, 0, 0);
    #undef PK
  }
}
struct Job { const bf16* Q; const bf16* K; const bf16* V; bf16* O; float* lse; const float* lutg; int NT, i0, kq0, dsh, cls; };
template <int MODE, int THRL, bool NOMAX = false> __device__ __forceinline__ void attn_unit(const Job& J, char* shm, const int wid_in) {
  int wid = wid_in; asm volatile("" : "+s"(wid));
  constexpr int QP = MODE == 0 ? 1024 : 256, KP = 256;
  const int lane = lane_id_asm(), tid = wid * 64 + lane, r32 = lane & 31, hi = lane >> 5;
  const bf16* Qw = J.Q + (long)(wid * QBLK) * QP;
  const bf16* Kh = J.K; const bf16* Vh = J.V;
  const unsigned lds0 = (unsigned)(uintptr_t)shm;
  float* wsf = (float*)(shm + LDS_WS) + wid * 64;
  const bf16* ksrc = Kh + (long)lane * KP + wid * 8;
  const bf16* vsrc = Vh + (long)(16 * (wid & 3) + (lane >> 2)) * KP + (wid >> 2) * 32 + (lane & 3) * 8;
  const unsigned kdst = lds0 + LDS_K + wid * 1024, vdst = lds0 + LDS_V + wid * 1024;
  #define DMA_K(t, slot) glds16(ksrc + (long)(t) * KVBLK * KP, (unsigned)__builtin_amdgcn_readfirstlane(kdst + (slot)))
  #define DMA_V(t, slot) glds16(vsrc + (long)(t) * KVBLK * KP, (unsigned)__builtin_amdgcn_readfirstlane(vdst + (slot)))
  const int vb0 = (int)(lds0 + LDS_V) + ((lane >> 4) & 1) * 32 + (lane & 3) * 8 + (4 * hi + ((lane & 15) >> 2)) * 64;
  const char* Kbase = shm + LDS_K; bf16x8 kf[8];
  const lds_cptr shm3 = (lds_cptr)shm; const lds_cptr kp0 = shm3 + LDS_K + hi * 1024 + r32 * 16; const lds_cptr vp0 = shm3 + LDS_V + ((lane >> 4) & 1) * 32 + (lane & 3) * 8 + (4 * hi + ((lane & 15) >> 2)) * 64;
  const int NT = J.NT;
  if (MODE == 1) {
    __attribute__((address_space(3))) float* lut = (__attribute__((address_space(3))) float*)(shm3 + LDS_LUT);
    lut[tid] = J.lutg[tid]; if (tid < LUT_N - 512) lut[512 + tid] = J.lutg[512 + tid];
  }
  DMA_K(0, 0); DMA_V(0, 0); DMA_K(1, SLOTB);
  bf16x8 qr[4];
  #pragma unroll
  for (int d0 = 0; d0 < 4; ++d0) qr[d0] = *reinterpret_cast<const bf16x8*>(&Qw[(long)r32 * QP + d0 * 16 + hi * 8]);
  float mhat = 0.f, l_reg = 0.f; f32x16 o[2]; o[0] = f32x16{}; o[1] = f32x16{}; f32x16 negm = f32x16{}; if (!NOMAX) asm volatile("" : "+v"(negm));
  const int qrel = wid * QBLK + r32;
  const __attribute__((address_space(3))) float* lutq = (const __attribute__((address_space(3))) float*)(shm3 + LDS_LUT) + (J.kq0 - qrel + 383 + 4 * hi);
  #define CMASK(P0, P1, t) do { if (MODE == 1) { const __attribute__((address_space(3))) float* lp_ = lutq + 64 * (t); \
      _Pragma("unroll") for (int r = 0; r < 16; ++r) { const int ko_ = (r & 3) + 8 * (r >> 2); P0[r] += lp_[ko_]; P1[r] += lp_[ko_ + 32]; } } } while (0)
  bool resc = false;
  #define START(P0, P1) do { resc = false; if (!NOMAX) { const float rm = rowmax(P0, P1); \
    const float dl = MODE == 1 ? max2f(rm, MFLOOR) : rm; mhat = fadd_s(mhat, dl); \
      _Pragma("unroll") for (int r = 0; r < 16; ++r) { P0[r] = fsub_s(P0[r], dl); P1[r] = fsub_s(P1[r], dl); } \
      _Pragma("unroll") for (int r = 0; r < 16; ++r) negm[r] = -mhat; asm volatile("" : "+v"(negm)); } \
    _Pragma("unroll") for (int r = 0; r < 16; ++r) P0[r] = __builtin_amdgcn_exp2f(P0[r]); } while (0)
  #define RESC() do { if (resc) { asm volatile("s_waitcnt lgkmcnt(0)" ::: "memory"); \
      _Pragma("unroll") for (int d_ = 0; d_ < 2; ++d_) _Pragma("unroll") for (int r = 0; r < 16; ++r) o[d_][r] *= wsf[crow(r, hi)]; } } while (0)
  f32x16 pA0, pA1, pB0, pB1;
  int sl_prev = 0, sl_cur = 0, sl_next = SLOTB;
  #define ROT() do { sl_prev = sl_cur; sl_cur = sl_next; sl_next = (sl_next == (NSLOT - 1) * SLOTB) ? 0 : sl_next + SLOTB; } while (0)
  DMA_K(2, 2 * SLOTB);
  WAIT_BAR(3);
  qkt(pA0, pA1, Kbase, qr, negm, r32, hi); asm volatile("s_nop 15\n\ts_nop 7" : "+v"(pA0), "+v"(pA1)); CMASK(pA0, pA1, 0);
  START(pA0, pA1);
  _Pragma("unroll") for (int r = 0; r < 16; ++r) pA1[r] = __builtin_amdgcn_exp2f(pA1[r]);
  WAIT_BAR(0);
  DMA_K(3, 0); DMA_V(1, SLOTB);
  ROT();
  kload8(kf, kp0 + sl_cur);
  WAIT_BAR(2);
  s16x4 vlo[8], vhi[8]; u32x4 pw0, pw1, pw2, pw3;
  #define PKW(P, B) cvtpk_s(P[B], P[B + 1])
  #define PAF(k) __builtin_bit_cast(bf16x8, pw##k)
  #define VFR(i) (bf16x8){vlo[i][0], vlo[i][1], vlo[i][2], vlo[i][3], vhi[i][0], vhi[i][1], vhi[i][2], vhi[i][3]}
  #define PIN(x) asm volatile("" : "+v"(x))
  #define MX3(a, b, c) __builtin_fmaxf(__builtin_fmaxf((a), (b)), (c))
  #define GAPA(MF, A0, A1, A2, A3, W0, W1, PW) do { MF; sacc += A0; sacc += A1; sacc += A2; sacc += A3; PIN(sacc); W0; W1; PIN(PW); SBAR(); } while (0)
  #define EX(v) __builtin_amdgcn_exp2f(v)
  #define GAPB(MF, X, B) do { MF; X[B] = EX(X[B]); X[B + 1] = EX(X[B + 1]); X[B + 2] = EX(X[B + 2]); X[B + 3] = EX(X[B + 3]); PIN(X); SBAR(); } while (0)
  #define VRD(i) do { vlo[i] = vtr(vp_ + (((i) >> 2) * 4096 + ((i) & 3) * 1024)); vhi[i] = vtr(vp_ + (((i) >> 2) * 4096 + ((i) & 3) * 1024 + 512)); } while (0)
  #define KRD(G, j) do { if (G) { kload2(kf, kp0 + sl_next, j); SBAR(); } } while (0)
  #define STEP(C0, C1, P0, P1, t, GK, GV, GL) do { SBAR(); \
    const lds_cptr vp_ = vp0 + sl_prev; \
    VRD(0); SBAR(); float sacc = (P0[0] + P0[1]); \
    GAPA(C0 = __builtin_amdgcn_mfma_f32_32x32x16_bf16(kf[0], qr[0], negm, 0, 0, 0), P0[2], P0[3], P0[4], P0[5],     pw0[0] = PKW(P0, 0), pw0[1] = PKW(P0, 2), pw0); \
    VRD(4); SBAR(); GAPA(C1 = __builtin_amdgcn_mfma_f32_32x32x16_bf16(kf[1], qr[0], negm, 0, 0, 0), P0[6], P0[7], P0[8], P0[9],     pw0[2] = PKW(P0, 4), pw0[3] = PKW(P0, 6), pw0); \
    VRD(1); SBAR(); GAPA(C0 = __builtin_amdgcn_mfma_f32_32x32x16_bf16(kf[2], qr[1], C0, 0, 0, 0),   P0[10], P0[11], P0[12], P0[13], pw1[0] = PKW(P0, 8), pw1[1] = PKW(P0, 10), pw1); \
    VRD(5); SBAR(); GAPA(C1 = __builtin_amdgcn_mfma_f32_32x32x16_bf16(kf[3], qr[1], C1, 0, 0, 0),   P0[14], P0[15], P1[0], P1[1],   pw1[2] = PKW(P0, 12), pw1[3] = PKW(P0, 14), pw1); \
    VRD(2); SBAR(); GAPA(C0 = __builtin_amdgcn_mfma_f32_32x32x16_bf16(kf[4], qr[2], C0, 0, 0, 0),   P1[2], P1[3], P1[4], P1[5],     pw2[0] = PKW(P1, 0), pw2[1] = PKW(P1, 2), pw2); \
    VRD(6); SBAR(); GAPA(C1 = __builtin_amdgcn_mfma_f32_32x32x16_bf16(kf[5], qr[2], C1, 0, 0, 0),   P1[6], P1[7], P1[8], P1[9],     pw2[2] = PKW(P1, 4), pw2[3] = PKW(P1, 6), pw2); \
    VRD(3); SBAR(); GAPA(C0 = __builtin_amdgcn_mfma_f32_32x32x16_bf16(kf[6], qr[3], C0, 0, 0, 0),   P1[10], P1[11], P1[12], P1[13], pw3[0] = PKW(P1, 8), pw3[1] = PKW(P1, 10), pw3); \
    VRD(7); SBAR(); GAPA(C1 = __builtin_amdgcn_mfma_f32_32x32x16_bf16(kf[7], qr[3], C1, 0, 0, 0),   P1[14], P1[15], 0.f, 0.f,       pw3[2] = PKW(P1, 12), pw3[3] = PKW(P1, 14), pw3); \
    l_reg += sacc; \
    if (GK) { DMA_K((t) + 3, sl_cur); } if (GV) { DMA_V((t) + 1, sl_next); } \
    CMASK(C0, C1, t); \
    if (!NOMAX) { float a = MX3(C0[0], C0[1], C1[0]), b = MX3(C0[2], C0[3], C1[1]); a = MX3(a, C1[2], C1[3]); \
      _Pragma("unroll") for (int r = 4; r < 16; r += 4) { a = MX3(a, C0[r], C0[r + 1]); b = MX3(b, C0[r + 2], C0[r + 3]); a = MX3(a, C1[r], C1[r + 1]); b = MX3(b, C1[r + 2], C1[r + 3]); } \
      float rm = __builtin_fmaxf(a, b); { auto rr = __builtin_amdgcn_permlane32_swap(__float_as_uint(rm), __float_as_uint(rm), false, false); rm = __builtin_fmaxf(__uint_as_float(rr[0]), __uint_as_float(rr[1])); } \
      resc = false; \
      if (__builtin_expect(__any(rm > (float)THRL), 0)) { const float dl = __builtin_fmaxf(rm, 0.f); mhat += dl; \
        _Pragma("unroll") for (int r = 0; r < 16; ++r) { C0[r] -= dl; C1[r] -= dl; } \
        _Pragma("unroll") for (int r = 0; r < 16; ++r) negm[r] = -mhat; asm volatile("" : "+v"(negm)); \
        const float f = __builtin_amdgcn_exp2f(-dl); l_reg *= f; if (hi == 0) wsf[r32] = f; resc = true; } } \
    SBAR(); \
    GAPB(o[0] = __builtin_amdgcn_mfma_f32_32x32x16_bf16(PAF(0), VFR(0), o[0], 0, 0, 0), C0, 0); \
    GAPB(o[1] = __builtin_amdgcn_mfma_f32_32x32x16_bf16(PAF(0), VFR(4), o[1], 0, 0, 0), C0, 4); \
    KRD(GL, 0); GAPB(o[0] = __builtin_amdgcn_mfma_f32_32x32x16_bf16(PAF(1), VFR(1), o[0], 0, 0, 0), C0, 8); \
    KRD(GL, 1); GAPB(o[1] = __builtin_amdgcn_mfma_f32_32x32x16_bf16(PAF(1), VFR(5), o[1], 0, 0, 0), C0, 12); \
    KRD(GL, 2); GAPB(o[0] = __builtin_amdgcn_mfma_f32_32x32x16_bf16(PAF(2), VFR(2), o[0], 0, 0, 0), C1, 0); \
    KRD(GL, 3); GAPB(o[1] = __builtin_amdgcn_mfma_f32_32x32x16_bf16(PAF(2), VFR(6), o[1], 0, 0, 0), C1, 4); \
    GAPB(o[0] = __builtin_amdgcn_mfma_f32_32x32x16_bf16(PAF(3), VFR(3), o[0], 0, 0, 0), C1, 8); \
    GAPB(o[1] = __builtin_amdgcn_mfma_f32_32x32x16_bf16(PAF(3), VFR(7), o[1], 0, 0, 0), C1, 12); \
    } while (0)
  int t = 1;
  for (; t + 5 < NT; t += 2) {
    STEP(pB0, pB1, pA0, pA1, t, true, true, true);     WAIT_BAR(2); RESC(); ROT();
    STEP(pA0, pA1, pB0, pB1, t + 1, true, true, true); WAIT_BAR(2); RESC(); ROT();
  }
  #define ENDW(tt) do { if ((tt) + 3 < NT) { WAIT_BAR(2); } else if ((tt) + 2 < NT) { WAIT_BAR(1); } else { WAIT_BAR(0); } } while (0)
  for (; t + 1 < NT; t += 2) {
    STEP(pB0, pB1, pA0, pA1, t, (t + 3 < NT), (t + 1 < NT), (t + 1 < NT));       ENDW(t);     RESC(); ROT();
    STEP(pA0, pA1, pB0, pB1, t + 1, (t + 4 < NT), (t + 2 < NT), (t + 2 < NT));   ENDW(t + 1); RESC(); ROT();
  }
  STEP(pB0, pB1, pA0, pA1, NT - 1, false, false, false); RESC();
  { float sacc = pB0[0] + pB0[1]; _Pragma("unroll") for (int r = 2; r < 16; ++r) sacc += pB0[r]; _Pragma("unroll") for (int r = 0; r < 16; ++r) sacc += pB1[r]; l_reg += sacc;
    pw0 = (u32x4){PKW(pB0, 0), PKW(pB0, 2), PKW(pB0, 4), PKW(pB0, 6)}; pw1 = (u32x4){PKW(pB0, 8), PKW(pB0, 10), PKW(pB0, 12), PKW(pB0, 14)}; pw2 = (u32x4){PKW(pB1, 0), PKW(pB1, 2), PKW(pB1, 4), PKW(pB1, 6)}; pw3 = (u32x4){PKW(pB1, 8), PKW(pB1, 10), PKW(pB1, 12), PKW(pB1, 14)};
    SBAR(); pv(o, vb0 + sl_cur, PAF(0), PAF(1), PAF(2), PAF(3)); }
  #undef PKW
  #undef PAF
  #undef VFR
  #undef PIN
  #undef MX3
  #undef GAPA
  #undef GAPB
  #undef EX
  #undef VRD
  #undef KRD
  #undef STEP
  #undef ENDW
  { auto rr = __builtin_amdgcn_permlane32_swap(__float_as_uint(l_reg), __float_as_uint(l_reg), false, false); l_reg = __uint_as_float(rr[0]) + __uint_as_float(rr[1]); }
  if (hi == 0) wsf[32 + r32] = l_reg; asm volatile("s_waitcnt lgkmcnt(0)" ::: "memory");
  float rli[16];
  #pragma unroll
  for (int r = 0; r < 16; ++r) rli[r] = __builtin_amdgcn_rcpf(wsf[32 + crow(r, hi)]);
  if (MODE == 0 && OB_F8) {
    unsigned char* stg8 = (unsigned char*)(shm + LDS_OST) + wid * 4096;
    #pragma unroll
    for (int r = 0; r < 16; ++r) { const int orow = crow(r, hi);
      #pragma unroll
      for (int d0 = 0; d0 < 2; ++d0) { const float ov = o[d0][r] * rli[r]; stg8[orow * 64 + d0 * 32 + r32] = (unsigned char)(__builtin_amdgcn_cvt_pk_fp8_f32(ov, ov, 0, false) & 0xff); } }
    asm volatile("s_waitcnt lgkmcnt(0)" ::: "memory");
    unsigned char* Ow = (unsigned char*)J.O + (long)(wid * QBLK) * 1024;
    #pragma unroll
    for (int i = 0; i < 2; ++i) { const int row = i * 16 + (lane >> 2), ch = lane & 3; const u32x4 v = *(const u32x4*)(stg8 + row * 64 + ch * 16); *(u32x4*)(Ow + (long)row * 1024 + ch * 16) = v; }
  } else {
    bf16* stg = (bf16*)(shm + LDS_OST) + wid * 2048;
    #pragma unroll
    for (int r = 0; r < 16; ++r) { const int orow = crow(r, hi);
      #pragma unroll
      for (int d0 = 0; d0 < 2; ++d0) stg[orow * 64 + d0 * 32 + r32] = __float2bfloat16(o[d0][r] * rli[r]); }
    asm volatile("s_waitcnt lgkmcnt(0)" ::: "memory");
    if (MODE == 0) {
      bf16* Ow = J.O + (long)(wid * QBLK) * 1024;
      #pragma unroll
      for (int i = 0; i < 4; ++i) { const int row = i * 8 + (lane >> 3), ch = lane & 7; const u32x4 v = *(const u32x4*)(stg + row * 64 + ch * 8); *(u32x4*)(Ow + (long)row * 1024 + ch * 8) = v; }
    } else {
      #pragma unroll
      for (int i = 0; i < 4; ++i) { const int row = i * 8 + (lane >> 3), ch = lane & 7; const u32x4 v = *(const u32x4*)(stg + row * 64 + ch * 8);
        const long tok = ((long)(J.i0 + wid * QBLK + row) << J.dsh) + J.cls; *(u32x4*)(J.O + tok * 256 + ch * 8) = v; }
      if (hi == 0) { const long tok = ((long)(J.i0 + qrel) << J.dsh) + J.cls; J.lse[tok * 4] = mhat + __builtin_amdgcn_logf(l_reg); }
    } }
  asm volatile("s_waitcnt lgkmcnt(0)\n\ts_barrier" ::: "memory");
  #undef DMA_K
  #undef DMA_V
  #undef CMASK
  #undef START
  #undef RESC
  #undef ROT
}
#undef SBAR
#undef WAIT_BAR
}


namespace attn8 {
typedef int i32x8 __attribute__((ext_vector_type(8)));
typedef int i32x4 __attribute__((ext_vector_type(4)));
typedef float f32x16 __attribute__((ext_vector_type(16)));
typedef unsigned u32x4 __attribute__((ext_vector_type(4)));
constexpr int SLOT = 4096, RING = 8, NSL = RING;
constexpr int L_K = 0, L_V = NSL * SLOT, L_WS = 2 * NSL * SLOT, L_OST = L_WS + 8 * 256, L_BYTES = L_OST + 8 * 4096;
struct Job { const unsigned char* Q; const unsigned char* K; const unsigned char* VT; unsigned char* O; };
__device__ __forceinline__ void glds16(const void* gsrc, unsigned lds_dst) { unsigned keep;
  asm volatile("s_mov_b32 %0, m0\n\ts_mov_b32 m0, %2\n\ts_nop 0\n\tglobal_load_lds_dwordx4 %1, off\n\ts_mov_b32 m0, %0" : "=&s"(keep) : "v"(gsrc), "s"(lds_dst) : "memory"); }
__device__ __forceinline__ int crow(int r, int hi) { return (r & 3) + 8 * (r >> 2) + 4 * hi; }
#define A8_WAITBAR(N) asm volatile("s_waitcnt vmcnt(" #N ") lgkmcnt(0)\n\ts_barrier" ::: "memory")
#define A8_WAITBAR_N(N) asm volatile("s_waitcnt vmcnt(%0) lgkmcnt(0)\n\ts_barrier" :: "n"(N) : "memory")
template <int NT> __device__ __forceinline__ void attn_unit_f8(const Job& J, char* shm, const int wid_in) {
  int wid = wid_in; asm volatile("" : "+s"(wid));
  const int lane = lane_id_asm(), r32 = lane & 31, hi = lane >> 5;
  const unsigned lds0 = (unsigned)(uintptr_t)shm;
  typedef __attribute__((address_space(3))) const char* lds_cptr;
  const lds_cptr shm3 = (lds_cptr)shm;
  const bool kwave = wid < 4;
  const int w4 = wid & 3; const int drow = 16 * w4 + (lane >> 2); const int cl = (lane & 3) ^ ((drow >> 2) & 3);
  const unsigned char* dsrc = kwave ? J.K + (long)drow * 256 + 16 * cl : J.VT + (long)drow * 4096 + 16 * cl;
  const long dstep = kwave ? 64 * 256 : 64;
  const unsigned ddst = lds0 + (kwave ? L_K : L_V) + w4 * 1024;
  #define A8_DMA(t, slot) glds16(dsrc + (long)(t) * dstep, (unsigned)__builtin_amdgcn_readfirstlane(ddst + (slot)))
  const int sw = (r32 >> 2) & 3; const int foff0 = r32 * 64 + 16 * ((2 * hi) ^ sw), foff1 = r32 * 64 + 16 * ((2 * hi + 1) ^ sw);
  #define A8_FRAG(base, half) __builtin_shufflevector(*(const __attribute__((address_space(3))) i32x4*)((base) + (half) * 2048 + foff0), *(const __attribute__((address_space(3))) i32x4*)((base) + (half) * 2048 + foff1), 0, 1, 2, 3, 4, 5, 6, 7)
  const unsigned char* qp = J.Q + (long)(wid * 32 + r32) * 1024 + 32 * hi;
  const i32x8 qf = __builtin_shufflevector(*(const i32x4*)qp, *(const i32x4*)(qp + 16), 0, 1, 2, 3, 4, 5, 6, 7);
  if (kwave) { _Pragma("unroll") for (int i = 0; i < RING; ++i) A8_DMA(i, i * SLOT); } else { _Pragma("unroll") for (int i = 0; i < RING - 2; ++i) A8_DMA(i, i * SLOT); }
  f32x16 o0 = f32x16{}, o1 = f32x16{}, o2 = f32x16{}; const f32x16 zero = f32x16{};
  int one_w = 0x38383838; asm volatile("" : "+v"(one_w));
  i32x8 ones; _Pragma("unroll") for (int w = 0; w < 8; ++w) ones[w] = one_w;
  asm volatile("" : "+v"(ones));
  f32x16 SA0, SA1, SB0, SB1; i32x8 PA, PB;
  A8_WAITBAR_N(RING - 1);
  { const i32x8 k0 = A8_FRAG(shm3 + L_K, 0), k1 = A8_FRAG(shm3 + L_K, 1);
    SA0 = __builtin_amdgcn_mfma_scale_f32_32x32x64_f8f6f4(k0, qf, zero, 0, 0, 0, 0, 0, 0); SA1 = __builtin_amdgcn_mfma_scale_f32_32x32x64_f8f6f4(k1, qf, zero, 0, 0, 0, 0, 0, 0); }
  #define A8_SB() __builtin_amdgcn_sched_barrier(0)
  #define A8_SLOTOF(i) ((((i) + RING) & (RING - 1)) * SLOT)
  #define A8_EXP8(X, B) do { _Pragma("unroll") for (int r = 0; r < 8; ++r) X[(B) + r] = __builtin_amdgcn_exp2f(X[(B) + r]); asm volatile("" : "+v"(X)); } while (0)
  #define A8_CVT4(P, WB, X) do { _Pragma("unroll") for (int w = 0; w < 4; ++w) { unsigned a_ = (unsigned)P[(WB) + w];     \
      a_ = __builtin_amdgcn_cvt_pk_bf8_f32(X[4 * w], X[4 * w + 1], a_, false); a_ = __builtin_amdgcn_cvt_pk_bf8_f32(X[4 * w + 2], X[4 * w + 3], a_, true); P[(WB) + w] = (int)a_; } asm volatile("" : "+v"(P)); } while (0)
  #define A8_STEP(C0, C1, N0, N1, PP, PN, t, WK, WV, DK, DV, QK, PV, EX) do { \
    if (kwave) { A8_WAITBAR_N(WK); } else { A8_WAITBAR_N(WV); } \
    if (kwave) { if (DK) A8_DMA((t) + RING, A8_SLOTOF(t)); } else { if (DV) A8_DMA((t) - 2 + RING, A8_SLOTOF((t) - 2)); } \
    i32x8 k0_ = ones, k1_ = ones, v0_ = ones, v1_ = ones; \
    if (QK) { k0_ = A8_FRAG(shm3 + L_K + A8_SLOTOF((t) + 1), 0); k1_ = A8_FRAG(shm3 + L_K + A8_SLOTOF((t) + 1), 1); } \
    if (PV) { v0_ = A8_FRAG(shm3 + L_V + A8_SLOTOF((t) - 1), 0); v1_ = A8_FRAG(shm3 + L_V + A8_SLOTOF((t) - 1), 1); } \
    A8_SB(); \
    if (EX) A8_EXP8(C0, 0); A8_SB(); \
    if (QK) { __builtin_amdgcn_s_setprio(1); N0 = __builtin_amdgcn_mfma_scale_f32_32x32x64_f8f6f4(k0_, qf, zero, 0, 0, 0, 0, 0, 0); __builtin_amdgcn_s_setprio(0); } if (EX) A8_EXP8(C0, 8); A8_SB(); \
    if (QK) { __builtin_amdgcn_s_setprio(1); N1 = __builtin_amdgcn_mfma_scale_f32_32x32x64_f8f6f4(k1_, qf, zero, 0, 0, 0, 0, 0, 0); __builtin_amdgcn_s_setprio(0); } if (EX) A8_EXP8(C1, 0); A8_SB(); \
    if (PV) { __builtin_amdgcn_s_setprio(1); o0 = __builtin_amdgcn_mfma_scale_f32_32x32x64_f8f6f4(PP, v0_, o0, 1, 0, 0, 0, 0, 0); __builtin_amdgcn_s_setprio(0); } if (EX) A8_EXP8(C1, 8); A8_SB(); \
    if (PV) { __builtin_amdgcn_s_setprio(1); o1 = __builtin_amdgcn_mfma_scale_f32_32x32x64_f8f6f4(PP, v1_, o1, 1, 0, 0, 0, 0, 0); __builtin_amdgcn_s_setprio(0); } if (EX) A8_CVT4(PN, 0, C0); A8_SB(); \
    if (PV) { __builtin_amdgcn_s_setprio(1); o2 = __builtin_amdgcn_mfma_scale_f32_32x32x64_f8f6f4(PP, ones, o2, 1, 0, 0, 0, 0, 0); __builtin_amdgcn_s_setprio(0); } if (EX) A8_CVT4(PN, 4, C1); A8_SB();     \
  } while (0)
  #define A8_EVEN(t, WK, WV, DK, DV, QK, PV, EX) A8_STEP(SA0, SA1, SB0, SB1, PB, PA, t, WK, WV, DK, DV, QK, PV, EX)
  #define A8_ODD(t, WK, WV, DK, DV, QK, PV, EX)  A8_STEP(SB0, SB1, SA0, SA1, PA, PB, t, WK, WV, DK, DV, QK, PV, EX)
  PA = ones; PB = ones;
  static_assert(RING == 8 && NT % 2 == 0 && NT >= 2 * RING, "the peeled tail below is written for RING = 8");
  A8_EVEN(0, 6, 6, true, true, true, false, true);
#pragma unroll 1
  for (int t = 1; t < NT - 9; t += 2) {
    A8_ODD(t, 6, 6, true, true, true, true, true);
    A8_EVEN(t + 1, 6, 6, true, true, true, true, true);
  }
  A8_ODD(NT - 9, 6, 6, true, true, true, true, true);
  A8_EVEN(NT - 8, 6, 6, false, true, true, true, true);
  A8_ODD(NT - 7, 5, 6, false, true, true, true, true);
  A8_EVEN(NT - 6, 4, 6, false, false, true, true, true);
  A8_ODD(NT - 5, 3, 5, false, false, true, true, true);
  A8_EVEN(NT - 4, 2, 4, false, false, true, true, true);
  A8_ODD(NT - 3, 1, 3, false, false, true, true, true);
  A8_EVEN(NT - 2, 0, 2, false, false, true, true, true);
  A8_ODD(NT - 1, 0, 1, false, false, false, true, true);
  A8_EVEN(NT, 0, 0, false, false, false, true, false);
  #undef A8_EVEN
  #undef A8_ODD
  #undef A8_STEP
  #undef A8_EXP8
  #undef A8_CVT4
  #undef A8_SB
  #undef A8_SLOTOF
  #undef A8_FRAG
  #undef A8_DMA
  float rli[16];
  #pragma unroll
  for (int r = 0; r < 16; ++r) rli[r] = __builtin_amdgcn_rcpf(o2[r]);
  unsigned char* stg8 = (unsigned char*)(shm + L_OST) + wid * 4096;
  #pragma unroll
  for (int r = 0; r < 16; ++r) { const int orow = crow(r, hi);
    const float a = o0[r] * rli[r], b = o1[r] * rli[r];
    stg8[orow * 64 + r32] = (unsigned char)(__builtin_amdgcn_cvt_pk_fp8_f32(a, a, 0, false) & 0xff); stg8[orow * 64 + 32 + r32] = (unsigned char)(__builtin_amdgcn_cvt_pk_fp8_f32(b, b, 0, false) & 0xff); }
  asm volatile("s_waitcnt lgkmcnt(0)" ::: "memory");
  unsigned char* Ow = J.O + (long)(wid * 32) * 1024;
  #pragma unroll
  for (int i = 0; i < 2; ++i) { const int row = i * 16 + (lane >> 2), ch = lane & 3; const u32x4 v = *(const u32x4*)(stg8 + row * 64 + ch * 16); *(u32x4*)(Ow + (long)row * 1024 + ch * 16) = v; }
  asm volatile("s_waitcnt lgkmcnt(0)\n\ts_barrier" ::: "memory");
}
#undef A8_WAITBAR
#undef A8_WAITBAR_N
}

constexpr size_t MiB = 1u << 20;
constexpr size_t WS_CTL = 0, CTL_ZERO_BYTES = 1 * MiB;
constexpr size_t WS_CNT = 512 * 1024;
constexpr size_t WS_MOD = 1 * MiB;
constexpr size_t WS_ROPE = WS_MOD + 512 * 1024;
constexpr size_t WS_BLUT = WS_ROPE + 8192;
constexpr size_t WS_RC0 = WS_BLUT + 12 * 768 * 4;
constexpr size_t WS_HIST = WS_RC0 + 4096;
constexpr size_t WS_TILEE = WS_HIST + 32768;
constexpr size_t WS_TOPE = 2 * MiB;
constexpr size_t WS_TOPW = WS_TOPE + 512 * 1024;
constexpr size_t WS_SLOT = WS_TOPW + 512 * 1024;
constexpr size_t WS_ROWW = WS_SLOT + 512 * 1024;
constexpr size_t WS_ROWTOK = 4 * MiB + 256 * 1024;
constexpr size_t WS_LSE = 5 * MiB;
constexpr size_t WS_WRHI = 7 * MiB;
constexpr size_t WS_WRLO = 8 * MiB;
constexpr size_t WS_WIN = 9 * MiB;
constexpr size_t WS_WBRA = 32 * MiB;
constexpr size_t WS_WBRB = 33 * MiB;
constexpr size_t WS_WOUT = 37 * MiB;
constexpr size_t WS_WGU = 41 * MiB;
constexpr size_t WS_WDN = 297 * MiB;
constexpr size_t WS_X = 425 * MiB;
constexpr size_t WS_H = 553 * MiB;
constexpr size_t WS_R = 617 * MiB;
constexpr size_t WS_AQKV = WS_R;
constexpr size_t WS_QB = WS_R + 144 * MiB;
constexpr size_t WS_KB = WS_R + 208 * MiB;
constexpr size_t WS_VB = WS_R + 224 * MiB;
constexpr size_t WS_GATE = WS_R + 240 * MiB;
constexpr size_t WS_OAG = WS_R + 368 * MiB;
constexpr size_t WS_OA = WS_R + 416 * MiB;
constexpr size_t WS_MERGED = WS_R + 432 * MiB;
constexpr size_t WS_XS = WS_R;
constexpr size_t WS_ACT = WS_R + 136 * MiB;
constexpr size_t WS_Y = WS_R + 272 * MiB;
constexpr size_t WS_OB = WS_R + 496 * MiB;
constexpr size_t WS_M8 = WS_R + 560 * MiB;
constexpr size_t WS_END = WS_R + 592 * MiB;
constexpr int CW_BAR = 4096;

constexpr int RING_BYTES = 133120;
constexpr int LDSCTL_OFF = RING_BYTES;
constexpr int LDS_BYTES = 147456;
constexpr int NWAVES = 8;

#define GAS __attribute__((address_space(1)))
#define LAS __attribute__((address_space(3)))
typedef unsigned short bf16;
typedef unsigned v4u __attribute__((ext_vector_type(4)));
typedef unsigned v2u __attribute__((ext_vector_type(2)));
typedef float f32x4 __attribute__((ext_vector_type(4)));
typedef float f32x16 __attribute__((ext_vector_type(16)));
typedef int i32x4 __attribute__((ext_vector_type(4)));
typedef short bf16x8 __attribute__((ext_vector_type(8)));
typedef GAS unsigned gu32;
#define RLX_AGENT __ATOMIC_RELAXED, __HIP_MEMORY_SCOPE_AGENT
#define LDS_WAIT() asm volatile("s_waitcnt lgkmcnt(0)" ::: "memory")
__device__ __forceinline__ unsigned f2bf(float f) { unsigned u = __builtin_bit_cast(unsigned, f); return (u + 0x7fffu + ((u >> 16) & 1u)) >> 16; }
__device__ __forceinline__ unsigned pk2(float lo, float hi) { return f2bf(lo) | (f2bf(hi) << 16); }
__device__ __forceinline__ float bfl(unsigned w) { return __uint_as_float(w << 16); }
__device__ __forceinline__ float bfh(unsigned w) { return __uint_as_float(w & 0xffff0000u); }

#define XB_TMO      128
#define XB_XCNT(j)  (256  + 64 * (j))
#define XB_XSUB(j)  (1280 + 64 * (j))
#define XB_XGEN(j)  (2304 + 64 * (j))
#define XB_TOP      3328
#define XB_TOPGEN   3392
#define XCD_BAR_WORDS 3456
#define XB_SPIN_CAP (1u << 18)
__device__ __forceinline__ unsigned xb_ld(unsigned* p)              { return __hip_atomic_load(p, __ATOMIC_RELAXED, __HIP_MEMORY_SCOPE_AGENT); }
__device__ __forceinline__ unsigned xb_add(unsigned* p, unsigned v) { return __hip_atomic_fetch_add(p, v, __ATOMIC_RELAXED, __HIP_MEMORY_SCOPE_AGENT); }
__device__ __forceinline__ unsigned xb_xcc_id() { return (unsigned)__builtin_amdgcn_s_getreg((3 << 11) | 20) & 0xFu; }
#define XB_SPIN(cond, bar) do { unsigned _sp = 0; while (cond) { __builtin_amdgcn_s_sleep(1); \
    if ((++_sp & 255u) == 0u) { if (xb_ld(&(bar)[XB_TMO])) break; if (_sp > XB_SPIN_CAP) { atomicAdd(&(bar)[XB_TMO], 1u); break; } } } } while (0)
struct XcdBarrier { unsigned* bar; unsigned x; volatile LAS unsigned* st; };
__device__ __forceinline__ XcdBarrier xcd_barrier_post(unsigned* bar, volatile LAS unsigned* st) {
    XcdBarrier b; b.bar = bar; b.x = xb_xcc_id(); b.st = st;
    if (threadIdx.x == 0) (void)xb_add(&bar[XB_XCNT(b.x)], 1u);
    return b;
}
__device__ __forceinline__ void xcd_barrier_complete(unsigned* bar, unsigned x, unsigned& nloc, unsigned& nx) {
    const unsigned G = gridDim.x * gridDim.y * gridDim.z;
    unsigned sum, cnt, mine, sp = 0u;
    for (;;) {
        sum = 0u; cnt = 0u; mine = 0u;
#pragma unroll
        for (unsigned j = 0; j < 16; ++j) { const unsigned c = xb_ld(&bar[XB_XCNT(j)]); sum += c; cnt += (c > 0u) ? 1u : 0u; mine = (j == x) ? c : mine; }
        if (sum == G) break;
        __builtin_amdgcn_s_sleep(1);
        if ((++sp & 255u) == 0u) { if (xb_ld(&bar[XB_TMO])) break; if (sp > XB_SPIN_CAP) { atomicAdd(&bar[XB_TMO], 1u); break; } }
    }
    nloc = mine > 0u ? mine : 1u; nx = cnt > 0u ? cnt : 1u;
}
__device__ __forceinline__ void xcd_barrier(const XcdBarrier& b) {
    asm volatile("s_waitcnt vmcnt(0)" ::: "memory");
    __syncthreads();
    if (threadIdx.x == 0) {
        unsigned* bar = b.bar;
        __builtin_amdgcn_s_waitcnt(0);
        unsigned nloc = b.st[0], nx = b.st[1];
        if (nloc == 0u) { xcd_barrier_complete(bar, b.x, nloc, nx); b.st[0] = nloc; b.st[1] = nx; }
        const unsigned old = xb_add(&bar[XB_XSUB(b.x)], 1u);
        const unsigned gen = old / nloc;
        if (old + 1u == (gen + 1u) * nloc) {
            __builtin_amdgcn_fence(__ATOMIC_RELEASE, "agent");
            asm volatile("s_waitcnt vmcnt(0)" ::: "memory");
            const unsigned og = xb_add(&bar[XB_TOP], 1u);
            const unsigned tg = og / nx;
            if (og + 1u == (tg + 1u) * nx) xb_add(&bar[XB_TOPGEN], 1u);
            else XB_SPIN(xb_ld(&bar[XB_TOPGEN]) == tg, bar);
            __builtin_amdgcn_fence(__ATOMIC_ACQUIRE, "agent");
            xb_add(&bar[XB_XGEN(b.x)], 1u);
            asm volatile("s_waitcnt vmcnt(0)" ::: "memory");
        } else {
            XB_SPIN(xb_ld(&bar[XB_XGEN(b.x)]) == gen, bar);
            __builtin_amdgcn_fence(__ATOMIC_ACQUIRE, "agent");
            asm volatile("s_waitcnt vmcnt(0)" ::: "memory");
        }
    }
    __syncthreads();
}

__device__ __forceinline__ float wave_sum(float v) {
    v = xsum<1>(v); v = xsum<2>(v); v = xsum<4>(v); v = xsum<8>(v); v = xsum<16>(v); v = xsum<32>(v);
    return v;
}
struct CvtItem { const float* W; unsigned char* WT; int ldw, K, srcA, srcB, dst_row0, k0; bool ident; };
__device__ __forceinline__ void cvt_load_f8(const CvtItem& I, int lane, f32x4 (&v)[16]) {
    const int kq = lane >> 4, nq = lane & 15; const int scol = (nq < 8 ? I.srcA + 4 * nq : I.srcB + 4 * (nq - 8));
#pragma unroll
    for (int i = 0; i < 16; ++i) v[i] = __builtin_nontemporal_load((const GAS f32x4*)(I.W + (size_t)(I.k0 + 4 * i + kq) * I.ldw + scol));
}
__device__ __forceinline__ void cvt_store_f8(const CvtItem& I, const f32x4 (&v)[16], LAS float* scr, int lane) {
    const int kq = lane >> 4, nq = lane & 15;
#pragma unroll
    for (int i = 0; i < 16; ++i)
#pragma unroll
        for (int e = 0; e < 4; ++e) scr[(4 * i + kq) * 65 + 4 * nq + e] = v[i][e] * pg8::W8_SCALE;
    LDS_WAIT(); asm volatile("" ::: "memory");
    const int c = lane & 7, rr = lane >> 3;
#pragma unroll
    for (int j = 0; j < 8; ++j) { const int rho = rr + 8 * j; const int sc = (rho & 32) + (I.ident ? (rho & 31) : pg8::perm32(rho & 31)); const LAS float* s = scr + (8 * c) * 65 + sc;
        unsigned w0 = 0, w1 = 0;
        w0 = __builtin_amdgcn_cvt_pk_fp8_f32(s[0 * 65], s[1 * 65], w0, false); w0 = __builtin_amdgcn_cvt_pk_fp8_f32(s[2 * 65], s[3 * 65], w0, true);
        w1 = __builtin_amdgcn_cvt_pk_fp8_f32(s[4 * 65], s[5 * 65], w1, false); w1 = __builtin_amdgcn_cvt_pk_fp8_f32(s[6 * 65], s[7 * 65], w1, true);
        v2u o; o.x = w0; o.y = w1; *(GAS v2u*)(I.WT + (size_t)(I.dst_row0 + rho) * I.K + I.k0 + 8 * c) = o; }
    LDS_WAIT(); asm volatile("" ::: "memory");
}
__device__ __forceinline__ int win_src(int X) { const int pn = X >> 3, bj = (X >> 2) & 1, wc = X & 3; return (pn >= 9 && pn < 14) ? pn * 256 + 64 * wc + 32 * bj : 32 * X; }
__device__ __forceinline__ int wgu_src(int X) { const int pn = X >> 3, bj = (X >> 2) & 1, wc = X & 3; return bj * 1024 + 128 * pn + 32 * wc; }

__device__ __forceinline__ void norm_rows2_f8(const float* xrow, const float* g, const float* sc, const float* sh, unsigned char* orow, int lane) {
    const float* xr = xrow + 16 * lane;
    f32x4 v[2][4]; float s0 = 0.f, s1 = 0.f;
#pragma unroll
    for (int j = 0; j < 4; ++j) { v[0][j] = *(const GAS f32x4*)(xr + 4 * j); v[1][j] = *(const GAS f32x4*)(xr + D + 4 * j); }
#pragma unroll
    for (int j = 0; j < 4; ++j) { s0 += (v[0][j].x * v[0][j].x + v[0][j].y * v[0][j].y) + (v[0][j].z * v[0][j].z + v[0][j].w * v[0][j].w); s1 += (v[1][j].x * v[1][j].x + v[1][j].y * v[1][j].y) + (v[1][j].z * v[1][j].z + v[1][j].w * v[1][j].w); }
    const float rs0 = rsqrtf(wave_sum(s0) * (1.0f / D) + EPS), rs1 = rsqrtf(wave_sum(s1) * (1.0f / D) + EPS);
    v4u h0, h1; const int c = 16 * lane;
#pragma unroll
    for (int j = 0; j < 4; ++j) {
        const f32x4 gg = *(const GAS f32x4*)(g + c + 4 * j), a1 = *(const GAS f32x4*)(sc + c + 4 * j) + 1.0f, a0 = *(const GAS f32x4*)(sh + c + 4 * j);
        const f32x4 y0 = (v[0][j] * rs0 * gg) * a1 + a0, y1 = (v[1][j] * rs1 * gg) * a1 + a0;
        unsigned w0 = 0, w1 = 0;
        w0 = __builtin_amdgcn_cvt_pk_fp8_f32(y0.x, y0.y, w0, false); w0 = __builtin_amdgcn_cvt_pk_fp8_f32(y0.z, y0.w, w0, true);
        w1 = __builtin_amdgcn_cvt_pk_fp8_f32(y1.x, y1.y, w1, false); w1 = __builtin_amdgcn_cvt_pk_fp8_f32(y1.z, y1.w, w1, true);
        h0[j] = w0; h1[j] = w1; }
    *(GAS v4u*)(orow + c) = h0; *(GAS v4u*)(orow + D + c) = h1;
}

__device__ __forceinline__ bool gqa_bound_ok(const float* qg, const float* kg, int lane) {
    float gq = fabsf(qg[lane]), gk = fabsf(kg[lane]);
#define MK_MAXSTEP(m) gq = fmaxf(gq, __int_as_float(__builtin_amdgcn_ds_swizzle(__float_as_int(gq), 0x1f | ((m) << 10)))); gk = fmaxf(gk, __int_as_float(__builtin_amdgcn_ds_swizzle(__float_as_int(gk), 0x1f | ((m) << 10))))
    MK_MAXSTEP(1); MK_MAXSTEP(2); MK_MAXSTEP(4); MK_MAXSTEP(8); MK_MAXSTEP(16);
#undef MK_MAXSTEP
    gq = fmaxf(gq, xget32(gq, lane >> 5)); gk = fmaxf(gk, xget32(gk, lane >> 5));
    const float bound = 64.0f * gq * gk * C2 * 1.01f; return __builtin_amdgcn_readfirstlane((int)(bound <= 14.0f)) != 0;
}

struct Args { const float* in[20]; float* out; unsigned char* ws; int ph_lo, ph_hi, li, pad; };
constexpr int N_PHASES = 2 + 10 * DEPTH;

typedef const __attribute__((address_space(4))) Args* kargs_t;
__device__ __forceinline__ kargs_t kargs_opaque() { kargs_t p = (kargs_t)__builtin_amdgcn_kernarg_segment_ptr(); asm volatile("" : "+s"(p)); return p; }
#define PH_BEGIN() kargs_t ap = kargs_opaque(); unsigned char* ws = ap->ws; (void)ws; \
    int wave = wave_s; asm volatile("" : "+s"(wave)); const int lane = lane_id_asm(); const int tid = wave * 64 + lane; (void)lane; (void)tid; \
    int bx = blockIdx.x; asm volatile("" : "+s"(bx)); int G = gridDim.x; asm volatile("" : "+s"(G)); const int vcu = (G % 8 == 0) ? (bx % 8) * (G / 8) + bx / 8 : bx; (void)vcu; \
    const int gw = vcu * NWAVES + wave, NGW = G * NWAVES; (void)gw; (void)NGW; const int gtid = vcu * (NWAVES * 64) + tid, NGT = G * NWAVES * 64; (void)gtid; (void)NGT
#define INP(k) (ap->in[k])
#define x_in INP(0)
#define c_in INP(1)
#define w_ada INP(2)
#define b_ada INP(3)
#define norm1_g INP(4)
#define w_in INP(5)
#define q_norm_g INP(6)
#define k_norm_g INP(7)
#define rel_bias INP(8)
#define w_br_a INP(9)
#define w_br_b INP(10)
#define w_out INP(11)
#define norm2_g INP(12)
#define w_router INP(13)
#define b_router INP(14)
#define w_gate_up INP(15)
#define b_gate_up INP(16)
#define w_down INP(17)
#define b_down INP(18)
#define final_g INP(19)
#define MOD ((float*)(ws + WS_MOD))
#define ROPE ((float*)(ws + WS_ROPE))
#define BLUT ((float*)(ws + WS_BLUT))
#define RC0 ((float*)(ws + WS_RC0))
#define HIST ((int*)(ws + WS_HIST))
#define TILEE ((int*)(ws + WS_TILEE))
#define TOPE ((int*)(ws + WS_TOPE))
#define TOPW ((float*)(ws + WS_TOPW))
#define SLOT ((int*)(ws + WS_SLOT))
#define ROWW ((float*)(ws + WS_ROWW))
#define ROWTOK ((int*)(ws + WS_ROWTOK))
#define CNT ((int*)(ws + WS_CNT))
#define ROWTOK2 ((int*)(ws + WS_XS))
#define ROWW2 ((float*)(ws + WS_XS + 4 * MiB))
#define LSE ((float*)(ws + WS_LSE))
#define WRHI ((bf16*)(ws + WS_WRHI))
#define WRLO ((bf16*)(ws + WS_WRLO))
#define WIN ((unsigned char*)(ws + WS_WIN))
#define WBRA ((unsigned char*)(ws + WS_WBRA))
#define WBRB ((unsigned char*)(ws + WS_WBRB))
#define WOUT ((unsigned char*)(ws + WS_WOUT))
#define WGU ((unsigned char*)(ws + WS_WGU))
#define WDN ((unsigned char*)(ws + WS_WDN))
#define X ((bf16*)(ws + WS_X))
#define H ((bf16*)(ws + WS_H))
#define H8 ((unsigned char*)(ws + WS_H))
#define AQKV ((bf16*)(ws + WS_AQKV))
#define QB ((bf16*)(ws + WS_QB))
#define KB ((bf16*)(ws + WS_KB))
#define VB ((bf16*)(ws + WS_VB))
#define GATE ((bf16*)(ws + WS_GATE))
#define OAG ((bf16*)(ws + WS_OAG))
#define OA ((unsigned char*)(ws + WS_OA))
#define MERGED ((bf16*)(ws + WS_MERGED))
#define OB ((unsigned char*)(ws + WS_OB))
#define M8 ((unsigned char*)(ws + WS_M8))
#define XS ((unsigned char*)(ws + WS_XS))
#define ACT ((unsigned char*)(ws + WS_ACT))
#define YB ((unsigned char*)(ws + WS_Y))
__global__ void __launch_bounds__(NWAVES * 64, 2) mk_fwd(Args args) {
    extern __shared__ __attribute__((aligned(16))) unsigned char lds[];
    LAS unsigned char* L = (LAS unsigned char*)lds;
    volatile LAS unsigned* MISC = (volatile LAS unsigned*)(L + LDSCTL_OFF);
    gu32* ctl = (gu32*)(args.ws + WS_CTL);
    const int wave_s = __builtin_amdgcn_readfirstlane(threadIdx.x >> 6);
    for (int u = threadIdx.x; u < (LDS_BYTES - LDSCTL_OFF) / 4; u += NWAVES * 64) ((LAS unsigned*)(L + LDSCTL_OFF))[u] = 0u;
    __syncthreads();
    XcdBarrier bar; bar.bar = (unsigned*)(ctl + CW_BAR) + args.li * XCD_BAR_WORDS; bar.x = 0; bar.st = nullptr;
    if (!MK_PER_PHASE) bar = xcd_barrier_post((unsigned*)(ctl + CW_BAR) + args.li * XCD_BAR_WORDS, MISC + 8);
    const int lo = args.ph_lo, hi = args.ph_hi;
    unsigned long long t_prev = PROBE_SPIN_MASK ? __builtin_amdgcn_s_memrealtime() : 0ull; (void)t_prev;
#define IN(k) (lo <= (k) && (k) < hi)
#define KIND(q) ((PH_KIND_MASK >> (q)) & 1)
#define SEAM(k) SEAMK(k, ((k) < 2 ? (k) : 2 + ((k) - 2) % 10))
#define SEAMK(k, kind) do { if (IN(k) && IN((k) + 1)) { xcd_barrier(bar); \
    if (PROBE_SPIN_MASK) { if (blockIdx.x == 0) { if (threadIdx.x == 0) { const unsigned long long tn_ = __builtin_amdgcn_s_memrealtime(); \
          if ((PROBE_SPIN_MASK >> (kind)) & 1) { const unsigned long long te_ = tn_ + 9ull * (tn_ - t_prev); while (__builtin_amdgcn_s_memrealtime() < te_) __builtin_amdgcn_s_sleep(8); } } \
        __syncthreads(); } t_prev = __builtin_amdgcn_s_memrealtime(); } } } while (0)

    for (int rep0 = 0; rep0 < 1 + PROBE_P0; ++rep0) {
    if (KIND(0) && IN(0)) { PH_BEGIN();
        {
            LAS float* cact = (LAS float*)L;
            LAS float* part = (LAS float*)(L + 32768);
            for (int i = tid; i < NB * D; i += NWAVES * 64) { const float cv = c_in[i]; cact[i] = cv / (1.0f + __expf(-cv)); }
            __syncthreads();
            for (int vb = bx; vb < 256; vb += G) {
                const int gc0 = vb * 48; const int l = gc0 / 6144, col0 = gc0 % 6144;
                const int kq = lane / 12, c4 = lane % 12;
                if (lane < 48) {
                    const float* wp = w_ada + (size_t)l * D * 6144 + col0 + 4 * c4 + (size_t)(wave * 128 + kq) * 6144;
                    f32x4 w[32];
#pragma unroll
                    for (int i = 0; i < 32; ++i) w[i] = *(const GAS f32x4*)(wp + (size_t)(4 * i) * 6144);
                    f32x4 a[NB];
#pragma unroll
                    for (int b = 0; b < NB; ++b) a[b] = (f32x4){0.f, 0.f, 0.f, 0.f};
#pragma unroll
                    for (int i = 0; i < 32; ++i) { const int k = wave * 128 + 4 * i + kq;
#pragma unroll
                        for (int b = 0; b < NB; ++b) a[b] += w[i] * cact[b * D + k]; }
#pragma unroll
                    for (int b = 0; b < NB; ++b) *(LAS f32x4*)(part + ((wave * 4 + kq) * NB + b) * 48 + 4 * c4) = a[b];
                }
                __syncthreads();
                if (tid < NB * 48) { const int b = tid / 48, cl = tid % 48;
                    float s = b_ada[l * 6144 + col0 + cl];
#pragma unroll 8
                    for (int q = 0; q < 32; ++q) s += part[(q * NB + b) * 48 + cl];
                    MOD[((size_t)l * NB + b) * 6144 + col0 + cl] = s; }
                __syncthreads();
            }
        }
        for (int i = gtid; i < 1024 + 12 * 768; i += NGT) {
            if (i < 1024) { const int p = i >> 4, f = i & 15; const double inv = pow(10000.0, -(double)f / 16.0); const double ang = (double)p * inv; ROPE[i] = (float)cos(ang); ROPE[1024 + i] = (float)sin(ang); }
            else { const int j = i - 1024; const int hh = j / 768, di = j % 768; const int delta = di - 383; const int g = hh >> 2; const int dil = g == 0 ? 1 : (g == 1 ? 4 : 16);
                float val = -INFINITY;
                if (delta >= -64 && delta <= 64) { const int rel = delta * dil; const int n = rel < 0 ? -rel : rel; int bk = rel > 0 ? 16 : 0;
                    if (n < 8) bk += n; else { int lg = 8 + (int)(logf((float)n / 8.0f) / logf(128.0f) * 8.0f); if (lg > 15) lg = 15; bk += lg; }
                    val = rel_bias[bk * 12 + hh] * LOG2E; }
                BLUT[j] = val; }
        }
        {
            LAS float* scr = (LAS float*)(L + wave * 16640);
            __syncthreads();
            constexpr int I_IN = 16 * 92, I_BRA = 4 * 16, I_BRB = 16 * 16, I_OUT = 16 * 16, I_GU = 16 * 32, I_DN = 16 * 16;
            constexpr int PER_L = I_IN + I_BRA + I_BRB + I_OUT;
            constexpr int NITEMS = DEPTH * PER_L + DEPTH * NE * (I_GU + I_DN);
#define CVT_DECODE(I, it_) do { int r = (it_); \
                if (r < DEPTH * PER_L) { const int l = r / PER_L; r %= PER_L; \
                    if (r < I_IN) { const int kb = r / 92, g64 = r % 92; I = CvtItem{w_in + (size_t)l * D * N_IN, WIN + (size_t)l * N_IN * D, N_IN, D, win_src(2 * g64), win_src(2 * g64 + 1), 64 * g64, 64 * kb, (g64 >> 2) >= 9 && (g64 >> 2) < 14}; break; } r -= I_IN; \
                    if (r < I_BRA) { const int kb = r / 16, g64 = r % 16; I = CvtItem{w_br_a + (size_t)l * 256 * D, WBRA + (size_t)l * D * 256, D, 256, 64 * g64, 64 * g64 + 32, 64 * g64, 64 * kb, false}; break; } r -= I_BRA; \
                    if (r < I_BRB) { const int kb = r / 16, g64 = r % 16; I = CvtItem{w_br_b + (size_t)l * D * D, WBRB + (size_t)l * D * D, D, D, 64 * g64, 64 * g64 + 32, 64 * g64, 64 * kb, false}; break; } r -= I_BRB; \
                    { const int kb = r / 16, g64 = r % 16; I = CvtItem{w_out + (size_t)l * D * D, WOUT + (size_t)l * D * D, D, D, 64 * g64, 64 * g64 + 32, 64 * g64, 64 * kb, false}; break; } } \
                r -= DEPTH * PER_L; \
                if (r < DEPTH * NE * I_GU) { const int le = r / I_GU; r %= I_GU; const int kb = r / 32, g64 = r % 32; \
                    I = CvtItem{w_gate_up + (size_t)le * D * 2048, WGU + (size_t)le * 2048 * D, 2048, D, wgu_src(2 * g64), wgu_src(2 * g64 + 1), 64 * g64, 64 * kb, false}; break; } \
                r -= DEPTH * NE * I_GU; \
                { const int le = r / I_DN; r %= I_DN; const int kb = r / 16, g64 = r % 16; I = CvtItem{w_down + (size_t)le * D * D, WDN + (size_t)le * D * D, D, D, 64 * g64, 64 * g64 + 32, 64 * g64, 64 * kb, false}; } } while (0)
            CvtItem ia, ib; f32x4 va[16], vb[16];
            int it = gw;
            if (it < NITEMS) { CVT_DECODE(ia, it); cvt_load_f8(ia, lane, va); }
            for (; it < NITEMS; it += 2 * NGW) {
                const bool h1 = it + NGW < NITEMS;
                if (h1) { CVT_DECODE(ib, it + NGW); cvt_load_f8(ib, lane, vb); }
                cvt_store_f8(ia, va, scr, lane);
                if (it + 2 * NGW < NITEMS) { CVT_DECODE(ia, it + 2 * NGW); cvt_load_f8(ia, lane, va); }
                if (h1) cvt_store_f8(ib, vb, scr, lane);
            }
#undef CVT_DECODE
        }
    }
    SEAM(0);
    }
    if (KIND(1) && IN(1)) { PH_BEGIN();
        for (int rg = gw; rg < T / 16; rg += NGW) { const int mb = rg * 16, b = mb >> 12, c = 16 * lane; const float* md = MOD + (size_t)b * 6144;
            f32x4 gna[4], a0v[4];
#pragma unroll
            for (int j = 0; j < 4; ++j) { gna[j] = *(const GAS f32x4*)(norm1_g + c + 4 * j) * (*(const GAS f32x4*)(md + 1024 + c + 4 * j) + 1.0f); a0v[j] = *(const GAS f32x4*)(md + c + 4 * j); }
            f32x4 xv[2][2][4];
#define N1_LOAD(buf, it) _Pragma("unroll") for (int q = 0; q < 2; ++q) _Pragma("unroll") for (int j = 0; j < 4; ++j) xv[buf][q][j] = __builtin_nontemporal_load((const GAS f32x4*)(x_in + (size_t)(mb + 2 * (it) + q) * D + c + 4 * j))
            N1_LOAD(0, 0);
#pragma unroll
            for (int it = 0; it < 8; ++it) { const int cb = it & 1;
                if (it < 7) { N1_LOAD(cb ^ 1, it + 1); }
                float s0 = 0.f, s1 = 0.f;
#pragma unroll
                for (int j = 0; j < 4; ++j) { const f32x4 u = xv[cb][0][j], w = xv[cb][1][j]; s0 += (u.x * u.x + u.y * u.y) + (u.z * u.z + u.w * u.w); s1 += (w.x * w.x + w.y * w.y) + (w.z * w.z + w.w * w.w); }
                const float rs0 = rsqrtf(wave_sum(s0) * (1.0f / D) + EPS), rs1 = rsqrtf(wave_sum(s1) * (1.0f / D) + EPS);
                v4u h0, h1;
#pragma unroll
                for (int j = 0; j < 4; ++j) { const f32x4 y0 = (xv[cb][0][j] * rs0) * gna[j] + a0v[j], y1 = (xv[cb][1][j] * rs1) * gna[j] + a0v[j];
                    unsigned w0 = 0, w1 = 0;
                    w0 = __builtin_amdgcn_cvt_pk_fp8_f32(y0.x, y0.y, w0, false); w0 = __builtin_amdgcn_cvt_pk_fp8_f32(y0.z, y0.w, w0, true);
                    w1 = __builtin_amdgcn_cvt_pk_fp8_f32(y1.x, y1.y, w1, false); w1 = __builtin_amdgcn_cvt_pk_fp8_f32(y1.z, y1.w, w1, true);
                    h0[j] = w0; h1[j] = w1; }
                *(GAS v4u*)(H8 + (size_t)(mb + 2 * it) * D + c) = h0; *(GAS v4u*)(H8 + (size_t)(mb + 2 * it + 1) * D + c) = h1;
            }
#undef N1_LOAD
        }
        for (int i = gtid; i < DEPTH * NB * NE * D; i += NGT) { const int k = i & 1023, e = (i >> 10) & 31, b = (i >> 15) & 7, l = i >> 18;
            const float v = norm2_g[l * D + k] * (1.0f + MOD[((size_t)l * NB + b) * 6144 + 4 * 1024 + k]) * w_router[((size_t)l * D + k) * NE + e];
            const unsigned hb = f2bf(v); const float lv = v - __uint_as_float(hb << 16);
            { const int s_ = 2 * (k >> 6) + ((k >> 3) & 1), kb_ = (k >> 4) & 3, j_ = k & 7, h_ = e >> 4, i_ = e & 15;
              const size_t o = (size_t)(l * NB + b) * 65536 + (size_t)((s_ * 2 + h_) * 2) * 512 + (kb_ * 16 + i_) * 8 + j_;
              WRHI[o] = (bf16)hb; WRHI[o + 512] = (bf16)f2bf(lv); } }
        for (int i = gw; i < DEPTH * NB * NE; i += NGW) { const int e = i & 31, b = (i >> 5) & 7, l = i >> 8; float s = 0.f;
            for (int k = lane; k < D; k += 64) s += MOD[((size_t)l * NB + b) * 6144 + 3 * 1024 + k] * w_router[((size_t)l * D + k) * NE + e];
            s = wave_sum(s); if (lane == 0) RC0[i] = s + b_router[l * NE + e]; }
    }
    SEAM(1);

    for (int li = (PROBE_MASK ? -1 : 0); li < DEPTH; ++li) {
        const int l = li < 0 ? 0 : li; const bool virt = li < 0;
        const int P = 2 + 10 * l;
#define VK(q) (!virt || ((PROBE_MASK >> (q)) & 1))
        if (KIND(2) && IN(P + 0) && VK(2)) { PH_BEGIN();
            pg8::Gemm g{H, (const bf16*)(WIN + (size_t)l * N_IN * D), D / 2}; pg8::StaticOrder S; S.init(T, N_IN, G, bx);
            const bool f8attn = gqa_bound_ok(q_norm_g + l * 64, k_norm_g + l * 64, lane);
            pg8::EpiIn E{AQKV, QB, KB, VB, GATE, q_norm_g + l * 64, k_norm_g + l * 64, ROPE, pg8::W8_INV, f8attn};
            pg8::gemm_phase_f8<pg8::EpiIn, pg8::StaticOrder>(L, g, S, E, wave);
        }
        if (VK(2)) SEAM(P + 0);
        if (KIND(3) && IN(P + 1) && VK(3)) { PH_BEGIN();
            namespace ab = attn_body;
            const bool nomax = gqa_bound_ok(q_norm_g + l * 64, k_norm_g + l * 64, lane);
            for (int j = 0; j < 8; ++j) {
                const int uidx = vcu * 8 + j; if (uidx >= 2048) break;
                const int pair = uidx >> 6, idx = uidx & 63; const int b = pair >> 2, kvh = pair & 3, hq = idx >> 4, qb = idx & 15; const int h = kvh * 4 + hq;
                ab::Job J; J.Q = (const ab::bf16*)QB + ((size_t)b * SEQ + qb * 256) * 1024 + h * 64; J.K = (const ab::bf16*)KB + (size_t)b * SEQ * 256 + kvh * 64; J.V = (const ab::bf16*)VB + (size_t)b * SEQ * 256 + kvh * 64;
                J.O = (ab::bf16*)(OB + ((size_t)b * SEQ + qb * 256) * 1024 + h * 64)  ; J.lse = nullptr; J.lutg = nullptr; J.NT = 64; J.i0 = 0; J.kq0 = 0; J.dsh = 0; J.cls = 0;
                if (nomax) { attn8::Job J8; J8.Q = (const unsigned char*)QB + ((size_t)b * SEQ + qb * 256) * 1024 + h * 64; J8.K = (const unsigned char*)KB + (size_t)b * SEQ * 256 + kvh * 64;
                    J8.VT = (const unsigned char*)VB + ((size_t)((b * 4 + kvh) * 64) << 12); J8.O = OB + ((size_t)b * SEQ + qb * 256) * 1024 + h * 64;
                    attn8::attn_unit_f8<64>(J8, (char*)lds, wave); }
                else ab::attn_unit<0, 8, false>(J, (char*)lds, wave);
            }
            for (int j = 0; j < 6; ++j) {
                const int uidx = vcu * 6 + j; if (uidx >= 1536) break;
                const int g = uidx / 512, r = uidx % 512; const int b = r >> 6, hs = (r >> 4) & 3, combo = r & 15;
                const int dsh = 2 * g; const int Lc = SEQ >> dsh; const int nqb = Lc >> 8;
                const int cls = combo / nqb, qb = combo % nqb; const int i0 = qb * 256;
                int t0 = (i0 >> 6) - 1; const int ntile = Lc >> 6; const int NT = ntile >= 6 ? 6 : 4; if (t0 < 0) t0 = 0; if (t0 > ntile - NT) t0 = ntile - NT;
                const size_t cbase = (size_t)b * SEQ + (size_t)cls * Lc;
                const ab::bf16* aq = (const ab::bf16*)AQKV + (size_t)(g * 3 + 0) * T * 256; const ab::bf16* ak = (const ab::bf16*)AQKV + (size_t)(g * 3 + 1) * T * 256; const ab::bf16* av = (const ab::bf16*)AQKV + (size_t)(g * 3 + 2) * T * 256;
                ab::Job J; J.Q = aq + (cbase + i0) * 256 + hs * 64; J.K = ak + (cbase + t0 * 64) * 256 + hs * 64; J.V = av + (cbase + t0 * 64) * 256 + hs * 64;
                J.O = (ab::bf16*)OAG + (size_t)g * T * 256 + (size_t)b * SEQ * 256 + hs * 64; J.lse = LSE + (size_t)g * T * 4 + (size_t)b * SEQ * 4 + hs; J.lutg = BLUT + (g * 4 + hs) * 768;
                J.NT = NT; J.i0 = i0; J.kq0 = t0 * 64 - i0; J.dsh = dsh; J.cls = cls;
                ab::attn_unit<1, 8>(J, (char*)lds, wave);
            }
        }
        if (VK(3)) SEAM(P + 1);
        if (KIND(5) && IN(P + 3) && VK(5)) { PH_BEGIN();
            pg8::StaticOrder S; S.init(T, D, G, bx);
#define LC_ITEM_W(u_) const float mx = fmaxf(l0[u_], fmaxf(l1[u_], l2[u_])); float w0 = exp2f(l0[u_] - mx), w1 = exp2f(l1[u_] - mx), w2 = exp2f(l2[u_] - mx); const float inv = 1.0f / (w0 + w1 + w2); w0 *= inv; w1 *= inv; w2 *= inv; \
                        unsigned o0 = 0, o1 = 0;     \
                        o0 = __builtin_amdgcn_cvt_pk_fp8_f32(w0 * bfl(a[u_].x) + w1 * bfl(bq[u_].x) + w2 * bfl(cq[u_].x), w0 * bfh(a[u_].x) + w1 * bfh(bq[u_].x) + w2 * bfh(cq[u_].x), o0, false); \
                        o0 = __builtin_amdgcn_cvt_pk_fp8_f32(w0 * bfl(a[u_].y) + w1 * bfl(bq[u_].y) + w2 * bfl(cq[u_].y), w0 * bfh(a[u_].y) + w1 * bfh(bq[u_].y) + w2 * bfh(cq[u_].y), o0, true); \
                        o1 = __builtin_amdgcn_cvt_pk_fp8_f32(w0 * bfl(a[u_].z) + w1 * bfl(bq[u_].z) + w2 * bfl(cq[u_].z), w0 * bfh(a[u_].z) + w1 * bfh(bq[u_].z) + w2 * bfh(cq[u_].z), o1, false); \
                        o1 = __builtin_amdgcn_cvt_pk_fp8_f32(w0 * bfl(a[u_].w) + w1 * bfl(bq[u_].w) + w2 * bfl(cq[u_].w), w0 * bfh(a[u_].w) + w1 * bfh(bq[u_].w) + w2 * bfh(cq[u_].w), o1, true); \
                        v2u o; o.x = o0; o.y = o1; *(GAS v2u*)(OA + (size_t)t * 256 + ch * 8) = o;
#define LC_LOAD(u_, i_) { const int t = (i_) >> 5, ch = (i_) & 31, hs = ch >> 3; l0[u_] = LSE[(size_t)t * 4 + hs]; l1[u_] = LSE[(size_t)T * 4 + (size_t)t * 4 + hs]; l2[u_] = LSE[(size_t)2 * T * 4 + (size_t)t * 4 + hs]; \
                        a[u_] = *(const GAS v4u*)(OAG + (size_t)t * 256 + ch * 8); bq[u_] = *(const GAS v4u*)(OAG + (size_t)T * 256 + (size_t)t * 256 + ch * 8); cq[u_] = *(const GAS v4u*)(OAG + (size_t)2 * T * 256 + (size_t)t * 256 + ch * 8); }
            { int prev_pm = -1; pg8::Unit uu;
              for (int iu = 0; S.next(iu, uu); ++iu) { if (uu.pm == prev_pm) continue; prev_pm = uu.pm;
                for (int j0 = tid; j0 < 256 * 32; j0 += 4 * NWAVES * 64) {
                    float l0[4], l1[4], l2[4]; v4u a[4], bq[4], cq[4];
#pragma unroll
                    for (int u = 0; u < 4; ++u) LC_LOAD(u, uu.pm * (256 * 32) + j0 + u * (NWAVES * 64))
#pragma unroll
                    for (int u = 0; u < 4; ++u) { const int i = uu.pm * (256 * 32) + j0 + u * (NWAVES * 64); const int t = i >> 5, ch = i & 31; LC_ITEM_W(u) }
                } }
              asm volatile("s_waitcnt vmcnt(0)" ::: "memory"); __syncthreads(); }
#undef LC_ITEM_W
#undef LC_LOAD
            { pg8::Gemm g{(const bf16*)OA, (const bf16*)(WBRA + (size_t)l * D * 256), 128}; pg8::EpiMergeA E{GATE, MERGED}; pg8::gemm_phase_f8<pg8::EpiMergeA, pg8::StaticOrder>(L, g, S, E, wave); }
            { pg8::Gemm g{(const bf16*)OB, (const bf16*)(WBRB + (size_t)l * D * D), D / 2}; pg8::EpiMergeB<true> E{GATE, MERGED, M8}; pg8::gemm_phase_f8<pg8::EpiMergeB<true>, pg8::StaticOrder>(L, g, S, E, wave); }
        }
        if (VK(5)) SEAM(P + 3);
        if (KIND(6) && IN(P + 4) && VK(6)) { PH_BEGIN();
            pg8::Gemm g{(const bf16*)M8, (const bf16*)(WOUT + (size_t)l * D * D), D / 2}; pg8::StaticOrder S; S.init(T, D, G, bx);
            pg8::EpiOut E{l == 0 ? x_in : nullptr, l == 0 ? nullptr : X, X, MOD + (size_t)l * NB * 6144 + 2 * 1024};
            pg8::gemm_phase_f8<pg8::EpiOut, pg8::StaticOrder>(L, g, S, E, wave);
        }
        if (VK(6)) SEAM(P + 4);
        if (KIND(7) && IN(P + 5) && VK(7)) { PH_BEGIN();
            LAS int* hist = (LAS int*)(L + LDSCTL_OFF + 256);
            for (int vb = bx; vb < 256; vb += G) {
                if (tid < NE) hist[tid] = 0;
                __syncthreads();
                {
                    const int tt = 8 * vb + wave; const int r0 = tt * 16; const int b = r0 >> 12; const int i = lane & 15, kb = lane >> 4;
                    const char* wsrc = (const char*)(WRHI + (size_t)(l * NB + b) * 65536) + lane * 16;
#pragma unroll
                    for (int j = 0; j < 16; ++j) __builtin_amdgcn_global_load_lds((const unsigned*)(wsrc + (wave * 16 + j) * 1024), (LAS unsigned*)(L + (wave * 16 + j) * 1024), 16, 0, 0);
                    LAS float* modl = (LAS float*)(L + LDSCTL_OFF + 1024);
                    if (tid < 256) { const float* md = MOD + ((size_t)l * NB + b) * 6144; const int k4 = tid * 4;
                        *(LAS f32x4*)(modl + k4) = *(const GAS f32x4*)(norm2_g + l * D + k4) * (*(const GAS f32x4*)(md + 4 * 1024 + k4) + 1.0f); *(LAS f32x4*)(modl + 1024 + k4) = *(const GAS f32x4*)(md + 3 * 1024 + k4); }
                    const bf16* xp = X + (size_t)(r0 + i) * D + 16 * kb;
                    v4u xw[32];
#pragma unroll
                    for (int s = 0; s < 32; ++s) xw[s] = *(const GAS v4u*)(xp + 64 * (s >> 1) + 8 * (s & 1));
                    asm volatile("s_waitcnt vmcnt(0)" ::: "memory");
                    __syncthreads();
                    f32x4 acc0 = (f32x4){0.f, 0.f, 0.f, 0.f}, acc1 = acc0; float ss = 0.f;
                    bf16x8 wq[2][4];
#define RT_LDW(buf, s_) _Pragma("unroll") for (int f = 0; f < 4; ++f) wq[buf][f] = *(const LAS bf16x8*)(L + (s_) * 4096 + f * 1024 + lane * 16)
                    RT_LDW(0, 0);
#pragma unroll
                    for (int s = 0; s < 32; ++s) {
                        if (s < 31) { RT_LDW((s + 1) & 1, s + 1); }
                        { const float a0 = bfl(xw[s].x), a1 = bfh(xw[s].x), a2 = bfl(xw[s].y), a3 = bfh(xw[s].y), a4 = bfl(xw[s].z), a5 = bfh(xw[s].z), a6 = bfl(xw[s].w), a7 = bfh(xw[s].w);
                          ss += (a0 * a0 + a1 * a1) + (a2 * a2 + a3 * a3) + (a4 * a4 + a5 * a5) + (a6 * a6 + a7 * a7); }
                        const bf16x8 ahv = __builtin_bit_cast(bf16x8, xw[s]);
                        acc0 = __builtin_amdgcn_mfma_f32_16x16x32_bf16(wq[s & 1][0], ahv, acc0, 0, 0, 0); acc1 = __builtin_amdgcn_mfma_f32_16x16x32_bf16(wq[s & 1][2], ahv, acc1, 0, 0, 0);
                        acc0 = __builtin_amdgcn_mfma_f32_16x16x32_bf16(wq[s & 1][1], ahv, acc0, 0, 0, 0); acc1 = __builtin_amdgcn_mfma_f32_16x16x32_bf16(wq[s & 1][3], ahv, acc1, 0, 0, 0);
                        __builtin_amdgcn_sched_barrier(0);
                    }
#undef RT_LDW
                    ss = xsum<16>(ss); ss = xsum<32>(ss);
                    const float rs = rsqrtf(ss * (1.0f / D) + EPS);
#pragma unroll
                    for (int sp = 0; sp < 16; ++sp) { const int cb0 = 64 * sp + 16 * kb; v4u o;
                        int mo = 16 * kb; asm volatile("" : "+v"(mo) : "v"(rs));
                        const LAS float* mq = modl + mo + 64 * sp;
#pragma unroll
                        for (int q4 = 0; q4 < 4; ++q4) { const f32x4 a1 = *(const LAS f32x4*)(mq + 4 * q4), a0 = *(const LAS f32x4*)(mq + 1024 + 4 * q4);
                            const v4u xq = xw[2 * sp + (q4 >> 1)]; unsigned u0 = (q4 & 1) ? xq.z : xq.x, u1 = (q4 & 1) ? xq.w : xq.y;
                            asm volatile("" : "+v"(u0), "+v"(u1));
                            const f32x4 y = ((f32x4){bfl(u0), bfh(u0), bfl(u1), bfh(u1)} * rs) * a1 + a0;
                            unsigned w = 0; w = __builtin_amdgcn_cvt_pk_fp8_f32(y.x, y.y, w, false); w = __builtin_amdgcn_cvt_pk_fp8_f32(y.z, y.w, w, true); o[q4] = w; }
                        *(GAS v4u*)(H8 + (size_t)(r0 + i) * D + cb0) = o; }
                    float v[8]; const float* rc = RC0 + (l * NB + b) * NE;
#pragma unroll
                    for (int r = 0; r < 4; ++r) { v[r] = rs * acc0[r] + rc[4 * kb + r]; v[4 + r] = rs * acc1[r] + rc[16 + 4 * kb + r]; }
                    float tv[4]; int ti[4];
#pragma unroll
                    for (int k = 0; k < 4; ++k) { float best = v[0]; int br = 0;
#pragma unroll
                        for (int r = 1; r < 8; ++r) if (v[r] > best) { best = v[r]; br = r; }
#pragma unroll
                        for (int r = 0; r < 8; ++r) v[r] = (r == br) ? -INFINITY : v[r];
                        tv[k] = best; ti[k] = (br & 3) + 16 * (br >> 2) + 4 * kb; }
#pragma unroll
                    for (int round = 0; round < 2; ++round) {
                        float bv[8]; int bi[8];
#pragma unroll
                        for (int k = 0; k < 4; ++k) { bv[k] = tv[k]; bi[k] = ti[k];
                            if (round == 0) { bv[4 + k] = __int_as_float(__builtin_amdgcn_ds_swizzle(__float_as_int(tv[k]), 0x1f | (16 << 10))); bi[4 + k] = __builtin_amdgcn_ds_swizzle(ti[k], 0x1f | (16 << 10)); }
                            else { bv[4 + k] = xget32(tv[k], lane >> 5); bi[4 + k] = xget32(ti[k], lane >> 5); } }
#pragma unroll
                        for (int k = 0; k < 4; ++k) { float best = bv[0]; int bq = 0, sel = bi[0];
#pragma unroll
                            for (int r = 1; r < 8; ++r) if (bv[r] > best || (bv[r] == best && bi[r] < sel)) { best = bv[r]; bq = r; sel = bi[r]; }
#pragma unroll
                            for (int r = 0; r < 8; ++r) bv[r] = (r == bq) ? -INFINITY : bv[r];
                            tv[k] = best; ti[k] = sel; }
                    }
                    float rw[4] = {0.f, 0.f, 0.f, 0.f};
                    if (kb == 0) {
                        const float e1 = __expf(tv[1] - tv[0]), e2 = __expf(tv[2] - tv[0]), e3 = __expf(tv[3] - tv[0]); const float inv = 1.0f / (1.0f + e1 + e2 + e3);
                        rw[0] = inv; rw[1] = e1 * inv; rw[2] = e2 * inv; rw[3] = e3 * inv;
#pragma unroll
                        for (int k = 0; k < 4; ++k) atomicAdd((int*)&hist[ti[k]], 1);
                    }
                    __syncthreads();
                    if (tid < NE) { const int hv = hist[tid]; hist[32 + tid] = hv ? __hip_atomic_fetch_add(CNT + l * NE + tid, hv, RLX_AGENT) : 0; hist[64 + tid] = 0; }
                    __syncthreads();
                    if (kb == 0) { const int tok = r0 + i; i32x4 sl;
#pragma unroll
                        for (int k = 0; k < 4; ++k) { const int e = ti[k]; const int idx = hist[32 + e] + atomicAdd((int*)&hist[64 + e], 1);
                            sl[k] = (e << 20) | idx; ROWTOK2[(size_t)e * T + idx] = tok; ROWW2[(size_t)e * T + idx] = rw[k]; }
                        *(GAS i32x4*)(SLOT + (size_t)tok * 4) = sl; }
                }
                __syncthreads();
            }
        }
        if (VK(7)) SEAM(P + 5);
        if (KIND(9) && IN(P + 7) && VK(9)) { PH_BEGIN();
            LAS int* et_l = (LAS int*)(L + LDSCTL_OFF + 256); LAS int* te_l = (LAS int*)(L + LDSCTL_OFF + 1024);
            if (tid < NE) et_l[tid] = __hip_atomic_load(CNT + l * NE + tid, RLX_AGENT);
            __syncthreads();
            if (tid < NE) { int ft = 0; for (int e = 0; e < tid; ++e) ft += (et_l[e] + 255) >> 8; et_l[32 + tid] = ft; if (tid == NE - 1) et_l[64] = ft + ((et_l[tid] + 255) >> 8); }
            __syncthreads();
            const int nmt = __builtin_amdgcn_readfirstlane(et_l[64]);
            for (int mt = tid; mt < nmt; mt += NWAVES * 64) { int e = 0;
#pragma unroll 8
                for (int q = 1; q < NE; ++q) if (et_l[32 + q] <= mt) e = q;
                te_l[mt] = e; }
            __syncthreads();
            LAS unsigned short* rt_l = (LAS unsigned short*)(L + LDSCTL_OFF + 4096);
            for (int q = tid; q < GU_MAXU * 256; q += NWAVES * 64) { const long Lu = (long)(q >> 8) * G + vcu;
                if (Lu < (long)nmt * 8) { const int mt = (int)(Lu >> 3), e = te_l[mt]; const int loc = (mt - et_l[32 + e]) * 256 + (q & 255); rt_l[q] = loc < et_l[e] ? (unsigned short)ROWTOK2[(size_t)e * T + loc] : (unsigned short)0; } }
            __syncthreads();
            pg8::Gemm g{(const bf16*)H8, (const bf16*)(WGU + (size_t)l * NE * 2048 * D), D / 2}; pg8::MoeOrder S{te_l, nmt * 8, 8, G, vcu};
            pg8::EpiGU8 E{b_gate_up + (size_t)l * NE * 2048, ACT};
            pg8::gemm_phase_f8<pg8::EpiGU8, pg8::MoeOrder, true>(L, g, S, E, wave, rt_l);
        }
        if (VK(9)) SEAM(P + 7);
        if (KIND(10) && IN(P + 8) && VK(10)) { PH_BEGIN();
            LAS int* et_l = (LAS int*)(L + LDSCTL_OFF + 256); LAS int* te_l = (LAS int*)(L + LDSCTL_OFF + 1024);
            if (tid < NE) et_l[tid] = __hip_atomic_load(CNT + l * NE + tid, RLX_AGENT);
            __syncthreads();
            if (tid < NE) { int ft = 0; for (int e = 0; e < tid; ++e) ft += (et_l[e] + 255) >> 8; et_l[32 + tid] = ft; if (tid == NE - 1) et_l[64] = ft + ((et_l[tid] + 255) >> 8); }
            __syncthreads();
            const int nmt = __builtin_amdgcn_readfirstlane(et_l[64]);
            for (int mt = tid; mt < nmt; mt += NWAVES * 64) { int e = 0;
#pragma unroll 8
                for (int q = 1; q < NE; ++q) if (et_l[32 + q] <= mt) e = q;
                te_l[mt] = e; }
            __syncthreads();
            pg8::Gemm g{(const bf16*)ACT, (const bf16*)(WDN + (size_t)l * NE * D * D), D / 2}; pg8::MoeOrder S{te_l, nmt * 4, 4, G, vcu};
            pg8::EpiDN8 E{b_down + (size_t)l * NE * D, ROWW2, et_l + 32, YB};
            pg8::gemm_phase_f8<pg8::EpiDN8, pg8::MoeOrder>(L, g, S, E, wave);
        }
        if (VK(10)) SEAM(P + 8);
        if (KIND(11) && IN(P + 9) && VK(11)) { PH_BEGIN();
            const bool lastl = (l == DEPTH - 1);
            bf16* Xw = virt ? (bf16*)(ws + WS_R) : X; bf16* Hw = virt ? (bf16*)(ws + WS_R + 128 * MiB) : H;
            int frow_v = 0;
            { const int cn = lane < NE ? __hip_atomic_load(CNT + l * NE + (lane & 31), RLX_AGENT) : 0; const int tiles = (cn + 255) >> 8; int run = 0;
#pragma unroll
              for (int e = 0; e < NE; ++e) { if (lane == e) frow_v = run * 256; run += __builtin_amdgcn_readlane(tiles, e); } }
            for (int rg = gw; rg < T / 16; rg += NGW) { const int mb = rg * 16, b = mb >> 12; const int c = 16 * lane;
                const int myslot = __hip_atomic_load(SLOT + (size_t)mb * 4 + lane, RLX_AGENT);
                f32x4 g2v[4], gna[4], a0v[4];
                { const float* g2 = MOD + ((size_t)l * NB + b) * 6144 + 5 * 1024; const float* md = MOD + ((size_t)(lastl ? l : l + 1) * NB + b) * 6144; const float* gn = lastl ? final_g : norm1_g + (l + 1) * D;
#pragma unroll
                  for (int j = 0; j < 4; ++j) { g2v[j] = *(const GAS f32x4*)(g2 + c + 4 * j); gna[j] = *(const GAS f32x4*)(gn + c + 4 * j); a0v[j] = (f32x4){0.f, 0.f, 0.f, 0.f};
                      if (!lastl) { gna[j] = gna[j] * (*(const GAS f32x4*)(md + 1024 + c + 4 * j) + 1.0f); a0v[j] = *(const GAS f32x4*)(md + c + 4 * j); } } }
                v4u xa[2][2][2], yy[2][2][4];
#define CMB_LOAD(buf, it) _Pragma("unroll") for (int q = 0; q < 2; ++q) { const size_t row_ = (size_t)(mb + 2 * (it) + q); xa[buf][q][0] = *(const GAS v4u*)(X + row_ * D + c); xa[buf][q][1] = *(const GAS v4u*)(X + row_ * D + c + 8); \
                    _Pragma("unroll") for (int k = 0; k < 4; ++k) { const int sv_ = __builtin_amdgcn_readlane(myslot, (2 * (it) + q) * 4 + k); const int sl_ = __builtin_amdgcn_readlane(frow_v, sv_ >> 20) + (sv_ & 0xFFFFF); yy[buf][q][k] = *(const GAS v4u*)(YB + (size_t)sl_ * D + c); } }
                CMB_LOAD(0, 0)
#pragma unroll
                for (int it = 0; it < 8; ++it) { const int cb = it & 1; const int m0 = mb + 2 * it;
                    if (it < 7) { CMB_LOAD(cb ^ 1, it + 1) }
                    f32x4 v[2][4];
#pragma unroll
                    for (int q = 0; q < 2; ++q) { const v4u wa = xa[cb][q][0], wb = xa[cb][q][1];
                        v[q][0] = (f32x4){bfl(wa.x), bfh(wa.x), bfl(wa.y), bfh(wa.y)}; v[q][1] = (f32x4){bfl(wa.z), bfh(wa.z), bfl(wa.w), bfh(wa.w)};
                        v[q][2] = (f32x4){bfl(wb.x), bfh(wb.x), bfl(wb.y), bfh(wb.y)}; v[q][3] = (f32x4){bfl(wb.z), bfh(wb.z), bfl(wb.w), bfh(wb.w)}; }
                    float s[2] = {0.f, 0.f};
#pragma unroll
                    for (int q = 0; q < 2; ++q)
#pragma unroll
                        for (int j = 0; j < 4; ++j) { f32x4 ys = (f32x4){0.f, 0.f, 0.f, 0.f};
#pragma unroll
                            for (int k = 0; k < 4; ++k) { const unsigned w = yy[cb][q][k][j];
                                const auto lo = __builtin_amdgcn_cvt_pk_f32_fp8((int)w, false), hi2 = __builtin_amdgcn_cvt_pk_f32_fp8((int)w, true);
                                ys.x += lo[0]; ys.y += lo[1]; ys.z += hi2[0]; ys.w += hi2[1]; }
                            v[q][j] = v[q][j] + g2v[j] * ys;
                            s[q] += (v[q][j].x * v[q][j].x + v[q][j].y * v[q][j].y) + (v[q][j].z * v[q][j].z + v[q][j].w * v[q][j].w); }
                    if (!lastl) {
#pragma unroll
                        for (int q = 0; q < 2; ++q) { v4u wa, wb; wa.x = pg8::cvt_pk_bf16(v[q][0].x, v[q][0].y); wa.y = pg8::cvt_pk_bf16(v[q][0].z, v[q][0].w); wa.z = pg8::cvt_pk_bf16(v[q][1].x, v[q][1].y); wa.w = pg8::cvt_pk_bf16(v[q][1].z, v[q][1].w);
                            wb.x = pg8::cvt_pk_bf16(v[q][2].x, v[q][2].y); wb.y = pg8::cvt_pk_bf16(v[q][2].z, v[q][2].w); wb.z = pg8::cvt_pk_bf16(v[q][3].x, v[q][3].y); wb.w = pg8::cvt_pk_bf16(v[q][3].z, v[q][3].w);
                            *(GAS v4u*)(Xw + (size_t)(m0 + q) * D + c) = wa; *(GAS v4u*)(Xw + (size_t)(m0 + q) * D + c + 8) = wb; } }
                    const float rs0 = rsqrtf(wave_sum(s[0]) * (1.0f / D) + EPS), rs1 = rsqrtf(wave_sum(s[1]) * (1.0f / D) + EPS);
                    if (!lastl) {
                        v4u h0, h1;
#pragma unroll
                        for (int j = 0; j < 4; ++j) {
                            const f32x4 y0 = (v[0][j] * rs0) * gna[j] + a0v[j], y1 = (v[1][j] * rs1) * gna[j] + a0v[j];
                            unsigned w0 = 0, w1 = 0;
                            w0 = __builtin_amdgcn_cvt_pk_fp8_f32(y0.x, y0.y, w0, false); w0 = __builtin_amdgcn_cvt_pk_fp8_f32(y0.z, y0.w, w0, true);
                            w1 = __builtin_amdgcn_cvt_pk_fp8_f32(y1.x, y1.y, w1, false); w1 = __builtin_amdgcn_cvt_pk_fp8_f32(y1.z, y1.w, w1, true);
                            h0[j] = w0; h1[j] = w1; }
                        *(GAS v4u*)((unsigned char*)Hw + (size_t)m0 * D + c) = h0; *(GAS v4u*)((unsigned char*)Hw + (size_t)(m0 + 1) * D + c) = h1;
                    } else {
#pragma unroll
                        for (int j = 0; j < 4; ++j) {
                            *(GAS f32x4*)(ap->out + (size_t)m0 * D + c + 4 * j) = v[0][j] * rs0 * gna[j]; *(GAS f32x4*)(ap->out + (size_t)(m0 + 1) * D + c + 4 * j) = v[1][j] * rs1 * gna[j]; }
                    }
                }
#undef CMB_LOAD
            }
        }
        if (VK(11)) SEAM(P + 9);
        if (virt) { PH_BEGIN();
            for (int m = 2 * gw; m < T; m += 2 * NGW) { const int b = m >> 12; const float* md = MOD + (size_t)b * 6144; norm_rows2_f8(x_in + (size_t)m * D, norm1_g, md + 1024, md, (unsigned char*)H + (size_t)m * D, lane); }
            xcd_barrier(bar); }
    }
#undef IN
#undef SEAM
}

extern "C" void kernel_launch(void* const* d_in, const int* in_sizes, int n_in, void* d_out, int out_size, void* d_ws, size_t ws_size, hipStream_t stream) {
    static int grid = 0;
    if (grid == 0) {
        if (n_in != 20 || in_sizes[0] != T * D || out_size != T * D || ws_size < WS_END) { fprintf(stderr, "kernel_launch: unexpected shapes (n_in %d, in0 %d, out %d, ws %zu < %zu); nothing launched\n", n_in, n_in > 0 ? in_sizes[0] : -1, out_size, ws_size, (size_t)WS_END); grid = -1; return; }
        int dev = 0, cus = 0, per_cu = 0;
        if (hipGetDevice(&dev) != hipSuccess || hipDeviceGetAttribute(&cus, hipDeviceAttributeMultiprocessorCount, dev) != hipSuccess) { grid = -1; return; }
        if (hipFuncSetAttribute((const void*)mk_fwd, hipFuncAttributeMaxDynamicSharedMemorySize, LDS_BYTES) != hipSuccess) { fprintf(stderr, "kernel_launch: hipFuncSetAttribute failed\n"); grid = -1; return; }
        if (hipOccupancyMaxActiveBlocksPerMultiprocessor(&per_cu, (const void*)mk_fwd, NWAVES * 64, LDS_BYTES) != hipSuccess || per_cu < 1)
            fprintf(stderr, "kernel_launch: note: occupancy query reports %d workgroups per CU\n", per_cu);
        (void)hipGetLastError();
        grid = cus < 256 ? cus : 256;
        if (grid != 256) fprintf(stderr, "kernel_launch: %d CUs; this kernel's unit deals assume 256\n", grid);
    }
    if (grid < 0) return;
    if (hipMemsetAsync((char*)d_ws + WS_CTL, 0, CTL_ZERO_BYTES, stream) != hipSuccess) { fprintf(stderr, "kernel_launch: memset failed\n"); return; }
    Args a{};
    for (int i = 0; i < 20; ++i) a.in[i] = (const float*)d_in[i];
    a.out = (float*)d_out; a.ws = (unsigned char*)d_ws; a.pad = 0;
#if MK_PER_PHASE
    for (int p = 0; p < N_PHASES; ++p) { a.ph_lo = p; a.ph_hi = p + 1; a.li = 0; hipLaunchKernelGGL(mk_fwd, dim3(grid), dim3(NWAVES * 64), LDS_BYTES, stream, a); }
#else
    a.ph_lo = 0; a.ph_hi = N_PHASES; a.li = 0;
    hipLaunchKernelGGL(mk_fwd, dim3(grid), dim3(NWAVES * 64), LDS_BYTES, stream, a);
#endif
    const hipError_t le = hipPeekAtLastError();
    if (le != hipSuccess) fprintf(stderr, "kernel_launch: launch failed: %s\n", hipGetErrorName(le));
}
```

```cpp
#include <hip/hip_runtime.h>
#include <hip/hip_bf16.h>
#include <cstdio>
#include <cstdint>
#include <cmath>

#ifndef PH_KIND_MASK
#define PH_KIND_MASK 0xFFF
#endif
#ifndef PROBE_MASK
#define PROBE_MASK 0
#endif
#ifndef PROBE_P0
#define PROBE_P0 0
#endif
#ifndef PROBE_SPIN_MASK
#define PROBE_SPIN_MASK 0
#endif
#ifndef MK_PER_PHASE
#define MK_PER_PHASE 0
#endif

constexpr int NB = 8, SEQ = 4096, T = NB * SEQ, D = 1024, DEPTH = 2;
constexpr int N_IN = 5888, NE = 32, TOPK = 4;
constexpr int NASSIGN = T * TOPK;
constexpr int MAX_MT = NASSIGN / 256 + NE;
constexpr int CAP_ROWS = MAX_MT * 256;
constexpr int GU_MAXU = 20;
constexpr float C2 = 0.125f * 1.4426950408889634f;
constexpr float LOG2E = 1.4426950408889634f;
constexpr float EPS = 1e-6f;

__device__ __forceinline__ int lane_id_asm() { int l; asm volatile("v_mbcnt_lo_u32_b32 %0, -1, 0\n\tv_mbcnt_hi_u32_b32 %0, -1, %0" : "=v"(l)); return l; }

template <int M> __device__ __forceinline__ float xsum(float v) {
    if constexpr (M < 32) return v + __int_as_float(__builtin_amdgcn_ds_swizzle(__float_as_int(v), 0x1f | (M << 10)));
    else { auto rr = __builtin_amdgcn_permlane32_swap(__float_as_uint(v), __float_as_uint(v), false, false); return __uint_as_float(rr[0]) + __uint_as_float(rr[1]); }
}
template <class Tv> __device__ __forceinline__ Tv xget32(Tv v, int hf) {
    auto rr = __builtin_amdgcn_permlane32_swap(__builtin_bit_cast(unsigned, v), __builtin_bit_cast(unsigned, v), false, false); return __builtin_bit_cast(Tv, hf ? rr[0] : rr[1]);
}

namespace pg8 {
#define PG8_LAS __attribute__((address_space(3)))
typedef unsigned short bf16_t;
typedef short bf16x8 __attribute__((ext_vector_type(8)));
typedef float f32x4 __attribute__((ext_vector_type(4)));
typedef unsigned u32x4 __attribute__((ext_vector_type(4)));
typedef unsigned u32x2 __attribute__((ext_vector_type(2)));
constexpr int BM = 256, BK = 64, HALF = 128, HTB = HALF * BK * 2, STAGE_BYTES = 8 * HTB, NXCD = 8, WGM = 8;

__host__ __device__ __forceinline__ int lds_byte(int r, int c) { const int st = (r >> 4) * 2 + (c >> 5), rr = r & 15, cc = c & 31, ob = rr * 64 + cc * 2; return st * 1024 + (ob ^ (((ob >> 9) & 1) << 5)); }
__host__ __device__ __forceinline__ void stage_rc(int b, int& R, int& C) { const int st = b / 1024, sb = b % 1024, swz = sb ^ (((sb >> 9) & 1) << 5); R = (st >> 1) * 16 + swz / 64; C = (st & 1) * 32 + (swz % 64) / 2; }
__host__ __device__ __forceinline__ int perm32(int rho) { const int n = rho >> 4, i = rho & 15; return 8 * (i >> 2) + 4 * n + (i & 3); }

struct Unit { int pm, pn; };
struct Gemm { const bf16_t* A; const bf16_t* Bt; int K; };

struct StaticOrder {
    int nM, nN, nwg, G, c;
    __device__ void init(int M, int N, int G_, int c_) { nM = M / BM; nN = N / BM; nwg = nM * nN; G = G_; c = c_; }
    __device__ __forceinline__ bool next(int i, Unit& u) const {
        const long L = (long)i * G + c; if (L >= nwg) return false;
        int wgid = (int)L; { const int q = nwg / NXCD, r = nwg % NXCD, xcd = wgid % NXCD, off = wgid / NXCD; wgid = (xcd < r ? xcd * (q + 1) : r * (q + 1) + (xcd - r) * q) + off; }
        const int nig = WGM * nN, gid = wgid / nig, fm = gid * WGM, gsz = (nM - fm) < WGM ? (nM - fm) : WGM;
        u.pm = fm + ((wgid % nig) % gsz); u.pn = (wgid % nig) / gsz; return true;
    }
};
struct MoeOrder {
    const PG8_LAS int* tile_e; int n_units, nN, G, vcu; int rev = 0;
    __device__ __forceinline__ bool next(int i, Unit& u) const {
        const long L = (long)i * G + vcu; if (L >= n_units) return false;
        const int mt0 = (int)L / nN, pl = (int)L % nN; const int mt = rev ? n_units / nN - 1 - mt0 : mt0; const int e = __builtin_amdgcn_readfirstlane(tile_e[mt]);
        u.pm = mt; u.pn = e * nN + pl; return true;
    }
};

__device__ __forceinline__ unsigned cvt_pk_bf16(float lo, float hi) { unsigned r; asm volatile("v_cvt_pk_bf16_f32 %0, %1, %2" : "=v"(r) : "v"(lo), "v"(hi)); return r; }
__device__ __forceinline__ float bf_lo(unsigned w) { return __uint_as_float(w << 16); }
__device__ __forceinline__ float bf_hi(unsigned w) { return __uint_as_float(w & 0xffff0000u); }
__device__ __forceinline__ float sigmoid_f(float x) { return __builtin_amdgcn_rcpf(1.0f + __builtin_amdgcn_exp2f(-LOG2E * x)); }

typedef int i32x4_t __attribute__((ext_vector_type(4)));
template <class Epi, class Sched, bool GATHER = false>
__device__ __forceinline__ void gemm_phase_f8(PG8_LAS unsigned char* lds, const Gemm g, const Sched& S, const Epi& E, const int wid_in, const PG8_LAS unsigned short* rt = nullptr) {
    int wid = wid_in; asm volatile("" : "+s"(wid));
    const int lane = lane_id_asm(), tid = wid * 64 + lane, wr = wid >> 2, wc = wid & 3, fr = lane & 15, fq = lane >> 4;
    int K_o = g.K; asm volatile("" : "+s"(K_o)); const int K = K_o, nt = K / BK;
    unsigned voff[2];
#pragma unroll
    for (int i = 0; i < 2; ++i) { int R, C; stage_rc(tid * 16 + i * 8192, R, C); voff[i] = (unsigned)(R * K + C) * 2u; }
    const size_t kstep = (size_t)(BK * 2);
    const size_t hstep = (size_t)HALF * K * 2;
    const size_t tstep = 2 * hstep;
    const unsigned ldsw = (unsigned)wid * 1024u;
    const int aoff = lds_byte(wr * 64 + fr, fq * 8), boff = lds_byte(wc * 32 + fr, fq * 8);
#define PG8_SA(b, h) (((b) * 2 + (h)) * HTB)
#define PG8_SB(b, h) ((4 + (b) * 2 + (h)) * HTB)
#define PG8_STAGE(bufoff, gbase) do { _Pragma("unroll") for (int _i = 0; _i < 2; ++_i) \
        __builtin_amdgcn_global_load_lds((const unsigned*)((const char*)(gbase) + voff[_i]), (PG8_LAS unsigned*)(lds + (bufoff) + ldsw + _i * 8192), 16, 0, 0); } while (0)
#define PG8_STAGE_A(bufoff, gbase, va, h, koff) do { if constexpr (GATHER) { _Pragma("unroll") for (int _i = 0; _i < 2; ++_i) \
        __builtin_amdgcn_global_load_lds((const unsigned*)((const char*)g.A + (size_t)((va)[h][_i] + (unsigned)(koff))), (PG8_LAS unsigned*)(lds + (bufoff) + ldsw + _i * 8192), 16, 0, 0); } else PG8_STAGE(bufoff, gbase); } while (0)
#define PG8_LOAD_VA(va, uidx) do { _Pragma("unroll") for (int _h = 0; _h < 2; ++_h) _Pragma("unroll") for (int _i = 0; _i < 2; ++_i) { int R, C; stage_rc(tid * 16 + _i * 8192, R, C); \
        (va)[_h][_i] = (unsigned)rt[(uidx) * 256 + _h * HALF + R] * (unsigned)(K * 2) + (unsigned)(C * 2); } } while (0)
#define PG8_LDA(dst, b, h) do { _Pragma("unroll") for (int m = 0; m < 4; ++m) _Pragma("unroll") for (int k = 0; k < 2; ++k) dst[m][k] = *(const PG8_LAS bf16x8*)(lds + PG8_SA(b, h) + aoff + m * 2048 + k * 1024); } while (0)
#define PG8_LDB(dst, b, h) do { _Pragma("unroll") for (int n = 0; n < 2; ++n) _Pragma("unroll") for (int k = 0; k < 2; ++k) dst[n][k] = *(const PG8_LAS bf16x8*)(lds + PG8_SB(b, h) + boff + n * 2048 + k * 1024); } while (0)
#define PG8_F8(x) __builtin_shufflevector(__builtin_bit_cast(i32x4_t, (x)[0]), __builtin_bit_cast(i32x4_t, (x)[1]), 0, 1, 2, 3, 4, 5, 6, 7)
#define PG8_MMA(ai, bj, At, Bt) do { __builtin_amdgcn_s_setprio(1); asm volatile("s_nop 1" ::: ); _Pragma("unroll") for (int m = 0; m < 4; ++m) _Pragma("unroll") for (int n = 0; n < 2; ++n) \
        asm volatile("v_mfma_f32_16x16x128_f8f6f4 %0, %1, %2, %0" : "+v"(acc[ai][bj][m][n]) : "v"(PG8_F8(Bt[n])), "v"(PG8_F8(At[m]))); __builtin_amdgcn_s_setprio(0); } while (0)
#define PG8_ACC_SETTLE asm volatile("s_nop 15\n\ts_nop 15" ::: "memory")
#define PG8_WAIT_V(n) asm volatile("s_waitcnt vmcnt(" #n ")" ::: "memory")
#define PG8_WAIT_L(n) asm volatile("s_waitcnt lgkmcnt(" #n ")" ::: "memory")
#define PG8_BAR __builtin_amdgcn_s_barrier()
#define PG8_SCHED __builtin_amdgcn_sched_barrier(0)
    Unit cur, nxt; int ui = 0; int sprev = 0;
    if (!S.next(0, cur)) return;
    f32x4 acc[2][2][4][2];
#pragma unroll
    for (int a = 0; a < 2; ++a)
#pragma unroll
        for (int b = 0; b < 2; ++b)
#pragma unroll
            for (int m = 0; m < 4; ++m)
#pragma unroll
                for (int n = 0; n < 2; ++n) acc[a][b][m][n] = (f32x4){0.f, 0.f, 0.f, 0.f};
    bf16x8 At[4][2], B0[2][2], B1[2][2];
    const char* cA = (const char*)g.A + (size_t)cur.pm * tstep; const char* cB = (const char*)g.Bt + (size_t)cur.pn * tstep;
    unsigned va_c[2][2] = {{0u, 0u}, {0u, 0u}}, va_n[2][2] = {{0u, 0u}, {0u, 0u}};
    if constexpr (GATHER) PG8_LOAD_VA(va_c, 0);
    PG8_STAGE(PG8_SB(0, 0), cB); PG8_STAGE(PG8_SB(0, 1), cB + hstep); PG8_STAGE_A(PG8_SA(0, 0), cA, va_c, 0, 0); PG8_STAGE_A(PG8_SA(0, 1), cA + hstep, va_c, 1, 0);
    if (wr == 1) PG8_BAR;
    PG8_WAIT_V(2); PG8_BAR;
    PG8_STAGE(PG8_SB(1, 0), cB + kstep); PG8_STAGE_A(PG8_SA(1, 0), cA + kstep, va_c, 0, kstep); PG8_STAGE(PG8_SB(1, 1), cB + hstep + kstep);
    PG8_WAIT_V(6); PG8_BAR;
    for (;;) {
        const bool has_next = S.next(ui + 1, nxt);
        const char* nA = has_next ? (const char*)g.A + (size_t)nxt.pm * tstep : cA; const char* nB = has_next ? (const char*)g.Bt + (size_t)nxt.pn * tstep : cB;
        if constexpr (GATHER) { if (has_next) PG8_LOAD_VA(va_n, ui + 1); }
#define PG8_WAITSEL do { if (!first) { PG8_WAIT_V(8); } else if (sprev == 4) { PG8_WAIT_V(12); } else if (sprev == 8) { PG8_WAIT_V(16); } else if (sprev == 16) { PG8_WAIT_V(24); } else { PG8_WAIT_V(40); } } while (0)
        for (int t = 0; t < nt; t += 2) {
            const bool last = (t == nt - 2);
            const bool first = (t == 0) && (sprev != 0);
            const char* a1 = cA + (size_t)(t + 1) * kstep;
            const char* a2 = last ? nA : cA + (size_t)(t + 2) * kstep; const char* b2 = last ? nB : cB + (size_t)(t + 2) * kstep;
            const char* a3 = a2 + kstep; const char* b3 = b2 + kstep;
            unsigned v2[2][2]; const unsigned k1 = (unsigned)(t + 1) * (unsigned)kstep, k2 = last ? 0u : (unsigned)(t + 2) * (unsigned)kstep;
            if constexpr (GATHER) {
#pragma unroll
                for (int h_ = 0; h_ < 2; ++h_)
#pragma unroll
                    for (int i_ = 0; i_ < 2; ++i_) v2[h_][i_] = last ? va_n[h_][i_] : va_c[h_][i_]; }
            PG8_LDB(B0, 0, 0); PG8_LDB(B1, 0, 1); PG8_SCHED; PG8_LDA(At, 0, 0); if (!first) PG8_STAGE_A(PG8_SA(1, 1), a1 + hstep, va_c, 1, k1);
            PG8_WAITSEL; PG8_WAIT_L(0); PG8_BAR; PG8_MMA(0, 0, At, B0); PG8_MMA(0, 1, At, B1); PG8_BAR; PG8_SCHED;
            PG8_LDA(At, 0, 1); PG8_STAGE(PG8_SB(0, 0), b2); PG8_STAGE(PG8_SB(0, 1), b2 + hstep); PG8_STAGE_A(PG8_SA(0, 0), a2, v2, 0, k2);
            PG8_WAITSEL; PG8_WAIT_L(0); PG8_BAR; PG8_MMA(1, 0, At, B0); PG8_MMA(1, 1, At, B1); PG8_BAR; PG8_SCHED;
            PG8_LDB(B0, 1, 0); PG8_LDB(B1, 1, 1); PG8_SCHED; PG8_LDA(At, 1, 0); PG8_STAGE_A(PG8_SA(0, 1), a2 + hstep, v2, 1, k2);
            PG8_WAITSEL; PG8_WAIT_L(0); PG8_BAR; PG8_MMA(0, 0, At, B0); PG8_MMA(0, 1, At, B1); PG8_BAR; PG8_SCHED;
            PG8_LDA(At, 1, 1); PG8_STAGE(PG8_SB(1, 0), b3); PG8_STAGE(PG8_SB(1, 1), b3 + hstep); PG8_STAGE_A(PG8_SA(1, 0), a3, v2, 0, k2 + (unsigned)kstep);
            PG8_WAIT_V(8); PG8_WAIT_L(0); PG8_BAR; PG8_MMA(1, 0, At, B0); PG8_MMA(1, 1, At, B1); PG8_BAR; PG8_SCHED;
        }
#undef PG8_WAITSEL
        if (wr == 0) PG8_BAR;
        sprev = has_next ? E.nst(cur) : 0;
        if (sprev != 0) PG8_STAGE_A(PG8_SA(1, 1), nA + kstep + hstep, va_n, 1, kstep);
        PG8_ACC_SETTLE;
        E(acc, cur, wr, wc, fr, fq);
        if (!has_next) break;
#pragma unroll
        for (int a = 0; a < 2; ++a)
#pragma unroll
            for (int b = 0; b < 2; ++b)
#pragma unroll
                for (int m = 0; m < 4; ++m)
#pragma unroll
                    for (int n = 0; n < 2; ++n) acc[a][b][m][n] = (f32x4){0.f, 0.f, 0.f, 0.f};
        cur = nxt; cA = nA; cB = nB; ++ui;
        if constexpr (GATHER) {
#pragma unroll
            for (int h_ = 0; h_ < 2; ++h_)
#pragma unroll
                for (int i_ = 0; i_ < 2; ++i_) va_c[h_][i_] = va_n[h_][i_]; }
        if (wr == 1) PG8_BAR;
    }
    PG8_WAIT_V(0);
    PG8_BAR;
#undef PG8_SA
#undef PG8_SB
#undef PG8_STAGE
#undef PG8_STAGE_A
#undef PG8_LOAD_VA
#undef PG8_LDA
#undef PG8_LDB
#undef PG8_MMA
#undef PG8_F8
#undef PG8_ACC_SETTLE
#undef PG8_WAIT_V
#undef PG8_WAIT_L
#undef PG8_BAR
#undef PG8_SCHED
}

#define EPI_ROWS(...) _Pragma("unroll") for (int ai = 0; ai < 2; ++ai) _Pragma("unroll") for (int m = 0; m < 4; ++m) { const int row = u.pm * BM + ai * HALF + wr * 64 + m * 16 + fr; __VA_ARGS__ }
__device__ __forceinline__ u32x4 pack8(const f32x4 a, const f32x4 b) { u32x4 w; w.x = cvt_pk_bf16(a[0], a[1]); w.y = cvt_pk_bf16(a[2], a[3]); w.z = cvt_pk_bf16(b[0], b[1]); w.w = cvt_pk_bf16(b[2], b[3]); return w; }

__device__ __forceinline__ u32x2 pack8_f8(const f32x4 a, const f32x4 b) { unsigned w0 = 0, w1 = 0;
    w0 = __builtin_amdgcn_cvt_pk_fp8_f32(a[0], a[1], w0, false); w0 = __builtin_amdgcn_cvt_pk_fp8_f32(a[2], a[3], w0, true);
    w1 = __builtin_amdgcn_cvt_pk_fp8_f32(b[0], b[1], w1, false); w1 = __builtin_amdgcn_cvt_pk_fp8_f32(b[2], b[3], w1, true); u32x2 r; r.x = w0; r.y = w1; return r; }
constexpr float W8_SCALE = 64.0f, W8_INV = 1.0f / 64.0f;
#define MK_QUAD(sidx, ctrl) { const unsigned as_ = (unsigned)__builtin_amdgcn_mov_dpp((int)a, ctrl, 0xf, 0xf, true), cs_ = (unsigned)__builtin_amdgcn_mov_dpp((int)c, ctrl, 0xf, 0xf, true); \
        const unsigned pr_ = ((q4 < 2 ? as_ : cs_) >> (16 * (q4 & 1))) & 0xffffu; lo |= (pr_ & 0xffu) << (8 * (sidx)); hi |= (pr_ >> 8) << (8 * (sidx)); }
__device__ __forceinline__ u32x4 widen16(const u32x2 a, const u32x2 b) {
    const auto r0 = __builtin_amdgcn_permlane16_swap(a.x, b.x, false, false), r1 = __builtin_amdgcn_permlane16_swap(a.y, b.y, false, false);
    u32x4 w; w.x = r0[0]; w.y = r1[0]; w.z = r0[1]; w.w = r1[1]; return w; }
typedef float f32x2 __attribute__((ext_vector_type(2)));
__device__ __forceinline__ f32x2 pk_fma(f32x2 a, f32x2 b, f32x2 c) { return __builtin_elementwise_fma(a, b, c); }
__device__ __forceinline__ f32x2 pk_mul(f32x2 a, f32x2 b) { return a * b; }
__device__ __forceinline__ f32x2 pk_add(f32x2 a, f32x2 b) { return a + b; }
struct EpiIn {
    __device__ __forceinline__ int nst(const Unit& u) const { const int pn = u.pn; if (pn >= 9 && pn < 14) return f8attn ? 8 : 32; if (pn == 14 && f8attn) return 32; return pn >= 15 ? 8 : 16; }
    bf16_t* aqkv; bf16_t* qb; bf16_t* kb; bf16_t* vb; bf16_t* gate; const float* qg; const float* kg; const float* rope; float asc; bool f8attn;
    __device__ __forceinline__ void operator()(const f32x4 (&acc)[2][2][4][2], const Unit& u, int wr, int wc, int fr_in, int fq_in) const {
        int fr = fr_in, fq = fq_in; asm volatile("" : "+v"(fr), "+v"(fq) :: "memory");
        const int pn = u.pn;
        if (pn >= 9 && pn < 14) {
            const bool isq = pn < 13; const int head = isq ? (pn - 9) * 4 + wc : wc; bf16_t* dst = isq ? qb : kb; const int pitch = isq ? 1024 : 256;
            const float* gvec = isq ? qg : kg; const float osc = isq ? C2 : 1.0f;
            f32x4 gv[2][2];
#pragma unroll
            for (int bj = 0; bj < 2; ++bj)
#pragma unroll
                for (int n = 0; n < 2; ++n) gv[bj][n] = *(const f32x4*)(gvec + 32 * bj + 16 * n + 4 * fq);
            f32x4 csr[2], snr[2], csc[4], snc[4];
#pragma unroll
            for (int ai = 0; ai < 2; ++ai) { const int pr = ((u.pm * BM + ai * HALF + wr * 64) & (SEQ - 1)) >> 6; csr[ai] = *(const f32x4*)(rope + pr * 16 + 4 * fq); snr[ai] = *(const f32x4*)(rope + 1024 + pr * 16 + 4 * fq); }
#pragma unroll
            for (int m = 0; m < 4; ++m) { const int pc = m * 16 + fr; csc[m] = *(const f32x4*)(rope + pc * 16 + 4 * fq); snc[m] = *(const f32x4*)(rope + 1024 + pc * 16 + 4 * fq); }
            EPI_ROWS(
                float ss = 0.f;
                _Pragma("unroll") for (int bj = 0; bj < 2; ++bj) _Pragma("unroll") for (int n = 0; n < 2; ++n) { const f32x4 x = acc[ai][bj][m][n] * asc; ss += (x[0] * x[0] + x[1] * x[1]) + (x[2] * x[2] + x[3] * x[3]); }
                ss = xsum<16>(ss); ss = xsum<32>(ss);
                const float sc = rsqrtf(ss * (1.0f / 64.0f) + EPS) * osc * asc;
                u32x4 w8;
                _Pragma("unroll") for (int bj = 0; bj < 2; ++bj) {
                    const f32x4 cs = bj == 0 ? csr[ai] : csc[m]; const f32x4 sn = bj == 0 ? snr[ai] : snc[m];
                    const f32x4 y0 = acc[ai][bj][m][0] * sc * gv[bj][0]; const f32x4 y1 = acc[ai][bj][m][1] * sc * gv[bj][1];
                    const f32x4 o0 = y0 * cs - y1 * sn; const f32x4 o1 = y1 * cs + y0 * sn;
                    if (f8attn) {
                        unsigned a = 0, b = 0; a = __builtin_amdgcn_cvt_pk_fp8_f32(o0[0], o0[1], a, false); a = __builtin_amdgcn_cvt_pk_fp8_f32(o0[2], o0[3], a, true);
                        b = __builtin_amdgcn_cvt_pk_fp8_f32(o1[0], o1[1], b, false); b = __builtin_amdgcn_cvt_pk_fp8_f32(o1[2], o1[3], b, true);
                        w8[2 * bj] = a; w8[2 * bj + 1] = b;
                    } else {
                    bf16_t* p = dst + (size_t)row * pitch + head * 64 + 32 * bj + 4 * fq;
                    u32x2 w0; w0.x = cvt_pk_bf16(o0[0], o0[1]); w0.y = cvt_pk_bf16(o0[2], o0[3]);
                    u32x2 w1; w1.x = cvt_pk_bf16(o1[0], o1[1]); w1.y = cvt_pk_bf16(o1[2], o1[3]);
                    *(u32x2*)p = w0; *(u32x2*)(p + 16) = w1; }
                }
                if (f8attn) *(u32x4*)((unsigned char*)dst + (size_t)row * pitch + head * 64 + 16 * fq) = w8;
            )
        } else if (pn == 14 && f8attn) {
            unsigned char* vt = (unsigned char*)vb;
            int q4 = fr & 3; asm volatile("" : "+v"(q4));
            EPI_ROWS(
                const int b = row >> 12; const int t = row & (SEQ - 1); const int kk = t & 63;
                const int pos4 = 32 * ((kk >> 2) & 1) + 4 * ((kk >> 3) & 3) + 16 * (kk >> 5);
                _Pragma("unroll") for (int bj = 0; bj < 2; ++bj) {
                    const int kvh = bj * 2 + (wc >> 1); const int d0 = (wc & 1) * 32 + 8 * fq;
                    const f32x4 v0 = acc[ai][bj][m][0] * asc; const f32x4 v1 = acc[ai][bj][m][1] * asc;
                    unsigned a = 0, c = 0; a = __builtin_amdgcn_cvt_pk_fp8_f32(v0[0], v0[1], a, false); a = __builtin_amdgcn_cvt_pk_fp8_f32(v0[2], v0[3], a, true);
                    c = __builtin_amdgcn_cvt_pk_fp8_f32(v1[0], v1[1], c, false); c = __builtin_amdgcn_cvt_pk_fp8_f32(v1[2], v1[3], c, true);
                    unsigned lo = 0, hi = 0;
                    MK_QUAD(0, 0x00) MK_QUAD(1, 0x55) MK_QUAD(2, 0xAA) MK_QUAD(3, 0xFF)
                    unsigned char* p = vt + ((size_t)((b * 4 + kvh) * 64 + d0 + 2 * q4) << 12) + (t & ~63) + pos4;
                    *(unsigned*)p = lo; *(unsigned*)(p + 4096) = hi;
                }
            )
        } else {
            bf16_t* dst; int pitch, colt, dsh = 0; float sc = asc; bool sig = false, fold = false;
            if (pn < 9) { dst = aqkv + (size_t)pn * T * 256; pitch = 256; colt = 0; fold = true; dsh = 2 * (pn / 3); if (pn % 3 == 0) sc = C2 * asc; }
            else if (pn == 14) { dst = vb; pitch = 256; colt = 0; }
            else { dst = gate; pitch = 2048; colt = (pn - 15) * 256; sig = true; }
            const int col0 = colt + wc * 32 + 8 * fq;
            f32x2 ks2 = {-LOG2E * asc, -LOG2E * asc}, one2 = {1.0f, 1.0f}; asm volatile("" : "+s"(ks2), "+s"(one2));
            if (sig) {
#pragma unroll
                for (int ai = 0; ai < 2; ++ai)
#pragma unroll
                    for (int mp = 0; mp < 2; ++mp)
#pragma unroll
                        for (int bj = 0; bj < 2; ++bj) { u32x2 ov[2];
#pragma unroll
                            for (int ms = 0; ms < 2; ++ms) { const int m = 2 * mp + ms; const f32x4 v0 = acc[ai][bj][m][0], v1 = acc[ai][bj][m][1]; unsigned w[2] = {0u, 0u};
#pragma unroll
                                for (int q = 0; q < 4; ++q) { const f32x4 a = q < 2 ? v0 : v1; const f32x2 t = pk_mul((f32x2){a[2 * (q & 1)], a[2 * (q & 1) + 1]}, ks2);
                                    const f32x2 d = pk_add((f32x2){__builtin_amdgcn_exp2f(t.x), __builtin_amdgcn_exp2f(t.y)}, one2); const float r0 = __builtin_amdgcn_rcpf(d.x), r1 = __builtin_amdgcn_rcpf(d.y);
                                    if (q & 1) w[q >> 1] = __builtin_amdgcn_cvt_pk_fp8_f32(r0, r1, w[q >> 1], true); else w[q >> 1] = __builtin_amdgcn_cvt_pk_fp8_f32(r0, r1, w[q >> 1], false); }
                                ov[ms].x = w[0]; ov[ms].y = w[1]; }
                            int fq1 = fq & 1; asm volatile("" : "+v"(fq1) :: "memory");
                            const int row = u.pm * BM + ai * HALF + wr * 64 + (2 * mp + fq1) * 16 + fr;
                            *(u32x4*)((unsigned char*)dst + (size_t)row * pitch + col0 + bj * HALF - 8 * fq1) = widen16(ov[0], ov[1]); }
            } else {
            EPI_ROWS(
                int drow = row;
                if (fold) { const int t = row & (SEQ - 1); drow = (row & ~(SEQ - 1)) | ((t & ((1 << dsh) - 1)) << (12 - dsh)) | (t >> dsh); }
                bf16_t* rowp = dst + (size_t)drow * pitch + col0;
                _Pragma("unroll") for (int bj = 0; bj < 2; ++bj) {
                    f32x4 v0 = acc[ai][bj][m][0], v1 = acc[ai][bj][m][1];
                    v0 = v0 * sc; v1 = v1 * sc; *(u32x4*)(rowp + bj * HALF) = pack8(v0, v1);
                }
            )
            }
        }
    }
};
struct EpiMergeA {
    __device__ __forceinline__ int nst(const Unit&) const { return 8; }
    const bf16_t* gate; bf16_t* merged;
    __device__ __forceinline__ void operator()(const f32x4 (&acc)[2][2][4][2], const Unit& u, int wr, int wc, int fr, int fq) const {
        const int col0 = u.pn * BM + wc * 32 + 8 * fq;
        f32x2 wi2 = {W8_INV, W8_INV}; asm volatile("" : "+s"(wi2));
        u32x2 gwv[2][4][2];
#pragma unroll
        for (int ai = 0; ai < 2; ++ai)
#pragma unroll
            for (int m = 0; m < 4; ++m)
#pragma unroll
                for (int bj = 0; bj < 2; ++bj) gwv[ai][m][bj] = *(const u32x2*)((const unsigned char*)gate + (size_t)(u.pm * BM + ai * HALF + wr * 64 + m * 16 + fr) * 2048 + col0 + bj * HALF);
        asm volatile("" ::: "memory");
#pragma unroll
        for (int ai = 0; ai < 2; ++ai)
#pragma unroll
            for (int mp = 0; mp < 2; ++mp)
#pragma unroll
                for (int bj = 0; bj < 2; ++bj) { u32x2 ov[2];
#pragma unroll
                    for (int ms = 0; ms < 2; ++ms) { const int m = 2 * mp + ms; const u32x2 gw = gwv[ai][m][bj];
                        const auto g01 = __builtin_amdgcn_cvt_pk_f32_fp8((int)gw.x, false), g23 = __builtin_amdgcn_cvt_pk_f32_fp8((int)gw.x, true), g45 = __builtin_amdgcn_cvt_pk_f32_fp8((int)gw.y, false), g67 = __builtin_amdgcn_cvt_pk_f32_fp8((int)gw.y, true);
                        const f32x4 a0 = acc[ai][bj][m][0], a1 = acc[ai][bj][m][1];
                        const f32x2 p0 = pk_mul(pk_mul((f32x2){a0[0], a0[1]}, wi2), (f32x2){g01[0], g01[1]}), p1 = pk_mul(pk_mul((f32x2){a0[2], a0[3]}, wi2), (f32x2){g23[0], g23[1]});
                        const f32x2 p2 = pk_mul(pk_mul((f32x2){a1[0], a1[1]}, wi2), (f32x2){g45[0], g45[1]}), p3 = pk_mul(pk_mul((f32x2){a1[2], a1[3]}, wi2), (f32x2){g67[0], g67[1]});
                        ov[ms] = pack8_f8((f32x4){p0.x, p0.y, p1.x, p1.y}, (f32x4){p2.x, p2.y, p3.x, p3.y}); }
                    const int row = u.pm * BM + ai * HALF + wr * 64 + (2 * mp + (fq & 1)) * 16 + fr;
                    *(u32x4*)((unsigned char*)merged + (size_t)row * 1024 + col0 + bj * HALF - 8 * (fq & 1)) = widen16(ov[0], ov[1]); }
        asm volatile("" ::: "memory");
    }
};
template <bool F8> struct EpiMergeB {
    __device__ __forceinline__ int nst(const Unit&) const { return 8; }
    const bf16_t* gate; const bf16_t* merged; unsigned char* m8;
    __device__ __forceinline__ void operator()(const f32x4 (&acc)[2][2][4][2], const Unit& u, int wr, int wc, int fr, int fq) const {
        const int col0 = u.pn * BM + wc * 32 + 8 * fq;
        f32x2 wi2 = {F8 ? W8_INV : 1.0f, F8 ? W8_INV : 1.0f}; asm volatile("" : "+s"(wi2));
        u32x2 gwv[2][4][2], mwv[2][4][2];
#pragma unroll
        for (int ai = 0; ai < 2; ++ai)
#pragma unroll
            for (int m = 0; m < 4; ++m)
#pragma unroll
                for (int bj = 0; bj < 2; ++bj) { const int row = u.pm * BM + ai * HALF + wr * 64 + m * 16 + fr;
                    gwv[ai][m][bj] = *(const u32x2*)((const unsigned char*)gate + (size_t)row * 2048 + 1024 + col0 + bj * HALF); mwv[ai][m][bj] = *(const u32x2*)((const unsigned char*)merged + (size_t)row * 1024 + col0 + bj * HALF); }
        asm volatile("" ::: "memory");
#pragma unroll
        for (int ai = 0; ai < 2; ++ai)
#pragma unroll
            for (int mp = 0; mp < 2; ++mp)
#pragma unroll
                for (int bj = 0; bj < 2; ++bj) { u32x2 ov[2];
#pragma unroll
                    for (int ms = 0; ms < 2; ++ms) { const int m = 2 * mp + ms; const u32x2 gw = gwv[ai][m][bj]; const u32x2 mw = mwv[ai][m][bj];
                        const auto m01 = __builtin_amdgcn_cvt_pk_f32_fp8((int)mw.x, false), m23 = __builtin_amdgcn_cvt_pk_f32_fp8((int)mw.x, true), m45 = __builtin_amdgcn_cvt_pk_f32_fp8((int)mw.y, false), m67 = __builtin_amdgcn_cvt_pk_f32_fp8((int)mw.y, true);
                        const auto g01 = __builtin_amdgcn_cvt_pk_f32_fp8((int)gw.x, false), g23 = __builtin_amdgcn_cvt_pk_f32_fp8((int)gw.x, true), g45 = __builtin_amdgcn_cvt_pk_f32_fp8((int)gw.y, false), g67 = __builtin_amdgcn_cvt_pk_f32_fp8((int)gw.y, true);
                        const f32x4 a0 = acc[ai][bj][m][0], a1 = acc[ai][bj][m][1];
                        const f32x2 p0 = pk_fma(pk_mul((f32x2){a0[0], a0[1]}, wi2), (f32x2){g01[0], g01[1]}, (f32x2){m01[0], m01[1]}), p1 = pk_fma(pk_mul((f32x2){a0[2], a0[3]}, wi2), (f32x2){g23[0], g23[1]}, (f32x2){m23[0], m23[1]});
                        const f32x2 p2 = pk_fma(pk_mul((f32x2){a1[0], a1[1]}, wi2), (f32x2){g45[0], g45[1]}, (f32x2){m45[0], m45[1]}), p3 = pk_fma(pk_mul((f32x2){a1[2], a1[3]}, wi2), (f32x2){g67[0], g67[1]}, (f32x2){m67[0], m67[1]});
                        ov[ms] = pack8_f8((f32x4){p0.x, p0.y, p1.x, p1.y}, (f32x4){p2.x, p2.y, p3.x, p3.y}); }
                    const int row = u.pm * BM + ai * HALF + wr * 64 + (2 * mp + (fq & 1)) * 16 + fr;
                    *(u32x4*)(m8 + (size_t)row * 1024 + col0 + bj * HALF - 8 * (fq & 1)) = widen16(ov[0], ov[1]); }
        asm volatile("" ::: "memory");
    }
};
struct EpiOut {
    __device__ __forceinline__ int nst(const Unit&) const { return 16; }
    const float* xin32; const bf16_t* xin16; bf16_t* xout; const float* g1;
    __device__ __forceinline__ void operator()(const f32x4 (&acc)[2][2][4][2], const Unit& u, int wr, int wc, int fr, int fq) const {
        const int col0 = u.pn * BM + wc * 32 + 8 * fq; const int b = (u.pm * BM) >> 12;
        float wi = W8_INV; asm volatile("" : "+s"(wi));
        f32x4 gv[2][2];
#pragma unroll
        for (int bj = 0; bj < 2; ++bj)
#pragma unroll
            for (int n = 0; n < 2; ++n) gv[bj][n] = *(const f32x4*)(g1 + (size_t)b * 6144 + col0 + bj * HALF + 4 * n) * wi;
        if (xin32) {
#pragma unroll
            for (int ai = 0; ai < 2; ++ai) {
                f32x4 xv[4][2][2];
#pragma unroll
                for (int m = 0; m < 4; ++m)
#pragma unroll
                    for (int bj = 0; bj < 2; ++bj) { const size_t off = (size_t)(u.pm * BM + ai * HALF + wr * 64 + m * 16 + fr) * 1024 + col0 + bj * HALF;
                        xv[m][bj][0] = *(const f32x4*)(xin32 + off); xv[m][bj][1] = *(const f32x4*)(xin32 + off + 4); }
                asm volatile("" ::: "memory");
#pragma unroll
                for (int m = 0; m < 4; ++m)
#pragma unroll
                    for (int bj = 0; bj < 2; ++bj) { const size_t off = (size_t)(u.pm * BM + ai * HALF + wr * 64 + m * 16 + fr) * 1024 + col0 + bj * HALF;
                        *(u32x4*)(xout + off) = pack8(__builtin_elementwise_fma(gv[bj][0], acc[ai][bj][m][0], xv[m][bj][0]), __builtin_elementwise_fma(gv[bj][1], acc[ai][bj][m][1], xv[m][bj][1])); }
                asm volatile("" ::: "memory");
            }
        } else {
            u32x4 xw[2][4][2];
#pragma unroll
            for (int ai = 0; ai < 2; ++ai)
#pragma unroll
                for (int m = 0; m < 4; ++m)
#pragma unroll
                    for (int bj = 0; bj < 2; ++bj) xw[ai][m][bj] = *(const u32x4*)(xin16 + (size_t)(u.pm * BM + ai * HALF + wr * 64 + m * 16 + fr) * 1024 + col0 + bj * HALF);
            asm volatile("" ::: "memory");
#pragma unroll
            for (int ai = 0; ai < 2; ++ai)
#pragma unroll
                for (int m = 0; m < 4; ++m)
#pragma unroll
                    for (int bj = 0; bj < 2; ++bj) { const size_t off = (size_t)(u.pm * BM + ai * HALF + wr * 64 + m * 16 + fr) * 1024 + col0 + bj * HALF; const u32x4 w = xw[ai][m][bj];
                        const f32x4 x0 = (f32x4){bf_lo(w.x), bf_hi(w.x), bf_lo(w.y), bf_hi(w.y)}, x1 = (f32x4){bf_lo(w.z), bf_hi(w.z), bf_lo(w.w), bf_hi(w.w)};
                        *(u32x4*)(xout + off) = pack8(__builtin_elementwise_fma(gv[bj][0], acc[ai][bj][m][0], x0), __builtin_elementwise_fma(gv[bj][1], acc[ai][bj][m][1], x1)); }
            asm volatile("" ::: "memory");
        }
    }
};
struct EpiGU8 {
    __device__ __forceinline__ int nst(const Unit&) const { return 4; }
    const float* bgu; unsigned char* act;
    __device__ __forceinline__ void operator()(const f32x4 (&acc)[2][2][4][2], const Unit& u, int wr, int wc, int fr, int fq) const {
        const int e = u.pn >> 3, pl = u.pn & 7; const int c0 = pl * 128 + wc * 32 + 8 * fq;
        const float* bp = bgu + (size_t)e * 2048 + c0;
        const f32x4 bg0 = *(const f32x4*)bp, bg1 = *(const f32x4*)(bp + 4), bl0 = *(const f32x4*)(bp + 1024), bl1 = *(const f32x4*)(bp + 1028);
        const f32x2 bg[4] = {{bg0[0], bg0[1]}, {bg0[2], bg0[3]}, {bg1[0], bg1[1]}, {bg1[2], bg1[3]}}, bl[4] = {{bl0[0], bl0[1]}, {bl0[2], bl0[3]}, {bl1[0], bl1[1]}, {bl1[2], bl1[3]}};
        f32x2 winv = {W8_INV, W8_INV}, kk = {-1.702f * LOG2E, -1.702f * LOG2E}, one2 = {1.0f, 1.0f};
        asm volatile("" : "+s"(winv), "+s"(kk), "+s"(one2));
#pragma unroll
        for (int ai = 0; ai < 2; ++ai)
#pragma unroll
            for (int mp = 0; mp < 2; ++mp) {
                u32x2 ov[2];
#pragma unroll
                for (int ms = 0; ms < 2; ++ms) { const int m = 2 * mp + ms; unsigned w[2] = {0u, 0u};
#pragma unroll
                    for (int q = 0; q < 4; ++q) {
                        const f32x4 ag = acc[ai][0][m][q >> 1], al = acc[ai][1][m][q >> 1];
                        const f32x2 gl = pk_fma((f32x2){ag[2 * (q & 1)], ag[2 * (q & 1) + 1]}, winv, bg[q]), ln = pk_fma((f32x2){al[2 * (q & 1)], al[2 * (q & 1) + 1]}, winv, bl[q]);
                        const f32x2 xg = {fminf(gl.x, 7.0f), fminf(gl.y, 7.0f)}, xl = {fminf(fmaxf(ln.x, -7.0f), 7.0f), fminf(fmaxf(ln.y, -7.0f), 7.0f)};
                        const f32x2 t = pk_mul(xg, kk); const f32x2 d = pk_add((f32x2){__builtin_amdgcn_exp2f(t.x), __builtin_amdgcn_exp2f(t.y)}, one2);
                        const f32x2 xs = pk_mul(xg, (f32x2){__builtin_amdgcn_rcpf(d.x), __builtin_amdgcn_rcpf(d.y)});
                        const f32x2 o = pk_fma(xs, xl, xs);
                        if (q & 1) w[q >> 1] = __builtin_amdgcn_cvt_pk_fp8_f32(o.x, o.y, w[q >> 1], true); else w[q >> 1] = __builtin_amdgcn_cvt_pk_fp8_f32(o.x, o.y, w[q >> 1], false);
                    }
                    ov[ms].x = w[0]; ov[ms].y = w[1]; }
                const int row = u.pm * BM + ai * HALF + wr * 64 + (2 * mp + (fq & 1)) * 16 + fr;
                *(u32x4*)(act + (size_t)row * 1024 + c0 - 8 * (fq & 1)) = widen16(ov[0], ov[1]);
            }
    }
};
struct EpiDN8 {
    __device__ __forceinline__ int nst(const Unit&) const { return 8; }
    const float* bdn; const float* roww; const PG8_LAS int* ft; unsigned char* y;
    __device__ __forceinline__ void operator()(const f32x4 (&acc)[2][2][4][2], const Unit& u, int wr, int wc, int fr, int fq) const {
        const int e = u.pn >> 2, pl = u.pn & 3; const int col0 = pl * BM + wc * 32 + 8 * fq;
        float wi = W8_INV; asm volatile("" : "+s"(wi)); const f32x4 wiv = {wi, wi, wi, wi};
        f32x4 bv[2][2];
#pragma unroll
        for (int bj = 0; bj < 2; ++bj)
#pragma unroll
            for (int n = 0; n < 2; ++n) bv[bj][n] = *(const f32x4*)(bdn + (size_t)e * 1024 + col0 + bj * HALF + 4 * n);
        float wv[2][4];
#pragma unroll
        for (int ai = 0; ai < 2; ++ai)
#pragma unroll
            for (int m = 0; m < 4; ++m) wv[ai][m] = roww[(size_t)e * T + (u.pm - ft[e]) * BM + ai * HALF + wr * 64 + m * 16 + fr];
#pragma unroll
        for (int ai = 0; ai < 2; ++ai)
#pragma unroll
            for (int mp = 0; mp < 2; ++mp)
#pragma unroll
                for (int bj = 0; bj < 2; ++bj) { u32x2 ov[2];
#pragma unroll
                    for (int ms = 0; ms < 2; ++ms) { const int m = 2 * mp + ms; const float w = wv[ai][m];
                        ov[ms] = pack8_f8(__builtin_elementwise_fma(acc[ai][bj][m][0], wiv, bv[bj][0]) * w, __builtin_elementwise_fma(acc[ai][bj][m][1], wiv, bv[bj][1]) * w); }
                    const int row = u.pm * BM + ai * HALF + wr * 64 + (2 * mp + (fq & 1)) * 16 + fr;
                    *(u32x4*)(y + (size_t)row * 1024 + col0 + bj * HALF - 8 * (fq & 1)) = widen16(ov[0], ov[1]); }
    }
};
}

namespace attn_body {
using bf16 = __hip_bfloat16;
using bf16x8 = __attribute__((ext_vector_type(8))) short;
using s16x4 = __attribute__((ext_vector_type(4))) short;
using f32x16 = __attribute__((ext_vector_type(16))) float;
using u32x4 = __attribute__((ext_vector_type(4))) unsigned;
constexpr int D = 64, NW = 8, QBLK = 32, QB = QBLK * NW, KVBLK = 64;
__device__ __forceinline__ int crow(int r, int hi) { return (r & 3) + 8 * (r >> 2) + 4 * hi; }
#define SBAR() __builtin_amdgcn_sched_barrier(0)
constexpr int NSLOT = 3, SLOTB = 8192;
constexpr int LDS_K = 0, LDS_V = NSLOT * SLOTB, LDS_WS = 2 * NSLOT * SLOTB, LDS_OST = LDS_WS + NW * 64 * 4, LDS_LUT = LDS_OST + NW * 4096, LUT_N = 768, LDS_BYTES = LDS_LUT + LUT_N * 4;
constexpr bool OB_F8 = true;
constexpr float MFLOOR = -1024.0f;
__device__ __forceinline__ void glds16(const void* gsrc, unsigned lds_dst) { unsigned keep;
  asm volatile("s_mov_b32 %0, m0\n\ts_mov_b32 m0, %2\n\ts_nop 0\n\tglobal_load_lds_dwordx4 %1, off\n\ts_mov_b32 m0, %0" : "=&s"(keep) : "v"(gsrc), "s"(lds_dst) : "memory"); }
__device__ __forceinline__ float max3f(float a, float b, float c) { float r; asm("v_max3_f32 %0, %1, %2, %3" : "=v"(r) : "v"(a), "v"(b), "v"(c)); return r; }
__device__ __forceinline__ float max2f(float a, float b) { float r; asm("v_max_f32_e32 %0, %1, %2" : "=v"(r) : "v"(a), "v"(b)); return r; }
__device__ __forceinline__ float fadd_s(float a, float b) { float r; asm("v_add_f32_e32 %0, %1, %2" : "=v"(r) : "v"(a), "v"(b)); return r; }
__device__ __forceinline__ float fsub_s(float a, float b) { float r; asm("v_sub_f32_e32 %0, %1, %2" : "=v"(r) : "v"(a), "v"(b)); return r; }
typedef float f32x2_t __attribute__((ext_vector_type(2))); typedef __bf16 bf16x2_t __attribute__((ext_vector_type(2)));
__device__ __forceinline__ unsigned cvtpk_s(float lo, float hi) { f32x2_t v = {lo, hi}; bf16x2_t b = __builtin_convertvector(v, bf16x2_t); return __builtin_bit_cast(unsigned, b); }
#define WAIT_BAR(N) asm volatile("s_waitcnt vmcnt(" #N ") lgkmcnt(0)\n\ts_barrier" ::: "memory")

__device__ __forceinline__ void qkt(f32x16& p0, f32x16& p1, const char* Kslot, const bf16x8* qr, const f32x16& negm, int r32, int hi) {
  const char* kb = Kslot + hi * 1024 + r32 * 16;
  #pragma unroll
  for (int d0 = 0; d0 < 4; ++d0) {
    const bf16x8 b0 = *reinterpret_cast<const bf16x8*>(kb + d0 * 2048);
    const bf16x8 b1 = *reinterpret_cast<const bf16x8*>(kb + d0 * 2048 + 512);
    if (d0 == 0) { p0 = __builtin_amdgcn_mfma_f32_32x32x16_bf16(b0, qr[0], negm, 0, 0, 0); p1 = __builtin_amdgcn_mfma_f32_32x32x16_bf16(b1, qr[0], negm, 0, 0, 0); }
    else { p0 = __builtin_amdgcn_mfma_f32_32x32x16_bf16(b0, qr[d0], p0, 0, 0, 0); p1 = __builtin_amdgcn_mfma_f32_32x32x16_bf16(b1, qr[d0], p1, 0, 0, 0); } }
}
typedef __attribute__((address_space(3))) const char* lds_cptr;
typedef short v4i16_t __attribute__((ext_vector_type(4)));
__device__ __forceinline__ void kload8(bf16x8* kf, lds_cptr kp) {
  kf[0] = *(const __attribute__((address_space(3))) bf16x8*)(kp);        kf[1] = *(const __attribute__((address_space(3))) bf16x8*)(kp + 512);
  kf[2] = *(const __attribute__((address_space(3))) bf16x8*)(kp + 2048); kf[3] = *(const __attribute__((address_space(3))) bf16x8*)(kp + 2560);
  kf[4] = *(const __attribute__((address_space(3))) bf16x8*)(kp + 4096); kf[5] = *(const __attribute__((address_space(3))) bf16x8*)(kp + 4608);
  kf[6] = *(const __attribute__((address_space(3))) bf16x8*)(kp + 6144); kf[7] = *(const __attribute__((address_space(3))) bf16x8*)(kp + 6656);
}
__device__ __forceinline__ void kload2(bf16x8* kf, lds_cptr kp, int j) { kf[2 * j] = *(const __attribute__((address_space(3))) bf16x8*)(kp + j * 2048); kf[2 * j + 1] = *(const __attribute__((address_space(3))) bf16x8*)(kp + j * 2048 + 512); }
__device__ __forceinline__ s16x4 vtr(lds_cptr p) { return __builtin_bit_cast(s16x4, __builtin_amdgcn_ds_read_tr16_b64_v4i16((__attribute__((address_space(3))) v4i16_t*)p)); }
__device__ __forceinline__ float rowmax(const f32x16& p0, const f32x16& p1) {
  float a = max3f(p0[0], p0[1], p1[0]), b = max3f(p0[2], p0[3], p1[1]); a = max3f(a, p1[2], p1[3]);
  #pragma unroll
  for (int r = 4; r < 16; r += 4) { a = max3f(a, p0[r], p0[r + 1]); b = max3f(b, p0[r + 2], p0[r + 3]); a = max3f(a, p1[r], p1[r + 1]); b = max3f(b, p1[r + 2], p1[r + 3]); }
  const float m = max2f(a, b);
  auto rr = __builtin_amdgcn_permlane32_swap(__float_as_uint(m), __float_as_uint(m), false, false);
  return max2f(__uint_as_float(rr[0]), __uint_as_float(rr[1]));
}
__device__ __forceinline__ void pv(f32x16* o, int vb, bf16x8 pa0, bf16x8 pa1, bf16x8 pa2, bf16x8 pa3) {
  #pragma unroll
  for (int d0 = 0; d0 < 2; ++d0) { s16x4 lo[4], hi[4];
    #pragma unroll
    for (int ks = 0; ks < 4; ++ks) {
      asm volatile("ds_read_b64_tr_b16 %0,%1 offset:%c2" : "=&v"(lo[ks]) : "v"(vb), "i"(d0 * 4096 + ks * 1024) : "memory");
      asm volatile("ds_read_b64_tr_b16 %0,%1 offset:%c2" : "=&v"(hi[ks]) : "v"(vb), "i"(d0 * 4096 + ks * 1024 + 512) : "memory"); }
    asm volatile("s_waitcnt lgkmcnt(0)" ::: "memory"); SBAR();
    #define PK(k) (bf16x8){lo[k][0], lo[k][1], lo[k][2], lo[k][3], hi[k][0], hi[k][1], hi[k][2], hi[k][3]}
    o[d0] = __builtin_amdgcn_mfma_f32_32x32x16_bf16(pa0, PK(0), o[d0], 0, 0, 0);
    o[d0] = __builtin_amdgcn_mfma_f32_32x32x16_bf16(pa1, PK(1), o[d0], 0, 0, 0);
    o[d0] = __builtin_amdgcn_mfma_f32_32x32x16_bf16(pa2, PK(2), o[d0], 0, 0, 0);
    o[d0] = __builtin_amdgcn_mfma_f32_32x32x16_bf16(pa3, PK(3), o[d0], 0, 0, 0);
    #undef PK
  }
}
struct Job { const bf16* Q; const bf16* K; const bf16* V; bf16* O; float* lse; const float* lutg; int NT, i0, kq0, dsh, cls; };
template <int MODE, int THRL, bool NOMAX = false> __device__ __forceinline__ void attn_unit(const Job& J, char* shm, const int wid_in) {
  int wid = wid_in; asm volatile("" : "+s"(wid));
  constexpr int QP = MODE == 0 ? 1024 : 256, KP = 256;
  const int lane = lane_id_asm(), tid = wid * 64 + lane, r32 = lane & 31, hi = lane >> 5;
  const bf16* Qw = J.Q + (long)(wid * QBLK) * QP;
  const bf16* Kh = J.K; const bf16* Vh = J.V;
  const unsigned lds0 = (unsigned)(uintptr_t)shm;
  float* wsf = (float*)(shm + LDS_WS) + wid * 64;
  const bf16* ksrc = Kh + (long)lane * KP + wid * 8;
  const bf16* vsrc = Vh + (long)(16 * (wid & 3) + (lane >> 2)) * KP + (wid >> 2) * 32 + (lane & 3) * 8;
  const unsigned kdst = lds0 + LDS_K + wid * 1024, vdst = lds0 + LDS_V + wid * 1024;
  #define DMA_K(t, slot) glds16(ksrc + (long)(t) * KVBLK * KP, (unsigned)__builtin_amdgcn_readfirstlane(kdst + (slot)))
  #define DMA_V(t, slot) glds16(vsrc + (long)(t) * KVBLK * KP, (unsigned)__builtin_amdgcn_readfirstlane(vdst + (slot)))
  const int vb0 = (int)(lds0 + LDS_V) + ((lane >> 4) & 1) * 32 + (lane & 3) * 8 + (4 * hi + ((lane & 15) >> 2)) * 64;
  const char* Kbase = shm + LDS_K; bf16x8 kf[8];
  const lds_cptr shm3 = (lds_cptr)shm; const lds_cptr kp0 = shm3 + LDS_K + hi * 1024 + r32 * 16; const lds_cptr vp0 = shm3 + LDS_V + ((lane >> 4) & 1) * 32 + (lane & 3) * 8 + (4 * hi + ((lane & 15) >> 2)) * 64;
  const int NT = J.NT;
  if (MODE == 1) {
    __attribute__((address_space(3))) float* lut = (__attribute__((address_space(3))) float*)(shm3 + LDS_LUT);
    lut[tid] = J.lutg[tid]; if (tid < LUT_N - 512) lut[512 + tid] = J.lutg[512 + tid];
  }
  DMA_K(0, 0); DMA_V(0, 0); DMA_K(1, SLOTB);
  bf16x8 qr[4];
  #pragma unroll
  for (int d0 = 0; d0 < 4; ++d0) qr[d0] = *reinterpret_cast<const bf16x8*>(&Qw[(long)r32 * QP + d0 * 16 + hi * 8]);
  float mhat = 0.f, l_reg = 0.f; f32x16 o[2]; o[0] = f32x16{}; o[1] = f32x16{}; f32x16 negm = f32x16{}; if (!NOMAX) asm volatile("" : "+v"(negm));
  const int qrel = wid * QBLK + r32;
  const __attribute__((address_space(3))) float* lutq = (const __attribute__((address_space(3))) float*)(shm3 + LDS_LUT) + (J.kq0 - qrel + 383 + 4 * hi);
  #define CMASK(P0, P1, t) do { if (MODE == 1) { const __attribute__((address_space(3))) float* lp_ = lutq + 64 * (t); \
      _Pragma("unroll") for (int r = 0; r < 16; ++r) { const int ko_ = (r & 3) + 8 * (r >> 2); P0[r] += lp_[ko_]; P1[r] += lp_[ko_ + 32]; } } } while (0)
  bool resc = false;
  #define START(P0, P1) do { resc = false; if (!NOMAX) { const float rm = rowmax(P0, P1); \
    const float dl = MODE == 1 ? max2f(rm, MFLOOR) : rm; mhat = fadd_s(mhat, dl); \
      _Pragma("unroll") for (int r = 0; r < 16; ++r) { P0[r] = fsub_s(P0[r], dl); P1[r] = fsub_s(P1[r], dl); } \
      _Pragma("unroll") for (int r = 0; r < 16; ++r) negm[r] = -mhat; asm volatile("" : "+v"(negm)); } \
    _Pragma("unroll") for (int r = 0; r < 16; ++r) P0[r] = __builtin_amdgcn_exp2f(P0[r]); } while (0)
  #define RESC() do { if (resc) { asm volatile("s_waitcnt lgkmcnt(0)" ::: "memory"); \
      _Pragma("unroll") for (int d_ = 0; d_ < 2; ++d_) _Pragma("unroll") for (int r = 0; r < 16; ++r) o[d_][r] *= wsf[crow(r, hi)]; } } while (0)
  f32x16 pA0, pA1, pB0, pB1;
  int sl_prev = 0, sl_cur = 0, sl_next = SLOTB;
  #define ROT() do { sl_prev = sl_cur; sl_cur = sl_next; sl_next = (sl_next == (NSLOT - 1) * SLOTB) ? 0 : sl_next + SLOTB; } while (0)
  DMA_K(2, 2 * SLOTB);
  WAIT_BAR(3);
  qkt(pA0, pA1, Kbase, qr, negm, r32, hi); asm volatile("s_nop 15\n\ts_nop 7" : "+v"(pA0), "+v"(pA1)); CMASK(pA0, pA1, 0);
  START(pA0, pA1);
  _Pragma("unroll") for (int r = 0; r < 16; ++r) pA1[r] = __builtin_amdgcn_exp2f(pA1[r]);
  WAIT_BAR(0);
  DMA_K(3, 0); DMA_V(1, SLOTB);
  ROT();
  kload8(kf, kp0 + sl_cur);
  WAIT_BAR(2);
  s16x4 vlo[8], vhi[8]; u32x4 pw0, pw1, pw2, pw3;
  #define PKW(P, B) cvtpk_s(P[B], P[B + 1])
  #define PAF(k) __builtin_bit_cast(bf16x8, pw##k)
  #define VFR(i) (bf16x8){vlo[i][0], vlo[i][1], vlo[i][2], vlo[i][3], vhi[i][0], vhi[i][1], vhi[i][2], vhi[i][3]}
  #define PIN(x) asm volatile("" : "+v"(x))
  #define MX3(a, b, c) __builtin_fmaxf(__builtin_fmaxf((a), (b)), (c))
  #define GAPA(MF, A0, A1, A2, A3, W0, W1, PW) do { MF; sacc += A0; sacc += A1; sacc += A2; sacc += A3; PIN(sacc); W0; W1; PIN(PW); SBAR(); } while (0)
  #define EX(v) __builtin_amdgcn_exp2f(v)
  #define GAPB(MF, X, B) do { MF; X[B] = EX(X[B]); X[B + 1] = EX(X[B + 1]); X[B + 2] = EX(X[B + 2]); X[B + 3] = EX(X[B + 3]); PIN(X); SBAR(); } while (0)
  #define VRD(i) do { vlo[i] = vtr(vp_ + (((i) >> 2) * 4096 + ((i) & 3) * 1024)); vhi[i] = vtr(vp_ + (((i) >> 2) * 4096 + ((i) & 3) * 1024 + 512)); } while (0)
  #define KRD(G, j) do { if (G) { kload2(kf, kp0 + sl_next, j); SBAR(); } } while (0)
  #define STEP(C0, C1, P0, P1, t, GK, GV, GL) do { SBAR(); \
    const lds_cptr vp_ = vp0 + sl_prev; \
    VRD(0); SBAR(); float sacc = (P0[0] + P0[1]); \
    GAPA(C0 = __builtin_amdgcn_mfma_f32_32x32x16_bf16(kf[0], qr[0], negm, 0, 0, 0), P0[2], P0[3], P0[4], P0[5],     pw0[0] = PKW(P0, 0), pw0[1] = PKW(P0, 2), pw0); \
    VRD(4); SBAR(); GAPA(C1 = __builtin_amdgcn_mfma_f32_32x32x16_bf16(kf[1], qr[0], negm, 0, 0, 0), P0[6], P0[7], P0[8], P0[9],     pw0[2] = PKW(P0, 4), pw0[3] = PKW(P0, 6), pw0); \
    VRD(1); SBAR(); GAPA(C0 = __builtin_amdgcn_mfma_f32_32x32x16_bf16(kf[2], qr[1], C0, 0, 0, 0),   P0[10], P0[11], P0[12], P0[13], pw1[0] = PKW(P0, 8), pw1[1] = PKW(P0, 10), pw1); \
    VRD(5); SBAR(); GAPA(C1 = __builtin_amdgcn_mfma_f32_32x32x16_bf16(kf[3], qr[1], C1, 0, 0, 0),   P0[14], P0[15], P1[0], P1[1],   pw1[2] = PKW(P0, 12), pw1[3] = PKW(P0, 14), pw1); \
    VRD(2); SBAR(); GAPA(C0 = __builtin_amdgcn_mfma_f32_32x32x16_bf16(kf[4], qr[2], C0, 0, 0, 0),   P1[2], P1[3], P1[4], P1[5],     pw2[0] = PKW(P1, 0), pw2[1] = PKW(P1, 2), pw2); \
    VRD(6); SBAR(); GAPA(C1 = __builtin_amdgcn_mfma_f32_32x32x16_bf16(kf[5], qr[2], C1, 0, 0, 0),   P1[6], P1[7], P1[8], P1[9],     pw2[2] = PKW(P1, 4), pw2[3] = PKW(P1, 6), pw2); \
    VRD(3); SBAR(); GAPA(C0 = __builtin_amdgcn_mfma_f32_32x32x16_bf16(kf[6], qr[3], C0, 0, 0, 0),   P1[10], P1[11], P1[12], P1[13], pw3[0] = PKW(P1, 8), pw3[1] = PKW(P1, 10), pw3); \
    VRD(7); SBAR(); GAPA(C1 = __builtin_amdgcn_mfma_f32_32x32x16_bf16(kf[7], qr[3], C1, 0, 0, 0),   P1[14], P1[15], 0.f, 0.f,       pw3[2] = PKW(P1, 12), pw3[3] = PKW(P1, 14), pw3); \
    l_reg += sacc; \
    if (GK) { DMA_K((t) + 3, sl_cur); } if (GV) { DMA_V((t) + 1, sl_next); } \
    CMASK(C0, C1, t); \
    if (!NOMAX) { float a = MX3(C0[0], C0[1], C1[0]), b = MX3(C0[2], C0[3], C1[1]); a = MX3(a, C1[2], C1[3]); \
      _Pragma("unroll") for (int r = 4; r < 16; r += 4) { a = MX3(a, C0[r], C0[r + 1]); b = MX3(b, C0[r + 2], C0[r + 3]); a = MX3(a, C1[r], C1[r + 1]); b = MX3(b, C1[r + 2], C1[r + 3]); } \
      float rm = __builtin_fmaxf(a, b); { auto rr = __builtin_amdgcn_permlane32_swap(__float_as_uint(rm), __float_as_uint(rm), false, false); rm = __builtin_fmaxf(__uint_as_float(rr[0]), __uint_as_float(rr[1])); } \
      resc = false; \
      if (__builtin_expect(__any(rm > (float)THRL), 0)) { const float dl = __builtin_fmaxf(rm, 0.f); mhat += dl; \
        _Pragma("unroll") for (int r = 0; r < 16; ++r) { C0[r] -= dl; C1[r] -= dl; } \
        _Pragma("unroll") for (int r = 0; r < 16; ++r) negm[r] = -mhat; asm volatile("" : "+v"(negm)); \
        const float f = __builtin_amdgcn_exp2f(-dl); l_reg *= f; if (hi == 0) wsf[r32] = f; resc = true; } } \
    SBAR(); \
    GAPB(o[0] = __builtin_amdgcn_mfma_f32_32x32x16_bf16(PAF(0), VFR(0), o[0], 0, 0, 0), C0, 0); \
    GAPB(o[1] = __builtin_amdgcn_mfma_f32_32x32x16_bf16(PAF(0), VFR(4), o[1], 0, 0, 0), C0, 4); \
    KRD(GL, 0); GAPB(o[0] = __builtin_amdgcn_mfma_f32_32x32x16_bf16(PAF(1), VFR(1), o[0], 0, 0, 0), C0, 8); \
    KRD(GL, 1); GAPB(o[1] = __builtin_amdgcn_mfma_f32_32x32x16_bf16(PAF(1), VFR(5), o[1], 0, 0, 0), C0, 12); \
    KRD(GL, 2); GAPB(o[0] = __builtin_amdgcn_mfma_f32_32x32x16_bf16(PAF(2), VFR(2), o[0], 0, 0, 0), C1, 0); \
    KRD(GL, 3); GAPB(o[1] = __builtin_amdgcn_mfma_f32_32x32x16_bf16(PAF(2), VFR(6), o[1], 0, 0, 0), C1, 4); \
    GAPB(o[0] = __builtin_amdgcn_mfma_f32_32x32x16_bf16(PAF(3), VFR(3), o[0], 0, 0, 0), C1, 8); \
    GAPB(o[1] = __builtin_amdgcn_mfma_f32_32x32x16_bf16(PAF(3), VFR(7), o[1], 0, 0, 0), C1, 12); \
    } while (0)
  int t = 1;
  for (; t + 5 < NT; t += 2) {
    STEP(pB0, pB1, pA0, pA1, t, true, true, true);     WAIT_BAR(2); RESC(); ROT();
    STEP(pA0, pA1, pB0, pB1, t + 1, true, true, true); WAIT_BAR(2); RESC(); ROT();
  }
  #define ENDW(tt) do { if ((tt) + 3 < NT) { WAIT_BAR(2); } else if ((tt) + 2 < NT) { WAIT_BAR(1); } else { WAIT_BAR(0); } } while (0)
  for (; t + 1 < NT; t += 2) {
    STEP(pB0, pB1, pA0, pA1, t, (t + 3 < NT), (t + 1 < NT), (t + 1 < NT));       ENDW(t);     RESC(); ROT();
    STEP(pA0, pA1, pB0, pB1, t + 1, (t + 4 < NT), (t + 2 < NT), (t + 2 < NT));   ENDW(t + 1); RESC(); ROT();
  }
  STEP(pB0, pB1, pA0, pA1, NT - 1, false, false, false); RESC();
  { float sacc = pB0[0] + pB0[1]; _Pragma("unroll") for (int r = 2; r < 16; ++r) sacc += pB0[r]; _Pragma("unroll") for (int r = 0; r < 16; ++r) sacc += pB1[r]; l_reg += sacc;
    pw0 = (u32x4){PKW(pB0, 0), PKW(pB0, 2), PKW(pB0, 4), PKW(pB0, 6)}; pw1 = (u32x4){PKW(pB0, 8), PKW(pB0, 10), PKW(pB0, 12), PKW(pB0, 14)}; pw2 = (u32x4){PKW(pB1, 0), PKW(pB1, 2), PKW(pB1, 4), PKW(pB1, 6)}; pw3 = (u32x4){PKW(pB1, 8), PKW(pB1, 10), PKW(pB1, 12), PKW(pB1, 14)};
    SBAR(); pv(o, vb0 + sl_cur, PAF(0), PAF(1), PAF(2), PAF(3)); }
  #undef PKW
  #undef PAF
  #undef VFR
  #undef PIN
  #undef MX3
  #undef GAPA
  #undef GAPB
  #undef EX
  #undef VRD
  #undef KRD
  #undef STEP
  #undef ENDW
  { auto rr = __builtin_amdgcn_permlane32_swap(__float_as_uint(l_reg), __float_as_uint(l_reg), false, false); l_reg = __uint_as_float(rr[0]) + __uint_as_float(rr[1]); }
  if (hi == 0) wsf[32 + r32] = l_reg; asm volatile("s_waitcnt lgkmcnt(0)" ::: "memory");
  float rli[16];
  #pragma unroll
  for (int r = 0; r < 16; ++r) rli[r] = __builtin_amdgcn_rcpf(wsf[32 + crow(r, hi)]);
  if (MODE == 0 && OB_F8) {
    unsigned char* stg8 = (unsigned char*)(shm + LDS_OST) + wid * 4096;
    #pragma unroll
    for (int r = 0; r < 16; ++r) { const int orow = crow(r, hi);
      #pragma unroll
      for (int d0 = 0; d0 < 2; ++d0) { const float ov = o[d0][r] * rli[r]; stg8[orow * 64 + d0 * 32 + r32] = (unsigned char)(__builtin_amdgcn_cvt_pk_fp8_f32(ov, ov, 0, false) & 0xff); } }
    asm volatile("s_waitcnt lgkmcnt(0)" ::: "memory");
    unsigned char* Ow = (unsigned char*)J.O + (long)(wid * QBLK) * 1024;
    #pragma unroll
    for (int i = 0; i < 2; ++i) { const int row = i * 16 + (lane >> 2), ch = lane & 3; const u32x4 v = *(const u32x4*)(stg8 + row * 64 + ch * 16); *(u32x4*)(Ow + (long)row * 1024 + ch * 16) = v; }
  } else {
    bf16* stg = (bf16*)(shm + LDS_OST) + wid * 2048;
    #pragma unroll
    for (int r = 0; r < 16; ++r) { const int orow = crow(r, hi);
      #pragma unroll
      for (int d0 = 0; d0 < 2; ++d0) stg[orow * 64 + d0 * 32 + r32] = __float2bfloat16(o[d0][r] * rli[r]); }
    asm volatile("s_waitcnt lgkmcnt(0)" ::: "memory");
    if (MODE == 0) {
      bf16* Ow = J.O + (long)(wid * QBLK) * 1024;
      #pragma unroll
      for (int i = 0; i < 4; ++i) { const int row = i * 8 + (lane >> 3), ch = lane & 7; const u32x4 v = *(const u32x4*)(stg + row * 64 + ch * 8); *(u32x4*)(Ow + (long)row * 1024 + ch * 8) = v; }
    } else {
      #pragma unroll
      for (int i = 0; i < 4; ++i) { const int row = i * 8 + (lane >> 3), ch = lane & 7; const u32x4 v = *(const u32x4*)(stg + row * 64 + ch * 8);
        const long tok = ((long)(J.i0 + wid * QBLK + row) << J.dsh) + J.cls; *(u32x4*)(J.O + tok * 256 + ch * 8) = v; }
      if (hi == 0) { const long tok = ((long)(J.i0 + qrel) << J.dsh) + J.cls; J.lse[tok * 4] = mhat + __builtin_amdgcn_logf(l_reg); }
    } }
  asm volatile("s_waitcnt lgkmcnt(0)\n\ts_barrier" ::: "memory");
  #undef DMA_K
  #undef DMA_V
  #undef CMASK
  #undef START
  #undef RESC
  #undef ROT
}
#undef SBAR
#undef WAIT_BAR
}


namespace attn8 {
typedef int i32x8 __attribute__((ext_vector_type(8)));
typedef int i32x4 __attribute__((ext_vector_type(4)));
typedef float f32x16 __attribute__((ext_vector_type(16)));
typedef unsigned u32x4 __attribute__((ext_vector_type(4)));
constexpr int SLOT = 4096, RING = 8, NSL = RING;
constexpr int L_K = 0, L_V = NSL * SLOT, L_WS = 2 * NSL * SLOT, L_OST = L_WS + 8 * 256, L_BYTES = L_OST + 8 * 4096;
struct Job { const unsigned char* Q; const unsigned char* K; const unsigned char* VT; unsigned char* O; };
__device__ __forceinline__ void glds16(const void* gsrc, unsigned lds_dst) { unsigned keep;
  asm volatile("s_mov_b32 %0, m0\n\ts_mov_b32 m0, %2\n\ts_nop 0\n\tglobal_load_lds_dwordx4 %1, off\n\ts_mov_b32 m0, %0" : "=&s"(keep) : "v"(gsrc), "s"(lds_dst) : "memory"); }
__device__ __forceinline__ int crow(int r, int hi) { return (r & 3) + 8 * (r >> 2) + 4 * hi; }
#define A8_WAITBAR(N) asm volatile("s_waitcnt vmcnt(" #N ") lgkmcnt(0)\n\ts_barrier" ::: "memory")
#define A8_WAITBAR_N(N) asm volatile("s_waitcnt vmcnt(%0) lgkmcnt(0)\n\ts_barrier" :: "n"(N) : "memory")
template <int NT> __device__ __forceinline__ void attn_unit_f8(const Job& J, char* shm, const int wid_in) {
  int wid = wid_in; asm volatile("" : "+s"(wid));
  const int lane = lane_id_asm(), r32 = lane & 31, hi = lane >> 5;
  const unsigned lds0 = (unsigned)(uintptr_t)shm;
  typedef __attribute__((address_space(3))) const char* lds_cptr;
  const lds_cptr shm3 = (lds_cptr)shm;
  const bool kwave = wid < 4;
  const int w4 = wid & 3; const int drow = 16 * w4 + (lane >> 2); const int cl = (lane & 3) ^ ((drow >> 2) & 3);
  const unsigned char* dsrc = kwave ? J.K + (long)drow * 256 + 16 * cl : J.VT + (long)drow * 4096 + 16 * cl;
  const long dstep = kwave ? 64 * 256 : 64;
  const unsigned ddst = lds0 + (kwave ? L_K : L_V) + w4 * 1024;
  #define A8_DMA(t, slot) glds16(dsrc + (long)(t) * dstep, (unsigned)__builtin_amdgcn_readfirstlane(ddst + (slot)))
  const int sw = (r32 >> 2) & 3; const int foff0 = r32 * 64 + 16 * ((2 * hi) ^ sw), foff1 = r32 * 64 + 16 * ((2 * hi + 1) ^ sw);
  #define A8_FRAG(base, half) __builtin_shufflevector(*(const __attribute__((address_space(3))) i32x4*)((base) + (half) * 2048 + foff0), *(const __attribute__((address_space(3))) i32x4*)((base) + (half) * 2048 + foff1), 0, 1, 2, 3, 4, 5, 6, 7)
  const unsigned char* qp = J.Q + (long)(wid * 32 + r32) * 1024 + 32 * hi;
  const i32x8 qf = __builtin_shufflevector(*(const i32x4*)qp, *(const i32x4*)(qp + 16), 0, 1, 2, 3, 4, 5, 6, 7);
  if (kwave) { _Pragma("unroll") for (int i = 0; i < RING; ++i) A8_DMA(i, i * SLOT); } else { _Pragma("unroll") for (int i = 0; i < RING - 2; ++i) A8_DMA(i, i * SLOT); }
  f32x16 o0 = f32x16{}, o1 = f32x16{}, o2 = f32x16{}; const f32x16 zero = f32x16{};
  int one_w = 0x38383838; asm volatile("" : "+v"(one_w));
  i32x8 ones; _Pragma("unroll") for (int w = 0; w < 8; ++w) ones[w] = one_w;
  asm volatile("" : "+v"(ones));
  f32x16 SA0, SA1, SB0, SB1; i32x8 PA, PB;
  A8_WAITBAR_N(RING - 1);
  { const i32x8 k0 = A8_FRAG(shm3 + L_K, 0), k1 = A8_FRAG(shm3 + L_K, 1);
    SA0 = __builtin_amdgcn_mfma_scale_f32_32x32x64_f8f6f4(k0, qf, zero, 0, 0, 0, 0, 0, 0); SA1 = __builtin_amdgcn_mfma_scale_f32_32x32x64_f8f6f4(k1, qf, zero, 0, 0, 0, 0, 0, 0); }
  #define A8_SB() __builtin_amdgcn_sched_barrier(0)
  #define A8_SLOTOF(i) ((((i) + RING) & (RING - 1)) * SLOT)
  #define A8_EXP8(X, B) do { _Pragma("unroll") for (int r = 0; r < 8; ++r) X[(B) + r] = __builtin_amdgcn_exp2f(X[(B) + r]); asm volatile("" : "+v"(X)); } while (0)
  #define A8_CVT4(P, WB, X) do { _Pragma("unroll") for (int w = 0; w < 4; ++w) { unsigned a_ = (unsigned)P[(WB) + w];     \
      a_ = __builtin_amdgcn_cvt_pk_bf8_f32(X[4 * w], X[4 * w + 1], a_, false); a_ = __builtin_amdgcn_cvt_pk_bf8_f32(X[4 * w + 2], X[4 * w + 3], a_, true); P[(WB) + w] = (int)a_; } asm volatile("" : "+v"(P)); } while (0)
  #define A8_STEP(C0, C1, N0, N1, PP, PN, t, WK, WV, DK, DV, QK, PV, EX) do { \
    if (kwave) { A8_WAITBAR_N(WK); } else { A8_WAITBAR_N(WV); } \
    if (kwave) { if (DK) A8_DMA((t) + RING, A8_SLOTOF(t)); } else { if (DV) A8_DMA((t) - 2 + RING, A8_SLOTOF((t) - 2)); } \
    i32x8 k0_ = ones, k1_ = ones, v0_ = ones, v1_ = ones; \
    if (QK) { k0_ = A8_FRAG(shm3 + L_K + A8_SLOTOF((t) + 1), 0); k1_ = A8_FRAG(shm3 + L_K + A8_SLOTOF((t) + 1), 1); } \
    if (PV) { v0_ = A8_FRAG(shm3 + L_V + A8_SLOTOF((t) - 1), 0); v1_ = A8_FRAG(shm3 + L_V + A8_SLOTOF((t) - 1), 1); } \
    A8_SB(); \
    if (EX) A8_EXP8(C0, 0); A8_SB(); \
    if (QK) { __builtin_amdgcn_s_setprio(1); N0 = __builtin_amdgcn_mfma_scale_f32_32x32x64_f8f6f4(k0_, qf, zero, 0, 0, 0, 0, 0, 0); __builtin_amdgcn_s_setprio(0); } if (EX) A8_EXP8(C0, 8); A8_SB(); \
    if (QK) { __builtin_amdgcn_s_setprio(1); N1 = __builtin_amdgcn_mfma_scale_f32_32x32x64_f8f6f4(k1_, qf, zero, 0, 0, 0, 0, 0, 0); __builtin_amdgcn_s_setprio(0); } if (EX) A8_EXP8(C1, 0); A8_SB(); \
    if (PV) { __builtin_amdgcn_s_setprio(1); o0 = __builtin_amdgcn_mfma_scale_f32_32x32x64_f8f6f4(PP, v0_, o0, 1, 0, 0, 0, 0, 0); __builtin_amdgcn_s_setprio(0); } if (EX) A8_EXP8(C1, 8); A8_SB(); \
    if (PV) { __builtin_amdgcn_s_setprio(1); o1 = __builtin_amdgcn_mfma_scale_f32_32x32x64_f8f6f4(PP, v1_, o1, 1, 0, 0, 0, 0, 0); __builtin_amdgcn_s_setprio(0); } if (EX) A8_CVT4(PN, 0, C0); A8_SB(); \
    if (PV) { __builtin_amdgcn_s_setprio(1); o2 = __builtin_amdgcn_mfma_scale_f32_32x32x64_f8f6f4(PP, ones, o2, 1, 0, 0, 0, 0, 0); __builtin_amdgcn_s_setprio(0); } if (EX) A8_CVT4(PN, 4, C1); A8_SB();     \
  } while (0)
  #define A8_EVEN(t, WK, WV, DK, DV, QK, PV, EX) A8_STEP(SA0, SA1, SB0, SB1, PB, PA, t, WK, WV, DK, DV, QK, PV, EX)
  #define A8_ODD(t, WK, WV, DK, DV, QK, PV, EX)  A8_STEP(SB0, SB1, SA0, SA1, PA, PB, t, WK, WV, DK, DV, QK, PV, EX)
  PA = ones; PB = ones;
  static_assert(RING == 8 && NT % 2 == 0 && NT >= 2 * RING, "the peeled tail below is written for RING = 8");
  A8_EVEN(0, 6, 6, true, true, true, false, true);
#pragma unroll 1
  for (int t = 1; t < NT - 9; t += 2) {
    A8_ODD(t, 6, 6, true, true, true, true, true);
    A8_EVEN(t + 1, 6, 6, true, true, true, true, true);
  }
  A8_ODD(NT - 9, 6, 6, true, true, true, true, true);
  A8_EVEN(NT - 8, 6, 6, false, true, true, true, true);
  A8_ODD(NT - 7, 5, 6, false, true, true, true, true);
  A8_EVEN(NT - 6, 4, 6, false, false, true, true, true);
  A8_ODD(NT - 5, 3, 5, false, false, true, true, true);
  A8_EVEN(NT - 4, 2, 4, false, false, true, true, true);
  A8_ODD(NT - 3, 1, 3, false, false, true, true, true);
  A8_EVEN(NT - 2, 0, 2, false, false, true, true, true);
  A8_ODD(NT - 1, 0, 1, false, false, false, true, true);
  A8_EVEN(NT, 0, 0, false, false, false, true, false);
  #undef A8_EVEN
  #undef A8_ODD
  #undef A8_STEP
  #undef A8_EXP8
  #undef A8_CVT4
  #undef A8_SB
  #undef A8_SLOTOF
  #undef A8_FRAG
  #undef A8_DMA
  float rli[16];
  #pragma unroll
  for (int r = 0; r < 16; ++r) rli[r] = __builtin_amdgcn_rcpf(o2[r]);
  unsigned char* stg8 = (unsigned char*)(shm + L_OST) + wid * 4096;
  #pragma unroll
  for (int r = 0; r < 16; ++r) { const int orow = crow(r, hi);
    const float a = o0[r] * rli[r], b = o1[r] * rli[r];
    stg8[orow * 64 + r32] = (unsigned char)(__builtin_amdgcn_cvt_pk_fp8_f32(a, a, 0, false) & 0xff); stg8[orow * 64 + 32 + r32] = (unsigned char)(__builtin_amdgcn_cvt_pk_fp8_f32(b, b, 0, false) & 0xff); }
  asm volatile("s_waitcnt lgkmcnt(0)" ::: "memory");
  unsigned char* Ow = J.O + (long)(wid * 32) * 1024;
  #pragma unroll
  for (int i = 0; i < 2; ++i) { const int row = i * 16 + (lane >> 2), ch = lane & 3; const u32x4 v = *(const u32x4*)(stg8 + row * 64 + ch * 16); *(u32x4*)(Ow + (long)row * 1024 + ch * 16) = v; }
  asm volatile("s_waitcnt lgkmcnt(0)\n\ts_barrier" ::: "memory");
}
#undef A8_WAITBAR
#undef A8_WAITBAR_N
}

constexpr size_t MiB = 1u << 20;
constexpr size_t WS_CTL = 0, CTL_ZERO_BYTES = 1 * MiB;
constexpr size_t WS_CNT = 512 * 1024;
constexpr size_t WS_MOD = 1 * MiB;
constexpr size_t WS_ROPE = WS_MOD + 512 * 1024;
constexpr size_t WS_BLUT = WS_ROPE + 8192;
constexpr size_t WS_RC0 = WS_BLUT + 12 * 768 * 4;
constexpr size_t WS_HIST = WS_RC0 + 4096;
constexpr size_t WS_TILEE = WS_HIST + 32768;
constexpr size_t WS_TOPE = 2 * MiB;
constexpr size_t WS_TOPW = WS_TOPE + 512 * 1024;
constexpr size_t WS_SLOT = WS_TOPW + 512 * 1024;
constexpr size_t WS_ROWW = WS_SLOT + 512 * 1024;
constexpr size_t WS_ROWTOK = 4 * MiB + 256 * 1024;
constexpr size_t WS_LSE = 5 * MiB;
constexpr size_t WS_WRHI = 7 * MiB;
constexpr size_t WS_WRLO = 8 * MiB;
constexpr size_t WS_WIN = 9 * MiB;
constexpr size_t WS_WBRA = 32 * MiB;
constexpr size_t WS_WBRB = 33 * MiB;
constexpr size_t WS_WOUT = 37 * MiB;
constexpr size_t WS_WGU = 41 * MiB;
constexpr size_t WS_WDN = 297 * MiB;
constexpr size_t WS_X = 425 * MiB;
constexpr size_t WS_H = 553 * MiB;
constexpr size_t WS_R = 617 * MiB;
constexpr size_t WS_AQKV = WS_R;
constexpr size_t WS_QB = WS_R + 144 * MiB;
constexpr size_t WS_KB = WS_R + 208 * MiB;
constexpr size_t WS_VB = WS_R + 224 * MiB;
constexpr size_t WS_GATE = WS_R + 240 * MiB;
constexpr size_t WS_OAG = WS_R + 368 * MiB;
constexpr size_t WS_OA = WS_R + 416 * MiB;
constexpr size_t WS_MERGED = WS_R + 432 * MiB;
constexpr size_t WS_XS = WS_R;
constexpr size_t WS_ACT = WS_R + 136 * MiB;
constexpr size_t WS_Y = WS_R + 272 * MiB;
constexpr size_t WS_OB = WS_R + 496 * MiB;
constexpr size_t WS_M8 = WS_R + 560 * MiB;
constexpr size_t WS_END = WS_R + 592 * MiB;
constexpr int CW_BAR = 4096;

constexpr int RING_BYTES = 133120;
constexpr int LDSCTL_OFF = RING_BYTES;
constexpr int LDS_BYTES = 147456;
constexpr int NWAVES = 8;

#define GAS __attribute__((address_space(1)))
#define LAS __attribute__((address_space(3)))
typedef unsigned short bf16;
typedef unsigned v4u __attribute__((ext_vector_type(4)));
typedef unsigned v2u __attribute__((ext_vector_type(2)));
typedef float f32x4 __attribute__((ext_vector_type(4)));
typedef float f32x16 __attribute__((ext_vector_type(16)));
typedef int i32x4 __attribute__((ext_vector_type(4)));
typedef short bf16x8 __attribute__((ext_vector_type(8)));
typedef GAS unsigned gu32;
#define RLX_AGENT __ATOMIC_RELAXED, __HIP_MEMORY_SCOPE_AGENT
#define LDS_WAIT() asm volatile("s_waitcnt lgkmcnt(0)" ::: "memory")
__device__ __forceinline__ unsigned f2bf(float f) { unsigned u = __builtin_bit_cast(unsigned, f); return (u + 0x7fffu + ((u >> 16) & 1u)) >> 16; }
__device__ __forceinline__ unsigned pk2(float lo, float hi) { return f2bf(lo) | (f2bf(hi) << 16); }
__device__ __forceinline__ float bfl(unsigned w) { return __uint_as_float(w << 16); }
__device__ __forceinline__ float bfh(unsigned w) { return __uint_as_float(w & 0xffff0000u); }

#define XB_TMO      128
#define XB_XCNT(j)  (256  + 64 * (j))
#define XB_XSUB(j)  (1280 + 64 * (j))
#define XB_XGEN(j)  (2304 + 64 * (j))
#define XB_TOP      3328
#define XB_TOPGEN   3392
#define XCD_BAR_WORDS 3456
#define XB_SPIN_CAP (1u << 18)
__device__ __forceinline__ unsigned xb_ld(unsigned* p)              { return __hip_atomic_load(p, __ATOMIC_RELAXED, __HIP_MEMORY_SCOPE_AGENT); }
__device__ __forceinline__ unsigned xb_add(unsigned* p, unsigned v) { return __hip_atomic_fetch_add(p, v, __ATOMIC_RELAXED, __HIP_MEMORY_SCOPE_AGENT); }
__device__ __forceinline__ unsigned xb_xcc_id() { return (unsigned)__builtin_amdgcn_s_getreg((3 << 11) | 20) & 0xFu; }
#define XB_SPIN(cond, bar) do { unsigned _sp = 0; while (cond) { __builtin_amdgcn_s_sleep(1); \
    if ((++_sp & 255u) == 0u) { if (xb_ld(&(bar)[XB_TMO])) break; if (_sp > XB_SPIN_CAP) { atomicAdd(&(bar)[XB_TMO], 1u); break; } } } } while (0)
struct XcdBarrier { unsigned* bar; unsigned x; volatile LAS unsigned* st; };
__device__ __forceinline__ XcdBarrier xcd_barrier_post(unsigned* bar, volatile LAS unsigned* st) {
    XcdBarrier b; b.bar = bar; b.x = xb_xcc_id(); b.st = st;
    if (threadIdx.x == 0) (void)xb_add(&bar[XB_XCNT(b.x)], 1u);
    return b;
}
__device__ __forceinline__ void xcd_barrier_complete(unsigned* bar, unsigned x, unsigned& nloc, unsigned& nx) {
    const unsigned G = gridDim.x * gridDim.y * gridDim.z;
    unsigned sum, cnt, mine, sp = 0u;
    for (;;) {
        sum = 0u; cnt = 0u; mine = 0u;
#pragma unroll
        for (unsigned j = 0; j < 16; ++j) { const unsigned c = xb_ld(&bar[XB_XCNT(j)]); sum += c; cnt += (c > 0u) ? 1u : 0u; mine = (j == x) ? c : mine; }
        if (sum == G) break;
        __builtin_amdgcn_s_sleep(1);
        if ((++sp & 255u) == 0u) { if (xb_ld(&bar[XB_TMO])) break; if (sp > XB_SPIN_CAP) { atomicAdd(&bar[XB_TMO], 1u); break; } }
    }
    nloc = mine > 0u ? mine : 1u; nx = cnt > 0u ? cnt : 1u;
}
__device__ __forceinline__ void xcd_barrier(const XcdBarrier& b) {
    asm volatile("s_waitcnt vmcnt(0)" ::: "memory");
    __syncthreads();
    if (threadIdx.x == 0) {
        unsigned* bar = b.bar;
        __builtin_amdgcn_s_waitcnt(0);
        unsigned nloc = b.st[0], nx = b.st[1];
        if (nloc == 0u) { xcd_barrier_complete(bar, b.x, nloc, nx); b.st[0] = nloc; b.st[1] = nx; }
        const unsigned old = xb_add(&bar[XB_XSUB(b.x)], 1u);
        const unsigned gen = old / nloc;
        if (old + 1u == (gen + 1u) * nloc) {
            __builtin_amdgcn_fence(__ATOMIC_RELEASE, "agent");
            asm volatile("s_waitcnt vmcnt(0)" ::: "memory");
            const unsigned og = xb_add(&bar[XB_TOP], 1u);
            const unsigned tg = og / nx;
            if (og + 1u == (tg + 1u) * nx) xb_add(&bar[XB_TOPGEN], 1u);
            else XB_SPIN(xb_ld(&bar[XB_TOPGEN]) == tg, bar);
            __builtin_amdgcn_fence(__ATOMIC_ACQUIRE, "agent");
            xb_add(&bar[XB_XGEN(b.x)], 1u);
            asm volatile("s_waitcnt vmcnt(0)" ::: "memory");
        } else {
            XB_SPIN(xb_ld(&bar[XB_XGEN(b.x)]) == gen, bar);
            __builtin_amdgcn_fence(__ATOMIC_ACQUIRE, "agent");
            asm volatile("s_waitcnt vmcnt(0)" ::: "memory");
        }
    }
    __syncthreads();
}

__device__ __forceinline__ float wave_sum(float v) {
    v = xsum<1>(v); v = xsum<2>(v); v = xsum<4>(v); v = xsum<8>(v); v = xsum<16>(v); v = xsum<32>(v);
    return v;
}
struct CvtItem { const float* W; unsigned char* WT; int ldw, K, srcA, srcB, dst_row0, k0; bool ident; };
__device__ __forceinline__ void cvt_load_f8(const CvtItem& I, int lane, f32x4 (&v)[16]) {
    const int kq = lane >> 4, nq = lane & 15; const int scol = (nq < 8 ? I.srcA + 4 * nq : I.srcB + 4 * (nq - 8));
#pragma unroll
    for (int i = 0; i < 16; ++i) v[i] = __builtin_nontemporal_load((const GAS f32x4*)(I.W + (size_t)(I.k0 + 4 * i + kq) * I.ldw + scol));
}
__device__ __forceinline__ void cvt_store_f8(const CvtItem& I, const f32x4 (&v)[16], LAS float* scr, int lane) {
    const int kq = lane >> 4, nq = lane & 15;
#pragma unroll
    for (int i = 0; i < 16; ++i)
#pragma unroll
        for (int e = 0; e < 4; ++e) scr[(4 * i + kq) * 65 + 4 * nq + e] = v[i][e] * pg8::W8_SCALE;
    LDS_WAIT(); asm volatile("" ::: "memory");
    const int c = lane & 7, rr = lane >> 3;
#pragma unroll
    for (int j = 0; j < 8; ++j) { const int rho = rr + 8 * j; const int sc = (rho & 32) + (I.ident ? (rho & 31) : pg8::perm32(rho & 31)); const LAS float* s = scr + (8 * c) * 65 + sc;
        unsigned w0 = 0, w1 = 0;
        w0 = __builtin_amdgcn_cvt_pk_fp8_f32(s[0 * 65], s[1 * 65], w0, false); w0 = __builtin_amdgcn_cvt_pk_fp8_f32(s[2 * 65], s[3 * 65], w0, true);
        w1 = __builtin_amdgcn_cvt_pk_fp8_f32(s[4 * 65], s[5 * 65], w1, false); w1 = __builtin_amdgcn_cvt_pk_fp8_f32(s[6 * 65], s[7 * 65], w1, true);
        v2u o; o.x = w0; o.y = w1; *(GAS v2u*)(I.WT + (size_t)(I.dst_row0 + rho) * I.K + I.k0 + 8 * c) = o; }
    LDS_WAIT(); asm volatile("" ::: "memory");
}
__device__ __forceinline__ int win_src(int X) { const int pn = X >> 3, bj = (X >> 2) & 1, wc = X & 3; return (pn >= 9 && pn < 14) ? pn * 256 + 64 * wc + 32 * bj : 32 * X; }
__device__ __forceinline__ int wgu_src(int X) { const int pn = X >> 3, bj = (X >> 2) & 1, wc = X & 3; return bj * 1024 + 128 * pn + 32 * wc; }

__device__ __forceinline__ void norm_rows2_f8(const float* xrow, const float* g, const float* sc, const float* sh, unsigned char* orow, int lane) {
    const float* xr = xrow + 16 * lane;
    f32x4 v[2][4]; float s0 = 0.f, s1 = 0.f;
#pragma unroll
    for (int j = 0; j < 4; ++j) { v[0][j] = *(const GAS f32x4*)(xr + 4 * j); v[1][j] = *(const GAS f32x4*)(xr + D + 4 * j); }
#pragma unroll
    for (int j = 0; j < 4; ++j) { s0 += (v[0][j].x * v[0][j].x + v[0][j].y * v[0][j].y) + (v[0][j].z * v[0][j].z + v[0][j].w * v[0][j].w); s1 += (v[1][j].x * v[1][j].x + v[1][j].y * v[1][j].y) + (v[1][j].z * v[1][j].z + v[1][j].w * v[1][j].w); }
    const float rs0 = rsqrtf(wave_sum(s0) * (1.0f / D) + EPS), rs1 = rsqrtf(wave_sum(s1) * (1.0f / D) + EPS);
    v4u h0, h1; const int c = 16 * lane;
#pragma unroll
    for (int j = 0; j < 4; ++j) {
        const f32x4 gg = *(const GAS f32x4*)(g + c + 4 * j), a1 = *(const GAS f32x4*)(sc + c + 4 * j) + 1.0f, a0 = *(const GAS f32x4*)(sh + c + 4 * j);
        const f32x4 y0 = (v[0][j] * rs0 * gg) * a1 + a0, y1 = (v[1][j] * rs1 * gg) * a1 + a0;
        unsigned w0 = 0, w1 = 0;
        w0 = __builtin_amdgcn_cvt_pk_fp8_f32(y0.x, y0.y, w0, false); w0 = __builtin_amdgcn_cvt_pk_fp8_f32(y0.z, y0.w, w0, true);
        w1 = __builtin_amdgcn_cvt_pk_fp8_f32(y1.x, y1.y, w1, false); w1 = __builtin_amdgcn_cvt_pk_fp8_f32(y1.z, y1.w, w1, true);
        h0[j] = w0; h1[j] = w1; }
    *(GAS v4u*)(orow + c) = h0; *(GAS v4u*)(orow + D + c) = h1;
}

__device__ __forceinline__ bool gqa_bound_ok(const float* qg, const float* kg, int lane) {
    float gq = fabsf(qg[lane]), gk = fabsf(kg[lane]);
#define MK_MAXSTEP(m) gq = fmaxf(gq, __int_as_float(__builtin_amdgcn_ds_swizzle(__float_as_int(gq), 0x1f | ((m) << 10)))); gk = fmaxf(gk, __int_as_float(__builtin_amdgcn_ds_swizzle(__float_as_int(gk), 0x1f | ((m) << 10))))
    MK_MAXSTEP(1); MK_MAXSTEP(2); MK_MAXSTEP(4); MK_MAXSTEP(8); MK_MAXSTEP(16);
#undef MK_MAXSTEP
    gq = fmaxf(gq, xget32(gq, lane >> 5)); gk = fmaxf(gk, xget32(gk, lane >> 5));
    const float bound = 64.0f * gq * gk * C2 * 1.01f; return __builtin_amdgcn_readfirstlane((int)(bound <= 14.0f)) != 0;
}

struct Args { const float* in[20]; float* out; unsigned char* ws; int ph_lo, ph_hi, li, pad; };
constexpr int N_PHASES = 2 + 10 * DEPTH;

typedef const __attribute__((address_space(4))) Args* kargs_t;
__device__ __forceinline__ kargs_t kargs_opaque() { kargs_t p = (kargs_t)__builtin_amdgcn_kernarg_segment_ptr(); asm volatile("" : "+s"(p)); return p; }
#define PH_BEGIN() kargs_t ap = kargs_opaque(); unsigned char* ws = ap->ws; (void)ws; \
    int wave = wave_s; asm volatile("" : "+s"(wave)); const int lane = lane_id_asm(); const int tid = wave * 64 + lane; (void)lane; (void)tid; \
    int bx = blockIdx.x; asm volatile("" : "+s"(bx)); int G = gridDim.x; asm volatile("" : "+s"(G)); const int vcu = (G % 8 == 0) ? (bx % 8) * (G / 8) + bx / 8 : bx; (void)vcu; \
    const int gw = vcu * NWAVES + wave, NGW = G * NWAVES; (void)gw; (void)NGW; const int gtid = vcu * (NWAVES * 64) + tid, NGT = G * NWAVES * 64; (void)gtid; (void)NGT
#define INP(k) (ap->in[k])
#define x_in INP(0)
#define c_in INP(1)
#define w_ada INP(2)
#define b_ada INP(3)
#define norm1_g INP(4)
#define w_in INP(5)
#define q_norm_g INP(6)
#define k_norm_g INP(7)
#define rel_bias INP(8)
#define w_br_a INP(9)
#define w_br_b INP(10)
#define w_out INP(11)
#define norm2_g INP(12)
#define w_router INP(13)
#define b_router INP(14)
#define w_gate_up INP(15)
#define b_gate_up INP(16)
#define w_down INP(17)
#define b_down INP(18)
#define final_g INP(19)
#define MOD ((float*)(ws + WS_MOD))
#define ROPE ((float*)(ws + WS_ROPE))
#define BLUT ((float*)(ws + WS_BLUT))
#define RC0 ((float*)(ws + WS_RC0))
#define HIST ((int*)(ws + WS_HIST))
#define TILEE ((int*)(ws + WS_TILEE))
#define TOPE ((int*)(ws + WS_TOPE))
#define TOPW ((float*)(ws + WS_TOPW))
#define SLOT ((int*)(ws + WS_SLOT))
#define ROWW ((float*)(ws + WS_ROWW))
#define ROWTOK ((int*)(ws + WS_ROWTOK))
#define CNT ((int*)(ws + WS_CNT))
#define ROWTOK2 ((int*)(ws + WS_XS))
#define ROWW2 ((float*)(ws + WS_XS + 4 * MiB))
#define LSE ((float*)(ws + WS_LSE))
#define WRHI ((bf16*)(ws + WS_WRHI))
#define WRLO ((bf16*)(ws + WS_WRLO))
#define WIN ((unsigned char*)(ws + WS_WIN))
#define WBRA ((unsigned char*)(ws + WS_WBRA))
#define WBRB ((unsigned char*)(ws + WS_WBRB))
#define WOUT ((unsigned char*)(ws + WS_WOUT))
#define WGU ((unsigned char*)(ws + WS_WGU))
#define WDN ((unsigned char*)(ws + WS_WDN))
#define X ((bf16*)(ws + WS_X))
#define H ((bf16*)(ws + WS_H))
#define H8 ((unsigned char*)(ws + WS_H))
#define AQKV ((bf16*)(ws + WS_AQKV))
#define QB ((bf16*)(ws + WS_QB))
#define KB ((bf16*)(ws + WS_KB))
#define VB ((bf16*)(ws + WS_VB))
#define GATE ((bf16*)(ws + WS_GATE))
#define OAG ((bf16*)(ws + WS_OAG))
#define OA ((unsigned char*)(ws + WS_OA))
#define MERGED ((bf16*)(ws + WS_MERGED))
#define OB ((unsigned char*)(ws + WS_OB))
#define M8 ((unsigned char*)(ws + WS_M8))
#define XS ((unsigned char*)(ws + WS_XS))
#define ACT ((unsigned char*)(ws + WS_ACT))
#define YB ((unsigned char*)(ws + WS_Y))
__global__ void __launch_bounds__(NWAVES * 64, 2) mk_fwd(Args args) {
    extern __shared__ __attribute__((aligned(16))) unsigned char lds[];
    LAS unsigned char* L = (LAS unsigned char*)lds;
    volatile LAS unsigned* MISC = (volatile LAS unsigned*)(L + LDSCTL_OFF);
    gu32* ctl = (gu32*)(args.ws + WS_CTL);
    const int wave_s = __builtin_amdgcn_readfirstlane(threadIdx.x >> 6);
    for (int u = threadIdx.x; u < (LDS_BYTES - LDSCTL_OFF) / 4; u += NWAVES * 64) ((LAS unsigned*)(L + LDSCTL_OFF))[u] = 0u;
    __syncthreads();
    XcdBarrier bar; bar.bar = (unsigned*)(ctl + CW_BAR) + args.li * XCD_BAR_WORDS; bar.x = 0; bar.st = nullptr;
    if (!MK_PER_PHASE) bar = xcd_barrier_post((unsigned*)(ctl + CW_BAR) + args.li * XCD_BAR_WORDS, MISC + 8);
    const int lo = args.ph_lo, hi = args.ph_hi;
    unsigned long long t_prev = PROBE_SPIN_MASK ? __builtin_amdgcn_s_memrealtime() : 0ull; (void)t_prev;
#define IN(k) (lo <= (k) && (k) < hi)
#define KIND(q) ((PH_KIND_MASK >> (q)) & 1)
#define SEAM(k) SEAMK(k, ((k) < 2 ? (k) : 2 + ((k) - 2) % 10))
#define SEAMK(k, kind) do { if (IN(k) && IN((k) + 1)) { xcd_barrier(bar); \
    if (PROBE_SPIN_MASK) { if (blockIdx.x == 0) { if (threadIdx.x == 0) { const unsigned long long tn_ = __builtin_amdgcn_s_memrealtime(); \
          if ((PROBE_SPIN_MASK >> (kind)) & 1) { const unsigned long long te_ = tn_ + 9ull * (tn_ - t_prev); while (__builtin_amdgcn_s_memrealtime() < te_) __builtin_amdgcn_s_sleep(8); } } \
        __syncthreads(); } t_prev = __builtin_amdgcn_s_memrealtime(); } } } while (0)

    for (int rep0 = 0; rep0 < 1 + PROBE_P0; ++rep0) {
    if (KIND(0) && IN(0)) { PH_BEGIN();
        {
            LAS float* cact = (LAS float*)L;
            LAS float* part = (LAS float*)(L + 32768);
            for (int i = tid; i < NB * D; i += NWAVES * 64) { const float cv = c_in[i]; cact[i] = cv / (1.0f + __expf(-cv)); }
            __syncthreads();
            for (int vb = bx; vb < 256; vb += G) {
                const int gc0 = vb * 48; const int l = gc0 / 6144, col0 = gc0 % 6144;
                const int kq = lane / 12, c4 = lane % 12;
                if (lane < 48) {
                    const float* wp = w_ada + (size_t)l * D * 6144 + col0 + 4 * c4 + (size_t)(wave * 128 + kq) * 6144;
                    f32x4 w[32];
#pragma unroll
                    for (int i = 0; i < 32; ++i) w[i] = *(const GAS f32x4*)(wp + (size_t)(4 * i) * 6144);
                    f32x4 a[NB];
#pragma unroll
                    for (int b = 0; b < NB; ++b) a[b] = (f32x4){0.f, 0.f, 0.f, 0.f};
#pragma unroll
                    for (int i = 0; i < 32; ++i) { const int k = wave * 128 + 4 * i + kq;
#pragma unroll
                        for (int b = 0; b < NB; ++b) a[b] += w[i] * cact[b * D + k]; }
#pragma unroll
                    for (int b = 0; b < NB; ++b) *(LAS f32x4*)(part + ((wave * 4 + kq) * NB + b) * 48 + 4 * c4) = a[b];
                }
                __syncthreads();
                if (tid < NB * 48) { const int b = tid / 48, cl = tid % 48;
                    float s = b_ada[l * 6144 + col0 + cl];
#pragma unroll 8
                    for (int q = 0; q < 32; ++q) s += part[(q * NB + b) * 48 + cl];
                    MOD[((size_t)l * NB + b) * 6144 + col0 + cl] = s; }
                __syncthreads();
            }
        }
        for (int i = gtid; i < 1024 + 12 * 768; i += NGT) {
            if (i < 1024) { const int p = i >> 4, f = i & 15; const double inv = pow(10000.0, -(double)f / 16.0); const double ang = (double)p * inv; ROPE[i] = (float)cos(ang); ROPE[1024 + i] = (float)sin(ang); }
            else { const int j = i - 1024; const int hh = j / 768, di = j % 768; const int delta = di - 383; const int g = hh >> 2; const int dil = g == 0 ? 1 : (g == 1 ? 4 : 16);
                float val = -INFINITY;
                if (delta >= -64 && delta <= 64) { const int rel = delta * dil; const int n = rel < 0 ? -rel : rel; int bk = rel > 0 ? 16 : 0;
                    if (n < 8) bk += n; else { int lg = 8 + (int)(logf((float)n / 8.0f) / logf(128.0f) * 8.0f); if (lg > 15) lg = 15; bk += lg; }
                    val = rel_bias[bk * 12 + hh] * LOG2E; }
                BLUT[j] = val; }
        }
        {
            LAS float* scr = (LAS float*)(L + wave * 16640);
            __syncthreads();
            constexpr int I_IN = 16 * 92, I_BRA = 4 * 16, I_BRB = 16 * 16, I_OUT = 16 * 16, I_GU = 16 * 32, I_DN = 16 * 16;
            constexpr int PER_L = I_IN + I_BRA + I_BRB + I_OUT;
            constexpr int NITEMS = DEPTH * PER_L + DEPTH * NE * (I_GU + I_DN);
#define CVT_DECODE(I, it_) do { int r = (it_); \
                if (r < DEPTH * PER_L) { const int l = r / PER_L; r %= PER_L; \
                    if (r < I_IN) { const int kb = r / 92, g64 = r % 92; I = CvtItem{w_in + (size_t)l * D * N_IN, WIN + (size_t)l * N_IN * D, N_IN, D, win_src(2 * g64), win_src(2 * g64 + 1), 64 * g64, 64 * kb, (g64 >> 2) >= 9 && (g64 >> 2) < 14}; break; } r -= I_IN; \
                    if (r < I_BRA) { const int kb = r / 16, g64 = r % 16; I = CvtItem{w_br_a + (size_t)l * 256 * D, WBRA + (size_t)l * D * 256, D, 256, 64 * g64, 64 * g64 + 32, 64 * g64, 64 * kb, false}; break; } r -= I_BRA; \
                    if (r < I_BRB) { const int kb = r / 16, g64 = r % 16; I = CvtItem{w_br_b + (size_t)l * D * D, WBRB + (size_t)l * D * D, D, D, 64 * g64, 64 * g64 + 32, 64 * g64, 64 * kb, false}; break; } r -= I_BRB; \
                    { const int kb = r / 16, g64 = r % 16; I = CvtItem{w_out + (size_t)l * D * D, WOUT + (size_t)l * D * D, D, D, 64 * g64, 64 * g64 + 32, 64 * g64, 64 * kb, false}; break; } } \
                r -= DEPTH * PER_L; \
                if (r < DEPTH * NE * I_GU) { const int le = r / I_GU; r %= I_GU; const int kb = r / 32, g64 = r % 32; \
                    I = CvtItem{w_gate_up + (size_t)le * D * 2048, WGU + (size_t)le * 2048 * D, 2048, D, wgu_src(2 * g64), wgu_src(2 * g64 + 1), 64 * g64, 64 * kb, false}; break; } \
                r -= DEPTH * NE * I_GU; \
                { const int le = r / I_DN; r %= I_DN; const int kb = r / 16, g64 = r % 16; I = CvtItem{w_down + (size_t)le * D * D, WDN + (size_t)le * D * D, D, D, 64 * g64, 64 * g64 + 32, 64 * g64, 64 * kb, false}; } } while (0)
            CvtItem ia, ib; f32x4 va[16], vb[16];
            int it = gw;
            if (it < NITEMS) { CVT_DECODE(ia, it); cvt_load_f8(ia, lane, va); }
            for (; it < NITEMS; it += 2 * NGW) {
                const bool h1 = it + NGW < NITEMS;
                if (h1) { CVT_DECODE(ib, it + NGW); cvt_load_f8(ib, lane, vb); }
                cvt_store_f8(ia, va, scr, lane);
                if (it + 2 * NGW < NITEMS) { CVT_DECODE(ia, it + 2 * NGW); cvt_load_f8(ia, lane, va); }
                if (h1) cvt_store_f8(ib, vb, scr, lane);
            }
#undef CVT_DECODE
        }
    }
    SEAM(0);
    }
    if (KIND(1) && IN(1)) { PH_BEGIN();
        for (int rg = gw; rg < T / 16; rg += NGW) { const int mb = rg * 16, b = mb >> 12, c = 16 * lane; const float* md = MOD + (size_t)b * 6144;
            f32x4 gna[4], a0v[4];
#pragma unroll
            for (int j = 0; j < 4; ++j) { gna[j] = *(const GAS f32x4*)(norm1_g + c + 4 * j) * (*(const GAS f32x4*)(md + 1024 + c + 4 * j) + 1.0f); a0v[j] = *(const GAS f32x4*)(md + c + 4 * j); }
            f32x4 xv[2][2][4];
#define N1_LOAD(buf, it) _Pragma("unroll") for (int q = 0; q < 2; ++q) _Pragma("unroll") for (int j = 0; j < 4; ++j) xv[buf][q][j] = __builtin_nontemporal_load((const GAS f32x4*)(x_in + (size_t)(mb + 2 * (it) + q) * D + c + 4 * j))
            N1_LOAD(0, 0);
#pragma unroll
            for (int it = 0; it < 8; ++it) { const int cb = it & 1;
                if (it < 7) { N1_LOAD(cb ^ 1, it + 1); }
                float s0 = 0.f, s1 = 0.f;
#pragma unroll
                for (int j = 0; j < 4; ++j) { const f32x4 u = xv[cb][0][j], w = xv[cb][1][j]; s0 += (u.x * u.x + u.y * u.y) + (u.z * u.z + u.w * u.w); s1 += (w.x * w.x + w.y * w.y) + (w.z * w.z + w.w * w.w); }
                const float rs0 = rsqrtf(wave_sum(s0) * (1.0f / D) + EPS), rs1 = rsqrtf(wave_sum(s1) * (1.0f / D) + EPS);
                v4u h0, h1;
#pragma unroll
                for (int j = 0; j < 4; ++j) { const f32x4 y0 = (xv[cb][0][j] * rs0) * gna[j] + a0v[j], y1 = (xv[cb][1][j] * rs1) * gna[j] + a0v[j];
                    unsigned w0 = 0, w1 = 0;
                    w0 = __builtin_amdgcn_cvt_pk_fp8_f32(y0.x, y0.y, w0, false); w0 = __builtin_amdgcn_cvt_pk_fp8_f32(y0.z, y0.w, w0, true);
                    w1 = __builtin_amdgcn_cvt_pk_fp8_f32(y1.x, y1.y, w1, false); w1 = __builtin_amdgcn_cvt_pk_fp8_f32(y1.z, y1.w, w1, true);
                    h0[j] = w0; h1[j] = w1; }
                *(GAS v4u*)(H8 + (size_t)(mb + 2 * it) * D + c) = h0; *(GAS v4u*)(H8 + (size_t)(mb + 2 * it + 1) * D + c) = h1;
            }
#undef N1_LOAD
        }
        for (int i = gtid; i < DEPTH * NB * NE * D; i += NGT) { const int k = i & 1023, e = (i >> 10) & 31, b = (i >> 15) & 7, l = i >> 18;
            const float v = norm2_g[l * D + k] * (1.0f + MOD[((size_t)l * NB + b) * 6144 + 4 * 1024 + k]) * w_router[((size_t)l * D + k) * NE + e];
            const unsigned hb = f2bf(v); const float lv = v - __uint_as_float(hb << 16);
            { const int s_ = 2 * (k >> 6) + ((k >> 3) & 1), kb_ = (k >> 4) & 3, j_ = k & 7, h_ = e >> 4, i_ = e & 15;
              const size_t o = (size_t)(l * NB + b) * 65536 + (size_t)((s_ * 2 + h_) * 2) * 512 + (kb_ * 16 + i_) * 8 + j_;
              WRHI[o] = (bf16)hb; WRHI[o + 512] = (bf16)f2bf(lv); } }
        for (int i = gw; i < DEPTH * NB * NE; i += NGW) { const int e = i & 31, b = (i >> 5) & 7, l = i >> 8; float s = 0.f;
            for (int k = lane; k < D; k += 64) s += MOD[((size_t)l * NB + b) * 6144 + 3 * 1024 + k] * w_router[((size_t)l * D + k) * NE + e];
            s = wave_sum(s); if (lane == 0) RC0[i] = s + b_router[l * NE + e]; }
    }
    SEAM(1);

    for (int li = (PROBE_MASK ? -1 : 0); li < DEPTH; ++li) {
        const int l = li < 0 ? 0 : li; const bool virt = li < 0;
        const int P = 2 + 10 * l;
#define VK(q) (!virt || ((PROBE_MASK >> (q)) & 1))
        if (KIND(2) && IN(P + 0) && VK(2)) { PH_BEGIN();
            pg8::Gemm g{H, (const bf16*)(WIN + (size_t)l * N_IN * D), D / 2}; pg8::StaticOrder S; S.init(T, N_IN, G, bx);
            const bool f8attn = gqa_bound_ok(q_norm_g + l * 64, k_norm_g + l * 64, lane);
            pg8::EpiIn E{AQKV, QB, KB, VB, GATE, q_norm_g + l * 64, k_norm_g + l * 64, ROPE, pg8::W8_INV, f8attn};
            pg8::gemm_phase_f8<pg8::EpiIn, pg8::StaticOrder>(L, g, S, E, wave);
        }
        if (VK(2)) SEAM(P + 0);
        if (KIND(3) && IN(P + 1) && VK(3)) { PH_BEGIN();
            namespace ab = attn_body;
            const bool nomax = gqa_bound_ok(q_norm_g + l * 64, k_norm_g + l * 64, lane);
            for (int j = 0; j < 8; ++j) {
                const int uidx = vcu * 8 + j; if (uidx >= 2048) break;
                const int pair = uidx >> 6, idx = uidx & 63; const int b = pair >> 2, kvh = pair & 3, hq = idx >> 4, qb = idx & 15; const int h = kvh * 4 + hq;
                ab::Job J; J.Q = (const ab::bf16*)QB + ((size_t)b * SEQ + qb * 256) * 1024 + h * 64; J.K = (const ab::bf16*)KB + (size_t)b * SEQ * 256 + kvh * 64; J.V = (const ab::bf16*)VB + (size_t)b * SEQ * 256 + kvh * 64;
                J.O = (ab::bf16*)(OB + ((size_t)b * SEQ + qb * 256) * 1024 + h * 64)  ; J.lse = nullptr; J.lutg = nullptr; J.NT = 64; J.i0 = 0; J.kq0 = 0; J.dsh = 0; J.cls = 0;
                if (nomax) { attn8::Job J8; J8.Q = (const unsigned char*)QB + ((size_t)b * SEQ + qb * 256) * 1024 + h * 64; J8.K = (const unsigned char*)KB + (size_t)b * SEQ * 256 + kvh * 64;
                    J8.VT = (const unsigned char*)VB + ((size_t)((b * 4 + kvh) * 64) << 12); J8.O = OB + ((size_t)b * SEQ + qb * 256) * 1024 + h * 64;
                    attn8::attn_unit_f8<64>(J8, (char*)lds, wave); }
                else ab::attn_unit<0, 8, false>(J, (char*)lds, wave);
            }
            for (int j = 0; j < 6; ++j) {
                const int uidx = vcu * 6 + j; if (uidx >= 1536) break;
                const int g = uidx / 512, r = uidx % 512; const int b = r >> 6, hs = (r >> 4) & 3, combo = r & 15;
                const int dsh = 2 * g; const int Lc = SEQ >> dsh; const int nqb = Lc >> 8;
                const int cls = combo / nqb, qb = combo % nqb; const int i0 = qb * 256;
                int t0 = (i0 >> 6) - 1; const int ntile = Lc >> 6; const int NT = ntile >= 6 ? 6 : 4; if (t0 < 0) t0 = 0; if (t0 > ntile - NT) t0 = ntile - NT;
                const size_t cbase = (size_t)b * SEQ + (size_t)cls * Lc;
                const ab::bf16* aq = (const ab::bf16*)AQKV + (size_t)(g * 3 + 0) * T * 256; const ab::bf16* ak = (const ab::bf16*)AQKV + (size_t)(g * 3 + 1) * T * 256; const ab::bf16* av = (const ab::bf16*)AQKV + (size_t)(g * 3 + 2) * T * 256;
                ab::Job J; J.Q = aq + (cbase + i0) * 256 + hs * 64; J.K = ak + (cbase + t0 * 64) * 256 + hs * 64; J.V = av + (cbase + t0 * 64) * 256 + hs * 64;
                J.O = (ab::bf16*)OAG + (size_t)g * T * 256 + (size_t)b * SEQ * 256 + hs * 64; J.lse = LSE + (size_t)g * T * 4 + (size_t)b * SEQ * 4 + hs; J.lutg = BLUT + (g * 4 + hs) * 768;
                J.NT = NT; J.i0 = i0; J.kq0 = t0 * 64 - i0; J.dsh = dsh; J.cls = cls;
                ab::attn_unit<1, 8>(J, (char*)lds, wave);
            }
        }
        if (VK(3)) SEAM(P + 1);
        if (KIND(5) && IN(P + 3) && VK(5)) { PH_BEGIN();
            pg8::StaticOrder S; S.init(T, D, G, bx);
#define LC_ITEM_W(u_) const float mx = fmaxf(l0[u_], fmaxf(l1[u_], l2[u_])); float w0 = exp2f(l0[u_] - mx), w1 = exp2f(l1[u_] - mx), w2 = exp2f(l2[u_] - mx); const float inv = 1.0f / (w0 + w1 + w2); w0 *= inv; w1 *= inv; w2 *= inv; \
                        unsigned o0 = 0, o1 = 0;     \
                        o0 = __builtin_amdgcn_cvt_pk_fp8_f32(w0 * bfl(a[u_].x) + w1 * bfl(bq[u_].x) + w2 * bfl(cq[u_].x), w0 * bfh(a[u_].x) + w1 * bfh(bq[u_].x) + w2 * bfh(cq[u_].x), o0, false); \
                        o0 = __builtin_amdgcn_cvt_pk_fp8_f32(w0 * bfl(a[u_].y) + w1 * bfl(bq[u_].y) + w2 * bfl(cq[u_].y), w0 * bfh(a[u_].y) + w1 * bfh(bq[u_].y) + w2 * bfh(cq[u_].y), o0, true); \
                        o1 = __builtin_amdgcn_cvt_pk_fp8_f32(w0 * bfl(a[u_].z) + w1 * bfl(bq[u_].z) + w2 * bfl(cq[u_].z), w0 * bfh(a[u_].z) + w1 * bfh(bq[u_].z) + w2 * bfh(cq[u_].z), o1, false); \
                        o1 = __builtin_amdgcn_cvt_pk_fp8_f32(w0 * bfl(a[u_].w) + w1 * bfl(bq[u_].w) + w2 * bfl(cq[u_].w), w0 * bfh(a[u_].w) + w1 * bfh(bq[u_].w) + w2 * bfh(cq[u_].w), o1, true); \
                        v2u o; o.x = o0; o.y = o1; *(GAS v2u*)(OA + (size_t)t * 256 + ch * 8) = o;
#define LC_LOAD(u_, i_) { const int t = (i_) >> 5, ch = (i_) & 31, hs = ch >> 3; l0[u_] = LSE[(size_t)t * 4 + hs]; l1[u_] = LSE[(size_t)T * 4 + (size_t)t * 4 + hs]; l2[u_] = LSE[(size_t)2 * T * 4 + (size_t)t * 4 + hs]; \
                        a[u_] = *(const GAS v4u*)(OAG + (size_t)t * 256 + ch * 8); bq[u_] = *(const GAS v4u*)(OAG + (size_t)T * 256 + (size_t)t * 256 + ch * 8); cq[u_] = *(const GAS v4u*)(OAG + (size_t)2 * T * 256 + (size_t)t * 256 + ch * 8); }
            { int prev_pm = -1; pg8::Unit uu;
              for (int iu = 0; S.next(iu, uu); ++iu) { if (uu.pm == prev_pm) continue; prev_pm = uu.pm;
                for (int j0 = tid; j0 < 256 * 32; j0 += 4 * NWAVES * 64) {
                    float l0[4], l1[4], l2[4]; v4u a[4], bq[4], cq[4];
#pragma unroll
                    for (int u = 0; u < 4; ++u) LC_LOAD(u, uu.pm * (256 * 32) + j0 + u * (NWAVES * 64))
#pragma unroll
                    for (int u = 0; u < 4; ++u) { const int i = uu.pm * (256 * 32) + j0 + u * (NWAVES * 64); const int t = i >> 5, ch = i & 31; LC_ITEM_W(u) }
                } }
              asm volatile("s_waitcnt vmcnt(0)" ::: "memory"); __syncthreads(); }
#undef LC_ITEM_W
#undef LC_LOAD
            { pg8::Gemm g{(const bf16*)OA, (const bf16*)(WBRA + (size_t)l * D * 256), 128}; pg8::EpiMergeA E{GATE, MERGED}; pg8::gemm_phase_f8<pg8::EpiMergeA, pg8::StaticOrder>(L, g, S, E, wave); }
            { pg8::Gemm g{(const bf16*)OB, (const bf16*)(WBRB + (size_t)l * D * D), D / 2}; pg8::EpiMergeB<true> E{GATE, MERGED, M8}; pg8::gemm_phase_f8<pg8::EpiMergeB<true>, pg8::StaticOrder>(L, g, S, E, wave); }
        }
        if (VK(5)) SEAM(P + 3);
        if (KIND(6) && IN(P + 4) && VK(6)) { PH_BEGIN();
            pg8::Gemm g{(const bf16*)M8, (const bf16*)(WOUT + (size_t)l * D * D), D / 2}; pg8::StaticOrder S; S.init(T, D, G, bx);
            pg8::EpiOut E{l == 0 ? x_in : nullptr, l == 0 ? nullptr : X, X, MOD + (size_t)l * NB * 6144 + 2 * 1024};
            pg8::gemm_phase_f8<pg8::EpiOut, pg8::StaticOrder>(L, g, S, E, wave);
        }
        if (VK(6)) SEAM(P + 4);
        if (KIND(7) && IN(P + 5) && VK(7)) { PH_BEGIN();
            LAS int* hist = (LAS int*)(L + LDSCTL_OFF + 256);
            for (int vb = bx; vb < 256; vb += G) {
                if (tid < NE) hist[tid] = 0;
                __syncthreads();
                {
                    const int tt = 8 * vb + wave; const int r0 = tt * 16; const int b = r0 >> 12; const int i = lane & 15, kb = lane >> 4;
                    const char* wsrc = (const char*)(WRHI + (size_t)(l * NB + b) * 65536) + lane * 16;
#pragma unroll
                    for (int j = 0; j < 16; ++j) __builtin_amdgcn_global_load_lds((const unsigned*)(wsrc + (wave * 16 + j) * 1024), (LAS unsigned*)(L + (wave * 16 + j) * 1024), 16, 0, 0);
                    LAS float* modl = (LAS float*)(L + LDSCTL_OFF + 1024);
                    if (tid < 256) { const float* md = MOD + ((size_t)l * NB + b) * 6144; const int k4 = tid * 4;
                        *(LAS f32x4*)(modl + k4) = *(const GAS f32x4*)(norm2_g + l * D + k4) * (*(const GAS f32x4*)(md + 4 * 1024 + k4) + 1.0f); *(LAS f32x4*)(modl + 1024 + k4) = *(const GAS f32x4*)(md + 3 * 1024 + k4); }
                    const bf16* xp = X + (size_t)(r0 + i) * D + 16 * kb;
                    v4u xw[32];
#pragma unroll
                    for (int s = 0; s < 32; ++s) xw[s] = *(const GAS v4u*)(xp + 64 * (s >> 1) + 8 * (s & 1));
                    asm volatile("s_waitcnt vmcnt(0)" ::: "memory");
                    __syncthreads();
                    f32x4 acc0 = (f32x4){0.f, 0.f, 0.f, 0.f}, acc1 = acc0; float ss = 0.f;
                    bf16x8 wq[2][4];
#define RT_LDW(buf, s_) _Pragma("unroll") for (int f = 0; f < 4; ++f) wq[buf][f] = *(const LAS bf16x8*)(L + (s_) * 4096 + f * 1024 + lane * 16)
                    RT_LDW(0, 0);
#pragma unroll
                    for (int s = 0; s < 32; ++s) {
                        if (s < 31) { RT_LDW((s + 1) & 1, s + 1); }
                        { const float a0 = bfl(xw[s].x), a1 = bfh(xw[s].x), a2 = bfl(xw[s].y), a3 = bfh(xw[s].y), a4 = bfl(xw[s].z), a5 = bfh(xw[s].z), a6 = bfl(xw[s].w), a7 = bfh(xw[s].w);
                          ss += (a0 * a0 + a1 * a1) + (a2 * a2 + a3 * a3) + (a4 * a4 + a5 * a5) + (a6 * a6 + a7 * a7); }
                        const bf16x8 ahv = __builtin_bit_cast(bf16x8, xw[s]);
                        acc0 = __builtin_amdgcn_mfma_f32_16x16x32_bf16(wq[s & 1][0], ahv, acc0, 0, 0, 0); acc1 = __builtin_amdgcn_mfma_f32_16x16x32_bf16(wq[s & 1][2], ahv, acc1, 0, 0, 0);
                        acc0 = __builtin_amdgcn_mfma_f32_16x16x32_bf16(wq[s & 1][1], ahv, acc0, 0, 0, 0); acc1 = __builtin_amdgcn_mfma_f32_16x16x32_bf16(wq[s & 1][3], ahv, acc1, 0, 0, 0);
                        __builtin_amdgcn_sched_barrier(0);
                    }
#undef RT_LDW
                    ss = xsum<16>(ss); ss = xsum<32>(ss);
                    const float rs = rsqrtf(ss * (1.0f / D) + EPS);
#pragma unroll
                    for (int sp = 0; sp < 16; ++sp) { const int cb0 = 64 * sp + 16 * kb; v4u o;
                        int mo = 16 * kb; asm volatile("" : "+v"(mo) : "v"(rs));
                        const LAS float* mq = modl + mo + 64 * sp;
#pragma unroll
                        for (int q4 = 0; q4 < 4; ++q4) { const f32x4 a1 = *(const LAS f32x4*)(mq + 4 * q4), a0 = *(const LAS f32x4*)(mq + 1024 + 4 * q4);
                            const v4u xq = xw[2 * sp + (q4 >> 1)]; unsigned u0 = (q4 & 1) ? xq.z : xq.x, u1 = (q4 & 1) ? xq.w : xq.y;
                            asm volatile("" : "+v"(u0), "+v"(u1));
                            const f32x4 y = ((f32x4){bfl(u0), bfh(u0), bfl(u1), bfh(u1)} * rs) * a1 + a0;
                            unsigned w = 0; w = __builtin_amdgcn_cvt_pk_fp8_f32(y.x, y.y, w, false); w = __builtin_amdgcn_cvt_pk_fp8_f32(y.z, y.w, w, true); o[q4] = w; }
                        *(GAS v4u*)(H8 + (size_t)(r0 + i) * D + cb0) = o; }
                    float v[8]; const float* rc = RC0 + (l * NB + b) * NE;
#pragma unroll
                    for (int r = 0; r < 4; ++r) { v[r] = rs * acc0[r] + rc[4 * kb + r]; v[4 + r] = rs * acc1[r] + rc[16 + 4 * kb + r]; }
                    float tv[4]; int ti[4];
#pragma unroll
                    for (int k = 0; k < 4; ++k) { float best = v[0]; int br = 0;
#pragma unroll
                        for (int r = 1; r < 8; ++r) if (v[r] > best) { best = v[r]; br = r; }
#pragma unroll
                        for (int r = 0; r < 8; ++r) v[r] = (r == br) ? -INFINITY : v[r];
                        tv[k] = best; ti[k] = (br & 3) + 16 * (br >> 2) + 4 * kb; }
#pragma unroll
                    for (int round = 0; round < 2; ++round) {
                        float bv[8]; int bi[8];
#pragma unroll
                        for (int k = 0; k < 4; ++k) { bv[k] = tv[k]; bi[k] = ti[k];
                            if (round == 0) { bv[4 + k] = __int_as_float(__builtin_amdgcn_ds_swizzle(__float_as_int(tv[k]), 0x1f | (16 << 10))); bi[4 + k] = __builtin_amdgcn_ds_swizzle(ti[k], 0x1f | (16 << 10)); }
                            else { bv[4 + k] = xget32(tv[k], lane >> 5); bi[4 + k] = xget32(ti[k], lane >> 5); } }
#pragma unroll
                        for (int k = 0; k < 4; ++k) { float best = bv[0]; int bq = 0, sel = bi[0];
#pragma unroll
                            for (int r = 1; r < 8; ++r) if (bv[r] > best || (bv[r] == best && bi[r] < sel)) { best = bv[r]; bq = r; sel = bi[r]; }
#pragma unroll
                            for (int r = 0; r < 8; ++r) bv[r] = (r == bq) ? -INFINITY : bv[r];
                            tv[k] = best; ti[k] = sel; }
                    }
                    float rw[4] = {0.f, 0.f, 0.f, 0.f};
                    if (kb == 0) {
                        const float e1 = __expf(tv[1] - tv[0]), e2 = __expf(tv[2] - tv[0]), e3 = __expf(tv[3] - tv[0]); const float inv = 1.0f / (1.0f + e1 + e2 + e3);
                        rw[0] = inv; rw[1] = e1 * inv; rw[2] = e2 * inv; rw[3] = e3 * inv;
#pragma unroll
                        for (int k = 0; k < 4; ++k) atomicAdd((int*)&hist[ti[k]], 1);
                    }
                    __syncthreads();
                    if (tid < NE) { const int hv = hist[tid]; hist[32 + tid] = hv ? __hip_atomic_fetch_add(CNT + l * NE + tid, hv, RLX_AGENT) : 0; hist[64 + tid] = 0; }
                    __syncthreads();
                    if (kb == 0) { const int tok = r0 + i; i32x4 sl;
#pragma unroll
                        for (int k = 0; k < 4; ++k) { const int e = ti[k]; const int idx = hist[32 + e] + atomicAdd((int*)&hist[64 + e], 1);
                            sl[k] = (e << 20) | idx; ROWTOK2[(size_t)e * T + idx] = tok; ROWW2[(size_t)e * T + idx] = rw[k]; }
                        *(GAS i32x4*)(SLOT + (size_t)tok * 4) = sl; }
                }
                __syncthreads();
            }
        }
        if (VK(7)) SEAM(P + 5);
        if (KIND(9) && IN(P + 7) && VK(9)) { PH_BEGIN();
            LAS int* et_l = (LAS int*)(L + LDSCTL_OFF + 256); LAS int* te_l = (LAS int*)(L + LDSCTL_OFF + 1024);
            if (tid < NE) et_l[tid] = __hip_atomic_load(CNT + l * NE + tid, RLX_AGENT);
            __syncthreads();
            if (tid < NE) { int ft = 0; for (int e = 0; e < tid; ++e) ft += (et_l[e] + 255) >> 8; et_l[32 + tid] = ft; if (tid == NE - 1) et_l[64] = ft + ((et_l[tid] + 255) >> 8); }
            __syncthreads();
            const int nmt = __builtin_amdgcn_readfirstlane(et_l[64]);
            for (int mt = tid; mt < nmt; mt += NWAVES * 64) { int e = 0;
#pragma unroll 8
                for (int q = 1; q < NE; ++q) if (et_l[32 + q] <= mt) e = q;
                te_l[mt] = e; }
            __syncthreads();
            LAS unsigned short* rt_l = (LAS unsigned short*)(L + LDSCTL_OFF + 4096);
            for (int q = tid; q < GU_MAXU * 256; q += NWAVES * 64) { const long Lu = (long)(q >> 8) * G + vcu;
                if (Lu < (long)nmt * 8) { const int mt = (int)(Lu >> 3), e = te_l[mt]; const int loc = (mt - et_l[32 + e]) * 256 + (q & 255); rt_l[q] = loc < et_l[e] ? (unsigned short)ROWTOK2[(size_t)e * T + loc] : (unsigned short)0; } }
            __syncthreads();
            pg8::Gemm g{(const bf16*)H8, (const bf16*)(WGU + (size_t)l * NE * 2048 * D), D / 2}; pg8::MoeOrder S{te_l, nmt * 8, 8, G, vcu};
            pg8::EpiGU8 E{b_gate_up + (size_t)l * NE * 2048, ACT};
            pg8::gemm_phase_f8<pg8::EpiGU8, pg8::MoeOrder, true>(L, g, S, E, wave, rt_l);
        }
        if (VK(9)) SEAM(P + 7);
        if (KIND(10) && IN(P + 8) && VK(10)) { PH_BEGIN();
            LAS int* et_l = (LAS int*)(L + LDSCTL_OFF + 256); LAS int* te_l = (LAS int*)(L + LDSCTL_OFF + 1024);
            if (tid < NE) et_l[tid] = __hip_atomic_load(CNT + l * NE + tid, RLX_AGENT);
            __syncthreads();
            if (tid < NE) { int ft = 0; for (int e = 0; e < tid; ++e) ft += (et_l[e] + 255) >> 8; et_l[32 + tid] = ft; if (tid == NE - 1) et_l[64] = ft + ((et_l[tid] + 255) >> 8); }
            __syncthreads();
            const int nmt = __builtin_amdgcn_readfirstlane(et_l[64]);
            for (int mt = tid; mt < nmt; mt += NWAVES * 64) { int e = 0;
#pragma unroll 8
                for (int q = 1; q < NE; ++q) if (et_l[32 + q] <= mt) e = q;
                te_l[mt] = e; }
            __syncthreads();
            pg8::Gemm g{(const bf16*)ACT, (const bf16*)(WDN + (size_t)l * NE * D * D), D / 2}; pg8::MoeOrder S{te_l, nmt * 4, 4, G, vcu, 1};
            pg8::EpiDN8 E{b_down + (size_t)l * NE * D, ROWW2, et_l + 32, YB};
            pg8::gemm_phase_f8<pg8::EpiDN8, pg8::MoeOrder>(L, g, S, E, wave);
        }
        if (VK(10)) SEAM(P + 8);
        if (KIND(11) && IN(P + 9) && VK(11)) { PH_BEGIN();
            const bool lastl = (l == DEPTH - 1);
            bf16* Xw = virt ? (bf16*)(ws + WS_R) : X; bf16* Hw = virt ? (bf16*)(ws + WS_R + 128 * MiB) : H;
            int frow_v = 0;
            { const int cn = lane < NE ? __hip_atomic_load(CNT + l * NE + (lane & 31), RLX_AGENT) : 0; const int tiles = (cn + 255) >> 8; int run = 0;
#pragma unroll
              for (int e = 0; e < NE; ++e) { if (lane == e) frow_v = run * 256; run += __builtin_amdgcn_readlane(tiles, e); } }
            for (int rg = gw; rg < T / 16; rg += NGW) { const int mb = rg * 16, b = mb >> 12; const int c = 16 * lane;
                const int myslot = __hip_atomic_load(SLOT + (size_t)mb * 4 + lane, RLX_AGENT);
                f32x4 g2v[4], gna[4], a0v[4];
                { const float* g2 = MOD + ((size_t)l * NB + b) * 6144 + 5 * 1024; const float* md = MOD + ((size_t)(lastl ? l : l + 1) * NB + b) * 6144; const float* gn = lastl ? final_g : norm1_g + (l + 1) * D;
#pragma unroll
                  for (int j = 0; j < 4; ++j) { g2v[j] = *(const GAS f32x4*)(g2 + c + 4 * j); gna[j] = *(const GAS f32x4*)(gn + c + 4 * j); a0v[j] = (f32x4){0.f, 0.f, 0.f, 0.f};
                      if (!lastl) { gna[j] = gna[j] * (*(const GAS f32x4*)(md + 1024 + c + 4 * j) + 1.0f); a0v[j] = *(const GAS f32x4*)(md + c + 4 * j); } } }
                v4u xa[2][2][2], yy[2][2][4];
#define CMB_LOAD(buf, it) _Pragma("unroll") for (int q = 0; q < 2; ++q) { const size_t row_ = (size_t)(mb + 2 * (it) + q); xa[buf][q][0] = *(const GAS v4u*)(X + row_ * D + c); xa[buf][q][1] = *(const GAS v4u*)(X + row_ * D + c + 8); \
                    _Pragma("unroll") for (int k = 0; k < 4; ++k) { const int sv_ = __builtin_amdgcn_readlane(myslot, (2 * (it) + q) * 4 + k); const int sl_ = __builtin_amdgcn_readlane(frow_v, sv_ >> 20) + (sv_ & 0xFFFFF); yy[buf][q][k] = *(const GAS v4u*)(YB + (size_t)sl_ * D + c); } }
                CMB_LOAD(0, 0)
#pragma unroll
                for (int it = 0; it < 8; ++it) { const int cb = it & 1; const int m0 = mb + 2 * it;
                    if (it < 7) { CMB_LOAD(cb ^ 1, it + 1) }
                    f32x4 v[2][4];
#pragma unroll
                    for (int q = 0; q < 2; ++q) { const v4u wa = xa[cb][q][0], wb = xa[cb][q][1];
                        v[q][0] = (f32x4){bfl(wa.x), bfh(wa.x), bfl(wa.y), bfh(wa.y)}; v[q][1] = (f32x4){bfl(wa.z), bfh(wa.z), bfl(wa.w), bfh(wa.w)};
                        v[q][2] = (f32x4){bfl(wb.x), bfh(wb.x), bfl(wb.y), bfh(wb.y)}; v[q][3] = (f32x4){bfl(wb.z), bfh(wb.z), bfl(wb.w), bfh(wb.w)}; }
                    float s[2] = {0.f, 0.f};
#pragma unroll
                    for (int q = 0; q < 2; ++q)
#pragma unroll
                        for (int j = 0; j < 4; ++j) { f32x4 ys = (f32x4){0.f, 0.f, 0.f, 0.f};
#pragma unroll
                            for (int k = 0; k < 4; ++k) { const unsigned w = yy[cb][q][k][j];
                                const auto lo = __builtin_amdgcn_cvt_pk_f32_fp8((int)w, false), hi2 = __builtin_amdgcn_cvt_pk_f32_fp8((int)w, true);
                                ys.x += lo[0]; ys.y += lo[1]; ys.z += hi2[0]; ys.w += hi2[1]; }
                            v[q][j] = v[q][j] + g2v[j] * ys;
                            s[q] += (v[q][j].x * v[q][j].x + v[q][j].y * v[q][j].y) + (v[q][j].z * v[q][j].z + v[q][j].w * v[q][j].w); }
                    if (!lastl) {
#pragma unroll
                        for (int q = 0; q < 2; ++q) { v4u wa, wb; wa.x = pg8::cvt_pk_bf16(v[q][0].x, v[q][0].y); wa.y = pg8::cvt_pk_bf16(v[q][0].z, v[q][0].w); wa.z = pg8::cvt_pk_bf16(v[q][1].x, v[q][1].y); wa.w = pg8::cvt_pk_bf16(v[q][1].z, v[q][1].w);
                            wb.x = pg8::cvt_pk_bf16(v[q][2].x, v[q][2].y); wb.y = pg8::cvt_pk_bf16(v[q][2].z, v[q][2].w); wb.z = pg8::cvt_pk_bf16(v[q][3].x, v[q][3].y); wb.w = pg8::cvt_pk_bf16(v[q][3].z, v[q][3].w);
                            *(GAS v4u*)(Xw + (size_t)(m0 + q) * D + c) = wa; *(GAS v4u*)(Xw + (size_t)(m0 + q) * D + c + 8) = wb; } }
                    const float rs0 = rsqrtf(wave_sum(s[0]) * (1.0f / D) + EPS), rs1 = rsqrtf(wave_sum(s[1]) * (1.0f / D) + EPS);
                    if (!lastl) {
                        v4u h0, h1;
#pragma unroll
                        for (int j = 0; j < 4; ++j) {
                            const f32x4 y0 = (v[0][j] * rs0) * gna[j] + a0v[j], y1 = (v[1][j] * rs1) * gna[j] + a0v[j];
                            unsigned w0 = 0, w1 = 0;
                            w0 = __builtin_amdgcn_cvt_pk_fp8_f32(y0.x, y0.y, w0, false); w0 = __builtin_amdgcn_cvt_pk_fp8_f32(y0.z, y0.w, w0, true);
                            w1 = __builtin_amdgcn_cvt_pk_fp8_f32(y1.x, y1.y, w1, false); w1 = __builtin_amdgcn_cvt_pk_fp8_f32(y1.z, y1.w, w1, true);
                            h0[j] = w0; h1[j] = w1; }
                        *(GAS v4u*)((unsigned char*)Hw + (size_t)m0 * D + c) = h0; *(GAS v4u*)((unsigned char*)Hw + (size_t)(m0 + 1) * D + c) = h1;
                    } else {
#pragma unroll
                        for (int j = 0; j < 4; ++j) {
                            *(GAS f32x4*)(ap->out + (size_t)m0 * D + c + 4 * j) = v[0][j] * rs0 * gna[j]; *(GAS f32x4*)(ap->out + (size_t)(m0 + 1) * D + c + 4 * j) = v[1][j] * rs1 * gna[j]; }
                    }
                }
#undef CMB_LOAD
            }
        }
        if (VK(11)) SEAM(P + 9);
        if (virt) { PH_BEGIN();
            for (int m = 2 * gw; m < T; m += 2 * NGW) { const int b = m >> 12; const float* md = MOD + (size_t)b * 6144; norm_rows2_f8(x_in + (size_t)m * D, norm1_g, md + 1024, md, (unsigned char*)H + (size_t)m * D, lane); }
            xcd_barrier(bar); }
    }
#undef IN
#undef SEAM
}

extern "C" void kernel_launch(void* const* d_in, const int* in_sizes, int n_in, void* d_out, int out_size, void* d_ws, size_t ws_size, hipStream_t stream) {
    static int grid = 0;
    if (grid == 0) {
        if (n_in != 20 || in_sizes[0] != T * D || out_size != T * D || ws_size < WS_END) { fprintf(stderr, "kernel_launch: unexpected shapes (n_in %d, in0 %d, out %d, ws %zu < %zu); nothing launched\n", n_in, n_in > 0 ? in_sizes[0] : -1, out_size, ws_size, (size_t)WS_END); grid = -1; return; }
        int dev = 0, cus = 0, per_cu = 0;
        if (hipGetDevice(&dev) != hipSuccess || hipDeviceGetAttribute(&cus, hipDeviceAttributeMultiprocessorCount, dev) != hipSuccess) { grid = -1; return; }
        if (hipFuncSetAttribute((const void*)mk_fwd, hipFuncAttributeMaxDynamicSharedMemorySize, LDS_BYTES) != hipSuccess) { fprintf(stderr, "kernel_launch: hipFuncSetAttribute failed\n"); grid = -1; return; }
        if (hipOccupancyMaxActiveBlocksPerMultiprocessor(&per_cu, (const void*)mk_fwd, NWAVES * 64, LDS_BYTES) != hipSuccess || per_cu < 1)
            fprintf(stderr, "kernel_launch: note: occupancy query reports %d workgroups per CU\n", per_cu);
        (void)hipGetLastError();
        grid = cus < 256 ? cus : 256;
        if (grid != 256) fprintf(stderr, "kernel_launch: %d CUs; this kernel's unit deals assume 256\n", grid);
    }
    if (grid < 0) return;
    if (hipMemsetAsync((char*)d_ws + WS_CTL, 0, CTL_ZERO_BYTES, stream) != hipSuccess) { fprintf(stderr, "kernel_launch: memset failed\n"); return; }
    Args a{};
    for (int i = 0; i < 20; ++i) a.in[i] = (const float*)d_in[i];
    a.out = (float*)d_out; a.ws = (unsigned char*)d_ws; a.pad = 0;
#if MK_PER_PHASE
    for (int p = 0; p < N_PHASES; ++p) { a.ph_lo = p; a.ph_hi = p + 1; a.li = 0; hipLaunchKernelGGL(mk_fwd, dim3(grid), dim3(NWAVES * 64), LDS_BYTES, stream, a); }
#else
    a.ph_lo = 0; a.ph_hi = N_PHASES; a.li = 0;
    hipLaunchKernelGGL(mk_fwd, dim3(grid), dim3(NWAVES * 64), LDS_BYTES, stream, a);
#endif
    const hipError_t le = hipPeekAtLastError();
    if (le != hipSuccess) fprintf(stderr, "kernel_launch: launch failed: %s\n", hipGetErrorName(le));
}
```
